# Optimizing an MI355X kernel written in HIP

```python
import jax, jax.numpy as jnp
from jax import lax
import numpy as np

D_MODEL = 1024
BATCH = 4
SEQ = 8192
DEPTH = 1

M_HEADS = 4
M_QK_DIM = 256
M_V_DIM = 512
M_CHUNK = 128
CONV_W = 4
G_HEADS = 8
G_K_DIM = 128
G_V_DIM = 128
G_CHUNK = 64
P_HEADS = 8
P_NKEYS = 128
P_EXPERTS = P_NKEYS * P_NKEYS
P_QDIM = 256
P_TOPK = 16
P_TOKEN_BLOCK = 128
EPS = 1e-6

M_QK = M_HEADS * M_QK_DIM
M_V = M_HEADS * M_V_DIM
G_K = G_HEADS * G_K_DIM
G_V = G_HEADS * G_V_DIM
IN_SPLITS = (2 * M_QK, M_V, M_V, M_HEADS, M_HEADS, G_K, G_V, G_K, G_V, D_MODEL, D_MODEL)
IN_COLS = sum(IN_SPLITS)
MF_OFFSET = 2 * M_QK + 2 * M_V + M_HEADS

kernel_name = "hybrid_mlstm_hgrn2_peer_block"


def rmsnorm(x, g):
    xf = x.astype(jnp.float32)
    y = xf * lax.rsqrt(jnp.mean(xf * xf, axis=-1, keepdims=True) + EPS)
    return (y * g.astype(jnp.float32)).astype(x.dtype)


def head_rmsnorm(h, g, n_heads):
    shp = h.shape
    hf = h.astype(jnp.float32).reshape(shp[:-1] + (n_heads, shp[-1] // n_heads))
    hf = hf * lax.rsqrt(jnp.mean(hf * hf, axis=-1, keepdims=True) + EPS)
    return (hf.reshape(shp) * g.astype(jnp.float32)).astype(h.dtype)


def causal_conv(x, w, b):
    S = x.shape[1]
    xp = jnp.pad(x, ((0, 0), (CONV_W - 1, 0), (0, 0)))
    y = b + xp[:, 0:S] * w[0]
    for j in range(1, CONV_W):
        y = y + xp[:, j:j + S] * w[j]
    return y


def to_chunks(t, L):
    B, S, H = t.shape[:3]
    t = t.reshape((B, S // L, L, H) + t.shape[3:])
    return jnp.moveaxis(t, (1, 3), (0, 2))


def from_chunks(t):
    t = jnp.moveaxis(t, (0, 2), (1, 3))
    B, NC, L, H, d = t.shape
    return t.reshape(B, NC * L, H * d)


def mlstm_chunkwise(q, k, v, i_pre, f_pre):
    B, S, H, dk = q.shape
    dv = v.shape[-1]
    L = M_CHUNK
    f32 = jnp.float32
    qc = to_chunks(q.astype(f32) * (dk ** -0.5), L)
    kc = to_chunks(k.astype(f32), L)
    vc = to_chunks(v.astype(f32), L)
    ic = to_chunks(i_pre.astype(f32), L)
    lfc = to_chunks(jax.nn.log_sigmoid(f_pre.astype(f32)), L)
    causal = jnp.tril(jnp.ones((L, L), dtype=bool))

    def step(carry, inp):
        C, n, m = carry
        qb, kb, vb, ib, lfb = inp
        b = jnp.cumsum(lfb, axis=-1)
        dmat = b[..., :, None] - b[..., None, :] + ib[..., None, :]
        dmat = jnp.where(causal, dmat, -jnp.inf)
        inter = b + m[..., None]
        m_t = jnp.maximum(inter, jnp.max(dmat, axis=-1))
        dexp = jnp.exp(dmat - m_t[..., None])
        inter_w = jnp.exp(inter - m_t)
        scores = jnp.einsum('bhtd,bhsd->bhts', qb, kb) * dexp
        num = (jnp.einsum('bhts,bhsv->bhtv', scores, vb)
               + inter_w[..., None] * jnp.einsum('bhtd,bhdv->bhtv', qb, C))
        den = jnp.sum(scores, axis=-1) + inter_w * jnp.einsum('bhtd,bhd->bht', qb, n)
        h = num / jnp.maximum(jnp.abs(den), jnp.exp(-m_t))[..., None]
        m_new = m_t[..., -1]
        w_s = jnp.exp(b[..., -1:] - b + ib - m_new[..., None])
        decay = jnp.exp(b[..., -1] + m - m_new)
        kw = kb * w_s[..., None]
        C_new = decay[..., None, None] * C + jnp.einsum('bhsd,bhsv->bhdv', kw, vb)
        n_new = decay[..., None] * n + jnp.sum(kw, axis=2)
        return (C_new, n_new, m_new), h

    init = (jnp.zeros((B, H, dk, dv), f32), jnp.zeros((B, H, dk), f32), jnp.zeros((B, H), f32))
    _, h = lax.scan(step, init, (qc, kc, vc, ic, lfc))
    return from_chunks(h).astype(q.dtype)


def hgrn2_chunkwise(q, k, log_f, i):
    B, S, H, dk = q.shape
    dv = i.shape[-1]
    L = G_CHUNK
    f32 = jnp.float32
    qc = to_chunks(q.astype(f32), L)
    kc = to_chunks(k.astype(f32), L)
    gc = to_chunks(log_f.astype(f32), L)
    ic = to_chunks(i.astype(f32), L)
    causal = jnp.tril(jnp.ones((L, L), dtype=bool))

    def step(state, inp):
        qb, kb, gb, ib = inp
        cum = jnp.cumsum(gb, axis=2)
        rel = cum[:, :, :, None, :] - cum[:, :, None, :, :]
        rel = jnp.where(causal[:, :, None], rel, -jnp.inf)
        att = jnp.einsum('bhtd,bhsd,bhtsd->bhts', qb, kb, jnp.exp(rel))
        intra = jnp.einsum('bhts,bhsv->bhtv', att, ib)
        inter = jnp.einsum('bhtd,bhdv->bhtv', qb * jnp.exp(cum), state)
        last = cum[:, :, -1:, :]
        state_new = (jnp.exp(last[:, :, 0])[..., None] * state
                     + jnp.einsum('bhsd,bhsv->bhdv', kb * jnp.exp(last - cum), ib))
        return state_new, intra + inter

    init = jnp.zeros((B, H, dk, dv), f32)
    _, o = lax.scan(step, init, (qc, kc, gc, ic))
    return from_chunks(o).astype(q.dtype)


def mixer_block(u, w_in, b_in, conv_w, conv_b, m_head_g, lb, g_head_g, w_br_m, w_br_g, w_out):
    B, S, _ = u.shape
    proj = u @ w_in + b_in
    points = [int(c) for c in np.cumsum(IN_SPLITS)[:-1]]
    mqk, mv, mo, mi, mf, gf, gi, gq, gg, a_m, a_g = jnp.split(proj, points, axis=-1)

    qk = jax.nn.silu(causal_conv(mqk, conv_w, conv_b))
    mq = qk[..., :M_QK].reshape(B, S, M_HEADS, M_QK_DIM)
    mk = qk[..., M_QK:].reshape(B, S, M_HEADS, M_QK_DIM)
    h_m = mlstm_chunkwise(mq, mk, mv.reshape(B, S, M_HEADS, M_V_DIM), mi, mf)
    y_m = jax.nn.sigmoid(mo) * head_rmsnorm(h_m, m_head_g, M_HEADS)

    lb_h = lb.astype(jnp.float32).reshape(G_HEADS, G_K_DIM)
    f = lb_h + (1.0 - lb_h) * jax.nn.sigmoid(gf.astype(jnp.float32).reshape(B, S, G_HEADS, G_K_DIM))
    o_g = hgrn2_chunkwise(jax.nn.silu(gq).reshape(B, S, G_HEADS, G_K_DIM), 1.0 - f, jnp.log(f),
                          gi.reshape(B, S, G_HEADS, G_V_DIM))
    y_g = head_rmsnorm(o_g, g_head_g, G_HEADS) * jax.nn.silu(gg)

    z = jax.nn.sigmoid(a_m) * (y_m @ w_br_m) + jax.nn.sigmoid(a_g) * (y_g @ w_br_g)
    return z @ w_out


def peer_ffn(x, w_pq, sub_keys, u_emb, v_emb):
    B, S, D = x.shape
    T = B * S
    half = P_QDIM // 2

    def block(xb):
        tb = xb.shape[0]
        q = (xb @ w_pq).reshape(tb, P_HEADS, 2, half)
        s = jnp.einsum('thpc,hpnc->thpn', q, sub_keys).astype(jnp.float32)
        sv, si = lax.top_k(s, P_TOPK)
        cand = (sv[:, :, 0, :, None] + sv[:, :, 1, None, :]).reshape(tb, P_HEADS, P_TOPK * P_TOPK)
        cidx = (si[:, :, 0, :, None] * P_NKEYS + si[:, :, 1, None, :]).reshape(tb, P_HEADS, P_TOPK * P_TOPK)
        top_s, pos = lax.top_k(cand, P_TOPK)
        eidx = jnp.take_along_axis(cidx, pos, axis=-1)
        gate = jax.nn.softmax(top_s, axis=-1).astype(xb.dtype)
        act = jax.nn.gelu(jnp.einsum('thkd,td->thk', u_emb[eidx], xb), approximate=False)
        return jnp.einsum('thk,thkd->td', gate * act, v_emb[eidx])

    y = lax.map(block, x.reshape(T // P_TOKEN_BLOCK, P_TOKEN_BLOCK, D))
    return y.reshape(B, S, D)


def setup_inputs(seed: int = 0) -> dict:
    key = jax.random.key(seed)
    ks = jax.random.split(key, 20)

    def nrm(k, shape, scale):
        return jax.random.normal(k, shape, jnp.float32) * scale

    x = nrm(ks[0], (BATCH, SEQ, D_MODEL), 1.0)
    norm1_g = 1.0 + nrm(ks[1], (DEPTH, D_MODEL), 0.02)
    w_in = nrm(ks[2], (DEPTH, D_MODEL, IN_COLS), D_MODEL ** -0.5)
    b_in = nrm(ks[3], (DEPTH, IN_COLS), 0.01)
    b_in = b_in.at[:, MF_OFFSET:MF_OFFSET + M_HEADS].add(jnp.linspace(3.0, 6.0, M_HEADS))
    conv_w = nrm(ks[4], (DEPTH, CONV_W, 2 * M_QK), CONV_W ** -0.5)
    conv_b = nrm(ks[5], (DEPTH, 2 * M_QK), 0.01)
    m_head_g = 1.0 + nrm(ks[6], (DEPTH, M_V), 0.02)
    lb_table = nrm(ks[7], (DEPTH + 1, G_K), 0.1)
    g_head_g = 1.0 + nrm(ks[8], (DEPTH, G_V), 0.02)
    w_br_m = nrm(ks[9], (DEPTH, M_V, D_MODEL), M_V ** -0.5)
    w_br_g = nrm(ks[10], (DEPTH, G_V, D_MODEL), G_V ** -0.5)
    w_out = nrm(ks[11], (DEPTH, D_MODEL, D_MODEL), D_MODEL ** -0.5)
    norm2_g = 1.0 + nrm(ks[12], (DEPTH, D_MODEL), 0.02)
    w_pq = nrm(ks[13], (DEPTH, D_MODEL, P_HEADS * P_QDIM), D_MODEL ** -0.5)
    sub_keys = nrm(ks[14], (DEPTH, P_HEADS, 2, P_NKEYS, P_QDIM // 2), (P_QDIM // 2) ** -0.5)
    u_emb = nrm(ks[15], (DEPTH, P_EXPERTS, D_MODEL), D_MODEL ** -0.5)
    v_emb = nrm(ks[16], (DEPTH, P_EXPERTS, D_MODEL), 0.5)
    final_g = 1.0 + nrm(ks[17], (D_MODEL,), 0.02)
    return {"x": x, "norm1_g": norm1_g, "w_in": w_in, "b_in": b_in, "conv_w": conv_w,
            "conv_b": conv_b, "m_head_g": m_head_g, "lb_table": lb_table, "g_head_g": g_head_g,
            "w_br_m": w_br_m, "w_br_g": w_br_g, "w_out": w_out, "norm2_g": norm2_g,
            "w_pq": w_pq, "sub_keys": sub_keys, "u_emb": u_emb, "v_emb": v_emb, "final_g": final_g}


def reference(x, norm1_g, w_in, b_in, conv_w, conv_b, m_head_g, lb_table, g_head_g,
              w_br_m, w_br_g, w_out, norm2_g, w_pq, sub_keys, u_emb, v_emb, final_g):
    lb_all = jnp.cumsum(jax.nn.softmax(lb_table.astype(jnp.float32), axis=0), axis=0)
    for l in range(DEPTH):
        x = x + mixer_block(rmsnorm(x, norm1_g[l]), w_in[l], b_in[l], conv_w[l], conv_b[l],
                            m_head_g[l], lb_all[l], g_head_g[l], w_br_m[l], w_br_g[l], w_out[l])
        x = x + peer_ffn(rmsnorm(x, norm2_g[l]), w_pq[l], sub_keys[l], u_emb[l], v_emb[l])
    return rmsnorm(x, final_g)
```

```cpp
#define TOPK_REF 1
#include <hip/hip_runtime.h>
#include <hip/hip_cooperative_groups.h>
#include <cstdio>
#include <cstdint>
namespace cg = cooperative_groups;

#define LAS __attribute__((address_space(3)))
typedef unsigned short bf16_t;
typedef short bf16x8 __attribute__((ext_vector_type(8)));
typedef float f32x4 __attribute__((ext_vector_type(4)));
typedef float f32x2 __attribute__((ext_vector_type(2)));
typedef unsigned u32x4 __attribute__((ext_vector_type(4)));
typedef unsigned u32x2 __attribute__((ext_vector_type(2)));

constexpr int D = 1024, BATCH = 4, SEQ = 8192, T = BATCH * SEQ;
constexpr int IN_COLS = 12296, NP = 12288;
constexpr int RT = 16384, NROUND = 2;
constexpr int N1 = 7168, N2 = 5120;
constexpr float EPS = 1e-6f;
constexpr int NWAVES = 8, NTHR = 512;

constexpr size_t MiB = 1u << 20;
constexpr size_t WS_CTL = 0;
constexpr size_t WS_WIN = 1 * MiB;
constexpr size_t WS_WM = 25 * MiB;
constexpr size_t WS_WG = 29 * MiB;
constexpr size_t WS_WO = 31 * MiB;
constexpr size_t WS_WPQ = 33 * MiB;
constexpr size_t WS_SK = 37 * MiB;
constexpr size_t WS_BIASP = 37 * MiB + 512 * 1024;
constexpr size_t WS_LB = WS_BIASP + 64 * 1024;
constexpr size_t WS_GATES = 38 * MiB;
constexpr size_t WS_MPREV = 39 * MiB;
constexpr size_t WS_DEN = 40 * MiB;
constexpr size_t WS_MT = 40 * MiB + 512 * 1024;
constexpr size_t WS_HGDEC = 41 * MiB;
constexpr size_t WS_MDEC = 43 * MiB;
constexpr size_t WS_XN = 44 * MiB;
constexpr size_t WS_QKPRE = 108 * MiB;
constexpr size_t WS_V = 172 * MiB;
constexpr size_t WS_GFLOG = 236 * MiB;
constexpr size_t WS_GI = 268 * MiB;
constexpr size_t WS_GQ = 300 * MiB;
constexpr size_t WS_S = 332 * MiB;
constexpr size_t WS_QT = 348 * MiB;
constexpr size_t WS_KWT = 380 * MiB;
constexpr size_t WS_ATT = 412 * MiB;
constexpr size_t WS_QTG = 428 * MiB;
constexpr size_t WS_KENDT = 460 * MiB;
constexpr size_t WS_SIGO = 332 * MiB;
constexpr size_t WS_SGG = 396 * MiB;
constexpr size_t WS_SAM = 428 * MiB;
constexpr size_t WS_SAG = 460 * MiB;
constexpr size_t WS_END = 492 * MiB;
constexpr size_t WS_QP = 108 * MiB;
constexpr size_t WS_UB = 236 * MiB;
constexpr size_t WS_VB = 268 * MiB;
constexpr size_t WS_EIDX = 300 * MiB;
constexpr size_t WS_GATE = 316 * MiB;

constexpr int LDS_BYTES = 147456;

__device__ __forceinline__ unsigned f2bf(float f) { unsigned u = __builtin_bit_cast(unsigned, f); return (u + 0x7fffu + ((u >> 16) & 1u)) >> 16; }
__device__ __forceinline__ unsigned pk2(float lo, float hi) { return f2bf(lo) | (f2bf(hi) << 16); }
__device__ __forceinline__ float bf_lo(unsigned w) { return __builtin_bit_cast(float, w << 16); }
__device__ __forceinline__ float bf_hi(unsigned w) { return __builtin_bit_cast(float, w & 0xffff0000u); }
__device__ __forceinline__ float bf2f(bf16_t h) { return __builtin_bit_cast(float, ((unsigned)h) << 16); }
__device__ __forceinline__ float shx(float v, int o, int lane) { return __builtin_bit_cast(float, __builtin_amdgcn_ds_bpermute((lane ^ o) << 2, __builtin_bit_cast(int, v))); }
__device__ __forceinline__ float shup(float v, int o, int lane) { return __builtin_bit_cast(float, __builtin_amdgcn_ds_bpermute(((lane - o) & 63) << 2, __builtin_bit_cast(int, v))); }
__device__ __forceinline__ float rdlane(float v, int l) { return __builtin_bit_cast(float, __builtin_amdgcn_readlane(__builtin_bit_cast(int, v), l)); }
__device__ __forceinline__ float wave_sum(float v, int lane) {
#pragma unroll
    for (int o = 1; o < 64; o <<= 1) v += shx(v, o, lane);
    return v;
}
__device__ __forceinline__ float sigmoidf_(float x) { return 1.0f / (1.0f + __expf(-x)); }
__device__ __forceinline__ float siluf_(float x) { return x / (1.0f + __expf(-x)); }
#define LDS_WAIT() asm volatile("s_waitcnt lgkmcnt(0)" ::: "memory")
__device__ __forceinline__ int tid_() { int t = threadIdx.x; asm volatile("" : "+v"(t)); return t; }

struct Args {
    const float* x; const float* norm1_g; const float* w_in; const float* b_in; const float* conv_w; const float* conv_b;
    const float* m_head_g; const float* lb_table; const float* g_head_g; const float* w_br_m; const float* w_br_g; const float* w_out;
    const float* norm2_g; const float* w_pq; const float* sub_keys; const float* u_emb; const float* v_emb; const float* final_g;
    float* out; unsigned char* ws;
};

namespace pg8 {
constexpr int BM = 256, BK = 64, HALF = 128, HTB = HALF * BK * 2, STAGE_BYTES = 8 * HTB, NXCD = 8, WGM = 8;
__host__ __device__ __forceinline__ int lds_byte(int r, int c) { const int st = (r >> 4) * 2 + (c >> 5), rr = r & 15, cc = c & 31, ob = rr * 64 + cc * 2; return st * 1024 + (ob ^ (((ob >> 9) & 1) << 5)); }
__host__ __device__ __forceinline__ void stage_rc(int b, int& R, int& C) { const int st = b / 1024, sb = b % 1024, swz = sb ^ (((sb >> 9) & 1) << 5); R = (st >> 1) * 16 + swz / 64; C = (st & 1) * 32 + (swz % 64) / 2; }
__host__ __device__ __forceinline__ int perm32(int rho) { const int n = rho >> 4, i = rho & 15; return 8 * (i >> 2) + 4 * n + (i & 3); }
struct Unit { int pm, pn; };
struct Gemm { const bf16_t* A; const bf16_t* Bt; int M, N, K; };
struct StaticOrder {
    int nM, nN, nwg, G, c;
    __host__ __device__ void init(int M, int N, int G_, int c_) { nM = M / BM; nN = N / BM; nwg = nM * nN; G = G_; c = c_; }
    __host__ __device__ bool next(int i, Unit& u) const {
        const long L = (long)i * G + c; if (L >= nwg) return false;
        int wgid = (int)L; { const int q = nwg / NXCD, r = nwg % NXCD, xcd = wgid % NXCD, off = wgid / NXCD; wgid = (xcd < r ? xcd * (q + 1) : r * (q + 1) + (xcd - r) * q) + off; }
        const int nig = WGM * nN, gid = wgid / nig, fm = gid * WGM, gsz = (nM - fm) < WGM ? (nM - fm) : WGM;
        u.pm = fm + ((wgid % nig) % gsz); u.pn = (wgid % nig) / gsz; return true;
    }
    __device__ __forceinline__ void a_ready(const Unit&) const {}
    __device__ __forceinline__ void done(const Unit&) const {}
};

template <class Epi, class Sched, bool ALIGN_EPI = false, bool SP2 = false>
__device__ __forceinline__ void gemm_phase(LAS unsigned char* lds, const Gemm g, const Sched& S, const Epi& E) {
    const int tid = tid_(), wid = __builtin_amdgcn_readfirstlane(tid >> 6), lane = tid & 63, wr = wid >> 2, wc = wid & 3, fr = lane & 15, fq = lane >> 4;
    const int K = g.K, nt = K / BK;
    unsigned voffA[2], voffB[2];
#pragma unroll
    for (int i = 0; i < 2; ++i) { int R, C; stage_rc(tid * 16 + i * 8192, R, C); const int Rb = Epi::PERM ? ((R & ~31) + perm32(R & 31)) : R;
        voffA[i] = (unsigned)(R * K + C) * 2u; voffB[i] = (unsigned)(Rb * K + C) * 2u; }
    const size_t kstep = (size_t)(BK * 2);
    const size_t hstep = (size_t)HALF * K * 2;
    const size_t tstep = 2 * hstep;
    const unsigned ldsw = (unsigned)wid * 1024u;
    const int aoff = lds_byte(wr * 64 + fr, fq * 8), boff = lds_byte(wc * 32 + fr, fq * 8);
#define PG8_SA(b, h) (((b) * 2 + (h)) * HTB)
#define PG8_SB(b, h) ((4 + (b) * 2 + (h)) * HTB)
#define PG8_STAGE(bufoff, gbase, voff) do { _Pragma("unroll") for (int _i = 0; _i < 2; ++_i) \
        __builtin_amdgcn_global_load_lds((const unsigned*)((const char*)(gbase) + (voff)[_i]), (LAS unsigned*)(lds + (bufoff) + ldsw + _i * 8192), 16, 0, 0); } while (0)
#define PG8_LDA(dst, b, h) do { _Pragma("unroll") for (int m = 0; m < 4; ++m) _Pragma("unroll") for (int k = 0; k < 2; ++k) dst[m][k] = *(const LAS bf16x8*)(lds + PG8_SA(b, h) + aoff + m * 2048 + k * 1024); } while (0)
#define PG8_LDB(dst, b, h) do { _Pragma("unroll") for (int n = 0; n < 2; ++n) _Pragma("unroll") for (int k = 0; k < 2; ++k) dst[n][k] = *(const LAS bf16x8*)(lds + PG8_SB(b, h) + boff + n * 2048 + k * 1024); } while (0)
#define PG8_MMA(ai, bj, At, Bt) do { __builtin_amdgcn_s_setprio(1); _Pragma("unroll") for (int m = 0; m < 4; ++m) _Pragma("unroll") for (int n = 0; n < 2; ++n) _Pragma("unroll") for (int k = 0; k < 2; ++k) \
        acc[ai][bj][m][n] = __builtin_amdgcn_mfma_f32_16x16x32_bf16(Bt[n][k], At[m][k], acc[ai][bj][m][n], 0, 0, 0); __builtin_amdgcn_s_setprio(0); } while (0)
#define PG8_WAIT_V(n) asm volatile("s_waitcnt vmcnt(" #n ")" ::: "memory")
#define PG8_WAIT_L(n) asm volatile("s_waitcnt lgkmcnt(" #n ")" ::: "memory")
#define PG8_BAR __builtin_amdgcn_s_barrier()
#define PG8_SCHED __builtin_amdgcn_sched_barrier(0)
    Unit cur, nxt; int ui = 0;
    if (!S.next(0, cur)) return;
    f32x4 acc[2][2][4][2];
#pragma unroll
    for (int a = 0; a < 2; ++a)
#pragma unroll
        for (int b = 0; b < 2; ++b)
#pragma unroll
            for (int m = 0; m < 4; ++m)
#pragma unroll
                for (int n = 0; n < 2; ++n) acc[a][b][m][n] = (f32x4){0.f, 0.f, 0.f, 0.f};
    bf16x8 At[4][2], B0[2][2], B1[2][2];
    const char* cA = (const char*)g.A + (size_t)cur.pm * tstep; const char* cB = (const char*)g.Bt + (size_t)cur.pn * tstep;
    S.a_ready(cur);
    if constexpr (SP2) {
        PG8_STAGE(PG8_SB(0, 0), cB, voffB); PG8_STAGE(PG8_SB(0, 1), cB + hstep, voffB); PG8_STAGE(PG8_SA(0, 0), cA, voffA); PG8_STAGE(PG8_SA(0, 1), cA + hstep, voffA);
        if (wr == 1) PG8_BAR;
        PG8_WAIT_V(2); PG8_BAR;
        PG8_STAGE(PG8_SB(1, 0), cB + kstep, voffB); PG8_STAGE(PG8_SA(1, 0), cA + kstep, voffA); PG8_STAGE(PG8_SB(1, 1), cB + hstep + kstep, voffB);
        PG8_WAIT_V(6); PG8_BAR;
    } else {
        PG8_STAGE(PG8_SB(0, 0), cB, voffB); PG8_STAGE(PG8_SA(0, 0), cA, voffA); PG8_STAGE(PG8_SB(0, 1), cB + hstep, voffB); PG8_STAGE(PG8_SA(0, 1), cA + hstep, voffA);
        if (wr == 1) PG8_BAR;
        PG8_WAIT_V(4); PG8_BAR;
        PG8_STAGE(PG8_SB(1, 0), cB + kstep, voffB); PG8_STAGE(PG8_SA(1, 0), cA + kstep, voffA); PG8_STAGE(PG8_SB(1, 1), cB + hstep + kstep, voffB);
        PG8_WAIT_V(6); PG8_BAR;
    }
    for (;;) {
        const bool has_next = S.next(ui + 1, nxt);
        const char* nA = has_next ? (const char*)g.A + (size_t)nxt.pm * tstep : cA; const char* nB = has_next ? (const char*)g.Bt + (size_t)nxt.pn * tstep : cB;
        for (int t = 0; t < nt; t += 2) {
            const bool last = (t == nt - 2);
            const char* a1 = cA + (size_t)(t + 1) * kstep;
            const char* a2 = last ? nA : cA + (size_t)(t + 2) * kstep; const char* b2 = last ? nB : cB + (size_t)(t + 2) * kstep;
            const char* a3 = a2 + kstep; const char* b3 = b2 + kstep;
            if (last && has_next) S.a_ready(nxt);
            if constexpr (SP2) {
            PG8_LDB(B0, 0, 0); PG8_LDB(B1, 0, 1); PG8_SCHED; PG8_LDA(At, 0, 0); PG8_STAGE(PG8_SA(1, 1), a1 + hstep, voffA);
            PG8_WAIT_V(8); PG8_WAIT_L(0); PG8_BAR; PG8_MMA(0, 0, At, B0); PG8_MMA(0, 1, At, B1); PG8_BAR; PG8_SCHED;
            PG8_LDA(At, 0, 1); PG8_STAGE(PG8_SB(0, 0), b2, voffB); PG8_STAGE(PG8_SB(0, 1), b2 + hstep, voffB); PG8_STAGE(PG8_SA(0, 0), a2, voffA);
            PG8_WAIT_V(8); PG8_WAIT_L(0); PG8_BAR; PG8_MMA(1, 0, At, B0); PG8_MMA(1, 1, At, B1); PG8_BAR; PG8_SCHED;
            PG8_LDB(B0, 1, 0); PG8_LDB(B1, 1, 1); PG8_SCHED; PG8_LDA(At, 1, 0); PG8_STAGE(PG8_SA(0, 1), a2 + hstep, voffA);
            PG8_WAIT_V(8); PG8_WAIT_L(0); PG8_BAR; PG8_MMA(0, 0, At, B0); PG8_MMA(0, 1, At, B1); PG8_BAR; PG8_SCHED;
            PG8_LDA(At, 1, 1); PG8_STAGE(PG8_SB(1, 0), b3, voffB); PG8_STAGE(PG8_SB(1, 1), b3 + hstep, voffB); PG8_STAGE(PG8_SA(1, 0), a3, voffA);
            PG8_WAIT_V(8); PG8_WAIT_L(0); PG8_BAR; PG8_MMA(1, 0, At, B0); PG8_MMA(1, 1, At, B1); PG8_BAR; PG8_SCHED;
            } else {
            PG8_LDB(B0, 0, 0); PG8_SCHED; PG8_LDA(At, 0, 0); PG8_STAGE(PG8_SA(1, 1), a1 + hstep, voffA);
            PG8_WAIT_L(8); PG8_BAR; PG8_WAIT_L(0); PG8_MMA(0, 0, At, B0); PG8_BAR; PG8_SCHED;
            PG8_LDB(B1, 0, 1); PG8_STAGE(PG8_SB(0, 0), b2, voffB);
            PG8_BAR; PG8_WAIT_L(0); PG8_MMA(0, 1, At, B1); PG8_BAR;
            PG8_LDA(At, 0, 1); PG8_STAGE(PG8_SA(0, 0), a2, voffA);
            PG8_BAR; PG8_WAIT_L(0); PG8_MMA(1, 0, At, B0); PG8_BAR; PG8_SCHED;
            PG8_STAGE(PG8_SB(0, 1), b2 + hstep, voffB);
            PG8_WAIT_V(6); PG8_BAR; PG8_MMA(1, 1, At, B1); PG8_BAR;
            PG8_LDB(B0, 1, 0); PG8_SCHED; PG8_LDA(At, 1, 0); PG8_STAGE(PG8_SA(0, 1), a2 + hstep, voffA);
            PG8_WAIT_L(8); PG8_BAR; PG8_WAIT_L(0); PG8_MMA(0, 0, At, B0); PG8_BAR; PG8_SCHED;
            PG8_LDB(B1, 1, 1); PG8_STAGE(PG8_SB(1, 0), b3, voffB);
            PG8_BAR; PG8_WAIT_L(0); PG8_MMA(0, 1, At, B1); PG8_BAR;
            PG8_LDA(At, 1, 1); PG8_STAGE(PG8_SA(1, 0), a3, voffA);
            PG8_BAR; PG8_WAIT_L(0); PG8_MMA(1, 0, At, B0); PG8_BAR; PG8_SCHED;
            PG8_STAGE(PG8_SB(1, 1), b3 + hstep, voffB);
            PG8_WAIT_V(6); PG8_BAR; PG8_MMA(1, 1, At, B1); PG8_BAR;
            }
        }
        if constexpr (ALIGN_EPI) { if (wr == 0) PG8_BAR; }
        E(acc, cur, wr, wc, fr, fq);
        if (!has_next) break;
#pragma unroll
        for (int a = 0; a < 2; ++a)
#pragma unroll
            for (int b = 0; b < 2; ++b)
#pragma unroll
                for (int m = 0; m < 4; ++m)
#pragma unroll
                    for (int n = 0; n < 2; ++n) acc[a][b][m][n] = (f32x4){0.f, 0.f, 0.f, 0.f};
        cur = nxt; cA = nA; cB = nB; ++ui;
        if constexpr (ALIGN_EPI) { if (wr == 1) PG8_BAR; }
    }
    PG8_WAIT_V(0);
    if constexpr (!ALIGN_EPI) { if (wr == 0) PG8_BAR; }
    PG8_BAR;
#undef PG8_SA
#undef PG8_SB
#undef PG8_STAGE
#undef PG8_LDA
#undef PG8_LDB
#undef PG8_MMA
#undef PG8_WAIT_V
#undef PG8_WAIT_L
#undef PG8_BAR
#undef PG8_SCHED
}
}

struct EpiPtrs {
    const float* biasp; const float* lb; const float* x; float* out; unsigned char* ws; int round;
};
template <int MODE> struct EpiX {
    static constexpr bool PERM = true, AFTER_DRAIN = false;
    EpiPtrs P;
    __device__ __forceinline__ void operator()(const f32x4 (&acc)[2][2][4][2], const pg8::Unit& u, int wr, int wc, int fr, int fq) const {
        const int row0 = u.pm * 256 + wr * 64 + fr;
        const int colt = u.pn * 256 + wc * 32 + 8 * fq;
        unsigned char* ws = P.ws;
        bf16_t* dst = nullptr; int ld = 0, coff = 0, act = 0; const float* bias = nullptr;
        if (MODE == 1) {
            bias = P.biasp;
            if (u.pn < 8) { dst = (bf16_t*)(ws + WS_QKPRE); ld = 2048; coff = 0; act = 0; }
            else if (u.pn < 16) { dst = (bf16_t*)(ws + WS_V); ld = 2048; coff = 2048; act = 0; }
            else if (u.pn < 20) { dst = (bf16_t*)(ws + WS_GFLOG); ld = 1024; coff = 4096; act = 3; }
            else if (u.pn < 24) { dst = (bf16_t*)(ws + WS_GI); ld = 1024; coff = 5120; act = 0; }
            else { dst = (bf16_t*)(ws + WS_GQ); ld = 1024; coff = 6144; act = 2; }
        } else if (MODE == 2) {
            bias = P.biasp + N1;
            if (u.pn < 8) { dst = (bf16_t*)(ws + WS_SIGO); ld = 2048; coff = 0; act = 1; }
            else if (u.pn < 12) { dst = (bf16_t*)(ws + WS_SGG); ld = 1024; coff = 2048; act = 2; }
            else if (u.pn < 16) { dst = (bf16_t*)(ws + WS_SAM); ld = 1024; coff = 3072; act = 1; }
            else { dst = (bf16_t*)(ws + WS_SAG); ld = 1024; coff = 4096; act = 1; }
        } else if (MODE == 6) { dst = (bf16_t*)(ws + WS_QP); ld = 2048; coff = 0; act = 0; }
#pragma unroll
        for (int bj = 0; bj < 2; ++bj) {
            const int col = colt + bj * 128;
            f32x4 b0 = (f32x4){0.f, 0.f, 0.f, 0.f}, b1 = b0, l0 = b0, l1 = b0;
            if (MODE == 1 || MODE == 2) { b0 = *(const f32x4*)(bias + col); b1 = *(const f32x4*)(bias + col + 4); }
            if (MODE == 1) { if (act == 3) { l0 = *(const f32x4*)(P.lb + (col - coff)); l1 = *(const f32x4*)(P.lb + (col - coff) + 4); } }
#pragma unroll
            for (int ai = 0; ai < 2; ++ai)
#pragma unroll
                for (int m = 0; m < 4; ++m) {
                    const int row = row0 + ai * 128 + m * 16;
                    f32x4 v0 = acc[ai][bj][m][0] + b0, v1 = acc[ai][bj][m][1] + b1;
                    if (MODE == 1 || MODE == 2 || MODE == 6) {
                        if (act == 1) {
#pragma unroll
                            for (int j = 0; j < 4; ++j) { v0[j] = sigmoidf_(v0[j]); v1[j] = sigmoidf_(v1[j]); }
                        } else if (act == 2) {
#pragma unroll
                            for (int j = 0; j < 4; ++j) { v0[j] = siluf_(v0[j]); v1[j] = siluf_(v1[j]); }
                        } else if (act == 3) {
#pragma unroll
                            for (int j = 0; j < 4; ++j) { v0[j] = __logf(l0[j] + (1.0f - l0[j]) * sigmoidf_(v0[j])); v1[j] = __logf(l1[j] + (1.0f - l1[j]) * sigmoidf_(v1[j])); }
                        }
                        u32x4 w; w.x = pk2(v0[0], v0[1]); w.y = pk2(v0[2], v0[3]); w.z = pk2(v1[0], v1[1]); w.w = pk2(v1[2], v1[3]);
                        *(u32x4*)(dst + (size_t)row * ld + (col - coff)) = w;
                    } else if (MODE == 3) {
                        const u32x4 g = *(const u32x4*)((const bf16_t*)(ws + WS_SAM) + (size_t)row * 1024 + col);
                        float* o = P.out + ((size_t)P.round * RT + row) * 1024 + col;
                        f32x4 r0, r1;
                        r0[0] = v0[0] * bf_lo(g.x); r0[1] = v0[1] * bf_hi(g.x); r0[2] = v0[2] * bf_lo(g.y); r0[3] = v0[3] * bf_hi(g.y);
                        r1[0] = v1[0] * bf_lo(g.z); r1[1] = v1[1] * bf_hi(g.z); r1[2] = v1[2] * bf_lo(g.w); r1[3] = v1[3] * bf_hi(g.w);
                        *(f32x4*)o = r0; *(f32x4*)(o + 4) = r1;
                    } else if (MODE == 4) {
                        const u32x4 g = *(const u32x4*)((const bf16_t*)(ws + WS_SAG) + (size_t)row * 1024 + col);
                        const float* zp = P.out + ((size_t)P.round * RT + row) * 1024 + col;
                        const f32x4 p0 = *(const f32x4*)zp, p1 = *(const f32x4*)(zp + 4);
                        f32x4 r0, r1;
                        r0[0] = p0[0] + v0[0] * bf_lo(g.x); r0[1] = p0[1] + v0[1] * bf_hi(g.x); r0[2] = p0[2] + v0[2] * bf_lo(g.y); r0[3] = p0[3] + v0[3] * bf_hi(g.y);
                        r1[0] = p1[0] + v1[0] * bf_lo(g.z); r1[1] = p1[1] + v1[1] * bf_hi(g.z); r1[2] = p1[2] + v1[2] * bf_lo(g.w); r1[3] = p1[3] + v1[3] * bf_hi(g.w);
                        u32x4 w; w.x = pk2(r0[0], r0[1]); w.y = pk2(r0[2], r0[3]); w.z = pk2(r1[0], r1[1]); w.w = pk2(r1[2], r1[3]);
                        *(u32x4*)((bf16_t*)(ws + WS_GFLOG) + (size_t)row * 1024 + col) = w;
                    } else if (MODE == 5) {
                        const size_t off = ((size_t)P.round * RT + row) * 1024 + col;
                        const f32x4 x0 = *(const f32x4*)(P.x + off), x1 = *(const f32x4*)(P.x + off + 4);
                        *(f32x4*)(P.out + off) = x0 + v0; *(f32x4*)(P.out + off + 4) = x1 + v1;
                    }
                }
        }
    }
};

__device__ __forceinline__ void p0_transpose_item(const float* W, int ldw, int K, int k0, int scol, bf16_t* WT, int drow, LAS float* scr, int lane) {
#pragma unroll 8
    for (int i = 0; i < 32; ++i) { const int kk = 2 * i + (lane >> 5); scr[kk * 33 + (lane & 31)] = W[(size_t)(k0 + kk) * ldw + scol + (lane & 31)]; }
    LDS_WAIT(); asm volatile("" ::: "memory");
    const int c = lane & 7;
#pragma unroll
    for (int j = 0; j < 4; ++j) { const int n = (lane >> 3) + 8 * j; const LAS float* s = scr + (8 * c) * 33 + n;
        u32x4 o; o.x = pk2(s[0 * 33], s[1 * 33]); o.y = pk2(s[2 * 33], s[3 * 33]); o.z = pk2(s[4 * 33], s[5 * 33]); o.w = pk2(s[6 * 33], s[7 * 33]);
        *(u32x4*)(WT + (size_t)(drow + n) * K + k0 + 8 * c) = o; }
    LDS_WAIT(); asm volatile("" ::: "memory");
}
__device__ __forceinline__ int win_src_col(int n) {
    if (n < 4096) return n;
    if (n < 7168) return n - 4096 + 6152;
    if (n < 9216) return n - 7168 + 4096;
    return n - 9216 + 9224;
}

__device__ __forceinline__ void phase_p0(const Args& a, LAS unsigned char* lds, int vcu, int G) {
    const int tid = tid_(), lane = tid & 63, wave = tid >> 6;
    const int gw = vcu * NWAVES + wave, NGW = G * NWAVES;
    unsigned char* ws = a.ws;
    LAS float* scr = (LAS float*)(lds + wave * 16384);
    constexpr int I_IN = 16 * 384, I_M = 32 * 32, I_G = 16 * 32, I_O = 16 * 32, I_PQ = 16 * 64;
    constexpr int NITEMS = I_IN + I_M + I_G + I_O + I_PQ;
    for (int it = gw; it < NITEMS; it += NGW) {
        int r = it;
        if (r < I_IN) { const int kb = r / 384, nb = r % 384; p0_transpose_item(a.w_in, IN_COLS, 1024, kb * 64, win_src_col(nb * 32), (bf16_t*)(ws + WS_WIN), nb * 32, scr, lane); continue; } r -= I_IN;
        if (r < I_M) { const int kb = r / 32, nb = r % 32; p0_transpose_item(a.w_br_m, 1024, 2048, kb * 64, nb * 32, (bf16_t*)(ws + WS_WM), nb * 32, scr, lane); continue; } r -= I_M;
        if (r < I_G) { const int kb = r / 32, nb = r % 32; p0_transpose_item(a.w_br_g, 1024, 1024, kb * 64, nb * 32, (bf16_t*)(ws + WS_WG), nb * 32, scr, lane); continue; } r -= I_G;
        if (r < I_O) { const int kb = r / 32, nb = r % 32; p0_transpose_item(a.w_out, 1024, 1024, kb * 64, nb * 32, (bf16_t*)(ws + WS_WO), nb * 32, scr, lane); continue; } r -= I_O;
        { const int kb = r / 64, nb = r % 64; p0_transpose_item(a.w_pq, 2048, 1024, kb * 64, nb * 32, (bf16_t*)(ws + WS_WPQ), nb * 32, scr, lane); }
    }
    const int gt = vcu * NTHR + tid, NGT = G * NTHR;
    for (int i = gt; i < NP; i += NGT) ((float*)(ws + WS_BIASP))[i] = a.b_in[win_src_col(i)];
    for (int i = gt; i < 1024; i += NGT) { const float t0 = a.lb_table[i], t1 = a.lb_table[1024 + i]; ((float*)(ws + WS_LB))[i] = 1.0f / (1.0f + __expf(t1 - t0)); }
    for (int i = gt; i < 8 * 2 * 128 * 128 / 4; i += NGT) { const f32x4 v = ((const f32x4*)a.sub_keys)[i]; u32x2 o; o.x = pk2(v[0], v[1]); o.y = pk2(v[2], v[3]); ((u32x2*)(ws + WS_SK))[i] = o; }
    f32x4 g1[4];
#pragma unroll
    for (int j = 0; j < 4; ++j) g1[j] = ((const f32x4*)a.norm1_g)[64 * j + lane];
    for (int m = gw; m < T; m += NGW) {
        const f32x4* xr = (const f32x4*)(a.x + (size_t)m * D) + lane;
        f32x4 v[4]; float s = 0.f;
#pragma unroll
        for (int j = 0; j < 4; ++j) { v[j] = xr[64 * j]; s += (v[j][0] * v[j][0] + v[j][1] * v[j][1]) + (v[j][2] * v[j][2] + v[j][3] * v[j][3]); }
        const float rstd = rsqrtf(wave_sum(s, lane) * (1.f / D) + EPS);
        unsigned long long* o8 = (unsigned long long*)((bf16_t*)(ws + WS_XN) + (size_t)m * D) + lane;
        float ga[8];
#pragma unroll
        for (int q = 0; q < 8; ++q) ga[q] = 0.f;
#pragma unroll
        for (int j = 0; j < 4; ++j) {
            v[j] = v[j] * rstd * g1[j];
            o8[64 * j] = (unsigned long long)pk2(v[j][0], v[j][1]) | ((unsigned long long)pk2(v[j][2], v[j][3]) << 32);
#pragma unroll
            for (int e = 0; e < 4; ++e) {
                const int k = 256 * j + 4 * lane + e;
                const f32x4 w0 = *(const f32x4*)(a.w_in + (size_t)k * IN_COLS + 6144), w1 = *(const f32x4*)(a.w_in + (size_t)k * IN_COLS + 6148);
                ga[0] += v[j][e] * w0[0]; ga[1] += v[j][e] * w0[1]; ga[2] += v[j][e] * w0[2]; ga[3] += v[j][e] * w0[3];
                ga[4] += v[j][e] * w1[0]; ga[5] += v[j][e] * w1[1]; ga[6] += v[j][e] * w1[2]; ga[7] += v[j][e] * w1[3];
            }
        }
#pragma unroll
        for (int q = 0; q < 8; ++q) ga[q] = wave_sum(ga[q], lane);
        if (lane < 8) { float r = ga[0];
#pragma unroll
            for (int q = 1; q < 8; ++q) r = (lane == q) ? ga[q] : r;
            ((float*)(ws + WS_GATES))[(size_t)m * 8 + lane] = r + a.b_in[6144 + lane]; }
    }
}


__device__ __forceinline__ float logsigf_(float x) { return fminf(x, 0.f) - log1pf(__expf(-fabsf(x))); }
#define MFMA16(a, b, c) __builtin_amdgcn_mfma_f32_16x16x32_bf16((a), (b), (c), 0, 0, 0)
__device__ __forceinline__ bf16x8 lfrag(const LAS unsigned char* base, int pitch, int row, int k0, int fq) { return *(const LAS bf16x8*)(base + row * pitch + (k0 + 8 * fq) * 2); }
__device__ __forceinline__ bf16x8 gfrag(const bf16_t* base, int ld, int row, int k0, int fq) { return *(const bf16x8*)(base + (size_t)row * ld + k0 + 8 * fq); }

__device__ __forceinline__ void mscan_pair(const Args& a, int round, int p, int lane) {
    const int bl = p >> 2, h = p & 3, b = round * 2 + bl;
    const float* g = (const float*)(a.ws + WS_GATES) + ((size_t)b * SEQ + (size_t)lane * 128) * 8;
    float bsum = 0.f, gm = -INFINITY;
    for (int s = 0; s < 128; ++s) { const float ip = g[s * 8 + h], fp = g[s * 8 + 4 + h]; bsum += logsigf_(fp); gm = fmaxf(gm, ip - bsum); }
    float mprev = 0.f, mine = 0.f;
    for (int c = 0; c < 64; ++c) {
        const float bc = rdlane(bsum, c), gc = rdlane(gm, c);
        if (lane == c) mine = mprev; mprev = bc + fmaxf(mprev, gc); }
    ((float*)(a.ws + WS_MPREV))[(round * 8 + p) * 64 + lane] = mine;
}

constexpr int PQ_PITCH = 528, PS_PITCH = 272;
__device__ __forceinline__ void mlstm_pre_item(const Args& a, LAS unsigned char* lds, int round, int item) {
    const int tid = tid_(), lane = tid & 63, wave = __builtin_amdgcn_readfirstlane(tid >> 6), fr = lane & 15, fq = lane >> 4;
    const int p = item >> 6, c = item & 63, bl = p >> 2, h = p & 3, b = round * 2 + bl;
    const int tl0 = bl * SEQ + c * 128; const size_t tg0 = (size_t)b * SEQ + c * 128;
    unsigned char* ws = a.ws;
    LAS unsigned char* QL = lds; LAS unsigned char* KL = lds + 67584;
    LAS float* AS = (LAS float*)(lds + 135168); LAS float* MS = AS + 128; LAS float* SC = AS + 256;
    if (wave == 0) {
        const float mprev = ((const float*)(ws + WS_MPREV))[(round * 8 + p) * 64 + c];
        const float* g = (const float*)(ws + WS_GATES) + (tg0 + 2 * lane) * 8;
        const float ip0 = g[h], fp0 = g[4 + h], ip1 = g[8 + h], fp1 = g[12 + h];
        const float lf0 = logsigf_(fp0), lf1 = logsigf_(fp1), pp = lf0 + lf1;
        float incl = pp;
#pragma unroll
        for (int o = 1; o < 64; o <<= 1) { const float t = shup(incl, o, lane); if (lane >= o) incl += t; }
        const float excl = incl - pp, b0 = excl + lf0, b1 = incl;
        const float a0 = ip0 - b0, a1 = ip1 - b1;
        float inclm = fmaxf(a0, a1);
#pragma unroll
        for (int o = 1; o < 64; o <<= 1) { const float t = shup(inclm, o, lane); if (lane >= o) inclm = fmaxf(inclm, t); }
        float exclm = shup(inclm, 1, lane); if (lane == 0) exclm = -INFINITY;
        const float M0 = fmaxf(mprev, fmaxf(exclm, a0)), M1 = fmaxf(mprev, inclm);
        AS[2 * lane] = a0; AS[2 * lane + 1] = a1; MS[2 * lane] = M0; MS[2 * lane + 1] = M1;
        float* mt = (float*)(ws + WS_MT) + (tg0 + 2 * lane) * 4 + h;
        mt[0] = b0 + M0; mt[4] = b1 + M1;
        const float Mlast = rdlane(M1, 63);
        if (lane == 0) { SC[0] = mprev; SC[1] = Mlast; ((float*)(ws + WS_MDEC))[item] = __expf(mprev - Mlast); }
    }
    {
        const int cgp = tid & 63, strip = tid >> 6;
        const int col = (cgp < 32) ? (h * 256 + cgp * 8) : (1024 + h * 256 + (cgp - 32) * 8);
        float w[4][8], bb[8];
#pragma unroll
        for (int j = 0; j < 4; ++j) { const f32x4 w0 = *(const f32x4*)(a.conv_w + j * 2048 + col), w1 = *(const f32x4*)(a.conv_w + j * 2048 + col + 4);
#pragma unroll
            for (int e = 0; e < 4; ++e) { w[j][e] = w0[e]; w[j][4 + e] = w1[e]; } }
        { const f32x4 b0 = *(const f32x4*)(a.conv_b + col), b1 = *(const f32x4*)(a.conv_b + col + 4);
#pragma unroll
            for (int e = 0; e < 4; ++e) { bb[e] = b0[e]; bb[4 + e] = b1[e]; } }
        const bf16_t* src = (const bf16_t*)(ws + WS_QKPRE) + (size_t)(tl0 + 16 * strip) * 2048 + col;
        const float qs = (cgp < 32) ? 0.0625f : 1.0f;
        LAS unsigned char* dstt = ((cgp < 32) ? QL : KL) + (cgp & 31) * 16;
#pragma unroll 1
        for (int half = 0; half < 2; ++half) {
            u32x4 xr[11];
#pragma unroll
            for (int r = 0; r < 11; ++r) {
                const int sl = c * 128 + 16 * strip + 8 * half + r - 3;
                xr[r] = (sl >= 0) ? *(const u32x4*)(src + (ptrdiff_t)(8 * half + r - 3) * 2048) : (u32x4){0u, 0u, 0u, 0u};
            }
#pragma unroll
            for (int r = 0; r < 8; ++r) {
                float y[8];
#pragma unroll
                for (int e = 0; e < 8; ++e) y[e] = bb[e];
#pragma unroll
                for (int j = 0; j < 4; ++j) { const u32x4 xv = xr[r + j];
                    y[0] += w[j][0] * bf_lo(xv.x); y[1] += w[j][1] * bf_hi(xv.x); y[2] += w[j][2] * bf_lo(xv.y); y[3] += w[j][3] * bf_hi(xv.y);
                    y[4] += w[j][4] * bf_lo(xv.z); y[5] += w[j][5] * bf_hi(xv.z); y[6] += w[j][6] * bf_lo(xv.w); y[7] += w[j][7] * bf_hi(xv.w); }
#pragma unroll
                for (int e = 0; e < 8; ++e) y[e] = siluf_(y[e]) * qs;
                u32x4 o; o.x = pk2(y[0], y[1]); o.y = pk2(y[2], y[3]); o.z = pk2(y[4], y[5]); o.w = pk2(y[6], y[7]);
                *(LAS u32x4*)(dstt + (16 * strip + 8 * half + r) * PQ_PITCH) = o;
            }
        }
    }
    __syncthreads();
    const float mprev = SC[0], Mlast = SC[1];
    {
        bf16_t* Sg = (bf16_t*)(ws + WS_S) + (size_t)item * 128 * 128;
        const int t = wave * 16 + fr; const float Mt = MS[t];
        for (int st = 0; st < 8; ++st) {
            u32x2 o = (u32x2){0u, 0u};
            if (st <= wave) {
                f32x4 acc = (f32x4){0.f, 0.f, 0.f, 0.f};
#pragma unroll
                for (int ks = 0; ks < 8; ++ks) acc = MFMA16(lfrag(KL, PQ_PITCH, st * 16 + fr, ks * 32, fq), lfrag(QL, PQ_PITCH, wave * 16 + fr, ks * 32, fq), acc);
                float v[4];
#pragma unroll
                for (int j = 0; j < 4; ++j) { const int s = st * 16 + 4 * fq + j; v[j] = (s <= t) ? acc[j] * __expf(AS[s] - Mt) : 0.f; }
                o.x = pk2(v[0], v[1]); o.y = pk2(v[2], v[3]);
            }
            *(u32x2*)(Sg + (size_t)t * 128 + st * 16 + 4 * fq) = o;
        }
    }
    {
        bf16_t* Qg = (bf16_t*)(ws + WS_QT) + (size_t)item * 128 * 256;
#pragma unroll
        for (int i = 0; i < 8; ++i) { const int idx = tid + 512 * i, t = idx >> 5, ch = idx & 31;
            const u32x4 v = *(const LAS u32x4*)(QL + t * PQ_PITCH + ch * 16); const float s = __expf(mprev - MS[t]);
            u32x4 o; o.x = pk2(bf_lo(v.x) * s, bf_hi(v.x) * s); o.y = pk2(bf_lo(v.y) * s, bf_hi(v.y) * s); o.z = pk2(bf_lo(v.z) * s, bf_hi(v.z) * s); o.w = pk2(bf_lo(v.w) * s, bf_hi(v.w) * s);
            *(u32x4*)(Qg + (size_t)t * 256 + ch * 8) = o; }
    }
    {
        bf16_t* Kg = (bf16_t*)(ws + WS_KWT) + (size_t)item * 256 * 128;
        const int dlo = lane & 15, sglo = lane >> 4;
#pragma unroll
        for (int i = 0; i < 8; ++i) { const int combo = wave * 8 + i, d = (combo >> 2) * 16 + dlo, s0 = ((combo & 3) * 4 + sglo) * 8;
            float v[8];
#pragma unroll
            for (int e = 0; e < 8; ++e) v[e] = bf2f(*(const LAS bf16_t*)(KL + (s0 + e) * PQ_PITCH + d * 2)) * __expf(AS[s0 + e] - Mlast);
            u32x4 o; o.x = pk2(v[0], v[1]); o.y = pk2(v[2], v[3]); o.z = pk2(v[4], v[5]); o.w = pk2(v[6], v[7]);
            *(u32x4*)(Kg + (size_t)d * 128 + s0) = o; }
    }
    __syncthreads();
}

__device__ __forceinline__ void hgrn_pre_item(const Args& a, LAS unsigned char* lds, int round, int item) {
    const int tid = tid_(), lane = tid & 63, wave = __builtin_amdgcn_readfirstlane(tid >> 6), fr = lane & 15, fq = lane >> 4;
    const int p = item >> 7, c = item & 127, bl = p >> 3, h = p & 7;
    const int tl0 = bl * SEQ + c * 64;
    unsigned char* ws = a.ws;
    LAS float* CUM = (LAS float*)lds;
    LAS float* GL = (LAS float*)(lds + 32768);
    LAS unsigned char* QH = lds + 65536;
    LAS unsigned char* KE = lds + 65536 + 64 * PS_PITCH;
    LAS float* QF = (LAS float*)(lds + 65536 + 128 * PS_PITCH);
#pragma unroll
    for (int i = 0; i < 2; ++i) { const int idx = tid + 512 * i, s = idx >> 4, ch = idx & 15;
        const u32x4 gv = *(const u32x4*)((const bf16_t*)(ws + WS_GFLOG) + (size_t)(tl0 + s) * 1024 + h * 128 + ch * 8);
        const u32x4 qv = *(const u32x4*)((const bf16_t*)(ws + WS_GQ) + (size_t)(tl0 + s) * 1024 + h * 128 + ch * 8);
        LAS float* gd = GL + s * 128 + ch * 8; LAS float* qd = QF + s * 128 + ch * 8;
        gd[0] = bf_lo(gv.x); gd[1] = bf_hi(gv.x); gd[2] = bf_lo(gv.y); gd[3] = bf_hi(gv.y); gd[4] = bf_lo(gv.z); gd[5] = bf_hi(gv.z); gd[6] = bf_lo(gv.w); gd[7] = bf_hi(gv.w);
        qd[0] = bf_lo(qv.x); qd[1] = bf_hi(qv.x); qd[2] = bf_lo(qv.y); qd[3] = bf_hi(qv.y); qd[4] = bf_lo(qv.z); qd[5] = bf_hi(qv.z); qd[6] = bf_lo(qv.w); qd[7] = bf_hi(qv.w); }
    __syncthreads();
    if (tid < 128) { float cs = 0.f;
        for (int s = 0; s < 64; ++s) { cs += GL[s * 128 + tid]; CUM[s * 128 + tid] = cs; }
        ((float*)(ws + WS_HGDEC))[(size_t)item * 128 + tid] = __expf(cs); }
    __syncthreads();
    {
        bf16_t* Qg = (bf16_t*)(ws + WS_QTG) + (size_t)item * 64 * 128;
#pragma unroll
        for (int i = 0; i < 2; ++i) { const int idx = tid + 512 * i, s = idx >> 4, ch = idx & 15;
            float qt[8], qh[8], ke[8];
#pragma unroll
            for (int e = 0; e < 8; ++e) { const int d = ch * 8 + e; const float cm = CUM[s * 128 + d], last = CUM[63 * 128 + d], q = QF[s * 128 + d], g = GL[s * 128 + d];
                qt[e] = q * __expf(cm); qh[e] = q * __expf(cm - last); ke[e] = (1.0f - __expf(g)) * __expf(last - cm); }
            u32x4 o; o.x = pk2(qt[0], qt[1]); o.y = pk2(qt[2], qt[3]); o.z = pk2(qt[4], qt[5]); o.w = pk2(qt[6], qt[7]);
            *(u32x4*)(Qg + (size_t)s * 128 + ch * 8) = o;
            o.x = pk2(qh[0], qh[1]); o.y = pk2(qh[2], qh[3]); o.z = pk2(qh[4], qh[5]); o.w = pk2(qh[6], qh[7]);
            *(LAS u32x4*)(QH + s * PS_PITCH + ch * 16) = o;
            o.x = pk2(ke[0], ke[1]); o.y = pk2(ke[2], ke[3]); o.z = pk2(ke[4], ke[5]); o.w = pk2(ke[6], ke[7]);
            *(LAS u32x4*)(KE + s * PS_PITCH + ch * 16) = o; }
    }
    __syncthreads();
    {
        bf16_t* Ag = (bf16_t*)(ws + WS_ATT) + (size_t)item * 64 * 64;
#pragma unroll
        for (int i = 0; i < 2; ++i) { const int tile = wave * 2 + i, tt = tile >> 2, st = tile & 3; const int t = tt * 16 + fr;
            u32x2 o = (u32x2){0u, 0u};
            if (st <= tt) { f32x4 acc = (f32x4){0.f, 0.f, 0.f, 0.f};
#pragma unroll
                for (int ks = 0; ks < 4; ++ks) acc = MFMA16(lfrag(KE, PS_PITCH, st * 16 + fr, ks * 32, fq), lfrag(QH, PS_PITCH, tt * 16 + fr, ks * 32, fq), acc);
                float v[4];
#pragma unroll
                for (int j = 0; j < 4; ++j) { const int s = st * 16 + 4 * fq + j; v[j] = (s <= t) ? acc[j] : 0.f; }
                o.x = pk2(v[0], v[1]); o.y = pk2(v[2], v[3]); }
            *(u32x2*)(Ag + (size_t)t * 64 + st * 16 + 4 * fq) = o; }
    }
    {
        bf16_t* Kg = (bf16_t*)(ws + WS_KENDT) + (size_t)item * 128 * 64;
        const int dlo = lane & 15, sglo = lane >> 4;
#pragma unroll
        for (int i = 0; i < 2; ++i) { const int combo = wave * 2 + i, d = (combo >> 1) * 16 + dlo, s0 = ((combo & 1) * 4 + sglo) * 8;
            unsigned v[8];
#pragma unroll
            for (int e = 0; e < 8; ++e) v[e] = *(const LAS bf16_t*)(KE + (s0 + e) * PS_PITCH + d * 2);
            u32x4 o; o.x = v[0] | (v[1] << 16); o.y = v[2] | (v[3] << 16); o.z = v[4] | (v[5] << 16); o.w = v[6] | (v[7] << 16);
            *(u32x4*)(Kg + (size_t)d * 64 + s0) = o; }
    }
    __syncthreads();
}

__device__ __forceinline__ void mlstm_scan(const Args& a, LAS unsigned char* lds, int round, int p, int sl) {
    const int tid = tid_(), lane = tid & 63, wave = __builtin_amdgcn_readfirstlane(tid >> 6), fr = lane & 15, fq = lane >> 4;
    const int bl = p >> 2, h = p & 3, b = round * 2 + bl;
    unsigned char* ws = a.ws;
    constexpr int VTB = 48 * PS_PITCH, CTB = 48 * PQ_PITCH;
    LAS unsigned char* VT = lds; LAS unsigned char* CT = lds + 2 * VTB;
    for (int i = tid; i < (2 * VTB + 2 * CTB) / 4; i += NTHR) ((LAS unsigned*)lds)[i] = 0u;
    __syncthreads();
    if (tid < 256) { const int bufi = tid >> 7, s = tid & 127; *(LAS bf16_t*)(VT + bufi * VTB + 32 * PS_PITCH + s * 2) = (bf16_t)0x3F80; }
    f32x4 st[2][3];
#pragma unroll
    for (int dt = 0; dt < 2; ++dt)
#pragma unroll
        for (int vt = 0; vt < 3; ++vt) st[dt][vt] = (f32x4){0.f, 0.f, 0.f, 0.f};
    const int vcol = h * 512 + sl * 32;
    for (int c = 0; c < 64; ++c) {
        const int item = p * 64 + c, tl0 = bl * SEQ + c * 128; const size_t tg0 = (size_t)b * SEQ + c * 128;
        LAS unsigned char* vt_ = VT + (c & 1) * VTB; LAS unsigned char* ct_ = CT + (c & 1) * CTB; LAS unsigned char* ctn = CT + ((c + 1) & 1) * CTB;
        {
            const int s = tid >> 2, part = tid & 3;
            const u32x4 v = *(const u32x4*)((const bf16_t*)(ws + WS_V) + (size_t)(tl0 + s) * 2048 + vcol + part * 8);
            LAS unsigned char* d0 = vt_ + (part * 8) * PS_PITCH + s * 2;
            *(LAS bf16_t*)(d0 + 0 * PS_PITCH) = (bf16_t)(v.x & 0xffffu); *(LAS bf16_t*)(d0 + 1 * PS_PITCH) = (bf16_t)(v.x >> 16);
            *(LAS bf16_t*)(d0 + 2 * PS_PITCH) = (bf16_t)(v.y & 0xffffu); *(LAS bf16_t*)(d0 + 3 * PS_PITCH) = (bf16_t)(v.y >> 16);
            *(LAS bf16_t*)(d0 + 4 * PS_PITCH) = (bf16_t)(v.z & 0xffffu); *(LAS bf16_t*)(d0 + 5 * PS_PITCH) = (bf16_t)(v.z >> 16);
            *(LAS bf16_t*)(d0 + 6 * PS_PITCH) = (bf16_t)(v.w & 0xffffu); *(LAS bf16_t*)(d0 + 7 * PS_PITCH) = (bf16_t)(v.w >> 16);
        }
        __syncthreads();
        {
            const bf16_t* Sg = (const bf16_t*)(ws + WS_S) + (size_t)item * 128 * 128;
            const bf16_t* Qg = (const bf16_t*)(ws + WS_QT) + (size_t)item * 128 * 256;
            f32x4 acc[3];
#pragma unroll
            for (int vt = 0; vt < 3; ++vt) acc[vt] = (f32x4){0.f, 0.f, 0.f, 0.f};
#pragma unroll
            for (int ks = 0; ks < 4; ++ks) { const bf16x8 bS = gfrag(Sg, 128, wave * 16 + fr, ks * 32, fq);
#pragma unroll
                for (int vt = 0; vt < 3; ++vt) acc[vt] = MFMA16(lfrag(vt_, PS_PITCH, vt * 16 + fr, ks * 32, fq), bS, acc[vt]); }
#pragma unroll
            for (int ks = 0; ks < 8; ++ks) { const bf16x8 bQ = gfrag(Qg, 256, wave * 16 + fr, ks * 32, fq);
#pragma unroll
                for (int vt = 0; vt < 3; ++vt) acc[vt] = MFMA16(lfrag(ct_, PQ_PITCH, vt * 16 + fr, ks * 32, fq), bQ, acc[vt]); }
            const int t = wave * 16 + fr;
            bf16_t* hn = (bf16_t*)(ws + WS_QKPRE) + (size_t)(tl0 + t) * 2048 + vcol + 4 * fq;
#pragma unroll
            for (int vt = 0; vt < 2; ++vt) { u32x2 o; o.x = pk2(acc[vt][0], acc[vt][1]); o.y = pk2(acc[vt][2], acc[vt][3]); *(u32x2*)(hn + vt * 16) = o; }
            if (sl == 0 && fq == 0) ((float*)(ws + WS_DEN))[(tg0 + t) * 4 + h] = acc[2][0];
        }
        {
            const bf16_t* Kg = (const bf16_t*)(ws + WS_KWT) + (size_t)item * 256 * 128;
            const float dec = ((const float*)(ws + WS_MDEC))[item];
#pragma unroll
            for (int dt = 0; dt < 2; ++dt)
#pragma unroll
                for (int vt = 0; vt < 3; ++vt) st[dt][vt] = st[dt][vt] * dec;
#pragma unroll
            for (int ks = 0; ks < 4; ++ks) {
                bf16x8 bV[3];
#pragma unroll
                for (int vt = 0; vt < 3; ++vt) bV[vt] = lfrag(vt_, PS_PITCH, vt * 16 + fr, ks * 32, fq);
#pragma unroll
                for (int dt = 0; dt < 2; ++dt) { const bf16x8 aK = gfrag(Kg, 128, wave * 32 + dt * 16 + fr, ks * 32, fq);
#pragma unroll
                    for (int vt = 0; vt < 3; ++vt) st[dt][vt] = MFMA16(aK, bV[vt], st[dt][vt]); }
            }
#pragma unroll
            for (int dt = 0; dt < 2; ++dt)
#pragma unroll
                for (int vt = 0; vt < 3; ++vt) { u32x2 o; o.x = pk2(st[dt][vt][0], st[dt][vt][1]); o.y = pk2(st[dt][vt][2], st[dt][vt][3]);
                    *(LAS u32x2*)(ctn + (vt * 16 + fr) * PQ_PITCH + (wave * 32 + dt * 16 + 4 * fq) * 2) = o; }
        }
    }
    __syncthreads();
}

__device__ __forceinline__ void hgrn_scan(const Args& a, LAS unsigned char* lds, int round, int p, int sl) {
    const int tid = tid_(), lane = tid & 63, wave = __builtin_amdgcn_readfirstlane(tid >> 6), fr = lane & 15, fq = lane >> 4;
    const int bl = p >> 3, h = p & 7;
    unsigned char* ws = a.ws;
    constexpr int IP = 144, ITB = 16 * IP, STB = 16 * PS_PITCH;
    LAS unsigned char* IT = lds; LAS unsigned char* ST = lds + 2 * ITB;
    for (int i = tid; i < (2 * ITB + 2 * STB) / 4; i += NTHR) ((LAS unsigned*)lds)[i] = 0u;
    __syncthreads();
    f32x4 st = (f32x4){0.f, 0.f, 0.f, 0.f};
    const int vcol = h * 128 + sl * 16;
    for (int c = 0; c < 128; ++c) {
        const int item = p * 128 + c, tl0 = bl * SEQ + c * 64;
        LAS unsigned char* it_ = IT + (c & 1) * ITB; LAS unsigned char* st_ = ST + (c & 1) * STB; LAS unsigned char* stn = ST + ((c + 1) & 1) * STB;
        if (tid < 128) { const int s = tid >> 1, part = tid & 1;
            const u32x4 v = *(const u32x4*)((const bf16_t*)(ws + WS_GI) + (size_t)(tl0 + s) * 1024 + vcol + part * 8);
            LAS unsigned char* d0 = it_ + (part * 8) * IP + s * 2;
            *(LAS bf16_t*)(d0 + 0 * IP) = (bf16_t)(v.x & 0xffffu); *(LAS bf16_t*)(d0 + 1 * IP) = (bf16_t)(v.x >> 16);
            *(LAS bf16_t*)(d0 + 2 * IP) = (bf16_t)(v.y & 0xffffu); *(LAS bf16_t*)(d0 + 3 * IP) = (bf16_t)(v.y >> 16);
            *(LAS bf16_t*)(d0 + 4 * IP) = (bf16_t)(v.z & 0xffffu); *(LAS bf16_t*)(d0 + 5 * IP) = (bf16_t)(v.z >> 16);
            *(LAS bf16_t*)(d0 + 6 * IP) = (bf16_t)(v.w & 0xffffu); *(LAS bf16_t*)(d0 + 7 * IP) = (bf16_t)(v.w >> 16); }
        __syncthreads();
        if (wave < 4) {
            const bf16_t* Ag = (const bf16_t*)(ws + WS_ATT) + (size_t)item * 64 * 64;
            const bf16_t* Qg = (const bf16_t*)(ws + WS_QTG) + (size_t)item * 64 * 128;
            f32x4 acc = (f32x4){0.f, 0.f, 0.f, 0.f};
#pragma unroll
            for (int ks = 0; ks < 2; ++ks) acc = MFMA16(lfrag(it_, IP, fr, ks * 32, fq), gfrag(Ag, 64, wave * 16 + fr, ks * 32, fq), acc);
#pragma unroll
            for (int ks = 0; ks < 4; ++ks) acc = MFMA16(lfrag(st_, PS_PITCH, fr, ks * 32, fq), gfrag(Qg, 128, wave * 16 + fr, ks * 32, fq), acc);
            u32x2 o; o.x = pk2(acc[0], acc[1]); o.y = pk2(acc[2], acc[3]);
            *(u32x2*)((bf16_t*)(ws + WS_GQ) + (size_t)(tl0 + wave * 16 + fr) * 1024 + vcol + 4 * fq) = o;
        }
        {
            const bf16_t* Kg = (const bf16_t*)(ws + WS_KENDT) + (size_t)item * 128 * 64;
            const f32x4 dec = *(const f32x4*)((const float*)(ws + WS_HGDEC) + (size_t)item * 128 + wave * 16 + 4 * fq);
            st = st * dec;
#pragma unroll
            for (int ks = 0; ks < 2; ++ks) st = MFMA16(gfrag(Kg, 64, wave * 16 + fr, ks * 32, fq), lfrag(it_, IP, fr, ks * 32, fq), st);
            u32x2 o; o.x = pk2(st[0], st[1]); o.y = pk2(st[2], st[3]);
            *(LAS u32x2*)(stn + fr * PS_PITCH + (wave * 16 + 4 * fq) * 2) = o;
        }
    }
    __syncthreads();
}

__device__ __forceinline__ void phase_ypass(const Args& a, int round, int vcu, int G) {
    const int tid = tid_(), lane = tid & 63, wave = tid >> 6;
    const int gw = vcu * NWAVES + wave, NGW = G * NWAVES;
    unsigned char* ws = a.ws;
    for (int tl = gw; tl < RT; tl += NGW) {
        const size_t tg = (size_t)round * RT + tl;
        const f32x4 den4 = *(const f32x4*)((const float*)(ws + WS_DEN) + tg * 4), mt4 = *(const f32x4*)((const float*)(ws + WS_MT) + tg * 4);
#pragma unroll
        for (int j = 0; j < 4; ++j) {
            const int col = j * 512 + lane * 8;
            const u32x4 nv = *(const u32x4*)((const bf16_t*)(ws + WS_QKPRE) + (size_t)tl * 2048 + col);
            const u32x4 ov = *(const u32x4*)((const bf16_t*)(ws + WS_SIGO) + (size_t)tl * 2048 + col);
            const float inv = 1.0f / fmaxf(fabsf(den4[j]), __expf(-mt4[j]));
            float hv[8] = {bf_lo(nv.x) * inv, bf_hi(nv.x) * inv, bf_lo(nv.y) * inv, bf_hi(nv.y) * inv, bf_lo(nv.z) * inv, bf_hi(nv.z) * inv, bf_lo(nv.w) * inv, bf_hi(nv.w) * inv};
            float ss = 0.f;
#pragma unroll
            for (int e = 0; e < 8; ++e) ss += hv[e] * hv[e];
            const float r = rsqrtf(wave_sum(ss, lane) * (1.f / 512.f) + EPS);
            const f32x4 g0 = *(const f32x4*)(a.m_head_g + col), g1 = *(const f32x4*)(a.m_head_g + col + 4);
            const float og[8] = {bf_lo(ov.x), bf_hi(ov.x), bf_lo(ov.y), bf_hi(ov.y), bf_lo(ov.z), bf_hi(ov.z), bf_lo(ov.w), bf_hi(ov.w)};
            float y[8];
#pragma unroll
            for (int e = 0; e < 8; ++e) y[e] = og[e] * hv[e] * r * (e < 4 ? g0[e] : g1[e - 4]);
            u32x4 o; o.x = pk2(y[0], y[1]); o.y = pk2(y[2], y[3]); o.z = pk2(y[4], y[5]); o.w = pk2(y[6], y[7]);
            *(u32x4*)((bf16_t*)(ws + WS_V) + (size_t)tl * 2048 + col) = o;
        }
        {
            const int col = lane * 16;
            const u32x4 n0 = *(const u32x4*)((const bf16_t*)(ws + WS_GQ) + (size_t)tl * 1024 + col), n1 = *(const u32x4*)((const bf16_t*)(ws + WS_GQ) + (size_t)tl * 1024 + col + 8);
            const u32x4 s0 = *(const u32x4*)((const bf16_t*)(ws + WS_SGG) + (size_t)tl * 1024 + col), s1 = *(const u32x4*)((const bf16_t*)(ws + WS_SGG) + (size_t)tl * 1024 + col + 8);
            float ov[16] = {bf_lo(n0.x), bf_hi(n0.x), bf_lo(n0.y), bf_hi(n0.y), bf_lo(n0.z), bf_hi(n0.z), bf_lo(n0.w), bf_hi(n0.w), bf_lo(n1.x), bf_hi(n1.x), bf_lo(n1.y), bf_hi(n1.y), bf_lo(n1.z), bf_hi(n1.z), bf_lo(n1.w), bf_hi(n1.w)};
            const float sg[16] = {bf_lo(s0.x), bf_hi(s0.x), bf_lo(s0.y), bf_hi(s0.y), bf_lo(s0.z), bf_hi(s0.z), bf_lo(s0.w), bf_hi(s0.w), bf_lo(s1.x), bf_hi(s1.x), bf_lo(s1.y), bf_hi(s1.y), bf_lo(s1.z), bf_hi(s1.z), bf_lo(s1.w), bf_hi(s1.w)};
            float ss = 0.f;
#pragma unroll
            for (int e = 0; e < 16; ++e) ss += ov[e] * ov[e];
            ss += shx(ss, 1, lane); ss += shx(ss, 2, lane); ss += shx(ss, 4, lane);
            const float r = rsqrtf(ss * (1.f / 128.f) + EPS);
            float y[16];
#pragma unroll
            for (int e = 0; e < 16; ++e) y[e] = ov[e] * r * a.g_head_g[col + e] * sg[e];
            u32x4 o; o.x = pk2(y[0], y[1]); o.y = pk2(y[2], y[3]); o.z = pk2(y[4], y[5]); o.w = pk2(y[6], y[7]);
            *(u32x4*)((bf16_t*)(ws + WS_GI) + (size_t)tl * 1024 + col) = o;
            o.x = pk2(y[8], y[9]); o.y = pk2(y[10], y[11]); o.z = pk2(y[12], y[13]); o.w = pk2(y[14], y[15]);
            *(u32x4*)((bf16_t*)(ws + WS_GI) + (size_t)tl * 1024 + col + 8) = o;
        }
    }
}


__device__ __forceinline__ void phase_p8(const Args& a, int vcu, int G) {
    const int tid = tid_(), lane = tid & 63, wave = tid >> 6;
    const int gw = vcu * NWAVES + wave, NGW = G * NWAVES;
    unsigned char* ws = a.ws;
    f32x4 g2[4];
#pragma unroll
    for (int j = 0; j < 4; ++j) g2[j] = ((const f32x4*)a.norm2_g)[64 * j + lane];
    for (int m = gw; m < T; m += NGW) {
        const f32x4* xr = (const f32x4*)(a.out + (size_t)m * D) + lane;
        f32x4 v[4]; float s = 0.f;
#pragma unroll
        for (int j = 0; j < 4; ++j) { v[j] = xr[64 * j]; s += (v[j][0] * v[j][0] + v[j][1] * v[j][1]) + (v[j][2] * v[j][2] + v[j][3] * v[j][3]); }
        const float rstd = rsqrtf(wave_sum(s, lane) * (1.f / D) + EPS);
        unsigned long long* o8 = (unsigned long long*)((bf16_t*)(ws + WS_XN) + (size_t)m * D) + lane;
#pragma unroll
        for (int j = 0; j < 4; ++j) { v[j] = v[j] * rstd * g2[j]; o8[64 * j] = (unsigned long long)pk2(v[j][0], v[j][1]) | ((unsigned long long)pk2(v[j][2], v[j][3]) << 32); }
    }
    const size_t gt = (size_t)vcu * NTHR + tid, NGT = (size_t)G * NTHR;
    for (size_t i = gt; i < (size_t)16384 * 1024 / 8; i += NGT) {
        const f32x4 u0 = ((const f32x4*)a.u_emb)[2 * i], u1 = ((const f32x4*)a.u_emb)[2 * i + 1];
        const f32x4 v0 = ((const f32x4*)a.v_emb)[2 * i], v1 = ((const f32x4*)a.v_emb)[2 * i + 1];
        u32x4 o; o.x = pk2(u0[0], u0[1]); o.y = pk2(u0[2], u0[3]); o.z = pk2(u1[0], u1[1]); o.w = pk2(u1[2], u1[3]);
        ((u32x4*)(ws + WS_UB))[i] = o;
        o.x = pk2(v0[0], v0[1]); o.y = pk2(v0[2], v0[3]); o.z = pk2(v1[0], v1[1]); o.w = pk2(v1[2], v1[3]);
        ((u32x4*)(ws + WS_VB))[i] = o;
    }
}

__device__ __forceinline__ unsigned f2ord(float f) { const unsigned u = __builtin_bit_cast(unsigned, f); return (u & 0x80000000u) ? ~u : (u | 0x80000000u); }
__device__ __forceinline__ float ord2f(unsigned k) { const unsigned u = (k & 0x80000000u) ? (k & 0x7fffffffu) : ~k; return __builtin_bit_cast(float, u); }
__device__ __forceinline__ unsigned umax_(unsigned a, unsigned b) { return a > b ? a : b; }
__device__ __forceinline__ unsigned shxu(unsigned v, int o, int lane) { return (unsigned)__builtin_amdgcn_ds_bpermute((lane ^ o) << 2, (int)v); }

__device__ __forceinline__ void phase_topk(const Args& a, LAS unsigned char* lds, int bx, int G) {
    const int tid = tid_(), lane = tid & 63, wave = __builtin_amdgcn_readfirstlane(tid >> 6), fr = lane & 15, fq = lane >> 4;
    unsigned char* ws = a.ws;
    const int h = bx & 7;
    LAS unsigned char* KY = lds;
    LAS unsigned char* QL = lds + 2 * 128 * PS_PITCH;
    LAS unsigned* TOP = (LAS unsigned*)(lds + 2 * 128 * PS_PITCH + 64 * PQ_PITCH);
#pragma unroll
    for (int i = 0; i < 8; ++i) { const int idx = tid + 512 * i, row = idx >> 4, ch = idx & 15;
        *(LAS u32x4*)(KY + row * PS_PITCH + ch * 16) = *(const u32x4*)((const bf16_t*)(ws + WS_SK) + ((size_t)h * 256 + row) * 128 + ch * 8); }
    const int ntile = T / 64;
    for (int tile = bx >> 3; tile < ntile; tile += (G >> 3)) {
        const size_t t0 = (size_t)tile * 64;
        __syncthreads();
#pragma unroll
        for (int i = 0; i < 4; ++i) { const int idx = tid + 512 * i, row = idx >> 5, ch = idx & 31;
            *(LAS u32x4*)(QL + row * PQ_PITCH + ch * 16) = *(const u32x4*)((const bf16_t*)(ws + WS_QP) + (t0 + row) * 2048 + h * 256 + ch * 8); }
        __syncthreads();
        {
            const int mt = wave & 3, p = wave >> 2;
            unsigned key[32];
#pragma unroll
            for (int nt = 0; nt < 8; ++nt) { f32x4 acc = (f32x4){0.f, 0.f, 0.f, 0.f};
#pragma unroll
                for (int ks = 0; ks < 4; ++ks) acc = MFMA16(lfrag(KY + p * 128 * PS_PITCH, PS_PITCH, nt * 16 + fr, ks * 32, fq), lfrag(QL, PQ_PITCH, mt * 16 + fr, p * 128 + ks * 32, fq), acc);
#pragma unroll
                for (int j = 0; j < 4; ++j) { const int n = nt * 16 + 4 * fq + j; key[nt * 4 + j] = (f2ord(acc[j]) & ~127u) | (unsigned)(127 - n); } }
#pragma unroll 1
            for (int k = 0; k < 16; ++k) {
                unsigned m = key[0];
#pragma unroll
                for (int e = 1; e < 32; ++e) m = umax_(m, key[e]);
                m = umax_(m, shxu(m, 16, lane)); m = umax_(m, shxu(m, 32, lane));
#pragma unroll
                for (int e = 0; e < 32; ++e) key[e] = (key[e] == m) ? 0u : key[e];
                if (fq == (k & 3)) TOP[(p * 64 + mt * 16 + fr) * 16 + k] = m;
            }
        }
        __syncthreads();
        {
            const int t = tid >> 3, sub = tid & 7;
            unsigned ck[7];
#pragma unroll
            for (int e = 0; e < 7; ++e) {
                const int ci = sub + 8 * e;
                int i = 0, base = 0; bool ok = ci < 50;
                if (ci >= 42) { i = 8 + (ci - 42); base = ci; } else if (ci >= 40) { i = 7; base = 40; } else if (ci >= 38) { i = 6; base = 38; } else if (ci >= 36) { i = 5; base = 36; }
                else if (ci >= 33) { i = 4; base = 33; } else if (ci >= 29) { i = 3; base = 29; } else if (ci >= 24) { i = 2; base = 24; } else if (ci >= 16) { i = 1; base = 16; }
                const int j = ci - base;
                unsigned kk = 0u;
                if (ok) { const float s0 = ord2f(TOP[(0 * 64 + t) * 16 + i] & ~127u), s1 = ord2f(TOP[(1 * 64 + t) * 16 + j] & ~127u);
                    kk = (f2ord(s0 + s1) & ~255u) | (unsigned)(255 - (i * 16 + j)); }
                ck[e] = kk;
            }
            unsigned w0 = 0u, w1 = 0u;
#pragma unroll 1
            for (int k = 0; k < 16; ++k) {
                unsigned m = ck[0];
#pragma unroll
                for (int e = 1; e < 7; ++e) m = umax_(m, ck[e]);
                m = umax_(m, shxu(m, 1, lane)); m = umax_(m, shxu(m, 2, lane)); m = umax_(m, shxu(m, 4, lane));
#pragma unroll
                for (int e = 0; e < 7; ++e) ck[e] = (ck[e] == m) ? 0u : ck[e];
                if (k == sub) w0 = m; if (k == sub + 8) w1 = m;
            }
            const int f0 = 255 - (int)(w0 & 255u), f1 = 255 - (int)(w1 & 255u);
            const float sc0 = ord2f(w0 & ~255u), sc1 = ord2f(w1 & ~255u);
            float mx = fmaxf(sc0, sc1); mx = fmaxf(mx, shx(mx, 1, lane)); mx = fmaxf(mx, shx(mx, 2, lane)); mx = fmaxf(mx, shx(mx, 4, lane));
            const float e0 = __expf(sc0 - mx), e1 = __expf(sc1 - mx);
            float sm = e0 + e1; sm += shx(sm, 1, lane); sm += shx(sm, 2, lane); sm += shx(sm, 4, lane);
            const float inv = 1.0f / sm;
            const int i0 = 127 - (int)(TOP[(0 * 64 + t) * 16 + (f0 >> 4)] & 127u), j0 = 127 - (int)(TOP[(1 * 64 + t) * 16 + (f0 & 15)] & 127u);
            const int i1 = 127 - (int)(TOP[(0 * 64 + t) * 16 + (f1 >> 4)] & 127u), j1 = 127 - (int)(TOP[(1 * 64 + t) * 16 + (f1 & 15)] & 127u);
            int* ei = (int*)(ws + WS_EIDX) + ((t0 + t) * 8 + h) * 16; float* gp = (float*)(ws + WS_GATE) + ((t0 + t) * 8 + h) * 16;
            ei[sub] = i0 * 128 + j0; ei[sub + 8] = i1 * 128 + j1; gp[sub] = e0 * inv; gp[sub + 8] = e1 * inv;
        }
    }
    __syncthreads();
}

__device__ __forceinline__ void ins16(float (&v)[16], int (&id)[16], float x, int n) {
    if (x > v[15]) { v[15] = x; id[15] = n;
#pragma unroll
        for (int i = 15; i >= 1; --i) { if (v[i] > v[i - 1]) { const float tv = v[i]; v[i] = v[i - 1]; v[i - 1] = tv; const int ti = id[i]; id[i] = id[i - 1]; id[i - 1] = ti; } } }
}
__device__ __forceinline__ void phase_topk_ref(const Args& a, int vcu, int G) {
    const int tid = tid_();
    unsigned char* ws = a.ws;
    const int gt = vcu * NTHR + tid, NGT = G * NTHR;
    for (int pair = gt; pair < T * 8; pair += NGT) {
        const int t = pair >> 3, h = pair & 7;
        float sv[2][16]; int si[2][16];
#pragma unroll
        for (int p = 0; p < 2; ++p) {
#pragma unroll
            for (int i = 0; i < 16; ++i) { sv[p][i] = -INFINITY; si[p][i] = 0; }
            const bf16_t* qp = (const bf16_t*)(ws + WS_QP) + (size_t)t * 2048 + h * 256 + p * 128;
            for (int n = 0; n < 128; ++n) {
                const bf16_t* kp = (const bf16_t*)(ws + WS_SK) + ((size_t)(h * 2 + p) * 128 + n) * 128;
                float s = 0.f;
                for (int c = 0; c < 128; c += 8) { const u32x4 qv = *(const u32x4*)(qp + c), kv = *(const u32x4*)(kp + c);
                    s += bf_lo(qv.x) * bf_lo(kv.x) + bf_hi(qv.x) * bf_hi(kv.x) + bf_lo(qv.y) * bf_lo(kv.y) + bf_hi(qv.y) * bf_hi(kv.y)
                       + bf_lo(qv.z) * bf_lo(kv.z) + bf_hi(qv.z) * bf_hi(kv.z) + bf_lo(qv.w) * bf_lo(kv.w) + bf_hi(qv.w) * bf_hi(kv.w); }
                ins16(sv[p], si[p], s, n);
            }
        }
        float tv[16]; int ti[16];
#pragma unroll
        for (int i = 0; i < 16; ++i) { tv[i] = -INFINITY; ti[i] = 0; }
#pragma unroll
        for (int i = 0; i < 16; ++i)
#pragma unroll
            for (int j = 0; j < 16; ++j) ins16(tv, ti, sv[0][i] + sv[1][j], i * 16 + j);
        float sm = 0.f, ex[16];
#pragma unroll
        for (int k = 0; k < 16; ++k) { ex[k] = __expf(tv[k] - tv[0]); sm += ex[k]; }
        int* ei = (int*)(ws + WS_EIDX) + (size_t)pair * 16; float* gp = (float*)(ws + WS_GATE) + (size_t)pair * 16;
#pragma unroll
        for (int k = 0; k < 16; ++k) {
            int e0 = 0, e1 = 0;
#pragma unroll
            for (int i = 0; i < 16; ++i) { e0 = ((ti[k] >> 4) == i) ? si[0][i] : e0; e1 = ((ti[k] & 15) == i) ? si[1][i] : e1; }
            ei[k] = e0 * 128 + e1; gp[k] = ex[k] / sm; }
    }
}

typedef __bf16 bf16x2_t __attribute__((ext_vector_type(2)));
__device__ __forceinline__ float dot8(const u32x4 a, const u32x4 b, float c) {
    c += bf_lo(a.x) * bf_lo(b.x) + bf_hi(a.x) * bf_hi(b.x) + bf_lo(a.y) * bf_lo(b.y) + bf_hi(a.y) * bf_hi(b.y)
       + bf_lo(a.z) * bf_lo(b.z) + bf_hi(a.z) * bf_hi(b.z) + bf_lo(a.w) * bf_lo(b.w) + bf_hi(a.w) * bf_hi(b.w);
    return c;
}
__device__ __forceinline__ void phase_gather(const Args& a, LAS unsigned char* lds, int bx, int G) {
    const int tid = tid_(), lane = tid & 63, wave = __builtin_amdgcn_readfirstlane(tid >> 6);
    unsigned char* ws = a.ws;
    LAS float* PART = (LAS float*)lds;
    LAS float* RED = (LAS float*)(lds + 32768);
    const bf16_t* UB = (const bf16_t*)(ws + WS_UB); const bf16_t* VB = (const bf16_t*)(ws + WS_VB);
    for (int tok = bx; tok < T; tok += G) {
        const int h = wave;
        const u32x4 x0 = *(const u32x4*)((const bf16_t*)(ws + WS_XN) + (size_t)tok * D + lane * 8), x1 = *(const u32x4*)((const bf16_t*)(ws + WS_XN) + (size_t)tok * D + 512 + lane * 8);
        int em = 0; float gm = 0.f;
        if (lane < 16) { em = ((const int*)(ws + WS_EIDX))[((size_t)tok * 8 + h) * 16 + lane]; gm = ((const float*)(ws + WS_GATE))[((size_t)tok * 8 + h) * 16 + lane]; }
        float wk[16];
#pragma unroll
        for (int half = 0; half < 2; ++half) {
            u32x4 r0[8], r1[8];
#pragma unroll
            for (int k = 0; k < 8; ++k) { const int e = __builtin_amdgcn_readlane(em, half * 8 + k); const bf16_t* up = UB + (size_t)e * D + lane * 8; r0[k] = *(const u32x4*)up; r1[k] = *(const u32x4*)(up + 512); }
#pragma unroll
            for (int k = 0; k < 8; ++k) { float d = dot8(r0[k], x0, 0.f); d = dot8(r1[k], x1, d); d = wave_sum(d, lane);
                const float act = 0.5f * d * (1.0f + erff(d * 0.70710678118654752f));
                wk[half * 8 + k] = act * rdlane(gm, half * 8 + k); }
        }
        float acc[16];
#pragma unroll
        for (int e = 0; e < 16; ++e) acc[e] = 0.f;
#pragma unroll
        for (int half = 0; half < 2; ++half) {
            u32x4 r0[8], r1[8];
#pragma unroll
            for (int k = 0; k < 8; ++k) { const int e = __builtin_amdgcn_readlane(em, half * 8 + k); const bf16_t* vp = VB + (size_t)e * D + lane * 8; r0[k] = *(const u32x4*)vp; r1[k] = *(const u32x4*)(vp + 512); }
#pragma unroll
            for (int k = 0; k < 8; ++k) { const float w = wk[half * 8 + k];
                acc[0] += w * bf_lo(r0[k].x); acc[1] += w * bf_hi(r0[k].x); acc[2] += w * bf_lo(r0[k].y); acc[3] += w * bf_hi(r0[k].y);
                acc[4] += w * bf_lo(r0[k].z); acc[5] += w * bf_hi(r0[k].z); acc[6] += w * bf_lo(r0[k].w); acc[7] += w * bf_hi(r0[k].w);
                acc[8] += w * bf_lo(r1[k].x); acc[9] += w * bf_hi(r1[k].x); acc[10] += w * bf_lo(r1[k].y); acc[11] += w * bf_hi(r1[k].y);
                acc[12] += w * bf_lo(r1[k].z); acc[13] += w * bf_hi(r1[k].z); acc[14] += w * bf_lo(r1[k].w); acc[15] += w * bf_hi(r1[k].w); }
        }
        __syncthreads();
        {
            LAS float* pw = PART + h * 1024 + lane * 8;
            *(LAS f32x4*)pw = (f32x4){acc[0], acc[1], acc[2], acc[3]}; *(LAS f32x4*)(pw + 4) = (f32x4){acc[4], acc[5], acc[6], acc[7]};
            *(LAS f32x4*)(pw + 512) = (f32x4){acc[8], acc[9], acc[10], acc[11]}; *(LAS f32x4*)(pw + 516) = (f32x4){acc[12], acc[13], acc[14], acc[15]};
        }
        __syncthreads();
        f32x2 xv = *(const f32x2*)(a.out + (size_t)tok * D + tid * 2);
#pragma unroll
        for (int w = 0; w < 8; ++w) { const f32x2 pv = *(const LAS f32x2*)(PART + w * 1024 + tid * 2); xv += pv; }
        float ss = wave_sum(xv[0] * xv[0] + xv[1] * xv[1], lane);
        if (lane == 0) RED[wave] = ss;
        __syncthreads();
        float tot = 0.f;
#pragma unroll
        for (int w = 0; w < 8; ++w) tot += RED[w];
        const float rstd = rsqrtf(tot * (1.f / D) + EPS);
        const f32x2 gf = *(const f32x2*)(a.final_g + tid * 2);
        *(f32x2*)(a.out + (size_t)tok * D + tid * 2) = xv * rstd * gf;
    }
    __syncthreads();
}

__device__ __forceinline__ void phase_final_plain(const Args& a, const float* src, int vcu, int G) {
    const int tid = tid_(), lane = tid & 63, wave = tid >> 6;
    const int gw = vcu * NWAVES + wave, NGW = G * NWAVES;
    f32x4 gf[4];
#pragma unroll
    for (int j = 0; j < 4; ++j) gf[j] = ((const f32x4*)a.final_g)[64 * j + lane];
    for (int m = gw; m < T; m += NGW) {
        const f32x4* xr = (const f32x4*)(src + (size_t)m * D) + lane;
        f32x4 v[4]; float s = 0.f;
#pragma unroll
        for (int j = 0; j < 4; ++j) { v[j] = xr[64 * j]; s += (v[j][0] * v[j][0] + v[j][1] * v[j][1]) + (v[j][2] * v[j][2] + v[j][3] * v[j][3]); }
        const float rstd = rsqrtf(wave_sum(s, lane) * (1.f / D) + EPS);
        f32x4* o = (f32x4*)(a.out + (size_t)m * D) + lane;
#pragma unroll
        for (int j = 0; j < 4; ++j) o[64 * j] = v[j] * rstd * gf[j];
    }
}


#define XB_TMO      128
#define XB_XCNT(j)  (256  + 64 * (j))
#define XB_XSUB(j)  (1280 + 64 * (j))
#define XB_XGEN(j)  (2304 + 64 * (j))
#define XB_TOP      3328
#define XB_TOPGEN   3392
#define XB_SPIN_CAP (1u << 22)
constexpr int CW_BAR = 4096;
constexpr int LDS_BARST = LDS_BYTES - 64;
__device__ __forceinline__ unsigned xb_ld(unsigned* p)              { return __hip_atomic_load(p, __ATOMIC_RELAXED, __HIP_MEMORY_SCOPE_AGENT); }
__device__ __forceinline__ unsigned xb_add(unsigned* p, unsigned v) { return __hip_atomic_fetch_add(p, v, __ATOMIC_RELAXED, __HIP_MEMORY_SCOPE_AGENT); }
__device__ __forceinline__ unsigned xb_xcc_id() { return (unsigned)__builtin_amdgcn_s_getreg((3 << 11) | 20) & 0xFu; }
#define XB_SPIN(cond, bar) do { unsigned _sp = 0; while (cond) { __builtin_amdgcn_s_sleep(1); \
    if ((++_sp & 255u) == 0u) { if (xb_ld(&(bar)[XB_TMO])) break; if (_sp > XB_SPIN_CAP) { atomicAdd(&(bar)[XB_TMO], 1u); break; } } } } while (0)
__device__ __forceinline__ void xcd_barrier_post(unsigned* bar) { if (tid_() == 0) (void)xb_add(&bar[XB_XCNT(xb_xcc_id())], 1u); }
__device__ __forceinline__ void xcd_barrier_complete(unsigned* bar, unsigned x, unsigned& nloc, unsigned& nx) {
    const unsigned G = gridDim.x;
    unsigned sum, cnt, mine, sp = 0u;
    for (;;) {
        sum = 0u; cnt = 0u; mine = 0u;
#pragma unroll
        for (unsigned j = 0; j < 16; ++j) { const unsigned c = xb_ld(&bar[XB_XCNT(j)]); sum += c; cnt += (c > 0u) ? 1u : 0u; mine = (j == x) ? c : mine; }
        if (sum == G) break;
        __builtin_amdgcn_s_sleep(1);
        if ((++sp & 255u) == 0u) { if (xb_ld(&bar[XB_TMO])) break; if (sp > XB_SPIN_CAP) { atomicAdd(&bar[XB_TMO], 1u); break; } }
    }
    nloc = mine > 0u ? mine : 1u; nx = cnt > 0u ? cnt : 1u;
}
__device__ __forceinline__ void xcd_barrier(unsigned* bar, volatile LAS unsigned* st) {
    asm volatile("s_waitcnt vmcnt(0)" ::: "memory");
    __syncthreads();
    if (tid_() == 0) {
        const unsigned x = xb_xcc_id();
        __builtin_amdgcn_s_waitcnt(0);
        unsigned nloc = st[0], nx = st[1];
        if (nloc == 0u) { xcd_barrier_complete(bar, x, nloc, nx); st[0] = nloc; st[1] = nx; }
        const unsigned old = xb_add(&bar[XB_XSUB(x)], 1u);
        const unsigned gen = old / nloc;
        if (old + 1u == (gen + 1u) * nloc) {
            __builtin_amdgcn_fence(__ATOMIC_RELEASE, "agent");
            asm volatile("s_waitcnt vmcnt(0)" ::: "memory");
            const unsigned og = xb_add(&bar[XB_TOP], 1u);
            const unsigned tg = og / nx;
            if (og + 1u == (tg + 1u) * nx) xb_add(&bar[XB_TOPGEN], 1u);
            else XB_SPIN(xb_ld(&bar[XB_TOPGEN]) == tg, bar);
            __builtin_amdgcn_fence(__ATOMIC_ACQUIRE, "agent");
            xb_add(&bar[XB_XGEN(x)], 1u);
            asm volatile("s_waitcnt vmcnt(0)" ::: "memory");
        } else {
            XB_SPIN(xb_ld(&bar[XB_XGEN(x)]) == gen, bar);
            __builtin_amdgcn_fence(__ATOMIC_ACQUIRE, "agent");
            asm volatile("s_waitcnt vmcnt(0)" ::: "memory");
        }
    }
    __syncthreads();
}

__device__ __forceinline__ Args load_args() {
    const Args* p = (const Args*)__builtin_amdgcn_kernarg_segment_ptr();
    asm volatile("" : "+s"(p));
    Args r; __builtin_memcpy(&r, (const void*)p, sizeof(Args)); return r;
}
__device__ __forceinline__ EpiPtrs make_ep(const Args& a, int round) {
    EpiPtrs ep; ep.biasp = (const float*)(a.ws + WS_BIASP); ep.lb = (const float*)(a.ws + WS_LB); ep.x = a.x; ep.out = a.out; ep.ws = a.ws; ep.round = round; return ep;
}
#define GRID_SYNC() do { const Args a_ = load_args(); xcd_barrier((unsigned*)(a_.ws + WS_CTL) + CW_BAR, (volatile LAS unsigned*)(lds + LDS_BARST)); } while (0)

__device__ __forceinline__ int bx_() { int t = blockIdx.x; asm volatile("" : "+s"(t)); return t; }
__device__ __forceinline__ int gd_() { int t = gridDim.x; asm volatile("" : "+s"(t)); return t; }
#define PH_BEGIN const Args a = load_args(); const int bx = bx_(), G = gd_(); const int vcu = (G % 8 == 0) ? (bx % 8) * (G / 8) + bx / 8 : bx; (void)vcu; (void)bx;

__global__ void __launch_bounds__(NTHR, 2) fwd_megakernel(Args a_unused) {
    extern __shared__ __attribute__((aligned(16))) unsigned char lds_raw[];
    LAS unsigned char* lds = (LAS unsigned char*)lds_raw;
    cg::grid_group grid = cg::this_grid();

    { const int t_ = tid_(); if (t_ < 16) ((LAS unsigned*)(lds + LDS_BARST))[t_] = 0u; __syncthreads();
      const Args a_ = load_args(); xcd_barrier_post((unsigned*)(a_.ws + WS_CTL) + CW_BAR); }
    { PH_BEGIN phase_p0(a, lds, vcu, G); }
    grid.sync();
#pragma unroll 1
    for (int round = 0; round < NROUND; ++round) {
        { PH_BEGIN const int t0_ = tid_(); if (bx < 8 && t0_ < 64) mscan_pair(a, round, bx, t0_); }
        {
            PH_BEGIN
            pg8::Gemm g{(const bf16_t*)(a.ws + WS_XN) + (size_t)round * RT * D, (const bf16_t*)(a.ws + WS_WIN), RT, N1, D};
            pg8::StaticOrder S; S.init(RT, N1, G, bx);
            EpiX<1> E{make_ep(a, round)};
            pg8::gemm_phase<EpiX<1>, pg8::StaticOrder, true, true>(lds, g, S, E);
        }
        GRID_SYNC();
        { PH_BEGIN for (int it = bx; it < 512; it += G) mlstm_pre_item(a, lds, round, it); }
        { PH_BEGIN for (int it = bx; it < 2048; it += G) hgrn_pre_item(a, lds, round, it); }
        GRID_SYNC();
        { PH_BEGIN
          if (bx < 128) mlstm_scan(a, lds, round, bx & 7, bx >> 3);
          else if (bx < 256) { const int id2 = bx - 128; hgrn_scan(a, lds, round, (id2 & 7) * 2 + ((id2 >> 3) & 1), id2 >> 4); } }
        GRID_SYNC();
        {
            PH_BEGIN
            pg8::Gemm g{(const bf16_t*)(a.ws + WS_XN) + (size_t)round * RT * D, (const bf16_t*)(a.ws + WS_WIN) + (size_t)N1 * D, RT, N2, D};
            pg8::StaticOrder S; S.init(RT, N2, G, bx);
            EpiX<2> E{make_ep(a, round)};
            pg8::gemm_phase<EpiX<2>, pg8::StaticOrder, true, true>(lds, g, S, E);
        }
        GRID_SYNC();
        { PH_BEGIN phase_ypass(a, round, vcu, G); }
        GRID_SYNC();
        {
            { PH_BEGIN pg8::StaticOrder S; S.init(RT, D, G, bx);
              pg8::Gemm g{(const bf16_t*)(a.ws + WS_V), (const bf16_t*)(a.ws + WS_WM), RT, D, 2048}; EpiX<3> E{make_ep(a, round)}; pg8::gemm_phase<EpiX<3>, pg8::StaticOrder, true, true>(lds, g, S, E); }
            { PH_BEGIN pg8::StaticOrder S; S.init(RT, D, G, bx);
              pg8::Gemm g{(const bf16_t*)(a.ws + WS_GI), (const bf16_t*)(a.ws + WS_WG), RT, D, D}; EpiX<4> E{make_ep(a, round)}; pg8::gemm_phase<EpiX<4>, pg8::StaticOrder, true, true>(lds, g, S, E); }
        }
        GRID_SYNC();
        {
            PH_BEGIN pg8::StaticOrder S; S.init(RT, D, G, bx);
            pg8::Gemm g{(const bf16_t*)(a.ws + WS_GFLOG), (const bf16_t*)(a.ws + WS_WO), RT, D, D}; EpiX<5> E{make_ep(a, round)}; pg8::gemm_phase<EpiX<5>, pg8::StaticOrder, true, true>(lds, g, S, E);
        }
        GRID_SYNC();
    }
    { PH_BEGIN phase_p8(a, vcu, G); }
    GRID_SYNC();
    {
        PH_BEGIN pg8::StaticOrder S; S.init(T, 2048, G, bx);
        pg8::Gemm g{(const bf16_t*)(a.ws + WS_XN), (const bf16_t*)(a.ws + WS_WPQ), T, 2048, D}; EpiX<6> E{make_ep(a, 0)}; pg8::gemm_phase<EpiX<6>, pg8::StaticOrder, true, true>(lds, g, S, E);
    }
    GRID_SYNC();
#ifdef TOPK_REF
    { PH_BEGIN phase_topk_ref(a, vcu, G); }
#else
    { PH_BEGIN phase_topk(a, lds, bx, G); }
#endif
    GRID_SYNC();
    { PH_BEGIN phase_gather(a, lds, bx, G); }
}

extern "C" void kernel_launch(void* const* d_in, const int* in_sizes, int n_in, void* d_out, int out_size, void* d_ws, size_t ws_size, hipStream_t stream) {
    static int grid = 0;
    if (grid == 0) {
        if (n_in != 18 || in_sizes[0] != T * D || out_size != T * D || ws_size < WS_END) {
            fprintf(stderr, "kernel_launch: unexpected shapes/workspace (n_in %d, in0 %d, out %d, ws %zu, need %zu)\n", n_in, n_in > 0 ? in_sizes[0] : -1, out_size, ws_size, (size_t)WS_END);
            grid = -1; return; }
        int dev = 0, cus = 0, per_cu = 0;
        hipGetDevice(&dev);
        hipDeviceGetAttribute(&cus, hipDeviceAttributeMultiprocessorCount, dev);
        hipFuncSetAttribute((const void*)fwd_megakernel, hipFuncAttributeMaxDynamicSharedMemorySize, LDS_BYTES);
        hipOccupancyMaxActiveBlocksPerMultiprocessor(&per_cu, (const void*)fwd_megakernel, NTHR, LDS_BYTES);
        if (per_cu < 1) { fprintf(stderr, "kernel_launch: occupancy query says %d blocks/CU\n", per_cu); per_cu = 1; }
        grid = cus;
        (void)hipGetLastError();
    }
    if (grid < 0) return;
    hipMemsetAsync((char*)d_ws + WS_CTL, 0, 1 * MiB, stream);
    Args a{};
    a.x = (const float*)d_in[0]; a.norm1_g = (const float*)d_in[1]; a.w_in = (const float*)d_in[2]; a.b_in = (const float*)d_in[3];
    a.conv_w = (const float*)d_in[4]; a.conv_b = (const float*)d_in[5]; a.m_head_g = (const float*)d_in[6]; a.lb_table = (const float*)d_in[7];
    a.g_head_g = (const float*)d_in[8]; a.w_br_m = (const float*)d_in[9]; a.w_br_g = (const float*)d_in[10]; a.w_out = (const float*)d_in[11];
    a.norm2_g = (const float*)d_in[12]; a.w_pq = (const float*)d_in[13]; a.sub_keys = (const float*)d_in[14]; a.u_emb = (const float*)d_in[15];
    a.v_emb = (const float*)d_in[16]; a.final_g = (const float*)d_in[17];
    a.out = (float*)d_out; a.ws = (unsigned char*)d_ws;
    void* args[] = {&a};
    hipError_t e = hipLaunchCooperativeKernel((const void*)fwd_megakernel, dim3(grid), dim3(NTHR), args, LDS_BYTES, stream);
    if (e != hipSuccess) fprintf(stderr, "cooperative launch failed: %s (grid %d)\n", hipGetErrorString(e), grid);
}
```

```cpp
#include <hip/hip_runtime.h>
#include <hip/hip_cooperative_groups.h>
#include <cstdio>
#include <cstdint>
namespace cg = cooperative_groups;

#define LAS __attribute__((address_space(3)))
typedef unsigned short bf16_t;
typedef short bf16x8 __attribute__((ext_vector_type(8)));
typedef float f32x4 __attribute__((ext_vector_type(4)));
typedef float f32x2 __attribute__((ext_vector_type(2)));
typedef unsigned u32x4 __attribute__((ext_vector_type(4)));
typedef unsigned u32x2 __attribute__((ext_vector_type(2)));

constexpr int D = 1024, BATCH = 4, SEQ = 8192, T = BATCH * SEQ;
constexpr int IN_COLS = 12296, NP = 12288;
constexpr int RT = 16384, NROUND = 2;
constexpr int N1 = 7168, N2 = 5120;
constexpr float EPS = 1e-6f;
constexpr int NWAVES = 8, NTHR = 512;

constexpr size_t MiB = 1u << 20;
constexpr size_t WS_CTL = 0;
constexpr size_t WS_WIN = 1 * MiB;
constexpr size_t WS_WM = 25 * MiB;
constexpr size_t WS_WG = 29 * MiB;
constexpr size_t WS_WO = 31 * MiB;
constexpr size_t WS_WPQ = 33 * MiB;
constexpr size_t WS_SK = 37 * MiB;
constexpr size_t WS_BIASP = 37 * MiB + 512 * 1024;
constexpr size_t WS_LB = WS_BIASP + 64 * 1024;
constexpr size_t WS_GATES = 38 * MiB;
constexpr size_t WS_MPREV = 39 * MiB;
constexpr size_t WS_DEN = 40 * MiB;
constexpr size_t WS_MT = 40 * MiB + 512 * 1024;
constexpr size_t WS_HGDEC = 41 * MiB;
constexpr size_t WS_MDEC = 43 * MiB;
constexpr size_t WS_XN = 44 * MiB;
constexpr size_t WS_QKPRE = 108 * MiB;
constexpr size_t WS_V = 172 * MiB;
constexpr size_t WS_GFLOG = 236 * MiB;
constexpr size_t WS_GI = 268 * MiB;
constexpr size_t WS_GQ = 300 * MiB;
constexpr size_t WS_S = 332 * MiB;
constexpr size_t WS_QT = 348 * MiB;
constexpr size_t WS_KWT = 380 * MiB;
constexpr size_t WS_ATT = 412 * MiB;
constexpr size_t WS_QTG = 428 * MiB;
constexpr size_t WS_KENDT = 460 * MiB;
constexpr size_t WS_SIGO = 332 * MiB;
constexpr size_t WS_SGG = 396 * MiB;
constexpr size_t WS_SAM = 428 * MiB;
constexpr size_t WS_SAG = 460 * MiB;
constexpr size_t WS_END = 492 * MiB;
constexpr size_t WS_QP = 108 * MiB;
constexpr size_t WS_UB = 236 * MiB;
constexpr size_t WS_VB = 252 * MiB;
constexpr size_t WS_USC = 268 * MiB;
constexpr size_t WS_VSC = 268 * MiB + 65536;
constexpr size_t WS_EIDX = 300 * MiB;
constexpr size_t WS_GATE = 316 * MiB;

constexpr int LDS_BYTES = 147456;

__device__ __forceinline__ unsigned f2bf(float f) { unsigned u = __builtin_bit_cast(unsigned, f); return (u + 0x7fffu + ((u >> 16) & 1u)) >> 16; }
typedef __bf16 bf16x2_t __attribute__((ext_vector_type(2)));
__device__ __forceinline__ unsigned pk2(float lo, float hi) { bf16x2_t v; v[0] = (__bf16)lo; v[1] = (__bf16)hi; return __builtin_bit_cast(unsigned, v); }
__device__ __forceinline__ float bf_lo(unsigned w) { return __builtin_bit_cast(float, w << 16); }
__device__ __forceinline__ float bf_hi(unsigned w) { return __builtin_bit_cast(float, w & 0xffff0000u); }
__device__ __forceinline__ float bf2f(bf16_t h) { return __builtin_bit_cast(float, ((unsigned)h) << 16); }
__device__ __forceinline__ float shx(float v, int o, int lane) { return __builtin_bit_cast(float, __builtin_amdgcn_ds_bpermute((lane ^ o) << 2, __builtin_bit_cast(int, v))); }
__device__ __forceinline__ float shup(float v, int o, int lane) { return __builtin_bit_cast(float, __builtin_amdgcn_ds_bpermute(((lane - o) & 63) << 2, __builtin_bit_cast(int, v))); }
__device__ __forceinline__ float rdlane(float v, int l) { return __builtin_bit_cast(float, __builtin_amdgcn_readlane(__builtin_bit_cast(int, v), l)); }
__device__ __forceinline__ float wave_sum(float v, int lane) {
#pragma unroll
    for (int o = 1; o < 64; o <<= 1) v += shx(v, o, lane);
    return v;
}
__device__ __forceinline__ float sigmoidf_(float x) { return __builtin_amdgcn_rcpf(1.0f + __expf(-x)); }
__device__ __forceinline__ float siluf_(float x) { return x * __builtin_amdgcn_rcpf(1.0f + __expf(-x)); }
#define LDS_WAIT() asm volatile("s_waitcnt lgkmcnt(0)" ::: "memory")
__device__ __forceinline__ int tid_() { int t = threadIdx.x; asm volatile("" : "+v"(t)); return t; }

struct Args {
    const float* x; const float* norm1_g; const float* w_in; const float* b_in; const float* conv_w; const float* conv_b;
    const float* m_head_g; const float* lb_table; const float* g_head_g; const float* w_br_m; const float* w_br_g; const float* w_out;
    const float* norm2_g; const float* w_pq; const float* sub_keys; const float* u_emb; const float* v_emb; const float* final_g;
    float* out; unsigned char* ws;
};

namespace pg8 {
constexpr int BM = 256, BK = 64, HALF = 128, HTB = HALF * BK * 2, STAGE_BYTES = 8 * HTB, NXCD = 8, WGM = 8;
__host__ __device__ __forceinline__ int lds_byte(int r, int c) { const int st = (r >> 4) * 2 + (c >> 5), rr = r & 15, cc = c & 31, ob = rr * 64 + cc * 2; return st * 1024 + (ob ^ (((ob >> 9) & 1) << 5)); }
__host__ __device__ __forceinline__ void stage_rc(int b, int& R, int& C) { const int st = b / 1024, sb = b % 1024, swz = sb ^ (((sb >> 9) & 1) << 5); R = (st >> 1) * 16 + swz / 64; C = (st & 1) * 32 + (swz % 64) / 2; }
__host__ __device__ __forceinline__ int perm32(int rho) { const int n = rho >> 4, i = rho & 15; return 8 * (i >> 2) + 4 * n + (i & 3); }
struct Unit { int pm, pn; };
struct Gemm { const bf16_t* A; const bf16_t* Bt; int M, N, K; };
struct StaticOrder {
    int nM, nN, nwg, G, c;
    __host__ __device__ void init(int M, int N, int G_, int c_) { nM = M / BM; nN = N / BM; nwg = nM * nN; G = G_; c = c_; }
    __host__ __device__ bool next(int i, Unit& u) const {
        const long L = (long)i * G + c; if (L >= nwg) return false;
        int wgid = (int)L; { const int q = nwg / NXCD, r = nwg % NXCD, xcd = wgid % NXCD, off = wgid / NXCD; wgid = (xcd < r ? xcd * (q + 1) : r * (q + 1) + (xcd - r) * q) + off; }
        const int nig = WGM * nN, gid = wgid / nig, fm = gid * WGM, gsz = (nM - fm) < WGM ? (nM - fm) : WGM;
        u.pm = fm + ((wgid % nig) % gsz); u.pn = (wgid % nig) / gsz; return true;
    }
    __device__ __forceinline__ void a_ready(const Unit&) const {}
    __device__ __forceinline__ void done(const Unit&) const {}
};

template <class Epi, class Sched, bool ALIGN_EPI = false, bool SP2 = false>
__device__ __forceinline__ void gemm_phase(LAS unsigned char* lds, const Gemm g, const Sched& S, const Epi& E) {
    const int tid = tid_(), wid = __builtin_amdgcn_readfirstlane(tid >> 6), lane = tid & 63, wr = wid >> 2, wc = wid & 3, fr = lane & 15, fq = lane >> 4;
    const int K = g.K, nt = K / BK;
    unsigned voffA[2], voffB[2];
#pragma unroll
    for (int i = 0; i < 2; ++i) { int R, C; stage_rc(tid * 16 + i * 8192, R, C); const int Rb = Epi::PERM ? ((R & ~31) + perm32(R & 31)) : R;
        voffA[i] = (unsigned)(R * K + C) * 2u; voffB[i] = (unsigned)(Rb * K + C) * 2u; }
    const size_t kstep = (size_t)(BK * 2);
    const size_t hstep = (size_t)HALF * K * 2;
    const size_t tstep = 2 * hstep;
    const unsigned ldsw = (unsigned)wid * 1024u;
    const int aoff = lds_byte(wr * 64 + fr, fq * 8), boff = lds_byte(wc * 32 + fr, fq * 8);
#define PG8_SA(b, h) (((b) * 2 + (h)) * HTB)
#define PG8_SB(b, h) ((4 + (b) * 2 + (h)) * HTB)
#define PG8_STAGE(bufoff, gbase, voff) do { _Pragma("unroll") for (int _i = 0; _i < 2; ++_i) \
        __builtin_amdgcn_global_load_lds((const unsigned*)((const char*)(gbase) + (voff)[_i]), (LAS unsigned*)(lds + (bufoff) + ldsw + _i * 8192), 16, 0, 0); } while (0)
#define PG8_LDA(dst, b, h) do { _Pragma("unroll") for (int m = 0; m < 4; ++m) _Pragma("unroll") for (int k = 0; k < 2; ++k) dst[m][k] = *(const LAS bf16x8*)(lds + PG8_SA(b, h) + aoff + m * 2048 + k * 1024); } while (0)
#define PG8_LDB(dst, b, h) do { _Pragma("unroll") for (int n = 0; n < 2; ++n) _Pragma("unroll") for (int k = 0; k < 2; ++k) dst[n][k] = *(const LAS bf16x8*)(lds + PG8_SB(b, h) + boff + n * 2048 + k * 1024); } while (0)
#define PG8_MMA(ai, bj, At, Bt) do { __builtin_amdgcn_s_setprio(1); _Pragma("unroll") for (int m = 0; m < 4; ++m) _Pragma("unroll") for (int n = 0; n < 2; ++n) _Pragma("unroll") for (int k = 0; k < 2; ++k) \
        acc[ai][bj][m][n] = __builtin_amdgcn_mfma_f32_16x16x32_bf16(Bt[n][k], At[m][k], acc[ai][bj][m][n], 0, 0, 0); __builtin_amdgcn_s_setprio(0); } while (0)
#define PG8_WAIT_V(n) asm volatile("s_waitcnt vmcnt(" #n ")" ::: "memory")
#define PG8_WAIT_L(n) asm volatile("s_waitcnt lgkmcnt(" #n ")" ::: "memory")
#define PG8_BAR __builtin_amdgcn_s_barrier()
#define PG8_SCHED __builtin_amdgcn_sched_barrier(0)
    Unit cur, nxt; int ui = 0;
    if (!S.next(0, cur)) return;
    f32x4 acc[2][2][4][2];
#pragma unroll
    for (int a = 0; a < 2; ++a)
#pragma unroll
        for (int b = 0; b < 2; ++b)
#pragma unroll
            for (int m = 0; m < 4; ++m)
#pragma unroll
                for (int n = 0; n < 2; ++n) acc[a][b][m][n] = (f32x4){0.f, 0.f, 0.f, 0.f};
    bf16x8 At[4][2], B0[2][2], B1[2][2];
    const char* cA = (const char*)g.A + (size_t)cur.pm * tstep; const char* cB = (const char*)g.Bt + (size_t)cur.pn * tstep;
    S.a_ready(cur);
    if constexpr (SP2) {
        PG8_STAGE(PG8_SB(0, 0), cB, voffB); PG8_STAGE(PG8_SB(0, 1), cB + hstep, voffB); PG8_STAGE(PG8_SA(0, 0), cA, voffA); PG8_STAGE(PG8_SA(0, 1), cA + hstep, voffA);
        if (wr == 1) PG8_BAR;
        PG8_WAIT_V(2); PG8_BAR;
        PG8_STAGE(PG8_SB(1, 0), cB + kstep, voffB); PG8_STAGE(PG8_SA(1, 0), cA + kstep, voffA); PG8_STAGE(PG8_SB(1, 1), cB + hstep + kstep, voffB);
        PG8_WAIT_V(6); PG8_BAR;
    } else {
        PG8_STAGE(PG8_SB(0, 0), cB, voffB); PG8_STAGE(PG8_SA(0, 0), cA, voffA); PG8_STAGE(PG8_SB(0, 1), cB + hstep, voffB); PG8_STAGE(PG8_SA(0, 1), cA + hstep, voffA);
        if (wr == 1) PG8_BAR;
        PG8_WAIT_V(4); PG8_BAR;
        PG8_STAGE(PG8_SB(1, 0), cB + kstep, voffB); PG8_STAGE(PG8_SA(1, 0), cA + kstep, voffA); PG8_STAGE(PG8_SB(1, 1), cB + hstep + kstep, voffB);
        PG8_WAIT_V(6); PG8_BAR;
    }
    for (;;) {
        const bool has_next = S.next(ui + 1, nxt);
        const char* nA = has_next ? (const char*)g.A + (size_t)nxt.pm * tstep : cA; const char* nB = has_next ? (const char*)g.Bt + (size_t)nxt.pn * tstep : cB;
        for (int t = 0; t < nt; t += 2) {
            const bool last = (t == nt - 2);
            const char* a1 = cA + (size_t)(t + 1) * kstep;
            const char* a2 = last ? nA : cA + (size_t)(t + 2) * kstep; const char* b2 = last ? nB : cB + (size_t)(t + 2) * kstep;
            const char* a3 = a2 + kstep; const char* b3 = b2 + kstep;
            if (last && has_next) S.a_ready(nxt);
            if constexpr (SP2) {
            PG8_LDB(B0, 0, 0); PG8_LDB(B1, 0, 1); PG8_SCHED; PG8_LDA(At, 0, 0); PG8_STAGE(PG8_SA(1, 1), a1 + hstep, voffA);
            PG8_WAIT_V(8); PG8_WAIT_L(0); PG8_BAR; PG8_MMA(0, 0, At, B0); PG8_MMA(0, 1, At, B1); PG8_BAR; PG8_SCHED;
            PG8_LDA(At, 0, 1); PG8_STAGE(PG8_SB(0, 0), b2, voffB); PG8_STAGE(PG8_SB(0, 1), b2 + hstep, voffB); PG8_STAGE(PG8_SA(0, 0), a2, voffA);
            PG8_WAIT_V(8); PG8_WAIT_L(0); PG8_BAR; PG8_MMA(1, 0, At, B0); PG8_MMA(1, 1, At, B1); PG8_BAR; PG8_SCHED;
            PG8_LDB(B0, 1, 0); PG8_LDB(B1, 1, 1); PG8_SCHED; PG8_LDA(At, 1, 0); PG8_STAGE(PG8_SA(0, 1), a2 + hstep, voffA);
            PG8_WAIT_V(8); PG8_WAIT_L(0); PG8_BAR; PG8_MMA(0, 0, At, B0); PG8_MMA(0, 1, At, B1); PG8_BAR; PG8_SCHED;
            PG8_LDA(At, 1, 1); PG8_STAGE(PG8_SB(1, 0), b3, voffB); PG8_STAGE(PG8_SB(1, 1), b3 + hstep, voffB); PG8_STAGE(PG8_SA(1, 0), a3, voffA);
            PG8_WAIT_V(8); PG8_WAIT_L(0); PG8_BAR; PG8_MMA(1, 0, At, B0); PG8_MMA(1, 1, At, B1); PG8_BAR; PG8_SCHED;
            } else {
            PG8_LDB(B0, 0, 0); PG8_SCHED; PG8_LDA(At, 0, 0); PG8_STAGE(PG8_SA(1, 1), a1 + hstep, voffA);
            PG8_WAIT_L(8); PG8_BAR; PG8_WAIT_L(0); PG8_MMA(0, 0, At, B0); PG8_BAR; PG8_SCHED;
            PG8_LDB(B1, 0, 1); PG8_STAGE(PG8_SB(0, 0), b2, voffB);
            PG8_BAR; PG8_WAIT_L(0); PG8_MMA(0, 1, At, B1); PG8_BAR;
            PG8_LDA(At, 0, 1); PG8_STAGE(PG8_SA(0, 0), a2, voffA);
            PG8_BAR; PG8_WAIT_L(0); PG8_MMA(1, 0, At, B0); PG8_BAR; PG8_SCHED;
            PG8_STAGE(PG8_SB(0, 1), b2 + hstep, voffB);
            PG8_WAIT_V(6); PG8_BAR; PG8_MMA(1, 1, At, B1); PG8_BAR;
            PG8_LDB(B0, 1, 0); PG8_SCHED; PG8_LDA(At, 1, 0); PG8_STAGE(PG8_SA(0, 1), a2 + hstep, voffA);
            PG8_WAIT_L(8); PG8_BAR; PG8_WAIT_L(0); PG8_MMA(0, 0, At, B0); PG8_BAR; PG8_SCHED;
            PG8_LDB(B1, 1, 1); PG8_STAGE(PG8_SB(1, 0), b3, voffB);
            PG8_BAR; PG8_WAIT_L(0); PG8_MMA(0, 1, At, B1); PG8_BAR;
            PG8_LDA(At, 1, 1); PG8_STAGE(PG8_SA(1, 0), a3, voffA);
            PG8_BAR; PG8_WAIT_L(0); PG8_MMA(1, 0, At, B0); PG8_BAR; PG8_SCHED;
            PG8_STAGE(PG8_SB(1, 1), b3 + hstep, voffB);
            PG8_WAIT_V(6); PG8_BAR; PG8_MMA(1, 1, At, B1); PG8_BAR;
            }
        }
        if constexpr (ALIGN_EPI) { if (wr == 0) PG8_BAR; }
        E(acc, cur, wr, wc, fr, fq);
        if (!has_next) break;
#pragma unroll
        for (int a = 0; a < 2; ++a)
#pragma unroll
            for (int b = 0; b < 2; ++b)
#pragma unroll
                for (int m = 0; m < 4; ++m)
#pragma unroll
                    for (int n = 0; n < 2; ++n) acc[a][b][m][n] = (f32x4){0.f, 0.f, 0.f, 0.f};
        cur = nxt; cA = nA; cB = nB; ++ui;
        if constexpr (ALIGN_EPI) { if (wr == 1) PG8_BAR; }
    }
    PG8_WAIT_V(0);
    if constexpr (!ALIGN_EPI) { if (wr == 0) PG8_BAR; }
    PG8_BAR;
#undef PG8_SA
#undef PG8_SB
#undef PG8_STAGE
#undef PG8_LDA
#undef PG8_LDB
#undef PG8_MMA
#undef PG8_WAIT_V
#undef PG8_WAIT_L
#undef PG8_BAR
#undef PG8_SCHED
}
}

struct EpiPtrs {
    const float* biasp; const float* lb; const float* x; float* out; unsigned char* ws; int round;
};
template <int MODE> struct EpiX {
    static constexpr bool PERM = true, AFTER_DRAIN = false;
    EpiPtrs P;
    __device__ __forceinline__ void operator()(const f32x4 (&acc)[2][2][4][2], const pg8::Unit& u, int wr, int wc, int fr, int fq) const {
        const int row0 = u.pm * 256 + wr * 64 + fr;
        const int colt = u.pn * 256 + wc * 32 + 8 * fq;
        unsigned char* ws = P.ws;
        bf16_t* dst = nullptr; int ld = 0, coff = 0, act = 0; const float* bias = nullptr;
        if (MODE == 1) {
            bias = P.biasp;
            if (u.pn < 8) { dst = (bf16_t*)(ws + WS_QKPRE); ld = 2048; coff = 0; act = 0; }
            else if (u.pn < 16) { dst = (bf16_t*)(ws + WS_V); ld = 2048; coff = 2048; act = 0; }
            else if (u.pn < 20) { dst = (bf16_t*)(ws + WS_GFLOG); ld = 1024; coff = 4096; act = 3; }
            else if (u.pn < 24) { dst = (bf16_t*)(ws + WS_GI); ld = 1024; coff = 5120; act = 0; }
            else { dst = (bf16_t*)(ws + WS_GQ); ld = 1024; coff = 6144; act = 2; }
        } else if (MODE == 2) {
            bias = P.biasp + N1;
            if (u.pn < 8) { dst = (bf16_t*)(ws + WS_SIGO); ld = 2048; coff = 0; act = 1; }
            else if (u.pn < 12) { dst = (bf16_t*)(ws + WS_SGG); ld = 1024; coff = 2048; act = 2; }
            else if (u.pn < 16) { dst = (bf16_t*)(ws + WS_SAM); ld = 1024; coff = 3072; act = 1; }
            else { dst = (bf16_t*)(ws + WS_SAG); ld = 1024; coff = 4096; act = 1; }
        } else if (MODE == 6) { dst = (bf16_t*)(ws + WS_QP); ld = 2048; coff = 0; act = 0; }
#pragma unroll
        for (int bj = 0; bj < 2; ++bj) {
            const int col = colt + bj * 128;
            f32x4 b0 = (f32x4){0.f, 0.f, 0.f, 0.f}, b1 = b0, l0 = b0, l1 = b0;
            if (MODE == 1 || MODE == 2) { b0 = *(const f32x4*)(bias + col); b1 = *(const f32x4*)(bias + col + 4); }
            if (MODE == 1) { if (act == 3) { l0 = *(const f32x4*)(P.lb + (col - coff)); l1 = *(const f32x4*)(P.lb + (col - coff) + 4); } }
#pragma unroll
            for (int ai = 0; ai < 2; ++ai)
#pragma unroll
                for (int m = 0; m < 4; ++m) {
                    const int row = row0 + ai * 128 + m * 16;
                    f32x4 v0 = acc[ai][bj][m][0] + b0, v1 = acc[ai][bj][m][1] + b1;
                    if (MODE == 1 || MODE == 2 || MODE == 6) {
                        if (act == 1) {
#pragma unroll
                            for (int j = 0; j < 4; ++j) { v0[j] = sigmoidf_(v0[j]); v1[j] = sigmoidf_(v1[j]); }
                        } else if (act == 2) {
#pragma unroll
                            for (int j = 0; j < 4; ++j) { v0[j] = siluf_(v0[j]); v1[j] = siluf_(v1[j]); }
                        } else if (act == 3) {
#pragma unroll
                            for (int j = 0; j < 4; ++j) { v0[j] = __logf(l0[j] + (1.0f - l0[j]) * sigmoidf_(v0[j])); v1[j] = __logf(l1[j] + (1.0f - l1[j]) * sigmoidf_(v1[j])); }
                        }
                        u32x4 w; w.x = pk2(v0[0], v0[1]); w.y = pk2(v0[2], v0[3]); w.z = pk2(v1[0], v1[1]); w.w = pk2(v1[2], v1[3]);
                        *(u32x4*)(dst + (size_t)row * ld + (col - coff)) = w;
                    } else if (MODE == 3) {
                        const u32x4 g = *(const u32x4*)((const bf16_t*)(ws + WS_SAM) + (size_t)row * 1024 + col);
                        float* o = P.out + ((size_t)P.round * RT + row) * 1024 + col;
                        f32x4 r0, r1;
                        r0[0] = v0[0] * bf_lo(g.x); r0[1] = v0[1] * bf_hi(g.x); r0[2] = v0[2] * bf_lo(g.y); r0[3] = v0[3] * bf_hi(g.y);
                        r1[0] = v1[0] * bf_lo(g.z); r1[1] = v1[1] * bf_hi(g.z); r1[2] = v1[2] * bf_lo(g.w); r1[3] = v1[3] * bf_hi(g.w);
                        *(f32x4*)o = r0; *(f32x4*)(o + 4) = r1;
                    } else if (MODE == 4) {
                        const u32x4 g = *(const u32x4*)((const bf16_t*)(ws + WS_SAG) + (size_t)row * 1024 + col);
                        const float* zp = P.out + ((size_t)P.round * RT + row) * 1024 + col;
                        const f32x4 p0 = *(const f32x4*)zp, p1 = *(const f32x4*)(zp + 4);
                        f32x4 r0, r1;
                        r0[0] = p0[0] + v0[0] * bf_lo(g.x); r0[1] = p0[1] + v0[1] * bf_hi(g.x); r0[2] = p0[2] + v0[2] * bf_lo(g.y); r0[3] = p0[3] + v0[3] * bf_hi(g.y);
                        r1[0] = p1[0] + v1[0] * bf_lo(g.z); r1[1] = p1[1] + v1[1] * bf_hi(g.z); r1[2] = p1[2] + v1[2] * bf_lo(g.w); r1[3] = p1[3] + v1[3] * bf_hi(g.w);
                        u32x4 w; w.x = pk2(r0[0], r0[1]); w.y = pk2(r0[2], r0[3]); w.z = pk2(r1[0], r1[1]); w.w = pk2(r1[2], r1[3]);
                        *(u32x4*)((bf16_t*)(ws + WS_GFLOG) + (size_t)row * 1024 + col) = w;
                    } else if (MODE == 5) {
                        const size_t off = ((size_t)P.round * RT + row) * 1024 + col;
                        const f32x4 x0 = *(const f32x4*)(P.x + off), x1 = *(const f32x4*)(P.x + off + 4);
                        *(f32x4*)(P.out + off) = x0 + v0; *(f32x4*)(P.out + off + 4) = x1 + v1;
                    }
                }
        }
    }
};

__device__ __forceinline__ void p0_transpose_item(const float* W, int ldw, int K, int k0, int scol, bf16_t* WT, int drow, LAS float* scr, int lane) {
#pragma unroll 8
    for (int i = 0; i < 32; ++i) { const int kk = 2 * i + (lane >> 5); scr[kk * 33 + (lane & 31)] = W[(size_t)(k0 + kk) * ldw + scol + (lane & 31)]; }
    LDS_WAIT(); asm volatile("" ::: "memory");
    const int c = lane & 7;
#pragma unroll
    for (int j = 0; j < 4; ++j) { const int n = (lane >> 3) + 8 * j; const LAS float* s = scr + (8 * c) * 33 + n;
        u32x4 o; o.x = pk2(s[0 * 33], s[1 * 33]); o.y = pk2(s[2 * 33], s[3 * 33]); o.z = pk2(s[4 * 33], s[5 * 33]); o.w = pk2(s[6 * 33], s[7 * 33]);
        *(u32x4*)(WT + (size_t)(drow + n) * K + k0 + 8 * c) = o; }
    LDS_WAIT(); asm volatile("" ::: "memory");
}
__device__ __forceinline__ int win_src_col(int n) {
    if (n < 4096) return n;
    if (n < 7168) return n - 4096 + 6152;
    if (n < 9216) return n - 7168 + 4096;
    return n - 9216 + 9224;
}

__device__ __forceinline__ void phase_p0(const Args& a, LAS unsigned char* lds, int vcu, int G) {
    const int tid = tid_(), lane = tid & 63, wave = tid >> 6;
    const int gw = vcu * NWAVES + wave, NGW = G * NWAVES;
    unsigned char* ws = a.ws;
    LAS float* scr = (LAS float*)(lds + wave * 16384);
    constexpr int I_IN = 16 * 384, I_M = 32 * 32, I_G = 16 * 32, I_O = 16 * 32, I_PQ = 16 * 64;
    constexpr int NITEMS = I_IN + I_M + I_G + I_O + I_PQ;
    for (int it = gw; it < NITEMS; it += NGW) {
        int r = it;
        if (r < I_IN) { const int kb = r / 384, nb = r % 384; p0_transpose_item(a.w_in, IN_COLS, 1024, kb * 64, win_src_col(nb * 32), (bf16_t*)(ws + WS_WIN), nb * 32, scr, lane); continue; } r -= I_IN;
        if (r < I_M) { const int kb = r / 32, nb = r % 32; p0_transpose_item(a.w_br_m, 1024, 2048, kb * 64, nb * 32, (bf16_t*)(ws + WS_WM), nb * 32, scr, lane); continue; } r -= I_M;
        if (r < I_G) { const int kb = r / 32, nb = r % 32; p0_transpose_item(a.w_br_g, 1024, 1024, kb * 64, nb * 32, (bf16_t*)(ws + WS_WG), nb * 32, scr, lane); continue; } r -= I_G;
        if (r < I_O) { const int kb = r / 32, nb = r % 32; p0_transpose_item(a.w_out, 1024, 1024, kb * 64, nb * 32, (bf16_t*)(ws + WS_WO), nb * 32, scr, lane); continue; } r -= I_O;
        { const int kb = r / 64, nb = r % 64; p0_transpose_item(a.w_pq, 2048, 1024, kb * 64, nb * 32, (bf16_t*)(ws + WS_WPQ), nb * 32, scr, lane); }
    }
    const int gt = vcu * NTHR + tid, NGT = G * NTHR;
    for (int i = gt; i < NP; i += NGT) ((float*)(ws + WS_BIASP))[i] = a.b_in[win_src_col(i)];
    for (int i = gt; i < 1024; i += NGT) { const float t0 = a.lb_table[i], t1 = a.lb_table[1024 + i]; ((float*)(ws + WS_LB))[i] = 1.0f / (1.0f + __expf(t1 - t0)); }
    for (int i = gt; i < 8 * 2 * 128 * 128 / 4; i += NGT) { const f32x4 v = ((const f32x4*)a.sub_keys)[i]; u32x2 o; o.x = pk2(v[0], v[1]); o.y = pk2(v[2], v[3]); ((u32x2*)(ws + WS_SK))[i] = o; }
    f32x4 g1[4];
#pragma unroll
    for (int j = 0; j < 4; ++j) g1[j] = ((const f32x4*)a.norm1_g)[64 * j + lane];
    for (int m = gw; m < T; m += NGW) {
        const f32x4* xr = (const f32x4*)(a.x + (size_t)m * D) + lane;
        f32x4 v[4]; float s = 0.f;
#pragma unroll
        for (int j = 0; j < 4; ++j) { v[j] = xr[64 * j]; s += (v[j][0] * v[j][0] + v[j][1] * v[j][1]) + (v[j][2] * v[j][2] + v[j][3] * v[j][3]); }
        const float rstd = rsqrtf(wave_sum(s, lane) * (1.f / D) + EPS);
        unsigned long long* o8 = (unsigned long long*)((bf16_t*)(ws + WS_XN) + (size_t)m * D) + lane;
        float ga[8];
#pragma unroll
        for (int q = 0; q < 8; ++q) ga[q] = 0.f;
#pragma unroll
        for (int j = 0; j < 4; ++j) {
            v[j] = v[j] * rstd * g1[j];
            o8[64 * j] = (unsigned long long)pk2(v[j][0], v[j][1]) | ((unsigned long long)pk2(v[j][2], v[j][3]) << 32);
#pragma unroll
            for (int e = 0; e < 4; ++e) {
                const int k = 256 * j + 4 * lane + e;
                const f32x4 w0 = *(const f32x4*)(a.w_in + (size_t)k * IN_COLS + 6144), w1 = *(const f32x4*)(a.w_in + (size_t)k * IN_COLS + 6148);
                ga[0] += v[j][e] * w0[0]; ga[1] += v[j][e] * w0[1]; ga[2] += v[j][e] * w0[2]; ga[3] += v[j][e] * w0[3];
                ga[4] += v[j][e] * w1[0]; ga[5] += v[j][e] * w1[1]; ga[6] += v[j][e] * w1[2]; ga[7] += v[j][e] * w1[3];
            }
        }
#pragma unroll
        for (int q = 0; q < 8; ++q) ga[q] = wave_sum(ga[q], lane);
        if (lane < 8) { float r = ga[0];
#pragma unroll
            for (int q = 1; q < 8; ++q) r = (lane == q) ? ga[q] : r;
            ((float*)(ws + WS_GATES))[(size_t)m * 8 + lane] = r + a.b_in[6144 + lane]; }
    }
}


__device__ __forceinline__ float logsigf_(float x) { return fminf(x, 0.f) - log1pf(__expf(-fabsf(x))); }
#define MFMA16(a, b, c) __builtin_amdgcn_mfma_f32_16x16x32_bf16((a), (b), (c), 0, 0, 0)
__device__ __forceinline__ bf16x8 lfrag(const LAS unsigned char* base, int pitch, int row, int k0, int fq) { return *(const LAS bf16x8*)(base + row * pitch + (k0 + 8 * fq) * 2); }
__device__ __forceinline__ bf16x8 gfrag(const bf16_t* base, int ld, int row, int k0, int fq) { return *(const bf16x8*)(base + (size_t)row * ld + k0 + 8 * fq); }

__device__ __forceinline__ void mscan_pair(const Args& a, int round, int p, int lane) {
    const int bl = p >> 2, h = p & 3, b = round * 2 + bl;
    const float* g = (const float*)(a.ws + WS_GATES) + ((size_t)b * SEQ + (size_t)lane * 128) * 8;
    float bsum = 0.f, gm = -INFINITY;
    for (int s = 0; s < 128; ++s) { const float ip = g[s * 8 + h], fp = g[s * 8 + 4 + h]; bsum += logsigf_(fp); gm = fmaxf(gm, ip - bsum); }
    float mprev = 0.f, mine = 0.f;
    for (int c = 0; c < 64; ++c) {
        const float bc = rdlane(bsum, c), gc = rdlane(gm, c);
        if (lane == c) mine = mprev; mprev = bc + fmaxf(mprev, gc); }
    ((float*)(a.ws + WS_MPREV))[(round * 8 + p) * 64 + lane] = mine;
}

constexpr int PQ_PITCH = 528, PS_PITCH = 272;
__device__ __forceinline__ void mlstm_pre_item(const Args& a, LAS unsigned char* lds, int round, int item) {
    const int tid = tid_(), lane = tid & 63, wave = __builtin_amdgcn_readfirstlane(tid >> 6), fr = lane & 15, fq = lane >> 4;
    const int p = item >> 6, c = item & 63, bl = p >> 2, h = p & 3, b = round * 2 + bl;
    const int tl0 = bl * SEQ + c * 128; const size_t tg0 = (size_t)b * SEQ + c * 128;
    unsigned char* ws = a.ws;
    LAS unsigned char* QL = lds; LAS unsigned char* KL = lds + 67584;
    LAS float* AS = (LAS float*)(lds + 135168); LAS float* MS = AS + 128; LAS float* SC = AS + 256;
    if (wave == 0) {
        const float mprev = ((const float*)(ws + WS_MPREV))[(round * 8 + p) * 64 + c];
        const float* g = (const float*)(ws + WS_GATES) + (tg0 + 2 * lane) * 8;
        const float ip0 = g[h], fp0 = g[4 + h], ip1 = g[8 + h], fp1 = g[12 + h];
        const float lf0 = logsigf_(fp0), lf1 = logsigf_(fp1), pp = lf0 + lf1;
        float incl = pp;
#pragma unroll
        for (int o = 1; o < 64; o <<= 1) { const float t = shup(incl, o, lane); if (lane >= o) incl += t; }
        const float excl = incl - pp, b0 = excl + lf0, b1 = incl;
        const float a0 = ip0 - b0, a1 = ip1 - b1;
        float inclm = fmaxf(a0, a1);
#pragma unroll
        for (int o = 1; o < 64; o <<= 1) { const float t = shup(inclm, o, lane); if (lane >= o) inclm = fmaxf(inclm, t); }
        float exclm = shup(inclm, 1, lane); if (lane == 0) exclm = -INFINITY;
        const float M0 = fmaxf(mprev, fmaxf(exclm, a0)), M1 = fmaxf(mprev, inclm);
        AS[2 * lane] = a0; AS[2 * lane + 1] = a1; MS[2 * lane] = M0; MS[2 * lane + 1] = M1;
        float* mt = (float*)(ws + WS_MT) + (tg0 + 2 * lane) * 4 + h;
        mt[0] = b0 + M0; mt[4] = b1 + M1;
        const float Mlast = rdlane(M1, 63);
        if (lane == 0) { SC[0] = mprev; SC[1] = Mlast; ((float*)(ws + WS_MDEC))[item] = __expf(mprev - Mlast); }
    }
    {
        const int cgp = tid & 63, strip = tid >> 6;
        const int col = (cgp < 32) ? (h * 256 + cgp * 8) : (1024 + h * 256 + (cgp - 32) * 8);
        float w[4][8], bb[8];
#pragma unroll
        for (int j = 0; j < 4; ++j) { const f32x4 w0 = *(const f32x4*)(a.conv_w + j * 2048 + col), w1 = *(const f32x4*)(a.conv_w + j * 2048 + col + 4);
#pragma unroll
            for (int e = 0; e < 4; ++e) { w[j][e] = w0[e]; w[j][4 + e] = w1[e]; } }
        { const f32x4 b0 = *(const f32x4*)(a.conv_b + col), b1 = *(const f32x4*)(a.conv_b + col + 4);
#pragma unroll
            for (int e = 0; e < 4; ++e) { bb[e] = b0[e]; bb[4 + e] = b1[e]; } }
        const bf16_t* src = (const bf16_t*)(ws + WS_QKPRE) + (size_t)(tl0 + 16 * strip) * 2048 + col;
        const float qs = (cgp < 32) ? 0.0625f : 1.0f;
        LAS unsigned char* dstt = ((cgp < 32) ? QL : KL) + (cgp & 31) * 16;
#pragma unroll 1
        for (int half = 0; half < 2; ++half) {
            u32x4 xr[11];
#pragma unroll
            for (int r = 0; r < 11; ++r) {
                const int sl = c * 128 + 16 * strip + 8 * half + r - 3;
                xr[r] = (sl >= 0) ? *(const u32x4*)(src + (ptrdiff_t)(8 * half + r - 3) * 2048) : (u32x4){0u, 0u, 0u, 0u};
            }
#pragma unroll
            for (int r = 0; r < 8; ++r) {
                float y[8];
#pragma unroll
                for (int e = 0; e < 8; ++e) y[e] = bb[e];
#pragma unroll
                for (int j = 0; j < 4; ++j) { const u32x4 xv = xr[r + j];
                    y[0] += w[j][0] * bf_lo(xv.x); y[1] += w[j][1] * bf_hi(xv.x); y[2] += w[j][2] * bf_lo(xv.y); y[3] += w[j][3] * bf_hi(xv.y);
                    y[4] += w[j][4] * bf_lo(xv.z); y[5] += w[j][5] * bf_hi(xv.z); y[6] += w[j][6] * bf_lo(xv.w); y[7] += w[j][7] * bf_hi(xv.w); }
#pragma unroll
                for (int e = 0; e < 8; ++e) y[e] = siluf_(y[e]) * qs;
                u32x4 o; o.x = pk2(y[0], y[1]); o.y = pk2(y[2], y[3]); o.z = pk2(y[4], y[5]); o.w = pk2(y[6], y[7]);
                *(LAS u32x4*)(dstt + (16 * strip + 8 * half + r) * PQ_PITCH) = o;
            }
        }
    }
    __syncthreads();
    const float mprev = SC[0], Mlast = SC[1];
    {
        bf16_t* Sg = (bf16_t*)(ws + WS_S) + (size_t)item * 128 * 128;
        const int t = wave * 16 + fr; const float Mt = MS[t];
        for (int st = 0; st < 8; ++st) {
            u32x2 o = (u32x2){0u, 0u};
            if (st <= wave) {
                f32x4 acc = (f32x4){0.f, 0.f, 0.f, 0.f};
#pragma unroll
                for (int ks = 0; ks < 8; ++ks) acc = MFMA16(lfrag(KL, PQ_PITCH, st * 16 + fr, ks * 32, fq), lfrag(QL, PQ_PITCH, wave * 16 + fr, ks * 32, fq), acc);
                float v[4];
#pragma unroll
                for (int j = 0; j < 4; ++j) { const int s = st * 16 + 4 * fq + j; v[j] = (s <= t) ? acc[j] * __expf(AS[s] - Mt) : 0.f; }
                o.x = pk2(v[0], v[1]); o.y = pk2(v[2], v[3]);
            }
            *(u32x2*)(Sg + (size_t)t * 128 + st * 16 + 4 * fq) = o;
        }
    }
    {
        bf16_t* Qg = (bf16_t*)(ws + WS_QT) + (size_t)item * 128 * 256;
#pragma unroll
        for (int i = 0; i < 8; ++i) { const int idx = tid + 512 * i, t = idx >> 5, ch = idx & 31;
            const u32x4 v = *(const LAS u32x4*)(QL + t * PQ_PITCH + ch * 16); const float s = __expf(mprev - MS[t]);
            u32x4 o; o.x = pk2(bf_lo(v.x) * s, bf_hi(v.x) * s); o.y = pk2(bf_lo(v.y) * s, bf_hi(v.y) * s); o.z = pk2(bf_lo(v.z) * s, bf_hi(v.z) * s); o.w = pk2(bf_lo(v.w) * s, bf_hi(v.w) * s);
            *(u32x4*)(Qg + (size_t)t * 256 + ch * 8) = o; }
    }
    {
        bf16_t* Kg = (bf16_t*)(ws + WS_KWT) + (size_t)item * 256 * 128;
        const int dlo = lane & 15, sglo = lane >> 4;
#pragma unroll
        for (int i = 0; i < 8; ++i) { const int combo = wave * 8 + i, d = (combo >> 2) * 16 + dlo, s0 = ((combo & 3) * 4 + sglo) * 8;
            float v[8];
#pragma unroll
            for (int e = 0; e < 8; ++e) v[e] = bf2f(*(const LAS bf16_t*)(KL + (s0 + e) * PQ_PITCH + d * 2)) * __expf(AS[s0 + e] - Mlast);
            u32x4 o; o.x = pk2(v[0], v[1]); o.y = pk2(v[2], v[3]); o.z = pk2(v[4], v[5]); o.w = pk2(v[6], v[7]);
            *(u32x4*)(Kg + (size_t)d * 128 + s0) = o; }
    }
    __syncthreads();
}

__device__ __forceinline__ void hgrn_pre_item(const Args& a, LAS unsigned char* lds, int round, int item) {
    const int tid = tid_(), lane = tid & 63, wave = __builtin_amdgcn_readfirstlane(tid >> 6), fr = lane & 15, fq = lane >> 4;
    const int p = item >> 7, c = item & 127, bl = p >> 3, h = p & 7;
    const int tl0 = bl * SEQ + c * 64;
    unsigned char* ws = a.ws;
    LAS float* CUM = (LAS float*)lds;
    LAS float* GL = (LAS float*)(lds + 32768);
    LAS unsigned char* QH = lds + 65536;
    LAS unsigned char* KE = lds + 65536 + 64 * PS_PITCH;
    LAS float* QF = (LAS float*)(lds + 65536 + 128 * PS_PITCH);
#pragma unroll
    for (int i = 0; i < 2; ++i) { const int idx = tid + 512 * i, s = idx >> 4, ch = idx & 15;
        const u32x4 gv = *(const u32x4*)((const bf16_t*)(ws + WS_GFLOG) + (size_t)(tl0 + s) * 1024 + h * 128 + ch * 8);
        const u32x4 qv = *(const u32x4*)((const bf16_t*)(ws + WS_GQ) + (size_t)(tl0 + s) * 1024 + h * 128 + ch * 8);
        LAS float* gd = GL + s * 128 + ch * 8; LAS float* qd = QF + s * 128 + ch * 8;
        gd[0] = bf_lo(gv.x); gd[1] = bf_hi(gv.x); gd[2] = bf_lo(gv.y); gd[3] = bf_hi(gv.y); gd[4] = bf_lo(gv.z); gd[5] = bf_hi(gv.z); gd[6] = bf_lo(gv.w); gd[7] = bf_hi(gv.w);
        qd[0] = bf_lo(qv.x); qd[1] = bf_hi(qv.x); qd[2] = bf_lo(qv.y); qd[3] = bf_hi(qv.y); qd[4] = bf_lo(qv.z); qd[5] = bf_hi(qv.z); qd[6] = bf_lo(qv.w); qd[7] = bf_hi(qv.w); }
    __syncthreads();
    if (tid < 128) { float cs = 0.f;
        for (int s = 0; s < 64; ++s) { cs += GL[s * 128 + tid]; CUM[s * 128 + tid] = cs; }
        ((float*)(ws + WS_HGDEC))[(size_t)item * 128 + tid] = __expf(cs); }
    __syncthreads();
    {
        bf16_t* Qg = (bf16_t*)(ws + WS_QTG) + (size_t)item * 64 * 128;
#pragma unroll
        for (int i = 0; i < 2; ++i) { const int idx = tid + 512 * i, s = idx >> 4, ch = idx & 15;
            float qt[8], qh[8], ke[8];
#pragma unroll
            for (int e = 0; e < 8; ++e) { const int d = ch * 8 + e; const float cm = CUM[s * 128 + d], last = CUM[63 * 128 + d], q = QF[s * 128 + d], g = GL[s * 128 + d];
                qt[e] = q * __expf(cm); qh[e] = q * __expf(cm - last); ke[e] = (1.0f - __expf(g)) * __expf(last - cm); }
            u32x4 o; o.x = pk2(qt[0], qt[1]); o.y = pk2(qt[2], qt[3]); o.z = pk2(qt[4], qt[5]); o.w = pk2(qt[6], qt[7]);
            *(u32x4*)(Qg + (size_t)s * 128 + ch * 8) = o;
            o.x = pk2(qh[0], qh[1]); o.y = pk2(qh[2], qh[3]); o.z = pk2(qh[4], qh[5]); o.w = pk2(qh[6], qh[7]);
            *(LAS u32x4*)(QH + s * PS_PITCH + ch * 16) = o;
            o.x = pk2(ke[0], ke[1]); o.y = pk2(ke[2], ke[3]); o.z = pk2(ke[4], ke[5]); o.w = pk2(ke[6], ke[7]);
            *(LAS u32x4*)(KE + s * PS_PITCH + ch * 16) = o; }
    }
    __syncthreads();
    {
        bf16_t* Ag = (bf16_t*)(ws + WS_ATT) + (size_t)item * 64 * 64;
#pragma unroll
        for (int i = 0; i < 2; ++i) { const int tile = wave * 2 + i, tt = tile >> 2, st = tile & 3; const int t = tt * 16 + fr;
            u32x2 o = (u32x2){0u, 0u};
            if (st <= tt) { f32x4 acc = (f32x4){0.f, 0.f, 0.f, 0.f};
#pragma unroll
                for (int ks = 0; ks < 4; ++ks) acc = MFMA16(lfrag(KE, PS_PITCH, st * 16 + fr, ks * 32, fq), lfrag(QH, PS_PITCH, tt * 16 + fr, ks * 32, fq), acc);
                float v[4];
#pragma unroll
                for (int j = 0; j < 4; ++j) { const int s = st * 16 + 4 * fq + j; v[j] = (s <= t) ? acc[j] : 0.f; }
                o.x = pk2(v[0], v[1]); o.y = pk2(v[2], v[3]); }
            *(u32x2*)(Ag + (size_t)t * 64 + st * 16 + 4 * fq) = o; }
    }
    {
        bf16_t* Kg = (bf16_t*)(ws + WS_KENDT) + (size_t)item * 128 * 64;
        const int dlo = lane & 15, sglo = lane >> 4;
#pragma unroll
        for (int i = 0; i < 2; ++i) { const int combo = wave * 2 + i, d = (combo >> 1) * 16 + dlo, s0 = ((combo & 1) * 4 + sglo) * 8;
            unsigned v[8];
#pragma unroll
            for (int e = 0; e < 8; ++e) v[e] = *(const LAS bf16_t*)(KE + (s0 + e) * PS_PITCH + d * 2);
            u32x4 o; o.x = v[0] | (v[1] << 16); o.y = v[2] | (v[3] << 16); o.z = v[4] | (v[5] << 16); o.w = v[6] | (v[7] << 16);
            *(u32x4*)(Kg + (size_t)d * 64 + s0) = o; }
    }
    __syncthreads();
}

__device__ __forceinline__ void mlstm_scan(const Args& a, LAS unsigned char* lds, int round, int p, int sl) {
    const int tid = tid_(), lane = tid & 63, wave = __builtin_amdgcn_readfirstlane(tid >> 6), fr = lane & 15, fq = lane >> 4;
    const int bl = p >> 2, h = p & 3, b = round * 2 + bl;
    unsigned char* ws = a.ws;
    constexpr int VTB = 48 * PS_PITCH, CTB = 48 * PQ_PITCH;
    LAS unsigned char* VT = lds; LAS unsigned char* CT = lds + 2 * VTB;
    for (int i = tid; i < (2 * VTB + 2 * CTB) / 4; i += NTHR) ((LAS unsigned*)lds)[i] = 0u;
    __syncthreads();
    if (tid < 256) { const int bufi = tid >> 7, s = tid & 127; *(LAS bf16_t*)(VT + bufi * VTB + 32 * PS_PITCH + s * 2) = (bf16_t)0x3F80; }
    f32x4 st[2][3];
#pragma unroll
    for (int dt = 0; dt < 2; ++dt)
#pragma unroll
        for (int vt = 0; vt < 3; ++vt) st[dt][vt] = (f32x4){0.f, 0.f, 0.f, 0.f};
    const int vcol = h * 512 + sl * 32;
    const int vs = tid >> 2, vpart = tid & 3;
    const bf16_t* Sg0 = (const bf16_t*)(ws + WS_S) + (size_t)(p * 64) * 128 * 128 + (size_t)(wave * 16 + fr) * 128 + 8 * fq;
    const bf16_t* Qg0 = (const bf16_t*)(ws + WS_QT) + (size_t)(p * 64) * 128 * 256 + (size_t)(wave * 16 + fr) * 256 + 8 * fq;
    const bf16_t* Kg0 = (const bf16_t*)(ws + WS_KWT) + (size_t)(p * 64) * 256 * 128 + (size_t)(wave * 32 + fr) * 128 + 8 * fq;
    const bf16_t* Vg0 = (const bf16_t*)(ws + WS_V) + (size_t)(bl * SEQ + vs) * 2048 + vcol + vpart * 8;
    bf16x8 bS[4], bQ[8], aK[2][4]; u32x4 vreg; float dec;
#pragma unroll
    for (int ks = 0; ks < 4; ++ks) bS[ks] = *(const bf16x8*)(Sg0 + ks * 32);
#pragma unroll
    for (int ks = 0; ks < 8; ++ks) bQ[ks] = *(const bf16x8*)(Qg0 + ks * 32);
#pragma unroll
    for (int dt = 0; dt < 2; ++dt)
#pragma unroll
        for (int ks = 0; ks < 4; ++ks) aK[dt][ks] = *(const bf16x8*)(Kg0 + (size_t)dt * 16 * 128 + ks * 32);
    vreg = *(const u32x4*)Vg0; dec = ((const float*)(ws + WS_MDEC))[p * 64];
#pragma unroll 1
    for (int c = 0; c < 64; ++c) {
        const int tl0 = bl * SEQ + c * 128; const size_t tg0 = (size_t)b * SEQ + c * 128;
        const int cn = c < 63 ? c + 1 : 63;
        LAS unsigned char* vt_ = VT + (c & 1) * VTB; LAS unsigned char* ct_ = CT + (c & 1) * CTB; LAS unsigned char* ctn = CT + ((c + 1) & 1) * CTB;
        {
            LAS unsigned char* d0 = vt_ + (vpart * 8) * PS_PITCH + vs * 2;
            *(LAS bf16_t*)(d0 + 0 * PS_PITCH) = (bf16_t)(vreg.x & 0xffffu); *(LAS bf16_t*)(d0 + 1 * PS_PITCH) = (bf16_t)(vreg.x >> 16);
            *(LAS bf16_t*)(d0 + 2 * PS_PITCH) = (bf16_t)(vreg.y & 0xffffu); *(LAS bf16_t*)(d0 + 3 * PS_PITCH) = (bf16_t)(vreg.y >> 16);
            *(LAS bf16_t*)(d0 + 4 * PS_PITCH) = (bf16_t)(vreg.z & 0xffffu); *(LAS bf16_t*)(d0 + 5 * PS_PITCH) = (bf16_t)(vreg.z >> 16);
            *(LAS bf16_t*)(d0 + 6 * PS_PITCH) = (bf16_t)(vreg.w & 0xffffu); *(LAS bf16_t*)(d0 + 7 * PS_PITCH) = (bf16_t)(vreg.w >> 16);
            vreg = *(const u32x4*)(Vg0 + (size_t)cn * 128 * 2048);
        }
        __syncthreads();
        bf16x8 vf[3][4];
#pragma unroll
        for (int vt = 0; vt < 3; ++vt)
#pragma unroll
            for (int ks = 0; ks < 4; ++ks) vf[vt][ks] = lfrag(vt_, PS_PITCH, vt * 16 + fr, ks * 32, fq);
        {
            f32x4 acc[3];
#pragma unroll
            for (int vt = 0; vt < 3; ++vt) acc[vt] = (f32x4){0.f, 0.f, 0.f, 0.f};
            bf16x8 cf[3][4];
#pragma unroll
            for (int vt = 0; vt < 3; ++vt)
#pragma unroll
                for (int ks = 0; ks < 4; ++ks) cf[vt][ks] = lfrag(ct_, PQ_PITCH, vt * 16 + fr, ks * 32, fq);
            __builtin_amdgcn_sched_barrier(0);
#pragma unroll
            for (int ks = 0; ks < 4; ++ks) {
#pragma unroll
                for (int vt = 0; vt < 3; ++vt) acc[vt] = MFMA16(vf[vt][ks], bS[ks], acc[vt]); }
#pragma unroll
            for (int ks = 0; ks < 4; ++ks) {
#pragma unroll
                for (int vt = 0; vt < 3; ++vt) acc[vt] = MFMA16(cf[vt][ks], bQ[ks], acc[vt]); }
            __builtin_amdgcn_sched_barrier(0);
#pragma unroll
            for (int vt = 0; vt < 3; ++vt)
#pragma unroll
                for (int ks = 0; ks < 4; ++ks) cf[vt][ks] = lfrag(ct_, PQ_PITCH, vt * 16 + fr, 128 + ks * 32, fq);
            __builtin_amdgcn_sched_barrier(0);
#pragma unroll
            for (int ks = 0; ks < 4; ++ks) {
#pragma unroll
                for (int vt = 0; vt < 3; ++vt) acc[vt] = MFMA16(cf[vt][ks], bQ[4 + ks], acc[vt]); }
            __builtin_amdgcn_sched_barrier(0);
#pragma unroll
            for (int ks = 0; ks < 4; ++ks) bS[ks] = *(const bf16x8*)(Sg0 + (size_t)cn * 128 * 128 + ks * 32);
#pragma unroll
            for (int ks = 0; ks < 8; ++ks) bQ[ks] = *(const bf16x8*)(Qg0 + (size_t)cn * 128 * 256 + ks * 32);
            const int t = wave * 16 + fr;
            bf16_t* hn = (bf16_t*)(ws + WS_QKPRE) + (size_t)(tl0 + t) * 2048 + vcol + 4 * fq;
#pragma unroll
            for (int vt = 0; vt < 2; ++vt) { u32x2 o; o.x = pk2(acc[vt][0], acc[vt][1]); o.y = pk2(acc[vt][2], acc[vt][3]); *(u32x2*)(hn + vt * 16) = o; }
            if (sl == 0 && fq == 0) ((float*)(ws + WS_DEN))[(tg0 + t) * 4 + h] = acc[2][0];
        }
        {
#pragma unroll
            for (int dt = 0; dt < 2; ++dt)
#pragma unroll
                for (int vt = 0; vt < 3; ++vt) st[dt][vt] = st[dt][vt] * dec;
#pragma unroll
            for (int ks = 0; ks < 4; ++ks) {
#pragma unroll
                for (int dt = 0; dt < 2; ++dt) {
#pragma unroll
                    for (int vt = 0; vt < 3; ++vt) st[dt][vt] = MFMA16(aK[dt][ks], vf[vt][ks], st[dt][vt]); }
            }
            __builtin_amdgcn_sched_barrier(0);
#pragma unroll
            for (int dt = 0; dt < 2; ++dt)
#pragma unroll
                for (int ks = 0; ks < 4; ++ks) aK[dt][ks] = *(const bf16x8*)(Kg0 + (size_t)cn * 256 * 128 + (size_t)dt * 16 * 128 + ks * 32);
            dec = ((const float*)(ws + WS_MDEC))[p * 64 + cn];
#pragma unroll
            for (int dt = 0; dt < 2; ++dt)
#pragma unroll
                for (int vt = 0; vt < 3; ++vt) { u32x2 o; o.x = pk2(st[dt][vt][0], st[dt][vt][1]); o.y = pk2(st[dt][vt][2], st[dt][vt][3]);
                    *(LAS u32x2*)(ctn + (vt * 16 + fr) * PQ_PITCH + (wave * 32 + dt * 16 + 4 * fq) * 2) = o; }
        }
    }
    __syncthreads();
}

__device__ __forceinline__ void hgrn_scan(const Args& a, LAS unsigned char* lds, int round, int p, int sl) {
    const int tid = tid_(), lane = tid & 63, wave = __builtin_amdgcn_readfirstlane(tid >> 6), fr = lane & 15, fq = lane >> 4;
    const int bl = p >> 3, h = p & 7;
    unsigned char* ws = a.ws;
    constexpr int IP = 144, ITB = 16 * IP, STB = 16 * PS_PITCH;
    LAS unsigned char* IT = lds; LAS unsigned char* ST = lds + 2 * ITB;
    for (int i = tid; i < (2 * ITB + 2 * STB) / 4; i += NTHR) ((LAS unsigned*)lds)[i] = 0u;
    __syncthreads();
    f32x4 st = (f32x4){0.f, 0.f, 0.f, 0.f};
    const int vcol = h * 128 + sl * 16;
    const int is = (tid & 127) >> 1, ipart = tid & 1;
    const int w4 = wave & 3;
    const bf16_t* Ag0 = (const bf16_t*)(ws + WS_ATT) + (size_t)(p * 128) * 64 * 64 + (size_t)(w4 * 16 + fr) * 64 + 8 * fq;
    const bf16_t* Qg0 = (const bf16_t*)(ws + WS_QTG) + (size_t)(p * 128) * 64 * 128 + (size_t)(w4 * 16 + fr) * 128 + 8 * fq;
    const bf16_t* Kg0 = (const bf16_t*)(ws + WS_KENDT) + (size_t)(p * 128) * 128 * 64 + (size_t)(wave * 16 + fr) * 64 + 8 * fq;
    const float* Dg0 = (const float*)(ws + WS_HGDEC) + (size_t)(p * 128) * 128 + wave * 16 + 4 * fq;
    const bf16_t* Ig0 = (const bf16_t*)(ws + WS_GI) + (size_t)(bl * SEQ + is) * 1024 + vcol + ipart * 8;
    bf16x8 bA[2], bQ[4], aK[2]; f32x4 dec; u32x4 ireg;
#pragma unroll
    for (int ks = 0; ks < 2; ++ks) { bA[ks] = *(const bf16x8*)(Ag0 + ks * 32); aK[ks] = *(const bf16x8*)(Kg0 + ks * 32); }
#pragma unroll
    for (int ks = 0; ks < 4; ++ks) bQ[ks] = *(const bf16x8*)(Qg0 + ks * 32);
    dec = *(const f32x4*)Dg0; ireg = *(const u32x4*)Ig0;
#pragma unroll 1
    for (int c = 0; c < 128; ++c) {
        const int tl0 = bl * SEQ + c * 64;
        const int cn = c < 127 ? c + 1 : 127;
        LAS unsigned char* it_ = IT + (c & 1) * ITB; LAS unsigned char* st_ = ST + (c & 1) * STB; LAS unsigned char* stn = ST + ((c + 1) & 1) * STB;
        if (tid < 128) {
            LAS unsigned char* d0 = it_ + (ipart * 8) * IP + is * 2;
            *(LAS bf16_t*)(d0 + 0 * IP) = (bf16_t)(ireg.x & 0xffffu); *(LAS bf16_t*)(d0 + 1 * IP) = (bf16_t)(ireg.x >> 16);
            *(LAS bf16_t*)(d0 + 2 * IP) = (bf16_t)(ireg.y & 0xffffu); *(LAS bf16_t*)(d0 + 3 * IP) = (bf16_t)(ireg.y >> 16);
            *(LAS bf16_t*)(d0 + 4 * IP) = (bf16_t)(ireg.z & 0xffffu); *(LAS bf16_t*)(d0 + 5 * IP) = (bf16_t)(ireg.z >> 16);
            *(LAS bf16_t*)(d0 + 6 * IP) = (bf16_t)(ireg.w & 0xffffu); *(LAS bf16_t*)(d0 + 7 * IP) = (bf16_t)(ireg.w >> 16); }
        ireg = *(const u32x4*)(Ig0 + (size_t)cn * 64 * 1024);
        __syncthreads();
        if (wave < 4) {
            f32x4 acc = (f32x4){0.f, 0.f, 0.f, 0.f};
#pragma unroll
            for (int ks = 0; ks < 2; ++ks) acc = MFMA16(lfrag(it_, IP, fr, ks * 32, fq), bA[ks], acc);
#pragma unroll
            for (int ks = 0; ks < 4; ++ks) acc = MFMA16(lfrag(st_, PS_PITCH, fr, ks * 32, fq), bQ[ks], acc);
#pragma unroll
            for (int ks = 0; ks < 2; ++ks) bA[ks] = *(const bf16x8*)(Ag0 + (size_t)cn * 64 * 64 + ks * 32);
#pragma unroll
            for (int ks = 0; ks < 4; ++ks) bQ[ks] = *(const bf16x8*)(Qg0 + (size_t)cn * 64 * 128 + ks * 32);
            u32x2 o; o.x = pk2(acc[0], acc[1]); o.y = pk2(acc[2], acc[3]);
            *(u32x2*)((bf16_t*)(ws + WS_GQ) + (size_t)(tl0 + wave * 16 + fr) * 1024 + vcol + 4 * fq) = o;
        }
        {
            st = st * dec;
#pragma unroll
            for (int ks = 0; ks < 2; ++ks) st = MFMA16(aK[ks], lfrag(it_, IP, fr, ks * 32, fq), st);
#pragma unroll
            for (int ks = 0; ks < 2; ++ks) aK[ks] = *(const bf16x8*)(Kg0 + (size_t)cn * 128 * 64 + ks * 32);
            dec = *(const f32x4*)(Dg0 + (size_t)cn * 128);
            u32x2 o; o.x = pk2(st[0], st[1]); o.y = pk2(st[2], st[3]);
            *(LAS u32x2*)(stn + fr * PS_PITCH + (wave * 16 + 4 * fq) * 2) = o;
        }
    }
    __syncthreads();
}

__device__ __forceinline__ void phase_ypass(const Args& a, int round, int vcu, int G) {
    const int tid = tid_(), lane = tid & 63, wave = tid >> 6;
    const int gw = vcu * NWAVES + wave, NGW = G * NWAVES;
    unsigned char* ws = a.ws;
    for (int tl = gw; tl < RT; tl += NGW) {
        const size_t tg = (size_t)round * RT + tl;
        const f32x4 den4 = *(const f32x4*)((const float*)(ws + WS_DEN) + tg * 4), mt4 = *(const f32x4*)((const float*)(ws + WS_MT) + tg * 4);
#pragma unroll
        for (int j = 0; j < 4; ++j) {
            const int col = j * 512 + lane * 8;
            const u32x4 nv = *(const u32x4*)((const bf16_t*)(ws + WS_QKPRE) + (size_t)tl * 2048 + col);
            const u32x4 ov = *(const u32x4*)((const bf16_t*)(ws + WS_SIGO) + (size_t)tl * 2048 + col);
            const float inv = 1.0f / fmaxf(fabsf(den4[j]), __expf(-mt4[j]));
            float hv[8] = {bf_lo(nv.x) * inv, bf_hi(nv.x) * inv, bf_lo(nv.y) * inv, bf_hi(nv.y) * inv, bf_lo(nv.z) * inv, bf_hi(nv.z) * inv, bf_lo(nv.w) * inv, bf_hi(nv.w) * inv};
            float ss = 0.f;
#pragma unroll
            for (int e = 0; e < 8; ++e) ss += hv[e] * hv[e];
            const float r = rsqrtf(wave_sum(ss, lane) * (1.f / 512.f) + EPS);
            const f32x4 g0 = *(const f32x4*)(a.m_head_g + col), g1 = *(const f32x4*)(a.m_head_g + col + 4);
            const float og[8] = {bf_lo(ov.x), bf_hi(ov.x), bf_lo(ov.y), bf_hi(ov.y), bf_lo(ov.z), bf_hi(ov.z), bf_lo(ov.w), bf_hi(ov.w)};
            float y[8];
#pragma unroll
            for (int e = 0; e < 8; ++e) y[e] = og[e] * hv[e] * r * (e < 4 ? g0[e] : g1[e - 4]);
            u32x4 o; o.x = pk2(y[0], y[1]); o.y = pk2(y[2], y[3]); o.z = pk2(y[4], y[5]); o.w = pk2(y[6], y[7]);
            *(u32x4*)((bf16_t*)(ws + WS_V) + (size_t)tl * 2048 + col) = o;
        }
        {
            const int col = lane * 16;
            const u32x4 n0 = *(const u32x4*)((const bf16_t*)(ws + WS_GQ) + (size_t)tl * 1024 + col), n1 = *(const u32x4*)((const bf16_t*)(ws + WS_GQ) + (size_t)tl * 1024 + col + 8);
            const u32x4 s0 = *(const u32x4*)((const bf16_t*)(ws + WS_SGG) + (size_t)tl * 1024 + col), s1 = *(const u32x4*)((const bf16_t*)(ws + WS_SGG) + (size_t)tl * 1024 + col + 8);
            float ov[16] = {bf_lo(n0.x), bf_hi(n0.x), bf_lo(n0.y), bf_hi(n0.y), bf_lo(n0.z), bf_hi(n0.z), bf_lo(n0.w), bf_hi(n0.w), bf_lo(n1.x), bf_hi(n1.x), bf_lo(n1.y), bf_hi(n1.y), bf_lo(n1.z), bf_hi(n1.z), bf_lo(n1.w), bf_hi(n1.w)};
            const float sg[16] = {bf_lo(s0.x), bf_hi(s0.x), bf_lo(s0.y), bf_hi(s0.y), bf_lo(s0.z), bf_hi(s0.z), bf_lo(s0.w), bf_hi(s0.w), bf_lo(s1.x), bf_hi(s1.x), bf_lo(s1.y), bf_hi(s1.y), bf_lo(s1.z), bf_hi(s1.z), bf_lo(s1.w), bf_hi(s1.w)};
            float ss = 0.f;
#pragma unroll
            for (int e = 0; e < 16; ++e) ss += ov[e] * ov[e];
            ss += shx(ss, 1, lane); ss += shx(ss, 2, lane); ss += shx(ss, 4, lane);
            const float r = rsqrtf(ss * (1.f / 128.f) + EPS);
            float y[16];
#pragma unroll
            for (int e = 0; e < 16; ++e) y[e] = ov[e] * r * a.g_head_g[col + e] * sg[e];
            u32x4 o; o.x = pk2(y[0], y[1]); o.y = pk2(y[2], y[3]); o.z = pk2(y[4], y[5]); o.w = pk2(y[6], y[7]);
            *(u32x4*)((bf16_t*)(ws + WS_GI) + (size_t)tl * 1024 + col) = o;
            o.x = pk2(y[8], y[9]); o.y = pk2(y[10], y[11]); o.z = pk2(y[12], y[13]); o.w = pk2(y[14], y[15]);
            *(u32x4*)((bf16_t*)(ws + WS_GI) + (size_t)tl * 1024 + col + 8) = o;
        }
    }
}


__device__ __forceinline__ void phase_p8(const Args& a, int vcu, int G) {
    const int tid = tid_(), lane = tid & 63, wave = tid >> 6;
    const int gw = vcu * NWAVES + wave, NGW = G * NWAVES;
    unsigned char* ws = a.ws;
    f32x4 g2[4];
#pragma unroll
    for (int j = 0; j < 4; ++j) g2[j] = ((const f32x4*)a.norm2_g)[64 * j + lane];
    for (int m = gw; m < T; m += NGW) {
        const f32x4* xr = (const f32x4*)(a.out + (size_t)m * D) + lane;
        f32x4 v[4]; float s = 0.f;
#pragma unroll
        for (int j = 0; j < 4; ++j) { v[j] = xr[64 * j]; s += (v[j][0] * v[j][0] + v[j][1] * v[j][1]) + (v[j][2] * v[j][2] + v[j][3] * v[j][3]); }
        const float rstd = rsqrtf(wave_sum(s, lane) * (1.f / D) + EPS);
        unsigned long long* o8 = (unsigned long long*)((bf16_t*)(ws + WS_XN) + (size_t)m * D) + lane;
#pragma unroll
        for (int j = 0; j < 4; ++j) { v[j] = v[j] * rstd * g2[j]; o8[64 * j] = (unsigned long long)pk2(v[j][0], v[j][1]) | ((unsigned long long)pk2(v[j][2], v[j][3]) << 32); }
    }
    for (int r = gw; r < 2 * 16384; r += NGW) {
        const bool isv = r >= 16384; const int row = isv ? r - 16384 : r;
        const float* src = (isv ? a.v_emb : a.u_emb) + (size_t)row * D + lane * 16;
        f32x4 v[4]; float mx = 0.f;
#pragma unroll
        for (int j = 0; j < 4; ++j) { v[j] = *(const f32x4*)(src + 4 * j); mx = fmaxf(mx, fmaxf(fmaxf(fabsf(v[j][0]), fabsf(v[j][1])), fmaxf(fabsf(v[j][2]), fabsf(v[j][3])))); }
#pragma unroll
        for (int o = 1; o < 64; o <<= 1) mx = fmaxf(mx, shx(mx, o, lane));
        const float sc = mx > 0.f ? 448.0f / mx : 1.0f;
        u32x4 o;
#pragma unroll
        for (int j = 0; j < 4; ++j) { int p = __builtin_amdgcn_cvt_pk_fp8_f32(v[j][0] * sc, v[j][1] * sc, 0, false); p = __builtin_amdgcn_cvt_pk_fp8_f32(v[j][2] * sc, v[j][3] * sc, p, true); o[j] = (unsigned)p; }
        *(u32x4*)(ws + (isv ? WS_VB : WS_UB) + (size_t)row * 1024 + lane * 16) = o;
        if (lane == 0) ((float*)(ws + (isv ? WS_VSC : WS_USC)))[row] = mx > 0.f ? mx * (1.0f / 448.0f) : 1.0f;
    }
}

__device__ __forceinline__ unsigned f2ord(float f) { const unsigned u = __builtin_bit_cast(unsigned, f); return (u & 0x80000000u) ? ~u : (u | 0x80000000u); }
__device__ __forceinline__ float ord2f(unsigned k) { const unsigned u = (k & 0x80000000u) ? (k & 0x7fffffffu) : ~k; return __builtin_bit_cast(float, u); }
__device__ __forceinline__ unsigned umax_(unsigned a, unsigned b) { return a > b ? a : b; }
__device__ __forceinline__ unsigned shxu(unsigned v, int o, int lane) { return (unsigned)__builtin_amdgcn_ds_bpermute((lane ^ o) << 2, (int)v); }

__device__ __forceinline__ void phase_topk(const Args& a, LAS unsigned char* lds, int bx, int G) {
    const int tid = tid_(), lane = tid & 63, wave = __builtin_amdgcn_readfirstlane(tid >> 6), fr = lane & 15, fq = lane >> 4;
    unsigned char* ws = a.ws;
    const int h = bx & 7;
    LAS unsigned char* KY = lds;
    LAS unsigned char* QL = lds + 2 * 128 * PS_PITCH;
    LAS unsigned* TOP = (LAS unsigned*)(lds + 2 * 128 * PS_PITCH + 64 * PQ_PITCH);
#pragma unroll
    for (int i = 0; i < 8; ++i) { const int idx = tid + 512 * i, row = idx >> 4, ch = idx & 15;
        *(LAS u32x4*)(KY + row * PS_PITCH + ch * 16) = *(const u32x4*)((const bf16_t*)(ws + WS_SK) + ((size_t)h * 256 + row) * 128 + ch * 8); }
    const int ntile = T / 64;
    for (int tile = bx >> 3; tile < ntile; tile += (G >> 3)) {
        const size_t t0 = (size_t)tile * 64;
        __syncthreads();
#pragma unroll
        for (int i = 0; i < 4; ++i) { const int idx = tid + 512 * i, row = idx >> 5, ch = idx & 31;
            *(LAS u32x4*)(QL + row * PQ_PITCH + ch * 16) = *(const u32x4*)((const bf16_t*)(ws + WS_QP) + (t0 + row) * 2048 + h * 256 + ch * 8); }
        __syncthreads();
        {
            const int mt = wave & 3, p = wave >> 2;
            unsigned key[32];
#pragma unroll
            for (int nt = 0; nt < 8; ++nt) { f32x4 acc = (f32x4){0.f, 0.f, 0.f, 0.f};
#pragma unroll
                for (int ks = 0; ks < 4; ++ks) acc = MFMA16(lfrag(KY + p * 128 * PS_PITCH, PS_PITCH, nt * 16 + fr, ks * 32, fq), lfrag(QL, PQ_PITCH, mt * 16 + fr, p * 128 + ks * 32, fq), acc);
#pragma unroll
                for (int j = 0; j < 4; ++j) { const int n = nt * 16 + 4 * fq + j; key[nt * 4 + j] = (f2ord(acc[j]) & ~127u) | (unsigned)(127 - n); } }
#pragma unroll 1
            for (int k = 0; k < 16; ++k) {
                unsigned m = key[0];
#pragma unroll
                for (int e = 1; e < 32; ++e) m = umax_(m, key[e]);
                m = umax_(m, shxu(m, 16, lane)); m = umax_(m, shxu(m, 32, lane));
#pragma unroll
                for (int e = 0; e < 32; ++e) key[e] = (key[e] == m) ? 0u : key[e];
                if (fq == (k & 3)) TOP[(p * 64 + mt * 16 + fr) * 16 + k] = m;
            }
        }
        __syncthreads();
        {
            const int t = tid >> 3, sub = tid & 7;
            unsigned ck[7];
#pragma unroll
            for (int e = 0; e < 7; ++e) {
                const int ci = sub + 8 * e;
                int i = 0, base = 0; bool ok = ci < 50;
                if (ci >= 42) { i = 8 + (ci - 42); base = ci; } else if (ci >= 40) { i = 7; base = 40; } else if (ci >= 38) { i = 6; base = 38; } else if (ci >= 36) { i = 5; base = 36; }
                else if (ci >= 33) { i = 4; base = 33; } else if (ci >= 29) { i = 3; base = 29; } else if (ci >= 24) { i = 2; base = 24; } else if (ci >= 16) { i = 1; base = 16; }
                const int j = ci - base;
                unsigned kk = 0u;
                if (ok) { const float s0 = ord2f(TOP[(0 * 64 + t) * 16 + i] & ~127u), s1 = ord2f(TOP[(1 * 64 + t) * 16 + j] & ~127u);
                    kk = (f2ord(s0 + s1) & ~255u) | (unsigned)(255 - (i * 16 + j)); }
                ck[e] = kk;
            }
            unsigned w0 = 0u, w1 = 0u;
#pragma unroll 1
            for (int k = 0; k < 16; ++k) {
                unsigned m = ck[0];
#pragma unroll
                for (int e = 1; e < 7; ++e) m = umax_(m, ck[e]);
                m = umax_(m, shxu(m, 1, lane)); m = umax_(m, shxu(m, 2, lane)); m = umax_(m, shxu(m, 4, lane));
#pragma unroll
                for (int e = 0; e < 7; ++e) ck[e] = (ck[e] == m) ? 0u : ck[e];
                if (k == sub) w0 = m; if (k == sub + 8) w1 = m;
            }
            const int f0 = 255 - (int)(w0 & 255u), f1 = 255 - (int)(w1 & 255u);
            const float sc0 = ord2f(w0 & ~255u), sc1 = ord2f(w1 & ~255u);
            float mx = fmaxf(sc0, sc1); mx = fmaxf(mx, shx(mx, 1, lane)); mx = fmaxf(mx, shx(mx, 2, lane)); mx = fmaxf(mx, shx(mx, 4, lane));
            const float e0 = __expf(sc0 - mx), e1 = __expf(sc1 - mx);
            float sm = e0 + e1; sm += shx(sm, 1, lane); sm += shx(sm, 2, lane); sm += shx(sm, 4, lane);
            const float inv = 1.0f / sm;
            const int i0 = 127 - (int)(TOP[(0 * 64 + t) * 16 + (f0 >> 4)] & 127u), j0 = 127 - (int)(TOP[(1 * 64 + t) * 16 + (f0 & 15)] & 127u);
            const int i1 = 127 - (int)(TOP[(0 * 64 + t) * 16 + (f1 >> 4)] & 127u), j1 = 127 - (int)(TOP[(1 * 64 + t) * 16 + (f1 & 15)] & 127u);
            int* ei = (int*)(ws + WS_EIDX) + ((t0 + t) * 8 + h) * 16; float* gp = (float*)(ws + WS_GATE) + ((t0 + t) * 8 + h) * 16;
            ei[sub] = i0 * 128 + j0; ei[sub + 8] = i1 * 128 + j1; gp[sub] = e0 * inv; gp[sub + 8] = e1 * inv;
        }
    }
    __syncthreads();
}

__device__ __forceinline__ void ins16(float (&v)[16], int (&id)[16], float x, int n) {
    if (x > v[15]) { v[15] = x; id[15] = n;
#pragma unroll
        for (int i = 15; i >= 1; --i) { if (v[i] > v[i - 1]) { const float tv = v[i]; v[i] = v[i - 1]; v[i - 1] = tv; const int ti = id[i]; id[i] = id[i - 1]; id[i - 1] = ti; } } }
}
__device__ __forceinline__ void phase_topk_ref(const Args& a, int vcu, int G) {
    const int tid = tid_();
    unsigned char* ws = a.ws;
    const int gt = vcu * NTHR + tid, NGT = G * NTHR;
    for (int pair = gt; pair < T * 8; pair += NGT) {
        const int t = pair >> 3, h = pair & 7;
        float sv[2][16]; int si[2][16];
#pragma unroll
        for (int p = 0; p < 2; ++p) {
#pragma unroll
            for (int i = 0; i < 16; ++i) { sv[p][i] = -INFINITY; si[p][i] = 0; }
            const bf16_t* qp = (const bf16_t*)(ws + WS_QP) + (size_t)t * 2048 + h * 256 + p * 128;
            for (int n = 0; n < 128; ++n) {
                const bf16_t* kp = (const bf16_t*)(ws + WS_SK) + ((size_t)(h * 2 + p) * 128 + n) * 128;
                float s = 0.f;
                for (int c = 0; c < 128; c += 8) { const u32x4 qv = *(const u32x4*)(qp + c), kv = *(const u32x4*)(kp + c);
                    s += bf_lo(qv.x) * bf_lo(kv.x) + bf_hi(qv.x) * bf_hi(kv.x) + bf_lo(qv.y) * bf_lo(kv.y) + bf_hi(qv.y) * bf_hi(kv.y)
                       + bf_lo(qv.z) * bf_lo(kv.z) + bf_hi(qv.z) * bf_hi(kv.z) + bf_lo(qv.w) * bf_lo(kv.w) + bf_hi(qv.w) * bf_hi(kv.w); }
                ins16(sv[p], si[p], s, n);
            }
        }
        float tv[16]; int ti[16];
#pragma unroll
        for (int i = 0; i < 16; ++i) { tv[i] = -INFINITY; ti[i] = 0; }
#pragma unroll
        for (int i = 0; i < 16; ++i)
#pragma unroll
            for (int j = 0; j < 16; ++j) ins16(tv, ti, sv[0][i] + sv[1][j], i * 16 + j);
        float sm = 0.f, ex[16];
#pragma unroll
        for (int k = 0; k < 16; ++k) { ex[k] = __expf(tv[k] - tv[0]); sm += ex[k]; }
        int* ei = (int*)(ws + WS_EIDX) + (size_t)pair * 16; float* gp = (float*)(ws + WS_GATE) + (size_t)pair * 16;
#pragma unroll
        for (int k = 0; k < 16; ++k) {
            int e0 = 0, e1 = 0;
#pragma unroll
            for (int i = 0; i < 16; ++i) { e0 = ((ti[k] >> 4) == i) ? si[0][i] : e0; e1 = ((ti[k] & 15) == i) ? si[1][i] : e1; }
            ei[k] = e0 * 128 + e1; gp[k] = ex[k] / sm; }
    }
}

#define FP8LO(w) __builtin_amdgcn_cvt_pk_f32_fp8((int)(w), false)
#define FP8HI(w) __builtin_amdgcn_cvt_pk_f32_fp8((int)(w), true)
__device__ __forceinline__ float dot16_fp8(const u32x4 r, const float (&x)[16]) {
    float c = 0.f;
#pragma unroll
    for (int j = 0; j < 4; ++j) { const f32x2 lo = FP8LO(r[j]), hi = FP8HI(r[j]); c += lo[0] * x[4 * j] + lo[1] * x[4 * j + 1] + hi[0] * x[4 * j + 2] + hi[1] * x[4 * j + 3]; }
    return c;
}
__device__ __forceinline__ float bperm(float v, int srclane) { return __builtin_bit_cast(float, __builtin_amdgcn_ds_bpermute(srclane << 2, __builtin_bit_cast(int, v))); }
__device__ __forceinline__ float reduce8(const float (&p)[8], int lane) {
    float q4[4], q2[2];
    const bool b5 = lane & 32, b4 = lane & 16, b3 = lane & 8;
#pragma unroll
    for (int i = 0; i < 4; ++i) { const float send = b5 ? p[i] : p[i + 4], keep = b5 ? p[i + 4] : p[i]; q4[i] = keep + bperm(send, lane ^ 32); }
#pragma unroll
    for (int i = 0; i < 2; ++i) { const float send = b4 ? q4[i] : q4[i + 2], keep = b4 ? q4[i + 2] : q4[i]; q2[i] = keep + bperm(send, lane ^ 16); }
    const float send = b3 ? q2[0] : q2[1], keep = b3 ? q2[1] : q2[0];
    float q1 = keep + bperm(send, lane ^ 8);
    q1 += bperm(q1, lane ^ 4); q1 += bperm(q1, lane ^ 2); q1 += bperm(q1, lane ^ 1);
    return q1;
}
__device__ __forceinline__ void phase_gather(const Args& a, LAS unsigned char* lds, int bx, int G) {
    const int tid = tid_(), lane = tid & 63, wave = __builtin_amdgcn_readfirstlane(tid >> 6);
    unsigned char* ws = a.ws;
    LAS float* PART = (LAS float*)lds;
    LAS float* RED = (LAS float*)(lds + 32768);
    const unsigned char* UB = ws + WS_UB; const unsigned char* VB = ws + WS_VB;
    const int h = wave, g8 = lane >> 3;
#define G_INFO(tok_, em_, cu_, cv_) do { em_ = 0; cu_ = 0.f; cv_ = 0.f; if (lane < 16) { em_ = ((const int*)(ws + WS_EIDX))[((size_t)(tok_) * 8 + h) * 16 + lane]; \
        const float g_ = ((const float*)(ws + WS_GATE))[((size_t)(tok_) * 8 + h) * 16 + lane]; cu_ = ((const float*)(ws + WS_USC))[em_]; cv_ = g_ * ((const float*)(ws + WS_VSC))[em_]; } } while (0)
#define G_ISSUE(R_, TB_, em_, off_) do { _Pragma("unroll") for (int k_ = 0; k_ < 8; ++k_) { const int e_ = __builtin_amdgcn_readlane(em_, (off_) + k_); R_[k_] = *(const u32x4*)((TB_) + (size_t)e_ * 1024 + lane * 16); } } while (0)
#define G_DOTS(R_, off_, w_) do { float p_[8]; _Pragma("unroll") for (int k_ = 0; k_ < 8; ++k_) p_[k_] = dot16_fp8(R_[k_], xf); \
        const float d_ = reduce8(p_, lane) * bperm(cu, (off_) + g8); w_ = 0.5f * d_ * (1.0f + erff(d_ * 0.70710678118654752f)) * bperm(cv, (off_) + g8); } while (0)
#define G_ACC(R_, w_) do { _Pragma("unroll") for (int k_ = 0; k_ < 8; ++k_) { const float wk_ = rdlane(w_, 8 * k_); _Pragma("unroll") for (int j_ = 0; j_ < 4; ++j_) { const f32x2 lo_ = FP8LO(R_[k_][j_]), hi_ = FP8HI(R_[k_][j_]); \
        acc[4 * j_] += wk_ * lo_[0]; acc[4 * j_ + 1] += wk_ * lo_[1]; acc[4 * j_ + 2] += wk_ * hi_[0]; acc[4 * j_ + 3] += wk_ * hi_[1]; } } } while (0)
    int tok = bx;
    int em, emN = 0; float cu, cv, cuN = 0.f, cvN = 0.f;
    u32x4 A[8], B[8];
    u32x4 xq0 = (u32x4){0u, 0u, 0u, 0u}, xq1 = xq0;
    if (tok < T) { G_INFO(tok, em, cu, cv); G_ISSUE(A, UB, em, 0); G_ISSUE(B, UB, em, 8);
        xq0 = *(const u32x4*)((const bf16_t*)(ws + WS_XN) + (size_t)tok * D + lane * 16); xq1 = *(const u32x4*)((const bf16_t*)(ws + WS_XN) + (size_t)tok * D + lane * 16 + 8); }
    for (; tok < T; tok += G) {
        const int tokN = tok + G; const bool hasN = tokN < T;
        const float xf[16] = {bf_lo(xq0.x), bf_hi(xq0.x), bf_lo(xq0.y), bf_hi(xq0.y), bf_lo(xq0.z), bf_hi(xq0.z), bf_lo(xq0.w), bf_hi(xq0.w),
                              bf_lo(xq1.x), bf_hi(xq1.x), bf_lo(xq1.y), bf_hi(xq1.y), bf_lo(xq1.z), bf_hi(xq1.z), bf_lo(xq1.w), bf_hi(xq1.w)};
        if (hasN) { G_INFO(tokN, emN, cuN, cvN);
            xq0 = *(const u32x4*)((const bf16_t*)(ws + WS_XN) + (size_t)tokN * D + lane * 16); xq1 = *(const u32x4*)((const bf16_t*)(ws + WS_XN) + (size_t)tokN * D + lane * 16 + 8); }
        float wA, wB;
        G_DOTS(A, 0, wA);
        G_ISSUE(A, VB, em, 0);
        G_DOTS(B, 8, wB);
        G_ISSUE(B, VB, em, 8);
        float acc[16];
#pragma unroll
        for (int e = 0; e < 16; ++e) acc[e] = 0.f;
        G_ACC(A, wA);
        if (hasN) G_ISSUE(A, UB, emN, 0);
        G_ACC(B, wB);
        if (hasN) G_ISSUE(B, UB, emN, 8);
        __syncthreads();
        {
            LAS float* pw = PART + h * 1024 + lane * 16;
#pragma unroll
            for (int j = 0; j < 4; ++j) *(LAS f32x4*)(pw + 4 * j) = (f32x4){acc[4 * j], acc[4 * j + 1], acc[4 * j + 2], acc[4 * j + 3]};
        }
        __syncthreads();
        f32x2 xv = *(const f32x2*)(a.out + (size_t)tok * D + tid * 2);
#pragma unroll
        for (int w = 0; w < 8; ++w) { const f32x2 pv = *(const LAS f32x2*)(PART + w * 1024 + tid * 2); xv += pv; }
        float ss = wave_sum(xv[0] * xv[0] + xv[1] * xv[1], lane);
        if (lane == 0) RED[wave] = ss;
        __syncthreads();
        float tot = 0.f;
#pragma unroll
        for (int w = 0; w < 8; ++w) tot += RED[w];
        const float rstd = rsqrtf(tot * (1.f / D) + EPS);
        const f32x2 gf = *(const f32x2*)(a.final_g + tid * 2);
        *(f32x2*)(a.out + (size_t)tok * D + tid * 2) = xv * rstd * gf;
        em = emN; cu = cuN; cv = cvN;
    }
    __syncthreads();
#undef G_INFO
#undef G_ISSUE
#undef G_DOTS
#undef G_ACC
}

__device__ __forceinline__ void phase_final_plain(const Args& a, const float* src, int vcu, int G) {
    const int tid = tid_(), lane = tid & 63, wave = tid >> 6;
    const int gw = vcu * NWAVES + wave, NGW = G * NWAVES;
    f32x4 gf[4];
#pragma unroll
    for (int j = 0; j < 4; ++j) gf[j] = ((const f32x4*)a.final_g)[64 * j + lane];
    for (int m = gw; m < T; m += NGW) {
        const f32x4* xr = (const f32x4*)(src + (size_t)m * D) + lane;
        f32x4 v[4]; float s = 0.f;
#pragma unroll
        for (int j = 0; j < 4; ++j) { v[j] = xr[64 * j]; s += (v[j][0] * v[j][0] + v[j][1] * v[j][1]) + (v[j][2] * v[j][2] + v[j][3] * v[j][3]); }
        const float rstd = rsqrtf(wave_sum(s, lane) * (1.f / D) + EPS);
        f32x4* o = (f32x4*)(a.out + (size_t)m * D) + lane;
#pragma unroll
        for (int j = 0; j < 4; ++j) o[64 * j] = v[j] * rstd * gf[j];
    }
}


#define XB_TMO      128
#define XB_XCNT(j)  (256  + 64 * (j))
#define XB_XSUB(j)  (1280 + 64 * (j))
#define XB_XGEN(j)  (2304 + 64 * (j))
#define XB_TOP      3328
#define XB_TOPGEN   3392
#define XB_SPIN_CAP (1u << 22)
constexpr int CW_BAR = 4096;
constexpr int LDS_BARST = LDS_BYTES - 64;
__device__ __forceinline__ unsigned xb_ld(unsigned* p)              { return __hip_atomic_load(p, __ATOMIC_RELAXED, __HIP_MEMORY_SCOPE_AGENT); }
__device__ __forceinline__ unsigned xb_add(unsigned* p, unsigned v) { return __hip_atomic_fetch_add(p, v, __ATOMIC_RELAXED, __HIP_MEMORY_SCOPE_AGENT); }
__device__ __forceinline__ unsigned xb_xcc_id() { return (unsigned)__builtin_amdgcn_s_getreg((3 << 11) | 20) & 0xFu; }
#define XB_SPIN(cond, bar) do { unsigned _sp = 0; while (cond) { __builtin_amdgcn_s_sleep(1); \
    if ((++_sp & 255u) == 0u) { if (xb_ld(&(bar)[XB_TMO])) break; if (_sp > XB_SPIN_CAP) { atomicAdd(&(bar)[XB_TMO], 1u); break; } } } } while (0)
__device__ __forceinline__ void xcd_barrier_post(unsigned* bar) { if (tid_() == 0) (void)xb_add(&bar[XB_XCNT(xb_xcc_id())], 1u); }
__device__ __forceinline__ void xcd_barrier_complete(unsigned* bar, unsigned x, unsigned& nloc, unsigned& nx) {
    const unsigned G = gridDim.x;
    unsigned sum, cnt, mine, sp = 0u;
    for (;;) {
        sum = 0u; cnt = 0u; mine = 0u;
#pragma unroll
        for (unsigned j = 0; j < 16; ++j) { const unsigned c = xb_ld(&bar[XB_XCNT(j)]); sum += c; cnt += (c > 0u) ? 1u : 0u; mine = (j == x) ? c : mine; }
        if (sum == G) break;
        __builtin_amdgcn_s_sleep(1);
        if ((++sp & 255u) == 0u) { if (xb_ld(&bar[XB_TMO])) break; if (sp > XB_SPIN_CAP) { atomicAdd(&bar[XB_TMO], 1u); break; } }
    }
    nloc = mine > 0u ? mine : 1u; nx = cnt > 0u ? cnt : 1u;
}
__device__ __forceinline__ void xcd_barrier(unsigned* bar, volatile LAS unsigned* st) {
    asm volatile("s_waitcnt vmcnt(0)" ::: "memory");
    __syncthreads();
    if (tid_() == 0) {
        const unsigned x = xb_xcc_id();
        __builtin_amdgcn_s_waitcnt(0);
        unsigned nloc = st[0], nx = st[1];
        if (nloc == 0u) { xcd_barrier_complete(bar, x, nloc, nx); st[0] = nloc; st[1] = nx; }
        const unsigned old = xb_add(&bar[XB_XSUB(x)], 1u);
        const unsigned gen = old / nloc;
        if (old + 1u == (gen + 1u) * nloc) {
            __builtin_amdgcn_fence(__ATOMIC_RELEASE, "agent");
            asm volatile("s_waitcnt vmcnt(0)" ::: "memory");
            const unsigned og = xb_add(&bar[XB_TOP], 1u);
            const unsigned tg = og / nx;
            if (og + 1u == (tg + 1u) * nx) xb_add(&bar[XB_TOPGEN], 1u);
            else XB_SPIN(xb_ld(&bar[XB_TOPGEN]) == tg, bar);
            __builtin_amdgcn_fence(__ATOMIC_ACQUIRE, "agent");
            xb_add(&bar[XB_XGEN(x)], 1u);
            asm volatile("s_waitcnt vmcnt(0)" ::: "memory");
        } else {
            XB_SPIN(xb_ld(&bar[XB_XGEN(x)]) == gen, bar);
            __builtin_amdgcn_fence(__ATOMIC_ACQUIRE, "agent");
            asm volatile("s_waitcnt vmcnt(0)" ::: "memory");
        }
    }
    __syncthreads();
}

__device__ __forceinline__ Args load_args() {
    const Args* p = (const Args*)__builtin_amdgcn_kernarg_segment_ptr();
    asm volatile("" : "+s"(p));
    Args r; __builtin_memcpy(&r, (const void*)p, sizeof(Args)); return r;
}
__device__ __forceinline__ EpiPtrs make_ep(const Args& a, int round) {
    EpiPtrs ep; ep.biasp = (const float*)(a.ws + WS_BIASP); ep.lb = (const float*)(a.ws + WS_LB); ep.x = a.x; ep.out = a.out; ep.ws = a.ws; ep.round = round; return ep;
}
#define GRID_SYNC() do { const Args a_ = load_args(); xcd_barrier((unsigned*)(a_.ws + WS_CTL) + CW_BAR, (volatile LAS unsigned*)(lds + LDS_BARST)); } while (0)

__device__ __forceinline__ int bx_() { int t = blockIdx.x; asm volatile("" : "+s"(t)); return t; }
__device__ __forceinline__ int gd_() { int t = gridDim.x; asm volatile("" : "+s"(t)); return t; }
#define PH_BEGIN const Args a = load_args(); const int bx = bx_(), G = gd_(); const int vcu = (G % 8 == 0) ? (bx % 8) * (G / 8) + bx / 8 : bx; (void)vcu; (void)bx;

__global__ void __launch_bounds__(NTHR, 2) fwd_megakernel(Args a_unused) {
    extern __shared__ __attribute__((aligned(16))) unsigned char lds_raw[];
    LAS unsigned char* lds = (LAS unsigned char*)lds_raw;
    cg::grid_group grid = cg::this_grid();

    { const int t_ = tid_(); if (t_ < 16) ((LAS unsigned*)(lds + LDS_BARST))[t_] = 0u; __syncthreads();
      const Args a_ = load_args(); xcd_barrier_post((unsigned*)(a_.ws + WS_CTL) + CW_BAR); }
    { PH_BEGIN phase_p0(a, lds, vcu, G); }
    grid.sync();
#pragma unroll 1
    for (int round = 0; round < NROUND; ++round) {
        {
            PH_BEGIN
            pg8::Gemm g{(const bf16_t*)(a.ws + WS_XN) + (size_t)round * RT * D, (const bf16_t*)(a.ws + WS_WIN), RT, N1, D};
            pg8::StaticOrder S; S.init(RT, N1, G, bx);
            EpiX<1> E{make_ep(a, round)};
            pg8::gemm_phase<EpiX<1>, pg8::StaticOrder, true, true>(lds, g, S, E);
        }
        { PH_BEGIN const int t0_ = tid_(); if (bx < 8 && t0_ < 64) mscan_pair(a, round, bx, t0_); }
        GRID_SYNC();
        { PH_BEGIN for (int it = bx; it < 512; it += G) mlstm_pre_item(a, lds, round, it); }
        { PH_BEGIN for (int it = bx; it < 2048; it += G) hgrn_pre_item(a, lds, round, it); }
        GRID_SYNC();
        { PH_BEGIN
          if (bx < 128) mlstm_scan(a, lds, round, bx & 7, bx >> 3);
          else if (bx < 256) { const int id2 = bx - 128; hgrn_scan(a, lds, round, (id2 & 7) * 2 + ((id2 >> 3) & 1), id2 >> 4); } }
        GRID_SYNC();
        {
            PH_BEGIN
            pg8::Gemm g{(const bf16_t*)(a.ws + WS_XN) + (size_t)round * RT * D, (const bf16_t*)(a.ws + WS_WIN) + (size_t)N1 * D, RT, N2, D};
            pg8::StaticOrder S; S.init(RT, N2, G, bx);
            EpiX<2> E{make_ep(a, round)};
            pg8::gemm_phase<EpiX<2>, pg8::StaticOrder, true, true>(lds, g, S, E);
        }
        GRID_SYNC();
        { PH_BEGIN phase_ypass(a, round, vcu, G); }
        GRID_SYNC();
        {
            { PH_BEGIN pg8::StaticOrder S; S.init(RT, D, G, bx);
              pg8::Gemm g{(const bf16_t*)(a.ws + WS_V), (const bf16_t*)(a.ws + WS_WM), RT, D, 2048}; EpiX<3> E{make_ep(a, round)}; pg8::gemm_phase<EpiX<3>, pg8::StaticOrder, true, true>(lds, g, S, E); }
            { PH_BEGIN pg8::StaticOrder S; S.init(RT, D, G, bx);
              pg8::Gemm g{(const bf16_t*)(a.ws + WS_GI), (const bf16_t*)(a.ws + WS_WG), RT, D, D}; EpiX<4> E{make_ep(a, round)}; pg8::gemm_phase<EpiX<4>, pg8::StaticOrder, true, true>(lds, g, S, E); }
        }
        GRID_SYNC();
        {
            PH_BEGIN pg8::StaticOrder S; S.init(RT, D, G, bx);
            pg8::Gemm g{(const bf16_t*)(a.ws + WS_GFLOG), (const bf16_t*)(a.ws + WS_WO), RT, D, D}; EpiX<5> E{make_ep(a, round)}; pg8::gemm_phase<EpiX<5>, pg8::StaticOrder, true, true>(lds, g, S, E);
        }
        GRID_SYNC();
    }
    { PH_BEGIN phase_p8(a, vcu, G); }
    GRID_SYNC();
    {
        PH_BEGIN pg8::StaticOrder S; S.init(T, 2048, G, bx);
        pg8::Gemm g{(const bf16_t*)(a.ws + WS_XN), (const bf16_t*)(a.ws + WS_WPQ), T, 2048, D}; EpiX<6> E{make_ep(a, 0)}; pg8::gemm_phase<EpiX<6>, pg8::StaticOrder, true, true>(lds, g, S, E);
    }
    GRID_SYNC();
#ifdef TOPK_REF
    { PH_BEGIN phase_topk_ref(a, vcu, G); }
#else
    { PH_BEGIN phase_topk(a, lds, bx, G); }
#endif
    GRID_SYNC();
    { PH_BEGIN phase_gather(a, lds, bx, G); }
}

extern "C" void kernel_launch(void* const* d_in, const int* in_sizes, int n_in, void* d_out, int out_size, void* d_ws, size_t ws_size, hipStream_t stream) {
    static int grid = 0;
    if (grid == 0) {
        if (n_in != 18 || in_sizes[0] != T * D || out_size != T * D || ws_size < WS_END) {
            fprintf(stderr, "kernel_launch: unexpected shapes/workspace (n_in %d, in0 %d, out %d, ws %zu, need %zu)\n", n_in, n_in > 0 ? in_sizes[0] : -1, out_size, ws_size, (size_t)WS_END);
            grid = -1; return; }
        int dev = 0, cus = 0, per_cu = 0;
        hipGetDevice(&dev);
        hipDeviceGetAttribute(&cus, hipDeviceAttributeMultiprocessorCount, dev);
        hipFuncSetAttribute((const void*)fwd_megakernel, hipFuncAttributeMaxDynamicSharedMemorySize, LDS_BYTES);
        hipOccupancyMaxActiveBlocksPerMultiprocessor(&per_cu, (const void*)fwd_megakernel, NTHR, LDS_BYTES);
        if (per_cu < 1) { fprintf(stderr, "kernel_launch: occupancy query says %d blocks/CU\n", per_cu); per_cu = 1; }
        grid = cus;
        (void)hipGetLastError();
    }
    if (grid < 0) return;
    hipMemsetAsync((char*)d_ws + WS_CTL, 0, 1 * MiB, stream);
    Args a{};
    a.x = (const float*)d_in[0]; a.norm1_g = (const float*)d_in[1]; a.w_in = (const float*)d_in[2]; a.b_in = (const float*)d_in[3];
    a.conv_w = (const float*)d_in[4]; a.conv_b = (const float*)d_in[5]; a.m_head_g = (const float*)d_in[6]; a.lb_table = (const float*)d_in[7];
    a.g_head_g = (const float*)d_in[8]; a.w_br_m = (const float*)d_in[9]; a.w_br_g = (const float*)d_in[10]; a.w_out = (const float*)d_in[11];
    a.norm2_g = (const float*)d_in[12]; a.w_pq = (const float*)d_in[13]; a.sub_keys = (const float*)d_in[14]; a.u_emb = (const float*)d_in[15];
    a.v_emb = (const float*)d_in[16]; a.final_g = (const float*)d_in[17];
    a.out = (float*)d_out; a.ws = (unsigned char*)d_ws;
    void* args[] = {&a};
    hipError_t e = hipLaunchCooperativeKernel((const void*)fwd_megakernel, dim3(grid), dim3(NTHR), args, LDS_BYTES, stream);
    if (e != hipSuccess) fprintf(stderr, "cooperative launch failed: %s (grid %d)\n", hipGetErrorString(e), grid);
}
```

```cpp
#include <hip/hip_runtime.h>
#include <hip/hip_cooperative_groups.h>
#include <cstdio>
#include <cstdint>
namespace cg = cooperative_groups;

#define LAS __attribute__((address_space(3)))
typedef unsigned short bf16_t;
typedef short bf16x8 __attribute__((ext_vector_type(8)));
typedef float f32x4 __attribute__((ext_vector_type(4)));
typedef float f32x2 __attribute__((ext_vector_type(2)));
typedef unsigned u32x4 __attribute__((ext_vector_type(4)));
typedef unsigned u32x2 __attribute__((ext_vector_type(2)));

constexpr int D = 1024, BATCH = 4, SEQ = 8192, T = BATCH * SEQ;
constexpr int IN_COLS = 12296, NP = 12288;
constexpr int RT = 16384, NROUND = 2;
constexpr int N1 = 7168, N2 = 5120;
constexpr float EPS = 1e-6f;
constexpr int NWAVES = 8, NTHR = 512;

constexpr size_t MiB = 1u << 20;
constexpr size_t WS_CTL = 0;
constexpr size_t WS_WIN = 1 * MiB;
constexpr size_t WS_WM = 25 * MiB;
constexpr size_t WS_WG = 29 * MiB;
constexpr size_t WS_WO = 31 * MiB;
constexpr size_t WS_WPQ = 33 * MiB;
constexpr size_t WS_SK = 37 * MiB;
constexpr size_t WS_BIASP = 37 * MiB + 512 * 1024;
constexpr size_t WS_LB = WS_BIASP + 64 * 1024;
constexpr size_t WS_GATES = 38 * MiB;
constexpr size_t WS_MPREV = 39 * MiB;
constexpr size_t WS_DEN = 40 * MiB;
constexpr size_t WS_MT = 40 * MiB + 512 * 1024;
constexpr size_t WS_HGDEC = 41 * MiB;
constexpr size_t WS_MDEC = 43 * MiB;
constexpr size_t WS_XN = 44 * MiB;
constexpr size_t WS_QKPRE = 108 * MiB;
constexpr size_t WS_V = 172 * MiB;
constexpr size_t WS_GFLOG = 236 * MiB;
constexpr size_t WS_GI = 268 * MiB;
constexpr size_t WS_GQ = 300 * MiB;
constexpr size_t WS_S = 332 * MiB;
constexpr size_t WS_QT = 348 * MiB;
constexpr size_t WS_KWT = 380 * MiB;
constexpr size_t WS_ATT = 412 * MiB;
constexpr size_t WS_QTG = 428 * MiB;
constexpr size_t WS_KENDT = 460 * MiB;
constexpr size_t WS_SIGO = 332 * MiB;
constexpr size_t WS_SGG = 396 * MiB;
constexpr size_t WS_SAM = 428 * MiB;
constexpr size_t WS_SAG = 460 * MiB;
constexpr size_t WS_END = 492 * MiB;
constexpr size_t WS_QP = 108 * MiB;
constexpr size_t WS_UB = 236 * MiB;
constexpr size_t WS_VB = 252 * MiB;
constexpr size_t WS_USC = 268 * MiB;
constexpr size_t WS_VSC = 268 * MiB + 65536;
constexpr size_t WS_EIDX = 300 * MiB;
constexpr size_t WS_GATE = 316 * MiB;
constexpr size_t WS_X8 = 348 * MiB;
constexpr size_t WS_PW = 332 * MiB;

constexpr int CW_TMAX = 64;
constexpr int LDS_BYTES = 147456;

__device__ __forceinline__ unsigned f2bf(float f) { unsigned u = __builtin_bit_cast(unsigned, f); return (u + 0x7fffu + ((u >> 16) & 1u)) >> 16; }
typedef __bf16 bf16x2_t __attribute__((ext_vector_type(2)));
__device__ __forceinline__ unsigned pk2(float lo, float hi) { bf16x2_t v; v[0] = (__bf16)lo; v[1] = (__bf16)hi; return __builtin_bit_cast(unsigned, v); }
__device__ __forceinline__ float bf_lo(unsigned w) { return __builtin_bit_cast(float, w << 16); }
__device__ __forceinline__ float bf_hi(unsigned w) { return __builtin_bit_cast(float, w & 0xffff0000u); }
__device__ __forceinline__ float bf2f(bf16_t h) { return __builtin_bit_cast(float, ((unsigned)h) << 16); }
__device__ __forceinline__ float shx(float v, int o, int lane) { return __builtin_bit_cast(float, __builtin_amdgcn_ds_bpermute((lane ^ o) << 2, __builtin_bit_cast(int, v))); }
__device__ __forceinline__ float shup(float v, int o, int lane) { return __builtin_bit_cast(float, __builtin_amdgcn_ds_bpermute(((lane - o) & 63) << 2, __builtin_bit_cast(int, v))); }
__device__ __forceinline__ float rdlane(float v, int l) { return __builtin_bit_cast(float, __builtin_amdgcn_readlane(__builtin_bit_cast(int, v), l)); }
#define DPP_(v, ctrl) __builtin_bit_cast(float, __builtin_amdgcn_update_dpp(0, __builtin_bit_cast(int, (v)), (ctrl), 0xF, 0xF, false))
__device__ __forceinline__ float wave_sum(float v, int lane) {
    (void)lane;
    v += DPP_(v, 0xB1); v += DPP_(v, 0x4E); v += DPP_(v, 0x141); v += DPP_(v, 0x140);
    return (rdlane(v, 0) + rdlane(v, 16)) + (rdlane(v, 32) + rdlane(v, 48));
}
#define SWZI_(v, pat) __builtin_amdgcn_ds_swizzle((int)(v), (pat))
#define DPPI_(v, ctrl) __builtin_amdgcn_update_dpp(0, (int)(v), (ctrl), 0xF, 0xF, false)
__device__ __forceinline__ unsigned xor32u_(unsigned v, bool hi) {
#if defined(__HIP_DEVICE_COMPILE__)
    const auto r = __builtin_amdgcn_permlane32_swap(v, v, false, false);
    return hi ? r[0] : r[1];
#else
    (void)hi; return v;
#endif
}
__device__ __forceinline__ float sigmoidf_(float x) { return __builtin_amdgcn_rcpf(1.0f + __expf(-x)); }
__device__ __forceinline__ float siluf_(float x) { return x * __builtin_amdgcn_rcpf(1.0f + __expf(-x)); }
#define LDS_WAIT() asm volatile("s_waitcnt lgkmcnt(0)" ::: "memory")
__device__ __forceinline__ int tid_() { int t = threadIdx.x; asm volatile("" : "+v"(t)); return t; }

#define GAS __attribute__((address_space(1)))
struct DArgs {
    const GAS float* x; const GAS float* norm1_g; const GAS float* w_in; const GAS float* b_in; const GAS float* conv_w; const GAS float* conv_b;
    const GAS float* m_head_g; const GAS float* lb_table; const GAS float* g_head_g; const GAS float* w_br_m; const GAS float* w_br_g; const GAS float* w_out;
    const GAS float* norm2_g; const GAS float* w_pq; const GAS float* sub_keys; const GAS float* u_emb; const GAS float* v_emb; const GAS float* final_g;
    GAS float* out; GAS unsigned char* ws;
};
struct Args {
    const float* x; const float* norm1_g; const float* w_in; const float* b_in; const float* conv_w; const float* conv_b;
    const float* m_head_g; const float* lb_table; const float* g_head_g; const float* w_br_m; const float* w_br_g; const float* w_out;
    const float* norm2_g; const float* w_pq; const float* sub_keys; const float* u_emb; const float* v_emb; const float* final_g;
    float* out; unsigned char* ws;
};

namespace pg8 {
constexpr int BM = 256, BK = 64, HALF = 128, HTB = HALF * BK * 2, STAGE_BYTES = 8 * HTB, NXCD = 8, WGM = 8;
__host__ __device__ __forceinline__ int lds_byte(int r, int c) { const int st = (r >> 4) * 2 + (c >> 5), rr = r & 15, cc = c & 31, ob = rr * 64 + cc * 2; return st * 1024 + (ob ^ (((ob >> 9) & 1) << 5)); }
__host__ __device__ __forceinline__ void stage_rc(int b, int& R, int& C) { const int st = b / 1024, sb = b % 1024, swz = sb ^ (((sb >> 9) & 1) << 5); R = (st >> 1) * 16 + swz / 64; C = (st & 1) * 32 + (swz % 64) / 2; }
__host__ __device__ __forceinline__ int perm32(int rho) { const int n = rho >> 4, i = rho & 15; return 8 * (i >> 2) + 4 * n + (i & 3); }
struct Unit { int pm, pn; };
struct Gemm { const bf16_t* A; const bf16_t* Bt; int M, N, K; };
struct StaticOrder {
    int nM, nN, nwg, G, c;
    __host__ __device__ void init(int M, int N, int G_, int c_) { nM = M / BM; nN = N / BM; nwg = nM * nN; G = G_; c = c_; }
    __host__ __device__ bool next(int i, Unit& u) const {
        const long L = (long)i * G + c; if (L >= nwg) return false;
        int wgid = (int)L; { const int q = nwg / NXCD, r = nwg % NXCD, xcd = wgid % NXCD, off = wgid / NXCD; wgid = (xcd < r ? xcd * (q + 1) : r * (q + 1) + (xcd - r) * q) + off; }
        const int nig = WGM * nN, gid = wgid / nig, fm = gid * WGM, gsz = (nM - fm) < WGM ? (nM - fm) : WGM;
        u.pm = fm + ((wgid % nig) % gsz); u.pn = (wgid % nig) / gsz; return true;
    }
    __device__ __forceinline__ void a_ready(const Unit&) const {}
    __device__ __forceinline__ void done(const Unit&) const {}
};

template <class Epi, class Sched, bool ALIGN_EPI = false, bool SP2 = false>
__device__ __forceinline__ void gemm_phase(LAS unsigned char* lds, const Gemm g, const Sched& S, const Epi& E) {
    const int tid = tid_(), wid = __builtin_amdgcn_readfirstlane(tid >> 6), lane = tid & 63, wr = wid >> 2, wc = wid & 3, fr = lane & 15, fq = lane >> 4;
    const int K = g.K, nt = K / BK;
    unsigned voffA[2], voffB[2];
#pragma unroll
    for (int i = 0; i < 2; ++i) { int R, C; stage_rc(tid * 16 + i * 8192, R, C); const int Rb = Epi::PERM ? ((R & ~31) + perm32(R & 31)) : R;
        voffA[i] = (unsigned)(R * K + C) * 2u; voffB[i] = (unsigned)(Rb * K + C) * 2u; }
    const size_t kstep = (size_t)(BK * 2);
    const size_t hstep = (size_t)HALF * K * 2;
    const size_t tstep = 2 * hstep;
    const unsigned ldsw = (unsigned)wid * 1024u;
    const int aoff = lds_byte(wr * 64 + fr, fq * 8), boff = lds_byte(wc * 32 + fr, fq * 8);
#define PG8_SA(b, h) (((b) * 2 + (h)) * HTB)
#define PG8_SB(b, h) ((4 + (b) * 2 + (h)) * HTB)
#define PG8_STAGE(bufoff, gbase, voff) do { _Pragma("unroll") for (int _i = 0; _i < 2; ++_i) \
        __builtin_amdgcn_global_load_lds((const unsigned*)((const char*)(gbase) + (voff)[_i]), (LAS unsigned*)(lds + (bufoff) + ldsw + _i * 8192), 16, 0, 0); } while (0)
#define PG8_LDA(dst, b, h) do { _Pragma("unroll") for (int m = 0; m < 4; ++m) _Pragma("unroll") for (int k = 0; k < 2; ++k) dst[m][k] = *(const LAS bf16x8*)(lds + PG8_SA(b, h) + aoff + m * 2048 + k * 1024); } while (0)
#define PG8_LDB(dst, b, h) do { _Pragma("unroll") for (int n = 0; n < 2; ++n) _Pragma("unroll") for (int k = 0; k < 2; ++k) dst[n][k] = *(const LAS bf16x8*)(lds + PG8_SB(b, h) + boff + n * 2048 + k * 1024); } while (0)
#define PG8_MMA(ai, bj, At, Bt) do { __builtin_amdgcn_s_setprio(1); _Pragma("unroll") for (int m = 0; m < 4; ++m) _Pragma("unroll") for (int n = 0; n < 2; ++n) _Pragma("unroll") for (int k = 0; k < 2; ++k) \
        acc[ai][bj][m][n] = __builtin_amdgcn_mfma_f32_16x16x32_bf16(Bt[n][k], At[m][k], acc[ai][bj][m][n], 0, 0, 0); __builtin_amdgcn_s_setprio(0); } while (0)
#define PG8_WAIT_V(n) asm volatile("s_waitcnt vmcnt(" #n ")" ::: "memory")
#define PG8_WAIT_L(n) asm volatile("s_waitcnt lgkmcnt(" #n ")" ::: "memory")
#define PG8_BAR __builtin_amdgcn_s_barrier()
#define PG8_SCHED __builtin_amdgcn_sched_barrier(0)
    Unit cur, nxt; int ui = 0;
    if (!S.next(0, cur)) return;
    f32x4 acc[2][2][4][2];
#pragma unroll
    for (int a = 0; a < 2; ++a)
#pragma unroll
        for (int b = 0; b < 2; ++b)
#pragma unroll
            for (int m = 0; m < 4; ++m)
#pragma unroll
                for (int n = 0; n < 2; ++n) acc[a][b][m][n] = (f32x4){0.f, 0.f, 0.f, 0.f};
    bf16x8 At[4][2], B0[2][2], B1[2][2];
    const char* cA = (const char*)g.A + (size_t)cur.pm * tstep; const char* cB = (const char*)g.Bt + (size_t)cur.pn * tstep;
    S.a_ready(cur);
    if constexpr (SP2) {
        PG8_STAGE(PG8_SB(0, 0), cB, voffB); PG8_STAGE(PG8_SB(0, 1), cB + hstep, voffB); PG8_STAGE(PG8_SA(0, 0), cA, voffA); PG8_STAGE(PG8_SA(0, 1), cA + hstep, voffA);
        if (wr == 1) PG8_BAR;
        PG8_WAIT_V(2); PG8_BAR;
        PG8_STAGE(PG8_SB(1, 0), cB + kstep, voffB); PG8_STAGE(PG8_SA(1, 0), cA + kstep, voffA); PG8_STAGE(PG8_SB(1, 1), cB + hstep + kstep, voffB);
        PG8_WAIT_V(6); PG8_BAR;
    } else {
        PG8_STAGE(PG8_SB(0, 0), cB, voffB); PG8_STAGE(PG8_SA(0, 0), cA, voffA); PG8_STAGE(PG8_SB(0, 1), cB + hstep, voffB); PG8_STAGE(PG8_SA(0, 1), cA + hstep, voffA);
        if (wr == 1) PG8_BAR;
        PG8_WAIT_V(4); PG8_BAR;
        PG8_STAGE(PG8_SB(1, 0), cB + kstep, voffB); PG8_STAGE(PG8_SA(1, 0), cA + kstep, voffA); PG8_STAGE(PG8_SB(1, 1), cB + hstep + kstep, voffB);
        PG8_WAIT_V(6); PG8_BAR;
    }
    for (;;) {
        const bool has_next = S.next(ui + 1, nxt);
        const char* nA = has_next ? (const char*)g.A + (size_t)nxt.pm * tstep : cA; const char* nB = has_next ? (const char*)g.Bt + (size_t)nxt.pn * tstep : cB;
        for (int t = 0; t < nt; t += 2) {
            const bool last = (t == nt - 2);
            const char* a1 = cA + (size_t)(t + 1) * kstep;
            const char* a2 = last ? nA : cA + (size_t)(t + 2) * kstep; const char* b2 = last ? nB : cB + (size_t)(t + 2) * kstep;
            const char* a3 = a2 + kstep; const char* b3 = b2 + kstep;
            if (last && has_next) S.a_ready(nxt);
            if constexpr (SP2) {
            PG8_LDB(B0, 0, 0); PG8_LDB(B1, 0, 1); PG8_SCHED; PG8_LDA(At, 0, 0); PG8_STAGE(PG8_SA(1, 1), a1 + hstep, voffA);
            PG8_WAIT_V(8); PG8_WAIT_L(0); PG8_BAR; PG8_MMA(0, 0, At, B0); PG8_MMA(0, 1, At, B1); PG8_BAR; PG8_SCHED;
            PG8_LDA(At, 0, 1); PG8_STAGE(PG8_SB(0, 0), b2, voffB); PG8_STAGE(PG8_SB(0, 1), b2 + hstep, voffB); PG8_STAGE(PG8_SA(0, 0), a2, voffA);
            PG8_WAIT_V(8); PG8_WAIT_L(0); PG8_BAR; PG8_MMA(1, 0, At, B0); PG8_MMA(1, 1, At, B1); PG8_BAR; PG8_SCHED;
            PG8_LDB(B0, 1, 0); PG8_LDB(B1, 1, 1); PG8_SCHED; PG8_LDA(At, 1, 0); PG8_STAGE(PG8_SA(0, 1), a2 + hstep, voffA);
            PG8_WAIT_V(8); PG8_WAIT_L(0); PG8_BAR; PG8_MMA(0, 0, At, B0); PG8_MMA(0, 1, At, B1); PG8_BAR; PG8_SCHED;
            PG8_LDA(At, 1, 1); PG8_STAGE(PG8_SB(1, 0), b3, voffB); PG8_STAGE(PG8_SB(1, 1), b3 + hstep, voffB); PG8_STAGE(PG8_SA(1, 0), a3, voffA);
            PG8_WAIT_V(8); PG8_WAIT_L(0); PG8_BAR; PG8_MMA(1, 0, At, B0); PG8_MMA(1, 1, At, B1); PG8_BAR; PG8_SCHED;
            } else {
            PG8_LDB(B0, 0, 0); PG8_SCHED; PG8_LDA(At, 0, 0); PG8_STAGE(PG8_SA(1, 1), a1 + hstep, voffA);
            PG8_WAIT_L(8); PG8_BAR; PG8_WAIT_L(0); PG8_MMA(0, 0, At, B0); PG8_BAR; PG8_SCHED;
            PG8_LDB(B1, 0, 1); PG8_STAGE(PG8_SB(0, 0), b2, voffB);
            PG8_BAR; PG8_WAIT_L(0); PG8_MMA(0, 1, At, B1); PG8_BAR;
            PG8_LDA(At, 0, 1); PG8_STAGE(PG8_SA(0, 0), a2, voffA);
            PG8_BAR; PG8_WAIT_L(0); PG8_MMA(1, 0, At, B0); PG8_BAR; PG8_SCHED;
            PG8_STAGE(PG8_SB(0, 1), b2 + hstep, voffB);
            PG8_WAIT_V(6); PG8_BAR; PG8_MMA(1, 1, At, B1); PG8_BAR;
            PG8_LDB(B0, 1, 0); PG8_SCHED; PG8_LDA(At, 1, 0); PG8_STAGE(PG8_SA(0, 1), a2 + hstep, voffA);
            PG8_WAIT_L(8); PG8_BAR; PG8_WAIT_L(0); PG8_MMA(0, 0, At, B0); PG8_BAR; PG8_SCHED;
            PG8_LDB(B1, 1, 1); PG8_STAGE(PG8_SB(1, 0), b3, voffB);
            PG8_BAR; PG8_WAIT_L(0); PG8_MMA(0, 1, At, B1); PG8_BAR;
            PG8_LDA(At, 1, 1); PG8_STAGE(PG8_SA(1, 0), a3, voffA);
            PG8_BAR; PG8_WAIT_L(0); PG8_MMA(1, 0, At, B0); PG8_BAR; PG8_SCHED;
            PG8_STAGE(PG8_SB(1, 1), b3 + hstep, voffB);
            PG8_WAIT_V(6); PG8_BAR; PG8_MMA(1, 1, At, B1); PG8_BAR;
            }
        }
        if constexpr (ALIGN_EPI) { if (wr == 0) PG8_BAR; }
        E(acc, cur, wr, wc, fr, fq);
        if (!has_next) break;
#pragma unroll
        for (int a = 0; a < 2; ++a)
#pragma unroll
            for (int b = 0; b < 2; ++b)
#pragma unroll
                for (int m = 0; m < 4; ++m)
#pragma unroll
                    for (int n = 0; n < 2; ++n) acc[a][b][m][n] = (f32x4){0.f, 0.f, 0.f, 0.f};
        cur = nxt; cA = nA; cB = nB; ++ui;
        if constexpr (ALIGN_EPI) { if (wr == 1) PG8_BAR; }
    }
    PG8_WAIT_V(0);
    if constexpr (!ALIGN_EPI) { if (wr == 0) PG8_BAR; }
    PG8_BAR;
#undef PG8_SA
#undef PG8_SB
#undef PG8_STAGE
#undef PG8_LDA
#undef PG8_LDB
#undef PG8_MMA
#undef PG8_WAIT_V
#undef PG8_WAIT_L
#undef PG8_BAR
#undef PG8_SCHED
}
}

struct EpiPtrs {
    const GAS float* biasp; const GAS float* lb; const GAS float* x; GAS float* out; GAS unsigned char* ws; int round;
};
template <int MODE> struct EpiX {
    static constexpr bool PERM = true, AFTER_DRAIN = false;
    EpiPtrs P;
    __device__ __forceinline__ void operator()(const f32x4 (&acc)[2][2][4][2], const pg8::Unit& u, int wr, int wc, int fr, int fq) const {
        const int row0 = u.pm * 256 + wr * 64 + fr;
        const int colt = u.pn * 256 + wc * 32 + 8 * fq;
        GAS unsigned char* ws = P.ws;
        bf16_t* dst = nullptr; int ld = 0, coff = 0, act = 0; const GAS float* bias = nullptr;
        if (MODE == 1) {
            bias = P.biasp;
            if (u.pn < 8) { dst = (bf16_t*)(ws + WS_QKPRE); ld = 2048; coff = 0; act = 0; }
            else if (u.pn < 16) { dst = (bf16_t*)(ws + WS_V); ld = 2048; coff = 2048; act = 0; }
            else if (u.pn < 20) { dst = (bf16_t*)(ws + WS_GFLOG); ld = 1024; coff = 4096; act = 3; }
            else if (u.pn < 24) { dst = (bf16_t*)(ws + WS_GI); ld = 1024; coff = 5120; act = 0; }
            else { dst = (bf16_t*)(ws + WS_GQ); ld = 1024; coff = 6144; act = 2; }
        } else if (MODE == 2) {
            bias = P.biasp + N1;
            if (u.pn < 8) { dst = (bf16_t*)(ws + WS_SIGO); ld = 2048; coff = 0; act = 1; }
            else if (u.pn < 12) { dst = (bf16_t*)(ws + WS_SGG); ld = 1024; coff = 2048; act = 2; }
            else if (u.pn < 16) { dst = (bf16_t*)(ws + WS_SAM); ld = 1024; coff = 3072; act = 1; }
            else { dst = (bf16_t*)(ws + WS_SAG); ld = 1024; coff = 4096; act = 1; }
        } else if (MODE == 6) { dst = (bf16_t*)(ws + WS_QP); ld = 2048; coff = 0; act = 0; }
#pragma unroll
        for (int bj = 0; bj < 2; ++bj) {
            const int col = colt + bj * 128;
            f32x4 b0 = (f32x4){0.f, 0.f, 0.f, 0.f}, b1 = b0, l0 = b0, l1 = b0;
            if (MODE == 1 || MODE == 2) { b0 = *(const f32x4*)(bias + col); b1 = *(const f32x4*)(bias + col + 4); }
            if (MODE == 1) { if (act == 3) { l0 = *(const f32x4*)(P.lb + (col - coff)); l1 = *(const f32x4*)(P.lb + (col - coff) + 4); } }
#pragma unroll
            for (int ai = 0; ai < 2; ++ai)
#pragma unroll
                for (int m = 0; m < 4; ++m) {
                    const int row = row0 + ai * 128 + m * 16;
                    f32x4 v0 = acc[ai][bj][m][0] + b0, v1 = acc[ai][bj][m][1] + b1;
                    if (MODE == 1 || MODE == 2 || MODE == 6) {
                        if (act == 1) {
#pragma unroll
                            for (int j = 0; j < 4; ++j) { v0[j] = sigmoidf_(v0[j]); v1[j] = sigmoidf_(v1[j]); }
                        } else if (act == 2) {
#pragma unroll
                            for (int j = 0; j < 4; ++j) { v0[j] = siluf_(v0[j]); v1[j] = siluf_(v1[j]); }
                        } else if (act == 3) {
#pragma unroll
                            for (int j = 0; j < 4; ++j) { v0[j] = __logf(l0[j] + (1.0f - l0[j]) * sigmoidf_(v0[j])); v1[j] = __logf(l1[j] + (1.0f - l1[j]) * sigmoidf_(v1[j])); }
                        }
                        u32x4 w; w.x = pk2(v0[0], v0[1]); w.y = pk2(v0[2], v0[3]); w.z = pk2(v1[0], v1[1]); w.w = pk2(v1[2], v1[3]);
                        *(u32x4*)(dst + (size_t)row * ld + (col - coff)) = w;
                    } else if (MODE == 3) {
                        const u32x4 g = *(const u32x4*)((const bf16_t*)(ws + WS_SAM) + (size_t)row * 1024 + col);
                        GAS float* o = P.out + ((size_t)P.round * RT + row) * 1024 + col;
                        f32x4 r0, r1;
                        r0[0] = v0[0] * bf_lo(g.x); r0[1] = v0[1] * bf_hi(g.x); r0[2] = v0[2] * bf_lo(g.y); r0[3] = v0[3] * bf_hi(g.y);
                        r1[0] = v1[0] * bf_lo(g.z); r1[1] = v1[1] * bf_hi(g.z); r1[2] = v1[2] * bf_lo(g.w); r1[3] = v1[3] * bf_hi(g.w);
                        *(f32x4*)o = r0; *(f32x4*)(o + 4) = r1;
                    } else if (MODE == 4) {
                        const u32x4 g = *(const u32x4*)((const bf16_t*)(ws + WS_SAG) + (size_t)row * 1024 + col);
                        const GAS float* zp = P.out + ((size_t)P.round * RT + row) * 1024 + col;
                        const f32x4 p0 = *(const f32x4*)zp, p1 = *(const f32x4*)(zp + 4);
                        f32x4 r0, r1;
                        r0[0] = p0[0] + v0[0] * bf_lo(g.x); r0[1] = p0[1] + v0[1] * bf_hi(g.x); r0[2] = p0[2] + v0[2] * bf_lo(g.y); r0[3] = p0[3] + v0[3] * bf_hi(g.y);
                        r1[0] = p1[0] + v1[0] * bf_lo(g.z); r1[1] = p1[1] + v1[1] * bf_hi(g.z); r1[2] = p1[2] + v1[2] * bf_lo(g.w); r1[3] = p1[3] + v1[3] * bf_hi(g.w);
                        u32x4 w; w.x = pk2(r0[0], r0[1]); w.y = pk2(r0[2], r0[3]); w.z = pk2(r1[0], r1[1]); w.w = pk2(r1[2], r1[3]);
                        *(u32x4*)((bf16_t*)(ws + WS_GFLOG) + (size_t)row * 1024 + col) = w;
                    } else if (MODE == 5) {
                        const size_t off = ((size_t)P.round * RT + row) * 1024 + col;
                        const f32x4 x0 = *(const f32x4*)(P.x + off), x1 = *(const f32x4*)(P.x + off + 4);
                        *(f32x4*)(P.out + off) = x0 + v0; *(f32x4*)(P.out + off + 4) = x1 + v1;
                    }
                }
        }
    }
};

__device__ __forceinline__ void p0_transpose_item(const GAS float* W, int ldw, int K, int k0, int scol, GAS bf16_t* WT, int drow, LAS float* scr, int lane) {
#pragma unroll 8
    for (int i = 0; i < 32; ++i) { const int kk = 2 * i + (lane >> 5); scr[kk * 33 + (lane & 31)] = W[(size_t)(k0 + kk) * ldw + scol + (lane & 31)]; }
    LDS_WAIT(); asm volatile("" ::: "memory");
    const int c = lane & 7;
#pragma unroll
    for (int j = 0; j < 4; ++j) { const int n = (lane >> 3) + 8 * j; const LAS float* s = scr + (8 * c) * 33 + n;
        u32x4 o; o.x = pk2(s[0 * 33], s[1 * 33]); o.y = pk2(s[2 * 33], s[3 * 33]); o.z = pk2(s[4 * 33], s[5 * 33]); o.w = pk2(s[6 * 33], s[7 * 33]);
        *(u32x4*)(WT + (size_t)(drow + n) * K + k0 + 8 * c) = o; }
    LDS_WAIT(); asm volatile("" ::: "memory");
}
__device__ __forceinline__ int win_src_col(int n) {
    if (n < 4096) return n;
    if (n < 7168) return n - 4096 + 6152;
    if (n < 9216) return n - 7168 + 4096;
    return n - 9216 + 9224;
}

__device__ __forceinline__ void phase_p0(const DArgs& a, LAS unsigned char* lds, int vcu, int G) {
    const int tid = tid_(), lane = tid & 63, wave = tid >> 6;
    const int gw = vcu * NWAVES + wave, NGW = G * NWAVES;
    GAS unsigned char* ws = a.ws;
    LAS float* scr = (LAS float*)(lds + wave * 16384);
    constexpr int I_IN = 16 * 384, I_M = 32 * 32, I_G = 16 * 32, I_O = 16 * 32, I_PQ = 16 * 64;
    constexpr int NITEMS = I_IN + I_M + I_G + I_O + I_PQ;
    for (int it = gw; it < NITEMS; it += NGW) {
        int r = it;
        if (r < I_IN) { const int kb = r / 384, nb = r % 384; p0_transpose_item(a.w_in, IN_COLS, 1024, kb * 64, win_src_col(nb * 32), (GAS bf16_t*)(ws + WS_WIN), nb * 32, scr, lane); continue; } r -= I_IN;
        if (r < I_M) { const int kb = r / 32, nb = r % 32; p0_transpose_item(a.w_br_m, 1024, 2048, kb * 64, nb * 32, (GAS bf16_t*)(ws + WS_WM), nb * 32, scr, lane); continue; } r -= I_M;
        if (r < I_G) { const int kb = r / 32, nb = r % 32; p0_transpose_item(a.w_br_g, 1024, 1024, kb * 64, nb * 32, (GAS bf16_t*)(ws + WS_WG), nb * 32, scr, lane); continue; } r -= I_G;
        if (r < I_O) { const int kb = r / 32, nb = r % 32; p0_transpose_item(a.w_out, 1024, 1024, kb * 64, nb * 32, (GAS bf16_t*)(ws + WS_WO), nb * 32, scr, lane); continue; } r -= I_O;
        { const int kb = r / 64, nb = r % 64; p0_transpose_item(a.w_pq, 2048, 1024, kb * 64, nb * 32, (GAS bf16_t*)(ws + WS_WPQ), nb * 32, scr, lane); }
    }
    const int gt = vcu * NTHR + tid, NGT = G * NTHR;
    for (int i = gt; i < NP; i += NGT) ((float*)(ws + WS_BIASP))[i] = a.b_in[win_src_col(i)];
    for (int i = gt; i < 1024; i += NGT) { const float t0 = a.lb_table[i], t1 = a.lb_table[1024 + i]; ((float*)(ws + WS_LB))[i] = 1.0f / (1.0f + __expf(t1 - t0)); }
    for (int i = gt; i < 8 * 2 * 128 * 128 / 4; i += NGT) { const f32x4 v = ((const f32x4*)a.sub_keys)[i]; u32x2 o; o.x = pk2(v[0], v[1]); o.y = pk2(v[2], v[3]); ((u32x2*)(ws + WS_SK))[i] = o; }
    {
        float mu = 0.f, mv = 0.f;
        for (size_t i = (size_t)vcu * NTHR + tid; i < (size_t)16384 * 1024 / 4; i += (size_t)G * NTHR) {
            const f32x4 u4 = ((const GAS f32x4*)a.u_emb)[i], v4 = ((const GAS f32x4*)a.v_emb)[i];
            mu = fmaxf(mu, fmaxf(fmaxf(fabsf(u4[0]), fabsf(u4[1])), fmaxf(fabsf(u4[2]), fabsf(u4[3]))));
            mv = fmaxf(mv, fmaxf(fmaxf(fabsf(v4[0]), fabsf(v4[1])), fmaxf(fabsf(v4[2]), fabsf(v4[3])))); }
#pragma unroll
        for (int o = 1; o < 64; o <<= 1) { mu = fmaxf(mu, shx(mu, o, lane)); mv = fmaxf(mv, shx(mv, o, lane)); }
        if (lane == 0) { atomicMax((unsigned*)(ws + WS_CTL) + CW_TMAX, __builtin_bit_cast(unsigned, mu)); atomicMax((unsigned*)(ws + WS_CTL) + CW_TMAX + 1, __builtin_bit_cast(unsigned, mv)); }
    }
    f32x4 g1[4];
#pragma unroll
    for (int j = 0; j < 4; ++j) g1[j] = ((const GAS f32x4*)a.norm1_g)[64 * j + lane];
    f32x4 gw0[16], gw1[16];
#pragma unroll
    for (int j = 0; j < 4; ++j)
#pragma unroll
        for (int e = 0; e < 4; ++e) { const int k = 256 * j + 4 * lane + e; gw0[4 * j + e] = *(const GAS f32x4*)(a.w_in + (size_t)k * IN_COLS + 6144); gw1[4 * j + e] = *(const GAS f32x4*)(a.w_in + (size_t)k * IN_COLS + 6148); }
    const float gbias = lane < 8 ? a.b_in[6144 + lane] : 0.f;
    for (int m = gw; m < T; m += NGW) {
        const GAS f32x4* xr = (const GAS f32x4*)(a.x + (size_t)m * D) + lane;
        f32x4 v[4]; float s = 0.f;
#pragma unroll
        for (int j = 0; j < 4; ++j) { v[j] = xr[64 * j]; s += (v[j][0] * v[j][0] + v[j][1] * v[j][1]) + (v[j][2] * v[j][2] + v[j][3] * v[j][3]); }
        const float rstd = rsqrtf(wave_sum(s, lane) * (1.f / D) + EPS);
        GAS unsigned long long* o8 = (GAS unsigned long long*)((GAS bf16_t*)(ws + WS_XN) + (size_t)m * D) + lane;
        f32x4 ga0 = (f32x4){0.f, 0.f, 0.f, 0.f}, ga1 = ga0;
#pragma unroll
        for (int j = 0; j < 4; ++j) {
            v[j] = v[j] * rstd * g1[j];
            o8[64 * j] = (unsigned long long)pk2(v[j][0], v[j][1]) | ((unsigned long long)pk2(v[j][2], v[j][3]) << 32);
#pragma unroll
            for (int e = 0; e < 4; ++e) { ga0 += gw0[4 * j + e] * v[j][e]; ga1 += gw1[4 * j + e] * v[j][e]; }
        }
        float ga[8] = {ga0[0], ga0[1], ga0[2], ga0[3], ga1[0], ga1[1], ga1[2], ga1[3]};
#pragma unroll
        for (int q = 0; q < 8; ++q) ga[q] = wave_sum(ga[q], lane);
        if (lane < 8) { float r = ga[0];
#pragma unroll
            for (int q = 1; q < 8; ++q) r = (lane == q) ? ga[q] : r;
            ((GAS float*)(ws + WS_GATES))[(size_t)m * 8 + lane] = r + gbias; }
    }
}

__device__ __forceinline__ float logsigf_(float x) { return fminf(x, 0.f) - log1pf(__expf(-fabsf(x))); }
#define LDS_BAR() do { asm volatile("s_waitcnt lgkmcnt(0)" ::: "memory"); __builtin_amdgcn_s_barrier(); asm volatile("" ::: "memory"); } while (0)
#define MFMA16(a, b, c) __builtin_amdgcn_mfma_f32_16x16x32_bf16((a), (b), (c), 0, 0, 0)
__device__ __forceinline__ bf16x8 lfrag(const LAS unsigned char* base, int pitch, int row, int k0, int fq) { return *(const LAS bf16x8*)(base + row * pitch + (k0 + 8 * fq) * 2); }
__device__ __forceinline__ bf16x8 gfrag(const bf16_t* base, int ld, int row, int k0, int fq) { return *(const bf16x8*)(base + (size_t)row * ld + k0 + 8 * fq); }

__device__ __forceinline__ void mscan_pair(const DArgs& a, int round, int p, int lane) {
    const int bl = p >> 2, h = p & 3, b = round * 2 + bl;
    const float* g = (const float*)(a.ws + WS_GATES) + ((size_t)b * SEQ + (size_t)lane * 128) * 8;
    float bsum = 0.f, gm = -INFINITY;
    for (int s = 0; s < 128; ++s) { const float ip = g[s * 8 + h], fp = g[s * 8 + 4 + h]; bsum += logsigf_(fp); gm = fmaxf(gm, ip - bsum); }
    float mprev = 0.f, mine = 0.f;
    for (int c = 0; c < 64; ++c) {
        const float bc = rdlane(bsum, c), gc = rdlane(gm, c);
        if (lane == c) mine = mprev; mprev = bc + fmaxf(mprev, gc); }
    ((float*)(a.ws + WS_MPREV))[(round * 8 + p) * 64 + lane] = mine;
}

constexpr int PQ_PITCH = 528, PS_PITCH = 272;
__device__ __forceinline__ void mlstm_pre_item(const DArgs& a, LAS unsigned char* lds, int round, int item) {
    const int tid = tid_(), lane = tid & 63, wave = __builtin_amdgcn_readfirstlane(tid >> 6), fr = lane & 15, fq = lane >> 4;
    const int p = item >> 6, c = item & 63, bl = p >> 2, h = p & 3, b = round * 2 + bl;
    const int tl0 = bl * SEQ + c * 128; const size_t tg0 = (size_t)b * SEQ + c * 128;
    GAS unsigned char* ws = a.ws;
    LAS unsigned char* QL = lds; LAS unsigned char* KL = lds + 67584;
    LAS float* AS = (LAS float*)(lds + 135168); LAS float* MS = AS + 128; LAS float* SC = AS + 256;
    if (wave == 0) {
        const float mprev = ((const float*)(ws + WS_MPREV))[(round * 8 + p) * 64 + c];
        const float* g = (const float*)(ws + WS_GATES) + (tg0 + 2 * lane) * 8;
        const float ip0 = g[h], fp0 = g[4 + h], ip1 = g[8 + h], fp1 = g[12 + h];
        const float lf0 = logsigf_(fp0), lf1 = logsigf_(fp1), pp = lf0 + lf1;
        float incl = pp;
#pragma unroll
        for (int o = 1; o < 64; o <<= 1) { const float t = shup(incl, o, lane); if (lane >= o) incl += t; }
        const float excl = incl - pp, b0 = excl + lf0, b1 = incl;
        const float a0 = ip0 - b0, a1 = ip1 - b1;
        float inclm = fmaxf(a0, a1);
#pragma unroll
        for (int o = 1; o < 64; o <<= 1) { const float t = shup(inclm, o, lane); if (lane >= o) inclm = fmaxf(inclm, t); }
        float exclm = shup(inclm, 1, lane); if (lane == 0) exclm = -INFINITY;
        const float M0 = fmaxf(mprev, fmaxf(exclm, a0)), M1 = fmaxf(mprev, inclm);
        AS[2 * lane] = a0; AS[2 * lane + 1] = a1; MS[2 * lane] = M0; MS[2 * lane + 1] = M1;
        float* mt = (float*)(ws + WS_MT) + (tg0 + 2 * lane) * 4 + h;
        mt[0] = b0 + M0; mt[4] = b1 + M1;
        const float Mlast = rdlane(M1, 63);
        if (lane == 0) { SC[0] = mprev; SC[1] = Mlast; ((float*)(ws + WS_MDEC))[item] = __expf(mprev - Mlast); }
    }
    {
        const int cgp = tid & 63, strip = tid >> 6;
        const int col = (cgp < 32) ? (h * 256 + cgp * 8) : (1024 + h * 256 + (cgp - 32) * 8);
        float w[4][8], bb[8];
#pragma unroll
        for (int j = 0; j < 4; ++j) { const f32x4 w0 = *(const f32x4*)(a.conv_w + j * 2048 + col), w1 = *(const f32x4*)(a.conv_w + j * 2048 + col + 4);
#pragma unroll
            for (int e = 0; e < 4; ++e) { w[j][e] = w0[e]; w[j][4 + e] = w1[e]; } }
        { const f32x4 b0 = *(const f32x4*)(a.conv_b + col), b1 = *(const f32x4*)(a.conv_b + col + 4);
#pragma unroll
            for (int e = 0; e < 4; ++e) { bb[e] = b0[e]; bb[4 + e] = b1[e]; } }
        const bf16_t* src = (const bf16_t*)(ws + WS_QKPRE) + (size_t)(tl0 + 16 * strip) * 2048 + col;
        const float qs = (cgp < 32) ? 0.0625f : 1.0f;
        LAS unsigned char* dstt = ((cgp < 32) ? QL : KL) + (cgp & 31) * 16;
#pragma unroll 1
        for (int half = 0; half < 2; ++half) {
            u32x4 xr[11];
#pragma unroll
            for (int r = 0; r < 11; ++r) {
                const int sl = c * 128 + 16 * strip + 8 * half + r - 3;
                xr[r] = (sl >= 0) ? *(const u32x4*)(src + (ptrdiff_t)(8 * half + r - 3) * 2048) : (u32x4){0u, 0u, 0u, 0u};
            }
#pragma unroll
            for (int r = 0; r < 8; ++r) {
                float y[8];
#pragma unroll
                for (int e = 0; e < 8; ++e) y[e] = bb[e];
#pragma unroll
                for (int j = 0; j < 4; ++j) { const u32x4 xv = xr[r + j];
                    y[0] += w[j][0] * bf_lo(xv.x); y[1] += w[j][1] * bf_hi(xv.x); y[2] += w[j][2] * bf_lo(xv.y); y[3] += w[j][3] * bf_hi(xv.y);
                    y[4] += w[j][4] * bf_lo(xv.z); y[5] += w[j][5] * bf_hi(xv.z); y[6] += w[j][6] * bf_lo(xv.w); y[7] += w[j][7] * bf_hi(xv.w); }
#pragma unroll
                for (int e = 0; e < 8; ++e) y[e] = siluf_(y[e]) * qs;
                u32x4 o; o.x = pk2(y[0], y[1]); o.y = pk2(y[2], y[3]); o.z = pk2(y[4], y[5]); o.w = pk2(y[6], y[7]);
                *(LAS u32x4*)(dstt + (16 * strip + 8 * half + r) * PQ_PITCH) = o;
            }
        }
    }
    __syncthreads();
    const float mprev = SC[0], Mlast = SC[1];
    {
        bf16_t* Sg = (bf16_t*)(ws + WS_S) + (size_t)item * 128 * 128;
        const int t = wave * 16 + fr; const float Mt = MS[t];
        for (int st = 0; st < 8; ++st) {
            u32x2 o = (u32x2){0u, 0u};
            if (st <= wave) {
                f32x4 acc = (f32x4){0.f, 0.f, 0.f, 0.f};
#pragma unroll
                for (int ks = 0; ks < 8; ++ks) acc = MFMA16(lfrag(KL, PQ_PITCH, st * 16 + fr, ks * 32, fq), lfrag(QL, PQ_PITCH, wave * 16 + fr, ks * 32, fq), acc);
                float v[4];
#pragma unroll
                for (int j = 0; j < 4; ++j) { const int s = st * 16 + 4 * fq + j; v[j] = (s <= t) ? acc[j] * __expf(AS[s] - Mt) : 0.f; }
                o.x = pk2(v[0], v[1]); o.y = pk2(v[2], v[3]);
            }
            *(u32x2*)(Sg + (size_t)t * 128 + st * 16 + 4 * fq) = o;
        }
    }
    {
        bf16_t* Qg = (bf16_t*)(ws + WS_QT) + (size_t)item * 128 * 256;
#pragma unroll
        for (int i = 0; i < 8; ++i) { const int idx = tid + 512 * i, t = idx >> 5, ch = idx & 31;
            const u32x4 v = *(const LAS u32x4*)(QL + t * PQ_PITCH + ch * 16); const float s = __expf(mprev - MS[t]);
            u32x4 o; o.x = pk2(bf_lo(v.x) * s, bf_hi(v.x) * s); o.y = pk2(bf_lo(v.y) * s, bf_hi(v.y) * s); o.z = pk2(bf_lo(v.z) * s, bf_hi(v.z) * s); o.w = pk2(bf_lo(v.w) * s, bf_hi(v.w) * s);
            *(u32x4*)(Qg + (size_t)t * 256 + ch * 8) = o; }
    }
    {
        bf16_t* Kg = (bf16_t*)(ws + WS_KWT) + (size_t)item * 256 * 128;
        const int dlo = lane & 15, sglo = lane >> 4;
#pragma unroll
        for (int i = 0; i < 8; ++i) { const int combo = wave * 8 + i, d = (combo >> 2) * 16 + dlo, s0 = ((combo & 3) * 4 + sglo) * 8;
            float v[8];
#pragma unroll
            for (int e = 0; e < 8; ++e) v[e] = bf2f(*(const LAS bf16_t*)(KL + (s0 + e) * PQ_PITCH + d * 2)) * __expf(AS[s0 + e] - Mlast);
            u32x4 o; o.x = pk2(v[0], v[1]); o.y = pk2(v[2], v[3]); o.z = pk2(v[4], v[5]); o.w = pk2(v[6], v[7]);
            *(u32x4*)(Kg + (size_t)d * 128 + s0) = o; }
    }
    __syncthreads();
}

__device__ __forceinline__ void hgrn_pre_item(const DArgs& a, LAS unsigned char* lds, int round, int item) {
    const int tid = tid_(), lane = tid & 63, wave = __builtin_amdgcn_readfirstlane(tid >> 6), fr = lane & 15, fq = lane >> 4;
    const int p = item >> 7, c = item & 127, bl = p >> 3, h = p & 7;
    const int tl0 = bl * SEQ + c * 64;
    GAS unsigned char* ws = a.ws;
    LAS float* CUM = (LAS float*)lds;
    LAS float* GL = (LAS float*)(lds + 32768);
    LAS unsigned char* QH = lds + 65536;
    LAS unsigned char* KE = lds + 65536 + 64 * PS_PITCH;
    LAS float* QF = (LAS float*)(lds + 65536 + 128 * PS_PITCH);
#pragma unroll
    for (int i = 0; i < 2; ++i) { const int idx = tid + 512 * i, s = idx >> 4, ch = idx & 15;
        const u32x4 gv = *(const u32x4*)((const bf16_t*)(ws + WS_GFLOG) + (size_t)(tl0 + s) * 1024 + h * 128 + ch * 8);
        const u32x4 qv = *(const u32x4*)((const bf16_t*)(ws + WS_GQ) + (size_t)(tl0 + s) * 1024 + h * 128 + ch * 8);
        LAS float* gd = GL + s * 128 + ch * 8; LAS float* qd = QF + s * 128 + ch * 8;
        gd[0] = bf_lo(gv.x); gd[1] = bf_hi(gv.x); gd[2] = bf_lo(gv.y); gd[3] = bf_hi(gv.y); gd[4] = bf_lo(gv.z); gd[5] = bf_hi(gv.z); gd[6] = bf_lo(gv.w); gd[7] = bf_hi(gv.w);
        qd[0] = bf_lo(qv.x); qd[1] = bf_hi(qv.x); qd[2] = bf_lo(qv.y); qd[3] = bf_hi(qv.y); qd[4] = bf_lo(qv.z); qd[5] = bf_hi(qv.z); qd[6] = bf_lo(qv.w); qd[7] = bf_hi(qv.w); }
    __syncthreads();
    if (tid < 128) { float cs = 0.f;
        for (int s = 0; s < 64; ++s) { cs += GL[s * 128 + tid]; CUM[s * 128 + tid] = cs; }
        ((float*)(ws + WS_HGDEC))[(size_t)item * 128 + tid] = __expf(cs); }
    __syncthreads();
    {
        bf16_t* Qg = (bf16_t*)(ws + WS_QTG) + (size_t)item * 64 * 128;
#pragma unroll
        for (int i = 0; i < 2; ++i) { const int idx = tid + 512 * i, s = idx >> 4, ch = idx & 15;
            float qt[8], qh[8], ke[8];
#pragma unroll
            for (int e = 0; e < 8; ++e) { const int d = ch * 8 + e; const float cm = CUM[s * 128 + d], last = CUM[63 * 128 + d], q = QF[s * 128 + d], g = GL[s * 128 + d];
                qt[e] = q * __expf(cm); qh[e] = q * __expf(cm - last); ke[e] = (1.0f - __expf(g)) * __expf(last - cm); }
            u32x4 o; o.x = pk2(qt[0], qt[1]); o.y = pk2(qt[2], qt[3]); o.z = pk2(qt[4], qt[5]); o.w = pk2(qt[6], qt[7]);
            *(u32x4*)(Qg + (size_t)s * 128 + ch * 8) = o;
            o.x = pk2(qh[0], qh[1]); o.y = pk2(qh[2], qh[3]); o.z = pk2(qh[4], qh[5]); o.w = pk2(qh[6], qh[7]);
            *(LAS u32x4*)(QH + s * PS_PITCH + ch * 16) = o;
            o.x = pk2(ke[0], ke[1]); o.y = pk2(ke[2], ke[3]); o.z = pk2(ke[4], ke[5]); o.w = pk2(ke[6], ke[7]);
            *(LAS u32x4*)(KE + s * PS_PITCH + ch * 16) = o; }
    }
    __syncthreads();
    {
        bf16_t* Ag = (bf16_t*)(ws + WS_ATT) + (size_t)item * 64 * 64;
#pragma unroll
        for (int i = 0; i < 2; ++i) { const int tile = wave * 2 + i, tt = tile >> 2, st = tile & 3; const int t = tt * 16 + fr;
            u32x2 o = (u32x2){0u, 0u};
            if (st <= tt) { f32x4 acc = (f32x4){0.f, 0.f, 0.f, 0.f};
#pragma unroll
                for (int ks = 0; ks < 4; ++ks) acc = MFMA16(lfrag(KE, PS_PITCH, st * 16 + fr, ks * 32, fq), lfrag(QH, PS_PITCH, tt * 16 + fr, ks * 32, fq), acc);
                float v[4];
#pragma unroll
                for (int j = 0; j < 4; ++j) { const int s = st * 16 + 4 * fq + j; v[j] = (s <= t) ? acc[j] : 0.f; }
                o.x = pk2(v[0], v[1]); o.y = pk2(v[2], v[3]); }
            *(u32x2*)(Ag + (size_t)t * 64 + st * 16 + 4 * fq) = o; }
    }
    {
        bf16_t* Kg = (bf16_t*)(ws + WS_KENDT) + (size_t)item * 128 * 64;
        const int dlo = lane & 15, sglo = lane >> 4;
#pragma unroll
        for (int i = 0; i < 2; ++i) { const int combo = wave * 2 + i, d = (combo >> 1) * 16 + dlo, s0 = ((combo & 1) * 4 + sglo) * 8;
            unsigned v[8];
#pragma unroll
            for (int e = 0; e < 8; ++e) v[e] = *(const LAS bf16_t*)(KE + (s0 + e) * PS_PITCH + d * 2);
            u32x4 o; o.x = v[0] | (v[1] << 16); o.y = v[2] | (v[3] << 16); o.z = v[4] | (v[5] << 16); o.w = v[6] | (v[7] << 16);
            *(u32x4*)(Kg + (size_t)d * 64 + s0) = o; }
    }
    __syncthreads();
}

__device__ __forceinline__ void mlstm_scan(const DArgs& a, LAS unsigned char* lds, int round, int p, int sl) {
    const int tid = tid_(), lane = tid & 63, wave = __builtin_amdgcn_readfirstlane(tid >> 6), fr = lane & 15, fq = lane >> 4;
    const int bl = p >> 2, h = p & 3, b = round * 2 + bl;
    GAS unsigned char* ws = a.ws;
    constexpr int VTB = 48 * PS_PITCH, CTB = 48 * PQ_PITCH;
    LAS unsigned char* VT = lds; LAS unsigned char* CT = lds + 2 * VTB;
    for (int i = tid; i < (2 * VTB + 2 * CTB) / 4; i += NTHR) ((LAS unsigned*)lds)[i] = 0u;
    __syncthreads();
    if (tid < 256) { const int bufi = tid >> 7, s = tid & 127; *(LAS bf16_t*)(VT + bufi * VTB + 32 * PS_PITCH + s * 2) = (bf16_t)0x3F80; }
    f32x4 st[2][3];
#pragma unroll
    for (int dt = 0; dt < 2; ++dt)
#pragma unroll
        for (int vt = 0; vt < 3; ++vt) st[dt][vt] = (f32x4){0.f, 0.f, 0.f, 0.f};
    const int vcol = h * 512 + sl * 32;
    const int vs = tid >> 2, vpart = tid & 3;
    const bf16_t* Sg0 = (const bf16_t*)(ws + WS_S) + (size_t)(p * 64) * 128 * 128 + (size_t)(wave * 16 + fr) * 128 + 8 * fq;
    const bf16_t* Qg0 = (const bf16_t*)(ws + WS_QT) + (size_t)(p * 64) * 128 * 256 + (size_t)(wave * 16 + fr) * 256 + 8 * fq;
    const bf16_t* Kg0 = (const bf16_t*)(ws + WS_KWT) + (size_t)(p * 64) * 256 * 128 + (size_t)(wave * 32 + fr) * 128 + 8 * fq;
    const bf16_t* Vg0 = (const bf16_t*)(ws + WS_V) + (size_t)(bl * SEQ + vs) * 2048 + vcol + vpart * 8;
    bf16x8 bS[4], bQ[8], aK[2][4]; u32x4 vreg; float dec;
    vreg = *(const u32x4*)Vg0;
#pragma unroll
    for (int ks = 0; ks < 4; ++ks) bS[ks] = *(const bf16x8*)(Sg0 + ks * 32);
#pragma unroll
    for (int ks = 0; ks < 8; ++ks) bQ[ks] = *(const bf16x8*)(Qg0 + ks * 32);
#pragma unroll
    for (int dt = 0; dt < 2; ++dt)
#pragma unroll
        for (int ks = 0; ks < 4; ++ks) aK[dt][ks] = *(const bf16x8*)(Kg0 + (size_t)dt * 16 * 128 + ks * 32);
    dec = ((const GAS float*)(ws + WS_MDEC))[p * 64];
#pragma unroll 1
    for (int c = 0; c < 64; ++c) {
        const int tl0 = bl * SEQ + c * 128; const size_t tg0 = (size_t)b * SEQ + c * 128;
        const int cn = c < 63 ? c + 1 : 63;
        LAS unsigned char* vt_ = VT + (c & 1) * VTB; LAS unsigned char* ct_ = CT + (c & 1) * CTB; LAS unsigned char* ctn = CT + ((c + 1) & 1) * CTB;
        {
            LAS unsigned char* d0 = vt_ + (vpart * 8) * PS_PITCH + vs * 2;
            *(LAS bf16_t*)(d0 + 0 * PS_PITCH) = (bf16_t)(vreg.x & 0xffffu); *(LAS bf16_t*)(d0 + 1 * PS_PITCH) = (bf16_t)(vreg.x >> 16);
            *(LAS bf16_t*)(d0 + 2 * PS_PITCH) = (bf16_t)(vreg.y & 0xffffu); *(LAS bf16_t*)(d0 + 3 * PS_PITCH) = (bf16_t)(vreg.y >> 16);
            *(LAS bf16_t*)(d0 + 4 * PS_PITCH) = (bf16_t)(vreg.z & 0xffffu); *(LAS bf16_t*)(d0 + 5 * PS_PITCH) = (bf16_t)(vreg.z >> 16);
            *(LAS bf16_t*)(d0 + 6 * PS_PITCH) = (bf16_t)(vreg.w & 0xffffu); *(LAS bf16_t*)(d0 + 7 * PS_PITCH) = (bf16_t)(vreg.w >> 16);
            vreg = *(const u32x4*)(Vg0 + (size_t)cn * 128 * 2048);
        }
        LDS_BAR();
        bf16x8 vf[3][4];
#pragma unroll
        for (int vt = 0; vt < 3; ++vt)
#pragma unroll
            for (int ks = 0; ks < 4; ++ks) vf[vt][ks] = lfrag(vt_, PS_PITCH, vt * 16 + fr, ks * 32, fq);
        {
            f32x4 acc[3];
#pragma unroll
            for (int vt = 0; vt < 3; ++vt) acc[vt] = (f32x4){0.f, 0.f, 0.f, 0.f};
            bf16x8 cf[3][4];
#pragma unroll
            for (int vt = 0; vt < 3; ++vt)
#pragma unroll
                for (int ks = 0; ks < 4; ++ks) cf[vt][ks] = lfrag(ct_, PQ_PITCH, vt * 16 + fr, ks * 32, fq);
            __builtin_amdgcn_sched_barrier(0);
#pragma unroll
            for (int ks = 0; ks < 4; ++ks) {
#pragma unroll
                for (int vt = 0; vt < 3; ++vt) acc[vt] = MFMA16(vf[vt][ks], bS[ks], acc[vt]); }
#pragma unroll
            for (int ks = 0; ks < 4; ++ks) {
#pragma unroll
                for (int vt = 0; vt < 3; ++vt) acc[vt] = MFMA16(cf[vt][ks], bQ[ks], acc[vt]); }
            __builtin_amdgcn_sched_barrier(0);
#pragma unroll
            for (int vt = 0; vt < 3; ++vt)
#pragma unroll
                for (int ks = 0; ks < 4; ++ks) cf[vt][ks] = lfrag(ct_, PQ_PITCH, vt * 16 + fr, 128 + ks * 32, fq);
            __builtin_amdgcn_sched_barrier(0);
#pragma unroll
            for (int ks = 0; ks < 4; ++ks) {
#pragma unroll
                for (int vt = 0; vt < 3; ++vt) acc[vt] = MFMA16(cf[vt][ks], bQ[4 + ks], acc[vt]); }
            __builtin_amdgcn_sched_barrier(0);
#pragma unroll
            for (int ks = 0; ks < 4; ++ks) bS[ks] = *(const bf16x8*)(Sg0 + (size_t)cn * 128 * 128 + ks * 32);
#pragma unroll
            for (int ks = 0; ks < 8; ++ks) bQ[ks] = *(const bf16x8*)(Qg0 + (size_t)cn * 128 * 256 + ks * 32);
            const int t = wave * 16 + fr;
            bf16_t* hn = (bf16_t*)(ws + WS_QKPRE) + (size_t)(tl0 + t) * 2048 + vcol + 4 * fq;
#pragma unroll
            for (int vt = 0; vt < 2; ++vt) { u32x2 o; o.x = pk2(acc[vt][0], acc[vt][1]); o.y = pk2(acc[vt][2], acc[vt][3]); *(u32x2*)(hn + vt * 16) = o; }
            if (sl == 0 && fq == 0) ((float*)(ws + WS_DEN))[(tg0 + t) * 4 + h] = acc[2][0];
        }
        {
#pragma unroll
            for (int dt = 0; dt < 2; ++dt)
#pragma unroll
                for (int vt = 0; vt < 3; ++vt) st[dt][vt] = st[dt][vt] * dec;
#pragma unroll
            for (int ks = 0; ks < 4; ++ks) {
#pragma unroll
                for (int dt = 0; dt < 2; ++dt) {
#pragma unroll
                    for (int vt = 0; vt < 3; ++vt) st[dt][vt] = MFMA16(aK[dt][ks], vf[vt][ks], st[dt][vt]); }
            }
            __builtin_amdgcn_sched_barrier(0);
#pragma unroll
            for (int dt = 0; dt < 2; ++dt)
#pragma unroll
                for (int ks = 0; ks < 4; ++ks) aK[dt][ks] = *(const bf16x8*)(Kg0 + (size_t)cn * 256 * 128 + (size_t)dt * 16 * 128 + ks * 32);
            dec = ((const float*)(ws + WS_MDEC))[p * 64 + cn];
#pragma unroll
            for (int dt = 0; dt < 2; ++dt)
#pragma unroll
                for (int vt = 0; vt < 3; ++vt) { u32x2 o; o.x = pk2(st[dt][vt][0], st[dt][vt][1]); o.y = pk2(st[dt][vt][2], st[dt][vt][3]);
                    *(LAS u32x2*)(ctn + (vt * 16 + fr) * PQ_PITCH + (wave * 32 + dt * 16 + 4 * fq) * 2) = o; }
        }
    }
    __syncthreads();
}

__device__ __forceinline__ void hgrn_scan(const DArgs& a, LAS unsigned char* lds, int round, int p, int sl) {
    const int tid = tid_(), lane = tid & 63, wave = __builtin_amdgcn_readfirstlane(tid >> 6), fr = lane & 15, fq = lane >> 4;
    const int bl = p >> 3, h = p & 7;
    GAS unsigned char* ws = a.ws;
    constexpr int IP = 144, ITB = 32 * IP, STB = 32 * PS_PITCH;
    LAS unsigned char* IT = lds; LAS unsigned char* ST = lds + 2 * ITB;
    for (int i = tid; i < (2 * ITB + 2 * STB) / 4; i += NTHR) ((LAS unsigned*)lds)[i] = 0u;
    __syncthreads();
    f32x4 st[2];
    st[0] = (f32x4){0.f, 0.f, 0.f, 0.f}; st[1] = st[0];
    const int vcol = h * 128 + sl * 32;
    const int is = (tid & 255) >> 2, ipart = tid & 3;
    const int w4 = wave & 3, vtw = wave >> 2;
    const bf16_t* Ag0 = (const bf16_t*)(ws + WS_ATT) + (size_t)(p * 128) * 64 * 64 + (size_t)(w4 * 16 + fr) * 64 + 8 * fq;
    const bf16_t* Qg0 = (const bf16_t*)(ws + WS_QTG) + (size_t)(p * 128) * 64 * 128 + (size_t)(w4 * 16 + fr) * 128 + 8 * fq;
    const bf16_t* Kg0 = (const bf16_t*)(ws + WS_KENDT) + (size_t)(p * 128) * 128 * 64 + (size_t)(wave * 16 + fr) * 64 + 8 * fq;
    const float* Dg0 = (const float*)(ws + WS_HGDEC) + (size_t)(p * 128) * 128 + wave * 16 + 4 * fq;
    const bf16_t* Ig0 = (const bf16_t*)(ws + WS_GI) + (size_t)(bl * SEQ + is) * 1024 + vcol + ipart * 8;
    bf16x8 bA[2], bQ[4], aK[2]; f32x4 dec; u32x4 ireg;
    ireg = *(const u32x4*)(Ig0);
#pragma unroll
    for (int ks = 0; ks < 2; ++ks) bA[ks] = *(const bf16x8*)(Ag0 + ks * 32);
#pragma unroll
    for (int ks = 0; ks < 4; ++ks) bQ[ks] = *(const bf16x8*)(Qg0 + ks * 32);
#pragma unroll
    for (int ks = 0; ks < 2; ++ks) aK[ks] = *(const bf16x8*)(Kg0 + ks * 32);
    dec = *(const f32x4*)(Dg0);
#pragma unroll 1
    for (int c = 0; c < 128; ++c) {
        const int tl0 = bl * SEQ + c * 64;
        const int cn = c < 127 ? c + 1 : 127;
        LAS unsigned char* it_ = IT + (c & 1) * ITB; LAS unsigned char* st_ = ST + (c & 1) * STB; LAS unsigned char* stn = ST + ((c + 1) & 1) * STB;
        {
            if (tid < 256) {
                LAS unsigned char* d0 = it_ + (ipart * 8) * IP + is * 2;
                *(LAS bf16_t*)(d0 + 0 * IP) = (bf16_t)(ireg.x & 0xffffu); *(LAS bf16_t*)(d0 + 1 * IP) = (bf16_t)(ireg.x >> 16);
                *(LAS bf16_t*)(d0 + 2 * IP) = (bf16_t)(ireg.y & 0xffffu); *(LAS bf16_t*)(d0 + 3 * IP) = (bf16_t)(ireg.y >> 16);
                *(LAS bf16_t*)(d0 + 4 * IP) = (bf16_t)(ireg.z & 0xffffu); *(LAS bf16_t*)(d0 + 5 * IP) = (bf16_t)(ireg.z >> 16);
                *(LAS bf16_t*)(d0 + 6 * IP) = (bf16_t)(ireg.w & 0xffffu); *(LAS bf16_t*)(d0 + 7 * IP) = (bf16_t)(ireg.w >> 16); }
            ireg = *(const u32x4*)(Ig0 + (size_t)cn * 64 * 1024);
        }
        LDS_BAR();
        bf16x8 itf[2][2];
#pragma unroll
        for (int vt = 0; vt < 2; ++vt)
#pragma unroll
            for (int ks = 0; ks < 2; ++ks) itf[vt][ks] = lfrag(it_, IP, vt * 16 + fr, ks * 32, fq);
        {
            bf16x8 sf[4];
#pragma unroll
            for (int ks = 0; ks < 4; ++ks) sf[ks] = lfrag(st_, PS_PITCH, vtw * 16 + fr, ks * 32, fq);
            f32x4 acc = (f32x4){0.f, 0.f, 0.f, 0.f};
#pragma unroll
            for (int ks = 0; ks < 2; ++ks) acc = MFMA16(vtw ? itf[1][ks] : itf[0][ks], bA[ks], acc);
#pragma unroll
            for (int ks = 0; ks < 4; ++ks) acc = MFMA16(sf[ks], bQ[ks], acc);
            __builtin_amdgcn_sched_barrier(0);
#pragma unroll
            for (int ks = 0; ks < 2; ++ks) bA[ks] = *(const bf16x8*)(Ag0 + (size_t)cn * 64 * 64 + ks * 32);
#pragma unroll
            for (int ks = 0; ks < 4; ++ks) bQ[ks] = *(const bf16x8*)(Qg0 + (size_t)cn * 64 * 128 + ks * 32);
            u32x2 o; o.x = pk2(acc[0], acc[1]); o.y = pk2(acc[2], acc[3]);
            *(u32x2*)((bf16_t*)(ws + WS_GQ) + (size_t)(tl0 + w4 * 16 + fr) * 1024 + vcol + vtw * 16 + 4 * fq) = o;
        }
        {
#pragma unroll
            for (int vt = 0; vt < 2; ++vt) { st[vt] = st[vt] * dec;
#pragma unroll
                for (int ks = 0; ks < 2; ++ks) st[vt] = MFMA16(aK[ks], itf[vt][ks], st[vt]); }
            __builtin_amdgcn_sched_barrier(0);
#pragma unroll
            for (int ks = 0; ks < 2; ++ks) aK[ks] = *(const bf16x8*)(Kg0 + (size_t)cn * 128 * 64 + ks * 32);
            dec = *(const f32x4*)(Dg0 + (size_t)cn * 128);
#pragma unroll
            for (int vt = 0; vt < 2; ++vt) { u32x2 o; o.x = pk2(st[vt][0], st[vt][1]); o.y = pk2(st[vt][2], st[vt][3]);
                *(LAS u32x2*)(stn + (vt * 16 + fr) * PS_PITCH + (wave * 16 + 4 * fq) * 2) = o; }
        }
    }
    __syncthreads();
}

__device__ __forceinline__ void phase_ypass(const DArgs& a, int round, int vcu, int G) {
    const int tid = tid_(), lane = tid & 63, wave = tid >> 6;
    const int gw = vcu * NWAVES + wave, NGW = G * NWAVES;
    GAS unsigned char* ws = a.ws;
    f32x4 mg0[4], mg1[4], gg4[4];
#pragma unroll
    for (int j = 0; j < 4; ++j) { mg0[j] = *(const GAS f32x4*)(a.m_head_g + j * 512 + lane * 8); mg1[j] = *(const GAS f32x4*)(a.m_head_g + j * 512 + lane * 8 + 4); gg4[j] = *(const GAS f32x4*)(a.g_head_g + lane * 16 + 4 * j); }
    for (int tl = gw; tl < RT; tl += NGW) {
        const size_t tg = (size_t)round * RT + tl;
        const f32x4 den4 = *(const f32x4*)((const float*)(ws + WS_DEN) + tg * 4), mt4 = *(const f32x4*)((const float*)(ws + WS_MT) + tg * 4);
#pragma unroll
        for (int j = 0; j < 4; ++j) {
            const int col = j * 512 + lane * 8;
            const u32x4 nv = *(const u32x4*)((const bf16_t*)(ws + WS_QKPRE) + (size_t)tl * 2048 + col);
            const u32x4 ov = *(const u32x4*)((const bf16_t*)(ws + WS_SIGO) + (size_t)tl * 2048 + col);
            const float inv = 1.0f / fmaxf(fabsf(den4[j]), __expf(-mt4[j]));
            float hv[8] = {bf_lo(nv.x) * inv, bf_hi(nv.x) * inv, bf_lo(nv.y) * inv, bf_hi(nv.y) * inv, bf_lo(nv.z) * inv, bf_hi(nv.z) * inv, bf_lo(nv.w) * inv, bf_hi(nv.w) * inv};
            float ss = 0.f;
#pragma unroll
            for (int e = 0; e < 8; ++e) ss += hv[e] * hv[e];
            const float r = rsqrtf(wave_sum(ss, lane) * (1.f / 512.f) + EPS);
            const f32x4 g0 = mg0[j], g1 = mg1[j];
            const float og[8] = {bf_lo(ov.x), bf_hi(ov.x), bf_lo(ov.y), bf_hi(ov.y), bf_lo(ov.z), bf_hi(ov.z), bf_lo(ov.w), bf_hi(ov.w)};
            float y[8];
#pragma unroll
            for (int e = 0; e < 8; ++e) y[e] = og[e] * hv[e] * r * (e < 4 ? g0[e] : g1[e - 4]);
            u32x4 o; o.x = pk2(y[0], y[1]); o.y = pk2(y[2], y[3]); o.z = pk2(y[4], y[5]); o.w = pk2(y[6], y[7]);
            *(u32x4*)((bf16_t*)(ws + WS_V) + (size_t)tl * 2048 + col) = o;
        }
        {
            const int col = lane * 16;
            const u32x4 n0 = *(const u32x4*)((const bf16_t*)(ws + WS_GQ) + (size_t)tl * 1024 + col), n1 = *(const u32x4*)((const bf16_t*)(ws + WS_GQ) + (size_t)tl * 1024 + col + 8);
            const u32x4 s0 = *(const u32x4*)((const bf16_t*)(ws + WS_SGG) + (size_t)tl * 1024 + col), s1 = *(const u32x4*)((const bf16_t*)(ws + WS_SGG) + (size_t)tl * 1024 + col + 8);
            float ov[16] = {bf_lo(n0.x), bf_hi(n0.x), bf_lo(n0.y), bf_hi(n0.y), bf_lo(n0.z), bf_hi(n0.z), bf_lo(n0.w), bf_hi(n0.w), bf_lo(n1.x), bf_hi(n1.x), bf_lo(n1.y), bf_hi(n1.y), bf_lo(n1.z), bf_hi(n1.z), bf_lo(n1.w), bf_hi(n1.w)};
            const float sg[16] = {bf_lo(s0.x), bf_hi(s0.x), bf_lo(s0.y), bf_hi(s0.y), bf_lo(s0.z), bf_hi(s0.z), bf_lo(s0.w), bf_hi(s0.w), bf_lo(s1.x), bf_hi(s1.x), bf_lo(s1.y), bf_hi(s1.y), bf_lo(s1.z), bf_hi(s1.z), bf_lo(s1.w), bf_hi(s1.w)};
            float ss = 0.f;
#pragma unroll
            for (int e = 0; e < 16; ++e) ss += ov[e] * ov[e];
            ss += DPP_(ss, 0xB1); ss += DPP_(ss, 0x4E); ss += DPP_(ss, 0x141);
            const float r = rsqrtf(ss * (1.f / 128.f) + EPS);
            float y[16];
#pragma unroll
            for (int e = 0; e < 16; ++e) y[e] = ov[e] * r * gg4[e >> 2][e & 3] * sg[e];
            u32x4 o; o.x = pk2(y[0], y[1]); o.y = pk2(y[2], y[3]); o.z = pk2(y[4], y[5]); o.w = pk2(y[6], y[7]);
            *(u32x4*)((bf16_t*)(ws + WS_GI) + (size_t)tl * 1024 + col) = o;
            o.x = pk2(y[8], y[9]); o.y = pk2(y[10], y[11]); o.z = pk2(y[12], y[13]); o.w = pk2(y[14], y[15]);
            *(u32x4*)((bf16_t*)(ws + WS_GI) + (size_t)tl * 1024 + col + 8) = o;
        }
    }
}


#define XB_TMO      128
#define XB_XCNT(j)  (256  + 64 * (j))
#define XB_XSUB(j)  (1280 + 64 * (j))
#define XB_XGEN(j)  (2304 + 64 * (j))
#define XB_TOP      3328
#define XB_TOPGEN   3392
#define XB_SPIN_CAP (1u << 22)
constexpr int CW_BAR = 4096;
constexpr int LDS_BARST = LDS_BYTES - 64;
__device__ __forceinline__ unsigned xb_ld(unsigned* p)              { return __hip_atomic_load(p, __ATOMIC_RELAXED, __HIP_MEMORY_SCOPE_AGENT); }
__device__ __forceinline__ unsigned xb_add(unsigned* p, unsigned v) { return __hip_atomic_fetch_add(p, v, __ATOMIC_RELAXED, __HIP_MEMORY_SCOPE_AGENT); }
__device__ __forceinline__ unsigned xb_xcc_id() { return (unsigned)__builtin_amdgcn_s_getreg((3 << 11) | 20) & 0xFu; }
#define XB_SPIN(cond, bar) do { unsigned _sp = 0; while (cond) { __builtin_amdgcn_s_sleep(1); \
    if ((++_sp & 255u) == 0u) { if (xb_ld(&(bar)[XB_TMO])) break; if (_sp > XB_SPIN_CAP) { atomicAdd(&(bar)[XB_TMO], 1u); break; } } } } while (0)
__device__ __forceinline__ void xcd_barrier_post(unsigned* bar, volatile LAS unsigned* st) { if (tid_() == 0) st[2] = xb_add(&bar[XB_XCNT(xb_xcc_id())], 1u); }
__device__ __forceinline__ void xcd_barrier_complete(unsigned* bar, unsigned x, unsigned& nloc, unsigned& nx) {
    const unsigned G = gridDim.x;
    unsigned sum, cnt, mine, sp = 0u;
    for (;;) {
        sum = 0u; cnt = 0u; mine = 0u;
#pragma unroll
        for (unsigned j = 0; j < 16; ++j) { const unsigned c = xb_ld(&bar[XB_XCNT(j)]); sum += c; cnt += (c > 0u) ? 1u : 0u; mine = (j == x) ? c : mine; }
        if (sum == G) break;
        __builtin_amdgcn_s_sleep(1);
        if ((++sp & 255u) == 0u) { if (xb_ld(&bar[XB_TMO])) break; if (sp > XB_SPIN_CAP) { atomicAdd(&bar[XB_TMO], 1u); break; } }
    }
    nloc = mine > 0u ? mine : 1u; nx = cnt > 0u ? cnt : 1u;
}
__device__ __forceinline__ void xcd_barrier(unsigned* bar, volatile LAS unsigned* st) {
    asm volatile("s_waitcnt vmcnt(0)" ::: "memory");
    __syncthreads();
    if (tid_() == 0) {
        const unsigned x = xb_xcc_id();
        __builtin_amdgcn_s_waitcnt(0);
        unsigned nloc = st[0], nx = st[1];
        if (nloc == 0u) { xcd_barrier_complete(bar, x, nloc, nx); st[0] = nloc; st[1] = nx; }
        const unsigned old = xb_add(&bar[XB_XSUB(x)], 1u);
        const unsigned gen = old / nloc;
        if (old + 1u == (gen + 1u) * nloc) {
            __builtin_amdgcn_fence(__ATOMIC_RELEASE, "agent");
            asm volatile("s_waitcnt vmcnt(0)" ::: "memory");
            const unsigned og = xb_add(&bar[XB_TOP], 1u);
            const unsigned tg = og / nx;
            if (og + 1u == (tg + 1u) * nx) xb_add(&bar[XB_TOPGEN], 1u);
            else XB_SPIN(xb_ld(&bar[XB_TOPGEN]) == tg, bar);
            __builtin_amdgcn_fence(__ATOMIC_ACQUIRE, "agent");
            xb_add(&bar[XB_XGEN(x)], 1u);
            asm volatile("s_waitcnt vmcnt(0)" ::: "memory");
        } else {
            XB_SPIN(xb_ld(&bar[XB_XGEN(x)]) == gen, bar);
            __builtin_amdgcn_fence(__ATOMIC_ACQUIRE, "agent");
            asm volatile("s_waitcnt vmcnt(0)" ::: "memory");
        }
    }
    __syncthreads();
}

__device__ __forceinline__ void phase_p8(const DArgs& a, int vcu, int G) {
    const int tid = tid_(), lane = tid & 63, wave = tid >> 6;
    const int gw = vcu * NWAVES + wave, NGW = G * NWAVES;
    GAS unsigned char* ws = a.ws;
    f32x4 g2[4];
#pragma unroll
    for (int j = 0; j < 4; ++j) g2[j] = ((const f32x4*)a.norm2_g)[64 * j + lane];
    for (int m = gw; m < T; m += NGW) {
        const f32x4* xr = (const f32x4*)(a.out + (size_t)m * D) + lane;
        f32x4 v[4]; float s = 0.f;
#pragma unroll
        for (int j = 0; j < 4; ++j) { v[j] = xr[64 * j]; s += (v[j][0] * v[j][0] + v[j][1] * v[j][1]) + (v[j][2] * v[j][2] + v[j][3] * v[j][3]); }
        const float rstd = rsqrtf(wave_sum(s, lane) * (1.f / D) + EPS);
        unsigned long long* o8 = (unsigned long long*)((bf16_t*)(ws + WS_XN) + (size_t)m * D) + lane;
#pragma unroll
        for (int j = 0; j < 4; ++j) { v[j] = v[j] * rstd * g2[j]; o8[64 * j] = (unsigned long long)pk2(v[j][0], v[j][1]) | ((unsigned long long)pk2(v[j][2], v[j][3]) << 32); }
    }
    {
        const float mu = __builtin_bit_cast(float, ((const GAS unsigned*)(ws + WS_CTL))[CW_TMAX]), mv = __builtin_bit_cast(float, ((const GAS unsigned*)(ws + WS_CTL))[CW_TMAX + 1]);
        const float su = mu > 0.f ? 448.0f / mu : 1.0f, sv = mv > 0.f ? 448.0f / mv : 1.0f;
        if (vcu == 0 && tid == 0) { ((GAS float*)(ws + WS_USC))[0] = 1.0f / su; ((GAS float*)(ws + WS_USC))[1] = 1.0f / sv; }
        for (size_t i = (size_t)vcu * NTHR + tid; i < (size_t)16384 * 1024 / 8; i += (size_t)G * NTHR) {
            const f32x4 u0 = ((const GAS f32x4*)a.u_emb)[2 * i], u1 = ((const GAS f32x4*)a.u_emb)[2 * i + 1];
            const f32x4 v0 = ((const GAS f32x4*)a.v_emb)[2 * i], v1 = ((const GAS f32x4*)a.v_emb)[2 * i + 1];
            u32x2 o; int p;
            p = __builtin_amdgcn_cvt_pk_fp8_f32(u0[0] * su, u0[1] * su, 0, false); p = __builtin_amdgcn_cvt_pk_fp8_f32(u0[2] * su, u0[3] * su, p, true); o.x = (unsigned)p;
            p = __builtin_amdgcn_cvt_pk_fp8_f32(u1[0] * su, u1[1] * su, 0, false); p = __builtin_amdgcn_cvt_pk_fp8_f32(u1[2] * su, u1[3] * su, p, true); o.y = (unsigned)p;
            ((GAS u32x2*)(ws + WS_UB))[i] = o;
            p = __builtin_amdgcn_cvt_pk_fp8_f32(v0[0] * sv, v0[1] * sv, 0, false); p = __builtin_amdgcn_cvt_pk_fp8_f32(v0[2] * sv, v0[3] * sv, p, true); o.x = (unsigned)p;
            p = __builtin_amdgcn_cvt_pk_fp8_f32(v1[0] * sv, v1[1] * sv, 0, false); p = __builtin_amdgcn_cvt_pk_fp8_f32(v1[2] * sv, v1[3] * sv, p, true); o.y = (unsigned)p;
            ((GAS u32x2*)(ws + WS_VB))[i] = o;
        }
    }
}

__device__ __forceinline__ unsigned f2ord(float f) { const unsigned u = __builtin_bit_cast(unsigned, f); return (u & 0x80000000u) ? ~u : (u | 0x80000000u); }
__device__ __forceinline__ float ord2f(unsigned k) { const unsigned u = (k & 0x80000000u) ? (k & 0x7fffffffu) : ~k; return __builtin_bit_cast(float, u); }
__device__ __forceinline__ unsigned umax_(unsigned a, unsigned b) { return a > b ? a : b; }
__device__ __forceinline__ unsigned shxu(unsigned v, int o, int lane) { return (unsigned)__builtin_amdgcn_ds_bpermute((lane ^ o) << 2, (int)v); }

__device__ __forceinline__ void phase_topk(const DArgs& a, LAS unsigned char* lds, int bx, int G) {
    const int tid = tid_(), lane = tid & 63, wave = __builtin_amdgcn_readfirstlane(tid >> 6), fr = lane & 15, fq = lane >> 4;
    GAS unsigned char* ws = a.ws;
    const int h = bx & 7;
    LAS unsigned char* KY = lds;
    LAS unsigned char* QL = lds + 2 * 128 * PS_PITCH;
    LAS unsigned* TOP = (LAS unsigned*)(lds + 2 * 128 * PS_PITCH + 64 * PQ_PITCH);
#pragma unroll
    for (int i = 0; i < 8; ++i) { const int idx = tid + 512 * i, row = idx >> 4, ch = idx & 15;
        *(LAS u32x4*)(KY + row * PS_PITCH + ch * 16) = *(const u32x4*)((const bf16_t*)(ws + WS_SK) + ((size_t)h * 256 + row) * 128 + ch * 8); }
    const int ntile = T / 64;
    for (int tile = bx >> 3; tile < ntile; tile += (G >> 3)) {
        const size_t t0 = (size_t)tile * 64;
        __syncthreads();
#pragma unroll
        for (int i = 0; i < 4; ++i) { const int idx = tid + 512 * i, row = idx >> 5, ch = idx & 31;
            *(LAS u32x4*)(QL + row * PQ_PITCH + ch * 16) = *(const u32x4*)((const bf16_t*)(ws + WS_QP) + (t0 + row) * 2048 + h * 256 + ch * 8); }
        __syncthreads();
        {
            const int mt = wave & 3, p = wave >> 2;
            unsigned key[32];
#pragma unroll
            for (int nt = 0; nt < 8; ++nt) { f32x4 acc = (f32x4){0.f, 0.f, 0.f, 0.f};
#pragma unroll
                for (int ks = 0; ks < 4; ++ks) acc = MFMA16(lfrag(KY + p * 128 * PS_PITCH, PS_PITCH, nt * 16 + fr, ks * 32, fq), lfrag(QL, PQ_PITCH, mt * 16 + fr, p * 128 + ks * 32, fq), acc);
#pragma unroll
                for (int j = 0; j < 4; ++j) { const int n = nt * 16 + 4 * fq + j; key[nt * 4 + j] = (f2ord(acc[j]) & ~127u) | (unsigned)(127 - n); } }
#pragma unroll 1
            for (int k = 0; k < 16; ++k) {
                unsigned m = key[0];
#pragma unroll
                for (int e = 1; e < 32; ++e) m = umax_(m, key[e]);
                m = umax_(m, (unsigned)SWZI_(m, 0x401F)); m = umax_(m, xor32u_(m, lane >= 32));
#pragma unroll
                for (int e = 0; e < 32; ++e) key[e] = (key[e] == m) ? 0u : key[e];
                if (fq == (k & 3)) TOP[(p * 64 + mt * 16 + fr) * 16 + k] = m;
            }
        }
        __syncthreads();
        {
            const int t = tid >> 3, sub = tid & 7;
            unsigned ck[7];
#pragma unroll
            for (int e = 0; e < 7; ++e) {
                const int ci = sub + 8 * e;
                int i = 0, base = 0; bool ok = ci < 50;
                if (ci >= 42) { i = 8 + (ci - 42); base = ci; } else if (ci >= 40) { i = 7; base = 40; } else if (ci >= 38) { i = 6; base = 38; } else if (ci >= 36) { i = 5; base = 36; }
                else if (ci >= 33) { i = 4; base = 33; } else if (ci >= 29) { i = 3; base = 29; } else if (ci >= 24) { i = 2; base = 24; } else if (ci >= 16) { i = 1; base = 16; }
                const int j = ci - base;
                unsigned kk = 0u;
                if (ok) { const float s0 = ord2f(TOP[(0 * 64 + t) * 16 + i] & ~127u), s1 = ord2f(TOP[(1 * 64 + t) * 16 + j] & ~127u);
                    kk = (f2ord(s0 + s1) & ~255u) | (unsigned)(255 - (i * 16 + j)); }
                ck[e] = kk;
            }
            unsigned w0 = 0u, w1 = 0u;
#pragma unroll 1
            for (int k = 0; k < 16; ++k) {
                unsigned m = ck[0];
#pragma unroll
                for (int e = 1; e < 7; ++e) m = umax_(m, ck[e]);
                m = umax_(m, (unsigned)DPPI_(m, 0xB1)); m = umax_(m, (unsigned)DPPI_(m, 0x4E)); m = umax_(m, (unsigned)DPPI_(m, 0x141));
#pragma unroll
                for (int e = 0; e < 7; ++e) ck[e] = (ck[e] == m) ? 0u : ck[e];
                if (k == sub) w0 = m; if (k == sub + 8) w1 = m;
            }
            const int f0 = 255 - (int)(w0 & 255u), f1 = 255 - (int)(w1 & 255u);
            const float sc0 = ord2f(w0 & ~255u), sc1 = ord2f(w1 & ~255u);
            float mx = fmaxf(sc0, sc1); mx = fmaxf(mx, DPP_(mx, 0xB1)); mx = fmaxf(mx, DPP_(mx, 0x4E)); mx = fmaxf(mx, DPP_(mx, 0x141));
            const float e0 = __expf(sc0 - mx), e1 = __expf(sc1 - mx);
            float sm = e0 + e1; sm += DPP_(sm, 0xB1); sm += DPP_(sm, 0x4E); sm += DPP_(sm, 0x141);
            const float inv = 1.0f / sm;
            const int i0 = 127 - (int)(TOP[(0 * 64 + t) * 16 + (f0 >> 4)] & 127u), j0 = 127 - (int)(TOP[(1 * 64 + t) * 16 + (f0 & 15)] & 127u);
            const int i1 = 127 - (int)(TOP[(0 * 64 + t) * 16 + (f1 >> 4)] & 127u), j1 = 127 - (int)(TOP[(1 * 64 + t) * 16 + (f1 & 15)] & 127u);
            int* ei = (int*)(ws + WS_EIDX) + ((t0 + t) * 8 + h) * 16; float* gp = (float*)(ws + WS_GATE) + ((t0 + t) * 8 + h) * 16;
            ei[sub] = i0 * 128 + j0; ei[sub + 8] = i1 * 128 + j1; gp[sub] = e0 * inv; gp[sub + 8] = e1 * inv;
        }
    }
    __syncthreads();
}

__device__ __forceinline__ void ins16(float (&v)[16], int (&id)[16], float x, int n) {
    if (x > v[15]) { v[15] = x; id[15] = n;
#pragma unroll
        for (int i = 15; i >= 1; --i) { if (v[i] > v[i - 1]) { const float tv = v[i]; v[i] = v[i - 1]; v[i - 1] = tv; const int ti = id[i]; id[i] = id[i - 1]; id[i - 1] = ti; } } }
}
__device__ __forceinline__ void phase_topk_ref(const DArgs& a, int vcu, int G) {
    const int tid = tid_();
    GAS unsigned char* ws = a.ws;
    const int gt = vcu * NTHR + tid, NGT = G * NTHR;
    for (int pair = gt; pair < T * 8; pair += NGT) {
        const int t = pair >> 3, h = pair & 7;
        float sv[2][16]; int si[2][16];
#pragma unroll
        for (int p = 0; p < 2; ++p) {
#pragma unroll
            for (int i = 0; i < 16; ++i) { sv[p][i] = -INFINITY; si[p][i] = 0; }
            const bf16_t* qp = (const bf16_t*)(ws + WS_QP) + (size_t)t * 2048 + h * 256 + p * 128;
            for (int n = 0; n < 128; ++n) {
                const bf16_t* kp = (const bf16_t*)(ws + WS_SK) + ((size_t)(h * 2 + p) * 128 + n) * 128;
                float s = 0.f;
                for (int c = 0; c < 128; c += 8) { const u32x4 qv = *(const u32x4*)(qp + c), kv = *(const u32x4*)(kp + c);
                    s += bf_lo(qv.x) * bf_lo(kv.x) + bf_hi(qv.x) * bf_hi(kv.x) + bf_lo(qv.y) * bf_lo(kv.y) + bf_hi(qv.y) * bf_hi(kv.y)
                       + bf_lo(qv.z) * bf_lo(kv.z) + bf_hi(qv.z) * bf_hi(kv.z) + bf_lo(qv.w) * bf_lo(kv.w) + bf_hi(qv.w) * bf_hi(kv.w); }
                ins16(sv[p], si[p], s, n);
            }
        }
        float tv[16]; int ti[16];
#pragma unroll
        for (int i = 0; i < 16; ++i) { tv[i] = -INFINITY; ti[i] = 0; }
#pragma unroll
        for (int i = 0; i < 16; ++i)
#pragma unroll
            for (int j = 0; j < 16; ++j) ins16(tv, ti, sv[0][i] + sv[1][j], i * 16 + j);
        float sm = 0.f, ex[16];
#pragma unroll
        for (int k = 0; k < 16; ++k) { ex[k] = __expf(tv[k] - tv[0]); sm += ex[k]; }
        int* ei = (int*)(ws + WS_EIDX) + (size_t)pair * 16; float* gp = (float*)(ws + WS_GATE) + (size_t)pair * 16;
#pragma unroll
        for (int k = 0; k < 16; ++k) {
            int e0 = 0, e1 = 0;
#pragma unroll
            for (int i = 0; i < 16; ++i) { e0 = ((ti[k] >> 4) == i) ? si[0][i] : e0; e1 = ((ti[k] & 15) == i) ? si[1][i] : e1; }
            ei[k] = e0 * 128 + e1; gp[k] = ex[k] / sm; }
    }
}

#define FP8LO(w) __builtin_amdgcn_cvt_pk_f32_fp8((int)(w), false)
#define FP8HI(w) __builtin_amdgcn_cvt_pk_f32_fp8((int)(w), true)
__device__ __forceinline__ float dot16_fp8(const u32x4 r, const float (&x)[16]) {
    float c = 0.f;
#pragma unroll
    for (int j = 0; j < 4; ++j) { const f32x2 lo = FP8LO(r[j]), hi = FP8HI(r[j]); c += lo[0] * x[4 * j] + lo[1] * x[4 * j + 1] + hi[0] * x[4 * j + 2] + hi[1] * x[4 * j + 3]; }
    return c;
}
__device__ __forceinline__ float gelu_erf(float d) {
    const float ad = fabsf(d), t = __builtin_amdgcn_rcpf(ad * 0.2316418882f + 1.0f);
    float q = t * 0.5307027145f + (-0.7265760135f); q = q * t + 0.7107068705f; q = q * t + (-0.142248368f); q = q * t + 0.127414796f; q = q * t;
    const float m = d * (q * __builtin_amdgcn_exp2f(d * d * (-0.72134752044f)));
    return d < 0.f ? m : d - m;
}
__device__ __forceinline__ float bperm(float v, int srclane) { return __builtin_bit_cast(float, __builtin_amdgcn_ds_bpermute(srclane << 2, __builtin_bit_cast(int, v))); }
#define SWZ_(v, pat) __builtin_bit_cast(float, __builtin_amdgcn_ds_swizzle(__builtin_bit_cast(int, (v)), (pat)))
__device__ __forceinline__ float xor32_(float v, bool hi) {
#if defined(__HIP_DEVICE_COMPILE__)
    const auto r = __builtin_amdgcn_permlane32_swap(__builtin_bit_cast(unsigned, v), __builtin_bit_cast(unsigned, v), false, false);
    return __builtin_bit_cast(float, hi ? r[0] : r[1]);
#else
    (void)hi; return v;
#endif
}
__device__ __forceinline__ float reduce8(const float (&p)[8], int lane) {
    float q4[4], q2[2];
    const bool b5 = lane & 32, b4 = lane & 16, b3 = lane & 8;
#pragma unroll
    for (int i = 0; i < 4; ++i) { const float send = b5 ? p[i] : p[i + 4], keep = b5 ? p[i + 4] : p[i]; q4[i] = keep + xor32_(send, b5); }
#pragma unroll
    for (int i = 0; i < 2; ++i) { const float send = b4 ? q4[i] : q4[i + 2], keep = b4 ? q4[i + 2] : q4[i]; q2[i] = keep + SWZ_(send, 0x401F); }
    const float send = b3 ? q2[0] : q2[1], keep = b3 ? q2[1] : q2[0];
    float q1 = keep + SWZ_(send, 0x201F);
    q1 += DPP_(q1, 0xB1); q1 += DPP_(q1, 0x4E); q1 += DPP_(q1, 0x141);
    return q1;
}
__device__ __forceinline__ void phase_udots(const DArgs& a, LAS unsigned char* lds) {
    const int tid = tid_(), lane = tid & 63, wave = __builtin_amdgcn_readfirstlane(tid >> 6);
    GAS unsigned char* ws = a.ws;
    volatile LAS unsigned* bst = (volatile LAS unsigned*)(lds + LDS_BARST);
    const int nloc = (int)bst[0], nx = (int)bst[1], rank = (int)bst[2];
    unsigned* bar = (unsigned*)(ws + WS_CTL) + CW_BAR;
    const unsigned myx = xb_xcc_id();
    int q = 0;
    for (unsigned j = 0; j < 16; ++j) { const unsigned c = xb_ld(&bar[XB_XCNT(j)]); if (c > 0u && j < myx) ++q; }
    LAS int* LE = (LAS int*)(lds + wave * 2048);
    LAS int* LP = LE + 128; LAS float* LG = (LAS float*)(LE + 256);
    const GAS unsigned char* UB = ws + WS_UB;
    const int g8 = lane >> 3;
    const float usc = ((const GAS float*)(ws + WS_USC))[0], vsc = ((const GAS float*)(ws + WS_USC))[1];
    for (int s = q; s < 8; s += nx) {
        int tok = rank * 8 + wave;
        u32x4 xq0 = (u32x4){0u, 0u, 0u, 0u}, xq1 = xq0; u32x2 e2 = (u32x2){0u, 0u}; f32x2 g2 = (f32x2){0.f, 0.f};
#define U_INFO(t_) do { xq0 = *(const u32x4*)((const GAS bf16_t*)(ws + WS_XN) + (size_t)(t_) * D + lane * 16); xq1 = *(const u32x4*)((const GAS bf16_t*)(ws + WS_XN) + (size_t)(t_) * D + lane * 16 + 8); \
        e2 = *(const u32x2*)((const GAS int*)(ws + WS_EIDX) + (size_t)(t_) * 128 + 2 * lane); g2 = *(const f32x2*)((const GAS float*)(ws + WS_GATE) + (size_t)(t_) * 128 + 2 * lane); } while (0)
        if (tok < T) U_INFO(tok);
        for (; tok < T; tok += nloc * 8) {
            const bool in0 = (int)(e2.x >> 11) == s, in1 = (int)(e2.y >> 11) == s;
            const unsigned long long m0 = __ballot(in0), m1 = __ballot(in1);
            const unsigned long long lt = (1ull << lane) - 1ull;
            const int n0 = __popcll(m0), n = n0 + __popcll(m1);
            if (in0) { const int pos = __popcll(m0 & lt); LE[pos] = (int)e2.x; LP[pos] = 2 * lane; LG[pos] = g2[0]; }
            if (in1) { const int pos = n0 + __popcll(m1 & lt); LE[pos] = (int)e2.y; LP[pos] = 2 * lane + 1; LG[pos] = g2[1]; }
            const float xf[16] = {bf_lo(xq0.x), bf_hi(xq0.x), bf_lo(xq0.y), bf_hi(xq0.y), bf_lo(xq0.z), bf_hi(xq0.z), bf_lo(xq0.w), bf_hi(xq0.w),
                                  bf_lo(xq1.x), bf_hi(xq1.x), bf_lo(xq1.y), bf_hi(xq1.y), bf_lo(xq1.z), bf_hi(xq1.z), bf_lo(xq1.w), bf_hi(xq1.w)};
            asm volatile("s_waitcnt lgkmcnt(0)" ::: "memory");
            u32x4 R0[8], R1[8], R2[8];
#define U_ISSUE(R_, g0_) do { _Pragma("unroll") for (int k = 0; k < 8; ++k) { const int slot_ = ((g0_) + k < n) ? (g0_) + k : n - 1; const int e_ = LE[slot_]; R_[k] = *(const u32x4*)(UB + (size_t)e_ * 1024 + lane * 16); } } while (0)
#define U_DOTS(R_, g0_) do { float pp_[8]; _Pragma("unroll") for (int k = 0; k < 8; ++k) pp_[k] = dot16_fp8(R_[k], xf); const float dsum_ = reduce8(pp_, lane); const int slot_ = (g0_) + g8; \
            if (slot_ < n && (lane & 7) == 0) { const float d_ = dsum_ * usc; \
                ((GAS float*)(ws + WS_PW))[(size_t)tok * 128 + LP[slot_]] = 0.5f * d_ * (1.0f + erff(d_ * 0.70710678118654752f)) * LG[slot_] * vsc; } } while (0)
            if (n > 0) U_ISSUE(R0, 0);
            if (n > 8) U_ISSUE(R1, 8);
            if (n > 16) U_ISSUE(R2, 16);
            const int tokN = tok + nloc * 8;
            if (tokN < T) U_INFO(tokN);
            if (n > 0) U_DOTS(R0, 0);
            if (n > 8) U_DOTS(R1, 8);
            if (n > 16) U_DOTS(R2, 16);
            for (int g0 = 24; g0 < n; g0 += 8) { U_ISSUE(R0, g0); U_DOTS(R0, g0); }
            asm volatile("s_waitcnt lgkmcnt(0)" ::: "memory");
        }
#undef U_INFO
#undef U_ISSUE
#undef U_DOTS
    }
}

__device__ __forceinline__ void phase_gather(const DArgs& a, LAS unsigned char* lds, int vcu, int G) {
    (void)lds;
    const int tid = tid_(), lane = tid & 63, wave = __builtin_amdgcn_readfirstlane(tid >> 6);
    GAS unsigned char* ws = a.ws;
    const GAS unsigned char* UB = ws + WS_UB; const GAS unsigned char* VB = ws + WS_VB;
    const int gw = vcu * NWAVES + wave, NGW = G * NWAVES;
    const unsigned lane16 = (unsigned)lane * 16u;
    const float usc = ((const GAS float*)(ws + WS_USC))[0], vsc = ((const GAS float*)(ws + WS_USC))[1];
#define G_INFO(tok_, e2_, g2_, x0_, x1_) do { e2_ = (u32x2){0u, 0u}; g2_ = (f32x2){0.f, 0.f}; x0_ = (u32x4){0u, 0u, 0u, 0u}; x1_ = x0_; if ((tok_) < T) { \
        e2_ = *(const GAS u32x2*)((const GAS int*)(ws + WS_EIDX) + (size_t)(tok_) * 128 + 2 * lane); g2_ = *(const GAS f32x2*)((const GAS float*)(ws + WS_GATE) + (size_t)(tok_) * 128 + 2 * lane); \
        x0_ = *(const GAS u32x4*)((const GAS bf16_t*)(ws + WS_XN) + (size_t)(tok_) * D + lane16); x1_ = *(const GAS u32x4*)((const GAS bf16_t*)(ws + WS_XN) + (size_t)(tok_) * D + lane16 + 8); } } while (0)
#define G_ISSUE(R_, e2_, gg_) do { const GAS unsigned char* tb_ = ((gg_) < 16) ? UB : VB; const int p_ = (gg_) & 15; \
        _Pragma("unroll") for (int k_ = 0; k_ < 8; ++k_) { const int e_ = __builtin_amdgcn_readlane((k_ & 1) ? (int)e2_.y : (int)e2_.x, 4 * p_ + (k_ >> 1)); R_[k_] = *(const GAS u32x4*)(tb_ + ((unsigned)e_ * 1024u + lane16)); } } while (0)
    int tok = gw;
    u32x2 e2, e2N; f32x2 g2, g2N; u32x4 xq0, xq1, xq0N, xq1N;
    u32x4 S0[8], S1[8], S2[8];
    G_INFO(tok, e2, g2, xq0, xq1); G_INFO(tok + NGW, e2N, g2N, xq0N, xq1N);
    if (tok < T) { G_ISSUE(S0, e2, 0); G_ISSUE(S1, e2, 1); G_ISSUE(S2, e2, 2); }
    float xf[16];
#define G_UNPACK() do { xf[0] = bf_lo(xq0.x); xf[1] = bf_hi(xq0.x); xf[2] = bf_lo(xq0.y); xf[3] = bf_hi(xq0.y); xf[4] = bf_lo(xq0.z); xf[5] = bf_hi(xq0.z); xf[6] = bf_lo(xq0.w); xf[7] = bf_hi(xq0.w); \
        xf[8] = bf_lo(xq1.x); xf[9] = bf_hi(xq1.x); xf[10] = bf_lo(xq1.y); xf[11] = bf_hi(xq1.y); xf[12] = bf_lo(xq1.z); xf[13] = bf_hi(xq1.z); xf[14] = bf_lo(xq1.w); xf[15] = bf_hi(xq1.w); } while (0)
    G_UNPACK();
    f32x2 w2 = (f32x2){0.f, 0.f};
    f32x2 acc2[8];
#pragma unroll
    for (int e = 0; e < 8; ++e) acc2[e] = (f32x2){0.f, 0.f};
    int g = 0;
#define G_STEP(S_) do { \
        if (g < 16) {     \
            float pp_[8]; _Pragma("unroll") for (int k_ = 0; k_ < 8; ++k_) pp_[k_] = dot16_fp8(S_[k_], xf); \
            const float ds_ = reduce8(pp_, lane); const int j_ = lane - 4 * g; const bool mine_ = (j_ >= 0) && (j_ < 4); const int src_ = mine_ ? 16 * j_ : 0; \
            const float d0_ = bperm(ds_, src_) * usc, d1_ = bperm(ds_, src_ + 8) * usc; \
            if (mine_) { w2[0] = gelu_erf(d0_) * g2[0] * vsc; w2[1] = gelu_erf(d1_) * g2[1] * vsc; } \
        } else { \
            const int p_ = g - 16; \
            _Pragma("unroll") for (int k_ = 0; k_ < 8; ++k_) { const float wk_ = rdlane((k_ & 1) ? w2[1] : w2[0], 4 * p_ + (k_ >> 1)); const f32x2 wp_ = (f32x2){wk_, wk_}; \
                _Pragma("unroll") for (int jj_ = 0; jj_ < 4; ++jj_) { acc2[2 * jj_] += wp_ * FP8LO(S_[k_][jj_]); acc2[2 * jj_ + 1] += wp_ * FP8HI(S_[k_][jj_]); } } \
        } \
        { const int gi_ = g + 3; if (gi_ < 32) G_ISSUE(S_, e2, gi_); else if (tok + NGW < T) G_ISSUE(S_, e2N, gi_ - 32); } \
        if (++g == 32) { \
            f32x4 xr_[4]; \
            _Pragma("unroll") for (int j_ = 0; j_ < 4; ++j_) xr_[j_] = *(const GAS f32x4*)(a.out + (size_t)tok * D + lane16 + 4 * j_); \
            float ss_ = 0.f; \
            _Pragma("unroll") for (int j_ = 0; j_ < 4; ++j_) { xr_[j_][0] += acc2[2 * j_][0]; xr_[j_][1] += acc2[2 * j_][1]; xr_[j_][2] += acc2[2 * j_ + 1][0]; xr_[j_][3] += acc2[2 * j_ + 1][1]; \
                ss_ += (xr_[j_][0] * xr_[j_][0] + xr_[j_][1] * xr_[j_][1]) + (xr_[j_][2] * xr_[j_][2] + xr_[j_][3] * xr_[j_][3]); } \
            const float rstd_ = rsqrtf(wave_sum(ss_, lane) * (1.f / D) + EPS); \
            _Pragma("unroll") for (int j_ = 0; j_ < 4; ++j_) { const f32x4 gf_ = *(const GAS f32x4*)(a.final_g + lane16 + 4 * j_); *(GAS f32x4*)(a.out + (size_t)tok * D + lane16 + 4 * j_) = xr_[j_] * rstd_ * gf_; } \
            _Pragma("unroll") for (int e_ = 0; e_ < 8; ++e_) acc2[e_] = (f32x2){0.f, 0.f}; \
            g = 0; tok += NGW; e2 = e2N; g2 = g2N; xq0 = xq0N; xq1 = xq1N; G_UNPACK(); G_INFO(tok + NGW, e2N, g2N, xq0N, xq1N); } } while (0)
    while (tok < T) {
        G_STEP(S0); if (tok >= T) break;
        G_STEP(S1); if (tok >= T) break;
        G_STEP(S2);
    }
#undef G_STEP
#undef G_INFO
#undef G_ISSUE
#undef G_UNPACK
}

__device__ __forceinline__ void phase_final_plain(const DArgs& a, const float* src, int vcu, int G) {
    const int tid = tid_(), lane = tid & 63, wave = tid >> 6;
    const int gw = vcu * NWAVES + wave, NGW = G * NWAVES;
    f32x4 gf[4];
#pragma unroll
    for (int j = 0; j < 4; ++j) gf[j] = ((const f32x4*)a.final_g)[64 * j + lane];
    for (int m = gw; m < T; m += NGW) {
        const f32x4* xr = (const f32x4*)(src + (size_t)m * D) + lane;
        f32x4 v[4]; float s = 0.f;
#pragma unroll
        for (int j = 0; j < 4; ++j) { v[j] = xr[64 * j]; s += (v[j][0] * v[j][0] + v[j][1] * v[j][1]) + (v[j][2] * v[j][2] + v[j][3] * v[j][3]); }
        const float rstd = rsqrtf(wave_sum(s, lane) * (1.f / D) + EPS);
        f32x4* o = (f32x4*)(a.out + (size_t)m * D) + lane;
#pragma unroll
        for (int j = 0; j < 4; ++j) o[64 * j] = v[j] * rstd * gf[j];
    }
}


__device__ __forceinline__ DArgs load_args() {
    DArgs r;
#if defined(__HIP_DEVICE_COMPILE__)
    typedef const DArgs __attribute__((address_space(4))) KArgs;
    KArgs* p = (KArgs*)__builtin_amdgcn_kernarg_segment_ptr();
    asm volatile("" : "+s"(p));
    r.x = p->x; r.norm1_g = p->norm1_g; r.w_in = p->w_in; r.b_in = p->b_in; r.conv_w = p->conv_w; r.conv_b = p->conv_b; r.m_head_g = p->m_head_g; r.lb_table = p->lb_table;
    r.g_head_g = p->g_head_g; r.w_br_m = p->w_br_m; r.w_br_g = p->w_br_g; r.w_out = p->w_out; r.norm2_g = p->norm2_g; r.w_pq = p->w_pq; r.sub_keys = p->sub_keys;
    r.u_emb = p->u_emb; r.v_emb = p->v_emb; r.final_g = p->final_g; r.out = p->out; r.ws = p->ws;
#else
    r = DArgs{};
#endif
    return r;
}
__device__ __forceinline__ EpiPtrs make_ep(const DArgs& a, int round) {
    EpiPtrs ep; ep.biasp = (const GAS float*)(a.ws + WS_BIASP); ep.lb = (const GAS float*)(a.ws + WS_LB); ep.x = a.x; ep.out = a.out; ep.ws = a.ws; ep.round = round; return ep;
}
#define GRID_SYNC() do { const DArgs a_ = load_args(); xcd_barrier((unsigned*)(a_.ws + WS_CTL) + CW_BAR, (volatile LAS unsigned*)(lds + LDS_BARST)); } while (0)

__device__ __forceinline__ int bx_() { int t = blockIdx.x; asm volatile("" : "+s"(t)); return t; }
__device__ __forceinline__ int gd_() { int t = gridDim.x; asm volatile("" : "+s"(t)); return t; }
#define PH_BEGIN const DArgs a = load_args(); const int bx = bx_(), G = gd_(); const int vcu = (G % 8 == 0) ? (bx % 8) * (G / 8) + bx / 8 : bx; (void)vcu; (void)bx;

__global__ void __launch_bounds__(NTHR, 2) fwd_megakernel(Args a_unused) {
    extern __shared__ __attribute__((aligned(16))) unsigned char lds_raw[];
    LAS unsigned char* lds = (LAS unsigned char*)lds_raw;
    cg::grid_group grid = cg::this_grid();

    { const int t_ = tid_(); if (t_ < 16) ((LAS unsigned*)(lds + LDS_BARST))[t_] = 0u; __syncthreads();
      const DArgs a_ = load_args(); xcd_barrier_post((unsigned*)(a_.ws + WS_CTL) + CW_BAR, (volatile LAS unsigned*)(lds + LDS_BARST)); }
    { PH_BEGIN phase_p0(a, lds, vcu, G); }
    grid.sync();
#pragma unroll 1
    for (int round = 0; round < NROUND; ++round) {
        {
            PH_BEGIN
            pg8::Gemm g{(const bf16_t*)(a.ws + WS_XN) + (size_t)round * RT * D, (const bf16_t*)(a.ws + WS_WIN), RT, N1, D};
            pg8::StaticOrder S; S.init(RT, N1, G, bx);
            EpiX<1> E{make_ep(a, round)};
            pg8::gemm_phase<EpiX<1>, pg8::StaticOrder, true, true>(lds, g, S, E);
        }
        { PH_BEGIN const int t0_ = tid_(); if (bx < 8 && t0_ < 64) mscan_pair(a, round, bx, t0_); }
        GRID_SYNC();
        { PH_BEGIN for (int it = bx; it < 512; it += G) mlstm_pre_item(a, lds, round, it); }
        { PH_BEGIN for (int it = bx; it < 2048; it += G) hgrn_pre_item(a, lds, round, it); }
        GRID_SYNC();
        { PH_BEGIN
          if (bx < 128) mlstm_scan(a, lds, round, bx & 7, bx >> 3);
          else if (bx < 192) { const int id2 = bx - 128; hgrn_scan(a, lds, round, (id2 & 7) * 2 + ((id2 >> 3) & 1), id2 >> 4); } }
        GRID_SYNC();
        {
            PH_BEGIN
            pg8::Gemm g{(const bf16_t*)(a.ws + WS_XN) + (size_t)round * RT * D, (const bf16_t*)(a.ws + WS_WIN) + (size_t)N1 * D, RT, N2, D};
            pg8::StaticOrder S; S.init(RT, N2, G, bx);
            EpiX<2> E{make_ep(a, round)};
            pg8::gemm_phase<EpiX<2>, pg8::StaticOrder, true, true>(lds, g, S, E);
        }
        GRID_SYNC();
        { PH_BEGIN phase_ypass(a, round, vcu, G); }
        GRID_SYNC();
        {
            { PH_BEGIN pg8::StaticOrder S; S.init(RT, D, G, bx);
              pg8::Gemm g{(const bf16_t*)(a.ws + WS_V), (const bf16_t*)(a.ws + WS_WM), RT, D, 2048}; EpiX<3> E{make_ep(a, round)}; pg8::gemm_phase<EpiX<3>, pg8::StaticOrder, true, true>(lds, g, S, E); }
            { PH_BEGIN pg8::StaticOrder S; S.init(RT, D, G, bx);
              pg8::Gemm g{(const bf16_t*)(a.ws + WS_GI), (const bf16_t*)(a.ws + WS_WG), RT, D, D}; EpiX<4> E{make_ep(a, round)}; pg8::gemm_phase<EpiX<4>, pg8::StaticOrder, true, true>(lds, g, S, E); }
        }
        GRID_SYNC();
        {
            PH_BEGIN pg8::StaticOrder S; S.init(RT, D, G, bx);
            pg8::Gemm g{(const bf16_t*)(a.ws + WS_GFLOG), (const bf16_t*)(a.ws + WS_WO), RT, D, D}; EpiX<5> E{make_ep(a, round)}; pg8::gemm_phase<EpiX<5>, pg8::StaticOrder, true, true>(lds, g, S, E);
        }
        GRID_SYNC();
    }
    { PH_BEGIN phase_p8(a, vcu, G); }
    GRID_SYNC();
    {
        PH_BEGIN pg8::StaticOrder S; S.init(T, 2048, G, bx);
        pg8::Gemm g{(const bf16_t*)(a.ws + WS_XN), (const bf16_t*)(a.ws + WS_WPQ), T, 2048, D}; EpiX<6> E{make_ep(a, 0)}; pg8::gemm_phase<EpiX<6>, pg8::StaticOrder, true, true>(lds, g, S, E);
    }
    GRID_SYNC();
#ifdef TOPK_REF
    { PH_BEGIN phase_topk_ref(a, vcu, G); }
#else
    { PH_BEGIN phase_topk(a, lds, bx, G); }
#endif
    GRID_SYNC();
    { PH_BEGIN phase_gather(a, lds, vcu, G); }
}

extern "C" void kernel_launch(void* const* d_in, const int* in_sizes, int n_in, void* d_out, int out_size, void* d_ws, size_t ws_size, hipStream_t stream) {
    static int grid = 0;
    if (grid == 0) {
        if (n_in != 18 || in_sizes[0] != T * D || out_size != T * D || ws_size < WS_END) {
            fprintf(stderr, "kernel_launch: unexpected shapes/workspace (n_in %d, in0 %d, out %d, ws %zu, need %zu)\n", n_in, n_in > 0 ? in_sizes[0] : -1, out_size, ws_size, (size_t)WS_END);
            grid = -1; return; }
        int dev = 0, cus = 0, per_cu = 0;
        hipGetDevice(&dev);
        hipDeviceGetAttribute(&cus, hipDeviceAttributeMultiprocessorCount, dev);
        hipFuncSetAttribute((const void*)fwd_megakernel, hipFuncAttributeMaxDynamicSharedMemorySize, LDS_BYTES);
        hipOccupancyMaxActiveBlocksPerMultiprocessor(&per_cu, (const void*)fwd_megakernel, NTHR, LDS_BYTES);
        if (per_cu < 1) { fprintf(stderr, "kernel_launch: occupancy query says %d blocks/CU\n", per_cu); per_cu = 1; }
        grid = cus;
        (void)hipGetLastError();
    }
    if (grid < 0) return;
    hipMemsetAsync((char*)d_ws + WS_CTL, 0, 1 * MiB, stream);
    Args a{};
    a.x = (const float*)d_in[0]; a.norm1_g = (const float*)d_in[1]; a.w_in = (const float*)d_in[2]; a.b_in = (const float*)d_in[3];
    a.conv_w = (const float*)d_in[4]; a.conv_b = (const float*)d_in[5]; a.m_head_g = (const float*)d_in[6]; a.lb_table = (const float*)d_in[7];
    a.g_head_g = (const float*)d_in[8]; a.w_br_m = (const float*)d_in[9]; a.w_br_g = (const float*)d_in[10]; a.w_out = (const float*)d_in[11];
    a.norm2_g = (const float*)d_in[12]; a.w_pq = (const float*)d_in[13]; a.sub_keys = (const float*)d_in[14]; a.u_emb = (const float*)d_in[15];
    a.v_emb = (const float*)d_in[16]; a.final_g = (const float*)d_in[17];
    a.out = (float*)d_out; a.ws = (unsigned char*)d_ws;
    void* args[] = {&a};
    hipError_t e = hipLaunchCooperativeKernel((const void*)fwd_megakernel, dim3(grid), dim3(NTHR), args, LDS_BYTES, stream);
    if (e != hipSuccess) fprintf(stderr, "cooperative launch failed: %s (grid %d)\n", hipGetErrorString(e), grid);
}
```

```cpp
#include <hip/hip_runtime.h>
#include <hip/hip_cooperative_groups.h>
#include <cstdio>
#include <cstdint>
namespace cg = cooperative_groups;

#define LAS __attribute__((address_space(3)))
typedef unsigned short bf16_t;
typedef short bf16x8 __attribute__((ext_vector_type(8)));
typedef float f32x4 __attribute__((ext_vector_type(4)));
typedef float f32x2 __attribute__((ext_vector_type(2)));
typedef unsigned u32x4 __attribute__((ext_vector_type(4)));
typedef unsigned u32x2 __attribute__((ext_vector_type(2)));

constexpr int D = 1024, BATCH = 4, SEQ = 8192, T = BATCH * SEQ;
constexpr int IN_COLS = 12296, NP = 12288;
constexpr int RT = 16384, NROUND = 2;
constexpr int N1 = 7168, N2 = 5120;
constexpr float EPS = 1e-6f;
constexpr int NWAVES = 8, NTHR = 512;

constexpr size_t MiB = 1u << 20;
constexpr size_t WS_CTL = 0;
constexpr size_t WS_WIN = 1 * MiB;
constexpr size_t WS_WM = 25 * MiB;
constexpr size_t WS_WG = 29 * MiB;
constexpr size_t WS_WO = 31 * MiB;
constexpr size_t WS_WPQ = 33 * MiB;
constexpr size_t WS_SK = 37 * MiB;
constexpr size_t WS_BIASP = 37 * MiB + 512 * 1024;
constexpr size_t WS_LB = WS_BIASP + 64 * 1024;
constexpr size_t WS_GATES = 38 * MiB;
constexpr size_t WS_MPREV = 39 * MiB;
constexpr size_t WS_DEN = 40 * MiB;
constexpr size_t WS_MT = 40 * MiB + 512 * 1024;
constexpr size_t WS_HGDEC = 41 * MiB;
constexpr size_t WS_MDEC = 43 * MiB;
constexpr size_t WS_XN = 44 * MiB;
constexpr size_t WS_QKPRE = 108 * MiB;
constexpr size_t WS_V = 172 * MiB;
constexpr size_t WS_GFLOG = 236 * MiB;
constexpr size_t WS_GI = 268 * MiB;
constexpr size_t WS_GQ = 300 * MiB;
constexpr size_t WS_S = 332 * MiB;
constexpr size_t WS_QT = 348 * MiB;
constexpr size_t WS_KWT = 380 * MiB;
constexpr size_t WS_ATT = 412 * MiB;
constexpr size_t WS_QTG = 428 * MiB;
constexpr size_t WS_KENDT = 460 * MiB;
constexpr size_t WS_SIGO = 332 * MiB;
constexpr size_t WS_SGG = 396 * MiB;
constexpr size_t WS_SAM = 428 * MiB;
constexpr size_t WS_SAG = 460 * MiB;
constexpr size_t WS_END = 492 * MiB;
constexpr size_t WS_QP = 108 * MiB;
constexpr size_t WS_UB = 236 * MiB;
constexpr size_t WS_VB = 252 * MiB;
constexpr size_t WS_USC = 268 * MiB;
constexpr size_t WS_VSC = 268 * MiB + 65536;
constexpr size_t WS_EIDX = 300 * MiB;
constexpr size_t WS_GATE = 316 * MiB;
constexpr size_t WS_X8 = 348 * MiB;
constexpr size_t WS_PARTU = 108 * MiB;
constexpr size_t WS_SS = 348 * MiB;
constexpr size_t WS_PW = 332 * MiB;

constexpr int CW_TMAX = 64;
constexpr int LDS_BYTES = 147456;

__device__ __forceinline__ unsigned f2bf(float f) { unsigned u = __builtin_bit_cast(unsigned, f); return (u + 0x7fffu + ((u >> 16) & 1u)) >> 16; }
typedef __bf16 bf16x2_t __attribute__((ext_vector_type(2)));
__device__ __forceinline__ unsigned pk2(float lo, float hi) { bf16x2_t v; v[0] = (__bf16)lo; v[1] = (__bf16)hi; return __builtin_bit_cast(unsigned, v); }
__device__ __forceinline__ float bf_lo(unsigned w) { return __builtin_bit_cast(float, w << 16); }
__device__ __forceinline__ float bf_hi(unsigned w) { return __builtin_bit_cast(float, w & 0xffff0000u); }
__device__ __forceinline__ float bf2f(bf16_t h) { return __builtin_bit_cast(float, ((unsigned)h) << 16); }
__device__ __forceinline__ float shx(float v, int o, int lane) { return __builtin_bit_cast(float, __builtin_amdgcn_ds_bpermute((lane ^ o) << 2, __builtin_bit_cast(int, v))); }
__device__ __forceinline__ float shup(float v, int o, int lane) { return __builtin_bit_cast(float, __builtin_amdgcn_ds_bpermute(((lane - o) & 63) << 2, __builtin_bit_cast(int, v))); }
__device__ __forceinline__ float rdlane(float v, int l) { return __builtin_bit_cast(float, __builtin_amdgcn_readlane(__builtin_bit_cast(int, v), l)); }
#define DPP_(v, ctrl) __builtin_bit_cast(float, __builtin_amdgcn_update_dpp(0, __builtin_bit_cast(int, (v)), (ctrl), 0xF, 0xF, false))
__device__ __forceinline__ float wave_sum(float v, int lane) {
    (void)lane;
    v += DPP_(v, 0xB1); v += DPP_(v, 0x4E); v += DPP_(v, 0x141); v += DPP_(v, 0x140);
    return (rdlane(v, 0) + rdlane(v, 16)) + (rdlane(v, 32) + rdlane(v, 48));
}
#define SWZI_(v, pat) __builtin_amdgcn_ds_swizzle((int)(v), (pat))
#define DPPI_(v, ctrl) __builtin_amdgcn_update_dpp(0, (int)(v), (ctrl), 0xF, 0xF, false)
__device__ __forceinline__ unsigned xor32u_(unsigned v, bool hi) {
#if defined(__HIP_DEVICE_COMPILE__)
    const auto r = __builtin_amdgcn_permlane32_swap(v, v, false, false);
    return hi ? r[0] : r[1];
#else
    (void)hi; return v;
#endif
}
__device__ __forceinline__ float sigmoidf_(float x) { return __builtin_amdgcn_rcpf(1.0f + __expf(-x)); }
__device__ __forceinline__ float siluf_(float x) { return x * __builtin_amdgcn_rcpf(1.0f + __expf(-x)); }
#define LDS_WAIT() asm volatile("s_waitcnt lgkmcnt(0)" ::: "memory")
__device__ __forceinline__ int tid_() { int t = threadIdx.x; asm volatile("" : "+v"(t)); return t; }

#define GAS __attribute__((address_space(1)))
struct DArgs {
    const GAS float* x; const GAS float* norm1_g; const GAS float* w_in; const GAS float* b_in; const GAS float* conv_w; const GAS float* conv_b;
    const GAS float* m_head_g; const GAS float* lb_table; const GAS float* g_head_g; const GAS float* w_br_m; const GAS float* w_br_g; const GAS float* w_out;
    const GAS float* norm2_g; const GAS float* w_pq; const GAS float* sub_keys; const GAS float* u_emb; const GAS float* v_emb; const GAS float* final_g;
    GAS float* out; GAS unsigned char* ws;
};
struct Args {
    const float* x; const float* norm1_g; const float* w_in; const float* b_in; const float* conv_w; const float* conv_b;
    const float* m_head_g; const float* lb_table; const float* g_head_g; const float* w_br_m; const float* w_br_g; const float* w_out;
    const float* norm2_g; const float* w_pq; const float* sub_keys; const float* u_emb; const float* v_emb; const float* final_g;
    float* out; unsigned char* ws;
};

namespace pg8 {
constexpr int BM = 256, BK = 64, HALF = 128, HTB = HALF * BK * 2, STAGE_BYTES = 8 * HTB, NXCD = 8, WGM = 8;
__host__ __device__ __forceinline__ int lds_byte(int r, int c) { const int st = (r >> 4) * 2 + (c >> 5), rr = r & 15, cc = c & 31, ob = rr * 64 + cc * 2; return st * 1024 + (ob ^ (((ob >> 9) & 1) << 5)); }
__host__ __device__ __forceinline__ void stage_rc(int b, int& R, int& C) { const int st = b / 1024, sb = b % 1024, swz = sb ^ (((sb >> 9) & 1) << 5); R = (st >> 1) * 16 + swz / 64; C = (st & 1) * 32 + (swz % 64) / 2; }
__host__ __device__ __forceinline__ int perm32(int rho) { const int n = rho >> 4, i = rho & 15; return 8 * (i >> 2) + 4 * n + (i & 3); }
struct Unit { int pm, pn; };
struct Gemm { const bf16_t* A; const bf16_t* Bt; int M, N, K; };
struct StaticOrder {
    int nM, nN, nwg, G, c;
    __host__ __device__ void init(int M, int N, int G_, int c_) { nM = M / BM; nN = N / BM; nwg = nM * nN; G = G_; c = c_; }
    __host__ __device__ bool next(int i, Unit& u) const {
        const long L = (long)i * G + c; if (L >= nwg) return false;
        int wgid = (int)L; { const int q = nwg / NXCD, r = nwg % NXCD, xcd = wgid % NXCD, off = wgid / NXCD; wgid = (xcd < r ? xcd * (q + 1) : r * (q + 1) + (xcd - r) * q) + off; }
        const int nig = WGM * nN, gid = wgid / nig, fm = gid * WGM, gsz = (nM - fm) < WGM ? (nM - fm) : WGM;
        u.pm = fm + ((wgid % nig) % gsz); u.pn = (wgid % nig) / gsz; return true;
    }
    __device__ __forceinline__ void a_ready(const Unit&) const {}
    __device__ __forceinline__ void done(const Unit&) const {}
};

template <class Epi, class Sched, bool ALIGN_EPI = false, bool SP2 = false>
__device__ __forceinline__ void gemm_phase(LAS unsigned char* lds, const Gemm g, const Sched& S, const Epi& E) {
    const int tid = tid_(), wid = __builtin_amdgcn_readfirstlane(tid >> 6), lane = tid & 63, wr = wid >> 2, wc = wid & 3, fr = lane & 15, fq = lane >> 4;
    const int K = g.K, nt = K / BK;
    unsigned voffA[2], voffB[2];
#pragma unroll
    for (int i = 0; i < 2; ++i) { int R, C; stage_rc(tid * 16 + i * 8192, R, C); const int Rb = Epi::PERM ? ((R & ~31) + perm32(R & 31)) : R;
        voffA[i] = (unsigned)(R * K + C) * 2u; voffB[i] = (unsigned)(Rb * K + C) * 2u; }
    const size_t kstep = (size_t)(BK * 2);
    const size_t hstep = (size_t)HALF * K * 2;
    const size_t tstep = 2 * hstep;
    const unsigned ldsw = (unsigned)wid * 1024u;
    const int aoff = lds_byte(wr * 64 + fr, fq * 8), boff = lds_byte(wc * 32 + fr, fq * 8);
#define PG8_SA(b, h) (((b) * 2 + (h)) * HTB)
#define PG8_SB(b, h) ((4 + (b) * 2 + (h)) * HTB)
#define PG8_STAGE(bufoff, gbase, voff) do { _Pragma("unroll") for (int _i = 0; _i < 2; ++_i) \
        __builtin_amdgcn_global_load_lds((const unsigned*)((const char*)(gbase) + (voff)[_i]), (LAS unsigned*)(lds + (bufoff) + ldsw + _i * 8192), 16, 0, 0); } while (0)
#define PG8_LDA(dst, b, h) do { _Pragma("unroll") for (int m = 0; m < 4; ++m) _Pragma("unroll") for (int k = 0; k < 2; ++k) dst[m][k] = *(const LAS bf16x8*)(lds + PG8_SA(b, h) + aoff + m * 2048 + k * 1024); } while (0)
#define PG8_LDB(dst, b, h) do { _Pragma("unroll") for (int n = 0; n < 2; ++n) _Pragma("unroll") for (int k = 0; k < 2; ++k) dst[n][k] = *(const LAS bf16x8*)(lds + PG8_SB(b, h) + boff + n * 2048 + k * 1024); } while (0)
#define PG8_MMA(ai, bj, At, Bt) do { __builtin_amdgcn_s_setprio(1); _Pragma("unroll") for (int m = 0; m < 4; ++m) _Pragma("unroll") for (int n = 0; n < 2; ++n) _Pragma("unroll") for (int k = 0; k < 2; ++k) \
        acc[ai][bj][m][n] = __builtin_amdgcn_mfma_f32_16x16x32_bf16(Bt[n][k], At[m][k], acc[ai][bj][m][n], 0, 0, 0); __builtin_amdgcn_s_setprio(0); } while (0)
#define PG8_WAIT_V(n) asm volatile("s_waitcnt vmcnt(" #n ")" ::: "memory")
#define PG8_WAIT_L(n) asm volatile("s_waitcnt lgkmcnt(" #n ")" ::: "memory")
#define PG8_BAR __builtin_amdgcn_s_barrier()
#define PG8_SCHED __builtin_amdgcn_sched_barrier(0)
    Unit cur, nxt; int ui = 0;
    if (!S.next(0, cur)) return;
    f32x4 acc[2][2][4][2];
#pragma unroll
    for (int a = 0; a < 2; ++a)
#pragma unroll
        for (int b = 0; b < 2; ++b)
#pragma unroll
            for (int m = 0; m < 4; ++m)
#pragma unroll
                for (int n = 0; n < 2; ++n) acc[a][b][m][n] = (f32x4){0.f, 0.f, 0.f, 0.f};
    bf16x8 At[4][2], B0[2][2], B1[2][2];
    const char* cA = (const char*)g.A + (size_t)cur.pm * tstep; const char* cB = (const char*)g.Bt + (size_t)cur.pn * tstep;
    S.a_ready(cur);
    if constexpr (SP2) {
        PG8_STAGE(PG8_SB(0, 0), cB, voffB); PG8_STAGE(PG8_SB(0, 1), cB + hstep, voffB); PG8_STAGE(PG8_SA(0, 0), cA, voffA); PG8_STAGE(PG8_SA(0, 1), cA + hstep, voffA);
        if (wr == 1) PG8_BAR;
        PG8_WAIT_V(2); PG8_BAR;
        PG8_STAGE(PG8_SB(1, 0), cB + kstep, voffB); PG8_STAGE(PG8_SA(1, 0), cA + kstep, voffA); PG8_STAGE(PG8_SB(1, 1), cB + hstep + kstep, voffB);
        PG8_WAIT_V(6); PG8_BAR;
    } else {
        PG8_STAGE(PG8_SB(0, 0), cB, voffB); PG8_STAGE(PG8_SA(0, 0), cA, voffA); PG8_STAGE(PG8_SB(0, 1), cB + hstep, voffB); PG8_STAGE(PG8_SA(0, 1), cA + hstep, voffA);
        if (wr == 1) PG8_BAR;
        PG8_WAIT_V(4); PG8_BAR;
        PG8_STAGE(PG8_SB(1, 0), cB + kstep, voffB); PG8_STAGE(PG8_SA(1, 0), cA + kstep, voffA); PG8_STAGE(PG8_SB(1, 1), cB + hstep + kstep, voffB);
        PG8_WAIT_V(6); PG8_BAR;
    }
    for (;;) {
        const bool has_next = S.next(ui + 1, nxt);
        const char* nA = has_next ? (const char*)g.A + (size_t)nxt.pm * tstep : cA; const char* nB = has_next ? (const char*)g.Bt + (size_t)nxt.pn * tstep : cB;
        for (int t = 0; t < nt; t += 2) {
            const bool last = (t == nt - 2);
            const char* a1 = cA + (size_t)(t + 1) * kstep;
            const char* a2 = last ? nA : cA + (size_t)(t + 2) * kstep; const char* b2 = last ? nB : cB + (size_t)(t + 2) * kstep;
            const char* a3 = a2 + kstep; const char* b3 = b2 + kstep;
            if (last && has_next) S.a_ready(nxt);
            if constexpr (SP2) {
            PG8_LDB(B0, 0, 0); PG8_LDB(B1, 0, 1); PG8_SCHED; PG8_LDA(At, 0, 0); PG8_STAGE(PG8_SA(1, 1), a1 + hstep, voffA);
            PG8_WAIT_V(8); PG8_WAIT_L(0); PG8_BAR; PG8_MMA(0, 0, At, B0); PG8_MMA(0, 1, At, B1); PG8_BAR; PG8_SCHED;
            PG8_LDA(At, 0, 1); PG8_STAGE(PG8_SB(0, 0), b2, voffB); PG8_STAGE(PG8_SB(0, 1), b2 + hstep, voffB); PG8_STAGE(PG8_SA(0, 0), a2, voffA);
            PG8_WAIT_V(8); PG8_WAIT_L(0); PG8_BAR; PG8_MMA(1, 0, At, B0); PG8_MMA(1, 1, At, B1); PG8_BAR; PG8_SCHED;
            PG8_LDB(B0, 1, 0); PG8_LDB(B1, 1, 1); PG8_SCHED; PG8_LDA(At, 1, 0); PG8_STAGE(PG8_SA(0, 1), a2 + hstep, voffA);
            PG8_WAIT_V(8); PG8_WAIT_L(0); PG8_BAR; PG8_MMA(0, 0, At, B0); PG8_MMA(0, 1, At, B1); PG8_BAR; PG8_SCHED;
            PG8_LDA(At, 1, 1); PG8_STAGE(PG8_SB(1, 0), b3, voffB); PG8_STAGE(PG8_SB(1, 1), b3 + hstep, voffB); PG8_STAGE(PG8_SA(1, 0), a3, voffA);
            PG8_WAIT_V(8); PG8_WAIT_L(0); PG8_BAR; PG8_MMA(1, 0, At, B0); PG8_MMA(1, 1, At, B1); PG8_BAR; PG8_SCHED;
            } else {
            PG8_LDB(B0, 0, 0); PG8_SCHED; PG8_LDA(At, 0, 0); PG8_STAGE(PG8_SA(1, 1), a1 + hstep, voffA);
            PG8_WAIT_L(8); PG8_BAR; PG8_WAIT_L(0); PG8_MMA(0, 0, At, B0); PG8_BAR; PG8_SCHED;
            PG8_LDB(B1, 0, 1); PG8_STAGE(PG8_SB(0, 0), b2, voffB);
            PG8_BAR; PG8_WAIT_L(0); PG8_MMA(0, 1, At, B1); PG8_BAR;
            PG8_LDA(At, 0, 1); PG8_STAGE(PG8_SA(0, 0), a2, voffA);
            PG8_BAR; PG8_WAIT_L(0); PG8_MMA(1, 0, At, B0); PG8_BAR; PG8_SCHED;
            PG8_STAGE(PG8_SB(0, 1), b2 + hstep, voffB);
            PG8_WAIT_V(6); PG8_BAR; PG8_MMA(1, 1, At, B1); PG8_BAR;
            PG8_LDB(B0, 1, 0); PG8_SCHED; PG8_LDA(At, 1, 0); PG8_STAGE(PG8_SA(0, 1), a2 + hstep, voffA);
            PG8_WAIT_L(8); PG8_BAR; PG8_WAIT_L(0); PG8_MMA(0, 0, At, B0); PG8_BAR; PG8_SCHED;
            PG8_LDB(B1, 1, 1); PG8_STAGE(PG8_SB(1, 0), b3, voffB);
            PG8_BAR; PG8_WAIT_L(0); PG8_MMA(0, 1, At, B1); PG8_BAR;
            PG8_LDA(At, 1, 1); PG8_STAGE(PG8_SA(1, 0), a3, voffA);
            PG8_BAR; PG8_WAIT_L(0); PG8_MMA(1, 0, At, B0); PG8_BAR; PG8_SCHED;
            PG8_STAGE(PG8_SB(1, 1), b3 + hstep, voffB);
            PG8_WAIT_V(6); PG8_BAR; PG8_MMA(1, 1, At, B1); PG8_BAR;
            }
        }
        if constexpr (ALIGN_EPI) { if (wr == 0) PG8_BAR; }
        E(acc, cur, wr, wc, fr, fq);
        if (!has_next) break;
#pragma unroll
        for (int a = 0; a < 2; ++a)
#pragma unroll
            for (int b = 0; b < 2; ++b)
#pragma unroll
                for (int m = 0; m < 4; ++m)
#pragma unroll
                    for (int n = 0; n < 2; ++n) acc[a][b][m][n] = (f32x4){0.f, 0.f, 0.f, 0.f};
        cur = nxt; cA = nA; cB = nB; ++ui;
        if constexpr (ALIGN_EPI) { if (wr == 1) PG8_BAR; }
    }
    PG8_WAIT_V(0);
    if constexpr (!ALIGN_EPI) { if (wr == 0) PG8_BAR; }
    PG8_BAR;
#undef PG8_SA
#undef PG8_SB
#undef PG8_STAGE
#undef PG8_LDA
#undef PG8_LDB
#undef PG8_MMA
#undef PG8_WAIT_V
#undef PG8_WAIT_L
#undef PG8_BAR
#undef PG8_SCHED
}
}

struct EpiPtrs {
    const GAS float* biasp; const GAS float* lb; const GAS float* x; GAS float* out; GAS unsigned char* ws; int round;
};
template <int MODE> struct EpiX {
    static constexpr bool PERM = true, AFTER_DRAIN = false;
    EpiPtrs P;
    __device__ __forceinline__ void operator()(const f32x4 (&acc)[2][2][4][2], const pg8::Unit& u, int wr, int wc, int fr, int fq) const {
        const int row0 = u.pm * 256 + wr * 64 + fr;
        const int colt = u.pn * 256 + wc * 32 + 8 * fq;
        GAS unsigned char* ws = P.ws;
        bf16_t* dst = nullptr; int ld = 0, coff = 0, act = 0; const GAS float* bias = nullptr;
        if (MODE == 1) {
            bias = P.biasp;
            if (u.pn < 8) { dst = (bf16_t*)(ws + WS_QKPRE); ld = 2048; coff = 0; act = 0; }
            else if (u.pn < 16) { dst = (bf16_t*)(ws + WS_V); ld = 2048; coff = 2048; act = 0; }
            else if (u.pn < 20) { dst = (bf16_t*)(ws + WS_GFLOG); ld = 1024; coff = 4096; act = 3; }
            else if (u.pn < 24) { dst = (bf16_t*)(ws + WS_GI); ld = 1024; coff = 5120; act = 0; }
            else { dst = (bf16_t*)(ws + WS_GQ); ld = 1024; coff = 6144; act = 2; }
        } else if (MODE == 2) {
            bias = P.biasp + N1;
            if (u.pn < 8) { dst = (bf16_t*)(ws + WS_SIGO); ld = 2048; coff = 0; act = 1; }
            else if (u.pn < 12) { dst = (bf16_t*)(ws + WS_SGG); ld = 1024; coff = 2048; act = 2; }
            else if (u.pn < 16) { dst = (bf16_t*)(ws + WS_SAM); ld = 1024; coff = 3072; act = 1; }
            else { dst = (bf16_t*)(ws + WS_SAG); ld = 1024; coff = 4096; act = 1; }
        } else if (MODE == 6) { dst = (bf16_t*)(ws + WS_QP); ld = 2048; coff = 0; act = 0; }
#pragma unroll
        for (int bj = 0; bj < 2; ++bj) {
            const int col = colt + bj * 128;
            f32x4 b0 = (f32x4){0.f, 0.f, 0.f, 0.f}, b1 = b0, l0 = b0, l1 = b0;
            if (MODE == 1 || MODE == 2) { b0 = *(const f32x4*)(bias + col); b1 = *(const f32x4*)(bias + col + 4); }
            if (MODE == 1) { if (act == 3) { l0 = *(const f32x4*)(P.lb + (col - coff)); l1 = *(const f32x4*)(P.lb + (col - coff) + 4); } }
#pragma unroll
            for (int ai = 0; ai < 2; ++ai)
#pragma unroll
                for (int m = 0; m < 4; ++m) {
                    const int row = row0 + ai * 128 + m * 16;
                    f32x4 v0 = acc[ai][bj][m][0] + b0, v1 = acc[ai][bj][m][1] + b1;
                    if (MODE == 1 || MODE == 2 || MODE == 6) {
                        if (act == 1) {
#pragma unroll
                            for (int j = 0; j < 4; ++j) { v0[j] = sigmoidf_(v0[j]); v1[j] = sigmoidf_(v1[j]); }
                        } else if (act == 2) {
#pragma unroll
                            for (int j = 0; j < 4; ++j) { v0[j] = siluf_(v0[j]); v1[j] = siluf_(v1[j]); }
                        } else if (act == 3) {
#pragma unroll
                            for (int j = 0; j < 4; ++j) { v0[j] = __logf(l0[j] + (1.0f - l0[j]) * sigmoidf_(v0[j])); v1[j] = __logf(l1[j] + (1.0f - l1[j]) * sigmoidf_(v1[j])); }
                        }
                        u32x4 w; w.x = pk2(v0[0], v0[1]); w.y = pk2(v0[2], v0[3]); w.z = pk2(v1[0], v1[1]); w.w = pk2(v1[2], v1[3]);
                        *(u32x4*)(dst + (size_t)row * ld + (col - coff)) = w;
                    } else if (MODE == 3) {
                        const u32x4 g = *(const u32x4*)((const bf16_t*)(ws + WS_SAM) + (size_t)row * 1024 + col);
                        GAS float* o = P.out + ((size_t)P.round * RT + row) * 1024 + col;
                        f32x4 r0, r1;
                        r0[0] = v0[0] * bf_lo(g.x); r0[1] = v0[1] * bf_hi(g.x); r0[2] = v0[2] * bf_lo(g.y); r0[3] = v0[3] * bf_hi(g.y);
                        r1[0] = v1[0] * bf_lo(g.z); r1[1] = v1[1] * bf_hi(g.z); r1[2] = v1[2] * bf_lo(g.w); r1[3] = v1[3] * bf_hi(g.w);
                        *(f32x4*)o = r0; *(f32x4*)(o + 4) = r1;
                    } else if (MODE == 4) {
                        const u32x4 g = *(const u32x4*)((const bf16_t*)(ws + WS_SAG) + (size_t)row * 1024 + col);
                        const GAS float* zp = P.out + ((size_t)P.round * RT + row) * 1024 + col;
                        const f32x4 p0 = *(const f32x4*)zp, p1 = *(const f32x4*)(zp + 4);
                        f32x4 r0, r1;
                        r0[0] = p0[0] + v0[0] * bf_lo(g.x); r0[1] = p0[1] + v0[1] * bf_hi(g.x); r0[2] = p0[2] + v0[2] * bf_lo(g.y); r0[3] = p0[3] + v0[3] * bf_hi(g.y);
                        r1[0] = p1[0] + v1[0] * bf_lo(g.z); r1[1] = p1[1] + v1[1] * bf_hi(g.z); r1[2] = p1[2] + v1[2] * bf_lo(g.w); r1[3] = p1[3] + v1[3] * bf_hi(g.w);
                        u32x4 w; w.x = pk2(r0[0], r0[1]); w.y = pk2(r0[2], r0[3]); w.z = pk2(r1[0], r1[1]); w.w = pk2(r1[2], r1[3]);
                        *(u32x4*)((bf16_t*)(ws + WS_GFLOG) + (size_t)row * 1024 + col) = w;
                    } else if (MODE == 5) {
                        const size_t off = ((size_t)P.round * RT + row) * 1024 + col;
                        const f32x4 x0 = *(const f32x4*)(P.x + off), x1 = *(const f32x4*)(P.x + off + 4);
                        *(f32x4*)(P.out + off) = x0 + v0; *(f32x4*)(P.out + off + 4) = x1 + v1;
                    }
                }
        }
    }
};

__device__ __forceinline__ void p0_transpose_item(const GAS float* W, int ldw, int K, int k0, int scol, GAS bf16_t* WT, int drow, LAS float* scr, int lane) {
#pragma unroll 8
    for (int i = 0; i < 32; ++i) { const int kk = 2 * i + (lane >> 5); scr[kk * 33 + (lane & 31)] = W[(size_t)(k0 + kk) * ldw + scol + (lane & 31)]; }
    LDS_WAIT(); asm volatile("" ::: "memory");
    const int c = lane & 7;
#pragma unroll
    for (int j = 0; j < 4; ++j) { const int n = (lane >> 3) + 8 * j; const LAS float* s = scr + (8 * c) * 33 + n;
        u32x4 o; o.x = pk2(s[0 * 33], s[1 * 33]); o.y = pk2(s[2 * 33], s[3 * 33]); o.z = pk2(s[4 * 33], s[5 * 33]); o.w = pk2(s[6 * 33], s[7 * 33]);
        *(u32x4*)(WT + (size_t)(drow + n) * K + k0 + 8 * c) = o; }
    LDS_WAIT(); asm volatile("" ::: "memory");
}
__device__ __forceinline__ int win_src_col(int n) {
    if (n < 4096) return n;
    if (n < 7168) return n - 4096 + 6152;
    if (n < 9216) return n - 7168 + 4096;
    return n - 9216 + 9224;
}

__device__ __forceinline__ void phase_p0(const DArgs& a, LAS unsigned char* lds, int vcu, int G) {
    const int tid = tid_(), lane = tid & 63, wave = tid >> 6;
    const int gw = vcu * NWAVES + wave, NGW = G * NWAVES;
    GAS unsigned char* ws = a.ws;
    LAS float* scr = (LAS float*)(lds + wave * 16384);
    constexpr int I_IN = 16 * 384, I_M = 32 * 32, I_G = 16 * 32, I_O = 16 * 32, I_PQ = 16 * 64;
    constexpr int NITEMS = I_IN + I_M + I_G + I_O + I_PQ;
    for (int it = gw; it < NITEMS; it += NGW) {
        int r = it;
        if (r < I_IN) { const int kb = r / 384, nb = r % 384; p0_transpose_item(a.w_in, IN_COLS, 1024, kb * 64, win_src_col(nb * 32), (GAS bf16_t*)(ws + WS_WIN), nb * 32, scr, lane); continue; } r -= I_IN;
        if (r < I_M) { const int kb = r / 32, nb = r % 32; p0_transpose_item(a.w_br_m, 1024, 2048, kb * 64, nb * 32, (GAS bf16_t*)(ws + WS_WM), nb * 32, scr, lane); continue; } r -= I_M;
        if (r < I_G) { const int kb = r / 32, nb = r % 32; p0_transpose_item(a.w_br_g, 1024, 1024, kb * 64, nb * 32, (GAS bf16_t*)(ws + WS_WG), nb * 32, scr, lane); continue; } r -= I_G;
        if (r < I_O) { const int kb = r / 32, nb = r % 32; p0_transpose_item(a.w_out, 1024, 1024, kb * 64, nb * 32, (GAS bf16_t*)(ws + WS_WO), nb * 32, scr, lane); continue; } r -= I_O;
        { const int kb = r / 64, nb = r % 64; p0_transpose_item(a.w_pq, 2048, 1024, kb * 64, nb * 32, (GAS bf16_t*)(ws + WS_WPQ), nb * 32, scr, lane); }
    }
    const int gt = vcu * NTHR + tid, NGT = G * NTHR;
    for (int i = gt; i < NP; i += NGT) ((float*)(ws + WS_BIASP))[i] = a.b_in[win_src_col(i)];
    for (int i = gt; i < 1024; i += NGT) { const float t0 = a.lb_table[i], t1 = a.lb_table[1024 + i]; ((float*)(ws + WS_LB))[i] = 1.0f / (1.0f + __expf(t1 - t0)); }
    for (int i = gt; i < 8 * 2 * 128 * 128 / 4; i += NGT) { const f32x4 v = ((const f32x4*)a.sub_keys)[i]; u32x2 o; o.x = pk2(v[0], v[1]); o.y = pk2(v[2], v[3]); ((u32x2*)(ws + WS_SK))[i] = o; }
    {
        float mu = 0.f, mv = 0.f;
        for (size_t i = (size_t)vcu * NTHR + tid; i < (size_t)16384 * 1024 / 4; i += (size_t)G * NTHR) {
            const f32x4 u4 = ((const GAS f32x4*)a.u_emb)[i], v4 = ((const GAS f32x4*)a.v_emb)[i];
            mu = fmaxf(mu, fmaxf(fmaxf(fabsf(u4[0]), fabsf(u4[1])), fmaxf(fabsf(u4[2]), fabsf(u4[3]))));
            mv = fmaxf(mv, fmaxf(fmaxf(fabsf(v4[0]), fabsf(v4[1])), fmaxf(fabsf(v4[2]), fabsf(v4[3])))); }
#pragma unroll
        for (int o = 1; o < 64; o <<= 1) { mu = fmaxf(mu, shx(mu, o, lane)); mv = fmaxf(mv, shx(mv, o, lane)); }
        if (lane == 0) { atomicMax((unsigned*)(ws + WS_CTL) + CW_TMAX, __builtin_bit_cast(unsigned, mu)); atomicMax((unsigned*)(ws + WS_CTL) + CW_TMAX + 1, __builtin_bit_cast(unsigned, mv)); }
    }
    f32x4 g1[4];
#pragma unroll
    for (int j = 0; j < 4; ++j) g1[j] = ((const GAS f32x4*)a.norm1_g)[64 * j + lane];
    f32x4 gw0[16], gw1[16];
#pragma unroll
    for (int j = 0; j < 4; ++j)
#pragma unroll
        for (int e = 0; e < 4; ++e) { const int k = 256 * j + 4 * lane + e; gw0[4 * j + e] = *(const GAS f32x4*)(a.w_in + (size_t)k * IN_COLS + 6144); gw1[4 * j + e] = *(const GAS f32x4*)(a.w_in + (size_t)k * IN_COLS + 6148); }
    const float gbias = lane < 8 ? a.b_in[6144 + lane] : 0.f;
    for (int m = gw; m < T; m += NGW) {
        const GAS f32x4* xr = (const GAS f32x4*)(a.x + (size_t)m * D) + lane;
        f32x4 v[4]; float s = 0.f;
#pragma unroll
        for (int j = 0; j < 4; ++j) { v[j] = xr[64 * j]; s += (v[j][0] * v[j][0] + v[j][1] * v[j][1]) + (v[j][2] * v[j][2] + v[j][3] * v[j][3]); }
        const float rstd = rsqrtf(wave_sum(s, lane) * (1.f / D) + EPS);
        GAS unsigned long long* o8 = (GAS unsigned long long*)((GAS bf16_t*)(ws + WS_XN) + (size_t)m * D) + lane;
        f32x4 ga0 = (f32x4){0.f, 0.f, 0.f, 0.f}, ga1 = ga0;
#pragma unroll
        for (int j = 0; j < 4; ++j) {
            v[j] = v[j] * rstd * g1[j];
            o8[64 * j] = (unsigned long long)pk2(v[j][0], v[j][1]) | ((unsigned long long)pk2(v[j][2], v[j][3]) << 32);
#pragma unroll
            for (int e = 0; e < 4; ++e) { ga0 += gw0[4 * j + e] * v[j][e]; ga1 += gw1[4 * j + e] * v[j][e]; }
        }
        float ga[8] = {ga0[0], ga0[1], ga0[2], ga0[3], ga1[0], ga1[1], ga1[2], ga1[3]};
#pragma unroll
        for (int q = 0; q < 8; ++q) ga[q] = wave_sum(ga[q], lane);
        if (lane < 8) { float r = ga[0];
#pragma unroll
            for (int q = 1; q < 8; ++q) r = (lane == q) ? ga[q] : r;
            ((GAS float*)(ws + WS_GATES))[(size_t)m * 8 + lane] = r + gbias; }
    }
}

__device__ __forceinline__ float logsigf_(float x) { return fminf(x, 0.f) - log1pf(__expf(-fabsf(x))); }
#define LDS_BAR() do { asm volatile("s_waitcnt lgkmcnt(0)" ::: "memory"); __builtin_amdgcn_s_barrier(); asm volatile("" ::: "memory"); } while (0)
#define MFMA16(a, b, c) __builtin_amdgcn_mfma_f32_16x16x32_bf16((a), (b), (c), 0, 0, 0)
__device__ __forceinline__ bf16x8 lfrag(const LAS unsigned char* base, int pitch, int row, int k0, int fq) { return *(const LAS bf16x8*)(base + row * pitch + (k0 + 8 * fq) * 2); }
__device__ __forceinline__ bf16x8 gfrag(const bf16_t* base, int ld, int row, int k0, int fq) { return *(const bf16x8*)(base + (size_t)row * ld + k0 + 8 * fq); }

__device__ __forceinline__ void mscan_pair(const DArgs& a, LAS unsigned char* lds, int round, int p) {
    const int tid = tid_(), lane = tid & 63, part = tid >> 6;
    const int bl = p >> 2, h = p & 3, b = round * 2 + bl;
    const GAS float* g = (const GAS float*)(a.ws + WS_GATES) + ((size_t)b * SEQ + (size_t)lane * 128 + part * 16) * 8;
    float bsum = 0.f, gm = -INFINITY;
#pragma unroll 4
    for (int s = 0; s < 16; ++s) { const float ip = g[s * 8 + h], fp = g[s * 8 + 4 + h]; bsum += logsigf_(fp); gm = fmaxf(gm, ip - bsum); }
    LAS float* PS = (LAS float*)lds; LAS float* PM = PS + 512;
    PS[part * 64 + lane] = bsum; PM[part * 64 + lane] = gm;
    __syncthreads();
    if (tid < 64) {
        float bs = 0.f, g2 = -INFINITY;
#pragma unroll
        for (int q = 0; q < 8; ++q) { g2 = fmaxf(g2, PM[q * 64 + lane] - bs); bs += PS[q * 64 + lane]; }
        float mprev = 0.f, mine = 0.f;
        for (int c = 0; c < 64; ++c) {
            const float bc = rdlane(bs, c), gc = rdlane(g2, c);
            if (lane == c) mine = mprev; mprev = bc + fmaxf(mprev, gc); }
        ((GAS float*)(a.ws + WS_MPREV))[(round * 8 + p) * 64 + lane] = mine;
    }
    __syncthreads();
}

constexpr int PQ_PITCH = 528, PS_PITCH = 272;
__device__ __forceinline__ void mlstm_pre_item(const DArgs& a, LAS unsigned char* lds, int round, int item) {
    const int tid = tid_(), lane = tid & 63, wave = __builtin_amdgcn_readfirstlane(tid >> 6), fr = lane & 15, fq = lane >> 4;
    const int p = item >> 6, c = item & 63, bl = p >> 2, h = p & 3, b = round * 2 + bl;
    const int tl0 = bl * SEQ + c * 128; const size_t tg0 = (size_t)b * SEQ + c * 128;
    GAS unsigned char* ws = a.ws;
    LAS unsigned char* QL = lds; LAS unsigned char* KL = lds + 67584;
    LAS float* AS = (LAS float*)(lds + 135168); LAS float* MS = AS + 128; LAS float* SC = AS + 256;
    if (wave == 0) {
        const float mprev = ((const float*)(ws + WS_MPREV))[(round * 8 + p) * 64 + c];
        const float* g = (const float*)(ws + WS_GATES) + (tg0 + 2 * lane) * 8;
        const float ip0 = g[h], fp0 = g[4 + h], ip1 = g[8 + h], fp1 = g[12 + h];
        const float lf0 = logsigf_(fp0), lf1 = logsigf_(fp1), pp = lf0 + lf1;
        float incl = pp;
#pragma unroll
        for (int o = 1; o < 64; o <<= 1) { const float t = shup(incl, o, lane); if (lane >= o) incl += t; }
        const float excl = incl - pp, b0 = excl + lf0, b1 = incl;
        const float a0 = ip0 - b0, a1 = ip1 - b1;
        float inclm = fmaxf(a0, a1);
#pragma unroll
        for (int o = 1; o < 64; o <<= 1) { const float t = shup(inclm, o, lane); if (lane >= o) inclm = fmaxf(inclm, t); }
        float exclm = shup(inclm, 1, lane); if (lane == 0) exclm = -INFINITY;
        const float M0 = fmaxf(mprev, fmaxf(exclm, a0)), M1 = fmaxf(mprev, inclm);
        AS[2 * lane] = a0; AS[2 * lane + 1] = a1; MS[2 * lane] = M0; MS[2 * lane + 1] = M1;
        float* mt = (float*)(ws + WS_MT) + (tg0 + 2 * lane) * 4 + h;
        mt[0] = b0 + M0; mt[4] = b1 + M1;
        const float Mlast = rdlane(M1, 63);
        if (lane == 0) { SC[0] = mprev; SC[1] = Mlast; ((float*)(ws + WS_MDEC))[item] = __expf(mprev - Mlast); }
    }
    {
        const int cgp = tid & 63, strip = tid >> 6;
        const int col = (cgp < 32) ? (h * 256 + cgp * 8) : (1024 + h * 256 + (cgp - 32) * 8);
        float w[4][8], bb[8];
#pragma unroll
        for (int j = 0; j < 4; ++j) { const f32x4 w0 = *(const f32x4*)(a.conv_w + j * 2048 + col), w1 = *(const f32x4*)(a.conv_w + j * 2048 + col + 4);
#pragma unroll
            for (int e = 0; e < 4; ++e) { w[j][e] = w0[e]; w[j][4 + e] = w1[e]; } }
        { const f32x4 b0 = *(const f32x4*)(a.conv_b + col), b1 = *(const f32x4*)(a.conv_b + col + 4);
#pragma unroll
            for (int e = 0; e < 4; ++e) { bb[e] = b0[e]; bb[4 + e] = b1[e]; } }
        const bf16_t* src = (const bf16_t*)(ws + WS_QKPRE) + (size_t)(tl0 + 16 * strip) * 2048 + col;
        const float qs = (cgp < 32) ? 0.0625f : 1.0f;
        LAS unsigned char* dstt = ((cgp < 32) ? QL : KL) + (cgp & 31) * 16;
#pragma unroll 1
        for (int half = 0; half < 2; ++half) {
            u32x4 xr[11];
#pragma unroll
            for (int r = 0; r < 11; ++r) {
                const int sl = c * 128 + 16 * strip + 8 * half + r - 3;
                xr[r] = (sl >= 0) ? *(const u32x4*)(src + (ptrdiff_t)(8 * half + r - 3) * 2048) : (u32x4){0u, 0u, 0u, 0u};
            }
#pragma unroll
            for (int r = 0; r < 8; ++r) {
                float y[8];
#pragma unroll
                for (int e = 0; e < 8; ++e) y[e] = bb[e];
#pragma unroll
                for (int j = 0; j < 4; ++j) { const u32x4 xv = xr[r + j];
                    y[0] += w[j][0] * bf_lo(xv.x); y[1] += w[j][1] * bf_hi(xv.x); y[2] += w[j][2] * bf_lo(xv.y); y[3] += w[j][3] * bf_hi(xv.y);
                    y[4] += w[j][4] * bf_lo(xv.z); y[5] += w[j][5] * bf_hi(xv.z); y[6] += w[j][6] * bf_lo(xv.w); y[7] += w[j][7] * bf_hi(xv.w); }
#pragma unroll
                for (int e = 0; e < 8; ++e) y[e] = siluf_(y[e]) * qs;
                u32x4 o; o.x = pk2(y[0], y[1]); o.y = pk2(y[2], y[3]); o.z = pk2(y[4], y[5]); o.w = pk2(y[6], y[7]);
                *(LAS u32x4*)(dstt + (16 * strip + 8 * half + r) * PQ_PITCH) = o;
            }
        }
    }
    __syncthreads();
    const float mprev = SC[0], Mlast = SC[1];
    {
        bf16_t* Sg = (bf16_t*)(ws + WS_S) + (size_t)item * 128 * 128;
        const int t = wave * 16 + fr; const float Mt = MS[t];
        for (int st = 0; st < 8; ++st) {
            u32x2 o = (u32x2){0u, 0u};
            if (st <= wave) {
                f32x4 acc = (f32x4){0.f, 0.f, 0.f, 0.f};
#pragma unroll
                for (int ks = 0; ks < 8; ++ks) acc = MFMA16(lfrag(KL, PQ_PITCH, st * 16 + fr, ks * 32, fq), lfrag(QL, PQ_PITCH, wave * 16 + fr, ks * 32, fq), acc);
                float v[4];
#pragma unroll
                for (int j = 0; j < 4; ++j) { const int s = st * 16 + 4 * fq + j; v[j] = (s <= t) ? acc[j] * __expf(AS[s] - Mt) : 0.f; }
                o.x = pk2(v[0], v[1]); o.y = pk2(v[2], v[3]);
            }
            *(u32x2*)(Sg + (size_t)t * 128 + st * 16 + 4 * fq) = o;
        }
    }
    {
        bf16_t* Qg = (bf16_t*)(ws + WS_QT) + (size_t)item * 128 * 256;
#pragma unroll
        for (int i = 0; i < 8; ++i) { const int idx = tid + 512 * i, t = idx >> 5, ch = idx & 31;
            const u32x4 v = *(const LAS u32x4*)(QL + t * PQ_PITCH + ch * 16); const float s = __expf(mprev - MS[t]);
            u32x4 o; o.x = pk2(bf_lo(v.x) * s, bf_hi(v.x) * s); o.y = pk2(bf_lo(v.y) * s, bf_hi(v.y) * s); o.z = pk2(bf_lo(v.z) * s, bf_hi(v.z) * s); o.w = pk2(bf_lo(v.w) * s, bf_hi(v.w) * s);
            *(u32x4*)(Qg + (size_t)t * 256 + ch * 8) = o; }
    }
    {
        bf16_t* Kg = (bf16_t*)(ws + WS_KWT) + (size_t)item * 256 * 128;
        const int dlo = lane & 15, sglo = lane >> 4;
#pragma unroll
        for (int i = 0; i < 8; ++i) { const int combo = wave * 8 + i, d = (combo >> 2) * 16 + dlo, s0 = ((combo & 3) * 4 + sglo) * 8;
            float v[8];
#pragma unroll
            for (int e = 0; e < 8; ++e) v[e] = bf2f(*(const LAS bf16_t*)(KL + (s0 + e) * PQ_PITCH + d * 2)) * __expf(AS[s0 + e] - Mlast);
            u32x4 o; o.x = pk2(v[0], v[1]); o.y = pk2(v[2], v[3]); o.z = pk2(v[4], v[5]); o.w = pk2(v[6], v[7]);
            *(u32x4*)(Kg + (size_t)d * 128 + s0) = o; }
    }
    __syncthreads();
}

__device__ __forceinline__ void hgrn_pre_item(const DArgs& a, LAS unsigned char* lds, int round, int item) {
    const int tid = tid_(), lane = tid & 63, wave = __builtin_amdgcn_readfirstlane(tid >> 6), fr = lane & 15, fq = lane >> 4;
    const int p = item >> 7, c = item & 127, bl = p >> 3, h = p & 7;
    const int tl0 = bl * SEQ + c * 64;
    GAS unsigned char* ws = a.ws;
    LAS float* CUM = (LAS float*)lds;
    LAS float* GL = (LAS float*)(lds + 32768);
    LAS unsigned char* QH = lds + 65536;
    LAS unsigned char* KE = lds + 65536 + 64 * PS_PITCH;
    LAS float* QF = (LAS float*)(lds + 65536 + 128 * PS_PITCH);
#pragma unroll
    for (int i = 0; i < 2; ++i) { const int idx = tid + 512 * i, s = idx >> 4, ch = idx & 15;
        const u32x4 gv = *(const u32x4*)((const bf16_t*)(ws + WS_GFLOG) + (size_t)(tl0 + s) * 1024 + h * 128 + ch * 8);
        const u32x4 qv = *(const u32x4*)((const bf16_t*)(ws + WS_GQ) + (size_t)(tl0 + s) * 1024 + h * 128 + ch * 8);
        LAS float* gd = GL + s * 128 + ch * 8; LAS float* qd = QF + s * 128 + ch * 8;
        gd[0] = bf_lo(gv.x); gd[1] = bf_hi(gv.x); gd[2] = bf_lo(gv.y); gd[3] = bf_hi(gv.y); gd[4] = bf_lo(gv.z); gd[5] = bf_hi(gv.z); gd[6] = bf_lo(gv.w); gd[7] = bf_hi(gv.w);
        qd[0] = bf_lo(qv.x); qd[1] = bf_hi(qv.x); qd[2] = bf_lo(qv.y); qd[3] = bf_hi(qv.y); qd[4] = bf_lo(qv.z); qd[5] = bf_hi(qv.z); qd[6] = bf_lo(qv.w); qd[7] = bf_hi(qv.w); }
    __syncthreads();
    {
        const int d = tid & 127, qt = tid >> 7; float cs = 0.f;
#pragma unroll 4
        for (int s = 0; s < 16; ++s) { cs += GL[(qt * 16 + s) * 128 + d]; CUM[(qt * 16 + s) * 128 + d] = cs; }
        __syncthreads();
        float off = 0.f;
#pragma unroll
        for (int q = 0; q < 3; ++q) off += (q < qt) ? CUM[(q * 16 + 15) * 128 + d] : 0.f;
        __syncthreads();
#pragma unroll 4
        for (int s = 0; s < 16; ++s) CUM[(qt * 16 + s) * 128 + d] += off;
        if (qt == 3) ((GAS float*)(ws + WS_HGDEC))[(size_t)item * 128 + d] = __expf(cs + off);
    }
    __syncthreads();
    {
        bf16_t* Qg = (bf16_t*)(ws + WS_QTG) + (size_t)item * 64 * 128;
#pragma unroll
        for (int i = 0; i < 2; ++i) { const int idx = tid + 512 * i, s = idx >> 4, ch = idx & 15;
            float qt[8], qh[8], ke[8];
#pragma unroll
            for (int e = 0; e < 8; ++e) { const int d = ch * 8 + e; const float cm = CUM[s * 128 + d], last = CUM[63 * 128 + d], q = QF[s * 128 + d], g = GL[s * 128 + d];
                qt[e] = q * __expf(cm); qh[e] = q * __expf(cm - last); ke[e] = (1.0f - __expf(g)) * __expf(last - cm); }
            u32x4 o; o.x = pk2(qt[0], qt[1]); o.y = pk2(qt[2], qt[3]); o.z = pk2(qt[4], qt[5]); o.w = pk2(qt[6], qt[7]);
            *(u32x4*)(Qg + (size_t)s * 128 + ch * 8) = o;
            o.x = pk2(qh[0], qh[1]); o.y = pk2(qh[2], qh[3]); o.z = pk2(qh[4], qh[5]); o.w = pk2(qh[6], qh[7]);
            *(LAS u32x4*)(QH + s * PS_PITCH + ch * 16) = o;
            o.x = pk2(ke[0], ke[1]); o.y = pk2(ke[2], ke[3]); o.z = pk2(ke[4], ke[5]); o.w = pk2(ke[6], ke[7]);
            *(LAS u32x4*)(KE + s * PS_PITCH + ch * 16) = o; }
    }
    __syncthreads();
    {
        bf16_t* Ag = (bf16_t*)(ws + WS_ATT) + (size_t)item * 64 * 64;
#pragma unroll
        for (int i = 0; i < 2; ++i) { const int tile = wave * 2 + i, tt = tile >> 2, st = tile & 3; const int t = tt * 16 + fr;
            u32x2 o = (u32x2){0u, 0u};
            if (st <= tt) { f32x4 acc = (f32x4){0.f, 0.f, 0.f, 0.f};
#pragma unroll
                for (int ks = 0; ks < 4; ++ks) acc = MFMA16(lfrag(KE, PS_PITCH, st * 16 + fr, ks * 32, fq), lfrag(QH, PS_PITCH, tt * 16 + fr, ks * 32, fq), acc);
                float v[4];
#pragma unroll
                for (int j = 0; j < 4; ++j) { const int s = st * 16 + 4 * fq + j; v[j] = (s <= t) ? acc[j] : 0.f; }
                o.x = pk2(v[0], v[1]); o.y = pk2(v[2], v[3]); }
            *(u32x2*)(Ag + (size_t)t * 64 + st * 16 + 4 * fq) = o; }
    }
    {
        bf16_t* Kg = (bf16_t*)(ws + WS_KENDT) + (size_t)item * 128 * 64;
        const int dlo = lane & 15, sglo = lane >> 4;
#pragma unroll
        for (int i = 0; i < 2; ++i) { const int combo = wave * 2 + i, d = (combo >> 1) * 16 + dlo, s0 = ((combo & 1) * 4 + sglo) * 8;
            unsigned v[8];
#pragma unroll
            for (int e = 0; e < 8; ++e) v[e] = *(const LAS bf16_t*)(KE + (s0 + e) * PS_PITCH + d * 2);
            u32x4 o; o.x = v[0] | (v[1] << 16); o.y = v[2] | (v[3] << 16); o.z = v[4] | (v[5] << 16); o.w = v[6] | (v[7] << 16);
            *(u32x4*)(Kg + (size_t)d * 64 + s0) = o; }
    }
    __syncthreads();
}

__device__ __forceinline__ void mlstm_scan(const DArgs& a, LAS unsigned char* lds, int round, int p, int sl) {
    const int tid = tid_(), lane = tid & 63, wave = __builtin_amdgcn_readfirstlane(tid >> 6), fr = lane & 15, fq = lane >> 4;
    const int bl = p >> 2, h = p & 3, b = round * 2 + bl;
    GAS unsigned char* ws = a.ws;
    constexpr int VTB = 48 * PS_PITCH, CTB = 48 * PQ_PITCH;
    LAS unsigned char* VT = lds; LAS unsigned char* CT = lds + 2 * VTB; LAS float* DEC = (LAS float*)(lds + 2 * VTB + 2 * CTB); LAS unsigned char* SLAB = lds + 2 * VTB + 2 * CTB + 256;
    for (int i = tid; i < (2 * VTB + 2 * CTB) / 4; i += NTHR) ((LAS unsigned*)lds)[i] = 0u;
    if (tid < 64) DEC[tid] = ((const GAS float*)(ws + WS_MDEC))[p * 64 + tid];
    __syncthreads();
    if (tid < 256) { const int bufi = tid >> 7, s = tid & 127; *(LAS bf16_t*)(VT + bufi * VTB + 32 * PS_PITCH + s * 2) = (bf16_t)0x3F80; }
    f32x4 st[2][3];
#pragma unroll
    for (int dt = 0; dt < 2; ++dt)
#pragma unroll
        for (int vt = 0; vt < 3; ++vt) st[dt][vt] = (f32x4){0.f, 0.f, 0.f, 0.f};
    const int vcol = h * 512 + sl * 32;
    const int vs = tid >> 2, vpart = tid & 3;
    const GAS unsigned char* Sg0 = ws + WS_S + (size_t)(p * 64) * 32768;
    const GAS unsigned char* Qg0 = ws + WS_QT + (size_t)(p * 64) * 65536;
    const GAS unsigned char* Kg0 = ws + WS_KWT + (size_t)(p * 64) * 65536;
    const GAS bf16_t* Vg0 = (const GAS bf16_t*)(ws + WS_V) + (size_t)(bl * SEQ + vs) * 2048 + vcol + vpart * 8;
    u32x4 pf[4];
#define SL_LOAD_S(cc_) do { _Pragma("unroll") for (int j_ = 0; j_ < 4; ++j_) pf[j_] = *(const GAS u32x4*)(Sg0 + (size_t)(cc_) * 32768 + (tid + 512 * j_) * 16); } while (0)
#define SL_LOAD_Q(cc_, hf_) do { _Pragma("unroll") for (int j_ = 0; j_ < 4; ++j_) { const int q_ = tid + 512 * j_; pf[j_] = *(const GAS u32x4*)(Qg0 + (size_t)(cc_) * 65536 + (q_ >> 4) * 512 + (hf_) * 256 + (q_ & 15) * 16); } } while (0)
#define SL_LOAD_K(cc_, hf_) do { _Pragma("unroll") for (int j_ = 0; j_ < 4; ++j_) { const int q_ = tid + 512 * j_; pf[j_] = *(const GAS u32x4*)(Kg0 + (size_t)(cc_) * 65536 + (q_ >> 3) * 256 + (hf_) * 128 + (q_ & 7) * 16); } } while (0)
#define SL_WRITE256(slot_) do { _Pragma("unroll") for (int j_ = 0; j_ < 4; ++j_) { const int q_ = tid + 512 * j_, r_ = q_ >> 4, c_ = q_ & 15; *(LAS u32x4*)(SLAB + (slot_) * 32768 + r_ * 256 + ((c_ ^ (r_ & 15)) << 4)) = pf[j_]; } } while (0)
#define SL_WRITE128(slot_) do { _Pragma("unroll") for (int j_ = 0; j_ < 4; ++j_) { const int q_ = tid + 512 * j_, r_ = q_ >> 3, c_ = q_ & 7; *(LAS u32x4*)(SLAB + (slot_) * 32768 + r_ * 128 + ((c_ ^ ((r_ >> 1) & 7)) << 4)) = pf[j_]; } } while (0)
#define FRAG256(slot_, row_, ks_) (*(const LAS bf16x8*)(SLAB + (slot_) * 32768 + (row_) * 256 + (((4 * (ks_) + fq) ^ ((row_) & 15)) << 4)))
#define FRAG128(slot_, row_, ks_) (*(const LAS bf16x8*)(SLAB + (slot_) * 32768 + (row_) * 128 + (((4 * (ks_) + fq) ^ (((row_) >> 1) & 7)) << 4)))
#define V_STAGE(cc_, vreg_) do { LAS unsigned char* d0_ = VT + ((cc_) & 1) * VTB + (vpart * 8) * PS_PITCH + vs * 2; \
        *(LAS bf16_t*)(d0_ + 0 * PS_PITCH) = (bf16_t)(vreg_.x & 0xffffu); *(LAS bf16_t*)(d0_ + 1 * PS_PITCH) = (bf16_t)(vreg_.x >> 16); \
        *(LAS bf16_t*)(d0_ + 2 * PS_PITCH) = (bf16_t)(vreg_.y & 0xffffu); *(LAS bf16_t*)(d0_ + 3 * PS_PITCH) = (bf16_t)(vreg_.y >> 16); \
        *(LAS bf16_t*)(d0_ + 4 * PS_PITCH) = (bf16_t)(vreg_.z & 0xffffu); *(LAS bf16_t*)(d0_ + 5 * PS_PITCH) = (bf16_t)(vreg_.z >> 16); \
        *(LAS bf16_t*)(d0_ + 6 * PS_PITCH) = (bf16_t)(vreg_.w & 0xffffu); *(LAS bf16_t*)(d0_ + 7 * PS_PITCH) = (bf16_t)(vreg_.w >> 16); } while (0)
    u32x4 pfB[4];
#define PF_SWAP_USE_B()
    const int trow = wave * 16 + fr;
    { SL_LOAD_S(0); const u32x4 vreg = *(const GAS u32x4*)Vg0; SL_WRITE256(0); V_STAGE(0, vreg); }
    { _Pragma("unroll") for (int j_ = 0; j_ < 4; ++j_) { const int q_ = tid + 512 * j_; pfB[j_] = *(const GAS u32x4*)(Qg0 + (q_ >> 4) * 512 + (q_ & 15) * 16); } }
    LDS_BAR();
#define LOADX(P_, kind_, cc_) do { _Pragma("unroll") for (int j_ = 0; j_ < 4; ++j_) { const int q_ = tid + 512 * j_; \
        if ((kind_) == 0) P_[j_] = *(const GAS u32x4*)(Sg0 + (size_t)(cc_) * 32768 + q_ * 16); \
        else if ((kind_) <= 2) P_[j_] = *(const GAS u32x4*)(Qg0 + (size_t)(cc_) * 65536 + (q_ >> 4) * 512 + ((kind_) - 1) * 256 + (q_ & 15) * 16); \
        else P_[j_] = *(const GAS u32x4*)(Kg0 + (size_t)(cc_) * 65536 + (q_ >> 3) * 256 + ((kind_) - 3) * 128 + (q_ & 7) * 16); } } while (0)
#define WRITEX(P_, kind_, slot_) do { _Pragma("unroll") for (int j_ = 0; j_ < 4; ++j_) { const int q_ = tid + 512 * j_; \
        if ((kind_) <= 2) { const int r_ = q_ >> 4, c_ = q_ & 15; *(LAS u32x4*)(SLAB + (slot_) * 32768 + r_ * 256 + ((c_ ^ (r_ & 15)) << 4)) = P_[j_]; } \
        else { const int r_ = q_ >> 3, c_ = q_ & 7; *(LAS u32x4*)(SLAB + (slot_) * 32768 + r_ * 128 + ((c_ ^ ((r_ >> 1) & 7)) << 4)) = P_[j_]; } } } while (0)
#define CHUNK(c_, PAR_) do { \
        const int tl0 = bl * SEQ + (c_) * 128; const size_t tg0 = (size_t)b * SEQ + (c_) * 128; const int cn = (c_) < 63 ? (c_) + 1 : 63; \
        LAS unsigned char* vt_ = VT + ((c_) & 1) * VTB; LAS unsigned char* ct_ = CT + ((c_) & 1) * CTB; LAS unsigned char* ctn = CT + (((c_) + 1) & 1) * CTB; \
        bf16x8 vf[3][4]; \
        _Pragma("unroll") for (int vt = 0; vt < 3; ++vt) _Pragma("unroll") for (int ks = 0; ks < 4; ++ks) vf[vt][ks] = lfrag(vt_, PS_PITCH, vt * 16 + fr, ks * 32, fq); \
        f32x4 acc[3]; _Pragma("unroll") for (int vt = 0; vt < 3; ++vt) acc[vt] = (f32x4){0.f, 0.f, 0.f, 0.f}; \
          \
        { if (PAR_) LOADX(pfB, 2, (c_)); else LOADX(pf, 2, (c_)); \
          _Pragma("unroll") for (int ks = 0; ks < 4; ++ks) { const bf16x8 bS = FRAG256((PAR_), trow, ks); _Pragma("unroll") for (int vt = 0; vt < 3; ++vt) acc[vt] = MFMA16(vf[vt][ks], bS, acc[vt]); } \
          if (PAR_) WRITEX(pf, 1, (PAR_) ^ 1); else WRITEX(pfB, 1, (PAR_) ^ 1); LDS_BAR(); } \
          \
        { if (PAR_) LOADX(pf, 3, (c_)); else LOADX(pfB, 3, (c_)); \
          _Pragma("unroll") for (int ks = 0; ks < 4; ++ks) { const bf16x8 bQ = FRAG256((PAR_) ^ 1, trow, ks); _Pragma("unroll") for (int vt = 0; vt < 3; ++vt) acc[vt] = MFMA16(lfrag(ct_, PQ_PITCH, vt * 16 + fr, ks * 32, fq), bQ, acc[vt]); } \
          if (PAR_) WRITEX(pfB, 2, (PAR_)); else WRITEX(pf, 2, (PAR_)); LDS_BAR(); } \
          \
        { if (PAR_) LOADX(pfB, 4, (c_)); else LOADX(pf, 4, (c_)); \
          _Pragma("unroll") for (int ks = 0; ks < 4; ++ks) { const bf16x8 bQ = FRAG256((PAR_), trow, ks); _Pragma("unroll") for (int vt = 0; vt < 3; ++vt) acc[vt] = MFMA16(lfrag(ct_, PQ_PITCH, vt * 16 + fr, 128 + ks * 32, fq), bQ, acc[vt]); } \
          GAS bf16_t* hn = (GAS bf16_t*)(ws + WS_QKPRE) + (size_t)(tl0 + trow) * 2048 + vcol + 4 * fq; \
          _Pragma("unroll") for (int vt = 0; vt < 2; ++vt) { u32x2 o; o.x = pk2(acc[vt][0], acc[vt][1]); o.y = pk2(acc[vt][2], acc[vt][3]); *(GAS u32x2*)(hn + vt * 16) = o; } \
          if (sl == 0 && fq == 0) ((GAS float*)(ws + WS_DEN))[(tg0 + trow) * 4 + h] = acc[2][0]; \
          if (PAR_) WRITEX(pf, 3, (PAR_) ^ 1); else WRITEX(pfB, 3, (PAR_) ^ 1); LDS_BAR(); } \
          \
        { if (PAR_) LOADX(pf, 0, cn); else LOADX(pfB, 0, cn); \
          const float dec = DEC[(c_)]; \
          _Pragma("unroll") for (int dt = 0; dt < 2; ++dt) _Pragma("unroll") for (int vt = 0; vt < 3; ++vt) st[dt][vt] = st[dt][vt] * dec; \
          _Pragma("unroll") for (int ks = 0; ks < 2; ++ks) _Pragma("unroll") for (int dt = 0; dt < 2; ++dt) { const bf16x8 aK = FRAG128((PAR_) ^ 1, wave * 32 + dt * 16 + fr, ks); \
              _Pragma("unroll") for (int vt = 0; vt < 3; ++vt) st[dt][vt] = MFMA16(aK, vf[vt][ks], st[dt][vt]); } \
          if (PAR_) WRITEX(pfB, 4, (PAR_)); else WRITEX(pf, 4, (PAR_)); LDS_BAR(); } \
          \
        { if (PAR_) LOADX(pfB, 1, cn); else LOADX(pf, 1, cn); const u32x4 vreg = *(const GAS u32x4*)(Vg0 + (size_t)cn * 128 * 2048); \
          _Pragma("unroll") for (int ks = 0; ks < 2; ++ks) _Pragma("unroll") for (int dt = 0; dt < 2; ++dt) { const bf16x8 aK = FRAG128((PAR_), wave * 32 + dt * 16 + fr, ks); \
              _Pragma("unroll") for (int vt = 0; vt < 3; ++vt) st[dt][vt] = MFMA16(aK, vf[vt][2 + ks], st[dt][vt]); } \
          _Pragma("unroll") for (int dt = 0; dt < 2; ++dt) _Pragma("unroll") for (int vt = 0; vt < 3; ++vt) { u32x2 o; o.x = pk2(st[dt][vt][0], st[dt][vt][1]); o.y = pk2(st[dt][vt][2], st[dt][vt][3]); \
              *(LAS u32x2*)(ctn + (vt * 16 + fr) * PQ_PITCH + (wave * 32 + dt * 16 + 4 * fq) * 2) = o; } \
          if (PAR_) WRITEX(pf, 0, (PAR_) ^ 1); else WRITEX(pfB, 0, (PAR_) ^ 1); V_STAGE((c_) + 1, vreg); LDS_BAR(); } \
    } while (0)
#pragma unroll 1
    for (int c = 0; c < 64; c += 2) { CHUNK(c, 0); CHUNK(c + 1, 1); }
    __syncthreads();
#undef LOADX
#undef WRITEX
#undef CHUNK
#undef SL_LOAD_S
#undef SL_LOAD_Q
#undef SL_LOAD_K
#undef SL_WRITE256
#undef SL_WRITE128
#undef FRAG256
#undef FRAG128
#undef V_STAGE
}

__device__ __forceinline__ void hgrn_scan(const DArgs& a, LAS unsigned char* lds, int round, int p, int sl) {
    const int tid = tid_(), lane = tid & 63, wave = __builtin_amdgcn_readfirstlane(tid >> 6), fr = lane & 15, fq = lane >> 4;
    const int bl = p >> 3, h = p & 7;
    GAS unsigned char* ws = a.ws;
    constexpr int IP = 144, ITB = 32 * IP, STB = 32 * PS_PITCH;
    LAS unsigned char* IT = lds; LAS unsigned char* ST = lds + 2 * ITB;
    for (int i = tid; i < (2 * ITB + 2 * STB) / 4; i += NTHR) ((LAS unsigned*)lds)[i] = 0u;
    __syncthreads();
    f32x4 st[2];
    st[0] = (f32x4){0.f, 0.f, 0.f, 0.f}; st[1] = st[0];
    const int vcol = h * 128 + sl * 32;
    const int is = (tid & 255) >> 2, ipart = tid & 3;
    const int w4 = wave & 3, vtw = wave >> 2;
    const bf16_t* Ag0 = (const bf16_t*)(ws + WS_ATT) + (size_t)(p * 128) * 64 * 64 + (size_t)(w4 * 16 + fr) * 64 + 8 * fq;
    const bf16_t* Qg0 = (const bf16_t*)(ws + WS_QTG) + (size_t)(p * 128) * 64 * 128 + (size_t)(w4 * 16 + fr) * 128 + 8 * fq;
    const bf16_t* Kg0 = (const bf16_t*)(ws + WS_KENDT) + (size_t)(p * 128) * 128 * 64 + (size_t)(wave * 16 + fr) * 64 + 8 * fq;
    const float* Dg0 = (const float*)(ws + WS_HGDEC) + (size_t)(p * 128) * 128 + wave * 16 + 4 * fq;
    const bf16_t* Ig0 = (const bf16_t*)(ws + WS_GI) + (size_t)(bl * SEQ + is) * 1024 + vcol + ipart * 8;
    bf16x8 bA[2], bQ[4], aK[2]; f32x4 dec; u32x4 ireg;
    ireg = *(const u32x4*)(Ig0);
#pragma unroll
    for (int ks = 0; ks < 2; ++ks) bA[ks] = *(const bf16x8*)(Ag0 + ks * 32);
#pragma unroll
    for (int ks = 0; ks < 4; ++ks) bQ[ks] = *(const bf16x8*)(Qg0 + ks * 32);
#pragma unroll
    for (int ks = 0; ks < 2; ++ks) aK[ks] = *(const bf16x8*)(Kg0 + ks * 32);
    dec = *(const f32x4*)(Dg0);
#pragma unroll 1
    for (int c = 0; c < 128; ++c) {
        const int tl0 = bl * SEQ + c * 64;
        const int cn = c < 127 ? c + 1 : 127;
        LAS unsigned char* it_ = IT + (c & 1) * ITB; LAS unsigned char* st_ = ST + (c & 1) * STB; LAS unsigned char* stn = ST + ((c + 1) & 1) * STB;
        {
            if (tid < 256) {
                LAS unsigned char* d0 = it_ + (ipart * 8) * IP + is * 2;
                *(LAS bf16_t*)(d0 + 0 * IP) = (bf16_t)(ireg.x & 0xffffu); *(LAS bf16_t*)(d0 + 1 * IP) = (bf16_t)(ireg.x >> 16);
                *(LAS bf16_t*)(d0 + 2 * IP) = (bf16_t)(ireg.y & 0xffffu); *(LAS bf16_t*)(d0 + 3 * IP) = (bf16_t)(ireg.y >> 16);
                *(LAS bf16_t*)(d0 + 4 * IP) = (bf16_t)(ireg.z & 0xffffu); *(LAS bf16_t*)(d0 + 5 * IP) = (bf16_t)(ireg.z >> 16);
                *(LAS bf16_t*)(d0 + 6 * IP) = (bf16_t)(ireg.w & 0xffffu); *(LAS bf16_t*)(d0 + 7 * IP) = (bf16_t)(ireg.w >> 16); }
            ireg = *(const u32x4*)(Ig0 + (size_t)cn * 64 * 1024);
        }
        LDS_BAR();
        bf16x8 itf[2][2];
#pragma unroll
        for (int vt = 0; vt < 2; ++vt)
#pragma unroll
            for (int ks = 0; ks < 2; ++ks) itf[vt][ks] = lfrag(it_, IP, vt * 16 + fr, ks * 32, fq);
        {
            bf16x8 sf[4];
#pragma unroll
            for (int ks = 0; ks < 4; ++ks) sf[ks] = lfrag(st_, PS_PITCH, vtw * 16 + fr, ks * 32, fq);
            f32x4 acc = (f32x4){0.f, 0.f, 0.f, 0.f};
#pragma unroll
            for (int ks = 0; ks < 2; ++ks) acc = MFMA16(vtw ? itf[1][ks] : itf[0][ks], bA[ks], acc);
#pragma unroll
            for (int ks = 0; ks < 4; ++ks) acc = MFMA16(sf[ks], bQ[ks], acc);
            __builtin_amdgcn_sched_barrier(0);
#pragma unroll
            for (int ks = 0; ks < 2; ++ks) bA[ks] = *(const bf16x8*)(Ag0 + (size_t)cn * 64 * 64 + ks * 32);
#pragma unroll
            for (int ks = 0; ks < 4; ++ks) bQ[ks] = *(const bf16x8*)(Qg0 + (size_t)cn * 64 * 128 + ks * 32);
            u32x2 o; o.x = pk2(acc[0], acc[1]); o.y = pk2(acc[2], acc[3]);
            *(u32x2*)((bf16_t*)(ws + WS_GQ) + (size_t)(tl0 + w4 * 16 + fr) * 1024 + vcol + vtw * 16 + 4 * fq) = o;
        }
        {
#pragma unroll
            for (int vt = 0; vt < 2; ++vt) { st[vt] = st[vt] * dec;
#pragma unroll
                for (int ks = 0; ks < 2; ++ks) st[vt] = MFMA16(aK[ks], itf[vt][ks], st[vt]); }
            __builtin_amdgcn_sched_barrier(0);
#pragma unroll
            for (int ks = 0; ks < 2; ++ks) aK[ks] = *(const bf16x8*)(Kg0 + (size_t)cn * 128 * 64 + ks * 32);
            dec = *(const f32x4*)(Dg0 + (size_t)cn * 128);
#pragma unroll
            for (int vt = 0; vt < 2; ++vt) { u32x2 o; o.x = pk2(st[vt][0], st[vt][1]); o.y = pk2(st[vt][2], st[vt][3]);
                *(LAS u32x2*)(stn + (vt * 16 + fr) * PS_PITCH + (wave * 16 + 4 * fq) * 2) = o; }
        }
    }
    __syncthreads();
}

__device__ __forceinline__ void phase_ypass(const DArgs& a, int round, int vcu, int G) {
    const int tid = tid_(), lane = tid & 63, wave = tid >> 6;
    const int gw = vcu * NWAVES + wave, NGW = G * NWAVES;
    GAS unsigned char* ws = a.ws;
    f32x4 mg0[4], mg1[4], gg4[4];
#pragma unroll
    for (int j = 0; j < 4; ++j) { mg0[j] = *(const GAS f32x4*)(a.m_head_g + j * 512 + lane * 8); mg1[j] = *(const GAS f32x4*)(a.m_head_g + j * 512 + lane * 8 + 4); gg4[j] = *(const GAS f32x4*)(a.g_head_g + lane * 16 + 4 * j); }
    for (int tl = gw; tl < RT; tl += NGW) {
        const size_t tg = (size_t)round * RT + tl;
        const f32x4 den4 = *(const f32x4*)((const float*)(ws + WS_DEN) + tg * 4), mt4 = *(const f32x4*)((const float*)(ws + WS_MT) + tg * 4);
#pragma unroll
        for (int j = 0; j < 4; ++j) {
            const int col = j * 512 + lane * 8;
            const u32x4 nv = *(const u32x4*)((const bf16_t*)(ws + WS_QKPRE) + (size_t)tl * 2048 + col);
            const u32x4 ov = *(const u32x4*)((const bf16_t*)(ws + WS_SIGO) + (size_t)tl * 2048 + col);
            const float inv = 1.0f / fmaxf(fabsf(den4[j]), __expf(-mt4[j]));
            float hv[8] = {bf_lo(nv.x) * inv, bf_hi(nv.x) * inv, bf_lo(nv.y) * inv, bf_hi(nv.y) * inv, bf_lo(nv.z) * inv, bf_hi(nv.z) * inv, bf_lo(nv.w) * inv, bf_hi(nv.w) * inv};
            float ss = 0.f;
#pragma unroll
            for (int e = 0; e < 8; ++e) ss += hv[e] * hv[e];
            const float r = rsqrtf(wave_sum(ss, lane) * (1.f / 512.f) + EPS);
            const f32x4 g0 = mg0[j], g1 = mg1[j];
            const float og[8] = {bf_lo(ov.x), bf_hi(ov.x), bf_lo(ov.y), bf_hi(ov.y), bf_lo(ov.z), bf_hi(ov.z), bf_lo(ov.w), bf_hi(ov.w)};
            float y[8];
#pragma unroll
            for (int e = 0; e < 8; ++e) y[e] = og[e] * hv[e] * r * (e < 4 ? g0[e] : g1[e - 4]);
            u32x4 o; o.x = pk2(y[0], y[1]); o.y = pk2(y[2], y[3]); o.z = pk2(y[4], y[5]); o.w = pk2(y[6], y[7]);
            *(u32x4*)((bf16_t*)(ws + WS_V) + (size_t)tl * 2048 + col) = o;
        }
        {
            const int col = lane * 16;
            const u32x4 n0 = *(const u32x4*)((const bf16_t*)(ws + WS_GQ) + (size_t)tl * 1024 + col), n1 = *(const u32x4*)((const bf16_t*)(ws + WS_GQ) + (size_t)tl * 1024 + col + 8);
            const u32x4 s0 = *(const u32x4*)((const bf16_t*)(ws + WS_SGG) + (size_t)tl * 1024 + col), s1 = *(const u32x4*)((const bf16_t*)(ws + WS_SGG) + (size_t)tl * 1024 + col + 8);
            float ov[16] = {bf_lo(n0.x), bf_hi(n0.x), bf_lo(n0.y), bf_hi(n0.y), bf_lo(n0.z), bf_hi(n0.z), bf_lo(n0.w), bf_hi(n0.w), bf_lo(n1.x), bf_hi(n1.x), bf_lo(n1.y), bf_hi(n1.y), bf_lo(n1.z), bf_hi(n1.z), bf_lo(n1.w), bf_hi(n1.w)};
            const float sg[16] = {bf_lo(s0.x), bf_hi(s0.x), bf_lo(s0.y), bf_hi(s0.y), bf_lo(s0.z), bf_hi(s0.z), bf_lo(s0.w), bf_hi(s0.w), bf_lo(s1.x), bf_hi(s1.x), bf_lo(s1.y), bf_hi(s1.y), bf_lo(s1.z), bf_hi(s1.z), bf_lo(s1.w), bf_hi(s1.w)};
            float ss = 0.f;
#pragma unroll
            for (int e = 0; e < 16; ++e) ss += ov[e] * ov[e];
            ss += DPP_(ss, 0xB1); ss += DPP_(ss, 0x4E); ss += DPP_(ss, 0x141);
            const float r = rsqrtf(ss * (1.f / 128.f) + EPS);
            float y[16];
#pragma unroll
            for (int e = 0; e < 16; ++e) y[e] = ov[e] * r * gg4[e >> 2][e & 3] * sg[e];
            u32x4 o; o.x = pk2(y[0], y[1]); o.y = pk2(y[2], y[3]); o.z = pk2(y[4], y[5]); o.w = pk2(y[6], y[7]);
            *(u32x4*)((bf16_t*)(ws + WS_GI) + (size_t)tl * 1024 + col) = o;
            o.x = pk2(y[8], y[9]); o.y = pk2(y[10], y[11]); o.z = pk2(y[12], y[13]); o.w = pk2(y[14], y[15]);
            *(u32x4*)((bf16_t*)(ws + WS_GI) + (size_t)tl * 1024 + col + 8) = o;
        }
    }
}


#define XB_TMO      128
#define XB_XCNT(j)  (256  + 64 * (j))
#define XB_XSUB(j)  (1280 + 64 * (j))
#define XB_XGEN(j)  (2304 + 64 * (j))
#define XB_TOP      3328
#define XB_TOPGEN   3392
#define XB_SPIN_CAP (1u << 22)
constexpr int CW_BAR = 4096;
constexpr int LDS_BARST = LDS_BYTES - 64;
__device__ __forceinline__ unsigned xb_ld(unsigned* p)              { return __hip_atomic_load(p, __ATOMIC_RELAXED, __HIP_MEMORY_SCOPE_AGENT); }
__device__ __forceinline__ unsigned xb_add(unsigned* p, unsigned v) { return __hip_atomic_fetch_add(p, v, __ATOMIC_RELAXED, __HIP_MEMORY_SCOPE_AGENT); }
__device__ __forceinline__ unsigned xb_xcc_id() { return (unsigned)__builtin_amdgcn_s_getreg((3 << 11) | 20) & 0xFu; }
#define XB_SPIN(cond, bar) do { unsigned _sp = 0; while (cond) { __builtin_amdgcn_s_sleep(1); \
    if ((++_sp & 255u) == 0u) { if (xb_ld(&(bar)[XB_TMO])) break; if (_sp > XB_SPIN_CAP) { atomicAdd(&(bar)[XB_TMO], 1u); break; } } } } while (0)
__device__ __forceinline__ void xcd_barrier_post(unsigned* bar, volatile LAS unsigned* st) { if (tid_() == 0) st[2] = xb_add(&bar[XB_XCNT(xb_xcc_id())], 1u); }
__device__ __forceinline__ void xcd_barrier_complete(unsigned* bar, unsigned x, unsigned& nloc, unsigned& nx) {
    const unsigned G = gridDim.x;
    unsigned sum, cnt, mine, sp = 0u;
    for (;;) {
        sum = 0u; cnt = 0u; mine = 0u;
#pragma unroll
        for (unsigned j = 0; j < 16; ++j) { const unsigned c = xb_ld(&bar[XB_XCNT(j)]); sum += c; cnt += (c > 0u) ? 1u : 0u; mine = (j == x) ? c : mine; }
        if (sum == G) break;
        __builtin_amdgcn_s_sleep(1);
        if ((++sp & 255u) == 0u) { if (xb_ld(&bar[XB_TMO])) break; if (sp > XB_SPIN_CAP) { atomicAdd(&bar[XB_TMO], 1u); break; } }
    }
    nloc = mine > 0u ? mine : 1u; nx = cnt > 0u ? cnt : 1u;
}
__device__ __forceinline__ void xcd_barrier(unsigned* bar, volatile LAS unsigned* st) {
    asm volatile("s_waitcnt vmcnt(0)" ::: "memory");
    __syncthreads();
    if (tid_() == 0) {
        const unsigned x = xb_xcc_id();
        __builtin_amdgcn_s_waitcnt(0);
        unsigned nloc = st[0], nx = st[1];
        if (nloc == 0u) { xcd_barrier_complete(bar, x, nloc, nx); st[0] = nloc; st[1] = nx; }
        const unsigned old = xb_add(&bar[XB_XSUB(x)], 1u);
        const unsigned gen = old / nloc;
        if (old + 1u == (gen + 1u) * nloc) {
            __builtin_amdgcn_fence(__ATOMIC_RELEASE, "agent");
            asm volatile("s_waitcnt vmcnt(0)" ::: "memory");
            const unsigned og = xb_add(&bar[XB_TOP], 1u);
            const unsigned tg = og / nx;
            if (og + 1u == (tg + 1u) * nx) xb_add(&bar[XB_TOPGEN], 1u);
            else XB_SPIN(xb_ld(&bar[XB_TOPGEN]) == tg, bar);
            __builtin_amdgcn_fence(__ATOMIC_ACQUIRE, "agent");
            xb_add(&bar[XB_XGEN(x)], 1u);
            asm volatile("s_waitcnt vmcnt(0)" ::: "memory");
        } else {
            XB_SPIN(xb_ld(&bar[XB_XGEN(x)]) == gen, bar);
            __builtin_amdgcn_fence(__ATOMIC_ACQUIRE, "agent");
            asm volatile("s_waitcnt vmcnt(0)" ::: "memory");
        }
    }
    __syncthreads();
}

__device__ __forceinline__ void phase_p8(const DArgs& a, int vcu, int G) {
    const int tid = tid_(), lane = tid & 63, wave = tid >> 6;
    const int gw = vcu * NWAVES + wave, NGW = G * NWAVES;
    GAS unsigned char* ws = a.ws;
    f32x4 g2[4];
#pragma unroll
    for (int j = 0; j < 4; ++j) g2[j] = ((const f32x4*)a.norm2_g)[64 * j + lane];
    for (int m = gw; m < T; m += NGW) {
        const f32x4* xr = (const f32x4*)(a.out + (size_t)m * D) + lane;
        f32x4 v[4]; float s = 0.f;
#pragma unroll
        for (int j = 0; j < 4; ++j) { v[j] = xr[64 * j]; s += (v[j][0] * v[j][0] + v[j][1] * v[j][1]) + (v[j][2] * v[j][2] + v[j][3] * v[j][3]); }
        const float rstd = rsqrtf(wave_sum(s, lane) * (1.f / D) + EPS);
        unsigned long long* o8 = (unsigned long long*)((bf16_t*)(ws + WS_XN) + (size_t)m * D) + lane;
#pragma unroll
        for (int j = 0; j < 4; ++j) { v[j] = v[j] * rstd * g2[j]; o8[64 * j] = (unsigned long long)pk2(v[j][0], v[j][1]) | ((unsigned long long)pk2(v[j][2], v[j][3]) << 32); }
    }
    {
        const float mu = __builtin_bit_cast(float, ((const GAS unsigned*)(ws + WS_CTL))[CW_TMAX]), mv = __builtin_bit_cast(float, ((const GAS unsigned*)(ws + WS_CTL))[CW_TMAX + 1]);
        const float su = mu > 0.f ? 448.0f / mu : 1.0f, sv = mv > 0.f ? 448.0f / mv : 1.0f;
        if (vcu == 0 && tid == 0) { ((GAS float*)(ws + WS_USC))[0] = 1.0f / su; ((GAS float*)(ws + WS_USC))[1] = 1.0f / sv; }
        for (size_t i = (size_t)vcu * NTHR + tid; i < (size_t)16384 * 1024 / 8; i += (size_t)G * NTHR) {
            const f32x4 u0 = ((const GAS f32x4*)a.u_emb)[2 * i], u1 = ((const GAS f32x4*)a.u_emb)[2 * i + 1];
            const f32x4 v0 = ((const GAS f32x4*)a.v_emb)[2 * i], v1 = ((const GAS f32x4*)a.v_emb)[2 * i + 1];
            u32x2 o; int p;
            p = __builtin_amdgcn_cvt_pk_fp8_f32(u0[0] * su, u0[1] * su, 0, false); p = __builtin_amdgcn_cvt_pk_fp8_f32(u0[2] * su, u0[3] * su, p, true); o.x = (unsigned)p;
            p = __builtin_amdgcn_cvt_pk_fp8_f32(u1[0] * su, u1[1] * su, 0, false); p = __builtin_amdgcn_cvt_pk_fp8_f32(u1[2] * su, u1[3] * su, p, true); o.y = (unsigned)p;
            ((GAS u32x2*)(ws + WS_UB))[i] = o;
            p = __builtin_amdgcn_cvt_pk_fp8_f32(v0[0] * sv, v0[1] * sv, 0, false); p = __builtin_amdgcn_cvt_pk_fp8_f32(v0[2] * sv, v0[3] * sv, p, true); o.x = (unsigned)p;
            p = __builtin_amdgcn_cvt_pk_fp8_f32(v1[0] * sv, v1[1] * sv, 0, false); p = __builtin_amdgcn_cvt_pk_fp8_f32(v1[2] * sv, v1[3] * sv, p, true); o.y = (unsigned)p;
            ((GAS u32x2*)(ws + WS_VB))[i] = o;
        }
    }
}

__device__ __forceinline__ unsigned f2ord(float f) { const unsigned u = __builtin_bit_cast(unsigned, f); return (u & 0x80000000u) ? ~u : (u | 0x80000000u); }
__device__ __forceinline__ float ord2f(unsigned k) { const unsigned u = (k & 0x80000000u) ? (k & 0x7fffffffu) : ~k; return __builtin_bit_cast(float, u); }
__device__ __forceinline__ unsigned umax_(unsigned a, unsigned b) { return a > b ? a : b; }
__device__ __forceinline__ unsigned shxu(unsigned v, int o, int lane) { return (unsigned)__builtin_amdgcn_ds_bpermute((lane ^ o) << 2, (int)v); }

__device__ __forceinline__ void phase_topk(const DArgs& a, LAS unsigned char* lds, int bx, int G) {
    const int tid = tid_(), lane = tid & 63, wave = __builtin_amdgcn_readfirstlane(tid >> 6), fr = lane & 15, fq = lane >> 4;
    GAS unsigned char* ws = a.ws;
    const int h = bx & 7;
    LAS unsigned char* KY = lds;
    LAS unsigned char* QL = lds + 2 * 128 * PS_PITCH;
    LAS unsigned* TOP = (LAS unsigned*)(lds + 2 * 128 * PS_PITCH + 64 * PQ_PITCH);
#pragma unroll
    for (int i = 0; i < 8; ++i) { const int idx = tid + 512 * i, row = idx >> 4, ch = idx & 15;
        *(LAS u32x4*)(KY + row * PS_PITCH + ch * 16) = *(const u32x4*)((const bf16_t*)(ws + WS_SK) + ((size_t)h * 256 + row) * 128 + ch * 8); }
    const int ntile = T / 64;
    for (int tile = bx >> 3; tile < ntile; tile += (G >> 3)) {
        const size_t t0 = (size_t)tile * 64;
        __syncthreads();
#pragma unroll
        for (int i = 0; i < 4; ++i) { const int idx = tid + 512 * i, row = idx >> 5, ch = idx & 31;
            *(LAS u32x4*)(QL + row * PQ_PITCH + ch * 16) = *(const u32x4*)((const bf16_t*)(ws + WS_QP) + (t0 + row) * 2048 + h * 256 + ch * 8); }
        __syncthreads();
        {
            const int mt = wave & 3, p = wave >> 2;
            unsigned key[32];
#pragma unroll
            for (int nt = 0; nt < 8; ++nt) { f32x4 acc = (f32x4){0.f, 0.f, 0.f, 0.f};
#pragma unroll
                for (int ks = 0; ks < 4; ++ks) acc = MFMA16(lfrag(KY + p * 128 * PS_PITCH, PS_PITCH, nt * 16 + fr, ks * 32, fq), lfrag(QL, PQ_PITCH, mt * 16 + fr, p * 128 + ks * 32, fq), acc);
#pragma unroll
                for (int j = 0; j < 4; ++j) { const int n = nt * 16 + 4 * fq + j; key[nt * 4 + j] = (f2ord(acc[j]) & ~127u) | (unsigned)(127 - n); } }
#pragma unroll 1
            for (int k = 0; k < 16; ++k) {
                unsigned m = key[0];
#pragma unroll
                for (int e = 1; e < 32; ++e) m = umax_(m, key[e]);
                m = umax_(m, (unsigned)SWZI_(m, 0x401F)); m = umax_(m, xor32u_(m, lane >= 32));
#pragma unroll
                for (int e = 0; e < 32; ++e) key[e] = (key[e] == m) ? 0u : key[e];
                if (fq == (k & 3)) TOP[(p * 64 + mt * 16 + fr) * 16 + k] = m;
            }
        }
        __syncthreads();
        {
            const int t = tid >> 3, sub = tid & 7;
            unsigned ck[7];
#pragma unroll
            for (int e = 0; e < 7; ++e) {
                const int ci = sub + 8 * e;
                int i = 0, base = 0; bool ok = ci < 50;
                if (ci >= 42) { i = 8 + (ci - 42); base = ci; } else if (ci >= 40) { i = 7; base = 40; } else if (ci >= 38) { i = 6; base = 38; } else if (ci >= 36) { i = 5; base = 36; }
                else if (ci >= 33) { i = 4; base = 33; } else if (ci >= 29) { i = 3; base = 29; } else if (ci >= 24) { i = 2; base = 24; } else if (ci >= 16) { i = 1; base = 16; }
                const int j = ci - base;
                unsigned kk = 0u;
                if (ok) { const float s0 = ord2f(TOP[(0 * 64 + t) * 16 + i] & ~127u), s1 = ord2f(TOP[(1 * 64 + t) * 16 + j] & ~127u);
                    kk = (f2ord(s0 + s1) & ~255u) | (unsigned)(255 - (i * 16 + j)); }
                ck[e] = kk;
            }
            unsigned w0 = 0u, w1 = 0u;
#pragma unroll 1
            for (int k = 0; k < 16; ++k) {
                unsigned m = ck[0];
#pragma unroll
                for (int e = 1; e < 7; ++e) m = umax_(m, ck[e]);
                m = umax_(m, (unsigned)DPPI_(m, 0xB1)); m = umax_(m, (unsigned)DPPI_(m, 0x4E)); m = umax_(m, (unsigned)DPPI_(m, 0x141));
#pragma unroll
                for (int e = 0; e < 7; ++e) ck[e] = (ck[e] == m) ? 0u : ck[e];
                if (k == sub) w0 = m; if (k == sub + 8) w1 = m;
            }
            const int f0 = 255 - (int)(w0 & 255u), f1 = 255 - (int)(w1 & 255u);
            const float sc0 = ord2f(w0 & ~255u), sc1 = ord2f(w1 & ~255u);
            float mx = fmaxf(sc0, sc1); mx = fmaxf(mx, DPP_(mx, 0xB1)); mx = fmaxf(mx, DPP_(mx, 0x4E)); mx = fmaxf(mx, DPP_(mx, 0x141));
            const float e0 = __expf(sc0 - mx), e1 = __expf(sc1 - mx);
            float sm = e0 + e1; sm += DPP_(sm, 0xB1); sm += DPP_(sm, 0x4E); sm += DPP_(sm, 0x141);
            const float inv = 1.0f / sm;
            const int i0 = 127 - (int)(TOP[(0 * 64 + t) * 16 + (f0 >> 4)] & 127u), j0 = 127 - (int)(TOP[(1 * 64 + t) * 16 + (f0 & 15)] & 127u);
            const int i1 = 127 - (int)(TOP[(0 * 64 + t) * 16 + (f1 >> 4)] & 127u), j1 = 127 - (int)(TOP[(1 * 64 + t) * 16 + (f1 & 15)] & 127u);
            int* ei = (int*)(ws + WS_EIDX) + ((t0 + t) * 8 + h) * 16; float* gp = (float*)(ws + WS_GATE) + ((t0 + t) * 8 + h) * 16;
            ei[sub] = i0 * 128 + j0; ei[sub + 8] = i1 * 128 + j1; gp[sub] = e0 * inv; gp[sub + 8] = e1 * inv;
        }
    }
    __syncthreads();
}

__device__ __forceinline__ void ins16(float (&v)[16], int (&id)[16], float x, int n) {
    if (x > v[15]) { v[15] = x; id[15] = n;
#pragma unroll
        for (int i = 15; i >= 1; --i) { if (v[i] > v[i - 1]) { const float tv = v[i]; v[i] = v[i - 1]; v[i - 1] = tv; const int ti = id[i]; id[i] = id[i - 1]; id[i - 1] = ti; } } }
}
__device__ __forceinline__ void phase_topk_ref(const DArgs& a, int vcu, int G) {
    const int tid = tid_();
    GAS unsigned char* ws = a.ws;
    const int gt = vcu * NTHR + tid, NGT = G * NTHR;
    for (int pair = gt; pair < T * 8; pair += NGT) {
        const int t = pair >> 3, h = pair & 7;
        float sv[2][16]; int si[2][16];
#pragma unroll
        for (int p = 0; p < 2; ++p) {
#pragma unroll
            for (int i = 0; i < 16; ++i) { sv[p][i] = -INFINITY; si[p][i] = 0; }
            const bf16_t* qp = (const bf16_t*)(ws + WS_QP) + (size_t)t * 2048 + h * 256 + p * 128;
            for (int n = 0; n < 128; ++n) {
                const bf16_t* kp = (const bf16_t*)(ws + WS_SK) + ((size_t)(h * 2 + p) * 128 + n) * 128;
                float s = 0.f;
                for (int c = 0; c < 128; c += 8) { const u32x4 qv = *(const u32x4*)(qp + c), kv = *(const u32x4*)(kp + c);
                    s += bf_lo(qv.x) * bf_lo(kv.x) + bf_hi(qv.x) * bf_hi(kv.x) + bf_lo(qv.y) * bf_lo(kv.y) + bf_hi(qv.y) * bf_hi(kv.y)
                       + bf_lo(qv.z) * bf_lo(kv.z) + bf_hi(qv.z) * bf_hi(kv.z) + bf_lo(qv.w) * bf_lo(kv.w) + bf_hi(qv.w) * bf_hi(kv.w); }
                ins16(sv[p], si[p], s, n);
            }
        }
        float tv[16]; int ti[16];
#pragma unroll
        for (int i = 0; i < 16; ++i) { tv[i] = -INFINITY; ti[i] = 0; }
#pragma unroll
        for (int i = 0; i < 16; ++i)
#pragma unroll
            for (int j = 0; j < 16; ++j) ins16(tv, ti, sv[0][i] + sv[1][j], i * 16 + j);
        float sm = 0.f, ex[16];
#pragma unroll
        for (int k = 0; k < 16; ++k) { ex[k] = __expf(tv[k] - tv[0]); sm += ex[k]; }
        int* ei = (int*)(ws + WS_EIDX) + (size_t)pair * 16; float* gp = (float*)(ws + WS_GATE) + (size_t)pair * 16;
#pragma unroll
        for (int k = 0; k < 16; ++k) {
            int e0 = 0, e1 = 0;
#pragma unroll
            for (int i = 0; i < 16; ++i) { e0 = ((ti[k] >> 4) == i) ? si[0][i] : e0; e1 = ((ti[k] & 15) == i) ? si[1][i] : e1; }
            ei[k] = e0 * 128 + e1; gp[k] = ex[k] / sm; }
    }
}

#define FP8LO(w) __builtin_amdgcn_cvt_pk_f32_fp8((int)(w), false)
#define FP8HI(w) __builtin_amdgcn_cvt_pk_f32_fp8((int)(w), true)
__device__ __forceinline__ float dot16_fp8(const u32x4 r, const float (&x)[16]) {
    float c = 0.f;
#pragma unroll
    for (int j = 0; j < 4; ++j) { const f32x2 lo = FP8LO(r[j]), hi = FP8HI(r[j]); c += lo[0] * x[4 * j] + lo[1] * x[4 * j + 1] + hi[0] * x[4 * j + 2] + hi[1] * x[4 * j + 3]; }
    return c;
}
__device__ __forceinline__ float gelu_erf(float d) {
    const float ad = fabsf(d), t = __builtin_amdgcn_rcpf(ad * 0.2316418882f + 1.0f);
    float q = t * 0.5307027145f + (-0.7265760135f); q = q * t + 0.7107068705f; q = q * t + (-0.142248368f); q = q * t + 0.127414796f; q = q * t;
    const float m = d * (q * __builtin_amdgcn_exp2f(d * d * (-0.72134752044f)));
    return d < 0.f ? m : d - m;
}
__device__ __forceinline__ float bperm(float v, int srclane) { return __builtin_bit_cast(float, __builtin_amdgcn_ds_bpermute(srclane << 2, __builtin_bit_cast(int, v))); }
#define SWZ_(v, pat) __builtin_bit_cast(float, __builtin_amdgcn_ds_swizzle(__builtin_bit_cast(int, (v)), (pat)))
__device__ __forceinline__ float xor32_(float v, bool hi) {
#if defined(__HIP_DEVICE_COMPILE__)
    const auto r = __builtin_amdgcn_permlane32_swap(__builtin_bit_cast(unsigned, v), __builtin_bit_cast(unsigned, v), false, false);
    return __builtin_bit_cast(float, hi ? r[0] : r[1]);
#else
    (void)hi; return v;
#endif
}
__device__ __forceinline__ float reduce8(const float (&p)[8], int lane) {
    float q4[4], q2[2];
    const bool b5 = lane & 32, b4 = lane & 16, b3 = lane & 8;
#pragma unroll
    for (int i = 0; i < 4; ++i) { const float send = b5 ? p[i] : p[i + 4], keep = b5 ? p[i + 4] : p[i]; q4[i] = keep + xor32_(send, b5); }
#pragma unroll
    for (int i = 0; i < 2; ++i) { const float send = b4 ? q4[i] : q4[i + 2], keep = b4 ? q4[i + 2] : q4[i]; q2[i] = keep + SWZ_(send, 0x401F); }
    const float send = b3 ? q2[0] : q2[1], keep = b3 ? q2[1] : q2[0];
    float q1 = keep + SWZ_(send, 0x201F);
    q1 += DPP_(q1, 0xB1); q1 += DPP_(q1, 0x4E); q1 += DPP_(q1, 0x141);
    return q1;
}
__device__ __forceinline__ void phase_udots(const DArgs& a, LAS unsigned char* lds) {
    const int tid = tid_(), lane = tid & 63, wave = __builtin_amdgcn_readfirstlane(tid >> 6);
    GAS unsigned char* ws = a.ws;
    volatile LAS unsigned* bst = (volatile LAS unsigned*)(lds + LDS_BARST);
    const int nloc = (int)bst[0], nx = (int)bst[1], rank = (int)bst[2];
    unsigned* bar = (unsigned*)(ws + WS_CTL) + CW_BAR;
    const unsigned myx = xb_xcc_id();
    int q = 0;
    for (unsigned j = 0; j < 16; ++j) { const unsigned c = xb_ld(&bar[XB_XCNT(j)]); if (c > 0u && j < myx) ++q; }
    LAS int* LE = (LAS int*)(lds + wave * 2048);
    LAS int* LP = LE + 128; LAS float* LG = (LAS float*)(LE + 256);
    const GAS unsigned char* UB = ws + WS_UB;
    const int g8 = lane >> 3;
    const float usc = ((const GAS float*)(ws + WS_USC))[0], vsc = ((const GAS float*)(ws + WS_USC))[1];
    for (int s = q; s < 8; s += nx) {
        int tok = rank * 8 + wave;
        u32x4 xq0 = (u32x4){0u, 0u, 0u, 0u}, xq1 = xq0; u32x2 e2 = (u32x2){0u, 0u}; f32x2 g2 = (f32x2){0.f, 0.f};
#define U_INFO(t_) do { xq0 = *(const u32x4*)((const GAS bf16_t*)(ws + WS_XN) + (size_t)(t_) * D + lane * 16); xq1 = *(const u32x4*)((const GAS bf16_t*)(ws + WS_XN) + (size_t)(t_) * D + lane * 16 + 8); \
        e2 = *(const u32x2*)((const GAS int*)(ws + WS_EIDX) + (size_t)(t_) * 128 + 2 * lane); g2 = *(const f32x2*)((const GAS float*)(ws + WS_GATE) + (size_t)(t_) * 128 + 2 * lane); } while (0)
        if (tok < T) U_INFO(tok);
        for (; tok < T; tok += nloc * 8) {
            const bool in0 = (int)(e2.x >> 11) == s, in1 = (int)(e2.y >> 11) == s;
            const unsigned long long m0 = __ballot(in0), m1 = __ballot(in1);
            const unsigned long long lt = (1ull << lane) - 1ull;
            const int n0 = __popcll(m0), n = n0 + __popcll(m1);
            if (in0) { const int pos = __popcll(m0 & lt); LE[pos] = (int)e2.x; LP[pos] = 2 * lane; LG[pos] = g2[0]; }
            if (in1) { const int pos = n0 + __popcll(m1 & lt); LE[pos] = (int)e2.y; LP[pos] = 2 * lane + 1; LG[pos] = g2[1]; }
            const float xf[16] = {bf_lo(xq0.x), bf_hi(xq0.x), bf_lo(xq0.y), bf_hi(xq0.y), bf_lo(xq0.z), bf_hi(xq0.z), bf_lo(xq0.w), bf_hi(xq0.w),
                                  bf_lo(xq1.x), bf_hi(xq1.x), bf_lo(xq1.y), bf_hi(xq1.y), bf_lo(xq1.z), bf_hi(xq1.z), bf_lo(xq1.w), bf_hi(xq1.w)};
            asm volatile("s_waitcnt lgkmcnt(0)" ::: "memory");
            u32x4 R0[8], R1[8], R2[8];
#define U_ISSUE(R_, g0_) do { _Pragma("unroll") for (int k = 0; k < 8; ++k) { const int slot_ = ((g0_) + k < n) ? (g0_) + k : n - 1; const int e_ = LE[slot_]; R_[k] = *(const u32x4*)(UB + (size_t)e_ * 1024 + lane * 16); } } while (0)
#define U_DOTS(R_, g0_) do { float pp_[8]; _Pragma("unroll") for (int k = 0; k < 8; ++k) pp_[k] = dot16_fp8(R_[k], xf); const float dsum_ = reduce8(pp_, lane); const int slot_ = (g0_) + g8; \
            if (slot_ < n && (lane & 7) == 0) { const float d_ = dsum_ * usc; \
                ((GAS float*)(ws + WS_PW))[(size_t)tok * 128 + LP[slot_]] = 0.5f * d_ * (1.0f + erff(d_ * 0.70710678118654752f)) * LG[slot_] * vsc; } } while (0)
            if (n > 0) U_ISSUE(R0, 0);
            if (n > 8) U_ISSUE(R1, 8);
            if (n > 16) U_ISSUE(R2, 16);
            const int tokN = tok + nloc * 8;
            if (tokN < T) U_INFO(tokN);
            if (n > 0) U_DOTS(R0, 0);
            if (n > 8) U_DOTS(R1, 8);
            if (n > 16) U_DOTS(R2, 16);
            for (int g0 = 24; g0 < n; g0 += 8) { U_ISSUE(R0, g0); U_DOTS(R0, g0); }
            asm volatile("s_waitcnt lgkmcnt(0)" ::: "memory");
        }
#undef U_INFO
#undef U_ISSUE
#undef U_DOTS
    }
}

struct XcdSlice { int nloc, nx, rank, q; };
__device__ __forceinline__ XcdSlice xcd_slice_setup(const DArgs& a, LAS unsigned char* lds) {
    volatile LAS unsigned* bst = (volatile LAS unsigned*)(lds + LDS_BARST);
    XcdSlice x; x.nloc = (int)bst[0]; x.nx = (int)bst[1]; x.rank = (int)bst[2];
    unsigned* bar = (unsigned*)(a.ws + WS_CTL) + CW_BAR; const unsigned myx = xb_xcc_id();
    x.q = 0; for (unsigned j = 0; j < 16; ++j) { const unsigned c = xb_ld(&bar[XB_XCNT(j)]); if (c > 0u && j < myx) ++x.q; }
    return x;
}
__device__ __forceinline__ void phase_ua(const DArgs& a, LAS unsigned char* lds) {
    const int tid = tid_(), lane = tid & 63, wave = __builtin_amdgcn_readfirstlane(tid >> 6), k = lane >> 3, c = lane & 7;
    GAS unsigned char* ws = a.ws;
    const XcdSlice X = xcd_slice_setup(a, lds);
    const int tstride = X.nloc * 8;
    for (int sl = X.q; sl < 8; sl += X.nx) {
        const GAS unsigned char* UBs = ws + WS_UB + sl * 128 + c * 16;
        GAS float* PU = (GAS float*)(ws + WS_PARTU) + (size_t)sl * T * 128;
        u32x4 ev[4], xq0, xq1;
#define A_INFO(t_) do { _Pragma("unroll") for (int j_ = 0; j_ < 4; ++j_) ev[j_] = *(const GAS u32x4*)((const GAS int*)(ws + WS_EIDX) + (size_t)(t_) * 128 + 16 * k + 4 * j_); \
        xq0 = *(const GAS u32x4*)((const GAS bf16_t*)(ws + WS_XN) + (size_t)(t_) * D + sl * 128 + c * 16); xq1 = *(const GAS u32x4*)((const GAS bf16_t*)(ws + WS_XN) + (size_t)(t_) * D + sl * 128 + c * 16 + 8); } while (0)
        int tok = X.rank * 8 + wave;
        if (tok < T) A_INFO(tok);
        for (; tok < T; tok += tstride) {
            u32x4 R[16];
#pragma unroll
            for (int g = 0; g < 16; ++g) R[g] = *(const GAS u32x4*)(UBs + (size_t)ev[g >> 2][g & 3] * 1024);
            const float xf[16] = {bf_lo(xq0.x), bf_hi(xq0.x), bf_lo(xq0.y), bf_hi(xq0.y), bf_lo(xq0.z), bf_hi(xq0.z), bf_lo(xq0.w), bf_hi(xq0.w),
                                  bf_lo(xq1.x), bf_hi(xq1.x), bf_lo(xq1.y), bf_hi(xq1.y), bf_lo(xq1.z), bf_hi(xq1.z), bf_lo(xq1.w), bf_hi(xq1.w)};
            if (tok + tstride < T) A_INFO(tok + tstride);
            f32x2 res = (f32x2){0.f, 0.f};
#pragma unroll
            for (int g = 0; g < 16; ++g) { float d = dot16_fp8(R[g], xf); d += DPP_(d, 0xB1); d += DPP_(d, 0x4E); d += DPP_(d, 0x141);
                if (c == (g >> 1)) res[g & 1] = d; }
            *(GAS f32x2*)(PU + (size_t)tok * 128 + 2 * lane) = res;
        }
#undef A_INFO
    }
}
__device__ __forceinline__ void phase_ua2(const DArgs& a, int vcu, int G) {
    const int tid = tid_();
    GAS unsigned char* ws = a.ws;
    const float usc = ((const GAS float*)(ws + WS_USC))[0], vsc = ((const GAS float*)(ws + WS_USC))[1];
    const GAS float* PU = (const GAS float*)(ws + WS_PARTU);
    for (size_t i = (size_t)vcu * NTHR + tid; i < (size_t)T * 128 / 4; i += (size_t)G * NTHR) {
        f32x4 d = (f32x4){0.f, 0.f, 0.f, 0.f};
#pragma unroll
        for (int sl = 0; sl < 8; ++sl) d += ((const GAS f32x4*)(PU + (size_t)sl * T * 128))[i];
        const f32x4 gt = ((const GAS f32x4*)(ws + WS_GATE))[i];
        f32x4 w;
#pragma unroll
        for (int e = 0; e < 4; ++e) w[e] = gelu_erf(d[e] * usc) * gt[e] * vsc;
        ((GAS f32x4*)(ws + WS_PW))[i] = w;
    }
}
__device__ __forceinline__ void phase_vb(const DArgs& a, LAS unsigned char* lds) {
    const int tid = tid_(), lane = tid & 63, wave = __builtin_amdgcn_readfirstlane(tid >> 6), k = lane >> 3, c = lane & 7;
    GAS unsigned char* ws = a.ws;
    const XcdSlice X = xcd_slice_setup(a, lds);
    const int tstride = X.nloc * 8;
    for (int sl = X.q; sl < 8; sl += X.nx) {
        const GAS unsigned char* VBs = ws + WS_VB + sl * 128 + c * 16;
        u32x4 ev[4]; f32x4 wv[4];
#define B_INFO(t_) do { _Pragma("unroll") for (int j_ = 0; j_ < 4; ++j_) { ev[j_] = *(const GAS u32x4*)((const GAS int*)(ws + WS_EIDX) + (size_t)(t_) * 128 + 16 * k + 4 * j_); \
        wv[j_] = *(const GAS f32x4*)((const GAS float*)(ws + WS_PW) + (size_t)(t_) * 128 + 16 * k + 4 * j_); } } while (0)
        int tok = X.rank * 8 + wave;
        if (tok < T) B_INFO(tok);
        for (; tok < T; tok += tstride) {
            u32x4 R[16];
#pragma unroll
            for (int g = 0; g < 16; ++g) R[g] = *(const GAS u32x4*)(VBs + (size_t)ev[g >> 2][g & 3] * 1024);
            float wk[16];
#pragma unroll
            for (int g = 0; g < 16; ++g) wk[g] = wv[g >> 2][g & 3];
            if (tok + tstride < T) B_INFO(tok + tstride);
            f32x4 xr[4];
#pragma unroll
            for (int j = 0; j < 4; ++j) xr[j] = *(const GAS f32x4*)(a.out + (size_t)tok * D + sl * 128 + c * 16 + 4 * j);
            f32x2 acc2[8];
#pragma unroll
            for (int e = 0; e < 8; ++e) acc2[e] = (f32x2){0.f, 0.f};
#pragma unroll
            for (int g = 0; g < 16; ++g) { const f32x2 wp = (f32x2){wk[g], wk[g]};
#pragma unroll
                for (int jj = 0; jj < 4; ++jj) { acc2[2 * jj] += wp * FP8LO(R[g][jj]); acc2[2 * jj + 1] += wp * FP8HI(R[g][jj]); } }
#pragma unroll
            for (int e = 0; e < 8; ++e) {
#pragma unroll
                for (int hh = 0; hh < 2; ++hh) { float v = acc2[e][hh]; v += SWZ_(v, 0x201F); v += SWZ_(v, 0x401F); v += xor32_(v, lane >= 32); acc2[e][hh] = v; } }
            float ss = 0.f;
#pragma unroll
            for (int j = 0; j < 4; ++j) { xr[j][0] += acc2[2 * j][0]; xr[j][1] += acc2[2 * j][1]; xr[j][2] += acc2[2 * j + 1][0]; xr[j][3] += acc2[2 * j + 1][1];
                ss += (xr[j][0] * xr[j][0] + xr[j][1] * xr[j][1]) + (xr[j][2] * xr[j][2] + xr[j][3] * xr[j][3]); }
            ss += DPP_(ss, 0xB1); ss += DPP_(ss, 0x4E); ss += DPP_(ss, 0x141);
            if (k == 0) {
#pragma unroll
                for (int j = 0; j < 4; ++j) *(GAS f32x4*)(a.out + (size_t)tok * D + sl * 128 + c * 16 + 4 * j) = xr[j];
                if (c == 0) ((GAS float*)(ws + WS_SS))[(size_t)tok * 8 + sl] = ss;
            }
        }
#undef B_INFO
    }
}
__device__ __forceinline__ void phase_vc(const DArgs& a, int vcu, int G) {
    const int tid = tid_(), lane = tid & 63, wave = tid >> 6;
    const int gw = vcu * NWAVES + wave, NGW = G * NWAVES;
    GAS unsigned char* ws = a.ws;
    f32x4 gf[4];
#pragma unroll
    for (int j = 0; j < 4; ++j) gf[j] = ((const GAS f32x4*)a.final_g)[64 * j + lane];
    for (int m = gw; m < T; m += NGW) {
        const f32x4 s0 = *(const GAS f32x4*)((const GAS float*)(ws + WS_SS) + (size_t)m * 8), s1 = *(const GAS f32x4*)((const GAS float*)(ws + WS_SS) + (size_t)m * 8 + 4);
        const float rstd = rsqrtf(((s0[0] + s0[1]) + (s0[2] + s0[3]) + (s1[0] + s1[1]) + (s1[2] + s1[3])) * (1.f / D) + EPS);
        GAS f32x4* o = (GAS f32x4*)(a.out + (size_t)m * D) + lane;
#pragma unroll
        for (int j = 0; j < 4; ++j) o[64 * j] = o[64 * j] * rstd * gf[j];
    }
}

__device__ __forceinline__ void phase_final_plain(const DArgs& a, const float* src, int vcu, int G) {
    const int tid = tid_(), lane = tid & 63, wave = tid >> 6;
    const int gw = vcu * NWAVES + wave, NGW = G * NWAVES;
    f32x4 gf[4];
#pragma unroll
    for (int j = 0; j < 4; ++j) gf[j] = ((const f32x4*)a.final_g)[64 * j + lane];
    for (int m = gw; m < T; m += NGW) {
        const f32x4* xr = (const f32x4*)(src + (size_t)m * D) + lane;
        f32x4 v[4]; float s = 0.f;
#pragma unroll
        for (int j = 0; j < 4; ++j) { v[j] = xr[64 * j]; s += (v[j][0] * v[j][0] + v[j][1] * v[j][1]) + (v[j][2] * v[j][2] + v[j][3] * v[j][3]); }
        const float rstd = rsqrtf(wave_sum(s, lane) * (1.f / D) + EPS);
        f32x4* o = (f32x4*)(a.out + (size_t)m * D) + lane;
#pragma unroll
        for (int j = 0; j < 4; ++j) o[64 * j] = v[j] * rstd * gf[j];
    }
}


__device__ __forceinline__ DArgs load_args() {
    DArgs r;
#if defined(__HIP_DEVICE_COMPILE__)
    typedef const DArgs __attribute__((address_space(4))) KArgs;
    KArgs* p = (KArgs*)__builtin_amdgcn_kernarg_segment_ptr();
    asm volatile("" : "+s"(p));
    r.x = p->x; r.norm1_g = p->norm1_g; r.w_in = p->w_in; r.b_in = p->b_in; r.conv_w = p->conv_w; r.conv_b = p->conv_b; r.m_head_g = p->m_head_g; r.lb_table = p->lb_table;
    r.g_head_g = p->g_head_g; r.w_br_m = p->w_br_m; r.w_br_g = p->w_br_g; r.w_out = p->w_out; r.norm2_g = p->norm2_g; r.w_pq = p->w_pq; r.sub_keys = p->sub_keys;
    r.u_emb = p->u_emb; r.v_emb = p->v_emb; r.final_g = p->final_g; r.out = p->out; r.ws = p->ws;
#else
    r = DArgs{};
#endif
    return r;
}
__device__ __forceinline__ EpiPtrs make_ep(const DArgs& a, int round) {
    EpiPtrs ep; ep.biasp = (const GAS float*)(a.ws + WS_BIASP); ep.lb = (const GAS float*)(a.ws + WS_LB); ep.x = a.x; ep.out = a.out; ep.ws = a.ws; ep.round = round; return ep;
}
#define GRID_SYNC() do { const DArgs a_ = load_args(); xcd_barrier((unsigned*)(a_.ws + WS_CTL) + CW_BAR, (volatile LAS unsigned*)(lds + LDS_BARST)); } while (0)

__device__ __forceinline__ int bx_() { int t = blockIdx.x; asm volatile("" : "+s"(t)); return t; }
__device__ __forceinline__ int gd_() { int t = gridDim.x; asm volatile("" : "+s"(t)); return t; }
#define PH_BEGIN const DArgs a = load_args(); const int bx = bx_(), G = gd_(); const int vcu = (G % 8 == 0) ? (bx % 8) * (G / 8) + bx / 8 : bx; (void)vcu; (void)bx;

__global__ void __launch_bounds__(NTHR, 2) fwd_megakernel(Args a_unused) {
    extern __shared__ __attribute__((aligned(16))) unsigned char lds_raw[];
    LAS unsigned char* lds = (LAS unsigned char*)lds_raw;
    cg::grid_group grid = cg::this_grid();

    { const int t_ = tid_(); if (t_ < 16) ((LAS unsigned*)(lds + LDS_BARST))[t_] = 0u; __syncthreads();
      const DArgs a_ = load_args(); xcd_barrier_post((unsigned*)(a_.ws + WS_CTL) + CW_BAR, (volatile LAS unsigned*)(lds + LDS_BARST)); }
    { PH_BEGIN phase_p0(a, lds, vcu, G); }
    grid.sync();
#pragma unroll 1
    for (int round = 0; round < NROUND; ++round) {
        {
            PH_BEGIN
            pg8::Gemm g{(const bf16_t*)(a.ws + WS_XN) + (size_t)round * RT * D, (const bf16_t*)(a.ws + WS_WIN), RT, N1, D};
            pg8::StaticOrder S; S.init(RT, N1, G, bx);
            EpiX<1> E{make_ep(a, round)};
            pg8::gemm_phase<EpiX<1>, pg8::StaticOrder, true, true>(lds, g, S, E);
        }
        { PH_BEGIN if (bx < 8) mscan_pair(a, lds, round, bx); }
        GRID_SYNC();
        { PH_BEGIN for (int it = bx; it < 512; it += G) mlstm_pre_item(a, lds, round, it); }
        { PH_BEGIN for (int it = bx; it < 2048; it += G) hgrn_pre_item(a, lds, round, it); }
        GRID_SYNC();
        { PH_BEGIN
          if (bx < 128) mlstm_scan(a, lds, round, bx & 7, bx >> 3);
          else if (bx < 192) { const int id2 = bx - 128; hgrn_scan(a, lds, round, (id2 & 7) * 2 + ((id2 >> 3) & 1), id2 >> 4); } }
        GRID_SYNC();
        {
            PH_BEGIN
            pg8::Gemm g{(const bf16_t*)(a.ws + WS_XN) + (size_t)round * RT * D, (const bf16_t*)(a.ws + WS_WIN) + (size_t)N1 * D, RT, N2, D};
            pg8::StaticOrder S; S.init(RT, N2, G, bx);
            EpiX<2> E{make_ep(a, round)};
            pg8::gemm_phase<EpiX<2>, pg8::StaticOrder, true, true>(lds, g, S, E);
        }
        GRID_SYNC();
        { PH_BEGIN phase_ypass(a, round, vcu, G); }
        GRID_SYNC();
        {
            { PH_BEGIN pg8::StaticOrder S; S.init(RT, D, G, bx);
              pg8::Gemm g{(const bf16_t*)(a.ws + WS_V), (const bf16_t*)(a.ws + WS_WM), RT, D, 2048}; EpiX<3> E{make_ep(a, round)}; pg8::gemm_phase<EpiX<3>, pg8::StaticOrder, true, true>(lds, g, S, E); }
            { PH_BEGIN pg8::StaticOrder S; S.init(RT, D, G, bx);
              pg8::Gemm g{(const bf16_t*)(a.ws + WS_GI), (const bf16_t*)(a.ws + WS_WG), RT, D, D}; EpiX<4> E{make_ep(a, round)}; pg8::gemm_phase<EpiX<4>, pg8::StaticOrder, true, true>(lds, g, S, E); }
        }
        GRID_SYNC();
        {
            PH_BEGIN pg8::StaticOrder S; S.init(RT, D, G, bx);
            pg8::Gemm g{(const bf16_t*)(a.ws + WS_GFLOG), (const bf16_t*)(a.ws + WS_WO), RT, D, D}; EpiX<5> E{make_ep(a, round)}; pg8::gemm_phase<EpiX<5>, pg8::StaticOrder, true, true>(lds, g, S, E);
        }
        GRID_SYNC();
    }
    { PH_BEGIN phase_p8(a, vcu, G); }
    GRID_SYNC();
    {
        PH_BEGIN pg8::StaticOrder S; S.init(T, 2048, G, bx);
        pg8::Gemm g{(const bf16_t*)(a.ws + WS_XN), (const bf16_t*)(a.ws + WS_WPQ), T, 2048, D}; EpiX<6> E{make_ep(a, 0)}; pg8::gemm_phase<EpiX<6>, pg8::StaticOrder, true, true>(lds, g, S, E);
    }
    GRID_SYNC();
#ifdef TOPK_REF
    { PH_BEGIN phase_topk_ref(a, vcu, G); }
#else
    { PH_BEGIN phase_topk(a, lds, bx, G); }
#endif
    GRID_SYNC();
    { PH_BEGIN phase_ua(a, lds); }
    GRID_SYNC();
    { PH_BEGIN phase_ua2(a, vcu, G); }
    GRID_SYNC();
    { PH_BEGIN phase_vb(a, lds); }
    GRID_SYNC();
    { PH_BEGIN phase_vc(a, vcu, G); }
}

extern "C" void kernel_launch(void* const* d_in, const int* in_sizes, int n_in, void* d_out, int out_size, void* d_ws, size_t ws_size, hipStream_t stream) {
    static int grid = 0;
    if (grid == 0) {
        if (n_in != 18 || in_sizes[0] != T * D || out_size != T * D || ws_size < WS_END) {
            fprintf(stderr, "kernel_launch: unexpected shapes/workspace (n_in %d, in0 %d, out %d, ws %zu, need %zu)\n", n_in, n_in > 0 ? in_sizes[0] : -1, out_size, ws_size, (size_t)WS_END);
            grid = -1; return; }
        int dev = 0, cus = 0, per_cu = 0;
        hipGetDevice(&dev);
        hipDeviceGetAttribute(&cus, hipDeviceAttributeMultiprocessorCount, dev);
        hipFuncSetAttribute((const void*)fwd_megakernel, hipFuncAttributeMaxDynamicSharedMemorySize, LDS_BYTES);
        hipOccupancyMaxActiveBlocksPerMultiprocessor(&per_cu, (const void*)fwd_megakernel, NTHR, LDS_BYTES);
        if (per_cu < 1) { fprintf(stderr, "kernel_launch: occupancy query says %d blocks/CU\n", per_cu); per_cu = 1; }
        grid = cus;
        (void)hipGetLastError();
    }
    if (grid < 0) return;
    hipMemsetAsync((char*)d_ws + WS_CTL, 0, 1 * MiB, stream);
    Args a{};
    a.x = (const float*)d_in[0]; a.norm1_g = (const float*)d_in[1]; a.w_in = (const float*)d_in[2]; a.b_in = (const float*)d_in[3];
    a.conv_w = (const float*)d_in[4]; a.conv_b = (const float*)d_in[5]; a.m_head_g = (const float*)d_in[6]; a.lb_table = (const float*)d_in[7];
    a.g_head_g = (const float*)d_in[8]; a.w_br_m = (const float*)d_in[9]; a.w_br_g = (const float*)d_in[10]; a.w_out = (const float*)d_in[11];
    a.norm2_g = (const float*)d_in[12]; a.w_pq = (const float*)d_in[13]; a.sub_keys = (const float*)d_in[14]; a.u_emb = (const float*)d_in[15];
    a.v_emb = (const float*)d_in[16]; a.final_g = (const float*)d_in[17];
    a.out = (float*)d_out; a.ws = (unsigned char*)d_ws;
    void* args[] = {&a};
    hipError_t e = hipLaunchCooperativeKernel((const void*)fwd_megakernel, dim3(grid), dim3(NTHR), args, LDS_BYTES, stream);
    if (e != hipSuccess) fprintf(stderr, "cooperative launch failed: %s (grid %d)\n", hipGetErrorString(e), grid);
}
```

```cpp
#include <hip/hip_runtime.h>
#include <hip/hip_cooperative_groups.h>
#include <cstdio>
#include <cstdint>
namespace cg = cooperative_groups;

#define LAS __attribute__((address_space(3)))
typedef unsigned short bf16_t;
typedef short bf16x8 __attribute__((ext_vector_type(8)));
typedef float f32x4 __attribute__((ext_vector_type(4)));
typedef float f32x2 __attribute__((ext_vector_type(2)));
typedef unsigned u32x4 __attribute__((ext_vector_type(4)));
typedef unsigned u32x2 __attribute__((ext_vector_type(2)));

constexpr int D = 1024, BATCH = 4, SEQ = 8192, T = BATCH * SEQ;
constexpr int IN_COLS = 12296, NP = 12288;
constexpr int RT = 16384, NROUND = 2;
constexpr int N1 = 7168, N2 = 5120;
constexpr float EPS = 1e-6f;
constexpr int NWAVES = 8, NTHR = 512;

constexpr size_t MiB = 1u << 20;
constexpr size_t WS_CTL = 0;
constexpr size_t WS_WIN = 1 * MiB;
constexpr size_t WS_WM = 25 * MiB;
constexpr size_t WS_WG = 29 * MiB;
constexpr size_t WS_WO = 31 * MiB;
constexpr size_t WS_WPQ = 33 * MiB;
constexpr size_t WS_SK = 37 * MiB;
constexpr size_t WS_BIASP = 37 * MiB + 512 * 1024;
constexpr size_t WS_LB = WS_BIASP + 64 * 1024;
constexpr size_t WS_GATES = 38 * MiB;
constexpr size_t WS_MPREV = 39 * MiB;
constexpr size_t WS_DEN = 40 * MiB;
constexpr size_t WS_MT = 40 * MiB + 512 * 1024;
constexpr size_t WS_HGDEC = 41 * MiB;
constexpr size_t WS_MDEC = 43 * MiB;
constexpr size_t WS_XN = 44 * MiB;
constexpr size_t WS_QKPRE = 108 * MiB;
constexpr size_t WS_V = 172 * MiB;
constexpr size_t WS_GFLOG = 236 * MiB;
constexpr size_t WS_GI = 268 * MiB;
constexpr size_t WS_GQ = 300 * MiB;
constexpr size_t WS_S = 332 * MiB;
constexpr size_t WS_QT = 348 * MiB;
constexpr size_t WS_KWT = 380 * MiB;
constexpr size_t WS_ATT = 412 * MiB;
constexpr size_t WS_QTG = 428 * MiB;
constexpr size_t WS_KENDT = 460 * MiB;
constexpr size_t WS_SIGO = 332 * MiB;
constexpr size_t WS_SGG = 396 * MiB;
constexpr size_t WS_SAM = 428 * MiB;
constexpr size_t WS_SAG = 460 * MiB;
constexpr size_t WS_END = 492 * MiB;
constexpr size_t WS_QP = 108 * MiB;
constexpr size_t WS_UB = 236 * MiB;
constexpr size_t WS_VB = 252 * MiB;
constexpr size_t WS_USC = 268 * MiB;
constexpr size_t WS_VSC = 268 * MiB + 65536;
constexpr size_t WS_EIDX = 300 * MiB;
constexpr size_t WS_GATE = 316 * MiB;
constexpr size_t WS_X8 = 348 * MiB;
constexpr size_t WS_PARTU = 108 * MiB;
constexpr size_t WS_SS = 348 * MiB;
constexpr size_t WS_PW = 332 * MiB;

constexpr int CW_TMAX = 64;
constexpr int LDS_BYTES = 147456;

__device__ __forceinline__ unsigned f2bf(float f) { unsigned u = __builtin_bit_cast(unsigned, f); return (u + 0x7fffu + ((u >> 16) & 1u)) >> 16; }
typedef __bf16 bf16x2_t __attribute__((ext_vector_type(2)));
__device__ __forceinline__ unsigned pk2(float lo, float hi) { bf16x2_t v; v[0] = (__bf16)lo; v[1] = (__bf16)hi; return __builtin_bit_cast(unsigned, v); }
__device__ __forceinline__ float bf_lo(unsigned w) { return __builtin_bit_cast(float, w << 16); }
__device__ __forceinline__ float bf_hi(unsigned w) { return __builtin_bit_cast(float, w & 0xffff0000u); }
__device__ __forceinline__ float bf2f(bf16_t h) { return __builtin_bit_cast(float, ((unsigned)h) << 16); }
__device__ __forceinline__ float shx(float v, int o, int lane) { return __builtin_bit_cast(float, __builtin_amdgcn_ds_bpermute((lane ^ o) << 2, __builtin_bit_cast(int, v))); }
__device__ __forceinline__ float shup(float v, int o, int lane) { return __builtin_bit_cast(float, __builtin_amdgcn_ds_bpermute(((lane - o) & 63) << 2, __builtin_bit_cast(int, v))); }
__device__ __forceinline__ float rdlane(float v, int l) { return __builtin_bit_cast(float, __builtin_amdgcn_readlane(__builtin_bit_cast(int, v), l)); }
#define DPP_(v, ctrl) __builtin_bit_cast(float, __builtin_amdgcn_update_dpp(0, __builtin_bit_cast(int, (v)), (ctrl), 0xF, 0xF, false))
__device__ __forceinline__ float wave_sum(float v, int lane) {
    (void)lane;
    v += DPP_(v, 0xB1); v += DPP_(v, 0x4E); v += DPP_(v, 0x141); v += DPP_(v, 0x140);
    return (rdlane(v, 0) + rdlane(v, 16)) + (rdlane(v, 32) + rdlane(v, 48));
}
#define SWZI_(v, pat) __builtin_amdgcn_ds_swizzle((int)(v), (pat))
#define DPPI_(v, ctrl) __builtin_amdgcn_update_dpp(0, (int)(v), (ctrl), 0xF, 0xF, false)
__device__ __forceinline__ unsigned xor32u_(unsigned v, bool hi) {
#if defined(__HIP_DEVICE_COMPILE__)
    const auto r = __builtin_amdgcn_permlane32_swap(v, v, false, false);
    return hi ? r[0] : r[1];
#else
    (void)hi; return v;
#endif
}
__device__ __forceinline__ float sigmoidf_(float x) { return __builtin_amdgcn_rcpf(1.0f + __expf(-x)); }
__device__ __forceinline__ float siluf_(float x) { return x * __builtin_amdgcn_rcpf(1.0f + __expf(-x)); }
#define LDS_WAIT() asm volatile("s_waitcnt lgkmcnt(0)" ::: "memory")
__device__ __forceinline__ int tid_() { int t = threadIdx.x; asm volatile("" : "+v"(t)); return t; }

#define GAS __attribute__((address_space(1)))
struct DArgs {
    const GAS float* x; const GAS float* norm1_g; const GAS float* w_in; const GAS float* b_in; const GAS float* conv_w; const GAS float* conv_b;
    const GAS float* m_head_g; const GAS float* lb_table; const GAS float* g_head_g; const GAS float* w_br_m; const GAS float* w_br_g; const GAS float* w_out;
    const GAS float* norm2_g; const GAS float* w_pq; const GAS float* sub_keys; const GAS float* u_emb; const GAS float* v_emb; const GAS float* final_g;
    GAS float* out; GAS unsigned char* ws;
};
struct Args {
    const float* x; const float* norm1_g; const float* w_in; const float* b_in; const float* conv_w; const float* conv_b;
    const float* m_head_g; const float* lb_table; const float* g_head_g; const float* w_br_m; const float* w_br_g; const float* w_out;
    const float* norm2_g; const float* w_pq; const float* sub_keys; const float* u_emb; const float* v_emb; const float* final_g;
    float* out; unsigned char* ws;
};

namespace pg8 {
constexpr int BM = 256, BK = 64, HALF = 128, HTB = HALF * BK * 2, STAGE_BYTES = 8 * HTB, NXCD = 8, WGM = 8;
__host__ __device__ __forceinline__ int lds_byte(int r, int c) { const int st = (r >> 4) * 2 + (c >> 5), rr = r & 15, cc = c & 31, ob = rr * 64 + cc * 2; return st * 1024 + (ob ^ (((ob >> 9) & 1) << 5)); }
__host__ __device__ __forceinline__ void stage_rc(int b, int& R, int& C) { const int st = b / 1024, sb = b % 1024, swz = sb ^ (((sb >> 9) & 1) << 5); R = (st >> 1) * 16 + swz / 64; C = (st & 1) * 32 + (swz % 64) / 2; }
__host__ __device__ __forceinline__ int perm32(int rho) { const int n = rho >> 4, i = rho & 15; return 8 * (i >> 2) + 4 * n + (i & 3); }
struct Unit { int pm, pn; };
struct Gemm { const bf16_t* A; const bf16_t* Bt; int M, N, K; };
struct StaticOrder {
    int nM, nN, nwg, G, c;
    __host__ __device__ void init(int M, int N, int G_, int c_) { nM = M / BM; nN = N / BM; nwg = nM * nN; G = G_; c = c_; }
    __host__ __device__ bool next(int i, Unit& u) const {
        const long L = (long)i * G + c; if (L >= nwg) return false;
        int wgid = (int)L; { const int q = nwg / NXCD, r = nwg % NXCD, xcd = wgid % NXCD, off = wgid / NXCD; wgid = (xcd < r ? xcd * (q + 1) : r * (q + 1) + (xcd - r) * q) + off; }
        const int nig = WGM * nN, gid = wgid / nig, fm = gid * WGM, gsz = (nM - fm) < WGM ? (nM - fm) : WGM;
        u.pm = fm + ((wgid % nig) % gsz); u.pn = (wgid % nig) / gsz; return true;
    }
    __device__ __forceinline__ void a_ready(const Unit&) const {}
    __device__ __forceinline__ void done(const Unit&) const {}
};

template <class Epi, class Sched, bool ALIGN_EPI = false, bool SP2 = false>
__device__ __forceinline__ void gemm_phase(LAS unsigned char* lds, const Gemm g, const Sched& S, const Epi& E) {
    const int tid = tid_(), wid = __builtin_amdgcn_readfirstlane(tid >> 6), lane = tid & 63, wr = wid >> 2, wc = wid & 3, fr = lane & 15, fq = lane >> 4;
    const int K = g.K, nt = K / BK;
    unsigned voffA[2], voffB[2];
#pragma unroll
    for (int i = 0; i < 2; ++i) { int R, C; stage_rc(tid * 16 + i * 8192, R, C); const int Rb = Epi::PERM ? ((R & ~31) + perm32(R & 31)) : R;
        voffA[i] = (unsigned)(R * K + C) * 2u; voffB[i] = (unsigned)(Rb * K + C) * 2u; }
    const size_t kstep = (size_t)(BK * 2);
    const size_t hstep = (size_t)HALF * K * 2;
    const size_t tstep = 2 * hstep;
    const unsigned ldsw = (unsigned)wid * 1024u;
    const int aoff = lds_byte(wr * 64 + fr, fq * 8), boff = lds_byte(wc * 32 + fr, fq * 8);
#define PG8_SA(b, h) (((b) * 2 + (h)) * HTB)
#define PG8_SB(b, h) ((4 + (b) * 2 + (h)) * HTB)
#define PG8_STAGE(bufoff, gbase, voff) do { _Pragma("unroll") for (int _i = 0; _i < 2; ++_i) \
        __builtin_amdgcn_global_load_lds((const unsigned*)((const char*)(gbase) + (voff)[_i]), (LAS unsigned*)(lds + (bufoff) + ldsw + _i * 8192), 16, 0, 0); } while (0)
#define PG8_LDA(dst, b, h) do { _Pragma("unroll") for (int m = 0; m < 4; ++m) _Pragma("unroll") for (int k = 0; k < 2; ++k) dst[m][k] = *(const LAS bf16x8*)(lds + PG8_SA(b, h) + aoff + m * 2048 + k * 1024); } while (0)
#define PG8_LDB(dst, b, h) do { _Pragma("unroll") for (int n = 0; n < 2; ++n) _Pragma("unroll") for (int k = 0; k < 2; ++k) dst[n][k] = *(const LAS bf16x8*)(lds + PG8_SB(b, h) + boff + n * 2048 + k * 1024); } while (0)
#define PG8_MMA(ai, bj, At, Bt) do { __builtin_amdgcn_s_setprio(1); _Pragma("unroll") for (int m = 0; m < 4; ++m) _Pragma("unroll") for (int n = 0; n < 2; ++n) _Pragma("unroll") for (int k = 0; k < 2; ++k) \
        acc[ai][bj][m][n] = __builtin_amdgcn_mfma_f32_16x16x32_bf16(Bt[n][k], At[m][k], acc[ai][bj][m][n], 0, 0, 0); __builtin_amdgcn_s_setprio(0); } while (0)
#define PG8_WAIT_V(n) asm volatile("s_waitcnt vmcnt(" #n ")" ::: "memory")
#define PG8_WAIT_L(n) asm volatile("s_waitcnt lgkmcnt(" #n ")" ::: "memory")
#define PG8_BAR __builtin_amdgcn_s_barrier()
#define PG8_SCHED __builtin_amdgcn_sched_barrier(0)
    Unit cur, nxt; int ui = 0;
    if (!S.next(0, cur)) return;
    f32x4 acc[2][2][4][2];
#pragma unroll
    for (int a = 0; a < 2; ++a)
#pragma unroll
        for (int b = 0; b < 2; ++b)
#pragma unroll
            for (int m = 0; m < 4; ++m)
#pragma unroll
                for (int n = 0; n < 2; ++n) acc[a][b][m][n] = (f32x4){0.f, 0.f, 0.f, 0.f};
    bf16x8 At[4][2], B0[2][2], B1[2][2];
    const char* cA = (const char*)g.A + (size_t)cur.pm * tstep; const char* cB = (const char*)g.Bt + (size_t)cur.pn * tstep;
    S.a_ready(cur);
    if constexpr (SP2) {
        PG8_STAGE(PG8_SB(0, 0), cB, voffB); PG8_STAGE(PG8_SB(0, 1), cB + hstep, voffB); PG8_STAGE(PG8_SA(0, 0), cA, voffA); PG8_STAGE(PG8_SA(0, 1), cA + hstep, voffA);
        if (wr == 1) PG8_BAR;
        PG8_WAIT_V(2); PG8_BAR;
        PG8_STAGE(PG8_SB(1, 0), cB + kstep, voffB); PG8_STAGE(PG8_SA(1, 0), cA + kstep, voffA); PG8_STAGE(PG8_SB(1, 1), cB + hstep + kstep, voffB);
        PG8_WAIT_V(6); PG8_BAR;
    } else {
        PG8_STAGE(PG8_SB(0, 0), cB, voffB); PG8_STAGE(PG8_SA(0, 0), cA, voffA); PG8_STAGE(PG8_SB(0, 1), cB + hstep, voffB); PG8_STAGE(PG8_SA(0, 1), cA + hstep, voffA);
        if (wr == 1) PG8_BAR;
        PG8_WAIT_V(4); PG8_BAR;
        PG8_STAGE(PG8_SB(1, 0), cB + kstep, voffB); PG8_STAGE(PG8_SA(1, 0), cA + kstep, voffA); PG8_STAGE(PG8_SB(1, 1), cB + hstep + kstep, voffB);
        PG8_WAIT_V(6); PG8_BAR;
    }
    for (;;) {
        const bool has_next = S.next(ui + 1, nxt);
        const char* nA = has_next ? (const char*)g.A + (size_t)nxt.pm * tstep : cA; const char* nB = has_next ? (const char*)g.Bt + (size_t)nxt.pn * tstep : cB;
        for (int t = 0; t < nt; t += 2) {
            const bool last = (t == nt - 2);
            const char* a1 = cA + (size_t)(t + 1) * kstep;
            const char* a2 = last ? nA : cA + (size_t)(t + 2) * kstep; const char* b2 = last ? nB : cB + (size_t)(t + 2) * kstep;
            const char* a3 = a2 + kstep; const char* b3 = b2 + kstep;
            if (last && has_next) S.a_ready(nxt);
            if constexpr (SP2) {
            PG8_LDB(B0, 0, 0); PG8_LDB(B1, 0, 1); PG8_SCHED; PG8_LDA(At, 0, 0); PG8_STAGE(PG8_SA(1, 1), a1 + hstep, voffA);
            PG8_WAIT_V(8); PG8_WAIT_L(0); PG8_BAR; PG8_MMA(0, 0, At, B0); PG8_MMA(0, 1, At, B1); PG8_BAR; PG8_SCHED;
            PG8_LDA(At, 0, 1); PG8_STAGE(PG8_SB(0, 0), b2, voffB); PG8_STAGE(PG8_SB(0, 1), b2 + hstep, voffB); PG8_STAGE(PG8_SA(0, 0), a2, voffA);
            PG8_WAIT_V(8); PG8_WAIT_L(0); PG8_BAR; PG8_MMA(1, 0, At, B0); PG8_MMA(1, 1, At, B1); PG8_BAR; PG8_SCHED;
            PG8_LDB(B0, 1, 0); PG8_LDB(B1, 1, 1); PG8_SCHED; PG8_LDA(At, 1, 0); PG8_STAGE(PG8_SA(0, 1), a2 + hstep, voffA);
            PG8_WAIT_V(8); PG8_WAIT_L(0); PG8_BAR; PG8_MMA(0, 0, At, B0); PG8_MMA(0, 1, At, B1); PG8_BAR; PG8_SCHED;
            PG8_LDA(At, 1, 1); PG8_STAGE(PG8_SB(1, 0), b3, voffB); PG8_STAGE(PG8_SB(1, 1), b3 + hstep, voffB); PG8_STAGE(PG8_SA(1, 0), a3, voffA);
            PG8_WAIT_V(8); PG8_WAIT_L(0); PG8_BAR; PG8_MMA(1, 0, At, B0); PG8_MMA(1, 1, At, B1); PG8_BAR; PG8_SCHED;
            } else {
            PG8_LDB(B0, 0, 0); PG8_SCHED; PG8_LDA(At, 0, 0); PG8_STAGE(PG8_SA(1, 1), a1 + hstep, voffA);
            PG8_WAIT_L(8); PG8_BAR; PG8_WAIT_L(0); PG8_MMA(0, 0, At, B0); PG8_BAR; PG8_SCHED;
            PG8_LDB(B1, 0, 1); PG8_STAGE(PG8_SB(0, 0), b2, voffB);
            PG8_BAR; PG8_WAIT_L(0); PG8_MMA(0, 1, At, B1); PG8_BAR;
            PG8_LDA(At, 0, 1); PG8_STAGE(PG8_SA(0, 0), a2, voffA);
            PG8_BAR; PG8_WAIT_L(0); PG8_MMA(1, 0, At, B0); PG8_BAR; PG8_SCHED;
            PG8_STAGE(PG8_SB(0, 1), b2 + hstep, voffB);
            PG8_WAIT_V(6); PG8_BAR; PG8_MMA(1, 1, At, B1); PG8_BAR;
            PG8_LDB(B0, 1, 0); PG8_SCHED; PG8_LDA(At, 1, 0); PG8_STAGE(PG8_SA(0, 1), a2 + hstep, voffA);
            PG8_WAIT_L(8); PG8_BAR; PG8_WAIT_L(0); PG8_MMA(0, 0, At, B0); PG8_BAR; PG8_SCHED;
            PG8_LDB(B1, 1, 1); PG8_STAGE(PG8_SB(1, 0), b3, voffB);
            PG8_BAR; PG8_WAIT_L(0); PG8_MMA(0, 1, At, B1); PG8_BAR;
            PG8_LDA(At, 1, 1); PG8_STAGE(PG8_SA(1, 0), a3, voffA);
            PG8_BAR; PG8_WAIT_L(0); PG8_MMA(1, 0, At, B0); PG8_BAR; PG8_SCHED;
            PG8_STAGE(PG8_SB(1, 1), b3 + hstep, voffB);
            PG8_WAIT_V(6); PG8_BAR; PG8_MMA(1, 1, At, B1); PG8_BAR;
            }
        }
        if constexpr (ALIGN_EPI) { if (wr == 0) PG8_BAR; }
        E(acc, cur, wr, wc, fr, fq);
        if (!has_next) break;
#pragma unroll
        for (int a = 0; a < 2; ++a)
#pragma unroll
            for (int b = 0; b < 2; ++b)
#pragma unroll
                for (int m = 0; m < 4; ++m)
#pragma unroll
                    for (int n = 0; n < 2; ++n) acc[a][b][m][n] = (f32x4){0.f, 0.f, 0.f, 0.f};
        cur = nxt; cA = nA; cB = nB; ++ui;
        if constexpr (ALIGN_EPI) { if (wr == 1) PG8_BAR; }
    }
    PG8_WAIT_V(0);
    if constexpr (!ALIGN_EPI) { if (wr == 0) PG8_BAR; }
    PG8_BAR;
#undef PG8_SA
#undef PG8_SB
#undef PG8_STAGE
#undef PG8_LDA
#undef PG8_LDB
#undef PG8_MMA
#undef PG8_WAIT_V
#undef PG8_WAIT_L
#undef PG8_BAR
#undef PG8_SCHED
}
}

struct EpiPtrs {
    const GAS float* biasp; const GAS float* lb; const GAS float* x; GAS float* out; GAS unsigned char* ws; int round;
};
template <int MODE> struct EpiX {
    static constexpr bool PERM = true, AFTER_DRAIN = false;
    EpiPtrs P;
    __device__ __forceinline__ void operator()(const f32x4 (&acc)[2][2][4][2], const pg8::Unit& u, int wr, int wc, int fr, int fq) const {
        const int row0 = u.pm * 256 + wr * 64 + fr;
        const int colt = u.pn * 256 + wc * 32 + 8 * fq;
        GAS unsigned char* ws = P.ws;
        bf16_t* dst = nullptr; int ld = 0, coff = 0, act = 0; const GAS float* bias = nullptr;
        if (MODE == 1) {
            bias = P.biasp;
            if (u.pn < 8) { dst = (bf16_t*)(ws + WS_QKPRE); ld = 2048; coff = 0; act = 0; }
            else if (u.pn < 16) { dst = (bf16_t*)(ws + WS_V); ld = 2048; coff = 2048; act = 0; }
            else if (u.pn < 20) { dst = (bf16_t*)(ws + WS_GFLOG); ld = 1024; coff = 4096; act = 3; }
            else if (u.pn < 24) { dst = (bf16_t*)(ws + WS_GI); ld = 1024; coff = 5120; act = 0; }
            else { dst = (bf16_t*)(ws + WS_GQ); ld = 1024; coff = 6144; act = 2; }
        } else if (MODE == 2) {
            bias = P.biasp + N1;
            if (u.pn < 8) { dst = (bf16_t*)(ws + WS_SIGO); ld = 2048; coff = 0; act = 1; }
            else if (u.pn < 12) { dst = (bf16_t*)(ws + WS_SGG); ld = 1024; coff = 2048; act = 2; }
            else if (u.pn < 16) { dst = (bf16_t*)(ws + WS_SAM); ld = 1024; coff = 3072; act = 1; }
            else { dst = (bf16_t*)(ws + WS_SAG); ld = 1024; coff = 4096; act = 1; }
        } else if (MODE == 6) { dst = (bf16_t*)(ws + WS_QP); ld = 2048; coff = 0; act = 0; }
#pragma unroll
        for (int bj = 0; bj < 2; ++bj) {
            const int col = colt + bj * 128;
            f32x4 b0 = (f32x4){0.f, 0.f, 0.f, 0.f}, b1 = b0, l0 = b0, l1 = b0;
            if (MODE == 1 || MODE == 2) { b0 = *(const f32x4*)(bias + col); b1 = *(const f32x4*)(bias + col + 4); }
            if (MODE == 1) { if (act == 3) { l0 = *(const f32x4*)(P.lb + (col - coff)); l1 = *(const f32x4*)(P.lb + (col - coff) + 4); } }
#pragma unroll
            for (int ai = 0; ai < 2; ++ai)
#pragma unroll
                for (int m = 0; m < 4; ++m) {
                    const int row = row0 + ai * 128 + m * 16;
                    f32x4 v0 = acc[ai][bj][m][0] + b0, v1 = acc[ai][bj][m][1] + b1;
                    if (MODE == 1 || MODE == 2 || MODE == 6) {
                        if (act == 1) {
#pragma unroll
                            for (int j = 0; j < 4; ++j) { v0[j] = sigmoidf_(v0[j]); v1[j] = sigmoidf_(v1[j]); }
                        } else if (act == 2) {
#pragma unroll
                            for (int j = 0; j < 4; ++j) { v0[j] = siluf_(v0[j]); v1[j] = siluf_(v1[j]); }
                        } else if (act == 3) {
#pragma unroll
                            for (int j = 0; j < 4; ++j) { v0[j] = __logf(l0[j] + (1.0f - l0[j]) * sigmoidf_(v0[j])); v1[j] = __logf(l1[j] + (1.0f - l1[j]) * sigmoidf_(v1[j])); }
                        }
                        u32x4 w; w.x = pk2(v0[0], v0[1]); w.y = pk2(v0[2], v0[3]); w.z = pk2(v1[0], v1[1]); w.w = pk2(v1[2], v1[3]);
                        *(u32x4*)(dst + (size_t)row * ld + (col - coff)) = w;
                    } else if (MODE == 3) {
                        const u32x4 g = *(const u32x4*)((const bf16_t*)(ws + WS_SAM) + (size_t)row * 1024 + col);
                        GAS float* o = P.out + ((size_t)P.round * RT + row) * 1024 + col;
                        f32x4 r0, r1;
                        r0[0] = v0[0] * bf_lo(g.x); r0[1] = v0[1] * bf_hi(g.x); r0[2] = v0[2] * bf_lo(g.y); r0[3] = v0[3] * bf_hi(g.y);
                        r1[0] = v1[0] * bf_lo(g.z); r1[1] = v1[1] * bf_hi(g.z); r1[2] = v1[2] * bf_lo(g.w); r1[3] = v1[3] * bf_hi(g.w);
                        *(f32x4*)o = r0; *(f32x4*)(o + 4) = r1;
                    } else if (MODE == 4) {
                        const u32x4 g = *(const u32x4*)((const bf16_t*)(ws + WS_SAG) + (size_t)row * 1024 + col);
                        const GAS float* zp = P.out + ((size_t)P.round * RT + row) * 1024 + col;
                        const f32x4 p0 = *(const f32x4*)zp, p1 = *(const f32x4*)(zp + 4);
                        f32x4 r0, r1;
                        r0[0] = p0[0] + v0[0] * bf_lo(g.x); r0[1] = p0[1] + v0[1] * bf_hi(g.x); r0[2] = p0[2] + v0[2] * bf_lo(g.y); r0[3] = p0[3] + v0[3] * bf_hi(g.y);
                        r1[0] = p1[0] + v1[0] * bf_lo(g.z); r1[1] = p1[1] + v1[1] * bf_hi(g.z); r1[2] = p1[2] + v1[2] * bf_lo(g.w); r1[3] = p1[3] + v1[3] * bf_hi(g.w);
                        u32x4 w; w.x = pk2(r0[0], r0[1]); w.y = pk2(r0[2], r0[3]); w.z = pk2(r1[0], r1[1]); w.w = pk2(r1[2], r1[3]);
                        *(u32x4*)((bf16_t*)(ws + WS_GFLOG) + (size_t)row * 1024 + col) = w;
                    } else if (MODE == 5) {
                        const size_t off = ((size_t)P.round * RT + row) * 1024 + col;
                        const f32x4 x0 = *(const f32x4*)(P.x + off), x1 = *(const f32x4*)(P.x + off + 4);
                        *(f32x4*)(P.out + off) = x0 + v0; *(f32x4*)(P.out + off + 4) = x1 + v1;
                    }
                }
        }
    }
};

__device__ __forceinline__ void p0_transpose_item(const GAS float* W, int ldw, int K, int k0, int scol, GAS bf16_t* WT, int drow, LAS float* scr, int lane) {
#pragma unroll 8
    for (int i = 0; i < 32; ++i) { const int kk = 2 * i + (lane >> 5); scr[kk * 33 + (lane & 31)] = W[(size_t)(k0 + kk) * ldw + scol + (lane & 31)]; }
    LDS_WAIT(); asm volatile("" ::: "memory");
    const int c = lane & 7;
#pragma unroll
    for (int j = 0; j < 4; ++j) { const int n = (lane >> 3) + 8 * j; const LAS float* s = scr + (8 * c) * 33 + n;
        u32x4 o; o.x = pk2(s[0 * 33], s[1 * 33]); o.y = pk2(s[2 * 33], s[3 * 33]); o.z = pk2(s[4 * 33], s[5 * 33]); o.w = pk2(s[6 * 33], s[7 * 33]);
        *(u32x4*)(WT + (size_t)(drow + n) * K + k0 + 8 * c) = o; }
    LDS_WAIT(); asm volatile("" ::: "memory");
}
__device__ __forceinline__ int win_src_col(int n) {
    if (n < 4096) return n;
    if (n < 7168) return n - 4096 + 6152;
    if (n < 9216) return n - 7168 + 4096;
    return n - 9216 + 9224;
}

__device__ __forceinline__ void phase_p0(const DArgs& a, LAS unsigned char* lds, int vcu, int G) {
    const int tid = tid_(), lane = tid & 63, wave = tid >> 6;
    const int gw = vcu * NWAVES + wave, NGW = G * NWAVES;
    GAS unsigned char* ws = a.ws;
    LAS float* scr = (LAS float*)(lds + wave * 16384);
    constexpr int I_IN = 16 * 384, I_M = 32 * 32, I_G = 16 * 32, I_O = 16 * 32, I_PQ = 16 * 64;
    constexpr int NITEMS = I_IN + I_M + I_G + I_O + I_PQ;
    for (int it = gw; it < NITEMS; it += NGW) {
        int r = it;
        if (r < I_IN) { const int kb = r / 384, nb = r % 384; p0_transpose_item(a.w_in, IN_COLS, 1024, kb * 64, win_src_col(nb * 32), (GAS bf16_t*)(ws + WS_WIN), nb * 32, scr, lane); continue; } r -= I_IN;
        if (r < I_M) { const int kb = r / 32, nb = r % 32; p0_transpose_item(a.w_br_m, 1024, 2048, kb * 64, nb * 32, (GAS bf16_t*)(ws + WS_WM), nb * 32, scr, lane); continue; } r -= I_M;
        if (r < I_G) { const int kb = r / 32, nb = r % 32; p0_transpose_item(a.w_br_g, 1024, 1024, kb * 64, nb * 32, (GAS bf16_t*)(ws + WS_WG), nb * 32, scr, lane); continue; } r -= I_G;
        if (r < I_O) { const int kb = r / 32, nb = r % 32; p0_transpose_item(a.w_out, 1024, 1024, kb * 64, nb * 32, (GAS bf16_t*)(ws + WS_WO), nb * 32, scr, lane); continue; } r -= I_O;
        { const int kb = r / 64, nb = r % 64; p0_transpose_item(a.w_pq, 2048, 1024, kb * 64, nb * 32, (GAS bf16_t*)(ws + WS_WPQ), nb * 32, scr, lane); }
    }
    const int gt = vcu * NTHR + tid, NGT = G * NTHR;
    for (int i = gt; i < NP; i += NGT) ((float*)(ws + WS_BIASP))[i] = a.b_in[win_src_col(i)];
    for (int i = gt; i < 1024; i += NGT) { const float t0 = a.lb_table[i], t1 = a.lb_table[1024 + i]; ((float*)(ws + WS_LB))[i] = 1.0f / (1.0f + __expf(t1 - t0)); }
    for (int i = gt; i < 8 * 2 * 128 * 128 / 4; i += NGT) { const f32x4 v = ((const f32x4*)a.sub_keys)[i]; u32x2 o; o.x = pk2(v[0], v[1]); o.y = pk2(v[2], v[3]); ((u32x2*)(ws + WS_SK))[i] = o; }
    {
        float mu = 0.f, mv = 0.f;
        for (size_t i = (size_t)vcu * NTHR + tid; i < (size_t)16384 * 1024 / 4; i += (size_t)G * NTHR) {
            const f32x4 u4 = ((const GAS f32x4*)a.u_emb)[i], v4 = ((const GAS f32x4*)a.v_emb)[i];
            mu = fmaxf(mu, fmaxf(fmaxf(fabsf(u4[0]), fabsf(u4[1])), fmaxf(fabsf(u4[2]), fabsf(u4[3]))));
            mv = fmaxf(mv, fmaxf(fmaxf(fabsf(v4[0]), fabsf(v4[1])), fmaxf(fabsf(v4[2]), fabsf(v4[3])))); }
#pragma unroll
        for (int o = 1; o < 64; o <<= 1) { mu = fmaxf(mu, shx(mu, o, lane)); mv = fmaxf(mv, shx(mv, o, lane)); }
        if (lane == 0) { atomicMax((unsigned*)(ws + WS_CTL) + CW_TMAX, __builtin_bit_cast(unsigned, mu)); atomicMax((unsigned*)(ws + WS_CTL) + CW_TMAX + 1, __builtin_bit_cast(unsigned, mv)); }
    }
    f32x4 g1[4];
#pragma unroll
    for (int j = 0; j < 4; ++j) g1[j] = ((const GAS f32x4*)a.norm1_g)[64 * j + lane];
    f32x4 gw0[16], gw1[16];
#pragma unroll
    for (int j = 0; j < 4; ++j)
#pragma unroll
        for (int e = 0; e < 4; ++e) { const int k = 256 * j + 4 * lane + e; gw0[4 * j + e] = *(const GAS f32x4*)(a.w_in + (size_t)k * IN_COLS + 6144); gw1[4 * j + e] = *(const GAS f32x4*)(a.w_in + (size_t)k * IN_COLS + 6148); }
    const float gbias = lane < 8 ? a.b_in[6144 + lane] : 0.f;
    for (int m = gw; m < T; m += NGW) {
        const GAS f32x4* xr = (const GAS f32x4*)(a.x + (size_t)m * D) + lane;
        f32x4 v[4]; float s = 0.f;
#pragma unroll
        for (int j = 0; j < 4; ++j) { v[j] = xr[64 * j]; s += (v[j][0] * v[j][0] + v[j][1] * v[j][1]) + (v[j][2] * v[j][2] + v[j][3] * v[j][3]); }
        const float rstd = rsqrtf(wave_sum(s, lane) * (1.f / D) + EPS);
        GAS unsigned long long* o8 = (GAS unsigned long long*)((GAS bf16_t*)(ws + WS_XN) + (size_t)m * D) + lane;
        f32x4 ga0 = (f32x4){0.f, 0.f, 0.f, 0.f}, ga1 = ga0;
#pragma unroll
        for (int j = 0; j < 4; ++j) {
            v[j] = v[j] * rstd * g1[j];
            o8[64 * j] = (unsigned long long)pk2(v[j][0], v[j][1]) | ((unsigned long long)pk2(v[j][2], v[j][3]) << 32);
#pragma unroll
            for (int e = 0; e < 4; ++e) { ga0 += gw0[4 * j + e] * v[j][e]; ga1 += gw1[4 * j + e] * v[j][e]; }
        }
        float ga[8] = {ga0[0], ga0[1], ga0[2], ga0[3], ga1[0], ga1[1], ga1[2], ga1[3]};
#pragma unroll
        for (int q = 0; q < 8; ++q) ga[q] = wave_sum(ga[q], lane);
        if (lane < 8) { float r = ga[0];
#pragma unroll
            for (int q = 1; q < 8; ++q) r = (lane == q) ? ga[q] : r;
            ((GAS float*)(ws + WS_GATES))[(size_t)m * 8 + lane] = r + gbias; }
    }
}

__device__ __forceinline__ float logsigf_(float x) { return fminf(x, 0.f) - log1pf(__expf(-fabsf(x))); }
#define LDS_BAR() do { asm volatile("s_waitcnt lgkmcnt(0)" ::: "memory"); __builtin_amdgcn_s_barrier(); asm volatile("" ::: "memory"); } while (0)
#define MFMA16(a, b, c) __builtin_amdgcn_mfma_f32_16x16x32_bf16((a), (b), (c), 0, 0, 0)
__device__ __forceinline__ bf16x8 lfrag(const LAS unsigned char* base, int pitch, int row, int k0, int fq) { return *(const LAS bf16x8*)(base + row * pitch + (k0 + 8 * fq) * 2); }
__device__ __forceinline__ int fm_off(int r, int k, int KB) { return (((r >> 4) * KB + (k >> 5)) << 10) + (((((k >> 3) & 3) << 4) + (r & 15)) << 4) + ((k & 7) << 1); }
__device__ __forceinline__ bf16x8 gfrag(const bf16_t* base, int ld, int row, int k0, int fq) { return *(const bf16x8*)(base + (size_t)row * ld + k0 + 8 * fq); }

__device__ __forceinline__ void mscan_pair(const DArgs& a, LAS unsigned char* lds, int round, int p) {
    const int tid = tid_(), lane = tid & 63, part = tid >> 6;
    const int bl = p >> 2, h = p & 3, b = round * 2 + bl;
    const GAS float* g = (const GAS float*)(a.ws + WS_GATES) + ((size_t)b * SEQ + (size_t)lane * 128 + part * 16) * 8;
    float bsum = 0.f, gm = -INFINITY;
#pragma unroll 4
    for (int s = 0; s < 16; ++s) { const float ip = g[s * 8 + h], fp = g[s * 8 + 4 + h]; bsum += logsigf_(fp); gm = fmaxf(gm, ip - bsum); }
    LAS float* PS = (LAS float*)lds; LAS float* PM = PS + 512;
    PS[part * 64 + lane] = bsum; PM[part * 64 + lane] = gm;
    __syncthreads();
    if (tid < 64) {
        float bs = 0.f, g2 = -INFINITY;
#pragma unroll
        for (int q = 0; q < 8; ++q) { g2 = fmaxf(g2, PM[q * 64 + lane] - bs); bs += PS[q * 64 + lane]; }
        float mprev = 0.f, mine = 0.f;
        for (int c = 0; c < 64; ++c) {
            const float bc = rdlane(bs, c), gc = rdlane(g2, c);
            if (lane == c) mine = mprev; mprev = bc + fmaxf(mprev, gc); }
        ((GAS float*)(a.ws + WS_MPREV))[(round * 8 + p) * 64 + lane] = mine;
    }
    __syncthreads();
}

constexpr int PQ_PITCH = 528, PS_PITCH = 272;
__device__ __forceinline__ void mlstm_pre_item(const DArgs& a, LAS unsigned char* lds, int round, int item) {
    const int tid = tid_(), lane = tid & 63, wave = __builtin_amdgcn_readfirstlane(tid >> 6), fr = lane & 15, fq = lane >> 4;
    const int p = item >> 6, c = item & 63, bl = p >> 2, h = p & 3, b = round * 2 + bl;
    const int tl0 = bl * SEQ + c * 128; const size_t tg0 = (size_t)b * SEQ + c * 128;
    GAS unsigned char* ws = a.ws;
    LAS unsigned char* QL = lds; LAS unsigned char* KL = lds + 67584;
    LAS float* AS = (LAS float*)(lds + 135168); LAS float* MS = AS + 128; LAS float* SC = AS + 256;
    if (wave == 0) {
        const float mprev = ((const float*)(ws + WS_MPREV))[(round * 8 + p) * 64 + c];
        const float* g = (const float*)(ws + WS_GATES) + (tg0 + 2 * lane) * 8;
        const float ip0 = g[h], fp0 = g[4 + h], ip1 = g[8 + h], fp1 = g[12 + h];
        const float lf0 = logsigf_(fp0), lf1 = logsigf_(fp1), pp = lf0 + lf1;
        float incl = pp;
#pragma unroll
        for (int o = 1; o < 64; o <<= 1) { const float t = shup(incl, o, lane); if (lane >= o) incl += t; }
        const float excl = incl - pp, b0 = excl + lf0, b1 = incl;
        const float a0 = ip0 - b0, a1 = ip1 - b1;
        float inclm = fmaxf(a0, a1);
#pragma unroll
        for (int o = 1; o < 64; o <<= 1) { const float t = shup(inclm, o, lane); if (lane >= o) inclm = fmaxf(inclm, t); }
        float exclm = shup(inclm, 1, lane); if (lane == 0) exclm = -INFINITY;
        const float M0 = fmaxf(mprev, fmaxf(exclm, a0)), M1 = fmaxf(mprev, inclm);
        AS[2 * lane] = a0; AS[2 * lane + 1] = a1; MS[2 * lane] = M0; MS[2 * lane + 1] = M1;
        float* mt = (float*)(ws + WS_MT) + (tg0 + 2 * lane) * 4 + h;
        mt[0] = b0 + M0; mt[4] = b1 + M1;
        const float Mlast = rdlane(M1, 63);
        if (lane == 0) { SC[0] = mprev; SC[1] = Mlast; ((float*)(ws + WS_MDEC))[item] = __expf(mprev - Mlast); }
    }
    {
        const int cgp = tid & 63, strip = tid >> 6;
        const int col = (cgp < 32) ? (h * 256 + cgp * 8) : (1024 + h * 256 + (cgp - 32) * 8);
        float w[4][8], bb[8];
#pragma unroll
        for (int j = 0; j < 4; ++j) { const f32x4 w0 = *(const f32x4*)(a.conv_w + j * 2048 + col), w1 = *(const f32x4*)(a.conv_w + j * 2048 + col + 4);
#pragma unroll
            for (int e = 0; e < 4; ++e) { w[j][e] = w0[e]; w[j][4 + e] = w1[e]; } }
        { const f32x4 b0 = *(const f32x4*)(a.conv_b + col), b1 = *(const f32x4*)(a.conv_b + col + 4);
#pragma unroll
            for (int e = 0; e < 4; ++e) { bb[e] = b0[e]; bb[4 + e] = b1[e]; } }
        const bf16_t* src = (const bf16_t*)(ws + WS_QKPRE) + (size_t)(tl0 + 16 * strip) * 2048 + col;
        const float qs = (cgp < 32) ? 0.0625f : 1.0f;
        LAS unsigned char* dstt = ((cgp < 32) ? QL : KL) + (cgp & 31) * 16;
#pragma unroll 1
        for (int half = 0; half < 2; ++half) {
            u32x4 xr[11];
#pragma unroll
            for (int r = 0; r < 11; ++r) {
                const int sl = c * 128 + 16 * strip + 8 * half + r - 3;
                xr[r] = (sl >= 0) ? *(const u32x4*)(src + (ptrdiff_t)(8 * half + r - 3) * 2048) : (u32x4){0u, 0u, 0u, 0u};
            }
#pragma unroll
            for (int r = 0; r < 8; ++r) {
                float y[8];
#pragma unroll
                for (int e = 0; e < 8; ++e) y[e] = bb[e];
#pragma unroll
                for (int j = 0; j < 4; ++j) { const u32x4 xv = xr[r + j];
                    y[0] += w[j][0] * bf_lo(xv.x); y[1] += w[j][1] * bf_hi(xv.x); y[2] += w[j][2] * bf_lo(xv.y); y[3] += w[j][3] * bf_hi(xv.y);
                    y[4] += w[j][4] * bf_lo(xv.z); y[5] += w[j][5] * bf_hi(xv.z); y[6] += w[j][6] * bf_lo(xv.w); y[7] += w[j][7] * bf_hi(xv.w); }
#pragma unroll
                for (int e = 0; e < 8; ++e) y[e] = siluf_(y[e]) * qs;
                u32x4 o; o.x = pk2(y[0], y[1]); o.y = pk2(y[2], y[3]); o.z = pk2(y[4], y[5]); o.w = pk2(y[6], y[7]);
                *(LAS u32x4*)(dstt + (16 * strip + 8 * half + r) * PQ_PITCH) = o;
            }
        }
    }
    __syncthreads();
    const float mprev = SC[0], Mlast = SC[1];
    {
        bf16_t* Sg = (bf16_t*)(ws + WS_S) + (size_t)item * 128 * 128;
        const int t = wave * 16 + fr; const float Mt = MS[t];
        for (int st = 0; st < 8; ++st) {
            u32x2 o = (u32x2){0u, 0u};
            if (st <= wave) {
                f32x4 acc = (f32x4){0.f, 0.f, 0.f, 0.f};
#pragma unroll
                for (int ks = 0; ks < 8; ++ks) acc = MFMA16(lfrag(KL, PQ_PITCH, st * 16 + fr, ks * 32, fq), lfrag(QL, PQ_PITCH, wave * 16 + fr, ks * 32, fq), acc);
                float v[4];
#pragma unroll
                for (int j = 0; j < 4; ++j) { const int s = st * 16 + 4 * fq + j; v[j] = (s <= t) ? acc[j] * __expf(AS[s] - Mt) : 0.f; }
                o.x = pk2(v[0], v[1]); o.y = pk2(v[2], v[3]);
            }
            *(u32x2*)((unsigned char*)Sg + fm_off(t, st * 16 + 4 * fq, 4)) = o;
        }
    }
    {
        bf16_t* Qg = (bf16_t*)(ws + WS_QT) + (size_t)item * 128 * 256;
#pragma unroll
        for (int i = 0; i < 8; ++i) { const int idx = tid + 512 * i, blk = idx >> 6, t = (blk >> 3) * 16 + (idx & 15), ch = (blk & 7) * 4 + ((idx >> 4) & 3);
            const u32x4 v = *(const LAS u32x4*)(QL + t * PQ_PITCH + ch * 16); const float s = __expf(mprev - MS[t]);
            u32x4 o; o.x = pk2(bf_lo(v.x) * s, bf_hi(v.x) * s); o.y = pk2(bf_lo(v.y) * s, bf_hi(v.y) * s); o.z = pk2(bf_lo(v.z) * s, bf_hi(v.z) * s); o.w = pk2(bf_lo(v.w) * s, bf_hi(v.w) * s);
            *(u32x4*)((unsigned char*)Qg + fm_off(t, ch * 8, 8)) = o; }
    }
    {
        bf16_t* Kg = (bf16_t*)(ws + WS_KWT) + (size_t)item * 256 * 128;
        const int dlo = lane & 15, sglo = lane >> 4;
#pragma unroll
        for (int i = 0; i < 8; ++i) { const int combo = wave * 8 + i, d = (combo >> 2) * 16 + dlo, s0 = ((combo & 3) * 4 + sglo) * 8;
            float v[8];
#pragma unroll
            for (int e = 0; e < 8; ++e) v[e] = bf2f(*(const LAS bf16_t*)(KL + (s0 + e) * PQ_PITCH + d * 2)) * __expf(AS[s0 + e] - Mlast);
            u32x4 o; o.x = pk2(v[0], v[1]); o.y = pk2(v[2], v[3]); o.z = pk2(v[4], v[5]); o.w = pk2(v[6], v[7]);
            *(u32x4*)((unsigned char*)Kg + fm_off(d, s0, 4)) = o; }
    }
    __syncthreads();
}

__device__ __forceinline__ void hgrn_pre_item(const DArgs& a, LAS unsigned char* lds, int round, int item) {
    const int tid = tid_(), lane = tid & 63, wave = __builtin_amdgcn_readfirstlane(tid >> 6), fr = lane & 15, fq = lane >> 4;
    const int p = item >> 7, c = item & 127, bl = p >> 3, h = p & 7;
    const int tl0 = bl * SEQ + c * 64;
    GAS unsigned char* ws = a.ws;
    LAS float* CUM = (LAS float*)lds;
    LAS float* GL = (LAS float*)(lds + 32768);
    LAS unsigned char* QH = lds + 65536;
    LAS unsigned char* KE = lds + 65536 + 64 * PS_PITCH;
    LAS float* QF = (LAS float*)(lds + 65536 + 128 * PS_PITCH);
#pragma unroll
    for (int i = 0; i < 2; ++i) { const int idx = tid + 512 * i, s = idx >> 4, ch = idx & 15;
        const u32x4 gv = *(const u32x4*)((const bf16_t*)(ws + WS_GFLOG) + (size_t)(tl0 + s) * 1024 + h * 128 + ch * 8);
        const u32x4 qv = *(const u32x4*)((const bf16_t*)(ws + WS_GQ) + (size_t)(tl0 + s) * 1024 + h * 128 + ch * 8);
        LAS float* gd = GL + s * 128 + ch * 8; LAS float* qd = QF + s * 128 + ch * 8;
        gd[0] = bf_lo(gv.x); gd[1] = bf_hi(gv.x); gd[2] = bf_lo(gv.y); gd[3] = bf_hi(gv.y); gd[4] = bf_lo(gv.z); gd[5] = bf_hi(gv.z); gd[6] = bf_lo(gv.w); gd[7] = bf_hi(gv.w);
        qd[0] = bf_lo(qv.x); qd[1] = bf_hi(qv.x); qd[2] = bf_lo(qv.y); qd[3] = bf_hi(qv.y); qd[4] = bf_lo(qv.z); qd[5] = bf_hi(qv.z); qd[6] = bf_lo(qv.w); qd[7] = bf_hi(qv.w); }
    __syncthreads();
    {
        const int d = tid & 127, qt = tid >> 7; float cs = 0.f;
#pragma unroll 4
        for (int s = 0; s < 16; ++s) { cs += GL[(qt * 16 + s) * 128 + d]; CUM[(qt * 16 + s) * 128 + d] = cs; }
        __syncthreads();
        float off = 0.f;
#pragma unroll
        for (int q = 0; q < 3; ++q) off += (q < qt) ? CUM[(q * 16 + 15) * 128 + d] : 0.f;
        __syncthreads();
#pragma unroll 4
        for (int s = 0; s < 16; ++s) CUM[(qt * 16 + s) * 128 + d] += off;
        if (qt == 3) ((GAS float*)(ws + WS_HGDEC))[(size_t)item * 128 + d] = __expf(cs + off);
    }
    __syncthreads();
    {
        bf16_t* Qg = (bf16_t*)(ws + WS_QTG) + (size_t)item * 64 * 128;
#pragma unroll
        for (int i = 0; i < 2; ++i) { const int idx = tid + 512 * i, s = idx >> 4, ch = idx & 15;
            float qt[8], qh[8], ke[8];
#pragma unroll
            for (int e = 0; e < 8; ++e) { const int d = ch * 8 + e; const float cm = CUM[s * 128 + d], last = CUM[63 * 128 + d], q = QF[s * 128 + d], g = GL[s * 128 + d];
                qt[e] = q * __expf(cm); qh[e] = q * __expf(cm - last); ke[e] = (1.0f - __expf(g)) * __expf(last - cm); }
            u32x4 o; o.x = pk2(qt[0], qt[1]); o.y = pk2(qt[2], qt[3]); o.z = pk2(qt[4], qt[5]); o.w = pk2(qt[6], qt[7]);
            *(u32x4*)((unsigned char*)Qg + fm_off(s, ch * 8, 4)) = o;
            o.x = pk2(qh[0], qh[1]); o.y = pk2(qh[2], qh[3]); o.z = pk2(qh[4], qh[5]); o.w = pk2(qh[6], qh[7]);
            *(LAS u32x4*)(QH + s * PS_PITCH + ch * 16) = o;
            o.x = pk2(ke[0], ke[1]); o.y = pk2(ke[2], ke[3]); o.z = pk2(ke[4], ke[5]); o.w = pk2(ke[6], ke[7]);
            *(LAS u32x4*)(KE + s * PS_PITCH + ch * 16) = o; }
    }
    __syncthreads();
    {
        bf16_t* Ag = (bf16_t*)(ws + WS_ATT) + (size_t)item * 64 * 64;
#pragma unroll
        for (int i = 0; i < 2; ++i) { const int tile = wave * 2 + i, tt = tile >> 2, st = tile & 3; const int t = tt * 16 + fr;
            u32x2 o = (u32x2){0u, 0u};
            if (st <= tt) { f32x4 acc = (f32x4){0.f, 0.f, 0.f, 0.f};
#pragma unroll
                for (int ks = 0; ks < 4; ++ks) acc = MFMA16(lfrag(KE, PS_PITCH, st * 16 + fr, ks * 32, fq), lfrag(QH, PS_PITCH, tt * 16 + fr, ks * 32, fq), acc);
                float v[4];
#pragma unroll
                for (int j = 0; j < 4; ++j) { const int s = st * 16 + 4 * fq + j; v[j] = (s <= t) ? acc[j] : 0.f; }
                o.x = pk2(v[0], v[1]); o.y = pk2(v[2], v[3]); }
            *(u32x2*)((unsigned char*)Ag + fm_off(t, st * 16 + 4 * fq, 2)) = o; }
    }
    {
        bf16_t* Kg = (bf16_t*)(ws + WS_KENDT) + (size_t)item * 128 * 64;
        const int dlo = lane & 15, sglo = lane >> 4;
#pragma unroll
        for (int i = 0; i < 2; ++i) { const int combo = wave * 2 + i, d = (combo >> 1) * 16 + dlo, s0 = ((combo & 1) * 4 + sglo) * 8;
            unsigned v[8];
#pragma unroll
            for (int e = 0; e < 8; ++e) v[e] = *(const LAS bf16_t*)(KE + (s0 + e) * PS_PITCH + d * 2);
            u32x4 o; o.x = v[0] | (v[1] << 16); o.y = v[2] | (v[3] << 16); o.z = v[4] | (v[5] << 16); o.w = v[6] | (v[7] << 16);
            *(u32x4*)((unsigned char*)Kg + fm_off(d, s0, 2)) = o; }
    }
    __syncthreads();
}

__device__ __forceinline__ void mlstm_scan(const DArgs& a, LAS unsigned char* lds, int round, int p, int sl) {
    const int tid = tid_(), lane = tid & 63, wave = __builtin_amdgcn_readfirstlane(tid >> 6), fr = lane & 15, fq = lane >> 4;
    const int bl = p >> 2, h = p & 3, b = round * 2 + bl;
    GAS unsigned char* ws = a.ws;
    constexpr int VTB = 48 * PS_PITCH, CTB = 48 * PQ_PITCH;
    LAS unsigned char* VT = lds; LAS unsigned char* CT = lds + 2 * VTB;
    for (int i = tid; i < (2 * VTB + 2 * CTB) / 4; i += NTHR) ((LAS unsigned*)lds)[i] = 0u;
    __syncthreads();
    if (tid < 256) { const int bufi = tid >> 7, s = tid & 127; *(LAS bf16_t*)(VT + bufi * VTB + 32 * PS_PITCH + s * 2) = (bf16_t)0x3F80; }
    f32x4 st[2][3];
#pragma unroll
    for (int dt = 0; dt < 2; ++dt)
#pragma unroll
        for (int vt = 0; vt < 3; ++vt) st[dt][vt] = (f32x4){0.f, 0.f, 0.f, 0.f};
    const int vcol = h * 512 + sl * 32;
    const int vs = tid >> 2, vpart = tid & 3;
    const GAS unsigned char* Sg0 = ws + WS_S + (size_t)(p * 64) * 32768 + wave * 4096 + lane * 16;
    const GAS unsigned char* Qg0 = ws + WS_QT + (size_t)(p * 64) * 65536 + wave * 8192 + lane * 16;
    const GAS unsigned char* Kg0 = ws + WS_KWT + (size_t)(p * 64) * 65536 + wave * 8192 + lane * 16;
    const bf16_t* Vg0 = (const bf16_t*)(ws + WS_V) + (size_t)(bl * SEQ + vs) * 2048 + vcol + vpart * 8;
    bf16x8 bS[4], bQ[8], aK[2][4]; u32x4 vreg; float dec;
    vreg = *(const u32x4*)Vg0;
#pragma unroll
    for (int ks = 0; ks < 4; ++ks) bS[ks] = *(const GAS bf16x8*)(Sg0 + ks * 1024);
#pragma unroll
    for (int ks = 0; ks < 8; ++ks) bQ[ks] = *(const GAS bf16x8*)(Qg0 + ks * 1024);
#pragma unroll
    for (int dt = 0; dt < 2; ++dt)
#pragma unroll
        for (int ks = 0; ks < 4; ++ks) aK[dt][ks] = *(const GAS bf16x8*)(Kg0 + (dt * 4 + ks) * 1024);
    dec = ((const GAS float*)(ws + WS_MDEC))[p * 64];
#pragma unroll 1
    for (int c = 0; c < 64; ++c) {
        const int tl0 = bl * SEQ + c * 128; const size_t tg0 = (size_t)b * SEQ + c * 128;
        const int cn = c < 63 ? c + 1 : 63;
        LAS unsigned char* vt_ = VT + (c & 1) * VTB; LAS unsigned char* ct_ = CT + (c & 1) * CTB; LAS unsigned char* ctn = CT + ((c + 1) & 1) * CTB;
        {
            LAS unsigned char* d0 = vt_ + (vpart * 8) * PS_PITCH + vs * 2;
            *(LAS bf16_t*)(d0 + 0 * PS_PITCH) = (bf16_t)(vreg.x & 0xffffu); *(LAS bf16_t*)(d0 + 1 * PS_PITCH) = (bf16_t)(vreg.x >> 16);
            *(LAS bf16_t*)(d0 + 2 * PS_PITCH) = (bf16_t)(vreg.y & 0xffffu); *(LAS bf16_t*)(d0 + 3 * PS_PITCH) = (bf16_t)(vreg.y >> 16);
            *(LAS bf16_t*)(d0 + 4 * PS_PITCH) = (bf16_t)(vreg.z & 0xffffu); *(LAS bf16_t*)(d0 + 5 * PS_PITCH) = (bf16_t)(vreg.z >> 16);
            *(LAS bf16_t*)(d0 + 6 * PS_PITCH) = (bf16_t)(vreg.w & 0xffffu); *(LAS bf16_t*)(d0 + 7 * PS_PITCH) = (bf16_t)(vreg.w >> 16);
            vreg = *(const u32x4*)(Vg0 + (size_t)cn * 128 * 2048);
        }
        LDS_BAR();
        bf16x8 vf[3][4];
#pragma unroll
        for (int vt = 0; vt < 3; ++vt)
#pragma unroll
            for (int ks = 0; ks < 4; ++ks) vf[vt][ks] = lfrag(vt_, PS_PITCH, vt * 16 + fr, ks * 32, fq);
        {
            f32x4 acc[3];
#pragma unroll
            for (int vt = 0; vt < 3; ++vt) acc[vt] = (f32x4){0.f, 0.f, 0.f, 0.f};
            bf16x8 cf[3][4];
#pragma unroll
            for (int vt = 0; vt < 3; ++vt)
#pragma unroll
                for (int ks = 0; ks < 4; ++ks) cf[vt][ks] = lfrag(ct_, PQ_PITCH, vt * 16 + fr, ks * 32, fq);
            __builtin_amdgcn_sched_barrier(0);
#pragma unroll
            for (int ks = 0; ks < 4; ++ks) {
#pragma unroll
                for (int vt = 0; vt < 3; ++vt) acc[vt] = MFMA16(vf[vt][ks], bS[ks], acc[vt]); }
#pragma unroll
            for (int ks = 0; ks < 4; ++ks) {
#pragma unroll
                for (int vt = 0; vt < 3; ++vt) acc[vt] = MFMA16(cf[vt][ks], bQ[ks], acc[vt]); }
            __builtin_amdgcn_sched_barrier(0);
#pragma unroll
            for (int vt = 0; vt < 3; ++vt)
#pragma unroll
                for (int ks = 0; ks < 4; ++ks) cf[vt][ks] = lfrag(ct_, PQ_PITCH, vt * 16 + fr, 128 + ks * 32, fq);
            __builtin_amdgcn_sched_barrier(0);
#pragma unroll
            for (int ks = 0; ks < 4; ++ks) {
#pragma unroll
                for (int vt = 0; vt < 3; ++vt) acc[vt] = MFMA16(cf[vt][ks], bQ[4 + ks], acc[vt]); }
            __builtin_amdgcn_sched_barrier(0);
#pragma unroll
            for (int ks = 0; ks < 4; ++ks) bS[ks] = *(const GAS bf16x8*)(Sg0 + (size_t)cn * 32768 + ks * 1024);
#pragma unroll
            for (int ks = 0; ks < 8; ++ks) bQ[ks] = *(const GAS bf16x8*)(Qg0 + (size_t)cn * 65536 + ks * 1024);
            const int t = wave * 16 + fr;
            bf16_t* hn = (bf16_t*)(ws + WS_QKPRE) + (size_t)(tl0 + t) * 2048 + vcol + 4 * fq;
#pragma unroll
            for (int vt = 0; vt < 2; ++vt) { u32x2 o; o.x = pk2(acc[vt][0], acc[vt][1]); o.y = pk2(acc[vt][2], acc[vt][3]); *(u32x2*)(hn + vt * 16) = o; }
            if (sl == 0 && fq == 0) ((float*)(ws + WS_DEN))[(tg0 + t) * 4 + h] = acc[2][0];
        }
        {
#pragma unroll
            for (int dt = 0; dt < 2; ++dt)
#pragma unroll
                for (int vt = 0; vt < 3; ++vt) st[dt][vt] = st[dt][vt] * dec;
#pragma unroll
            for (int ks = 0; ks < 4; ++ks) {
#pragma unroll
                for (int dt = 0; dt < 2; ++dt) {
#pragma unroll
                    for (int vt = 0; vt < 3; ++vt) st[dt][vt] = MFMA16(aK[dt][ks], vf[vt][ks], st[dt][vt]); }
            }
            __builtin_amdgcn_sched_barrier(0);
#pragma unroll
            for (int dt = 0; dt < 2; ++dt)
#pragma unroll
                for (int ks = 0; ks < 4; ++ks) aK[dt][ks] = *(const GAS bf16x8*)(Kg0 + (size_t)cn * 65536 + (dt * 4 + ks) * 1024);
            dec = ((const float*)(ws + WS_MDEC))[p * 64 + cn];
#pragma unroll
            for (int dt = 0; dt < 2; ++dt)
#pragma unroll
                for (int vt = 0; vt < 3; ++vt) { u32x2 o; o.x = pk2(st[dt][vt][0], st[dt][vt][1]); o.y = pk2(st[dt][vt][2], st[dt][vt][3]);
                    *(LAS u32x2*)(ctn + (vt * 16 + fr) * PQ_PITCH + (wave * 32 + dt * 16 + 4 * fq) * 2) = o; }
        }
    }
    __syncthreads();
}

constexpr int HG_PD = 4;
__device__ __forceinline__ void hgrn_scan(const DArgs& a, LAS unsigned char* lds, int round, int p, int sl) {
    const int tid = tid_(), lane = tid & 63, wave = __builtin_amdgcn_readfirstlane(tid >> 6), fr = lane & 15, fq = lane >> 4;
    const int bl = p >> 3, h = p & 7;
    GAS unsigned char* ws = a.ws;
    constexpr int IP = 144, ITB = 32 * IP, STB = 32 * PS_PITCH;
    LAS unsigned char* IT = lds; LAS unsigned char* ST = lds + 2 * ITB;
    for (int i = tid; i < (2 * ITB + 2 * STB) / 4; i += NTHR) ((LAS unsigned*)lds)[i] = 0u;
    __syncthreads();
    f32x4 st[2];
    st[0] = (f32x4){0.f, 0.f, 0.f, 0.f}; st[1] = st[0];
    const int vcol = h * 128 + sl * 32;
    const int is = (tid & 255) >> 2, ipart = tid & 3;
    const int w4 = wave & 3, vtw = wave >> 2;
    const GAS unsigned char* Ag0 = ws + WS_ATT + (size_t)(p * 128) * 8192 + w4 * 2048 + lane * 16;
    const GAS unsigned char* Qg0 = ws + WS_QTG + (size_t)(p * 128) * 16384 + w4 * 4096 + lane * 16;
    const GAS unsigned char* Kg0 = ws + WS_KENDT + (size_t)(p * 128) * 16384 + wave * 2048 + lane * 16;
    const GAS float* Dg0 = (const GAS float*)(ws + WS_HGDEC) + (size_t)(p * 128) * 128 + wave * 16 + 4 * fq;
    const GAS bf16_t* Ig0 = (const GAS bf16_t*)(ws + WS_GI) + (size_t)(bl * SEQ + is) * 1024 + vcol + ipart * 8;
    bf16x8 bA[HG_PD][2], bQ[HG_PD][4], aK[HG_PD][2]; f32x4 dec[HG_PD]; u32x4 ireg[HG_PD];
#pragma unroll
    for (int k = 0; k < HG_PD; ++k) {
        ireg[k] = *(const GAS u32x4*)(Ig0 + (size_t)k * 64 * 1024);
#pragma unroll
        for (int ks = 0; ks < 2; ++ks) bA[k][ks] = *(const GAS bf16x8*)(Ag0 + (size_t)k * 8192 + ks * 1024);
#pragma unroll
        for (int ks = 0; ks < 4; ++ks) bQ[k][ks] = *(const GAS bf16x8*)(Qg0 + (size_t)k * 16384 + ks * 1024);
#pragma unroll
        for (int ks = 0; ks < 2; ++ks) aK[k][ks] = *(const GAS bf16x8*)(Kg0 + (size_t)k * 16384 + ks * 1024);
        dec[k] = *(const GAS f32x4*)(Dg0 + (size_t)k * 128);
    }
#pragma unroll 1
    for (int c0 = 0; c0 < 128; c0 += HG_PD) {
#pragma unroll
      for (int k = 0; k < HG_PD; ++k) {
        const int c = c0 + k;
        const int tl0 = bl * SEQ + c * 64;
        const int cn = (c + HG_PD < 128) ? c + HG_PD : 127;
        LAS unsigned char* it_ = IT + (k & 1) * ITB; LAS unsigned char* st_ = ST + (k & 1) * STB; LAS unsigned char* stn = ST + ((k + 1) & 1) * STB;
        {
            if (tid < 256) {
                LAS unsigned char* d0 = it_ + (ipart * 8) * IP + is * 2;
                *(LAS bf16_t*)(d0 + 0 * IP) = (bf16_t)(ireg[k].x & 0xffffu); *(LAS bf16_t*)(d0 + 1 * IP) = (bf16_t)(ireg[k].x >> 16);
                *(LAS bf16_t*)(d0 + 2 * IP) = (bf16_t)(ireg[k].y & 0xffffu); *(LAS bf16_t*)(d0 + 3 * IP) = (bf16_t)(ireg[k].y >> 16);
                *(LAS bf16_t*)(d0 + 4 * IP) = (bf16_t)(ireg[k].z & 0xffffu); *(LAS bf16_t*)(d0 + 5 * IP) = (bf16_t)(ireg[k].z >> 16);
                *(LAS bf16_t*)(d0 + 6 * IP) = (bf16_t)(ireg[k].w & 0xffffu); *(LAS bf16_t*)(d0 + 7 * IP) = (bf16_t)(ireg[k].w >> 16); }
            ireg[k] = *(const GAS u32x4*)(Ig0 + (size_t)cn * 64 * 1024);
        }
        LDS_BAR();
        bf16x8 itf[2][2];
#pragma unroll
        for (int vt = 0; vt < 2; ++vt)
#pragma unroll
            for (int ks = 0; ks < 2; ++ks) itf[vt][ks] = lfrag(it_, IP, vt * 16 + fr, ks * 32, fq);
        {
            bf16x8 sf[4];
#pragma unroll
            for (int ks = 0; ks < 4; ++ks) sf[ks] = lfrag(st_, PS_PITCH, vtw * 16 + fr, ks * 32, fq);
            f32x4 acc = (f32x4){0.f, 0.f, 0.f, 0.f};
#pragma unroll
            for (int ks = 0; ks < 2; ++ks) acc = MFMA16(vtw ? itf[1][ks] : itf[0][ks], bA[k][ks], acc);
#pragma unroll
            for (int ks = 0; ks < 4; ++ks) acc = MFMA16(sf[ks], bQ[k][ks], acc);
            __builtin_amdgcn_sched_barrier(0);
#pragma unroll
            for (int ks = 0; ks < 2; ++ks) bA[k][ks] = *(const GAS bf16x8*)(Ag0 + (size_t)cn * 8192 + ks * 1024);
#pragma unroll
            for (int ks = 0; ks < 4; ++ks) bQ[k][ks] = *(const GAS bf16x8*)(Qg0 + (size_t)cn * 16384 + ks * 1024);
            u32x2 o; o.x = pk2(acc[0], acc[1]); o.y = pk2(acc[2], acc[3]);
            *(GAS u32x2*)((GAS bf16_t*)(ws + WS_GQ) + (size_t)(tl0 + w4 * 16 + fr) * 1024 + vcol + vtw * 16 + 4 * fq) = o;
        }
        {
#pragma unroll
            for (int vt = 0; vt < 2; ++vt) { st[vt] = st[vt] * dec[k];
#pragma unroll
                for (int ks = 0; ks < 2; ++ks) st[vt] = MFMA16(aK[k][ks], itf[vt][ks], st[vt]); }
            __builtin_amdgcn_sched_barrier(0);
#pragma unroll
            for (int ks = 0; ks < 2; ++ks) aK[k][ks] = *(const GAS bf16x8*)(Kg0 + (size_t)cn * 16384 + ks * 1024);
            dec[k] = *(const GAS f32x4*)(Dg0 + (size_t)cn * 128);
#pragma unroll
            for (int vt = 0; vt < 2; ++vt) { u32x2 o; o.x = pk2(st[vt][0], st[vt][1]); o.y = pk2(st[vt][2], st[vt][3]);
                *(LAS u32x2*)(stn + (vt * 16 + fr) * PS_PITCH + (wave * 16 + 4 * fq) * 2) = o; }
        }
      }
    }
    __syncthreads();
}

__device__ __forceinline__ void phase_ypass(const DArgs& a, int round, int vcu, int G) {
    const int tid = tid_(), lane = tid & 63, wave = tid >> 6;
    const int gw = vcu * NWAVES + wave, NGW = G * NWAVES;
    GAS unsigned char* ws = a.ws;
    f32x4 mg0[4], mg1[4], gg4[4];
#pragma unroll
    for (int j = 0; j < 4; ++j) { mg0[j] = *(const GAS f32x4*)(a.m_head_g + j * 512 + lane * 8); mg1[j] = *(const GAS f32x4*)(a.m_head_g + j * 512 + lane * 8 + 4); gg4[j] = *(const GAS f32x4*)(a.g_head_g + lane * 16 + 4 * j); }
    for (int tl = gw; tl < RT; tl += NGW) {
        const size_t tg = (size_t)round * RT + tl;
        const f32x4 den4 = *(const f32x4*)((const float*)(ws + WS_DEN) + tg * 4), mt4 = *(const f32x4*)((const float*)(ws + WS_MT) + tg * 4);
#pragma unroll
        for (int j = 0; j < 4; ++j) {
            const int col = j * 512 + lane * 8;
            const u32x4 nv = *(const u32x4*)((const bf16_t*)(ws + WS_QKPRE) + (size_t)tl * 2048 + col);
            const u32x4 ov = *(const u32x4*)((const bf16_t*)(ws + WS_SIGO) + (size_t)tl * 2048 + col);
            const float inv = 1.0f / fmaxf(fabsf(den4[j]), __expf(-mt4[j]));
            float hv[8] = {bf_lo(nv.x) * inv, bf_hi(nv.x) * inv, bf_lo(nv.y) * inv, bf_hi(nv.y) * inv, bf_lo(nv.z) * inv, bf_hi(nv.z) * inv, bf_lo(nv.w) * inv, bf_hi(nv.w) * inv};
            float ss = 0.f;
#pragma unroll
            for (int e = 0; e < 8; ++e) ss += hv[e] * hv[e];
            const float r = rsqrtf(wave_sum(ss, lane) * (1.f / 512.f) + EPS);
            const f32x4 g0 = mg0[j], g1 = mg1[j];
            const float og[8] = {bf_lo(ov.x), bf_hi(ov.x), bf_lo(ov.y), bf_hi(ov.y), bf_lo(ov.z), bf_hi(ov.z), bf_lo(ov.w), bf_hi(ov.w)};
            float y[8];
#pragma unroll
            for (int e = 0; e < 8; ++e) y[e] = og[e] * hv[e] * r * (e < 4 ? g0[e] : g1[e - 4]);
            u32x4 o; o.x = pk2(y[0], y[1]); o.y = pk2(y[2], y[3]); o.z = pk2(y[4], y[5]); o.w = pk2(y[6], y[7]);
            *(u32x4*)((bf16_t*)(ws + WS_V) + (size_t)tl * 2048 + col) = o;
        }
        {
            const int col = lane * 16;
            const u32x4 n0 = *(const u32x4*)((const bf16_t*)(ws + WS_GQ) + (size_t)tl * 1024 + col), n1 = *(const u32x4*)((const bf16_t*)(ws + WS_GQ) + (size_t)tl * 1024 + col + 8);
            const u32x4 s0 = *(const u32x4*)((const bf16_t*)(ws + WS_SGG) + (size_t)tl * 1024 + col), s1 = *(const u32x4*)((const bf16_t*)(ws + WS_SGG) + (size_t)tl * 1024 + col + 8);
            float ov[16] = {bf_lo(n0.x), bf_hi(n0.x), bf_lo(n0.y), bf_hi(n0.y), bf_lo(n0.z), bf_hi(n0.z), bf_lo(n0.w), bf_hi(n0.w), bf_lo(n1.x), bf_hi(n1.x), bf_lo(n1.y), bf_hi(n1.y), bf_lo(n1.z), bf_hi(n1.z), bf_lo(n1.w), bf_hi(n1.w)};
            const float sg[16] = {bf_lo(s0.x), bf_hi(s0.x), bf_lo(s0.y), bf_hi(s0.y), bf_lo(s0.z), bf_hi(s0.z), bf_lo(s0.w), bf_hi(s0.w), bf_lo(s1.x), bf_hi(s1.x), bf_lo(s1.y), bf_hi(s1.y), bf_lo(s1.z), bf_hi(s1.z), bf_lo(s1.w), bf_hi(s1.w)};
            float ss = 0.f;
#pragma unroll
            for (int e = 0; e < 16; ++e) ss += ov[e] * ov[e];
            ss += DPP_(ss, 0xB1); ss += DPP_(ss, 0x4E); ss += DPP_(ss, 0x141);
            const float r = rsqrtf(ss * (1.f / 128.f) + EPS);
            float y[16];
#pragma unroll
            for (int e = 0; e < 16; ++e) y[e] = ov[e] * r * gg4[e >> 2][e & 3] * sg[e];
            u32x4 o; o.x = pk2(y[0], y[1]); o.y = pk2(y[2], y[3]); o.z = pk2(y[4], y[5]); o.w = pk2(y[6], y[7]);
            *(u32x4*)((bf16_t*)(ws + WS_GI) + (size_t)tl * 1024 + col) = o;
            o.x = pk2(y[8], y[9]); o.y = pk2(y[10], y[11]); o.z = pk2(y[12], y[13]); o.w = pk2(y[14], y[15]);
            *(u32x4*)((bf16_t*)(ws + WS_GI) + (size_t)tl * 1024 + col + 8) = o;
        }
    }
}


#define XB_TMO      128
#define XB_XCNT(j)  (256  + 64 * (j))
#define XB_XSUB(j)  (1280 + 64 * (j))
#define XB_XGEN(j)  (2304 + 64 * (j))
#define XB_TOP      3328
#define XB_TOPGEN   3392
#define XB_SPIN_CAP (1u << 22)
constexpr int CW_BAR = 4096;
constexpr int LDS_BARST = LDS_BYTES - 64;
__device__ __forceinline__ unsigned xb_ld(unsigned* p)              { return __hip_atomic_load(p, __ATOMIC_RELAXED, __HIP_MEMORY_SCOPE_AGENT); }
__device__ __forceinline__ unsigned xb_add(unsigned* p, unsigned v) { return __hip_atomic_fetch_add(p, v, __ATOMIC_RELAXED, __HIP_MEMORY_SCOPE_AGENT); }
__device__ __forceinline__ unsigned xb_xcc_id() { return (unsigned)__builtin_amdgcn_s_getreg((3 << 11) | 20) & 0xFu; }
#define XB_SPIN(cond, bar) do { unsigned _sp = 0; while (cond) { __builtin_amdgcn_s_sleep(1); \
    if ((++_sp & 255u) == 0u) { if (xb_ld(&(bar)[XB_TMO])) break; if (_sp > XB_SPIN_CAP) { atomicAdd(&(bar)[XB_TMO], 1u); break; } } } } while (0)
__device__ __forceinline__ void xcd_barrier_post(unsigned* bar, volatile LAS unsigned* st) { if (tid_() == 0) st[2] = xb_add(&bar[XB_XCNT(xb_xcc_id())], 1u); }
__device__ __forceinline__ void xcd_barrier_complete(unsigned* bar, unsigned x, unsigned& nloc, unsigned& nx) {
    const unsigned G = gridDim.x;
    unsigned sum, cnt, mine, sp = 0u;
    for (;;) {
        sum = 0u; cnt = 0u; mine = 0u;
#pragma unroll
        for (unsigned j = 0; j < 16; ++j) { const unsigned c = xb_ld(&bar[XB_XCNT(j)]); sum += c; cnt += (c > 0u) ? 1u : 0u; mine = (j == x) ? c : mine; }
        if (sum == G) break;
        __builtin_amdgcn_s_sleep(1);
        if ((++sp & 255u) == 0u) { if (xb_ld(&bar[XB_TMO])) break; if (sp > XB_SPIN_CAP) { atomicAdd(&bar[XB_TMO], 1u); break; } }
    }
    nloc = mine > 0u ? mine : 1u; nx = cnt > 0u ? cnt : 1u;
}
__device__ __forceinline__ void xcd_barrier(unsigned* bar, volatile LAS unsigned* st) {
    asm volatile("s_waitcnt vmcnt(0)" ::: "memory");
    __syncthreads();
    if (tid_() == 0) {
        const unsigned x = xb_xcc_id();
        __builtin_amdgcn_s_waitcnt(0);
        unsigned nloc = st[0], nx = st[1];
        if (nloc == 0u) { xcd_barrier_complete(bar, x, nloc, nx); st[0] = nloc; st[1] = nx; }
        const unsigned old = xb_add(&bar[XB_XSUB(x)], 1u);
        const unsigned gen = old / nloc;
        if (old + 1u == (gen + 1u) * nloc) {
            __builtin_amdgcn_fence(__ATOMIC_RELEASE, "agent");
            asm volatile("s_waitcnt vmcnt(0)" ::: "memory");
            const unsigned og = xb_add(&bar[XB_TOP], 1u);
            const unsigned tg = og / nx;
            if (og + 1u == (tg + 1u) * nx) xb_add(&bar[XB_TOPGEN], 1u);
            else XB_SPIN(xb_ld(&bar[XB_TOPGEN]) == tg, bar);
            __builtin_amdgcn_fence(__ATOMIC_ACQUIRE, "agent");
            xb_add(&bar[XB_XGEN(x)], 1u);
            asm volatile("s_waitcnt vmcnt(0)" ::: "memory");
        } else {
            XB_SPIN(xb_ld(&bar[XB_XGEN(x)]) == gen, bar);
            __builtin_amdgcn_fence(__ATOMIC_ACQUIRE, "agent");
            asm volatile("s_waitcnt vmcnt(0)" ::: "memory");
        }
    }
    __syncthreads();
}

__device__ __forceinline__ void phase_p8(const DArgs& a, int vcu, int G) {
    const int tid = tid_(), lane = tid & 63, wave = tid >> 6;
    const int gw = vcu * NWAVES + wave, NGW = G * NWAVES;
    GAS unsigned char* ws = a.ws;
    f32x4 g2[4];
#pragma unroll
    for (int j = 0; j < 4; ++j) g2[j] = ((const f32x4*)a.norm2_g)[64 * j + lane];
    for (int m = gw; m < T; m += NGW) {
        const f32x4* xr = (const f32x4*)(a.out + (size_t)m * D) + lane;
        f32x4 v[4]; float s = 0.f;
#pragma unroll
        for (int j = 0; j < 4; ++j) { v[j] = xr[64 * j]; s += (v[j][0] * v[j][0] + v[j][1] * v[j][1]) + (v[j][2] * v[j][2] + v[j][3] * v[j][3]); }
        const float rstd = rsqrtf(wave_sum(s, lane) * (1.f / D) + EPS);
        unsigned long long* o8 = (unsigned long long*)((bf16_t*)(ws + WS_XN) + (size_t)m * D) + lane;
#pragma unroll
        for (int j = 0; j < 4; ++j) { v[j] = v[j] * rstd * g2[j]; o8[64 * j] = (unsigned long long)pk2(v[j][0], v[j][1]) | ((unsigned long long)pk2(v[j][2], v[j][3]) << 32); }
    }
    {
        const float mu = __builtin_bit_cast(float, ((const GAS unsigned*)(ws + WS_CTL))[CW_TMAX]), mv = __builtin_bit_cast(float, ((const GAS unsigned*)(ws + WS_CTL))[CW_TMAX + 1]);
        const float su = mu > 0.f ? 448.0f / mu : 1.0f, sv = mv > 0.f ? 448.0f / mv : 1.0f;
        if (vcu == 0 && tid == 0) { ((GAS float*)(ws + WS_USC))[0] = 1.0f / su; ((GAS float*)(ws + WS_USC))[1] = 1.0f / sv; }
        for (size_t i = (size_t)vcu * NTHR + tid; i < (size_t)16384 * 1024 / 8; i += (size_t)G * NTHR) {
            const f32x4 u0 = ((const GAS f32x4*)a.u_emb)[2 * i], u1 = ((const GAS f32x4*)a.u_emb)[2 * i + 1];
            const f32x4 v0 = ((const GAS f32x4*)a.v_emb)[2 * i], v1 = ((const GAS f32x4*)a.v_emb)[2 * i + 1];
            u32x2 o; int p;
            p = __builtin_amdgcn_cvt_pk_fp8_f32(u0[0] * su, u0[1] * su, 0, false); p = __builtin_amdgcn_cvt_pk_fp8_f32(u0[2] * su, u0[3] * su, p, true); o.x = (unsigned)p;
            p = __builtin_amdgcn_cvt_pk_fp8_f32(u1[0] * su, u1[1] * su, 0, false); p = __builtin_amdgcn_cvt_pk_fp8_f32(u1[2] * su, u1[3] * su, p, true); o.y = (unsigned)p;
            ((GAS u32x2*)(ws + WS_UB))[i] = o;
            p = __builtin_amdgcn_cvt_pk_fp8_f32(v0[0] * sv, v0[1] * sv, 0, false); p = __builtin_amdgcn_cvt_pk_fp8_f32(v0[2] * sv, v0[3] * sv, p, true); o.x = (unsigned)p;
            p = __builtin_amdgcn_cvt_pk_fp8_f32(v1[0] * sv, v1[1] * sv, 0, false); p = __builtin_amdgcn_cvt_pk_fp8_f32(v1[2] * sv, v1[3] * sv, p, true); o.y = (unsigned)p;
            ((GAS u32x2*)(ws + WS_VB))[i] = o;
        }
    }
}

__device__ __forceinline__ unsigned f2ord(float f) { const unsigned u = __builtin_bit_cast(unsigned, f); return (u & 0x80000000u) ? ~u : (u | 0x80000000u); }
__device__ __forceinline__ float ord2f(unsigned k) { const unsigned u = (k & 0x80000000u) ? (k & 0x7fffffffu) : ~k; return __builtin_bit_cast(float, u); }
__device__ __forceinline__ unsigned umax_(unsigned a, unsigned b) { return a > b ? a : b; }
__device__ __forceinline__ unsigned shxu(unsigned v, int o, int lane) { return (unsigned)__builtin_amdgcn_ds_bpermute((lane ^ o) << 2, (int)v); }

__device__ __forceinline__ void phase_topk(const DArgs& a, LAS unsigned char* lds, int bx, int G) {
    const int tid = tid_(), lane = tid & 63, wave = __builtin_amdgcn_readfirstlane(tid >> 6), fr = lane & 15, fq = lane >> 4;
    GAS unsigned char* ws = a.ws;
    const int h = bx & 7;
    LAS unsigned char* KY = lds;
    LAS unsigned char* QL = lds + 2 * 128 * PS_PITCH;
    LAS unsigned* TOP = (LAS unsigned*)(lds + 2 * 128 * PS_PITCH + 64 * PQ_PITCH);
#pragma unroll
    for (int i = 0; i < 8; ++i) { const int idx = tid + 512 * i, row = idx >> 4, ch = idx & 15;
        *(LAS u32x4*)(KY + row * PS_PITCH + ch * 16) = *(const u32x4*)((const bf16_t*)(ws + WS_SK) + ((size_t)h * 256 + row) * 128 + ch * 8); }
    const int ntile = T / 64;
    for (int tile = bx >> 3; tile < ntile; tile += (G >> 3)) {
        const size_t t0 = (size_t)tile * 64;
        __syncthreads();
#pragma unroll
        for (int i = 0; i < 4; ++i) { const int idx = tid + 512 * i, row = idx >> 5, ch = idx & 31;
            *(LAS u32x4*)(QL + row * PQ_PITCH + ch * 16) = *(const u32x4*)((const bf16_t*)(ws + WS_QP) + (t0 + row) * 2048 + h * 256 + ch * 8); }
        __syncthreads();
        {
            const int mt = wave & 3, p = wave >> 2;
            unsigned key[32];
#pragma unroll
            for (int nt = 0; nt < 8; ++nt) { f32x4 acc = (f32x4){0.f, 0.f, 0.f, 0.f};
#pragma unroll
                for (int ks = 0; ks < 4; ++ks) acc = MFMA16(lfrag(KY + p * 128 * PS_PITCH, PS_PITCH, nt * 16 + fr, ks * 32, fq), lfrag(QL, PQ_PITCH, mt * 16 + fr, p * 128 + ks * 32, fq), acc);
#pragma unroll
                for (int j = 0; j < 4; ++j) { const int n = nt * 16 + 4 * fq + j; key[nt * 4 + j] = (f2ord(acc[j]) & ~127u) | (unsigned)(127 - n); } }
#pragma unroll 1
            for (int k = 0; k < 16; ++k) {
                unsigned m = key[0];
#pragma unroll
                for (int e = 1; e < 32; ++e) m = umax_(m, key[e]);
                m = umax_(m, (unsigned)SWZI_(m, 0x401F)); m = umax_(m, xor32u_(m, lane >= 32));
#pragma unroll
                for (int e = 0; e < 32; ++e) key[e] = (key[e] == m) ? 0u : key[e];
                if (fq == (k & 3)) TOP[(p * 64 + mt * 16 + fr) * 16 + k] = m;
            }
        }
        __syncthreads();
        {
            const int t = tid >> 3, sub = tid & 7;
            unsigned ck[7];
#pragma unroll
            for (int e = 0; e < 7; ++e) {
                const int ci = sub + 8 * e;
                int i = 0, base = 0; bool ok = ci < 50;
                if (ci >= 42) { i = 8 + (ci - 42); base = ci; } else if (ci >= 40) { i = 7; base = 40; } else if (ci >= 38) { i = 6; base = 38; } else if (ci >= 36) { i = 5; base = 36; }
                else if (ci >= 33) { i = 4; base = 33; } else if (ci >= 29) { i = 3; base = 29; } else if (ci >= 24) { i = 2; base = 24; } else if (ci >= 16) { i = 1; base = 16; }
                const int j = ci - base;
                unsigned kk = 0u;
                if (ok) { const float s0 = ord2f(TOP[(0 * 64 + t) * 16 + i] & ~127u), s1 = ord2f(TOP[(1 * 64 + t) * 16 + j] & ~127u);
                    kk = (f2ord(s0 + s1) & ~255u) | (unsigned)(255 - (i * 16 + j)); }
                ck[e] = kk;
            }
            unsigned w0 = 0u, w1 = 0u;
#pragma unroll 1
            for (int k = 0; k < 16; ++k) {
                unsigned m = ck[0];
#pragma unroll
                for (int e = 1; e < 7; ++e) m = umax_(m, ck[e]);
                m = umax_(m, (unsigned)DPPI_(m, 0xB1)); m = umax_(m, (unsigned)DPPI_(m, 0x4E)); m = umax_(m, (unsigned)DPPI_(m, 0x141));
#pragma unroll
                for (int e = 0; e < 7; ++e) ck[e] = (ck[e] == m) ? 0u : ck[e];
                if (k == sub) w0 = m; if (k == sub + 8) w1 = m;
            }
            const int f0 = 255 - (int)(w0 & 255u), f1 = 255 - (int)(w1 & 255u);
            const float sc0 = ord2f(w0 & ~255u), sc1 = ord2f(w1 & ~255u);
            float mx = fmaxf(sc0, sc1); mx = fmaxf(mx, DPP_(mx, 0xB1)); mx = fmaxf(mx, DPP_(mx, 0x4E)); mx = fmaxf(mx, DPP_(mx, 0x141));
            const float e0 = __expf(sc0 - mx), e1 = __expf(sc1 - mx);
            float sm = e0 + e1; sm += DPP_(sm, 0xB1); sm += DPP_(sm, 0x4E); sm += DPP_(sm, 0x141);
            const float inv = 1.0f / sm;
            const int i0 = 127 - (int)(TOP[(0 * 64 + t) * 16 + (f0 >> 4)] & 127u), j0 = 127 - (int)(TOP[(1 * 64 + t) * 16 + (f0 & 15)] & 127u);
            const int i1 = 127 - (int)(TOP[(0 * 64 + t) * 16 + (f1 >> 4)] & 127u), j1 = 127 - (int)(TOP[(1 * 64 + t) * 16 + (f1 & 15)] & 127u);
            int* ei = (int*)(ws + WS_EIDX) + ((t0 + t) * 8 + h) * 16; float* gp = (float*)(ws + WS_GATE) + ((t0 + t) * 8 + h) * 16;
            ei[sub] = i0 * 128 + j0; ei[sub + 8] = i1 * 128 + j1; gp[sub] = e0 * inv; gp[sub + 8] = e1 * inv;
        }
    }
    __syncthreads();
}

__device__ __forceinline__ void ins16(float (&v)[16], int (&id)[16], float x, int n) {
    if (x > v[15]) { v[15] = x; id[15] = n;
#pragma unroll
        for (int i = 15; i >= 1; --i) { if (v[i] > v[i - 1]) { const float tv = v[i]; v[i] = v[i - 1]; v[i - 1] = tv; const int ti = id[i]; id[i] = id[i - 1]; id[i - 1] = ti; } } }
}
__device__ __forceinline__ void phase_topk_ref(const DArgs& a, int vcu, int G) {
    const int tid = tid_();
    GAS unsigned char* ws = a.ws;
    const int gt = vcu * NTHR + tid, NGT = G * NTHR;
    for (int pair = gt; pair < T * 8; pair += NGT) {
        const int t = pair >> 3, h = pair & 7;
        float sv[2][16]; int si[2][16];
#pragma unroll
        for (int p = 0; p < 2; ++p) {
#pragma unroll
            for (int i = 0; i < 16; ++i) { sv[p][i] = -INFINITY; si[p][i] = 0; }
            const bf16_t* qp = (const bf16_t*)(ws + WS_QP) + (size_t)t * 2048 + h * 256 + p * 128;
            for (int n = 0; n < 128; ++n) {
                const bf16_t* kp = (const bf16_t*)(ws + WS_SK) + ((size_t)(h * 2 + p) * 128 + n) * 128;
                float s = 0.f;
                for (int c = 0; c < 128; c += 8) { const u32x4 qv = *(const u32x4*)(qp + c), kv = *(const u32x4*)(kp + c);
                    s += bf_lo(qv.x) * bf_lo(kv.x) + bf_hi(qv.x) * bf_hi(kv.x) + bf_lo(qv.y) * bf_lo(kv.y) + bf_hi(qv.y) * bf_hi(kv.y)
                       + bf_lo(qv.z) * bf_lo(kv.z) + bf_hi(qv.z) * bf_hi(kv.z) + bf_lo(qv.w) * bf_lo(kv.w) + bf_hi(qv.w) * bf_hi(kv.w); }
                ins16(sv[p], si[p], s, n);
            }
        }
        float tv[16]; int ti[16];
#pragma unroll
        for (int i = 0; i < 16; ++i) { tv[i] = -INFINITY; ti[i] = 0; }
#pragma unroll
        for (int i = 0; i < 16; ++i)
#pragma unroll
            for (int j = 0; j < 16; ++j) ins16(tv, ti, sv[0][i] + sv[1][j], i * 16 + j);
        float sm = 0.f, ex[16];
#pragma unroll
        for (int k = 0; k < 16; ++k) { ex[k] = __expf(tv[k] - tv[0]); sm += ex[k]; }
        int* ei = (int*)(ws + WS_EIDX) + (size_t)pair * 16; float* gp = (float*)(ws + WS_GATE) + (size_t)pair * 16;
#pragma unroll
        for (int k = 0; k < 16; ++k) {
            int e0 = 0, e1 = 0;
#pragma unroll
            for (int i = 0; i < 16; ++i) { e0 = ((ti[k] >> 4) == i) ? si[0][i] : e0; e1 = ((ti[k] & 15) == i) ? si[1][i] : e1; }
            ei[k] = e0 * 128 + e1; gp[k] = ex[k] / sm; }
    }
}

#define FP8LO(w) __builtin_amdgcn_cvt_pk_f32_fp8((int)(w), false)
#define FP8HI(w) __builtin_amdgcn_cvt_pk_f32_fp8((int)(w), true)
__device__ __forceinline__ float dot16_fp8(const u32x4 r, const float (&x)[16]) {
    float c = 0.f;
#pragma unroll
    for (int j = 0; j < 4; ++j) { const f32x2 lo = FP8LO(r[j]), hi = FP8HI(r[j]); c += lo[0] * x[4 * j] + lo[1] * x[4 * j + 1] + hi[0] * x[4 * j + 2] + hi[1] * x[4 * j + 3]; }
    return c;
}
__device__ __forceinline__ float gelu_erf(float d) {
    const float ad = fabsf(d), t = __builtin_amdgcn_rcpf(ad * 0.2316418882f + 1.0f);
    float q = t * 0.5307027145f + (-0.7265760135f); q = q * t + 0.7107068705f; q = q * t + (-0.142248368f); q = q * t + 0.127414796f; q = q * t;
    const float m = d * (q * __builtin_amdgcn_exp2f(d * d * (-0.72134752044f)));
    return d < 0.f ? m : d - m;
}
__device__ __forceinline__ float bperm(float v, int srclane) { return __builtin_bit_cast(float, __builtin_amdgcn_ds_bpermute(srclane << 2, __builtin_bit_cast(int, v))); }
#define SWZ_(v, pat) __builtin_bit_cast(float, __builtin_amdgcn_ds_swizzle(__builtin_bit_cast(int, (v)), (pat)))
__device__ __forceinline__ float xor32_(float v, bool hi) {
#if defined(__HIP_DEVICE_COMPILE__)
    const auto r = __builtin_amdgcn_permlane32_swap(__builtin_bit_cast(unsigned, v), __builtin_bit_cast(unsigned, v), false, false);
    return __builtin_bit_cast(float, hi ? r[0] : r[1]);
#else
    (void)hi; return v;
#endif
}
__device__ __forceinline__ float reduce8(const float (&p)[8], int lane) {
    float q4[4], q2[2];
    const bool b5 = lane & 32, b4 = lane & 16, b3 = lane & 8;
#pragma unroll
    for (int i = 0; i < 4; ++i) { const float send = b5 ? p[i] : p[i + 4], keep = b5 ? p[i + 4] : p[i]; q4[i] = keep + xor32_(send, b5); }
#pragma unroll
    for (int i = 0; i < 2; ++i) { const float send = b4 ? q4[i] : q4[i + 2], keep = b4 ? q4[i + 2] : q4[i]; q2[i] = keep + SWZ_(send, 0x401F); }
    const float send = b3 ? q2[0] : q2[1], keep = b3 ? q2[1] : q2[0];
    float q1 = keep + SWZ_(send, 0x201F);
    q1 += DPP_(q1, 0xB1); q1 += DPP_(q1, 0x4E); q1 += DPP_(q1, 0x141);
    return q1;
}
__device__ __forceinline__ void phase_udots(const DArgs& a, LAS unsigned char* lds) {
    const int tid = tid_(), lane = tid & 63, wave = __builtin_amdgcn_readfirstlane(tid >> 6);
    GAS unsigned char* ws = a.ws;
    volatile LAS unsigned* bst = (volatile LAS unsigned*)(lds + LDS_BARST);
    const int nloc = (int)bst[0], nx = (int)bst[1], rank = (int)bst[2];
    unsigned* bar = (unsigned*)(ws + WS_CTL) + CW_BAR;
    const unsigned myx = xb_xcc_id();
    int q = 0;
    for (unsigned j = 0; j < 16; ++j) { const unsigned c = xb_ld(&bar[XB_XCNT(j)]); if (c > 0u && j < myx) ++q; }
    LAS int* LE = (LAS int*)(lds + wave * 2048);
    LAS int* LP = LE + 128; LAS float* LG = (LAS float*)(LE + 256);
    const GAS unsigned char* UB = ws + WS_UB;
    const int g8 = lane >> 3;
    const float usc = ((const GAS float*)(ws + WS_USC))[0], vsc = ((const GAS float*)(ws + WS_USC))[1];
    for (int s = q; s < 8; s += nx) {
        int tok = rank * 8 + wave;
        u32x4 xq0 = (u32x4){0u, 0u, 0u, 0u}, xq1 = xq0; u32x2 e2 = (u32x2){0u, 0u}; f32x2 g2 = (f32x2){0.f, 0.f};
#define U_INFO(t_) do { xq0 = *(const u32x4*)((const GAS bf16_t*)(ws + WS_XN) + (size_t)(t_) * D + lane * 16); xq1 = *(const u32x4*)((const GAS bf16_t*)(ws + WS_XN) + (size_t)(t_) * D + lane * 16 + 8); \
        e2 = *(const u32x2*)((const GAS int*)(ws + WS_EIDX) + (size_t)(t_) * 128 + 2 * lane); g2 = *(const f32x2*)((const GAS float*)(ws + WS_GATE) + (size_t)(t_) * 128 + 2 * lane); } while (0)
        if (tok < T) U_INFO(tok);
        for (; tok < T; tok += nloc * 8) {
            const bool in0 = (int)(e2.x >> 11) == s, in1 = (int)(e2.y >> 11) == s;
            const unsigned long long m0 = __ballot(in0), m1 = __ballot(in1);
            const unsigned long long lt = (1ull << lane) - 1ull;
            const int n0 = __popcll(m0), n = n0 + __popcll(m1);
            if (in0) { const int pos = __popcll(m0 & lt); LE[pos] = (int)e2.x; LP[pos] = 2 * lane; LG[pos] = g2[0]; }
            if (in1) { const int pos = n0 + __popcll(m1 & lt); LE[pos] = (int)e2.y; LP[pos] = 2 * lane + 1; LG[pos] = g2[1]; }
            const float xf[16] = {bf_lo(xq0.x), bf_hi(xq0.x), bf_lo(xq0.y), bf_hi(xq0.y), bf_lo(xq0.z), bf_hi(xq0.z), bf_lo(xq0.w), bf_hi(xq0.w),
                                  bf_lo(xq1.x), bf_hi(xq1.x), bf_lo(xq1.y), bf_hi(xq1.y), bf_lo(xq1.z), bf_hi(xq1.z), bf_lo(xq1.w), bf_hi(xq1.w)};
            asm volatile("s_waitcnt lgkmcnt(0)" ::: "memory");
            u32x4 R0[8], R1[8], R2[8];
#define U_ISSUE(R_, g0_) do { _Pragma("unroll") for (int k = 0; k < 8; ++k) { const int slot_ = ((g0_) + k < n) ? (g0_) + k : n - 1; const int e_ = LE[slot_]; R_[k] = *(const u32x4*)(UB + (size_t)e_ * 1024 + lane * 16); } } while (0)
#define U_DOTS(R_, g0_) do { float pp_[8]; _Pragma("unroll") for (int k = 0; k < 8; ++k) pp_[k] = dot16_fp8(R_[k], xf); const float dsum_ = reduce8(pp_, lane); const int slot_ = (g0_) + g8; \
            if (slot_ < n && (lane & 7) == 0) { const float d_ = dsum_ * usc; \
                ((GAS float*)(ws + WS_PW))[(size_t)tok * 128 + LP[slot_]] = 0.5f * d_ * (1.0f + erff(d_ * 0.70710678118654752f)) * LG[slot_] * vsc; } } while (0)
            if (n > 0) U_ISSUE(R0, 0);
            if (n > 8) U_ISSUE(R1, 8);
            if (n > 16) U_ISSUE(R2, 16);
            const int tokN = tok + nloc * 8;
            if (tokN < T) U_INFO(tokN);
            if (n > 0) U_DOTS(R0, 0);
            if (n > 8) U_DOTS(R1, 8);
            if (n > 16) U_DOTS(R2, 16);
            for (int g0 = 24; g0 < n; g0 += 8) { U_ISSUE(R0, g0); U_DOTS(R0, g0); }
            asm volatile("s_waitcnt lgkmcnt(0)" ::: "memory");
        }
#undef U_INFO
#undef U_ISSUE
#undef U_DOTS
    }
}

struct XcdSlice { int nloc, nx, rank, q; };
__device__ __forceinline__ XcdSlice xcd_slice_setup(const DArgs& a, LAS unsigned char* lds) {
    volatile LAS unsigned* bst = (volatile LAS unsigned*)(lds + LDS_BARST);
    XcdSlice x; x.nloc = (int)bst[0]; x.nx = (int)bst[1]; x.rank = (int)bst[2];
    unsigned* bar = (unsigned*)(a.ws + WS_CTL) + CW_BAR; const unsigned myx = xb_xcc_id();
    x.q = 0; for (unsigned j = 0; j < 16; ++j) { const unsigned c = xb_ld(&bar[XB_XCNT(j)]); if (c > 0u && j < myx) ++x.q; }
    return x;
}
__device__ __forceinline__ void phase_ua(const DArgs& a, LAS unsigned char* lds) {
    const int tid = tid_(), lane = tid & 63, wave = __builtin_amdgcn_readfirstlane(tid >> 6), k = lane >> 3, c = lane & 7;
    GAS unsigned char* ws = a.ws;
    const XcdSlice X = xcd_slice_setup(a, lds);
    const int tstride = X.nloc * 8;
    for (int sl = X.q; sl < 8; sl += X.nx) {
        const GAS unsigned char* UBs = ws + WS_UB + sl * 128 + c * 16;
        GAS float* PU = (GAS float*)(ws + WS_PARTU) + (size_t)sl * T * 128;
        u32x4 ev[4], xq0, xq1;
#define A_INFO(t_) do { _Pragma("unroll") for (int j_ = 0; j_ < 4; ++j_) ev[j_] = *(const GAS u32x4*)((const GAS int*)(ws + WS_EIDX) + (size_t)(t_) * 128 + 16 * k + 4 * j_); \
        xq0 = *(const GAS u32x4*)((const GAS bf16_t*)(ws + WS_XN) + (size_t)(t_) * D + sl * 128 + c * 16); xq1 = *(const GAS u32x4*)((const GAS bf16_t*)(ws + WS_XN) + (size_t)(t_) * D + sl * 128 + c * 16 + 8); } while (0)
        int tok = X.rank * 8 + wave;
        if (tok < T) A_INFO(tok);
        for (; tok < T; tok += tstride) {
            u32x4 R[16];
#pragma unroll
            for (int g = 0; g < 16; ++g) R[g] = *(const GAS u32x4*)(UBs + (size_t)ev[g >> 2][g & 3] * 1024);
            const float xf[16] = {bf_lo(xq0.x), bf_hi(xq0.x), bf_lo(xq0.y), bf_hi(xq0.y), bf_lo(xq0.z), bf_hi(xq0.z), bf_lo(xq0.w), bf_hi(xq0.w),
                                  bf_lo(xq1.x), bf_hi(xq1.x), bf_lo(xq1.y), bf_hi(xq1.y), bf_lo(xq1.z), bf_hi(xq1.z), bf_lo(xq1.w), bf_hi(xq1.w)};
            if (tok + tstride < T) A_INFO(tok + tstride);
            f32x2 res = (f32x2){0.f, 0.f};
#pragma unroll
            for (int g = 0; g < 16; ++g) { float d = dot16_fp8(R[g], xf); d += DPP_(d, 0xB1); d += DPP_(d, 0x4E); d += DPP_(d, 0x141);
                if (c == (g >> 1)) res[g & 1] = d; }
            *(GAS f32x2*)(PU + (size_t)tok * 128 + 2 * lane) = res;
        }
#undef A_INFO
    }
}
__device__ __forceinline__ void phase_ua2(const DArgs& a, int vcu, int G) {
    const int tid = tid_();
    GAS unsigned char* ws = a.ws;
    const float usc = ((const GAS float*)(ws + WS_USC))[0], vsc = ((const GAS float*)(ws + WS_USC))[1];
    const GAS float* PU = (const GAS float*)(ws + WS_PARTU);
    for (size_t i = (size_t)vcu * NTHR + tid; i < (size_t)T * 128 / 4; i += (size_t)G * NTHR) {
        f32x4 d = (f32x4){0.f, 0.f, 0.f, 0.f};
#pragma unroll
        for (int sl = 0; sl < 8; ++sl) d += ((const GAS f32x4*)(PU + (size_t)sl * T * 128))[i];
        const f32x4 gt = ((const GAS f32x4*)(ws + WS_GATE))[i];
        f32x4 w;
#pragma unroll
        for (int e = 0; e < 4; ++e) w[e] = gelu_erf(d[e] * usc) * gt[e] * vsc;
        ((GAS f32x4*)(ws + WS_PW))[i] = w;
    }
}
__device__ __forceinline__ void phase_vb(const DArgs& a, LAS unsigned char* lds) {
    const int tid = tid_(), lane = tid & 63, wave = __builtin_amdgcn_readfirstlane(tid >> 6), k = lane >> 3, c = lane & 7;
    GAS unsigned char* ws = a.ws;
    const XcdSlice X = xcd_slice_setup(a, lds);
    const int tstride = X.nloc * 8;
    for (int sl = X.q; sl < 8; sl += X.nx) {
        const GAS unsigned char* VBs = ws + WS_VB + sl * 128 + c * 16;
        u32x4 ev[4]; f32x4 wv[4];
#define B_INFO(t_) do { _Pragma("unroll") for (int j_ = 0; j_ < 4; ++j_) { ev[j_] = *(const GAS u32x4*)((const GAS int*)(ws + WS_EIDX) + (size_t)(t_) * 128 + 16 * k + 4 * j_); \
        wv[j_] = *(const GAS f32x4*)((const GAS float*)(ws + WS_PW) + (size_t)(t_) * 128 + 16 * k + 4 * j_); } } while (0)
        int tok = X.rank * 8 + wave;
        if (tok < T) B_INFO(tok);
        for (; tok < T; tok += tstride) {
            u32x4 R[16];
#pragma unroll
            for (int g = 0; g < 16; ++g) R[g] = *(const GAS u32x4*)(VBs + (size_t)ev[g >> 2][g & 3] * 1024);
            float wk[16];
#pragma unroll
            for (int g = 0; g < 16; ++g) wk[g] = wv[g >> 2][g & 3];
            if (tok + tstride < T) B_INFO(tok + tstride);
            f32x4 xr[4];
#pragma unroll
            for (int j = 0; j < 4; ++j) xr[j] = *(const GAS f32x4*)(a.out + (size_t)tok * D + sl * 128 + c * 16 + 4 * j);
            f32x2 acc2[8];
#pragma unroll
            for (int e = 0; e < 8; ++e) acc2[e] = (f32x2){0.f, 0.f};
#pragma unroll
            for (int g = 0; g < 16; ++g) { const f32x2 wp = (f32x2){wk[g], wk[g]};
#pragma unroll
                for (int jj = 0; jj < 4; ++jj) { acc2[2 * jj] += wp * FP8LO(R[g][jj]); acc2[2 * jj + 1] += wp * FP8HI(R[g][jj]); } }
#pragma unroll
            for (int e = 0; e < 8; ++e) {
#pragma unroll
                for (int hh = 0; hh < 2; ++hh) { float v = acc2[e][hh]; v += SWZ_(v, 0x201F); v += SWZ_(v, 0x401F); v += xor32_(v, lane >= 32); acc2[e][hh] = v; } }
            float ss = 0.f;
#pragma unroll
            for (int j = 0; j < 4; ++j) { xr[j][0] += acc2[2 * j][0]; xr[j][1] += acc2[2 * j][1]; xr[j][2] += acc2[2 * j + 1][0]; xr[j][3] += acc2[2 * j + 1][1];
                ss += (xr[j][0] * xr[j][0] + xr[j][1] * xr[j][1]) + (xr[j][2] * xr[j][2] + xr[j][3] * xr[j][3]); }
            ss += DPP_(ss, 0xB1); ss += DPP_(ss, 0x4E); ss += DPP_(ss, 0x141);
            if (k == 0) {
#pragma unroll
                for (int j = 0; j < 4; ++j) *(GAS f32x4*)(a.out + (size_t)tok * D + sl * 128 + c * 16 + 4 * j) = xr[j];
                if (c == 0) ((GAS float*)(ws + WS_SS))[(size_t)tok * 8 + sl] = ss;
            }
        }
#undef B_INFO
    }
}
__device__ __forceinline__ void phase_vc(const DArgs& a, int vcu, int G) {
    const int tid = tid_(), lane = tid & 63, wave = tid >> 6;
    const int gw = vcu * NWAVES + wave, NGW = G * NWAVES;
    GAS unsigned char* ws = a.ws;
    f32x4 gf[4];
#pragma unroll
    for (int j = 0; j < 4; ++j) gf[j] = ((const GAS f32x4*)a.final_g)[64 * j + lane];
    for (int m = gw; m < T; m += NGW) {
        const f32x4 s0 = *(const GAS f32x4*)((const GAS float*)(ws + WS_SS) + (size_t)m * 8), s1 = *(const GAS f32x4*)((const GAS float*)(ws + WS_SS) + (size_t)m * 8 + 4);
        const float rstd = rsqrtf(((s0[0] + s0[1]) + (s0[2] + s0[3]) + (s1[0] + s1[1]) + (s1[2] + s1[3])) * (1.f / D) + EPS);
        GAS f32x4* o = (GAS f32x4*)(a.out + (size_t)m * D) + lane;
#pragma unroll
        for (int j = 0; j < 4; ++j) o[64 * j] = o[64 * j] * rstd * gf[j];
    }
}

__device__ __forceinline__ void phase_final_plain(const DArgs& a, const float* src, int vcu, int G) {
    const int tid = tid_(), lane = tid & 63, wave = tid >> 6;
    const int gw = vcu * NWAVES + wave, NGW = G * NWAVES;
    f32x4 gf[4];
#pragma unroll
    for (int j = 0; j < 4; ++j) gf[j] = ((const f32x4*)a.final_g)[64 * j + lane];
    for (int m = gw; m < T; m += NGW) {
        const f32x4* xr = (const f32x4*)(src + (size_t)m * D) + lane;
        f32x4 v[4]; float s = 0.f;
#pragma unroll
        for (int j = 0; j < 4; ++j) { v[j] = xr[64 * j]; s += (v[j][0] * v[j][0] + v[j][1] * v[j][1]) + (v[j][2] * v[j][2] + v[j][3] * v[j][3]); }
        const float rstd = rsqrtf(wave_sum(s, lane) * (1.f / D) + EPS);
        f32x4* o = (f32x4*)(a.out + (size_t)m * D) + lane;
#pragma unroll
        for (int j = 0; j < 4; ++j) o[64 * j] = v[j] * rstd * gf[j];
    }
}


__device__ __forceinline__ DArgs load_args() {
    DArgs r;
#if defined(__HIP_DEVICE_COMPILE__)
    typedef const DArgs __attribute__((address_space(4))) KArgs;
    KArgs* p = (KArgs*)__builtin_amdgcn_kernarg_segment_ptr();
    asm volatile("" : "+s"(p));
    r.x = p->x; r.norm1_g = p->norm1_g; r.w_in = p->w_in; r.b_in = p->b_in; r.conv_w = p->conv_w; r.conv_b = p->conv_b; r.m_head_g = p->m_head_g; r.lb_table = p->lb_table;
    r.g_head_g = p->g_head_g; r.w_br_m = p->w_br_m; r.w_br_g = p->w_br_g; r.w_out = p->w_out; r.norm2_g = p->norm2_g; r.w_pq = p->w_pq; r.sub_keys = p->sub_keys;
    r.u_emb = p->u_emb; r.v_emb = p->v_emb; r.final_g = p->final_g; r.out = p->out; r.ws = p->ws;
#else
    r = DArgs{};
#endif
    return r;
}
__device__ __forceinline__ EpiPtrs make_ep(const DArgs& a, int round) {
    EpiPtrs ep; ep.biasp = (const GAS float*)(a.ws + WS_BIASP); ep.lb = (const GAS float*)(a.ws + WS_LB); ep.x = a.x; ep.out = a.out; ep.ws = a.ws; ep.round = round; return ep;
}
#define GRID_SYNC() do { const DArgs a_ = load_args(); xcd_barrier((unsigned*)(a_.ws + WS_CTL) + CW_BAR, (volatile LAS unsigned*)(lds + LDS_BARST)); } while (0)

__device__ __forceinline__ int bx_() { int t = blockIdx.x; asm volatile("" : "+s"(t)); return t; }
__device__ __forceinline__ int gd_() { int t = gridDim.x; asm volatile("" : "+s"(t)); return t; }
#define PH_BEGIN const DArgs a = load_args(); const int bx = bx_(), G = gd_(); const int vcu = (G % 8 == 0) ? (bx % 8) * (G / 8) + bx / 8 : bx; (void)vcu; (void)bx;

__global__ void __launch_bounds__(NTHR, 2) fwd_megakernel(Args a_unused) {
    extern __shared__ __attribute__((aligned(16))) unsigned char lds_raw[];
    LAS unsigned char* lds = (LAS unsigned char*)lds_raw;
    cg::grid_group grid = cg::this_grid();

    { const int t_ = tid_(); if (t_ < 16) ((LAS unsigned*)(lds + LDS_BARST))[t_] = 0u; __syncthreads();
      const DArgs a_ = load_args(); xcd_barrier_post((unsigned*)(a_.ws + WS_CTL) + CW_BAR, (volatile LAS unsigned*)(lds + LDS_BARST)); }
    { PH_BEGIN phase_p0(a, lds, vcu, G); }
    grid.sync();
#pragma unroll 1
    for (int round = 0; round < NROUND; ++round) {
        {
            PH_BEGIN
            pg8::Gemm g{(const bf16_t*)(a.ws + WS_XN) + (size_t)round * RT * D, (const bf16_t*)(a.ws + WS_WIN), RT, N1, D};
            pg8::StaticOrder S; S.init(RT, N1, G, bx);
            EpiX<1> E{make_ep(a, round)};
            pg8::gemm_phase<EpiX<1>, pg8::StaticOrder, true, true>(lds, g, S, E);
        }
        { PH_BEGIN if (bx < 8) mscan_pair(a, lds, round, bx); }
        GRID_SYNC();
        { PH_BEGIN for (int it = bx; it < 512; it += G) mlstm_pre_item(a, lds, round, it); }
        { PH_BEGIN for (int it = bx; it < 2048; it += G) hgrn_pre_item(a, lds, round, it); }
        GRID_SYNC();
        { PH_BEGIN
          if (bx < 128) mlstm_scan(a, lds, round, bx & 7, bx >> 3);
          else if (bx < 192) { const int id2 = bx - 128; hgrn_scan(a, lds, round, (id2 & 7) * 2 + ((id2 >> 3) & 1), id2 >> 4); } }
        GRID_SYNC();
        {
            PH_BEGIN
            pg8::Gemm g{(const bf16_t*)(a.ws + WS_XN) + (size_t)round * RT * D, (const bf16_t*)(a.ws + WS_WIN) + (size_t)N1 * D, RT, N2, D};
            pg8::StaticOrder S; S.init(RT, N2, G, bx);
            EpiX<2> E{make_ep(a, round)};
            pg8::gemm_phase<EpiX<2>, pg8::StaticOrder, true, true>(lds, g, S, E);
        }
        GRID_SYNC();
        { PH_BEGIN phase_ypass(a, round, vcu, G); }
        GRID_SYNC();
        {
            { PH_BEGIN pg8::StaticOrder S; S.init(RT, D, G, bx);
              pg8::Gemm g{(const bf16_t*)(a.ws + WS_V), (const bf16_t*)(a.ws + WS_WM), RT, D, 2048}; EpiX<3> E{make_ep(a, round)}; pg8::gemm_phase<EpiX<3>, pg8::StaticOrder, true, true>(lds, g, S, E); }
            { PH_BEGIN pg8::StaticOrder S; S.init(RT, D, G, bx);
              pg8::Gemm g{(const bf16_t*)(a.ws + WS_GI), (const bf16_t*)(a.ws + WS_WG), RT, D, D}; EpiX<4> E{make_ep(a, round)}; pg8::gemm_phase<EpiX<4>, pg8::StaticOrder, true, true>(lds, g, S, E); }
        }
        GRID_SYNC();
        {
            PH_BEGIN pg8::StaticOrder S; S.init(RT, D, G, bx);
            pg8::Gemm g{(const bf16_t*)(a.ws + WS_GFLOG), (const bf16_t*)(a.ws + WS_WO), RT, D, D}; EpiX<5> E{make_ep(a, round)}; pg8::gemm_phase<EpiX<5>, pg8::StaticOrder, true, true>(lds, g, S, E);
        }
        GRID_SYNC();
    }
    { PH_BEGIN phase_p8(a, vcu, G); }
    GRID_SYNC();
    {
        PH_BEGIN pg8::StaticOrder S; S.init(T, 2048, G, bx);
        pg8::Gemm g{(const bf16_t*)(a.ws + WS_XN), (const bf16_t*)(a.ws + WS_WPQ), T, 2048, D}; EpiX<6> E{make_ep(a, 0)}; pg8::gemm_phase<EpiX<6>, pg8::StaticOrder, true, true>(lds, g, S, E);
    }
    GRID_SYNC();
#ifdef TOPK_REF
    { PH_BEGIN phase_topk_ref(a, vcu, G); }
#else
    { PH_BEGIN phase_topk(a, lds, bx, G); }
#endif
    GRID_SYNC();
    { PH_BEGIN phase_ua(a, lds); }
    GRID_SYNC();
    { PH_BEGIN phase_ua2(a, vcu, G); }
    GRID_SYNC();
    { PH_BEGIN phase_vb(a, lds); }
    GRID_SYNC();
    { PH_BEGIN phase_vc(a, vcu, G); }
}

extern "C" void kernel_launch(void* const* d_in, const int* in_sizes, int n_in, void* d_out, int out_size, void* d_ws, size_t ws_size, hipStream_t stream) {
    static int grid = 0;
    if (grid == 0) {
        if (n_in != 18 || in_sizes[0] != T * D || out_size != T * D || ws_size < WS_END) {
            fprintf(stderr, "kernel_launch: unexpected shapes/workspace (n_in %d, in0 %d, out %d, ws %zu, need %zu)\n", n_in, n_in > 0 ? in_sizes[0] : -1, out_size, ws_size, (size_t)WS_END);
            grid = -1; return; }
        int dev = 0, cus = 0, per_cu = 0;
        hipGetDevice(&dev);
        hipDeviceGetAttribute(&cus, hipDeviceAttributeMultiprocessorCount, dev);
        hipFuncSetAttribute((const void*)fwd_megakernel, hipFuncAttributeMaxDynamicSharedMemorySize, LDS_BYTES);
        hipOccupancyMaxActiveBlocksPerMultiprocessor(&per_cu, (const void*)fwd_megakernel, NTHR, LDS_BYTES);
        if (per_cu < 1) { fprintf(stderr, "kernel_launch: occupancy query says %d blocks/CU\n", per_cu); per_cu = 1; }
        grid = cus;
        (void)hipGetLastError();
    }
    if (grid < 0) return;
    hipMemsetAsync((char*)d_ws + WS_CTL, 0, 1 * MiB, stream);
    Args a{};
    a.x = (const float*)d_in[0]; a.norm1_g = (const float*)d_in[1]; a.w_in = (const float*)d_in[2]; a.b_in = (const float*)d_in[3];
    a.conv_w = (const float*)d_in[4]; a.conv_b = (const float*)d_in[5]; a.m_head_g = (const float*)d_in[6]; a.lb_table = (const float*)d_in[7];
    a.g_head_g = (const float*)d_in[8]; a.w_br_m = (const float*)d_in[9]; a.w_br_g = (const float*)d_in[10]; a.w_out = (const float*)d_in[11];
    a.norm2_g = (const float*)d_in[12]; a.w_pq = (const float*)d_in[13]; a.sub_keys = (const float*)d_in[14]; a.u_emb = (const float*)d_in[15];
    a.v_emb = (const float*)d_in[16]; a.final_g = (const float*)d_in[17];
    a.out = (float*)d_out; a.ws = (unsigned char*)d_ws;
    void* args[] = {&a};
    hipError_t e = hipLaunchCooperativeKernel((const void*)fwd_megakernel, dim3(grid), dim3(NTHR), args, LDS_BYTES, stream);
    if (e != hipSuccess) fprintf(stderr, "cooperative launch failed: %s (grid %d)\n", hipGetErrorString(e), grid);
}
```

```cpp
#include <hip/hip_runtime.h>
#include <hip/hip_cooperative_groups.h>
#include <cstdio>
#include <cstdint>
namespace cg = cooperative_groups;

#define LAS __attribute__((address_space(3)))
typedef unsigned short bf16_t;
typedef short bf16x8 __attribute__((ext_vector_type(8)));
typedef float f32x4 __attribute__((ext_vector_type(4)));
typedef float f32x2 __attribute__((ext_vector_type(2)));
typedef unsigned u32x4 __attribute__((ext_vector_type(4)));
typedef unsigned u32x2 __attribute__((ext_vector_type(2)));

constexpr int D = 1024, BATCH = 4, SEQ = 8192, T = BATCH * SEQ;
constexpr int IN_COLS = 12296, NP = 12288;
constexpr int RT = 16384, NROUND = 2;
constexpr int N1 = 7168, N2 = 5120;
constexpr float EPS = 1e-6f;
constexpr int NWAVES = 8, NTHR = 512;

constexpr size_t MiB = 1u << 20;
constexpr size_t WS_CTL = 0;
constexpr size_t WS_WIN = 1 * MiB;
constexpr size_t WS_WM = 25 * MiB;
constexpr size_t WS_WG = 29 * MiB;
constexpr size_t WS_WO = 31 * MiB;
constexpr size_t WS_WPQ = 33 * MiB;
constexpr size_t WS_SK = 37 * MiB;
constexpr size_t WS_BIASP = 37 * MiB + 512 * 1024;
constexpr size_t WS_LB = WS_BIASP + 64 * 1024;
constexpr size_t WS_GATES = 38 * MiB;
constexpr size_t WS_MPREV = 39 * MiB;
constexpr size_t WS_DEN = 40 * MiB;
constexpr size_t WS_MT = 40 * MiB + 512 * 1024;
constexpr size_t WS_HGDEC = 41 * MiB;
constexpr size_t WS_MDEC = 43 * MiB;
constexpr size_t WS_XN = 44 * MiB;
constexpr size_t WS_QKPRE = 108 * MiB;
constexpr size_t WS_V = 172 * MiB;
constexpr size_t WS_GFLOG = 236 * MiB;
constexpr size_t WS_GI = 268 * MiB;
constexpr size_t WS_GQ = 300 * MiB;
constexpr size_t WS_S = 332 * MiB;
constexpr size_t WS_QT = 348 * MiB;
constexpr size_t WS_KWT = 380 * MiB;
constexpr size_t WS_ATT = 412 * MiB;
constexpr size_t WS_QTG = 428 * MiB;
constexpr size_t WS_KENDT = 460 * MiB;
constexpr size_t WS_SIGO = 332 * MiB;
constexpr size_t WS_SGG = 396 * MiB;
constexpr size_t WS_SAM = 428 * MiB;
constexpr size_t WS_SAG = 460 * MiB;
constexpr size_t WS_END = 492 * MiB;
constexpr size_t WS_QP = 108 * MiB;
constexpr size_t WS_UB = 236 * MiB;
constexpr size_t WS_VB = 252 * MiB;
constexpr size_t WS_USC = 268 * MiB;
constexpr size_t WS_VSC = 268 * MiB + 65536;
constexpr size_t WS_EIDX = 300 * MiB;
constexpr size_t WS_GATE = 316 * MiB;
constexpr size_t WS_X8 = 348 * MiB;
constexpr size_t WS_PARTU = 108 * MiB;
constexpr size_t WS_SS = 348 * MiB;
constexpr size_t WS_PW = 332 * MiB;

constexpr int CW_TMAX = 64;
constexpr int LDS_BYTES = 147456;

__device__ __forceinline__ unsigned f2bf(float f) { unsigned u = __builtin_bit_cast(unsigned, f); return (u + 0x7fffu + ((u >> 16) & 1u)) >> 16; }
typedef __bf16 bf16x2_t __attribute__((ext_vector_type(2)));
__device__ __forceinline__ unsigned pk2(float lo, float hi) { bf16x2_t v; v[0] = (__bf16)lo; v[1] = (__bf16)hi; return __builtin_bit_cast(unsigned, v); }
__device__ __forceinline__ float bf_lo(unsigned w) { return __builtin_bit_cast(float, w << 16); }
__device__ __forceinline__ float bf_hi(unsigned w) { return __builtin_bit_cast(float, w & 0xffff0000u); }
__device__ __forceinline__ float bf2f(bf16_t h) { return __builtin_bit_cast(float, ((unsigned)h) << 16); }
__device__ __forceinline__ float shx(float v, int o, int lane) { return __builtin_bit_cast(float, __builtin_amdgcn_ds_bpermute((lane ^ o) << 2, __builtin_bit_cast(int, v))); }
__device__ __forceinline__ float shup(float v, int o, int lane) { return __builtin_bit_cast(float, __builtin_amdgcn_ds_bpermute(((lane - o) & 63) << 2, __builtin_bit_cast(int, v))); }
__device__ __forceinline__ float rdlane(float v, int l) { return __builtin_bit_cast(float, __builtin_amdgcn_readlane(__builtin_bit_cast(int, v), l)); }
#define DPP_(v, ctrl) __builtin_bit_cast(float, __builtin_amdgcn_update_dpp(0, __builtin_bit_cast(int, (v)), (ctrl), 0xF, 0xF, false))
__device__ __forceinline__ float wave_sum(float v, int lane) {
    (void)lane;
    v += DPP_(v, 0xB1); v += DPP_(v, 0x4E); v += DPP_(v, 0x141); v += DPP_(v, 0x140);
    return (rdlane(v, 0) + rdlane(v, 16)) + (rdlane(v, 32) + rdlane(v, 48));
}
#define SWZI_(v, pat) __builtin_amdgcn_ds_swizzle((int)(v), (pat))
#define DPPI_(v, ctrl) __builtin_amdgcn_update_dpp(0, (int)(v), (ctrl), 0xF, 0xF, false)
__device__ __forceinline__ unsigned xor32u_(unsigned v, bool hi) {
#if defined(__HIP_DEVICE_COMPILE__)
    const auto r = __builtin_amdgcn_permlane32_swap(v, v, false, false);
    return hi ? r[0] : r[1];
#else
    (void)hi; return v;
#endif
}
__device__ __forceinline__ float sigmoidf_(float x) { return __builtin_amdgcn_rcpf(1.0f + __expf(-x)); }
__device__ __forceinline__ float siluf_(float x) { return x * __builtin_amdgcn_rcpf(1.0f + __expf(-x)); }
#define LDS_WAIT() asm volatile("s_waitcnt lgkmcnt(0)" ::: "memory")
__device__ __forceinline__ int tid_() { int t = threadIdx.x; asm volatile("" : "+v"(t)); return t; }

#define GAS __attribute__((address_space(1)))
struct DArgs {
    const GAS float* x; const GAS float* norm1_g; const GAS float* w_in; const GAS float* b_in; const GAS float* conv_w; const GAS float* conv_b;
    const GAS float* m_head_g; const GAS float* lb_table; const GAS float* g_head_g; const GAS float* w_br_m; const GAS float* w_br_g; const GAS float* w_out;
    const GAS float* norm2_g; const GAS float* w_pq; const GAS float* sub_keys; const GAS float* u_emb; const GAS float* v_emb; const GAS float* final_g;
    GAS float* out; GAS unsigned char* ws;
};
struct Args {
    const float* x; const float* norm1_g; const float* w_in; const float* b_in; const float* conv_w; const float* conv_b;
    const float* m_head_g; const float* lb_table; const float* g_head_g; const float* w_br_m; const float* w_br_g; const float* w_out;
    const float* norm2_g; const float* w_pq; const float* sub_keys; const float* u_emb; const float* v_emb; const float* final_g;
    float* out; unsigned char* ws;
};

namespace pg8 {
constexpr int BM = 256, BK = 64, HALF = 128, HTB = HALF * BK * 2, STAGE_BYTES = 8 * HTB, NXCD = 8, WGM = 8;
__host__ __device__ __forceinline__ int lds_byte(int r, int c) { const int st = (r >> 4) * 2 + (c >> 5), rr = r & 15, cc = c & 31, ob = rr * 64 + cc * 2; return st * 1024 + (ob ^ (((ob >> 9) & 1) << 5)); }
__host__ __device__ __forceinline__ void stage_rc(int b, int& R, int& C) { const int st = b / 1024, sb = b % 1024, swz = sb ^ (((sb >> 9) & 1) << 5); R = (st >> 1) * 16 + swz / 64; C = (st & 1) * 32 + (swz % 64) / 2; }
__host__ __device__ __forceinline__ int perm32(int rho) { const int n = rho >> 4, i = rho & 15; return 8 * (i >> 2) + 4 * n + (i & 3); }
struct Unit { int pm, pn; };
struct Gemm { const bf16_t* A; const bf16_t* Bt; int M, N, K; };
struct StaticOrder {
    int nM, nN, nwg, G, c;
    __host__ __device__ void init(int M, int N, int G_, int c_) { nM = M / BM; nN = N / BM; nwg = nM * nN; G = G_; c = c_; }
    __host__ __device__ bool next(int i, Unit& u) const {
        const long L = (long)i * G + c; if (L >= nwg) return false;
        int wgid = (int)L; { const int q = nwg / NXCD, r = nwg % NXCD, xcd = wgid % NXCD, off = wgid / NXCD; wgid = (xcd < r ? xcd * (q + 1) : r * (q + 1) + (xcd - r) * q) + off; }
        const int nig = WGM * nN, gid = wgid / nig, fm = gid * WGM, gsz = (nM - fm) < WGM ? (nM - fm) : WGM;
        u.pm = fm + ((wgid % nig) % gsz); u.pn = (wgid % nig) / gsz; return true;
    }
    __device__ __forceinline__ void a_ready(const Unit&) const {}
    __device__ __forceinline__ void done(const Unit&) const {}
};

template <class Epi, class Sched, bool ALIGN_EPI = false, bool SP2 = false>
__device__ __forceinline__ void gemm_phase(LAS unsigned char* lds, const Gemm g, const Sched& S, const Epi& E) {
    const int tid = tid_(), wid = __builtin_amdgcn_readfirstlane(tid >> 6), lane = tid & 63, wr = wid >> 2, wc = wid & 3, fr = lane & 15, fq = lane >> 4;
    const int K = g.K, nt = K / BK;
    unsigned voffA[2], voffB[2];
#pragma unroll
    for (int i = 0; i < 2; ++i) { int R, C; stage_rc(tid * 16 + i * 8192, R, C); const int Rb = Epi::PERM ? ((R & ~31) + perm32(R & 31)) : R;
        voffA[i] = (unsigned)(R * K + C) * 2u; voffB[i] = (unsigned)(Rb * K + C) * 2u; }
    const size_t kstep = (size_t)(BK * 2);
    const size_t hstep = (size_t)HALF * K * 2;
    const size_t tstep = 2 * hstep;
    const unsigned ldsw = (unsigned)wid * 1024u;
    const int aoff = lds_byte(wr * 64 + fr, fq * 8), boff = lds_byte(wc * 32 + fr, fq * 8);
#define PG8_SA(b, h) (((b) * 2 + (h)) * HTB)
#define PG8_SB(b, h) ((4 + (b) * 2 + (h)) * HTB)
#define PG8_STAGE(bufoff, gbase, voff) do { _Pragma("unroll") for (int _i = 0; _i < 2; ++_i) \
        __builtin_amdgcn_global_load_lds((const unsigned*)((const char*)(gbase) + (voff)[_i]), (LAS unsigned*)(lds + (bufoff) + ldsw + _i * 8192), 16, 0, 0); } while (0)
#define PG8_LDA(dst, b, h) do { _Pragma("unroll") for (int m = 0; m < 4; ++m) _Pragma("unroll") for (int k = 0; k < 2; ++k) dst[m][k] = *(const LAS bf16x8*)(lds + PG8_SA(b, h) + aoff + m * 2048 + k * 1024); } while (0)
#define PG8_LDB(dst, b, h) do { _Pragma("unroll") for (int n = 0; n < 2; ++n) _Pragma("unroll") for (int k = 0; k < 2; ++k) dst[n][k] = *(const LAS bf16x8*)(lds + PG8_SB(b, h) + boff + n * 2048 + k * 1024); } while (0)
#define PG8_MMA(ai, bj, At, Bt) do { __builtin_amdgcn_s_setprio(1); _Pragma("unroll") for (int m = 0; m < 4; ++m) _Pragma("unroll") for (int n = 0; n < 2; ++n) _Pragma("unroll") for (int k = 0; k < 2; ++k) \
        acc[ai][bj][m][n] = __builtin_amdgcn_mfma_f32_16x16x32_bf16(Bt[n][k], At[m][k], acc[ai][bj][m][n], 0, 0, 0); __builtin_amdgcn_s_setprio(0); } while (0)
#define PG8_WAIT_V(n) asm volatile("s_waitcnt vmcnt(" #n ")" ::: "memory")
#define PG8_WAIT_L(n) asm volatile("s_waitcnt lgkmcnt(" #n ")" ::: "memory")
#define PG8_BAR __builtin_amdgcn_s_barrier()
#define PG8_SCHED __builtin_amdgcn_sched_barrier(0)
    Unit cur, nxt; int ui = 0;
    if (!S.next(0, cur)) return;
    f32x4 acc[2][2][4][2];
#pragma unroll
    for (int a = 0; a < 2; ++a)
#pragma unroll
        for (int b = 0; b < 2; ++b)
#pragma unroll
            for (int m = 0; m < 4; ++m)
#pragma unroll
                for (int n = 0; n < 2; ++n) acc[a][b][m][n] = (f32x4){0.f, 0.f, 0.f, 0.f};
    bf16x8 At[4][2], B0[2][2], B1[2][2];
    const char* cA = (const char*)g.A + (size_t)cur.pm * tstep; const char* cB = (const char*)g.Bt + (size_t)cur.pn * tstep;
    S.a_ready(cur);
    if constexpr (SP2) {
        PG8_STAGE(PG8_SB(0, 0), cB, voffB); PG8_STAGE(PG8_SB(0, 1), cB + hstep, voffB); PG8_STAGE(PG8_SA(0, 0), cA, voffA); PG8_STAGE(PG8_SA(0, 1), cA + hstep, voffA);
        if (wr == 1) PG8_BAR;
        PG8_WAIT_V(2); PG8_BAR;
        PG8_STAGE(PG8_SB(1, 0), cB + kstep, voffB); PG8_STAGE(PG8_SA(1, 0), cA + kstep, voffA); PG8_STAGE(PG8_SB(1, 1), cB + hstep + kstep, voffB);
        PG8_WAIT_V(6); PG8_BAR;
    } else {
        PG8_STAGE(PG8_SB(0, 0), cB, voffB); PG8_STAGE(PG8_SA(0, 0), cA, voffA); PG8_STAGE(PG8_SB(0, 1), cB + hstep, voffB); PG8_STAGE(PG8_SA(0, 1), cA + hstep, voffA);
        if (wr == 1) PG8_BAR;
        PG8_WAIT_V(4); PG8_BAR;
        PG8_STAGE(PG8_SB(1, 0), cB + kstep, voffB); PG8_STAGE(PG8_SA(1, 0), cA + kstep, voffA); PG8_STAGE(PG8_SB(1, 1), cB + hstep + kstep, voffB);
        PG8_WAIT_V(6); PG8_BAR;
    }
    for (;;) {
        const bool has_next = S.next(ui + 1, nxt);
        const char* nA = has_next ? (const char*)g.A + (size_t)nxt.pm * tstep : cA; const char* nB = has_next ? (const char*)g.Bt + (size_t)nxt.pn * tstep : cB;
        for (int t = 0; t < nt; t += 2) {
            const bool last = (t == nt - 2);
            const char* a1 = cA + (size_t)(t + 1) * kstep;
            const char* a2 = last ? nA : cA + (size_t)(t + 2) * kstep; const char* b2 = last ? nB : cB + (size_t)(t + 2) * kstep;
            const char* a3 = a2 + kstep; const char* b3 = b2 + kstep;
            if (last && has_next) S.a_ready(nxt);
            if constexpr (SP2) {
            PG8_LDB(B0, 0, 0); PG8_LDB(B1, 0, 1); PG8_SCHED; PG8_LDA(At, 0, 0); PG8_STAGE(PG8_SA(1, 1), a1 + hstep, voffA);
            PG8_WAIT_V(8); PG8_WAIT_L(0); PG8_BAR; PG8_MMA(0, 0, At, B0); PG8_MMA(0, 1, At, B1); PG8_BAR; PG8_SCHED;
            PG8_LDA(At, 0, 1); PG8_STAGE(PG8_SB(0, 0), b2, voffB); PG8_STAGE(PG8_SB(0, 1), b2 + hstep, voffB); PG8_STAGE(PG8_SA(0, 0), a2, voffA);
            PG8_WAIT_V(8); PG8_WAIT_L(0); PG8_BAR; PG8_MMA(1, 0, At, B0); PG8_MMA(1, 1, At, B1); PG8_BAR; PG8_SCHED;
            PG8_LDB(B0, 1, 0); PG8_LDB(B1, 1, 1); PG8_SCHED; PG8_LDA(At, 1, 0); PG8_STAGE(PG8_SA(0, 1), a2 + hstep, voffA);
            PG8_WAIT_V(8); PG8_WAIT_L(0); PG8_BAR; PG8_MMA(0, 0, At, B0); PG8_MMA(0, 1, At, B1); PG8_BAR; PG8_SCHED;
            PG8_LDA(At, 1, 1); PG8_STAGE(PG8_SB(1, 0), b3, voffB); PG8_STAGE(PG8_SB(1, 1), b3 + hstep, voffB); PG8_STAGE(PG8_SA(1, 0), a3, voffA);
            PG8_WAIT_V(8); PG8_WAIT_L(0); PG8_BAR; PG8_MMA(1, 0, At, B0); PG8_MMA(1, 1, At, B1); PG8_BAR; PG8_SCHED;
            } else {
            PG8_LDB(B0, 0, 0); PG8_SCHED; PG8_LDA(At, 0, 0); PG8_STAGE(PG8_SA(1, 1), a1 + hstep, voffA);
            PG8_WAIT_L(8); PG8_BAR; PG8_WAIT_L(0); PG8_MMA(0, 0, At, B0); PG8_BAR; PG8_SCHED;
            PG8_LDB(B1, 0, 1); PG8_STAGE(PG8_SB(0, 0), b2, voffB);
            PG8_BAR; PG8_WAIT_L(0); PG8_MMA(0, 1, At, B1); PG8_BAR;
            PG8_LDA(At, 0, 1); PG8_STAGE(PG8_SA(0, 0), a2, voffA);
            PG8_BAR; PG8_WAIT_L(0); PG8_MMA(1, 0, At, B0); PG8_BAR; PG8_SCHED;
            PG8_STAGE(PG8_SB(0, 1), b2 + hstep, voffB);
            PG8_WAIT_V(6); PG8_BAR; PG8_MMA(1, 1, At, B1); PG8_BAR;
            PG8_LDB(B0, 1, 0); PG8_SCHED; PG8_LDA(At, 1, 0); PG8_STAGE(PG8_SA(0, 1), a2 + hstep, voffA);
            PG8_WAIT_L(8); PG8_BAR; PG8_WAIT_L(0); PG8_MMA(0, 0, At, B0); PG8_BAR; PG8_SCHED;
            PG8_LDB(B1, 1, 1); PG8_STAGE(PG8_SB(1, 0), b3, voffB);
            PG8_BAR; PG8_WAIT_L(0); PG8_MMA(0, 1, At, B1); PG8_BAR;
            PG8_LDA(At, 1, 1); PG8_STAGE(PG8_SA(1, 0), a3, voffA);
            PG8_BAR; PG8_WAIT_L(0); PG8_MMA(1, 0, At, B0); PG8_BAR; PG8_SCHED;
            PG8_STAGE(PG8_SB(1, 1), b3 + hstep, voffB);
            PG8_WAIT_V(6); PG8_BAR; PG8_MMA(1, 1, At, B1); PG8_BAR;
            }
        }
        if constexpr (ALIGN_EPI) { if (wr == 0) PG8_BAR; }
        E(acc, cur, wr, wc, fr, fq);
        if (!has_next) break;
#pragma unroll
        for (int a = 0; a < 2; ++a)
#pragma unroll
            for (int b = 0; b < 2; ++b)
#pragma unroll
                for (int m = 0; m < 4; ++m)
#pragma unroll
                    for (int n = 0; n < 2; ++n) acc[a][b][m][n] = (f32x4){0.f, 0.f, 0.f, 0.f};
        cur = nxt; cA = nA; cB = nB; ++ui;
        if constexpr (ALIGN_EPI) { if (wr == 1) PG8_BAR; }
    }
    PG8_WAIT_V(0);
    if constexpr (!ALIGN_EPI) { if (wr == 0) PG8_BAR; }
    PG8_BAR;
#undef PG8_SA
#undef PG8_SB
#undef PG8_STAGE
#undef PG8_LDA
#undef PG8_LDB
#undef PG8_MMA
#undef PG8_WAIT_V
#undef PG8_WAIT_L
#undef PG8_BAR
#undef PG8_SCHED
}
}

struct EpiPtrs {
    const GAS float* biasp; const GAS float* lb; const GAS float* x; GAS float* out; GAS unsigned char* ws; int round;
};
template <int MODE> struct EpiX {
    static constexpr bool PERM = true, AFTER_DRAIN = false;
    EpiPtrs P;
    __device__ __forceinline__ void operator()(const f32x4 (&acc)[2][2][4][2], const pg8::Unit& u, int wr, int wc, int fr, int fq) const {
        const int row0 = u.pm * 256 + wr * 64 + fr;
        const int colt = u.pn * 256 + wc * 32 + 8 * fq;
        GAS unsigned char* ws = P.ws;
        bf16_t* dst = nullptr; int ld = 0, coff = 0, act = 0; const GAS float* bias = nullptr;
        if (MODE == 1) {
            bias = P.biasp;
            if (u.pn < 8) { dst = (bf16_t*)(ws + WS_QKPRE); ld = 2048; coff = 0; act = 0; }
            else if (u.pn < 16) { dst = (bf16_t*)(ws + WS_V); ld = 2048; coff = 2048; act = 0; }
            else if (u.pn < 20) { dst = (bf16_t*)(ws + WS_GFLOG); ld = 1024; coff = 4096; act = 3; }
            else if (u.pn < 24) { dst = (bf16_t*)(ws + WS_GI); ld = 1024; coff = 5120; act = 0; }
            else { dst = (bf16_t*)(ws + WS_GQ); ld = 1024; coff = 6144; act = 2; }
        } else if (MODE == 2) {
            bias = P.biasp + N1;
            if (u.pn < 8) { dst = (bf16_t*)(ws + WS_SIGO); ld = 2048; coff = 0; act = 1; }
            else if (u.pn < 12) { dst = (bf16_t*)(ws + WS_SGG); ld = 1024; coff = 2048; act = 2; }
            else if (u.pn < 16) { dst = (bf16_t*)(ws + WS_SAM); ld = 1024; coff = 3072; act = 1; }
            else { dst = (bf16_t*)(ws + WS_SAG); ld = 1024; coff = 4096; act = 1; }
        } else if (MODE == 6) { dst = (bf16_t*)(ws + WS_QP); ld = 2048; coff = 0; act = 0; }
#pragma unroll
        for (int bj = 0; bj < 2; ++bj) {
            const int col = colt + bj * 128;
            f32x4 b0 = (f32x4){0.f, 0.f, 0.f, 0.f}, b1 = b0, l0 = b0, l1 = b0;
            if (MODE == 1 || MODE == 2) { b0 = *(const f32x4*)(bias + col); b1 = *(const f32x4*)(bias + col + 4); }
            if (MODE == 1) { if (act == 3) { l0 = *(const f32x4*)(P.lb + (col - coff)); l1 = *(const f32x4*)(P.lb + (col - coff) + 4); } }
#pragma unroll
            for (int ai = 0; ai < 2; ++ai)
#pragma unroll
                for (int m = 0; m < 4; ++m) {
                    const int row = row0 + ai * 128 + m * 16;
                    f32x4 v0 = acc[ai][bj][m][0] + b0, v1 = acc[ai][bj][m][1] + b1;
                    if (MODE == 1 || MODE == 2 || MODE == 6) {
                        if (act == 1) {
#pragma unroll
                            for (int j = 0; j < 4; ++j) { v0[j] = sigmoidf_(v0[j]); v1[j] = sigmoidf_(v1[j]); }
                        } else if (act == 2) {
#pragma unroll
                            for (int j = 0; j < 4; ++j) { v0[j] = siluf_(v0[j]); v1[j] = siluf_(v1[j]); }
                        } else if (act == 3) {
#pragma unroll
                            for (int j = 0; j < 4; ++j) { v0[j] = __logf(l0[j] + (1.0f - l0[j]) * sigmoidf_(v0[j])); v1[j] = __logf(l1[j] + (1.0f - l1[j]) * sigmoidf_(v1[j])); }
                        }
                        u32x4 w; w.x = pk2(v0[0], v0[1]); w.y = pk2(v0[2], v0[3]); w.z = pk2(v1[0], v1[1]); w.w = pk2(v1[2], v1[3]);
                        *(u32x4*)(dst + (size_t)row * ld + (col - coff)) = w;
                    } else if (MODE == 3) {
                        const u32x4 g = *(const u32x4*)((const bf16_t*)(ws + WS_SAM) + (size_t)row * 1024 + col);
                        GAS float* o = P.out + ((size_t)P.round * RT + row) * 1024 + col;
                        f32x4 r0, r1;
                        r0[0] = v0[0] * bf_lo(g.x); r0[1] = v0[1] * bf_hi(g.x); r0[2] = v0[2] * bf_lo(g.y); r0[3] = v0[3] * bf_hi(g.y);
                        r1[0] = v1[0] * bf_lo(g.z); r1[1] = v1[1] * bf_hi(g.z); r1[2] = v1[2] * bf_lo(g.w); r1[3] = v1[3] * bf_hi(g.w);
                        *(f32x4*)o = r0; *(f32x4*)(o + 4) = r1;
                    } else if (MODE == 4) {
                        const u32x4 g = *(const u32x4*)((const bf16_t*)(ws + WS_SAG) + (size_t)row * 1024 + col);
                        const GAS float* zp = P.out + ((size_t)P.round * RT + row) * 1024 + col;
                        const f32x4 p0 = *(const f32x4*)zp, p1 = *(const f32x4*)(zp + 4);
                        f32x4 r0, r1;
                        r0[0] = p0[0] + v0[0] * bf_lo(g.x); r0[1] = p0[1] + v0[1] * bf_hi(g.x); r0[2] = p0[2] + v0[2] * bf_lo(g.y); r0[3] = p0[3] + v0[3] * bf_hi(g.y);
                        r1[0] = p1[0] + v1[0] * bf_lo(g.z); r1[1] = p1[1] + v1[1] * bf_hi(g.z); r1[2] = p1[2] + v1[2] * bf_lo(g.w); r1[3] = p1[3] + v1[3] * bf_hi(g.w);
                        u32x4 w; w.x = pk2(r0[0], r0[1]); w.y = pk2(r0[2], r0[3]); w.z = pk2(r1[0], r1[1]); w.w = pk2(r1[2], r1[3]);
                        *(u32x4*)((bf16_t*)(ws + WS_GFLOG) + (size_t)row * 1024 + col) = w;
                    } else if (MODE == 5) {
                        const size_t off = ((size_t)P.round * RT + row) * 1024 + col;
                        const f32x4 x0 = *(const f32x4*)(P.x + off), x1 = *(const f32x4*)(P.x + off + 4);
                        *(f32x4*)(P.out + off) = x0 + v0; *(f32x4*)(P.out + off + 4) = x1 + v1;
                    }
                }
        }
    }
};

__device__ __forceinline__ void p0_transpose_item(const GAS float* W, int ldw, int K, int k0, int scol, GAS bf16_t* WT, int drow, LAS float* scr, int lane) {
#pragma unroll 8
    for (int i = 0; i < 32; ++i) { const int kk = 2 * i + (lane >> 5); scr[kk * 33 + (lane & 31)] = W[(size_t)(k0 + kk) * ldw + scol + (lane & 31)]; }
    LDS_WAIT(); asm volatile("" ::: "memory");
    const int c = lane & 7;
#pragma unroll
    for (int j = 0; j < 4; ++j) { const int n = (lane >> 3) + 8 * j; const LAS float* s = scr + (8 * c) * 33 + n;
        u32x4 o; o.x = pk2(s[0 * 33], s[1 * 33]); o.y = pk2(s[2 * 33], s[3 * 33]); o.z = pk2(s[4 * 33], s[5 * 33]); o.w = pk2(s[6 * 33], s[7 * 33]);
        *(u32x4*)(WT + (size_t)(drow + n) * K + k0 + 8 * c) = o; }
    LDS_WAIT(); asm volatile("" ::: "memory");
}
__device__ __forceinline__ int win_src_col(int n) {
    if (n < 4096) return n;
    if (n < 7168) return n - 4096 + 6152;
    if (n < 9216) return n - 7168 + 4096;
    return n - 9216 + 9224;
}

__device__ __forceinline__ void phase_p0(const DArgs& a, LAS unsigned char* lds, int vcu, int G) {
    const int tid = tid_(), lane = tid & 63, wave = tid >> 6;
    const int gw = vcu * NWAVES + wave, NGW = G * NWAVES;
    GAS unsigned char* ws = a.ws;
    LAS float* scr = (LAS float*)(lds + wave * 16384);
    constexpr int I_IN = 16 * 384, I_M = 32 * 32, I_G = 16 * 32, I_O = 16 * 32, I_PQ = 16 * 64;
    constexpr int NITEMS = I_IN + I_M + I_G + I_O + I_PQ;
    for (int it = gw; it < NITEMS; it += NGW) {
        int r = it;
        if (r < I_IN) { const int kb = r / 384, nb = r % 384; p0_transpose_item(a.w_in, IN_COLS, 1024, kb * 64, win_src_col(nb * 32), (GAS bf16_t*)(ws + WS_WIN), nb * 32, scr, lane); continue; } r -= I_IN;
        if (r < I_M) { const int kb = r / 32, nb = r % 32; p0_transpose_item(a.w_br_m, 1024, 2048, kb * 64, nb * 32, (GAS bf16_t*)(ws + WS_WM), nb * 32, scr, lane); continue; } r -= I_M;
        if (r < I_G) { const int kb = r / 32, nb = r % 32; p0_transpose_item(a.w_br_g, 1024, 1024, kb * 64, nb * 32, (GAS bf16_t*)(ws + WS_WG), nb * 32, scr, lane); continue; } r -= I_G;
        if (r < I_O) { const int kb = r / 32, nb = r % 32; p0_transpose_item(a.w_out, 1024, 1024, kb * 64, nb * 32, (GAS bf16_t*)(ws + WS_WO), nb * 32, scr, lane); continue; } r -= I_O;
        { const int kb = r / 64, nb = r % 64; p0_transpose_item(a.w_pq, 2048, 1024, kb * 64, nb * 32, (GAS bf16_t*)(ws + WS_WPQ), nb * 32, scr, lane); }
    }
    const int gt = vcu * NTHR + tid, NGT = G * NTHR;
    for (int i = gt; i < NP; i += NGT) ((float*)(ws + WS_BIASP))[i] = a.b_in[win_src_col(i)];
    for (int i = gt; i < 1024; i += NGT) { const float t0 = a.lb_table[i], t1 = a.lb_table[1024 + i]; ((float*)(ws + WS_LB))[i] = 1.0f / (1.0f + __expf(t1 - t0)); }
    for (int i = gt; i < 8 * 2 * 128 * 128 / 4; i += NGT) { const f32x4 v = ((const f32x4*)a.sub_keys)[i]; u32x2 o; o.x = pk2(v[0], v[1]); o.y = pk2(v[2], v[3]); ((u32x2*)(ws + WS_SK))[i] = o; }
    {
        float mu = 0.f, mv = 0.f;
        for (size_t i = (size_t)vcu * NTHR + tid; i < (size_t)16384 * 1024 / 4; i += (size_t)G * NTHR) {
            const f32x4 u4 = ((const GAS f32x4*)a.u_emb)[i], v4 = ((const GAS f32x4*)a.v_emb)[i];
            mu = fmaxf(mu, fmaxf(fmaxf(fabsf(u4[0]), fabsf(u4[1])), fmaxf(fabsf(u4[2]), fabsf(u4[3]))));
            mv = fmaxf(mv, fmaxf(fmaxf(fabsf(v4[0]), fabsf(v4[1])), fmaxf(fabsf(v4[2]), fabsf(v4[3])))); }
#pragma unroll
        for (int o = 1; o < 64; o <<= 1) { mu = fmaxf(mu, shx(mu, o, lane)); mv = fmaxf(mv, shx(mv, o, lane)); }
        if (lane == 0) { atomicMax((unsigned*)(ws + WS_CTL) + CW_TMAX, __builtin_bit_cast(unsigned, mu)); atomicMax((unsigned*)(ws + WS_CTL) + CW_TMAX + 1, __builtin_bit_cast(unsigned, mv)); }
    }
    f32x4 g1[4];
#pragma unroll
    for (int j = 0; j < 4; ++j) g1[j] = ((const GAS f32x4*)a.norm1_g)[64 * j + lane];
    f32x4 gw0[16], gw1[16];
#pragma unroll
    for (int j = 0; j < 4; ++j)
#pragma unroll
        for (int e = 0; e < 4; ++e) { const int k = 256 * j + 4 * lane + e; gw0[4 * j + e] = *(const GAS f32x4*)(a.w_in + (size_t)k * IN_COLS + 6144); gw1[4 * j + e] = *(const GAS f32x4*)(a.w_in + (size_t)k * IN_COLS + 6148); }
    const float gbias = lane < 8 ? a.b_in[6144 + lane] : 0.f;
    for (int m = gw; m < T; m += NGW) {
        const GAS f32x4* xr = (const GAS f32x4*)(a.x + (size_t)m * D) + lane;
        f32x4 v[4]; float s = 0.f;
#pragma unroll
        for (int j = 0; j < 4; ++j) { v[j] = xr[64 * j]; s += (v[j][0] * v[j][0] + v[j][1] * v[j][1]) + (v[j][2] * v[j][2] + v[j][3] * v[j][3]); }
        const float rstd = rsqrtf(wave_sum(s, lane) * (1.f / D) + EPS);
        GAS unsigned long long* o8 = (GAS unsigned long long*)((GAS bf16_t*)(ws + WS_XN) + (size_t)m * D) + lane;
        f32x4 ga0 = (f32x4){0.f, 0.f, 0.f, 0.f}, ga1 = ga0;
#pragma unroll
        for (int j = 0; j < 4; ++j) {
            v[j] = v[j] * rstd * g1[j];
            o8[64 * j] = (unsigned long long)pk2(v[j][0], v[j][1]) | ((unsigned long long)pk2(v[j][2], v[j][3]) << 32);
#pragma unroll
            for (int e = 0; e < 4; ++e) { ga0 += gw0[4 * j + e] * v[j][e]; ga1 += gw1[4 * j + e] * v[j][e]; }
        }
        float ga[8] = {ga0[0], ga0[1], ga0[2], ga0[3], ga1[0], ga1[1], ga1[2], ga1[3]};
#pragma unroll
        for (int q = 0; q < 8; ++q) ga[q] = wave_sum(ga[q], lane);
        if (lane < 8) { float r = ga[0];
#pragma unroll
            for (int q = 1; q < 8; ++q) r = (lane == q) ? ga[q] : r;
            ((GAS float*)(ws + WS_GATES))[(size_t)m * 8 + lane] = r + gbias; }
    }
}

__device__ __forceinline__ float logsigf_(float x) { return fminf(x, 0.f) - log1pf(__expf(-fabsf(x))); }
#define LDS_BAR() do { asm volatile("s_waitcnt lgkmcnt(0)" ::: "memory"); __builtin_amdgcn_s_barrier(); asm volatile("" ::: "memory"); } while (0)
#define MFMA16(a, b, c) __builtin_amdgcn_mfma_f32_16x16x32_bf16((a), (b), (c), 0, 0, 0)
__device__ __forceinline__ bf16x8 lfrag(const LAS unsigned char* base, int pitch, int row, int k0, int fq) { return *(const LAS bf16x8*)(base + row * pitch + (k0 + 8 * fq) * 2); }
__device__ __forceinline__ int fm_off(int r, int k, int KB) { return (((r >> 4) * KB + (k >> 5)) << 10) + (((((k >> 3) & 3) << 4) + (r & 15)) << 4) + ((k & 7) << 1); }
__device__ __forceinline__ bf16x8 gfrag(const bf16_t* base, int ld, int row, int k0, int fq) { return *(const bf16x8*)(base + (size_t)row * ld + k0 + 8 * fq); }

__device__ __forceinline__ void mscan_pair(const DArgs& a, LAS unsigned char* lds, int round, int p) {
    const int tid = tid_(), lane = tid & 63, part = tid >> 6;
    const int bl = p >> 2, h = p & 3, b = round * 2 + bl;
    const GAS float* g = (const GAS float*)(a.ws + WS_GATES) + ((size_t)b * SEQ + (size_t)lane * 128 + part * 16) * 8;
    float bsum = 0.f, gm = -INFINITY;
#pragma unroll 4
    for (int s = 0; s < 16; ++s) { const float ip = g[s * 8 + h], fp = g[s * 8 + 4 + h]; bsum += logsigf_(fp); gm = fmaxf(gm, ip - bsum); }
    LAS float* PS = (LAS float*)lds; LAS float* PM = PS + 512;
    PS[part * 64 + lane] = bsum; PM[part * 64 + lane] = gm;
    __syncthreads();
    if (tid < 64) {
        float bs = 0.f, g2 = -INFINITY;
#pragma unroll
        for (int q = 0; q < 8; ++q) { g2 = fmaxf(g2, PM[q * 64 + lane] - bs); bs += PS[q * 64 + lane]; }
        float mprev = 0.f, mine = 0.f;
        for (int c = 0; c < 64; ++c) {
            const float bc = rdlane(bs, c), gc = rdlane(g2, c);
            if (lane == c) mine = mprev; mprev = bc + fmaxf(mprev, gc); }
        ((GAS float*)(a.ws + WS_MPREV))[(round * 8 + p) * 64 + lane] = mine;
    }
    __syncthreads();
}

constexpr int PQ_PITCH = 528, PS_PITCH = 272;
__device__ __forceinline__ void mlstm_pre_item(const DArgs& a, LAS unsigned char* lds, int round, int item) {
    const int tid = tid_(), lane = tid & 63, wave = __builtin_amdgcn_readfirstlane(tid >> 6), fr = lane & 15, fq = lane >> 4;
    const int p = item >> 6, c = item & 63, bl = p >> 2, h = p & 3, b = round * 2 + bl;
    const int tl0 = bl * SEQ + c * 128; const size_t tg0 = (size_t)b * SEQ + c * 128;
    GAS unsigned char* ws = a.ws;
    LAS unsigned char* QL = lds; LAS unsigned char* KL = lds + 67584;
    LAS float* AS = (LAS float*)(lds + 135168); LAS float* MS = AS + 128; LAS float* SC = AS + 256;
    if (wave == 0) {
        const float mprev = ((const float*)(ws + WS_MPREV))[(round * 8 + p) * 64 + c];
        const float* g = (const float*)(ws + WS_GATES) + (tg0 + 2 * lane) * 8;
        const float ip0 = g[h], fp0 = g[4 + h], ip1 = g[8 + h], fp1 = g[12 + h];
        const float lf0 = logsigf_(fp0), lf1 = logsigf_(fp1), pp = lf0 + lf1;
        float incl = pp;
#pragma unroll
        for (int o = 1; o < 64; o <<= 1) { const float t = shup(incl, o, lane); if (lane >= o) incl += t; }
        const float excl = incl - pp, b0 = excl + lf0, b1 = incl;
        const float a0 = ip0 - b0, a1 = ip1 - b1;
        float inclm = fmaxf(a0, a1);
#pragma unroll
        for (int o = 1; o < 64; o <<= 1) { const float t = shup(inclm, o, lane); if (lane >= o) inclm = fmaxf(inclm, t); }
        float exclm = shup(inclm, 1, lane); if (lane == 0) exclm = -INFINITY;
        const float M0 = fmaxf(mprev, fmaxf(exclm, a0)), M1 = fmaxf(mprev, inclm);
        AS[2 * lane] = a0; AS[2 * lane + 1] = a1; MS[2 * lane] = M0; MS[2 * lane + 1] = M1;
        float* mt = (float*)(ws + WS_MT) + (tg0 + 2 * lane) * 4 + h;
        mt[0] = b0 + M0; mt[4] = b1 + M1;
        const float Mlast = rdlane(M1, 63);
        if (lane == 0) { SC[0] = mprev; SC[1] = Mlast; ((float*)(ws + WS_MDEC))[item] = __expf(mprev - Mlast); }
    }
    {
        const int cgp = tid & 63, strip = tid >> 6;
        const int col = (cgp < 32) ? (h * 256 + cgp * 8) : (1024 + h * 256 + (cgp - 32) * 8);
        float w[4][8], bb[8];
#pragma unroll
        for (int j = 0; j < 4; ++j) { const f32x4 w0 = *(const f32x4*)(a.conv_w + j * 2048 + col), w1 = *(const f32x4*)(a.conv_w + j * 2048 + col + 4);
#pragma unroll
            for (int e = 0; e < 4; ++e) { w[j][e] = w0[e]; w[j][4 + e] = w1[e]; } }
        { const f32x4 b0 = *(const f32x4*)(a.conv_b + col), b1 = *(const f32x4*)(a.conv_b + col + 4);
#pragma unroll
            for (int e = 0; e < 4; ++e) { bb[e] = b0[e]; bb[4 + e] = b1[e]; } }
        const bf16_t* src = (const bf16_t*)(ws + WS_QKPRE) + (size_t)(tl0 + 16 * strip) * 2048 + col;
        const float qs = (cgp < 32) ? 0.0625f : 1.0f;
        LAS unsigned char* dstt = ((cgp < 32) ? QL : KL) + (cgp & 31) * 16;
#pragma unroll 1
        for (int half = 0; half < 2; ++half) {
            u32x4 xr[11];
#pragma unroll
            for (int r = 0; r < 11; ++r) {
                const int sl = c * 128 + 16 * strip + 8 * half + r - 3;
                xr[r] = (sl >= 0) ? *(const u32x4*)(src + (ptrdiff_t)(8 * half + r - 3) * 2048) : (u32x4){0u, 0u, 0u, 0u};
            }
#pragma unroll
            for (int r = 0; r < 8; ++r) {
                float y[8];
#pragma unroll
                for (int e = 0; e < 8; ++e) y[e] = bb[e];
#pragma unroll
                for (int j = 0; j < 4; ++j) { const u32x4 xv = xr[r + j];
                    y[0] += w[j][0] * bf_lo(xv.x); y[1] += w[j][1] * bf_hi(xv.x); y[2] += w[j][2] * bf_lo(xv.y); y[3] += w[j][3] * bf_hi(xv.y);
                    y[4] += w[j][4] * bf_lo(xv.z); y[5] += w[j][5] * bf_hi(xv.z); y[6] += w[j][6] * bf_lo(xv.w); y[7] += w[j][7] * bf_hi(xv.w); }
#pragma unroll
                for (int e = 0; e < 8; ++e) y[e] = siluf_(y[e]) * qs;
                u32x4 o; o.x = pk2(y[0], y[1]); o.y = pk2(y[2], y[3]); o.z = pk2(y[4], y[5]); o.w = pk2(y[6], y[7]);
                *(LAS u32x4*)(dstt + (16 * strip + 8 * half + r) * PQ_PITCH) = o;
            }
        }
    }
    __syncthreads();
    const float mprev = SC[0], Mlast = SC[1];
    {
        bf16_t* Sg = (bf16_t*)(ws + WS_S) + (size_t)item * 128 * 128;
        const int t = wave * 16 + fr; const float Mt = MS[t];
        for (int st = 0; st < 8; ++st) {
            u32x2 o = (u32x2){0u, 0u};
            if (st <= wave) {
                f32x4 acc = (f32x4){0.f, 0.f, 0.f, 0.f};
#pragma unroll
                for (int ks = 0; ks < 8; ++ks) acc = MFMA16(lfrag(KL, PQ_PITCH, st * 16 + fr, ks * 32, fq), lfrag(QL, PQ_PITCH, wave * 16 + fr, ks * 32, fq), acc);
                float v[4];
#pragma unroll
                for (int j = 0; j < 4; ++j) { const int s = st * 16 + 4 * fq + j; v[j] = (s <= t) ? acc[j] * __expf(AS[s] - Mt) : 0.f; }
                o.x = pk2(v[0], v[1]); o.y = pk2(v[2], v[3]);
            }
            *(u32x2*)((unsigned char*)Sg + fm_off(t, st * 16 + 4 * fq, 4)) = o;
        }
    }
    {
        bf16_t* Qg = (bf16_t*)(ws + WS_QT) + (size_t)item * 128 * 256;
#pragma unroll
        for (int i = 0; i < 8; ++i) { const int idx = tid + 512 * i, blk = idx >> 6, t = (blk >> 3) * 16 + (idx & 15), ch = (blk & 7) * 4 + ((idx >> 4) & 3);
            const u32x4 v = *(const LAS u32x4*)(QL + t * PQ_PITCH + ch * 16); const float s = __expf(mprev - MS[t]);
            u32x4 o; o.x = pk2(bf_lo(v.x) * s, bf_hi(v.x) * s); o.y = pk2(bf_lo(v.y) * s, bf_hi(v.y) * s); o.z = pk2(bf_lo(v.z) * s, bf_hi(v.z) * s); o.w = pk2(bf_lo(v.w) * s, bf_hi(v.w) * s);
            *(u32x4*)((unsigned char*)Qg + fm_off(t, ch * 8, 8)) = o; }
    }
    {
        bf16_t* Kg = (bf16_t*)(ws + WS_KWT) + (size_t)item * 256 * 128;
        const int dlo = lane & 15, sglo = lane >> 4;
#pragma unroll
        for (int i = 0; i < 8; ++i) { const int combo = wave * 8 + i, d = (combo >> 2) * 16 + dlo, s0 = ((combo & 3) * 4 + sglo) * 8;
            float v[8];
#pragma unroll
            for (int e = 0; e < 8; ++e) v[e] = bf2f(*(const LAS bf16_t*)(KL + (s0 + e) * PQ_PITCH + d * 2)) * __expf(AS[s0 + e] - Mlast);
            u32x4 o; o.x = pk2(v[0], v[1]); o.y = pk2(v[2], v[3]); o.z = pk2(v[4], v[5]); o.w = pk2(v[6], v[7]);
            *(u32x4*)((unsigned char*)Kg + fm_off(d, s0, 4)) = o; }
    }
    __syncthreads();
}

__device__ __forceinline__ void hgrn_pre_item(const DArgs& a, LAS unsigned char* lds, int round, int item) {
    const int tid = tid_(), lane = tid & 63, wave = __builtin_amdgcn_readfirstlane(tid >> 6), fr = lane & 15, fq = lane >> 4;
    const int p = item >> 7, c = item & 127, bl = p >> 3, h = p & 7;
    const int tl0 = bl * SEQ + c * 64;
    GAS unsigned char* ws = a.ws;
    LAS float* CUM = (LAS float*)lds;
    LAS float* GL = (LAS float*)(lds + 32768);
    LAS unsigned char* QH = lds + 65536;
    LAS unsigned char* KE = lds + 65536 + 64 * PS_PITCH;
    LAS float* QF = (LAS float*)(lds + 65536 + 128 * PS_PITCH);
#pragma unroll
    for (int i = 0; i < 2; ++i) { const int idx = tid + 512 * i, s = idx >> 4, ch = idx & 15;
        const u32x4 gv = *(const u32x4*)((const bf16_t*)(ws + WS_GFLOG) + (size_t)(tl0 + s) * 1024 + h * 128 + ch * 8);
        const u32x4 qv = *(const u32x4*)((const bf16_t*)(ws + WS_GQ) + (size_t)(tl0 + s) * 1024 + h * 128 + ch * 8);
        LAS float* gd = GL + s * 128 + ch * 8; LAS float* qd = QF + s * 128 + ch * 8;
        gd[0] = bf_lo(gv.x); gd[1] = bf_hi(gv.x); gd[2] = bf_lo(gv.y); gd[3] = bf_hi(gv.y); gd[4] = bf_lo(gv.z); gd[5] = bf_hi(gv.z); gd[6] = bf_lo(gv.w); gd[7] = bf_hi(gv.w);
        qd[0] = bf_lo(qv.x); qd[1] = bf_hi(qv.x); qd[2] = bf_lo(qv.y); qd[3] = bf_hi(qv.y); qd[4] = bf_lo(qv.z); qd[5] = bf_hi(qv.z); qd[6] = bf_lo(qv.w); qd[7] = bf_hi(qv.w); }
    __syncthreads();
    {
        const int d = tid & 127, qt = tid >> 7; float cs = 0.f;
#pragma unroll 4
        for (int s = 0; s < 16; ++s) { cs += GL[(qt * 16 + s) * 128 + d]; CUM[(qt * 16 + s) * 128 + d] = cs; }
        __syncthreads();
        float off = 0.f;
#pragma unroll
        for (int q = 0; q < 3; ++q) off += (q < qt) ? CUM[(q * 16 + 15) * 128 + d] : 0.f;
        __syncthreads();
#pragma unroll 4
        for (int s = 0; s < 16; ++s) CUM[(qt * 16 + s) * 128 + d] += off;
        if (qt == 3) ((GAS float*)(ws + WS_HGDEC))[(size_t)item * 128 + d] = __expf(cs + off);
    }
    __syncthreads();
    {
        bf16_t* Qg = (bf16_t*)(ws + WS_QTG) + (size_t)item * 64 * 128;
#pragma unroll
        for (int i = 0; i < 2; ++i) { const int idx = tid + 512 * i, s = idx >> 4, ch = idx & 15;
            float qt[8], qh[8], ke[8];
#pragma unroll
            for (int e = 0; e < 8; ++e) { const int d = ch * 8 + e; const float cm = CUM[s * 128 + d], last = CUM[63 * 128 + d], q = QF[s * 128 + d], g = GL[s * 128 + d];
                qt[e] = q * __expf(cm); qh[e] = q * __expf(cm - last); ke[e] = (1.0f - __expf(g)) * __expf(last - cm); }
            u32x4 o; o.x = pk2(qt[0], qt[1]); o.y = pk2(qt[2], qt[3]); o.z = pk2(qt[4], qt[5]); o.w = pk2(qt[6], qt[7]);
            *(u32x4*)((unsigned char*)Qg + fm_off(s, ch * 8, 4)) = o;
            o.x = pk2(qh[0], qh[1]); o.y = pk2(qh[2], qh[3]); o.z = pk2(qh[4], qh[5]); o.w = pk2(qh[6], qh[7]);
            *(LAS u32x4*)(QH + s * PS_PITCH + ch * 16) = o;
            o.x = pk2(ke[0], ke[1]); o.y = pk2(ke[2], ke[3]); o.z = pk2(ke[4], ke[5]); o.w = pk2(ke[6], ke[7]);
            *(LAS u32x4*)(KE + s * PS_PITCH + ch * 16) = o; }
    }
    __syncthreads();
    {
        bf16_t* Ag = (bf16_t*)(ws + WS_ATT) + (size_t)item * 64 * 64;
#pragma unroll
        for (int i = 0; i < 2; ++i) { const int tile = wave * 2 + i, tt = tile >> 2, st = tile & 3; const int t = tt * 16 + fr;
            u32x2 o = (u32x2){0u, 0u};
            if (st <= tt) { f32x4 acc = (f32x4){0.f, 0.f, 0.f, 0.f};
#pragma unroll
                for (int ks = 0; ks < 4; ++ks) acc = MFMA16(lfrag(KE, PS_PITCH, st * 16 + fr, ks * 32, fq), lfrag(QH, PS_PITCH, tt * 16 + fr, ks * 32, fq), acc);
                float v[4];
#pragma unroll
                for (int j = 0; j < 4; ++j) { const int s = st * 16 + 4 * fq + j; v[j] = (s <= t) ? acc[j] : 0.f; }
                o.x = pk2(v[0], v[1]); o.y = pk2(v[2], v[3]); }
            *(u32x2*)((unsigned char*)Ag + fm_off(t, st * 16 + 4 * fq, 2)) = o; }
    }
    {
        bf16_t* Kg = (bf16_t*)(ws + WS_KENDT) + (size_t)item * 128 * 64;
        const int dlo = lane & 15, sglo = lane >> 4;
#pragma unroll
        for (int i = 0; i < 2; ++i) { const int combo = wave * 2 + i, d = (combo >> 1) * 16 + dlo, s0 = ((combo & 1) * 4 + sglo) * 8;
            unsigned v[8];
#pragma unroll
            for (int e = 0; e < 8; ++e) v[e] = *(const LAS bf16_t*)(KE + (s0 + e) * PS_PITCH + d * 2);
            u32x4 o; o.x = v[0] | (v[1] << 16); o.y = v[2] | (v[3] << 16); o.z = v[4] | (v[5] << 16); o.w = v[6] | (v[7] << 16);
            *(u32x4*)((unsigned char*)Kg + fm_off(d, s0, 2)) = o; }
    }
    __syncthreads();
}

template <int NVT, bool DEN>
__device__ __forceinline__ void mlstm_scan(const DArgs& a, LAS unsigned char* lds, int round, int p, int sl) {
    const int tid = tid_(), lane = tid & 63, wave = __builtin_amdgcn_readfirstlane(tid >> 6), fr = lane & 15, fq = lane >> 4;
    const int bl = p >> 2, h = p & 3, b = round * 2 + bl;
    GAS unsigned char* ws = a.ws;
    constexpr int VTB = NVT * 16 * PS_PITCH, CTB = NVT * 16 * PQ_PITCH;
    LAS unsigned char* VT = lds; LAS unsigned char* CT = lds + 2 * VTB; LAS float* DEC = (LAS float*)(lds + 2 * VTB + 2 * CTB);
    for (int i = tid; i < (2 * VTB + 2 * CTB) / 4; i += NTHR) ((LAS unsigned*)lds)[i] = 0u;
    if (tid < 64) DEC[tid] = ((const GAS float*)(ws + WS_MDEC))[p * 64 + tid];
    __syncthreads();
    if (DEN) { if (tid < 256) { const int bufi = tid >> 7, s = tid & 127; *(LAS bf16_t*)(VT + bufi * VTB + s * 2) = (bf16_t)0x3F80; } }
    f32x4 st[2][NVT];
#pragma unroll
    for (int dt = 0; dt < 2; ++dt)
#pragma unroll
        for (int vt = 0; vt < NVT; ++vt) st[dt][vt] = (f32x4){0.f, 0.f, 0.f, 0.f};
    const int vcol = h * 512 + sl * 32;
    const int vs = tid >> 2, vpart = tid & 3;
    const GAS unsigned char* Sg0 = ws + WS_S + (size_t)(p * 64) * 32768 + wave * 4096 + lane * 16;
    const GAS unsigned char* Qg0 = ws + WS_QT + (size_t)(p * 64) * 65536 + wave * 8192 + lane * 16;
    const GAS unsigned char* Kg0 = ws + WS_KWT + (size_t)(p * 64) * 65536 + wave * 8192 + lane * 16;
    const GAS bf16_t* Vg0 = (const GAS bf16_t*)(ws + WS_V) + (size_t)(bl * SEQ + vs) * 2048 + vcol + vpart * 8;
    bf16x8 bS[4], bQ[8], aK[2][4]; u32x4 vreg = (u32x4){0u, 0u, 0u, 0u};
#define V_STAGE(cc_) do { LAS unsigned char* d0_ = VT + ((cc_) & 1) * VTB + (vpart * 8) * PS_PITCH + vs * 2; \
        *(LAS bf16_t*)(d0_ + 0 * PS_PITCH) = (bf16_t)(vreg.x & 0xffffu); *(LAS bf16_t*)(d0_ + 1 * PS_PITCH) = (bf16_t)(vreg.x >> 16); \
        *(LAS bf16_t*)(d0_ + 2 * PS_PITCH) = (bf16_t)(vreg.y & 0xffffu); *(LAS bf16_t*)(d0_ + 3 * PS_PITCH) = (bf16_t)(vreg.y >> 16); \
        *(LAS bf16_t*)(d0_ + 4 * PS_PITCH) = (bf16_t)(vreg.z & 0xffffu); *(LAS bf16_t*)(d0_ + 5 * PS_PITCH) = (bf16_t)(vreg.z >> 16); \
        *(LAS bf16_t*)(d0_ + 6 * PS_PITCH) = (bf16_t)(vreg.w & 0xffffu); *(LAS bf16_t*)(d0_ + 7 * PS_PITCH) = (bf16_t)(vreg.w >> 16); } while (0)
    if (!DEN) { vreg = *(const GAS u32x4*)Vg0; V_STAGE(0); }
    __builtin_amdgcn_sched_barrier(0);
#pragma unroll
    for (int ks = 0; ks < 4; ++ks)
#pragma unroll
        for (int dt = 0; dt < 2; ++dt) aK[dt][ks] = *(const GAS bf16x8*)(Kg0 + (dt * 4 + ks) * 1024);
    __builtin_amdgcn_sched_barrier(0);
#pragma unroll
    for (int ks = 0; ks < 4; ++ks) bS[ks] = *(const GAS bf16x8*)(Sg0 + ks * 1024);
    __builtin_amdgcn_sched_barrier(0);
#pragma unroll
    for (int ks = 0; ks < 8; ++ks) bQ[ks] = *(const GAS bf16x8*)(Qg0 + ks * 1024);
    __builtin_amdgcn_sched_barrier(0);
    if (!DEN) vreg = *(const GAS u32x4*)(Vg0 + (size_t)128 * 2048);
    __builtin_amdgcn_sched_barrier(0);
    const GAS unsigned char* pfp; unsigned pfstride;
    { const int tt = (wave * 64 + lane) < 160 ? wave * 64 + lane : 159; const int idx = sl * 10 + (tt >> 4), off = (tt & 15) * 64;
      pfp = (idx < 32 ? ws + WS_S + (size_t)(p * 64) * 32768 + idx * 1024 : idx < 96 ? ws + WS_QT + (size_t)(p * 64) * 65536 + (idx - 32) * 1024 : ws + WS_KWT + (size_t)(p * 64) * 65536 + (idx - 96) * 1024) + off;
      pfstride = idx < 32 ? 32768u : 65536u; }
    unsigned pfv = 0u;
#pragma unroll 1
    for (int c = 0; c < 64; ++c) {
        const int tl0 = bl * SEQ + c * 128; const size_t tg0 = (size_t)b * SEQ + c * 128;
        const int cn = c < 63 ? c + 1 : 63, cn2 = c < 62 ? c + 2 : 63;
        LAS unsigned char* vt_ = VT + (c & 1) * VTB; LAS unsigned char* ct_ = CT + (c & 1) * CTB; LAS unsigned char* ctn = CT + ((c + 1) & 1) * CTB;
        LDS_BAR();
        if (!DEN && wave < 3) { asm volatile("" :: "v"(pfv)); const int c3 = c < 60 ? c + 3 : 63; pfv = *(const GAS unsigned*)(pfp + (size_t)c3 * pfstride); }
        bf16x8 vf[NVT][4], cf[NVT][4];
#pragma unroll
        for (int vt = 0; vt < NVT; ++vt)
#pragma unroll
            for (int ks = 0; ks < 4; ++ks) vf[vt][ks] = lfrag(vt_, PS_PITCH, vt * 16 + fr, ks * 32, fq);
        const float dec = DEC[c];
        __builtin_amdgcn_sched_barrier(0);
#pragma unroll
        for (int dt = 0; dt < 2; ++dt)
#pragma unroll
            for (int vt = 0; vt < NVT; ++vt) st[dt][vt] = st[dt][vt] * dec;
#pragma unroll
        for (int ks = 0; ks < 4; ++ks) {
#pragma unroll
            for (int vt = 0; vt < NVT; ++vt) cf[vt][ks] = lfrag(ct_, PQ_PITCH, vt * 16 + fr, ks * 32, fq);
#pragma unroll
            for (int dt = 0; dt < 2; ++dt) {
#pragma unroll
                for (int vt = 0; vt < NVT; ++vt) st[dt][vt] = MFMA16(aK[dt][ks], vf[vt][ks], st[dt][vt]);
                aK[dt][ks] = *(const GAS bf16x8*)(Kg0 + (size_t)cn * 65536 + (dt * 4 + ks) * 1024);
            }
            __builtin_amdgcn_sched_barrier(0);
        }
#pragma unroll
        for (int dt = 0; dt < 2; ++dt)
#pragma unroll
            for (int vt = 0; vt < NVT; ++vt) { u32x2 o; o.x = pk2(st[dt][vt][0], st[dt][vt][1]); o.y = pk2(st[dt][vt][2], st[dt][vt][3]);
                *(LAS u32x2*)(ctn + (vt * 16 + fr) * PQ_PITCH + (wave * 32 + dt * 16 + 4 * fq) * 2) = o; }
        __builtin_amdgcn_sched_barrier(0);
        f32x4 acc[NVT];
#pragma unroll
        for (int vt = 0; vt < NVT; ++vt) acc[vt] = (f32x4){0.f, 0.f, 0.f, 0.f};
#pragma unroll
        for (int ks = 0; ks < 4; ++ks) {
#pragma unroll
            for (int vt = 0; vt < NVT; ++vt) acc[vt] = MFMA16(vf[vt][ks], bS[ks], acc[vt]);
            bS[ks] = *(const GAS bf16x8*)(Sg0 + (size_t)cn * 32768 + ks * 1024);
            __builtin_amdgcn_sched_barrier(0);
        }
#pragma unroll
        for (int ks = 0; ks < 8; ++ks) {
#pragma unroll
            for (int vt = 0; vt < NVT; ++vt) acc[vt] = MFMA16(cf[vt][ks & 3], bQ[ks], acc[vt]);
            if (ks < 4) {
#pragma unroll
                for (int vt = 0; vt < NVT; ++vt) cf[vt][ks] = lfrag(ct_, PQ_PITCH, vt * 16 + fr, 128 + ks * 32, fq);
            }
            bQ[ks] = *(const GAS bf16x8*)(Qg0 + (size_t)cn * 65536 + ks * 1024);
            __builtin_amdgcn_sched_barrier(0);
        }
        const int t = wave * 16 + fr;
        if (!DEN) {
            GAS bf16_t* hn = (GAS bf16_t*)(ws + WS_QKPRE) + (size_t)(tl0 + t) * 2048 + vcol + 4 * fq;
#pragma unroll
            for (int vt = 0; vt < NVT; ++vt) { u32x2 o; o.x = pk2(acc[vt][0], acc[vt][1]); o.y = pk2(acc[vt][2], acc[vt][3]); *(GAS u32x2*)(hn + vt * 16) = o; }
            V_STAGE(c + 1); vreg = *(const GAS u32x4*)(Vg0 + (size_t)cn2 * 128 * 2048);
        } else {
            if (fq == 0) ((GAS float*)(ws + WS_DEN))[(tg0 + t) * 4 + h] = acc[0][0];
        }
    }
    asm volatile("" :: "v"(pfv));
    __syncthreads();
#undef V_STAGE
}

constexpr int HG_PD = 4;
__device__ __forceinline__ void hgrn_scan(const DArgs& a, LAS unsigned char* lds, int round, int p, int sl) {
    const int tid = tid_(), lane = tid & 63, wave = __builtin_amdgcn_readfirstlane(tid >> 6), fr = lane & 15, fq = lane >> 4;
    const int bl = p >> 3, h = p & 7;
    GAS unsigned char* ws = a.ws;
    constexpr int IP = 144, ITB = 32 * IP, STB = 32 * PS_PITCH;
    LAS unsigned char* IT = lds; LAS unsigned char* ST = lds + 2 * ITB;
    for (int i = tid; i < (2 * ITB + 2 * STB) / 4; i += NTHR) ((LAS unsigned*)lds)[i] = 0u;
    __syncthreads();
    f32x4 st[2][2];
#pragma unroll
    for (int i = 0; i < 2; ++i) { st[i][0] = (f32x4){0.f, 0.f, 0.f, 0.f}; st[i][1] = st[i][0]; }
    const int vcol = h * 128 + sl * 32;
    const int is = (tid & 255) >> 2, ipart = tid & 3;
    const bool outw = wave < 4;
    const int w4 = wave & 3;
    const GAS unsigned char* Ag0 = ws + WS_ATT + (size_t)(p * 128) * 8192 + w4 * 2048 + lane * 16;
    const GAS unsigned char* Qg0 = ws + WS_QTG + (size_t)(p * 128) * 16384 + w4 * 4096 + lane * 16;
    const GAS unsigned char* Kg0 = ws + WS_KENDT + (size_t)(p * 128) * 16384 + w4 * 4096 + lane * 16;
    const GAS unsigned char* Dg0 = ws + WS_HGDEC + ((size_t)(p * 128) * 128 + w4 * 32 + 4 * fq) * 4;
    const GAS unsigned char* Ig0 = ws + WS_GI + ((size_t)(bl * SEQ + is) * 1024 + vcol + ipart * 8) * 2;
    const GAS unsigned char* gb0 = outw ? Ag0 : Kg0;          const unsigned gs0 = outw ? 8192u : 16384u;
    const GAS unsigned char* gb1 = outw ? Qg0 : Kg0 + 2048;   const unsigned gs1 = 16384u;
    const GAS unsigned char* gb2 = outw ? Qg0 + 2048 : Dg0;   const unsigned gs2 = outw ? 16384u : 512u, gt2 = outw ? 1024u : 64u;
    const GAS unsigned char* gb3 = outw ? Ig0 : Dg0;          const unsigned gs3 = outw ? 131072u : 512u;
    u32x4 pf[HG_PD][7];
#define HG_LD01(k_, cc_) do { _Pragma("unroll") for (int j_ = 0; j_ < 2; ++j_) pf[k_][j_] = *(const GAS u32x4*)(gb0 + (size_t)(cc_) * gs0 + j_ * 1024); } while (0)
#define HG_LD23(k_, cc_) do { _Pragma("unroll") for (int j_ = 0; j_ < 2; ++j_) pf[k_][2 + j_] = *(const GAS u32x4*)(gb1 + (size_t)(cc_) * gs1 + j_ * 1024); } while (0)
#define HG_LD45(k_, cc_) do { _Pragma("unroll") for (int j_ = 0; j_ < 2; ++j_) pf[k_][4 + j_] = *(const GAS u32x4*)(gb2 + (size_t)(cc_) * gs2 + j_ * gt2); } while (0)
#define HG_LD6(k_, cc_) do { pf[k_][6] = *(const GAS u32x4*)(gb3 + (size_t)(cc_) * gs3); } while (0)
#pragma unroll
    for (int k = 0; k < HG_PD; ++k) { HG_LD01(k, k); HG_LD23(k, k); HG_LD45(k, k); __builtin_amdgcn_sched_barrier(0); HG_LD6((k + 1) % HG_PD, (k + 1 < HG_PD ? k + 1 : HG_PD)); __builtin_amdgcn_sched_barrier(0); }
    const GAS unsigned char* pfp; unsigned pfstride;
    { const int tt = (wave * 64 + lane) < 160 ? wave * 64 + lane : 159; const int idx = sl * 10 + (tt >> 4), off = (tt & 15) * 64;
      pfp = (idx < 8 ? ws + WS_ATT + (size_t)(p * 128) * 8192 + idx * 1024 : idx < 24 ? ws + WS_QTG + (size_t)(p * 128) * 16384 + (idx - 8) * 1024 : ws + WS_KENDT + (size_t)(p * 128) * 16384 + (idx - 24) * 1024) + off;
      pfstride = idx < 8 ? 8192u : 16384u; }
    unsigned pfv[HG_PD];
#pragma unroll
    for (int k = 0; k < HG_PD; ++k) pfv[k] = 0u;
#define HG_STAGE(dst_, iv_) do { LAS unsigned char* d0_ = (dst_) + (ipart * 8) * IP + is * 2; \
        *(LAS bf16_t*)(d0_ + 0 * IP) = (bf16_t)((iv_).x & 0xffffu); *(LAS bf16_t*)(d0_ + 1 * IP) = (bf16_t)((iv_).x >> 16); \
        *(LAS bf16_t*)(d0_ + 2 * IP) = (bf16_t)((iv_).y & 0xffffu); *(LAS bf16_t*)(d0_ + 3 * IP) = (bf16_t)((iv_).y >> 16); \
        *(LAS bf16_t*)(d0_ + 4 * IP) = (bf16_t)((iv_).z & 0xffffu); *(LAS bf16_t*)(d0_ + 5 * IP) = (bf16_t)((iv_).z >> 16); \
        *(LAS bf16_t*)(d0_ + 6 * IP) = (bf16_t)((iv_).w & 0xffffu); *(LAS bf16_t*)(d0_ + 7 * IP) = (bf16_t)((iv_).w >> 16); } while (0)
    if (outw) { const u32x4 iv = *(const GAS u32x4*)Ig0; HG_STAGE(IT, iv); }
#pragma unroll 1
    for (int c0 = 0; c0 < 128; c0 += HG_PD) {
#pragma unroll
      for (int k = 0; k < HG_PD; ++k) {
        const int c = c0 + k;
        const int tl0 = bl * SEQ + c * 64;
        const int cn = (c + HG_PD < 128) ? c + HG_PD : 127;
        LAS unsigned char* it_ = IT + (k & 1) * ITB; LAS unsigned char* itn = IT + ((k + 1) & 1) * ITB; LAS unsigned char* st_ = ST + (k & 1) * STB; LAS unsigned char* stn = ST + ((k + 1) & 1) * STB;
        LDS_BAR();
        if (wave < 3) { asm volatile("" :: "v"(pfv[k])); const int c7 = (c + HG_PD + 3 < 128) ? c + HG_PD + 3 : 127; pfv[k] = *(const GAS unsigned*)(pfp + (size_t)c7 * pfstride); }
        bf16x8 itf[2][2];
#pragma unroll
        for (int vt = 0; vt < 2; ++vt)
#pragma unroll
            for (int ks = 0; ks < 2; ++ks) itf[vt][ks] = lfrag(it_, IP, vt * 16 + fr, ks * 32, fq);
        bf16x8 sf[2][4];
        f32x4 acc[2];
        acc[0] = (f32x4){0.f, 0.f, 0.f, 0.f}; acc[1] = acc[0];
        if (outw) {
#pragma unroll
            for (int vt = 0; vt < 2; ++vt)
#pragma unroll
                for (int ks = 0; ks < 4; ++ks) sf[vt][ks] = lfrag(st_, PS_PITCH, vt * 16 + fr, ks * 32, fq);
#pragma unroll
            for (int ks = 0; ks < 2; ++ks)
#pragma unroll
                for (int vt = 0; vt < 2; ++vt) acc[vt] = MFMA16(itf[vt][ks], __builtin_bit_cast(bf16x8, pf[k][ks]), acc[vt]);
        } else {
            const f32x4 dec = __builtin_bit_cast(f32x4, pf[k][4]);
#pragma unroll
            for (int vt = 0; vt < 2; ++vt) { st[0][vt] = st[0][vt] * dec;
#pragma unroll
                for (int ks = 0; ks < 2; ++ks) st[0][vt] = MFMA16(__builtin_bit_cast(bf16x8, pf[k][ks]), itf[vt][ks], st[0][vt]); }
        }
        __builtin_amdgcn_sched_barrier(0);
        HG_LD01(k, cn);
        __builtin_amdgcn_sched_barrier(0);
        if (outw) {
#pragma unroll
            for (int ks = 0; ks < 2; ++ks)
#pragma unroll
                for (int vt = 0; vt < 2; ++vt) acc[vt] = MFMA16(sf[vt][ks], __builtin_bit_cast(bf16x8, pf[k][2 + ks]), acc[vt]);
        } else {
            const f32x4 dec = __builtin_bit_cast(f32x4, pf[k][5]);
#pragma unroll
            for (int vt = 0; vt < 2; ++vt) { st[1][vt] = st[1][vt] * dec;
#pragma unroll
                for (int ks = 0; ks < 2; ++ks) st[1][vt] = MFMA16(__builtin_bit_cast(bf16x8, pf[k][2 + ks]), itf[vt][ks], st[1][vt]); }
        }
        __builtin_amdgcn_sched_barrier(0);
        HG_LD23(k, cn);
        __builtin_amdgcn_sched_barrier(0);
        if (outw) {
#pragma unroll
            for (int ks = 2; ks < 4; ++ks)
#pragma unroll
                for (int vt = 0; vt < 2; ++vt) acc[vt] = MFMA16(sf[vt][ks], __builtin_bit_cast(bf16x8, pf[k][2 + ks]), acc[vt]);
        } else {
#pragma unroll
            for (int dtile = 0; dtile < 2; ++dtile)
#pragma unroll
                for (int vt = 0; vt < 2; ++vt) { u32x2 o; o.x = pk2(st[dtile][vt][0], st[dtile][vt][1]); o.y = pk2(st[dtile][vt][2], st[dtile][vt][3]);
                    *(LAS u32x2*)(stn + (vt * 16 + fr) * PS_PITCH + (w4 * 32 + dtile * 16 + 4 * fq) * 2) = o; }
        }
        __builtin_amdgcn_sched_barrier(0);
        HG_LD45(k, cn);
        __builtin_amdgcn_sched_barrier(0);
        if (outw) {
            HG_STAGE(itn, pf[(k + 1) % HG_PD][6]);
            GAS bf16_t* og = (GAS bf16_t*)(ws + WS_GQ) + (size_t)(tl0 + w4 * 16 + fr) * 1024 + vcol + 4 * fq;
#pragma unroll
            for (int vt = 0; vt < 2; ++vt) { u32x2 o; o.x = pk2(acc[vt][0], acc[vt][1]); o.y = pk2(acc[vt][2], acc[vt][3]); *(GAS u32x2*)(og + vt * 16) = o; }
        }
        __builtin_amdgcn_sched_barrier(0);
        { const int cni = (c + 1 + HG_PD < 128) ? c + 1 + HG_PD : 127; HG_LD6((k + 1) % HG_PD, cni); }
        __builtin_amdgcn_sched_barrier(0);
      }
    }
#pragma unroll
    for (int k = 0; k < HG_PD; ++k) asm volatile("" :: "v"(pfv[k]));
    __syncthreads();
#undef HG_LD01
#undef HG_LD23
#undef HG_LD45
#undef HG_LD6
#undef HG_STAGE
}

__device__ __forceinline__ void phase_ypass(const DArgs& a, int round, int vcu, int G) {
    const int tid = tid_(), lane = tid & 63, wave = tid >> 6;
    const int gw = vcu * NWAVES + wave, NGW = G * NWAVES;
    GAS unsigned char* ws = a.ws;
    f32x4 mg0[4], mg1[4], gg4[4];
#pragma unroll
    for (int j = 0; j < 4; ++j) { mg0[j] = *(const GAS f32x4*)(a.m_head_g + j * 512 + lane * 8); mg1[j] = *(const GAS f32x4*)(a.m_head_g + j * 512 + lane * 8 + 4); gg4[j] = *(const GAS f32x4*)(a.g_head_g + lane * 16 + 4 * j); }
    for (int tl = gw; tl < RT; tl += NGW) {
        const size_t tg = (size_t)round * RT + tl;
        const f32x4 den4 = *(const f32x4*)((const float*)(ws + WS_DEN) + tg * 4), mt4 = *(const f32x4*)((const float*)(ws + WS_MT) + tg * 4);
#pragma unroll
        for (int j = 0; j < 4; ++j) {
            const int col = j * 512 + lane * 8;
            const u32x4 nv = *(const u32x4*)((const bf16_t*)(ws + WS_QKPRE) + (size_t)tl * 2048 + col);
            const u32x4 ov = *(const u32x4*)((const bf16_t*)(ws + WS_SIGO) + (size_t)tl * 2048 + col);
            const float inv = 1.0f / fmaxf(fabsf(den4[j]), __expf(-mt4[j]));
            float hv[8] = {bf_lo(nv.x) * inv, bf_hi(nv.x) * inv, bf_lo(nv.y) * inv, bf_hi(nv.y) * inv, bf_lo(nv.z) * inv, bf_hi(nv.z) * inv, bf_lo(nv.w) * inv, bf_hi(nv.w) * inv};
            float ss = 0.f;
#pragma unroll
            for (int e = 0; e < 8; ++e) ss += hv[e] * hv[e];
            const float r = rsqrtf(wave_sum(ss, lane) * (1.f / 512.f) + EPS);
            const f32x4 g0 = mg0[j], g1 = mg1[j];
            const float og[8] = {bf_lo(ov.x), bf_hi(ov.x), bf_lo(ov.y), bf_hi(ov.y), bf_lo(ov.z), bf_hi(ov.z), bf_lo(ov.w), bf_hi(ov.w)};
            float y[8];
#pragma unroll
            for (int e = 0; e < 8; ++e) y[e] = og[e] * hv[e] * r * (e < 4 ? g0[e] : g1[e - 4]);
            u32x4 o; o.x = pk2(y[0], y[1]); o.y = pk2(y[2], y[3]); o.z = pk2(y[4], y[5]); o.w = pk2(y[6], y[7]);
            *(u32x4*)((bf16_t*)(ws + WS_V) + (size_t)tl * 2048 + col) = o;
        }
        {
            const int col = lane * 16;
            const u32x4 n0 = *(const u32x4*)((const bf16_t*)(ws + WS_GQ) + (size_t)tl * 1024 + col), n1 = *(const u32x4*)((const bf16_t*)(ws + WS_GQ) + (size_t)tl * 1024 + col + 8);
            const u32x4 s0 = *(const u32x4*)((const bf16_t*)(ws + WS_SGG) + (size_t)tl * 1024 + col), s1 = *(const u32x4*)((const bf16_t*)(ws + WS_SGG) + (size_t)tl * 1024 + col + 8);
            float ov[16] = {bf_lo(n0.x), bf_hi(n0.x), bf_lo(n0.y), bf_hi(n0.y), bf_lo(n0.z), bf_hi(n0.z), bf_lo(n0.w), bf_hi(n0.w), bf_lo(n1.x), bf_hi(n1.x), bf_lo(n1.y), bf_hi(n1.y), bf_lo(n1.z), bf_hi(n1.z), bf_lo(n1.w), bf_hi(n1.w)};
            const float sg[16] = {bf_lo(s0.x), bf_hi(s0.x), bf_lo(s0.y), bf_hi(s0.y), bf_lo(s0.z), bf_hi(s0.z), bf_lo(s0.w), bf_hi(s0.w), bf_lo(s1.x), bf_hi(s1.x), bf_lo(s1.y), bf_hi(s1.y), bf_lo(s1.z), bf_hi(s1.z), bf_lo(s1.w), bf_hi(s1.w)};
            float ss = 0.f;
#pragma unroll
            for (int e = 0; e < 16; ++e) ss += ov[e] * ov[e];
            ss += DPP_(ss, 0xB1); ss += DPP_(ss, 0x4E); ss += DPP_(ss, 0x141);
            const float r = rsqrtf(ss * (1.f / 128.f) + EPS);
            float y[16];
#pragma unroll
            for (int e = 0; e < 16; ++e) y[e] = ov[e] * r * gg4[e >> 2][e & 3] * sg[e];
            u32x4 o; o.x = pk2(y[0], y[1]); o.y = pk2(y[2], y[3]); o.z = pk2(y[4], y[5]); o.w = pk2(y[6], y[7]);
            *(u32x4*)((bf16_t*)(ws + WS_GI) + (size_t)tl * 1024 + col) = o;
            o.x = pk2(y[8], y[9]); o.y = pk2(y[10], y[11]); o.z = pk2(y[12], y[13]); o.w = pk2(y[14], y[15]);
            *(u32x4*)((bf16_t*)(ws + WS_GI) + (size_t)tl * 1024 + col + 8) = o;
        }
    }
}


#define XB_TMO      128
#define XB_XCNT(j)  (256  + 64 * (j))
#define XB_XSUB(j)  (1280 + 64 * (j))
#define XB_XGEN(j)  (2304 + 64 * (j))
#define XB_TOP      3328
#define XB_TOPGEN   3392
#define XB_SPIN_CAP (1u << 22)
constexpr int CW_BAR = 4096;
constexpr int LDS_BARST = LDS_BYTES - 64;
__device__ __forceinline__ unsigned xb_ld(unsigned* p)              { return __hip_atomic_load(p, __ATOMIC_RELAXED, __HIP_MEMORY_SCOPE_AGENT); }
__device__ __forceinline__ unsigned xb_add(unsigned* p, unsigned v) { return __hip_atomic_fetch_add(p, v, __ATOMIC_RELAXED, __HIP_MEMORY_SCOPE_AGENT); }
__device__ __forceinline__ unsigned xb_xcc_id() { return (unsigned)__builtin_amdgcn_s_getreg((3 << 11) | 20) & 0xFu; }
#define XB_SPIN(cond, bar) do { unsigned _sp = 0; while (cond) { __builtin_amdgcn_s_sleep(1); \
    if ((++_sp & 255u) == 0u) { if (xb_ld(&(bar)[XB_TMO])) break; if (_sp > XB_SPIN_CAP) { atomicAdd(&(bar)[XB_TMO], 1u); break; } } } } while (0)
__device__ __forceinline__ void xcd_barrier_post(unsigned* bar, volatile LAS unsigned* st) { if (tid_() == 0) st[2] = xb_add(&bar[XB_XCNT(xb_xcc_id())], 1u); }
__device__ __forceinline__ void xcd_barrier_complete(unsigned* bar, unsigned x, unsigned& nloc, unsigned& nx) {
    const unsigned G = gridDim.x;
    unsigned sum, cnt, mine, sp = 0u;
    for (;;) {
        sum = 0u; cnt = 0u; mine = 0u;
#pragma unroll
        for (unsigned j = 0; j < 16; ++j) { const unsigned c = xb_ld(&bar[XB_XCNT(j)]); sum += c; cnt += (c > 0u) ? 1u : 0u; mine = (j == x) ? c : mine; }
        if (sum == G) break;
        __builtin_amdgcn_s_sleep(1);
        if ((++sp & 255u) == 0u) { if (xb_ld(&bar[XB_TMO])) break; if (sp > XB_SPIN_CAP) { atomicAdd(&bar[XB_TMO], 1u); break; } }
    }
    nloc = mine > 0u ? mine : 1u; nx = cnt > 0u ? cnt : 1u;
}
__device__ __forceinline__ void xcd_barrier(unsigned* bar, volatile LAS unsigned* st) {
    asm volatile("s_waitcnt vmcnt(0)" ::: "memory");
    __syncthreads();
    if (tid_() == 0) {
        const unsigned x = xb_xcc_id();
        __builtin_amdgcn_s_waitcnt(0);
        unsigned nloc = st[0], nx = st[1];
        if (nloc == 0u) { xcd_barrier_complete(bar, x, nloc, nx); st[0] = nloc; st[1] = nx; }
        const unsigned old = xb_add(&bar[XB_XSUB(x)], 1u);
        const unsigned gen = old / nloc;
        if (old + 1u == (gen + 1u) * nloc) {
            __builtin_amdgcn_fence(__ATOMIC_RELEASE, "agent");
            asm volatile("s_waitcnt vmcnt(0)" ::: "memory");
            const unsigned og = xb_add(&bar[XB_TOP], 1u);
            const unsigned tg = og / nx;
            if (og + 1u == (tg + 1u) * nx) xb_add(&bar[XB_TOPGEN], 1u);
            else XB_SPIN(xb_ld(&bar[XB_TOPGEN]) == tg, bar);
            __builtin_amdgcn_fence(__ATOMIC_ACQUIRE, "agent");
            xb_add(&bar[XB_XGEN(x)], 1u);
            asm volatile("s_waitcnt vmcnt(0)" ::: "memory");
        } else {
            XB_SPIN(xb_ld(&bar[XB_XGEN(x)]) == gen, bar);
            __builtin_amdgcn_fence(__ATOMIC_ACQUIRE, "agent");
            asm volatile("s_waitcnt vmcnt(0)" ::: "memory");
        }
    }
    __syncthreads();
}

__device__ __forceinline__ void phase_p8(const DArgs& a, int vcu, int G) {
    const int tid = tid_(), lane = tid & 63, wave = tid >> 6;
    const int gw = vcu * NWAVES + wave, NGW = G * NWAVES;
    GAS unsigned char* ws = a.ws;
    f32x4 g2[4];
#pragma unroll
    for (int j = 0; j < 4; ++j) g2[j] = ((const f32x4*)a.norm2_g)[64 * j + lane];
    for (int m = gw; m < T; m += NGW) {
        const f32x4* xr = (const f32x4*)(a.out + (size_t)m * D) + lane;
        f32x4 v[4]; float s = 0.f;
#pragma unroll
        for (int j = 0; j < 4; ++j) { v[j] = xr[64 * j]; s += (v[j][0] * v[j][0] + v[j][1] * v[j][1]) + (v[j][2] * v[j][2] + v[j][3] * v[j][3]); }
        const float rstd = rsqrtf(wave_sum(s, lane) * (1.f / D) + EPS);
        unsigned long long* o8 = (unsigned long long*)((bf16_t*)(ws + WS_XN) + (size_t)m * D) + lane;
#pragma unroll
        for (int j = 0; j < 4; ++j) { v[j] = v[j] * rstd * g2[j]; o8[64 * j] = (unsigned long long)pk2(v[j][0], v[j][1]) | ((unsigned long long)pk2(v[j][2], v[j][3]) << 32); }
    }
    {
        const float mu = __builtin_bit_cast(float, ((const GAS unsigned*)(ws + WS_CTL))[CW_TMAX]), mv = __builtin_bit_cast(float, ((const GAS unsigned*)(ws + WS_CTL))[CW_TMAX + 1]);
        const float su = mu > 0.f ? 448.0f / mu : 1.0f, sv = mv > 0.f ? 448.0f / mv : 1.0f;
        if (vcu == 0 && tid == 0) { ((GAS float*)(ws + WS_USC))[0] = 1.0f / su; ((GAS float*)(ws + WS_USC))[1] = 1.0f / sv; }
        for (size_t i = (size_t)vcu * NTHR + tid; i < (size_t)16384 * 1024 / 8; i += (size_t)G * NTHR) {
            const f32x4 u0 = ((const GAS f32x4*)a.u_emb)[2 * i], u1 = ((const GAS f32x4*)a.u_emb)[2 * i + 1];
            const f32x4 v0 = ((const GAS f32x4*)a.v_emb)[2 * i], v1 = ((const GAS f32x4*)a.v_emb)[2 * i + 1];
            u32x2 o; int p;
            p = __builtin_amdgcn_cvt_pk_fp8_f32(u0[0] * su, u0[1] * su, 0, false); p = __builtin_amdgcn_cvt_pk_fp8_f32(u0[2] * su, u0[3] * su, p, true); o.x = (unsigned)p;
            p = __builtin_amdgcn_cvt_pk_fp8_f32(u1[0] * su, u1[1] * su, 0, false); p = __builtin_amdgcn_cvt_pk_fp8_f32(u1[2] * su, u1[3] * su, p, true); o.y = (unsigned)p;
            ((GAS u32x2*)(ws + WS_UB))[i] = o;
            p = __builtin_amdgcn_cvt_pk_fp8_f32(v0[0] * sv, v0[1] * sv, 0, false); p = __builtin_amdgcn_cvt_pk_fp8_f32(v0[2] * sv, v0[3] * sv, p, true); o.x = (unsigned)p;
            p = __builtin_amdgcn_cvt_pk_fp8_f32(v1[0] * sv, v1[1] * sv, 0, false); p = __builtin_amdgcn_cvt_pk_fp8_f32(v1[2] * sv, v1[3] * sv, p, true); o.y = (unsigned)p;
            ((GAS u32x2*)(ws + WS_VB))[i] = o;
        }
    }
}

__device__ __forceinline__ unsigned f2ord(float f) { const unsigned u = __builtin_bit_cast(unsigned, f); return (u & 0x80000000u) ? ~u : (u | 0x80000000u); }
__device__ __forceinline__ float ord2f(unsigned k) { const unsigned u = (k & 0x80000000u) ? (k & 0x7fffffffu) : ~k; return __builtin_bit_cast(float, u); }
__device__ __forceinline__ unsigned umax_(unsigned a, unsigned b) { return a > b ? a : b; }
__device__ __forceinline__ unsigned shxu(unsigned v, int o, int lane) { return (unsigned)__builtin_amdgcn_ds_bpermute((lane ^ o) << 2, (int)v); }

__device__ __forceinline__ void phase_topk(const DArgs& a, LAS unsigned char* lds, int bx, int G) {
    const int tid = tid_(), lane = tid & 63, wave = __builtin_amdgcn_readfirstlane(tid >> 6), fr = lane & 15, fq = lane >> 4;
    GAS unsigned char* ws = a.ws;
    const int h = bx & 7;
    LAS unsigned char* KY = lds;
    LAS unsigned char* QL = lds + 2 * 128 * PS_PITCH;
    LAS unsigned* TOP = (LAS unsigned*)(lds + 2 * 128 * PS_PITCH + 64 * PQ_PITCH);
#pragma unroll
    for (int i = 0; i < 8; ++i) { const int idx = tid + 512 * i, row = idx >> 4, ch = idx & 15;
        *(LAS u32x4*)(KY + row * PS_PITCH + ch * 16) = *(const u32x4*)((const bf16_t*)(ws + WS_SK) + ((size_t)h * 256 + row) * 128 + ch * 8); }
    const int ntile = T / 64;
    for (int tile = bx >> 3; tile < ntile; tile += (G >> 3)) {
        const size_t t0 = (size_t)tile * 64;
        __syncthreads();
#pragma unroll
        for (int i = 0; i < 4; ++i) { const int idx = tid + 512 * i, row = idx >> 5, ch = idx & 31;
            *(LAS u32x4*)(QL + row * PQ_PITCH + ch * 16) = *(const u32x4*)((const bf16_t*)(ws + WS_QP) + (t0 + row) * 2048 + h * 256 + ch * 8); }
        __syncthreads();
        {
            const int mt = wave & 3, p = wave >> 2;
            unsigned key[32];
#pragma unroll
            for (int nt = 0; nt < 8; ++nt) { f32x4 acc = (f32x4){0.f, 0.f, 0.f, 0.f};
#pragma unroll
                for (int ks = 0; ks < 4; ++ks) acc = MFMA16(lfrag(KY + p * 128 * PS_PITCH, PS_PITCH, nt * 16 + fr, ks * 32, fq), lfrag(QL, PQ_PITCH, mt * 16 + fr, p * 128 + ks * 32, fq), acc);
#pragma unroll
                for (int j = 0; j < 4; ++j) { const int n = nt * 16 + 4 * fq + j; key[nt * 4 + j] = (f2ord(acc[j]) & ~127u) | (unsigned)(127 - n); } }
#pragma unroll 1
            for (int k = 0; k < 16; ++k) {
                unsigned m = key[0];
#pragma unroll
                for (int e = 1; e < 32; ++e) m = umax_(m, key[e]);
                m = umax_(m, (unsigned)SWZI_(m, 0x401F)); m = umax_(m, xor32u_(m, lane >= 32));
#pragma unroll
                for (int e = 0; e < 32; ++e) key[e] = (key[e] == m) ? 0u : key[e];
                if (fq == (k & 3)) TOP[(p * 64 + mt * 16 + fr) * 16 + k] = m;
            }
        }
        __syncthreads();
        {
            const int t = tid >> 3, sub = tid & 7;
            unsigned ck[7];
#pragma unroll
            for (int e = 0; e < 7; ++e) {
                const int ci = sub + 8 * e;
                int i = 0, base = 0; bool ok = ci < 50;
                if (ci >= 42) { i = 8 + (ci - 42); base = ci; } else if (ci >= 40) { i = 7; base = 40; } else if (ci >= 38) { i = 6; base = 38; } else if (ci >= 36) { i = 5; base = 36; }
                else if (ci >= 33) { i = 4; base = 33; } else if (ci >= 29) { i = 3; base = 29; } else if (ci >= 24) { i = 2; base = 24; } else if (ci >= 16) { i = 1; base = 16; }
                const int j = ci - base;
                unsigned kk = 0u;
                if (ok) { const float s0 = ord2f(TOP[(0 * 64 + t) * 16 + i] & ~127u), s1 = ord2f(TOP[(1 * 64 + t) * 16 + j] & ~127u);
                    kk = (f2ord(s0 + s1) & ~255u) | (unsigned)(255 - (i * 16 + j)); }
                ck[e] = kk;
            }
            unsigned w0 = 0u, w1 = 0u;
#pragma unroll 1
            for (int k = 0; k < 16; ++k) {
                unsigned m = ck[0];
#pragma unroll
                for (int e = 1; e < 7; ++e) m = umax_(m, ck[e]);
                m = umax_(m, (unsigned)DPPI_(m, 0xB1)); m = umax_(m, (unsigned)DPPI_(m, 0x4E)); m = umax_(m, (unsigned)DPPI_(m, 0x141));
#pragma unroll
                for (int e = 0; e < 7; ++e) ck[e] = (ck[e] == m) ? 0u : ck[e];
                if (k == sub) w0 = m; if (k == sub + 8) w1 = m;
            }
            const int f0 = 255 - (int)(w0 & 255u), f1 = 255 - (int)(w1 & 255u);
            const float sc0 = ord2f(w0 & ~255u), sc1 = ord2f(w1 & ~255u);
            float mx = fmaxf(sc0, sc1); mx = fmaxf(mx, DPP_(mx, 0xB1)); mx = fmaxf(mx, DPP_(mx, 0x4E)); mx = fmaxf(mx, DPP_(mx, 0x141));
            const float e0 = __expf(sc0 - mx), e1 = __expf(sc1 - mx);
            float sm = e0 + e1; sm += DPP_(sm, 0xB1); sm += DPP_(sm, 0x4E); sm += DPP_(sm, 0x141);
            const float inv = 1.0f / sm;
            const int i0 = 127 - (int)(TOP[(0 * 64 + t) * 16 + (f0 >> 4)] & 127u), j0 = 127 - (int)(TOP[(1 * 64 + t) * 16 + (f0 & 15)] & 127u);
            const int i1 = 127 - (int)(TOP[(0 * 64 + t) * 16 + (f1 >> 4)] & 127u), j1 = 127 - (int)(TOP[(1 * 64 + t) * 16 + (f1 & 15)] & 127u);
            int* ei = (int*)(ws + WS_EIDX) + ((t0 + t) * 8 + h) * 16; float* gp = (float*)(ws + WS_GATE) + ((t0 + t) * 8 + h) * 16;
            ei[sub] = i0 * 128 + j0; ei[sub + 8] = i1 * 128 + j1; gp[sub] = e0 * inv; gp[sub + 8] = e1 * inv;
        }
    }
    __syncthreads();
}

__device__ __forceinline__ void ins16(float (&v)[16], int (&id)[16], float x, int n) {
    if (x > v[15]) { v[15] = x; id[15] = n;
#pragma unroll
        for (int i = 15; i >= 1; --i) { if (v[i] > v[i - 1]) { const float tv = v[i]; v[i] = v[i - 1]; v[i - 1] = tv; const int ti = id[i]; id[i] = id[i - 1]; id[i - 1] = ti; } } }
}
__device__ __forceinline__ void phase_topk_ref(const DArgs& a, int vcu, int G) {
    const int tid = tid_();
    GAS unsigned char* ws = a.ws;
    const int gt = vcu * NTHR + tid, NGT = G * NTHR;
    for (int pair = gt; pair < T * 8; pair += NGT) {
        const int t = pair >> 3, h = pair & 7;
        float sv[2][16]; int si[2][16];
#pragma unroll
        for (int p = 0; p < 2; ++p) {
#pragma unroll
            for (int i = 0; i < 16; ++i) { sv[p][i] = -INFINITY; si[p][i] = 0; }
            const bf16_t* qp = (const bf16_t*)(ws + WS_QP) + (size_t)t * 2048 + h * 256 + p * 128;
            for (int n = 0; n < 128; ++n) {
                const bf16_t* kp = (const bf16_t*)(ws + WS_SK) + ((size_t)(h * 2 + p) * 128 + n) * 128;
                float s = 0.f;
                for (int c = 0; c < 128; c += 8) { const u32x4 qv = *(const u32x4*)(qp + c), kv = *(const u32x4*)(kp + c);
                    s += bf_lo(qv.x) * bf_lo(kv.x) + bf_hi(qv.x) * bf_hi(kv.x) + bf_lo(qv.y) * bf_lo(kv.y) + bf_hi(qv.y) * bf_hi(kv.y)
                       + bf_lo(qv.z) * bf_lo(kv.z) + bf_hi(qv.z) * bf_hi(kv.z) + bf_lo(qv.w) * bf_lo(kv.w) + bf_hi(qv.w) * bf_hi(kv.w); }
                ins16(sv[p], si[p], s, n);
            }
        }
        float tv[16]; int ti[16];
#pragma unroll
        for (int i = 0; i < 16; ++i) { tv[i] = -INFINITY; ti[i] = 0; }
#pragma unroll
        for (int i = 0; i < 16; ++i)
#pragma unroll
            for (int j = 0; j < 16; ++j) ins16(tv, ti, sv[0][i] + sv[1][j], i * 16 + j);
        float sm = 0.f, ex[16];
#pragma unroll
        for (int k = 0; k < 16; ++k) { ex[k] = __expf(tv[k] - tv[0]); sm += ex[k]; }
        int* ei = (int*)(ws + WS_EIDX) + (size_t)pair * 16; float* gp = (float*)(ws + WS_GATE) + (size_t)pair * 16;
#pragma unroll
        for (int k = 0; k < 16; ++k) {
            int e0 = 0, e1 = 0;
#pragma unroll
            for (int i = 0; i < 16; ++i) { e0 = ((ti[k] >> 4) == i) ? si[0][i] : e0; e1 = ((ti[k] & 15) == i) ? si[1][i] : e1; }
            ei[k] = e0 * 128 + e1; gp[k] = ex[k] / sm; }
    }
}

#define FP8LO(w) __builtin_amdgcn_cvt_pk_f32_fp8((int)(w), false)
#define FP8HI(w) __builtin_amdgcn_cvt_pk_f32_fp8((int)(w), true)
__device__ __forceinline__ float dot16_fp8(const u32x4 r, const float (&x)[16]) {
    float c = 0.f;
#pragma unroll
    for (int j = 0; j < 4; ++j) { const f32x2 lo = FP8LO(r[j]), hi = FP8HI(r[j]); c += lo[0] * x[4 * j] + lo[1] * x[4 * j + 1] + hi[0] * x[4 * j + 2] + hi[1] * x[4 * j + 3]; }
    return c;
}
__device__ __forceinline__ float gelu_erf(float d) {
    const float ad = fabsf(d), t = __builtin_amdgcn_rcpf(ad * 0.2316418882f + 1.0f);
    float q = t * 0.5307027145f + (-0.7265760135f); q = q * t + 0.7107068705f; q = q * t + (-0.142248368f); q = q * t + 0.127414796f; q = q * t;
    const float m = d * (q * __builtin_amdgcn_exp2f(d * d * (-0.72134752044f)));
    return d < 0.f ? m : d - m;
}
__device__ __forceinline__ float bperm(float v, int srclane) { return __builtin_bit_cast(float, __builtin_amdgcn_ds_bpermute(srclane << 2, __builtin_bit_cast(int, v))); }
#define SWZ_(v, pat) __builtin_bit_cast(float, __builtin_amdgcn_ds_swizzle(__builtin_bit_cast(int, (v)), (pat)))
__device__ __forceinline__ float xor32_(float v, bool hi) {
#if defined(__HIP_DEVICE_COMPILE__)
    const auto r = __builtin_amdgcn_permlane32_swap(__builtin_bit_cast(unsigned, v), __builtin_bit_cast(unsigned, v), false, false);
    return __builtin_bit_cast(float, hi ? r[0] : r[1]);
#else
    (void)hi; return v;
#endif
}
__device__ __forceinline__ float reduce8(const float (&p)[8], int lane) {
    float q4[4], q2[2];
    const bool b5 = lane & 32, b4 = lane & 16, b3 = lane & 8;
#pragma unroll
    for (int i = 0; i < 4; ++i) { const float send = b5 ? p[i] : p[i + 4], keep = b5 ? p[i + 4] : p[i]; q4[i] = keep + xor32_(send, b5); }
#pragma unroll
    for (int i = 0; i < 2; ++i) { const float send = b4 ? q4[i] : q4[i + 2], keep = b4 ? q4[i + 2] : q4[i]; q2[i] = keep + SWZ_(send, 0x401F); }
    const float send = b3 ? q2[0] : q2[1], keep = b3 ? q2[1] : q2[0];
    float q1 = keep + SWZ_(send, 0x201F);
    q1 += DPP_(q1, 0xB1); q1 += DPP_(q1, 0x4E); q1 += DPP_(q1, 0x141);
    return q1;
}
__device__ __forceinline__ void phase_udots(const DArgs& a, LAS unsigned char* lds) {
    const int tid = tid_(), lane = tid & 63, wave = __builtin_amdgcn_readfirstlane(tid >> 6);
    GAS unsigned char* ws = a.ws;
    volatile LAS unsigned* bst = (volatile LAS unsigned*)(lds + LDS_BARST);
    const int nloc = (int)bst[0], nx = (int)bst[1], rank = (int)bst[2];
    unsigned* bar = (unsigned*)(ws + WS_CTL) + CW_BAR;
    const unsigned myx = xb_xcc_id();
    int q = 0;
    for (unsigned j = 0; j < 16; ++j) { const unsigned c = xb_ld(&bar[XB_XCNT(j)]); if (c > 0u && j < myx) ++q; }
    LAS int* LE = (LAS int*)(lds + wave * 2048);
    LAS int* LP = LE + 128; LAS float* LG = (LAS float*)(LE + 256);
    const GAS unsigned char* UB = ws + WS_UB;
    const int g8 = lane >> 3;
    const float usc = ((const GAS float*)(ws + WS_USC))[0], vsc = ((const GAS float*)(ws + WS_USC))[1];
    for (int s = q; s < 8; s += nx) {
        int tok = rank * 8 + wave;
        u32x4 xq0 = (u32x4){0u, 0u, 0u, 0u}, xq1 = xq0; u32x2 e2 = (u32x2){0u, 0u}; f32x2 g2 = (f32x2){0.f, 0.f};
#define U_INFO(t_) do { xq0 = *(const u32x4*)((const GAS bf16_t*)(ws + WS_XN) + (size_t)(t_) * D + lane * 16); xq1 = *(const u32x4*)((const GAS bf16_t*)(ws + WS_XN) + (size_t)(t_) * D + lane * 16 + 8); \
        e2 = *(const u32x2*)((const GAS int*)(ws + WS_EIDX) + (size_t)(t_) * 128 + 2 * lane); g2 = *(const f32x2*)((const GAS float*)(ws + WS_GATE) + (size_t)(t_) * 128 + 2 * lane); } while (0)
        if (tok < T) U_INFO(tok);
        for (; tok < T; tok += nloc * 8) {
            const bool in0 = (int)(e2.x >> 11) == s, in1 = (int)(e2.y >> 11) == s;
            const unsigned long long m0 = __ballot(in0), m1 = __ballot(in1);
            const unsigned long long lt = (1ull << lane) - 1ull;
            const int n0 = __popcll(m0), n = n0 + __popcll(m1);
            if (in0) { const int pos = __popcll(m0 & lt); LE[pos] = (int)e2.x; LP[pos] = 2 * lane; LG[pos] = g2[0]; }
            if (in1) { const int pos = n0 + __popcll(m1 & lt); LE[pos] = (int)e2.y; LP[pos] = 2 * lane + 1; LG[pos] = g2[1]; }
            const float xf[16] = {bf_lo(xq0.x), bf_hi(xq0.x), bf_lo(xq0.y), bf_hi(xq0.y), bf_lo(xq0.z), bf_hi(xq0.z), bf_lo(xq0.w), bf_hi(xq0.w),
                                  bf_lo(xq1.x), bf_hi(xq1.x), bf_lo(xq1.y), bf_hi(xq1.y), bf_lo(xq1.z), bf_hi(xq1.z), bf_lo(xq1.w), bf_hi(xq1.w)};
            asm volatile("s_waitcnt lgkmcnt(0)" ::: "memory");
            u32x4 R0[8], R1[8], R2[8];
#define U_ISSUE(R_, g0_) do { _Pragma("unroll") for (int k = 0; k < 8; ++k) { const int slot_ = ((g0_) + k < n) ? (g0_) + k : n - 1; const int e_ = LE[slot_]; R_[k] = *(const u32x4*)(UB + (size_t)e_ * 1024 + lane * 16); } } while (0)
#define U_DOTS(R_, g0_) do { float pp_[8]; _Pragma("unroll") for (int k = 0; k < 8; ++k) pp_[k] = dot16_fp8(R_[k], xf); const float dsum_ = reduce8(pp_, lane); const int slot_ = (g0_) + g8; \
            if (slot_ < n && (lane & 7) == 0) { const float d_ = dsum_ * usc; \
                ((GAS float*)(ws + WS_PW))[(size_t)tok * 128 + LP[slot_]] = 0.5f * d_ * (1.0f + erff(d_ * 0.70710678118654752f)) * LG[slot_] * vsc; } } while (0)
            if (n > 0) U_ISSUE(R0, 0);
            if (n > 8) U_ISSUE(R1, 8);
            if (n > 16) U_ISSUE(R2, 16);
            const int tokN = tok + nloc * 8;
            if (tokN < T) U_INFO(tokN);
            if (n > 0) U_DOTS(R0, 0);
            if (n > 8) U_DOTS(R1, 8);
            if (n > 16) U_DOTS(R2, 16);
            for (int g0 = 24; g0 < n; g0 += 8) { U_ISSUE(R0, g0); U_DOTS(R0, g0); }
            asm volatile("s_waitcnt lgkmcnt(0)" ::: "memory");
        }
#undef U_INFO
#undef U_ISSUE
#undef U_DOTS
    }
}

struct XcdSlice { int nloc, nx, rank, q; };
__device__ __forceinline__ XcdSlice xcd_slice_setup(const DArgs& a, LAS unsigned char* lds) {
    volatile LAS unsigned* bst = (volatile LAS unsigned*)(lds + LDS_BARST);
    XcdSlice x; x.nloc = (int)bst[0]; x.nx = (int)bst[1]; x.rank = (int)bst[2];
    unsigned* bar = (unsigned*)(a.ws + WS_CTL) + CW_BAR; const unsigned myx = xb_xcc_id();
    x.q = 0; for (unsigned j = 0; j < 16; ++j) { const unsigned c = xb_ld(&bar[XB_XCNT(j)]); if (c > 0u && j < myx) ++x.q; }
    return x;
}
__device__ __forceinline__ void phase_ua(const DArgs& a, LAS unsigned char* lds) {
    const int tid = tid_(), lane = tid & 63, wave = __builtin_amdgcn_readfirstlane(tid >> 6), k = lane >> 3, c = lane & 7;
    GAS unsigned char* ws = a.ws;
    const XcdSlice X = xcd_slice_setup(a, lds);
    const int tstride = X.nloc * 8;
    for (int sl = X.q; sl < 8; sl += X.nx) {
        const GAS unsigned char* UBs = ws + WS_UB + sl * 128 + c * 16;
        GAS float* PU = (GAS float*)(ws + WS_PARTU) + (size_t)sl * T * 128;
        u32x4 ev[4], xq0, xq1;
#define A_INFO(t_) do { _Pragma("unroll") for (int j_ = 0; j_ < 4; ++j_) ev[j_] = *(const GAS u32x4*)((const GAS int*)(ws + WS_EIDX) + (size_t)(t_) * 128 + 16 * k + 4 * j_); \
        xq0 = *(const GAS u32x4*)((const GAS bf16_t*)(ws + WS_XN) + (size_t)(t_) * D + sl * 128 + c * 16); xq1 = *(const GAS u32x4*)((const GAS bf16_t*)(ws + WS_XN) + (size_t)(t_) * D + sl * 128 + c * 16 + 8); } while (0)
        int tok = X.rank * 8 + wave;
        if (tok < T) A_INFO(tok);
        for (; tok < T; tok += tstride) {
            u32x4 R[16];
#pragma unroll
            for (int g = 0; g < 16; ++g) R[g] = *(const GAS u32x4*)(UBs + (size_t)ev[g >> 2][g & 3] * 1024);
            const float xf[16] = {bf_lo(xq0.x), bf_hi(xq0.x), bf_lo(xq0.y), bf_hi(xq0.y), bf_lo(xq0.z), bf_hi(xq0.z), bf_lo(xq0.w), bf_hi(xq0.w),
                                  bf_lo(xq1.x), bf_hi(xq1.x), bf_lo(xq1.y), bf_hi(xq1.y), bf_lo(xq1.z), bf_hi(xq1.z), bf_lo(xq1.w), bf_hi(xq1.w)};
            if (tok + tstride < T) A_INFO(tok + tstride);
            f32x2 res = (f32x2){0.f, 0.f};
#pragma unroll
            for (int g = 0; g < 16; ++g) { float d = dot16_fp8(R[g], xf); d += DPP_(d, 0xB1); d += DPP_(d, 0x4E); d += DPP_(d, 0x141);
                if (c == (g >> 1)) res[g & 1] = d; }
            *(GAS f32x2*)(PU + (size_t)tok * 128 + 2 * lane) = res;
        }
#undef A_INFO
    }
}
__device__ __forceinline__ void phase_ua2(const DArgs& a, int vcu, int G) {
    const int tid = tid_();
    GAS unsigned char* ws = a.ws;
    const float usc = ((const GAS float*)(ws + WS_USC))[0], vsc = ((const GAS float*)(ws + WS_USC))[1];
    const GAS float* PU = (const GAS float*)(ws + WS_PARTU);
    for (size_t i = (size_t)vcu * NTHR + tid; i < (size_t)T * 128 / 4; i += (size_t)G * NTHR) {
        f32x4 d = (f32x4){0.f, 0.f, 0.f, 0.f};
#pragma unroll
        for (int sl = 0; sl < 8; ++sl) d += ((const GAS f32x4*)(PU + (size_t)sl * T * 128))[i];
        const f32x4 gt = ((const GAS f32x4*)(ws + WS_GATE))[i];
        f32x4 w;
#pragma unroll
        for (int e = 0; e < 4; ++e) w[e] = gelu_erf(d[e] * usc) * gt[e] * vsc;
        ((GAS f32x4*)(ws + WS_PW))[i] = w;
    }
}
__device__ __forceinline__ void phase_vb(const DArgs& a, LAS unsigned char* lds) {
    const int tid = tid_(), lane = tid & 63, wave = __builtin_amdgcn_readfirstlane(tid >> 6), k = lane >> 3, c = lane & 7;
    GAS unsigned char* ws = a.ws;
    const XcdSlice X = xcd_slice_setup(a, lds);
    const int tstride = X.nloc * 8;
    for (int sl = X.q; sl < 8; sl += X.nx) {
        const GAS unsigned char* VBs = ws + WS_VB + sl * 128 + c * 16;
        u32x4 ev[4]; f32x4 wv[4];
#define B_INFO(t_) do { _Pragma("unroll") for (int j_ = 0; j_ < 4; ++j_) { ev[j_] = *(const GAS u32x4*)((const GAS int*)(ws + WS_EIDX) + (size_t)(t_) * 128 + 16 * k + 4 * j_); \
        wv[j_] = *(const GAS f32x4*)((const GAS float*)(ws + WS_PW) + (size_t)(t_) * 128 + 16 * k + 4 * j_); } } while (0)
        int tok = X.rank * 8 + wave;
        if (tok < T) B_INFO(tok);
        for (; tok < T; tok += tstride) {
            u32x4 R[16];
#pragma unroll
            for (int g = 0; g < 16; ++g) R[g] = *(const GAS u32x4*)(VBs + (size_t)ev[g >> 2][g & 3] * 1024);
            float wk[16];
#pragma unroll
            for (int g = 0; g < 16; ++g) wk[g] = wv[g >> 2][g & 3];
            if (tok + tstride < T) B_INFO(tok + tstride);
            f32x4 xr[4];
#pragma unroll
            for (int j = 0; j < 4; ++j) xr[j] = *(const GAS f32x4*)(a.out + (size_t)tok * D + sl * 128 + c * 16 + 4 * j);
            f32x2 acc2[8];
#pragma unroll
            for (int e = 0; e < 8; ++e) acc2[e] = (f32x2){0.f, 0.f};
#pragma unroll
            for (int g = 0; g < 16; ++g) { const f32x2 wp = (f32x2){wk[g], wk[g]};
#pragma unroll
                for (int jj = 0; jj < 4; ++jj) { acc2[2 * jj] += wp * FP8LO(R[g][jj]); acc2[2 * jj + 1] += wp * FP8HI(R[g][jj]); } }
#pragma unroll
            for (int e = 0; e < 8; ++e) {
#pragma unroll
                for (int hh = 0; hh < 2; ++hh) { float v = acc2[e][hh]; v += SWZ_(v, 0x201F); v += SWZ_(v, 0x401F); v += xor32_(v, lane >= 32); acc2[e][hh] = v; } }
            float ss = 0.f;
#pragma unroll
            for (int j = 0; j < 4; ++j) { xr[j][0] += acc2[2 * j][0]; xr[j][1] += acc2[2 * j][1]; xr[j][2] += acc2[2 * j + 1][0]; xr[j][3] += acc2[2 * j + 1][1];
                ss += (xr[j][0] * xr[j][0] + xr[j][1] * xr[j][1]) + (xr[j][2] * xr[j][2] + xr[j][3] * xr[j][3]); }
            ss += DPP_(ss, 0xB1); ss += DPP_(ss, 0x4E); ss += DPP_(ss, 0x141);
            if (k == 0) {
#pragma unroll
                for (int j = 0; j < 4; ++j) *(GAS f32x4*)(a.out + (size_t)tok * D + sl * 128 + c * 16 + 4 * j) = xr[j];
                if (c == 0) ((GAS float*)(ws + WS_SS))[(size_t)tok * 8 + sl] = ss;
            }
        }
#undef B_INFO
    }
}
__device__ __forceinline__ void phase_vc(const DArgs& a, int vcu, int G) {
    const int tid = tid_(), lane = tid & 63, wave = tid >> 6;
    const int gw = vcu * NWAVES + wave, NGW = G * NWAVES;
    GAS unsigned char* ws = a.ws;
    f32x4 gf[4];
#pragma unroll
    for (int j = 0; j < 4; ++j) gf[j] = ((const GAS f32x4*)a.final_g)[64 * j + lane];
    for (int m = gw; m < T; m += NGW) {
        const f32x4 s0 = *(const GAS f32x4*)((const GAS float*)(ws + WS_SS) + (size_t)m * 8), s1 = *(const GAS f32x4*)((const GAS float*)(ws + WS_SS) + (size_t)m * 8 + 4);
        const float rstd = rsqrtf(((s0[0] + s0[1]) + (s0[2] + s0[3]) + (s1[0] + s1[1]) + (s1[2] + s1[3])) * (1.f / D) + EPS);
        GAS f32x4* o = (GAS f32x4*)(a.out + (size_t)m * D) + lane;
#pragma unroll
        for (int j = 0; j < 4; ++j) o[64 * j] = o[64 * j] * rstd * gf[j];
    }
}

__device__ __forceinline__ void phase_final_plain(const DArgs& a, const float* src, int vcu, int G) {
    const int tid = tid_(), lane = tid & 63, wave = tid >> 6;
    const int gw = vcu * NWAVES + wave, NGW = G * NWAVES;
    f32x4 gf[4];
#pragma unroll
    for (int j = 0; j < 4; ++j) gf[j] = ((const f32x4*)a.final_g)[64 * j + lane];
    for (int m = gw; m < T; m += NGW) {
        const f32x4* xr = (const f32x4*)(src + (size_t)m * D) + lane;
        f32x4 v[4]; float s = 0.f;
#pragma unroll
        for (int j = 0; j < 4; ++j) { v[j] = xr[64 * j]; s += (v[j][0] * v[j][0] + v[j][1] * v[j][1]) + (v[j][2] * v[j][2] + v[j][3] * v[j][3]); }
        const float rstd = rsqrtf(wave_sum(s, lane) * (1.f / D) + EPS);
        f32x4* o = (f32x4*)(a.out + (size_t)m * D) + lane;
#pragma unroll
        for (int j = 0; j < 4; ++j) o[64 * j] = v[j] * rstd * gf[j];
    }
}


__device__ __forceinline__ DArgs load_args() {
    DArgs r;
#if defined(__HIP_DEVICE_COMPILE__)
    typedef const DArgs __attribute__((address_space(4))) KArgs;
    KArgs* p = (KArgs*)__builtin_amdgcn_kernarg_segment_ptr();
    asm volatile("" : "+s"(p));
    r.x = p->x; r.norm1_g = p->norm1_g; r.w_in = p->w_in; r.b_in = p->b_in; r.conv_w = p->conv_w; r.conv_b = p->conv_b; r.m_head_g = p->m_head_g; r.lb_table = p->lb_table;
    r.g_head_g = p->g_head_g; r.w_br_m = p->w_br_m; r.w_br_g = p->w_br_g; r.w_out = p->w_out; r.norm2_g = p->norm2_g; r.w_pq = p->w_pq; r.sub_keys = p->sub_keys;
    r.u_emb = p->u_emb; r.v_emb = p->v_emb; r.final_g = p->final_g; r.out = p->out; r.ws = p->ws;
#else
    r = DArgs{};
#endif
    return r;
}
__device__ __forceinline__ EpiPtrs make_ep(const DArgs& a, int round) {
    EpiPtrs ep; ep.biasp = (const GAS float*)(a.ws + WS_BIASP); ep.lb = (const GAS float*)(a.ws + WS_LB); ep.x = a.x; ep.out = a.out; ep.ws = a.ws; ep.round = round; return ep;
}
#define GRID_SYNC() do { const DArgs a_ = load_args(); xcd_barrier((unsigned*)(a_.ws + WS_CTL) + CW_BAR, (volatile LAS unsigned*)(lds + LDS_BARST)); } while (0)

__device__ __forceinline__ int bx_() { int t = blockIdx.x; asm volatile("" : "+s"(t)); return t; }
__device__ __forceinline__ int gd_() { int t = gridDim.x; asm volatile("" : "+s"(t)); return t; }
#define PH_BEGIN const DArgs a = load_args(); const int bx = bx_(), G = gd_(); const int vcu = (G % 8 == 0) ? (bx % 8) * (G / 8) + bx / 8 : bx; (void)vcu; (void)bx;

__global__ void __launch_bounds__(NTHR, 2) fwd_megakernel(Args a_unused) {
    extern __shared__ __attribute__((aligned(16))) unsigned char lds_raw[];
    LAS unsigned char* lds = (LAS unsigned char*)lds_raw;
    cg::grid_group grid = cg::this_grid();

    { const int t_ = tid_(); if (t_ < 16) ((LAS unsigned*)(lds + LDS_BARST))[t_] = 0u; __syncthreads();
      const DArgs a_ = load_args(); xcd_barrier_post((unsigned*)(a_.ws + WS_CTL) + CW_BAR, (volatile LAS unsigned*)(lds + LDS_BARST)); }
    { PH_BEGIN phase_p0(a, lds, vcu, G); }
    grid.sync();
#pragma unroll 1
    for (int round = 0; round < NROUND; ++round) {
        {
            PH_BEGIN
            pg8::Gemm g{(const bf16_t*)(a.ws + WS_XN) + (size_t)round * RT * D, (const bf16_t*)(a.ws + WS_WIN), RT, N1, D};
            pg8::StaticOrder S; S.init(RT, N1, G, bx);
            EpiX<1> E{make_ep(a, round)};
            pg8::gemm_phase<EpiX<1>, pg8::StaticOrder, true, true>(lds, g, S, E);
        }
        { PH_BEGIN if (bx < 8) mscan_pair(a, lds, round, bx); }
        GRID_SYNC();
        { PH_BEGIN for (int it = bx; it < 512; it += G) mlstm_pre_item(a, lds, round, it); }
        { PH_BEGIN for (int it = bx; it < 2048; it += G) hgrn_pre_item(a, lds, round, it); }
        GRID_SYNC();
        { PH_BEGIN
          if (bx < 128) mlstm_scan<2, false>(a, lds, round, bx & 7, bx >> 3);
          else if (bx >= 192 && bx < 200) mlstm_scan<1, true>(a, lds, round, bx - 192, 0);
          else if (bx < 192) { const int id2 = bx - 128; hgrn_scan(a, lds, round, (id2 & 7) * 2 + ((id2 >> 3) & 1), id2 >> 4); } }
        GRID_SYNC();
        {
            PH_BEGIN
            pg8::Gemm g{(const bf16_t*)(a.ws + WS_XN) + (size_t)round * RT * D, (const bf16_t*)(a.ws + WS_WIN) + (size_t)N1 * D, RT, N2, D};
            pg8::StaticOrder S; S.init(RT, N2, G, bx);
            EpiX<2> E{make_ep(a, round)};
            pg8::gemm_phase<EpiX<2>, pg8::StaticOrder, true, true>(lds, g, S, E);
        }
        GRID_SYNC();
        { PH_BEGIN phase_ypass(a, round, vcu, G); }
        GRID_SYNC();
        {
            { PH_BEGIN pg8::StaticOrder S; S.init(RT, D, G, bx);
              pg8::Gemm g{(const bf16_t*)(a.ws + WS_V), (const bf16_t*)(a.ws + WS_WM), RT, D, 2048}; EpiX<3> E{make_ep(a, round)}; pg8::gemm_phase<EpiX<3>, pg8::StaticOrder, true, true>(lds, g, S, E); }
            { PH_BEGIN pg8::StaticOrder S; S.init(RT, D, G, bx);
              pg8::Gemm g{(const bf16_t*)(a.ws + WS_GI), (const bf16_t*)(a.ws + WS_WG), RT, D, D}; EpiX<4> E{make_ep(a, round)}; pg8::gemm_phase<EpiX<4>, pg8::StaticOrder, true, true>(lds, g, S, E); }
        }
        GRID_SYNC();
        {
            PH_BEGIN pg8::StaticOrder S; S.init(RT, D, G, bx);
            pg8::Gemm g{(const bf16_t*)(a.ws + WS_GFLOG), (const bf16_t*)(a.ws + WS_WO), RT, D, D}; EpiX<5> E{make_ep(a, round)}; pg8::gemm_phase<EpiX<5>, pg8::StaticOrder, true, true>(lds, g, S, E);
        }
        GRID_SYNC();
    }
    { PH_BEGIN phase_p8(a, vcu, G); }
    GRID_SYNC();
    {
        PH_BEGIN pg8::StaticOrder S; S.init(T, 2048, G, bx);
        pg8::Gemm g{(const bf16_t*)(a.ws + WS_XN), (const bf16_t*)(a.ws + WS_WPQ), T, 2048, D}; EpiX<6> E{make_ep(a, 0)}; pg8::gemm_phase<EpiX<6>, pg8::StaticOrder, true, true>(lds, g, S, E);
    }
    GRID_SYNC();
#ifdef TOPK_REF
    { PH_BEGIN phase_topk_ref(a, vcu, G); }
#else
    { PH_BEGIN phase_topk(a, lds, bx, G); }
#endif
    GRID_SYNC();
    { PH_BEGIN phase_ua(a, lds); }
    GRID_SYNC();
    { PH_BEGIN phase_ua2(a, vcu, G); }
    GRID_SYNC();
    { PH_BEGIN phase_vb(a, lds); }
    GRID_SYNC();
    { PH_BEGIN phase_vc(a, vcu, G); }
}

extern "C" void kernel_launch(void* const* d_in, const int* in_sizes, int n_in, void* d_out, int out_size, void* d_ws, size_t ws_size, hipStream_t stream) {
    static int grid = 0;
    if (grid == 0) {
        if (n_in != 18 || in_sizes[0] != T * D || out_size != T * D || ws_size < WS_END) {
            fprintf(stderr, "kernel_launch: unexpected shapes/workspace (n_in %d, in0 %d, out %d, ws %zu, need %zu)\n", n_in, n_in > 0 ? in_sizes[0] : -1, out_size, ws_size, (size_t)WS_END);
            grid = -1; return; }
        int dev = 0, cus = 0, per_cu = 0;
        hipGetDevice(&dev);
        hipDeviceGetAttribute(&cus, hipDeviceAttributeMultiprocessorCount, dev);
        hipFuncSetAttribute((const void*)fwd_megakernel, hipFuncAttributeMaxDynamicSharedMemorySize, LDS_BYTES);
        hipOccupancyMaxActiveBlocksPerMultiprocessor(&per_cu, (const void*)fwd_megakernel, NTHR, LDS_BYTES);
        if (per_cu < 1) { fprintf(stderr, "kernel_launch: occupancy query says %d blocks/CU\n", per_cu); per_cu = 1; }
        grid = cus;
        (void)hipGetLastError();
    }
    if (grid < 0) return;
    hipMemsetAsync((char*)d_ws + WS_CTL, 0, 1 * MiB, stream);
    Args a{};
    a.x = (const float*)d_in[0]; a.norm1_g = (const float*)d_in[1]; a.w_in = (const float*)d_in[2]; a.b_in = (const float*)d_in[3];
    a.conv_w = (const float*)d_in[4]; a.conv_b = (const float*)d_in[5]; a.m_head_g = (const float*)d_in[6]; a.lb_table = (const float*)d_in[7];
    a.g_head_g = (const float*)d_in[8]; a.w_br_m = (const float*)d_in[9]; a.w_br_g = (const float*)d_in[10]; a.w_out = (const float*)d_in[11];
    a.norm2_g = (const float*)d_in[12]; a.w_pq = (const float*)d_in[13]; a.sub_keys = (const float*)d_in[14]; a.u_emb = (const float*)d_in[15];
    a.v_emb = (const float*)d_in[16]; a.final_g = (const float*)d_in[17];
    a.out = (float*)d_out; a.ws = (unsigned char*)d_ws;
    void* args[] = {&a};
    hipError_t e = hipLaunchCooperativeKernel((const void*)fwd_megakernel, dim3(grid), dim3(NTHR), args, LDS_BYTES, stream);
    if (e != hipSuccess) fprintf(stderr, "cooperative launch failed: %s (grid %d)\n", hipGetErrorString(e), grid);
}
```

```cpp
#include <hip/hip_runtime.h>
#include <hip/hip_cooperative_groups.h>
#include <cstdio>
#include <cstdint>
namespace cg = cooperative_groups;

#define LAS __attribute__((address_space(3)))
typedef unsigned short bf16_t;
typedef short bf16x8 __attribute__((ext_vector_type(8)));
typedef float f32x4 __attribute__((ext_vector_type(4)));
typedef float f32x2 __attribute__((ext_vector_type(2)));
typedef unsigned u32x4 __attribute__((ext_vector_type(4)));
typedef unsigned u32x2 __attribute__((ext_vector_type(2)));

constexpr int D = 1024, BATCH = 4, SEQ = 8192, T = BATCH * SEQ;
constexpr int IN_COLS = 12296, NP = 12288;
constexpr int RT = 16384, NROUND = 2;
constexpr int N1 = 7168, N2 = 5120;
constexpr float EPS = 1e-6f;
constexpr int NWAVES = 8, NTHR = 512;

constexpr size_t MiB = 1u << 20;
constexpr size_t WS_CTL = 0;
constexpr size_t WS_WIN = 1 * MiB;
constexpr size_t WS_WM = 25 * MiB;
constexpr size_t WS_WG = 29 * MiB;
constexpr size_t WS_WO = 31 * MiB;
constexpr size_t WS_WPQ = 33 * MiB;
constexpr size_t WS_SK = 37 * MiB;
constexpr size_t WS_BIASP = 37 * MiB + 512 * 1024;
constexpr size_t WS_LB = WS_BIASP + 64 * 1024;
constexpr size_t WS_GATES = 38 * MiB;
constexpr size_t WS_MPREV = 39 * MiB;
constexpr size_t WS_DEN = 40 * MiB;
constexpr size_t WS_MT = 40 * MiB + 512 * 1024;
constexpr size_t WS_HGDEC = 41 * MiB;
constexpr size_t WS_MDEC = 43 * MiB;
constexpr size_t WS_XN = 44 * MiB;
constexpr size_t WS_QKPRE = 108 * MiB;
constexpr size_t WS_V = 172 * MiB;
constexpr size_t WS_GFLOG = 236 * MiB;
constexpr size_t WS_GI = 268 * MiB;
constexpr size_t WS_GQ = 300 * MiB;
constexpr size_t WS_S = 332 * MiB;
constexpr size_t WS_QT = 348 * MiB;
constexpr size_t WS_KWT = 380 * MiB;
constexpr size_t WS_ATT = 412 * MiB;
constexpr size_t WS_QTG = 428 * MiB;
constexpr size_t WS_KENDT = 460 * MiB;
constexpr size_t WS_SIGO = 332 * MiB;
constexpr size_t WS_SGG = 396 * MiB;
constexpr size_t WS_SAM = 428 * MiB;
constexpr size_t WS_SAG = 460 * MiB;
constexpr size_t WS_END = 492 * MiB;
constexpr size_t WS_QP = 108 * MiB;
constexpr size_t WS_UB = 236 * MiB;
constexpr size_t WS_VB = 252 * MiB;
constexpr size_t WS_USC = 268 * MiB;
constexpr size_t WS_VSC = 268 * MiB + 65536;
constexpr size_t WS_EIDX = 300 * MiB;
constexpr size_t WS_GATE = 316 * MiB;
constexpr size_t WS_X8 = 348 * MiB;
constexpr size_t WS_PARTU = 108 * MiB;
constexpr size_t WS_SS = 348 * MiB;
constexpr size_t WS_PW = 332 * MiB;

constexpr int CW_TMAX = 64;
constexpr int LDS_BYTES = 147456;

__device__ __forceinline__ unsigned f2bf(float f) { unsigned u = __builtin_bit_cast(unsigned, f); return (u + 0x7fffu + ((u >> 16) & 1u)) >> 16; }
typedef __bf16 bf16x2_t __attribute__((ext_vector_type(2)));
__device__ __forceinline__ unsigned pk2(float lo, float hi) { bf16x2_t v; v[0] = (__bf16)lo; v[1] = (__bf16)hi; return __builtin_bit_cast(unsigned, v); }
__device__ __forceinline__ float bf_lo(unsigned w) { return __builtin_bit_cast(float, w << 16); }
__device__ __forceinline__ float bf_hi(unsigned w) { return __builtin_bit_cast(float, w & 0xffff0000u); }
__device__ __forceinline__ float bf2f(bf16_t h) { return __builtin_bit_cast(float, ((unsigned)h) << 16); }
__device__ __forceinline__ float shx(float v, int o, int lane) { return __builtin_bit_cast(float, __builtin_amdgcn_ds_bpermute((lane ^ o) << 2, __builtin_bit_cast(int, v))); }
__device__ __forceinline__ float shup(float v, int o, int lane) { return __builtin_bit_cast(float, __builtin_amdgcn_ds_bpermute(((lane - o) & 63) << 2, __builtin_bit_cast(int, v))); }
__device__ __forceinline__ float rdlane(float v, int l) { return __builtin_bit_cast(float, __builtin_amdgcn_readlane(__builtin_bit_cast(int, v), l)); }
#define DPP_(v, ctrl) __builtin_bit_cast(float, __builtin_amdgcn_update_dpp(0, __builtin_bit_cast(int, (v)), (ctrl), 0xF, 0xF, false))
__device__ __forceinline__ float wave_sum(float v, int lane) {
    (void)lane;
    v += DPP_(v, 0xB1); v += DPP_(v, 0x4E); v += DPP_(v, 0x141); v += DPP_(v, 0x140);
    return (rdlane(v, 0) + rdlane(v, 16)) + (rdlane(v, 32) + rdlane(v, 48));
}
#define SWZI_(v, pat) __builtin_amdgcn_ds_swizzle((int)(v), (pat))
#define DPPI_(v, ctrl) __builtin_amdgcn_update_dpp(0, (int)(v), (ctrl), 0xF, 0xF, false)
__device__ __forceinline__ unsigned xor32u_(unsigned v, bool hi) {
#if defined(__HIP_DEVICE_COMPILE__)
    const auto r = __builtin_amdgcn_permlane32_swap(v, v, false, false);
    return hi ? r[0] : r[1];
#else
    (void)hi; return v;
#endif
}
__device__ __forceinline__ float sigmoidf_(float x) { return __builtin_amdgcn_rcpf(1.0f + __expf(-x)); }
__device__ __forceinline__ float siluf_(float x) { return x * __builtin_amdgcn_rcpf(1.0f + __expf(-x)); }
#define LDS_WAIT() asm volatile("s_waitcnt lgkmcnt(0)" ::: "memory")
__device__ __forceinline__ int tid_() { int t = threadIdx.x; asm volatile("" : "+v"(t)); return t; }

#define GAS __attribute__((address_space(1)))
struct DArgs {
    const GAS float* x; const GAS float* norm1_g; const GAS float* w_in; const GAS float* b_in; const GAS float* conv_w; const GAS float* conv_b;
    const GAS float* m_head_g; const GAS float* lb_table; const GAS float* g_head_g; const GAS float* w_br_m; const GAS float* w_br_g; const GAS float* w_out;
    const GAS float* norm2_g; const GAS float* w_pq; const GAS float* sub_keys; const GAS float* u_emb; const GAS float* v_emb; const GAS float* final_g;
    GAS float* out; GAS unsigned char* ws;
};
struct Args {
    const float* x; const float* norm1_g; const float* w_in; const float* b_in; const float* conv_w; const float* conv_b;
    const float* m_head_g; const float* lb_table; const float* g_head_g; const float* w_br_m; const float* w_br_g; const float* w_out;
    const float* norm2_g; const float* w_pq; const float* sub_keys; const float* u_emb; const float* v_emb; const float* final_g;
    float* out; unsigned char* ws;
};

namespace pg8 {
constexpr int BM = 256, BK = 64, HALF = 128, HTB = HALF * BK * 2, STAGE_BYTES = 8 * HTB, NXCD = 8, WGM = 8;
__host__ __device__ __forceinline__ int lds_byte(int r, int c) { const int st = (r >> 4) * 2 + (c >> 5), rr = r & 15, cc = c & 31, ob = rr * 64 + cc * 2; return st * 1024 + (ob ^ (((ob >> 9) & 1) << 5)); }
__host__ __device__ __forceinline__ void stage_rc(int b, int& R, int& C) { const int st = b / 1024, sb = b % 1024, swz = sb ^ (((sb >> 9) & 1) << 5); R = (st >> 1) * 16 + swz / 64; C = (st & 1) * 32 + (swz % 64) / 2; }
__host__ __device__ __forceinline__ int perm32(int rho) { const int n = rho >> 4, i = rho & 15; return 8 * (i >> 2) + 4 * n + (i & 3); }
struct Unit { int pm, pn; };
struct Gemm { const bf16_t* A; const bf16_t* Bt; int M, N, K; };
struct StaticOrder {
    int nM, nN, nwg, G, c;
    __host__ __device__ void init(int M, int N, int G_, int c_) { nM = M / BM; nN = N / BM; nwg = nM * nN; G = G_; c = c_; }
    __host__ __device__ bool next(int i, Unit& u) const {
        const long L = (long)i * G + c; if (L >= nwg) return false;
        int wgid = (int)L; { const int q = nwg / NXCD, r = nwg % NXCD, xcd = wgid % NXCD, off = wgid / NXCD; wgid = (xcd < r ? xcd * (q + 1) : r * (q + 1) + (xcd - r) * q) + off; }
        const int nig = WGM * nN, gid = wgid / nig, fm = gid * WGM, gsz = (nM - fm) < WGM ? (nM - fm) : WGM;
        u.pm = fm + ((wgid % nig) % gsz); u.pn = (wgid % nig) / gsz; return true;
    }
    __device__ __forceinline__ void a_ready(const Unit&) const {}
    __device__ __forceinline__ void done(const Unit&) const {}
};

template <class Epi, class Sched, bool ALIGN_EPI = false, bool SP2 = false>
__device__ __forceinline__ void gemm_phase(LAS unsigned char* lds, const Gemm g, const Sched& S, const Epi& E) {
    const int tid = tid_(), wid = __builtin_amdgcn_readfirstlane(tid >> 6), lane = tid & 63, wr = wid >> 2, wc = wid & 3, fr = lane & 15, fq = lane >> 4;
    const int K = g.K, nt = K / BK;
    unsigned voffA[2], voffB[2];
#pragma unroll
    for (int i = 0; i < 2; ++i) { int R, C; stage_rc(tid * 16 + i * 8192, R, C); const int Rb = Epi::PERM ? ((R & ~31) + perm32(R & 31)) : R;
        voffA[i] = (unsigned)(R * K + C) * 2u; voffB[i] = (unsigned)(Rb * K + C) * 2u; }
    const size_t kstep = (size_t)(BK * 2);
    const size_t hstep = (size_t)HALF * K * 2;
    const size_t tstep = 2 * hstep;
    const unsigned ldsw = (unsigned)wid * 1024u;
    const int aoff = lds_byte(wr * 64 + fr, fq * 8), boff = lds_byte(wc * 32 + fr, fq * 8);
#define PG8_SA(b, h) (((b) * 2 + (h)) * HTB)
#define PG8_SB(b, h) ((4 + (b) * 2 + (h)) * HTB)
#define PG8_STAGE(bufoff, gbase, voff) do { _Pragma("unroll") for (int _i = 0; _i < 2; ++_i) \
        __builtin_amdgcn_global_load_lds((const unsigned*)((const char*)(gbase) + (voff)[_i]), (LAS unsigned*)(lds + (bufoff) + ldsw + _i * 8192), 16, 0, 0); } while (0)
#define PG8_LDA(dst, b, h) do { _Pragma("unroll") for (int m = 0; m < 4; ++m) _Pragma("unroll") for (int k = 0; k < 2; ++k) dst[m][k] = *(const LAS bf16x8*)(lds + PG8_SA(b, h) + aoff + m * 2048 + k * 1024); } while (0)
#define PG8_LDB(dst, b, h) do { _Pragma("unroll") for (int n = 0; n < 2; ++n) _Pragma("unroll") for (int k = 0; k < 2; ++k) dst[n][k] = *(const LAS bf16x8*)(lds + PG8_SB(b, h) + boff + n * 2048 + k * 1024); } while (0)
#define PG8_MMA(ai, bj, At, Bt) do { __builtin_amdgcn_s_setprio(1); _Pragma("unroll") for (int m = 0; m < 4; ++m) _Pragma("unroll") for (int n = 0; n < 2; ++n) _Pragma("unroll") for (int k = 0; k < 2; ++k) \
        acc[ai][bj][m][n] = __builtin_amdgcn_mfma_f32_16x16x32_bf16(Bt[n][k], At[m][k], acc[ai][bj][m][n], 0, 0, 0); __builtin_amdgcn_s_setprio(0); } while (0)
#define PG8_WAIT_V(n) asm volatile("s_waitcnt vmcnt(" #n ")" ::: "memory")
#define PG8_WAIT_L(n) asm volatile("s_waitcnt lgkmcnt(" #n ")" ::: "memory")
#define PG8_BAR __builtin_amdgcn_s_barrier()
#define PG8_SCHED __builtin_amdgcn_sched_barrier(0)
    Unit cur, nxt; int ui = 0;
    if (!S.next(0, cur)) return;
    f32x4 acc[2][2][4][2];
#pragma unroll
    for (int a = 0; a < 2; ++a)
#pragma unroll
        for (int b = 0; b < 2; ++b)
#pragma unroll
            for (int m = 0; m < 4; ++m)
#pragma unroll
                for (int n = 0; n < 2; ++n) acc[a][b][m][n] = (f32x4){0.f, 0.f, 0.f, 0.f};
    bf16x8 At[4][2], B0[2][2], B1[2][2];
    const char* cA = (const char*)g.A + (size_t)cur.pm * tstep; const char* cB = (const char*)g.Bt + (size_t)cur.pn * tstep;
    S.a_ready(cur);
    if constexpr (SP2) {
        PG8_STAGE(PG8_SB(0, 0), cB, voffB); PG8_STAGE(PG8_SB(0, 1), cB + hstep, voffB); PG8_STAGE(PG8_SA(0, 0), cA, voffA); PG8_STAGE(PG8_SA(0, 1), cA + hstep, voffA);
        if (wr == 1) PG8_BAR;
        PG8_WAIT_V(2); PG8_BAR;
        PG8_STAGE(PG8_SB(1, 0), cB + kstep, voffB); PG8_STAGE(PG8_SA(1, 0), cA + kstep, voffA); PG8_STAGE(PG8_SB(1, 1), cB + hstep + kstep, voffB);
        PG8_WAIT_V(6); PG8_BAR;
    } else {
        PG8_STAGE(PG8_SB(0, 0), cB, voffB); PG8_STAGE(PG8_SA(0, 0), cA, voffA); PG8_STAGE(PG8_SB(0, 1), cB + hstep, voffB); PG8_STAGE(PG8_SA(0, 1), cA + hstep, voffA);
        if (wr == 1) PG8_BAR;
        PG8_WAIT_V(4); PG8_BAR;
        PG8_STAGE(PG8_SB(1, 0), cB + kstep, voffB); PG8_STAGE(PG8_SA(1, 0), cA + kstep, voffA); PG8_STAGE(PG8_SB(1, 1), cB + hstep + kstep, voffB);
        PG8_WAIT_V(6); PG8_BAR;
    }
    for (;;) {
        const bool has_next = S.next(ui + 1, nxt);
        const char* nA = has_next ? (const char*)g.A + (size_t)nxt.pm * tstep : cA; const char* nB = has_next ? (const char*)g.Bt + (size_t)nxt.pn * tstep : cB;
        for (int t = 0; t < nt; t += 2) {
            const bool last = (t == nt - 2);
            const char* a1 = cA + (size_t)(t + 1) * kstep;
            const char* a2 = last ? nA : cA + (size_t)(t + 2) * kstep; const char* b2 = last ? nB : cB + (size_t)(t + 2) * kstep;
            const char* a3 = a2 + kstep; const char* b3 = b2 + kstep;
            if (last && has_next) S.a_ready(nxt);
            if constexpr (SP2) {
            PG8_LDB(B0, 0, 0); PG8_LDB(B1, 0, 1); PG8_SCHED; PG8_LDA(At, 0, 0); PG8_STAGE(PG8_SA(1, 1), a1 + hstep, voffA);
            PG8_WAIT_V(8); PG8_WAIT_L(0); PG8_BAR; PG8_MMA(0, 0, At, B0); PG8_MMA(0, 1, At, B1); PG8_BAR; PG8_SCHED;
            PG8_LDA(At, 0, 1); PG8_STAGE(PG8_SB(0, 0), b2, voffB); PG8_STAGE(PG8_SB(0, 1), b2 + hstep, voffB); PG8_STAGE(PG8_SA(0, 0), a2, voffA);
            PG8_WAIT_V(8); PG8_WAIT_L(0); PG8_BAR; PG8_MMA(1, 0, At, B0); PG8_MMA(1, 1, At, B1); PG8_BAR; PG8_SCHED;
            PG8_LDB(B0, 1, 0); PG8_LDB(B1, 1, 1); PG8_SCHED; PG8_LDA(At, 1, 0); PG8_STAGE(PG8_SA(0, 1), a2 + hstep, voffA);
            PG8_WAIT_V(8); PG8_WAIT_L(0); PG8_BAR; PG8_MMA(0, 0, At, B0); PG8_MMA(0, 1, At, B1); PG8_BAR; PG8_SCHED;
            PG8_LDA(At, 1, 1); PG8_STAGE(PG8_SB(1, 0), b3, voffB); PG8_STAGE(PG8_SB(1, 1), b3 + hstep, voffB); PG8_STAGE(PG8_SA(1, 0), a3, voffA);
            PG8_WAIT_V(8); PG8_WAIT_L(0); PG8_BAR; PG8_MMA(1, 0, At, B0); PG8_MMA(1, 1, At, B1); PG8_BAR; PG8_SCHED;
            } else {
            PG8_LDB(B0, 0, 0); PG8_SCHED; PG8_LDA(At, 0, 0); PG8_STAGE(PG8_SA(1, 1), a1 + hstep, voffA);
            PG8_WAIT_L(8); PG8_BAR; PG8_WAIT_L(0); PG8_MMA(0, 0, At, B0); PG8_BAR; PG8_SCHED;
            PG8_LDB(B1, 0, 1); PG8_STAGE(PG8_SB(0, 0), b2, voffB);
            PG8_BAR; PG8_WAIT_L(0); PG8_MMA(0, 1, At, B1); PG8_BAR;
            PG8_LDA(At, 0, 1); PG8_STAGE(PG8_SA(0, 0), a2, voffA);
            PG8_BAR; PG8_WAIT_L(0); PG8_MMA(1, 0, At, B0); PG8_BAR; PG8_SCHED;
            PG8_STAGE(PG8_SB(0, 1), b2 + hstep, voffB);
            PG8_WAIT_V(6); PG8_BAR; PG8_MMA(1, 1, At, B1); PG8_BAR;
            PG8_LDB(B0, 1, 0); PG8_SCHED; PG8_LDA(At, 1, 0); PG8_STAGE(PG8_SA(0, 1), a2 + hstep, voffA);
            PG8_WAIT_L(8); PG8_BAR; PG8_WAIT_L(0); PG8_MMA(0, 0, At, B0); PG8_BAR; PG8_SCHED;
            PG8_LDB(B1, 1, 1); PG8_STAGE(PG8_SB(1, 0), b3, voffB);
            PG8_BAR; PG8_WAIT_L(0); PG8_MMA(0, 1, At, B1); PG8_BAR;
            PG8_LDA(At, 1, 1); PG8_STAGE(PG8_SA(1, 0), a3, voffA);
            PG8_BAR; PG8_WAIT_L(0); PG8_MMA(1, 0, At, B0); PG8_BAR; PG8_SCHED;
            PG8_STAGE(PG8_SB(1, 1), b3 + hstep, voffB);
            PG8_WAIT_V(6); PG8_BAR; PG8_MMA(1, 1, At, B1); PG8_BAR;
            }
        }
        if constexpr (ALIGN_EPI) { if (wr == 0) PG8_BAR; }
        E(acc, cur, wr, wc, fr, fq);
        if (!has_next) break;
#pragma unroll
        for (int a = 0; a < 2; ++a)
#pragma unroll
            for (int b = 0; b < 2; ++b)
#pragma unroll
                for (int m = 0; m < 4; ++m)
#pragma unroll
                    for (int n = 0; n < 2; ++n) acc[a][b][m][n] = (f32x4){0.f, 0.f, 0.f, 0.f};
        cur = nxt; cA = nA; cB = nB; ++ui;
        if constexpr (ALIGN_EPI) { if (wr == 1) PG8_BAR; }
    }
    PG8_WAIT_V(0);
    if constexpr (!ALIGN_EPI) { if (wr == 0) PG8_BAR; }
    PG8_BAR;
#undef PG8_SA
#undef PG8_SB
#undef PG8_STAGE
#undef PG8_LDA
#undef PG8_LDB
#undef PG8_MMA
#undef PG8_WAIT_V
#undef PG8_WAIT_L
#undef PG8_BAR
#undef PG8_SCHED
}
}

struct EpiPtrs {
    const GAS float* biasp; const GAS float* lb; const GAS float* x; GAS float* out; GAS unsigned char* ws; int round;
};
template <int MODE> struct EpiX {
    static constexpr bool PERM = true, AFTER_DRAIN = false;
    EpiPtrs P;
    __device__ __forceinline__ void operator()(const f32x4 (&acc)[2][2][4][2], const pg8::Unit& u, int wr, int wc, int fr, int fq) const {
        const int row0 = u.pm * 256 + wr * 64 + fr;
        const int colt = u.pn * 256 + wc * 32 + 8 * fq;
        GAS unsigned char* ws = P.ws;
        bf16_t* dst = nullptr; int ld = 0, coff = 0, act = 0; const GAS float* bias = nullptr;
        if (MODE == 1) {
            bias = P.biasp;
            if (u.pn < 8) { dst = (bf16_t*)(ws + WS_QKPRE); ld = 2048; coff = 0; act = 0; }
            else if (u.pn < 16) { dst = (bf16_t*)(ws + WS_V); ld = 2048; coff = 2048; act = 0; }
            else if (u.pn < 20) { dst = (bf16_t*)(ws + WS_GFLOG); ld = 1024; coff = 4096; act = 3; }
            else if (u.pn < 24) { dst = (bf16_t*)(ws + WS_GI); ld = 1024; coff = 5120; act = 0; }
            else { dst = (bf16_t*)(ws + WS_GQ); ld = 1024; coff = 6144; act = 2; }
        } else if (MODE == 2) {
            bias = P.biasp + N1;
            if (u.pn < 8) { dst = (bf16_t*)(ws + WS_SIGO); ld = 2048; coff = 0; act = 1; }
            else if (u.pn < 12) { dst = (bf16_t*)(ws + WS_SGG); ld = 1024; coff = 2048; act = 2; }
            else if (u.pn < 16) { dst = (bf16_t*)(ws + WS_SAM); ld = 1024; coff = 3072; act = 1; }
            else { dst = (bf16_t*)(ws + WS_SAG); ld = 1024; coff = 4096; act = 1; }
        } else if (MODE == 6) { dst = (bf16_t*)(ws + WS_QP); ld = 2048; coff = 0; act = 0; }
#pragma unroll
        for (int bj = 0; bj < 2; ++bj) {
            const int col = colt + bj * 128;
            f32x4 b0 = (f32x4){0.f, 0.f, 0.f, 0.f}, b1 = b0, l0 = b0, l1 = b0;
            if (MODE == 1 || MODE == 2) { b0 = *(const f32x4*)(bias + col); b1 = *(const f32x4*)(bias + col + 4); }
            if (MODE == 1) { if (act == 3) { l0 = *(const f32x4*)(P.lb + (col - coff)); l1 = *(const f32x4*)(P.lb + (col - coff) + 4); } }
#pragma unroll
            for (int ai = 0; ai < 2; ++ai)
#pragma unroll
                for (int m = 0; m < 4; ++m) {
                    const int row = row0 + ai * 128 + m * 16;
                    f32x4 v0 = acc[ai][bj][m][0] + b0, v1 = acc[ai][bj][m][1] + b1;
                    if (MODE == 1 || MODE == 2 || MODE == 6) {
                        if (act == 1) {
#pragma unroll
                            for (int j = 0; j < 4; ++j) { v0[j] = sigmoidf_(v0[j]); v1[j] = sigmoidf_(v1[j]); }
                        } else if (act == 2) {
#pragma unroll
                            for (int j = 0; j < 4; ++j) { v0[j] = siluf_(v0[j]); v1[j] = siluf_(v1[j]); }
                        } else if (act == 3) {
#pragma unroll
                            for (int j = 0; j < 4; ++j) { v0[j] = __logf(l0[j] + (1.0f - l0[j]) * sigmoidf_(v0[j])); v1[j] = __logf(l1[j] + (1.0f - l1[j]) * sigmoidf_(v1[j])); }
                        }
                        u32x4 w; w.x = pk2(v0[0], v0[1]); w.y = pk2(v0[2], v0[3]); w.z = pk2(v1[0], v1[1]); w.w = pk2(v1[2], v1[3]);
                        *(u32x4*)(dst + (size_t)row * ld + (col - coff)) = w;
                    } else if (MODE == 3) {
                        const u32x4 g = *(const u32x4*)((const bf16_t*)(ws + WS_SAM) + (size_t)row * 1024 + col);
                        GAS float* o = P.out + ((size_t)P.round * RT + row) * 1024 + col;
                        f32x4 r0, r1;
                        r0[0] = v0[0] * bf_lo(g.x); r0[1] = v0[1] * bf_hi(g.x); r0[2] = v0[2] * bf_lo(g.y); r0[3] = v0[3] * bf_hi(g.y);
                        r1[0] = v1[0] * bf_lo(g.z); r1[1] = v1[1] * bf_hi(g.z); r1[2] = v1[2] * bf_lo(g.w); r1[3] = v1[3] * bf_hi(g.w);
                        *(f32x4*)o = r0; *(f32x4*)(o + 4) = r1;
                    } else if (MODE == 4) {
                        const u32x4 g = *(const u32x4*)((const bf16_t*)(ws + WS_SAG) + (size_t)row * 1024 + col);
                        const GAS float* zp = P.out + ((size_t)P.round * RT + row) * 1024 + col;
                        const f32x4 p0 = *(const f32x4*)zp, p1 = *(const f32x4*)(zp + 4);
                        f32x4 r0, r1;
                        r0[0] = p0[0] + v0[0] * bf_lo(g.x); r0[1] = p0[1] + v0[1] * bf_hi(g.x); r0[2] = p0[2] + v0[2] * bf_lo(g.y); r0[3] = p0[3] + v0[3] * bf_hi(g.y);
                        r1[0] = p1[0] + v1[0] * bf_lo(g.z); r1[1] = p1[1] + v1[1] * bf_hi(g.z); r1[2] = p1[2] + v1[2] * bf_lo(g.w); r1[3] = p1[3] + v1[3] * bf_hi(g.w);
                        u32x4 w; w.x = pk2(r0[0], r0[1]); w.y = pk2(r0[2], r0[3]); w.z = pk2(r1[0], r1[1]); w.w = pk2(r1[2], r1[3]);
                        *(u32x4*)((bf16_t*)(ws + WS_GFLOG) + (size_t)row * 1024 + col) = w;
                    } else if (MODE == 5) {
                        const size_t off = ((size_t)P.round * RT + row) * 1024 + col;
                        const f32x4 x0 = *(const f32x4*)(P.x + off), x1 = *(const f32x4*)(P.x + off + 4);
                        *(f32x4*)(P.out + off) = x0 + v0; *(f32x4*)(P.out + off + 4) = x1 + v1;
                    }
                }
        }
    }
};

__device__ __forceinline__ void p0_transpose_item(const GAS float* W, int ldw, int K, int k0, int scol, GAS bf16_t* WT, int drow, LAS float* scr, int lane) {
#pragma unroll 8
    for (int i = 0; i < 32; ++i) { const int kk = 2 * i + (lane >> 5); scr[kk * 33 + (lane & 31)] = W[(size_t)(k0 + kk) * ldw + scol + (lane & 31)]; }
    LDS_WAIT(); asm volatile("" ::: "memory");
    const int c = lane & 7;
#pragma unroll
    for (int j = 0; j < 4; ++j) { const int n = (lane >> 3) + 8 * j; const LAS float* s = scr + (8 * c) * 33 + n;
        u32x4 o; o.x = pk2(s[0 * 33], s[1 * 33]); o.y = pk2(s[2 * 33], s[3 * 33]); o.z = pk2(s[4 * 33], s[5 * 33]); o.w = pk2(s[6 * 33], s[7 * 33]);
        *(u32x4*)(WT + (size_t)(drow + n) * K + k0 + 8 * c) = o; }
    LDS_WAIT(); asm volatile("" ::: "memory");
}
__device__ __forceinline__ int win_src_col(int n) {
    if (n < 4096) return n;
    if (n < 7168) return n - 4096 + 6152;
    if (n < 9216) return n - 7168 + 4096;
    return n - 9216 + 9224;
}

__device__ __forceinline__ void phase_p0(const DArgs& a, LAS unsigned char* lds, int vcu, int G) {
    const int tid = tid_(), lane = tid & 63, wave = tid >> 6;
    const int gw = vcu * NWAVES + wave, NGW = G * NWAVES;
    GAS unsigned char* ws = a.ws;
    LAS float* scr = (LAS float*)(lds + wave * 16384);
    constexpr int I_IN = 16 * 384, I_M = 32 * 32, I_G = 16 * 32, I_O = 16 * 32, I_PQ = 16 * 64;
    constexpr int NITEMS = I_IN + I_M + I_G + I_O + I_PQ;
    for (int it = gw; it < NITEMS; it += NGW) {
        int r = it;
        if (r < I_IN) { const int kb = r / 384, nb = r % 384; p0_transpose_item(a.w_in, IN_COLS, 1024, kb * 64, win_src_col(nb * 32), (GAS bf16_t*)(ws + WS_WIN), nb * 32, scr, lane); continue; } r -= I_IN;
        if (r < I_M) { const int kb = r / 32, nb = r % 32; p0_transpose_item(a.w_br_m, 1024, 2048, kb * 64, nb * 32, (GAS bf16_t*)(ws + WS_WM), nb * 32, scr, lane); continue; } r -= I_M;
        if (r < I_G) { const int kb = r / 32, nb = r % 32; p0_transpose_item(a.w_br_g, 1024, 1024, kb * 64, nb * 32, (GAS bf16_t*)(ws + WS_WG), nb * 32, scr, lane); continue; } r -= I_G;
        if (r < I_O) { const int kb = r / 32, nb = r % 32; p0_transpose_item(a.w_out, 1024, 1024, kb * 64, nb * 32, (GAS bf16_t*)(ws + WS_WO), nb * 32, scr, lane); continue; } r -= I_O;
        { const int kb = r / 64, nb = r % 64; p0_transpose_item(a.w_pq, 2048, 1024, kb * 64, nb * 32, (GAS bf16_t*)(ws + WS_WPQ), nb * 32, scr, lane); }
    }
    const int gt = vcu * NTHR + tid, NGT = G * NTHR;
    for (int i = gt; i < NP; i += NGT) ((float*)(ws + WS_BIASP))[i] = a.b_in[win_src_col(i)];
    for (int i = gt; i < 1024; i += NGT) { const float t0 = a.lb_table[i], t1 = a.lb_table[1024 + i]; ((float*)(ws + WS_LB))[i] = 1.0f / (1.0f + __expf(t1 - t0)); }
    for (int i = gt; i < 8 * 2 * 128 * 128 / 4; i += NGT) { const f32x4 v = ((const f32x4*)a.sub_keys)[i]; u32x2 o; o.x = pk2(v[0], v[1]); o.y = pk2(v[2], v[3]); ((u32x2*)(ws + WS_SK))[i] = o; }
    {
        float mu = 0.f, mv = 0.f;
        for (size_t i = (size_t)vcu * NTHR + tid; i < (size_t)16384 * 1024 / 4; i += (size_t)G * NTHR) {
            const f32x4 u4 = ((const GAS f32x4*)a.u_emb)[i], v4 = ((const GAS f32x4*)a.v_emb)[i];
            mu = fmaxf(mu, fmaxf(fmaxf(fabsf(u4[0]), fabsf(u4[1])), fmaxf(fabsf(u4[2]), fabsf(u4[3]))));
            mv = fmaxf(mv, fmaxf(fmaxf(fabsf(v4[0]), fabsf(v4[1])), fmaxf(fabsf(v4[2]), fabsf(v4[3])))); }
#pragma unroll
        for (int o = 1; o < 64; o <<= 1) { mu = fmaxf(mu, shx(mu, o, lane)); mv = fmaxf(mv, shx(mv, o, lane)); }
        if (lane == 0) { atomicMax((unsigned*)(ws + WS_CTL) + CW_TMAX, __builtin_bit_cast(unsigned, mu)); atomicMax((unsigned*)(ws + WS_CTL) + CW_TMAX + 1, __builtin_bit_cast(unsigned, mv)); }
    }
    f32x4 g1[4];
#pragma unroll
    for (int j = 0; j < 4; ++j) g1[j] = ((const GAS f32x4*)a.norm1_g)[64 * j + lane];
    f32x4 gw0[16], gw1[16];
#pragma unroll
    for (int j = 0; j < 4; ++j)
#pragma unroll
        for (int e = 0; e < 4; ++e) { const int k = 256 * j + 4 * lane + e; gw0[4 * j + e] = *(const GAS f32x4*)(a.w_in + (size_t)k * IN_COLS + 6144); gw1[4 * j + e] = *(const GAS f32x4*)(a.w_in + (size_t)k * IN_COLS + 6148); }
    const float gbias = lane < 8 ? a.b_in[6144 + lane] : 0.f;
    for (int m = gw; m < T; m += NGW) {
        const GAS f32x4* xr = (const GAS f32x4*)(a.x + (size_t)m * D) + lane;
        f32x4 v[4]; float s = 0.f;
#pragma unroll
        for (int j = 0; j < 4; ++j) { v[j] = xr[64 * j]; s += (v[j][0] * v[j][0] + v[j][1] * v[j][1]) + (v[j][2] * v[j][2] + v[j][3] * v[j][3]); }
        const float rstd = rsqrtf(wave_sum(s, lane) * (1.f / D) + EPS);
        GAS unsigned long long* o8 = (GAS unsigned long long*)((GAS bf16_t*)(ws + WS_XN) + (size_t)m * D) + lane;
        f32x4 ga0 = (f32x4){0.f, 0.f, 0.f, 0.f}, ga1 = ga0;
#pragma unroll
        for (int j = 0; j < 4; ++j) {
            v[j] = v[j] * rstd * g1[j];
            o8[64 * j] = (unsigned long long)pk2(v[j][0], v[j][1]) | ((unsigned long long)pk2(v[j][2], v[j][3]) << 32);
#pragma unroll
            for (int e = 0; e < 4; ++e) { ga0 += gw0[4 * j + e] * v[j][e]; ga1 += gw1[4 * j + e] * v[j][e]; }
        }
        float ga[8] = {ga0[0], ga0[1], ga0[2], ga0[3], ga1[0], ga1[1], ga1[2], ga1[3]};
#pragma unroll
        for (int q = 0; q < 8; ++q) ga[q] = wave_sum(ga[q], lane);
        if (lane < 8) { float r = ga[0];
#pragma unroll
            for (int q = 1; q < 8; ++q) r = (lane == q) ? ga[q] : r;
            ((GAS float*)(ws + WS_GATES))[(size_t)m * 8 + lane] = r + gbias; }
    }
}

__device__ __forceinline__ float logsigf_(float x) { return fminf(x, 0.f) - log1pf(__expf(-fabsf(x))); }
#define LDS_BAR() do { asm volatile("s_waitcnt lgkmcnt(0)" ::: "memory"); __builtin_amdgcn_s_barrier(); asm volatile("" ::: "memory"); } while (0)
#define MFMA16(a, b, c) __builtin_amdgcn_mfma_f32_16x16x32_bf16((a), (b), (c), 0, 0, 0)
__device__ __forceinline__ bf16x8 lfrag(const LAS unsigned char* base, int pitch, int row, int k0, int fq) { return *(const LAS bf16x8*)(base + row * pitch + (k0 + 8 * fq) * 2); }
__device__ __forceinline__ int fm_off(int r, int k, int KB) { return (((r >> 4) * KB + (k >> 5)) << 10) + (((((k >> 3) & 3) << 4) + (r & 15)) << 4) + ((k & 7) << 1); }
__device__ __forceinline__ bf16x8 gfrag(const bf16_t* base, int ld, int row, int k0, int fq) { return *(const bf16x8*)(base + (size_t)row * ld + k0 + 8 * fq); }

__device__ __forceinline__ void mscan_pair(const DArgs& a, LAS unsigned char* lds, int round, int p) {
    const int tid = tid_(), lane = tid & 63, part = tid >> 6;
    const int bl = p >> 2, h = p & 3, b = round * 2 + bl;
    const GAS float* g = (const GAS float*)(a.ws + WS_GATES) + ((size_t)b * SEQ + (size_t)lane * 128 + part * 16) * 8;
    float bsum = 0.f, gm = -INFINITY;
#pragma unroll 4
    for (int s = 0; s < 16; ++s) { const float ip = g[s * 8 + h], fp = g[s * 8 + 4 + h]; bsum += logsigf_(fp); gm = fmaxf(gm, ip - bsum); }
    LAS float* PS = (LAS float*)lds; LAS float* PM = PS + 512;
    PS[part * 64 + lane] = bsum; PM[part * 64 + lane] = gm;
    __syncthreads();
    if (tid < 64) {
        float bs = 0.f, g2 = -INFINITY;
#pragma unroll
        for (int q = 0; q < 8; ++q) { g2 = fmaxf(g2, PM[q * 64 + lane] - bs); bs += PS[q * 64 + lane]; }
        float mprev = 0.f, mine = 0.f;
        for (int c = 0; c < 64; ++c) {
            const float bc = rdlane(bs, c), gc = rdlane(g2, c);
            if (lane == c) mine = mprev; mprev = bc + fmaxf(mprev, gc); }
        ((GAS float*)(a.ws + WS_MPREV))[(round * 8 + p) * 64 + lane] = mine;
    }
    __syncthreads();
}

constexpr int PQ_PITCH = 528, PS_PITCH = 272;
__device__ __forceinline__ void mlstm_pre_item(const DArgs& a, LAS unsigned char* lds, int round, int item) {
    const int tid = tid_(), lane = tid & 63, wave = __builtin_amdgcn_readfirstlane(tid >> 6), fr = lane & 15, fq = lane >> 4;
    const int p = item >> 6, c = item & 63, bl = p >> 2, h = p & 3, b = round * 2 + bl;
    const int tl0 = bl * SEQ + c * 128; const size_t tg0 = (size_t)b * SEQ + c * 128;
    GAS unsigned char* ws = a.ws;
    LAS unsigned char* QL = lds; LAS unsigned char* KL = lds + 67584;
    LAS float* AS = (LAS float*)(lds + 135168); LAS float* MS = AS + 128; LAS float* SC = AS + 256;
    if (wave == 0) {
        const float mprev = ((const float*)(ws + WS_MPREV))[(round * 8 + p) * 64 + c];
        const float* g = (const float*)(ws + WS_GATES) + (tg0 + 2 * lane) * 8;
        const float ip0 = g[h], fp0 = g[4 + h], ip1 = g[8 + h], fp1 = g[12 + h];
        const float lf0 = logsigf_(fp0), lf1 = logsigf_(fp1), pp = lf0 + lf1;
        float incl = pp;
#pragma unroll
        for (int o = 1; o < 64; o <<= 1) { const float t = shup(incl, o, lane); if (lane >= o) incl += t; }
        const float excl = incl - pp, b0 = excl + lf0, b1 = incl;
        const float a0 = ip0 - b0, a1 = ip1 - b1;
        float inclm = fmaxf(a0, a1);
#pragma unroll
        for (int o = 1; o < 64; o <<= 1) { const float t = shup(inclm, o, lane); if (lane >= o) inclm = fmaxf(inclm, t); }
        float exclm = shup(inclm, 1, lane); if (lane == 0) exclm = -INFINITY;
        const float M0 = fmaxf(mprev, fmaxf(exclm, a0)), M1 = fmaxf(mprev, inclm);
        AS[2 * lane] = a0; AS[2 * lane + 1] = a1; MS[2 * lane] = M0; MS[2 * lane + 1] = M1;
        float* mt = (float*)(ws + WS_MT) + (tg0 + 2 * lane) * 4 + h;
        mt[0] = b0 + M0; mt[4] = b1 + M1;
        const float Mlast = rdlane(M1, 63);
        if (lane == 0) { SC[0] = mprev; SC[1] = Mlast; ((float*)(ws + WS_MDEC))[item] = __expf(mprev - Mlast); }
    }
    {
        const int cgp = tid & 63, strip = tid >> 6;
        const int col = (cgp < 32) ? (h * 256 + cgp * 8) : (1024 + h * 256 + (cgp - 32) * 8);
        float w[4][8], bb[8];
#pragma unroll
        for (int j = 0; j < 4; ++j) { const f32x4 w0 = *(const f32x4*)(a.conv_w + j * 2048 + col), w1 = *(const f32x4*)(a.conv_w + j * 2048 + col + 4);
#pragma unroll
            for (int e = 0; e < 4; ++e) { w[j][e] = w0[e]; w[j][4 + e] = w1[e]; } }
        { const f32x4 b0 = *(const f32x4*)(a.conv_b + col), b1 = *(const f32x4*)(a.conv_b + col + 4);
#pragma unroll
            for (int e = 0; e < 4; ++e) { bb[e] = b0[e]; bb[4 + e] = b1[e]; } }
        const bf16_t* src = (const bf16_t*)(ws + WS_QKPRE) + (size_t)(tl0 + 16 * strip) * 2048 + col;
        const float qs = (cgp < 32) ? 0.0625f : 1.0f;
        LAS unsigned char* dstt = ((cgp < 32) ? QL : KL) + (cgp & 31) * 16;
#pragma unroll 1
        for (int half = 0; half < 2; ++half) {
            u32x4 xr[11];
#pragma unroll
            for (int r = 0; r < 11; ++r) {
                const int sl = c * 128 + 16 * strip + 8 * half + r - 3;
                xr[r] = (sl >= 0) ? *(const u32x4*)(src + (ptrdiff_t)(8 * half + r - 3) * 2048) : (u32x4){0u, 0u, 0u, 0u};
            }
#pragma unroll
            for (int r = 0; r < 8; ++r) {
                float y[8];
#pragma unroll
                for (int e = 0; e < 8; ++e) y[e] = bb[e];
#pragma unroll
                for (int j = 0; j < 4; ++j) { const u32x4 xv = xr[r + j];
                    y[0] += w[j][0] * bf_lo(xv.x); y[1] += w[j][1] * bf_hi(xv.x); y[2] += w[j][2] * bf_lo(xv.y); y[3] += w[j][3] * bf_hi(xv.y);
                    y[4] += w[j][4] * bf_lo(xv.z); y[5] += w[j][5] * bf_hi(xv.z); y[6] += w[j][6] * bf_lo(xv.w); y[7] += w[j][7] * bf_hi(xv.w); }
#pragma unroll
                for (int e = 0; e < 8; ++e) y[e] = siluf_(y[e]) * qs;
                u32x4 o; o.x = pk2(y[0], y[1]); o.y = pk2(y[2], y[3]); o.z = pk2(y[4], y[5]); o.w = pk2(y[6], y[7]);
                *(LAS u32x4*)(dstt + (16 * strip + 8 * half + r) * PQ_PITCH) = o;
            }
        }
    }
    __syncthreads();
    const float mprev = SC[0], Mlast = SC[1];
    {
        bf16_t* Sg = (bf16_t*)(ws + WS_S) + (size_t)item * 128 * 128;
        const int t = wave * 16 + fr; const float Mt = MS[t];
        for (int st = 0; st < 8; ++st) {
            u32x2 o = (u32x2){0u, 0u};
            if (st <= wave) {
                f32x4 acc = (f32x4){0.f, 0.f, 0.f, 0.f};
#pragma unroll
                for (int ks = 0; ks < 8; ++ks) acc = MFMA16(lfrag(KL, PQ_PITCH, st * 16 + fr, ks * 32, fq), lfrag(QL, PQ_PITCH, wave * 16 + fr, ks * 32, fq), acc);
                float v[4];
#pragma unroll
                for (int j = 0; j < 4; ++j) { const int s = st * 16 + 4 * fq + j; v[j] = (s <= t) ? acc[j] * __expf(AS[s] - Mt) : 0.f; }
                o.x = pk2(v[0], v[1]); o.y = pk2(v[2], v[3]);
            }
            *(u32x2*)((unsigned char*)Sg + fm_off(t, st * 16 + 4 * fq, 4)) = o;
        }
    }
    {
        bf16_t* Qg = (bf16_t*)(ws + WS_QT) + (size_t)item * 128 * 256;
#pragma unroll
        for (int i = 0; i < 8; ++i) { const int idx = tid + 512 * i, blk = idx >> 6, t = (blk >> 3) * 16 + (idx & 15), ch = (blk & 7) * 4 + ((idx >> 4) & 3);
            const u32x4 v = *(const LAS u32x4*)(QL + t * PQ_PITCH + ch * 16); const float s = __expf(mprev - MS[t]);
            u32x4 o; o.x = pk2(bf_lo(v.x) * s, bf_hi(v.x) * s); o.y = pk2(bf_lo(v.y) * s, bf_hi(v.y) * s); o.z = pk2(bf_lo(v.z) * s, bf_hi(v.z) * s); o.w = pk2(bf_lo(v.w) * s, bf_hi(v.w) * s);
            *(u32x4*)((unsigned char*)Qg + fm_off(t, ch * 8, 8)) = o; }
    }
    {
        bf16_t* Kg = (bf16_t*)(ws + WS_KWT) + (size_t)item * 256 * 128;
        const int dlo = lane & 15, sglo = lane >> 4;
#pragma unroll
        for (int i = 0; i < 8; ++i) { const int combo = wave * 8 + i, d = (combo >> 2) * 16 + dlo, s0 = ((combo & 3) * 4 + sglo) * 8;
            float v[8];
#pragma unroll
            for (int e = 0; e < 8; ++e) v[e] = bf2f(*(const LAS bf16_t*)(KL + (s0 + e) * PQ_PITCH + d * 2)) * __expf(AS[s0 + e] - Mlast);
            u32x4 o; o.x = pk2(v[0], v[1]); o.y = pk2(v[2], v[3]); o.z = pk2(v[4], v[5]); o.w = pk2(v[6], v[7]);
            *(u32x4*)((unsigned char*)Kg + fm_off(d, s0, 4)) = o; }
    }
    __syncthreads();
}

__device__ __forceinline__ void hgrn_pre_load(const DArgs& a, int round, int item, u32x4 (&gq)[4]) {
    const int tid = tid_();
    const int p = item >> 7, c = item & 127, bl = p >> 3, h = p & 7;
    const int tl0 = bl * SEQ + c * 64;
    GAS unsigned char* ws = a.ws;
#pragma unroll
    for (int i = 0; i < 2; ++i) { const int idx = tid + 512 * i, s = idx >> 4, ch = idx & 15;
        gq[2 * i] = *(const GAS u32x4*)((const GAS bf16_t*)(ws + WS_GFLOG) + (size_t)(tl0 + s) * 1024 + h * 128 + ch * 8);
        gq[2 * i + 1] = *(const GAS u32x4*)((const GAS bf16_t*)(ws + WS_GQ) + (size_t)(tl0 + s) * 1024 + h * 128 + ch * 8); }
}
__device__ __forceinline__ void hgrn_pre_item(const DArgs& a, LAS unsigned char* lds, int round, int item, u32x4 (&gq)[4], int next_item) {
    const int tid = tid_(), lane = tid & 63, wave = __builtin_amdgcn_readfirstlane(tid >> 6), fr = lane & 15, fq = lane >> 4;
    const int p = item >> 7, c = item & 127, bl = p >> 3, h = p & 7;
    const int tl0 = bl * SEQ + c * 64;
    GAS unsigned char* ws = a.ws;
    LAS float* CUM = (LAS float*)lds;
    LAS float* GL = (LAS float*)(lds + 32768);
    LAS unsigned char* QH = lds + 65536;
    LAS unsigned char* KE = lds + 65536 + 64 * PS_PITCH;
    LAS float* QF = (LAS float*)(lds + 65536 + 128 * PS_PITCH);
#pragma unroll
    for (int i = 0; i < 2; ++i) { const int idx = tid + 512 * i, s = idx >> 4, ch = idx & 15;
        const u32x4 gv = gq[2 * i], qv = gq[2 * i + 1];
        LAS float* gd = GL + s * 128 + ch * 8; LAS float* qd = QF + s * 128 + ch * 8;
        gd[0] = bf_lo(gv.x); gd[1] = bf_hi(gv.x); gd[2] = bf_lo(gv.y); gd[3] = bf_hi(gv.y); gd[4] = bf_lo(gv.z); gd[5] = bf_hi(gv.z); gd[6] = bf_lo(gv.w); gd[7] = bf_hi(gv.w);
        qd[0] = bf_lo(qv.x); qd[1] = bf_hi(qv.x); qd[2] = bf_lo(qv.y); qd[3] = bf_hi(qv.y); qd[4] = bf_lo(qv.z); qd[5] = bf_hi(qv.z); qd[6] = bf_lo(qv.w); qd[7] = bf_hi(qv.w); }
    if (next_item < 2048) hgrn_pre_load(a, round, next_item, gq);
    LDS_BAR();
    {
        const int d = tid & 127, qt = tid >> 7; float cs = 0.f;
#pragma unroll 4
        for (int s = 0; s < 16; ++s) { cs += GL[(qt * 16 + s) * 128 + d]; CUM[(qt * 16 + s) * 128 + d] = cs; }
        LDS_BAR();
        float off = 0.f;
#pragma unroll
        for (int q = 0; q < 3; ++q) off += (q < qt) ? CUM[(q * 16 + 15) * 128 + d] : 0.f;
        LDS_BAR();
#pragma unroll 4
        for (int s = 0; s < 16; ++s) CUM[(qt * 16 + s) * 128 + d] += off;
        if (qt == 3) ((GAS float*)(ws + WS_HGDEC))[(size_t)item * 128 + d] = __expf(cs + off);
    }
    LDS_BAR();
    {
        bf16_t* Qg = (bf16_t*)(ws + WS_QTG) + (size_t)item * 64 * 128;
#pragma unroll
        for (int i = 0; i < 2; ++i) { const int idx = tid + 512 * i, s = idx >> 4, ch = idx & 15;
            float qt[8], qh[8], ke[8];
#pragma unroll
            for (int e = 0; e < 8; ++e) { const int d = ch * 8 + e; const float cm = CUM[s * 128 + d], last = CUM[63 * 128 + d], q = QF[s * 128 + d], g = GL[s * 128 + d];
                qt[e] = q * __expf(cm); qh[e] = q * __expf(cm - last); ke[e] = (1.0f - __expf(g)) * __expf(last - cm); }
            u32x4 o; o.x = pk2(qt[0], qt[1]); o.y = pk2(qt[2], qt[3]); o.z = pk2(qt[4], qt[5]); o.w = pk2(qt[6], qt[7]);
            *(u32x4*)((unsigned char*)Qg + fm_off(s, ch * 8, 4)) = o;
            o.x = pk2(qh[0], qh[1]); o.y = pk2(qh[2], qh[3]); o.z = pk2(qh[4], qh[5]); o.w = pk2(qh[6], qh[7]);
            *(LAS u32x4*)(QH + s * PS_PITCH + ch * 16) = o;
            o.x = pk2(ke[0], ke[1]); o.y = pk2(ke[2], ke[3]); o.z = pk2(ke[4], ke[5]); o.w = pk2(ke[6], ke[7]);
            *(LAS u32x4*)(KE + s * PS_PITCH + ch * 16) = o; }
    }
    LDS_BAR();
    {
        bf16_t* Ag = (bf16_t*)(ws + WS_ATT) + (size_t)item * 64 * 64;
#pragma unroll
        for (int i = 0; i < 2; ++i) { const int tile = wave * 2 + i, tt = tile >> 2, st = tile & 3; const int t = tt * 16 + fr;
            u32x2 o = (u32x2){0u, 0u};
            if (st <= tt) { f32x4 acc = (f32x4){0.f, 0.f, 0.f, 0.f};
#pragma unroll
                for (int ks = 0; ks < 4; ++ks) acc = MFMA16(lfrag(KE, PS_PITCH, st * 16 + fr, ks * 32, fq), lfrag(QH, PS_PITCH, tt * 16 + fr, ks * 32, fq), acc);
                float v[4];
#pragma unroll
                for (int j = 0; j < 4; ++j) { const int s = st * 16 + 4 * fq + j; v[j] = (s <= t) ? acc[j] : 0.f; }
                o.x = pk2(v[0], v[1]); o.y = pk2(v[2], v[3]); }
            *(u32x2*)((unsigned char*)Ag + fm_off(t, st * 16 + 4 * fq, 2)) = o; }
    }
    {
        bf16_t* Kg = (bf16_t*)(ws + WS_KENDT) + (size_t)item * 128 * 64;
        const int dlo = lane & 15, sglo = lane >> 4;
#pragma unroll
        for (int i = 0; i < 2; ++i) { const int combo = wave * 2 + i, d = (combo >> 1) * 16 + dlo, s0 = ((combo & 1) * 4 + sglo) * 8;
            unsigned v[8];
#pragma unroll
            for (int e = 0; e < 8; ++e) v[e] = *(const LAS bf16_t*)(KE + (s0 + e) * PS_PITCH + d * 2);
            u32x4 o; o.x = v[0] | (v[1] << 16); o.y = v[2] | (v[3] << 16); o.z = v[4] | (v[5] << 16); o.w = v[6] | (v[7] << 16);
            *(u32x4*)((unsigned char*)Kg + fm_off(d, s0, 2)) = o; }
    }
    LDS_BAR();
}

template <int NVT, bool DEN>
__device__ __forceinline__ void mlstm_scan(const DArgs& a, LAS unsigned char* lds, int round, int p, int sl) {
    const int tid = tid_(), lane = tid & 63, wave = __builtin_amdgcn_readfirstlane(tid >> 6), fr = lane & 15, fq = lane >> 4;
    const int bl = p >> 2, h = p & 3, b = round * 2 + bl;
    GAS unsigned char* ws = a.ws;
    constexpr int VTB = NVT * 16 * PS_PITCH, CTB = NVT * 16 * PQ_PITCH;
    LAS unsigned char* VT = lds; LAS unsigned char* CT = lds + 2 * VTB; LAS float* DEC = (LAS float*)(lds + 2 * VTB + 2 * CTB);
    for (int i = tid; i < (2 * VTB + 2 * CTB) / 4; i += NTHR) ((LAS unsigned*)lds)[i] = 0u;
    if (tid < 64) DEC[tid] = ((const GAS float*)(ws + WS_MDEC))[p * 64 + tid];
    __syncthreads();
    if (DEN) { if (tid < 256) { const int bufi = tid >> 7, s = tid & 127; *(LAS bf16_t*)(VT + bufi * VTB + s * 2) = (bf16_t)0x3F80; } }
    f32x4 st[2][NVT];
#pragma unroll
    for (int dt = 0; dt < 2; ++dt)
#pragma unroll
        for (int vt = 0; vt < NVT; ++vt) st[dt][vt] = (f32x4){0.f, 0.f, 0.f, 0.f};
    const int vcol = h * 512 + sl * 32;
    const int vs = tid >> 2, vpart = tid & 3;
    const GAS unsigned char* Sg0 = ws + WS_S + (size_t)(p * 64) * 32768 + wave * 4096 + lane * 16;
    const GAS unsigned char* Qg0 = ws + WS_QT + (size_t)(p * 64) * 65536 + wave * 8192 + lane * 16;
    const GAS unsigned char* Kg0 = ws + WS_KWT + (size_t)(p * 64) * 65536 + wave * 8192 + lane * 16;
    const GAS bf16_t* Vg0 = (const GAS bf16_t*)(ws + WS_V) + (size_t)(bl * SEQ + vs) * 2048 + vcol + vpart * 8;
    bf16x8 bS[4], bQ[8], aK[2][4]; u32x4 vreg = (u32x4){0u, 0u, 0u, 0u};
#define V_STAGE(cc_) do { LAS unsigned char* d0_ = VT + ((cc_) & 1) * VTB + (vpart * 8) * PS_PITCH + vs * 2; \
        *(LAS bf16_t*)(d0_ + 0 * PS_PITCH) = (bf16_t)(vreg.x & 0xffffu); *(LAS bf16_t*)(d0_ + 1 * PS_PITCH) = (bf16_t)(vreg.x >> 16); \
        *(LAS bf16_t*)(d0_ + 2 * PS_PITCH) = (bf16_t)(vreg.y & 0xffffu); *(LAS bf16_t*)(d0_ + 3 * PS_PITCH) = (bf16_t)(vreg.y >> 16); \
        *(LAS bf16_t*)(d0_ + 4 * PS_PITCH) = (bf16_t)(vreg.z & 0xffffu); *(LAS bf16_t*)(d0_ + 5 * PS_PITCH) = (bf16_t)(vreg.z >> 16); \
        *(LAS bf16_t*)(d0_ + 6 * PS_PITCH) = (bf16_t)(vreg.w & 0xffffu); *(LAS bf16_t*)(d0_ + 7 * PS_PITCH) = (bf16_t)(vreg.w >> 16); } while (0)
    if (!DEN) { vreg = *(const GAS u32x4*)Vg0; V_STAGE(0); }
    __builtin_amdgcn_sched_barrier(0);
#pragma unroll
    for (int ks = 0; ks < 4; ++ks)
#pragma unroll
        for (int dt = 0; dt < 2; ++dt) aK[dt][ks] = *(const GAS bf16x8*)(Kg0 + (dt * 4 + ks) * 1024);
    __builtin_amdgcn_sched_barrier(0);
#pragma unroll
    for (int ks = 0; ks < 4; ++ks) bS[ks] = *(const GAS bf16x8*)(Sg0 + ks * 1024);
    __builtin_amdgcn_sched_barrier(0);
#pragma unroll
    for (int ks = 0; ks < 8; ++ks) bQ[ks] = *(const GAS bf16x8*)(Qg0 + ks * 1024);
    __builtin_amdgcn_sched_barrier(0);
    if (!DEN) vreg = *(const GAS u32x4*)(Vg0 + (size_t)128 * 2048);
    __builtin_amdgcn_sched_barrier(0);
    const GAS unsigned char* pfp; unsigned pfstride;
    { const int tt = (wave * 64 + lane) < 160 ? wave * 64 + lane : 159; const int idx = sl * 10 + (tt >> 4), off = (tt & 15) * 64;
      pfp = (idx < 32 ? ws + WS_S + (size_t)(p * 64) * 32768 + idx * 1024 : idx < 96 ? ws + WS_QT + (size_t)(p * 64) * 65536 + (idx - 32) * 1024 : ws + WS_KWT + (size_t)(p * 64) * 65536 + (idx - 96) * 1024) + off;
      pfstride = idx < 32 ? 32768u : 65536u; }
    unsigned pfv = 0u;
#pragma unroll 1
    for (int c = 0; c < 64; ++c) {
        const int tl0 = bl * SEQ + c * 128; const size_t tg0 = (size_t)b * SEQ + c * 128;
        const int cn = c < 63 ? c + 1 : 63, cn2 = c < 62 ? c + 2 : 63;
        LAS unsigned char* vt_ = VT + (c & 1) * VTB; LAS unsigned char* ct_ = CT + (c & 1) * CTB; LAS unsigned char* ctn = CT + ((c + 1) & 1) * CTB;
        LDS_BAR();
        if (!DEN && wave < 3) { asm volatile("" :: "v"(pfv)); const int c3 = c < 60 ? c + 3 : 63; pfv = *(const GAS unsigned*)(pfp + (size_t)c3 * pfstride); }
        bf16x8 vf[NVT][4], cf[NVT][4];
#pragma unroll
        for (int vt = 0; vt < NVT; ++vt)
#pragma unroll
            for (int ks = 0; ks < 4; ++ks) vf[vt][ks] = lfrag(vt_, PS_PITCH, vt * 16 + fr, ks * 32, fq);
        const float dec = DEC[c];
        __builtin_amdgcn_sched_barrier(0);
#pragma unroll
        for (int dt = 0; dt < 2; ++dt)
#pragma unroll
            for (int vt = 0; vt < NVT; ++vt) st[dt][vt] = st[dt][vt] * dec;
#pragma unroll
        for (int ks = 0; ks < 4; ++ks) {
#pragma unroll
            for (int vt = 0; vt < NVT; ++vt) cf[vt][ks] = lfrag(ct_, PQ_PITCH, vt * 16 + fr, ks * 32, fq);
#pragma unroll
            for (int dt = 0; dt < 2; ++dt) {
#pragma unroll
                for (int vt = 0; vt < NVT; ++vt) st[dt][vt] = MFMA16(aK[dt][ks], vf[vt][ks], st[dt][vt]);
                aK[dt][ks] = *(const GAS bf16x8*)(Kg0 + (size_t)cn * 65536 + (dt * 4 + ks) * 1024);
            }
            __builtin_amdgcn_sched_barrier(0);
        }
#pragma unroll
        for (int dt = 0; dt < 2; ++dt)
#pragma unroll
            for (int vt = 0; vt < NVT; ++vt) { u32x2 o; o.x = pk2(st[dt][vt][0], st[dt][vt][1]); o.y = pk2(st[dt][vt][2], st[dt][vt][3]);
                *(LAS u32x2*)(ctn + (vt * 16 + fr) * PQ_PITCH + (wave * 32 + dt * 16 + 4 * fq) * 2) = o; }
        __builtin_amdgcn_sched_barrier(0);
        f32x4 acc[NVT];
#pragma unroll
        for (int vt = 0; vt < NVT; ++vt) acc[vt] = (f32x4){0.f, 0.f, 0.f, 0.f};
#pragma unroll
        for (int ks = 0; ks < 4; ++ks) {
#pragma unroll
            for (int vt = 0; vt < NVT; ++vt) acc[vt] = MFMA16(vf[vt][ks], bS[ks], acc[vt]);
            bS[ks] = *(const GAS bf16x8*)(Sg0 + (size_t)cn * 32768 + ks * 1024);
            __builtin_amdgcn_sched_barrier(0);
        }
#pragma unroll
        for (int ks = 0; ks < 8; ++ks) {
#pragma unroll
            for (int vt = 0; vt < NVT; ++vt) acc[vt] = MFMA16(cf[vt][ks & 3], bQ[ks], acc[vt]);
            if (ks < 4) {
#pragma unroll
                for (int vt = 0; vt < NVT; ++vt) cf[vt][ks] = lfrag(ct_, PQ_PITCH, vt * 16 + fr, 128 + ks * 32, fq);
            }
            bQ[ks] = *(const GAS bf16x8*)(Qg0 + (size_t)cn * 65536 + ks * 1024);
            __builtin_amdgcn_sched_barrier(0);
        }
        const int t = wave * 16 + fr;
        if (!DEN) {
            GAS bf16_t* hn = (GAS bf16_t*)(ws + WS_QKPRE) + (size_t)(tl0 + t) * 2048 + vcol + 4 * fq;
#pragma unroll
            for (int vt = 0; vt < NVT; ++vt) { u32x2 o; o.x = pk2(acc[vt][0], acc[vt][1]); o.y = pk2(acc[vt][2], acc[vt][3]); *(GAS u32x2*)(hn + vt * 16) = o; }
            V_STAGE(c + 1); vreg = *(const GAS u32x4*)(Vg0 + (size_t)cn2 * 128 * 2048);
        } else {
            if (fq == 0) ((GAS float*)(ws + WS_DEN))[(tg0 + t) * 4 + h] = acc[0][0];
        }
    }
    asm volatile("" :: "v"(pfv));
    __syncthreads();
#undef V_STAGE
}

constexpr int HG_PD = 4;
__device__ __forceinline__ void hgrn_scan(const DArgs& a, LAS unsigned char* lds, int round, int p, int sl) {
    const int tid = tid_(), lane = tid & 63, wave = __builtin_amdgcn_readfirstlane(tid >> 6), fr = lane & 15, fq = lane >> 4;
    const int bl = p >> 3, h = p & 7;
    GAS unsigned char* ws = a.ws;
    constexpr int IP = 144, ITB = 32 * IP, STB = 32 * PS_PITCH;
    LAS unsigned char* IT = lds; LAS unsigned char* ST = lds + 2 * ITB;
    for (int i = tid; i < (2 * ITB + 2 * STB) / 4; i += NTHR) ((LAS unsigned*)lds)[i] = 0u;
    __syncthreads();
    f32x4 st[2][2];
#pragma unroll
    for (int i = 0; i < 2; ++i) { st[i][0] = (f32x4){0.f, 0.f, 0.f, 0.f}; st[i][1] = st[i][0]; }
    const int vcol = h * 128 + sl * 32;
    const int is = (tid & 255) >> 2, ipart = tid & 3;
    const bool outw = wave < 4;
    const int w4 = wave & 3;
    const GAS unsigned char* Ag0 = ws + WS_ATT + (size_t)(p * 128) * 8192 + w4 * 2048 + lane * 16;
    const GAS unsigned char* Qg0 = ws + WS_QTG + (size_t)(p * 128) * 16384 + w4 * 4096 + lane * 16;
    const GAS unsigned char* Kg0 = ws + WS_KENDT + (size_t)(p * 128) * 16384 + w4 * 4096 + lane * 16;
    const GAS unsigned char* Dg0 = ws + WS_HGDEC + ((size_t)(p * 128) * 128 + w4 * 32 + 4 * fq) * 4;
    const GAS unsigned char* Ig0 = ws + WS_GI + ((size_t)(bl * SEQ + is) * 1024 + vcol + ipart * 8) * 2;
    const GAS unsigned char* gb0 = outw ? Ag0 : Kg0;          const unsigned gs0 = outw ? 8192u : 16384u;
    const GAS unsigned char* gb1 = outw ? Qg0 : Kg0 + 2048;   const unsigned gs1 = 16384u;
    const GAS unsigned char* gb2 = outw ? Qg0 + 2048 : Dg0;   const unsigned gs2 = outw ? 16384u : 512u, gt2 = outw ? 1024u : 64u;
    const GAS unsigned char* gb3 = outw ? Ig0 : Dg0;          const unsigned gs3 = outw ? 131072u : 512u;
    u32x4 pf[HG_PD][7];
#define HG_LD01(k_, cc_) do { _Pragma("unroll") for (int j_ = 0; j_ < 2; ++j_) pf[k_][j_] = *(const GAS u32x4*)(gb0 + (size_t)(cc_) * gs0 + j_ * 1024); } while (0)
#define HG_LD23(k_, cc_) do { _Pragma("unroll") for (int j_ = 0; j_ < 2; ++j_) pf[k_][2 + j_] = *(const GAS u32x4*)(gb1 + (size_t)(cc_) * gs1 + j_ * 1024); } while (0)
#define HG_LD45(k_, cc_) do { _Pragma("unroll") for (int j_ = 0; j_ < 2; ++j_) pf[k_][4 + j_] = *(const GAS u32x4*)(gb2 + (size_t)(cc_) * gs2 + j_ * gt2); } while (0)
#define HG_LD6(k_, cc_) do { pf[k_][6] = *(const GAS u32x4*)(gb3 + (size_t)(cc_) * gs3); } while (0)
#pragma unroll
    for (int k = 0; k < HG_PD; ++k) { HG_LD01(k, k); HG_LD23(k, k); HG_LD45(k, k); __builtin_amdgcn_sched_barrier(0); HG_LD6((k + 1) % HG_PD, (k + 1 < HG_PD ? k + 1 : HG_PD)); __builtin_amdgcn_sched_barrier(0); }
    const GAS unsigned char* pfp; unsigned pfstride;
    { const int tt = (wave * 64 + lane) < 160 ? wave * 64 + lane : 159; const int idx = sl * 10 + (tt >> 4), off = (tt & 15) * 64;
      pfp = (idx < 8 ? ws + WS_ATT + (size_t)(p * 128) * 8192 + idx * 1024 : idx < 24 ? ws + WS_QTG + (size_t)(p * 128) * 16384 + (idx - 8) * 1024 : ws + WS_KENDT + (size_t)(p * 128) * 16384 + (idx - 24) * 1024) + off;
      pfstride = idx < 8 ? 8192u : 16384u; }
    unsigned pfv[HG_PD];
#pragma unroll
    for (int k = 0; k < HG_PD; ++k) pfv[k] = 0u;
#define HG_STAGE(dst_, iv_) do { LAS unsigned char* d0_ = (dst_) + (ipart * 8) * IP + is * 2; \
        *(LAS bf16_t*)(d0_ + 0 * IP) = (bf16_t)((iv_).x & 0xffffu); *(LAS bf16_t*)(d0_ + 1 * IP) = (bf16_t)((iv_).x >> 16); \
        *(LAS bf16_t*)(d0_ + 2 * IP) = (bf16_t)((iv_).y & 0xffffu); *(LAS bf16_t*)(d0_ + 3 * IP) = (bf16_t)((iv_).y >> 16); \
        *(LAS bf16_t*)(d0_ + 4 * IP) = (bf16_t)((iv_).z & 0xffffu); *(LAS bf16_t*)(d0_ + 5 * IP) = (bf16_t)((iv_).z >> 16); \
        *(LAS bf16_t*)(d0_ + 6 * IP) = (bf16_t)((iv_).w & 0xffffu); *(LAS bf16_t*)(d0_ + 7 * IP) = (bf16_t)((iv_).w >> 16); } while (0)
    if (outw) { const u32x4 iv = *(const GAS u32x4*)Ig0; HG_STAGE(IT, iv); }
#pragma unroll 1
    for (int c0 = 0; c0 < 128; c0 += HG_PD) {
#pragma unroll
      for (int k = 0; k < HG_PD; ++k) {
        const int c = c0 + k;
        const int tl0 = bl * SEQ + c * 64;
        const int cn = (c + HG_PD < 128) ? c + HG_PD : 127;
        LAS unsigned char* it_ = IT + (k & 1) * ITB; LAS unsigned char* itn = IT + ((k + 1) & 1) * ITB; LAS unsigned char* st_ = ST + (k & 1) * STB; LAS unsigned char* stn = ST + ((k + 1) & 1) * STB;
        LDS_BAR();
        if (wave < 3) { asm volatile("" :: "v"(pfv[k])); const int c7 = (c + HG_PD + 3 < 128) ? c + HG_PD + 3 : 127; pfv[k] = *(const GAS unsigned*)(pfp + (size_t)c7 * pfstride); }
        bf16x8 itf[2][2];
#pragma unroll
        for (int vt = 0; vt < 2; ++vt)
#pragma unroll
            for (int ks = 0; ks < 2; ++ks) itf[vt][ks] = lfrag(it_, IP, vt * 16 + fr, ks * 32, fq);
        bf16x8 sf[2][4];
        f32x4 acc[2];
        acc[0] = (f32x4){0.f, 0.f, 0.f, 0.f}; acc[1] = acc[0];
        if (outw) {
#pragma unroll
            for (int vt = 0; vt < 2; ++vt)
#pragma unroll
                for (int ks = 0; ks < 4; ++ks) sf[vt][ks] = lfrag(st_, PS_PITCH, vt * 16 + fr, ks * 32, fq);
#pragma unroll
            for (int ks = 0; ks < 2; ++ks)
#pragma unroll
                for (int vt = 0; vt < 2; ++vt) acc[vt] = MFMA16(itf[vt][ks], __builtin_bit_cast(bf16x8, pf[k][ks]), acc[vt]);
        } else {
            const f32x4 dec = __builtin_bit_cast(f32x4, pf[k][4]);
#pragma unroll
            for (int vt = 0; vt < 2; ++vt) { st[0][vt] = st[0][vt] * dec;
#pragma unroll
                for (int ks = 0; ks < 2; ++ks) st[0][vt] = MFMA16(__builtin_bit_cast(bf16x8, pf[k][ks]), itf[vt][ks], st[0][vt]); }
        }
        __builtin_amdgcn_sched_barrier(0);
        HG_LD01(k, cn);
        __builtin_amdgcn_sched_barrier(0);
        if (outw) {
#pragma unroll
            for (int ks = 0; ks < 2; ++ks)
#pragma unroll
                for (int vt = 0; vt < 2; ++vt) acc[vt] = MFMA16(sf[vt][ks], __builtin_bit_cast(bf16x8, pf[k][2 + ks]), acc[vt]);
        } else {
            const f32x4 dec = __builtin_bit_cast(f32x4, pf[k][5]);
#pragma unroll
            for (int vt = 0; vt < 2; ++vt) { st[1][vt] = st[1][vt] * dec;
#pragma unroll
                for (int ks = 0; ks < 2; ++ks) st[1][vt] = MFMA16(__builtin_bit_cast(bf16x8, pf[k][2 + ks]), itf[vt][ks], st[1][vt]); }
        }
        __builtin_amdgcn_sched_barrier(0);
        HG_LD23(k, cn);
        __builtin_amdgcn_sched_barrier(0);
        if (outw) {
#pragma unroll
            for (int ks = 2; ks < 4; ++ks)
#pragma unroll
                for (int vt = 0; vt < 2; ++vt) acc[vt] = MFMA16(sf[vt][ks], __builtin_bit_cast(bf16x8, pf[k][2 + ks]), acc[vt]);
        } else {
#pragma unroll
            for (int dtile = 0; dtile < 2; ++dtile)
#pragma unroll
                for (int vt = 0; vt < 2; ++vt) { u32x2 o; o.x = pk2(st[dtile][vt][0], st[dtile][vt][1]); o.y = pk2(st[dtile][vt][2], st[dtile][vt][3]);
                    *(LAS u32x2*)(stn + (vt * 16 + fr) * PS_PITCH + (w4 * 32 + dtile * 16 + 4 * fq) * 2) = o; }
        }
        __builtin_amdgcn_sched_barrier(0);
        HG_LD45(k, cn);
        __builtin_amdgcn_sched_barrier(0);
        if (outw) {
            HG_STAGE(itn, pf[(k + 1) % HG_PD][6]);
            GAS bf16_t* og = (GAS bf16_t*)(ws + WS_GQ) + (size_t)(tl0 + w4 * 16 + fr) * 1024 + vcol + 4 * fq;
#pragma unroll
            for (int vt = 0; vt < 2; ++vt) { u32x2 o; o.x = pk2(acc[vt][0], acc[vt][1]); o.y = pk2(acc[vt][2], acc[vt][3]); *(GAS u32x2*)(og + vt * 16) = o; }
        }
        __builtin_amdgcn_sched_barrier(0);
        { const int cni = (c + 1 + HG_PD < 128) ? c + 1 + HG_PD : 127; HG_LD6((k + 1) % HG_PD, cni); }
        __builtin_amdgcn_sched_barrier(0);
      }
    }
#pragma unroll
    for (int k = 0; k < HG_PD; ++k) asm volatile("" :: "v"(pfv[k]));
    __syncthreads();
#undef HG_LD01
#undef HG_LD23
#undef HG_LD45
#undef HG_LD6
#undef HG_STAGE
}

__device__ __forceinline__ void phase_ypass(const DArgs& a, int round, int vcu, int G) {
    const int tid = tid_(), lane = tid & 63, wave = tid >> 6;
    const int gw = vcu * NWAVES + wave, NGW = G * NWAVES;
    GAS unsigned char* ws = a.ws;
    f32x4 mg0[4], mg1[4], gg4[4];
#pragma unroll
    for (int j = 0; j < 4; ++j) { mg0[j] = *(const GAS f32x4*)(a.m_head_g + j * 512 + lane * 8); mg1[j] = *(const GAS f32x4*)(a.m_head_g + j * 512 + lane * 8 + 4); gg4[j] = *(const GAS f32x4*)(a.g_head_g + lane * 16 + 4 * j); }
    for (int tl = gw; tl < RT; tl += NGW) {
        const size_t tg = (size_t)round * RT + tl;
        const f32x4 den4 = *(const f32x4*)((const float*)(ws + WS_DEN) + tg * 4), mt4 = *(const f32x4*)((const float*)(ws + WS_MT) + tg * 4);
#pragma unroll
        for (int j = 0; j < 4; ++j) {
            const int col = j * 512 + lane * 8;
            const u32x4 nv = *(const u32x4*)((const bf16_t*)(ws + WS_QKPRE) + (size_t)tl * 2048 + col);
            const u32x4 ov = *(const u32x4*)((const bf16_t*)(ws + WS_SIGO) + (size_t)tl * 2048 + col);
            const float inv = 1.0f / fmaxf(fabsf(den4[j]), __expf(-mt4[j]));
            float hv[8] = {bf_lo(nv.x) * inv, bf_hi(nv.x) * inv, bf_lo(nv.y) * inv, bf_hi(nv.y) * inv, bf_lo(nv.z) * inv, bf_hi(nv.z) * inv, bf_lo(nv.w) * inv, bf_hi(nv.w) * inv};
            float ss = 0.f;
#pragma unroll
            for (int e = 0; e < 8; ++e) ss += hv[e] * hv[e];
            const float r = rsqrtf(wave_sum(ss, lane) * (1.f / 512.f) + EPS);
            const f32x4 g0 = mg0[j], g1 = mg1[j];
            const float og[8] = {bf_lo(ov.x), bf_hi(ov.x), bf_lo(ov.y), bf_hi(ov.y), bf_lo(ov.z), bf_hi(ov.z), bf_lo(ov.w), bf_hi(ov.w)};
            float y[8];
#pragma unroll
            for (int e = 0; e < 8; ++e) y[e] = og[e] * hv[e] * r * (e < 4 ? g0[e] : g1[e - 4]);
            u32x4 o; o.x = pk2(y[0], y[1]); o.y = pk2(y[2], y[3]); o.z = pk2(y[4], y[5]); o.w = pk2(y[6], y[7]);
            *(u32x4*)((bf16_t*)(ws + WS_V) + (size_t)tl * 2048 + col) = o;
        }
        {
            const int col = lane * 16;
            const u32x4 n0 = *(const u32x4*)((const bf16_t*)(ws + WS_GQ) + (size_t)tl * 1024 + col), n1 = *(const u32x4*)((const bf16_t*)(ws + WS_GQ) + (size_t)tl * 1024 + col + 8);
            const u32x4 s0 = *(const u32x4*)((const bf16_t*)(ws + WS_SGG) + (size_t)tl * 1024 + col), s1 = *(const u32x4*)((const bf16_t*)(ws + WS_SGG) + (size_t)tl * 1024 + col + 8);
            float ov[16] = {bf_lo(n0.x), bf_hi(n0.x), bf_lo(n0.y), bf_hi(n0.y), bf_lo(n0.z), bf_hi(n0.z), bf_lo(n0.w), bf_hi(n0.w), bf_lo(n1.x), bf_hi(n1.x), bf_lo(n1.y), bf_hi(n1.y), bf_lo(n1.z), bf_hi(n1.z), bf_lo(n1.w), bf_hi(n1.w)};
            const float sg[16] = {bf_lo(s0.x), bf_hi(s0.x), bf_lo(s0.y), bf_hi(s0.y), bf_lo(s0.z), bf_hi(s0.z), bf_lo(s0.w), bf_hi(s0.w), bf_lo(s1.x), bf_hi(s1.x), bf_lo(s1.y), bf_hi(s1.y), bf_lo(s1.z), bf_hi(s1.z), bf_lo(s1.w), bf_hi(s1.w)};
            float ss = 0.f;
#pragma unroll
            for (int e = 0; e < 16; ++e) ss += ov[e] * ov[e];
            ss += DPP_(ss, 0xB1); ss += DPP_(ss, 0x4E); ss += DPP_(ss, 0x141);
            const float r = rsqrtf(ss * (1.f / 128.f) + EPS);
            float y[16];
#pragma unroll
            for (int e = 0; e < 16; ++e) y[e] = ov[e] * r * gg4[e >> 2][e & 3] * sg[e];
            u32x4 o; o.x = pk2(y[0], y[1]); o.y = pk2(y[2], y[3]); o.z = pk2(y[4], y[5]); o.w = pk2(y[6], y[7]);
            *(u32x4*)((bf16_t*)(ws + WS_GI) + (size_t)tl * 1024 + col) = o;
            o.x = pk2(y[8], y[9]); o.y = pk2(y[10], y[11]); o.z = pk2(y[12], y[13]); o.w = pk2(y[14], y[15]);
            *(u32x4*)((bf16_t*)(ws + WS_GI) + (size_t)tl * 1024 + col + 8) = o;
        }
    }
}


#define XB_TMO      128
#define XB_XCNT(j)  (256  + 64 * (j))
#define XB_XSUB(j)  (1280 + 64 * (j))
#define XB_XGEN(j)  (2304 + 64 * (j))
#define XB_TOP      3328
#define XB_TOPGEN   3392
#define XB_SPIN_CAP (1u << 22)
constexpr int CW_BAR = 4096;
constexpr int LDS_BARST = LDS_BYTES - 64;
__device__ __forceinline__ unsigned xb_ld(unsigned* p)              { return __hip_atomic_load(p, __ATOMIC_RELAXED, __HIP_MEMORY_SCOPE_AGENT); }
__device__ __forceinline__ unsigned xb_add(unsigned* p, unsigned v) { return __hip_atomic_fetch_add(p, v, __ATOMIC_RELAXED, __HIP_MEMORY_SCOPE_AGENT); }
__device__ __forceinline__ unsigned xb_xcc_id() { return (unsigned)__builtin_amdgcn_s_getreg((3 << 11) | 20) & 0xFu; }
#define XB_SPIN(cond, bar) do { unsigned _sp = 0; while (cond) { __builtin_amdgcn_s_sleep(1); \
    if ((++_sp & 255u) == 0u) { if (xb_ld(&(bar)[XB_TMO])) break; if (_sp > XB_SPIN_CAP) { atomicAdd(&(bar)[XB_TMO], 1u); break; } } } } while (0)
__device__ __forceinline__ void xcd_barrier_post(unsigned* bar, volatile LAS unsigned* st) { if (tid_() == 0) st[2] = xb_add(&bar[XB_XCNT(xb_xcc_id())], 1u); }
__device__ __forceinline__ void xcd_barrier_complete(unsigned* bar, unsigned x, unsigned& nloc, unsigned& nx) {
    const unsigned G = gridDim.x;
    unsigned sum, cnt, mine, sp = 0u;
    for (;;) {
        sum = 0u; cnt = 0u; mine = 0u;
#pragma unroll
        for (unsigned j = 0; j < 16; ++j) { const unsigned c = xb_ld(&bar[XB_XCNT(j)]); sum += c; cnt += (c > 0u) ? 1u : 0u; mine = (j == x) ? c : mine; }
        if (sum == G) break;
        __builtin_amdgcn_s_sleep(1);
        if ((++sp & 255u) == 0u) { if (xb_ld(&bar[XB_TMO])) break; if (sp > XB_SPIN_CAP) { atomicAdd(&bar[XB_TMO], 1u); break; } }
    }
    nloc = mine > 0u ? mine : 1u; nx = cnt > 0u ? cnt : 1u;
}
__device__ __forceinline__ void xcd_barrier(unsigned* bar, volatile LAS unsigned* st) {
    asm volatile("s_waitcnt vmcnt(0)" ::: "memory");
    __syncthreads();
    if (tid_() == 0) {
        const unsigned x = xb_xcc_id();
        __builtin_amdgcn_s_waitcnt(0);
        unsigned nloc = st[0], nx = st[1];
        if (nloc == 0u) { xcd_barrier_complete(bar, x, nloc, nx); st[0] = nloc; st[1] = nx; }
        const unsigned old = xb_add(&bar[XB_XSUB(x)], 1u);
        const unsigned gen = old / nloc;
        if (old + 1u == (gen + 1u) * nloc) {
            __builtin_amdgcn_fence(__ATOMIC_RELEASE, "agent");
            asm volatile("s_waitcnt vmcnt(0)" ::: "memory");
            const unsigned og = xb_add(&bar[XB_TOP], 1u);
            const unsigned tg = og / nx;
            if (og + 1u == (tg + 1u) * nx) xb_add(&bar[XB_TOPGEN], 1u);
            else XB_SPIN(xb_ld(&bar[XB_TOPGEN]) == tg, bar);
            __builtin_amdgcn_fence(__ATOMIC_ACQUIRE, "agent");
            xb_add(&bar[XB_XGEN(x)], 1u);
            asm volatile("s_waitcnt vmcnt(0)" ::: "memory");
        } else {
            XB_SPIN(xb_ld(&bar[XB_XGEN(x)]) == gen, bar);
            __builtin_amdgcn_fence(__ATOMIC_ACQUIRE, "agent");
            asm volatile("s_waitcnt vmcnt(0)" ::: "memory");
        }
    }
    __syncthreads();
}

__device__ __forceinline__ void phase_p8(const DArgs& a, int vcu, int G) {
    const int tid = tid_(), lane = tid & 63, wave = tid >> 6;
    const int gw = vcu * NWAVES + wave, NGW = G * NWAVES;
    GAS unsigned char* ws = a.ws;
    f32x4 g2[4];
#pragma unroll
    for (int j = 0; j < 4; ++j) g2[j] = ((const f32x4*)a.norm2_g)[64 * j + lane];
    for (int m = gw; m < T; m += NGW) {
        const f32x4* xr = (const f32x4*)(a.out + (size_t)m * D) + lane;
        f32x4 v[4]; float s = 0.f;
#pragma unroll
        for (int j = 0; j < 4; ++j) { v[j] = xr[64 * j]; s += (v[j][0] * v[j][0] + v[j][1] * v[j][1]) + (v[j][2] * v[j][2] + v[j][3] * v[j][3]); }
        const float rstd = rsqrtf(wave_sum(s, lane) * (1.f / D) + EPS);
        unsigned long long* o8 = (unsigned long long*)((bf16_t*)(ws + WS_XN) + (size_t)m * D) + lane;
#pragma unroll
        for (int j = 0; j < 4; ++j) { v[j] = v[j] * rstd * g2[j]; o8[64 * j] = (unsigned long long)pk2(v[j][0], v[j][1]) | ((unsigned long long)pk2(v[j][2], v[j][3]) << 32); }
    }
    {
        const float mu = __builtin_bit_cast(float, ((const GAS unsigned*)(ws + WS_CTL))[CW_TMAX]), mv = __builtin_bit_cast(float, ((const GAS unsigned*)(ws + WS_CTL))[CW_TMAX + 1]);
        const float su = mu > 0.f ? 448.0f / mu : 1.0f, sv = mv > 0.f ? 448.0f / mv : 1.0f;
        if (vcu == 0 && tid == 0) { ((GAS float*)(ws + WS_USC))[0] = 1.0f / su; ((GAS float*)(ws + WS_USC))[1] = 1.0f / sv; }
        for (size_t i = (size_t)vcu * NTHR + tid; i < (size_t)16384 * 1024 / 8; i += (size_t)G * NTHR) {
            const f32x4 u0 = ((const GAS f32x4*)a.u_emb)[2 * i], u1 = ((const GAS f32x4*)a.u_emb)[2 * i + 1];
            const f32x4 v0 = ((const GAS f32x4*)a.v_emb)[2 * i], v1 = ((const GAS f32x4*)a.v_emb)[2 * i + 1];
            u32x2 o; int p;
            p = __builtin_amdgcn_cvt_pk_fp8_f32(u0[0] * su, u0[1] * su, 0, false); p = __builtin_amdgcn_cvt_pk_fp8_f32(u0[2] * su, u0[3] * su, p, true); o.x = (unsigned)p;
            p = __builtin_amdgcn_cvt_pk_fp8_f32(u1[0] * su, u1[1] * su, 0, false); p = __builtin_amdgcn_cvt_pk_fp8_f32(u1[2] * su, u1[3] * su, p, true); o.y = (unsigned)p;
            ((GAS u32x2*)(ws + WS_UB))[i] = o;
            p = __builtin_amdgcn_cvt_pk_fp8_f32(v0[0] * sv, v0[1] * sv, 0, false); p = __builtin_amdgcn_cvt_pk_fp8_f32(v0[2] * sv, v0[3] * sv, p, true); o.x = (unsigned)p;
            p = __builtin_amdgcn_cvt_pk_fp8_f32(v1[0] * sv, v1[1] * sv, 0, false); p = __builtin_amdgcn_cvt_pk_fp8_f32(v1[2] * sv, v1[3] * sv, p, true); o.y = (unsigned)p;
            ((GAS u32x2*)(ws + WS_VB))[i] = o;
        }
    }
}

__device__ __forceinline__ unsigned f2ord(float f) { const unsigned u = __builtin_bit_cast(unsigned, f); return (u & 0x80000000u) ? ~u : (u | 0x80000000u); }
__device__ __forceinline__ float ord2f(unsigned k) { const unsigned u = (k & 0x80000000u) ? (k & 0x7fffffffu) : ~k; return __builtin_bit_cast(float, u); }
__device__ __forceinline__ unsigned umax_(unsigned a, unsigned b) { return a > b ? a : b; }
__device__ __forceinline__ unsigned shxu(unsigned v, int o, int lane) { return (unsigned)__builtin_amdgcn_ds_bpermute((lane ^ o) << 2, (int)v); }

__device__ __forceinline__ void phase_topk(const DArgs& a, LAS unsigned char* lds, int bx, int G) {
    const int tid = tid_(), lane = tid & 63, wave = __builtin_amdgcn_readfirstlane(tid >> 6), fr = lane & 15, fq = lane >> 4;
    GAS unsigned char* ws = a.ws;
    const int h = bx & 7;
    LAS unsigned char* KY = lds;
    LAS unsigned char* QL = lds + 2 * 128 * PS_PITCH;
    LAS unsigned* TOP = (LAS unsigned*)(lds + 2 * 128 * PS_PITCH + 64 * PQ_PITCH);
#pragma unroll
    for (int i = 0; i < 8; ++i) { const int idx = tid + 512 * i, row = idx >> 4, ch = idx & 15;
        *(LAS u32x4*)(KY + row * PS_PITCH + ch * 16) = *(const u32x4*)((const bf16_t*)(ws + WS_SK) + ((size_t)h * 256 + row) * 128 + ch * 8); }
    const int ntile = T / 64;
    for (int tile = bx >> 3; tile < ntile; tile += (G >> 3)) {
        const size_t t0 = (size_t)tile * 64;
        __syncthreads();
#pragma unroll
        for (int i = 0; i < 4; ++i) { const int idx = tid + 512 * i, row = idx >> 5, ch = idx & 31;
            *(LAS u32x4*)(QL + row * PQ_PITCH + ch * 16) = *(const u32x4*)((const bf16_t*)(ws + WS_QP) + (t0 + row) * 2048 + h * 256 + ch * 8); }
        __syncthreads();
        {
            const int mt = wave & 3, p = wave >> 2;
            unsigned key[32];
#pragma unroll
            for (int nt = 0; nt < 8; ++nt) { f32x4 acc = (f32x4){0.f, 0.f, 0.f, 0.f};
#pragma unroll
                for (int ks = 0; ks < 4; ++ks) acc = MFMA16(lfrag(KY + p * 128 * PS_PITCH, PS_PITCH, nt * 16 + fr, ks * 32, fq), lfrag(QL, PQ_PITCH, mt * 16 + fr, p * 128 + ks * 32, fq), acc);
#pragma unroll
                for (int j = 0; j < 4; ++j) { const int n = nt * 16 + 4 * fq + j; key[nt * 4 + j] = (f2ord(acc[j]) & ~127u) | (unsigned)(127 - n); } }
#pragma unroll 1
            for (int k = 0; k < 16; ++k) {
                unsigned m = key[0];
#pragma unroll
                for (int e = 1; e < 32; ++e) m = umax_(m, key[e]);
                m = umax_(m, (unsigned)SWZI_(m, 0x401F)); m = umax_(m, xor32u_(m, lane >= 32));
#pragma unroll
                for (int e = 0; e < 32; ++e) key[e] = (key[e] == m) ? 0u : key[e];
                if (fq == (k & 3)) TOP[(p * 64 + mt * 16 + fr) * 16 + k] = m;
            }
        }
        __syncthreads();
        {
            const int t = tid >> 3, sub = tid & 7;
            unsigned ck[7];
#pragma unroll
            for (int e = 0; e < 7; ++e) {
                const int ci = sub + 8 * e;
                int i = 0, base = 0; bool ok = ci < 50;
                if (ci >= 42) { i = 8 + (ci - 42); base = ci; } else if (ci >= 40) { i = 7; base = 40; } else if (ci >= 38) { i = 6; base = 38; } else if (ci >= 36) { i = 5; base = 36; }
                else if (ci >= 33) { i = 4; base = 33; } else if (ci >= 29) { i = 3; base = 29; } else if (ci >= 24) { i = 2; base = 24; } else if (ci >= 16) { i = 1; base = 16; }
                const int j = ci - base;
                unsigned kk = 0u;
                if (ok) { const float s0 = ord2f(TOP[(0 * 64 + t) * 16 + i] & ~127u), s1 = ord2f(TOP[(1 * 64 + t) * 16 + j] & ~127u);
                    kk = (f2ord(s0 + s1) & ~255u) | (unsigned)(255 - (i * 16 + j)); }
                ck[e] = kk;
            }
            unsigned w0 = 0u, w1 = 0u;
#pragma unroll 1
            for (int k = 0; k < 16; ++k) {
                unsigned m = ck[0];
#pragma unroll
                for (int e = 1; e < 7; ++e) m = umax_(m, ck[e]);
                m = umax_(m, (unsigned)DPPI_(m, 0xB1)); m = umax_(m, (unsigned)DPPI_(m, 0x4E)); m = umax_(m, (unsigned)DPPI_(m, 0x141));
#pragma unroll
                for (int e = 0; e < 7; ++e) ck[e] = (ck[e] == m) ? 0u : ck[e];
                if (k == sub) w0 = m; if (k == sub + 8) w1 = m;
            }
            const int f0 = 255 - (int)(w0 & 255u), f1 = 255 - (int)(w1 & 255u);
            const float sc0 = ord2f(w0 & ~255u), sc1 = ord2f(w1 & ~255u);
            float mx = fmaxf(sc0, sc1); mx = fmaxf(mx, DPP_(mx, 0xB1)); mx = fmaxf(mx, DPP_(mx, 0x4E)); mx = fmaxf(mx, DPP_(mx, 0x141));
            const float e0 = __expf(sc0 - mx), e1 = __expf(sc1 - mx);
            float sm = e0 + e1; sm += DPP_(sm, 0xB1); sm += DPP_(sm, 0x4E); sm += DPP_(sm, 0x141);
            const float inv = 1.0f / sm;
            const int i0 = 127 - (int)(TOP[(0 * 64 + t) * 16 + (f0 >> 4)] & 127u), j0 = 127 - (int)(TOP[(1 * 64 + t) * 16 + (f0 & 15)] & 127u);
            const int i1 = 127 - (int)(TOP[(0 * 64 + t) * 16 + (f1 >> 4)] & 127u), j1 = 127 - (int)(TOP[(1 * 64 + t) * 16 + (f1 & 15)] & 127u);
            int* ei = (int*)(ws + WS_EIDX) + ((t0 + t) * 8 + h) * 16; float* gp = (float*)(ws + WS_GATE) + ((t0 + t) * 8 + h) * 16;
            ei[sub] = i0 * 128 + j0; ei[sub + 8] = i1 * 128 + j1; gp[sub] = e0 * inv; gp[sub + 8] = e1 * inv;
        }
    }
    __syncthreads();
}

__device__ __forceinline__ void ins16(float (&v)[16], int (&id)[16], float x, int n) {
    if (x > v[15]) { v[15] = x; id[15] = n;
#pragma unroll
        for (int i = 15; i >= 1; --i) { if (v[i] > v[i - 1]) { const float tv = v[i]; v[i] = v[i - 1]; v[i - 1] = tv; const int ti = id[i]; id[i] = id[i - 1]; id[i - 1] = ti; } } }
}
__device__ __forceinline__ void phase_topk_ref(const DArgs& a, int vcu, int G) {
    const int tid = tid_();
    GAS unsigned char* ws = a.ws;
    const int gt = vcu * NTHR + tid, NGT = G * NTHR;
    for (int pair = gt; pair < T * 8; pair += NGT) {
        const int t = pair >> 3, h = pair & 7;
        float sv[2][16]; int si[2][16];
#pragma unroll
        for (int p = 0; p < 2; ++p) {
#pragma unroll
            for (int i = 0; i < 16; ++i) { sv[p][i] = -INFINITY; si[p][i] = 0; }
            const bf16_t* qp = (const bf16_t*)(ws + WS_QP) + (size_t)t * 2048 + h * 256 + p * 128;
            for (int n = 0; n < 128; ++n) {
                const bf16_t* kp = (const bf16_t*)(ws + WS_SK) + ((size_t)(h * 2 + p) * 128 + n) * 128;
                float s = 0.f;
                for (int c = 0; c < 128; c += 8) { const u32x4 qv = *(const u32x4*)(qp + c), kv = *(const u32x4*)(kp + c);
                    s += bf_lo(qv.x) * bf_lo(kv.x) + bf_hi(qv.x) * bf_hi(kv.x) + bf_lo(qv.y) * bf_lo(kv.y) + bf_hi(qv.y) * bf_hi(kv.y)
                       + bf_lo(qv.z) * bf_lo(kv.z) + bf_hi(qv.z) * bf_hi(kv.z) + bf_lo(qv.w) * bf_lo(kv.w) + bf_hi(qv.w) * bf_hi(kv.w); }
                ins16(sv[p], si[p], s, n);
            }
        }
        float tv[16]; int ti[16];
#pragma unroll
        for (int i = 0; i < 16; ++i) { tv[i] = -INFINITY; ti[i] = 0; }
#pragma unroll
        for (int i = 0; i < 16; ++i)
#pragma unroll
            for (int j = 0; j < 16; ++j) ins16(tv, ti, sv[0][i] + sv[1][j], i * 16 + j);
        float sm = 0.f, ex[16];
#pragma unroll
        for (int k = 0; k < 16; ++k) { ex[k] = __expf(tv[k] - tv[0]); sm += ex[k]; }
        int* ei = (int*)(ws + WS_EIDX) + (size_t)pair * 16; float* gp = (float*)(ws + WS_GATE) + (size_t)pair * 16;
#pragma unroll
        for (int k = 0; k < 16; ++k) {
            int e0 = 0, e1 = 0;
#pragma unroll
            for (int i = 0; i < 16; ++i) { e0 = ((ti[k] >> 4) == i) ? si[0][i] : e0; e1 = ((ti[k] & 15) == i) ? si[1][i] : e1; }
            ei[k] = e0 * 128 + e1; gp[k] = ex[k] / sm; }
    }
}

#define FP8LO(w) __builtin_amdgcn_cvt_pk_f32_fp8((int)(w), false)
#define FP8HI(w) __builtin_amdgcn_cvt_pk_f32_fp8((int)(w), true)
__device__ __forceinline__ float dot16_fp8(const u32x4 r, const float (&x)[16]) {
    float c = 0.f;
#pragma unroll
    for (int j = 0; j < 4; ++j) { const f32x2 lo = FP8LO(r[j]), hi = FP8HI(r[j]); c += lo[0] * x[4 * j] + lo[1] * x[4 * j + 1] + hi[0] * x[4 * j + 2] + hi[1] * x[4 * j + 3]; }
    return c;
}
__device__ __forceinline__ float gelu_erf(float d) {
    const float ad = fabsf(d), t = __builtin_amdgcn_rcpf(ad * 0.2316418882f + 1.0f);
    float q = t * 0.5307027145f + (-0.7265760135f); q = q * t + 0.7107068705f; q = q * t + (-0.142248368f); q = q * t + 0.127414796f; q = q * t;
    const float m = d * (q * __builtin_amdgcn_exp2f(d * d * (-0.72134752044f)));
    return d < 0.f ? m : d - m;
}
__device__ __forceinline__ float bperm(float v, int srclane) { return __builtin_bit_cast(float, __builtin_amdgcn_ds_bpermute(srclane << 2, __builtin_bit_cast(int, v))); }
#define SWZ_(v, pat) __builtin_bit_cast(float, __builtin_amdgcn_ds_swizzle(__builtin_bit_cast(int, (v)), (pat)))
__device__ __forceinline__ float rs32_(float a, float b) {
#if defined(__HIP_DEVICE_COMPILE__)
    asm volatile("s_nop 1\n\tv_permlane32_swap_b32 %0, %1" : "+v"(a), "+v"(b));
#endif
    return a + b;
}
__device__ __forceinline__ float rs16_(float a, float b) {
#if defined(__HIP_DEVICE_COMPILE__)
    asm volatile("s_nop 1\n\tv_permlane16_swap_b32 %0, %1" : "+v"(a), "+v"(b));
#endif
    return a + b;
}
__device__ __forceinline__ float rs8_(float a, float b, bool bit3) {
    const float send = bit3 ? a : b, keep = bit3 ? b : a;
    return keep + DPP_(send, 0x128);
}
__device__ __forceinline__ float xor32_(float v, bool hi) {
#if defined(__HIP_DEVICE_COMPILE__)
    const auto r = __builtin_amdgcn_permlane32_swap(__builtin_bit_cast(unsigned, v), __builtin_bit_cast(unsigned, v), false, false);
    return __builtin_bit_cast(float, hi ? r[0] : r[1]);
#else
    (void)hi; return v;
#endif
}
__device__ __forceinline__ float reduce8(const float (&p)[8], int lane) {
    float q4[4], q2[2];
    const bool b5 = lane & 32, b4 = lane & 16, b3 = lane & 8;
#pragma unroll
    for (int i = 0; i < 4; ++i) { const float send = b5 ? p[i] : p[i + 4], keep = b5 ? p[i + 4] : p[i]; q4[i] = keep + xor32_(send, b5); }
#pragma unroll
    for (int i = 0; i < 2; ++i) { const float send = b4 ? q4[i] : q4[i + 2], keep = b4 ? q4[i + 2] : q4[i]; q2[i] = keep + SWZ_(send, 0x401F); }
    const float send = b3 ? q2[0] : q2[1], keep = b3 ? q2[1] : q2[0];
    float q1 = keep + SWZ_(send, 0x201F);
    q1 += DPP_(q1, 0xB1); q1 += DPP_(q1, 0x4E); q1 += DPP_(q1, 0x141);
    return q1;
}
__device__ __forceinline__ void phase_udots(const DArgs& a, LAS unsigned char* lds) {
    const int tid = tid_(), lane = tid & 63, wave = __builtin_amdgcn_readfirstlane(tid >> 6);
    GAS unsigned char* ws = a.ws;
    volatile LAS unsigned* bst = (volatile LAS unsigned*)(lds + LDS_BARST);
    const int nloc = (int)bst[0], nx = (int)bst[1], rank = (int)bst[2];
    unsigned* bar = (unsigned*)(ws + WS_CTL) + CW_BAR;
    const unsigned myx = xb_xcc_id();
    int q = 0;
    for (unsigned j = 0; j < 16; ++j) { const unsigned c = xb_ld(&bar[XB_XCNT(j)]); if (c > 0u && j < myx) ++q; }
    LAS int* LE = (LAS int*)(lds + wave * 2048);
    LAS int* LP = LE + 128; LAS float* LG = (LAS float*)(LE + 256);
    const GAS unsigned char* UB = ws + WS_UB;
    const int g8 = lane >> 3;
    const float usc = ((const GAS float*)(ws + WS_USC))[0], vsc = ((const GAS float*)(ws + WS_USC))[1];
    for (int s = q; s < 8; s += nx) {
        int tok = rank * 8 + wave;
        u32x4 xq0 = (u32x4){0u, 0u, 0u, 0u}, xq1 = xq0; u32x2 e2 = (u32x2){0u, 0u}; f32x2 g2 = (f32x2){0.f, 0.f};
#define U_INFO(t_) do { xq0 = *(const u32x4*)((const GAS bf16_t*)(ws + WS_XN) + (size_t)(t_) * D + lane * 16); xq1 = *(const u32x4*)((const GAS bf16_t*)(ws + WS_XN) + (size_t)(t_) * D + lane * 16 + 8); \
        e2 = *(const u32x2*)((const GAS int*)(ws + WS_EIDX) + (size_t)(t_) * 128 + 2 * lane); g2 = *(const f32x2*)((const GAS float*)(ws + WS_GATE) + (size_t)(t_) * 128 + 2 * lane); } while (0)
        if (tok < T) U_INFO(tok);
        for (; tok < T; tok += nloc * 8) {
            const bool in0 = (int)(e2.x >> 11) == s, in1 = (int)(e2.y >> 11) == s;
            const unsigned long long m0 = __ballot(in0), m1 = __ballot(in1);
            const unsigned long long lt = (1ull << lane) - 1ull;
            const int n0 = __popcll(m0), n = n0 + __popcll(m1);
            if (in0) { const int pos = __popcll(m0 & lt); LE[pos] = (int)e2.x; LP[pos] = 2 * lane; LG[pos] = g2[0]; }
            if (in1) { const int pos = n0 + __popcll(m1 & lt); LE[pos] = (int)e2.y; LP[pos] = 2 * lane + 1; LG[pos] = g2[1]; }
            const float xf[16] = {bf_lo(xq0.x), bf_hi(xq0.x), bf_lo(xq0.y), bf_hi(xq0.y), bf_lo(xq0.z), bf_hi(xq0.z), bf_lo(xq0.w), bf_hi(xq0.w),
                                  bf_lo(xq1.x), bf_hi(xq1.x), bf_lo(xq1.y), bf_hi(xq1.y), bf_lo(xq1.z), bf_hi(xq1.z), bf_lo(xq1.w), bf_hi(xq1.w)};
            asm volatile("s_waitcnt lgkmcnt(0)" ::: "memory");
            u32x4 R0[8], R1[8], R2[8];
#define U_ISSUE(R_, g0_) do { _Pragma("unroll") for (int k = 0; k < 8; ++k) { const int slot_ = ((g0_) + k < n) ? (g0_) + k : n - 1; const int e_ = LE[slot_]; R_[k] = *(const u32x4*)(UB + (size_t)e_ * 1024 + lane * 16); } } while (0)
#define U_DOTS(R_, g0_) do { float pp_[8]; _Pragma("unroll") for (int k = 0; k < 8; ++k) pp_[k] = dot16_fp8(R_[k], xf); const float dsum_ = reduce8(pp_, lane); const int slot_ = (g0_) + g8; \
            if (slot_ < n && (lane & 7) == 0) { const float d_ = dsum_ * usc; \
                ((GAS float*)(ws + WS_PW))[(size_t)tok * 128 + LP[slot_]] = 0.5f * d_ * (1.0f + erff(d_ * 0.70710678118654752f)) * LG[slot_] * vsc; } } while (0)
            if (n > 0) U_ISSUE(R0, 0);
            if (n > 8) U_ISSUE(R1, 8);
            if (n > 16) U_ISSUE(R2, 16);
            const int tokN = tok + nloc * 8;
            if (tokN < T) U_INFO(tokN);
            if (n > 0) U_DOTS(R0, 0);
            if (n > 8) U_DOTS(R1, 8);
            if (n > 16) U_DOTS(R2, 16);
            for (int g0 = 24; g0 < n; g0 += 8) { U_ISSUE(R0, g0); U_DOTS(R0, g0); }
            asm volatile("s_waitcnt lgkmcnt(0)" ::: "memory");
        }
#undef U_INFO
#undef U_ISSUE
#undef U_DOTS
    }
}

struct XcdSlice { int nloc, nx, rank, q; };
__device__ __forceinline__ XcdSlice xcd_slice_setup(const DArgs& a, LAS unsigned char* lds) {
    volatile LAS unsigned* bst = (volatile LAS unsigned*)(lds + LDS_BARST);
    XcdSlice x; x.nloc = __builtin_amdgcn_readfirstlane((int)bst[0]); x.nx = __builtin_amdgcn_readfirstlane((int)bst[1]); x.rank = __builtin_amdgcn_readfirstlane((int)bst[2]);
    unsigned* bar = (unsigned*)(a.ws + WS_CTL) + CW_BAR; const unsigned myx = xb_xcc_id();
    x.q = 0; for (unsigned j = 0; j < 16; ++j) { const unsigned c = xb_ld(&bar[XB_XCNT(j)]); if (c > 0u && j < myx) ++x.q; }
    x.q = __builtin_amdgcn_readfirstlane(x.q);
    return x;
}
__device__ __forceinline__ void phase_ua(const DArgs& a, LAS unsigned char* lds) {
    const int tid = tid_(), lane = tid & 63, wave = __builtin_amdgcn_readfirstlane(tid >> 6), k = lane >> 3, c = lane & 7;
    GAS unsigned char* ws = a.ws;
    const XcdSlice X = xcd_slice_setup(a, lds);
    const int tstride = X.nloc * 8;
    for (int sl = X.q; sl < 8; sl += X.nx) {
        const GAS unsigned char* UBs = ws + WS_UB + sl * 128;
        const unsigned coff = (unsigned)c * 16u;
        GAS float* PU = (GAS float*)(ws + WS_PARTU) + (size_t)sl * T * 128;
        u32x4 ev[4], RA[16], RB[16], xa0, xa1, xb0, xb1;
#define A_TOK(t_) ((t_) < T ? (t_) : T - 1)
#define A_INFO(ev_, t_) do { const int tq_ = A_TOK(t_); _Pragma("unroll") for (int j_ = 0; j_ < 4; ++j_) ev_[j_] = *(const GAS u32x4*)(ws + WS_EIDX + (size_t)tq_ * 512 + (unsigned)(64 * k + 16 * j_)); } while (0)
#define A_ISSUE(R_, x0_, x1_, ev_, t_) do { const int tq_ = A_TOK(t_); _Pragma("unroll") for (int g_ = 0; g_ < 16; ++g_) R_[g_] = *(const GAS u32x4*)(UBs + (ev_[g_ >> 2][g_ & 3] * 1024u + coff)); \
        x0_ = *(const GAS u32x4*)(ws + WS_XN + (size_t)tq_ * (D * 2) + sl * 256 + (unsigned)(c * 32)); x1_ = *(const GAS u32x4*)(ws + WS_XN + (size_t)tq_ * (D * 2) + sl * 256 + (unsigned)(c * 32 + 16)); } while (0)
#define A_DOTS(R_, x0_, x1_, t_) do { \
        const float xf_[16] = {bf_lo(x0_.x), bf_hi(x0_.x), bf_lo(x0_.y), bf_hi(x0_.y), bf_lo(x0_.z), bf_hi(x0_.z), bf_lo(x0_.w), bf_hi(x0_.w), \
                               bf_lo(x1_.x), bf_hi(x1_.x), bf_lo(x1_.y), bf_hi(x1_.y), bf_lo(x1_.z), bf_hi(x1_.z), bf_lo(x1_.w), bf_hi(x1_.w)}; \
        f32x2 res_ = (f32x2){0.f, 0.f}; \
        _Pragma("unroll") for (int g_ = 0; g_ < 16; ++g_) { float d_ = dot16_fp8(R_[g_], xf_); d_ += DPP_(d_, 0xB1); d_ += DPP_(d_, 0x4E); d_ += DPP_(d_, 0x141); \
            if (c == (g_ >> 1)) res_[g_ & 1] = d_;            \
            if (g_ & 1) __builtin_amdgcn_sched_barrier(0); } \
        if ((t_) < T) *(GAS f32x2*)((GAS unsigned char*)PU + (size_t)(t_) * 512 + (unsigned)(8 * lane)) = res_; } while (0)
        const int n0 = X.rank * 8 + wave;
        A_INFO(ev, n0);
        __builtin_amdgcn_sched_barrier(0);
        A_ISSUE(RA, xa0, xa1, ev, n0);
        __builtin_amdgcn_sched_barrier(0);
        A_INFO(ev, n0 + tstride);
        __builtin_amdgcn_sched_barrier(0);
#pragma unroll 1
        for (int n = n0; n < T; n += 2 * tstride) {
            A_ISSUE(RB, xb0, xb1, ev, n + tstride);
            __builtin_amdgcn_sched_barrier(0);
            A_INFO(ev, n + 2 * tstride);
            __builtin_amdgcn_sched_barrier(0);
            A_DOTS(RA, xa0, xa1, n);
            __builtin_amdgcn_sched_barrier(0);
            A_ISSUE(RA, xa0, xa1, ev, n + 2 * tstride);
            __builtin_amdgcn_sched_barrier(0);
            A_INFO(ev, n + 3 * tstride);
            __builtin_amdgcn_sched_barrier(0);
            A_DOTS(RB, xb0, xb1, n + tstride);
            __builtin_amdgcn_sched_barrier(0);
        }
#undef A_TOK
#undef A_INFO
#undef A_ISSUE
#undef A_DOTS
    }
}
__device__ __forceinline__ void phase_ua2(const DArgs& a, int vcu, int G) {
    const int tid = tid_();
    GAS unsigned char* ws = a.ws;
    const float usc = ((const GAS float*)(ws + WS_USC))[0], vsc = ((const GAS float*)(ws + WS_USC))[1];
    const GAS float* PU = (const GAS float*)(ws + WS_PARTU);
    for (size_t i = (size_t)vcu * NTHR + tid; i < (size_t)T * 128 / 4; i += (size_t)G * NTHR) {
        f32x4 d = (f32x4){0.f, 0.f, 0.f, 0.f};
#pragma unroll
        for (int sl = 0; sl < 8; ++sl) d += ((const GAS f32x4*)(PU + (size_t)sl * T * 128))[i];
        const f32x4 gt = ((const GAS f32x4*)(ws + WS_GATE))[i];
        f32x4 w;
#pragma unroll
        for (int e = 0; e < 4; ++e) w[e] = gelu_erf(d[e] * usc) * gt[e] * vsc;
        ((GAS f32x4*)(ws + WS_PW))[i] = w;
    }
}
__device__ __forceinline__ void phase_vb(const DArgs& a, LAS unsigned char* lds) {
    const int tid = tid_(), lane = tid & 63, wave = __builtin_amdgcn_readfirstlane(tid >> 6), k = lane >> 3, c = lane & 7;
    GAS unsigned char* ws = a.ws;
    const XcdSlice X = xcd_slice_setup(a, lds);
    const int tstride = X.nloc * 8;
    const bool bit3 = (lane & 8) != 0;
    for (int sl = X.q; sl < 8; sl += X.nx) {
        const GAS unsigned char* VBs = ws + WS_VB + sl * 128;
        const unsigned coff = (unsigned)c * 16u;
        const unsigned xoff = (unsigned)(sl * 128 + c * 16 + 2 * k) * 4u;
        u32x4 ev[4], RA[16], RB[16]; f32x4 wa[4], wb[4]; f32x2 xa, xb;
#define B_TOK(t_) ((t_) < T ? (t_) : T - 1)
#define B_INFO(t_) do { const int tq_ = B_TOK(t_); _Pragma("unroll") for (int j_ = 0; j_ < 4; ++j_) ev[j_] = *(const GAS u32x4*)(ws + WS_EIDX + (size_t)tq_ * 512 + (unsigned)(64 * k + 16 * j_)); } while (0)
#define B_ISSUE(R_, w_, x_, t_) do { const int tq_ = B_TOK(t_); _Pragma("unroll") for (int g_ = 0; g_ < 16; ++g_) R_[g_] = *(const GAS u32x4*)(VBs + (ev[g_ >> 2][g_ & 3] * 1024u + coff)); \
        _Pragma("unroll") for (int j_ = 0; j_ < 4; ++j_) w_[j_] = *(const GAS f32x4*)(ws + WS_PW + (size_t)tq_ * 512 + (unsigned)(64 * k + 16 * j_)); \
        x_ = *(const GAS f32x2*)((const GAS unsigned char*)a.out + (size_t)tq_ * (D * 4) + xoff); } while (0)
#define B_DOTS(R_, w_, x_, t_) do { \
        f32x2 acc2_[8]; _Pragma("unroll") for (int e_ = 0; e_ < 8; ++e_) acc2_[e_] = (f32x2){0.f, 0.f}; \
        _Pragma("unroll") for (int g_ = 0; g_ < 16; ++g_) { const float wk_ = w_[g_ >> 2][g_ & 3]; const f32x2 wp_ = (f32x2){wk_, wk_}; \
            _Pragma("unroll") for (int jj_ = 0; jj_ < 4; ++jj_) { acc2_[2 * jj_] += wp_ * FP8LO(R_[g_][jj_]); acc2_[2 * jj_ + 1] += wp_ * FP8HI(R_[g_][jj_]); } \
            if (g_ & 1) __builtin_amdgcn_sched_barrier(0); } \
        f32x2 w2_[4], x2_[2], y_; \
        _Pragma("unroll") for (int i_ = 0; i_ < 4; ++i_) { w2_[i_][0] = rs32_(acc2_[i_][0], acc2_[i_ + 4][0]); w2_[i_][1] = rs32_(acc2_[i_][1], acc2_[i_ + 4][1]); } \
        _Pragma("unroll") for (int i_ = 0; i_ < 2; ++i_) { x2_[i_][0] = rs16_(w2_[i_][0], w2_[i_ + 2][0]); x2_[i_][1] = rs16_(w2_[i_][1], w2_[i_ + 2][1]); } \
        y_[0] = rs8_(x2_[0][0], x2_[1][0], bit3) + x_[0]; y_[1] = rs8_(x2_[0][1], x2_[1][1], bit3) + x_[1]; \
        const float ss_ = wave_sum(y_[0] * y_[0] + y_[1] * y_[1], lane); \
        if ((t_) < T) { *(GAS f32x2*)((GAS unsigned char*)a.out + (size_t)(t_) * (D * 4) + xoff) = y_; \
            if (lane == 0) ((GAS float*)(ws + WS_SS))[(size_t)(t_) * 8 + sl] = ss_; } } while (0)
        const int n0 = X.rank * 8 + wave;
        B_INFO(n0);
        __builtin_amdgcn_sched_barrier(0);
        B_ISSUE(RA, wa, xa, n0);
        __builtin_amdgcn_sched_barrier(0);
        B_INFO(n0 + tstride);
        __builtin_amdgcn_sched_barrier(0);
#pragma unroll 1
        for (int n = n0; n < T; n += 2 * tstride) {
            B_ISSUE(RB, wb, xb, n + tstride);
            __builtin_amdgcn_sched_barrier(0);
            B_INFO(n + 2 * tstride);
            __builtin_amdgcn_sched_barrier(0);
            B_DOTS(RA, wa, xa, n);
            __builtin_amdgcn_sched_barrier(0);
            B_ISSUE(RA, wa, xa, n + 2 * tstride);
            __builtin_amdgcn_sched_barrier(0);
            B_INFO(n + 3 * tstride);
            __builtin_amdgcn_sched_barrier(0);
            B_DOTS(RB, wb, xb, n + tstride);
            __builtin_amdgcn_sched_barrier(0);
        }
#undef B_TOK
#undef B_INFO
#undef B_ISSUE
#undef B_DOTS
    }
}
__device__ __forceinline__ void phase_vc(const DArgs& a, int vcu, int G) {
    const int tid = tid_(), lane = tid & 63, wave = tid >> 6;
    const int gw = vcu * NWAVES + wave, NGW = G * NWAVES;
    GAS unsigned char* ws = a.ws;
    f32x4 gf[4];
#pragma unroll
    for (int j = 0; j < 4; ++j) gf[j] = ((const GAS f32x4*)a.final_g)[64 * j + lane];
    for (int m = gw; m < T; m += NGW) {
        const f32x4 s0 = *(const GAS f32x4*)((const GAS float*)(ws + WS_SS) + (size_t)m * 8), s1 = *(const GAS f32x4*)((const GAS float*)(ws + WS_SS) + (size_t)m * 8 + 4);
        const float rstd = rsqrtf(((s0[0] + s0[1]) + (s0[2] + s0[3]) + (s1[0] + s1[1]) + (s1[2] + s1[3])) * (1.f / D) + EPS);
        GAS f32x4* o = (GAS f32x4*)(a.out + (size_t)m * D) + lane;
#pragma unroll
        for (int j = 0; j < 4; ++j) o[64 * j] = o[64 * j] * rstd * gf[j];
    }
}

__device__ __forceinline__ void phase_final_plain(const DArgs& a, const float* src, int vcu, int G) {
    const int tid = tid_(), lane = tid & 63, wave = tid >> 6;
    const int gw = vcu * NWAVES + wave, NGW = G * NWAVES;
    f32x4 gf[4];
#pragma unroll
    for (int j = 0; j < 4; ++j) gf[j] = ((const f32x4*)a.final_g)[64 * j + lane];
    for (int m = gw; m < T; m += NGW) {
        const f32x4* xr = (const f32x4*)(src + (size_t)m * D) + lane;
        f32x4 v[4]; float s = 0.f;
#pragma unroll
        for (int j = 0; j < 4; ++j) { v[j] = xr[64 * j]; s += (v[j][0] * v[j][0] + v[j][1] * v[j][1]) + (v[j][2] * v[j][2] + v[j][3] * v[j][3]); }
        const float rstd = rsqrtf(wave_sum(s, lane) * (1.f / D) + EPS);
        f32x4* o = (f32x4*)(a.out + (size_t)m * D) + lane;
#pragma unroll
        for (int j = 0; j < 4; ++j) o[64 * j] = v[j] * rstd * gf[j];
    }
}


__device__ __forceinline__ DArgs load_args() {
    DArgs r;
#if defined(__HIP_DEVICE_COMPILE__)
    typedef const DArgs __attribute__((address_space(4))) KArgs;
    KArgs* p = (KArgs*)__builtin_amdgcn_kernarg_segment_ptr();
    asm volatile("" : "+s"(p));
    r.x = p->x; r.norm1_g = p->norm1_g; r.w_in = p->w_in; r.b_in = p->b_in; r.conv_w = p->conv_w; r.conv_b = p->conv_b; r.m_head_g = p->m_head_g; r.lb_table = p->lb_table;
    r.g_head_g = p->g_head_g; r.w_br_m = p->w_br_m; r.w_br_g = p->w_br_g; r.w_out = p->w_out; r.norm2_g = p->norm2_g; r.w_pq = p->w_pq; r.sub_keys = p->sub_keys;
    r.u_emb = p->u_emb; r.v_emb = p->v_emb; r.final_g = p->final_g; r.out = p->out; r.ws = p->ws;
#else
    r = DArgs{};
#endif
    return r;
}
__device__ __forceinline__ EpiPtrs make_ep(const DArgs& a, int round) {
    EpiPtrs ep; ep.biasp = (const GAS float*)(a.ws + WS_BIASP); ep.lb = (const GAS float*)(a.ws + WS_LB); ep.x = a.x; ep.out = a.out; ep.ws = a.ws; ep.round = round; return ep;
}
#define GRID_SYNC() do { const DArgs a_ = load_args(); xcd_barrier((unsigned*)(a_.ws + WS_CTL) + CW_BAR, (volatile LAS unsigned*)(lds + LDS_BARST)); } while (0)

__device__ __forceinline__ int bx_() { int t = blockIdx.x; asm volatile("" : "+s"(t)); return t; }
__device__ __forceinline__ int gd_() { int t = gridDim.x; asm volatile("" : "+s"(t)); return t; }
#define PH_BEGIN const DArgs a = load_args(); const int bx = bx_(), G = gd_(); const int vcu = (G % 8 == 0) ? (bx % 8) * (G / 8) + bx / 8 : bx; (void)vcu; (void)bx;

__global__ void __launch_bounds__(NTHR, 2) fwd_megakernel(Args a_unused) {
    extern __shared__ __attribute__((aligned(16))) unsigned char lds_raw[];
    LAS unsigned char* lds = (LAS unsigned char*)lds_raw;
    cg::grid_group grid = cg::this_grid();

    { const int t_ = tid_(); if (t_ < 16) ((LAS unsigned*)(lds + LDS_BARST))[t_] = 0u; __syncthreads();
      const DArgs a_ = load_args(); xcd_barrier_post((unsigned*)(a_.ws + WS_CTL) + CW_BAR, (volatile LAS unsigned*)(lds + LDS_BARST)); }
    { PH_BEGIN phase_p0(a, lds, vcu, G); }
    grid.sync();
#pragma unroll 1
    for (int round = 0; round < NROUND; ++round) {
        {
            PH_BEGIN
            pg8::Gemm g{(const bf16_t*)(a.ws + WS_XN) + (size_t)round * RT * D, (const bf16_t*)(a.ws + WS_WIN), RT, N1, D};
            pg8::StaticOrder S; S.init(RT, N1, G, bx);
            EpiX<1> E{make_ep(a, round)};
            pg8::gemm_phase<EpiX<1>, pg8::StaticOrder, true, true>(lds, g, S, E);
        }
        { PH_BEGIN if (bx < 8) mscan_pair(a, lds, round, bx); }
        GRID_SYNC();
        { PH_BEGIN for (int it = bx; it < 512; it += G) mlstm_pre_item(a, lds, round, it); }
        { PH_BEGIN u32x4 gq[4]; int it = bx; if (it < 2048) hgrn_pre_load(a, round, it, gq);
          for (; it < 2048; it += G) hgrn_pre_item(a, lds, round, it, gq, it + G); }
        GRID_SYNC();
        { PH_BEGIN
          if (bx < 128) mlstm_scan<2, false>(a, lds, round, bx & 7, bx >> 3);
          else if (bx >= 192 && bx < 200) mlstm_scan<1, true>(a, lds, round, bx - 192, 0);
          else if (bx < 192) { const int id2 = bx - 128; hgrn_scan(a, lds, round, (id2 & 7) * 2 + ((id2 >> 3) & 1), id2 >> 4); } }
        GRID_SYNC();
        {
            PH_BEGIN
            pg8::Gemm g{(const bf16_t*)(a.ws + WS_XN) + (size_t)round * RT * D, (const bf16_t*)(a.ws + WS_WIN) + (size_t)N1 * D, RT, N2, D};
            pg8::StaticOrder S; S.init(RT, N2, G, bx);
            EpiX<2> E{make_ep(a, round)};
            pg8::gemm_phase<EpiX<2>, pg8::StaticOrder, true, true>(lds, g, S, E);
        }
        GRID_SYNC();
        { PH_BEGIN phase_ypass(a, round, vcu, G); }
        GRID_SYNC();
        {
            { PH_BEGIN pg8::StaticOrder S; S.init(RT, D, G, bx);
              pg8::Gemm g{(const bf16_t*)(a.ws + WS_V), (const bf16_t*)(a.ws + WS_WM), RT, D, 2048}; EpiX<3> E{make_ep(a, round)}; pg8::gemm_phase<EpiX<3>, pg8::StaticOrder, true, true>(lds, g, S, E); }
            { PH_BEGIN pg8::StaticOrder S; S.init(RT, D, G, bx);
              pg8::Gemm g{(const bf16_t*)(a.ws + WS_GI), (const bf16_t*)(a.ws + WS_WG), RT, D, D}; EpiX<4> E{make_ep(a, round)}; pg8::gemm_phase<EpiX<4>, pg8::StaticOrder, true, true>(lds, g, S, E); }
        }
        GRID_SYNC();
        {
            PH_BEGIN pg8::StaticOrder S; S.init(RT, D, G, bx);
            pg8::Gemm g{(const bf16_t*)(a.ws + WS_GFLOG), (const bf16_t*)(a.ws + WS_WO), RT, D, D}; EpiX<5> E{make_ep(a, round)}; pg8::gemm_phase<EpiX<5>, pg8::StaticOrder, true, true>(lds, g, S, E);
        }
        GRID_SYNC();
    }
    { PH_BEGIN phase_p8(a, vcu, G); }
    GRID_SYNC();
    {
        PH_BEGIN pg8::StaticOrder S; S.init(T, 2048, G, bx);
        pg8::Gemm g{(const bf16_t*)(a.ws + WS_XN), (const bf16_t*)(a.ws + WS_WPQ), T, 2048, D}; EpiX<6> E{make_ep(a, 0)}; pg8::gemm_phase<EpiX<6>, pg8::StaticOrder, true, true>(lds, g, S, E);
    }
    GRID_SYNC();
#ifdef TOPK_REF
    { PH_BEGIN phase_topk_ref(a, vcu, G); }
#else
    { PH_BEGIN phase_topk(a, lds, bx, G); }
#endif
    GRID_SYNC();
    { PH_BEGIN phase_ua(a, lds); }
    GRID_SYNC();
    { PH_BEGIN phase_ua2(a, vcu, G); }
    GRID_SYNC();
    { PH_BEGIN phase_vb(a, lds); }
    GRID_SYNC();
    { PH_BEGIN phase_vc(a, vcu, G); }
}

extern "C" void kernel_launch(void* const* d_in, const int* in_sizes, int n_in, void* d_out, int out_size, void* d_ws, size_t ws_size, hipStream_t stream) {
    static int grid = 0;
    if (grid == 0) {
        if (n_in != 18 || in_sizes[0] != T * D || out_size != T * D || ws_size < WS_END) {
            fprintf(stderr, "kernel_launch: unexpected shapes/workspace (n_in %d, in0 %d, out %d, ws %zu, need %zu)\n", n_in, n_in > 0 ? in_sizes[0] : -1, out_size, ws_size, (size_t)WS_END);
            grid = -1; return; }
        int dev = 0, cus = 0, per_cu = 0;
        hipGetDevice(&dev);
        hipDeviceGetAttribute(&cus, hipDeviceAttributeMultiprocessorCount, dev);
        hipFuncSetAttribute((const void*)fwd_megakernel, hipFuncAttributeMaxDynamicSharedMemorySize, LDS_BYTES);
        hipOccupancyMaxActiveBlocksPerMultiprocessor(&per_cu, (const void*)fwd_megakernel, NTHR, LDS_BYTES);
        if (per_cu < 1) { fprintf(stderr, "kernel_launch: occupancy query says %d blocks/CU\n", per_cu); per_cu = 1; }
        grid = cus;
        (void)hipGetLastError();
    }
    if (grid < 0) return;
    hipMemsetAsync((char*)d_ws + WS_CTL, 0, 1 * MiB, stream);
    Args a{};
    a.x = (const float*)d_in[0]; a.norm1_g = (const float*)d_in[1]; a.w_in = (const float*)d_in[2]; a.b_in = (const float*)d_in[3];
    a.conv_w = (const float*)d_in[4]; a.conv_b = (const float*)d_in[5]; a.m_head_g = (const float*)d_in[6]; a.lb_table = (const float*)d_in[7];
    a.g_head_g = (const float*)d_in[8]; a.w_br_m = (const float*)d_in[9]; a.w_br_g = (const float*)d_in[10]; a.w_out = (const float*)d_in[11];
    a.norm2_g = (const float*)d_in[12]; a.w_pq = (const float*)d_in[13]; a.sub_keys = (const float*)d_in[14]; a.u_emb = (const float*)d_in[15];
    a.v_emb = (const float*)d_in[16]; a.final_g = (const float*)d_in[17];
    a.out = (float*)d_out; a.ws = (unsigned char*)d_ws;
    void* args[] = {&a};
    hipError_t e = hipLaunchCooperativeKernel((const void*)fwd_megakernel, dim3(grid), dim3(NTHR), args, LDS_BYTES, stream);
    if (e != hipSuccess) fprintf(stderr, "cooperative launch failed: %s (grid %d)\n", hipGetErrorString(e), grid);
}
```

```cpp
#include <hip/hip_runtime.h>
#include <hip/hip_cooperative_groups.h>
#include <cstdio>
#include <cstdint>
namespace cg = cooperative_groups;

#define LAS __attribute__((address_space(3)))
typedef unsigned short bf16_t;
typedef short bf16x8 __attribute__((ext_vector_type(8)));
typedef float f32x4 __attribute__((ext_vector_type(4)));
typedef float f32x2 __attribute__((ext_vector_type(2)));
typedef unsigned u32x4 __attribute__((ext_vector_type(4)));
typedef unsigned u32x2 __attribute__((ext_vector_type(2)));

constexpr int D = 1024, BATCH = 4, SEQ = 8192, T = BATCH * SEQ;
constexpr int IN_COLS = 12296, NP = 12288;
constexpr int RT = 16384, NROUND = 2;
constexpr int N1 = 7168, N2 = 5120;
constexpr float EPS = 1e-6f;
constexpr int NWAVES = 8, NTHR = 512;

constexpr size_t MiB = 1u << 20;
constexpr size_t WS_CTL = 0;
constexpr size_t WS_WIN = 1 * MiB;
constexpr size_t WS_WM = 25 * MiB;
constexpr size_t WS_WG = 29 * MiB;
constexpr size_t WS_WO = 31 * MiB;
constexpr size_t WS_WPQ = 33 * MiB;
constexpr size_t WS_SK = 37 * MiB;
constexpr size_t WS_BIASP = 37 * MiB + 512 * 1024;
constexpr size_t WS_LB = WS_BIASP + 64 * 1024;
constexpr size_t WS_GATES = 38 * MiB;
constexpr size_t WS_MPREV = 39 * MiB;
constexpr size_t WS_DEN = 40 * MiB;
constexpr size_t WS_MT = 40 * MiB + 512 * 1024;
constexpr size_t WS_HGDEC = 41 * MiB;
constexpr size_t WS_MDEC = 43 * MiB;
constexpr size_t WS_XN = 44 * MiB;
constexpr size_t WS_QKPRE = 108 * MiB;
constexpr size_t WS_V = 172 * MiB;
constexpr size_t WS_GFLOG = 236 * MiB;
constexpr size_t WS_GI = 268 * MiB;
constexpr size_t WS_GQ = 300 * MiB;
constexpr size_t WS_S = 332 * MiB;
constexpr size_t WS_QT = 348 * MiB;
constexpr size_t WS_KWT = 380 * MiB;
constexpr size_t WS_ATT = 412 * MiB;
constexpr size_t WS_QTG = 428 * MiB;
constexpr size_t WS_KENDT = 460 * MiB;
constexpr size_t WS_SIGO = 332 * MiB;
constexpr size_t WS_SGG = 396 * MiB;
constexpr size_t WS_SAM = 428 * MiB;
constexpr size_t WS_SAG = 460 * MiB;
constexpr size_t WS_END = 492 * MiB;
constexpr size_t WS_QP = 108 * MiB;
constexpr size_t WS_UB = 236 * MiB;
constexpr size_t WS_VB = 252 * MiB;
constexpr size_t WS_USC = 268 * MiB;
constexpr size_t WS_VSC = 268 * MiB + 65536;
constexpr size_t WS_EIDX = 300 * MiB;
constexpr size_t WS_GATE = 316 * MiB;
constexpr size_t WS_X8 = 348 * MiB;
constexpr size_t WS_PARTU = 108 * MiB;
constexpr size_t WS_SS = 348 * MiB;
constexpr size_t WS_PW = 332 * MiB;

constexpr int CW_TMAX = 64;
constexpr int LDS_BYTES = 147456;

__device__ __forceinline__ unsigned f2bf(float f) { unsigned u = __builtin_bit_cast(unsigned, f); return (u + 0x7fffu + ((u >> 16) & 1u)) >> 16; }
typedef __bf16 bf16x2_t __attribute__((ext_vector_type(2)));
__device__ __forceinline__ unsigned pk2(float lo, float hi) { bf16x2_t v; v[0] = (__bf16)lo; v[1] = (__bf16)hi; return __builtin_bit_cast(unsigned, v); }
__device__ __forceinline__ float bf_lo(unsigned w) { return __builtin_bit_cast(float, w << 16); }
__device__ __forceinline__ float bf_hi(unsigned w) { return __builtin_bit_cast(float, w & 0xffff0000u); }
__device__ __forceinline__ float bf2f(bf16_t h) { return __builtin_bit_cast(float, ((unsigned)h) << 16); }
__device__ __forceinline__ float shx(float v, int o, int lane) { return __builtin_bit_cast(float, __builtin_amdgcn_ds_bpermute((lane ^ o) << 2, __builtin_bit_cast(int, v))); }
__device__ __forceinline__ float shup(float v, int o, int lane) { return __builtin_bit_cast(float, __builtin_amdgcn_ds_bpermute(((lane - o) & 63) << 2, __builtin_bit_cast(int, v))); }
__device__ __forceinline__ float rdlane(float v, int l) { return __builtin_bit_cast(float, __builtin_amdgcn_readlane(__builtin_bit_cast(int, v), l)); }
#define DPP_(v, ctrl) __builtin_bit_cast(float, __builtin_amdgcn_update_dpp(0, __builtin_bit_cast(int, (v)), (ctrl), 0xF, 0xF, false))
__device__ __forceinline__ float wave_sum(float v, int lane) {
    (void)lane;
    v += DPP_(v, 0xB1); v += DPP_(v, 0x4E); v += DPP_(v, 0x141); v += DPP_(v, 0x140);
    return (rdlane(v, 0) + rdlane(v, 16)) + (rdlane(v, 32) + rdlane(v, 48));
}
#define SWZI_(v, pat) __builtin_amdgcn_ds_swizzle((int)(v), (pat))
#define DPPI_(v, ctrl) __builtin_amdgcn_update_dpp(0, (int)(v), (ctrl), 0xF, 0xF, false)
__device__ __forceinline__ unsigned xor32u_(unsigned v, bool hi) {
#if defined(__HIP_DEVICE_COMPILE__)
    const auto r = __builtin_amdgcn_permlane32_swap(v, v, false, false);
    return hi ? r[0] : r[1];
#else
    (void)hi; return v;
#endif
}
__device__ __forceinline__ float sigmoidf_(float x) { return __builtin_amdgcn_rcpf(1.0f + __expf(-x)); }
__device__ __forceinline__ float siluf_(float x) { return x * __builtin_amdgcn_rcpf(1.0f + __expf(-x)); }
#define LDS_WAIT() asm volatile("s_waitcnt lgkmcnt(0)" ::: "memory")
__device__ __forceinline__ int tid_() { int t = threadIdx.x; asm volatile("" : "+v"(t)); return t; }

#define GAS __attribute__((address_space(1)))
struct DArgs {
    const GAS float* x; const GAS float* norm1_g; const GAS float* w_in; const GAS float* b_in; const GAS float* conv_w; const GAS float* conv_b;
    const GAS float* m_head_g; const GAS float* lb_table; const GAS float* g_head_g; const GAS float* w_br_m; const GAS float* w_br_g; const GAS float* w_out;
    const GAS float* norm2_g; const GAS float* w_pq; const GAS float* sub_keys; const GAS float* u_emb; const GAS float* v_emb; const GAS float* final_g;
    GAS float* out; GAS unsigned char* ws;
};
struct Args {
    const float* x; const float* norm1_g; const float* w_in; const float* b_in; const float* conv_w; const float* conv_b;
    const float* m_head_g; const float* lb_table; const float* g_head_g; const float* w_br_m; const float* w_br_g; const float* w_out;
    const float* norm2_g; const float* w_pq; const float* sub_keys; const float* u_emb; const float* v_emb; const float* final_g;
    float* out; unsigned char* ws;
};

namespace pg8 {
constexpr int BM = 256, BK = 64, HALF = 128, HTB = HALF * BK * 2, STAGE_BYTES = 8 * HTB, NXCD = 8, WGM = 8;
__host__ __device__ __forceinline__ int lds_byte(int r, int c) { const int st = (r >> 4) * 2 + (c >> 5), rr = r & 15, cc = c & 31, ob = rr * 64 + cc * 2; return st * 1024 + (ob ^ (((ob >> 9) & 1) << 5)); }
__host__ __device__ __forceinline__ void stage_rc(int b, int& R, int& C) { const int st = b / 1024, sb = b % 1024, swz = sb ^ (((sb >> 9) & 1) << 5); R = (st >> 1) * 16 + swz / 64; C = (st & 1) * 32 + (swz % 64) / 2; }
__host__ __device__ __forceinline__ int perm32(int rho) { const int n = rho >> 4, i = rho & 15; return 8 * (i >> 2) + 4 * n + (i & 3); }
struct Unit { int pm, pn; };
struct Gemm { const bf16_t* A; const bf16_t* Bt; int M, N, K; };
struct StaticOrder {
    int nM, nN, nwg, G, c;
    __host__ __device__ void init(int M, int N, int G_, int c_) { nM = M / BM; nN = N / BM; nwg = nM * nN; G = G_; c = c_; }
    __host__ __device__ bool next(int i, Unit& u) const {
        const long L = (long)i * G + c; if (L >= nwg) return false;
        int wgid = (int)L; { const int q = nwg / NXCD, r = nwg % NXCD, xcd = wgid % NXCD, off = wgid / NXCD; wgid = (xcd < r ? xcd * (q + 1) : r * (q + 1) + (xcd - r) * q) + off; }
        const int nig = WGM * nN, gid = wgid / nig, fm = gid * WGM, gsz = (nM - fm) < WGM ? (nM - fm) : WGM;
        u.pm = fm + ((wgid % nig) % gsz); u.pn = (wgid % nig) / gsz; return true;
    }
    __device__ __forceinline__ void a_ready(const Unit&) const {}
    __device__ __forceinline__ void done(const Unit&) const {}
};

template <class Epi, class Sched, bool ALIGN_EPI = false, bool SP2 = false>
__device__ __forceinline__ void gemm_phase(LAS unsigned char* lds, const Gemm g, const Sched& S, const Epi& E) {
    const int tid = tid_(), wid = __builtin_amdgcn_readfirstlane(tid >> 6), lane = tid & 63, wr = wid >> 2, wc = wid & 3, fr = lane & 15, fq = lane >> 4;
    const int K = g.K, nt = K / BK;
    unsigned voffA[2], voffB[2];
#pragma unroll
    for (int i = 0; i < 2; ++i) { int R, C; stage_rc(tid * 16 + i * 8192, R, C); const int Rb = Epi::PERM ? ((R & ~31) + perm32(R & 31)) : R;
        voffA[i] = (unsigned)(R * K + C) * 2u; voffB[i] = (unsigned)(Rb * K + C) * 2u; }
    const size_t kstep = (size_t)(BK * 2);
    const size_t hstep = (size_t)HALF * K * 2;
    const size_t tstep = 2 * hstep;
    const unsigned ldsw = (unsigned)wid * 1024u;
    const int aoff = lds_byte(wr * 64 + fr, fq * 8), boff = lds_byte(wc * 32 + fr, fq * 8);
#define PG8_SA(b, h) (((b) * 2 + (h)) * HTB)
#define PG8_SB(b, h) ((4 + (b) * 2 + (h)) * HTB)
#define PG8_STAGE(bufoff, gbase, voff) do { _Pragma("unroll") for (int _i = 0; _i < 2; ++_i) \
        __builtin_amdgcn_global_load_lds((const unsigned*)((const char*)(gbase) + (voff)[_i]), (LAS unsigned*)(lds + (bufoff) + ldsw + _i * 8192), 16, 0, 0); } while (0)
#define PG8_LDA(dst, b, h) do { _Pragma("unroll") for (int m = 0; m < 4; ++m) _Pragma("unroll") for (int k = 0; k < 2; ++k) dst[m][k] = *(const LAS bf16x8*)(lds + PG8_SA(b, h) + aoff + m * 2048 + k * 1024); } while (0)
#define PG8_LDB(dst, b, h) do { _Pragma("unroll") for (int n = 0; n < 2; ++n) _Pragma("unroll") for (int k = 0; k < 2; ++k) dst[n][k] = *(const LAS bf16x8*)(lds + PG8_SB(b, h) + boff + n * 2048 + k * 1024); } while (0)
#define PG8_MMA(ai, bj, At, Bt) do { __builtin_amdgcn_s_setprio(1); _Pragma("unroll") for (int m = 0; m < 4; ++m) _Pragma("unroll") for (int n = 0; n < 2; ++n) _Pragma("unroll") for (int k = 0; k < 2; ++k) \
        acc[ai][bj][m][n] = __builtin_amdgcn_mfma_f32_16x16x32_bf16(Bt[n][k], At[m][k], acc[ai][bj][m][n], 0, 0, 0); __builtin_amdgcn_s_setprio(0); } while (0)
#define PG8_WAIT_V(n) asm volatile("s_waitcnt vmcnt(" #n ")" ::: "memory")
#define PG8_WAIT_L(n) asm volatile("s_waitcnt lgkmcnt(" #n ")" ::: "memory")
#define PG8_BAR __builtin_amdgcn_s_barrier()
#define PG8_SCHED __builtin_amdgcn_sched_barrier(0)
    Unit cur, nxt; int ui = 0;
    if (!S.next(0, cur)) return;
    f32x4 acc[2][2][4][2];
#pragma unroll
    for (int a = 0; a < 2; ++a)
#pragma unroll
        for (int b = 0; b < 2; ++b)
#pragma unroll
            for (int m = 0; m < 4; ++m)
#pragma unroll
                for (int n = 0; n < 2; ++n) acc[a][b][m][n] = (f32x4){0.f, 0.f, 0.f, 0.f};
    bf16x8 At[4][2], B0[2][2], B1[2][2];
    const char* cA = (const char*)g.A + (size_t)cur.pm * tstep; const char* cB = (const char*)g.Bt + (size_t)cur.pn * tstep;
    S.a_ready(cur);
    if constexpr (SP2) {
        PG8_STAGE(PG8_SB(0, 0), cB, voffB); PG8_STAGE(PG8_SB(0, 1), cB + hstep, voffB); PG8_STAGE(PG8_SA(0, 0), cA, voffA); PG8_STAGE(PG8_SA(0, 1), cA + hstep, voffA);
        if (wr == 1) PG8_BAR;
        PG8_WAIT_V(2); PG8_BAR;
        PG8_STAGE(PG8_SB(1, 0), cB + kstep, voffB); PG8_STAGE(PG8_SA(1, 0), cA + kstep, voffA); PG8_STAGE(PG8_SB(1, 1), cB + hstep + kstep, voffB);
        PG8_WAIT_V(6); PG8_BAR;
    } else {
        PG8_STAGE(PG8_SB(0, 0), cB, voffB); PG8_STAGE(PG8_SA(0, 0), cA, voffA); PG8_STAGE(PG8_SB(0, 1), cB + hstep, voffB); PG8_STAGE(PG8_SA(0, 1), cA + hstep, voffA);
        if (wr == 1) PG8_BAR;
        PG8_WAIT_V(4); PG8_BAR;
        PG8_STAGE(PG8_SB(1, 0), cB + kstep, voffB); PG8_STAGE(PG8_SA(1, 0), cA + kstep, voffA); PG8_STAGE(PG8_SB(1, 1), cB + hstep + kstep, voffB);
        PG8_WAIT_V(6); PG8_BAR;
    }
    for (;;) {
        const bool has_next = S.next(ui + 1, nxt);
        const char* nA = has_next ? (const char*)g.A + (size_t)nxt.pm * tstep : cA; const char* nB = has_next ? (const char*)g.Bt + (size_t)nxt.pn * tstep : cB;
        for (int t = 0; t < nt; t += 2) {
            const bool last = (t == nt - 2);
            const char* a1 = cA + (size_t)(t + 1) * kstep;
            const char* a2 = last ? nA : cA + (size_t)(t + 2) * kstep; const char* b2 = last ? nB : cB + (size_t)(t + 2) * kstep;
            const char* a3 = a2 + kstep; const char* b3 = b2 + kstep;
            if (last && has_next) S.a_ready(nxt);
            if constexpr (SP2) {
            PG8_LDB(B0, 0, 0); PG8_LDB(B1, 0, 1); PG8_SCHED; PG8_LDA(At, 0, 0); PG8_STAGE(PG8_SA(1, 1), a1 + hstep, voffA);
            PG8_WAIT_V(8); PG8_WAIT_L(0); PG8_BAR; PG8_MMA(0, 0, At, B0); PG8_MMA(0, 1, At, B1); PG8_BAR; PG8_SCHED;
            PG8_LDA(At, 0, 1); PG8_STAGE(PG8_SB(0, 0), b2, voffB); PG8_STAGE(PG8_SB(0, 1), b2 + hstep, voffB); PG8_STAGE(PG8_SA(0, 0), a2, voffA);
            PG8_WAIT_V(8); PG8_WAIT_L(0); PG8_BAR; PG8_MMA(1, 0, At, B0); PG8_MMA(1, 1, At, B1); PG8_BAR; PG8_SCHED;
            PG8_LDB(B0, 1, 0); PG8_LDB(B1, 1, 1); PG8_SCHED; PG8_LDA(At, 1, 0); PG8_STAGE(PG8_SA(0, 1), a2 + hstep, voffA);
            PG8_WAIT_V(8); PG8_WAIT_L(0); PG8_BAR; PG8_MMA(0, 0, At, B0); PG8_MMA(0, 1, At, B1); PG8_BAR; PG8_SCHED;
            PG8_LDA(At, 1, 1); PG8_STAGE(PG8_SB(1, 0), b3, voffB); PG8_STAGE(PG8_SB(1, 1), b3 + hstep, voffB); PG8_STAGE(PG8_SA(1, 0), a3, voffA);
            PG8_WAIT_V(8); PG8_WAIT_L(0); PG8_BAR; PG8_MMA(1, 0, At, B0); PG8_MMA(1, 1, At, B1); PG8_BAR; PG8_SCHED;
            } else {
            PG8_LDB(B0, 0, 0); PG8_SCHED; PG8_LDA(At, 0, 0); PG8_STAGE(PG8_SA(1, 1), a1 + hstep, voffA);
            PG8_WAIT_L(8); PG8_BAR; PG8_WAIT_L(0); PG8_MMA(0, 0, At, B0); PG8_BAR; PG8_SCHED;
            PG8_LDB(B1, 0, 1); PG8_STAGE(PG8_SB(0, 0), b2, voffB);
            PG8_BAR; PG8_WAIT_L(0); PG8_MMA(0, 1, At, B1); PG8_BAR;
            PG8_LDA(At, 0, 1); PG8_STAGE(PG8_SA(0, 0), a2, voffA);
            PG8_BAR; PG8_WAIT_L(0); PG8_MMA(1, 0, At, B0); PG8_BAR; PG8_SCHED;
            PG8_STAGE(PG8_SB(0, 1), b2 + hstep, voffB);
            PG8_WAIT_V(6); PG8_BAR; PG8_MMA(1, 1, At, B1); PG8_BAR;
            PG8_LDB(B0, 1, 0); PG8_SCHED; PG8_LDA(At, 1, 0); PG8_STAGE(PG8_SA(0, 1), a2 + hstep, voffA);
            PG8_WAIT_L(8); PG8_BAR; PG8_WAIT_L(0); PG8_MMA(0, 0, At, B0); PG8_BAR; PG8_SCHED;
            PG8_LDB(B1, 1, 1); PG8_STAGE(PG8_SB(1, 0), b3, voffB);
            PG8_BAR; PG8_WAIT_L(0); PG8_MMA(0, 1, At, B1); PG8_BAR;
            PG8_LDA(At, 1, 1); PG8_STAGE(PG8_SA(1, 0), a3, voffA);
            PG8_BAR; PG8_WAIT_L(0); PG8_MMA(1, 0, At, B0); PG8_BAR; PG8_SCHED;
            PG8_STAGE(PG8_SB(1, 1), b3 + hstep, voffB);
            PG8_WAIT_V(6); PG8_BAR; PG8_MMA(1, 1, At, B1); PG8_BAR;
            }
        }
        if constexpr (ALIGN_EPI) { if (wr == 0) PG8_BAR; }
        E(acc, cur, wr, wc, fr, fq);
        if (!has_next) break;
#pragma unroll
        for (int a = 0; a < 2; ++a)
#pragma unroll
            for (int b = 0; b < 2; ++b)
#pragma unroll
                for (int m = 0; m < 4; ++m)
#pragma unroll
                    for (int n = 0; n < 2; ++n) acc[a][b][m][n] = (f32x4){0.f, 0.f, 0.f, 0.f};
        cur = nxt; cA = nA; cB = nB; ++ui;
        if constexpr (ALIGN_EPI) { if (wr == 1) PG8_BAR; }
    }
    PG8_WAIT_V(0);
    if constexpr (!ALIGN_EPI) { if (wr == 0) PG8_BAR; }
    PG8_BAR;
#undef PG8_SA
#undef PG8_SB
#undef PG8_STAGE
#undef PG8_LDA
#undef PG8_LDB
#undef PG8_MMA
#undef PG8_WAIT_V
#undef PG8_WAIT_L
#undef PG8_BAR
#undef PG8_SCHED
}
}

struct EpiPtrs {
    const GAS float* biasp; const GAS float* lb; const GAS float* x; GAS float* out; GAS unsigned char* ws; int round;
};
template <int MODE> struct EpiX {
    static constexpr bool PERM = true, AFTER_DRAIN = false;
    EpiPtrs P;
    __device__ __forceinline__ void operator()(const f32x4 (&acc)[2][2][4][2], const pg8::Unit& u, int wr, int wc, int fr, int fq) const {
        const int row0 = u.pm * 256 + wr * 64 + fr;
        const int colt = u.pn * 256 + wc * 32 + 8 * fq;
        GAS unsigned char* ws = P.ws;
        bf16_t* dst = nullptr; int ld = 0, coff = 0, act = 0; const GAS float* bias = nullptr;
        if (MODE == 1) {
            bias = P.biasp;
            if (u.pn < 8) { dst = (bf16_t*)(ws + WS_QKPRE); ld = 2048; coff = 0; act = 0; }
            else if (u.pn < 16) { dst = (bf16_t*)(ws + WS_V); ld = 2048; coff = 2048; act = 0; }
            else if (u.pn < 20) { dst = (bf16_t*)(ws + WS_GFLOG); ld = 1024; coff = 4096; act = 3; }
            else if (u.pn < 24) { dst = (bf16_t*)(ws + WS_GI); ld = 1024; coff = 5120; act = 0; }
            else { dst = (bf16_t*)(ws + WS_GQ); ld = 1024; coff = 6144; act = 2; }
        } else if (MODE == 2) {
            bias = P.biasp + N1;
            if (u.pn < 8) { dst = (bf16_t*)(ws + WS_SIGO); ld = 2048; coff = 0; act = 1; }
            else if (u.pn < 12) { dst = (bf16_t*)(ws + WS_SGG); ld = 1024; coff = 2048; act = 2; }
            else if (u.pn < 16) { dst = (bf16_t*)(ws + WS_SAM); ld = 1024; coff = 3072; act = 1; }
            else { dst = (bf16_t*)(ws + WS_SAG); ld = 1024; coff = 4096; act = 1; }
        } else if (MODE == 6) { dst = (bf16_t*)(ws + WS_QP); ld = 2048; coff = 0; act = 0; }
#pragma unroll
        for (int bj = 0; bj < 2; ++bj) {
            const int col = colt + bj * 128;
            f32x4 b0 = (f32x4){0.f, 0.f, 0.f, 0.f}, b1 = b0, l0 = b0, l1 = b0;
            if (MODE == 1 || MODE == 2) { b0 = *(const f32x4*)(bias + col); b1 = *(const f32x4*)(bias + col + 4); }
            if (MODE == 1) { if (act == 3) { l0 = *(const f32x4*)(P.lb + (col - coff)); l1 = *(const f32x4*)(P.lb + (col - coff) + 4); } }
#pragma unroll
            for (int ai = 0; ai < 2; ++ai)
#pragma unroll
                for (int m = 0; m < 4; ++m) {
                    const int row = row0 + ai * 128 + m * 16;
                    f32x4 v0 = acc[ai][bj][m][0] + b0, v1 = acc[ai][bj][m][1] + b1;
                    if (MODE == 1 || MODE == 2 || MODE == 6) {
                        if (act == 1) {
#pragma unroll
                            for (int j = 0; j < 4; ++j) { v0[j] = sigmoidf_(v0[j]); v1[j] = sigmoidf_(v1[j]); }
                        } else if (act == 2) {
#pragma unroll
                            for (int j = 0; j < 4; ++j) { v0[j] = siluf_(v0[j]); v1[j] = siluf_(v1[j]); }
                        } else if (act == 3) {
#pragma unroll
                            for (int j = 0; j < 4; ++j) { v0[j] = __logf(l0[j] + (1.0f - l0[j]) * sigmoidf_(v0[j])); v1[j] = __logf(l1[j] + (1.0f - l1[j]) * sigmoidf_(v1[j])); }
                        }
                        u32x4 w; w.x = pk2(v0[0], v0[1]); w.y = pk2(v0[2], v0[3]); w.z = pk2(v1[0], v1[1]); w.w = pk2(v1[2], v1[3]);
                        *(u32x4*)(dst + (size_t)row * ld + (col - coff)) = w;
                    } else if (MODE == 3) {
                        const u32x4 g = *(const u32x4*)((const bf16_t*)(ws + WS_SAM) + (size_t)row * 1024 + col);
                        GAS float* o = P.out + ((size_t)P.round * RT + row) * 1024 + col;
                        f32x4 r0, r1;
                        r0[0] = v0[0] * bf_lo(g.x); r0[1] = v0[1] * bf_hi(g.x); r0[2] = v0[2] * bf_lo(g.y); r0[3] = v0[3] * bf_hi(g.y);
                        r1[0] = v1[0] * bf_lo(g.z); r1[1] = v1[1] * bf_hi(g.z); r1[2] = v1[2] * bf_lo(g.w); r1[3] = v1[3] * bf_hi(g.w);
                        *(f32x4*)o = r0; *(f32x4*)(o + 4) = r1;
                    } else if (MODE == 4) {
                        const u32x4 g = *(const u32x4*)((const bf16_t*)(ws + WS_SAG) + (size_t)row * 1024 + col);
                        const GAS float* zp = P.out + ((size_t)P.round * RT + row) * 1024 + col;
                        const f32x4 p0 = *(const f32x4*)zp, p1 = *(const f32x4*)(zp + 4);
                        f32x4 r0, r1;
                        r0[0] = p0[0] + v0[0] * bf_lo(g.x); r0[1] = p0[1] + v0[1] * bf_hi(g.x); r0[2] = p0[2] + v0[2] * bf_lo(g.y); r0[3] = p0[3] + v0[3] * bf_hi(g.y);
                        r1[0] = p1[0] + v1[0] * bf_lo(g.z); r1[1] = p1[1] + v1[1] * bf_hi(g.z); r1[2] = p1[2] + v1[2] * bf_lo(g.w); r1[3] = p1[3] + v1[3] * bf_hi(g.w);
                        u32x4 w; w.x = pk2(r0[0], r0[1]); w.y = pk2(r0[2], r0[3]); w.z = pk2(r1[0], r1[1]); w.w = pk2(r1[2], r1[3]);
                        *(u32x4*)((bf16_t*)(ws + WS_GFLOG) + (size_t)row * 1024 + col) = w;
                    } else if (MODE == 5) {
                        const size_t off = ((size_t)P.round * RT + row) * 1024 + col;
                        const f32x4 x0 = *(const f32x4*)(P.x + off), x1 = *(const f32x4*)(P.x + off + 4);
                        *(f32x4*)(P.out + off) = x0 + v0; *(f32x4*)(P.out + off + 4) = x1 + v1;
                    }
                }
        }
    }
};

__device__ __forceinline__ void p0_transpose_item(const GAS float* W, int ldw, int K, int k0, int scol, GAS bf16_t* WT, int drow, LAS float* scr, int lane) {
#pragma unroll 8
    for (int i = 0; i < 32; ++i) { const int kk = 2 * i + (lane >> 5); scr[kk * 33 + (lane & 31)] = W[(size_t)(k0 + kk) * ldw + scol + (lane & 31)]; }
    LDS_WAIT(); asm volatile("" ::: "memory");
    const int c = lane & 7;
#pragma unroll
    for (int j = 0; j < 4; ++j) { const int n = (lane >> 3) + 8 * j; const LAS float* s = scr + (8 * c) * 33 + n;
        u32x4 o; o.x = pk2(s[0 * 33], s[1 * 33]); o.y = pk2(s[2 * 33], s[3 * 33]); o.z = pk2(s[4 * 33], s[5 * 33]); o.w = pk2(s[6 * 33], s[7 * 33]);
        *(u32x4*)(WT + (size_t)(drow + n) * K + k0 + 8 * c) = o; }
    LDS_WAIT(); asm volatile("" ::: "memory");
}
__device__ __forceinline__ int win_src_col(int n) {
    if (n < 4096) return n;
    if (n < 7168) return n - 4096 + 6152;
    if (n < 9216) return n - 7168 + 4096;
    return n - 9216 + 9224;
}

__device__ __forceinline__ void phase_p0(const DArgs& a, LAS unsigned char* lds, int vcu, int G) {
    const int tid = tid_(), lane = tid & 63, wave = tid >> 6;
    const int gw = vcu * NWAVES + wave, NGW = G * NWAVES;
    GAS unsigned char* ws = a.ws;
    LAS float* scr = (LAS float*)(lds + wave * 16384);
    constexpr int I_IN = 16 * 384, I_M = 32 * 32, I_G = 16 * 32, I_O = 16 * 32, I_PQ = 16 * 64;
    constexpr int NITEMS = I_IN + I_M + I_G + I_O + I_PQ;
    for (int it = gw; it < NITEMS; it += NGW) {
        int r = it;
        if (r < I_IN) { const int kb = r / 384, nb = r % 384; p0_transpose_item(a.w_in, IN_COLS, 1024, kb * 64, win_src_col(nb * 32), (GAS bf16_t*)(ws + WS_WIN), nb * 32, scr, lane); continue; } r -= I_IN;
        if (r < I_M) { const int kb = r / 32, nb = r % 32; p0_transpose_item(a.w_br_m, 1024, 2048, kb * 64, nb * 32, (GAS bf16_t*)(ws + WS_WM), nb * 32, scr, lane); continue; } r -= I_M;
        if (r < I_G) { const int kb = r / 32, nb = r % 32; p0_transpose_item(a.w_br_g, 1024, 1024, kb * 64, nb * 32, (GAS bf16_t*)(ws + WS_WG), nb * 32, scr, lane); continue; } r -= I_G;
        if (r < I_O) { const int kb = r / 32, nb = r % 32; p0_transpose_item(a.w_out, 1024, 1024, kb * 64, nb * 32, (GAS bf16_t*)(ws + WS_WO), nb * 32, scr, lane); continue; } r -= I_O;
        { const int kb = r / 64, nb = r % 64; p0_transpose_item(a.w_pq, 2048, 1024, kb * 64, nb * 32, (GAS bf16_t*)(ws + WS_WPQ), nb * 32, scr, lane); }
    }
    const int gt = vcu * NTHR + tid, NGT = G * NTHR;
    for (int i = gt; i < NP; i += NGT) ((float*)(ws + WS_BIASP))[i] = a.b_in[win_src_col(i)];
    for (int i = gt; i < 1024; i += NGT) { const float t0 = a.lb_table[i], t1 = a.lb_table[1024 + i]; ((float*)(ws + WS_LB))[i] = 1.0f / (1.0f + __expf(t1 - t0)); }
    for (int i = gt; i < 8 * 2 * 128 * 128 / 4; i += NGT) { const f32x4 v = ((const f32x4*)a.sub_keys)[i]; u32x2 o; o.x = pk2(v[0], v[1]); o.y = pk2(v[2], v[3]); ((u32x2*)(ws + WS_SK))[i] = o; }
    {
        float mu = 0.f, mv = 0.f;
        for (size_t i = (size_t)vcu * NTHR + tid; i < (size_t)16384 * 1024 / 4; i += (size_t)G * NTHR) {
            const f32x4 u4 = ((const GAS f32x4*)a.u_emb)[i], v4 = ((const GAS f32x4*)a.v_emb)[i];
            mu = fmaxf(mu, fmaxf(fmaxf(fabsf(u4[0]), fabsf(u4[1])), fmaxf(fabsf(u4[2]), fabsf(u4[3]))));
            mv = fmaxf(mv, fmaxf(fmaxf(fabsf(v4[0]), fabsf(v4[1])), fmaxf(fabsf(v4[2]), fabsf(v4[3])))); }
#pragma unroll
        for (int o = 1; o < 64; o <<= 1) { mu = fmaxf(mu, shx(mu, o, lane)); mv = fmaxf(mv, shx(mv, o, lane)); }
        if (lane == 0) { atomicMax((unsigned*)(ws + WS_CTL) + CW_TMAX, __builtin_bit_cast(unsigned, mu)); atomicMax((unsigned*)(ws + WS_CTL) + CW_TMAX + 1, __builtin_bit_cast(unsigned, mv)); }
    }
    f32x4 g1[4];
#pragma unroll
    for (int j = 0; j < 4; ++j) g1[j] = ((const GAS f32x4*)a.norm1_g)[64 * j + lane];
    f32x4 gw0[16], gw1[16];
#pragma unroll
    for (int j = 0; j < 4; ++j)
#pragma unroll
        for (int e = 0; e < 4; ++e) { const int k = 256 * j + 4 * lane + e; gw0[4 * j + e] = *(const GAS f32x4*)(a.w_in + (size_t)k * IN_COLS + 6144); gw1[4 * j + e] = *(const GAS f32x4*)(a.w_in + (size_t)k * IN_COLS + 6148); }
    const float gbias = lane < 8 ? a.b_in[6144 + lane] : 0.f;
    for (int m = gw; m < T; m += NGW) {
        const GAS f32x4* xr = (const GAS f32x4*)(a.x + (size_t)m * D) + lane;
        f32x4 v[4]; float s = 0.f;
#pragma unroll
        for (int j = 0; j < 4; ++j) { v[j] = xr[64 * j]; s += (v[j][0] * v[j][0] + v[j][1] * v[j][1]) + (v[j][2] * v[j][2] + v[j][3] * v[j][3]); }
        const float rstd = rsqrtf(wave_sum(s, lane) * (1.f / D) + EPS);
        GAS unsigned long long* o8 = (GAS unsigned long long*)((GAS bf16_t*)(ws + WS_XN) + (size_t)m * D) + lane;
        f32x4 ga0 = (f32x4){0.f, 0.f, 0.f, 0.f}, ga1 = ga0;
#pragma unroll
        for (int j = 0; j < 4; ++j) {
            v[j] = v[j] * rstd * g1[j];
            o8[64 * j] = (unsigned long long)pk2(v[j][0], v[j][1]) | ((unsigned long long)pk2(v[j][2], v[j][3]) << 32);
#pragma unroll
            for (int e = 0; e < 4; ++e) { ga0 += gw0[4 * j + e] * v[j][e]; ga1 += gw1[4 * j + e] * v[j][e]; }
        }
        float ga[8] = {ga0[0], ga0[1], ga0[2], ga0[3], ga1[0], ga1[1], ga1[2], ga1[3]};
#pragma unroll
        for (int q = 0; q < 8; ++q) ga[q] = wave_sum(ga[q], lane);
        if (lane < 8) { float r = ga[0];
#pragma unroll
            for (int q = 1; q < 8; ++q) r = (lane == q) ? ga[q] : r;
            ((GAS float*)(ws + WS_GATES))[(size_t)m * 8 + lane] = r + gbias; }
    }
}

__device__ __forceinline__ float logsigf_(float x) { return fminf(x, 0.f) - log1pf(__expf(-fabsf(x))); }
#define LDS_BAR() do { asm volatile("s_waitcnt lgkmcnt(0)" ::: "memory"); __builtin_amdgcn_s_barrier(); asm volatile("" ::: "memory"); } while (0)
#define MFMA16(a, b, c) __builtin_amdgcn_mfma_f32_16x16x32_bf16((a), (b), (c), 0, 0, 0)
__device__ __forceinline__ bf16x8 lfrag(const LAS unsigned char* base, int pitch, int row, int k0, int fq) { return *(const LAS bf16x8*)(base + row * pitch + (k0 + 8 * fq) * 2); }
__device__ __forceinline__ int fm_off(int r, int k, int KB) { return (((r >> 4) * KB + (k >> 5)) << 10) + (((((k >> 3) & 3) << 4) + (r & 15)) << 4) + ((k & 7) << 1); }
__device__ __forceinline__ bf16x8 gfrag(const bf16_t* base, int ld, int row, int k0, int fq) { return *(const bf16x8*)(base + (size_t)row * ld + k0 + 8 * fq); }

__device__ __forceinline__ void mscan_pair(const DArgs& a, LAS unsigned char* lds, int round, int p) {
    const int tid = tid_(), lane = tid & 63, part = tid >> 6;
    const int bl = p >> 2, h = p & 3, b = round * 2 + bl;
    const GAS float* g = (const GAS float*)(a.ws + WS_GATES) + ((size_t)b * SEQ + (size_t)lane * 128 + part * 16) * 8;
    float bsum = 0.f, gm = -INFINITY;
#pragma unroll 4
    for (int s = 0; s < 16; ++s) { const float ip = g[s * 8 + h], fp = g[s * 8 + 4 + h]; bsum += logsigf_(fp); gm = fmaxf(gm, ip - bsum); }
    LAS float* PS = (LAS float*)lds; LAS float* PM = PS + 512;
    PS[part * 64 + lane] = bsum; PM[part * 64 + lane] = gm;
    __syncthreads();
    if (tid < 64) {
        float bs = 0.f, g2 = -INFINITY;
#pragma unroll
        for (int q = 0; q < 8; ++q) { g2 = fmaxf(g2, PM[q * 64 + lane] - bs); bs += PS[q * 64 + lane]; }
        float mprev = 0.f, mine = 0.f;
        for (int c = 0; c < 64; ++c) {
            const float bc = rdlane(bs, c), gc = rdlane(g2, c);
            if (lane == c) mine = mprev; mprev = bc + fmaxf(mprev, gc); }
        ((GAS float*)(a.ws + WS_MPREV))[(round * 8 + p) * 64 + lane] = mine;
    }
    __syncthreads();
}

constexpr int PQ_PITCH = 528, PS_PITCH = 272;
__device__ __forceinline__ void mlstm_pre_item(const DArgs& a, LAS unsigned char* lds, int round, int item) {
    const int tid = tid_(), lane = tid & 63, wave = __builtin_amdgcn_readfirstlane(tid >> 6), fr = lane & 15, fq = lane >> 4;
    const int p = item >> 6, c = item & 63, bl = p >> 2, h = p & 3, b = round * 2 + bl;
    const int tl0 = bl * SEQ + c * 128; const size_t tg0 = (size_t)b * SEQ + c * 128;
    GAS unsigned char* ws = a.ws;
    LAS unsigned char* QL = lds; LAS unsigned char* KL = lds + 67584;
    LAS float* AS = (LAS float*)(lds + 135168); LAS float* MS = AS + 128; LAS float* SC = AS + 256;
    if (wave == 0) {
        const float mprev = ((const float*)(ws + WS_MPREV))[(round * 8 + p) * 64 + c];
        const float* g = (const float*)(ws + WS_GATES) + (tg0 + 2 * lane) * 8;
        const float ip0 = g[h], fp0 = g[4 + h], ip1 = g[8 + h], fp1 = g[12 + h];
        const float lf0 = logsigf_(fp0), lf1 = logsigf_(fp1), pp = lf0 + lf1;
        float incl = pp;
#pragma unroll
        for (int o = 1; o < 64; o <<= 1) { const float t = shup(incl, o, lane); if (lane >= o) incl += t; }
        const float excl = incl - pp, b0 = excl + lf0, b1 = incl;
        const float a0 = ip0 - b0, a1 = ip1 - b1;
        float inclm = fmaxf(a0, a1);
#pragma unroll
        for (int o = 1; o < 64; o <<= 1) { const float t = shup(inclm, o, lane); if (lane >= o) inclm = fmaxf(inclm, t); }
        float exclm = shup(inclm, 1, lane); if (lane == 0) exclm = -INFINITY;
        const float M0 = fmaxf(mprev, fmaxf(exclm, a0)), M1 = fmaxf(mprev, inclm);
        AS[2 * lane] = a0; AS[2 * lane + 1] = a1; MS[2 * lane] = M0; MS[2 * lane + 1] = M1;
        float* mt = (float*)(ws + WS_MT) + (tg0 + 2 * lane) * 4 + h;
        mt[0] = b0 + M0; mt[4] = b1 + M1;
        const float Mlast = rdlane(M1, 63);
        if (lane == 0) { SC[0] = mprev; SC[1] = Mlast; ((float*)(ws + WS_MDEC))[item] = __expf(mprev - Mlast); }
    }
    {
        const int cgp = tid & 63, strip = tid >> 6;
        const int col = (cgp < 32) ? (h * 256 + cgp * 8) : (1024 + h * 256 + (cgp - 32) * 8);
        float w[4][8], bb[8];
#pragma unroll
        for (int j = 0; j < 4; ++j) { const f32x4 w0 = *(const f32x4*)(a.conv_w + j * 2048 + col), w1 = *(const f32x4*)(a.conv_w + j * 2048 + col + 4);
#pragma unroll
            for (int e = 0; e < 4; ++e) { w[j][e] = w0[e]; w[j][4 + e] = w1[e]; } }
        { const f32x4 b0 = *(const f32x4*)(a.conv_b + col), b1 = *(const f32x4*)(a.conv_b + col + 4);
#pragma unroll
            for (int e = 0; e < 4; ++e) { bb[e] = b0[e]; bb[4 + e] = b1[e]; } }
        const bf16_t* src = (const bf16_t*)(ws + WS_QKPRE) + (size_t)(tl0 + 16 * strip) * 2048 + col;
        const float qs = (cgp < 32) ? 0.0625f : 1.0f;
        LAS unsigned char* dstt = ((cgp < 32) ? QL : KL) + (cgp & 31) * 16;
#pragma unroll 1
        for (int half = 0; half < 2; ++half) {
            u32x4 xr[11];
#pragma unroll
            for (int r = 0; r < 11; ++r) {
                const int sl = c * 128 + 16 * strip + 8 * half + r - 3;
                xr[r] = (sl >= 0) ? *(const u32x4*)(src + (ptrdiff_t)(8 * half + r - 3) * 2048) : (u32x4){0u, 0u, 0u, 0u};
            }
#pragma unroll
            for (int r = 0; r < 8; ++r) {
                float y[8];
#pragma unroll
                for (int e = 0; e < 8; ++e) y[e] = bb[e];
#pragma unroll
                for (int j = 0; j < 4; ++j) { const u32x4 xv = xr[r + j];
                    y[0] += w[j][0] * bf_lo(xv.x); y[1] += w[j][1] * bf_hi(xv.x); y[2] += w[j][2] * bf_lo(xv.y); y[3] += w[j][3] * bf_hi(xv.y);
                    y[4] += w[j][4] * bf_lo(xv.z); y[5] += w[j][5] * bf_hi(xv.z); y[6] += w[j][6] * bf_lo(xv.w); y[7] += w[j][7] * bf_hi(xv.w); }
#pragma unroll
                for (int e = 0; e < 8; ++e) y[e] = siluf_(y[e]) * qs;
                u32x4 o; o.x = pk2(y[0], y[1]); o.y = pk2(y[2], y[3]); o.z = pk2(y[4], y[5]); o.w = pk2(y[6], y[7]);
                *(LAS u32x4*)(dstt + (16 * strip + 8 * half + r) * PQ_PITCH) = o;
            }
        }
    }
    __syncthreads();
    const float mprev = SC[0], Mlast = SC[1];
    {
        bf16_t* Sg = (bf16_t*)(ws + WS_S) + (size_t)item * 128 * 128;
        const int t = wave * 16 + fr; const float Mt = MS[t];
        for (int st = 0; st < 8; ++st) {
            u32x2 o = (u32x2){0u, 0u};
            if (st <= wave) {
                f32x4 acc = (f32x4){0.f, 0.f, 0.f, 0.f};
#pragma unroll
                for (int ks = 0; ks < 8; ++ks) acc = MFMA16(lfrag(KL, PQ_PITCH, st * 16 + fr, ks * 32, fq), lfrag(QL, PQ_PITCH, wave * 16 + fr, ks * 32, fq), acc);
                float v[4];
#pragma unroll
                for (int j = 0; j < 4; ++j) { const int s = st * 16 + 4 * fq + j; v[j] = (s <= t) ? acc[j] * __expf(AS[s] - Mt) : 0.f; }
                o.x = pk2(v[0], v[1]); o.y = pk2(v[2], v[3]);
            }
            *(u32x2*)((unsigned char*)Sg + fm_off(t, st * 16 + 4 * fq, 4)) = o;
        }
    }
    {
        bf16_t* Qg = (bf16_t*)(ws + WS_QT) + (size_t)item * 128 * 256;
#pragma unroll
        for (int i = 0; i < 8; ++i) { const int idx = tid + 512 * i, blk = idx >> 6, t = (blk >> 3) * 16 + (idx & 15), ch = (blk & 7) * 4 + ((idx >> 4) & 3);
            const u32x4 v = *(const LAS u32x4*)(QL + t * PQ_PITCH + ch * 16); const float s = __expf(mprev - MS[t]);
            u32x4 o; o.x = pk2(bf_lo(v.x) * s, bf_hi(v.x) * s); o.y = pk2(bf_lo(v.y) * s, bf_hi(v.y) * s); o.z = pk2(bf_lo(v.z) * s, bf_hi(v.z) * s); o.w = pk2(bf_lo(v.w) * s, bf_hi(v.w) * s);
            *(u32x4*)((unsigned char*)Qg + fm_off(t, ch * 8, 8)) = o; }
    }
    {
        bf16_t* Kg = (bf16_t*)(ws + WS_KWT) + (size_t)item * 256 * 128;
        const int dlo = lane & 15, sglo = lane >> 4;
#pragma unroll
        for (int i = 0; i < 8; ++i) { const int combo = wave * 8 + i, d = (combo >> 2) * 16 + dlo, s0 = ((combo & 3) * 4 + sglo) * 8;
            float v[8];
#pragma unroll
            for (int e = 0; e < 8; ++e) v[e] = bf2f(*(const LAS bf16_t*)(KL + (s0 + e) * PQ_PITCH + d * 2)) * __expf(AS[s0 + e] - Mlast);
            u32x4 o; o.x = pk2(v[0], v[1]); o.y = pk2(v[2], v[3]); o.z = pk2(v[4], v[5]); o.w = pk2(v[6], v[7]);
            *(u32x4*)((unsigned char*)Kg + fm_off(d, s0, 4)) = o; }
    }
    __syncthreads();
}

__device__ __forceinline__ void hgrn_pre_load(const DArgs& a, int round, int item, u32x4 (&gq)[4]) {
    const int tid = tid_();
    const int p = item >> 7, c = item & 127, bl = p >> 3, h = p & 7;
    const int tl0 = bl * SEQ + c * 64;
    GAS unsigned char* ws = a.ws;
#pragma unroll
    for (int i = 0; i < 2; ++i) { const int idx = tid + 512 * i, s = idx >> 4, ch = idx & 15;
        gq[2 * i] = *(const GAS u32x4*)((const GAS bf16_t*)(ws + WS_GFLOG) + (size_t)(tl0 + s) * 1024 + h * 128 + ch * 8);
        gq[2 * i + 1] = *(const GAS u32x4*)((const GAS bf16_t*)(ws + WS_GQ) + (size_t)(tl0 + s) * 1024 + h * 128 + ch * 8); }
}
__device__ __forceinline__ void hgrn_pre_item(const DArgs& a, LAS unsigned char* lds, int round, int item, u32x4 (&gq)[4], int next_item) {
    const int tid = tid_(), lane = tid & 63, wave = __builtin_amdgcn_readfirstlane(tid >> 6), fr = lane & 15, fq = lane >> 4;
    const int p = item >> 7, c = item & 127, bl = p >> 3, h = p & 7;
    const int tl0 = bl * SEQ + c * 64;
    GAS unsigned char* ws = a.ws;
    LAS float* CUM = (LAS float*)lds;
    LAS float* GL = (LAS float*)(lds + 32768);
    LAS unsigned char* QH = lds + 65536;
    LAS unsigned char* KE = lds + 65536 + 64 * PS_PITCH;
    LAS float* QF = (LAS float*)(lds + 65536 + 128 * PS_PITCH);
#pragma unroll
    for (int i = 0; i < 2; ++i) { const int idx = tid + 512 * i, s = idx >> 4, ch = idx & 15;
        const u32x4 gv = gq[2 * i], qv = gq[2 * i + 1];
        LAS float* gd = GL + s * 128 + ch * 8; LAS float* qd = QF + s * 128 + ch * 8;
        gd[0] = bf_lo(gv.x); gd[1] = bf_hi(gv.x); gd[2] = bf_lo(gv.y); gd[3] = bf_hi(gv.y); gd[4] = bf_lo(gv.z); gd[5] = bf_hi(gv.z); gd[6] = bf_lo(gv.w); gd[7] = bf_hi(gv.w);
        qd[0] = bf_lo(qv.x); qd[1] = bf_hi(qv.x); qd[2] = bf_lo(qv.y); qd[3] = bf_hi(qv.y); qd[4] = bf_lo(qv.z); qd[5] = bf_hi(qv.z); qd[6] = bf_lo(qv.w); qd[7] = bf_hi(qv.w); }
    if (next_item < 2048) hgrn_pre_load(a, round, next_item, gq);
    LDS_BAR();
    {
        const int d = tid & 127, qt = tid >> 7; float cs = 0.f;
#pragma unroll 4
        for (int s = 0; s < 16; ++s) { cs += GL[(qt * 16 + s) * 128 + d]; CUM[(qt * 16 + s) * 128 + d] = cs; }
        LDS_BAR();
        float off = 0.f;
#pragma unroll
        for (int q = 0; q < 3; ++q) off += (q < qt) ? CUM[(q * 16 + 15) * 128 + d] : 0.f;
        LDS_BAR();
#pragma unroll 4
        for (int s = 0; s < 16; ++s) CUM[(qt * 16 + s) * 128 + d] += off;
        if (qt == 3) ((GAS float*)(ws + WS_HGDEC))[(size_t)item * 128 + d] = __expf(cs + off);
    }
    LDS_BAR();
    {
        bf16_t* Qg = (bf16_t*)(ws + WS_QTG) + (size_t)item * 64 * 128;
#pragma unroll
        for (int i = 0; i < 2; ++i) { const int idx = tid + 512 * i, s = idx >> 4, ch = idx & 15;
            float qt[8], qh[8], ke[8];
#pragma unroll
            for (int e = 0; e < 8; ++e) { const int d = ch * 8 + e; const float cm = CUM[s * 128 + d], last = CUM[63 * 128 + d], q = QF[s * 128 + d], g = GL[s * 128 + d];
                qt[e] = q * __expf(cm); qh[e] = q * __expf(cm - last); ke[e] = (1.0f - __expf(g)) * __expf(last - cm); }
            u32x4 o; o.x = pk2(qt[0], qt[1]); o.y = pk2(qt[2], qt[3]); o.z = pk2(qt[4], qt[5]); o.w = pk2(qt[6], qt[7]);
            *(u32x4*)((unsigned char*)Qg + fm_off(s, ch * 8, 4)) = o;
            o.x = pk2(qh[0], qh[1]); o.y = pk2(qh[2], qh[3]); o.z = pk2(qh[4], qh[5]); o.w = pk2(qh[6], qh[7]);
            *(LAS u32x4*)(QH + s * PS_PITCH + ch * 16) = o;
            o.x = pk2(ke[0], ke[1]); o.y = pk2(ke[2], ke[3]); o.z = pk2(ke[4], ke[5]); o.w = pk2(ke[6], ke[7]);
            *(LAS u32x4*)(KE + s * PS_PITCH + ch * 16) = o; }
    }
    LDS_BAR();
    {
        bf16_t* Ag = (bf16_t*)(ws + WS_ATT) + (size_t)item * 64 * 64;
#pragma unroll
        for (int i = 0; i < 2; ++i) { const int tile = wave * 2 + i, tt = tile >> 2, st = tile & 3; const int t = tt * 16 + fr;
            u32x2 o = (u32x2){0u, 0u};
            if (st <= tt) { f32x4 acc = (f32x4){0.f, 0.f, 0.f, 0.f};
#pragma unroll
                for (int ks = 0; ks < 4; ++ks) acc = MFMA16(lfrag(KE, PS_PITCH, st * 16 + fr, ks * 32, fq), lfrag(QH, PS_PITCH, tt * 16 + fr, ks * 32, fq), acc);
                float v[4];
#pragma unroll
                for (int j = 0; j < 4; ++j) { const int s = st * 16 + 4 * fq + j; v[j] = (s <= t) ? acc[j] : 0.f; }
                o.x = pk2(v[0], v[1]); o.y = pk2(v[2], v[3]); }
            *(u32x2*)((unsigned char*)Ag + fm_off(t, st * 16 + 4 * fq, 2)) = o; }
    }
    {
        bf16_t* Kg = (bf16_t*)(ws + WS_KENDT) + (size_t)item * 128 * 64;
        const int dlo = lane & 15, sglo = lane >> 4;
#pragma unroll
        for (int i = 0; i < 2; ++i) { const int combo = wave * 2 + i, d = (combo >> 1) * 16 + dlo, s0 = ((combo & 1) * 4 + sglo) * 8;
            unsigned v[8];
#pragma unroll
            for (int e = 0; e < 8; ++e) v[e] = *(const LAS bf16_t*)(KE + (s0 + e) * PS_PITCH + d * 2);
            u32x4 o; o.x = v[0] | (v[1] << 16); o.y = v[2] | (v[3] << 16); o.z = v[4] | (v[5] << 16); o.w = v[6] | (v[7] << 16);
            *(u32x4*)((unsigned char*)Kg + fm_off(d, s0, 2)) = o; }
    }
    LDS_BAR();
}

template <int NVT, bool DEN>
__device__ __forceinline__ void mlstm_scan(const DArgs& a, LAS unsigned char* lds, int round, int p, int sl) {
    const int tid = tid_(), lane = tid & 63, wave = __builtin_amdgcn_readfirstlane(tid >> 6), fr = lane & 15, fq = lane >> 4;
    const int bl = p >> 2, h = p & 3, b = round * 2 + bl;
    GAS unsigned char* ws = a.ws;
    constexpr int VTB = NVT * 16 * PS_PITCH, CTB = NVT * 16 * PQ_PITCH;
    LAS unsigned char* VT = lds; LAS unsigned char* CT = lds + 2 * VTB; LAS float* DEC = (LAS float*)(lds + 2 * VTB + 2 * CTB);
    for (int i = tid; i < (2 * VTB + 2 * CTB) / 4; i += NTHR) ((LAS unsigned*)lds)[i] = 0u;
    if (tid < 64) DEC[tid] = ((const GAS float*)(ws + WS_MDEC))[p * 64 + tid];
    __syncthreads();
    if (DEN) { if (tid < 256) { const int bufi = tid >> 7, s = tid & 127; *(LAS bf16_t*)(VT + bufi * VTB + s * 2) = (bf16_t)0x3F80; } }
    f32x4 st[2][NVT];
#pragma unroll
    for (int dt = 0; dt < 2; ++dt)
#pragma unroll
        for (int vt = 0; vt < NVT; ++vt) st[dt][vt] = (f32x4){0.f, 0.f, 0.f, 0.f};
    const int vcol = h * 512 + sl * 32;
    const int vs = tid >> 2, vpart = tid & 3;
    const GAS unsigned char* Sg0 = ws + WS_S + (size_t)(p * 64) * 32768 + wave * 4096 + lane * 16;
    const GAS unsigned char* Qg0 = ws + WS_QT + (size_t)(p * 64) * 65536 + wave * 8192 + lane * 16;
    const GAS unsigned char* Kg0 = ws + WS_KWT + (size_t)(p * 64) * 65536 + wave * 8192 + lane * 16;
    const GAS bf16_t* Vg0 = (const GAS bf16_t*)(ws + WS_V) + (size_t)(bl * SEQ + vs) * 2048 + vcol + vpart * 8;
    bf16x8 bS[4], bQ[8], aK[2][4]; u32x4 vreg = (u32x4){0u, 0u, 0u, 0u};
#define V_STAGE(cc_) do { LAS unsigned char* d0_ = VT + ((cc_) & 1) * VTB + (vpart * 8) * PS_PITCH + vs * 2; \
        *(LAS bf16_t*)(d0_ + 0 * PS_PITCH) = (bf16_t)(vreg.x & 0xffffu); *(LAS bf16_t*)(d0_ + 1 * PS_PITCH) = (bf16_t)(vreg.x >> 16); \
        *(LAS bf16_t*)(d0_ + 2 * PS_PITCH) = (bf16_t)(vreg.y & 0xffffu); *(LAS bf16_t*)(d0_ + 3 * PS_PITCH) = (bf16_t)(vreg.y >> 16); \
        *(LAS bf16_t*)(d0_ + 4 * PS_PITCH) = (bf16_t)(vreg.z & 0xffffu); *(LAS bf16_t*)(d0_ + 5 * PS_PITCH) = (bf16_t)(vreg.z >> 16); \
        *(LAS bf16_t*)(d0_ + 6 * PS_PITCH) = (bf16_t)(vreg.w & 0xffffu); *(LAS bf16_t*)(d0_ + 7 * PS_PITCH) = (bf16_t)(vreg.w >> 16); } while (0)
    if (!DEN) { vreg = *(const GAS u32x4*)Vg0; V_STAGE(0); }
    __builtin_amdgcn_sched_barrier(0);
#pragma unroll
    for (int ks = 0; ks < 4; ++ks)
#pragma unroll
        for (int dt = 0; dt < 2; ++dt) aK[dt][ks] = *(const GAS bf16x8*)(Kg0 + (dt * 4 + ks) * 1024);
    __builtin_amdgcn_sched_barrier(0);
#pragma unroll
    for (int ks = 0; ks < 4; ++ks) bS[ks] = *(const GAS bf16x8*)(Sg0 + ks * 1024);
    __builtin_amdgcn_sched_barrier(0);
#pragma unroll
    for (int ks = 0; ks < 8; ++ks) bQ[ks] = *(const GAS bf16x8*)(Qg0 + ks * 1024);
    __builtin_amdgcn_sched_barrier(0);
    if (!DEN) vreg = *(const GAS u32x4*)(Vg0 + (size_t)128 * 2048);
    __builtin_amdgcn_sched_barrier(0);
    const GAS unsigned char* pfp; unsigned pfstride;
    { const int tt = (wave * 64 + lane) < 160 ? wave * 64 + lane : 159; const int idx = sl * 10 + (tt >> 4), off = (tt & 15) * 64;
      pfp = (idx < 32 ? ws + WS_S + (size_t)(p * 64) * 32768 + idx * 1024 : idx < 96 ? ws + WS_QT + (size_t)(p * 64) * 65536 + (idx - 32) * 1024 : ws + WS_KWT + (size_t)(p * 64) * 65536 + (idx - 96) * 1024) + off;
      pfstride = idx < 32 ? 32768u : 65536u; }
    unsigned pfv = 0u;
#pragma unroll 1
    for (int c = 0; c < 64; ++c) {
        const int tl0 = bl * SEQ + c * 128; const size_t tg0 = (size_t)b * SEQ + c * 128;
        const int cn = c < 63 ? c + 1 : 63, cn2 = c < 62 ? c + 2 : 63;
        LAS unsigned char* vt_ = VT + (c & 1) * VTB; LAS unsigned char* ct_ = CT + (c & 1) * CTB; LAS unsigned char* ctn = CT + ((c + 1) & 1) * CTB;
        LDS_BAR();
        if (!DEN && wave < 3) { asm volatile("" :: "v"(pfv)); const int c3 = c < 60 ? c + 3 : 63; pfv = *(const GAS unsigned*)(pfp + (size_t)c3 * pfstride); }
        bf16x8 vf[NVT][4], cf[NVT][4];
#pragma unroll
        for (int vt = 0; vt < NVT; ++vt)
#pragma unroll
            for (int ks = 0; ks < 4; ++ks) vf[vt][ks] = lfrag(vt_, PS_PITCH, vt * 16 + fr, ks * 32, fq);
        const float dec = DEC[c];
        __builtin_amdgcn_sched_barrier(0);
#pragma unroll
        for (int dt = 0; dt < 2; ++dt)
#pragma unroll
            for (int vt = 0; vt < NVT; ++vt) st[dt][vt] = st[dt][vt] * dec;
#pragma unroll
        for (int ks = 0; ks < 4; ++ks) {
#pragma unroll
            for (int vt = 0; vt < NVT; ++vt) cf[vt][ks] = lfrag(ct_, PQ_PITCH, vt * 16 + fr, ks * 32, fq);
#pragma unroll
            for (int dt = 0; dt < 2; ++dt) {
#pragma unroll
                for (int vt = 0; vt < NVT; ++vt) st[dt][vt] = MFMA16(aK[dt][ks], vf[vt][ks], st[dt][vt]);
                aK[dt][ks] = *(const GAS bf16x8*)(Kg0 + (size_t)cn * 65536 + (dt * 4 + ks) * 1024);
            }
            __builtin_amdgcn_sched_barrier(0);
        }
#pragma unroll
        for (int dt = 0; dt < 2; ++dt)
#pragma unroll
            for (int vt = 0; vt < NVT; ++vt) { u32x2 o; o.x = pk2(st[dt][vt][0], st[dt][vt][1]); o.y = pk2(st[dt][vt][2], st[dt][vt][3]);
                *(LAS u32x2*)(ctn + (vt * 16 + fr) * PQ_PITCH + (wave * 32 + dt * 16 + 4 * fq) * 2) = o; }
        __builtin_amdgcn_sched_barrier(0);
        f32x4 acc[NVT];
#pragma unroll
        for (int vt = 0; vt < NVT; ++vt) acc[vt] = (f32x4){0.f, 0.f, 0.f, 0.f};
#pragma unroll
        for (int ks = 0; ks < 4; ++ks) {
#pragma unroll
            for (int vt = 0; vt < NVT; ++vt) acc[vt] = MFMA16(vf[vt][ks], bS[ks], acc[vt]);
            bS[ks] = *(const GAS bf16x8*)(Sg0 + (size_t)cn * 32768 + ks * 1024);
            __builtin_amdgcn_sched_barrier(0);
        }
#pragma unroll
        for (int ks = 0; ks < 8; ++ks) {
#pragma unroll
            for (int vt = 0; vt < NVT; ++vt) acc[vt] = MFMA16(cf[vt][ks & 3], bQ[ks], acc[vt]);
            if (ks < 4) {
#pragma unroll
                for (int vt = 0; vt < NVT; ++vt) cf[vt][ks] = lfrag(ct_, PQ_PITCH, vt * 16 + fr, 128 + ks * 32, fq);
            }
            bQ[ks] = *(const GAS bf16x8*)(Qg0 + (size_t)cn * 65536 + ks * 1024);
            __builtin_amdgcn_sched_barrier(0);
        }
        const int t = wave * 16 + fr;
        if (!DEN) {
            GAS bf16_t* hn = (GAS bf16_t*)(ws + WS_QKPRE) + (size_t)(tl0 + t) * 2048 + vcol + 4 * fq;
#pragma unroll
            for (int vt = 0; vt < NVT; ++vt) { u32x2 o; o.x = pk2(acc[vt][0], acc[vt][1]); o.y = pk2(acc[vt][2], acc[vt][3]); *(GAS u32x2*)(hn + vt * 16) = o; }
            V_STAGE(c + 1); vreg = *(const GAS u32x4*)(Vg0 + (size_t)cn2 * 128 * 2048);
        } else {
            if (fq == 0) ((GAS float*)(ws + WS_DEN))[(tg0 + t) * 4 + h] = acc[0][0];
        }
    }
    asm volatile("" :: "v"(pfv));
    __syncthreads();
#undef V_STAGE
}

constexpr int HG_PD = 4;
__device__ __forceinline__ void hgrn_scan(const DArgs& a, LAS unsigned char* lds, int round, int p, int sl) {
    const int tid = tid_(), lane = tid & 63, wave = __builtin_amdgcn_readfirstlane(tid >> 6), fr = lane & 15, fq = lane >> 4;
    const int bl = p >> 3, h = p & 7;
    GAS unsigned char* ws = a.ws;
    constexpr int IP = 144, ITB = 32 * IP, STB = 32 * PS_PITCH;
    LAS unsigned char* IT = lds; LAS unsigned char* ST = lds + 2 * ITB;
    for (int i = tid; i < (2 * ITB + 2 * STB) / 4; i += NTHR) ((LAS unsigned*)lds)[i] = 0u;
    __syncthreads();
    f32x4 st[2][2];
#pragma unroll
    for (int i = 0; i < 2; ++i) { st[i][0] = (f32x4){0.f, 0.f, 0.f, 0.f}; st[i][1] = st[i][0]; }
    const int vcol = h * 128 + sl * 32;
    const int is = (tid & 255) >> 2, ipart = tid & 3;
    const bool outw = wave < 4;
    const int w4 = wave & 3;
    const GAS unsigned char* Ag0 = ws + WS_ATT + (size_t)(p * 128) * 8192 + w4 * 2048 + lane * 16;
    const GAS unsigned char* Qg0 = ws + WS_QTG + (size_t)(p * 128) * 16384 + w4 * 4096 + lane * 16;
    const GAS unsigned char* Kg0 = ws + WS_KENDT + (size_t)(p * 128) * 16384 + w4 * 4096 + lane * 16;
    const GAS unsigned char* Dg0 = ws + WS_HGDEC + ((size_t)(p * 128) * 128 + w4 * 32 + 4 * fq) * 4;
    const GAS unsigned char* Ig0 = ws + WS_GI + ((size_t)(bl * SEQ + is) * 1024 + vcol + ipart * 8) * 2;
    const GAS unsigned char* gb0 = outw ? Ag0 : Kg0;          const unsigned gs0 = outw ? 8192u : 16384u;
    const GAS unsigned char* gb1 = outw ? Qg0 : Kg0 + 2048;   const unsigned gs1 = 16384u;
    const GAS unsigned char* gb2 = outw ? Qg0 + 2048 : Dg0;   const unsigned gs2 = outw ? 16384u : 512u, gt2 = outw ? 1024u : 64u;
    const GAS unsigned char* gb3 = outw ? Ig0 : Dg0;          const unsigned gs3 = outw ? 131072u : 512u;
    u32x4 pf[HG_PD][7];
#define HG_LD01(k_, cc_) do { _Pragma("unroll") for (int j_ = 0; j_ < 2; ++j_) pf[k_][j_] = *(const GAS u32x4*)(gb0 + (size_t)(cc_) * gs0 + j_ * 1024); } while (0)
#define HG_LD23(k_, cc_) do { _Pragma("unroll") for (int j_ = 0; j_ < 2; ++j_) pf[k_][2 + j_] = *(const GAS u32x4*)(gb1 + (size_t)(cc_) * gs1 + j_ * 1024); } while (0)
#define HG_LD45(k_, cc_) do { _Pragma("unroll") for (int j_ = 0; j_ < 2; ++j_) pf[k_][4 + j_] = *(const GAS u32x4*)(gb2 + (size_t)(cc_) * gs2 + j_ * gt2); } while (0)
#define HG_LD6(k_, cc_) do { pf[k_][6] = *(const GAS u32x4*)(gb3 + (size_t)(cc_) * gs3); } while (0)
#pragma unroll
    for (int k = 0; k < HG_PD; ++k) { HG_LD01(k, k); HG_LD23(k, k); HG_LD45(k, k); __builtin_amdgcn_sched_barrier(0); HG_LD6((k + 1) % HG_PD, (k + 1 < HG_PD ? k + 1 : HG_PD)); __builtin_amdgcn_sched_barrier(0); }
    const GAS unsigned char* pfp; unsigned pfstride;
    { const int tt = (wave * 64 + lane) < 160 ? wave * 64 + lane : 159; const int idx = sl * 10 + (tt >> 4), off = (tt & 15) * 64;
      pfp = (idx < 8 ? ws + WS_ATT + (size_t)(p * 128) * 8192 + idx * 1024 : idx < 24 ? ws + WS_QTG + (size_t)(p * 128) * 16384 + (idx - 8) * 1024 : ws + WS_KENDT + (size_t)(p * 128) * 16384 + (idx - 24) * 1024) + off;
      pfstride = idx < 8 ? 8192u : 16384u; }
    unsigned pfv[HG_PD];
#pragma unroll
    for (int k = 0; k < HG_PD; ++k) pfv[k] = 0u;
#define HG_STAGE(dst_, iv_) do { LAS unsigned char* d0_ = (dst_) + (ipart * 8) * IP + is * 2; \
        *(LAS bf16_t*)(d0_ + 0 * IP) = (bf16_t)((iv_).x & 0xffffu); *(LAS bf16_t*)(d0_ + 1 * IP) = (bf16_t)((iv_).x >> 16); \
        *(LAS bf16_t*)(d0_ + 2 * IP) = (bf16_t)((iv_).y & 0xffffu); *(LAS bf16_t*)(d0_ + 3 * IP) = (bf16_t)((iv_).y >> 16); \
        *(LAS bf16_t*)(d0_ + 4 * IP) = (bf16_t)((iv_).z & 0xffffu); *(LAS bf16_t*)(d0_ + 5 * IP) = (bf16_t)((iv_).z >> 16); \
        *(LAS bf16_t*)(d0_ + 6 * IP) = (bf16_t)((iv_).w & 0xffffu); *(LAS bf16_t*)(d0_ + 7 * IP) = (bf16_t)((iv_).w >> 16); } while (0)
    if (outw) { const u32x4 iv = *(const GAS u32x4*)Ig0; HG_STAGE(IT, iv); }
#pragma unroll 1
    for (int c0 = 0; c0 < 128; c0 += HG_PD) {
#pragma unroll
      for (int k = 0; k < HG_PD; ++k) {
        const int c = c0 + k;
        const int tl0 = bl * SEQ + c * 64;
        const int cn = (c + HG_PD < 128) ? c + HG_PD : 127;
        LAS unsigned char* it_ = IT + (k & 1) * ITB; LAS unsigned char* itn = IT + ((k + 1) & 1) * ITB; LAS unsigned char* st_ = ST + (k & 1) * STB; LAS unsigned char* stn = ST + ((k + 1) & 1) * STB;
        LDS_BAR();
        if (wave < 3) { asm volatile("" :: "v"(pfv[k])); const int c7 = (c + HG_PD + 3 < 128) ? c + HG_PD + 3 : 127; pfv[k] = *(const GAS unsigned*)(pfp + (size_t)c7 * pfstride); }
        bf16x8 itf[2][2];
#pragma unroll
        for (int vt = 0; vt < 2; ++vt)
#pragma unroll
            for (int ks = 0; ks < 2; ++ks) itf[vt][ks] = lfrag(it_, IP, vt * 16 + fr, ks * 32, fq);
        bf16x8 sf[2][4];
        f32x4 acc[2];
        acc[0] = (f32x4){0.f, 0.f, 0.f, 0.f}; acc[1] = acc[0];
        if (outw) {
#pragma unroll
            for (int vt = 0; vt < 2; ++vt)
#pragma unroll
                for (int ks = 0; ks < 4; ++ks) sf[vt][ks] = lfrag(st_, PS_PITCH, vt * 16 + fr, ks * 32, fq);
#pragma unroll
            for (int ks = 0; ks < 2; ++ks)
#pragma unroll
                for (int vt = 0; vt < 2; ++vt) acc[vt] = MFMA16(itf[vt][ks], __builtin_bit_cast(bf16x8, pf[k][ks]), acc[vt]);
        } else {
            const f32x4 dec = __builtin_bit_cast(f32x4, pf[k][4]);
#pragma unroll
            for (int vt = 0; vt < 2; ++vt) { st[0][vt] = st[0][vt] * dec;
#pragma unroll
                for (int ks = 0; ks < 2; ++ks) st[0][vt] = MFMA16(__builtin_bit_cast(bf16x8, pf[k][ks]), itf[vt][ks], st[0][vt]); }
        }
        __builtin_amdgcn_sched_barrier(0);
        HG_LD01(k, cn);
        __builtin_amdgcn_sched_barrier(0);
        if (outw) {
#pragma unroll
            for (int ks = 0; ks < 2; ++ks)
#pragma unroll
                for (int vt = 0; vt < 2; ++vt) acc[vt] = MFMA16(sf[vt][ks], __builtin_bit_cast(bf16x8, pf[k][2 + ks]), acc[vt]);
        } else {
            const f32x4 dec = __builtin_bit_cast(f32x4, pf[k][5]);
#pragma unroll
            for (int vt = 0; vt < 2; ++vt) { st[1][vt] = st[1][vt] * dec;
#pragma unroll
                for (int ks = 0; ks < 2; ++ks) st[1][vt] = MFMA16(__builtin_bit_cast(bf16x8, pf[k][2 + ks]), itf[vt][ks], st[1][vt]); }
        }
        __builtin_amdgcn_sched_barrier(0);
        HG_LD23(k, cn);
        __builtin_amdgcn_sched_barrier(0);
        if (outw) {
#pragma unroll
            for (int ks = 2; ks < 4; ++ks)
#pragma unroll
                for (int vt = 0; vt < 2; ++vt) acc[vt] = MFMA16(sf[vt][ks], __builtin_bit_cast(bf16x8, pf[k][2 + ks]), acc[vt]);
        } else {
#pragma unroll
            for (int dtile = 0; dtile < 2; ++dtile)
#pragma unroll
                for (int vt = 0; vt < 2; ++vt) { u32x2 o; o.x = pk2(st[dtile][vt][0], st[dtile][vt][1]); o.y = pk2(st[dtile][vt][2], st[dtile][vt][3]);
                    *(LAS u32x2*)(stn + (vt * 16 + fr) * PS_PITCH + (w4 * 32 + dtile * 16 + 4 * fq) * 2) = o; }
        }
        __builtin_amdgcn_sched_barrier(0);
        HG_LD45(k, cn);
        __builtin_amdgcn_sched_barrier(0);
        if (outw) {
            HG_STAGE(itn, pf[(k + 1) % HG_PD][6]);
            GAS bf16_t* og = (GAS bf16_t*)(ws + WS_GQ) + (size_t)(tl0 + w4 * 16 + fr) * 1024 + vcol + 4 * fq;
#pragma unroll
            for (int vt = 0; vt < 2; ++vt) { u32x2 o; o.x = pk2(acc[vt][0], acc[vt][1]); o.y = pk2(acc[vt][2], acc[vt][3]); *(GAS u32x2*)(og + vt * 16) = o; }
        }
        __builtin_amdgcn_sched_barrier(0);
        { const int cni = (c + 1 + HG_PD < 128) ? c + 1 + HG_PD : 127; HG_LD6((k + 1) % HG_PD, cni); }
        __builtin_amdgcn_sched_barrier(0);
      }
    }
#pragma unroll
    for (int k = 0; k < HG_PD; ++k) asm volatile("" :: "v"(pfv[k]));
    __syncthreads();
#undef HG_LD01
#undef HG_LD23
#undef HG_LD45
#undef HG_LD6
#undef HG_STAGE
}

__device__ __forceinline__ void phase_ypass(const DArgs& a, int round, int vcu, int G) {
    const int tid = tid_(), lane = tid & 63, wave = tid >> 6;
    const int gw = vcu * NWAVES + wave, NGW = G * NWAVES;
    GAS unsigned char* ws = a.ws;
    f32x4 mg0[4], mg1[4], gg4[4];
#pragma unroll
    for (int j = 0; j < 4; ++j) { mg0[j] = *(const GAS f32x4*)(a.m_head_g + j * 512 + lane * 8); mg1[j] = *(const GAS f32x4*)(a.m_head_g + j * 512 + lane * 8 + 4); gg4[j] = *(const GAS f32x4*)(a.g_head_g + lane * 16 + 4 * j); }
    for (int tl = gw; tl < RT; tl += NGW) {
        const size_t tg = (size_t)round * RT + tl;
        const f32x4 den4 = *(const f32x4*)((const float*)(ws + WS_DEN) + tg * 4), mt4 = *(const f32x4*)((const float*)(ws + WS_MT) + tg * 4);
#pragma unroll
        for (int j = 0; j < 4; ++j) {
            const int col = j * 512 + lane * 8;
            const u32x4 nv = *(const u32x4*)((const bf16_t*)(ws + WS_QKPRE) + (size_t)tl * 2048 + col);
            const u32x4 ov = *(const u32x4*)((const bf16_t*)(ws + WS_SIGO) + (size_t)tl * 2048 + col);
            const float inv = 1.0f / fmaxf(fabsf(den4[j]), __expf(-mt4[j]));
            float hv[8] = {bf_lo(nv.x) * inv, bf_hi(nv.x) * inv, bf_lo(nv.y) * inv, bf_hi(nv.y) * inv, bf_lo(nv.z) * inv, bf_hi(nv.z) * inv, bf_lo(nv.w) * inv, bf_hi(nv.w) * inv};
            float ss = 0.f;
#pragma unroll
            for (int e = 0; e < 8; ++e) ss += hv[e] * hv[e];
            const float r = rsqrtf(wave_sum(ss, lane) * (1.f / 512.f) + EPS);
            const f32x4 g0 = mg0[j], g1 = mg1[j];
            const float og[8] = {bf_lo(ov.x), bf_hi(ov.x), bf_lo(ov.y), bf_hi(ov.y), bf_lo(ov.z), bf_hi(ov.z), bf_lo(ov.w), bf_hi(ov.w)};
            float y[8];
#pragma unroll
            for (int e = 0; e < 8; ++e) y[e] = og[e] * hv[e] * r * (e < 4 ? g0[e] : g1[e - 4]);
            u32x4 o; o.x = pk2(y[0], y[1]); o.y = pk2(y[2], y[3]); o.z = pk2(y[4], y[5]); o.w = pk2(y[6], y[7]);
            *(u32x4*)((bf16_t*)(ws + WS_V) + (size_t)tl * 2048 + col) = o;
        }
        {
            const int col = lane * 16;
            const u32x4 n0 = *(const u32x4*)((const bf16_t*)(ws + WS_GQ) + (size_t)tl * 1024 + col), n1 = *(const u32x4*)((const bf16_t*)(ws + WS_GQ) + (size_t)tl * 1024 + col + 8);
            const u32x4 s0 = *(const u32x4*)((const bf16_t*)(ws + WS_SGG) + (size_t)tl * 1024 + col), s1 = *(const u32x4*)((const bf16_t*)(ws + WS_SGG) + (size_t)tl * 1024 + col + 8);
            float ov[16] = {bf_lo(n0.x), bf_hi(n0.x), bf_lo(n0.y), bf_hi(n0.y), bf_lo(n0.z), bf_hi(n0.z), bf_lo(n0.w), bf_hi(n0.w), bf_lo(n1.x), bf_hi(n1.x), bf_lo(n1.y), bf_hi(n1.y), bf_lo(n1.z), bf_hi(n1.z), bf_lo(n1.w), bf_hi(n1.w)};
            const float sg[16] = {bf_lo(s0.x), bf_hi(s0.x), bf_lo(s0.y), bf_hi(s0.y), bf_lo(s0.z), bf_hi(s0.z), bf_lo(s0.w), bf_hi(s0.w), bf_lo(s1.x), bf_hi(s1.x), bf_lo(s1.y), bf_hi(s1.y), bf_lo(s1.z), bf_hi(s1.z), bf_lo(s1.w), bf_hi(s1.w)};
            float ss = 0.f;
#pragma unroll
            for (int e = 0; e < 16; ++e) ss += ov[e] * ov[e];
            ss += DPP_(ss, 0xB1); ss += DPP_(ss, 0x4E); ss += DPP_(ss, 0x141);
            const float r = rsqrtf(ss * (1.f / 128.f) + EPS);
            float y[16];
#pragma unroll
            for (int e = 0; e < 16; ++e) y[e] = ov[e] * r * gg4[e >> 2][e & 3] * sg[e];
            u32x4 o; o.x = pk2(y[0], y[1]); o.y = pk2(y[2], y[3]); o.z = pk2(y[4], y[5]); o.w = pk2(y[6], y[7]);
            *(u32x4*)((bf16_t*)(ws + WS_GI) + (size_t)tl * 1024 + col) = o;
            o.x = pk2(y[8], y[9]); o.y = pk2(y[10], y[11]); o.z = pk2(y[12], y[13]); o.w = pk2(y[14], y[15]);
            *(u32x4*)((bf16_t*)(ws + WS_GI) + (size_t)tl * 1024 + col + 8) = o;
        }
    }
}


#define XB_TMO      128
#define XB_XCNT(j)  (256  + 64 * (j))
#define XB_XSUB(j)  (1280 + 64 * (j))
#define XB_XGEN(j)  (2304 + 64 * (j))
#define XB_TOP      3328
#define XB_TOPGEN   3392
#define XB_SPIN_CAP (1u << 22)
constexpr int CW_BAR = 4096;
constexpr int LDS_BARST = LDS_BYTES - 64;
__device__ __forceinline__ unsigned xb_ld(unsigned* p)              { return __hip_atomic_load(p, __ATOMIC_RELAXED, __HIP_MEMORY_SCOPE_AGENT); }
__device__ __forceinline__ unsigned xb_add(unsigned* p, unsigned v) { return __hip_atomic_fetch_add(p, v, __ATOMIC_RELAXED, __HIP_MEMORY_SCOPE_AGENT); }
__device__ __forceinline__ unsigned xb_xcc_id() { return (unsigned)__builtin_amdgcn_s_getreg((3 << 11) | 20) & 0xFu; }
#define XB_SPIN(cond, bar) do { unsigned _sp = 0; while (cond) { __builtin_amdgcn_s_sleep(1); \
    if ((++_sp & 255u) == 0u) { if (xb_ld(&(bar)[XB_TMO])) break; if (_sp > XB_SPIN_CAP) { atomicAdd(&(bar)[XB_TMO], 1u); break; } } } } while (0)
__device__ __forceinline__ void xcd_barrier_post(unsigned* bar, volatile LAS unsigned* st) { if (tid_() == 0) st[2] = xb_add(&bar[XB_XCNT(xb_xcc_id())], 1u); }
__device__ __forceinline__ void xcd_barrier_complete(unsigned* bar, unsigned x, unsigned& nloc, unsigned& nx) {
    const unsigned G = gridDim.x;
    unsigned sum, cnt, mine, sp = 0u;
    for (;;) {
        sum = 0u; cnt = 0u; mine = 0u;
#pragma unroll
        for (unsigned j = 0; j < 16; ++j) { const unsigned c = xb_ld(&bar[XB_XCNT(j)]); sum += c; cnt += (c > 0u) ? 1u : 0u; mine = (j == x) ? c : mine; }
        if (sum == G) break;
        __builtin_amdgcn_s_sleep(1);
        if ((++sp & 255u) == 0u) { if (xb_ld(&bar[XB_TMO])) break; if (sp > XB_SPIN_CAP) { atomicAdd(&bar[XB_TMO], 1u); break; } }
    }
    nloc = mine > 0u ? mine : 1u; nx = cnt > 0u ? cnt : 1u;
}
__device__ __forceinline__ void xcd_barrier(unsigned* bar, volatile LAS unsigned* st) {
    asm volatile("s_waitcnt vmcnt(0)" ::: "memory");
    __syncthreads();
    if (tid_() == 0) {
        const unsigned x = xb_xcc_id();
        __builtin_amdgcn_s_waitcnt(0);
        unsigned nloc = st[0], nx = st[1];
        if (nloc == 0u) { xcd_barrier_complete(bar, x, nloc, nx); st[0] = nloc; st[1] = nx; }
        const unsigned old = xb_add(&bar[XB_XSUB(x)], 1u);
        const unsigned gen = old / nloc;
        if (old + 1u == (gen + 1u) * nloc) {
            __builtin_amdgcn_fence(__ATOMIC_RELEASE, "agent");
            asm volatile("s_waitcnt vmcnt(0)" ::: "memory");
            const unsigned og = xb_add(&bar[XB_TOP], 1u);
            const unsigned tg = og / nx;
            if (og + 1u == (tg + 1u) * nx) xb_add(&bar[XB_TOPGEN], 1u);
            else XB_SPIN(xb_ld(&bar[XB_TOPGEN]) == tg, bar);
            __builtin_amdgcn_fence(__ATOMIC_ACQUIRE, "agent");
            xb_add(&bar[XB_XGEN(x)], 1u);
            asm volatile("s_waitcnt vmcnt(0)" ::: "memory");
        } else {
            XB_SPIN(xb_ld(&bar[XB_XGEN(x)]) == gen, bar);
            __builtin_amdgcn_fence(__ATOMIC_ACQUIRE, "agent");
            asm volatile("s_waitcnt vmcnt(0)" ::: "memory");
        }
    }
    __syncthreads();
}

__device__ __forceinline__ void phase_p8(const DArgs& a, int vcu, int G) {
    const int tid = tid_(), lane = tid & 63, wave = tid >> 6;
    const int gw = vcu * NWAVES + wave, NGW = G * NWAVES;
    GAS unsigned char* ws = a.ws;
    f32x4 g2[4];
#pragma unroll
    for (int j = 0; j < 4; ++j) g2[j] = ((const f32x4*)a.norm2_g)[64 * j + lane];
    for (int m = gw; m < T; m += NGW) {
        const f32x4* xr = (const f32x4*)(a.out + (size_t)m * D) + lane;
        f32x4 v[4]; float s = 0.f;
#pragma unroll
        for (int j = 0; j < 4; ++j) { v[j] = xr[64 * j]; s += (v[j][0] * v[j][0] + v[j][1] * v[j][1]) + (v[j][2] * v[j][2] + v[j][3] * v[j][3]); }
        const float rstd = rsqrtf(wave_sum(s, lane) * (1.f / D) + EPS);
        unsigned long long* o8 = (unsigned long long*)((bf16_t*)(ws + WS_XN) + (size_t)m * D) + lane;
#pragma unroll
        for (int j = 0; j < 4; ++j) { v[j] = v[j] * rstd * g2[j]; o8[64 * j] = (unsigned long long)pk2(v[j][0], v[j][1]) | ((unsigned long long)pk2(v[j][2], v[j][3]) << 32); }
    }
    {
        const float mu = __builtin_bit_cast(float, ((const GAS unsigned*)(ws + WS_CTL))[CW_TMAX]), mv = __builtin_bit_cast(float, ((const GAS unsigned*)(ws + WS_CTL))[CW_TMAX + 1]);
        const float su = mu > 0.f ? 448.0f / mu : 1.0f, sv = mv > 0.f ? 448.0f / mv : 1.0f;
        if (vcu == 0 && tid == 0) { ((GAS float*)(ws + WS_USC))[0] = 1.0f / su; ((GAS float*)(ws + WS_USC))[1] = 1.0f / sv; }
        for (size_t i = (size_t)vcu * NTHR + tid; i < (size_t)16384 * 1024 / 8; i += (size_t)G * NTHR) {
            const f32x4 u0 = ((const GAS f32x4*)a.u_emb)[2 * i], u1 = ((const GAS f32x4*)a.u_emb)[2 * i + 1];
            const f32x4 v0 = ((const GAS f32x4*)a.v_emb)[2 * i], v1 = ((const GAS f32x4*)a.v_emb)[2 * i + 1];
            u32x2 o; int p;
            p = __builtin_amdgcn_cvt_pk_fp8_f32(u0[0] * su, u0[1] * su, 0, false); p = __builtin_amdgcn_cvt_pk_fp8_f32(u0[2] * su, u0[3] * su, p, true); o.x = (unsigned)p;
            p = __builtin_amdgcn_cvt_pk_fp8_f32(u1[0] * su, u1[1] * su, 0, false); p = __builtin_amdgcn_cvt_pk_fp8_f32(u1[2] * su, u1[3] * su, p, true); o.y = (unsigned)p;
            const size_t io = (size_t)((i & 127) >> 4) * 262144 + (i >> 7) * 16 + (i & 15);
            ((GAS u32x2*)(ws + WS_UB))[io] = o;
            p = __builtin_amdgcn_cvt_pk_fp8_f32(v0[0] * sv, v0[1] * sv, 0, false); p = __builtin_amdgcn_cvt_pk_fp8_f32(v0[2] * sv, v0[3] * sv, p, true); o.x = (unsigned)p;
            p = __builtin_amdgcn_cvt_pk_fp8_f32(v1[0] * sv, v1[1] * sv, 0, false); p = __builtin_amdgcn_cvt_pk_fp8_f32(v1[2] * sv, v1[3] * sv, p, true); o.y = (unsigned)p;
            ((GAS u32x2*)(ws + WS_VB))[io] = o;
        }
    }
}

__device__ __forceinline__ unsigned f2ord(float f) { const unsigned u = __builtin_bit_cast(unsigned, f); return (u & 0x80000000u) ? ~u : (u | 0x80000000u); }
__device__ __forceinline__ float ord2f(unsigned k) { const unsigned u = (k & 0x80000000u) ? (k & 0x7fffffffu) : ~k; return __builtin_bit_cast(float, u); }
__device__ __forceinline__ unsigned umax_(unsigned a, unsigned b) { return a > b ? a : b; }
__device__ __forceinline__ unsigned shxu(unsigned v, int o, int lane) { return (unsigned)__builtin_amdgcn_ds_bpermute((lane ^ o) << 2, (int)v); }

__device__ __forceinline__ void phase_topk(const DArgs& a, LAS unsigned char* lds, int bx, int G) {
    const int tid = tid_(), lane = tid & 63, wave = __builtin_amdgcn_readfirstlane(tid >> 6), fr = lane & 15, fq = lane >> 4;
    GAS unsigned char* ws = a.ws;
    const int h = bx & 7;
    LAS unsigned char* KY = lds;
    LAS unsigned char* QL = lds + 2 * 128 * PS_PITCH;
    LAS unsigned* TOP = (LAS unsigned*)(lds + 2 * 128 * PS_PITCH + 64 * PQ_PITCH);
#pragma unroll
    for (int i = 0; i < 8; ++i) { const int idx = tid + 512 * i, row = idx >> 4, ch = idx & 15;
        *(LAS u32x4*)(KY + row * PS_PITCH + ch * 16) = *(const u32x4*)((const bf16_t*)(ws + WS_SK) + ((size_t)h * 256 + row) * 128 + ch * 8); }
    const int ntile = T / 64;
    for (int tile = bx >> 3; tile < ntile; tile += (G >> 3)) {
        const size_t t0 = (size_t)tile * 64;
        __syncthreads();
#pragma unroll
        for (int i = 0; i < 4; ++i) { const int idx = tid + 512 * i, row = idx >> 5, ch = idx & 31;
            *(LAS u32x4*)(QL + row * PQ_PITCH + ch * 16) = *(const u32x4*)((const bf16_t*)(ws + WS_QP) + (t0 + row) * 2048 + h * 256 + ch * 8); }
        __syncthreads();
        {
            const int mt = wave & 3, p = wave >> 2;
            unsigned key[32];
#pragma unroll
            for (int nt = 0; nt < 8; ++nt) { f32x4 acc = (f32x4){0.f, 0.f, 0.f, 0.f};
#pragma unroll
                for (int ks = 0; ks < 4; ++ks) acc = MFMA16(lfrag(KY + p * 128 * PS_PITCH, PS_PITCH, nt * 16 + fr, ks * 32, fq), lfrag(QL, PQ_PITCH, mt * 16 + fr, p * 128 + ks * 32, fq), acc);
#pragma unroll
                for (int j = 0; j < 4; ++j) { const int n = nt * 16 + 4 * fq + j; key[nt * 4 + j] = (f2ord(acc[j]) & ~127u) | (unsigned)(127 - n); } }
#pragma unroll 1
            for (int k = 0; k < 16; ++k) {
                unsigned m = key[0];
#pragma unroll
                for (int e = 1; e < 32; ++e) m = umax_(m, key[e]);
                m = umax_(m, (unsigned)SWZI_(m, 0x401F)); m = umax_(m, xor32u_(m, lane >= 32));
#pragma unroll
                for (int e = 0; e < 32; ++e) key[e] = (key[e] == m) ? 0u : key[e];
                if (fq == (k & 3)) TOP[(p * 64 + mt * 16 + fr) * 16 + k] = m;
            }
        }
        __syncthreads();
        {
            const int t = tid >> 3, sub = tid & 7;
            unsigned ck[7];
#pragma unroll
            for (int e = 0; e < 7; ++e) {
                const int ci = sub + 8 * e;
                int i = 0, base = 0; bool ok = ci < 50;
                if (ci >= 42) { i = 8 + (ci - 42); base = ci; } else if (ci >= 40) { i = 7; base = 40; } else if (ci >= 38) { i = 6; base = 38; } else if (ci >= 36) { i = 5; base = 36; }
                else if (ci >= 33) { i = 4; base = 33; } else if (ci >= 29) { i = 3; base = 29; } else if (ci >= 24) { i = 2; base = 24; } else if (ci >= 16) { i = 1; base = 16; }
                const int j = ci - base;
                unsigned kk = 0u;
                if (ok) { const float s0 = ord2f(TOP[(0 * 64 + t) * 16 + i] & ~127u), s1 = ord2f(TOP[(1 * 64 + t) * 16 + j] & ~127u);
                    kk = (f2ord(s0 + s1) & ~255u) | (unsigned)(255 - (i * 16 + j)); }
                ck[e] = kk;
            }
            unsigned w0 = 0u, w1 = 0u;
#pragma unroll 1
            for (int k = 0; k < 16; ++k) {
                unsigned m = ck[0];
#pragma unroll
                for (int e = 1; e < 7; ++e) m = umax_(m, ck[e]);
                m = umax_(m, (unsigned)DPPI_(m, 0xB1)); m = umax_(m, (unsigned)DPPI_(m, 0x4E)); m = umax_(m, (unsigned)DPPI_(m, 0x141));
#pragma unroll
                for (int e = 0; e < 7; ++e) ck[e] = (ck[e] == m) ? 0u : ck[e];
                if (k == sub) w0 = m; if (k == sub + 8) w1 = m;
            }
            const int f0 = 255 - (int)(w0 & 255u), f1 = 255 - (int)(w1 & 255u);
            const float sc0 = ord2f(w0 & ~255u), sc1 = ord2f(w1 & ~255u);
            float mx = fmaxf(sc0, sc1); mx = fmaxf(mx, DPP_(mx, 0xB1)); mx = fmaxf(mx, DPP_(mx, 0x4E)); mx = fmaxf(mx, DPP_(mx, 0x141));
            const float e0 = __expf(sc0 - mx), e1 = __expf(sc1 - mx);
            float sm = e0 + e1; sm += DPP_(sm, 0xB1); sm += DPP_(sm, 0x4E); sm += DPP_(sm, 0x141);
            const float inv = 1.0f / sm;
            const int i0 = 127 - (int)(TOP[(0 * 64 + t) * 16 + (f0 >> 4)] & 127u), j0 = 127 - (int)(TOP[(1 * 64 + t) * 16 + (f0 & 15)] & 127u);
            const int i1 = 127 - (int)(TOP[(0 * 64 + t) * 16 + (f1 >> 4)] & 127u), j1 = 127 - (int)(TOP[(1 * 64 + t) * 16 + (f1 & 15)] & 127u);
            int* ei = (int*)(ws + WS_EIDX) + ((t0 + t) * 8 + h) * 16; float* gp = (float*)(ws + WS_GATE) + ((t0 + t) * 8 + h) * 16;
            ei[sub] = i0 * 128 + j0; ei[sub + 8] = i1 * 128 + j1; gp[sub] = e0 * inv; gp[sub + 8] = e1 * inv;
        }
    }
    __syncthreads();
}

__device__ __forceinline__ void ins16(float (&v)[16], int (&id)[16], float x, int n) {
    if (x > v[15]) { v[15] = x; id[15] = n;
#pragma unroll
        for (int i = 15; i >= 1; --i) { if (v[i] > v[i - 1]) { const float tv = v[i]; v[i] = v[i - 1]; v[i - 1] = tv; const int ti = id[i]; id[i] = id[i - 1]; id[i - 1] = ti; } } }
}
__device__ __forceinline__ void phase_topk_ref(const DArgs& a, int vcu, int G) {
    const int tid = tid_();
    GAS unsigned char* ws = a.ws;
    const int gt = vcu * NTHR + tid, NGT = G * NTHR;
    for (int pair = gt; pair < T * 8; pair += NGT) {
        const int t = pair >> 3, h = pair & 7;
        float sv[2][16]; int si[2][16];
#pragma unroll
        for (int p = 0; p < 2; ++p) {
#pragma unroll
            for (int i = 0; i < 16; ++i) { sv[p][i] = -INFINITY; si[p][i] = 0; }
            const bf16_t* qp = (const bf16_t*)(ws + WS_QP) + (size_t)t * 2048 + h * 256 + p * 128;
            for (int n = 0; n < 128; ++n) {
                const bf16_t* kp = (const bf16_t*)(ws + WS_SK) + ((size_t)(h * 2 + p) * 128 + n) * 128;
                float s = 0.f;
                for (int c = 0; c < 128; c += 8) { const u32x4 qv = *(const u32x4*)(qp + c), kv = *(const u32x4*)(kp + c);
                    s += bf_lo(qv.x) * bf_lo(kv.x) + bf_hi(qv.x) * bf_hi(kv.x) + bf_lo(qv.y) * bf_lo(kv.y) + bf_hi(qv.y) * bf_hi(kv.y)
                       + bf_lo(qv.z) * bf_lo(kv.z) + bf_hi(qv.z) * bf_hi(kv.z) + bf_lo(qv.w) * bf_lo(kv.w) + bf_hi(qv.w) * bf_hi(kv.w); }
                ins16(sv[p], si[p], s, n);
            }
        }
        float tv[16]; int ti[16];
#pragma unroll
        for (int i = 0; i < 16; ++i) { tv[i] = -INFINITY; ti[i] = 0; }
#pragma unroll
        for (int i = 0; i < 16; ++i)
#pragma unroll
            for (int j = 0; j < 16; ++j) ins16(tv, ti, sv[0][i] + sv[1][j], i * 16 + j);
        float sm = 0.f, ex[16];
#pragma unroll
        for (int k = 0; k < 16; ++k) { ex[k] = __expf(tv[k] - tv[0]); sm += ex[k]; }
        int* ei = (int*)(ws + WS_EIDX) + (size_t)pair * 16; float* gp = (float*)(ws + WS_GATE) + (size_t)pair * 16;
#pragma unroll
        for (int k = 0; k < 16; ++k) {
            int e0 = 0, e1 = 0;
#pragma unroll
            for (int i = 0; i < 16; ++i) { e0 = ((ti[k] >> 4) == i) ? si[0][i] : e0; e1 = ((ti[k] & 15) == i) ? si[1][i] : e1; }
            ei[k] = e0 * 128 + e1; gp[k] = ex[k] / sm; }
    }
}

#define FP8LO(w) __builtin_amdgcn_cvt_pk_f32_fp8((int)(w), false)
#define FP8HI(w) __builtin_amdgcn_cvt_pk_f32_fp8((int)(w), true)
__device__ __forceinline__ float dot16_fp8(const u32x4 r, const float (&x)[16]) {
    float c = 0.f;
#pragma unroll
    for (int j = 0; j < 4; ++j) { const f32x2 lo = FP8LO(r[j]), hi = FP8HI(r[j]); c += lo[0] * x[4 * j] + lo[1] * x[4 * j + 1] + hi[0] * x[4 * j + 2] + hi[1] * x[4 * j + 3]; }
    return c;
}
__device__ __forceinline__ float dot16_fp8p(const u32x4 r, const f32x2 (&xp)[8]) {
    f32x2 c2 = (f32x2){0.f, 0.f};
#pragma unroll
    for (int j = 0; j < 4; ++j) { c2 += FP8LO(r[j]) * xp[2 * j]; c2 += FP8HI(r[j]) * xp[2 * j + 1]; }
    return c2[0] + c2[1];
}
__device__ __forceinline__ float gelu_erf(float d) {
    const float ad = fabsf(d), t = __builtin_amdgcn_rcpf(ad * 0.2316418882f + 1.0f);
    float q = t * 0.5307027145f + (-0.7265760135f); q = q * t + 0.7107068705f; q = q * t + (-0.142248368f); q = q * t + 0.127414796f; q = q * t;
    const float m = d * (q * __builtin_amdgcn_exp2f(d * d * (-0.72134752044f)));
    return d < 0.f ? m : d - m;
}
__device__ __forceinline__ float bperm(float v, int srclane) { return __builtin_bit_cast(float, __builtin_amdgcn_ds_bpermute(srclane << 2, __builtin_bit_cast(int, v))); }
#define SWZ_(v, pat) __builtin_bit_cast(float, __builtin_amdgcn_ds_swizzle(__builtin_bit_cast(int, (v)), (pat)))
__device__ __forceinline__ float rs32_(float a, float b) {
#if defined(__HIP_DEVICE_COMPILE__)
    asm volatile("s_nop 1\n\tv_permlane32_swap_b32 %0, %1" : "+v"(a), "+v"(b));
#endif
    return a + b;
}
__device__ __forceinline__ float rs16_(float a, float b) {
#if defined(__HIP_DEVICE_COMPILE__)
    asm volatile("s_nop 1\n\tv_permlane16_swap_b32 %0, %1" : "+v"(a), "+v"(b));
#endif
    return a + b;
}
__device__ __forceinline__ float rs8_(float a, float b, bool bit3) {
    const float send = bit3 ? a : b, keep = bit3 ? b : a;
    return keep + DPP_(send, 0x128);
}
__device__ __forceinline__ float xor32_(float v, bool hi) {
#if defined(__HIP_DEVICE_COMPILE__)
    const auto r = __builtin_amdgcn_permlane32_swap(__builtin_bit_cast(unsigned, v), __builtin_bit_cast(unsigned, v), false, false);
    return __builtin_bit_cast(float, hi ? r[0] : r[1]);
#else
    (void)hi; return v;
#endif
}
__device__ __forceinline__ float reduce8(const float (&p)[8], int lane) {
    float q4[4], q2[2];
    const bool b5 = lane & 32, b4 = lane & 16, b3 = lane & 8;
#pragma unroll
    for (int i = 0; i < 4; ++i) { const float send = b5 ? p[i] : p[i + 4], keep = b5 ? p[i + 4] : p[i]; q4[i] = keep + xor32_(send, b5); }
#pragma unroll
    for (int i = 0; i < 2; ++i) { const float send = b4 ? q4[i] : q4[i + 2], keep = b4 ? q4[i + 2] : q4[i]; q2[i] = keep + SWZ_(send, 0x401F); }
    const float send = b3 ? q2[0] : q2[1], keep = b3 ? q2[1] : q2[0];
    float q1 = keep + SWZ_(send, 0x201F);
    q1 += DPP_(q1, 0xB1); q1 += DPP_(q1, 0x4E); q1 += DPP_(q1, 0x141);
    return q1;
}
__device__ __forceinline__ void phase_udots(const DArgs& a, LAS unsigned char* lds) {
    const int tid = tid_(), lane = tid & 63, wave = __builtin_amdgcn_readfirstlane(tid >> 6);
    GAS unsigned char* ws = a.ws;
    volatile LAS unsigned* bst = (volatile LAS unsigned*)(lds + LDS_BARST);
    const int nloc = (int)bst[0], nx = (int)bst[1], rank = (int)bst[2];
    unsigned* bar = (unsigned*)(ws + WS_CTL) + CW_BAR;
    const unsigned myx = xb_xcc_id();
    int q = 0;
    for (unsigned j = 0; j < 16; ++j) { const unsigned c = xb_ld(&bar[XB_XCNT(j)]); if (c > 0u && j < myx) ++q; }
    LAS int* LE = (LAS int*)(lds + wave * 2048);
    LAS int* LP = LE + 128; LAS float* LG = (LAS float*)(LE + 256);
    const GAS unsigned char* UB = ws + WS_UB;
    const int g8 = lane >> 3;
    const float usc = ((const GAS float*)(ws + WS_USC))[0], vsc = ((const GAS float*)(ws + WS_USC))[1];
    for (int s = q; s < 8; s += nx) {
        int tok = rank * 8 + wave;
        u32x4 xq0 = (u32x4){0u, 0u, 0u, 0u}, xq1 = xq0; u32x2 e2 = (u32x2){0u, 0u}; f32x2 g2 = (f32x2){0.f, 0.f};
#define U_INFO(t_) do { xq0 = *(const u32x4*)((const GAS bf16_t*)(ws + WS_XN) + (size_t)(t_) * D + lane * 16); xq1 = *(const u32x4*)((const GAS bf16_t*)(ws + WS_XN) + (size_t)(t_) * D + lane * 16 + 8); \
        e2 = *(const u32x2*)((const GAS int*)(ws + WS_EIDX) + (size_t)(t_) * 128 + 2 * lane); g2 = *(const f32x2*)((const GAS float*)(ws + WS_GATE) + (size_t)(t_) * 128 + 2 * lane); } while (0)
        if (tok < T) U_INFO(tok);
        for (; tok < T; tok += nloc * 8) {
            const bool in0 = (int)(e2.x >> 11) == s, in1 = (int)(e2.y >> 11) == s;
            const unsigned long long m0 = __ballot(in0), m1 = __ballot(in1);
            const unsigned long long lt = (1ull << lane) - 1ull;
            const int n0 = __popcll(m0), n = n0 + __popcll(m1);
            if (in0) { const int pos = __popcll(m0 & lt); LE[pos] = (int)e2.x; LP[pos] = 2 * lane; LG[pos] = g2[0]; }
            if (in1) { const int pos = n0 + __popcll(m1 & lt); LE[pos] = (int)e2.y; LP[pos] = 2 * lane + 1; LG[pos] = g2[1]; }
            const float xf[16] = {bf_lo(xq0.x), bf_hi(xq0.x), bf_lo(xq0.y), bf_hi(xq0.y), bf_lo(xq0.z), bf_hi(xq0.z), bf_lo(xq0.w), bf_hi(xq0.w),
                                  bf_lo(xq1.x), bf_hi(xq1.x), bf_lo(xq1.y), bf_hi(xq1.y), bf_lo(xq1.z), bf_hi(xq1.z), bf_lo(xq1.w), bf_hi(xq1.w)};
            asm volatile("s_waitcnt lgkmcnt(0)" ::: "memory");
            u32x4 R0[8], R1[8], R2[8];
#define U_ISSUE(R_, g0_) do { _Pragma("unroll") for (int k = 0; k < 8; ++k) { const int slot_ = ((g0_) + k < n) ? (g0_) + k : n - 1; const int e_ = LE[slot_]; R_[k] = *(const u32x4*)(UB + (size_t)e_ * 1024 + lane * 16); } } while (0)
#define U_DOTS(R_, g0_) do { float pp_[8]; _Pragma("unroll") for (int k = 0; k < 8; ++k) pp_[k] = dot16_fp8(R_[k], xf); const float dsum_ = reduce8(pp_, lane); const int slot_ = (g0_) + g8; \
            if (slot_ < n && (lane & 7) == 0) { const float d_ = dsum_ * usc; \
                ((GAS float*)(ws + WS_PW))[(size_t)tok * 128 + LP[slot_]] = 0.5f * d_ * (1.0f + erff(d_ * 0.70710678118654752f)) * LG[slot_] * vsc; } } while (0)
            if (n > 0) U_ISSUE(R0, 0);
            if (n > 8) U_ISSUE(R1, 8);
            if (n > 16) U_ISSUE(R2, 16);
            const int tokN = tok + nloc * 8;
            if (tokN < T) U_INFO(tokN);
            if (n > 0) U_DOTS(R0, 0);
            if (n > 8) U_DOTS(R1, 8);
            if (n > 16) U_DOTS(R2, 16);
            for (int g0 = 24; g0 < n; g0 += 8) { U_ISSUE(R0, g0); U_DOTS(R0, g0); }
            asm volatile("s_waitcnt lgkmcnt(0)" ::: "memory");
        }
#undef U_INFO
#undef U_ISSUE
#undef U_DOTS
    }
}

struct XcdSlice { int nloc, nx, rank, q; };
__device__ __forceinline__ XcdSlice xcd_slice_setup(const DArgs& a, LAS unsigned char* lds) {
    volatile LAS unsigned* bst = (volatile LAS unsigned*)(lds + LDS_BARST);
    XcdSlice x; x.nloc = __builtin_amdgcn_readfirstlane((int)bst[0]); x.nx = __builtin_amdgcn_readfirstlane((int)bst[1]); x.rank = __builtin_amdgcn_readfirstlane((int)bst[2]);
    unsigned* bar = (unsigned*)(a.ws + WS_CTL) + CW_BAR; const unsigned myx = xb_xcc_id();
    x.q = 0; for (unsigned j = 0; j < 16; ++j) { const unsigned c = xb_ld(&bar[XB_XCNT(j)]); if (c > 0u && j < myx) ++x.q; }
    x.q = __builtin_amdgcn_readfirstlane(x.q);
    return x;
}
__device__ __forceinline__ void phase_ua(const DArgs& a, LAS unsigned char* lds) {
    const int tid = tid_(), lane = tid & 63, wave = __builtin_amdgcn_readfirstlane(tid >> 6), k = lane >> 3, c = lane & 7;
    GAS unsigned char* ws = a.ws;
    const XcdSlice X = xcd_slice_setup(a, lds);
    const int tstride = X.nloc * 8;
    for (int sl = X.q; sl < 8; sl += X.nx) {
        const GAS unsigned char* UBs = ws + WS_UB + (size_t)sl * 2097152;
        const unsigned coff = (unsigned)c * 16u;
        GAS unsigned char* PU = ws + WS_PARTU + (size_t)sl * T * 256;
        u32x4 ev[4], RA[16], RB[16], xa0, xa1, xb0, xb1;
#define A_TOK(t_) ((t_) < T ? (t_) : T - 1)
#define A_INFO(ev_, t_) do { const int tq_ = A_TOK(t_); _Pragma("unroll") for (int j_ = 0; j_ < 4; ++j_) ev_[j_] = *(const GAS u32x4*)(ws + WS_EIDX + (size_t)tq_ * 512 + (unsigned)(64 * k + 16 * j_)); } while (0)
#define A_ISSUE(R_, x0_, x1_, ev_, t_) do { const int tq_ = A_TOK(t_); _Pragma("unroll") for (int g_ = 0; g_ < 16; ++g_) R_[g_] = *(const GAS u32x4*)(UBs + (ev_[g_ >> 2][g_ & 3] * 128u + coff)); \
        x0_ = *(const GAS u32x4*)(ws + WS_XN + (size_t)tq_ * (D * 2) + sl * 256 + (unsigned)(c * 32)); x1_ = *(const GAS u32x4*)(ws + WS_XN + (size_t)tq_ * (D * 2) + sl * 256 + (unsigned)(c * 32 + 16)); } while (0)
#define A_DOTS(R_, x0_, x1_, t_) do { \
        const f32x2 xf_[8] = {(f32x2){bf_lo(x0_.x), bf_hi(x0_.x)}, (f32x2){bf_lo(x0_.y), bf_hi(x0_.y)}, (f32x2){bf_lo(x0_.z), bf_hi(x0_.z)}, (f32x2){bf_lo(x0_.w), bf_hi(x0_.w)}, \
                              (f32x2){bf_lo(x1_.x), bf_hi(x1_.x)}, (f32x2){bf_lo(x1_.y), bf_hi(x1_.y)}, (f32x2){bf_lo(x1_.z), bf_hi(x1_.z)}, (f32x2){bf_lo(x1_.w), bf_hi(x1_.w)}}; \
        f32x2 res_ = (f32x2){0.f, 0.f}; \
        _Pragma("unroll") for (int gg_ = 0; gg_ < 4; ++gg_) {           \
            f32x2 c2_[4]; _Pragma("unroll") for (int q_ = 0; q_ < 4; ++q_) c2_[q_] = (f32x2){0.f, 0.f}; \
            _Pragma("unroll") for (int j_ = 0; j_ < 4; ++j_) { _Pragma("unroll") for (int q_ = 0; q_ < 4; ++q_) { c2_[q_] += FP8LO(R_[4 * gg_ + q_][j_]) * xf_[2 * j_]; c2_[q_] += FP8HI(R_[4 * gg_ + q_][j_]) * xf_[2 * j_ + 1]; } } \
            float d_[4]; _Pragma("unroll") for (int q_ = 0; q_ < 4; ++q_) d_[q_] = c2_[q_][0] + c2_[q_][1]; \
            _Pragma("unroll") for (int q_ = 0; q_ < 4; ++q_) d_[q_] += DPP_(d_[q_], 0xB1); \
            _Pragma("unroll") for (int q_ = 0; q_ < 4; ++q_) d_[q_] += DPP_(d_[q_], 0x4E); \
            _Pragma("unroll") for (int q_ = 0; q_ < 4; ++q_) d_[q_] += DPP_(d_[q_], 0x141);          \
            _Pragma("unroll") for (int q_ = 0; q_ < 4; ++q_) { if (c == ((4 * gg_ + q_) >> 1)) res_[q_ & 1] = d_[q_]; }          \
            __builtin_amdgcn_sched_barrier(0); } \
        if ((t_) < T) *(GAS unsigned*)(PU + (size_t)(t_) * 256 + (unsigned)(4 * lane)) = pk2(res_[0], res_[1]); } while (0)
        const int n0 = X.rank * 8 + wave;
        A_INFO(ev, n0);
        __builtin_amdgcn_sched_barrier(0);
        A_ISSUE(RA, xa0, xa1, ev, n0);
        __builtin_amdgcn_sched_barrier(0);
        A_INFO(ev, n0 + tstride);
        __builtin_amdgcn_sched_barrier(0);
#pragma unroll 1
        for (int n = n0; n < T; n += 2 * tstride) {
            A_ISSUE(RB, xb0, xb1, ev, n + tstride);
            __builtin_amdgcn_sched_barrier(0);
            A_INFO(ev, n + 2 * tstride);
            __builtin_amdgcn_sched_barrier(0);
            A_DOTS(RA, xa0, xa1, n);
            __builtin_amdgcn_sched_barrier(0);
            A_ISSUE(RA, xa0, xa1, ev, n + 2 * tstride);
            __builtin_amdgcn_sched_barrier(0);
            A_INFO(ev, n + 3 * tstride);
            __builtin_amdgcn_sched_barrier(0);
            A_DOTS(RB, xb0, xb1, n + tstride);
            __builtin_amdgcn_sched_barrier(0);
        }
#undef A_TOK
#undef A_INFO
#undef A_ISSUE
#undef A_DOTS
    }
}
__device__ __forceinline__ void phase_ua2(const DArgs& a, int vcu, int G) {
    const int tid = tid_();
    GAS unsigned char* ws = a.ws;
    const float usc = ((const GAS float*)(ws + WS_USC))[0], vsc = ((const GAS float*)(ws + WS_USC))[1];
    const GAS unsigned char* PU = ws + WS_PARTU;
    for (size_t i = (size_t)vcu * NTHR + tid; i < (size_t)T * 128 / 4; i += (size_t)G * NTHR) {
        f32x4 d = (f32x4){0.f, 0.f, 0.f, 0.f};
#pragma unroll
        for (int sl = 0; sl < 8; ++sl) { const u32x2 pv = ((const GAS u32x2*)(PU + (size_t)sl * T * 256))[i]; d[0] += bf_lo(pv.x); d[1] += bf_hi(pv.x); d[2] += bf_lo(pv.y); d[3] += bf_hi(pv.y); }
        const f32x4 gt = ((const GAS f32x4*)(ws + WS_GATE))[i];
        f32x4 w;
#pragma unroll
        for (int e = 0; e < 4; ++e) w[e] = gelu_erf(d[e] * usc) * gt[e] * vsc;
        ((GAS f32x4*)(ws + WS_PW))[i] = w;
    }
}
__device__ __forceinline__ void phase_vb(const DArgs& a, LAS unsigned char* lds) {
    const int tid = tid_(), lane = tid & 63, wave = __builtin_amdgcn_readfirstlane(tid >> 6), k = lane >> 3, c = lane & 7;
    GAS unsigned char* ws = a.ws;
    const XcdSlice X = xcd_slice_setup(a, lds);
    const int tstride = X.nloc * 8;
    const bool bit3 = (lane & 8) != 0;
    for (int sl = X.q; sl < 8; sl += X.nx) {
        const GAS unsigned char* VBs = ws + WS_VB + (size_t)sl * 2097152;
        const unsigned coff = (unsigned)c * 16u;
        const unsigned xoff = (unsigned)(sl * 128 + c * 16 + 2 * k) * 4u;
        u32x4 ev[4], RA[16], RB[16]; f32x4 wa[4], wb[4]; f32x2 xa, xb;
#define B_TOK(t_) ((t_) < T ? (t_) : T - 1)
#define B_INFO(t_) do { const int tq_ = B_TOK(t_); _Pragma("unroll") for (int j_ = 0; j_ < 4; ++j_) ev[j_] = *(const GAS u32x4*)(ws + WS_EIDX + (size_t)tq_ * 512 + (unsigned)(64 * k + 16 * j_)); } while (0)
#define B_ISSUE(R_, w_, x_, t_) do { const int tq_ = B_TOK(t_); _Pragma("unroll") for (int g_ = 0; g_ < 16; ++g_) R_[g_] = *(const GAS u32x4*)(VBs + (ev[g_ >> 2][g_ & 3] * 128u + coff)); \
        _Pragma("unroll") for (int j_ = 0; j_ < 4; ++j_) w_[j_] = *(const GAS f32x4*)(ws + WS_PW + (size_t)tq_ * 512 + (unsigned)(64 * k + 16 * j_)); \
        x_ = *(const GAS f32x2*)((const GAS unsigned char*)a.out + (size_t)tq_ * (D * 4) + xoff); } while (0)
#define B_DOTS(R_, w_, x_, t_) do { \
        f32x2 acc2_[8]; _Pragma("unroll") for (int e_ = 0; e_ < 8; ++e_) acc2_[e_] = (f32x2){0.f, 0.f}; \
        _Pragma("unroll") for (int g_ = 0; g_ < 16; ++g_) { const float wk_ = w_[g_ >> 2][g_ & 3]; const f32x2 wp_ = (f32x2){wk_, wk_}; \
            _Pragma("unroll") for (int jj_ = 0; jj_ < 4; ++jj_) { acc2_[2 * jj_] += wp_ * FP8LO(R_[g_][jj_]); acc2_[2 * jj_ + 1] += wp_ * FP8HI(R_[g_][jj_]); } \
            if (g_ & 1) __builtin_amdgcn_sched_barrier(0); } \
        f32x2 w2_[4], x2_[2], y_; \
        _Pragma("unroll") for (int i_ = 0; i_ < 4; ++i_) { w2_[i_][0] = rs32_(acc2_[i_][0], acc2_[i_ + 4][0]); w2_[i_][1] = rs32_(acc2_[i_][1], acc2_[i_ + 4][1]); } \
        _Pragma("unroll") for (int i_ = 0; i_ < 2; ++i_) { x2_[i_][0] = rs16_(w2_[i_][0], w2_[i_ + 2][0]); x2_[i_][1] = rs16_(w2_[i_][1], w2_[i_ + 2][1]); } \
        y_[0] = rs8_(x2_[0][0], x2_[1][0], bit3) + x_[0]; y_[1] = rs8_(x2_[0][1], x2_[1][1], bit3) + x_[1]; \
        const float ss_ = wave_sum(y_[0] * y_[0] + y_[1] * y_[1], lane); \
        if ((t_) < T) { *(GAS unsigned*)(ws + WS_PARTU + (size_t)(t_) * (D * 2) + (xoff >> 1)) = pk2(y_[0], y_[1]);       \
            if (lane == 0) ((GAS float*)(ws + WS_SS))[(size_t)(t_) * 8 + sl] = ss_; } } while (0)
        const int n0 = X.rank * 8 + wave;
        B_INFO(n0);
        __builtin_amdgcn_sched_barrier(0);
        B_ISSUE(RA, wa, xa, n0);
        __builtin_amdgcn_sched_barrier(0);
        B_INFO(n0 + tstride);
        __builtin_amdgcn_sched_barrier(0);
#pragma unroll 1
        for (int n = n0; n < T; n += 2 * tstride) {
            B_ISSUE(RB, wb, xb, n + tstride);
            __builtin_amdgcn_sched_barrier(0);
            B_INFO(n + 2 * tstride);
            __builtin_amdgcn_sched_barrier(0);
            B_DOTS(RA, wa, xa, n);
            __builtin_amdgcn_sched_barrier(0);
            B_ISSUE(RA, wa, xa, n + 2 * tstride);
            __builtin_amdgcn_sched_barrier(0);
            B_INFO(n + 3 * tstride);
            __builtin_amdgcn_sched_barrier(0);
            B_DOTS(RB, wb, xb, n + tstride);
            __builtin_amdgcn_sched_barrier(0);
        }
#undef B_TOK
#undef B_INFO
#undef B_ISSUE
#undef B_DOTS
    }
}
__device__ __forceinline__ void phase_vc(const DArgs& a, int vcu, int G) {
    const int tid = tid_(), lane = tid & 63, wave = tid >> 6;
    const int gw = vcu * NWAVES + wave, NGW = G * NWAVES;
    GAS unsigned char* ws = a.ws;
    f32x4 gf[4];
#pragma unroll
    for (int j = 0; j < 4; ++j) gf[j] = ((const GAS f32x4*)a.final_g)[64 * j + lane];
    for (int m = gw; m < T; m += NGW) {
        const f32x4 s0 = *(const GAS f32x4*)((const GAS float*)(ws + WS_SS) + (size_t)m * 8), s1 = *(const GAS f32x4*)((const GAS float*)(ws + WS_SS) + (size_t)m * 8 + 4);
        const float rstd = rsqrtf(((s0[0] + s0[1]) + (s0[2] + s0[3]) + (s1[0] + s1[1]) + (s1[2] + s1[3])) * (1.f / D) + EPS);
        const GAS u32x2* xi = (const GAS u32x2*)(ws + WS_PARTU + (size_t)m * (D * 2)) + lane;
        GAS f32x4* o = (GAS f32x4*)(a.out + (size_t)m * D) + lane;
#pragma unroll
        for (int j = 0; j < 4; ++j) { const u32x2 xv = xi[64 * j]; f32x4 v; v[0] = bf_lo(xv.x); v[1] = bf_hi(xv.x); v[2] = bf_lo(xv.y); v[3] = bf_hi(xv.y); o[64 * j] = v * rstd * gf[j]; }
    }
}

__device__ __forceinline__ void phase_final_plain(const DArgs& a, const float* src, int vcu, int G) {
    const int tid = tid_(), lane = tid & 63, wave = tid >> 6;
    const int gw = vcu * NWAVES + wave, NGW = G * NWAVES;
    f32x4 gf[4];
#pragma unroll
    for (int j = 0; j < 4; ++j) gf[j] = ((const f32x4*)a.final_g)[64 * j + lane];
    for (int m = gw; m < T; m += NGW) {
        const f32x4* xr = (const f32x4*)(src + (size_t)m * D) + lane;
        f32x4 v[4]; float s = 0.f;
#pragma unroll
        for (int j = 0; j < 4; ++j) { v[j] = xr[64 * j]; s += (v[j][0] * v[j][0] + v[j][1] * v[j][1]) + (v[j][2] * v[j][2] + v[j][3] * v[j][3]); }
        const float rstd = rsqrtf(wave_sum(s, lane) * (1.f / D) + EPS);
        f32x4* o = (f32x4*)(a.out + (size_t)m * D) + lane;
#pragma unroll
        for (int j = 0; j < 4; ++j) o[64 * j] = v[j] * rstd * gf[j];
    }
}


__device__ __forceinline__ DArgs load_args() {
    DArgs r;
#if defined(__HIP_DEVICE_COMPILE__)
    typedef const DArgs __attribute__((address_space(4))) KArgs;
    KArgs* p = (KArgs*)__builtin_amdgcn_kernarg_segment_ptr();
    asm volatile("" : "+s"(p));
    r.x = p->x; r.norm1_g = p->norm1_g; r.w_in = p->w_in; r.b_in = p->b_in; r.conv_w = p->conv_w; r.conv_b = p->conv_b; r.m_head_g = p->m_head_g; r.lb_table = p->lb_table;
    r.g_head_g = p->g_head_g; r.w_br_m = p->w_br_m; r.w_br_g = p->w_br_g; r.w_out = p->w_out; r.norm2_g = p->norm2_g; r.w_pq = p->w_pq; r.sub_keys = p->sub_keys;
    r.u_emb = p->u_emb; r.v_emb = p->v_emb; r.final_g = p->final_g; r.out = p->out; r.ws = p->ws;
#else
    r = DArgs{};
#endif
    return r;
}
__device__ __forceinline__ EpiPtrs make_ep(const DArgs& a, int round) {
    EpiPtrs ep; ep.biasp = (const GAS float*)(a.ws + WS_BIASP); ep.lb = (const GAS float*)(a.ws + WS_LB); ep.x = a.x; ep.out = a.out; ep.ws = a.ws; ep.round = round; return ep;
}
#define GRID_SYNC() do { const DArgs a_ = load_args(); xcd_barrier((unsigned*)(a_.ws + WS_CTL) + CW_BAR, (volatile LAS unsigned*)(lds + LDS_BARST)); } while (0)

__device__ __forceinline__ int bx_() { int t = blockIdx.x; asm volatile("" : "+s"(t)); return t; }
__device__ __forceinline__ int gd_() { int t = gridDim.x; asm volatile("" : "+s"(t)); return t; }
#define PH_BEGIN const DArgs a = load_args(); const int bx = bx_(), G = gd_(); const int vcu = (G % 8 == 0) ? (bx % 8) * (G / 8) + bx / 8 : bx; (void)vcu; (void)bx;

__global__ void __launch_bounds__(NTHR, 2) fwd_megakernel(Args a_unused) {
    extern __shared__ __attribute__((aligned(16))) unsigned char lds_raw[];
    LAS unsigned char* lds = (LAS unsigned char*)lds_raw;
    cg::grid_group grid = cg::this_grid();

    { const int t_ = tid_(); if (t_ < 16) ((LAS unsigned*)(lds + LDS_BARST))[t_] = 0u; __syncthreads();
      const DArgs a_ = load_args(); xcd_barrier_post((unsigned*)(a_.ws + WS_CTL) + CW_BAR, (volatile LAS unsigned*)(lds + LDS_BARST)); }
    { PH_BEGIN phase_p0(a, lds, vcu, G); }
    grid.sync();
#pragma unroll 1
    for (int round = 0; round < NROUND; ++round) {
        {
            PH_BEGIN
            pg8::Gemm g{(const bf16_t*)(a.ws + WS_XN) + (size_t)round * RT * D, (const bf16_t*)(a.ws + WS_WIN), RT, N1, D};
            pg8::StaticOrder S; S.init(RT, N1, G, bx);
            EpiX<1> E{make_ep(a, round)};
            pg8::gemm_phase<EpiX<1>, pg8::StaticOrder, true, true>(lds, g, S, E);
        }
        { PH_BEGIN if (bx < 8) mscan_pair(a, lds, round, bx); }
        GRID_SYNC();
        { PH_BEGIN for (int it = bx; it < 512; it += G) mlstm_pre_item(a, lds, round, it); }
        { PH_BEGIN u32x4 gq[4]; int it = bx; if (it < 2048) hgrn_pre_load(a, round, it, gq);
          for (; it < 2048; it += G) hgrn_pre_item(a, lds, round, it, gq, it + G); }
        GRID_SYNC();
        { PH_BEGIN
          if (bx < 128) mlstm_scan<2, false>(a, lds, round, bx & 7, bx >> 3);
          else if (bx >= 192 && bx < 200) mlstm_scan<1, true>(a, lds, round, bx - 192, 0);
          else if (bx < 192) { const int id2 = bx - 128; hgrn_scan(a, lds, round, (id2 & 7) * 2 + ((id2 >> 3) & 1), id2 >> 4); } }
        GRID_SYNC();
        {
            PH_BEGIN
            pg8::Gemm g{(const bf16_t*)(a.ws + WS_XN) + (size_t)round * RT * D, (const bf16_t*)(a.ws + WS_WIN) + (size_t)N1 * D, RT, N2, D};
            pg8::StaticOrder S; S.init(RT, N2, G, bx);
            EpiX<2> E{make_ep(a, round)};
            pg8::gemm_phase<EpiX<2>, pg8::StaticOrder, true, true>(lds, g, S, E);
        }
        GRID_SYNC();
        { PH_BEGIN phase_ypass(a, round, vcu, G); }
        GRID_SYNC();
        {
            { PH_BEGIN pg8::StaticOrder S; S.init(RT, D, G, bx);
              pg8::Gemm g{(const bf16_t*)(a.ws + WS_V), (const bf16_t*)(a.ws + WS_WM), RT, D, 2048}; EpiX<3> E{make_ep(a, round)}; pg8::gemm_phase<EpiX<3>, pg8::StaticOrder, true, true>(lds, g, S, E); }
            { PH_BEGIN pg8::StaticOrder S; S.init(RT, D, G, bx);
              pg8::Gemm g{(const bf16_t*)(a.ws + WS_GI), (const bf16_t*)(a.ws + WS_WG), RT, D, D}; EpiX<4> E{make_ep(a, round)}; pg8::gemm_phase<EpiX<4>, pg8::StaticOrder, true, true>(lds, g, S, E); }
        }
        GRID_SYNC();
        {
            PH_BEGIN pg8::StaticOrder S; S.init(RT, D, G, bx);
            pg8::Gemm g{(const bf16_t*)(a.ws + WS_GFLOG), (const bf16_t*)(a.ws + WS_WO), RT, D, D}; EpiX<5> E{make_ep(a, round)}; pg8::gemm_phase<EpiX<5>, pg8::StaticOrder, true, true>(lds, g, S, E);
        }
        GRID_SYNC();
    }
    { PH_BEGIN phase_p8(a, vcu, G); }
    GRID_SYNC();
    {
        PH_BEGIN pg8::StaticOrder S; S.init(T, 2048, G, bx);
        pg8::Gemm g{(const bf16_t*)(a.ws + WS_XN), (const bf16_t*)(a.ws + WS_WPQ), T, 2048, D}; EpiX<6> E{make_ep(a, 0)}; pg8::gemm_phase<EpiX<6>, pg8::StaticOrder, true, true>(lds, g, S, E);
    }
    GRID_SYNC();
#ifdef TOPK_REF
    { PH_BEGIN phase_topk_ref(a, vcu, G); }
#else
    { PH_BEGIN phase_topk(a, lds, bx, G); }
#endif
    GRID_SYNC();
    { PH_BEGIN phase_ua(a, lds); }
    GRID_SYNC();
    { PH_BEGIN phase_ua2(a, vcu, G); }
    GRID_SYNC();
    { PH_BEGIN phase_vb(a, lds); }
    GRID_SYNC();
    { PH_BEGIN phase_vc(a, vcu, G); }
}

extern "C" void kernel_launch(void* const* d_in, const int* in_sizes, int n_in, void* d_out, int out_size, void* d_ws, size_t ws_size, hipStream_t stream) {
    static int grid = 0;
    if (grid == 0) {
        if (n_in != 18 || in_sizes[0] != T * D || out_size != T * D || ws_size < WS_END) {
            fprintf(stderr, "kernel_launch: unexpected shapes/workspace (n_in %d, in0 %d, out %d, ws %zu, need %zu)\n", n_in, n_in > 0 ? in_sizes[0] : -1, out_size, ws_size, (size_t)WS_END);
            grid = -1; return; }
        int dev = 0, cus = 0, per_cu = 0;
        hipGetDevice(&dev);
        hipDeviceGetAttribute(&cus, hipDeviceAttributeMultiprocessorCount, dev);
        hipFuncSetAttribute((const void*)fwd_megakernel, hipFuncAttributeMaxDynamicSharedMemorySize, LDS_BYTES);
        hipOccupancyMaxActiveBlocksPerMultiprocessor(&per_cu, (const void*)fwd_megakernel, NTHR, LDS_BYTES);
        if (per_cu < 1) { fprintf(stderr, "kernel_launch: occupancy query says %d blocks/CU\n", per_cu); per_cu = 1; }
        grid = cus;
        (void)hipGetLastError();
    }
    if (grid < 0) return;
    hipMemsetAsync((char*)d_ws + WS_CTL, 0, 1 * MiB, stream);
    Args a{};
    a.x = (const float*)d_in[0]; a.norm1_g = (const float*)d_in[1]; a.w_in = (const float*)d_in[2]; a.b_in = (const float*)d_in[3];
    a.conv_w = (const float*)d_in[4]; a.conv_b = (const float*)d_in[5]; a.m_head_g = (const float*)d_in[6]; a.lb_table = (const float*)d_in[7];
    a.g_head_g = (const float*)d_in[8]; a.w_br_m = (const float*)d_in[9]; a.w_br_g = (const float*)d_in[10]; a.w_out = (const float*)d_in[11];
    a.norm2_g = (const float*)d_in[12]; a.w_pq = (const float*)d_in[13]; a.sub_keys = (const float*)d_in[14]; a.u_emb = (const float*)d_in[15];
    a.v_emb = (const float*)d_in[16]; a.final_g = (const float*)d_in[17];
    a.out = (float*)d_out; a.ws = (unsigned char*)d_ws;
    void* args[] = {&a};
    hipError_t e = hipLaunchCooperativeKernel((const void*)fwd_megakernel, dim3(grid), dim3(NTHR), args, LDS_BYTES, stream);
    if (e != hipSuccess) fprintf(stderr, "cooperative launch failed: %s (grid %d)\n", hipGetErrorString(e), grid);
}
```

```cpp
#include <hip/hip_runtime.h>
#include <hip/hip_cooperative_groups.h>
#include <cstdio>
#include <cstdint>
namespace cg = cooperative_groups;

#define LAS __attribute__((address_space(3)))
typedef unsigned short bf16_t;
typedef short bf16x8 __attribute__((ext_vector_type(8)));
typedef float f32x4 __attribute__((ext_vector_type(4)));
typedef float f32x2 __attribute__((ext_vector_type(2)));
typedef unsigned u32x4 __attribute__((ext_vector_type(4)));
typedef unsigned u32x2 __attribute__((ext_vector_type(2)));

constexpr int D = 1024, BATCH = 4, SEQ = 8192, T = BATCH * SEQ;
constexpr int IN_COLS = 12296, NP = 12288;
constexpr int RT = 16384, NROUND = 2;
constexpr int N1 = 7168, N2 = 5120;
constexpr float EPS = 1e-6f;
constexpr int NWAVES = 8, NTHR = 512;

constexpr size_t MiB = 1u << 20;
constexpr size_t WS_CTL = 0;
constexpr size_t WS_WIN = 1 * MiB;
constexpr size_t WS_WM = 25 * MiB;
constexpr size_t WS_WG = 29 * MiB;
constexpr size_t WS_WO = 31 * MiB;
constexpr size_t WS_WPQ = 33 * MiB;
constexpr size_t WS_SK = 37 * MiB;
constexpr size_t WS_BIASP = 37 * MiB + 512 * 1024;
constexpr size_t WS_LB = WS_BIASP + 64 * 1024;
constexpr size_t WS_GATES = 38 * MiB;
constexpr size_t WS_MPREV = 39 * MiB;
constexpr size_t WS_DEN = 40 * MiB;
constexpr size_t WS_MT = 40 * MiB + 512 * 1024;
constexpr size_t WS_HGDEC = 41 * MiB;
constexpr size_t WS_MDEC = 43 * MiB;
constexpr size_t WS_XN = 44 * MiB;
constexpr size_t WS_QKPRE = 108 * MiB;
constexpr size_t WS_V = 172 * MiB;
constexpr size_t WS_GFLOG = 236 * MiB;
constexpr size_t WS_GI = 268 * MiB;
constexpr size_t WS_GQ = 300 * MiB;
constexpr size_t WS_S = 332 * MiB;
constexpr size_t WS_QT = 348 * MiB;
constexpr size_t WS_KWT = 380 * MiB;
constexpr size_t WS_ATT = 412 * MiB;
constexpr size_t WS_QTG = 428 * MiB;
constexpr size_t WS_KENDT = 460 * MiB;
constexpr size_t WS_SIGO = 332 * MiB;
constexpr size_t WS_SGG = 396 * MiB;
constexpr size_t WS_SAM = 428 * MiB;
constexpr size_t WS_SAG = 460 * MiB;
constexpr size_t WS_END = 492 * MiB;
constexpr size_t WS_QP = 108 * MiB;
constexpr size_t WS_UB = 236 * MiB;
constexpr size_t WS_VB = 252 * MiB;
constexpr size_t WS_USC = 268 * MiB;
constexpr size_t WS_VSC = 268 * MiB + 65536;
constexpr size_t WS_EIDX = 300 * MiB;
constexpr size_t WS_GATE = 316 * MiB;
constexpr size_t WS_XQ = 380 * MiB;
constexpr size_t WS_XQS = 412 * MiB;
constexpr size_t WS_PARTU = 108 * MiB;
constexpr size_t WS_SS = 348 * MiB;
constexpr size_t WS_PW = 332 * MiB;

constexpr int CW_TMAX = 64;
constexpr int LDS_BYTES = 147456;

__device__ __forceinline__ unsigned f2bf(float f) { unsigned u = __builtin_bit_cast(unsigned, f); return (u + 0x7fffu + ((u >> 16) & 1u)) >> 16; }
typedef __bf16 bf16x2_t __attribute__((ext_vector_type(2)));
__device__ __forceinline__ unsigned pk2(float lo, float hi) { bf16x2_t v; v[0] = (__bf16)lo; v[1] = (__bf16)hi; return __builtin_bit_cast(unsigned, v); }
__device__ __forceinline__ float bf_lo(unsigned w) { return __builtin_bit_cast(float, w << 16); }
__device__ __forceinline__ float bf_hi(unsigned w) { return __builtin_bit_cast(float, w & 0xffff0000u); }
__device__ __forceinline__ float bf2f(bf16_t h) { return __builtin_bit_cast(float, ((unsigned)h) << 16); }
__device__ __forceinline__ float shx(float v, int o, int lane) { return __builtin_bit_cast(float, __builtin_amdgcn_ds_bpermute((lane ^ o) << 2, __builtin_bit_cast(int, v))); }
__device__ __forceinline__ float shup(float v, int o, int lane) { return __builtin_bit_cast(float, __builtin_amdgcn_ds_bpermute(((lane - o) & 63) << 2, __builtin_bit_cast(int, v))); }
__device__ __forceinline__ float rdlane(float v, int l) { return __builtin_bit_cast(float, __builtin_amdgcn_readlane(__builtin_bit_cast(int, v), l)); }
#define DPP_(v, ctrl) __builtin_bit_cast(float, __builtin_amdgcn_update_dpp(0, __builtin_bit_cast(int, (v)), (ctrl), 0xF, 0xF, false))
__device__ __forceinline__ float wave_sum(float v, int lane) {
    (void)lane;
    v += DPP_(v, 0xB1); v += DPP_(v, 0x4E); v += DPP_(v, 0x141); v += DPP_(v, 0x140);
    return (rdlane(v, 0) + rdlane(v, 16)) + (rdlane(v, 32) + rdlane(v, 48));
}
__device__ __forceinline__ float wave_max(float v) {
    v = fmaxf(v, DPP_(v, 0xB1)); v = fmaxf(v, DPP_(v, 0x4E)); v = fmaxf(v, DPP_(v, 0x141)); v = fmaxf(v, DPP_(v, 0x140));
    return fmaxf(fmaxf(rdlane(v, 0), rdlane(v, 16)), fmaxf(rdlane(v, 32), rdlane(v, 48)));
}
__device__ __forceinline__ unsigned pack_i8x4(float a, float b, float c, float d) {
    const int ia = (int)__builtin_rintf(a), ib = (int)__builtin_rintf(b), ic = (int)__builtin_rintf(c), id = (int)__builtin_rintf(d);
    return ((unsigned)ia & 255u) | (((unsigned)ib & 255u) << 8) | (((unsigned)ic & 255u) << 16) | ((unsigned)id << 24);
}
#define SWZI_(v, pat) __builtin_amdgcn_ds_swizzle((int)(v), (pat))
#define DPPI_(v, ctrl) __builtin_amdgcn_update_dpp(0, (int)(v), (ctrl), 0xF, 0xF, false)
__device__ __forceinline__ unsigned xor32u_(unsigned v, bool hi) {
#if defined(__HIP_DEVICE_COMPILE__)
    const auto r = __builtin_amdgcn_permlane32_swap(v, v, false, false);
    return hi ? r[0] : r[1];
#else
    (void)hi; return v;
#endif
}
__device__ __forceinline__ float sigmoidf_(float x) { return __builtin_amdgcn_rcpf(1.0f + __expf(-x)); }
__device__ __forceinline__ float siluf_(float x) { return x * __builtin_amdgcn_rcpf(1.0f + __expf(-x)); }
#define LDS_WAIT() asm volatile("s_waitcnt lgkmcnt(0)" ::: "memory")
__device__ __forceinline__ int tid_() { int t = threadIdx.x; asm volatile("" : "+v"(t)); return t; }

#define GAS __attribute__((address_space(1)))
struct DArgs {
    const GAS float* x; const GAS float* norm1_g; const GAS float* w_in; const GAS float* b_in; const GAS float* conv_w; const GAS float* conv_b;
    const GAS float* m_head_g; const GAS float* lb_table; const GAS float* g_head_g; const GAS float* w_br_m; const GAS float* w_br_g; const GAS float* w_out;
    const GAS float* norm2_g; const GAS float* w_pq; const GAS float* sub_keys; const GAS float* u_emb; const GAS float* v_emb; const GAS float* final_g;
    GAS float* out; GAS unsigned char* ws;
};
struct Args {
    const float* x; const float* norm1_g; const float* w_in; const float* b_in; const float* conv_w; const float* conv_b;
    const float* m_head_g; const float* lb_table; const float* g_head_g; const float* w_br_m; const float* w_br_g; const float* w_out;
    const float* norm2_g; const float* w_pq; const float* sub_keys; const float* u_emb; const float* v_emb; const float* final_g;
    float* out; unsigned char* ws;
};

namespace pg8 {
constexpr int BM = 256, BK = 64, HALF = 128, HTB = HALF * BK * 2, STAGE_BYTES = 8 * HTB, NXCD = 8, WGM = 8;
__host__ __device__ __forceinline__ int lds_byte(int r, int c) { const int st = (r >> 4) * 2 + (c >> 5), rr = r & 15, cc = c & 31, ob = rr * 64 + cc * 2; return st * 1024 + (ob ^ (((ob >> 9) & 1) << 5)); }
__host__ __device__ __forceinline__ void stage_rc(int b, int& R, int& C) { const int st = b / 1024, sb = b % 1024, swz = sb ^ (((sb >> 9) & 1) << 5); R = (st >> 1) * 16 + swz / 64; C = (st & 1) * 32 + (swz % 64) / 2; }
__host__ __device__ __forceinline__ int perm32(int rho) { const int n = rho >> 4, i = rho & 15; return 8 * (i >> 2) + 4 * n + (i & 3); }
struct Unit { int pm, pn; };
struct Gemm { const bf16_t* A; const bf16_t* Bt; int M, N, K; };
struct StaticOrder {
    int nM, nN, nwg, G, c;
    __host__ __device__ void init(int M, int N, int G_, int c_) { nM = M / BM; nN = N / BM; nwg = nM * nN; G = G_; c = c_; }
    __host__ __device__ bool next(int i, Unit& u) const {
        const long L = (long)i * G + c; if (L >= nwg) return false;
        int wgid = (int)L; { const int q = nwg / NXCD, r = nwg % NXCD, xcd = wgid % NXCD, off = wgid / NXCD; wgid = (xcd < r ? xcd * (q + 1) : r * (q + 1) + (xcd - r) * q) + off; }
        const int nig = WGM * nN, gid = wgid / nig, fm = gid * WGM, gsz = (nM - fm) < WGM ? (nM - fm) : WGM;
        u.pm = fm + ((wgid % nig) % gsz); u.pn = (wgid % nig) / gsz; return true;
    }
    __device__ __forceinline__ void a_ready(const Unit&) const {}
    __device__ __forceinline__ void done(const Unit&) const {}
};

template <class Epi, class Sched, bool ALIGN_EPI = false, bool SP2 = false>
__device__ __forceinline__ void gemm_phase(LAS unsigned char* lds, const Gemm g, const Sched& S, const Epi& E) {
    const int tid = tid_(), wid = __builtin_amdgcn_readfirstlane(tid >> 6), lane = tid & 63, wr = wid >> 2, wc = wid & 3, fr = lane & 15, fq = lane >> 4;
    const int K = g.K, nt = K / BK;
    unsigned voffA[2], voffB[2];
#pragma unroll
    for (int i = 0; i < 2; ++i) { int R, C; stage_rc(tid * 16 + i * 8192, R, C); const int Rb = Epi::PERM ? ((R & ~31) + perm32(R & 31)) : R;
        voffA[i] = (unsigned)(R * K + C) * 2u; voffB[i] = (unsigned)(Rb * K + C) * 2u; }
    const size_t kstep = (size_t)(BK * 2);
    const size_t hstep = (size_t)HALF * K * 2;
    const size_t tstep = 2 * hstep;
    const unsigned ldsw = (unsigned)wid * 1024u;
    const int aoff = lds_byte(wr * 64 + fr, fq * 8), boff = lds_byte(wc * 32 + fr, fq * 8);
#define PG8_SA(b, h) (((b) * 2 + (h)) * HTB)
#define PG8_SB(b, h) ((4 + (b) * 2 + (h)) * HTB)
#define PG8_STAGE(bufoff, gbase, voff) do { _Pragma("unroll") for (int _i = 0; _i < 2; ++_i) \
        __builtin_amdgcn_global_load_lds((const unsigned*)((const char*)(gbase) + (voff)[_i]), (LAS unsigned*)(lds + (bufoff) + ldsw + _i * 8192), 16, 0, 0); } while (0)
#define PG8_LDA(dst, b, h) do { _Pragma("unroll") for (int m = 0; m < 4; ++m) _Pragma("unroll") for (int k = 0; k < 2; ++k) dst[m][k] = *(const LAS bf16x8*)(lds + PG8_SA(b, h) + aoff + m * 2048 + k * 1024); } while (0)
#define PG8_LDB(dst, b, h) do { _Pragma("unroll") for (int n = 0; n < 2; ++n) _Pragma("unroll") for (int k = 0; k < 2; ++k) dst[n][k] = *(const LAS bf16x8*)(lds + PG8_SB(b, h) + boff + n * 2048 + k * 1024); } while (0)
#define PG8_MMA(ai, bj, At, Bt) do { __builtin_amdgcn_s_setprio(1); _Pragma("unroll") for (int m = 0; m < 4; ++m) _Pragma("unroll") for (int n = 0; n < 2; ++n) _Pragma("unroll") for (int k = 0; k < 2; ++k) \
        acc[ai][bj][m][n] = __builtin_amdgcn_mfma_f32_16x16x32_bf16(Bt[n][k], At[m][k], acc[ai][bj][m][n], 0, 0, 0); __builtin_amdgcn_s_setprio(0); } while (0)
#define PG8_WAIT_V(n) asm volatile("s_waitcnt vmcnt(" #n ")" ::: "memory")
#define PG8_WAIT_L(n) asm volatile("s_waitcnt lgkmcnt(" #n ")" ::: "memory")
#define PG8_BAR __builtin_amdgcn_s_barrier()
#define PG8_SCHED __builtin_amdgcn_sched_barrier(0)
    Unit cur, nxt; int ui = 0;
    if (!S.next(0, cur)) return;
    f32x4 acc[2][2][4][2];
#pragma unroll
    for (int a = 0; a < 2; ++a)
#pragma unroll
        for (int b = 0; b < 2; ++b)
#pragma unroll
            for (int m = 0; m < 4; ++m)
#pragma unroll
                for (int n = 0; n < 2; ++n) acc[a][b][m][n] = (f32x4){0.f, 0.f, 0.f, 0.f};
    bf16x8 At[4][2], B0[2][2], B1[2][2];
    const char* cA = (const char*)g.A + (size_t)cur.pm * tstep; const char* cB = (const char*)g.Bt + (size_t)cur.pn * tstep;
    S.a_ready(cur);
    if constexpr (SP2) {
        PG8_STAGE(PG8_SB(0, 0), cB, voffB); PG8_STAGE(PG8_SB(0, 1), cB + hstep, voffB); PG8_STAGE(PG8_SA(0, 0), cA, voffA); PG8_STAGE(PG8_SA(0, 1), cA + hstep, voffA);
        if (wr == 1) PG8_BAR;
        PG8_WAIT_V(2); PG8_BAR;
        PG8_STAGE(PG8_SB(1, 0), cB + kstep, voffB); PG8_STAGE(PG8_SA(1, 0), cA + kstep, voffA); PG8_STAGE(PG8_SB(1, 1), cB + hstep + kstep, voffB);
        PG8_WAIT_V(6); PG8_BAR;
    } else {
        PG8_STAGE(PG8_SB(0, 0), cB, voffB); PG8_STAGE(PG8_SA(0, 0), cA, voffA); PG8_STAGE(PG8_SB(0, 1), cB + hstep, voffB); PG8_STAGE(PG8_SA(0, 1), cA + hstep, voffA);
        if (wr == 1) PG8_BAR;
        PG8_WAIT_V(4); PG8_BAR;
        PG8_STAGE(PG8_SB(1, 0), cB + kstep, voffB); PG8_STAGE(PG8_SA(1, 0), cA + kstep, voffA); PG8_STAGE(PG8_SB(1, 1), cB + hstep + kstep, voffB);
        PG8_WAIT_V(6); PG8_BAR;
    }
    for (;;) {
        const bool has_next = S.next(ui + 1, nxt);
        const char* nA = has_next ? (const char*)g.A + (size_t)nxt.pm * tstep : cA; const char* nB = has_next ? (const char*)g.Bt + (size_t)nxt.pn * tstep : cB;
        for (int t = 0; t < nt; t += 2) {
            const bool last = (t == nt - 2);
            const char* a1 = cA + (size_t)(t + 1) * kstep;
            const char* a2 = last ? nA : cA + (size_t)(t + 2) * kstep; const char* b2 = last ? nB : cB + (size_t)(t + 2) * kstep;
            const char* a3 = a2 + kstep; const char* b3 = b2 + kstep;
            if (last && has_next) S.a_ready(nxt);
            if constexpr (SP2) {
            PG8_LDB(B0, 0, 0); PG8_LDB(B1, 0, 1); PG8_SCHED; PG8_LDA(At, 0, 0); PG8_STAGE(PG8_SA(1, 1), a1 + hstep, voffA);
            PG8_WAIT_V(8); PG8_WAIT_L(0); PG8_BAR; PG8_MMA(0, 0, At, B0); PG8_MMA(0, 1, At, B1); PG8_BAR; PG8_SCHED;
            PG8_LDA(At, 0, 1); PG8_STAGE(PG8_SB(0, 0), b2, voffB); PG8_STAGE(PG8_SB(0, 1), b2 + hstep, voffB); PG8_STAGE(PG8_SA(0, 0), a2, voffA);
            PG8_WAIT_V(8); PG8_WAIT_L(0); PG8_BAR; PG8_MMA(1, 0, At, B0); PG8_MMA(1, 1, At, B1); PG8_BAR; PG8_SCHED;
            PG8_LDB(B0, 1, 0); PG8_LDB(B1, 1, 1); PG8_SCHED; PG8_LDA(At, 1, 0); PG8_STAGE(PG8_SA(0, 1), a2 + hstep, voffA);
            PG8_WAIT_V(8); PG8_WAIT_L(0); PG8_BAR; PG8_MMA(0, 0, At, B0); PG8_MMA(0, 1, At, B1); PG8_BAR; PG8_SCHED;
            PG8_LDA(At, 1, 1); PG8_STAGE(PG8_SB(1, 0), b3, voffB); PG8_STAGE(PG8_SB(1, 1), b3 + hstep, voffB); PG8_STAGE(PG8_SA(1, 0), a3, voffA);
            PG8_WAIT_V(8); PG8_WAIT_L(0); PG8_BAR; PG8_MMA(1, 0, At, B0); PG8_MMA(1, 1, At, B1); PG8_BAR; PG8_SCHED;
            } else {
            PG8_LDB(B0, 0, 0); PG8_SCHED; PG8_LDA(At, 0, 0); PG8_STAGE(PG8_SA(1, 1), a1 + hstep, voffA);
            PG8_WAIT_L(8); PG8_BAR; PG8_WAIT_L(0); PG8_MMA(0, 0, At, B0); PG8_BAR; PG8_SCHED;
            PG8_LDB(B1, 0, 1); PG8_STAGE(PG8_SB(0, 0), b2, voffB);
            PG8_BAR; PG8_WAIT_L(0); PG8_MMA(0, 1, At, B1); PG8_BAR;
            PG8_LDA(At, 0, 1); PG8_STAGE(PG8_SA(0, 0), a2, voffA);
            PG8_BAR; PG8_WAIT_L(0); PG8_MMA(1, 0, At, B0); PG8_BAR; PG8_SCHED;
            PG8_STAGE(PG8_SB(0, 1), b2 + hstep, voffB);
            PG8_WAIT_V(6); PG8_BAR; PG8_MMA(1, 1, At, B1); PG8_BAR;
            PG8_LDB(B0, 1, 0); PG8_SCHED; PG8_LDA(At, 1, 0); PG8_STAGE(PG8_SA(0, 1), a2 + hstep, voffA);
            PG8_WAIT_L(8); PG8_BAR; PG8_WAIT_L(0); PG8_MMA(0, 0, At, B0); PG8_BAR; PG8_SCHED;
            PG8_LDB(B1, 1, 1); PG8_STAGE(PG8_SB(1, 0), b3, voffB);
            PG8_BAR; PG8_WAIT_L(0); PG8_MMA(0, 1, At, B1); PG8_BAR;
            PG8_LDA(At, 1, 1); PG8_STAGE(PG8_SA(1, 0), a3, voffA);
            PG8_BAR; PG8_WAIT_L(0); PG8_MMA(1, 0, At, B0); PG8_BAR; PG8_SCHED;
            PG8_STAGE(PG8_SB(1, 1), b3 + hstep, voffB);
            PG8_WAIT_V(6); PG8_BAR; PG8_MMA(1, 1, At, B1); PG8_BAR;
            }
        }
        if constexpr (ALIGN_EPI) { if (wr == 0) PG8_BAR; }
        E(acc, cur, wr, wc, fr, fq);
        if (!has_next) break;
#pragma unroll
        for (int a = 0; a < 2; ++a)
#pragma unroll
            for (int b = 0; b < 2; ++b)
#pragma unroll
                for (int m = 0; m < 4; ++m)
#pragma unroll
                    for (int n = 0; n < 2; ++n) acc[a][b][m][n] = (f32x4){0.f, 0.f, 0.f, 0.f};
        cur = nxt; cA = nA; cB = nB; ++ui;
        if constexpr (ALIGN_EPI) { if (wr == 1) PG8_BAR; }
    }
    PG8_WAIT_V(0);
    if constexpr (!ALIGN_EPI) { if (wr == 0) PG8_BAR; }
    PG8_BAR;
#undef PG8_SA
#undef PG8_SB
#undef PG8_STAGE
#undef PG8_LDA
#undef PG8_LDB
#undef PG8_MMA
#undef PG8_WAIT_V
#undef PG8_WAIT_L
#undef PG8_BAR
#undef PG8_SCHED
}
}

struct EpiPtrs {
    const GAS float* biasp; const GAS float* lb; const GAS float* x; GAS float* out; GAS unsigned char* ws; int round;
};
template <int MODE> struct EpiX {
    static constexpr bool PERM = true, AFTER_DRAIN = false;
    EpiPtrs P;
    __device__ __forceinline__ void operator()(const f32x4 (&acc)[2][2][4][2], const pg8::Unit& u, int wr, int wc, int fr, int fq) const {
        const int row0 = u.pm * 256 + wr * 64 + fr;
        const int colt = u.pn * 256 + wc * 32 + 8 * fq;
        GAS unsigned char* ws = P.ws;
        bf16_t* dst = nullptr; int ld = 0, coff = 0, act = 0; const GAS float* bias = nullptr;
        if (MODE == 1) {
            bias = P.biasp;
            if (u.pn < 8) { dst = (bf16_t*)(ws + WS_QKPRE); ld = 2048; coff = 0; act = 0; }
            else if (u.pn < 16) { dst = (bf16_t*)(ws + WS_V); ld = 2048; coff = 2048; act = 0; }
            else if (u.pn < 20) { dst = (bf16_t*)(ws + WS_GFLOG); ld = 1024; coff = 4096; act = 3; }
            else if (u.pn < 24) { dst = (bf16_t*)(ws + WS_GI); ld = 1024; coff = 5120; act = 0; }
            else { dst = (bf16_t*)(ws + WS_GQ); ld = 1024; coff = 6144; act = 2; }
        } else if (MODE == 2) {
            bias = P.biasp + N1;
            if (u.pn < 8) { dst = (bf16_t*)(ws + WS_SIGO); ld = 2048; coff = 0; act = 1; }
            else if (u.pn < 12) { dst = (bf16_t*)(ws + WS_SGG); ld = 1024; coff = 2048; act = 2; }
            else if (u.pn < 16) { dst = (bf16_t*)(ws + WS_SAM); ld = 1024; coff = 3072; act = 1; }
            else { dst = (bf16_t*)(ws + WS_SAG); ld = 1024; coff = 4096; act = 1; }
        } else if (MODE == 6) { dst = (bf16_t*)(ws + WS_QP); ld = 2048; coff = 0; act = 0; }
#pragma unroll
        for (int bj = 0; bj < 2; ++bj) {
            const int col = colt + bj * 128;
            f32x4 b0 = (f32x4){0.f, 0.f, 0.f, 0.f}, b1 = b0, l0 = b0, l1 = b0;
            if (MODE == 1 || MODE == 2) { b0 = *(const f32x4*)(bias + col); b1 = *(const f32x4*)(bias + col + 4); }
            if (MODE == 1) { if (act == 3) { l0 = *(const f32x4*)(P.lb + (col - coff)); l1 = *(const f32x4*)(P.lb + (col - coff) + 4); } }
#pragma unroll
            for (int ai = 0; ai < 2; ++ai)
#pragma unroll
                for (int m = 0; m < 4; ++m) {
                    const int row = row0 + ai * 128 + m * 16;
                    f32x4 v0 = acc[ai][bj][m][0] + b0, v1 = acc[ai][bj][m][1] + b1;
                    if (MODE == 1 || MODE == 2 || MODE == 6) {
                        if (act == 1) {
#pragma unroll
                            for (int j = 0; j < 4; ++j) { v0[j] = sigmoidf_(v0[j]); v1[j] = sigmoidf_(v1[j]); }
                        } else if (act == 2) {
#pragma unroll
                            for (int j = 0; j < 4; ++j) { v0[j] = siluf_(v0[j]); v1[j] = siluf_(v1[j]); }
                        } else if (act == 3) {
#pragma unroll
                            for (int j = 0; j < 4; ++j) { v0[j] = __logf(l0[j] + (1.0f - l0[j]) * sigmoidf_(v0[j])); v1[j] = __logf(l1[j] + (1.0f - l1[j]) * sigmoidf_(v1[j])); }
                        }
                        u32x4 w; w.x = pk2(v0[0], v0[1]); w.y = pk2(v0[2], v0[3]); w.z = pk2(v1[0], v1[1]); w.w = pk2(v1[2], v1[3]);
                        *(u32x4*)(dst + (size_t)row * ld + (col - coff)) = w;
                    } else if (MODE == 3) {
                        const u32x4 g = *(const u32x4*)((const bf16_t*)(ws + WS_SAM) + (size_t)row * 1024 + col);
                        GAS float* o = P.out + ((size_t)P.round * RT + row) * 1024 + col;
                        f32x4 r0, r1;
                        r0[0] = v0[0] * bf_lo(g.x); r0[1] = v0[1] * bf_hi(g.x); r0[2] = v0[2] * bf_lo(g.y); r0[3] = v0[3] * bf_hi(g.y);
                        r1[0] = v1[0] * bf_lo(g.z); r1[1] = v1[1] * bf_hi(g.z); r1[2] = v1[2] * bf_lo(g.w); r1[3] = v1[3] * bf_hi(g.w);
                        *(f32x4*)o = r0; *(f32x4*)(o + 4) = r1;
                    } else if (MODE == 4) {
                        const u32x4 g = *(const u32x4*)((const bf16_t*)(ws + WS_SAG) + (size_t)row * 1024 + col);
                        const GAS float* zp = P.out + ((size_t)P.round * RT + row) * 1024 + col;
                        const f32x4 p0 = *(const f32x4*)zp, p1 = *(const f32x4*)(zp + 4);
                        f32x4 r0, r1;
                        r0[0] = p0[0] + v0[0] * bf_lo(g.x); r0[1] = p0[1] + v0[1] * bf_hi(g.x); r0[2] = p0[2] + v0[2] * bf_lo(g.y); r0[3] = p0[3] + v0[3] * bf_hi(g.y);
                        r1[0] = p1[0] + v1[0] * bf_lo(g.z); r1[1] = p1[1] + v1[1] * bf_hi(g.z); r1[2] = p1[2] + v1[2] * bf_lo(g.w); r1[3] = p1[3] + v1[3] * bf_hi(g.w);
                        u32x4 w; w.x = pk2(r0[0], r0[1]); w.y = pk2(r0[2], r0[3]); w.z = pk2(r1[0], r1[1]); w.w = pk2(r1[2], r1[3]);
                        *(u32x4*)((bf16_t*)(ws + WS_GFLOG) + (size_t)row * 1024 + col) = w;
                    } else if (MODE == 5) {
                        const size_t off = ((size_t)P.round * RT + row) * 1024 + col;
                        const f32x4 x0 = *(const f32x4*)(P.x + off), x1 = *(const f32x4*)(P.x + off + 4);
                        *(f32x4*)(P.out + off) = x0 + v0; *(f32x4*)(P.out + off + 4) = x1 + v1;
                    }
                }
        }
    }
};

__device__ __forceinline__ void p0_transpose_item(const GAS float* W, int ldw, int K, int k0, int scol, GAS bf16_t* WT, int drow, LAS float* scr, int lane) {
#pragma unroll 8
    for (int i = 0; i < 32; ++i) { const int kk = 2 * i + (lane >> 5); scr[kk * 33 + (lane & 31)] = W[(size_t)(k0 + kk) * ldw + scol + (lane & 31)]; }
    LDS_WAIT(); asm volatile("" ::: "memory");
    const int c = lane & 7;
#pragma unroll
    for (int j = 0; j < 4; ++j) { const int n = (lane >> 3) + 8 * j; const LAS float* s = scr + (8 * c) * 33 + n;
        u32x4 o; o.x = pk2(s[0 * 33], s[1 * 33]); o.y = pk2(s[2 * 33], s[3 * 33]); o.z = pk2(s[4 * 33], s[5 * 33]); o.w = pk2(s[6 * 33], s[7 * 33]);
        *(u32x4*)(WT + (size_t)(drow + n) * K + k0 + 8 * c) = o; }
    LDS_WAIT(); asm volatile("" ::: "memory");
}
__device__ __forceinline__ int win_src_col(int n) {
    if (n < 4096) return n;
    if (n < 7168) return n - 4096 + 6152;
    if (n < 9216) return n - 7168 + 4096;
    return n - 9216 + 9224;
}

__device__ __forceinline__ void phase_p0(const DArgs& a, LAS unsigned char* lds, int vcu, int G) {
    const int tid = tid_(), lane = tid & 63, wave = tid >> 6;
    const int gw = vcu * NWAVES + wave, NGW = G * NWAVES;
    GAS unsigned char* ws = a.ws;
    LAS float* scr = (LAS float*)(lds + wave * 16384);
    constexpr int I_IN = 16 * 384, I_M = 32 * 32, I_G = 16 * 32, I_O = 16 * 32, I_PQ = 16 * 64;
    constexpr int NITEMS = I_IN + I_M + I_G + I_O + I_PQ;
    for (int it = gw; it < NITEMS; it += NGW) {
        int r = it;
        if (r < I_IN) { const int kb = r / 384, nb = r % 384; p0_transpose_item(a.w_in, IN_COLS, 1024, kb * 64, win_src_col(nb * 32), (GAS bf16_t*)(ws + WS_WIN), nb * 32, scr, lane); continue; } r -= I_IN;
        if (r < I_M) { const int kb = r / 32, nb = r % 32; p0_transpose_item(a.w_br_m, 1024, 2048, kb * 64, nb * 32, (GAS bf16_t*)(ws + WS_WM), nb * 32, scr, lane); continue; } r -= I_M;
        if (r < I_G) { const int kb = r / 32, nb = r % 32; p0_transpose_item(a.w_br_g, 1024, 1024, kb * 64, nb * 32, (GAS bf16_t*)(ws + WS_WG), nb * 32, scr, lane); continue; } r -= I_G;
        if (r < I_O) { const int kb = r / 32, nb = r % 32; p0_transpose_item(a.w_out, 1024, 1024, kb * 64, nb * 32, (GAS bf16_t*)(ws + WS_WO), nb * 32, scr, lane); continue; } r -= I_O;
        { const int kb = r / 64, nb = r % 64; p0_transpose_item(a.w_pq, 2048, 1024, kb * 64, nb * 32, (GAS bf16_t*)(ws + WS_WPQ), nb * 32, scr, lane); }
    }
    const int gt = vcu * NTHR + tid, NGT = G * NTHR;
    for (int i = gt; i < NP; i += NGT) ((float*)(ws + WS_BIASP))[i] = a.b_in[win_src_col(i)];
    for (int i = gt; i < 1024; i += NGT) { const float t0 = a.lb_table[i], t1 = a.lb_table[1024 + i]; ((float*)(ws + WS_LB))[i] = 1.0f / (1.0f + __expf(t1 - t0)); }
    for (int i = gt; i < 8 * 2 * 128 * 128 / 4; i += NGT) { const f32x4 v = ((const f32x4*)a.sub_keys)[i]; u32x2 o; o.x = pk2(v[0], v[1]); o.y = pk2(v[2], v[3]); ((u32x2*)(ws + WS_SK))[i] = o; }
    {
        float mu = 0.f, mv = 0.f;
        for (size_t i = (size_t)vcu * NTHR + tid; i < (size_t)16384 * 1024 / 4; i += (size_t)G * NTHR) {
            const f32x4 u4 = ((const GAS f32x4*)a.u_emb)[i], v4 = ((const GAS f32x4*)a.v_emb)[i];
            mu = fmaxf(mu, fmaxf(fmaxf(fabsf(u4[0]), fabsf(u4[1])), fmaxf(fabsf(u4[2]), fabsf(u4[3]))));
            mv = fmaxf(mv, fmaxf(fmaxf(fabsf(v4[0]), fabsf(v4[1])), fmaxf(fabsf(v4[2]), fabsf(v4[3])))); }
#pragma unroll
        for (int o = 1; o < 64; o <<= 1) { mu = fmaxf(mu, shx(mu, o, lane)); mv = fmaxf(mv, shx(mv, o, lane)); }
        if (lane == 0) { atomicMax((unsigned*)(ws + WS_CTL) + CW_TMAX, __builtin_bit_cast(unsigned, mu)); atomicMax((unsigned*)(ws + WS_CTL) + CW_TMAX + 1, __builtin_bit_cast(unsigned, mv)); }
    }
    f32x4 g1[4];
#pragma unroll
    for (int j = 0; j < 4; ++j) g1[j] = ((const GAS f32x4*)a.norm1_g)[64 * j + lane];
    f32x4 gw0[16], gw1[16];
#pragma unroll
    for (int j = 0; j < 4; ++j)
#pragma unroll
        for (int e = 0; e < 4; ++e) { const int k = 256 * j + 4 * lane + e; gw0[4 * j + e] = *(const GAS f32x4*)(a.w_in + (size_t)k * IN_COLS + 6144); gw1[4 * j + e] = *(const GAS f32x4*)(a.w_in + (size_t)k * IN_COLS + 6148); }
    const float gbias = lane < 8 ? a.b_in[6144 + lane] : 0.f;
    for (int m = gw; m < T; m += NGW) {
        const GAS f32x4* xr = (const GAS f32x4*)(a.x + (size_t)m * D) + lane;
        f32x4 v[4]; float s = 0.f;
#pragma unroll
        for (int j = 0; j < 4; ++j) { v[j] = xr[64 * j]; s += (v[j][0] * v[j][0] + v[j][1] * v[j][1]) + (v[j][2] * v[j][2] + v[j][3] * v[j][3]); }
        const float rstd = rsqrtf(wave_sum(s, lane) * (1.f / D) + EPS);
        GAS unsigned long long* o8 = (GAS unsigned long long*)((GAS bf16_t*)(ws + WS_XN) + (size_t)m * D) + lane;
        f32x4 ga0 = (f32x4){0.f, 0.f, 0.f, 0.f}, ga1 = ga0;
#pragma unroll
        for (int j = 0; j < 4; ++j) {
            v[j] = v[j] * rstd * g1[j];
            o8[64 * j] = (unsigned long long)pk2(v[j][0], v[j][1]) | ((unsigned long long)pk2(v[j][2], v[j][3]) << 32);
#pragma unroll
            for (int e = 0; e < 4; ++e) { ga0 += gw0[4 * j + e] * v[j][e]; ga1 += gw1[4 * j + e] * v[j][e]; }
        }
        float ga[8] = {ga0[0], ga0[1], ga0[2], ga0[3], ga1[0], ga1[1], ga1[2], ga1[3]};
#pragma unroll
        for (int q = 0; q < 8; ++q) ga[q] = wave_sum(ga[q], lane);
        if (lane < 8) { float r = ga[0];
#pragma unroll
            for (int q = 1; q < 8; ++q) r = (lane == q) ? ga[q] : r;
            ((GAS float*)(ws + WS_GATES))[(size_t)m * 8 + lane] = r + gbias; }
    }
}

__device__ __forceinline__ float logsigf_(float x) { return fminf(x, 0.f) - log1pf(__expf(-fabsf(x))); }
#define LDS_BAR() do { asm volatile("s_waitcnt lgkmcnt(0)" ::: "memory"); __builtin_amdgcn_s_barrier(); asm volatile("" ::: "memory"); } while (0)
#define MFMA16(a, b, c) __builtin_amdgcn_mfma_f32_16x16x32_bf16((a), (b), (c), 0, 0, 0)
__device__ __forceinline__ bf16x8 lfrag(const LAS unsigned char* base, int pitch, int row, int k0, int fq) { return *(const LAS bf16x8*)(base + row * pitch + (k0 + 8 * fq) * 2); }
__device__ __forceinline__ int fm_off(int r, int k, int KB) { return (((r >> 4) * KB + (k >> 5)) << 10) + (((((k >> 3) & 3) << 4) + (r & 15)) << 4) + ((k & 7) << 1); }
__device__ __forceinline__ bf16x8 gfrag(const bf16_t* base, int ld, int row, int k0, int fq) { return *(const bf16x8*)(base + (size_t)row * ld + k0 + 8 * fq); }

__device__ __forceinline__ void mscan_pair(const DArgs& a, LAS unsigned char* lds, int round, int p) {
    const int tid = tid_(), lane = tid & 63, part = tid >> 6;
    const int bl = p >> 2, h = p & 3, b = round * 2 + bl;
    const GAS float* g = (const GAS float*)(a.ws + WS_GATES) + ((size_t)b * SEQ + (size_t)lane * 128 + part * 16) * 8;
    float bsum = 0.f, gm = -INFINITY;
#pragma unroll 4
    for (int s = 0; s < 16; ++s) { const float ip = g[s * 8 + h], fp = g[s * 8 + 4 + h]; bsum += logsigf_(fp); gm = fmaxf(gm, ip - bsum); }
    LAS float* PS = (LAS float*)lds; LAS float* PM = PS + 512;
    PS[part * 64 + lane] = bsum; PM[part * 64 + lane] = gm;
    __syncthreads();
    if (tid < 64) {
        float bs = 0.f, g2 = -INFINITY;
#pragma unroll
        for (int q = 0; q < 8; ++q) { g2 = fmaxf(g2, PM[q * 64 + lane] - bs); bs += PS[q * 64 + lane]; }
        float mprev = 0.f, mine = 0.f;
        for (int c = 0; c < 64; ++c) {
            const float bc = rdlane(bs, c), gc = rdlane(g2, c);
            if (lane == c) mine = mprev; mprev = bc + fmaxf(mprev, gc); }
        ((GAS float*)(a.ws + WS_MPREV))[(round * 8 + p) * 64 + lane] = mine;
    }
    __syncthreads();
}

constexpr int PQ_PITCH = 528, PS_PITCH = 272;
__device__ __forceinline__ void mlstm_pre_item(const DArgs& a, LAS unsigned char* lds, int round, int item) {
    const int tid = tid_(), lane = tid & 63, wave = __builtin_amdgcn_readfirstlane(tid >> 6), fr = lane & 15, fq = lane >> 4;
    const int p = item >> 6, c = item & 63, bl = p >> 2, h = p & 3, b = round * 2 + bl;
    const int tl0 = bl * SEQ + c * 128; const size_t tg0 = (size_t)b * SEQ + c * 128;
    GAS unsigned char* ws = a.ws;
    LAS unsigned char* QL = lds; LAS unsigned char* KL = lds + 67584;
    LAS float* AS = (LAS float*)(lds + 135168); LAS float* MS = AS + 128; LAS float* SC = AS + 256;
    if (wave == 0) {
        const float mprev = ((const float*)(ws + WS_MPREV))[(round * 8 + p) * 64 + c];
        const float* g = (const float*)(ws + WS_GATES) + (tg0 + 2 * lane) * 8;
        const float ip0 = g[h], fp0 = g[4 + h], ip1 = g[8 + h], fp1 = g[12 + h];
        const float lf0 = logsigf_(fp0), lf1 = logsigf_(fp1), pp = lf0 + lf1;
        float incl = pp;
#pragma unroll
        for (int o = 1; o < 64; o <<= 1) { const float t = shup(incl, o, lane); if (lane >= o) incl += t; }
        const float excl = incl - pp, b0 = excl + lf0, b1 = incl;
        const float a0 = ip0 - b0, a1 = ip1 - b1;
        float inclm = fmaxf(a0, a1);
#pragma unroll
        for (int o = 1; o < 64; o <<= 1) { const float t = shup(inclm, o, lane); if (lane >= o) inclm = fmaxf(inclm, t); }
        float exclm = shup(inclm, 1, lane); if (lane == 0) exclm = -INFINITY;
        const float M0 = fmaxf(mprev, fmaxf(exclm, a0)), M1 = fmaxf(mprev, inclm);
        AS[2 * lane] = a0; AS[2 * lane + 1] = a1; MS[2 * lane] = M0; MS[2 * lane + 1] = M1;
        float* mt = (float*)(ws + WS_MT) + (tg0 + 2 * lane) * 4 + h;
        mt[0] = b0 + M0; mt[4] = b1 + M1;
        const float Mlast = rdlane(M1, 63);
        if (lane == 0) { SC[0] = mprev; SC[1] = Mlast; ((float*)(ws + WS_MDEC))[item] = __expf(mprev - Mlast); }
    }
    {
        const int cgp = tid & 63, strip = tid >> 6;
        const int col = (cgp < 32) ? (h * 256 + cgp * 8) : (1024 + h * 256 + (cgp - 32) * 8);
        float w[4][8], bb[8];
#pragma unroll
        for (int j = 0; j < 4; ++j) { const f32x4 w0 = *(const f32x4*)(a.conv_w + j * 2048 + col), w1 = *(const f32x4*)(a.conv_w + j * 2048 + col + 4);
#pragma unroll
            for (int e = 0; e < 4; ++e) { w[j][e] = w0[e]; w[j][4 + e] = w1[e]; } }
        { const f32x4 b0 = *(const f32x4*)(a.conv_b + col), b1 = *(const f32x4*)(a.conv_b + col + 4);
#pragma unroll
            for (int e = 0; e < 4; ++e) { bb[e] = b0[e]; bb[4 + e] = b1[e]; } }
        const bf16_t* src = (const bf16_t*)(ws + WS_QKPRE) + (size_t)(tl0 + 16 * strip) * 2048 + col;
        const float qs = (cgp < 32) ? 0.0625f : 1.0f;
        LAS unsigned char* dstt = ((cgp < 32) ? QL : KL) + (cgp & 31) * 16;
#pragma unroll 1
        for (int half = 0; half < 2; ++half) {
            u32x4 xr[11];
#pragma unroll
            for (int r = 0; r < 11; ++r) {
                const int sl = c * 128 + 16 * strip + 8 * half + r - 3;
                xr[r] = (sl >= 0) ? *(const u32x4*)(src + (ptrdiff_t)(8 * half + r - 3) * 2048) : (u32x4){0u, 0u, 0u, 0u};
            }
#pragma unroll
            for (int r = 0; r < 8; ++r) {
                float y[8];
#pragma unroll
                for (int e = 0; e < 8; ++e) y[e] = bb[e];
#pragma unroll
                for (int j = 0; j < 4; ++j) { const u32x4 xv = xr[r + j];
                    y[0] += w[j][0] * bf_lo(xv.x); y[1] += w[j][1] * bf_hi(xv.x); y[2] += w[j][2] * bf_lo(xv.y); y[3] += w[j][3] * bf_hi(xv.y);
                    y[4] += w[j][4] * bf_lo(xv.z); y[5] += w[j][5] * bf_hi(xv.z); y[6] += w[j][6] * bf_lo(xv.w); y[7] += w[j][7] * bf_hi(xv.w); }
#pragma unroll
                for (int e = 0; e < 8; ++e) y[e] = siluf_(y[e]) * qs;
                u32x4 o; o.x = pk2(y[0], y[1]); o.y = pk2(y[2], y[3]); o.z = pk2(y[4], y[5]); o.w = pk2(y[6], y[7]);
                *(LAS u32x4*)(dstt + (16 * strip + 8 * half + r) * PQ_PITCH) = o;
            }
        }
    }
    __syncthreads();
    const float mprev = SC[0], Mlast = SC[1];
    {
        bf16_t* Sg = (bf16_t*)(ws + WS_S) + (size_t)item * 128 * 128;
        const int t = wave * 16 + fr; const float Mt = MS[t];
        for (int st = 0; st < 8; ++st) {
            u32x2 o = (u32x2){0u, 0u};
            if (st <= wave) {
                f32x4 acc = (f32x4){0.f, 0.f, 0.f, 0.f};
#pragma unroll
                for (int ks = 0; ks < 8; ++ks) acc = MFMA16(lfrag(KL, PQ_PITCH, st * 16 + fr, ks * 32, fq), lfrag(QL, PQ_PITCH, wave * 16 + fr, ks * 32, fq), acc);
                float v[4];
#pragma unroll
                for (int j = 0; j < 4; ++j) { const int s = st * 16 + 4 * fq + j; v[j] = (s <= t) ? acc[j] * __expf(AS[s] - Mt) : 0.f; }
                o.x = pk2(v[0], v[1]); o.y = pk2(v[2], v[3]);
            }
            *(u32x2*)((unsigned char*)Sg + fm_off(t, st * 16 + 4 * fq, 4)) = o;
        }
    }
    {
        bf16_t* Qg = (bf16_t*)(ws + WS_QT) + (size_t)item * 128 * 256;
#pragma unroll
        for (int i = 0; i < 8; ++i) { const int idx = tid + 512 * i, blk = idx >> 6, t = (blk >> 3) * 16 + (idx & 15), ch = (blk & 7) * 4 + ((idx >> 4) & 3);
            const u32x4 v = *(const LAS u32x4*)(QL + t * PQ_PITCH + ch * 16); const float s = __expf(mprev - MS[t]);
            u32x4 o; o.x = pk2(bf_lo(v.x) * s, bf_hi(v.x) * s); o.y = pk2(bf_lo(v.y) * s, bf_hi(v.y) * s); o.z = pk2(bf_lo(v.z) * s, bf_hi(v.z) * s); o.w = pk2(bf_lo(v.w) * s, bf_hi(v.w) * s);
            *(u32x4*)((unsigned char*)Qg + fm_off(t, ch * 8, 8)) = o; }
    }
    {
        bf16_t* Kg = (bf16_t*)(ws + WS_KWT) + (size_t)item * 256 * 128;
        const int dlo = lane & 15, sglo = lane >> 4;
#pragma unroll
        for (int i = 0; i < 8; ++i) { const int combo = wave * 8 + i, d = (combo >> 2) * 16 + dlo, s0 = ((combo & 3) * 4 + sglo) * 8;
            float v[8];
#pragma unroll
            for (int e = 0; e < 8; ++e) v[e] = bf2f(*(const LAS bf16_t*)(KL + (s0 + e) * PQ_PITCH + d * 2)) * __expf(AS[s0 + e] - Mlast);
            u32x4 o; o.x = pk2(v[0], v[1]); o.y = pk2(v[2], v[3]); o.z = pk2(v[4], v[5]); o.w = pk2(v[6], v[7]);
            *(u32x4*)((unsigned char*)Kg + fm_off(d, s0, 4)) = o; }
    }
    __syncthreads();
}

__device__ __forceinline__ void hgrn_pre_load(const DArgs& a, int round, int item, u32x4 (&gq)[4]) {
    const int tid = tid_();
    const int p = item >> 7, c = item & 127, bl = p >> 3, h = p & 7;
    const int tl0 = bl * SEQ + c * 64;
    GAS unsigned char* ws = a.ws;
#pragma unroll
    for (int i = 0; i < 2; ++i) { const int idx = tid + 512 * i, s = idx >> 4, ch = idx & 15;
        gq[2 * i] = *(const GAS u32x4*)((const GAS bf16_t*)(ws + WS_GFLOG) + (size_t)(tl0 + s) * 1024 + h * 128 + ch * 8);
        gq[2 * i + 1] = *(const GAS u32x4*)((const GAS bf16_t*)(ws + WS_GQ) + (size_t)(tl0 + s) * 1024 + h * 128 + ch * 8); }
}
__device__ __forceinline__ void hgrn_pre_item(const DArgs& a, LAS unsigned char* lds, int round, int item, u32x4 (&gq)[4], int next_item) {
    const int tid = tid_(), lane = tid & 63, wave = __builtin_amdgcn_readfirstlane(tid >> 6), fr = lane & 15, fq = lane >> 4;
    const int p = item >> 7, c = item & 127, bl = p >> 3, h = p & 7;
    const int tl0 = bl * SEQ + c * 64;
    GAS unsigned char* ws = a.ws;
    LAS float* CUM = (LAS float*)lds;
    LAS float* GL = (LAS float*)(lds + 32768);
    LAS unsigned char* QH = lds + 65536;
    LAS unsigned char* KE = lds + 65536 + 64 * PS_PITCH;
    LAS float* QF = (LAS float*)(lds + 65536 + 128 * PS_PITCH);
#pragma unroll
    for (int i = 0; i < 2; ++i) { const int idx = tid + 512 * i, s = idx >> 4, ch = idx & 15;
        const u32x4 gv = gq[2 * i], qv = gq[2 * i + 1];
        LAS float* gd = GL + s * 128 + ch * 8; LAS float* qd = QF + s * 128 + ch * 8;
        gd[0] = bf_lo(gv.x); gd[1] = bf_hi(gv.x); gd[2] = bf_lo(gv.y); gd[3] = bf_hi(gv.y); gd[4] = bf_lo(gv.z); gd[5] = bf_hi(gv.z); gd[6] = bf_lo(gv.w); gd[7] = bf_hi(gv.w);
        qd[0] = bf_lo(qv.x); qd[1] = bf_hi(qv.x); qd[2] = bf_lo(qv.y); qd[3] = bf_hi(qv.y); qd[4] = bf_lo(qv.z); qd[5] = bf_hi(qv.z); qd[6] = bf_lo(qv.w); qd[7] = bf_hi(qv.w); }
    if (next_item < 2048) hgrn_pre_load(a, round, next_item, gq);
    LDS_BAR();
    {
        const int d = tid & 127, qt = tid >> 7; float cs = 0.f;
#pragma unroll 4
        for (int s = 0; s < 16; ++s) { cs += GL[(qt * 16 + s) * 128 + d]; CUM[(qt * 16 + s) * 128 + d] = cs; }
        LDS_BAR();
        float off = 0.f;
#pragma unroll
        for (int q = 0; q < 3; ++q) off += (q < qt) ? CUM[(q * 16 + 15) * 128 + d] : 0.f;
        LDS_BAR();
#pragma unroll 4
        for (int s = 0; s < 16; ++s) CUM[(qt * 16 + s) * 128 + d] += off;
        if (qt == 3) ((GAS float*)(ws + WS_HGDEC))[(size_t)item * 128 + d] = __expf(cs + off);
    }
    LDS_BAR();
    {
        bf16_t* Qg = (bf16_t*)(ws + WS_QTG) + (size_t)item * 64 * 128;
#pragma unroll
        for (int i = 0; i < 2; ++i) { const int idx = tid + 512 * i, s = idx >> 4, ch = idx & 15;
            float qt[8], qh[8], ke[8];
#pragma unroll
            for (int e = 0; e < 8; ++e) { const int d = ch * 8 + e; const float cm = CUM[s * 128 + d], last = CUM[63 * 128 + d], q = QF[s * 128 + d], g = GL[s * 128 + d];
                qt[e] = q * __expf(cm); qh[e] = q * __expf(cm - last); ke[e] = (1.0f - __expf(g)) * __expf(last - cm); }
            u32x4 o; o.x = pk2(qt[0], qt[1]); o.y = pk2(qt[2], qt[3]); o.z = pk2(qt[4], qt[5]); o.w = pk2(qt[6], qt[7]);
            *(u32x4*)((unsigned char*)Qg + fm_off(s, ch * 8, 4)) = o;
            o.x = pk2(qh[0], qh[1]); o.y = pk2(qh[2], qh[3]); o.z = pk2(qh[4], qh[5]); o.w = pk2(qh[6], qh[7]);
            *(LAS u32x4*)(QH + s * PS_PITCH + ch * 16) = o;
            o.x = pk2(ke[0], ke[1]); o.y = pk2(ke[2], ke[3]); o.z = pk2(ke[4], ke[5]); o.w = pk2(ke[6], ke[7]);
            *(LAS u32x4*)(KE + s * PS_PITCH + ch * 16) = o; }
    }
    LDS_BAR();
    {
        bf16_t* Ag = (bf16_t*)(ws + WS_ATT) + (size_t)item * 64 * 64;
#pragma unroll
        for (int i = 0; i < 2; ++i) { const int tile = wave * 2 + i, tt = tile >> 2, st = tile & 3; const int t = tt * 16 + fr;
            u32x2 o = (u32x2){0u, 0u};
            if (st <= tt) { f32x4 acc = (f32x4){0.f, 0.f, 0.f, 0.f};
#pragma unroll
                for (int ks = 0; ks < 4; ++ks) acc = MFMA16(lfrag(KE, PS_PITCH, st * 16 + fr, ks * 32, fq), lfrag(QH, PS_PITCH, tt * 16 + fr, ks * 32, fq), acc);
                float v[4];
#pragma unroll
                for (int j = 0; j < 4; ++j) { const int s = st * 16 + 4 * fq + j; v[j] = (s <= t) ? acc[j] : 0.f; }
                o.x = pk2(v[0], v[1]); o.y = pk2(v[2], v[3]); }
            *(u32x2*)((unsigned char*)Ag + fm_off(t, st * 16 + 4 * fq, 2)) = o; }
    }
    {
        bf16_t* Kg = (bf16_t*)(ws + WS_KENDT) + (size_t)item * 128 * 64;
        const int dlo = lane & 15, sglo = lane >> 4;
#pragma unroll
        for (int i = 0; i < 2; ++i) { const int combo = wave * 2 + i, d = (combo >> 1) * 16 + dlo, s0 = ((combo & 1) * 4 + sglo) * 8;
            unsigned v[8];
#pragma unroll
            for (int e = 0; e < 8; ++e) v[e] = *(const LAS bf16_t*)(KE + (s0 + e) * PS_PITCH + d * 2);
            u32x4 o; o.x = v[0] | (v[1] << 16); o.y = v[2] | (v[3] << 16); o.z = v[4] | (v[5] << 16); o.w = v[6] | (v[7] << 16);
            *(u32x4*)((unsigned char*)Kg + fm_off(d, s0, 2)) = o; }
    }
    LDS_BAR();
}

template <int NVT, bool DEN>
__device__ __forceinline__ void mlstm_scan(const DArgs& a, LAS unsigned char* lds, int round, int p, int sl) {
    const int tid = tid_(), lane = tid & 63, wave = __builtin_amdgcn_readfirstlane(tid >> 6), fr = lane & 15, fq = lane >> 4;
    const int bl = p >> 2, h = p & 3, b = round * 2 + bl;
    GAS unsigned char* ws = a.ws;
    constexpr int VTB = NVT * 16 * PS_PITCH, CTB = NVT * 16 * PQ_PITCH;
    LAS unsigned char* VT = lds; LAS unsigned char* CT = lds + 2 * VTB; LAS float* DEC = (LAS float*)(lds + 2 * VTB + 2 * CTB);
    for (int i = tid; i < (2 * VTB + 2 * CTB) / 4; i += NTHR) ((LAS unsigned*)lds)[i] = 0u;
    if (tid < 64) DEC[tid] = ((const GAS float*)(ws + WS_MDEC))[p * 64 + tid];
    __syncthreads();
    if (DEN) { if (tid < 256) { const int bufi = tid >> 7, s = tid & 127; *(LAS bf16_t*)(VT + bufi * VTB + s * 2) = (bf16_t)0x3F80; } }
    f32x4 st[2][NVT];
#pragma unroll
    for (int dt = 0; dt < 2; ++dt)
#pragma unroll
        for (int vt = 0; vt < NVT; ++vt) st[dt][vt] = (f32x4){0.f, 0.f, 0.f, 0.f};
    const int vcol = h * 512 + sl * 32;
    const int vs = tid >> 2, vpart = tid & 3;
    const GAS unsigned char* Sg0 = ws + WS_S + (size_t)(p * 64) * 32768 + wave * 4096 + lane * 16;
    const GAS unsigned char* Qg0 = ws + WS_QT + (size_t)(p * 64) * 65536 + wave * 8192 + lane * 16;
    const GAS unsigned char* Kg0 = ws + WS_KWT + (size_t)(p * 64) * 65536 + wave * 8192 + lane * 16;
    const GAS bf16_t* Vg0 = (const GAS bf16_t*)(ws + WS_V) + (size_t)(bl * SEQ + vs) * 2048 + vcol + vpart * 8;
    bf16x8 bS[4], bQ[8], aK[2][4]; u32x4 vreg = (u32x4){0u, 0u, 0u, 0u};
#define V_STAGE(cc_) do { LAS unsigned char* d0_ = VT + ((cc_) & 1) * VTB + (vpart * 8) * PS_PITCH + vs * 2; \
        *(LAS bf16_t*)(d0_ + 0 * PS_PITCH) = (bf16_t)(vreg.x & 0xffffu); *(LAS bf16_t*)(d0_ + 1 * PS_PITCH) = (bf16_t)(vreg.x >> 16); \
        *(LAS bf16_t*)(d0_ + 2 * PS_PITCH) = (bf16_t)(vreg.y & 0xffffu); *(LAS bf16_t*)(d0_ + 3 * PS_PITCH) = (bf16_t)(vreg.y >> 16); \
        *(LAS bf16_t*)(d0_ + 4 * PS_PITCH) = (bf16_t)(vreg.z & 0xffffu); *(LAS bf16_t*)(d0_ + 5 * PS_PITCH) = (bf16_t)(vreg.z >> 16); \
        *(LAS bf16_t*)(d0_ + 6 * PS_PITCH) = (bf16_t)(vreg.w & 0xffffu); *(LAS bf16_t*)(d0_ + 7 * PS_PITCH) = (bf16_t)(vreg.w >> 16); } while (0)
    if (!DEN) { vreg = *(const GAS u32x4*)Vg0; V_STAGE(0); }
    __builtin_amdgcn_sched_barrier(0);
#pragma unroll
    for (int ks = 0; ks < 4; ++ks)
#pragma unroll
        for (int dt = 0; dt < 2; ++dt) aK[dt][ks] = *(const GAS bf16x8*)(Kg0 + (dt * 4 + ks) * 1024);
    __builtin_amdgcn_sched_barrier(0);
#pragma unroll
    for (int ks = 0; ks < 4; ++ks) bS[ks] = *(const GAS bf16x8*)(Sg0 + ks * 1024);
    __builtin_amdgcn_sched_barrier(0);
#pragma unroll
    for (int ks = 0; ks < 8; ++ks) bQ[ks] = *(const GAS bf16x8*)(Qg0 + ks * 1024);
    __builtin_amdgcn_sched_barrier(0);
    if (!DEN) vreg = *(const GAS u32x4*)(Vg0 + (size_t)128 * 2048);
    __builtin_amdgcn_sched_barrier(0);
    const GAS unsigned char* pfp; unsigned pfstride;
    { const int tt = (wave * 64 + lane) < 160 ? wave * 64 + lane : 159; const int idx = sl * 10 + (tt >> 4), off = (tt & 15) * 64;
      pfp = (idx < 32 ? ws + WS_S + (size_t)(p * 64) * 32768 + idx * 1024 : idx < 96 ? ws + WS_QT + (size_t)(p * 64) * 65536 + (idx - 32) * 1024 : ws + WS_KWT + (size_t)(p * 64) * 65536 + (idx - 96) * 1024) + off;
      pfstride = idx < 32 ? 32768u : 65536u; }
    unsigned pfv = 0u;
#pragma unroll 1
    for (int c = 0; c < 64; ++c) {
        const int tl0 = bl * SEQ + c * 128; const size_t tg0 = (size_t)b * SEQ + c * 128;
        const int cn = c < 63 ? c + 1 : 63, cn2 = c < 62 ? c + 2 : 63;
        LAS unsigned char* vt_ = VT + (c & 1) * VTB; LAS unsigned char* ct_ = CT + (c & 1) * CTB; LAS unsigned char* ctn = CT + ((c + 1) & 1) * CTB;
        LDS_BAR();
        if (!DEN && wave < 3) { asm volatile("" :: "v"(pfv)); const int c3 = c < 60 ? c + 3 : 63; pfv = *(const GAS unsigned*)(pfp + (size_t)c3 * pfstride); }
        bf16x8 vf[NVT][4], cf[NVT][4];
#pragma unroll
        for (int vt = 0; vt < NVT; ++vt)
#pragma unroll
            for (int ks = 0; ks < 4; ++ks) vf[vt][ks] = lfrag(vt_, PS_PITCH, vt * 16 + fr, ks * 32, fq);
        const float dec = DEC[c];
        __builtin_amdgcn_sched_barrier(0);
#pragma unroll
        for (int dt = 0; dt < 2; ++dt)
#pragma unroll
            for (int vt = 0; vt < NVT; ++vt) st[dt][vt] = st[dt][vt] * dec;
#pragma unroll
        for (int ks = 0; ks < 4; ++ks) {
#pragma unroll
            for (int vt = 0; vt < NVT; ++vt) cf[vt][ks] = lfrag(ct_, PQ_PITCH, vt * 16 + fr, ks * 32, fq);
#pragma unroll
            for (int dt = 0; dt < 2; ++dt) {
#pragma unroll
                for (int vt = 0; vt < NVT; ++vt) st[dt][vt] = MFMA16(aK[dt][ks], vf[vt][ks], st[dt][vt]);
                aK[dt][ks] = *(const GAS bf16x8*)(Kg0 + (size_t)cn * 65536 + (dt * 4 + ks) * 1024);
            }
            __builtin_amdgcn_sched_barrier(0);
        }
#pragma unroll
        for (int dt = 0; dt < 2; ++dt)
#pragma unroll
            for (int vt = 0; vt < NVT; ++vt) { u32x2 o; o.x = pk2(st[dt][vt][0], st[dt][vt][1]); o.y = pk2(st[dt][vt][2], st[dt][vt][3]);
                *(LAS u32x2*)(ctn + (vt * 16 + fr) * PQ_PITCH + (wave * 32 + dt * 16 + 4 * fq) * 2) = o; }
        __builtin_amdgcn_sched_barrier(0);
        f32x4 acc[NVT];
#pragma unroll
        for (int vt = 0; vt < NVT; ++vt) acc[vt] = (f32x4){0.f, 0.f, 0.f, 0.f};
#pragma unroll
        for (int ks = 0; ks < 4; ++ks) {
#pragma unroll
            for (int vt = 0; vt < NVT; ++vt) acc[vt] = MFMA16(vf[vt][ks], bS[ks], acc[vt]);
            bS[ks] = *(const GAS bf16x8*)(Sg0 + (size_t)cn * 32768 + ks * 1024);
            __builtin_amdgcn_sched_barrier(0);
        }
#pragma unroll
        for (int ks = 0; ks < 8; ++ks) {
#pragma unroll
            for (int vt = 0; vt < NVT; ++vt) acc[vt] = MFMA16(cf[vt][ks & 3], bQ[ks], acc[vt]);
            if (ks < 4) {
#pragma unroll
                for (int vt = 0; vt < NVT; ++vt) cf[vt][ks] = lfrag(ct_, PQ_PITCH, vt * 16 + fr, 128 + ks * 32, fq);
            }
            bQ[ks] = *(const GAS bf16x8*)(Qg0 + (size_t)cn * 65536 + ks * 1024);
            __builtin_amdgcn_sched_barrier(0);
        }
        const int t = wave * 16 + fr;
        if (!DEN) {
            GAS bf16_t* hn = (GAS bf16_t*)(ws + WS_QKPRE) + (size_t)(tl0 + t) * 2048 + vcol + 4 * fq;
#pragma unroll
            for (int vt = 0; vt < NVT; ++vt) { u32x2 o; o.x = pk2(acc[vt][0], acc[vt][1]); o.y = pk2(acc[vt][2], acc[vt][3]); *(GAS u32x2*)(hn + vt * 16) = o; }
            V_STAGE(c + 1); vreg = *(const GAS u32x4*)(Vg0 + (size_t)cn2 * 128 * 2048);
        } else {
            if (fq == 0) ((GAS float*)(ws + WS_DEN))[(tg0 + t) * 4 + h] = acc[0][0];
        }
    }
    asm volatile("" :: "v"(pfv));
    __syncthreads();
#undef V_STAGE
}

constexpr int HG_PD = 4;
__device__ __forceinline__ void hgrn_scan(const DArgs& a, LAS unsigned char* lds, int round, int p, int sl) {
    const int tid = tid_(), lane = tid & 63, wave = __builtin_amdgcn_readfirstlane(tid >> 6), fr = lane & 15, fq = lane >> 4;
    const int bl = p >> 3, h = p & 7;
    GAS unsigned char* ws = a.ws;
    constexpr int IP = 144, ITB = 32 * IP, STB = 32 * PS_PITCH;
    LAS unsigned char* IT = lds; LAS unsigned char* ST = lds + 2 * ITB;
    for (int i = tid; i < (2 * ITB + 2 * STB) / 4; i += NTHR) ((LAS unsigned*)lds)[i] = 0u;
    __syncthreads();
    f32x4 st[2][2];
#pragma unroll
    for (int i = 0; i < 2; ++i) { st[i][0] = (f32x4){0.f, 0.f, 0.f, 0.f}; st[i][1] = st[i][0]; }
    const int vcol = h * 128 + sl * 32;
    const int is = (tid & 255) >> 2, ipart = tid & 3;
    const bool outw = wave < 4;
    const int w4 = wave & 3;
    const GAS unsigned char* Ag0 = ws + WS_ATT + (size_t)(p * 128) * 8192 + w4 * 2048 + lane * 16;
    const GAS unsigned char* Qg0 = ws + WS_QTG + (size_t)(p * 128) * 16384 + w4 * 4096 + lane * 16;
    const GAS unsigned char* Kg0 = ws + WS_KENDT + (size_t)(p * 128) * 16384 + w4 * 4096 + lane * 16;
    const GAS unsigned char* Dg0 = ws + WS_HGDEC + ((size_t)(p * 128) * 128 + w4 * 32 + 4 * fq) * 4;
    const GAS unsigned char* Ig0 = ws + WS_GI + ((size_t)(bl * SEQ + is) * 1024 + vcol + ipart * 8) * 2;
    const GAS unsigned char* gb0 = outw ? Ag0 : Kg0;          const unsigned gs0 = outw ? 8192u : 16384u;
    const GAS unsigned char* gb1 = outw ? Qg0 : Kg0 + 2048;   const unsigned gs1 = 16384u;
    const GAS unsigned char* gb2 = outw ? Qg0 + 2048 : Dg0;   const unsigned gs2 = outw ? 16384u : 512u, gt2 = outw ? 1024u : 64u;
    const GAS unsigned char* gb3 = outw ? Ig0 : Dg0;          const unsigned gs3 = outw ? 131072u : 512u;
    u32x4 pf[HG_PD][7];
#define HG_LD01(k_, cc_) do { _Pragma("unroll") for (int j_ = 0; j_ < 2; ++j_) pf[k_][j_] = *(const GAS u32x4*)(gb0 + (size_t)(cc_) * gs0 + j_ * 1024); } while (0)
#define HG_LD23(k_, cc_) do { _Pragma("unroll") for (int j_ = 0; j_ < 2; ++j_) pf[k_][2 + j_] = *(const GAS u32x4*)(gb1 + (size_t)(cc_) * gs1 + j_ * 1024); } while (0)
#define HG_LD45(k_, cc_) do { _Pragma("unroll") for (int j_ = 0; j_ < 2; ++j_) pf[k_][4 + j_] = *(const GAS u32x4*)(gb2 + (size_t)(cc_) * gs2 + j_ * gt2); } while (0)
#define HG_LD6(k_, cc_) do { pf[k_][6] = *(const GAS u32x4*)(gb3 + (size_t)(cc_) * gs3); } while (0)
#pragma unroll
    for (int k = 0; k < HG_PD; ++k) { HG_LD01(k, k); HG_LD23(k, k); HG_LD45(k, k); __builtin_amdgcn_sched_barrier(0); HG_LD6((k + 1) % HG_PD, (k + 1 < HG_PD ? k + 1 : HG_PD)); __builtin_amdgcn_sched_barrier(0); }
    const GAS unsigned char* pfp; unsigned pfstride;
    { const int tt = (wave * 64 + lane) < 160 ? wave * 64 + lane : 159; const int idx = sl * 10 + (tt >> 4), off = (tt & 15) * 64;
      pfp = (idx < 8 ? ws + WS_ATT + (size_t)(p * 128) * 8192 + idx * 1024 : idx < 24 ? ws + WS_QTG + (size_t)(p * 128) * 16384 + (idx - 8) * 1024 : ws + WS_KENDT + (size_t)(p * 128) * 16384 + (idx - 24) * 1024) + off;
      pfstride = idx < 8 ? 8192u : 16384u; }
    unsigned pfv[HG_PD];
#pragma unroll
    for (int k = 0; k < HG_PD; ++k) pfv[k] = 0u;
#define HG_STAGE(dst_, iv_) do { LAS unsigned char* d0_ = (dst_) + (ipart * 8) * IP + is * 2; \
        *(LAS bf16_t*)(d0_ + 0 * IP) = (bf16_t)((iv_).x & 0xffffu); *(LAS bf16_t*)(d0_ + 1 * IP) = (bf16_t)((iv_).x >> 16); \
        *(LAS bf16_t*)(d0_ + 2 * IP) = (bf16_t)((iv_).y & 0xffffu); *(LAS bf16_t*)(d0_ + 3 * IP) = (bf16_t)((iv_).y >> 16); \
        *(LAS bf16_t*)(d0_ + 4 * IP) = (bf16_t)((iv_).z & 0xffffu); *(LAS bf16_t*)(d0_ + 5 * IP) = (bf16_t)((iv_).z >> 16); \
        *(LAS bf16_t*)(d0_ + 6 * IP) = (bf16_t)((iv_).w & 0xffffu); *(LAS bf16_t*)(d0_ + 7 * IP) = (bf16_t)((iv_).w >> 16); } while (0)
    if (outw) { const u32x4 iv = *(const GAS u32x4*)Ig0; HG_STAGE(IT, iv); }
#pragma unroll 1
    for (int c0 = 0; c0 < 128; c0 += HG_PD) {
#pragma unroll
      for (int k = 0; k < HG_PD; ++k) {
        const int c = c0 + k;
        const int tl0 = bl * SEQ + c * 64;
        const int cn = (c + HG_PD < 128) ? c + HG_PD : 127;
        LAS unsigned char* it_ = IT + (k & 1) * ITB; LAS unsigned char* itn = IT + ((k + 1) & 1) * ITB; LAS unsigned char* st_ = ST + (k & 1) * STB; LAS unsigned char* stn = ST + ((k + 1) & 1) * STB;
        LDS_BAR();
        if (wave < 3) { asm volatile("" :: "v"(pfv[k])); const int c7 = (c + HG_PD + 3 < 128) ? c + HG_PD + 3 : 127; pfv[k] = *(const GAS unsigned*)(pfp + (size_t)c7 * pfstride); }
        bf16x8 itf[2][2];
#pragma unroll
        for (int vt = 0; vt < 2; ++vt)
#pragma unroll
            for (int ks = 0; ks < 2; ++ks) itf[vt][ks] = lfrag(it_, IP, vt * 16 + fr, ks * 32, fq);
        bf16x8 sf[2][4];
        f32x4 acc[2];
        acc[0] = (f32x4){0.f, 0.f, 0.f, 0.f}; acc[1] = acc[0];
        if (outw) {
#pragma unroll
            for (int vt = 0; vt < 2; ++vt)
#pragma unroll
                for (int ks = 0; ks < 4; ++ks) sf[vt][ks] = lfrag(st_, PS_PITCH, vt * 16 + fr, ks * 32, fq);
#pragma unroll
            for (int ks = 0; ks < 2; ++ks)
#pragma unroll
                for (int vt = 0; vt < 2; ++vt) acc[vt] = MFMA16(itf[vt][ks], __builtin_bit_cast(bf16x8, pf[k][ks]), acc[vt]);
        } else {
            const f32x4 dec = __builtin_bit_cast(f32x4, pf[k][4]);
#pragma unroll
            for (int vt = 0; vt < 2; ++vt) { st[0][vt] = st[0][vt] * dec;
#pragma unroll
                for (int ks = 0; ks < 2; ++ks) st[0][vt] = MFMA16(__builtin_bit_cast(bf16x8, pf[k][ks]), itf[vt][ks], st[0][vt]); }
        }
        __builtin_amdgcn_sched_barrier(0);
        HG_LD01(k, cn);
        __builtin_amdgcn_sched_barrier(0);
        if (outw) {
#pragma unroll
            for (int ks = 0; ks < 2; ++ks)
#pragma unroll
                for (int vt = 0; vt < 2; ++vt) acc[vt] = MFMA16(sf[vt][ks], __builtin_bit_cast(bf16x8, pf[k][2 + ks]), acc[vt]);
        } else {
            const f32x4 dec = __builtin_bit_cast(f32x4, pf[k][5]);
#pragma unroll
            for (int vt = 0; vt < 2; ++vt) { st[1][vt] = st[1][vt] * dec;
#pragma unroll
                for (int ks = 0; ks < 2; ++ks) st[1][vt] = MFMA16(__builtin_bit_cast(bf16x8, pf[k][2 + ks]), itf[vt][ks], st[1][vt]); }
        }
        __builtin_amdgcn_sched_barrier(0);
        HG_LD23(k, cn);
        __builtin_amdgcn_sched_barrier(0);
        if (outw) {
#pragma unroll
            for (int ks = 2; ks < 4; ++ks)
#pragma unroll
                for (int vt = 0; vt < 2; ++vt) acc[vt] = MFMA16(sf[vt][ks], __builtin_bit_cast(bf16x8, pf[k][2 + ks]), acc[vt]);
        } else {
#pragma unroll
            for (int dtile = 0; dtile < 2; ++dtile)
#pragma unroll
                for (int vt = 0; vt < 2; ++vt) { u32x2 o; o.x = pk2(st[dtile][vt][0], st[dtile][vt][1]); o.y = pk2(st[dtile][vt][2], st[dtile][vt][3]);
                    *(LAS u32x2*)(stn + (vt * 16 + fr) * PS_PITCH + (w4 * 32 + dtile * 16 + 4 * fq) * 2) = o; }
        }
        __builtin_amdgcn_sched_barrier(0);
        HG_LD45(k, cn);
        __builtin_amdgcn_sched_barrier(0);
        if (outw) {
            HG_STAGE(itn, pf[(k + 1) % HG_PD][6]);
            GAS bf16_t* og = (GAS bf16_t*)(ws + WS_GQ) + (size_t)(tl0 + w4 * 16 + fr) * 1024 + vcol + 4 * fq;
#pragma unroll
            for (int vt = 0; vt < 2; ++vt) { u32x2 o; o.x = pk2(acc[vt][0], acc[vt][1]); o.y = pk2(acc[vt][2], acc[vt][3]); *(GAS u32x2*)(og + vt * 16) = o; }
        }
        __builtin_amdgcn_sched_barrier(0);
        { const int cni = (c + 1 + HG_PD < 128) ? c + 1 + HG_PD : 127; HG_LD6((k + 1) % HG_PD, cni); }
        __builtin_amdgcn_sched_barrier(0);
      }
    }
#pragma unroll
    for (int k = 0; k < HG_PD; ++k) asm volatile("" :: "v"(pfv[k]));
    __syncthreads();
#undef HG_LD01
#undef HG_LD23
#undef HG_LD45
#undef HG_LD6
#undef HG_STAGE
}

__device__ __forceinline__ void phase_ypass(const DArgs& a, int round, int vcu, int G) {
    const int tid = tid_(), lane = tid & 63, wave = tid >> 6;
    const int gw = vcu * NWAVES + wave, NGW = G * NWAVES;
    GAS unsigned char* ws = a.ws;
    f32x4 mg0[4], mg1[4], gg4[4];
#pragma unroll
    for (int j = 0; j < 4; ++j) { mg0[j] = *(const GAS f32x4*)(a.m_head_g + j * 512 + lane * 8); mg1[j] = *(const GAS f32x4*)(a.m_head_g + j * 512 + lane * 8 + 4); gg4[j] = *(const GAS f32x4*)(a.g_head_g + lane * 16 + 4 * j); }
    for (int tl = gw; tl < RT; tl += NGW) {
        const size_t tg = (size_t)round * RT + tl;
        const f32x4 den4 = *(const f32x4*)((const float*)(ws + WS_DEN) + tg * 4), mt4 = *(const f32x4*)((const float*)(ws + WS_MT) + tg * 4);
#pragma unroll
        for (int j = 0; j < 4; ++j) {
            const int col = j * 512 + lane * 8;
            const u32x4 nv = *(const u32x4*)((const bf16_t*)(ws + WS_QKPRE) + (size_t)tl * 2048 + col);
            const u32x4 ov = *(const u32x4*)((const bf16_t*)(ws + WS_SIGO) + (size_t)tl * 2048 + col);
            const float inv = 1.0f / fmaxf(fabsf(den4[j]), __expf(-mt4[j]));
            float hv[8] = {bf_lo(nv.x) * inv, bf_hi(nv.x) * inv, bf_lo(nv.y) * inv, bf_hi(nv.y) * inv, bf_lo(nv.z) * inv, bf_hi(nv.z) * inv, bf_lo(nv.w) * inv, bf_hi(nv.w) * inv};
            float ss = 0.f;
#pragma unroll
            for (int e = 0; e < 8; ++e) ss += hv[e] * hv[e];
            const float r = rsqrtf(wave_sum(ss, lane) * (1.f / 512.f) + EPS);
            const f32x4 g0 = mg0[j], g1 = mg1[j];
            const float og[8] = {bf_lo(ov.x), bf_hi(ov.x), bf_lo(ov.y), bf_hi(ov.y), bf_lo(ov.z), bf_hi(ov.z), bf_lo(ov.w), bf_hi(ov.w)};
            float y[8];
#pragma unroll
            for (int e = 0; e < 8; ++e) y[e] = og[e] * hv[e] * r * (e < 4 ? g0[e] : g1[e - 4]);
            u32x4 o; o.x = pk2(y[0], y[1]); o.y = pk2(y[2], y[3]); o.z = pk2(y[4], y[5]); o.w = pk2(y[6], y[7]);
            *(u32x4*)((bf16_t*)(ws + WS_V) + (size_t)tl * 2048 + col) = o;
        }
        {
            const int col = lane * 16;
            const u32x4 n0 = *(const u32x4*)((const bf16_t*)(ws + WS_GQ) + (size_t)tl * 1024 + col), n1 = *(const u32x4*)((const bf16_t*)(ws + WS_GQ) + (size_t)tl * 1024 + col + 8);
            const u32x4 s0 = *(const u32x4*)((const bf16_t*)(ws + WS_SGG) + (size_t)tl * 1024 + col), s1 = *(const u32x4*)((const bf16_t*)(ws + WS_SGG) + (size_t)tl * 1024 + col + 8);
            float ov[16] = {bf_lo(n0.x), bf_hi(n0.x), bf_lo(n0.y), bf_hi(n0.y), bf_lo(n0.z), bf_hi(n0.z), bf_lo(n0.w), bf_hi(n0.w), bf_lo(n1.x), bf_hi(n1.x), bf_lo(n1.y), bf_hi(n1.y), bf_lo(n1.z), bf_hi(n1.z), bf_lo(n1.w), bf_hi(n1.w)};
            const float sg[16] = {bf_lo(s0.x), bf_hi(s0.x), bf_lo(s0.y), bf_hi(s0.y), bf_lo(s0.z), bf_hi(s0.z), bf_lo(s0.w), bf_hi(s0.w), bf_lo(s1.x), bf_hi(s1.x), bf_lo(s1.y), bf_hi(s1.y), bf_lo(s1.z), bf_hi(s1.z), bf_lo(s1.w), bf_hi(s1.w)};
            float ss = 0.f;
#pragma unroll
            for (int e = 0; e < 16; ++e) ss += ov[e] * ov[e];
            ss += DPP_(ss, 0xB1); ss += DPP_(ss, 0x4E); ss += DPP_(ss, 0x141);
            const float r = rsqrtf(ss * (1.f / 128.f) + EPS);
            float y[16];
#pragma unroll
            for (int e = 0; e < 16; ++e) y[e] = ov[e] * r * gg4[e >> 2][e & 3] * sg[e];
            u32x4 o; o.x = pk2(y[0], y[1]); o.y = pk2(y[2], y[3]); o.z = pk2(y[4], y[5]); o.w = pk2(y[6], y[7]);
            *(u32x4*)((bf16_t*)(ws + WS_GI) + (size_t)tl * 1024 + col) = o;
            o.x = pk2(y[8], y[9]); o.y = pk2(y[10], y[11]); o.z = pk2(y[12], y[13]); o.w = pk2(y[14], y[15]);
            *(u32x4*)((bf16_t*)(ws + WS_GI) + (size_t)tl * 1024 + col + 8) = o;
        }
    }
}


#define XB_TMO      128
#define XB_XCNT(j)  (256  + 64 * (j))
#define XB_XSUB(j)  (1280 + 64 * (j))
#define XB_XGEN(j)  (2304 + 64 * (j))
#define XB_TOP      3328
#define XB_TOPGEN   3392
#define XB_SPIN_CAP (1u << 22)
constexpr int CW_BAR = 4096;
constexpr int LDS_BARST = LDS_BYTES - 64;
__device__ __forceinline__ unsigned xb_ld(unsigned* p)              { return __hip_atomic_load(p, __ATOMIC_RELAXED, __HIP_MEMORY_SCOPE_AGENT); }
__device__ __forceinline__ unsigned xb_add(unsigned* p, unsigned v) { return __hip_atomic_fetch_add(p, v, __ATOMIC_RELAXED, __HIP_MEMORY_SCOPE_AGENT); }
__device__ __forceinline__ unsigned xb_xcc_id() { return (unsigned)__builtin_amdgcn_s_getreg((3 << 11) | 20) & 0xFu; }
#define XB_SPIN(cond, bar) do { unsigned _sp = 0; while (cond) { __builtin_amdgcn_s_sleep(1); \
    if ((++_sp & 255u) == 0u) { if (xb_ld(&(bar)[XB_TMO])) break; if (_sp > XB_SPIN_CAP) { atomicAdd(&(bar)[XB_TMO], 1u); break; } } } } while (0)
__device__ __forceinline__ void xcd_barrier_post(unsigned* bar, volatile LAS unsigned* st) { if (tid_() == 0) st[2] = xb_add(&bar[XB_XCNT(xb_xcc_id())], 1u); }
__device__ __forceinline__ void xcd_barrier_complete(unsigned* bar, unsigned x, unsigned& nloc, unsigned& nx) {
    const unsigned G = gridDim.x;
    unsigned sum, cnt, mine, sp = 0u;
    for (;;) {
        sum = 0u; cnt = 0u; mine = 0u;
#pragma unroll
        for (unsigned j = 0; j < 16; ++j) { const unsigned c = xb_ld(&bar[XB_XCNT(j)]); sum += c; cnt += (c > 0u) ? 1u : 0u; mine = (j == x) ? c : mine; }
        if (sum == G) break;
        __builtin_amdgcn_s_sleep(1);
        if ((++sp & 255u) == 0u) { if (xb_ld(&bar[XB_TMO])) break; if (sp > XB_SPIN_CAP) { atomicAdd(&bar[XB_TMO], 1u); break; } }
    }
    nloc = mine > 0u ? mine : 1u; nx = cnt > 0u ? cnt : 1u;
}
__device__ __forceinline__ void xcd_barrier(unsigned* bar, volatile LAS unsigned* st) {
    asm volatile("s_waitcnt vmcnt(0)" ::: "memory");
    __syncthreads();
    if (tid_() == 0) {
        const unsigned x = xb_xcc_id();
        __builtin_amdgcn_s_waitcnt(0);
        unsigned nloc = st[0], nx = st[1];
        if (nloc == 0u) { xcd_barrier_complete(bar, x, nloc, nx); st[0] = nloc; st[1] = nx; }
        const unsigned old = xb_add(&bar[XB_XSUB(x)], 1u);
        const unsigned gen = old / nloc;
        if (old + 1u == (gen + 1u) * nloc) {
            __builtin_amdgcn_fence(__ATOMIC_RELEASE, "agent");
            asm volatile("s_waitcnt vmcnt(0)" ::: "memory");
            const unsigned og = xb_add(&bar[XB_TOP], 1u);
            const unsigned tg = og / nx;
            if (og + 1u == (tg + 1u) * nx) xb_add(&bar[XB_TOPGEN], 1u);
            else XB_SPIN(xb_ld(&bar[XB_TOPGEN]) == tg, bar);
            __builtin_amdgcn_fence(__ATOMIC_ACQUIRE, "agent");
            xb_add(&bar[XB_XGEN(x)], 1u);
            asm volatile("s_waitcnt vmcnt(0)" ::: "memory");
        } else {
            XB_SPIN(xb_ld(&bar[XB_XGEN(x)]) == gen, bar);
            __builtin_amdgcn_fence(__ATOMIC_ACQUIRE, "agent");
            asm volatile("s_waitcnt vmcnt(0)" ::: "memory");
        }
    }
    __syncthreads();
}

__device__ __forceinline__ void phase_p8(const DArgs& a, int vcu, int G) {
    const int tid = tid_(), lane = tid & 63, wave = tid >> 6;
    const int gw = vcu * NWAVES + wave, NGW = G * NWAVES;
    GAS unsigned char* ws = a.ws;
    f32x4 g2[4];
#pragma unroll
    for (int j = 0; j < 4; ++j) g2[j] = ((const f32x4*)a.norm2_g)[64 * j + lane];
    for (int m = gw; m < T; m += NGW) {
        const f32x4* xr = (const f32x4*)(a.out + (size_t)m * D) + lane;
        f32x4 v[4]; float s = 0.f;
#pragma unroll
        for (int j = 0; j < 4; ++j) { v[j] = xr[64 * j]; s += (v[j][0] * v[j][0] + v[j][1] * v[j][1]) + (v[j][2] * v[j][2] + v[j][3] * v[j][3]); }
        const float rstd = rsqrtf(wave_sum(s, lane) * (1.f / D) + EPS);
        unsigned long long* o8 = (unsigned long long*)((bf16_t*)(ws + WS_XN) + (size_t)m * D) + lane;
#pragma unroll
        for (int j = 0; j < 4; ++j) { v[j] = v[j] * rstd * g2[j]; o8[64 * j] = (unsigned long long)pk2(v[j][0], v[j][1]) | ((unsigned long long)pk2(v[j][2], v[j][3]) << 32); }
        float mx = 0.f;
#pragma unroll
        for (int j = 0; j < 4; ++j) mx = fmaxf(mx, fmaxf(fmaxf(fabsf(v[j][0]), fabsf(v[j][1])), fmaxf(fabsf(v[j][2]), fabsf(v[j][3]))));
        mx = wave_max(mx);
        const float qs = mx > 0.f ? 127.0f / mx : 0.f;
#pragma unroll
        for (int j = 0; j < 4; ++j) ((GAS unsigned*)(ws + WS_XQ + (size_t)m * 1024))[64 * j + lane] = pack_i8x4(v[j][0] * qs, v[j][1] * qs, v[j][2] * qs, v[j][3] * qs);
        if (lane == 0) ((GAS float*)(ws + WS_XQS))[m] = mx * (1.0f / 127.0f);
    }
    {
        const float mu = __builtin_bit_cast(float, ((const GAS unsigned*)(ws + WS_CTL))[CW_TMAX]), mv = __builtin_bit_cast(float, ((const GAS unsigned*)(ws + WS_CTL))[CW_TMAX + 1]);
        const float su = mu > 0.f ? 127.0f / mu : 1.0f, sv = mv > 0.f ? 448.0f / mv : 1.0f;
        if (vcu == 0 && tid == 0) { ((GAS float*)(ws + WS_USC))[0] = 1.0f / su; ((GAS float*)(ws + WS_USC))[1] = 1.0f / sv; }
        for (size_t i = (size_t)vcu * NTHR + tid; i < (size_t)16384 * 1024 / 8; i += (size_t)G * NTHR) {
            const f32x4 u0 = ((const GAS f32x4*)a.u_emb)[2 * i], u1 = ((const GAS f32x4*)a.u_emb)[2 * i + 1];
            const f32x4 v0 = ((const GAS f32x4*)a.v_emb)[2 * i], v1 = ((const GAS f32x4*)a.v_emb)[2 * i + 1];
            u32x2 o; int p;
            o.x = pack_i8x4(u0[0] * su, u0[1] * su, u0[2] * su, u0[3] * su); o.y = pack_i8x4(u1[0] * su, u1[1] * su, u1[2] * su, u1[3] * su);
            const size_t io = (size_t)((i & 127) >> 4) * 262144 + (i >> 7) * 16 + (i & 15);
            ((GAS u32x2*)(ws + WS_UB))[io] = o;
            p = __builtin_amdgcn_cvt_pk_fp8_f32(v0[0] * sv, v0[1] * sv, 0, false); p = __builtin_amdgcn_cvt_pk_fp8_f32(v0[2] * sv, v0[3] * sv, p, true); o.x = (unsigned)p;
            p = __builtin_amdgcn_cvt_pk_fp8_f32(v1[0] * sv, v1[1] * sv, 0, false); p = __builtin_amdgcn_cvt_pk_fp8_f32(v1[2] * sv, v1[3] * sv, p, true); o.y = (unsigned)p;
            ((GAS u32x2*)(ws + WS_VB))[io] = o;
        }
    }
}

__device__ __forceinline__ unsigned f2ord(float f) { const unsigned u = __builtin_bit_cast(unsigned, f); return (u & 0x80000000u) ? ~u : (u | 0x80000000u); }
__device__ __forceinline__ float ord2f(unsigned k) { const unsigned u = (k & 0x80000000u) ? (k & 0x7fffffffu) : ~k; return __builtin_bit_cast(float, u); }
__device__ __forceinline__ unsigned umax_(unsigned a, unsigned b) { return a > b ? a : b; }
__device__ __forceinline__ unsigned shxu(unsigned v, int o, int lane) { return (unsigned)__builtin_amdgcn_ds_bpermute((lane ^ o) << 2, (int)v); }

__device__ __forceinline__ void phase_topk(const DArgs& a, LAS unsigned char* lds, int bx, int G) {
    const int tid = tid_(), lane = tid & 63, wave = __builtin_amdgcn_readfirstlane(tid >> 6), fr = lane & 15, fq = lane >> 4;
    GAS unsigned char* ws = a.ws;
    const int h = bx & 7;
    LAS unsigned char* KY = lds;
    LAS unsigned char* QL = lds + 2 * 128 * PS_PITCH;
    LAS unsigned* TOP = (LAS unsigned*)(lds + 2 * 128 * PS_PITCH + 64 * PQ_PITCH);
#pragma unroll
    for (int i = 0; i < 8; ++i) { const int idx = tid + 512 * i, row = idx >> 4, ch = idx & 15;
        *(LAS u32x4*)(KY + row * PS_PITCH + ch * 16) = *(const u32x4*)((const bf16_t*)(ws + WS_SK) + ((size_t)h * 256 + row) * 128 + ch * 8); }
    const int ntile = T / 64;
    for (int tile = bx >> 3; tile < ntile; tile += (G >> 3)) {
        const size_t t0 = (size_t)tile * 64;
        __syncthreads();
#pragma unroll
        for (int i = 0; i < 4; ++i) { const int idx = tid + 512 * i, row = idx >> 5, ch = idx & 31;
            *(LAS u32x4*)(QL + row * PQ_PITCH + ch * 16) = *(const u32x4*)((const bf16_t*)(ws + WS_QP) + (t0 + row) * 2048 + h * 256 + ch * 8); }
        __syncthreads();
        {
            const int mt = wave & 3, p = wave >> 2;
            unsigned key[32];
#pragma unroll
            for (int nt = 0; nt < 8; ++nt) { f32x4 acc = (f32x4){0.f, 0.f, 0.f, 0.f};
#pragma unroll
                for (int ks = 0; ks < 4; ++ks) acc = MFMA16(lfrag(KY + p * 128 * PS_PITCH, PS_PITCH, nt * 16 + fr, ks * 32, fq), lfrag(QL, PQ_PITCH, mt * 16 + fr, p * 128 + ks * 32, fq), acc);
#pragma unroll
                for (int j = 0; j < 4; ++j) { const int n = nt * 16 + 4 * fq + j; key[nt * 4 + j] = (f2ord(acc[j]) & ~127u) | (unsigned)(127 - n); } }
#pragma unroll 1
            for (int k = 0; k < 16; ++k) {
                unsigned m = key[0];
#pragma unroll
                for (int e = 1; e < 32; ++e) m = umax_(m, key[e]);
                m = umax_(m, (unsigned)SWZI_(m, 0x401F)); m = umax_(m, xor32u_(m, lane >= 32));
#pragma unroll
                for (int e = 0; e < 32; ++e) key[e] = (key[e] == m) ? 0u : key[e];
                if (fq == (k & 3)) TOP[(p * 64 + mt * 16 + fr) * 16 + k] = m;
            }
        }
        __syncthreads();
        {
            const int t = tid >> 3, sub = tid & 7;
            unsigned ck[7];
#pragma unroll
            for (int e = 0; e < 7; ++e) {
                const int ci = sub + 8 * e;
                int i = 0, base = 0; bool ok = ci < 50;
                if (ci >= 42) { i = 8 + (ci - 42); base = ci; } else if (ci >= 40) { i = 7; base = 40; } else if (ci >= 38) { i = 6; base = 38; } else if (ci >= 36) { i = 5; base = 36; }
                else if (ci >= 33) { i = 4; base = 33; } else if (ci >= 29) { i = 3; base = 29; } else if (ci >= 24) { i = 2; base = 24; } else if (ci >= 16) { i = 1; base = 16; }
                const int j = ci - base;
                unsigned kk = 0u;
                if (ok) { const float s0 = ord2f(TOP[(0 * 64 + t) * 16 + i] & ~127u), s1 = ord2f(TOP[(1 * 64 + t) * 16 + j] & ~127u);
                    kk = (f2ord(s0 + s1) & ~255u) | (unsigned)(255 - (i * 16 + j)); }
                ck[e] = kk;
            }
            unsigned w0 = 0u, w1 = 0u;
#pragma unroll 1
            for (int k = 0; k < 16; ++k) {
                unsigned m = ck[0];
#pragma unroll
                for (int e = 1; e < 7; ++e) m = umax_(m, ck[e]);
                m = umax_(m, (unsigned)DPPI_(m, 0xB1)); m = umax_(m, (unsigned)DPPI_(m, 0x4E)); m = umax_(m, (unsigned)DPPI_(m, 0x141));
#pragma unroll
                for (int e = 0; e < 7; ++e) ck[e] = (ck[e] == m) ? 0u : ck[e];
                if (k == sub) w0 = m; if (k == sub + 8) w1 = m;
            }
            const int f0 = 255 - (int)(w0 & 255u), f1 = 255 - (int)(w1 & 255u);
            const float sc0 = ord2f(w0 & ~255u), sc1 = ord2f(w1 & ~255u);
            float mx = fmaxf(sc0, sc1); mx = fmaxf(mx, DPP_(mx, 0xB1)); mx = fmaxf(mx, DPP_(mx, 0x4E)); mx = fmaxf(mx, DPP_(mx, 0x141));
            const float e0 = __expf(sc0 - mx), e1 = __expf(sc1 - mx);
            float sm = e0 + e1; sm += DPP_(sm, 0xB1); sm += DPP_(sm, 0x4E); sm += DPP_(sm, 0x141);
            const float inv = 1.0f / sm;
            const int i0 = 127 - (int)(TOP[(0 * 64 + t) * 16 + (f0 >> 4)] & 127u), j0 = 127 - (int)(TOP[(1 * 64 + t) * 16 + (f0 & 15)] & 127u);
            const int i1 = 127 - (int)(TOP[(0 * 64 + t) * 16 + (f1 >> 4)] & 127u), j1 = 127 - (int)(TOP[(1 * 64 + t) * 16 + (f1 & 15)] & 127u);
            int* ei = (int*)(ws + WS_EIDX) + ((t0 + t) * 8 + h) * 16; float* gp = (float*)(ws + WS_GATE) + ((t0 + t) * 8 + h) * 16;
            ei[sub] = i0 * 128 + j0; ei[sub + 8] = i1 * 128 + j1; gp[sub] = e0 * inv; gp[sub + 8] = e1 * inv;
        }
    }
    __syncthreads();
}

__device__ __forceinline__ void ins16(float (&v)[16], int (&id)[16], float x, int n) {
    if (x > v[15]) { v[15] = x; id[15] = n;
#pragma unroll
        for (int i = 15; i >= 1; --i) { if (v[i] > v[i - 1]) { const float tv = v[i]; v[i] = v[i - 1]; v[i - 1] = tv; const int ti = id[i]; id[i] = id[i - 1]; id[i - 1] = ti; } } }
}
__device__ __forceinline__ void phase_topk_ref(const DArgs& a, int vcu, int G) {
    const int tid = tid_();
    GAS unsigned char* ws = a.ws;
    const int gt = vcu * NTHR + tid, NGT = G * NTHR;
    for (int pair = gt; pair < T * 8; pair += NGT) {
        const int t = pair >> 3, h = pair & 7;
        float sv[2][16]; int si[2][16];
#pragma unroll
        for (int p = 0; p < 2; ++p) {
#pragma unroll
            for (int i = 0; i < 16; ++i) { sv[p][i] = -INFINITY; si[p][i] = 0; }
            const bf16_t* qp = (const bf16_t*)(ws + WS_QP) + (size_t)t * 2048 + h * 256 + p * 128;
            for (int n = 0; n < 128; ++n) {
                const bf16_t* kp = (const bf16_t*)(ws + WS_SK) + ((size_t)(h * 2 + p) * 128 + n) * 128;
                float s = 0.f;
                for (int c = 0; c < 128; c += 8) { const u32x4 qv = *(const u32x4*)(qp + c), kv = *(const u32x4*)(kp + c);
                    s += bf_lo(qv.x) * bf_lo(kv.x) + bf_hi(qv.x) * bf_hi(kv.x) + bf_lo(qv.y) * bf_lo(kv.y) + bf_hi(qv.y) * bf_hi(kv.y)
                       + bf_lo(qv.z) * bf_lo(kv.z) + bf_hi(qv.z) * bf_hi(kv.z) + bf_lo(qv.w) * bf_lo(kv.w) + bf_hi(qv.w) * bf_hi(kv.w); }
                ins16(sv[p], si[p], s, n);
            }
        }
        float tv[16]; int ti[16];
#pragma unroll
        for (int i = 0; i < 16; ++i) { tv[i] = -INFINITY; ti[i] = 0; }
#pragma unroll
        for (int i = 0; i < 16; ++i)
#pragma unroll
            for (int j = 0; j < 16; ++j) ins16(tv, ti, sv[0][i] + sv[1][j], i * 16 + j);
        float sm = 0.f, ex[16];
#pragma unroll
        for (int k = 0; k < 16; ++k) { ex[k] = __expf(tv[k] - tv[0]); sm += ex[k]; }
        int* ei = (int*)(ws + WS_EIDX) + (size_t)pair * 16; float* gp = (float*)(ws + WS_GATE) + (size_t)pair * 16;
#pragma unroll
        for (int k = 0; k < 16; ++k) {
            int e0 = 0, e1 = 0;
#pragma unroll
            for (int i = 0; i < 16; ++i) { e0 = ((ti[k] >> 4) == i) ? si[0][i] : e0; e1 = ((ti[k] & 15) == i) ? si[1][i] : e1; }
            ei[k] = e0 * 128 + e1; gp[k] = ex[k] / sm; }
    }
}

#define FP8LO(w) __builtin_amdgcn_cvt_pk_f32_fp8((int)(w), false)
#define FP8HI(w) __builtin_amdgcn_cvt_pk_f32_fp8((int)(w), true)
__device__ __forceinline__ float dot16_fp8(const u32x4 r, const float (&x)[16]) {
    float c = 0.f;
#pragma unroll
    for (int j = 0; j < 4; ++j) { const f32x2 lo = FP8LO(r[j]), hi = FP8HI(r[j]); c += lo[0] * x[4 * j] + lo[1] * x[4 * j + 1] + hi[0] * x[4 * j + 2] + hi[1] * x[4 * j + 3]; }
    return c;
}
__device__ __forceinline__ float dot16_fp8p(const u32x4 r, const f32x2 (&xp)[8]) {
    f32x2 c2 = (f32x2){0.f, 0.f};
#pragma unroll
    for (int j = 0; j < 4; ++j) { c2 += FP8LO(r[j]) * xp[2 * j]; c2 += FP8HI(r[j]) * xp[2 * j + 1]; }
    return c2[0] + c2[1];
}
__device__ __forceinline__ float gelu_erf(float d) {
    const float ad = fabsf(d), t = __builtin_amdgcn_rcpf(ad * 0.2316418882f + 1.0f);
    float q = t * 0.5307027145f + (-0.7265760135f); q = q * t + 0.7107068705f; q = q * t + (-0.142248368f); q = q * t + 0.127414796f; q = q * t;
    const float m = d * (q * __builtin_amdgcn_exp2f(d * d * (-0.72134752044f)));
    return d < 0.f ? m : d - m;
}
__device__ __forceinline__ float bperm(float v, int srclane) { return __builtin_bit_cast(float, __builtin_amdgcn_ds_bpermute(srclane << 2, __builtin_bit_cast(int, v))); }
#define SWZ_(v, pat) __builtin_bit_cast(float, __builtin_amdgcn_ds_swizzle(__builtin_bit_cast(int, (v)), (pat)))
__device__ __forceinline__ float rs32_(float a, float b) {
#if defined(__HIP_DEVICE_COMPILE__)
    asm volatile("s_nop 1\n\tv_permlane32_swap_b32 %0, %1" : "+v"(a), "+v"(b));
#endif
    return a + b;
}
__device__ __forceinline__ float rs16_(float a, float b) {
#if defined(__HIP_DEVICE_COMPILE__)
    asm volatile("s_nop 1\n\tv_permlane16_swap_b32 %0, %1" : "+v"(a), "+v"(b));
#endif
    return a + b;
}
__device__ __forceinline__ float rs8_(float a, float b, bool bit3) {
    const float send = bit3 ? a : b, keep = bit3 ? b : a;
    return keep + DPP_(send, 0x128);
}
__device__ __forceinline__ float xor32_(float v, bool hi) {
#if defined(__HIP_DEVICE_COMPILE__)
    const auto r = __builtin_amdgcn_permlane32_swap(__builtin_bit_cast(unsigned, v), __builtin_bit_cast(unsigned, v), false, false);
    return __builtin_bit_cast(float, hi ? r[0] : r[1]);
#else
    (void)hi; return v;
#endif
}
__device__ __forceinline__ float reduce8(const float (&p)[8], int lane) {
    float q4[4], q2[2];
    const bool b5 = lane & 32, b4 = lane & 16, b3 = lane & 8;
#pragma unroll
    for (int i = 0; i < 4; ++i) { const float send = b5 ? p[i] : p[i + 4], keep = b5 ? p[i + 4] : p[i]; q4[i] = keep + xor32_(send, b5); }
#pragma unroll
    for (int i = 0; i < 2; ++i) { const float send = b4 ? q4[i] : q4[i + 2], keep = b4 ? q4[i + 2] : q4[i]; q2[i] = keep + SWZ_(send, 0x401F); }
    const float send = b3 ? q2[0] : q2[1], keep = b3 ? q2[1] : q2[0];
    float q1 = keep + SWZ_(send, 0x201F);
    q1 += DPP_(q1, 0xB1); q1 += DPP_(q1, 0x4E); q1 += DPP_(q1, 0x141);
    return q1;
}
__device__ __forceinline__ void phase_udots(const DArgs& a, LAS unsigned char* lds) {
    const int tid = tid_(), lane = tid & 63, wave = __builtin_amdgcn_readfirstlane(tid >> 6);
    GAS unsigned char* ws = a.ws;
    volatile LAS unsigned* bst = (volatile LAS unsigned*)(lds + LDS_BARST);
    const int nloc = (int)bst[0], nx = (int)bst[1], rank = (int)bst[2];
    unsigned* bar = (unsigned*)(ws + WS_CTL) + CW_BAR;
    const unsigned myx = xb_xcc_id();
    int q = 0;
    for (unsigned j = 0; j < 16; ++j) { const unsigned c = xb_ld(&bar[XB_XCNT(j)]); if (c > 0u && j < myx) ++q; }
    LAS int* LE = (LAS int*)(lds + wave * 2048);
    LAS int* LP = LE + 128; LAS float* LG = (LAS float*)(LE + 256);
    const GAS unsigned char* UB = ws + WS_UB;
    const int g8 = lane >> 3;
    const float usc = ((const GAS float*)(ws + WS_USC))[0], vsc = ((const GAS float*)(ws + WS_USC))[1];
    for (int s = q; s < 8; s += nx) {
        int tok = rank * 8 + wave;
        u32x4 xq0 = (u32x4){0u, 0u, 0u, 0u}, xq1 = xq0; u32x2 e2 = (u32x2){0u, 0u}; f32x2 g2 = (f32x2){0.f, 0.f};
#define U_INFO(t_) do { xq0 = *(const u32x4*)((const GAS bf16_t*)(ws + WS_XN) + (size_t)(t_) * D + lane * 16); xq1 = *(const u32x4*)((const GAS bf16_t*)(ws + WS_XN) + (size_t)(t_) * D + lane * 16 + 8); \
        e2 = *(const u32x2*)((const GAS int*)(ws + WS_EIDX) + (size_t)(t_) * 128 + 2 * lane); g2 = *(const f32x2*)((const GAS float*)(ws + WS_GATE) + (size_t)(t_) * 128 + 2 * lane); } while (0)
        if (tok < T) U_INFO(tok);
        for (; tok < T; tok += nloc * 8) {
            const bool in0 = (int)(e2.x >> 11) == s, in1 = (int)(e2.y >> 11) == s;
            const unsigned long long m0 = __ballot(in0), m1 = __ballot(in1);
            const unsigned long long lt = (1ull << lane) - 1ull;
            const int n0 = __popcll(m0), n = n0 + __popcll(m1);
            if (in0) { const int pos = __popcll(m0 & lt); LE[pos] = (int)e2.x; LP[pos] = 2 * lane; LG[pos] = g2[0]; }
            if (in1) { const int pos = n0 + __popcll(m1 & lt); LE[pos] = (int)e2.y; LP[pos] = 2 * lane + 1; LG[pos] = g2[1]; }
            const float xf[16] = {bf_lo(xq0.x), bf_hi(xq0.x), bf_lo(xq0.y), bf_hi(xq0.y), bf_lo(xq0.z), bf_hi(xq0.z), bf_lo(xq0.w), bf_hi(xq0.w),
                                  bf_lo(xq1.x), bf_hi(xq1.x), bf_lo(xq1.y), bf_hi(xq1.y), bf_lo(xq1.z), bf_hi(xq1.z), bf_lo(xq1.w), bf_hi(xq1.w)};
            asm volatile("s_waitcnt lgkmcnt(0)" ::: "memory");
            u32x4 R0[8], R1[8], R2[8];
#define U_ISSUE(R_, g0_) do { _Pragma("unroll") for (int k = 0; k < 8; ++k) { const int slot_ = ((g0_) + k < n) ? (g0_) + k : n - 1; const int e_ = LE[slot_]; R_[k] = *(const u32x4*)(UB + (size_t)e_ * 1024 + lane * 16); } } while (0)
#define U_DOTS(R_, g0_) do { float pp_[8]; _Pragma("unroll") for (int k = 0; k < 8; ++k) pp_[k] = dot16_fp8(R_[k], xf); const float dsum_ = reduce8(pp_, lane); const int slot_ = (g0_) + g8; \
            if (slot_ < n && (lane & 7) == 0) { const float d_ = dsum_ * usc; \
                ((GAS float*)(ws + WS_PW))[(size_t)tok * 128 + LP[slot_]] = 0.5f * d_ * (1.0f + erff(d_ * 0.70710678118654752f)) * LG[slot_] * vsc; } } while (0)
            if (n > 0) U_ISSUE(R0, 0);
            if (n > 8) U_ISSUE(R1, 8);
            if (n > 16) U_ISSUE(R2, 16);
            const int tokN = tok + nloc * 8;
            if (tokN < T) U_INFO(tokN);
            if (n > 0) U_DOTS(R0, 0);
            if (n > 8) U_DOTS(R1, 8);
            if (n > 16) U_DOTS(R2, 16);
            for (int g0 = 24; g0 < n; g0 += 8) { U_ISSUE(R0, g0); U_DOTS(R0, g0); }
            asm volatile("s_waitcnt lgkmcnt(0)" ::: "memory");
        }
#undef U_INFO
#undef U_ISSUE
#undef U_DOTS
    }
}

struct XcdSlice { int nloc, nx, rank, q; };
__device__ __forceinline__ XcdSlice xcd_slice_setup(const DArgs& a, LAS unsigned char* lds) {
    volatile LAS unsigned* bst = (volatile LAS unsigned*)(lds + LDS_BARST);
    XcdSlice x; x.nloc = __builtin_amdgcn_readfirstlane((int)bst[0]); x.nx = __builtin_amdgcn_readfirstlane((int)bst[1]); x.rank = __builtin_amdgcn_readfirstlane((int)bst[2]);
    unsigned* bar = (unsigned*)(a.ws + WS_CTL) + CW_BAR; const unsigned myx = xb_xcc_id();
    x.q = 0; for (unsigned j = 0; j < 16; ++j) { const unsigned c = xb_ld(&bar[XB_XCNT(j)]); if (c > 0u && j < myx) ++x.q; }
    x.q = __builtin_amdgcn_readfirstlane(x.q);
    return x;
}
__device__ __forceinline__ void phase_ua(const DArgs& a, LAS unsigned char* lds) {
    const int tid = tid_(), lane = tid & 63, wave = __builtin_amdgcn_readfirstlane(tid >> 6), k = lane >> 3, c = lane & 7;
    GAS unsigned char* ws = a.ws;
    const XcdSlice X = xcd_slice_setup(a, lds);
    const int tstride = X.nloc * 8;
    for (int sl = X.q; sl < 8; sl += X.nx) {
        const GAS unsigned char* UBs = ws + WS_UB + (size_t)sl * 2097152;
        const unsigned coff = (unsigned)c * 16u;
        GAS unsigned char* PU = ws + WS_PARTU + (size_t)sl * T * 256;
        u32x4 ev[4], RA[16], RB[16], xa, xb; float sa, sb;
#define A_TOK(t_) ((t_) < T ? (t_) : T - 1)
#define A_INFO(ev_, t_) do { const int tq_ = A_TOK(t_); _Pragma("unroll") for (int j_ = 0; j_ < 4; ++j_) ev_[j_] = *(const GAS u32x4*)(ws + WS_EIDX + (size_t)tq_ * 512 + (unsigned)(64 * k + 16 * j_)); } while (0)
#define A_ISSUE(R_, x_, s_, ev_, t_) do { const int tq_ = A_TOK(t_); _Pragma("unroll") for (int g_ = 0; g_ < 16; ++g_) R_[g_] = *(const GAS u32x4*)(UBs + (ev_[g_ >> 2][g_ & 3] * 128u + coff)); \
        x_ = *(const GAS u32x4*)(ws + WS_XQ + (size_t)tq_ * 1024 + sl * 128 + coff); s_ = ((const GAS float*)(ws + WS_XQS))[tq_]; } while (0)
#define A_DOTS(R_, x_, s_, t_) do { \
        int ir0_ = 0, ir1_ = 0; \
        _Pragma("unroll") for (int gg_ = 0; gg_ < 4; ++gg_) {           \
            int d_[4]; _Pragma("unroll") for (int q_ = 0; q_ < 4; ++q_) d_[q_] = 0; \
            _Pragma("unroll") for (int j_ = 0; j_ < 4; ++j_) { _Pragma("unroll") for (int q_ = 0; q_ < 4; ++q_) d_[q_] = __builtin_amdgcn_sdot4((int)R_[4 * gg_ + q_][j_], (int)x_[j_], d_[q_], false); } \
            _Pragma("unroll") for (int q_ = 0; q_ < 4; ++q_) d_[q_] += DPPI_(d_[q_], 0xB1); \
            _Pragma("unroll") for (int q_ = 0; q_ < 4; ++q_) d_[q_] += DPPI_(d_[q_], 0x4E); \
            _Pragma("unroll") for (int q_ = 0; q_ < 4; ++q_) d_[q_] += DPPI_(d_[q_], 0x141);          \
            _Pragma("unroll") for (int q_ = 0; q_ < 4; ++q_) { if (c == ((4 * gg_ + q_) >> 1)) { if (q_ & 1) ir1_ = d_[q_]; else ir0_ = d_[q_]; } }          \
            __builtin_amdgcn_sched_barrier(0); } \
        if ((t_) < T) *(GAS unsigned*)(PU + (size_t)(t_) * 256 + (unsigned)(4 * lane)) = pk2((float)ir0_ * s_, (float)ir1_ * s_); } while (0)
        const int n0 = X.rank * 8 + wave;
        A_INFO(ev, n0);
        __builtin_amdgcn_sched_barrier(0);
        A_ISSUE(RA, xa, sa, ev, n0);
        __builtin_amdgcn_sched_barrier(0);
        A_INFO(ev, n0 + tstride);
        __builtin_amdgcn_sched_barrier(0);
#pragma unroll 1
        for (int n = n0; n < T; n += 2 * tstride) {
            A_ISSUE(RB, xb, sb, ev, n + tstride);
            __builtin_amdgcn_sched_barrier(0);
            A_INFO(ev, n + 2 * tstride);
            __builtin_amdgcn_sched_barrier(0);
            A_DOTS(RA, xa, sa, n);
            __builtin_amdgcn_sched_barrier(0);
            A_ISSUE(RA, xa, sa, ev, n + 2 * tstride);
            __builtin_amdgcn_sched_barrier(0);
            A_INFO(ev, n + 3 * tstride);
            __builtin_amdgcn_sched_barrier(0);
            A_DOTS(RB, xb, sb, n + tstride);
            __builtin_amdgcn_sched_barrier(0);
        }
#undef A_TOK
#undef A_INFO
#undef A_ISSUE
#undef A_DOTS
    }
}
__device__ __forceinline__ void phase_ua2(const DArgs& a, int vcu, int G) {
    const int tid = tid_();
    GAS unsigned char* ws = a.ws;
    const float usc = ((const GAS float*)(ws + WS_USC))[0], vsc = ((const GAS float*)(ws + WS_USC))[1];
    const GAS unsigned char* PU = ws + WS_PARTU;
    for (size_t i = (size_t)vcu * NTHR + tid; i < (size_t)T * 128 / 4; i += (size_t)G * NTHR) {
        f32x4 d = (f32x4){0.f, 0.f, 0.f, 0.f};
#pragma unroll
        for (int sl = 0; sl < 8; ++sl) { const u32x2 pv = ((const GAS u32x2*)(PU + (size_t)sl * T * 256))[i]; d[0] += bf_lo(pv.x); d[1] += bf_hi(pv.x); d[2] += bf_lo(pv.y); d[3] += bf_hi(pv.y); }
        const f32x4 gt = ((const GAS f32x4*)(ws + WS_GATE))[i];
        f32x4 w;
#pragma unroll
        for (int e = 0; e < 4; ++e) w[e] = gelu_erf(d[e] * usc) * gt[e] * vsc;
        ((GAS f32x4*)(ws + WS_PW))[i] = w;
    }
}
__device__ __forceinline__ void phase_vb(const DArgs& a, LAS unsigned char* lds) {
    const int tid = tid_(), lane = tid & 63, wave = __builtin_amdgcn_readfirstlane(tid >> 6), k = lane >> 3, c = lane & 7;
    GAS unsigned char* ws = a.ws;
    const XcdSlice X = xcd_slice_setup(a, lds);
    const int tstride = X.nloc * 8;
    const bool bit3 = (lane & 8) != 0;
    for (int sl = X.q; sl < 8; sl += X.nx) {
        const GAS unsigned char* VBs = ws + WS_VB + (size_t)sl * 2097152;
        const unsigned coff = (unsigned)c * 16u;
        const unsigned xoff = (unsigned)(sl * 128 + c * 16 + 2 * k) * 4u;
        u32x4 ev[4], RA[16], RB[16]; f32x4 wa[4], wb[4]; f32x2 xa, xb;
#define B_TOK(t_) ((t_) < T ? (t_) : T - 1)
#define B_INFO(t_) do { const int tq_ = B_TOK(t_); _Pragma("unroll") for (int j_ = 0; j_ < 4; ++j_) ev[j_] = *(const GAS u32x4*)(ws + WS_EIDX + (size_t)tq_ * 512 + (unsigned)(64 * k + 16 * j_)); } while (0)
#define B_ISSUE(R_, w_, x_, t_) do { const int tq_ = B_TOK(t_); _Pragma("unroll") for (int g_ = 0; g_ < 16; ++g_) R_[g_] = *(const GAS u32x4*)(VBs + (ev[g_ >> 2][g_ & 3] * 128u + coff)); \
        _Pragma("unroll") for (int j_ = 0; j_ < 4; ++j_) w_[j_] = *(const GAS f32x4*)(ws + WS_PW + (size_t)tq_ * 512 + (unsigned)(64 * k + 16 * j_)); \
        x_ = *(const GAS f32x2*)((const GAS unsigned char*)a.out + (size_t)tq_ * (D * 4) + xoff); } while (0)
#define B_DOTS(R_, w_, x_, t_) do { \
        f32x2 acc2_[8]; _Pragma("unroll") for (int e_ = 0; e_ < 8; ++e_) acc2_[e_] = (f32x2){0.f, 0.f}; \
        _Pragma("unroll") for (int g_ = 0; g_ < 16; ++g_) { const float wk_ = w_[g_ >> 2][g_ & 3]; const f32x2 wp_ = (f32x2){wk_, wk_}; \
            _Pragma("unroll") for (int jj_ = 0; jj_ < 4; ++jj_) { acc2_[2 * jj_] += wp_ * FP8LO(R_[g_][jj_]); acc2_[2 * jj_ + 1] += wp_ * FP8HI(R_[g_][jj_]); } \
            if (g_ & 1) __builtin_amdgcn_sched_barrier(0); } \
        f32x2 w2_[4], x2_[2], y_; \
        _Pragma("unroll") for (int i_ = 0; i_ < 4; ++i_) { w2_[i_][0] = rs32_(acc2_[i_][0], acc2_[i_ + 4][0]); w2_[i_][1] = rs32_(acc2_[i_][1], acc2_[i_ + 4][1]); } \
        _Pragma("unroll") for (int i_ = 0; i_ < 2; ++i_) { x2_[i_][0] = rs16_(w2_[i_][0], w2_[i_ + 2][0]); x2_[i_][1] = rs16_(w2_[i_][1], w2_[i_ + 2][1]); } \
        y_[0] = rs8_(x2_[0][0], x2_[1][0], bit3) + x_[0]; y_[1] = rs8_(x2_[0][1], x2_[1][1], bit3) + x_[1]; \
        const float ss_ = wave_sum(y_[0] * y_[0] + y_[1] * y_[1], lane); \
        if ((t_) < T) { *(GAS unsigned*)(ws + WS_PARTU + (size_t)(t_) * (D * 2) + (xoff >> 1)) = pk2(y_[0], y_[1]);       \
            if (lane == 0) ((GAS float*)(ws + WS_SS))[(size_t)(t_) * 8 + sl] = ss_; } } while (0)
        const int n0 = X.rank * 8 + wave;
        B_INFO(n0);
        __builtin_amdgcn_sched_barrier(0);
        B_ISSUE(RA, wa, xa, n0);
        __builtin_amdgcn_sched_barrier(0);
        B_INFO(n0 + tstride);
        __builtin_amdgcn_sched_barrier(0);
#pragma unroll 1
        for (int n = n0; n < T; n += 2 * tstride) {
            B_ISSUE(RB, wb, xb, n + tstride);
            __builtin_amdgcn_sched_barrier(0);
            B_INFO(n + 2 * tstride);
            __builtin_amdgcn_sched_barrier(0);
            B_DOTS(RA, wa, xa, n);
            __builtin_amdgcn_sched_barrier(0);
            B_ISSUE(RA, wa, xa, n + 2 * tstride);
            __builtin_amdgcn_sched_barrier(0);
            B_INFO(n + 3 * tstride);
            __builtin_amdgcn_sched_barrier(0);
            B_DOTS(RB, wb, xb, n + tstride);
            __builtin_amdgcn_sched_barrier(0);
        }
#undef B_TOK
#undef B_INFO
#undef B_ISSUE
#undef B_DOTS
    }
}
__device__ __forceinline__ void phase_vc(const DArgs& a, int vcu, int G) {
    const int tid = tid_(), lane = tid & 63, wave = tid >> 6;
    const int gw = vcu * NWAVES + wave, NGW = G * NWAVES;
    GAS unsigned char* ws = a.ws;
    f32x4 gf[4];
#pragma unroll
    for (int j = 0; j < 4; ++j) gf[j] = ((const GAS f32x4*)a.final_g)[64 * j + lane];
    for (int m = gw; m < T; m += NGW) {
        const f32x4 s0 = *(const GAS f32x4*)((const GAS float*)(ws + WS_SS) + (size_t)m * 8), s1 = *(const GAS f32x4*)((const GAS float*)(ws + WS_SS) + (size_t)m * 8 + 4);
        const float rstd = rsqrtf(((s0[0] + s0[1]) + (s0[2] + s0[3]) + (s1[0] + s1[1]) + (s1[2] + s1[3])) * (1.f / D) + EPS);
        const GAS u32x2* xi = (const GAS u32x2*)(ws + WS_PARTU + (size_t)m * (D * 2)) + lane;
        GAS f32x4* o = (GAS f32x4*)(a.out + (size_t)m * D) + lane;
#pragma unroll
        for (int j = 0; j < 4; ++j) { const u32x2 xv = xi[64 * j]; f32x4 v; v[0] = bf_lo(xv.x); v[1] = bf_hi(xv.x); v[2] = bf_lo(xv.y); v[3] = bf_hi(xv.y); o[64 * j] = v * rstd * gf[j]; }
    }
}

__device__ __forceinline__ void phase_final_plain(const DArgs& a, const float* src, int vcu, int G) {
    const int tid = tid_(), lane = tid & 63, wave = tid >> 6;
    const int gw = vcu * NWAVES + wave, NGW = G * NWAVES;
    f32x4 gf[4];
#pragma unroll
    for (int j = 0; j < 4; ++j) gf[j] = ((const f32x4*)a.final_g)[64 * j + lane];
    for (int m = gw; m < T; m += NGW) {
        const f32x4* xr = (const f32x4*)(src + (size_t)m * D) + lane;
        f32x4 v[4]; float s = 0.f;
#pragma unroll
        for (int j = 0; j < 4; ++j) { v[j] = xr[64 * j]; s += (v[j][0] * v[j][0] + v[j][1] * v[j][1]) + (v[j][2] * v[j][2] + v[j][3] * v[j][3]); }
        const float rstd = rsqrtf(wave_sum(s, lane) * (1.f / D) + EPS);
        f32x4* o = (f32x4*)(a.out + (size_t)m * D) + lane;
#pragma unroll
        for (int j = 0; j < 4; ++j) o[64 * j] = v[j] * rstd * gf[j];
    }
}


__device__ __forceinline__ DArgs load_args() {
    DArgs r;
#if defined(__HIP_DEVICE_COMPILE__)
    typedef const DArgs __attribute__((address_space(4))) KArgs;
    KArgs* p = (KArgs*)__builtin_amdgcn_kernarg_segment_ptr();
    asm volatile("" : "+s"(p));
    r.x = p->x; r.norm1_g = p->norm1_g; r.w_in = p->w_in; r.b_in = p->b_in; r.conv_w = p->conv_w; r.conv_b = p->conv_b; r.m_head_g = p->m_head_g; r.lb_table = p->lb_table;
    r.g_head_g = p->g_head_g; r.w_br_m = p->w_br_m; r.w_br_g = p->w_br_g; r.w_out = p->w_out; r.norm2_g = p->norm2_g; r.w_pq = p->w_pq; r.sub_keys = p->sub_keys;
    r.u_emb = p->u_emb; r.v_emb = p->v_emb; r.final_g = p->final_g; r.out = p->out; r.ws = p->ws;
#else
    r = DArgs{};
#endif
    return r;
}
__device__ __forceinline__ EpiPtrs make_ep(const DArgs& a, int round) {
    EpiPtrs ep; ep.biasp = (const GAS float*)(a.ws + WS_BIASP); ep.lb = (const GAS float*)(a.ws + WS_LB); ep.x = a.x; ep.out = a.out; ep.ws = a.ws; ep.round = round; return ep;
}
#define GRID_SYNC() do { const DArgs a_ = load_args(); xcd_barrier((unsigned*)(a_.ws + WS_CTL) + CW_BAR, (volatile LAS unsigned*)(lds + LDS_BARST)); } while (0)

__device__ __forceinline__ int bx_() { int t = blockIdx.x; asm volatile("" : "+s"(t)); return t; }
__device__ __forceinline__ int gd_() { int t = gridDim.x; asm volatile("" : "+s"(t)); return t; }
#define PH_BEGIN const DArgs a = load_args(); const int bx = bx_(), G = gd_(); const int vcu = (G % 8 == 0) ? (bx % 8) * (G / 8) + bx / 8 : bx; (void)vcu; (void)bx;

__global__ void __launch_bounds__(NTHR, 2) fwd_megakernel(Args a_unused) {
    extern __shared__ __attribute__((aligned(16))) unsigned char lds_raw[];
    LAS unsigned char* lds = (LAS unsigned char*)lds_raw;
    cg::grid_group grid = cg::this_grid();

    { const int t_ = tid_(); if (t_ < 16) ((LAS unsigned*)(lds + LDS_BARST))[t_] = 0u; __syncthreads();
      const DArgs a_ = load_args(); xcd_barrier_post((unsigned*)(a_.ws + WS_CTL) + CW_BAR, (volatile LAS unsigned*)(lds + LDS_BARST)); }
    { PH_BEGIN phase_p0(a, lds, vcu, G); }
    grid.sync();
#pragma unroll 1
    for (int round = 0; round < NROUND; ++round) {
        {
            PH_BEGIN
            pg8::Gemm g{(const bf16_t*)(a.ws + WS_XN) + (size_t)round * RT * D, (const bf16_t*)(a.ws + WS_WIN), RT, N1, D};
            pg8::StaticOrder S; S.init(RT, N1, G, bx);
            EpiX<1> E{make_ep(a, round)};
            pg8::gemm_phase<EpiX<1>, pg8::StaticOrder, true, true>(lds, g, S, E);
        }
        { PH_BEGIN if (bx < 8) mscan_pair(a, lds, round, bx); }
        GRID_SYNC();
        { PH_BEGIN for (int it = bx; it < 512; it += G) mlstm_pre_item(a, lds, round, it); }
        { PH_BEGIN u32x4 gq[4]; int it = bx; if (it < 2048) hgrn_pre_load(a, round, it, gq);
          for (; it < 2048; it += G) hgrn_pre_item(a, lds, round, it, gq, it + G); }
        GRID_SYNC();
        { PH_BEGIN
          if (bx < 128) mlstm_scan<2, false>(a, lds, round, bx & 7, bx >> 3);
          else if (bx >= 192 && bx < 200) mlstm_scan<1, true>(a, lds, round, bx - 192, 0);
          else if (bx < 192) { const int id2 = bx - 128; hgrn_scan(a, lds, round, (id2 & 7) * 2 + ((id2 >> 3) & 1), id2 >> 4); } }
        GRID_SYNC();
        {
            PH_BEGIN
            pg8::Gemm g{(const bf16_t*)(a.ws + WS_XN) + (size_t)round * RT * D, (const bf16_t*)(a.ws + WS_WIN) + (size_t)N1 * D, RT, N2, D};
            pg8::StaticOrder S; S.init(RT, N2, G, bx);
            EpiX<2> E{make_ep(a, round)};
            pg8::gemm_phase<EpiX<2>, pg8::StaticOrder, true, true>(lds, g, S, E);
        }
        GRID_SYNC();
        { PH_BEGIN phase_ypass(a, round, vcu, G); }
        GRID_SYNC();
        {
            { PH_BEGIN pg8::StaticOrder S; S.init(RT, D, G, bx);
              pg8::Gemm g{(const bf16_t*)(a.ws + WS_V), (const bf16_t*)(a.ws + WS_WM), RT, D, 2048}; EpiX<3> E{make_ep(a, round)}; pg8::gemm_phase<EpiX<3>, pg8::StaticOrder, true, true>(lds, g, S, E); }
            { PH_BEGIN pg8::StaticOrder S; S.init(RT, D, G, bx);
              pg8::Gemm g{(const bf16_t*)(a.ws + WS_GI), (const bf16_t*)(a.ws + WS_WG), RT, D, D}; EpiX<4> E{make_ep(a, round)}; pg8::gemm_phase<EpiX<4>, pg8::StaticOrder, true, true>(lds, g, S, E); }
        }
        GRID_SYNC();
        {
            PH_BEGIN pg8::StaticOrder S; S.init(RT, D, G, bx);
            pg8::Gemm g{(const bf16_t*)(a.ws + WS_GFLOG), (const bf16_t*)(a.ws + WS_WO), RT, D, D}; EpiX<5> E{make_ep(a, round)}; pg8::gemm_phase<EpiX<5>, pg8::StaticOrder, true, true>(lds, g, S, E);
        }
        GRID_SYNC();
    }
    { PH_BEGIN phase_p8(a, vcu, G); }
    GRID_SYNC();
    {
        PH_BEGIN pg8::StaticOrder S; S.init(T, 2048, G, bx);
        pg8::Gemm g{(const bf16_t*)(a.ws + WS_XN), (const bf16_t*)(a.ws + WS_WPQ), T, 2048, D}; EpiX<6> E{make_ep(a, 0)}; pg8::gemm_phase<EpiX<6>, pg8::StaticOrder, true, true>(lds, g, S, E);
    }
    GRID_SYNC();
#ifdef TOPK_REF
    { PH_BEGIN phase_topk_ref(a, vcu, G); }
#else
    { PH_BEGIN phase_topk(a, lds, bx, G); }
#endif
    GRID_SYNC();
    { PH_BEGIN phase_ua(a, lds); }
    GRID_SYNC();
    { PH_BEGIN phase_ua2(a, vcu, G); }
    GRID_SYNC();
    { PH_BEGIN phase_vb(a, lds); }
    GRID_SYNC();
    { PH_BEGIN phase_vc(a, vcu, G); }
}

extern "C" void kernel_launch(void* const* d_in, const int* in_sizes, int n_in, void* d_out, int out_size, void* d_ws, size_t ws_size, hipStream_t stream) {
    static int grid = 0;
    if (grid == 0) {
        if (n_in != 18 || in_sizes[0] != T * D || out_size != T * D || ws_size < WS_END) {
            fprintf(stderr, "kernel_launch: unexpected shapes/workspace (n_in %d, in0 %d, out %d, ws %zu, need %zu)\n", n_in, n_in > 0 ? in_sizes[0] : -1, out_size, ws_size, (size_t)WS_END);
            grid = -1; return; }
        int dev = 0, cus = 0, per_cu = 0;
        hipGetDevice(&dev);
        hipDeviceGetAttribute(&cus, hipDeviceAttributeMultiprocessorCount, dev);
        hipFuncSetAttribute((const void*)fwd_megakernel, hipFuncAttributeMaxDynamicSharedMemorySize, LDS_BYTES);
        hipOccupancyMaxActiveBlocksPerMultiprocessor(&per_cu, (const void*)fwd_megakernel, NTHR, LDS_BYTES);
        if (per_cu < 1) { fprintf(stderr, "kernel_launch: occupancy query says %d blocks/CU\n", per_cu); per_cu = 1; }
        grid = cus;
        (void)hipGetLastError();
    }
    if (grid < 0) return;
    hipMemsetAsync((char*)d_ws + WS_CTL, 0, 1 * MiB, stream);
    Args a{};
    a.x = (const float*)d_in[0]; a.norm1_g = (const float*)d_in[1]; a.w_in = (const float*)d_in[2]; a.b_in = (const float*)d_in[3];
    a.conv_w = (const float*)d_in[4]; a.conv_b = (const float*)d_in[5]; a.m_head_g = (const float*)d_in[6]; a.lb_table = (const float*)d_in[7];
    a.g_head_g = (const float*)d_in[8]; a.w_br_m = (const float*)d_in[9]; a.w_br_g = (const float*)d_in[10]; a.w_out = (const float*)d_in[11];
    a.norm2_g = (const float*)d_in[12]; a.w_pq = (const float*)d_in[13]; a.sub_keys = (const float*)d_in[14]; a.u_emb = (const float*)d_in[15];
    a.v_emb = (const float*)d_in[16]; a.final_g = (const float*)d_in[17];
    a.out = (float*)d_out; a.ws = (unsigned char*)d_ws;
    void* args[] = {&a};
    hipError_t e = hipLaunchCooperativeKernel((const void*)fwd_megakernel, dim3(grid), dim3(NTHR), args, LDS_BYTES, stream);
    if (e != hipSuccess) fprintf(stderr, "cooperative launch failed: %s (grid %d)\n", hipGetErrorString(e), grid);
}
```

```cpp
#include <hip/hip_runtime.h>
#include <hip/hip_cooperative_groups.h>
#include <cstdio>
#include <cstdint>
namespace cg = cooperative_groups;

#define LAS __attribute__((address_space(3)))
typedef unsigned short bf16_t;
typedef short bf16x8 __attribute__((ext_vector_type(8)));
typedef float f32x4 __attribute__((ext_vector_type(4)));
typedef float f32x2 __attribute__((ext_vector_type(2)));
typedef unsigned u32x4 __attribute__((ext_vector_type(4)));
typedef unsigned u32x2 __attribute__((ext_vector_type(2)));

constexpr int D = 1024, BATCH = 4, SEQ = 8192, T = BATCH * SEQ;
constexpr int IN_COLS = 12296, NP = 12288;
constexpr int RT = 16384, NROUND = 2;
constexpr int N1 = 7168, N2 = 5120;
constexpr float EPS = 1e-6f;
constexpr int NWAVES = 8, NTHR = 512;

constexpr size_t MiB = 1u << 20;
constexpr size_t WS_CTL = 0;
constexpr size_t WS_WIN = 1 * MiB;
constexpr size_t WS_WM = 25 * MiB;
constexpr size_t WS_WG = 29 * MiB;
constexpr size_t WS_WO = 31 * MiB;
constexpr size_t WS_WPQ = 33 * MiB;
constexpr size_t WS_SK = 37 * MiB;
constexpr size_t WS_BIASP = 37 * MiB + 512 * 1024;
constexpr size_t WS_LB = WS_BIASP + 64 * 1024;
constexpr size_t WS_GATES = 38 * MiB;
constexpr size_t WS_MPREV = 39 * MiB;
constexpr size_t WS_DEN = 40 * MiB;
constexpr size_t WS_MT = 40 * MiB + 512 * 1024;
constexpr size_t WS_HGDEC = 41 * MiB;
constexpr size_t WS_MDEC = 43 * MiB;
constexpr size_t WS_XN = 44 * MiB;
constexpr size_t WS_QKPRE = 108 * MiB;
constexpr size_t WS_V = 172 * MiB;
constexpr size_t WS_GFLOG = 236 * MiB;
constexpr size_t WS_GI = 268 * MiB;
constexpr size_t WS_GQ = 300 * MiB;
constexpr size_t WS_S = 332 * MiB;
constexpr size_t WS_QT = 348 * MiB;
constexpr size_t WS_KWT = 380 * MiB;
constexpr size_t WS_ATT = 412 * MiB;
constexpr size_t WS_QTG = 428 * MiB;
constexpr size_t WS_KENDT = 460 * MiB;
constexpr size_t WS_SIGO = 332 * MiB;
constexpr size_t WS_SGG = 396 * MiB;
constexpr size_t WS_SAM = 428 * MiB;
constexpr size_t WS_SAG = 460 * MiB;
constexpr size_t WS_END = 492 * MiB;
constexpr size_t WS_QP = 108 * MiB;
constexpr size_t WS_UB = 236 * MiB;
constexpr size_t WS_VB = 252 * MiB;
constexpr size_t WS_USC = 268 * MiB;
constexpr size_t WS_VSC = 268 * MiB + 65536;
constexpr size_t WS_EIDX = 300 * MiB;
constexpr size_t WS_GATE = 316 * MiB;
constexpr size_t WS_XQ = 380 * MiB;
constexpr size_t WS_XQS = 412 * MiB;
constexpr size_t WS_PARTU = 108 * MiB;
constexpr size_t WS_SS = 348 * MiB;
constexpr size_t WS_PW = 332 * MiB;

constexpr int CW_TMAX = 64;
constexpr int LDS_BYTES = 147456;

__device__ __forceinline__ unsigned f2bf(float f) { unsigned u = __builtin_bit_cast(unsigned, f); return (u + 0x7fffu + ((u >> 16) & 1u)) >> 16; }
typedef __bf16 bf16x2_t __attribute__((ext_vector_type(2)));
__device__ __forceinline__ unsigned pk2(float lo, float hi) { bf16x2_t v; v[0] = (__bf16)lo; v[1] = (__bf16)hi; return __builtin_bit_cast(unsigned, v); }
__device__ __forceinline__ float bf_lo(unsigned w) { return __builtin_bit_cast(float, w << 16); }
__device__ __forceinline__ float bf_hi(unsigned w) { return __builtin_bit_cast(float, w & 0xffff0000u); }
__device__ __forceinline__ float bf2f(bf16_t h) { return __builtin_bit_cast(float, ((unsigned)h) << 16); }
__device__ __forceinline__ float shx(float v, int o, int lane) { return __builtin_bit_cast(float, __builtin_amdgcn_ds_bpermute((lane ^ o) << 2, __builtin_bit_cast(int, v))); }
__device__ __forceinline__ float shup(float v, int o, int lane) { return __builtin_bit_cast(float, __builtin_amdgcn_ds_bpermute(((lane - o) & 63) << 2, __builtin_bit_cast(int, v))); }
__device__ __forceinline__ float rdlane(float v, int l) { return __builtin_bit_cast(float, __builtin_amdgcn_readlane(__builtin_bit_cast(int, v), l)); }
#define DPP_(v, ctrl) __builtin_bit_cast(float, __builtin_amdgcn_update_dpp(0, __builtin_bit_cast(int, (v)), (ctrl), 0xF, 0xF, false))
__device__ __forceinline__ float wave_sum(float v, int lane) {
    (void)lane;
    v += DPP_(v, 0xB1); v += DPP_(v, 0x4E); v += DPP_(v, 0x141); v += DPP_(v, 0x140);
    return (rdlane(v, 0) + rdlane(v, 16)) + (rdlane(v, 32) + rdlane(v, 48));
}
__device__ __forceinline__ float wave_max(float v) {
    v = fmaxf(v, DPP_(v, 0xB1)); v = fmaxf(v, DPP_(v, 0x4E)); v = fmaxf(v, DPP_(v, 0x141)); v = fmaxf(v, DPP_(v, 0x140));
    return fmaxf(fmaxf(rdlane(v, 0), rdlane(v, 16)), fmaxf(rdlane(v, 32), rdlane(v, 48)));
}
__device__ __forceinline__ unsigned pack_i8x4(float a, float b, float c, float d) {
    const int ia = (int)__builtin_rintf(a), ib = (int)__builtin_rintf(b), ic = (int)__builtin_rintf(c), id = (int)__builtin_rintf(d);
    return ((unsigned)ia & 255u) | (((unsigned)ib & 255u) << 8) | (((unsigned)ic & 255u) << 16) | ((unsigned)id << 24);
}
#define SWZI_(v, pat) __builtin_amdgcn_ds_swizzle((int)(v), (pat))
#define DPPI_(v, ctrl) __builtin_amdgcn_update_dpp(0, (int)(v), (ctrl), 0xF, 0xF, false)
__device__ __forceinline__ unsigned xor32u_(unsigned v, bool hi) {
#if defined(__HIP_DEVICE_COMPILE__)
    const auto r = __builtin_amdgcn_permlane32_swap(v, v, false, false);
    return hi ? r[0] : r[1];
#else
    (void)hi; return v;
#endif
}
__device__ __forceinline__ float sigmoidf_(float x) { return __builtin_amdgcn_rcpf(1.0f + __expf(-x)); }
__device__ __forceinline__ float siluf_(float x) { return x * __builtin_amdgcn_rcpf(1.0f + __expf(-x)); }
#define LDS_WAIT() asm volatile("s_waitcnt lgkmcnt(0)" ::: "memory")
__device__ __forceinline__ int tid_() { int t = threadIdx.x; asm volatile("" : "+v"(t)); return t; }

#define GAS __attribute__((address_space(1)))
struct DArgs {
    const GAS float* x; const GAS float* norm1_g; const GAS float* w_in; const GAS float* b_in; const GAS float* conv_w; const GAS float* conv_b;
    const GAS float* m_head_g; const GAS float* lb_table; const GAS float* g_head_g; const GAS float* w_br_m; const GAS float* w_br_g; const GAS float* w_out;
    const GAS float* norm2_g; const GAS float* w_pq; const GAS float* sub_keys; const GAS float* u_emb; const GAS float* v_emb; const GAS float* final_g;
    GAS float* out; GAS unsigned char* ws;
};
struct Args {
    const float* x; const float* norm1_g; const float* w_in; const float* b_in; const float* conv_w; const float* conv_b;
    const float* m_head_g; const float* lb_table; const float* g_head_g; const float* w_br_m; const float* w_br_g; const float* w_out;
    const float* norm2_g; const float* w_pq; const float* sub_keys; const float* u_emb; const float* v_emb; const float* final_g;
    float* out; unsigned char* ws;
};

namespace pg8 {
constexpr int BM = 256, BK = 64, HALF = 128, HTB = HALF * BK * 2, STAGE_BYTES = 8 * HTB, NXCD = 8, WGM = 8;
__host__ __device__ __forceinline__ int lds_byte(int r, int c) { const int st = (r >> 4) * 2 + (c >> 5), rr = r & 15, cc = c & 31, ob = rr * 64 + cc * 2; return st * 1024 + (ob ^ (((ob >> 9) & 1) << 5)); }
__host__ __device__ __forceinline__ void stage_rc(int b, int& R, int& C) { const int st = b / 1024, sb = b % 1024, swz = sb ^ (((sb >> 9) & 1) << 5); R = (st >> 1) * 16 + swz / 64; C = (st & 1) * 32 + (swz % 64) / 2; }
__host__ __device__ __forceinline__ int perm32(int rho) { const int n = rho >> 4, i = rho & 15; return 8 * (i >> 2) + 4 * n + (i & 3); }
struct Unit { int pm, pn; };
struct Gemm { const bf16_t* A; const bf16_t* Bt; int M, N, K; };
struct StaticOrder {
    int nM, nN, nwg, G, c;
    __host__ __device__ void init(int M, int N, int G_, int c_) { nM = M / BM; nN = N / BM; nwg = nM * nN; G = G_; c = c_; }
    __host__ __device__ bool next(int i, Unit& u) const {
        const long L = (long)i * G + c; if (L >= nwg) return false;
        int wgid = (int)L; { const int q = nwg / NXCD, r = nwg % NXCD, xcd = wgid % NXCD, off = wgid / NXCD; wgid = (xcd < r ? xcd * (q + 1) : r * (q + 1) + (xcd - r) * q) + off; }
        const int nig = WGM * nN, gid = wgid / nig, fm = gid * WGM, gsz = (nM - fm) < WGM ? (nM - fm) : WGM;
        u.pm = fm + ((wgid % nig) % gsz); u.pn = (wgid % nig) / gsz; return true;
    }
    __device__ __forceinline__ void a_ready(const Unit&) const {}
    __device__ __forceinline__ void done(const Unit&) const {}
};

template <class Epi, class Sched, bool ALIGN_EPI = false, bool SP2 = false>
__device__ __forceinline__ void gemm_phase(LAS unsigned char* lds, const Gemm g, const Sched& S, const Epi& E) {
    const int tid = tid_(), wid = __builtin_amdgcn_readfirstlane(tid >> 6), lane = tid & 63, wr = wid >> 2, wc = wid & 3, fr = lane & 15, fq = lane >> 4;
    const int K = g.K, nt = K / BK;
    unsigned voffA[2], voffB[2];
#pragma unroll
    for (int i = 0; i < 2; ++i) { int R, C; stage_rc(tid * 16 + i * 8192, R, C); const int Rb = Epi::PERM ? ((R & ~31) + perm32(R & 31)) : R;
        voffA[i] = (unsigned)(R * K + C) * 2u; voffB[i] = (unsigned)(Rb * K + C) * 2u; }
    const size_t kstep = (size_t)(BK * 2);
    const size_t hstep = (size_t)HALF * K * 2;
    const size_t tstep = 2 * hstep;
    const unsigned ldsw = (unsigned)wid * 1024u;
    const int aoff = lds_byte(wr * 64 + fr, fq * 8), boff = lds_byte(wc * 32 + fr, fq * 8);
#define PG8_SA(b, h) (((b) * 2 + (h)) * HTB)
#define PG8_SB(b, h) ((4 + (b) * 2 + (h)) * HTB)
#define PG8_STAGE(bufoff, gbase, voff) do { _Pragma("unroll") for (int _i = 0; _i < 2; ++_i) \
        __builtin_amdgcn_global_load_lds((const unsigned*)((const char*)(gbase) + (voff)[_i]), (LAS unsigned*)(lds + (bufoff) + ldsw + _i * 8192), 16, 0, 0); } while (0)
#define PG8_LDA(dst, b, h) do { _Pragma("unroll") for (int m = 0; m < 4; ++m) _Pragma("unroll") for (int k = 0; k < 2; ++k) dst[m][k] = *(const LAS bf16x8*)(lds + PG8_SA(b, h) + aoff + m * 2048 + k * 1024); } while (0)
#define PG8_LDB(dst, b, h) do { _Pragma("unroll") for (int n = 0; n < 2; ++n) _Pragma("unroll") for (int k = 0; k < 2; ++k) dst[n][k] = *(const LAS bf16x8*)(lds + PG8_SB(b, h) + boff + n * 2048 + k * 1024); } while (0)
#define PG8_MMA(ai, bj, At, Bt) do { __builtin_amdgcn_s_setprio(1); _Pragma("unroll") for (int m = 0; m < 4; ++m) _Pragma("unroll") for (int n = 0; n < 2; ++n) _Pragma("unroll") for (int k = 0; k < 2; ++k) \
        acc[ai][bj][m][n] = __builtin_amdgcn_mfma_f32_16x16x32_bf16(Bt[n][k], At[m][k], acc[ai][bj][m][n], 0, 0, 0); __builtin_amdgcn_s_setprio(0); } while (0)
#define PG8_WAIT_V(n) asm volatile("s_waitcnt vmcnt(" #n ")" ::: "memory")
#define PG8_WAIT_L(n) asm volatile("s_waitcnt lgkmcnt(" #n ")" ::: "memory")
#define PG8_BAR __builtin_amdgcn_s_barrier()
#define PG8_SCHED __builtin_amdgcn_sched_barrier(0)
    Unit cur, nxt; int ui = 0;
    if (!S.next(0, cur)) return;
    f32x4 acc[2][2][4][2];
#pragma unroll
    for (int a = 0; a < 2; ++a)
#pragma unroll
        for (int b = 0; b < 2; ++b)
#pragma unroll
            for (int m = 0; m < 4; ++m)
#pragma unroll
                for (int n = 0; n < 2; ++n) acc[a][b][m][n] = (f32x4){0.f, 0.f, 0.f, 0.f};
    bf16x8 At[4][2], B0[2][2], B1[2][2];
    const char* cA = (const char*)g.A + (size_t)cur.pm * tstep; const char* cB = (const char*)g.Bt + (size_t)cur.pn * tstep;
    S.a_ready(cur);
    if constexpr (SP2) {
        PG8_STAGE(PG8_SB(0, 0), cB, voffB); PG8_STAGE(PG8_SB(0, 1), cB + hstep, voffB); PG8_STAGE(PG8_SA(0, 0), cA, voffA); PG8_STAGE(PG8_SA(0, 1), cA + hstep, voffA);
        if (wr == 1) PG8_BAR;
        PG8_WAIT_V(2); PG8_BAR;
        PG8_STAGE(PG8_SB(1, 0), cB + kstep, voffB); PG8_STAGE(PG8_SA(1, 0), cA + kstep, voffA); PG8_STAGE(PG8_SB(1, 1), cB + hstep + kstep, voffB);
        PG8_WAIT_V(6); PG8_BAR;
    } else {
        PG8_STAGE(PG8_SB(0, 0), cB, voffB); PG8_STAGE(PG8_SA(0, 0), cA, voffA); PG8_STAGE(PG8_SB(0, 1), cB + hstep, voffB); PG8_STAGE(PG8_SA(0, 1), cA + hstep, voffA);
        if (wr == 1) PG8_BAR;
        PG8_WAIT_V(4); PG8_BAR;
        PG8_STAGE(PG8_SB(1, 0), cB + kstep, voffB); PG8_STAGE(PG8_SA(1, 0), cA + kstep, voffA); PG8_STAGE(PG8_SB(1, 1), cB + hstep + kstep, voffB);
        PG8_WAIT_V(6); PG8_BAR;
    }
    for (;;) {
        const bool has_next = S.next(ui + 1, nxt);
        const char* nA = has_next ? (const char*)g.A + (size_t)nxt.pm * tstep : cA; const char* nB = has_next ? (const char*)g.Bt + (size_t)nxt.pn * tstep : cB;
        for (int t = 0; t < nt; t += 2) {
            const bool last = (t == nt - 2);
            const char* a1 = cA + (size_t)(t + 1) * kstep;
            const char* a2 = last ? nA : cA + (size_t)(t + 2) * kstep; const char* b2 = last ? nB : cB + (size_t)(t + 2) * kstep;
            const char* a3 = a2 + kstep; const char* b3 = b2 + kstep;
            if (last && has_next) S.a_ready(nxt);
            if constexpr (SP2) {
            PG8_LDB(B0, 0, 0); PG8_LDB(B1, 0, 1); PG8_SCHED; PG8_LDA(At, 0, 0); PG8_STAGE(PG8_SA(1, 1), a1 + hstep, voffA);
            PG8_WAIT_V(8); PG8_WAIT_L(0); PG8_BAR; PG8_MMA(0, 0, At, B0); PG8_MMA(0, 1, At, B1); PG8_BAR; PG8_SCHED;
            PG8_LDA(At, 0, 1); PG8_STAGE(PG8_SB(0, 0), b2, voffB); PG8_STAGE(PG8_SB(0, 1), b2 + hstep, voffB); PG8_STAGE(PG8_SA(0, 0), a2, voffA);
            PG8_WAIT_V(8); PG8_WAIT_L(0); PG8_BAR; PG8_MMA(1, 0, At, B0); PG8_MMA(1, 1, At, B1); PG8_BAR; PG8_SCHED;
            PG8_LDB(B0, 1, 0); PG8_LDB(B1, 1, 1); PG8_SCHED; PG8_LDA(At, 1, 0); PG8_STAGE(PG8_SA(0, 1), a2 + hstep, voffA);
            PG8_WAIT_V(8); PG8_WAIT_L(0); PG8_BAR; PG8_MMA(0, 0, At, B0); PG8_MMA(0, 1, At, B1); PG8_BAR; PG8_SCHED;
            PG8_LDA(At, 1, 1); PG8_STAGE(PG8_SB(1, 0), b3, voffB); PG8_STAGE(PG8_SB(1, 1), b3 + hstep, voffB); PG8_STAGE(PG8_SA(1, 0), a3, voffA);
            PG8_WAIT_V(8); PG8_WAIT_L(0); PG8_BAR; PG8_MMA(1, 0, At, B0); PG8_MMA(1, 1, At, B1); PG8_BAR; PG8_SCHED;
            } else {
            PG8_LDB(B0, 0, 0); PG8_SCHED; PG8_LDA(At, 0, 0); PG8_STAGE(PG8_SA(1, 1), a1 + hstep, voffA);
            PG8_WAIT_L(8); PG8_BAR; PG8_WAIT_L(0); PG8_MMA(0, 0, At, B0); PG8_BAR; PG8_SCHED;
            PG8_LDB(B1, 0, 1); PG8_STAGE(PG8_SB(0, 0), b2, voffB);
            PG8_BAR; PG8_WAIT_L(0); PG8_MMA(0, 1, At, B1); PG8_BAR;
            PG8_LDA(At, 0, 1); PG8_STAGE(PG8_SA(0, 0), a2, voffA);
            PG8_BAR; PG8_WAIT_L(0); PG8_MMA(1, 0, At, B0); PG8_BAR; PG8_SCHED;
            PG8_STAGE(PG8_SB(0, 1), b2 + hstep, voffB);
            PG8_WAIT_V(6); PG8_BAR; PG8_MMA(1, 1, At, B1); PG8_BAR;
            PG8_LDB(B0, 1, 0); PG8_SCHED; PG8_LDA(At, 1, 0); PG8_STAGE(PG8_SA(0, 1), a2 + hstep, voffA);
            PG8_WAIT_L(8); PG8_BAR; PG8_WAIT_L(0); PG8_MMA(0, 0, At, B0); PG8_BAR; PG8_SCHED;
            PG8_LDB(B1, 1, 1); PG8_STAGE(PG8_SB(1, 0), b3, voffB);
            PG8_BAR; PG8_WAIT_L(0); PG8_MMA(0, 1, At, B1); PG8_BAR;
            PG8_LDA(At, 1, 1); PG8_STAGE(PG8_SA(1, 0), a3, voffA);
            PG8_BAR; PG8_WAIT_L(0); PG8_MMA(1, 0, At, B0); PG8_BAR; PG8_SCHED;
            PG8_STAGE(PG8_SB(1, 1), b3 + hstep, voffB);
            PG8_WAIT_V(6); PG8_BAR; PG8_MMA(1, 1, At, B1); PG8_BAR;
            }
        }
        if constexpr (ALIGN_EPI) { if (wr == 0) PG8_BAR; }
        E(acc, cur, wr, wc, fr, fq);
        if (!has_next) break;
#pragma unroll
        for (int a = 0; a < 2; ++a)
#pragma unroll
            for (int b = 0; b < 2; ++b)
#pragma unroll
                for (int m = 0; m < 4; ++m)
#pragma unroll
                    for (int n = 0; n < 2; ++n) acc[a][b][m][n] = (f32x4){0.f, 0.f, 0.f, 0.f};
        cur = nxt; cA = nA; cB = nB; ++ui;
        if constexpr (ALIGN_EPI) { if (wr == 1) PG8_BAR; }
    }
    PG8_WAIT_V(0);
    if constexpr (!ALIGN_EPI) { if (wr == 0) PG8_BAR; }
    PG8_BAR;
#undef PG8_SA
#undef PG8_SB
#undef PG8_STAGE
#undef PG8_LDA
#undef PG8_LDB
#undef PG8_MMA
#undef PG8_WAIT_V
#undef PG8_WAIT_L
#undef PG8_BAR
#undef PG8_SCHED
}
}

struct EpiPtrs {
    const GAS float* biasp; const GAS float* lb; const GAS float* x; GAS float* out; GAS unsigned char* ws; int round;
};
template <int MODE> struct EpiX {
    static constexpr bool PERM = true, AFTER_DRAIN = false;
    EpiPtrs P;
    __device__ __forceinline__ void operator()(const f32x4 (&acc)[2][2][4][2], const pg8::Unit& u, int wr, int wc, int fr, int fq) const {
        const int row0 = u.pm * 256 + wr * 64 + fr;
        const int colt = u.pn * 256 + wc * 32 + 8 * fq;
        GAS unsigned char* ws = P.ws;
        bf16_t* dst = nullptr; int ld = 0, coff = 0, act = 0; const GAS float* bias = nullptr;
        if (MODE == 1) {
            bias = P.biasp;
            if (u.pn < 8) { dst = (bf16_t*)(ws + WS_QKPRE); ld = 2048; coff = 0; act = 0; }
            else if (u.pn < 16) { dst = (bf16_t*)(ws + WS_V); ld = 2048; coff = 2048; act = 0; }
            else if (u.pn < 20) { dst = (bf16_t*)(ws + WS_GFLOG); ld = 1024; coff = 4096; act = 3; }
            else if (u.pn < 24) { dst = (bf16_t*)(ws + WS_GI); ld = 1024; coff = 5120; act = 0; }
            else { dst = (bf16_t*)(ws + WS_GQ); ld = 1024; coff = 6144; act = 2; }
        } else if (MODE == 2) {
            bias = P.biasp + N1;
            if (u.pn < 8) { dst = (bf16_t*)(ws + WS_SIGO); ld = 2048; coff = 0; act = 1; }
            else if (u.pn < 12) { dst = (bf16_t*)(ws + WS_SGG); ld = 1024; coff = 2048; act = 2; }
            else if (u.pn < 16) { dst = (bf16_t*)(ws + WS_SAM); ld = 1024; coff = 3072; act = 1; }
            else { dst = (bf16_t*)(ws + WS_SAG); ld = 1024; coff = 4096; act = 1; }
        } else if (MODE == 6) { dst = (bf16_t*)(ws + WS_QP); ld = 2048; coff = 0; act = 0; }
#pragma unroll
        for (int bj = 0; bj < 2; ++bj) {
            const int col = colt + bj * 128;
            f32x4 b0 = (f32x4){0.f, 0.f, 0.f, 0.f}, b1 = b0, l0 = b0, l1 = b0;
            if (MODE == 1 || MODE == 2) { b0 = *(const f32x4*)(bias + col); b1 = *(const f32x4*)(bias + col + 4); }
            if (MODE == 1) { if (act == 3) { l0 = *(const f32x4*)(P.lb + (col - coff)); l1 = *(const f32x4*)(P.lb + (col - coff) + 4); } }
#pragma unroll
            for (int ai = 0; ai < 2; ++ai)
#pragma unroll
                for (int m = 0; m < 4; ++m) {
                    const int row = row0 + ai * 128 + m * 16;
                    f32x4 v0 = acc[ai][bj][m][0] + b0, v1 = acc[ai][bj][m][1] + b1;
                    if (MODE == 1 || MODE == 2 || MODE == 6) {
                        if (act == 1) {
#pragma unroll
                            for (int j = 0; j < 4; ++j) { v0[j] = sigmoidf_(v0[j]); v1[j] = sigmoidf_(v1[j]); }
                        } else if (act == 2) {
#pragma unroll
                            for (int j = 0; j < 4; ++j) { v0[j] = siluf_(v0[j]); v1[j] = siluf_(v1[j]); }
                        } else if (act == 3) {
#pragma unroll
                            for (int j = 0; j < 4; ++j) { v0[j] = __logf(l0[j] + (1.0f - l0[j]) * sigmoidf_(v0[j])); v1[j] = __logf(l1[j] + (1.0f - l1[j]) * sigmoidf_(v1[j])); }
                        }
                        u32x4 w; w.x = pk2(v0[0], v0[1]); w.y = pk2(v0[2], v0[3]); w.z = pk2(v1[0], v1[1]); w.w = pk2(v1[2], v1[3]);
                        *(u32x4*)(dst + (size_t)row * ld + (col - coff)) = w;
                    } else if (MODE == 3) {
                        const u32x4 g = *(const u32x4*)((const bf16_t*)(ws + WS_SAM) + (size_t)row * 1024 + col);
                        GAS bf16_t* o = (GAS bf16_t*)P.out + (size_t)T * 1024 + ((size_t)P.round * RT + row) * 1024 + col;
                        f32x4 r0, r1;
                        r0[0] = v0[0] * bf_lo(g.x); r0[1] = v0[1] * bf_hi(g.x); r0[2] = v0[2] * bf_lo(g.y); r0[3] = v0[3] * bf_hi(g.y);
                        r1[0] = v1[0] * bf_lo(g.z); r1[1] = v1[1] * bf_hi(g.z); r1[2] = v1[2] * bf_lo(g.w); r1[3] = v1[3] * bf_hi(g.w);
                        u32x4 w; w.x = pk2(r0[0], r0[1]); w.y = pk2(r0[2], r0[3]); w.z = pk2(r1[0], r1[1]); w.w = pk2(r1[2], r1[3]);
                        *(GAS u32x4*)o = w;
                    } else if (MODE == 4) {
                        const u32x4 g = *(const u32x4*)((const bf16_t*)(ws + WS_SAG) + (size_t)row * 1024 + col);
                        const u32x4 zv = *(const GAS u32x4*)((const GAS bf16_t*)P.out + (size_t)T * 1024 + ((size_t)P.round * RT + row) * 1024 + col);
                        const f32x4 p0 = (f32x4){bf_lo(zv.x), bf_hi(zv.x), bf_lo(zv.y), bf_hi(zv.y)}, p1 = (f32x4){bf_lo(zv.z), bf_hi(zv.z), bf_lo(zv.w), bf_hi(zv.w)};
                        f32x4 r0, r1;
                        r0[0] = p0[0] + v0[0] * bf_lo(g.x); r0[1] = p0[1] + v0[1] * bf_hi(g.x); r0[2] = p0[2] + v0[2] * bf_lo(g.y); r0[3] = p0[3] + v0[3] * bf_hi(g.y);
                        r1[0] = p1[0] + v1[0] * bf_lo(g.z); r1[1] = p1[1] + v1[1] * bf_hi(g.z); r1[2] = p1[2] + v1[2] * bf_lo(g.w); r1[3] = p1[3] + v1[3] * bf_hi(g.w);
                        u32x4 w; w.x = pk2(r0[0], r0[1]); w.y = pk2(r0[2], r0[3]); w.z = pk2(r1[0], r1[1]); w.w = pk2(r1[2], r1[3]);
                        *(u32x4*)((bf16_t*)(ws + WS_GFLOG) + (size_t)row * 1024 + col) = w;
                    } else if (MODE == 5) {
                        const size_t off = ((size_t)P.round * RT + row) * 1024 + col;
                        const f32x4 x0 = *(const f32x4*)(P.x + off) + v0, x1 = *(const f32x4*)(P.x + off + 4) + v1;
                        u32x4 w; w.x = pk2(x0[0], x0[1]); w.y = pk2(x0[2], x0[3]); w.z = pk2(x1[0], x1[1]); w.w = pk2(x1[2], x1[3]);
                        *(GAS u32x4*)((GAS bf16_t*)P.out + off) = w;
                    }
                }
        }
    }
};

__device__ __forceinline__ void p0_transpose_item(const GAS float* W, int ldw, int K, int k0, int scol, GAS bf16_t* WT, int drow, LAS float* scr, int lane) {
#pragma unroll 8
    for (int i = 0; i < 32; ++i) { const int kk = 2 * i + (lane >> 5); scr[kk * 33 + (lane & 31)] = W[(size_t)(k0 + kk) * ldw + scol + (lane & 31)]; }
    LDS_WAIT(); asm volatile("" ::: "memory");
    const int c = lane & 7;
#pragma unroll
    for (int j = 0; j < 4; ++j) { const int n = (lane >> 3) + 8 * j; const LAS float* s = scr + (8 * c) * 33 + n;
        u32x4 o; o.x = pk2(s[0 * 33], s[1 * 33]); o.y = pk2(s[2 * 33], s[3 * 33]); o.z = pk2(s[4 * 33], s[5 * 33]); o.w = pk2(s[6 * 33], s[7 * 33]);
        *(u32x4*)(WT + (size_t)(drow + n) * K + k0 + 8 * c) = o; }
    LDS_WAIT(); asm volatile("" ::: "memory");
}
__device__ __forceinline__ int win_src_col(int n) {
    if (n < 4096) return n;
    if (n < 7168) return n - 4096 + 6152;
    if (n < 9216) return n - 7168 + 4096;
    return n - 9216 + 9224;
}

__device__ __forceinline__ void phase_p0(const DArgs& a, LAS unsigned char* lds, int vcu, int G) {
    const int tid = tid_(), lane = tid & 63, wave = tid >> 6;
    const int gw = vcu * NWAVES + wave, NGW = G * NWAVES;
    GAS unsigned char* ws = a.ws;
    LAS float* scr = (LAS float*)(lds + wave * 16384);
    constexpr int I_IN = 16 * 384, I_M = 32 * 32, I_G = 16 * 32, I_O = 16 * 32, I_PQ = 16 * 64;
    constexpr int NITEMS = I_IN + I_M + I_G + I_O + I_PQ;
    for (int it = gw; it < NITEMS; it += NGW) {
        int r = it;
        if (r < I_IN) { const int kb = r / 384, nb = r % 384; p0_transpose_item(a.w_in, IN_COLS, 1024, kb * 64, win_src_col(nb * 32), (GAS bf16_t*)(ws + WS_WIN), nb * 32, scr, lane); continue; } r -= I_IN;
        if (r < I_M) { const int kb = r / 32, nb = r % 32; p0_transpose_item(a.w_br_m, 1024, 2048, kb * 64, nb * 32, (GAS bf16_t*)(ws + WS_WM), nb * 32, scr, lane); continue; } r -= I_M;
        if (r < I_G) { const int kb = r / 32, nb = r % 32; p0_transpose_item(a.w_br_g, 1024, 1024, kb * 64, nb * 32, (GAS bf16_t*)(ws + WS_WG), nb * 32, scr, lane); continue; } r -= I_G;
        if (r < I_O) { const int kb = r / 32, nb = r % 32; p0_transpose_item(a.w_out, 1024, 1024, kb * 64, nb * 32, (GAS bf16_t*)(ws + WS_WO), nb * 32, scr, lane); continue; } r -= I_O;
        { const int kb = r / 64, nb = r % 64; p0_transpose_item(a.w_pq, 2048, 1024, kb * 64, nb * 32, (GAS bf16_t*)(ws + WS_WPQ), nb * 32, scr, lane); }
    }
    const int gt = vcu * NTHR + tid, NGT = G * NTHR;
    for (int i = gt; i < NP; i += NGT) ((float*)(ws + WS_BIASP))[i] = a.b_in[win_src_col(i)];
    for (int i = gt; i < 1024; i += NGT) { const float t0 = a.lb_table[i], t1 = a.lb_table[1024 + i]; ((float*)(ws + WS_LB))[i] = 1.0f / (1.0f + __expf(t1 - t0)); }
    for (int i = gt; i < 8 * 2 * 128 * 128 / 4; i += NGT) { const f32x4 v = ((const f32x4*)a.sub_keys)[i]; u32x2 o; o.x = pk2(v[0], v[1]); o.y = pk2(v[2], v[3]); ((u32x2*)(ws + WS_SK))[i] = o; }
    f32x4 g1[4];
#pragma unroll
    for (int j = 0; j < 4; ++j) g1[j] = ((const GAS f32x4*)a.norm1_g)[64 * j + lane];
    f32x4 gw0[16], gw1[16];
#pragma unroll
    for (int j = 0; j < 4; ++j)
#pragma unroll
        for (int e = 0; e < 4; ++e) { const int k = 256 * j + 4 * lane + e; gw0[4 * j + e] = *(const GAS f32x4*)(a.w_in + (size_t)k * IN_COLS + 6144); gw1[4 * j + e] = *(const GAS f32x4*)(a.w_in + (size_t)k * IN_COLS + 6148); }
    const float gbias = lane < 8 ? a.b_in[6144 + lane] : 0.f;
    for (int m = gw; m < T; m += NGW) {
        const GAS f32x4* xr = (const GAS f32x4*)(a.x + (size_t)m * D) + lane;
        f32x4 v[4]; float s = 0.f;
#pragma unroll
        for (int j = 0; j < 4; ++j) { v[j] = xr[64 * j]; s += (v[j][0] * v[j][0] + v[j][1] * v[j][1]) + (v[j][2] * v[j][2] + v[j][3] * v[j][3]); }
        const float rstd = rsqrtf(wave_sum(s, lane) * (1.f / D) + EPS);
        GAS unsigned long long* o8 = (GAS unsigned long long*)((GAS bf16_t*)(ws + WS_XN) + (size_t)m * D) + lane;
        f32x4 ga0 = (f32x4){0.f, 0.f, 0.f, 0.f}, ga1 = ga0;
#pragma unroll
        for (int j = 0; j < 4; ++j) {
            v[j] = v[j] * rstd * g1[j];
            o8[64 * j] = (unsigned long long)pk2(v[j][0], v[j][1]) | ((unsigned long long)pk2(v[j][2], v[j][3]) << 32);
#pragma unroll
            for (int e = 0; e < 4; ++e) { ga0 += gw0[4 * j + e] * v[j][e]; ga1 += gw1[4 * j + e] * v[j][e]; }
        }
        float ga[8] = {ga0[0], ga0[1], ga0[2], ga0[3], ga1[0], ga1[1], ga1[2], ga1[3]};
#pragma unroll
        for (int q = 0; q < 8; ++q) ga[q] = wave_sum(ga[q], lane);
        if (lane < 8) { float r = ga[0];
#pragma unroll
            for (int q = 1; q < 8; ++q) r = (lane == q) ? ga[q] : r;
            ((GAS float*)(ws + WS_GATES))[(size_t)m * 8 + lane] = r + gbias; }
    }
}

__device__ __forceinline__ float logsigf_(float x) { return fminf(x, 0.f) - log1pf(__expf(-fabsf(x))); }
#define LDS_BAR() do { asm volatile("s_waitcnt lgkmcnt(0)" ::: "memory"); __builtin_amdgcn_s_barrier(); asm volatile("" ::: "memory"); } while (0)
#define MFMA16(a, b, c) __builtin_amdgcn_mfma_f32_16x16x32_bf16((a), (b), (c), 0, 0, 0)
__device__ __forceinline__ bf16x8 lfrag(const LAS unsigned char* base, int pitch, int row, int k0, int fq) { return *(const LAS bf16x8*)(base + row * pitch + (k0 + 8 * fq) * 2); }
__device__ __forceinline__ int fm_off(int r, int k, int KB) { return (((r >> 4) * KB + (k >> 5)) << 10) + (((((k >> 3) & 3) << 4) + (r & 15)) << 4) + ((k & 7) << 1); }
__device__ __forceinline__ bf16x8 gfrag(const bf16_t* base, int ld, int row, int k0, int fq) { return *(const bf16x8*)(base + (size_t)row * ld + k0 + 8 * fq); }

__device__ __forceinline__ void mscan_pair(const DArgs& a, LAS unsigned char* lds, int round, int p) {
    const int tid = tid_(), lane = tid & 63, part = tid >> 6;
    const int bl = p >> 2, h = p & 3, b = round * 2 + bl;
    const GAS float* g = (const GAS float*)(a.ws + WS_GATES) + ((size_t)b * SEQ + (size_t)lane * 128 + part * 16) * 8;
    float bsum = 0.f, gm = -INFINITY;
#pragma unroll 4
    for (int s = 0; s < 16; ++s) { const float ip = g[s * 8 + h], fp = g[s * 8 + 4 + h]; bsum += logsigf_(fp); gm = fmaxf(gm, ip - bsum); }
    LAS float* PS = (LAS float*)lds; LAS float* PM = PS + 512;
    PS[part * 64 + lane] = bsum; PM[part * 64 + lane] = gm;
    __syncthreads();
    if (tid < 64) {
        float bs = 0.f, g2 = -INFINITY;
#pragma unroll
        for (int q = 0; q < 8; ++q) { g2 = fmaxf(g2, PM[q * 64 + lane] - bs); bs += PS[q * 64 + lane]; }
        float mprev = 0.f, mine = 0.f;
        for (int c = 0; c < 64; ++c) {
            const float bc = rdlane(bs, c), gc = rdlane(g2, c);
            if (lane == c) mine = mprev; mprev = bc + fmaxf(mprev, gc); }
        ((GAS float*)(a.ws + WS_MPREV))[(round * 8 + p) * 64 + lane] = mine;
    }
    __syncthreads();
}

constexpr int PQ_PITCH = 528, PS_PITCH = 272;
__device__ __forceinline__ void mlstm_pre_item(const DArgs& a, LAS unsigned char* lds, int round, int item) {
    const int tid = tid_(), lane = tid & 63, wave = __builtin_amdgcn_readfirstlane(tid >> 6), fr = lane & 15, fq = lane >> 4;
    const int p = item >> 6, c = item & 63, bl = p >> 2, h = p & 3, b = round * 2 + bl;
    const int tl0 = bl * SEQ + c * 128; const size_t tg0 = (size_t)b * SEQ + c * 128;
    GAS unsigned char* ws = a.ws;
    LAS unsigned char* QL = lds; LAS unsigned char* KL = lds + 67584;
    LAS float* AS = (LAS float*)(lds + 135168); LAS float* MS = AS + 128; LAS float* SC = AS + 256;
    if (wave == 0) {
        const float mprev = ((const float*)(ws + WS_MPREV))[(round * 8 + p) * 64 + c];
        const float* g = (const float*)(ws + WS_GATES) + (tg0 + 2 * lane) * 8;
        const float ip0 = g[h], fp0 = g[4 + h], ip1 = g[8 + h], fp1 = g[12 + h];
        const float lf0 = logsigf_(fp0), lf1 = logsigf_(fp1), pp = lf0 + lf1;
        float incl = pp;
#pragma unroll
        for (int o = 1; o < 64; o <<= 1) { const float t = shup(incl, o, lane); if (lane >= o) incl += t; }
        const float excl = incl - pp, b0 = excl + lf0, b1 = incl;
        const float a0 = ip0 - b0, a1 = ip1 - b1;
        float inclm = fmaxf(a0, a1);
#pragma unroll
        for (int o = 1; o < 64; o <<= 1) { const float t = shup(inclm, o, lane); if (lane >= o) inclm = fmaxf(inclm, t); }
        float exclm = shup(inclm, 1, lane); if (lane == 0) exclm = -INFINITY;
        const float M0 = fmaxf(mprev, fmaxf(exclm, a0)), M1 = fmaxf(mprev, inclm);
        AS[2 * lane] = a0; AS[2 * lane + 1] = a1; MS[2 * lane] = M0; MS[2 * lane + 1] = M1;
        float* mt = (float*)(ws + WS_MT) + (tg0 + 2 * lane) * 4 + h;
        mt[0] = b0 + M0; mt[4] = b1 + M1;
        const float Mlast = rdlane(M1, 63);
        if (lane == 0) { SC[0] = mprev; SC[1] = Mlast; ((float*)(ws + WS_MDEC))[item] = __expf(mprev - Mlast); }
    }
    {
        const int cgp = tid & 63, strip = tid >> 6;
        const int col = (cgp < 32) ? (h * 256 + cgp * 8) : (1024 + h * 256 + (cgp - 32) * 8);
        float w[4][8], bb[8];
#pragma unroll
        for (int j = 0; j < 4; ++j) { const f32x4 w0 = *(const f32x4*)(a.conv_w + j * 2048 + col), w1 = *(const f32x4*)(a.conv_w + j * 2048 + col + 4);
#pragma unroll
            for (int e = 0; e < 4; ++e) { w[j][e] = w0[e]; w[j][4 + e] = w1[e]; } }
        { const f32x4 b0 = *(const f32x4*)(a.conv_b + col), b1 = *(const f32x4*)(a.conv_b + col + 4);
#pragma unroll
            for (int e = 0; e < 4; ++e) { bb[e] = b0[e]; bb[4 + e] = b1[e]; } }
        const bf16_t* src = (const bf16_t*)(ws + WS_QKPRE) + (size_t)(tl0 + 16 * strip) * 2048 + col;
        const float qs = (cgp < 32) ? 0.0625f : 1.0f;
        LAS unsigned char* dstt = ((cgp < 32) ? QL : KL) + (cgp & 31) * 16;
#pragma unroll 1
        for (int half = 0; half < 2; ++half) {
            u32x4 xr[11];
#pragma unroll
            for (int r = 0; r < 11; ++r) {
                const int sl = c * 128 + 16 * strip + 8 * half + r - 3;
                xr[r] = (sl >= 0) ? *(const u32x4*)(src + (ptrdiff_t)(8 * half + r - 3) * 2048) : (u32x4){0u, 0u, 0u, 0u};
            }
#pragma unroll
            for (int r = 0; r < 8; ++r) {
                float y[8];
#pragma unroll
                for (int e = 0; e < 8; ++e) y[e] = bb[e];
#pragma unroll
                for (int j = 0; j < 4; ++j) { const u32x4 xv = xr[r + j];
                    y[0] += w[j][0] * bf_lo(xv.x); y[1] += w[j][1] * bf_hi(xv.x); y[2] += w[j][2] * bf_lo(xv.y); y[3] += w[j][3] * bf_hi(xv.y);
                    y[4] += w[j][4] * bf_lo(xv.z); y[5] += w[j][5] * bf_hi(xv.z); y[6] += w[j][6] * bf_lo(xv.w); y[7] += w[j][7] * bf_hi(xv.w); }
#pragma unroll
                for (int e = 0; e < 8; ++e) y[e] = siluf_(y[e]) * qs;
                u32x4 o; o.x = pk2(y[0], y[1]); o.y = pk2(y[2], y[3]); o.z = pk2(y[4], y[5]); o.w = pk2(y[6], y[7]);
                *(LAS u32x4*)(dstt + (16 * strip + 8 * half + r) * PQ_PITCH) = o;
            }
        }
    }
    __syncthreads();
    const float mprev = SC[0], Mlast = SC[1];
    {
        bf16_t* Sg = (bf16_t*)(ws + WS_S) + (size_t)item * 128 * 128;
        const int t = wave * 16 + fr; const float Mt = MS[t];
        for (int st = 0; st < 8; ++st) {
            u32x2 o = (u32x2){0u, 0u};
            if (st <= wave) {
                f32x4 acc = (f32x4){0.f, 0.f, 0.f, 0.f};
#pragma unroll
                for (int ks = 0; ks < 8; ++ks) acc = MFMA16(lfrag(KL, PQ_PITCH, st * 16 + fr, ks * 32, fq), lfrag(QL, PQ_PITCH, wave * 16 + fr, ks * 32, fq), acc);
                float v[4];
#pragma unroll
                for (int j = 0; j < 4; ++j) { const int s = st * 16 + 4 * fq + j; v[j] = (s <= t) ? acc[j] * __expf(AS[s] - Mt) : 0.f; }
                o.x = pk2(v[0], v[1]); o.y = pk2(v[2], v[3]);
            }
            *(u32x2*)((unsigned char*)Sg + fm_off(t, st * 16 + 4 * fq, 4)) = o;
        }
    }
    {
        bf16_t* Qg = (bf16_t*)(ws + WS_QT) + (size_t)item * 128 * 256;
#pragma unroll
        for (int i = 0; i < 8; ++i) { const int idx = tid + 512 * i, blk = idx >> 6, t = (blk >> 3) * 16 + (idx & 15), ch = (blk & 7) * 4 + ((idx >> 4) & 3);
            const u32x4 v = *(const LAS u32x4*)(QL + t * PQ_PITCH + ch * 16); const float s = __expf(mprev - MS[t]);
            u32x4 o; o.x = pk2(bf_lo(v.x) * s, bf_hi(v.x) * s); o.y = pk2(bf_lo(v.y) * s, bf_hi(v.y) * s); o.z = pk2(bf_lo(v.z) * s, bf_hi(v.z) * s); o.w = pk2(bf_lo(v.w) * s, bf_hi(v.w) * s);
            *(u32x4*)((unsigned char*)Qg + fm_off(t, ch * 8, 8)) = o; }
    }
    {
        bf16_t* Kg = (bf16_t*)(ws + WS_KWT) + (size_t)item * 256 * 128;
        const int dlo = lane & 15, sglo = lane >> 4;
#pragma unroll
        for (int i = 0; i < 8; ++i) { const int combo = wave * 8 + i, d = (combo >> 2) * 16 + dlo, s0 = ((combo & 3) * 4 + sglo) * 8;
            float v[8];
#pragma unroll
            for (int e = 0; e < 8; ++e) v[e] = bf2f(*(const LAS bf16_t*)(KL + (s0 + e) * PQ_PITCH + d * 2)) * __expf(AS[s0 + e] - Mlast);
            u32x4 o; o.x = pk2(v[0], v[1]); o.y = pk2(v[2], v[3]); o.z = pk2(v[4], v[5]); o.w = pk2(v[6], v[7]);
            *(u32x4*)((unsigned char*)Kg + fm_off(d, s0, 4)) = o; }
    }
    __syncthreads();
}

__device__ __forceinline__ void hgrn_pre_load(const DArgs& a, int round, int item, u32x4 (&gq)[4]) {
    const int tid = tid_();
    const int p = item >> 7, c = item & 127, bl = p >> 3, h = p & 7;
    const int tl0 = bl * SEQ + c * 64;
    GAS unsigned char* ws = a.ws;
#pragma unroll
    for (int i = 0; i < 2; ++i) { const int idx = tid + 512 * i, s = idx >> 4, ch = idx & 15;
        gq[2 * i] = *(const GAS u32x4*)((const GAS bf16_t*)(ws + WS_GFLOG) + (size_t)(tl0 + s) * 1024 + h * 128 + ch * 8);
        gq[2 * i + 1] = *(const GAS u32x4*)((const GAS bf16_t*)(ws + WS_GQ) + (size_t)(tl0 + s) * 1024 + h * 128 + ch * 8); }
}
__device__ __forceinline__ void hgrn_pre_item(const DArgs& a, LAS unsigned char* lds, int round, int item, u32x4 (&gq)[4], int next_item) {
    const int tid = tid_(), lane = tid & 63, wave = __builtin_amdgcn_readfirstlane(tid >> 6), fr = lane & 15, fq = lane >> 4;
    const int p = item >> 7, c = item & 127, bl = p >> 3, h = p & 7;
    const int tl0 = bl * SEQ + c * 64;
    GAS unsigned char* ws = a.ws;
    LAS float* CUM = (LAS float*)lds;
    LAS float* GL = (LAS float*)(lds + 32768);
    LAS unsigned char* QH = lds + 65536;
    LAS unsigned char* KE = lds + 65536 + 64 * PS_PITCH;
    LAS float* QF = (LAS float*)(lds + 65536 + 128 * PS_PITCH);
#pragma unroll
    for (int i = 0; i < 2; ++i) { const int idx = tid + 512 * i, s = idx >> 4, ch = idx & 15;
        const u32x4 gv = gq[2 * i], qv = gq[2 * i + 1];
        LAS float* gd = GL + s * 128 + ch * 8; LAS float* qd = QF + s * 128 + ch * 8;
        gd[0] = bf_lo(gv.x); gd[1] = bf_hi(gv.x); gd[2] = bf_lo(gv.y); gd[3] = bf_hi(gv.y); gd[4] = bf_lo(gv.z); gd[5] = bf_hi(gv.z); gd[6] = bf_lo(gv.w); gd[7] = bf_hi(gv.w);
        qd[0] = bf_lo(qv.x); qd[1] = bf_hi(qv.x); qd[2] = bf_lo(qv.y); qd[3] = bf_hi(qv.y); qd[4] = bf_lo(qv.z); qd[5] = bf_hi(qv.z); qd[6] = bf_lo(qv.w); qd[7] = bf_hi(qv.w); }
    if (next_item < 2048) hgrn_pre_load(a, round, next_item, gq);
    LDS_BAR();
    {
        const int d = tid & 127, qt = tid >> 7; float cs = 0.f;
#pragma unroll 4
        for (int s = 0; s < 16; ++s) { cs += GL[(qt * 16 + s) * 128 + d]; CUM[(qt * 16 + s) * 128 + d] = cs; }
        LDS_BAR();
        float off = 0.f;
#pragma unroll
        for (int q = 0; q < 3; ++q) off += (q < qt) ? CUM[(q * 16 + 15) * 128 + d] : 0.f;
        LDS_BAR();
#pragma unroll 4
        for (int s = 0; s < 16; ++s) CUM[(qt * 16 + s) * 128 + d] += off;
        if (qt == 3) ((GAS float*)(ws + WS_HGDEC))[(size_t)item * 128 + d] = __expf(cs + off);
    }
    LDS_BAR();
    {
        bf16_t* Qg = (bf16_t*)(ws + WS_QTG) + (size_t)item * 64 * 128;
#pragma unroll
        for (int i = 0; i < 2; ++i) { const int idx = tid + 512 * i, s = idx >> 4, ch = idx & 15;
            float qt[8], qh[8], ke[8];
#pragma unroll
            for (int e = 0; e < 8; ++e) { const int d = ch * 8 + e; const float cm = CUM[s * 128 + d], last = CUM[63 * 128 + d], q = QF[s * 128 + d], g = GL[s * 128 + d];
                qt[e] = q * __expf(cm); qh[e] = q * __expf(cm - last); ke[e] = (1.0f - __expf(g)) * __expf(last - cm); }
            u32x4 o; o.x = pk2(qt[0], qt[1]); o.y = pk2(qt[2], qt[3]); o.z = pk2(qt[4], qt[5]); o.w = pk2(qt[6], qt[7]);
            *(u32x4*)((unsigned char*)Qg + fm_off(s, ch * 8, 4)) = o;
            o.x = pk2(qh[0], qh[1]); o.y = pk2(qh[2], qh[3]); o.z = pk2(qh[4], qh[5]); o.w = pk2(qh[6], qh[7]);
            *(LAS u32x4*)(QH + s * PS_PITCH + ch * 16) = o;
            o.x = pk2(ke[0], ke[1]); o.y = pk2(ke[2], ke[3]); o.z = pk2(ke[4], ke[5]); o.w = pk2(ke[6], ke[7]);
            *(LAS u32x4*)(KE + s * PS_PITCH + ch * 16) = o; }
    }
    LDS_BAR();
    {
        bf16_t* Ag = (bf16_t*)(ws + WS_ATT) + (size_t)item * 64 * 64;
#pragma unroll
        for (int i = 0; i < 2; ++i) { const int tile = wave * 2 + i, tt = tile >> 2, st = tile & 3; const int t = tt * 16 + fr;
            u32x2 o = (u32x2){0u, 0u};
            if (st <= tt) { f32x4 acc = (f32x4){0.f, 0.f, 0.f, 0.f};
#pragma unroll
                for (int ks = 0; ks < 4; ++ks) acc = MFMA16(lfrag(KE, PS_PITCH, st * 16 + fr, ks * 32, fq), lfrag(QH, PS_PITCH, tt * 16 + fr, ks * 32, fq), acc);
                float v[4];
#pragma unroll
                for (int j = 0; j < 4; ++j) { const int s = st * 16 + 4 * fq + j; v[j] = (s <= t) ? acc[j] : 0.f; }
                o.x = pk2(v[0], v[1]); o.y = pk2(v[2], v[3]); }
            *(u32x2*)((unsigned char*)Ag + fm_off(t, st * 16 + 4 * fq, 2)) = o; }
    }
    {
        bf16_t* Kg = (bf16_t*)(ws + WS_KENDT) + (size_t)item * 128 * 64;
        const int dlo = lane & 15, sglo = lane >> 4;
#pragma unroll
        for (int i = 0; i < 2; ++i) { const int combo = wave * 2 + i, d = (combo >> 1) * 16 + dlo, s0 = ((combo & 1) * 4 + sglo) * 8;
            unsigned v[8];
#pragma unroll
            for (int e = 0; e < 8; ++e) v[e] = *(const LAS bf16_t*)(KE + (s0 + e) * PS_PITCH + d * 2);
            u32x4 o; o.x = v[0] | (v[1] << 16); o.y = v[2] | (v[3] << 16); o.z = v[4] | (v[5] << 16); o.w = v[6] | (v[7] << 16);
            *(u32x4*)((unsigned char*)Kg + fm_off(d, s0, 2)) = o; }
    }
    LDS_BAR();
}

template <int NVT, bool DEN>
__device__ __forceinline__ void mlstm_scan(const DArgs& a, LAS unsigned char* lds, int round, int p, int sl) {
    const int tid = tid_(), lane = tid & 63, wave = __builtin_amdgcn_readfirstlane(tid >> 6), fr = lane & 15, fq = lane >> 4;
    const int bl = p >> 2, h = p & 3, b = round * 2 + bl;
    GAS unsigned char* ws = a.ws;
    constexpr int VTB = NVT * 16 * PS_PITCH, CTB = NVT * 16 * PQ_PITCH;
    LAS unsigned char* VT = lds; LAS unsigned char* CT = lds + 2 * VTB; LAS float* DEC = (LAS float*)(lds + 2 * VTB + 2 * CTB);
    for (int i = tid; i < (2 * VTB + 2 * CTB) / 4; i += NTHR) ((LAS unsigned*)lds)[i] = 0u;
    if (tid < 64) DEC[tid] = ((const GAS float*)(ws + WS_MDEC))[p * 64 + tid];
    __syncthreads();
    if (DEN) { if (tid < 256) { const int bufi = tid >> 7, s = tid & 127; *(LAS bf16_t*)(VT + bufi * VTB + s * 2) = (bf16_t)0x3F80; } }
    f32x4 st[2][NVT];
#pragma unroll
    for (int dt = 0; dt < 2; ++dt)
#pragma unroll
        for (int vt = 0; vt < NVT; ++vt) st[dt][vt] = (f32x4){0.f, 0.f, 0.f, 0.f};
    const int vcol = h * 512 + sl * 32;
    const int vs = tid >> 2, vpart = tid & 3;
    const GAS unsigned char* Sg0 = ws + WS_S + (size_t)(p * 64) * 32768 + wave * 4096 + lane * 16;
    const GAS unsigned char* Qg0 = ws + WS_QT + (size_t)(p * 64) * 65536 + wave * 8192 + lane * 16;
    const GAS unsigned char* Kg0 = ws + WS_KWT + (size_t)(p * 64) * 65536 + wave * 8192 + lane * 16;
    const GAS bf16_t* Vg0 = (const GAS bf16_t*)(ws + WS_V) + (size_t)(bl * SEQ + vs) * 2048 + vcol + vpart * 8;
    bf16x8 bS[4], bQ[8], aK[2][4]; u32x4 vreg = (u32x4){0u, 0u, 0u, 0u};
#define V_STAGE(cc_) do { LAS unsigned char* d0_ = VT + ((cc_) & 1) * VTB + (vpart * 8) * PS_PITCH + vs * 2; \
        *(LAS bf16_t*)(d0_ + 0 * PS_PITCH) = (bf16_t)(vreg.x & 0xffffu); *(LAS bf16_t*)(d0_ + 1 * PS_PITCH) = (bf16_t)(vreg.x >> 16); \
        *(LAS bf16_t*)(d0_ + 2 * PS_PITCH) = (bf16_t)(vreg.y & 0xffffu); *(LAS bf16_t*)(d0_ + 3 * PS_PITCH) = (bf16_t)(vreg.y >> 16); \
        *(LAS bf16_t*)(d0_ + 4 * PS_PITCH) = (bf16_t)(vreg.z & 0xffffu); *(LAS bf16_t*)(d0_ + 5 * PS_PITCH) = (bf16_t)(vreg.z >> 16); \
        *(LAS bf16_t*)(d0_ + 6 * PS_PITCH) = (bf16_t)(vreg.w & 0xffffu); *(LAS bf16_t*)(d0_ + 7 * PS_PITCH) = (bf16_t)(vreg.w >> 16); } while (0)
    if (!DEN) { vreg = *(const GAS u32x4*)Vg0; V_STAGE(0); }
    __builtin_amdgcn_sched_barrier(0);
#pragma unroll
    for (int ks = 0; ks < 4; ++ks)
#pragma unroll
        for (int dt = 0; dt < 2; ++dt) aK[dt][ks] = *(const GAS bf16x8*)(Kg0 + (dt * 4 + ks) * 1024);
    __builtin_amdgcn_sched_barrier(0);
#pragma unroll
    for (int ks = 0; ks < 4; ++ks) bS[ks] = *(const GAS bf16x8*)(Sg0 + ks * 1024);
    __builtin_amdgcn_sched_barrier(0);
#pragma unroll
    for (int ks = 0; ks < 8; ++ks) bQ[ks] = *(const GAS bf16x8*)(Qg0 + ks * 1024);
    __builtin_amdgcn_sched_barrier(0);
    if (!DEN) vreg = *(const GAS u32x4*)(Vg0 + (size_t)128 * 2048);
    __builtin_amdgcn_sched_barrier(0);
    const GAS unsigned char* pfp; unsigned pfstride;
    { const int tt = (wave * 64 + lane) < 160 ? wave * 64 + lane : 159; const int idx = sl * 10 + (tt >> 4), off = (tt & 15) * 64;
      pfp = (idx < 32 ? ws + WS_S + (size_t)(p * 64) * 32768 + idx * 1024 : idx < 96 ? ws + WS_QT + (size_t)(p * 64) * 65536 + (idx - 32) * 1024 : ws + WS_KWT + (size_t)(p * 64) * 65536 + (idx - 96) * 1024) + off;
      pfstride = idx < 32 ? 32768u : 65536u; }
    unsigned pfv = 0u;
#pragma unroll 1
    for (int c = 0; c < 64; ++c) {
        const int tl0 = bl * SEQ + c * 128; const size_t tg0 = (size_t)b * SEQ + c * 128;
        const int cn = c < 63 ? c + 1 : 63, cn2 = c < 62 ? c + 2 : 63;
        LAS unsigned char* vt_ = VT + (c & 1) * VTB; LAS unsigned char* ct_ = CT + (c & 1) * CTB; LAS unsigned char* ctn = CT + ((c + 1) & 1) * CTB;
        LDS_BAR();
        if (!DEN && wave < 3) { asm volatile("" :: "v"(pfv)); const int c3 = c < 60 ? c + 3 : 63; pfv = *(const GAS unsigned*)(pfp + (size_t)c3 * pfstride); }
        bf16x8 vf[NVT][4], cf[NVT][4];
#pragma unroll
        for (int vt = 0; vt < NVT; ++vt)
#pragma unroll
            for (int ks = 0; ks < 4; ++ks) vf[vt][ks] = lfrag(vt_, PS_PITCH, vt * 16 + fr, ks * 32, fq);
        const float dec = DEC[c];
        __builtin_amdgcn_sched_barrier(0);
#pragma unroll
        for (int dt = 0; dt < 2; ++dt)
#pragma unroll
            for (int vt = 0; vt < NVT; ++vt) st[dt][vt] = st[dt][vt] * dec;
#pragma unroll
        for (int ks = 0; ks < 4; ++ks) {
#pragma unroll
            for (int vt = 0; vt < NVT; ++vt) cf[vt][ks] = lfrag(ct_, PQ_PITCH, vt * 16 + fr, ks * 32, fq);
#pragma unroll
            for (int dt = 0; dt < 2; ++dt) {
#pragma unroll
                for (int vt = 0; vt < NVT; ++vt) st[dt][vt] = MFMA16(aK[dt][ks], vf[vt][ks], st[dt][vt]);
                aK[dt][ks] = *(const GAS bf16x8*)(Kg0 + (size_t)cn * 65536 + (dt * 4 + ks) * 1024);
            }
            __builtin_amdgcn_sched_barrier(0);
        }
#pragma unroll
        for (int dt = 0; dt < 2; ++dt)
#pragma unroll
            for (int vt = 0; vt < NVT; ++vt) { u32x2 o; o.x = pk2(st[dt][vt][0], st[dt][vt][1]); o.y = pk2(st[dt][vt][2], st[dt][vt][3]);
                *(LAS u32x2*)(ctn + (vt * 16 + fr) * PQ_PITCH + (wave * 32 + dt * 16 + 4 * fq) * 2) = o; }
        __builtin_amdgcn_sched_barrier(0);
        f32x4 acc[NVT];
#pragma unroll
        for (int vt = 0; vt < NVT; ++vt) acc[vt] = (f32x4){0.f, 0.f, 0.f, 0.f};
#pragma unroll
        for (int ks = 0; ks < 4; ++ks) {
#pragma unroll
            for (int vt = 0; vt < NVT; ++vt) acc[vt] = MFMA16(vf[vt][ks], bS[ks], acc[vt]);
            bS[ks] = *(const GAS bf16x8*)(Sg0 + (size_t)cn * 32768 + ks * 1024);
            __builtin_amdgcn_sched_barrier(0);
        }
#pragma unroll
        for (int ks = 0; ks < 8; ++ks) {
#pragma unroll
            for (int vt = 0; vt < NVT; ++vt) acc[vt] = MFMA16(cf[vt][ks & 3], bQ[ks], acc[vt]);
            if (ks < 4) {
#pragma unroll
                for (int vt = 0; vt < NVT; ++vt) cf[vt][ks] = lfrag(ct_, PQ_PITCH, vt * 16 + fr, 128 + ks * 32, fq);
            }
            bQ[ks] = *(const GAS bf16x8*)(Qg0 + (size_t)cn * 65536 + ks * 1024);
            __builtin_amdgcn_sched_barrier(0);
        }
        const int t = wave * 16 + fr;
        if (!DEN) {
            GAS bf16_t* hn = (GAS bf16_t*)(ws + WS_QKPRE) + (size_t)(tl0 + t) * 2048 + vcol + 4 * fq;
#pragma unroll
            for (int vt = 0; vt < NVT; ++vt) { u32x2 o; o.x = pk2(acc[vt][0], acc[vt][1]); o.y = pk2(acc[vt][2], acc[vt][3]); *(GAS u32x2*)(hn + vt * 16) = o; }
            V_STAGE(c + 1); vreg = *(const GAS u32x4*)(Vg0 + (size_t)cn2 * 128 * 2048);
        } else {
            if (fq == 0) ((GAS float*)(ws + WS_DEN))[(tg0 + t) * 4 + h] = acc[0][0];
        }
    }
    asm volatile("" :: "v"(pfv));
    __syncthreads();
#undef V_STAGE
}

constexpr int HG_PD = 4;
__device__ __forceinline__ void hgrn_scan(const DArgs& a, LAS unsigned char* lds, int round, int p, int sl) {
    const int tid = tid_(), lane = tid & 63, wave = __builtin_amdgcn_readfirstlane(tid >> 6), fr = lane & 15, fq = lane >> 4;
    const int bl = p >> 3, h = p & 7;
    GAS unsigned char* ws = a.ws;
    constexpr int IP = 144, ITB = 32 * IP, STB = 32 * PS_PITCH;
    LAS unsigned char* IT = lds; LAS unsigned char* ST = lds + 2 * ITB;
    for (int i = tid; i < (2 * ITB + 2 * STB) / 4; i += NTHR) ((LAS unsigned*)lds)[i] = 0u;
    __syncthreads();
    f32x4 st[2][2];
#pragma unroll
    for (int i = 0; i < 2; ++i) { st[i][0] = (f32x4){0.f, 0.f, 0.f, 0.f}; st[i][1] = st[i][0]; }
    const int vcol = h * 128 + sl * 32;
    const int is = (tid & 255) >> 2, ipart = tid & 3;
    const bool outw = wave < 4;
    const int w4 = wave & 3;
    const GAS unsigned char* Ag0 = ws + WS_ATT + (size_t)(p * 128) * 8192 + w4 * 2048 + lane * 16;
    const GAS unsigned char* Qg0 = ws + WS_QTG + (size_t)(p * 128) * 16384 + w4 * 4096 + lane * 16;
    const GAS unsigned char* Kg0 = ws + WS_KENDT + (size_t)(p * 128) * 16384 + w4 * 4096 + lane * 16;
    const GAS unsigned char* Dg0 = ws + WS_HGDEC + ((size_t)(p * 128) * 128 + w4 * 32 + 4 * fq) * 4;
    const GAS unsigned char* Ig0 = ws + WS_GI + ((size_t)(bl * SEQ + is) * 1024 + vcol + ipart * 8) * 2;
    const GAS unsigned char* gb0 = outw ? Ag0 : Kg0;          const unsigned gs0 = outw ? 8192u : 16384u;
    const GAS unsigned char* gb1 = outw ? Qg0 : Kg0 + 2048;   const unsigned gs1 = 16384u;
    const GAS unsigned char* gb2 = outw ? Qg0 + 2048 : Dg0;   const unsigned gs2 = outw ? 16384u : 512u, gt2 = outw ? 1024u : 64u;
    const GAS unsigned char* gb3 = outw ? Ig0 : Dg0;          const unsigned gs3 = outw ? 131072u : 512u;
    u32x4 pf[HG_PD][7];
#define HG_LD01(k_, cc_) do { _Pragma("unroll") for (int j_ = 0; j_ < 2; ++j_) pf[k_][j_] = *(const GAS u32x4*)(gb0 + (size_t)(cc_) * gs0 + j_ * 1024); } while (0)
#define HG_LD23(k_, cc_) do { _Pragma("unroll") for (int j_ = 0; j_ < 2; ++j_) pf[k_][2 + j_] = *(const GAS u32x4*)(gb1 + (size_t)(cc_) * gs1 + j_ * 1024); } while (0)
#define HG_LD45(k_, cc_) do { _Pragma("unroll") for (int j_ = 0; j_ < 2; ++j_) pf[k_][4 + j_] = *(const GAS u32x4*)(gb2 + (size_t)(cc_) * gs2 + j_ * gt2); } while (0)
#define HG_LD6(k_, cc_) do { pf[k_][6] = *(const GAS u32x4*)(gb3 + (size_t)(cc_) * gs3); } while (0)
#pragma unroll
    for (int k = 0; k < HG_PD; ++k) { HG_LD01(k, k); HG_LD23(k, k); HG_LD45(k, k); __builtin_amdgcn_sched_barrier(0); HG_LD6((k + 1) % HG_PD, (k + 1 < HG_PD ? k + 1 : HG_PD)); __builtin_amdgcn_sched_barrier(0); }
    const GAS unsigned char* pfp; unsigned pfstride;
    { const int tt = (wave * 64 + lane) < 160 ? wave * 64 + lane : 159; const int idx = sl * 10 + (tt >> 4), off = (tt & 15) * 64;
      pfp = (idx < 8 ? ws + WS_ATT + (size_t)(p * 128) * 8192 + idx * 1024 : idx < 24 ? ws + WS_QTG + (size_t)(p * 128) * 16384 + (idx - 8) * 1024 : ws + WS_KENDT + (size_t)(p * 128) * 16384 + (idx - 24) * 1024) + off;
      pfstride = idx < 8 ? 8192u : 16384u; }
    unsigned pfv[HG_PD];
#pragma unroll
    for (int k = 0; k < HG_PD; ++k) pfv[k] = 0u;
#define HG_STAGE(dst_, iv_) do { LAS unsigned char* d0_ = (dst_) + (ipart * 8) * IP + is * 2; \
        *(LAS bf16_t*)(d0_ + 0 * IP) = (bf16_t)((iv_).x & 0xffffu); *(LAS bf16_t*)(d0_ + 1 * IP) = (bf16_t)((iv_).x >> 16); \
        *(LAS bf16_t*)(d0_ + 2 * IP) = (bf16_t)((iv_).y & 0xffffu); *(LAS bf16_t*)(d0_ + 3 * IP) = (bf16_t)((iv_).y >> 16); \
        *(LAS bf16_t*)(d0_ + 4 * IP) = (bf16_t)((iv_).z & 0xffffu); *(LAS bf16_t*)(d0_ + 5 * IP) = (bf16_t)((iv_).z >> 16); \
        *(LAS bf16_t*)(d0_ + 6 * IP) = (bf16_t)((iv_).w & 0xffffu); *(LAS bf16_t*)(d0_ + 7 * IP) = (bf16_t)((iv_).w >> 16); } while (0)
    if (outw) { const u32x4 iv = *(const GAS u32x4*)Ig0; HG_STAGE(IT, iv); }
#pragma unroll 1
    for (int c0 = 0; c0 < 128; c0 += HG_PD) {
#pragma unroll
      for (int k = 0; k < HG_PD; ++k) {
        const int c = c0 + k;
        const int tl0 = bl * SEQ + c * 64;
        const int cn = (c + HG_PD < 128) ? c + HG_PD : 127;
        LAS unsigned char* it_ = IT + (k & 1) * ITB; LAS unsigned char* itn = IT + ((k + 1) & 1) * ITB; LAS unsigned char* st_ = ST + (k & 1) * STB; LAS unsigned char* stn = ST + ((k + 1) & 1) * STB;
        LDS_BAR();
        if (wave < 3) { asm volatile("" :: "v"(pfv[k])); const int c7 = (c + HG_PD + 3 < 128) ? c + HG_PD + 3 : 127; pfv[k] = *(const GAS unsigned*)(pfp + (size_t)c7 * pfstride); }
        bf16x8 itf[2][2];
#pragma unroll
        for (int vt = 0; vt < 2; ++vt)
#pragma unroll
            for (int ks = 0; ks < 2; ++ks) itf[vt][ks] = lfrag(it_, IP, vt * 16 + fr, ks * 32, fq);
        bf16x8 sf[2][4];
        f32x4 acc[2];
        acc[0] = (f32x4){0.f, 0.f, 0.f, 0.f}; acc[1] = acc[0];
        if (outw) {
#pragma unroll
            for (int vt = 0; vt < 2; ++vt)
#pragma unroll
                for (int ks = 0; ks < 4; ++ks) sf[vt][ks] = lfrag(st_, PS_PITCH, vt * 16 + fr, ks * 32, fq);
#pragma unroll
            for (int ks = 0; ks < 2; ++ks)
#pragma unroll
                for (int vt = 0; vt < 2; ++vt) acc[vt] = MFMA16(itf[vt][ks], __builtin_bit_cast(bf16x8, pf[k][ks]), acc[vt]);
        } else {
            const f32x4 dec = __builtin_bit_cast(f32x4, pf[k][4]);
#pragma unroll
            for (int vt = 0; vt < 2; ++vt) { st[0][vt] = st[0][vt] * dec;
#pragma unroll
                for (int ks = 0; ks < 2; ++ks) st[0][vt] = MFMA16(__builtin_bit_cast(bf16x8, pf[k][ks]), itf[vt][ks], st[0][vt]); }
        }
        __builtin_amdgcn_sched_barrier(0);
        HG_LD01(k, cn);
        __builtin_amdgcn_sched_barrier(0);
        if (outw) {
#pragma unroll
            for (int ks = 0; ks < 2; ++ks)
#pragma unroll
                for (int vt = 0; vt < 2; ++vt) acc[vt] = MFMA16(sf[vt][ks], __builtin_bit_cast(bf16x8, pf[k][2 + ks]), acc[vt]);
        } else {
            const f32x4 dec = __builtin_bit_cast(f32x4, pf[k][5]);
#pragma unroll
            for (int vt = 0; vt < 2; ++vt) { st[1][vt] = st[1][vt] * dec;
#pragma unroll
                for (int ks = 0; ks < 2; ++ks) st[1][vt] = MFMA16(__builtin_bit_cast(bf16x8, pf[k][2 + ks]), itf[vt][ks], st[1][vt]); }
        }
        __builtin_amdgcn_sched_barrier(0);
        HG_LD23(k, cn);
        __builtin_amdgcn_sched_barrier(0);
        if (outw) {
#pragma unroll
            for (int ks = 2; ks < 4; ++ks)
#pragma unroll
                for (int vt = 0; vt < 2; ++vt) acc[vt] = MFMA16(sf[vt][ks], __builtin_bit_cast(bf16x8, pf[k][2 + ks]), acc[vt]);
        } else {
#pragma unroll
            for (int dtile = 0; dtile < 2; ++dtile)
#pragma unroll
                for (int vt = 0; vt < 2; ++vt) { u32x2 o; o.x = pk2(st[dtile][vt][0], st[dtile][vt][1]); o.y = pk2(st[dtile][vt][2], st[dtile][vt][3]);
                    *(LAS u32x2*)(stn + (vt * 16 + fr) * PS_PITCH + (w4 * 32 + dtile * 16 + 4 * fq) * 2) = o; }
        }
        __builtin_amdgcn_sched_barrier(0);
        HG_LD45(k, cn);
        __builtin_amdgcn_sched_barrier(0);
        if (outw) {
            HG_STAGE(itn, pf[(k + 1) % HG_PD][6]);
            GAS bf16_t* og = (GAS bf16_t*)(ws + WS_GQ) + (size_t)(tl0 + w4 * 16 + fr) * 1024 + vcol + 4 * fq;
#pragma unroll
            for (int vt = 0; vt < 2; ++vt) { u32x2 o; o.x = pk2(acc[vt][0], acc[vt][1]); o.y = pk2(acc[vt][2], acc[vt][3]); *(GAS u32x2*)(og + vt * 16) = o; }
        }
        __builtin_amdgcn_sched_barrier(0);
        { const int cni = (c + 1 + HG_PD < 128) ? c + 1 + HG_PD : 127; HG_LD6((k + 1) % HG_PD, cni); }
        __builtin_amdgcn_sched_barrier(0);
      }
    }
#pragma unroll
    for (int k = 0; k < HG_PD; ++k) asm volatile("" :: "v"(pfv[k]));
    __syncthreads();
#undef HG_LD01
#undef HG_LD23
#undef HG_LD45
#undef HG_LD6
#undef HG_STAGE
}

__device__ __forceinline__ void phase_ypass(const DArgs& a, int round, int vcu, int G) {
    const int tid = tid_(), lane = tid & 63, wave = tid >> 6;
    const int gw = vcu * NWAVES + wave, NGW = G * NWAVES;
    GAS unsigned char* ws = a.ws;
    f32x4 mg0[4], mg1[4], gg4[4];
#pragma unroll
    for (int j = 0; j < 4; ++j) { mg0[j] = *(const GAS f32x4*)(a.m_head_g + j * 512 + lane * 8); mg1[j] = *(const GAS f32x4*)(a.m_head_g + j * 512 + lane * 8 + 4); gg4[j] = *(const GAS f32x4*)(a.g_head_g + lane * 16 + 4 * j); }
    for (int tl = gw; tl < RT; tl += NGW) {
        const size_t tg = (size_t)round * RT + tl;
        const f32x4 den4 = *(const f32x4*)((const float*)(ws + WS_DEN) + tg * 4), mt4 = *(const f32x4*)((const float*)(ws + WS_MT) + tg * 4);
#pragma unroll
        for (int j = 0; j < 4; ++j) {
            const int col = j * 512 + lane * 8;
            const u32x4 nv = *(const u32x4*)((const bf16_t*)(ws + WS_QKPRE) + (size_t)tl * 2048 + col);
            const u32x4 ov = *(const u32x4*)((const bf16_t*)(ws + WS_SIGO) + (size_t)tl * 2048 + col);
            const float inv = 1.0f / fmaxf(fabsf(den4[j]), __expf(-mt4[j]));
            float hv[8] = {bf_lo(nv.x) * inv, bf_hi(nv.x) * inv, bf_lo(nv.y) * inv, bf_hi(nv.y) * inv, bf_lo(nv.z) * inv, bf_hi(nv.z) * inv, bf_lo(nv.w) * inv, bf_hi(nv.w) * inv};
            float ss = 0.f;
#pragma unroll
            for (int e = 0; e < 8; ++e) ss += hv[e] * hv[e];
            const float r = rsqrtf(wave_sum(ss, lane) * (1.f / 512.f) + EPS);
            const f32x4 g0 = mg0[j], g1 = mg1[j];
            const float og[8] = {bf_lo(ov.x), bf_hi(ov.x), bf_lo(ov.y), bf_hi(ov.y), bf_lo(ov.z), bf_hi(ov.z), bf_lo(ov.w), bf_hi(ov.w)};
            float y[8];
#pragma unroll
            for (int e = 0; e < 8; ++e) y[e] = og[e] * hv[e] * r * (e < 4 ? g0[e] : g1[e - 4]);
            u32x4 o; o.x = pk2(y[0], y[1]); o.y = pk2(y[2], y[3]); o.z = pk2(y[4], y[5]); o.w = pk2(y[6], y[7]);
            *(u32x4*)((bf16_t*)(ws + WS_V) + (size_t)tl * 2048 + col) = o;
        }
        {
            const int col = lane * 16;
            const u32x4 n0 = *(const u32x4*)((const bf16_t*)(ws + WS_GQ) + (size_t)tl * 1024 + col), n1 = *(const u32x4*)((const bf16_t*)(ws + WS_GQ) + (size_t)tl * 1024 + col + 8);
            const u32x4 s0 = *(const u32x4*)((const bf16_t*)(ws + WS_SGG) + (size_t)tl * 1024 + col), s1 = *(const u32x4*)((const bf16_t*)(ws + WS_SGG) + (size_t)tl * 1024 + col + 8);
            float ov[16] = {bf_lo(n0.x), bf_hi(n0.x), bf_lo(n0.y), bf_hi(n0.y), bf_lo(n0.z), bf_hi(n0.z), bf_lo(n0.w), bf_hi(n0.w), bf_lo(n1.x), bf_hi(n1.x), bf_lo(n1.y), bf_hi(n1.y), bf_lo(n1.z), bf_hi(n1.z), bf_lo(n1.w), bf_hi(n1.w)};
            const float sg[16] = {bf_lo(s0.x), bf_hi(s0.x), bf_lo(s0.y), bf_hi(s0.y), bf_lo(s0.z), bf_hi(s0.z), bf_lo(s0.w), bf_hi(s0.w), bf_lo(s1.x), bf_hi(s1.x), bf_lo(s1.y), bf_hi(s1.y), bf_lo(s1.z), bf_hi(s1.z), bf_lo(s1.w), bf_hi(s1.w)};
            float ss = 0.f;
#pragma unroll
            for (int e = 0; e < 16; ++e) ss += ov[e] * ov[e];
            ss += DPP_(ss, 0xB1); ss += DPP_(ss, 0x4E); ss += DPP_(ss, 0x141);
            const float r = rsqrtf(ss * (1.f / 128.f) + EPS);
            float y[16];
#pragma unroll
            for (int e = 0; e < 16; ++e) y[e] = ov[e] * r * gg4[e >> 2][e & 3] * sg[e];
            u32x4 o; o.x = pk2(y[0], y[1]); o.y = pk2(y[2], y[3]); o.z = pk2(y[4], y[5]); o.w = pk2(y[6], y[7]);
            *(u32x4*)((bf16_t*)(ws + WS_GI) + (size_t)tl * 1024 + col) = o;
            o.x = pk2(y[8], y[9]); o.y = pk2(y[10], y[11]); o.z = pk2(y[12], y[13]); o.w = pk2(y[14], y[15]);
            *(u32x4*)((bf16_t*)(ws + WS_GI) + (size_t)tl * 1024 + col + 8) = o;
        }
    }
}


#define XB_TMO      128
#define XB_XCNT(j)  (256  + 64 * (j))
#define XB_XSUB(j)  (1280 + 64 * (j))
#define XB_XGEN(j)  (2304 + 64 * (j))
#define XB_TOP      3328
#define XB_TOPGEN   3392
#define XB_SPIN_CAP (1u << 22)
constexpr int CW_BAR = 4096;
constexpr int LDS_BARST = LDS_BYTES - 64;
__device__ __forceinline__ unsigned xb_ld(unsigned* p)              { return __hip_atomic_load(p, __ATOMIC_RELAXED, __HIP_MEMORY_SCOPE_AGENT); }
__device__ __forceinline__ unsigned xb_add(unsigned* p, unsigned v) { return __hip_atomic_fetch_add(p, v, __ATOMIC_RELAXED, __HIP_MEMORY_SCOPE_AGENT); }
__device__ __forceinline__ unsigned xb_xcc_id() { return (unsigned)__builtin_amdgcn_s_getreg((3 << 11) | 20) & 0xFu; }
#define XB_SPIN(cond, bar) do { unsigned _sp = 0; while (cond) { __builtin_amdgcn_s_sleep(1); \
    if ((++_sp & 255u) == 0u) { if (xb_ld(&(bar)[XB_TMO])) break; if (_sp > XB_SPIN_CAP) { atomicAdd(&(bar)[XB_TMO], 1u); break; } } } } while (0)
__device__ __forceinline__ void xcd_barrier_post(unsigned* bar, volatile LAS unsigned* st) { if (tid_() == 0) st[2] = xb_add(&bar[XB_XCNT(xb_xcc_id())], 1u); }
__device__ __forceinline__ void xcd_barrier_complete(unsigned* bar, unsigned x, unsigned& nloc, unsigned& nx) {
    const unsigned G = gridDim.x;
    unsigned sum, cnt, mine, sp = 0u;
    for (;;) {
        sum = 0u; cnt = 0u; mine = 0u;
#pragma unroll
        for (unsigned j = 0; j < 16; ++j) { const unsigned c = xb_ld(&bar[XB_XCNT(j)]); sum += c; cnt += (c > 0u) ? 1u : 0u; mine = (j == x) ? c : mine; }
        if (sum == G) break;
        __builtin_amdgcn_s_sleep(1);
        if ((++sp & 255u) == 0u) { if (xb_ld(&bar[XB_TMO])) break; if (sp > XB_SPIN_CAP) { atomicAdd(&bar[XB_TMO], 1u); break; } }
    }
    nloc = mine > 0u ? mine : 1u; nx = cnt > 0u ? cnt : 1u;
}
__device__ __forceinline__ void xcd_barrier(unsigned* bar, volatile LAS unsigned* st) {
    asm volatile("s_waitcnt vmcnt(0)" ::: "memory");
    __syncthreads();
    if (tid_() == 0) {
        const unsigned x = xb_xcc_id();
        __builtin_amdgcn_s_waitcnt(0);
        unsigned nloc = st[0], nx = st[1];
        if (nloc == 0u) { xcd_barrier_complete(bar, x, nloc, nx); st[0] = nloc; st[1] = nx; }
        const unsigned old = xb_add(&bar[XB_XSUB(x)], 1u);
        const unsigned gen = old / nloc;
        if (old + 1u == (gen + 1u) * nloc) {
            __builtin_amdgcn_fence(__ATOMIC_RELEASE, "agent");
            asm volatile("s_waitcnt vmcnt(0)" ::: "memory");
            const unsigned og = xb_add(&bar[XB_TOP], 1u);
            const unsigned tg = og / nx;
            if (og + 1u == (tg + 1u) * nx) xb_add(&bar[XB_TOPGEN], 1u);
            else XB_SPIN(xb_ld(&bar[XB_TOPGEN]) == tg, bar);
            __builtin_amdgcn_fence(__ATOMIC_ACQUIRE, "agent");
            xb_add(&bar[XB_XGEN(x)], 1u);
            asm volatile("s_waitcnt vmcnt(0)" ::: "memory");
        } else {
            XB_SPIN(xb_ld(&bar[XB_XGEN(x)]) == gen, bar);
            __builtin_amdgcn_fence(__ATOMIC_ACQUIRE, "agent");
            asm volatile("s_waitcnt vmcnt(0)" ::: "memory");
        }
    }
    __syncthreads();
}

__device__ __forceinline__ void phase_p8(const DArgs& a, int vcu, int G) {
    const int tid = tid_(), lane = tid & 63, wave = tid >> 6;
    const int gw = vcu * NWAVES + wave, NGW = G * NWAVES;
    GAS unsigned char* ws = a.ws;
    f32x4 g2[4];
#pragma unroll
    for (int j = 0; j < 4; ++j) g2[j] = ((const f32x4*)a.norm2_g)[64 * j + lane];
    for (int m = gw; m < T; m += NGW) {
        const GAS u32x2* xr = (const GAS u32x2*)((const GAS bf16_t*)a.out + (size_t)m * D) + lane;
        f32x4 v[4]; float s = 0.f;
#pragma unroll
        for (int j = 0; j < 4; ++j) { const u32x2 xv = xr[64 * j]; v[j][0] = bf_lo(xv.x); v[j][1] = bf_hi(xv.x); v[j][2] = bf_lo(xv.y); v[j][3] = bf_hi(xv.y); s += (v[j][0] * v[j][0] + v[j][1] * v[j][1]) + (v[j][2] * v[j][2] + v[j][3] * v[j][3]); }
        const float rstd = rsqrtf(wave_sum(s, lane) * (1.f / D) + EPS);
        unsigned long long* o8 = (unsigned long long*)((bf16_t*)(ws + WS_XN) + (size_t)m * D) + lane;
#pragma unroll
        for (int j = 0; j < 4; ++j) { v[j] = v[j] * rstd * g2[j]; o8[64 * j] = (unsigned long long)pk2(v[j][0], v[j][1]) | ((unsigned long long)pk2(v[j][2], v[j][3]) << 32); }
        float mx = 0.f;
#pragma unroll
        for (int j = 0; j < 4; ++j) mx = fmaxf(mx, fmaxf(fmaxf(fabsf(v[j][0]), fabsf(v[j][1])), fmaxf(fabsf(v[j][2]), fabsf(v[j][3]))));
        mx = wave_max(mx);
        const float qs = mx > 0.f ? 127.0f / mx : 0.f;
#pragma unroll
        for (int j = 0; j < 4; ++j) ((GAS unsigned*)(ws + WS_XQ + (size_t)m * 1024))[64 * j + lane] = pack_i8x4(v[j][0] * qs, v[j][1] * qs, v[j][2] * qs, v[j][3] * qs);
        if (lane == 0) ((GAS float*)(ws + WS_XQS))[m] = mx * (1.0f / 127.0f);
    }
    for (int e = gw; e < 16384; e += NGW) {
        f32x4 uv[4], vv[4]; float mu = 0.f, mv = 0.f;
#pragma unroll
        for (int j = 0; j < 4; ++j) { uv[j] = ((const GAS f32x4*)(a.u_emb + (size_t)e * 1024))[64 * j + lane]; vv[j] = ((const GAS f32x4*)(a.v_emb + (size_t)e * 1024))[64 * j + lane];
            mu = fmaxf(mu, fmaxf(fmaxf(fabsf(uv[j][0]), fabsf(uv[j][1])), fmaxf(fabsf(uv[j][2]), fabsf(uv[j][3]))));
            mv = fmaxf(mv, fmaxf(fmaxf(fabsf(vv[j][0]), fabsf(vv[j][1])), fmaxf(fabsf(vv[j][2]), fabsf(vv[j][3])))); }
        mu = wave_max(mu); mv = wave_max(mv);
        const float su = mu > 0.f ? 127.0f / mu : 0.f, sv = mv > 0.f ? 448.0f / mv : 0.f;
        if (lane == 0) { ((GAS float*)(ws + WS_USC))[e] = mu * (1.0f / 127.0f); ((GAS float*)(ws + WS_VSC))[e] = mv * (1.0f / 448.0f); }
#pragma unroll
        for (int j = 0; j < 4; ++j) {
            const size_t ob = (size_t)(2 * j + (lane >> 5)) * 2097152 + (size_t)e * 128 + ((4 * lane) & 127);
            *(GAS unsigned*)(ws + WS_UB + ob) = pack_i8x4(uv[j][0] * su, uv[j][1] * su, uv[j][2] * su, uv[j][3] * su);
            int p = __builtin_amdgcn_cvt_pk_fp8_f32(vv[j][0] * sv, vv[j][1] * sv, 0, false); p = __builtin_amdgcn_cvt_pk_fp8_f32(vv[j][2] * sv, vv[j][3] * sv, p, true);
            *(GAS unsigned*)(ws + WS_VB + ob) = (unsigned)p; }
    }
}

__device__ __forceinline__ unsigned f2ord(float f) { const unsigned u = __builtin_bit_cast(unsigned, f); return (u & 0x80000000u) ? ~u : (u | 0x80000000u); }
__device__ __forceinline__ float ord2f(unsigned k) { const unsigned u = (k & 0x80000000u) ? (k & 0x7fffffffu) : ~k; return __builtin_bit_cast(float, u); }
__device__ __forceinline__ unsigned umax_(unsigned a, unsigned b) { return a > b ? a : b; }
__device__ __forceinline__ unsigned shxu(unsigned v, int o, int lane) { return (unsigned)__builtin_amdgcn_ds_bpermute((lane ^ o) << 2, (int)v); }

__device__ __forceinline__ void phase_topk(const DArgs& a, LAS unsigned char* lds, int bx, int G) {
    const int tid = tid_(), lane = tid & 63, wave = __builtin_amdgcn_readfirstlane(tid >> 6), fr = lane & 15, fq = lane >> 4;
    GAS unsigned char* ws = a.ws;
    const int h = bx & 7;
    LAS unsigned char* KY = lds;
    LAS unsigned char* QL = lds + 2 * 128 * PS_PITCH;
    LAS unsigned* TOP = (LAS unsigned*)(lds + 2 * 128 * PS_PITCH + 64 * PQ_PITCH);
#pragma unroll
    for (int i = 0; i < 8; ++i) { const int idx = tid + 512 * i, row = idx >> 4, ch = idx & 15;
        *(LAS u32x4*)(KY + row * PS_PITCH + ch * 16) = *(const u32x4*)((const bf16_t*)(ws + WS_SK) + ((size_t)h * 256 + row) * 128 + ch * 8); }
    const int ntile = T / 64;
    u32x4 qpre[4];
    { const int tile0 = bx >> 3; if (tile0 < ntile) {
#pragma unroll
        for (int i = 0; i < 4; ++i) { const int idx = tid + 512 * i, row = idx >> 5, ch = idx & 31;
            qpre[i] = *(const GAS u32x4*)((const GAS bf16_t*)(ws + WS_QP) + ((size_t)tile0 * 64 + row) * 2048 + h * 256 + ch * 8); } } }
    __syncthreads();
    for (int tile = bx >> 3; tile < ntile; tile += (G >> 3)) {
        const size_t t0 = (size_t)tile * 64;
        LDS_BAR();
#pragma unroll
        for (int i = 0; i < 4; ++i) { const int idx = tid + 512 * i, row = idx >> 5, ch = idx & 31;
            *(LAS u32x4*)(QL + row * PQ_PITCH + ch * 16) = qpre[i]; }
        { const int tn = tile + (G >> 3); if (tn < ntile) {
#pragma unroll
            for (int i = 0; i < 4; ++i) { const int idx = tid + 512 * i, row = idx >> 5, ch = idx & 31;
                qpre[i] = *(const GAS u32x4*)((const GAS bf16_t*)(ws + WS_QP) + ((size_t)tn * 64 + row) * 2048 + h * 256 + ch * 8); } } }
        LDS_BAR();
        {
            const int mt = wave & 3, p = wave >> 2;
            unsigned key[32];
#pragma unroll
            for (int nt = 0; nt < 8; ++nt) { f32x4 acc = (f32x4){0.f, 0.f, 0.f, 0.f};
#pragma unroll
                for (int ks = 0; ks < 4; ++ks) acc = MFMA16(lfrag(KY + p * 128 * PS_PITCH, PS_PITCH, nt * 16 + fr, ks * 32, fq), lfrag(QL, PQ_PITCH, mt * 16 + fr, p * 128 + ks * 32, fq), acc);
#pragma unroll
                for (int j = 0; j < 4; ++j) { const int n = nt * 16 + 4 * fq + j; key[nt * 4 + j] = (f2ord(acc[j]) & ~127u) | (unsigned)(127 - n); } }
#pragma unroll 1
            for (int k = 0; k < 16; ++k) {
                unsigned t3[11];
#pragma unroll
                for (int e = 0; e < 10; ++e) t3[e] = umax_(umax_(key[3 * e], key[3 * e + 1]), key[3 * e + 2]);
                t3[10] = umax_(key[30], key[31]);
                const unsigned u0 = umax_(umax_(t3[0], t3[1]), t3[2]), u1 = umax_(umax_(t3[3], t3[4]), t3[5]), u2 = umax_(umax_(t3[6], t3[7]), t3[8]), u3 = umax_(t3[9], t3[10]);
                unsigned m = umax_(umax_(u0, u1), umax_(u2, u3));
                m = umax_(m, (unsigned)SWZI_(m, 0x401F)); m = umax_(m, xor32u_(m, lane >= 32));
#pragma unroll
                for (int e = 0; e < 32; ++e) key[e] = (key[e] == m) ? 0u : key[e];
                if (fq == (k & 3)) TOP[(p * 64 + mt * 16 + fr) * 16 + k] = m;
            }
        }
        LDS_BAR();
        {
            const int t = tid >> 3, sub = tid & 7;
            unsigned ck[7];
#pragma unroll
            for (int e = 0; e < 7; ++e) {
                const int ci = sub + 8 * e;
                int i = 0, base = 0; bool ok = ci < 50;
                if (ci >= 42) { i = 8 + (ci - 42); base = ci; } else if (ci >= 40) { i = 7; base = 40; } else if (ci >= 38) { i = 6; base = 38; } else if (ci >= 36) { i = 5; base = 36; }
                else if (ci >= 33) { i = 4; base = 33; } else if (ci >= 29) { i = 3; base = 29; } else if (ci >= 24) { i = 2; base = 24; } else if (ci >= 16) { i = 1; base = 16; }
                const int j = ci - base;
                unsigned kk = 0u;
                if (ok) { const float s0 = ord2f(TOP[(0 * 64 + t) * 16 + i] & ~127u), s1 = ord2f(TOP[(1 * 64 + t) * 16 + j] & ~127u);
                    kk = (f2ord(s0 + s1) & ~255u) | (unsigned)(255 - (i * 16 + j)); }
                ck[e] = kk;
            }
            unsigned w0 = 0u, w1 = 0u;
#pragma unroll 1
            for (int k = 0; k < 16; ++k) {
                unsigned m = umax_(umax_(umax_(ck[0], ck[1]), ck[2]), umax_(umax_(umax_(ck[3], ck[4]), ck[5]), ck[6]));
                m = umax_(m, (unsigned)DPPI_(m, 0xB1)); m = umax_(m, (unsigned)DPPI_(m, 0x4E)); m = umax_(m, (unsigned)DPPI_(m, 0x141));
#pragma unroll
                for (int e = 0; e < 7; ++e) ck[e] = (ck[e] == m) ? 0u : ck[e];
                if (k == sub) w0 = m; if (k == sub + 8) w1 = m;
            }
            const int f0 = 255 - (int)(w0 & 255u), f1 = 255 - (int)(w1 & 255u);
            const float sc0 = ord2f(w0 & ~255u), sc1 = ord2f(w1 & ~255u);
            float mx = fmaxf(sc0, sc1); mx = fmaxf(mx, DPP_(mx, 0xB1)); mx = fmaxf(mx, DPP_(mx, 0x4E)); mx = fmaxf(mx, DPP_(mx, 0x141));
            const float e0 = __expf(sc0 - mx), e1 = __expf(sc1 - mx);
            float sm = e0 + e1; sm += DPP_(sm, 0xB1); sm += DPP_(sm, 0x4E); sm += DPP_(sm, 0x141);
            const float inv = 1.0f / sm;
            const int i0 = 127 - (int)(TOP[(0 * 64 + t) * 16 + (f0 >> 4)] & 127u), j0 = 127 - (int)(TOP[(1 * 64 + t) * 16 + (f0 & 15)] & 127u);
            const int i1 = 127 - (int)(TOP[(0 * 64 + t) * 16 + (f1 >> 4)] & 127u), j1 = 127 - (int)(TOP[(1 * 64 + t) * 16 + (f1 & 15)] & 127u);
            unsigned short* ei = (unsigned short*)(ws + WS_EIDX) + ((t0 + t) * 8 + h) * 16; float* gp = (float*)(ws + WS_GATE) + ((t0 + t) * 8 + h) * 16;
            ei[sub] = (unsigned short)(i0 * 128 + j0); ei[sub + 8] = (unsigned short)(i1 * 128 + j1); gp[sub] = e0 * inv; gp[sub + 8] = e1 * inv;
        }
    }
    __syncthreads();
}

__device__ __forceinline__ void ins16(float (&v)[16], int (&id)[16], float x, int n) {
    if (x > v[15]) { v[15] = x; id[15] = n;
#pragma unroll
        for (int i = 15; i >= 1; --i) { if (v[i] > v[i - 1]) { const float tv = v[i]; v[i] = v[i - 1]; v[i - 1] = tv; const int ti = id[i]; id[i] = id[i - 1]; id[i - 1] = ti; } } }
}
__device__ __forceinline__ void phase_topk_ref(const DArgs& a, int vcu, int G) {
    const int tid = tid_();
    GAS unsigned char* ws = a.ws;
    const int gt = vcu * NTHR + tid, NGT = G * NTHR;
    for (int pair = gt; pair < T * 8; pair += NGT) {
        const int t = pair >> 3, h = pair & 7;
        float sv[2][16]; int si[2][16];
#pragma unroll
        for (int p = 0; p < 2; ++p) {
#pragma unroll
            for (int i = 0; i < 16; ++i) { sv[p][i] = -INFINITY; si[p][i] = 0; }
            const bf16_t* qp = (const bf16_t*)(ws + WS_QP) + (size_t)t * 2048 + h * 256 + p * 128;
            for (int n = 0; n < 128; ++n) {
                const bf16_t* kp = (const bf16_t*)(ws + WS_SK) + ((size_t)(h * 2 + p) * 128 + n) * 128;
                float s = 0.f;
                for (int c = 0; c < 128; c += 8) { const u32x4 qv = *(const u32x4*)(qp + c), kv = *(const u32x4*)(kp + c);
                    s += bf_lo(qv.x) * bf_lo(kv.x) + bf_hi(qv.x) * bf_hi(kv.x) + bf_lo(qv.y) * bf_lo(kv.y) + bf_hi(qv.y) * bf_hi(kv.y)
                       + bf_lo(qv.z) * bf_lo(kv.z) + bf_hi(qv.z) * bf_hi(kv.z) + bf_lo(qv.w) * bf_lo(kv.w) + bf_hi(qv.w) * bf_hi(kv.w); }
                ins16(sv[p], si[p], s, n);
            }
        }
        float tv[16]; int ti[16];
#pragma unroll
        for (int i = 0; i < 16; ++i) { tv[i] = -INFINITY; ti[i] = 0; }
#pragma unroll
        for (int i = 0; i < 16; ++i)
#pragma unroll
            for (int j = 0; j < 16; ++j) ins16(tv, ti, sv[0][i] + sv[1][j], i * 16 + j);
        float sm = 0.f, ex[16];
#pragma unroll
        for (int k = 0; k < 16; ++k) { ex[k] = __expf(tv[k] - tv[0]); sm += ex[k]; }
        int* ei = (int*)(ws + WS_EIDX) + (size_t)pair * 16; float* gp = (float*)(ws + WS_GATE) + (size_t)pair * 16;
#pragma unroll
        for (int k = 0; k < 16; ++k) {
            int e0 = 0, e1 = 0;
#pragma unroll
            for (int i = 0; i < 16; ++i) { e0 = ((ti[k] >> 4) == i) ? si[0][i] : e0; e1 = ((ti[k] & 15) == i) ? si[1][i] : e1; }
            ei[k] = e0 * 128 + e1; gp[k] = ex[k] / sm; }
    }
}

#define FP8LO(w) __builtin_amdgcn_cvt_pk_f32_fp8((int)(w), false)
#define FP8HI(w) __builtin_amdgcn_cvt_pk_f32_fp8((int)(w), true)
__device__ __forceinline__ float dot16_fp8(const u32x4 r, const float (&x)[16]) {
    float c = 0.f;
#pragma unroll
    for (int j = 0; j < 4; ++j) { const f32x2 lo = FP8LO(r[j]), hi = FP8HI(r[j]); c += lo[0] * x[4 * j] + lo[1] * x[4 * j + 1] + hi[0] * x[4 * j + 2] + hi[1] * x[4 * j + 3]; }
    return c;
}
__device__ __forceinline__ float dot16_fp8p(const u32x4 r, const f32x2 (&xp)[8]) {
    f32x2 c2 = (f32x2){0.f, 0.f};
#pragma unroll
    for (int j = 0; j < 4; ++j) { c2 += FP8LO(r[j]) * xp[2 * j]; c2 += FP8HI(r[j]) * xp[2 * j + 1]; }
    return c2[0] + c2[1];
}
__device__ __forceinline__ float gelu_erf(float d) {
    const float ad = fabsf(d), t = __builtin_amdgcn_rcpf(ad * 0.2316418882f + 1.0f);
    float q = t * 0.5307027145f + (-0.7265760135f); q = q * t + 0.7107068705f; q = q * t + (-0.142248368f); q = q * t + 0.127414796f; q = q * t;
    const float m = d * (q * __builtin_amdgcn_exp2f(d * d * (-0.72134752044f)));
    return d < 0.f ? m : d - m;
}
__device__ __forceinline__ float bperm(float v, int srclane) { return __builtin_bit_cast(float, __builtin_amdgcn_ds_bpermute(srclane << 2, __builtin_bit_cast(int, v))); }
#define SWZ_(v, pat) __builtin_bit_cast(float, __builtin_amdgcn_ds_swizzle(__builtin_bit_cast(int, (v)), (pat)))
__device__ __forceinline__ float rs32_(float a, float b) {
#if defined(__HIP_DEVICE_COMPILE__)
    asm volatile("s_nop 1\n\tv_permlane32_swap_b32 %0, %1" : "+v"(a), "+v"(b));
#endif
    return a + b;
}
__device__ __forceinline__ float rs16_(float a, float b) {
#if defined(__HIP_DEVICE_COMPILE__)
    asm volatile("s_nop 1\n\tv_permlane16_swap_b32 %0, %1" : "+v"(a), "+v"(b));
#endif
    return a + b;
}
__device__ __forceinline__ float rs8_(float a, float b, bool bit3) {
    const float send = bit3 ? a : b, keep = bit3 ? b : a;
    return keep + DPP_(send, 0x128);
}
__device__ __forceinline__ float xor32_(float v, bool hi) {
#if defined(__HIP_DEVICE_COMPILE__)
    const auto r = __builtin_amdgcn_permlane32_swap(__builtin_bit_cast(unsigned, v), __builtin_bit_cast(unsigned, v), false, false);
    return __builtin_bit_cast(float, hi ? r[0] : r[1]);
#else
    (void)hi; return v;
#endif
}
__device__ __forceinline__ float reduce8(const float (&p)[8], int lane) {
    float q4[4], q2[2];
    const bool b5 = lane & 32, b4 = lane & 16, b3 = lane & 8;
#pragma unroll
    for (int i = 0; i < 4; ++i) { const float send = b5 ? p[i] : p[i + 4], keep = b5 ? p[i + 4] : p[i]; q4[i] = keep + xor32_(send, b5); }
#pragma unroll
    for (int i = 0; i < 2; ++i) { const float send = b4 ? q4[i] : q4[i + 2], keep = b4 ? q4[i + 2] : q4[i]; q2[i] = keep + SWZ_(send, 0x401F); }
    const float send = b3 ? q2[0] : q2[1], keep = b3 ? q2[1] : q2[0];
    float q1 = keep + SWZ_(send, 0x201F);
    q1 += DPP_(q1, 0xB1); q1 += DPP_(q1, 0x4E); q1 += DPP_(q1, 0x141);
    return q1;
}
__device__ __forceinline__ void phase_udots(const DArgs& a, LAS unsigned char* lds) {
    const int tid = tid_(), lane = tid & 63, wave = __builtin_amdgcn_readfirstlane(tid >> 6);
    GAS unsigned char* ws = a.ws;
    volatile LAS unsigned* bst = (volatile LAS unsigned*)(lds + LDS_BARST);
    const int nloc = (int)bst[0], nx = (int)bst[1], rank = (int)bst[2];
    unsigned* bar = (unsigned*)(ws + WS_CTL) + CW_BAR;
    const unsigned myx = xb_xcc_id();
    int q = 0;
    for (unsigned j = 0; j < 16; ++j) { const unsigned c = xb_ld(&bar[XB_XCNT(j)]); if (c > 0u && j < myx) ++q; }
    LAS int* LE = (LAS int*)(lds + wave * 2048);
    LAS int* LP = LE + 128; LAS float* LG = (LAS float*)(LE + 256);
    const GAS unsigned char* UB = ws + WS_UB;
    const int g8 = lane >> 3;
    const float usc = ((const GAS float*)(ws + WS_USC))[0], vsc = ((const GAS float*)(ws + WS_USC))[1];
    for (int s = q; s < 8; s += nx) {
        int tok = rank * 8 + wave;
        u32x4 xq0 = (u32x4){0u, 0u, 0u, 0u}, xq1 = xq0; u32x2 e2 = (u32x2){0u, 0u}; f32x2 g2 = (f32x2){0.f, 0.f};
#define U_INFO(t_) do { xq0 = *(const u32x4*)((const GAS bf16_t*)(ws + WS_XN) + (size_t)(t_) * D + lane * 16); xq1 = *(const u32x4*)((const GAS bf16_t*)(ws + WS_XN) + (size_t)(t_) * D + lane * 16 + 8); \
        e2 = *(const u32x2*)((const GAS int*)(ws + WS_EIDX) + (size_t)(t_) * 128 + 2 * lane); g2 = *(const f32x2*)((const GAS float*)(ws + WS_GATE) + (size_t)(t_) * 128 + 2 * lane); } while (0)
        if (tok < T) U_INFO(tok);
        for (; tok < T; tok += nloc * 8) {
            const bool in0 = (int)(e2.x >> 11) == s, in1 = (int)(e2.y >> 11) == s;
            const unsigned long long m0 = __ballot(in0), m1 = __ballot(in1);
            const unsigned long long lt = (1ull << lane) - 1ull;
            const int n0 = __popcll(m0), n = n0 + __popcll(m1);
            if (in0) { const int pos = __popcll(m0 & lt); LE[pos] = (int)e2.x; LP[pos] = 2 * lane; LG[pos] = g2[0]; }
            if (in1) { const int pos = n0 + __popcll(m1 & lt); LE[pos] = (int)e2.y; LP[pos] = 2 * lane + 1; LG[pos] = g2[1]; }
            const float xf[16] = {bf_lo(xq0.x), bf_hi(xq0.x), bf_lo(xq0.y), bf_hi(xq0.y), bf_lo(xq0.z), bf_hi(xq0.z), bf_lo(xq0.w), bf_hi(xq0.w),
                                  bf_lo(xq1.x), bf_hi(xq1.x), bf_lo(xq1.y), bf_hi(xq1.y), bf_lo(xq1.z), bf_hi(xq1.z), bf_lo(xq1.w), bf_hi(xq1.w)};
            asm volatile("s_waitcnt lgkmcnt(0)" ::: "memory");
            u32x4 R0[8], R1[8], R2[8];
#define U_ISSUE(R_, g0_) do { _Pragma("unroll") for (int k = 0; k < 8; ++k) { const int slot_ = ((g0_) + k < n) ? (g0_) + k : n - 1; const int e_ = LE[slot_]; R_[k] = *(const u32x4*)(UB + (size_t)e_ * 1024 + lane * 16); } } while (0)
#define U_DOTS(R_, g0_) do { float pp_[8]; _Pragma("unroll") for (int k = 0; k < 8; ++k) pp_[k] = dot16_fp8(R_[k], xf); const float dsum_ = reduce8(pp_, lane); const int slot_ = (g0_) + g8; \
            if (slot_ < n && (lane & 7) == 0) { const float d_ = dsum_ * usc; \
                ((GAS float*)(ws + WS_PW))[(size_t)tok * 128 + LP[slot_]] = 0.5f * d_ * (1.0f + erff(d_ * 0.70710678118654752f)) * LG[slot_] * vsc; } } while (0)
            if (n > 0) U_ISSUE(R0, 0);
            if (n > 8) U_ISSUE(R1, 8);
            if (n > 16) U_ISSUE(R2, 16);
            const int tokN = tok + nloc * 8;
            if (tokN < T) U_INFO(tokN);
            if (n > 0) U_DOTS(R0, 0);
            if (n > 8) U_DOTS(R1, 8);
            if (n > 16) U_DOTS(R2, 16);
            for (int g0 = 24; g0 < n; g0 += 8) { U_ISSUE(R0, g0); U_DOTS(R0, g0); }
            asm volatile("s_waitcnt lgkmcnt(0)" ::: "memory");
        }
#undef U_INFO
#undef U_ISSUE
#undef U_DOTS
    }
}

#define EV_OFF(ev_, g_) (((g_) & 1) ? ((ev_[(g_) >> 3][((g_) >> 1) & 3] >> 9) & 0x7fff80u) : ((ev_[(g_) >> 3][((g_) >> 1) & 3] << 7) & 0x7fff80u))
struct XcdSlice { int nloc, nx, rank, q; };
__device__ __forceinline__ XcdSlice xcd_slice_setup(const DArgs& a, LAS unsigned char* lds) {
    volatile LAS unsigned* bst = (volatile LAS unsigned*)(lds + LDS_BARST);
    XcdSlice x; x.nloc = __builtin_amdgcn_readfirstlane((int)bst[0]); x.nx = __builtin_amdgcn_readfirstlane((int)bst[1]); x.rank = __builtin_amdgcn_readfirstlane((int)bst[2]);
    unsigned* bar = (unsigned*)(a.ws + WS_CTL) + CW_BAR; const unsigned myx = xb_xcc_id();
    x.q = 0; for (unsigned j = 0; j < 16; ++j) { const unsigned c = xb_ld(&bar[XB_XCNT(j)]); if (c > 0u && j < myx) ++x.q; }
    x.q = __builtin_amdgcn_readfirstlane(x.q);
    return x;
}
__device__ __forceinline__ void phase_ua(const DArgs& a, LAS unsigned char* lds) {
    const int tid = tid_(), lane = tid & 63, wave = __builtin_amdgcn_readfirstlane(tid >> 6), k = lane >> 3, c = lane & 7;
    GAS unsigned char* ws = a.ws;
    const XcdSlice X = xcd_slice_setup(a, lds);
    const int tstride = X.nloc * 8;
    for (int sl = X.q; sl < 8; sl += X.nx) {
        const GAS unsigned char* UBs = ws + WS_UB + (size_t)sl * 2097152;
        const unsigned coff = (unsigned)c * 16u;
        GAS unsigned char* PU = ws + WS_PARTU + (size_t)sl * T * 256;
        u32x4 evA[2], evB[2], RA[16], RB[16], xa, xb; float sa, sb;
#define A_TOK(t_) ((t_) < T ? (t_) : T - 1)
#define A_INFO(ev_, t_) do { const int tq_ = A_TOK(t_); _Pragma("unroll") for (int j_ = 0; j_ < 2; ++j_) ev_[j_] = *(const GAS u32x4*)(ws + WS_EIDX + (size_t)tq_ * 256 + (unsigned)(32 * k + 16 * j_)); } while (0)
#define A_ISSUE(R_, x_, s_, ev_, t_) do { const int tq_ = A_TOK(t_); _Pragma("unroll") for (int g_ = 0; g_ < 16; ++g_) R_[g_] = *(const GAS u32x4*)(UBs + (EV_OFF(ev_, g_) | coff)); \
        x_ = *(const GAS u32x4*)(ws + WS_XQ + (size_t)tq_ * 1024 + sl * 128 + coff); s_ = ((const GAS float*)(ws + WS_XQS))[tq_]; } while (0)
#define A_DOTS(R_, x_, s_, t_) do { \
        int ir0_ = 0, ir1_ = 0; \
        _Pragma("unroll") for (int gg_ = 0; gg_ < 4; ++gg_) {           \
            int d_[4]; _Pragma("unroll") for (int q_ = 0; q_ < 4; ++q_) d_[q_] = 0; \
            _Pragma("unroll") for (int j_ = 0; j_ < 4; ++j_) { _Pragma("unroll") for (int q_ = 0; q_ < 4; ++q_) d_[q_] = __builtin_amdgcn_sdot4((int)R_[4 * gg_ + q_][j_], (int)x_[j_], d_[q_], false); } \
            _Pragma("unroll") for (int q_ = 0; q_ < 4; ++q_) d_[q_] += DPPI_(d_[q_], 0xB1); \
            _Pragma("unroll") for (int q_ = 0; q_ < 4; ++q_) d_[q_] += DPPI_(d_[q_], 0x4E); \
            _Pragma("unroll") for (int q_ = 0; q_ < 4; ++q_) d_[q_] += DPPI_(d_[q_], 0x141);          \
            _Pragma("unroll") for (int q_ = 0; q_ < 4; ++q_) { if (c == ((4 * gg_ + q_) >> 1)) { if (q_ & 1) ir1_ = d_[q_]; else ir0_ = d_[q_]; } }          \
            __builtin_amdgcn_sched_barrier(0); } \
        if ((t_) < T) *(GAS unsigned*)(PU + (size_t)(t_) * 256 + (unsigned)(4 * lane)) = pk2((float)ir0_ * s_, (float)ir1_ * s_); } while (0)
        const int n0 = X.rank * 8 + wave;
        A_INFO(evA, n0); A_INFO(evB, n0 + tstride);
        __builtin_amdgcn_sched_barrier(0);
        A_ISSUE(RA, xa, sa, evA, n0);
        __builtin_amdgcn_sched_barrier(0);
#pragma unroll 1
        for (int n = n0; n < T; n += 2 * tstride) {
            A_INFO(evA, n + 2 * tstride);
            __builtin_amdgcn_sched_barrier(0);
            A_ISSUE(RB, xb, sb, evB, n + tstride);
            __builtin_amdgcn_sched_barrier(0);
            A_DOTS(RA, xa, sa, n);
            __builtin_amdgcn_sched_barrier(0);
            A_INFO(evB, n + 3 * tstride);
            __builtin_amdgcn_sched_barrier(0);
            A_ISSUE(RA, xa, sa, evA, n + 2 * tstride);
            __builtin_amdgcn_sched_barrier(0);
            A_DOTS(RB, xb, sb, n + tstride);
            __builtin_amdgcn_sched_barrier(0);
        }
#undef A_TOK
#undef A_INFO
#undef A_ISSUE
#undef A_DOTS
    }
}
__device__ __forceinline__ void phase_ua2(const DArgs& a, int vcu, int G) {
    const int tid = tid_();
    GAS unsigned char* ws = a.ws;
    const GAS float* USC = (const GAS float*)(ws + WS_USC); const GAS float* VSC = (const GAS float*)(ws + WS_VSC);
    const GAS unsigned char* PU = ws + WS_PARTU;
    const size_t N4 = (size_t)T * 128 / 4, stride = (size_t)G * NTHR;
    for (size_t i = (size_t)vcu * NTHR + tid; i < N4; i += 2 * stride) {
        const size_t i1 = (i + stride < N4) ? i + stride : i;
        u32x2 pv0[8], pv1[8];
#pragma unroll
        for (int sl = 0; sl < 8; ++sl) { pv0[sl] = ((const GAS u32x2*)(PU + (size_t)sl * T * 256))[i]; pv1[sl] = ((const GAS u32x2*)(PU + (size_t)sl * T * 256))[i1]; }
        const f32x4 gt0 = ((const GAS f32x4*)(ws + WS_GATE))[i], gt1 = ((const GAS f32x4*)(ws + WS_GATE))[i1];
        const u32x2 ep0 = ((const GAS u32x2*)(ws + WS_EIDX))[i], ep1 = ((const GAS u32x2*)(ws + WS_EIDX))[i1];
        const unsigned e0[4] = {ep0.x & 0xffffu, ep0.x >> 16, ep0.y & 0xffffu, ep0.y >> 16}, e1[4] = {ep1.x & 0xffffu, ep1.x >> 16, ep1.y & 0xffffu, ep1.y >> 16};
        float us0[4], vs0[4], us1[4], vs1[4];
#pragma unroll
        for (int e = 0; e < 4; ++e) { us0[e] = USC[e0[e]]; vs0[e] = VSC[e0[e]]; us1[e] = USC[e1[e]]; vs1[e] = VSC[e1[e]]; }
        f32x4 d0 = (f32x4){0.f, 0.f, 0.f, 0.f}, d1 = d0;
#pragma unroll
        for (int sl = 0; sl < 8; ++sl) { d0[0] += bf_lo(pv0[sl].x); d0[1] += bf_hi(pv0[sl].x); d0[2] += bf_lo(pv0[sl].y); d0[3] += bf_hi(pv0[sl].y);
                                         d1[0] += bf_lo(pv1[sl].x); d1[1] += bf_hi(pv1[sl].x); d1[2] += bf_lo(pv1[sl].y); d1[3] += bf_hi(pv1[sl].y); }
        f32x4 w0, w1;
#pragma unroll
        for (int e = 0; e < 4; ++e) { w0[e] = gelu_erf(d0[e] * us0[e]) * gt0[e] * vs0[e]; w1[e] = gelu_erf(d1[e] * us1[e]) * gt1[e] * vs1[e]; }
        u32x2 wo; wo.x = pk2(w0[0], w0[1]); wo.y = pk2(w0[2], w0[3]); ((GAS u32x2*)(ws + WS_PW))[i] = wo;
        if (i + stride < N4) { wo.x = pk2(w1[0], w1[1]); wo.y = pk2(w1[2], w1[3]); ((GAS u32x2*)(ws + WS_PW))[i1] = wo; }
    }
}
__device__ __forceinline__ void phase_vb(const DArgs& a, LAS unsigned char* lds) {
    const int tid = tid_(), lane = tid & 63, wave = __builtin_amdgcn_readfirstlane(tid >> 6), k = lane >> 3, c = lane & 7;
    GAS unsigned char* ws = a.ws;
    const XcdSlice X = xcd_slice_setup(a, lds);
    const int tstride = X.nloc * 8;
    const bool bit3 = (lane & 8) != 0;
    for (int sl = X.q; sl < 8; sl += X.nx) {
        const GAS unsigned char* VBs = ws + WS_VB + (size_t)sl * 2097152;
        const unsigned coff = (unsigned)c * 16u;
        const unsigned xoff = (unsigned)(sl * 128 + c * 16 + 2 * k) * 4u;
        u32x4 evA[2], evB[2], RA[16], RB[16], wa[2], wb[2]; unsigned xa, xb;
#define B_TOK(t_) ((t_) < T ? (t_) : T - 1)
#define B_INFO(ev_, t_) do { const int tq_ = B_TOK(t_); _Pragma("unroll") for (int j_ = 0; j_ < 2; ++j_) ev_[j_] = *(const GAS u32x4*)(ws + WS_EIDX + (size_t)tq_ * 256 + (unsigned)(32 * k + 16 * j_)); } while (0)
#define B_ISSUE(R_, w_, x_, ev_, t_) do { const int tq_ = B_TOK(t_); _Pragma("unroll") for (int g_ = 0; g_ < 16; ++g_) R_[g_] = *(const GAS u32x4*)(VBs + (EV_OFF(ev_, g_) | coff)); \
        _Pragma("unroll") for (int j_ = 0; j_ < 2; ++j_) w_[j_] = *(const GAS u32x4*)(ws + WS_PW + (size_t)tq_ * 256 + (unsigned)(32 * k + 16 * j_)); \
        x_ = *(const GAS unsigned*)((const GAS unsigned char*)a.out + (size_t)tq_ * (D * 2) + (xoff >> 1)); } while (0)
#define B_DOTS(R_, w_, x_, t_) do { \
        f32x2 acc2_[8]; _Pragma("unroll") for (int e_ = 0; e_ < 8; ++e_) acc2_[e_] = (f32x2){0.f, 0.f}; \
        _Pragma("unroll") for (int g_ = 0; g_ < 16; ++g_) { const unsigned ww_ = w_[g_ >> 3][(g_ >> 1) & 3]; const float wk_ = (g_ & 1) ? bf_hi(ww_) : bf_lo(ww_); const f32x2 wp_ = (f32x2){wk_, wk_}; \
            _Pragma("unroll") for (int jj_ = 0; jj_ < 4; ++jj_) { acc2_[2 * jj_] += wp_ * FP8LO(R_[g_][jj_]); acc2_[2 * jj_ + 1] += wp_ * FP8HI(R_[g_][jj_]); } \
            if (g_ & 1) __builtin_amdgcn_sched_barrier(0); } \
        f32x2 w2_[4], x2_[2], y_; \
        _Pragma("unroll") for (int i_ = 0; i_ < 4; ++i_) { w2_[i_][0] = rs32_(acc2_[i_][0], acc2_[i_ + 4][0]); w2_[i_][1] = rs32_(acc2_[i_][1], acc2_[i_ + 4][1]); } \
        _Pragma("unroll") for (int i_ = 0; i_ < 2; ++i_) { x2_[i_][0] = rs16_(w2_[i_][0], w2_[i_ + 2][0]); x2_[i_][1] = rs16_(w2_[i_][1], w2_[i_ + 2][1]); } \
        y_[0] = rs8_(x2_[0][0], x2_[1][0], bit3) + bf_lo(x_); y_[1] = rs8_(x2_[0][1], x2_[1][1], bit3) + bf_hi(x_); \
        const float ss_ = wave_sum(y_[0] * y_[0] + y_[1] * y_[1], lane); \
        if ((t_) < T) { *(GAS unsigned*)(ws + WS_PARTU + (size_t)(t_) * (D * 2) + (xoff >> 1)) = pk2(y_[0], y_[1]);       \
            if (lane == 0) ((GAS float*)(ws + WS_SS))[(size_t)(t_) * 8 + sl] = ss_; } } while (0)
        const int n0 = X.rank * 8 + wave;
        B_INFO(evA, n0); B_INFO(evB, n0 + tstride);
        __builtin_amdgcn_sched_barrier(0);
        B_ISSUE(RA, wa, xa, evA, n0);
        __builtin_amdgcn_sched_barrier(0);
#pragma unroll 1
        for (int n = n0; n < T; n += 2 * tstride) {
            B_INFO(evA, n + 2 * tstride);
            __builtin_amdgcn_sched_barrier(0);
            B_ISSUE(RB, wb, xb, evB, n + tstride);
            __builtin_amdgcn_sched_barrier(0);
            B_DOTS(RA, wa, xa, n);
            __builtin_amdgcn_sched_barrier(0);
            B_INFO(evB, n + 3 * tstride);
            __builtin_amdgcn_sched_barrier(0);
            B_ISSUE(RA, wa, xa, evA, n + 2 * tstride);
            __builtin_amdgcn_sched_barrier(0);
            B_DOTS(RB, wb, xb, n + tstride);
            __builtin_amdgcn_sched_barrier(0);
        }
#undef B_TOK
#undef B_INFO
#undef B_ISSUE
#undef B_DOTS
    }
}
__device__ __forceinline__ void phase_vc(const DArgs& a, int vcu, int G) {
    const int tid = tid_(), lane = tid & 63, wave = tid >> 6;
    const int gw = vcu * NWAVES + wave, NGW = G * NWAVES;
    GAS unsigned char* ws = a.ws;
    f32x4 gf[4];
#pragma unroll
    for (int j = 0; j < 4; ++j) gf[j] = ((const GAS f32x4*)a.final_g)[64 * j + lane];
    for (int m = gw; m < T; m += NGW) {
        const f32x4 s0 = *(const GAS f32x4*)((const GAS float*)(ws + WS_SS) + (size_t)m * 8), s1 = *(const GAS f32x4*)((const GAS float*)(ws + WS_SS) + (size_t)m * 8 + 4);
        const float rstd = rsqrtf(((s0[0] + s0[1]) + (s0[2] + s0[3]) + (s1[0] + s1[1]) + (s1[2] + s1[3])) * (1.f / D) + EPS);
        const GAS u32x2* xi = (const GAS u32x2*)(ws + WS_PARTU + (size_t)m * (D * 2)) + lane;
        GAS f32x4* o = (GAS f32x4*)(a.out + (size_t)m * D) + lane;
#pragma unroll
        for (int j = 0; j < 4; ++j) { const u32x2 xv = xi[64 * j]; f32x4 v; v[0] = bf_lo(xv.x); v[1] = bf_hi(xv.x); v[2] = bf_lo(xv.y); v[3] = bf_hi(xv.y); o[64 * j] = v * rstd * gf[j]; }
    }
}

__device__ __forceinline__ void phase_final_plain(const DArgs& a, const float* src, int vcu, int G) {
    const int tid = tid_(), lane = tid & 63, wave = tid >> 6;
    const int gw = vcu * NWAVES + wave, NGW = G * NWAVES;
    f32x4 gf[4];
#pragma unroll
    for (int j = 0; j < 4; ++j) gf[j] = ((const f32x4*)a.final_g)[64 * j + lane];
    for (int m = gw; m < T; m += NGW) {
        const f32x4* xr = (const f32x4*)(src + (size_t)m * D) + lane;
        f32x4 v[4]; float s = 0.f;
#pragma unroll
        for (int j = 0; j < 4; ++j) { v[j] = xr[64 * j]; s += (v[j][0] * v[j][0] + v[j][1] * v[j][1]) + (v[j][2] * v[j][2] + v[j][3] * v[j][3]); }
        const float rstd = rsqrtf(wave_sum(s, lane) * (1.f / D) + EPS);
        f32x4* o = (f32x4*)(a.out + (size_t)m * D) + lane;
#pragma unroll
        for (int j = 0; j < 4; ++j) o[64 * j] = v[j] * rstd * gf[j];
    }
}


__device__ __forceinline__ DArgs load_args() {
    DArgs r;
#if defined(__HIP_DEVICE_COMPILE__)
    typedef const DArgs __attribute__((address_space(4))) KArgs;
    KArgs* p = (KArgs*)__builtin_amdgcn_kernarg_segment_ptr();
    asm volatile("" : "+s"(p));
    r.x = p->x; r.norm1_g = p->norm1_g; r.w_in = p->w_in; r.b_in = p->b_in; r.conv_w = p->conv_w; r.conv_b = p->conv_b; r.m_head_g = p->m_head_g; r.lb_table = p->lb_table;
    r.g_head_g = p->g_head_g; r.w_br_m = p->w_br_m; r.w_br_g = p->w_br_g; r.w_out = p->w_out; r.norm2_g = p->norm2_g; r.w_pq = p->w_pq; r.sub_keys = p->sub_keys;
    r.u_emb = p->u_emb; r.v_emb = p->v_emb; r.final_g = p->final_g; r.out = p->out; r.ws = p->ws;
#else
    r = DArgs{};
#endif
    return r;
}
__device__ __forceinline__ EpiPtrs make_ep(const DArgs& a, int round) {
    EpiPtrs ep; ep.biasp = (const GAS float*)(a.ws + WS_BIASP); ep.lb = (const GAS float*)(a.ws + WS_LB); ep.x = a.x; ep.out = a.out; ep.ws = a.ws; ep.round = round; return ep;
}
#define GRID_SYNC() do { const DArgs a_ = load_args(); xcd_barrier((unsigned*)(a_.ws + WS_CTL) + CW_BAR, (volatile LAS unsigned*)(lds + LDS_BARST)); } while (0)

__device__ __forceinline__ int bx_() { int t = blockIdx.x; asm volatile("" : "+s"(t)); return t; }
__device__ __forceinline__ int gd_() { int t = gridDim.x; asm volatile("" : "+s"(t)); return t; }
#define PH_BEGIN const DArgs a = load_args(); const int bx = bx_(), G = gd_(); const int vcu = (G % 8 == 0) ? (bx % 8) * (G / 8) + bx / 8 : bx; (void)vcu; (void)bx;

__global__ void __launch_bounds__(NTHR, 2) fwd_megakernel(Args a_unused) {
    extern __shared__ __attribute__((aligned(16))) unsigned char lds_raw[];
    LAS unsigned char* lds = (LAS unsigned char*)lds_raw;
    cg::grid_group grid = cg::this_grid();

    { const int t_ = tid_(); if (t_ < 16) ((LAS unsigned*)(lds + LDS_BARST))[t_] = 0u; __syncthreads();
      const DArgs a_ = load_args(); xcd_barrier_post((unsigned*)(a_.ws + WS_CTL) + CW_BAR, (volatile LAS unsigned*)(lds + LDS_BARST)); }
    { PH_BEGIN phase_p0(a, lds, vcu, G); }
    grid.sync();
#pragma unroll 1
    for (int round = 0; round < NROUND; ++round) {
        {
            PH_BEGIN
            pg8::Gemm g{(const bf16_t*)(a.ws + WS_XN) + (size_t)round * RT * D, (const bf16_t*)(a.ws + WS_WIN), RT, N1, D};
            pg8::StaticOrder S; S.init(RT, N1, G, bx);
            EpiX<1> E{make_ep(a, round)};
            pg8::gemm_phase<EpiX<1>, pg8::StaticOrder, true, true>(lds, g, S, E);
        }
        { PH_BEGIN if (bx < 8) mscan_pair(a, lds, round, bx); }
        GRID_SYNC();
        { PH_BEGIN for (int it = bx; it < 512; it += G) mlstm_pre_item(a, lds, round, it); }
        { PH_BEGIN u32x4 gq[4]; int it = bx; if (it < 2048) hgrn_pre_load(a, round, it, gq);
          for (; it < 2048; it += G) hgrn_pre_item(a, lds, round, it, gq, it + G); }
        GRID_SYNC();
        { PH_BEGIN
          if (bx < 128) mlstm_scan<2, false>(a, lds, round, bx & 7, bx >> 3);
          else if (bx >= 192 && bx < 200) mlstm_scan<1, true>(a, lds, round, bx - 192, 0);
          else if (bx < 192) { const int id2 = bx - 128; hgrn_scan(a, lds, round, (id2 & 7) * 2 + ((id2 >> 3) & 1), id2 >> 4); } }
        GRID_SYNC();
        {
            PH_BEGIN
            pg8::Gemm g{(const bf16_t*)(a.ws + WS_XN) + (size_t)round * RT * D, (const bf16_t*)(a.ws + WS_WIN) + (size_t)N1 * D, RT, N2, D};
            pg8::StaticOrder S; S.init(RT, N2, G, bx);
            EpiX<2> E{make_ep(a, round)};
            pg8::gemm_phase<EpiX<2>, pg8::StaticOrder, true, true>(lds, g, S, E);
        }
        GRID_SYNC();
        { PH_BEGIN phase_ypass(a, round, vcu, G); }
        GRID_SYNC();
        {
            { PH_BEGIN pg8::StaticOrder S; S.init(RT, D, G, bx);
              pg8::Gemm g{(const bf16_t*)(a.ws + WS_V), (const bf16_t*)(a.ws + WS_WM), RT, D, 2048}; EpiX<3> E{make_ep(a, round)}; pg8::gemm_phase<EpiX<3>, pg8::StaticOrder, true, true>(lds, g, S, E); }
            { PH_BEGIN pg8::StaticOrder S; S.init(RT, D, G, bx);
              pg8::Gemm g{(const bf16_t*)(a.ws + WS_GI), (const bf16_t*)(a.ws + WS_WG), RT, D, D}; EpiX<4> E{make_ep(a, round)}; pg8::gemm_phase<EpiX<4>, pg8::StaticOrder, true, true>(lds, g, S, E); }
        }
        GRID_SYNC();
        {
            PH_BEGIN pg8::StaticOrder S; S.init(RT, D, G, bx);
            pg8::Gemm g{(const bf16_t*)(a.ws + WS_GFLOG), (const bf16_t*)(a.ws + WS_WO), RT, D, D}; EpiX<5> E{make_ep(a, round)}; pg8::gemm_phase<EpiX<5>, pg8::StaticOrder, true, true>(lds, g, S, E);
        }
        GRID_SYNC();
    }
    { PH_BEGIN phase_p8(a, vcu, G); }
    GRID_SYNC();
    {
        PH_BEGIN pg8::StaticOrder S; S.init(T, 2048, G, bx);
        pg8::Gemm g{(const bf16_t*)(a.ws + WS_XN), (const bf16_t*)(a.ws + WS_WPQ), T, 2048, D}; EpiX<6> E{make_ep(a, 0)}; pg8::gemm_phase<EpiX<6>, pg8::StaticOrder, true, true>(lds, g, S, E);
    }
    GRID_SYNC();
#ifdef TOPK_REF
    { PH_BEGIN phase_topk_ref(a, vcu, G); }
#else
    { PH_BEGIN phase_topk(a, lds, bx, G); }
#endif
    GRID_SYNC();
    { PH_BEGIN phase_ua(a, lds); }
    GRID_SYNC();
    { PH_BEGIN phase_ua2(a, vcu, G); }
    GRID_SYNC();
    { PH_BEGIN phase_vb(a, lds); }
    GRID_SYNC();
    { PH_BEGIN phase_vc(a, vcu, G); }
}

extern "C" void kernel_launch(void* const* d_in, const int* in_sizes, int n_in, void* d_out, int out_size, void* d_ws, size_t ws_size, hipStream_t stream) {
    static int grid = 0;
    if (grid == 0) {
        if (n_in != 18 || in_sizes[0] != T * D || out_size != T * D || ws_size < WS_END) {
            fprintf(stderr, "kernel_launch: unexpected shapes/workspace (n_in %d, in0 %d, out %d, ws %zu, need %zu)\n", n_in, n_in > 0 ? in_sizes[0] : -1, out_size, ws_size, (size_t)WS_END);
            grid = -1; return; }
        int dev = 0, cus = 0, per_cu = 0;
        hipGetDevice(&dev);
        hipDeviceGetAttribute(&cus, hipDeviceAttributeMultiprocessorCount, dev);
        hipFuncSetAttribute((const void*)fwd_megakernel, hipFuncAttributeMaxDynamicSharedMemorySize, LDS_BYTES);
        hipOccupancyMaxActiveBlocksPerMultiprocessor(&per_cu, (const void*)fwd_megakernel, NTHR, LDS_BYTES);
        if (per_cu < 1) { fprintf(stderr, "kernel_launch: occupancy query says %d blocks/CU\n", per_cu); per_cu = 1; }
        grid = cus;
        (void)hipGetLastError();
    }
    if (grid < 0) return;
    hipMemsetAsync((char*)d_ws + WS_CTL, 0, 65536, stream);
    Args a{};
    a.x = (const float*)d_in[0]; a.norm1_g = (const float*)d_in[1]; a.w_in = (const float*)d_in[2]; a.b_in = (const float*)d_in[3];
    a.conv_w = (const float*)d_in[4]; a.conv_b = (const float*)d_in[5]; a.m_head_g = (const float*)d_in[6]; a.lb_table = (const float*)d_in[7];
    a.g_head_g = (const float*)d_in[8]; a.w_br_m = (const float*)d_in[9]; a.w_br_g = (const float*)d_in[10]; a.w_out = (const float*)d_in[11];
    a.norm2_g = (const float*)d_in[12]; a.w_pq = (const float*)d_in[13]; a.sub_keys = (const float*)d_in[14]; a.u_emb = (const float*)d_in[15];
    a.v_emb = (const float*)d_in[16]; a.final_g = (const float*)d_in[17];
    a.out = (float*)d_out; a.ws = (unsigned char*)d_ws;
    void* args[] = {&a};
    hipError_t e = hipLaunchCooperativeKernel((const void*)fwd_megakernel, dim3(grid), dim3(NTHR), args, LDS_BYTES, stream);
    if (e != hipSuccess) fprintf(stderr, "cooperative launch failed: %s (grid %d)\n", hipGetErrorString(e), grid);
}
```

```cpp
#include <hip/hip_runtime.h>
#include <hip/hip_cooperative_groups.h>
#include <cstdio>
#include <cstdint>
namespace cg = cooperative_groups;

#define LAS __attribute__((address_space(3)))
typedef unsigned short bf16_t;
typedef short bf16x8 __attribute__((ext_vector_type(8)));
typedef float f32x4 __attribute__((ext_vector_type(4)));
typedef float f32x2 __attribute__((ext_vector_type(2)));
typedef unsigned u32x4 __attribute__((ext_vector_type(4)));
typedef unsigned u32x2 __attribute__((ext_vector_type(2)));

constexpr int D = 1024, BATCH = 4, SEQ = 8192, T = BATCH * SEQ;
constexpr int IN_COLS = 12296, NP = 12288;
constexpr int RT = 16384, NROUND = 2;
constexpr int N1 = 7168, N2 = 5120;
constexpr float EPS = 1e-6f;
constexpr int NWAVES = 8, NTHR = 512;

constexpr size_t MiB = 1u << 20;
constexpr size_t WS_CTL = 0;
constexpr size_t WS_WIN = 1 * MiB;
constexpr size_t WS_WM = 25 * MiB;
constexpr size_t WS_WG = 29 * MiB;
constexpr size_t WS_WO = 31 * MiB;
constexpr size_t WS_WPQ = 33 * MiB;
constexpr size_t WS_SK = 37 * MiB;
constexpr size_t WS_BIASP = 37 * MiB + 512 * 1024;
constexpr size_t WS_LB = WS_BIASP + 64 * 1024;
constexpr size_t WS_GATES = 38 * MiB;
constexpr size_t WS_MPREV = 39 * MiB;
constexpr size_t WS_DEN = 40 * MiB;
constexpr size_t WS_MT = 40 * MiB + 512 * 1024;
constexpr size_t WS_HGDEC = 41 * MiB;
constexpr size_t WS_MDEC = 43 * MiB;
constexpr size_t WS_XN = 44 * MiB;
constexpr size_t WS_QKPRE = 108 * MiB;
constexpr size_t WS_V = 172 * MiB;
constexpr size_t WS_GFLOG = 236 * MiB;
constexpr size_t WS_GI = 268 * MiB;
constexpr size_t WS_GQ = 300 * MiB;
constexpr size_t WS_S = 332 * MiB;
constexpr size_t WS_QT = 348 * MiB;
constexpr size_t WS_KWT = 380 * MiB;
constexpr size_t WS_ATT = 412 * MiB;
constexpr size_t WS_QTG = 428 * MiB;
constexpr size_t WS_KENDT = 460 * MiB;
constexpr size_t WS_SIGO = 332 * MiB;
constexpr size_t WS_SGG = 396 * MiB;
constexpr size_t WS_SAM = 428 * MiB;
constexpr size_t WS_SAG = 460 * MiB;
constexpr size_t WS_XN8 = 492 * MiB;
constexpr size_t WS_SA8 = 508 * MiB;
constexpr size_t WS_SB8 = 508 * MiB + 262144;
constexpr size_t WS_W8A = WS_WIN;
constexpr size_t WS_W8 = WS_WIN + (size_t)7168 * 1024 * 2;
constexpr int NI8 = 4096 + 5120;
constexpr int CW_COLMAX = 16384;
constexpr size_t WS_END = 510 * MiB;
constexpr size_t WS_QP = 108 * MiB;
constexpr size_t WS_UB = 236 * MiB;
constexpr size_t WS_VB = 252 * MiB;
constexpr size_t WS_USC = 268 * MiB;
constexpr size_t WS_VSC = 268 * MiB + 65536;
constexpr size_t WS_EIDX = 300 * MiB;
constexpr size_t WS_GATE = 316 * MiB;
constexpr size_t WS_XQ = 380 * MiB;
constexpr size_t WS_XQS = 412 * MiB;
constexpr size_t WS_PARTU = 108 * MiB;
constexpr size_t WS_SS = 348 * MiB;
constexpr size_t WS_PW = 332 * MiB;

constexpr int CW_TMAX = 64;
constexpr int LDS_BYTES = 147456;

__device__ __forceinline__ unsigned f2bf(float f) { unsigned u = __builtin_bit_cast(unsigned, f); return (u + 0x7fffu + ((u >> 16) & 1u)) >> 16; }
typedef __bf16 bf16x2_t __attribute__((ext_vector_type(2)));
__device__ __forceinline__ unsigned pk2(float lo, float hi) { bf16x2_t v; v[0] = (__bf16)lo; v[1] = (__bf16)hi; return __builtin_bit_cast(unsigned, v); }
__device__ __forceinline__ float bf_lo(unsigned w) { return __builtin_bit_cast(float, w << 16); }
__device__ __forceinline__ float bf_hi(unsigned w) { return __builtin_bit_cast(float, w & 0xffff0000u); }
__device__ __forceinline__ float bf2f(bf16_t h) { return __builtin_bit_cast(float, ((unsigned)h) << 16); }
__device__ __forceinline__ float shx(float v, int o, int lane) { return __builtin_bit_cast(float, __builtin_amdgcn_ds_bpermute((lane ^ o) << 2, __builtin_bit_cast(int, v))); }
__device__ __forceinline__ float shup(float v, int o, int lane) { return __builtin_bit_cast(float, __builtin_amdgcn_ds_bpermute(((lane - o) & 63) << 2, __builtin_bit_cast(int, v))); }
__device__ __forceinline__ float rdlane(float v, int l) { return __builtin_bit_cast(float, __builtin_amdgcn_readlane(__builtin_bit_cast(int, v), l)); }
#define DPP_(v, ctrl) __builtin_bit_cast(float, __builtin_amdgcn_update_dpp(0, __builtin_bit_cast(int, (v)), (ctrl), 0xF, 0xF, false))
__device__ __forceinline__ float wave_sum(float v, int lane) {
    (void)lane;
    v += DPP_(v, 0xB1); v += DPP_(v, 0x4E); v += DPP_(v, 0x141); v += DPP_(v, 0x140);
    return (rdlane(v, 0) + rdlane(v, 16)) + (rdlane(v, 32) + rdlane(v, 48));
}
__device__ __forceinline__ float wave_max(float v) {
    v = fmaxf(v, DPP_(v, 0xB1)); v = fmaxf(v, DPP_(v, 0x4E)); v = fmaxf(v, DPP_(v, 0x141)); v = fmaxf(v, DPP_(v, 0x140));
    return fmaxf(fmaxf(rdlane(v, 0), rdlane(v, 16)), fmaxf(rdlane(v, 32), rdlane(v, 48)));
}
__device__ __forceinline__ unsigned pack_i8x4(float a, float b, float c, float d) {
    const int ia = (int)__builtin_rintf(a), ib = (int)__builtin_rintf(b), ic = (int)__builtin_rintf(c), id = (int)__builtin_rintf(d);
    return ((unsigned)ia & 255u) | (((unsigned)ib & 255u) << 8) | (((unsigned)ic & 255u) << 16) | ((unsigned)id << 24);
}
#define SWZI_(v, pat) __builtin_amdgcn_ds_swizzle((int)(v), (pat))
#define DPPI_(v, ctrl) __builtin_amdgcn_update_dpp(0, (int)(v), (ctrl), 0xF, 0xF, false)
__device__ __forceinline__ unsigned xor32u_(unsigned v, bool hi) {
#if defined(__HIP_DEVICE_COMPILE__)
    const auto r = __builtin_amdgcn_permlane32_swap(v, v, false, false);
    return hi ? r[0] : r[1];
#else
    (void)hi; return v;
#endif
}
__device__ __forceinline__ float sigmoidf_(float x) { return __builtin_amdgcn_rcpf(1.0f + __expf(-x)); }
__device__ __forceinline__ float siluf_(float x) { return x * __builtin_amdgcn_rcpf(1.0f + __expf(-x)); }
#define LDS_WAIT() asm volatile("s_waitcnt lgkmcnt(0)" ::: "memory")
__device__ __forceinline__ int tid_() { int t = threadIdx.x; asm volatile("" : "+v"(t)); return t; }

#define GAS __attribute__((address_space(1)))
struct DArgs {
    const GAS float* x; const GAS float* norm1_g; const GAS float* w_in; const GAS float* b_in; const GAS float* conv_w; const GAS float* conv_b;
    const GAS float* m_head_g; const GAS float* lb_table; const GAS float* g_head_g; const GAS float* w_br_m; const GAS float* w_br_g; const GAS float* w_out;
    const GAS float* norm2_g; const GAS float* w_pq; const GAS float* sub_keys; const GAS float* u_emb; const GAS float* v_emb; const GAS float* final_g;
    GAS float* out; GAS unsigned char* ws;
};
struct Args {
    const float* x; const float* norm1_g; const float* w_in; const float* b_in; const float* conv_w; const float* conv_b;
    const float* m_head_g; const float* lb_table; const float* g_head_g; const float* w_br_m; const float* w_br_g; const float* w_out;
    const float* norm2_g; const float* w_pq; const float* sub_keys; const float* u_emb; const float* v_emb; const float* final_g;
    float* out; unsigned char* ws;
};

namespace pg8 {
constexpr int BM = 256, BK = 64, HALF = 128, HTB = HALF * BK * 2, STAGE_BYTES = 8 * HTB, NXCD = 8, WGM = 8;
__host__ __device__ __forceinline__ int lds_byte(int r, int c) { const int st = (r >> 4) * 2 + (c >> 5), rr = r & 15, cc = c & 31, ob = rr * 64 + cc * 2; return st * 1024 + (ob ^ (((ob >> 9) & 1) << 5)); }
__host__ __device__ __forceinline__ void stage_rc(int b, int& R, int& C) { const int st = b / 1024, sb = b % 1024, swz = sb ^ (((sb >> 9) & 1) << 5); R = (st >> 1) * 16 + swz / 64; C = (st & 1) * 32 + (swz % 64) / 2; }
__host__ __device__ __forceinline__ int perm32(int rho) { const int n = rho >> 4, i = rho & 15; return 8 * (i >> 2) + 4 * n + (i & 3); }
struct Unit { int pm, pn; };
struct Gemm { const bf16_t* A; const bf16_t* Bt; int M, N, K; };
struct StaticOrder {
    int nM, nN, nwg, G, c;
    __host__ __device__ void init(int M, int N, int G_, int c_) { nM = M / BM; nN = N / BM; nwg = nM * nN; G = G_; c = c_; }
    __host__ __device__ bool next(int i, Unit& u) const {
        const long L = (long)i * G + c; if (L >= nwg) return false;
        int wgid = (int)L; { const int q = nwg / NXCD, r = nwg % NXCD, xcd = wgid % NXCD, off = wgid / NXCD; wgid = (xcd < r ? xcd * (q + 1) : r * (q + 1) + (xcd - r) * q) + off; }
        const int nig = WGM * nN, gid = wgid / nig, fm = gid * WGM, gsz = (nM - fm) < WGM ? (nM - fm) : WGM;
        u.pm = fm + ((wgid % nig) % gsz); u.pn = (wgid % nig) / gsz; return true;
    }
    __device__ __forceinline__ void a_ready(const Unit&) const {}
    __device__ __forceinline__ void done(const Unit&) const {}
};

typedef int i32x8 __attribute__((ext_vector_type(8)));
typedef int i32x4 __attribute__((ext_vector_type(4)));
template <class Epi, class Sched, bool ALIGN_EPI = false, bool SP2 = false, bool I8 = false>
__device__ __forceinline__ void gemm_phase(LAS unsigned char* lds, const Gemm g, const Sched& S, const Epi& E) {
    const int tid = tid_(), wid = __builtin_amdgcn_readfirstlane(tid >> 6), lane = tid & 63, wr = wid >> 2, wc = wid & 3, fr = lane & 15, fq = lane >> 4;
    const int K = g.K, nt = K / BK;
    unsigned voffA[2], voffB[2];
#pragma unroll
    for (int i = 0; i < 2; ++i) { int R, C; stage_rc(tid * 16 + i * 8192, R, C); const int Rb = Epi::PERM ? ((R & ~31) + perm32(R & 31)) : R;
        voffA[i] = (unsigned)(R * K + C) * 2u; voffB[i] = (unsigned)(Rb * K + C) * 2u; }
    const size_t kstep = (size_t)(BK * 2);
    const size_t hstep = (size_t)HALF * K * 2;
    const size_t tstep = 2 * hstep;
    const unsigned ldsw = (unsigned)wid * 1024u;
    const int aoff = lds_byte(wr * 64 + fr, fq * 8), boff = lds_byte(wc * 32 + fr, fq * 8);
#define PG8_SA(b, h) (((b) * 2 + (h)) * HTB)
#define PG8_SB(b, h) ((4 + (b) * 2 + (h)) * HTB)
#define PG8_STAGE(bufoff, gbase, voff) do { _Pragma("unroll") for (int _i = 0; _i < 2; ++_i) \
        __builtin_amdgcn_global_load_lds((const unsigned*)((const char*)(gbase) + (voff)[_i]), (LAS unsigned*)(lds + (bufoff) + ldsw + _i * 8192), 16, 0, 0); } while (0)
#define PG8_LDA(dst, b, h) do { _Pragma("unroll") for (int m = 0; m < 4; ++m) _Pragma("unroll") for (int k = 0; k < 2; ++k) dst[m][k] = *(const LAS bf16x8*)(lds + PG8_SA(b, h) + aoff + m * 2048 + k * 1024); } while (0)
#define PG8_LDB(dst, b, h) do { _Pragma("unroll") for (int n = 0; n < 2; ++n) _Pragma("unroll") for (int k = 0; k < 2; ++k) dst[n][k] = *(const LAS bf16x8*)(lds + PG8_SB(b, h) + boff + n * 2048 + k * 1024); } while (0)
#define PG8_MMA(ai, bj, At, Bt) do { __builtin_amdgcn_s_setprio(1); _Pragma("unroll") for (int m = 0; m < 4; ++m) _Pragma("unroll") for (int n = 0; n < 2; ++n) _Pragma("unroll") for (int k = 0; k < 2; ++k) { \
        if constexpr (I8) acc[ai][bj][m][n] = __builtin_bit_cast(f32x4, __builtin_amdgcn_mfma_i32_16x16x64_i8(__builtin_bit_cast(i32x4, Bt[n][k]), __builtin_bit_cast(i32x4, At[m][k]), __builtin_bit_cast(i32x4, acc[ai][bj][m][n]), 0, 0, 0)); \
        else acc[ai][bj][m][n] = __builtin_amdgcn_mfma_f32_16x16x32_bf16(Bt[n][k], At[m][k], acc[ai][bj][m][n], 0, 0, 0); } __builtin_amdgcn_s_setprio(0); } while (0)
#define PG8_WAIT_V(n) asm volatile("s_waitcnt vmcnt(" #n ")" ::: "memory")
#define PG8_WAIT_L(n) asm volatile("s_waitcnt lgkmcnt(" #n ")" ::: "memory")
#define PG8_BAR __builtin_amdgcn_s_barrier()
#define PG8_SCHED __builtin_amdgcn_sched_barrier(0)
    Unit cur, nxt; int ui = 0;
    if (!S.next(0, cur)) return;
    f32x4 acc[2][2][4][2];
#pragma unroll
    for (int a = 0; a < 2; ++a)
#pragma unroll
        for (int b = 0; b < 2; ++b)
#pragma unroll
            for (int m = 0; m < 4; ++m)
#pragma unroll
                for (int n = 0; n < 2; ++n) acc[a][b][m][n] = (f32x4){0.f, 0.f, 0.f, 0.f};
    bf16x8 At[4][2], B0[2][2], B1[2][2];
    const char* cA = (const char*)g.A + (size_t)cur.pm * tstep; const char* cB = (const char*)g.Bt + (size_t)cur.pn * tstep;
    S.a_ready(cur);
    if constexpr (SP2) {
        PG8_STAGE(PG8_SB(0, 0), cB, voffB); PG8_STAGE(PG8_SB(0, 1), cB + hstep, voffB); PG8_STAGE(PG8_SA(0, 0), cA, voffA); PG8_STAGE(PG8_SA(0, 1), cA + hstep, voffA);
        if (wr == 1) PG8_BAR;
        PG8_WAIT_V(2); PG8_BAR;
        PG8_STAGE(PG8_SB(1, 0), cB + kstep, voffB); PG8_STAGE(PG8_SA(1, 0), cA + kstep, voffA); PG8_STAGE(PG8_SB(1, 1), cB + hstep + kstep, voffB);
        PG8_WAIT_V(6); PG8_BAR;
    } else {
        PG8_STAGE(PG8_SB(0, 0), cB, voffB); PG8_STAGE(PG8_SA(0, 0), cA, voffA); PG8_STAGE(PG8_SB(0, 1), cB + hstep, voffB); PG8_STAGE(PG8_SA(0, 1), cA + hstep, voffA);
        if (wr == 1) PG8_BAR;
        PG8_WAIT_V(4); PG8_BAR;
        PG8_STAGE(PG8_SB(1, 0), cB + kstep, voffB); PG8_STAGE(PG8_SA(1, 0), cA + kstep, voffA); PG8_STAGE(PG8_SB(1, 1), cB + hstep + kstep, voffB);
        PG8_WAIT_V(6); PG8_BAR;
    }
    for (;;) {
        const bool has_next = S.next(ui + 1, nxt);
        const char* nA = has_next ? (const char*)g.A + (size_t)nxt.pm * tstep : cA; const char* nB = has_next ? (const char*)g.Bt + (size_t)nxt.pn * tstep : cB;
#pragma unroll 1
        for (int t = 0; t < nt; t += 2) {
            const bool last = (t == nt - 2);
            const char* a1 = cA + (size_t)(t + 1) * kstep;
            const char* a2 = last ? nA : cA + (size_t)(t + 2) * kstep; const char* b2 = last ? nB : cB + (size_t)(t + 2) * kstep;
            const char* a3 = a2 + kstep; const char* b3 = b2 + kstep;
            if (last && has_next) S.a_ready(nxt);
            if constexpr (SP2) {
            PG8_LDB(B0, 0, 0); PG8_LDB(B1, 0, 1); PG8_SCHED; PG8_LDA(At, 0, 0); PG8_STAGE(PG8_SA(1, 1), a1 + hstep, voffA);
            PG8_WAIT_V(8); PG8_WAIT_L(0); PG8_BAR; PG8_MMA(0, 0, At, B0); PG8_MMA(0, 1, At, B1); PG8_BAR; PG8_SCHED;
            PG8_LDA(At, 0, 1); PG8_STAGE(PG8_SB(0, 0), b2, voffB); PG8_STAGE(PG8_SB(0, 1), b2 + hstep, voffB); PG8_STAGE(PG8_SA(0, 0), a2, voffA);
            PG8_WAIT_V(8); PG8_WAIT_L(0); PG8_BAR; PG8_MMA(1, 0, At, B0); PG8_MMA(1, 1, At, B1); PG8_BAR; PG8_SCHED;
            PG8_LDB(B0, 1, 0); PG8_LDB(B1, 1, 1); PG8_SCHED; PG8_LDA(At, 1, 0); PG8_STAGE(PG8_SA(0, 1), a2 + hstep, voffA);
            PG8_WAIT_V(8); PG8_WAIT_L(0); PG8_BAR; PG8_MMA(0, 0, At, B0); PG8_MMA(0, 1, At, B1); PG8_BAR; PG8_SCHED;
            PG8_LDA(At, 1, 1); PG8_STAGE(PG8_SB(1, 0), b3, voffB); PG8_STAGE(PG8_SB(1, 1), b3 + hstep, voffB); PG8_STAGE(PG8_SA(1, 0), a3, voffA);
            PG8_WAIT_V(8); PG8_WAIT_L(0); PG8_BAR; PG8_MMA(1, 0, At, B0); PG8_MMA(1, 1, At, B1); PG8_BAR; PG8_SCHED;
            } else {
            PG8_LDB(B0, 0, 0); PG8_SCHED; PG8_LDA(At, 0, 0); PG8_STAGE(PG8_SA(1, 1), a1 + hstep, voffA);
            PG8_WAIT_L(8); PG8_BAR; PG8_WAIT_L(0); PG8_MMA(0, 0, At, B0); PG8_BAR; PG8_SCHED;
            PG8_LDB(B1, 0, 1); PG8_STAGE(PG8_SB(0, 0), b2, voffB);
            PG8_BAR; PG8_WAIT_L(0); PG8_MMA(0, 1, At, B1); PG8_BAR;
            PG8_LDA(At, 0, 1); PG8_STAGE(PG8_SA(0, 0), a2, voffA);
            PG8_BAR; PG8_WAIT_L(0); PG8_MMA(1, 0, At, B0); PG8_BAR; PG8_SCHED;
            PG8_STAGE(PG8_SB(0, 1), b2 + hstep, voffB);
            PG8_WAIT_V(6); PG8_BAR; PG8_MMA(1, 1, At, B1); PG8_BAR;
            PG8_LDB(B0, 1, 0); PG8_SCHED; PG8_LDA(At, 1, 0); PG8_STAGE(PG8_SA(0, 1), a2 + hstep, voffA);
            PG8_WAIT_L(8); PG8_BAR; PG8_WAIT_L(0); PG8_MMA(0, 0, At, B0); PG8_BAR; PG8_SCHED;
            PG8_LDB(B1, 1, 1); PG8_STAGE(PG8_SB(1, 0), b3, voffB);
            PG8_BAR; PG8_WAIT_L(0); PG8_MMA(0, 1, At, B1); PG8_BAR;
            PG8_LDA(At, 1, 1); PG8_STAGE(PG8_SA(1, 0), a3, voffA);
            PG8_BAR; PG8_WAIT_L(0); PG8_MMA(1, 0, At, B0); PG8_BAR; PG8_SCHED;
            PG8_STAGE(PG8_SB(1, 1), b3 + hstep, voffB);
            PG8_WAIT_V(6); PG8_BAR; PG8_MMA(1, 1, At, B1); PG8_BAR;
            }
        }
        if constexpr (ALIGN_EPI) { if (wr == 0) PG8_BAR; }
        E(acc, cur, wr, wc, fr, fq);
        if (!has_next) break;
#pragma unroll
        for (int a = 0; a < 2; ++a)
#pragma unroll
            for (int b = 0; b < 2; ++b)
#pragma unroll
                for (int m = 0; m < 4; ++m)
#pragma unroll
                    for (int n = 0; n < 2; ++n) acc[a][b][m][n] = (f32x4){0.f, 0.f, 0.f, 0.f};
        cur = nxt; cA = nA; cB = nB; ++ui;
        if constexpr (ALIGN_EPI) { if (wr == 1) PG8_BAR; }
    }
    PG8_WAIT_V(0);
    if constexpr (!ALIGN_EPI) { if (wr == 0) PG8_BAR; }
    PG8_BAR;
#undef PG8_SA
#undef PG8_SB
#undef PG8_STAGE
#undef PG8_LDA
#undef PG8_LDB
#undef PG8_MMA
#undef PG8_WAIT_V
#undef PG8_WAIT_L
#undef PG8_BAR
#undef PG8_SCHED
}
}

typedef int i32x4q __attribute__((ext_vector_type(4)));
struct EpiPtrs {
    const GAS float* biasp; const GAS float* lb; const GAS float* x; GAS float* out; GAS unsigned char* ws; int round;
    const GAS float* sa; const GAS float* sb;
};
template <int MODE> struct EpiX {
    static constexpr bool PERM = true, AFTER_DRAIN = false;
    EpiPtrs P;
    __device__ __forceinline__ void operator()(const f32x4 (&acc)[2][2][4][2], const pg8::Unit& u, int wr, int wc, int fr, int fq) const {
        const int upn = u.pn + (MODE == 1 ? 16 : 0);
        const int row0 = u.pm * 256 + wr * 64 + fr;
        const int colt = upn * 256 + wc * 32 + 8 * fq;
        GAS unsigned char* ws = P.ws;
        bf16_t* dst = nullptr; int ld = 0, coff = 0, act = 0; const GAS float* bias = nullptr;
        if (MODE == 1 || MODE == 7) {
            bias = P.biasp;
            if (upn < 8) { dst = (bf16_t*)(ws + WS_QKPRE); ld = 2048; coff = 0; act = 0; }
            else if (upn < 16) { dst = (bf16_t*)(ws + WS_V); ld = 2048; coff = 2048; act = 0; }
            else if (upn < 20) { dst = (bf16_t*)(ws + WS_GFLOG); ld = 1024; coff = 4096; act = 3; }
            else if (upn < 24) { dst = (bf16_t*)(ws + WS_GI); ld = 1024; coff = 5120; act = 0; }
            else { dst = (bf16_t*)(ws + WS_GQ); ld = 1024; coff = 6144; act = 2; }
        } else if (MODE == 2) {
            bias = P.biasp + N1;
            if (u.pn < 8) { dst = (bf16_t*)(ws + WS_SIGO); ld = 2048; coff = 0; act = 1; }
            else if (u.pn < 12) { dst = (bf16_t*)(ws + WS_SGG); ld = 1024; coff = 2048; act = 2; }
            else if (u.pn < 16) { dst = (bf16_t*)(ws + WS_SAM); ld = 1024; coff = 3072; act = 1; }
            else { dst = (bf16_t*)(ws + WS_SAG); ld = 1024; coff = 4096; act = 1; }
        } else if (MODE == 6) { dst = (bf16_t*)(ws + WS_QP); ld = 2048; coff = 0; act = 0; }
#pragma unroll
        for (int bj = 0; bj < 2; ++bj) {
            const int col = colt + bj * 128;
            f32x4 b0 = (f32x4){0.f, 0.f, 0.f, 0.f}, b1 = b0, l0 = b0, l1 = b0;
            if (MODE == 1 || MODE == 2 || MODE == 7) { b0 = *(const f32x4*)(bias + col); b1 = *(const f32x4*)(bias + col + 4); }
            f32x4 s0 = (f32x4){1.f, 1.f, 1.f, 1.f}, s1 = s0;
            if (MODE == 2) { s0 = *(const GAS f32x4*)(P.sb + 4096 + col); s1 = *(const GAS f32x4*)(P.sb + 4096 + col + 4); }
            if (MODE == 7) { s0 = *(const GAS f32x4*)(P.sb + col); s1 = *(const GAS f32x4*)(P.sb + col + 4); }
            if (MODE == 1) { if (act == 3) { l0 = *(const f32x4*)(P.lb + (col - coff)); l1 = *(const f32x4*)(P.lb + (col - coff) + 4); } }
#pragma unroll
            for (int ai = 0; ai < 2; ++ai)
#pragma unroll
                for (int m = 0; m < 4; ++m) {
                    const int row = row0 + ai * 128 + m * 16;
                    f32x4 v0, v1;
                    if (MODE == 2 || MODE == 7) { const float sr = P.sa[(size_t)P.round * RT + row]; const i32x4q q0 = __builtin_bit_cast(i32x4q, acc[ai][bj][m][0]), q1 = __builtin_bit_cast(i32x4q, acc[ai][bj][m][1]);
                        v0 = (f32x4){(float)q0[0], (float)q0[1], (float)q0[2], (float)q0[3]} * (s0 * sr) + b0; v1 = (f32x4){(float)q1[0], (float)q1[1], (float)q1[2], (float)q1[3]} * (s1 * sr) + b1; }
                    else { v0 = acc[ai][bj][m][0] + b0; v1 = acc[ai][bj][m][1] + b1; }
                    if (MODE == 1 || MODE == 2 || MODE == 6 || MODE == 7) {
                        if (act == 1) {
#pragma unroll
                            for (int j = 0; j < 4; ++j) { v0[j] = sigmoidf_(v0[j]); v1[j] = sigmoidf_(v1[j]); }
                        } else if (act == 2) {
#pragma unroll
                            for (int j = 0; j < 4; ++j) { v0[j] = siluf_(v0[j]); v1[j] = siluf_(v1[j]); }
                        } else if (act == 3) {
#pragma unroll
                            for (int j = 0; j < 4; ++j) { v0[j] = __logf(l0[j] + (1.0f - l0[j]) * sigmoidf_(v0[j])); v1[j] = __logf(l1[j] + (1.0f - l1[j]) * sigmoidf_(v1[j])); }
                        }
                        u32x4 w; w.x = pk2(v0[0], v0[1]); w.y = pk2(v0[2], v0[3]); w.z = pk2(v1[0], v1[1]); w.w = pk2(v1[2], v1[3]);
                        *(u32x4*)(dst + (size_t)row * ld + (col - coff)) = w;
                    } else if (MODE == 3) {
                        const u32x4 g = *(const u32x4*)((const bf16_t*)(ws + WS_SAM) + (size_t)row * 1024 + col);
                        GAS bf16_t* o = (GAS bf16_t*)P.out + (size_t)T * 1024 + ((size_t)P.round * RT + row) * 1024 + col;
                        f32x4 r0, r1;
                        r0[0] = v0[0] * bf_lo(g.x); r0[1] = v0[1] * bf_hi(g.x); r0[2] = v0[2] * bf_lo(g.y); r0[3] = v0[3] * bf_hi(g.y);
                        r1[0] = v1[0] * bf_lo(g.z); r1[1] = v1[1] * bf_hi(g.z); r1[2] = v1[2] * bf_lo(g.w); r1[3] = v1[3] * bf_hi(g.w);
                        u32x4 w; w.x = pk2(r0[0], r0[1]); w.y = pk2(r0[2], r0[3]); w.z = pk2(r1[0], r1[1]); w.w = pk2(r1[2], r1[3]);
                        *(GAS u32x4*)o = w;
                    } else if (MODE == 4) {
                        const u32x4 g = *(const u32x4*)((const bf16_t*)(ws + WS_SAG) + (size_t)row * 1024 + col);
                        const u32x4 zv = *(const GAS u32x4*)((const GAS bf16_t*)P.out + (size_t)T * 1024 + ((size_t)P.round * RT + row) * 1024 + col);
                        const f32x4 p0 = (f32x4){bf_lo(zv.x), bf_hi(zv.x), bf_lo(zv.y), bf_hi(zv.y)}, p1 = (f32x4){bf_lo(zv.z), bf_hi(zv.z), bf_lo(zv.w), bf_hi(zv.w)};
                        f32x4 r0, r1;
                        r0[0] = p0[0] + v0[0] * bf_lo(g.x); r0[1] = p0[1] + v0[1] * bf_hi(g.x); r0[2] = p0[2] + v0[2] * bf_lo(g.y); r0[3] = p0[3] + v0[3] * bf_hi(g.y);
                        r1[0] = p1[0] + v1[0] * bf_lo(g.z); r1[1] = p1[1] + v1[1] * bf_hi(g.z); r1[2] = p1[2] + v1[2] * bf_lo(g.w); r1[3] = p1[3] + v1[3] * bf_hi(g.w);
                        u32x4 w; w.x = pk2(r0[0], r0[1]); w.y = pk2(r0[2], r0[3]); w.z = pk2(r1[0], r1[1]); w.w = pk2(r1[2], r1[3]);
                        *(u32x4*)((bf16_t*)(ws + WS_GFLOG) + (size_t)row * 1024 + col) = w;
                    } else if (MODE == 5) {
                        const size_t off = ((size_t)P.round * RT + row) * 1024 + col;
                        const f32x4 x0 = *(const f32x4*)(P.x + off) + v0, x1 = *(const f32x4*)(P.x + off + 4) + v1;
                        u32x4 w; w.x = pk2(x0[0], x0[1]); w.y = pk2(x0[2], x0[3]); w.z = pk2(x1[0], x1[1]); w.w = pk2(x1[2], x1[3]);
                        *(GAS u32x4*)((GAS bf16_t*)P.out + off) = w;
                    }
                }
        }
    }
};

__device__ __forceinline__ void p0_transpose_item(const GAS float* W, int ldw, int K, int k0, int scol, GAS bf16_t* WT, int drow, LAS float* scr, int lane) {
#pragma unroll 8
    for (int i = 0; i < 32; ++i) { const int kk = 2 * i + (lane >> 5); scr[kk * 33 + (lane & 31)] = W[(size_t)(k0 + kk) * ldw + scol + (lane & 31)]; }
    LDS_WAIT(); asm volatile("" ::: "memory");
    const int c = lane & 7;
#pragma unroll
    for (int j = 0; j < 4; ++j) { const int n = (lane >> 3) + 8 * j; const LAS float* s = scr + (8 * c) * 33 + n;
        u32x4 o; o.x = pk2(s[0 * 33], s[1 * 33]); o.y = pk2(s[2 * 33], s[3 * 33]); o.z = pk2(s[4 * 33], s[5 * 33]); o.w = pk2(s[6 * 33], s[7 * 33]);
        *(u32x4*)(WT + (size_t)(drow + n) * K + k0 + 8 * c) = o; }
    LDS_WAIT(); asm volatile("" ::: "memory");
}
__device__ __forceinline__ void p0_colmax_item(const GAS float* W, int ldw, int k0, int scol, GAS unsigned* colmax, int lane) {
    float mx = 0.f;
#pragma unroll 8
    for (int i = 0; i < 32; ++i) { const int kk = 2 * i + (lane >> 5); mx = fmaxf(mx, fabsf(W[(size_t)(k0 + kk) * ldw + scol + (lane & 31)])); }
    mx = fmaxf(mx, __builtin_bit_cast(float, xor32u_(__builtin_bit_cast(unsigned, mx), lane >= 32)));
    if (lane < 32) atomicMax((unsigned*)colmax + lane, __builtin_bit_cast(unsigned, mx));
}
__device__ __forceinline__ void p0_cvt8_item(const GAS float* W, int ldw, int k0, int scol, const GAS unsigned* colmax, GAS unsigned char* WT8, GAS float* sb, int drow, LAS float* scr, int lane) {
    const float cm = __builtin_bit_cast(float, colmax[lane & 31]);
    const float qs = cm > 0.f ? 127.0f / cm : 0.f;
    if (k0 == 0 && lane < 32) sb[lane] = cm * (1.0f / 127.0f);
#pragma unroll 8
    for (int i = 0; i < 32; ++i) { const int kk = 2 * i + (lane >> 5); scr[kk * 33 + (lane & 31)] = W[(size_t)(k0 + kk) * ldw + scol + (lane & 31)] * qs; }
    LDS_WAIT(); asm volatile("" ::: "memory");
    const int n = lane >> 1, kh = lane & 1;
    const LAS float* sp = scr + (kh * 32) * 33 + n;
    u32x4 o0, o1;
#pragma unroll
    for (int q = 0; q < 8; ++q) { const unsigned p = pack_i8x4(sp[(4 * q) * 33], sp[(4 * q + 1) * 33], sp[(4 * q + 2) * 33], sp[(4 * q + 3) * 33]);
        if (q < 4) o0[q] = p; else o1[q - 4] = p; }
    GAS unsigned char* dst = WT8 + (size_t)(drow + n) * 1024 + k0 + kh * 32;
    *(GAS u32x4*)dst = o0; *(GAS u32x4*)(dst + 16) = o1;
    LDS_WAIT(); asm volatile("" ::: "memory");
}
__device__ __forceinline__ int i8_cid_block(int nb) { return nb < 128 ? nb : (nb >= 224 ? nb - 96 : -1); }
__device__ __forceinline__ int win_src_col(int n) {
    if (n < 4096) return n;
    if (n < 7168) return n - 4096 + 6152;
    if (n < 9216) return n - 7168 + 4096;
    return n - 9216 + 9224;
}

__device__ __forceinline__ void phase_p0(const DArgs& a, LAS unsigned char* lds, int vcu, int G) {
    const int tid = tid_(), lane = tid & 63, wave = tid >> 6;
    const int gw = vcu * NWAVES + wave, NGW = G * NWAVES;
    GAS unsigned char* ws = a.ws;
    LAS float* scr = (LAS float*)(lds + wave * 16384);
    constexpr int I_IN = 16 * 384, I_M = 32 * 32, I_G = 16 * 32, I_O = 16 * 32, I_PQ = 16 * 64;
    constexpr int NITEMS = I_IN + I_M + I_G + I_O + I_PQ;
    for (int it = gw; it < NITEMS; it += NGW) {
        int r = it;
        if (r < I_IN) { const int kb = r / 384, nb = r % 384; const int cb = i8_cid_block(nb);
            if (cb < 0) p0_transpose_item(a.w_in, IN_COLS, 1024, kb * 64, win_src_col(nb * 32), (GAS bf16_t*)(ws + WS_WIN), nb * 32, scr, lane);
            else p0_colmax_item(a.w_in, IN_COLS, kb * 64, win_src_col(nb * 32), (GAS unsigned*)(ws + WS_CTL) + CW_COLMAX + cb * 32, lane);
            continue; } r -= I_IN;
        if (r < I_M) { const int kb = r / 32, nb = r % 32; p0_transpose_item(a.w_br_m, 1024, 2048, kb * 64, nb * 32, (GAS bf16_t*)(ws + WS_WM), nb * 32, scr, lane); continue; } r -= I_M;
        if (r < I_G) { const int kb = r / 32, nb = r % 32; p0_transpose_item(a.w_br_g, 1024, 1024, kb * 64, nb * 32, (GAS bf16_t*)(ws + WS_WG), nb * 32, scr, lane); continue; } r -= I_G;
        if (r < I_O) { const int kb = r / 32, nb = r % 32; p0_transpose_item(a.w_out, 1024, 1024, kb * 64, nb * 32, (GAS bf16_t*)(ws + WS_WO), nb * 32, scr, lane); continue; } r -= I_O;
        { const int kb = r / 64, nb = r % 64; p0_transpose_item(a.w_pq, 2048, 1024, kb * 64, nb * 32, (GAS bf16_t*)(ws + WS_WPQ), nb * 32, scr, lane); }
    }
    const int gt = vcu * NTHR + tid, NGT = G * NTHR;
    for (int i = gt; i < NP; i += NGT) ((float*)(ws + WS_BIASP))[i] = a.b_in[win_src_col(i)];
    for (int i = gt; i < 1024; i += NGT) { const float t0 = a.lb_table[i], t1 = a.lb_table[1024 + i]; ((float*)(ws + WS_LB))[i] = 1.0f / (1.0f + __expf(t1 - t0)); }
    for (int i = gt; i < 8 * 2 * 128 * 128 / 4; i += NGT) { const f32x4 v = ((const f32x4*)a.sub_keys)[i]; u32x2 o; o.x = pk2(v[0], v[1]); o.y = pk2(v[2], v[3]); ((u32x2*)(ws + WS_SK))[i] = o; }
    f32x4 g1[4];
#pragma unroll
    for (int j = 0; j < 4; ++j) g1[j] = ((const GAS f32x4*)a.norm1_g)[64 * j + lane];
    f32x4 gw0[16], gw1[16];
#pragma unroll
    for (int j = 0; j < 4; ++j)
#pragma unroll
        for (int e = 0; e < 4; ++e) { const int k = 256 * j + 4 * lane + e; gw0[4 * j + e] = *(const GAS f32x4*)(a.w_in + (size_t)k * IN_COLS + 6144); gw1[4 * j + e] = *(const GAS f32x4*)(a.w_in + (size_t)k * IN_COLS + 6148); }
    const float gbias = lane < 8 ? a.b_in[6144 + lane] : 0.f;
    for (int m = gw; m < T; m += NGW) {
        const GAS f32x4* xr = (const GAS f32x4*)(a.x + (size_t)m * D) + lane;
        f32x4 v[4]; float s = 0.f;
#pragma unroll
        for (int j = 0; j < 4; ++j) { v[j] = xr[64 * j]; s += (v[j][0] * v[j][0] + v[j][1] * v[j][1]) + (v[j][2] * v[j][2] + v[j][3] * v[j][3]); }
        const float rstd = rsqrtf(wave_sum(s, lane) * (1.f / D) + EPS);
        GAS unsigned long long* o8 = (GAS unsigned long long*)((GAS bf16_t*)(ws + WS_XN) + (size_t)m * D) + lane;
        f32x4 ga0 = (f32x4){0.f, 0.f, 0.f, 0.f}, ga1 = ga0;
#pragma unroll
        for (int j = 0; j < 4; ++j) {
            v[j] = v[j] * rstd * g1[j];
            o8[64 * j] = (unsigned long long)pk2(v[j][0], v[j][1]) | ((unsigned long long)pk2(v[j][2], v[j][3]) << 32);
#pragma unroll
            for (int e = 0; e < 4; ++e) { ga0 += gw0[4 * j + e] * v[j][e]; ga1 += gw1[4 * j + e] * v[j][e]; }
        }
        if (m < RT) {
            float mx = 0.f;
#pragma unroll
            for (int jq = 0; jq < 4; ++jq) mx = fmaxf(mx, fmaxf(fmaxf(fabsf(v[jq][0]), fabsf(v[jq][1])), fmaxf(fabsf(v[jq][2]), fabsf(v[jq][3]))));
            mx = wave_max(mx);
            const float qs = mx > 0.f ? 127.0f / mx : 0.f;
#pragma unroll
            for (int jq = 0; jq < 4; ++jq) ((GAS unsigned*)(ws + WS_XN8 + (size_t)m * 1024))[64 * jq + lane] = pack_i8x4(v[jq][0] * qs, v[jq][1] * qs, v[jq][2] * qs, v[jq][3] * qs);
            if (lane == 0) ((GAS float*)(ws + WS_SA8))[m] = mx * (1.0f / 127.0f);
        }
        float ga[8] = {ga0[0], ga0[1], ga0[2], ga0[3], ga1[0], ga1[1], ga1[2], ga1[3]};
#pragma unroll
        for (int q = 0; q < 8; ++q) ga[q] = wave_sum(ga[q], lane);
        if (lane < 8) { float r = ga[0];
#pragma unroll
            for (int q = 1; q < 8; ++q) r = (lane == q) ? ga[q] : r;
            ((GAS float*)(ws + WS_GATES))[(size_t)m * 8 + lane] = r + gbias; }
    }
}

__device__ __forceinline__ float logsigf_(float x) { return fminf(x, 0.f) - log1pf(__expf(-fabsf(x))); }
#define LDS_BAR() do { asm volatile("s_waitcnt lgkmcnt(0)" ::: "memory"); __builtin_amdgcn_s_barrier(); asm volatile("" ::: "memory"); } while (0)
#define MFMA16(a, b, c) __builtin_amdgcn_mfma_f32_16x16x32_bf16((a), (b), (c), 0, 0, 0)
__device__ __forceinline__ bf16x8 lfrag(const LAS unsigned char* base, int pitch, int row, int k0, int fq) { return *(const LAS bf16x8*)(base + row * pitch + (k0 + 8 * fq) * 2); }
__device__ __forceinline__ int fm_off(int r, int k, int KB) { return (((r >> 4) * KB + (k >> 5)) << 10) + (((((k >> 3) & 3) << 4) + (r & 15)) << 4) + ((k & 7) << 1); }
__device__ __forceinline__ bf16x8 gfrag(const bf16_t* base, int ld, int row, int k0, int fq) { return *(const bf16x8*)(base + (size_t)row * ld + k0 + 8 * fq); }

__device__ __forceinline__ void phase_p0c(const DArgs& a, LAS unsigned char* lds, int vcu, int G) {
    const int tid = tid_(), lane = tid & 63, wave = tid >> 6;
    const int gw = vcu * NWAVES + wave, NGW = G * NWAVES;
    GAS unsigned char* ws = a.ws;
    LAS float* scr = (LAS float*)(lds + wave * 16384);
    for (int it = gw; it < 16 * (NI8 / 32); it += NGW) {
        const int kb = it / (NI8 / 32), cb = it % (NI8 / 32), nb = cb < 128 ? cb : cb + 96;
        GAS unsigned char* dst = cb < 128 ? ws + WS_W8A : ws + WS_W8; const int drow = (cb < 128 ? cb : cb - 128) * 32;
        p0_cvt8_item(a.w_in, IN_COLS, kb * 64, win_src_col(nb * 32), (const GAS unsigned*)(ws + WS_CTL) + CW_COLMAX + cb * 32, dst, (GAS float*)(ws + WS_SB8) + cb * 32, drow, scr, lane);
    }
}
__device__ __forceinline__ void mscan_pair(const DArgs& a, LAS unsigned char* lds, int round, int p) {
    const int tid = tid_(), lane = tid & 63, part = tid >> 6;
    const int bl = p >> 2, h = p & 3, b = round * 2 + bl;
    const GAS float* g = (const GAS float*)(a.ws + WS_GATES) + ((size_t)b * SEQ + (size_t)lane * 128 + part * 16) * 8;
    float bsum = 0.f, gm = -INFINITY;
#pragma unroll 4
    for (int s = 0; s < 16; ++s) { const float ip = g[s * 8 + h], fp = g[s * 8 + 4 + h]; bsum += logsigf_(fp); gm = fmaxf(gm, ip - bsum); }
    LAS float* PS = (LAS float*)lds; LAS float* PM = PS + 512;
    PS[part * 64 + lane] = bsum; PM[part * 64 + lane] = gm;
    __syncthreads();
    if (tid < 64) {
        float bs = 0.f, g2 = -INFINITY;
#pragma unroll
        for (int q = 0; q < 8; ++q) { g2 = fmaxf(g2, PM[q * 64 + lane] - bs); bs += PS[q * 64 + lane]; }
        float mprev = 0.f, mine = 0.f;
        for (int c = 0; c < 64; ++c) {
            const float bc = rdlane(bs, c), gc = rdlane(g2, c);
            if (lane == c) mine = mprev; mprev = bc + fmaxf(mprev, gc); }
        ((GAS float*)(a.ws + WS_MPREV))[(round * 8 + p) * 64 + lane] = mine;
    }
    __syncthreads();
}

constexpr int PQ_PITCH = 528, PS_PITCH = 272;
__device__ __forceinline__ void mlstm_pre_item(const DArgs& a, LAS unsigned char* lds, int round, int item) {
    const int tid = tid_(), lane = tid & 63, wave = __builtin_amdgcn_readfirstlane(tid >> 6), fr = lane & 15, fq = lane >> 4;
    const int p = item >> 6, c = item & 63, bl = p >> 2, h = p & 3, b = round * 2 + bl;
    const int tl0 = bl * SEQ + c * 128; const size_t tg0 = (size_t)b * SEQ + c * 128;
    GAS unsigned char* ws = a.ws;
    LAS unsigned char* QL = lds; LAS unsigned char* KL = lds + 67584;
    LAS float* AS = (LAS float*)(lds + 135168); LAS float* MS = AS + 128; LAS float* SC = AS + 256;
    if (wave == 0) {
        const float mprev = ((const float*)(ws + WS_MPREV))[(round * 8 + p) * 64 + c];
        const float* g = (const float*)(ws + WS_GATES) + (tg0 + 2 * lane) * 8;
        const float ip0 = g[h], fp0 = g[4 + h], ip1 = g[8 + h], fp1 = g[12 + h];
        const float lf0 = logsigf_(fp0), lf1 = logsigf_(fp1), pp = lf0 + lf1;
        float incl = pp;
#pragma unroll
        for (int o = 1; o < 64; o <<= 1) { const float t = shup(incl, o, lane); if (lane >= o) incl += t; }
        const float excl = incl - pp, b0 = excl + lf0, b1 = incl;
        const float a0 = ip0 - b0, a1 = ip1 - b1;
        float inclm = fmaxf(a0, a1);
#pragma unroll
        for (int o = 1; o < 64; o <<= 1) { const float t = shup(inclm, o, lane); if (lane >= o) inclm = fmaxf(inclm, t); }
        float exclm = shup(inclm, 1, lane); if (lane == 0) exclm = -INFINITY;
        const float M0 = fmaxf(mprev, fmaxf(exclm, a0)), M1 = fmaxf(mprev, inclm);
        AS[2 * lane] = a0; AS[2 * lane + 1] = a1; MS[2 * lane] = M0; MS[2 * lane + 1] = M1;
        float* mt = (float*)(ws + WS_MT) + (tg0 + 2 * lane) * 4 + h;
        mt[0] = b0 + M0; mt[4] = b1 + M1;
        const float Mlast = rdlane(M1, 63);
        if (lane == 0) { SC[0] = mprev; SC[1] = Mlast; ((float*)(ws + WS_MDEC))[item] = __expf(mprev - Mlast); }
    }
    {
        const int cgp = tid & 63, strip = tid >> 6;
        const int col = (cgp < 32) ? (h * 256 + cgp * 8) : (1024 + h * 256 + (cgp - 32) * 8);
        float w[4][8], bb[8];
#pragma unroll
        for (int j = 0; j < 4; ++j) { const f32x4 w0 = *(const f32x4*)(a.conv_w + j * 2048 + col), w1 = *(const f32x4*)(a.conv_w + j * 2048 + col + 4);
#pragma unroll
            for (int e = 0; e < 4; ++e) { w[j][e] = w0[e]; w[j][4 + e] = w1[e]; } }
        { const f32x4 b0 = *(const f32x4*)(a.conv_b + col), b1 = *(const f32x4*)(a.conv_b + col + 4);
#pragma unroll
            for (int e = 0; e < 4; ++e) { bb[e] = b0[e]; bb[4 + e] = b1[e]; } }
        const bf16_t* src = (const bf16_t*)(ws + WS_QKPRE) + (size_t)(tl0 + 16 * strip) * 2048 + col;
        const float qs = (cgp < 32) ? 0.0625f : 1.0f;
        LAS unsigned char* dstt = ((cgp < 32) ? QL : KL) + (cgp & 31) * 16;
#pragma unroll 1
        for (int half = 0; half < 2; ++half) {
            u32x4 xr[11];
#pragma unroll
            for (int r = 0; r < 11; ++r) {
                const int sl = c * 128 + 16 * strip + 8 * half + r - 3;
                xr[r] = (sl >= 0) ? *(const u32x4*)(src + (ptrdiff_t)(8 * half + r - 3) * 2048) : (u32x4){0u, 0u, 0u, 0u};
            }
#pragma unroll
            for (int r = 0; r < 8; ++r) {
                float y[8];
#pragma unroll
                for (int e = 0; e < 8; ++e) y[e] = bb[e];
#pragma unroll
                for (int j = 0; j < 4; ++j) { const u32x4 xv = xr[r + j];
                    y[0] += w[j][0] * bf_lo(xv.x); y[1] += w[j][1] * bf_hi(xv.x); y[2] += w[j][2] * bf_lo(xv.y); y[3] += w[j][3] * bf_hi(xv.y);
                    y[4] += w[j][4] * bf_lo(xv.z); y[5] += w[j][5] * bf_hi(xv.z); y[6] += w[j][6] * bf_lo(xv.w); y[7] += w[j][7] * bf_hi(xv.w); }
#pragma unroll
                for (int e = 0; e < 8; ++e) y[e] = siluf_(y[e]) * qs;
                u32x4 o; o.x = pk2(y[0], y[1]); o.y = pk2(y[2], y[3]); o.z = pk2(y[4], y[5]); o.w = pk2(y[6], y[7]);
                *(LAS u32x4*)(dstt + (16 * strip + 8 * half + r) * PQ_PITCH) = o;
            }
        }
    }
    __syncthreads();
    const float mprev = SC[0], Mlast = SC[1];
    {
        bf16_t* Sg = (bf16_t*)(ws + WS_S) + (size_t)item * 128 * 128;
        const int t = wave * 16 + fr; const float Mt = MS[t];
        for (int st = 0; st < 8; ++st) {
            u32x2 o = (u32x2){0u, 0u};
            if (st <= wave) {
                f32x4 acc = (f32x4){0.f, 0.f, 0.f, 0.f};
#pragma unroll
                for (int ks = 0; ks < 8; ++ks) acc = MFMA16(lfrag(KL, PQ_PITCH, st * 16 + fr, ks * 32, fq), lfrag(QL, PQ_PITCH, wave * 16 + fr, ks * 32, fq), acc);
                float v[4];
#pragma unroll
                for (int j = 0; j < 4; ++j) { const int s = st * 16 + 4 * fq + j; v[j] = (s <= t) ? acc[j] * __expf(AS[s] - Mt) : 0.f; }
                o.x = pk2(v[0], v[1]); o.y = pk2(v[2], v[3]);
            }
            *(u32x2*)((unsigned char*)Sg + fm_off(t, st * 16 + 4 * fq, 4)) = o;
        }
    }
    {
        bf16_t* Qg = (bf16_t*)(ws + WS_QT) + (size_t)item * 128 * 256;
#pragma unroll
        for (int i = 0; i < 8; ++i) { const int idx = tid + 512 * i, blk = idx >> 6, t = (blk >> 3) * 16 + (idx & 15), ch = (blk & 7) * 4 + ((idx >> 4) & 3);
            const u32x4 v = *(const LAS u32x4*)(QL + t * PQ_PITCH + ch * 16); const float s = __expf(mprev - MS[t]);
            u32x4 o; o.x = pk2(bf_lo(v.x) * s, bf_hi(v.x) * s); o.y = pk2(bf_lo(v.y) * s, bf_hi(v.y) * s); o.z = pk2(bf_lo(v.z) * s, bf_hi(v.z) * s); o.w = pk2(bf_lo(v.w) * s, bf_hi(v.w) * s);
            *(u32x4*)((unsigned char*)Qg + fm_off(t, ch * 8, 8)) = o; }
    }
    {
        bf16_t* Kg = (bf16_t*)(ws + WS_KWT) + (size_t)item * 256 * 128;
        const int dlo = lane & 15, sglo = lane >> 4;
#pragma unroll
        for (int i = 0; i < 8; ++i) { const int combo = wave * 8 + i, d = (combo >> 2) * 16 + dlo, s0 = ((combo & 3) * 4 + sglo) * 8;
            float v[8];
#pragma unroll
            for (int e = 0; e < 8; ++e) v[e] = bf2f(*(const LAS bf16_t*)(KL + (s0 + e) * PQ_PITCH + d * 2)) * __expf(AS[s0 + e] - Mlast);
            u32x4 o; o.x = pk2(v[0], v[1]); o.y = pk2(v[2], v[3]); o.z = pk2(v[4], v[5]); o.w = pk2(v[6], v[7]);
            *(u32x4*)((unsigned char*)Kg + fm_off(d, s0, 4)) = o; }
    }
    __syncthreads();
}

__device__ __forceinline__ void hgrn_pre_load(const DArgs& a, int round, int item, u32x4 (&gq)[4]) {
    const int tid = tid_();
    const int p = item >> 7, c = item & 127, bl = p >> 3, h = p & 7;
    const int tl0 = bl * SEQ + c * 64;
    GAS unsigned char* ws = a.ws;
#pragma unroll
    for (int i = 0; i < 2; ++i) { const int idx = tid + 512 * i, s = idx >> 4, ch = idx & 15;
        gq[2 * i] = *(const GAS u32x4*)((const GAS bf16_t*)(ws + WS_GFLOG) + (size_t)(tl0 + s) * 1024 + h * 128 + ch * 8);
        gq[2 * i + 1] = *(const GAS u32x4*)((const GAS bf16_t*)(ws + WS_GQ) + (size_t)(tl0 + s) * 1024 + h * 128 + ch * 8); }
}
__device__ __forceinline__ void hgrn_pre_item(const DArgs& a, LAS unsigned char* lds, int round, int item, u32x4 (&gq)[4], int next_item) {
    const int tid = tid_(), lane = tid & 63, wave = __builtin_amdgcn_readfirstlane(tid >> 6), fr = lane & 15, fq = lane >> 4;
    const int p = item >> 7, c = item & 127, bl = p >> 3, h = p & 7;
    const int tl0 = bl * SEQ + c * 64;
    GAS unsigned char* ws = a.ws;
    LAS float* CUM = (LAS float*)lds;
    LAS float* GL = (LAS float*)(lds + 32768);
    LAS unsigned char* QH = lds + 65536;
    LAS unsigned char* KE = lds + 65536 + 64 * PS_PITCH;
    LAS float* QF = (LAS float*)(lds + 65536 + 128 * PS_PITCH);
#pragma unroll
    for (int i = 0; i < 2; ++i) { const int idx = tid + 512 * i, s = idx >> 4, ch = idx & 15;
        const u32x4 gv = gq[2 * i], qv = gq[2 * i + 1];
        LAS float* gd = GL + s * 128 + ch * 8; LAS float* qd = QF + s * 128 + ch * 8;
        gd[0] = bf_lo(gv.x); gd[1] = bf_hi(gv.x); gd[2] = bf_lo(gv.y); gd[3] = bf_hi(gv.y); gd[4] = bf_lo(gv.z); gd[5] = bf_hi(gv.z); gd[6] = bf_lo(gv.w); gd[7] = bf_hi(gv.w);
        qd[0] = bf_lo(qv.x); qd[1] = bf_hi(qv.x); qd[2] = bf_lo(qv.y); qd[3] = bf_hi(qv.y); qd[4] = bf_lo(qv.z); qd[5] = bf_hi(qv.z); qd[6] = bf_lo(qv.w); qd[7] = bf_hi(qv.w); }
    if (next_item < 2048) hgrn_pre_load(a, round, next_item, gq);
    LDS_BAR();
    {
        const int d = tid & 127, qt = tid >> 7; float cs = 0.f;
#pragma unroll 4
        for (int s = 0; s < 16; ++s) { cs += GL[(qt * 16 + s) * 128 + d]; CUM[(qt * 16 + s) * 128 + d] = cs; }
        LDS_BAR();
        float off = 0.f;
#pragma unroll
        for (int q = 0; q < 3; ++q) off += (q < qt) ? CUM[(q * 16 + 15) * 128 + d] : 0.f;
        LDS_BAR();
#pragma unroll 4
        for (int s = 0; s < 16; ++s) CUM[(qt * 16 + s) * 128 + d] += off;
        if (qt == 3) ((GAS float*)(ws + WS_HGDEC))[(size_t)item * 128 + d] = __expf(cs + off);
    }
    LDS_BAR();
    {
        bf16_t* Qg = (bf16_t*)(ws + WS_QTG) + (size_t)item * 64 * 128;
#pragma unroll
        for (int i = 0; i < 2; ++i) { const int idx = tid + 512 * i, s = idx >> 4, ch = idx & 15;
            float qt[8], qh[8], ke[8];
#pragma unroll
            for (int e = 0; e < 8; ++e) { const int d = ch * 8 + e; const float cm = CUM[s * 128 + d], last = CUM[63 * 128 + d], q = QF[s * 128 + d], g = GL[s * 128 + d];
                qt[e] = q * __expf(cm); qh[e] = q * __expf(cm - last); ke[e] = (1.0f - __expf(g)) * __expf(last - cm); }
            u32x4 o; o.x = pk2(qt[0], qt[1]); o.y = pk2(qt[2], qt[3]); o.z = pk2(qt[4], qt[5]); o.w = pk2(qt[6], qt[7]);
            *(u32x4*)((unsigned char*)Qg + fm_off(s, ch * 8, 4)) = o;
            o.x = pk2(qh[0], qh[1]); o.y = pk2(qh[2], qh[3]); o.z = pk2(qh[4], qh[5]); o.w = pk2(qh[6], qh[7]);
            *(LAS u32x4*)(QH + s * PS_PITCH + ch * 16) = o;
            o.x = pk2(ke[0], ke[1]); o.y = pk2(ke[2], ke[3]); o.z = pk2(ke[4], ke[5]); o.w = pk2(ke[6], ke[7]);
            *(LAS u32x4*)(KE + s * PS_PITCH + ch * 16) = o; }
    }
    LDS_BAR();
    {
        bf16_t* Ag = (bf16_t*)(ws + WS_ATT) + (size_t)item * 64 * 64;
#pragma unroll
        for (int i = 0; i < 2; ++i) { const int tile = wave * 2 + i, tt = tile >> 2, st = tile & 3; const int t = tt * 16 + fr;
            u32x2 o = (u32x2){0u, 0u};
            if (st <= tt) { f32x4 acc = (f32x4){0.f, 0.f, 0.f, 0.f};
#pragma unroll
                for (int ks = 0; ks < 4; ++ks) acc = MFMA16(lfrag(KE, PS_PITCH, st * 16 + fr, ks * 32, fq), lfrag(QH, PS_PITCH, tt * 16 + fr, ks * 32, fq), acc);
                float v[4];
#pragma unroll
                for (int j = 0; j < 4; ++j) { const int s = st * 16 + 4 * fq + j; v[j] = (s <= t) ? acc[j] : 0.f; }
                o.x = pk2(v[0], v[1]); o.y = pk2(v[2], v[3]); }
            *(u32x2*)((unsigned char*)Ag + fm_off(t, st * 16 + 4 * fq, 2)) = o; }
    }
    {
        bf16_t* Kg = (bf16_t*)(ws + WS_KENDT) + (size_t)item * 128 * 64;
        const int dlo = lane & 15, sglo = lane >> 4;
#pragma unroll
        for (int i = 0; i < 2; ++i) { const int combo = wave * 2 + i, d = (combo >> 1) * 16 + dlo, s0 = ((combo & 1) * 4 + sglo) * 8;
            unsigned v[8];
#pragma unroll
            for (int e = 0; e < 8; ++e) v[e] = *(const LAS bf16_t*)(KE + (s0 + e) * PS_PITCH + d * 2);
            u32x4 o; o.x = v[0] | (v[1] << 16); o.y = v[2] | (v[3] << 16); o.z = v[4] | (v[5] << 16); o.w = v[6] | (v[7] << 16);
            *(u32x4*)((unsigned char*)Kg + fm_off(d, s0, 2)) = o; }
    }
    LDS_BAR();
}

template <int NVT, bool DEN>
__device__ __forceinline__ void mlstm_scan(const DArgs& a, LAS unsigned char* lds, int round, int p, int sl) {
    const int tid = tid_(), lane = tid & 63, wave = __builtin_amdgcn_readfirstlane(tid >> 6), fr = lane & 15, fq = lane >> 4;
    const int bl = p >> 2, h = p & 3, b = round * 2 + bl;
    GAS unsigned char* ws = a.ws;
    constexpr int VTB = NVT * 16 * PS_PITCH, CTB = NVT * 16 * PQ_PITCH;
    LAS unsigned char* VT = lds; LAS unsigned char* CT = lds + 2 * VTB; LAS float* DEC = (LAS float*)(lds + 2 * VTB + 2 * CTB);
    for (int i = tid; i < (2 * VTB + 2 * CTB) / 4; i += NTHR) ((LAS unsigned*)lds)[i] = 0u;
    if (tid < 64) DEC[tid] = ((const GAS float*)(ws + WS_MDEC))[p * 64 + tid];
    __syncthreads();
    if (DEN) { if (tid < 256) { const int bufi = tid >> 7, s = tid & 127; *(LAS bf16_t*)(VT + bufi * VTB + s * 2) = (bf16_t)0x3F80; } }
    f32x4 st[2][NVT];
#pragma unroll
    for (int dt = 0; dt < 2; ++dt)
#pragma unroll
        for (int vt = 0; vt < NVT; ++vt) st[dt][vt] = (f32x4){0.f, 0.f, 0.f, 0.f};
    const int vcol = h * 512 + sl * 32;
    const int vs = tid >> 2, vpart = tid & 3;
    const GAS unsigned char* Sg0 = ws + WS_S + (size_t)(p * 64) * 32768 + wave * 4096 + lane * 16;
    const GAS unsigned char* Qg0 = ws + WS_QT + (size_t)(p * 64) * 65536 + wave * 8192 + lane * 16;
    const GAS unsigned char* Kg0 = ws + WS_KWT + (size_t)(p * 64) * 65536 + wave * 8192 + lane * 16;
    const GAS bf16_t* Vg0 = (const GAS bf16_t*)(ws + WS_V) + (size_t)(bl * SEQ + vs) * 2048 + vcol + vpart * 8;
    bf16x8 bS[4], bQ[8], aK[2][4]; u32x4 vreg = (u32x4){0u, 0u, 0u, 0u};
#define V_STAGE(cc_) do { LAS unsigned char* d0_ = VT + ((cc_) & 1) * VTB + (vpart * 8) * PS_PITCH + vs * 2; \
        *(LAS bf16_t*)(d0_ + 0 * PS_PITCH) = (bf16_t)(vreg.x & 0xffffu); *(LAS bf16_t*)(d0_ + 1 * PS_PITCH) = (bf16_t)(vreg.x >> 16); \
        *(LAS bf16_t*)(d0_ + 2 * PS_PITCH) = (bf16_t)(vreg.y & 0xffffu); *(LAS bf16_t*)(d0_ + 3 * PS_PITCH) = (bf16_t)(vreg.y >> 16); \
        *(LAS bf16_t*)(d0_ + 4 * PS_PITCH) = (bf16_t)(vreg.z & 0xffffu); *(LAS bf16_t*)(d0_ + 5 * PS_PITCH) = (bf16_t)(vreg.z >> 16); \
        *(LAS bf16_t*)(d0_ + 6 * PS_PITCH) = (bf16_t)(vreg.w & 0xffffu); *(LAS bf16_t*)(d0_ + 7 * PS_PITCH) = (bf16_t)(vreg.w >> 16); } while (0)
    if (!DEN) { vreg = *(const GAS u32x4*)Vg0; V_STAGE(0); }
    __builtin_amdgcn_sched_barrier(0);
#pragma unroll
    for (int ks = 0; ks < 4; ++ks)
#pragma unroll
        for (int dt = 0; dt < 2; ++dt) aK[dt][ks] = *(const GAS bf16x8*)(Kg0 + (dt * 4 + ks) * 1024);
    __builtin_amdgcn_sched_barrier(0);
#pragma unroll
    for (int ks = 0; ks < 4; ++ks) bS[ks] = *(const GAS bf16x8*)(Sg0 + ks * 1024);
    __builtin_amdgcn_sched_barrier(0);
#pragma unroll
    for (int ks = 0; ks < 8; ++ks) bQ[ks] = *(const GAS bf16x8*)(Qg0 + ks * 1024);
    __builtin_amdgcn_sched_barrier(0);
    if (!DEN) vreg = *(const GAS u32x4*)(Vg0 + (size_t)128 * 2048);
    __builtin_amdgcn_sched_barrier(0);
    const GAS unsigned char* pfp; unsigned pfstride;
    { const int tt = (wave * 64 + lane) < 160 ? wave * 64 + lane : 159; const int idx = sl * 10 + (tt >> 4), off = (tt & 15) * 64;
      pfp = (idx < 32 ? ws + WS_S + (size_t)(p * 64) * 32768 + idx * 1024 : idx < 96 ? ws + WS_QT + (size_t)(p * 64) * 65536 + (idx - 32) * 1024 : ws + WS_KWT + (size_t)(p * 64) * 65536 + (idx - 96) * 1024) + off;
      pfstride = idx < 32 ? 32768u : 65536u; }
    unsigned pfv = 0u;
#pragma unroll 1
    for (int c = 0; c < 64; ++c) {
        const int tl0 = bl * SEQ + c * 128; const size_t tg0 = (size_t)b * SEQ + c * 128;
        const int cn = c < 63 ? c + 1 : 63, cn2 = c < 62 ? c + 2 : 63;
        LAS unsigned char* vt_ = VT + (c & 1) * VTB; LAS unsigned char* ct_ = CT + (c & 1) * CTB; LAS unsigned char* ctn = CT + ((c + 1) & 1) * CTB;
        LDS_BAR();
        if (!DEN && wave < 3) { asm volatile("" :: "v"(pfv)); const int c3 = c < 60 ? c + 3 : 63; pfv = *(const GAS unsigned*)(pfp + (size_t)c3 * pfstride); }
        bf16x8 vf[NVT][4], cf[NVT][4];
#pragma unroll
        for (int vt = 0; vt < NVT; ++vt)
#pragma unroll
            for (int ks = 0; ks < 4; ++ks) vf[vt][ks] = lfrag(vt_, PS_PITCH, vt * 16 + fr, ks * 32, fq);
        const float dec = DEC[c];
        __builtin_amdgcn_sched_barrier(0);
#pragma unroll
        for (int dt = 0; dt < 2; ++dt)
#pragma unroll
            for (int vt = 0; vt < NVT; ++vt) st[dt][vt] = st[dt][vt] * dec;
#pragma unroll
        for (int ks = 0; ks < 4; ++ks) {
#pragma unroll
            for (int vt = 0; vt < NVT; ++vt) cf[vt][ks] = lfrag(ct_, PQ_PITCH, vt * 16 + fr, ks * 32, fq);
#pragma unroll
            for (int dt = 0; dt < 2; ++dt) {
#pragma unroll
                for (int vt = 0; vt < NVT; ++vt) st[dt][vt] = MFMA16(aK[dt][ks], vf[vt][ks], st[dt][vt]);
                aK[dt][ks] = *(const GAS bf16x8*)(Kg0 + (size_t)cn * 65536 + (dt * 4 + ks) * 1024);
            }
            __builtin_amdgcn_sched_barrier(0);
        }
#pragma unroll
        for (int dt = 0; dt < 2; ++dt)
#pragma unroll
            for (int vt = 0; vt < NVT; ++vt) { u32x2 o; o.x = pk2(st[dt][vt][0], st[dt][vt][1]); o.y = pk2(st[dt][vt][2], st[dt][vt][3]);
                *(LAS u32x2*)(ctn + (vt * 16 + fr) * PQ_PITCH + (wave * 32 + dt * 16 + 4 * fq) * 2) = o; }
        __builtin_amdgcn_sched_barrier(0);
        f32x4 acc[NVT];
#pragma unroll
        for (int vt = 0; vt < NVT; ++vt) acc[vt] = (f32x4){0.f, 0.f, 0.f, 0.f};
#pragma unroll
        for (int ks = 0; ks < 4; ++ks) {
#pragma unroll
            for (int vt = 0; vt < NVT; ++vt) acc[vt] = MFMA16(vf[vt][ks], bS[ks], acc[vt]);
            bS[ks] = *(const GAS bf16x8*)(Sg0 + (size_t)cn * 32768 + ks * 1024);
            __builtin_amdgcn_sched_barrier(0);
        }
#pragma unroll
        for (int ks = 0; ks < 8; ++ks) {
#pragma unroll
            for (int vt = 0; vt < NVT; ++vt) acc[vt] = MFMA16(cf[vt][ks & 3], bQ[ks], acc[vt]);
            if (ks < 4) {
#pragma unroll
                for (int vt = 0; vt < NVT; ++vt) cf[vt][ks] = lfrag(ct_, PQ_PITCH, vt * 16 + fr, 128 + ks * 32, fq);
            }
            bQ[ks] = *(const GAS bf16x8*)(Qg0 + (size_t)cn * 65536 + ks * 1024);
            __builtin_amdgcn_sched_barrier(0);
        }
        const int t = wave * 16 + fr;
        if (!DEN) {
            GAS bf16_t* hn = (GAS bf16_t*)(ws + WS_QKPRE) + (size_t)(tl0 + t) * 2048 + vcol + 4 * fq;
#pragma unroll
            for (int vt = 0; vt < NVT; ++vt) { u32x2 o; o.x = pk2(acc[vt][0], acc[vt][1]); o.y = pk2(acc[vt][2], acc[vt][3]); *(GAS u32x2*)(hn + vt * 16) = o; }
            V_STAGE(c + 1); vreg = *(const GAS u32x4*)(Vg0 + (size_t)cn2 * 128 * 2048);
        } else {
            if (fq == 0) ((GAS float*)(ws + WS_DEN))[(tg0 + t) * 4 + h] = acc[0][0];
        }
    }
    asm volatile("" :: "v"(pfv));
    __syncthreads();
#undef V_STAGE
}

constexpr int HG_PD = 4;
__device__ __forceinline__ void hgrn_scan(const DArgs& a, LAS unsigned char* lds, int round, int p, int sl) {
    const int tid = tid_(), lane = tid & 63, wave = __builtin_amdgcn_readfirstlane(tid >> 6), fr = lane & 15, fq = lane >> 4;
    const int bl = p >> 3, h = p & 7;
    GAS unsigned char* ws = a.ws;
    constexpr int IP = 144, ITB = 32 * IP, STB = 32 * PS_PITCH;
    LAS unsigned char* IT = lds; LAS unsigned char* ST = lds + 2 * ITB;
    for (int i = tid; i < (2 * ITB + 2 * STB) / 4; i += NTHR) ((LAS unsigned*)lds)[i] = 0u;
    __syncthreads();
    f32x4 st[2][2];
#pragma unroll
    for (int i = 0; i < 2; ++i) { st[i][0] = (f32x4){0.f, 0.f, 0.f, 0.f}; st[i][1] = st[i][0]; }
    const int vcol = h * 128 + sl * 32;
    const int is = (tid & 255) >> 2, ipart = tid & 3;
    const bool outw = wave < 4;
    const int w4 = wave & 3;
    const GAS unsigned char* Ag0 = ws + WS_ATT + (size_t)(p * 128) * 8192 + w4 * 2048 + lane * 16;
    const GAS unsigned char* Qg0 = ws + WS_QTG + (size_t)(p * 128) * 16384 + w4 * 4096 + lane * 16;
    const GAS unsigned char* Kg0 = ws + WS_KENDT + (size_t)(p * 128) * 16384 + w4 * 4096 + lane * 16;
    const GAS unsigned char* Dg0 = ws + WS_HGDEC + ((size_t)(p * 128) * 128 + w4 * 32 + 4 * fq) * 4;
    const GAS unsigned char* Ig0 = ws + WS_GI + ((size_t)(bl * SEQ + is) * 1024 + vcol + ipart * 8) * 2;
    const GAS unsigned char* gb0 = outw ? Ag0 : Kg0;          const unsigned gs0 = outw ? 8192u : 16384u;
    const GAS unsigned char* gb1 = outw ? Qg0 : Kg0 + 2048;   const unsigned gs1 = 16384u;
    const GAS unsigned char* gb2 = outw ? Qg0 + 2048 : Dg0;   const unsigned gs2 = outw ? 16384u : 512u, gt2 = outw ? 1024u : 64u;
    const GAS unsigned char* gb3 = outw ? Ig0 : Dg0;          const unsigned gs3 = outw ? 131072u : 512u;
    u32x4 pf[HG_PD][7];
#define HG_LD01(k_, cc_) do { _Pragma("unroll") for (int j_ = 0; j_ < 2; ++j_) pf[k_][j_] = *(const GAS u32x4*)(gb0 + (size_t)(cc_) * gs0 + j_ * 1024); } while (0)
#define HG_LD23(k_, cc_) do { _Pragma("unroll") for (int j_ = 0; j_ < 2; ++j_) pf[k_][2 + j_] = *(const GAS u32x4*)(gb1 + (size_t)(cc_) * gs1 + j_ * 1024); } while (0)
#define HG_LD45(k_, cc_) do { _Pragma("unroll") for (int j_ = 0; j_ < 2; ++j_) pf[k_][4 + j_] = *(const GAS u32x4*)(gb2 + (size_t)(cc_) * gs2 + j_ * gt2); } while (0)
#define HG_LD6(k_, cc_) do { pf[k_][6] = *(const GAS u32x4*)(gb3 + (size_t)(cc_) * gs3); } while (0)
#pragma unroll
    for (int k = 0; k < HG_PD; ++k) { HG_LD01(k, k); HG_LD23(k, k); HG_LD45(k, k); __builtin_amdgcn_sched_barrier(0); HG_LD6((k + 1) % HG_PD, (k + 1 < HG_PD ? k + 1 : HG_PD)); __builtin_amdgcn_sched_barrier(0); }
    const GAS unsigned char* pfp; unsigned pfstride;
    { const int tt = (wave * 64 + lane) < 160 ? wave * 64 + lane : 159; const int idx = sl * 10 + (tt >> 4), off = (tt & 15) * 64;
      pfp = (idx < 8 ? ws + WS_ATT + (size_t)(p * 128) * 8192 + idx * 1024 : idx < 24 ? ws + WS_QTG + (size_t)(p * 128) * 16384 + (idx - 8) * 1024 : ws + WS_KENDT + (size_t)(p * 128) * 16384 + (idx - 24) * 1024) + off;
      pfstride = idx < 8 ? 8192u : 16384u; }
    unsigned pfv[HG_PD];
#pragma unroll
    for (int k = 0; k < HG_PD; ++k) pfv[k] = 0u;
#define HG_STAGE(dst_, iv_) do { LAS unsigned char* d0_ = (dst_) + (ipart * 8) * IP + is * 2; \
        *(LAS bf16_t*)(d0_ + 0 * IP) = (bf16_t)((iv_).x & 0xffffu); *(LAS bf16_t*)(d0_ + 1 * IP) = (bf16_t)((iv_).x >> 16); \
        *(LAS bf16_t*)(d0_ + 2 * IP) = (bf16_t)((iv_).y & 0xffffu); *(LAS bf16_t*)(d0_ + 3 * IP) = (bf16_t)((iv_).y >> 16); \
        *(LAS bf16_t*)(d0_ + 4 * IP) = (bf16_t)((iv_).z & 0xffffu); *(LAS bf16_t*)(d0_ + 5 * IP) = (bf16_t)((iv_).z >> 16); \
        *(LAS bf16_t*)(d0_ + 6 * IP) = (bf16_t)((iv_).w & 0xffffu); *(LAS bf16_t*)(d0_ + 7 * IP) = (bf16_t)((iv_).w >> 16); } while (0)
    if (outw) { const u32x4 iv = *(const GAS u32x4*)Ig0; HG_STAGE(IT, iv); }
#pragma unroll 1
    for (int c0 = 0; c0 < 128; c0 += HG_PD) {
#pragma unroll
      for (int k = 0; k < HG_PD; ++k) {
        const int c = c0 + k;
        const int tl0 = bl * SEQ + c * 64;
        const int cn = (c + HG_PD < 128) ? c + HG_PD : 127;
        LAS unsigned char* it_ = IT + (k & 1) * ITB; LAS unsigned char* itn = IT + ((k + 1) & 1) * ITB; LAS unsigned char* st_ = ST + (k & 1) * STB; LAS unsigned char* stn = ST + ((k + 1) & 1) * STB;
        LDS_BAR();
        if (wave < 3) { asm volatile("" :: "v"(pfv[k])); const int c7 = (c + HG_PD + 3 < 128) ? c + HG_PD + 3 : 127; pfv[k] = *(const GAS unsigned*)(pfp + (size_t)c7 * pfstride); }
        bf16x8 itf[2][2];
#pragma unroll
        for (int vt = 0; vt < 2; ++vt)
#pragma unroll
            for (int ks = 0; ks < 2; ++ks) itf[vt][ks] = lfrag(it_, IP, vt * 16 + fr, ks * 32, fq);
        bf16x8 sf[2][4];
        f32x4 acc[2];
        acc[0] = (f32x4){0.f, 0.f, 0.f, 0.f}; acc[1] = acc[0];
        if (outw) {
#pragma unroll
            for (int vt = 0; vt < 2; ++vt)
#pragma unroll
                for (int ks = 0; ks < 4; ++ks) sf[vt][ks] = lfrag(st_, PS_PITCH, vt * 16 + fr, ks * 32, fq);
#pragma unroll
            for (int ks = 0; ks < 2; ++ks)
#pragma unroll
                for (int vt = 0; vt < 2; ++vt) acc[vt] = MFMA16(itf[vt][ks], __builtin_bit_cast(bf16x8, pf[k][ks]), acc[vt]);
        } else {
            const f32x4 dec = __builtin_bit_cast(f32x4, pf[k][4]);
#pragma unroll
            for (int vt = 0; vt < 2; ++vt) { st[0][vt] = st[0][vt] * dec;
#pragma unroll
                for (int ks = 0; ks < 2; ++ks) st[0][vt] = MFMA16(__builtin_bit_cast(bf16x8, pf[k][ks]), itf[vt][ks], st[0][vt]); }
        }
        __builtin_amdgcn_sched_barrier(0);
        HG_LD01(k, cn);
        __builtin_amdgcn_sched_barrier(0);
        if (outw) {
#pragma unroll
            for (int ks = 0; ks < 2; ++ks)
#pragma unroll
                for (int vt = 0; vt < 2; ++vt) acc[vt] = MFMA16(sf[vt][ks], __builtin_bit_cast(bf16x8, pf[k][2 + ks]), acc[vt]);
        } else {
            const f32x4 dec = __builtin_bit_cast(f32x4, pf[k][5]);
#pragma unroll
            for (int vt = 0; vt < 2; ++vt) { st[1][vt] = st[1][vt] * dec;
#pragma unroll
                for (int ks = 0; ks < 2; ++ks) st[1][vt] = MFMA16(__builtin_bit_cast(bf16x8, pf[k][2 + ks]), itf[vt][ks], st[1][vt]); }
        }
        __builtin_amdgcn_sched_barrier(0);
        HG_LD23(k, cn);
        __builtin_amdgcn_sched_barrier(0);
        if (outw) {
#pragma unroll
            for (int ks = 2; ks < 4; ++ks)
#pragma unroll
                for (int vt = 0; vt < 2; ++vt) acc[vt] = MFMA16(sf[vt][ks], __builtin_bit_cast(bf16x8, pf[k][2 + ks]), acc[vt]);
        } else {
#pragma unroll
            for (int dtile = 0; dtile < 2; ++dtile)
#pragma unroll
                for (int vt = 0; vt < 2; ++vt) { u32x2 o; o.x = pk2(st[dtile][vt][0], st[dtile][vt][1]); o.y = pk2(st[dtile][vt][2], st[dtile][vt][3]);
                    *(LAS u32x2*)(stn + (vt * 16 + fr) * PS_PITCH + (w4 * 32 + dtile * 16 + 4 * fq) * 2) = o; }
        }
        __builtin_amdgcn_sched_barrier(0);
        HG_LD45(k, cn);
        __builtin_amdgcn_sched_barrier(0);
        if (outw) {
            HG_STAGE(itn, pf[(k + 1) % HG_PD][6]);
            GAS bf16_t* og = (GAS bf16_t*)(ws + WS_GQ) + (size_t)(tl0 + w4 * 16 + fr) * 1024 + vcol + 4 * fq;
#pragma unroll
            for (int vt = 0; vt < 2; ++vt) { u32x2 o; o.x = pk2(acc[vt][0], acc[vt][1]); o.y = pk2(acc[vt][2], acc[vt][3]); *(GAS u32x2*)(og + vt * 16) = o; }
        }
        __builtin_amdgcn_sched_barrier(0);
        { const int cni = (c + 1 + HG_PD < 128) ? c + 1 + HG_PD : 127; HG_LD6((k + 1) % HG_PD, cni); }
        __builtin_amdgcn_sched_barrier(0);
      }
    }
#pragma unroll
    for (int k = 0; k < HG_PD; ++k) asm volatile("" :: "v"(pfv[k]));
    __syncthreads();
#undef HG_LD01
#undef HG_LD23
#undef HG_LD45
#undef HG_LD6
#undef HG_STAGE
}

__device__ __forceinline__ void xn8_convert(const DArgs& a, int round, int vcu, int G) {
    const int tid = tid_(), lane = tid & 63, wave = tid >> 6;
    const int gw = vcu * NWAVES + wave, NGW = G * NWAVES;
    GAS unsigned char* ws = a.ws;
    for (int tl = gw; tl < RT; tl += NGW) {
        const size_t tg = (size_t)round * RT + tl;
        const GAS u32x2* xr = (const GAS u32x2*)((const GAS bf16_t*)(ws + WS_XN) + tg * D) + lane;
        f32x4 v[4]; float mx = 0.f;
#pragma unroll
        for (int j = 0; j < 4; ++j) { const u32x2 xv = xr[64 * j]; v[j][0] = bf_lo(xv.x); v[j][1] = bf_hi(xv.x); v[j][2] = bf_lo(xv.y); v[j][3] = bf_hi(xv.y);
            mx = fmaxf(mx, fmaxf(fmaxf(fabsf(v[j][0]), fabsf(v[j][1])), fmaxf(fabsf(v[j][2]), fabsf(v[j][3])))); }
        mx = wave_max(mx);
        const float qs = mx > 0.f ? 127.0f / mx : 0.f;
#pragma unroll
        for (int j = 0; j < 4; ++j) ((GAS unsigned*)(ws + WS_XN8 + (size_t)tl * 1024))[64 * j + lane] = pack_i8x4(v[j][0] * qs, v[j][1] * qs, v[j][2] * qs, v[j][3] * qs);
        if (lane == 0) ((GAS float*)(ws + WS_SA8))[tg] = mx * (1.0f / 127.0f);
    }
}

__device__ __forceinline__ void phase_ypass(const DArgs& a, int round, int vcu, int G) {
    const int tid = tid_(), lane = tid & 63, wave = tid >> 6;
    const int gw = vcu * NWAVES + wave, NGW = G * NWAVES;
    GAS unsigned char* ws = a.ws;
    f32x4 mg0[4], mg1[4], gg4[4];
#pragma unroll
    for (int j = 0; j < 4; ++j) { mg0[j] = *(const GAS f32x4*)(a.m_head_g + j * 512 + lane * 8); mg1[j] = *(const GAS f32x4*)(a.m_head_g + j * 512 + lane * 8 + 4); gg4[j] = *(const GAS f32x4*)(a.g_head_g + lane * 16 + 4 * j); }
    for (int tl = gw; tl < RT; tl += NGW) {
        const size_t tg = (size_t)round * RT + tl;
        const f32x4 den4 = *(const f32x4*)((const float*)(ws + WS_DEN) + tg * 4), mt4 = *(const f32x4*)((const float*)(ws + WS_MT) + tg * 4);
#pragma unroll
        for (int j = 0; j < 4; ++j) {
            const int col = j * 512 + lane * 8;
            const u32x4 nv = *(const u32x4*)((const bf16_t*)(ws + WS_QKPRE) + (size_t)tl * 2048 + col);
            const u32x4 ov = *(const u32x4*)((const bf16_t*)(ws + WS_SIGO) + (size_t)tl * 2048 + col);
            const float inv = 1.0f / fmaxf(fabsf(den4[j]), __expf(-mt4[j]));
            float hv[8] = {bf_lo(nv.x) * inv, bf_hi(nv.x) * inv, bf_lo(nv.y) * inv, bf_hi(nv.y) * inv, bf_lo(nv.z) * inv, bf_hi(nv.z) * inv, bf_lo(nv.w) * inv, bf_hi(nv.w) * inv};
            float ss = 0.f;
#pragma unroll
            for (int e = 0; e < 8; ++e) ss += hv[e] * hv[e];
            const float r = rsqrtf(wave_sum(ss, lane) * (1.f / 512.f) + EPS);
            const f32x4 g0 = mg0[j], g1 = mg1[j];
            const float og[8] = {bf_lo(ov.x), bf_hi(ov.x), bf_lo(ov.y), bf_hi(ov.y), bf_lo(ov.z), bf_hi(ov.z), bf_lo(ov.w), bf_hi(ov.w)};
            float y[8];
#pragma unroll
            for (int e = 0; e < 8; ++e) y[e] = og[e] * hv[e] * r * (e < 4 ? g0[e] : g1[e - 4]);
            u32x4 o; o.x = pk2(y[0], y[1]); o.y = pk2(y[2], y[3]); o.z = pk2(y[4], y[5]); o.w = pk2(y[6], y[7]);
            *(u32x4*)((bf16_t*)(ws + WS_V) + (size_t)tl * 2048 + col) = o;
        }
        {
            const int col = lane * 16;
            const u32x4 n0 = *(const u32x4*)((const bf16_t*)(ws + WS_GQ) + (size_t)tl * 1024 + col), n1 = *(const u32x4*)((const bf16_t*)(ws + WS_GQ) + (size_t)tl * 1024 + col + 8);
            const u32x4 s0 = *(const u32x4*)((const bf16_t*)(ws + WS_SGG) + (size_t)tl * 1024 + col), s1 = *(const u32x4*)((const bf16_t*)(ws + WS_SGG) + (size_t)tl * 1024 + col + 8);
            float ov[16] = {bf_lo(n0.x), bf_hi(n0.x), bf_lo(n0.y), bf_hi(n0.y), bf_lo(n0.z), bf_hi(n0.z), bf_lo(n0.w), bf_hi(n0.w), bf_lo(n1.x), bf_hi(n1.x), bf_lo(n1.y), bf_hi(n1.y), bf_lo(n1.z), bf_hi(n1.z), bf_lo(n1.w), bf_hi(n1.w)};
            const float sg[16] = {bf_lo(s0.x), bf_hi(s0.x), bf_lo(s0.y), bf_hi(s0.y), bf_lo(s0.z), bf_hi(s0.z), bf_lo(s0.w), bf_hi(s0.w), bf_lo(s1.x), bf_hi(s1.x), bf_lo(s1.y), bf_hi(s1.y), bf_lo(s1.z), bf_hi(s1.z), bf_lo(s1.w), bf_hi(s1.w)};
            float ss = 0.f;
#pragma unroll
            for (int e = 0; e < 16; ++e) ss += ov[e] * ov[e];
            ss += DPP_(ss, 0xB1); ss += DPP_(ss, 0x4E); ss += DPP_(ss, 0x141);
            const float r = rsqrtf(ss * (1.f / 128.f) + EPS);
            float y[16];
#pragma unroll
            for (int e = 0; e < 16; ++e) y[e] = ov[e] * r * gg4[e >> 2][e & 3] * sg[e];
            u32x4 o; o.x = pk2(y[0], y[1]); o.y = pk2(y[2], y[3]); o.z = pk2(y[4], y[5]); o.w = pk2(y[6], y[7]);
            *(u32x4*)((bf16_t*)(ws + WS_GI) + (size_t)tl * 1024 + col) = o;
            o.x = pk2(y[8], y[9]); o.y = pk2(y[10], y[11]); o.z = pk2(y[12], y[13]); o.w = pk2(y[14], y[15]);
            *(u32x4*)((bf16_t*)(ws + WS_GI) + (size_t)tl * 1024 + col + 8) = o;
        }
    }
}


#define XB_TMO      128
#define XB_XCNT(j)  (256  + 64 * (j))
#define XB_XSUB(j)  (1280 + 64 * (j))
#define XB_XGEN(j)  (2304 + 64 * (j))
#define XB_TOP      3328
#define XB_TOPGEN   3392
#define XB_SPIN_CAP (1u << 22)
constexpr int CW_BAR = 4096;
constexpr int LDS_BARST = LDS_BYTES - 64;
__device__ __forceinline__ unsigned xb_ld(unsigned* p)              { return __hip_atomic_load(p, __ATOMIC_RELAXED, __HIP_MEMORY_SCOPE_AGENT); }
__device__ __forceinline__ unsigned xb_add(unsigned* p, unsigned v) { return __hip_atomic_fetch_add(p, v, __ATOMIC_RELAXED, __HIP_MEMORY_SCOPE_AGENT); }
__device__ __forceinline__ unsigned xb_xcc_id() { return (unsigned)__builtin_amdgcn_s_getreg((3 << 11) | 20) & 0xFu; }
#define XB_SPIN(cond, bar) do { unsigned _sp = 0; while (cond) { __builtin_amdgcn_s_sleep(1); \
    if ((++_sp & 255u) == 0u) { if (xb_ld(&(bar)[XB_TMO])) break; if (_sp > XB_SPIN_CAP) { atomicAdd(&(bar)[XB_TMO], 1u); break; } } } } while (0)
__device__ __forceinline__ void xcd_barrier_post(unsigned* bar, volatile LAS unsigned* st) { if (tid_() == 0) st[2] = xb_add(&bar[XB_XCNT(xb_xcc_id())], 1u); }
__device__ __forceinline__ void xcd_barrier_complete(unsigned* bar, unsigned x, unsigned& nloc, unsigned& nx) {
    const unsigned G = gridDim.x;
    unsigned sum, cnt, mine, sp = 0u;
    for (;;) {
        sum = 0u; cnt = 0u; mine = 0u;
#pragma unroll
        for (unsigned j = 0; j < 16; ++j) { const unsigned c = xb_ld(&bar[XB_XCNT(j)]); sum += c; cnt += (c > 0u) ? 1u : 0u; mine = (j == x) ? c : mine; }
        if (sum == G) break;
        __builtin_amdgcn_s_sleep(1);
        if ((++sp & 255u) == 0u) { if (xb_ld(&bar[XB_TMO])) break; if (sp > XB_SPIN_CAP) { atomicAdd(&bar[XB_TMO], 1u); break; } }
    }
    nloc = mine > 0u ? mine : 1u; nx = cnt > 0u ? cnt : 1u;
}
__device__ __forceinline__ void xcd_barrier(unsigned* bar, volatile LAS unsigned* st) {
    asm volatile("s_waitcnt vmcnt(0)" ::: "memory");
    __syncthreads();
    if (tid_() == 0) {
        const unsigned x = xb_xcc_id();
        __builtin_amdgcn_s_waitcnt(0);
        unsigned nloc = st[0], nx = st[1];
        if (nloc == 0u) { xcd_barrier_complete(bar, x, nloc, nx); st[0] = nloc; st[1] = nx; }
        const unsigned old = xb_add(&bar[XB_XSUB(x)], 1u);
        const unsigned gen = old / nloc;
        if (old + 1u == (gen + 1u) * nloc) {
            __builtin_amdgcn_fence(__ATOMIC_RELEASE, "agent");
            asm volatile("s_waitcnt vmcnt(0)" ::: "memory");
            const unsigned og = xb_add(&bar[XB_TOP], 1u);
            const unsigned tg = og / nx;
            if (og + 1u == (tg + 1u) * nx) xb_add(&bar[XB_TOPGEN], 1u);
            else XB_SPIN(xb_ld(&bar[XB_TOPGEN]) == tg, bar);
            __builtin_amdgcn_fence(__ATOMIC_ACQUIRE, "agent");
            xb_add(&bar[XB_XGEN(x)], 1u);
            asm volatile("s_waitcnt vmcnt(0)" ::: "memory");
        } else {
            XB_SPIN(xb_ld(&bar[XB_XGEN(x)]) == gen, bar);
            __builtin_amdgcn_fence(__ATOMIC_ACQUIRE, "agent");
            asm volatile("s_waitcnt vmcnt(0)" ::: "memory");
        }
    }
    __syncthreads();
}

__device__ __forceinline__ void phase_p8(const DArgs& a, int vcu, int G) {
    const int tid = tid_(), lane = tid & 63, wave = tid >> 6;
    const int gw = vcu * NWAVES + wave, NGW = G * NWAVES;
    GAS unsigned char* ws = a.ws;
    f32x4 g2[4];
#pragma unroll
    for (int j = 0; j < 4; ++j) g2[j] = ((const f32x4*)a.norm2_g)[64 * j + lane];
    for (int m = gw; m < T; m += NGW) {
        const GAS u32x2* xr = (const GAS u32x2*)((const GAS bf16_t*)a.out + (size_t)m * D) + lane;
        f32x4 v[4]; float s = 0.f;
#pragma unroll
        for (int j = 0; j < 4; ++j) { const u32x2 xv = xr[64 * j]; v[j][0] = bf_lo(xv.x); v[j][1] = bf_hi(xv.x); v[j][2] = bf_lo(xv.y); v[j][3] = bf_hi(xv.y); s += (v[j][0] * v[j][0] + v[j][1] * v[j][1]) + (v[j][2] * v[j][2] + v[j][3] * v[j][3]); }
        const float rstd = rsqrtf(wave_sum(s, lane) * (1.f / D) + EPS);
        unsigned long long* o8 = (unsigned long long*)((bf16_t*)(ws + WS_XN) + (size_t)m * D) + lane;
#pragma unroll
        for (int j = 0; j < 4; ++j) { v[j] = v[j] * rstd * g2[j]; o8[64 * j] = (unsigned long long)pk2(v[j][0], v[j][1]) | ((unsigned long long)pk2(v[j][2], v[j][3]) << 32); }
        float mx = 0.f;
#pragma unroll
        for (int j = 0; j < 4; ++j) mx = fmaxf(mx, fmaxf(fmaxf(fabsf(v[j][0]), fabsf(v[j][1])), fmaxf(fabsf(v[j][2]), fabsf(v[j][3]))));
        mx = wave_max(mx);
        const float qs = mx > 0.f ? 127.0f / mx : 0.f;
#pragma unroll
        for (int j = 0; j < 4; ++j) ((GAS unsigned*)(ws + WS_XQ + (size_t)m * 1024))[64 * j + lane] = pack_i8x4(v[j][0] * qs, v[j][1] * qs, v[j][2] * qs, v[j][3] * qs);
        if (lane == 0) ((GAS float*)(ws + WS_XQS))[m] = mx * (1.0f / 127.0f);
    }
    for (int e = gw; e < 16384; e += NGW) {
        f32x4 uv[4], vv[4]; float mu = 0.f, mv = 0.f;
#pragma unroll
        for (int j = 0; j < 4; ++j) { uv[j] = ((const GAS f32x4*)(a.u_emb + (size_t)e * 1024))[64 * j + lane]; vv[j] = ((const GAS f32x4*)(a.v_emb + (size_t)e * 1024))[64 * j + lane];
            mu = fmaxf(mu, fmaxf(fmaxf(fabsf(uv[j][0]), fabsf(uv[j][1])), fmaxf(fabsf(uv[j][2]), fabsf(uv[j][3]))));
            mv = fmaxf(mv, fmaxf(fmaxf(fabsf(vv[j][0]), fabsf(vv[j][1])), fmaxf(fabsf(vv[j][2]), fabsf(vv[j][3])))); }
        mu = wave_max(mu); mv = wave_max(mv);
        const float su = mu > 0.f ? 127.0f / mu : 0.f, sv = mv > 0.f ? 448.0f / mv : 0.f;
        if (lane == 0) { ((GAS float*)(ws + WS_USC))[e] = mu * (1.0f / 127.0f); ((GAS float*)(ws + WS_VSC))[e] = mv * (1.0f / 448.0f); }
#pragma unroll
        for (int j = 0; j < 4; ++j) {
            const size_t ob = (size_t)(2 * j + (lane >> 5)) * 2097152 + (size_t)e * 128 + ((4 * lane) & 127);
            *(GAS unsigned*)(ws + WS_UB + ob) = pack_i8x4(uv[j][0] * su, uv[j][1] * su, uv[j][2] * su, uv[j][3] * su);
            int p = __builtin_amdgcn_cvt_pk_fp8_f32(vv[j][0] * sv, vv[j][1] * sv, 0, false); p = __builtin_amdgcn_cvt_pk_fp8_f32(vv[j][2] * sv, vv[j][3] * sv, p, true);
            *(GAS unsigned*)(ws + WS_VB + ob) = (unsigned)p; }
    }
}

__device__ __forceinline__ unsigned f2ord(float f) { const unsigned u = __builtin_bit_cast(unsigned, f); return (u & 0x80000000u) ? ~u : (u | 0x80000000u); }
__device__ __forceinline__ float ord2f(unsigned k) { const unsigned u = (k & 0x80000000u) ? (k & 0x7fffffffu) : ~k; return __builtin_bit_cast(float, u); }
__device__ __forceinline__ unsigned umax_(unsigned a, unsigned b) { return a > b ? a : b; }
__device__ __forceinline__ unsigned shxu(unsigned v, int o, int lane) { return (unsigned)__builtin_amdgcn_ds_bpermute((lane ^ o) << 2, (int)v); }

__device__ __forceinline__ void phase_topk(const DArgs& a, LAS unsigned char* lds, int bx, int G) {
    const int tid = tid_(), lane = tid & 63, wave = __builtin_amdgcn_readfirstlane(tid >> 6), fr = lane & 15, fq = lane >> 4;
    GAS unsigned char* ws = a.ws;
    const int h = bx & 7;
    LAS unsigned char* KY = lds;
    LAS unsigned char* QL = lds + 2 * 128 * PS_PITCH;
    LAS unsigned* TOP = (LAS unsigned*)(lds + 2 * 128 * PS_PITCH + 64 * PQ_PITCH);
#pragma unroll
    for (int i = 0; i < 8; ++i) { const int idx = tid + 512 * i, row = idx >> 4, ch = idx & 15;
        *(LAS u32x4*)(KY + row * PS_PITCH + ch * 16) = *(const u32x4*)((const bf16_t*)(ws + WS_SK) + ((size_t)h * 256 + row) * 128 + ch * 8); }
    const int ntile = T / 64;
    u32x4 qpre[4];
    { const int tile0 = bx >> 3; if (tile0 < ntile) {
#pragma unroll
        for (int i = 0; i < 4; ++i) { const int idx = tid + 512 * i, row = idx >> 5, ch = idx & 31;
            qpre[i] = *(const GAS u32x4*)((const GAS bf16_t*)(ws + WS_QP) + ((size_t)tile0 * 64 + row) * 2048 + h * 256 + ch * 8); } } }
    __syncthreads();
    for (int tile = bx >> 3; tile < ntile; tile += (G >> 3)) {
        const size_t t0 = (size_t)tile * 64;
        LDS_BAR();
#pragma unroll
        for (int i = 0; i < 4; ++i) { const int idx = tid + 512 * i, row = idx >> 5, ch = idx & 31;
            *(LAS u32x4*)(QL + row * PQ_PITCH + ch * 16) = qpre[i]; }
        { const int tn = tile + (G >> 3); if (tn < ntile) {
#pragma unroll
            for (int i = 0; i < 4; ++i) { const int idx = tid + 512 * i, row = idx >> 5, ch = idx & 31;
                qpre[i] = *(const GAS u32x4*)((const GAS bf16_t*)(ws + WS_QP) + ((size_t)tn * 64 + row) * 2048 + h * 256 + ch * 8); } } }
        LDS_BAR();
        {
            const int mt = wave & 3, p = wave >> 2;
            unsigned key[32];
#pragma unroll
            for (int nt = 0; nt < 8; ++nt) { f32x4 acc = (f32x4){0.f, 0.f, 0.f, 0.f};
#pragma unroll
                for (int ks = 0; ks < 4; ++ks) acc = MFMA16(lfrag(KY + p * 128 * PS_PITCH, PS_PITCH, nt * 16 + fr, ks * 32, fq), lfrag(QL, PQ_PITCH, mt * 16 + fr, p * 128 + ks * 32, fq), acc);
#pragma unroll
                for (int j = 0; j < 4; ++j) { const int n = nt * 16 + 4 * fq + j; key[nt * 4 + j] = (f2ord(acc[j]) & ~127u) | (unsigned)(127 - n); } }
#pragma unroll 1
            for (int k = 0; k < 16; ++k) {
                unsigned t3[11];
#pragma unroll
                for (int e = 0; e < 10; ++e) t3[e] = umax_(umax_(key[3 * e], key[3 * e + 1]), key[3 * e + 2]);
                t3[10] = umax_(key[30], key[31]);
                const unsigned u0 = umax_(umax_(t3[0], t3[1]), t3[2]), u1 = umax_(umax_(t3[3], t3[4]), t3[5]), u2 = umax_(umax_(t3[6], t3[7]), t3[8]), u3 = umax_(t3[9], t3[10]);
                unsigned m = umax_(umax_(u0, u1), umax_(u2, u3));
                m = umax_(m, (unsigned)SWZI_(m, 0x401F)); m = umax_(m, xor32u_(m, lane >= 32));
#pragma unroll
                for (int e = 0; e < 32; ++e) key[e] = (key[e] == m) ? 0u : key[e];
                if (fq == (k & 3)) TOP[(p * 64 + mt * 16 + fr) * 16 + k] = m;
            }
        }
        LDS_BAR();
        {
            const int t = tid >> 3, sub = tid & 7;
            unsigned ck[7];
#pragma unroll
            for (int e = 0; e < 7; ++e) {
                const int ci = sub + 8 * e;
                int i = 0, base = 0; bool ok = ci < 50;
                if (ci >= 42) { i = 8 + (ci - 42); base = ci; } else if (ci >= 40) { i = 7; base = 40; } else if (ci >= 38) { i = 6; base = 38; } else if (ci >= 36) { i = 5; base = 36; }
                else if (ci >= 33) { i = 4; base = 33; } else if (ci >= 29) { i = 3; base = 29; } else if (ci >= 24) { i = 2; base = 24; } else if (ci >= 16) { i = 1; base = 16; }
                const int j = ci - base;
                unsigned kk = 0u;
                if (ok) { const float s0 = ord2f(TOP[(0 * 64 + t) * 16 + i] & ~127u), s1 = ord2f(TOP[(1 * 64 + t) * 16 + j] & ~127u);
                    kk = (f2ord(s0 + s1) & ~255u) | (unsigned)(255 - (i * 16 + j)); }
                ck[e] = kk;
            }
            unsigned w0 = 0u, w1 = 0u;
#pragma unroll 1
            for (int k = 0; k < 16; ++k) {
                unsigned m = umax_(umax_(umax_(ck[0], ck[1]), ck[2]), umax_(umax_(umax_(ck[3], ck[4]), ck[5]), ck[6]));
                m = umax_(m, (unsigned)DPPI_(m, 0xB1)); m = umax_(m, (unsigned)DPPI_(m, 0x4E)); m = umax_(m, (unsigned)DPPI_(m, 0x141));
#pragma unroll
                for (int e = 0; e < 7; ++e) ck[e] = (ck[e] == m) ? 0u : ck[e];
                if (k == sub) w0 = m; if (k == sub + 8) w1 = m;
            }
            const int f0 = 255 - (int)(w0 & 255u), f1 = 255 - (int)(w1 & 255u);
            const float sc0 = ord2f(w0 & ~255u), sc1 = ord2f(w1 & ~255u);
            float mx = fmaxf(sc0, sc1); mx = fmaxf(mx, DPP_(mx, 0xB1)); mx = fmaxf(mx, DPP_(mx, 0x4E)); mx = fmaxf(mx, DPP_(mx, 0x141));
            const float e0 = __expf(sc0 - mx), e1 = __expf(sc1 - mx);
            float sm = e0 + e1; sm += DPP_(sm, 0xB1); sm += DPP_(sm, 0x4E); sm += DPP_(sm, 0x141);
            const float inv = 1.0f / sm;
            const int i0 = 127 - (int)(TOP[(0 * 64 + t) * 16 + (f0 >> 4)] & 127u), j0 = 127 - (int)(TOP[(1 * 64 + t) * 16 + (f0 & 15)] & 127u);
            const int i1 = 127 - (int)(TOP[(0 * 64 + t) * 16 + (f1 >> 4)] & 127u), j1 = 127 - (int)(TOP[(1 * 64 + t) * 16 + (f1 & 15)] & 127u);
            unsigned short* ei = (unsigned short*)(ws + WS_EIDX) + ((t0 + t) * 8 + h) * 16; float* gp = (float*)(ws + WS_GATE) + ((t0 + t) * 8 + h) * 16;
            ei[sub] = (unsigned short)(i0 * 128 + j0); ei[sub + 8] = (unsigned short)(i1 * 128 + j1); gp[sub] = e0 * inv; gp[sub + 8] = e1 * inv;
        }
    }
    __syncthreads();
}

__device__ __forceinline__ void ins16(float (&v)[16], int (&id)[16], float x, int n) {
    if (x > v[15]) { v[15] = x; id[15] = n;
#pragma unroll
        for (int i = 15; i >= 1; --i) { if (v[i] > v[i - 1]) { const float tv = v[i]; v[i] = v[i - 1]; v[i - 1] = tv; const int ti = id[i]; id[i] = id[i - 1]; id[i - 1] = ti; } } }
}
__device__ __forceinline__ void phase_topk_ref(const DArgs& a, int vcu, int G) {
    const int tid = tid_();
    GAS unsigned char* ws = a.ws;
    const int gt = vcu * NTHR + tid, NGT = G * NTHR;
    for (int pair = gt; pair < T * 8; pair += NGT) {
        const int t = pair >> 3, h = pair & 7;
        float sv[2][16]; int si[2][16];
#pragma unroll
        for (int p = 0; p < 2; ++p) {
#pragma unroll
            for (int i = 0; i < 16; ++i) { sv[p][i] = -INFINITY; si[p][i] = 0; }
            const bf16_t* qp = (const bf16_t*)(ws + WS_QP) + (size_t)t * 2048 + h * 256 + p * 128;
            for (int n = 0; n < 128; ++n) {
                const bf16_t* kp = (const bf16_t*)(ws + WS_SK) + ((size_t)(h * 2 + p) * 128 + n) * 128;
                float s = 0.f;
                for (int c = 0; c < 128; c += 8) { const u32x4 qv = *(const u32x4*)(qp + c), kv = *(const u32x4*)(kp + c);
                    s += bf_lo(qv.x) * bf_lo(kv.x) + bf_hi(qv.x) * bf_hi(kv.x) + bf_lo(qv.y) * bf_lo(kv.y) + bf_hi(qv.y) * bf_hi(kv.y)
                       + bf_lo(qv.z) * bf_lo(kv.z) + bf_hi(qv.z) * bf_hi(kv.z) + bf_lo(qv.w) * bf_lo(kv.w) + bf_hi(qv.w) * bf_hi(kv.w); }
                ins16(sv[p], si[p], s, n);
            }
        }
        float tv[16]; int ti[16];
#pragma unroll
        for (int i = 0; i < 16; ++i) { tv[i] = -INFINITY; ti[i] = 0; }
#pragma unroll
        for (int i = 0; i < 16; ++i)
#pragma unroll
            for (int j = 0; j < 16; ++j) ins16(tv, ti, sv[0][i] + sv[1][j], i * 16 + j);
        float sm = 0.f, ex[16];
#pragma unroll
        for (int k = 0; k < 16; ++k) { ex[k] = __expf(tv[k] - tv[0]); sm += ex[k]; }
        int* ei = (int*)(ws + WS_EIDX) + (size_t)pair * 16; float* gp = (float*)(ws + WS_GATE) + (size_t)pair * 16;
#pragma unroll
        for (int k = 0; k < 16; ++k) {
            int e0 = 0, e1 = 0;
#pragma unroll
            for (int i = 0; i < 16; ++i) { e0 = ((ti[k] >> 4) == i) ? si[0][i] : e0; e1 = ((ti[k] & 15) == i) ? si[1][i] : e1; }
            ei[k] = e0 * 128 + e1; gp[k] = ex[k] / sm; }
    }
}

#define FP8LO(w) __builtin_amdgcn_cvt_pk_f32_fp8((int)(w), false)
#define FP8HI(w) __builtin_amdgcn_cvt_pk_f32_fp8((int)(w), true)
__device__ __forceinline__ float dot16_fp8(const u32x4 r, const float (&x)[16]) {
    float c = 0.f;
#pragma unroll
    for (int j = 0; j < 4; ++j) { const f32x2 lo = FP8LO(r[j]), hi = FP8HI(r[j]); c += lo[0] * x[4 * j] + lo[1] * x[4 * j + 1] + hi[0] * x[4 * j + 2] + hi[1] * x[4 * j + 3]; }
    return c;
}
__device__ __forceinline__ float dot16_fp8p(const u32x4 r, const f32x2 (&xp)[8]) {
    f32x2 c2 = (f32x2){0.f, 0.f};
#pragma unroll
    for (int j = 0; j < 4; ++j) { c2 += FP8LO(r[j]) * xp[2 * j]; c2 += FP8HI(r[j]) * xp[2 * j + 1]; }
    return c2[0] + c2[1];
}
__device__ __forceinline__ float gelu_erf(float d) {
    const float ad = fabsf(d), t = __builtin_amdgcn_rcpf(ad * 0.2316418882f + 1.0f);
    float q = t * 0.5307027145f + (-0.7265760135f); q = q * t + 0.7107068705f; q = q * t + (-0.142248368f); q = q * t + 0.127414796f; q = q * t;
    const float m = d * (q * __builtin_amdgcn_exp2f(d * d * (-0.72134752044f)));
    return d < 0.f ? m : d - m;
}
__device__ __forceinline__ float bperm(float v, int srclane) { return __builtin_bit_cast(float, __builtin_amdgcn_ds_bpermute(srclane << 2, __builtin_bit_cast(int, v))); }
#define SWZ_(v, pat) __builtin_bit_cast(float, __builtin_amdgcn_ds_swizzle(__builtin_bit_cast(int, (v)), (pat)))
__device__ __forceinline__ float rs32_(float a, float b) {
#if defined(__HIP_DEVICE_COMPILE__)
    asm volatile("s_nop 1\n\tv_permlane32_swap_b32 %0, %1" : "+v"(a), "+v"(b));
#endif
    return a + b;
}
__device__ __forceinline__ float rs16_(float a, float b) {
#if defined(__HIP_DEVICE_COMPILE__)
    asm volatile("s_nop 1\n\tv_permlane16_swap_b32 %0, %1" : "+v"(a), "+v"(b));
#endif
    return a + b;
}
__device__ __forceinline__ float rs8_(float a, float b, bool bit3) {
    const float send = bit3 ? a : b, keep = bit3 ? b : a;
    return keep + DPP_(send, 0x128);
}
__device__ __forceinline__ float xor32_(float v, bool hi) {
#if defined(__HIP_DEVICE_COMPILE__)
    const auto r = __builtin_amdgcn_permlane32_swap(__builtin_bit_cast(unsigned, v), __builtin_bit_cast(unsigned, v), false, false);
    return __builtin_bit_cast(float, hi ? r[0] : r[1]);
#else
    (void)hi; return v;
#endif
}
__device__ __forceinline__ float reduce8(const float (&p)[8], int lane) {
    float q4[4], q2[2];
    const bool b5 = lane & 32, b4 = lane & 16, b3 = lane & 8;
#pragma unroll
    for (int i = 0; i < 4; ++i) { const float send = b5 ? p[i] : p[i + 4], keep = b5 ? p[i + 4] : p[i]; q4[i] = keep + xor32_(send, b5); }
#pragma unroll
    for (int i = 0; i < 2; ++i) { const float send = b4 ? q4[i] : q4[i + 2], keep = b4 ? q4[i + 2] : q4[i]; q2[i] = keep + SWZ_(send, 0x401F); }
    const float send = b3 ? q2[0] : q2[1], keep = b3 ? q2[1] : q2[0];
    float q1 = keep + SWZ_(send, 0x201F);
    q1 += DPP_(q1, 0xB1); q1 += DPP_(q1, 0x4E); q1 += DPP_(q1, 0x141);
    return q1;
}
__device__ __forceinline__ void phase_udots(const DArgs& a, LAS unsigned char* lds) {
    const int tid = tid_(), lane = tid & 63, wave = __builtin_amdgcn_readfirstlane(tid >> 6);
    GAS unsigned char* ws = a.ws;
    volatile LAS unsigned* bst = (volatile LAS unsigned*)(lds + LDS_BARST);
    const int nloc = (int)bst[0], nx = (int)bst[1], rank = (int)bst[2];
    unsigned* bar = (unsigned*)(ws + WS_CTL) + CW_BAR;
    const unsigned myx = xb_xcc_id();
    int q = 0;
    for (unsigned j = 0; j < 16; ++j) { const unsigned c = xb_ld(&bar[XB_XCNT(j)]); if (c > 0u && j < myx) ++q; }
    LAS int* LE = (LAS int*)(lds + wave * 2048);
    LAS int* LP = LE + 128; LAS float* LG = (LAS float*)(LE + 256);
    const GAS unsigned char* UB = ws + WS_UB;
    const int g8 = lane >> 3;
    const float usc = ((const GAS float*)(ws + WS_USC))[0], vsc = ((const GAS float*)(ws + WS_USC))[1];
    for (int s = q; s < 8; s += nx) {
        int tok = rank * 8 + wave;
        u32x4 xq0 = (u32x4){0u, 0u, 0u, 0u}, xq1 = xq0; u32x2 e2 = (u32x2){0u, 0u}; f32x2 g2 = (f32x2){0.f, 0.f};
#define U_INFO(t_) do { xq0 = *(const u32x4*)((const GAS bf16_t*)(ws + WS_XN) + (size_t)(t_) * D + lane * 16); xq1 = *(const u32x4*)((const GAS bf16_t*)(ws + WS_XN) + (size_t)(t_) * D + lane * 16 + 8); \
        e2 = *(const u32x2*)((const GAS int*)(ws + WS_EIDX) + (size_t)(t_) * 128 + 2 * lane); g2 = *(const f32x2*)((const GAS float*)(ws + WS_GATE) + (size_t)(t_) * 128 + 2 * lane); } while (0)
        if (tok < T) U_INFO(tok);
        for (; tok < T; tok += nloc * 8) {
            const bool in0 = (int)(e2.x >> 11) == s, in1 = (int)(e2.y >> 11) == s;
            const unsigned long long m0 = __ballot(in0), m1 = __ballot(in1);
            const unsigned long long lt = (1ull << lane) - 1ull;
            const int n0 = __popcll(m0), n = n0 + __popcll(m1);
            if (in0) { const int pos = __popcll(m0 & lt); LE[pos] = (int)e2.x; LP[pos] = 2 * lane; LG[pos] = g2[0]; }
            if (in1) { const int pos = n0 + __popcll(m1 & lt); LE[pos] = (int)e2.y; LP[pos] = 2 * lane + 1; LG[pos] = g2[1]; }
            const float xf[16] = {bf_lo(xq0.x), bf_hi(xq0.x), bf_lo(xq0.y), bf_hi(xq0.y), bf_lo(xq0.z), bf_hi(xq0.z), bf_lo(xq0.w), bf_hi(xq0.w),
                                  bf_lo(xq1.x), bf_hi(xq1.x), bf_lo(xq1.y), bf_hi(xq1.y), bf_lo(xq1.z), bf_hi(xq1.z), bf_lo(xq1.w), bf_hi(xq1.w)};
            asm volatile("s_waitcnt lgkmcnt(0)" ::: "memory");
            u32x4 R0[8], R1[8], R2[8];
#define U_ISSUE(R_, g0_) do { _Pragma("unroll") for (int k = 0; k < 8; ++k) { const int slot_ = ((g0_) + k < n) ? (g0_) + k : n - 1; const int e_ = LE[slot_]; R_[k] = *(const u32x4*)(UB + (size_t)e_ * 1024 + lane * 16); } } while (0)
#define U_DOTS(R_, g0_) do { float pp_[8]; _Pragma("unroll") for (int k = 0; k < 8; ++k) pp_[k] = dot16_fp8(R_[k], xf); const float dsum_ = reduce8(pp_, lane); const int slot_ = (g0_) + g8; \
            if (slot_ < n && (lane & 7) == 0) { const float d_ = dsum_ * usc; \
                ((GAS float*)(ws + WS_PW))[(size_t)tok * 128 + LP[slot_]] = 0.5f * d_ * (1.0f + erff(d_ * 0.70710678118654752f)) * LG[slot_] * vsc; } } while (0)
            if (n > 0) U_ISSUE(R0, 0);
            if (n > 8) U_ISSUE(R1, 8);
            if (n > 16) U_ISSUE(R2, 16);
            const int tokN = tok + nloc * 8;
            if (tokN < T) U_INFO(tokN);
            if (n > 0) U_DOTS(R0, 0);
            if (n > 8) U_DOTS(R1, 8);
            if (n > 16) U_DOTS(R2, 16);
            for (int g0 = 24; g0 < n; g0 += 8) { U_ISSUE(R0, g0); U_DOTS(R0, g0); }
            asm volatile("s_waitcnt lgkmcnt(0)" ::: "memory");
        }
#undef U_INFO
#undef U_ISSUE
#undef U_DOTS
    }
}

#define EV_OFF(ev_, g_) (((g_) & 1) ? ((ev_[(g_) >> 3][((g_) >> 1) & 3] >> 9) & 0x7fff80u) : ((ev_[(g_) >> 3][((g_) >> 1) & 3] << 7) & 0x7fff80u))
struct XcdSlice { int nloc, nx, rank, q; };
__device__ __forceinline__ XcdSlice xcd_slice_setup(const DArgs& a, LAS unsigned char* lds) {
    volatile LAS unsigned* bst = (volatile LAS unsigned*)(lds + LDS_BARST);
    XcdSlice x; x.nloc = __builtin_amdgcn_readfirstlane((int)bst[0]); x.nx = __builtin_amdgcn_readfirstlane((int)bst[1]); x.rank = __builtin_amdgcn_readfirstlane((int)bst[2]);
    unsigned* bar = (unsigned*)(a.ws + WS_CTL) + CW_BAR; const unsigned myx = xb_xcc_id();
    x.q = 0; for (unsigned j = 0; j < 16; ++j) { const unsigned c = xb_ld(&bar[XB_XCNT(j)]); if (c > 0u && j < myx) ++x.q; }
    x.q = __builtin_amdgcn_readfirstlane(x.q);
    return x;
}
__device__ __forceinline__ void phase_ua(const DArgs& a, LAS unsigned char* lds) {
    const int tid = tid_(), lane = tid & 63, wave = __builtin_amdgcn_readfirstlane(tid >> 6), k = lane >> 3, c = lane & 7;
    GAS unsigned char* ws = a.ws;
    const XcdSlice X = xcd_slice_setup(a, lds);
    const int tstride = X.nloc * 8;
    for (int sl = X.q; sl < 8; sl += X.nx) {
        const GAS unsigned char* UBs = ws + WS_UB + (size_t)sl * 2097152;
        const unsigned coff = (unsigned)c * 16u;
        GAS unsigned char* PU = ws + WS_PARTU + (size_t)sl * T * 256;
        u32x4 evA[2], evB[2], RA[16], RB[16], xa, xb; float sa, sb;
#define A_TOK(t_) ((t_) < T ? (t_) : T - 1)
#define A_INFO(ev_, t_) do { const int tq_ = A_TOK(t_); _Pragma("unroll") for (int j_ = 0; j_ < 2; ++j_) ev_[j_] = *(const GAS u32x4*)(ws + WS_EIDX + (size_t)tq_ * 256 + (unsigned)(32 * k + 16 * j_)); } while (0)
#define A_ISSUE(R_, x_, s_, ev_, t_) do { const int tq_ = A_TOK(t_); _Pragma("unroll") for (int g_ = 0; g_ < 16; ++g_) R_[g_] = *(const GAS u32x4*)(UBs + (EV_OFF(ev_, g_) | coff)); \
        x_ = *(const GAS u32x4*)(ws + WS_XQ + (size_t)tq_ * 1024 + sl * 128 + coff); s_ = ((const GAS float*)(ws + WS_XQS))[tq_]; } while (0)
#define A_DOTS(R_, x_, s_, t_) do { \
        int ir0_ = 0, ir1_ = 0; \
        _Pragma("unroll") for (int gg_ = 0; gg_ < 4; ++gg_) {           \
            int d_[4]; _Pragma("unroll") for (int q_ = 0; q_ < 4; ++q_) d_[q_] = 0; \
            _Pragma("unroll") for (int j_ = 0; j_ < 4; ++j_) { _Pragma("unroll") for (int q_ = 0; q_ < 4; ++q_) d_[q_] = __builtin_amdgcn_sdot4((int)R_[4 * gg_ + q_][j_], (int)x_[j_], d_[q_], false); } \
            _Pragma("unroll") for (int q_ = 0; q_ < 4; ++q_) d_[q_] += DPPI_(d_[q_], 0xB1); \
            _Pragma("unroll") for (int q_ = 0; q_ < 4; ++q_) d_[q_] += DPPI_(d_[q_], 0x4E); \
            _Pragma("unroll") for (int q_ = 0; q_ < 4; ++q_) d_[q_] += DPPI_(d_[q_], 0x141);          \
            _Pragma("unroll") for (int q_ = 0; q_ < 4; ++q_) { if (c == ((4 * gg_ + q_) >> 1)) { if (q_ & 1) ir1_ = d_[q_]; else ir0_ = d_[q_]; } }          \
            __builtin_amdgcn_sched_barrier(0); } \
        if ((t_) < T) *(GAS unsigned*)(PU + (size_t)(t_) * 256 + (unsigned)(4 * lane)) = pk2((float)ir0_ * s_, (float)ir1_ * s_); } while (0)
        const int n0 = X.rank * 8 + wave;
        A_INFO(evA, n0); A_INFO(evB, n0 + tstride);
        __builtin_amdgcn_sched_barrier(0);
        A_ISSUE(RA, xa, sa, evA, n0);
        __builtin_amdgcn_sched_barrier(0);
#pragma unroll 1
        for (int n = n0; n < T; n += 2 * tstride) {
            A_INFO(evA, n + 2 * tstride);
            __builtin_amdgcn_sched_barrier(0);
            A_ISSUE(RB, xb, sb, evB, n + tstride);
            __builtin_amdgcn_sched_barrier(0);
            A_DOTS(RA, xa, sa, n);
            __builtin_amdgcn_sched_barrier(0);
            A_INFO(evB, n + 3 * tstride);
            __builtin_amdgcn_sched_barrier(0);
            A_ISSUE(RA, xa, sa, evA, n + 2 * tstride);
            __builtin_amdgcn_sched_barrier(0);
            A_DOTS(RB, xb, sb, n + tstride);
            __builtin_amdgcn_sched_barrier(0);
        }
#undef A_TOK
#undef A_INFO
#undef A_ISSUE
#undef A_DOTS
    }
}
__device__ __forceinline__ void phase_ua2(const DArgs& a, int vcu, int G) {
    const int tid = tid_();
    GAS unsigned char* ws = a.ws;
    const GAS float* USC = (const GAS float*)(ws + WS_USC); const GAS float* VSC = (const GAS float*)(ws + WS_VSC);
    const GAS unsigned char* PU = ws + WS_PARTU;
    const size_t N4 = (size_t)T * 128 / 4, stride = (size_t)G * NTHR;
    for (size_t i = (size_t)vcu * NTHR + tid; i < N4; i += 2 * stride) {
        const size_t i1 = (i + stride < N4) ? i + stride : i;
        u32x2 pv0[8], pv1[8];
#pragma unroll
        for (int sl = 0; sl < 8; ++sl) { pv0[sl] = ((const GAS u32x2*)(PU + (size_t)sl * T * 256))[i]; pv1[sl] = ((const GAS u32x2*)(PU + (size_t)sl * T * 256))[i1]; }
        const f32x4 gt0 = ((const GAS f32x4*)(ws + WS_GATE))[i], gt1 = ((const GAS f32x4*)(ws + WS_GATE))[i1];
        const u32x2 ep0 = ((const GAS u32x2*)(ws + WS_EIDX))[i], ep1 = ((const GAS u32x2*)(ws + WS_EIDX))[i1];
        const unsigned e0[4] = {ep0.x & 0xffffu, ep0.x >> 16, ep0.y & 0xffffu, ep0.y >> 16}, e1[4] = {ep1.x & 0xffffu, ep1.x >> 16, ep1.y & 0xffffu, ep1.y >> 16};
        float us0[4], vs0[4], us1[4], vs1[4];
#pragma unroll
        for (int e = 0; e < 4; ++e) { us0[e] = USC[e0[e]]; vs0[e] = VSC[e0[e]]; us1[e] = USC[e1[e]]; vs1[e] = VSC[e1[e]]; }
        f32x4 d0 = (f32x4){0.f, 0.f, 0.f, 0.f}, d1 = d0;
#pragma unroll
        for (int sl = 0; sl < 8; ++sl) { d0[0] += bf_lo(pv0[sl].x); d0[1] += bf_hi(pv0[sl].x); d0[2] += bf_lo(pv0[sl].y); d0[3] += bf_hi(pv0[sl].y);
                                         d1[0] += bf_lo(pv1[sl].x); d1[1] += bf_hi(pv1[sl].x); d1[2] += bf_lo(pv1[sl].y); d1[3] += bf_hi(pv1[sl].y); }
        f32x4 w0, w1;
#pragma unroll
        for (int e = 0; e < 4; ++e) { w0[e] = gelu_erf(d0[e] * us0[e]) * gt0[e] * vs0[e]; w1[e] = gelu_erf(d1[e] * us1[e]) * gt1[e] * vs1[e]; }
        u32x2 wo; wo.x = pk2(w0[0], w0[1]); wo.y = pk2(w0[2], w0[3]); ((GAS u32x2*)(ws + WS_PW))[i] = wo;
        if (i + stride < N4) { wo.x = pk2(w1[0], w1[1]); wo.y = pk2(w1[2], w1[3]); ((GAS u32x2*)(ws + WS_PW))[i1] = wo; }
    }
}
__device__ __forceinline__ void phase_vb(const DArgs& a, LAS unsigned char* lds) {
    const int tid = tid_(), lane = tid & 63, wave = __builtin_amdgcn_readfirstlane(tid >> 6), k = lane >> 3, c = lane & 7;
    GAS unsigned char* ws = a.ws;
    const XcdSlice X = xcd_slice_setup(a, lds);
    const int tstride = X.nloc * 8;
    const bool bit3 = (lane & 8) != 0;
    for (int sl = X.q; sl < 8; sl += X.nx) {
        const GAS unsigned char* VBs = ws + WS_VB + (size_t)sl * 2097152;
        const unsigned coff = (unsigned)c * 16u;
        const unsigned xoff = (unsigned)(sl * 128 + c * 16 + 2 * k) * 4u;
        u32x4 evA[2], evB[2], RA[16], RB[16], wa[2], wb[2]; unsigned xa, xb;
#define B_TOK(t_) ((t_) < T ? (t_) : T - 1)
#define B_INFO(ev_, t_) do { const int tq_ = B_TOK(t_); _Pragma("unroll") for (int j_ = 0; j_ < 2; ++j_) ev_[j_] = *(const GAS u32x4*)(ws + WS_EIDX + (size_t)tq_ * 256 + (unsigned)(32 * k + 16 * j_)); } while (0)
#define B_ISSUE(R_, w_, x_, ev_, t_) do { const int tq_ = B_TOK(t_); _Pragma("unroll") for (int g_ = 0; g_ < 16; ++g_) R_[g_] = *(const GAS u32x4*)(VBs + (EV_OFF(ev_, g_) | coff)); \
        _Pragma("unroll") for (int j_ = 0; j_ < 2; ++j_) w_[j_] = *(const GAS u32x4*)(ws + WS_PW + (size_t)tq_ * 256 + (unsigned)(32 * k + 16 * j_)); \
        x_ = *(const GAS unsigned*)((const GAS unsigned char*)a.out + (size_t)tq_ * (D * 2) + (xoff >> 1)); } while (0)
#define B_DOTS(R_, w_, x_, t_) do { \
        f32x2 acc2_[8]; _Pragma("unroll") for (int e_ = 0; e_ < 8; ++e_) acc2_[e_] = (f32x2){0.f, 0.f}; \
        _Pragma("unroll") for (int g_ = 0; g_ < 16; ++g_) { const unsigned ww_ = w_[g_ >> 3][(g_ >> 1) & 3]; const float wk_ = (g_ & 1) ? bf_hi(ww_) : bf_lo(ww_); const f32x2 wp_ = (f32x2){wk_, wk_}; \
            _Pragma("unroll") for (int jj_ = 0; jj_ < 4; ++jj_) { acc2_[2 * jj_] += wp_ * FP8LO(R_[g_][jj_]); acc2_[2 * jj_ + 1] += wp_ * FP8HI(R_[g_][jj_]); } \
            if (g_ & 1) __builtin_amdgcn_sched_barrier(0); } \
        f32x2 w2_[4], x2_[2], y_; \
        _Pragma("unroll") for (int i_ = 0; i_ < 4; ++i_) { w2_[i_][0] = rs32_(acc2_[i_][0], acc2_[i_ + 4][0]); w2_[i_][1] = rs32_(acc2_[i_][1], acc2_[i_ + 4][1]); } \
        _Pragma("unroll") for (int i_ = 0; i_ < 2; ++i_) { x2_[i_][0] = rs16_(w2_[i_][0], w2_[i_ + 2][0]); x2_[i_][1] = rs16_(w2_[i_][1], w2_[i_ + 2][1]); } \
        y_[0] = rs8_(x2_[0][0], x2_[1][0], bit3) + bf_lo(x_); y_[1] = rs8_(x2_[0][1], x2_[1][1], bit3) + bf_hi(x_); \
        const float ss_ = wave_sum(y_[0] * y_[0] + y_[1] * y_[1], lane); \
        if ((t_) < T) { *(GAS unsigned*)(ws + WS_PARTU + (size_t)(t_) * (D * 2) + (xoff >> 1)) = pk2(y_[0], y_[1]);       \
            if (lane == 0) ((GAS float*)(ws + WS_SS))[(size_t)(t_) * 8 + sl] = ss_; } } while (0)
        const int n0 = X.rank * 8 + wave;
        B_INFO(evA, n0); B_INFO(evB, n0 + tstride);
        __builtin_amdgcn_sched_barrier(0);
        B_ISSUE(RA, wa, xa, evA, n0);
        __builtin_amdgcn_sched_barrier(0);
#pragma unroll 1
        for (int n = n0; n < T; n += 2 * tstride) {
            B_INFO(evA, n + 2 * tstride);
            __builtin_amdgcn_sched_barrier(0);
            B_ISSUE(RB, wb, xb, evB, n + tstride);
            __builtin_amdgcn_sched_barrier(0);
            B_DOTS(RA, wa, xa, n);
            __builtin_amdgcn_sched_barrier(0);
            B_INFO(evB, n + 3 * tstride);
            __builtin_amdgcn_sched_barrier(0);
            B_ISSUE(RA, wa, xa, evA, n + 2 * tstride);
            __builtin_amdgcn_sched_barrier(0);
            B_DOTS(RB, wb, xb, n + tstride);
            __builtin_amdgcn_sched_barrier(0);
        }
#undef B_TOK
#undef B_INFO
#undef B_ISSUE
#undef B_DOTS
    }
}
__device__ __forceinline__ void phase_vc(const DArgs& a, int vcu, int G) {
    const int tid = tid_(), lane = tid & 63, wave = tid >> 6;
    const int gw = vcu * NWAVES + wave, NGW = G * NWAVES;
    GAS unsigned char* ws = a.ws;
    f32x4 gf[4];
#pragma unroll
    for (int j = 0; j < 4; ++j) gf[j] = ((const GAS f32x4*)a.final_g)[64 * j + lane];
    for (int m = gw; m < T; m += NGW) {
        const f32x4 s0 = *(const GAS f32x4*)((const GAS float*)(ws + WS_SS) + (size_t)m * 8), s1 = *(const GAS f32x4*)((const GAS float*)(ws + WS_SS) + (size_t)m * 8 + 4);
        const float rstd = rsqrtf(((s0[0] + s0[1]) + (s0[2] + s0[3]) + (s1[0] + s1[1]) + (s1[2] + s1[3])) * (1.f / D) + EPS);
        const GAS u32x2* xi = (const GAS u32x2*)(ws + WS_PARTU + (size_t)m * (D * 2)) + lane;
        GAS f32x4* o = (GAS f32x4*)(a.out + (size_t)m * D) + lane;
#pragma unroll
        for (int j = 0; j < 4; ++j) { const u32x2 xv = xi[64 * j]; f32x4 v; v[0] = bf_lo(xv.x); v[1] = bf_hi(xv.x); v[2] = bf_lo(xv.y); v[3] = bf_hi(xv.y); o[64 * j] = v * rstd * gf[j]; }
    }
}

__device__ __forceinline__ void phase_final_plain(const DArgs& a, const float* src, int vcu, int G) {
    const int tid = tid_(), lane = tid & 63, wave = tid >> 6;
    const int gw = vcu * NWAVES + wave, NGW = G * NWAVES;
    f32x4 gf[4];
#pragma unroll
    for (int j = 0; j < 4; ++j) gf[j] = ((const f32x4*)a.final_g)[64 * j + lane];
    for (int m = gw; m < T; m += NGW) {
        const f32x4* xr = (const f32x4*)(src + (size_t)m * D) + lane;
        f32x4 v[4]; float s = 0.f;
#pragma unroll
        for (int j = 0; j < 4; ++j) { v[j] = xr[64 * j]; s += (v[j][0] * v[j][0] + v[j][1] * v[j][1]) + (v[j][2] * v[j][2] + v[j][3] * v[j][3]); }
        const float rstd = rsqrtf(wave_sum(s, lane) * (1.f / D) + EPS);
        f32x4* o = (f32x4*)(a.out + (size_t)m * D) + lane;
#pragma unroll
        for (int j = 0; j < 4; ++j) o[64 * j] = v[j] * rstd * gf[j];
    }
}


__device__ __forceinline__ DArgs load_args() {
    DArgs r;
#if defined(__HIP_DEVICE_COMPILE__)
    typedef const DArgs __attribute__((address_space(4))) KArgs;
    KArgs* p = (KArgs*)__builtin_amdgcn_kernarg_segment_ptr();
    asm volatile("" : "+s"(p));
    r.x = p->x; r.norm1_g = p->norm1_g; r.w_in = p->w_in; r.b_in = p->b_in; r.conv_w = p->conv_w; r.conv_b = p->conv_b; r.m_head_g = p->m_head_g; r.lb_table = p->lb_table;
    r.g_head_g = p->g_head_g; r.w_br_m = p->w_br_m; r.w_br_g = p->w_br_g; r.w_out = p->w_out; r.norm2_g = p->norm2_g; r.w_pq = p->w_pq; r.sub_keys = p->sub_keys;
    r.u_emb = p->u_emb; r.v_emb = p->v_emb; r.final_g = p->final_g; r.out = p->out; r.ws = p->ws;
#else
    r = DArgs{};
#endif
    return r;
}
__device__ __forceinline__ EpiPtrs make_ep(const DArgs& a, int round) {
    EpiPtrs ep; ep.biasp = (const GAS float*)(a.ws + WS_BIASP); ep.lb = (const GAS float*)(a.ws + WS_LB); ep.x = a.x; ep.out = a.out; ep.ws = a.ws; ep.round = round; ep.sa = (const GAS float*)(a.ws + WS_SA8); ep.sb = (const GAS float*)(a.ws + WS_SB8); return ep;
}
#define GRID_SYNC() do { const DArgs a_ = load_args(); xcd_barrier((unsigned*)(a_.ws + WS_CTL) + CW_BAR, (volatile LAS unsigned*)(lds + LDS_BARST)); } while (0)

__device__ __forceinline__ int bx_() { int t = blockIdx.x; asm volatile("" : "+s"(t)); return t; }
__device__ __forceinline__ int gd_() { int t = gridDim.x; asm volatile("" : "+s"(t)); return t; }
#define PH_BEGIN const DArgs a = load_args(); const int bx = bx_(), G = gd_(); const int vcu = (G % 8 == 0) ? (bx % 8) * (G / 8) + bx / 8 : bx; (void)vcu; (void)bx;

__global__ void __launch_bounds__(NTHR, 2) fwd_megakernel(Args a_unused) {
    extern __shared__ __attribute__((aligned(16))) unsigned char lds_raw[];
    LAS unsigned char* lds = (LAS unsigned char*)lds_raw;
    cg::grid_group grid = cg::this_grid();

    { const int t_ = tid_(); if (t_ < 16) ((LAS unsigned*)(lds + LDS_BARST))[t_] = 0u; __syncthreads();
      const DArgs a_ = load_args(); xcd_barrier_post((unsigned*)(a_.ws + WS_CTL) + CW_BAR, (volatile LAS unsigned*)(lds + LDS_BARST)); }
    { PH_BEGIN phase_p0(a, lds, vcu, G); }
    grid.sync();
    { PH_BEGIN phase_p0c(a, lds, vcu, G); }
    GRID_SYNC();
#pragma unroll 1
    for (int round = 0; round < NROUND; ++round) {
        {
            PH_BEGIN
            {
                pg8::Gemm g{(const bf16_t*)(a.ws + WS_XN8), (const bf16_t*)(a.ws + WS_W8A), RT, 4096, D / 2};
                pg8::StaticOrder S; S.init(RT, 4096, G, bx);
                EpiX<7> E{make_ep(a, round)};
                pg8::gemm_phase<EpiX<7>, pg8::StaticOrder, true, true, true>(lds, g, S, E);
            }
            {
                pg8::Gemm g{(const bf16_t*)(a.ws + WS_XN) + (size_t)round * RT * D, (const bf16_t*)(a.ws + WS_WIN) + (size_t)4096 * D, RT, N1 - 4096, D};
                pg8::StaticOrder S; S.init(RT, N1 - 4096, G, bx);
                EpiX<1> E{make_ep(a, round)};
                pg8::gemm_phase<EpiX<1>, pg8::StaticOrder, true, true>(lds, g, S, E);
            }
        }
        { PH_BEGIN if (bx < 8) mscan_pair(a, lds, round, bx); }
        GRID_SYNC();
        { PH_BEGIN for (int it = bx; it < 512; it += G) mlstm_pre_item(a, lds, round, it); }
        { PH_BEGIN u32x4 gq[4]; int it = bx; if (it < 2048) hgrn_pre_load(a, round, it, gq);
          for (; it < 2048; it += G) hgrn_pre_item(a, lds, round, it, gq, it + G); }
        GRID_SYNC();
        { PH_BEGIN
          if (bx < 128) mlstm_scan<2, false>(a, lds, round, bx & 7, bx >> 3);
          else if (bx >= 192 && bx < 200) mlstm_scan<1, true>(a, lds, round, bx - 192, 0);
          else if (bx < 192) { const int id2 = bx - 128; hgrn_scan(a, lds, round, (id2 & 7) * 2 + ((id2 >> 3) & 1), id2 >> 4); } }
        GRID_SYNC();
        {
            PH_BEGIN
            pg8::Gemm g{(const bf16_t*)(a.ws + WS_XN8), (const bf16_t*)(a.ws + WS_W8), RT, N2, D / 2};
            pg8::StaticOrder S; S.init(RT, N2, G, bx);
            EpiX<2> E{make_ep(a, round)};
            pg8::gemm_phase<EpiX<2>, pg8::StaticOrder, true, true, true>(lds, g, S, E);
        }
        GRID_SYNC();
        { PH_BEGIN phase_ypass(a, round, vcu, G); }
        if (round + 1 < NROUND) { PH_BEGIN xn8_convert(a, round + 1, vcu, G); }
        GRID_SYNC();
        {
            { PH_BEGIN pg8::StaticOrder S; S.init(RT, D, G, bx);
              pg8::Gemm g{(const bf16_t*)(a.ws + WS_V), (const bf16_t*)(a.ws + WS_WM), RT, D, 2048}; EpiX<3> E{make_ep(a, round)}; pg8::gemm_phase<EpiX<3>, pg8::StaticOrder, true, true>(lds, g, S, E); }
            { PH_BEGIN pg8::StaticOrder S; S.init(RT, D, G, bx);
              pg8::Gemm g{(const bf16_t*)(a.ws + WS_GI), (const bf16_t*)(a.ws + WS_WG), RT, D, D}; EpiX<4> E{make_ep(a, round)}; pg8::gemm_phase<EpiX<4>, pg8::StaticOrder, true, true>(lds, g, S, E); }
        }
        GRID_SYNC();
        {
            PH_BEGIN pg8::StaticOrder S; S.init(RT, D, G, bx);
            pg8::Gemm g{(const bf16_t*)(a.ws + WS_GFLOG), (const bf16_t*)(a.ws + WS_WO), RT, D, D}; EpiX<5> E{make_ep(a, round)}; pg8::gemm_phase<EpiX<5>, pg8::StaticOrder, true, true>(lds, g, S, E);
        }
        GRID_SYNC();
    }
    { PH_BEGIN phase_p8(a, vcu, G); }
    GRID_SYNC();
    {
        PH_BEGIN pg8::StaticOrder S; S.init(T, 2048, G, bx);
        pg8::Gemm g{(const bf16_t*)(a.ws + WS_XN), (const bf16_t*)(a.ws + WS_WPQ), T, 2048, D}; EpiX<6> E{make_ep(a, 0)}; pg8::gemm_phase<EpiX<6>, pg8::StaticOrder, true, true>(lds, g, S, E);
    }
    GRID_SYNC();
#ifdef TOPK_REF
    { PH_BEGIN phase_topk_ref(a, vcu, G); }
#else
    { PH_BEGIN phase_topk(a, lds, bx, G); }
#endif
    GRID_SYNC();
    { PH_BEGIN phase_ua(a, lds); }
    GRID_SYNC();
    { PH_BEGIN phase_ua2(a, vcu, G); }
    GRID_SYNC();
    { PH_BEGIN phase_vb(a, lds); }
    GRID_SYNC();
    { PH_BEGIN phase_vc(a, vcu, G); }
}

extern "C" void kernel_launch(void* const* d_in, const int* in_sizes, int n_in, void* d_out, int out_size, void* d_ws, size_t ws_size, hipStream_t stream) {
    static int grid = 0;
    if (grid == 0) {
        if (n_in != 18 || in_sizes[0] != T * D || out_size != T * D || ws_size < WS_END) {
            fprintf(stderr, "kernel_launch: unexpected shapes/workspace (n_in %d, in0 %d, out %d, ws %zu, need %zu)\n", n_in, n_in > 0 ? in_sizes[0] : -1, out_size, ws_size, (size_t)WS_END);
            grid = -1; return; }
        int dev = 0, cus = 0, per_cu = 0;
        hipGetDevice(&dev);
        hipDeviceGetAttribute(&cus, hipDeviceAttributeMultiprocessorCount, dev);
        hipFuncSetAttribute((const void*)fwd_megakernel, hipFuncAttributeMaxDynamicSharedMemorySize, LDS_BYTES);
        hipOccupancyMaxActiveBlocksPerMultiprocessor(&per_cu, (const void*)fwd_megakernel, NTHR, LDS_BYTES);
        if (per_cu < 1) { fprintf(stderr, "kernel_launch: occupancy query says %d blocks/CU\n", per_cu); per_cu = 1; }
        grid = cus;
        (void)hipGetLastError();
    }
    if (grid < 0) return;
    hipMemsetAsync((char*)d_ws + WS_CTL, 0, 131072, stream);
    Args a{};
    a.x = (const float*)d_in[0]; a.norm1_g = (const float*)d_in[1]; a.w_in = (const float*)d_in[2]; a.b_in = (const float*)d_in[3];
    a.conv_w = (const float*)d_in[4]; a.conv_b = (const float*)d_in[5]; a.m_head_g = (const float*)d_in[6]; a.lb_table = (const float*)d_in[7];
    a.g_head_g = (const float*)d_in[8]; a.w_br_m = (const float*)d_in[9]; a.w_br_g = (const float*)d_in[10]; a.w_out = (const float*)d_in[11];
    a.norm2_g = (const float*)d_in[12]; a.w_pq = (const float*)d_in[13]; a.sub_keys = (const float*)d_in[14]; a.u_emb = (const float*)d_in[15];
    a.v_emb = (const float*)d_in[16]; a.final_g = (const float*)d_in[17];
    a.out = (float*)d_out; a.ws = (unsigned char*)d_ws;
    void* args[] = {&a};
    hipError_t e = hipLaunchCooperativeKernel((const void*)fwd_megakernel, dim3(grid), dim3(NTHR), args, LDS_BYTES, stream);
    if (e != hipSuccess) fprintf(stderr, "cooperative launch failed: %s (grid %d)\n", hipGetErrorString(e), grid);
}
```

```cpp
#include <hip/hip_runtime.h>
#include <hip/hip_cooperative_groups.h>
#include <cstdio>
#include <cstdint>
namespace cg = cooperative_groups;

#define LAS __attribute__((address_space(3)))
typedef unsigned short bf16_t;
typedef short bf16x8 __attribute__((ext_vector_type(8)));
typedef float f32x4 __attribute__((ext_vector_type(4)));
typedef float f32x2 __attribute__((ext_vector_type(2)));
typedef unsigned u32x4 __attribute__((ext_vector_type(4)));
typedef unsigned u32x2 __attribute__((ext_vector_type(2)));

constexpr int D = 1024, BATCH = 4, SEQ = 8192, T = BATCH * SEQ;
constexpr int IN_COLS = 12296, NP = 12288;
constexpr int RT = 16384, NROUND = 2;
constexpr int N1 = 7168, N2 = 5120;
constexpr float EPS = 1e-6f;
constexpr int NWAVES = 8, NTHR = 512;

constexpr size_t MiB = 1u << 20;
constexpr size_t WS_CTL = 0;
constexpr size_t WS_WIN = 1 * MiB;
constexpr size_t WS_WM = 25 * MiB;
constexpr size_t WS_WG = 29 * MiB;
constexpr size_t WS_WO = 31 * MiB;
constexpr size_t WS_WPQ = 33 * MiB;
constexpr size_t WS_SK = 37 * MiB;
constexpr size_t WS_BIASP = 37 * MiB + 512 * 1024;
constexpr size_t WS_LB = WS_BIASP + 64 * 1024;
constexpr size_t WS_GATES = 38 * MiB;
constexpr size_t WS_MPREV = 39 * MiB;
constexpr size_t WS_DEN = 40 * MiB;
constexpr size_t WS_MT = 40 * MiB + 512 * 1024;
constexpr size_t WS_HGDEC = 41 * MiB;
constexpr size_t WS_MDEC = 43 * MiB;
constexpr size_t WS_XN = 44 * MiB;
constexpr size_t WS_QKPRE = 108 * MiB;
constexpr size_t WS_V = 172 * MiB;
constexpr size_t WS_GFLOG = 236 * MiB;
constexpr size_t WS_GI = 268 * MiB;
constexpr size_t WS_GQ = 300 * MiB;
constexpr size_t WS_S = 332 * MiB;
constexpr size_t WS_QT = 348 * MiB;
constexpr size_t WS_KWT = 380 * MiB;
constexpr size_t WS_ATT = 412 * MiB;
constexpr size_t WS_QTG = 428 * MiB;
constexpr size_t WS_KENDT = 460 * MiB;
constexpr size_t WS_SIGO = 332 * MiB;
constexpr size_t WS_SGG = 396 * MiB;
constexpr size_t WS_SAM = 428 * MiB;
constexpr size_t WS_SAG = 460 * MiB;
constexpr size_t WS_XN8 = 492 * MiB;
constexpr size_t WS_SA8 = 508 * MiB;
constexpr size_t WS_SB8 = 508 * MiB + 262144;
constexpr size_t WS_W8A = WS_WIN;
constexpr size_t WS_W8 = WS_WIN + (size_t)7168 * 1024 * 2;
constexpr int NI8 = 4096 + 5120 + 1024 + 1024;
constexpr size_t WS_SYM = 508 * MiB + 524288;
constexpr size_t WS_SYG = 508 * MiB + 655360;
constexpr int CW_COLMAX = 16384;
constexpr size_t WS_END = 510 * MiB;
constexpr size_t WS_QP = 108 * MiB;
constexpr size_t WS_UB = 236 * MiB;
constexpr size_t WS_VB = 252 * MiB;
constexpr size_t WS_USC = 268 * MiB;
constexpr size_t WS_VSC = 268 * MiB + 65536;
constexpr size_t WS_EIDX = 300 * MiB;
constexpr size_t WS_GATE = 316 * MiB;
constexpr size_t WS_XQ = 380 * MiB;
constexpr size_t WS_XQS = 412 * MiB;
constexpr size_t WS_PARTU = 108 * MiB;
constexpr size_t WS_SS = 348 * MiB;
constexpr size_t WS_PW = 332 * MiB;

constexpr int CW_TMAX = 64;
constexpr int LDS_BYTES = 147456;

__device__ __forceinline__ unsigned f2bf(float f) { unsigned u = __builtin_bit_cast(unsigned, f); return (u + 0x7fffu + ((u >> 16) & 1u)) >> 16; }
typedef __bf16 bf16x2_t __attribute__((ext_vector_type(2)));
__device__ __forceinline__ unsigned pk2(float lo, float hi) { bf16x2_t v; v[0] = (__bf16)lo; v[1] = (__bf16)hi; return __builtin_bit_cast(unsigned, v); }
__device__ __forceinline__ float bf_lo(unsigned w) { return __builtin_bit_cast(float, w << 16); }
__device__ __forceinline__ float bf_hi(unsigned w) { return __builtin_bit_cast(float, w & 0xffff0000u); }
__device__ __forceinline__ float bf2f(bf16_t h) { return __builtin_bit_cast(float, ((unsigned)h) << 16); }
__device__ __forceinline__ float shx(float v, int o, int lane) { return __builtin_bit_cast(float, __builtin_amdgcn_ds_bpermute((lane ^ o) << 2, __builtin_bit_cast(int, v))); }
__device__ __forceinline__ float shup(float v, int o, int lane) { return __builtin_bit_cast(float, __builtin_amdgcn_ds_bpermute(((lane - o) & 63) << 2, __builtin_bit_cast(int, v))); }
__device__ __forceinline__ float rdlane(float v, int l) { return __builtin_bit_cast(float, __builtin_amdgcn_readlane(__builtin_bit_cast(int, v), l)); }
#define DPP_(v, ctrl) __builtin_bit_cast(float, __builtin_amdgcn_update_dpp(0, __builtin_bit_cast(int, (v)), (ctrl), 0xF, 0xF, false))
__device__ __forceinline__ float wave_sum(float v, int lane) {
    (void)lane;
    v += DPP_(v, 0xB1); v += DPP_(v, 0x4E); v += DPP_(v, 0x141); v += DPP_(v, 0x140);
    return (rdlane(v, 0) + rdlane(v, 16)) + (rdlane(v, 32) + rdlane(v, 48));
}
__device__ __forceinline__ float wave_max(float v) {
    v = fmaxf(v, DPP_(v, 0xB1)); v = fmaxf(v, DPP_(v, 0x4E)); v = fmaxf(v, DPP_(v, 0x141)); v = fmaxf(v, DPP_(v, 0x140));
    return fmaxf(fmaxf(rdlane(v, 0), rdlane(v, 16)), fmaxf(rdlane(v, 32), rdlane(v, 48)));
}
__device__ __forceinline__ unsigned pack_i8x4(float a, float b, float c, float d) {
    const int ia = (int)__builtin_rintf(a), ib = (int)__builtin_rintf(b), ic = (int)__builtin_rintf(c), id = (int)__builtin_rintf(d);
    return ((unsigned)ia & 255u) | (((unsigned)ib & 255u) << 8) | (((unsigned)ic & 255u) << 16) | ((unsigned)id << 24);
}
#define SWZI_(v, pat) __builtin_amdgcn_ds_swizzle((int)(v), (pat))
#define DPPI_(v, ctrl) __builtin_amdgcn_update_dpp(0, (int)(v), (ctrl), 0xF, 0xF, false)
__device__ __forceinline__ unsigned xor32u_(unsigned v, bool hi) {
#if defined(__HIP_DEVICE_COMPILE__)
    const auto r = __builtin_amdgcn_permlane32_swap(v, v, false, false);
    return hi ? r[0] : r[1];
#else
    (void)hi; return v;
#endif
}
__device__ __forceinline__ float sigmoidf_(float x) { return __builtin_amdgcn_rcpf(1.0f + __expf(-x)); }
__device__ __forceinline__ float siluf_(float x) { return x * __builtin_amdgcn_rcpf(1.0f + __expf(-x)); }
#define LDS_WAIT() asm volatile("s_waitcnt lgkmcnt(0)" ::: "memory")
__device__ __forceinline__ int tid_() { int t = threadIdx.x; asm volatile("" : "+v"(t)); return t; }

#define GAS __attribute__((address_space(1)))
struct DArgs {
    const GAS float* x; const GAS float* norm1_g; const GAS float* w_in; const GAS float* b_in; const GAS float* conv_w; const GAS float* conv_b;
    const GAS float* m_head_g; const GAS float* lb_table; const GAS float* g_head_g; const GAS float* w_br_m; const GAS float* w_br_g; const GAS float* w_out;
    const GAS float* norm2_g; const GAS float* w_pq; const GAS float* sub_keys; const GAS float* u_emb; const GAS float* v_emb; const GAS float* final_g;
    GAS float* out; GAS unsigned char* ws;
};
struct Args {
    const float* x; const float* norm1_g; const float* w_in; const float* b_in; const float* conv_w; const float* conv_b;
    const float* m_head_g; const float* lb_table; const float* g_head_g; const float* w_br_m; const float* w_br_g; const float* w_out;
    const float* norm2_g; const float* w_pq; const float* sub_keys; const float* u_emb; const float* v_emb; const float* final_g;
    float* out; unsigned char* ws;
};

namespace pg8 {
constexpr int BM = 256, BK = 64, HALF = 128, HTB = HALF * BK * 2, STAGE_BYTES = 8 * HTB, NXCD = 8, WGM = 8;
__host__ __device__ __forceinline__ int lds_byte(int r, int c) { const int st = (r >> 4) * 2 + (c >> 5), rr = r & 15, cc = c & 31, ob = rr * 64 + cc * 2; return st * 1024 + (ob ^ (((ob >> 9) & 1) << 5)); }
__host__ __device__ __forceinline__ void stage_rc(int b, int& R, int& C) { const int st = b / 1024, sb = b % 1024, swz = sb ^ (((sb >> 9) & 1) << 5); R = (st >> 1) * 16 + swz / 64; C = (st & 1) * 32 + (swz % 64) / 2; }
__host__ __device__ __forceinline__ int perm32(int rho) { const int n = rho >> 4, i = rho & 15; return 8 * (i >> 2) + 4 * n + (i & 3); }
struct Unit { int pm, pn; };
struct Gemm { const bf16_t* A; const bf16_t* Bt; int M, N, K; };
struct StaticOrder {
    int nM, nN, nwg, G, c;
    __host__ __device__ void init(int M, int N, int G_, int c_) { nM = M / BM; nN = N / BM; nwg = nM * nN; G = G_; c = c_; }
    __host__ __device__ bool next(int i, Unit& u) const {
        const long L = (long)i * G + c; if (L >= nwg) return false;
        int wgid = (int)L; { const int q = nwg / NXCD, r = nwg % NXCD, xcd = wgid % NXCD, off = wgid / NXCD; wgid = (xcd < r ? xcd * (q + 1) : r * (q + 1) + (xcd - r) * q) + off; }
        const int nig = WGM * nN, gid = wgid / nig, fm = gid * WGM, gsz = (nM - fm) < WGM ? (nM - fm) : WGM;
        u.pm = fm + ((wgid % nig) % gsz); u.pn = (wgid % nig) / gsz; return true;
    }
    __device__ __forceinline__ void a_ready(const Unit&) const {}
    __device__ __forceinline__ void done(const Unit&) const {}
};

typedef int i32x8 __attribute__((ext_vector_type(8)));
typedef int i32x4 __attribute__((ext_vector_type(4)));
template <class Epi, class Sched, bool ALIGN_EPI = false, bool SP2 = false, bool I8 = false>
__device__ __forceinline__ void gemm_phase(LAS unsigned char* lds, const Gemm g, const Sched& S, const Epi& E) {
    const int tid = tid_(), wid = __builtin_amdgcn_readfirstlane(tid >> 6), lane = tid & 63, wr = wid >> 2, wc = wid & 3, fr = lane & 15, fq = lane >> 4;
    const int K = g.K, nt = K / BK;
    unsigned voffA[2], voffB[2];
#pragma unroll
    for (int i = 0; i < 2; ++i) { int R, C; stage_rc(tid * 16 + i * 8192, R, C); const int Rb = Epi::PERM ? ((R & ~31) + perm32(R & 31)) : R;
        voffA[i] = (unsigned)(R * K + C) * 2u; voffB[i] = (unsigned)(Rb * K + C) * 2u; }
    const size_t kstep = (size_t)(BK * 2);
    const size_t hstep = (size_t)HALF * K * 2;
    const size_t tstep = 2 * hstep;
    const unsigned ldsw = (unsigned)wid * 1024u;
    const int aoff = lds_byte(wr * 64 + fr, fq * 8), boff = lds_byte(wc * 32 + fr, fq * 8);
#define PG8_SA(b, h) (((b) * 2 + (h)) * HTB)
#define PG8_SB(b, h) ((4 + (b) * 2 + (h)) * HTB)
#define PG8_STAGE(bufoff, gbase, voff) do { _Pragma("unroll") for (int _i = 0; _i < 2; ++_i) \
        __builtin_amdgcn_global_load_lds((const unsigned*)((const char*)(gbase) + (voff)[_i]), (LAS unsigned*)(lds + (bufoff) + ldsw + _i * 8192), 16, 0, 0); } while (0)
#define PG8_LDA(dst, b, h) do { _Pragma("unroll") for (int m = 0; m < 4; ++m) _Pragma("unroll") for (int k = 0; k < 2; ++k) dst[m][k] = *(const LAS bf16x8*)(lds + PG8_SA(b, h) + aoff + m * 2048 + k * 1024); } while (0)
#define PG8_LDB(dst, b, h) do { _Pragma("unroll") for (int n = 0; n < 2; ++n) _Pragma("unroll") for (int k = 0; k < 2; ++k) dst[n][k] = *(const LAS bf16x8*)(lds + PG8_SB(b, h) + boff + n * 2048 + k * 1024); } while (0)
#define PG8_MMA(ai, bj, At, Bt) do { __builtin_amdgcn_s_setprio(1); _Pragma("unroll") for (int m = 0; m < 4; ++m) _Pragma("unroll") for (int n = 0; n < 2; ++n) _Pragma("unroll") for (int k = 0; k < 2; ++k) { \
        if constexpr (I8) acc[ai][bj][m][n] = __builtin_bit_cast(f32x4, __builtin_amdgcn_mfma_i32_16x16x64_i8(__builtin_bit_cast(i32x4, Bt[n][k]), __builtin_bit_cast(i32x4, At[m][k]), __builtin_bit_cast(i32x4, acc[ai][bj][m][n]), 0, 0, 0)); \
        else acc[ai][bj][m][n] = __builtin_amdgcn_mfma_f32_16x16x32_bf16(Bt[n][k], At[m][k], acc[ai][bj][m][n], 0, 0, 0); } __builtin_amdgcn_s_setprio(0); } while (0)
#define PG8_WAIT_V(n) asm volatile("s_waitcnt vmcnt(" #n ")" ::: "memory")
#define PG8_WAIT_L(n) asm volatile("s_waitcnt lgkmcnt(" #n ")" ::: "memory")
#define PG8_BAR __builtin_amdgcn_s_barrier()
#define PG8_SCHED __builtin_amdgcn_sched_barrier(0)
    Unit cur, nxt; int ui = 0;
    if (!S.next(0, cur)) return;
    f32x4 acc[2][2][4][2];
#pragma unroll
    for (int a = 0; a < 2; ++a)
#pragma unroll
        for (int b = 0; b < 2; ++b)
#pragma unroll
            for (int m = 0; m < 4; ++m)
#pragma unroll
                for (int n = 0; n < 2; ++n) acc[a][b][m][n] = (f32x4){0.f, 0.f, 0.f, 0.f};
    bf16x8 At[4][2], B0[2][2], B1[2][2];
    const char* cA = (const char*)g.A + (size_t)cur.pm * tstep; const char* cB = (const char*)g.Bt + (size_t)cur.pn * tstep;
    S.a_ready(cur);
    if constexpr (SP2) {
        PG8_STAGE(PG8_SB(0, 0), cB, voffB); PG8_STAGE(PG8_SB(0, 1), cB + hstep, voffB); PG8_STAGE(PG8_SA(0, 0), cA, voffA); PG8_STAGE(PG8_SA(0, 1), cA + hstep, voffA);
        if (wr == 1) PG8_BAR;
        PG8_WAIT_V(2); PG8_BAR;
        PG8_STAGE(PG8_SB(1, 0), cB + kstep, voffB); PG8_STAGE(PG8_SA(1, 0), cA + kstep, voffA); PG8_STAGE(PG8_SB(1, 1), cB + hstep + kstep, voffB);
        PG8_WAIT_V(6); PG8_BAR;
    } else {
        PG8_STAGE(PG8_SB(0, 0), cB, voffB); PG8_STAGE(PG8_SA(0, 0), cA, voffA); PG8_STAGE(PG8_SB(0, 1), cB + hstep, voffB); PG8_STAGE(PG8_SA(0, 1), cA + hstep, voffA);
        if (wr == 1) PG8_BAR;
        PG8_WAIT_V(4); PG8_BAR;
        PG8_STAGE(PG8_SB(1, 0), cB + kstep, voffB); PG8_STAGE(PG8_SA(1, 0), cA + kstep, voffA); PG8_STAGE(PG8_SB(1, 1), cB + hstep + kstep, voffB);
        PG8_WAIT_V(6); PG8_BAR;
    }
    for (;;) {
        const bool has_next = S.next(ui + 1, nxt);
        const char* nA = has_next ? (const char*)g.A + (size_t)nxt.pm * tstep : cA; const char* nB = has_next ? (const char*)g.Bt + (size_t)nxt.pn * tstep : cB;
#pragma unroll 1
        for (int t = 0; t < nt; t += 2) {
            const bool last = (t == nt - 2);
            const char* a1 = cA + (size_t)(t + 1) * kstep;
            const char* a2 = last ? nA : cA + (size_t)(t + 2) * kstep; const char* b2 = last ? nB : cB + (size_t)(t + 2) * kstep;
            const char* a3 = a2 + kstep; const char* b3 = b2 + kstep;
            if (last && has_next) S.a_ready(nxt);
            if constexpr (SP2) {
            PG8_LDB(B0, 0, 0); PG8_LDB(B1, 0, 1); PG8_SCHED; PG8_LDA(At, 0, 0); PG8_STAGE(PG8_SA(1, 1), a1 + hstep, voffA);
            PG8_WAIT_V(8); PG8_WAIT_L(0); PG8_BAR; PG8_MMA(0, 0, At, B0); PG8_MMA(0, 1, At, B1); PG8_BAR; PG8_SCHED;
            PG8_LDA(At, 0, 1); PG8_STAGE(PG8_SB(0, 0), b2, voffB); PG8_STAGE(PG8_SB(0, 1), b2 + hstep, voffB); PG8_STAGE(PG8_SA(0, 0), a2, voffA);
            PG8_WAIT_V(8); PG8_WAIT_L(0); PG8_BAR; PG8_MMA(1, 0, At, B0); PG8_MMA(1, 1, At, B1); PG8_BAR; PG8_SCHED;
            PG8_LDB(B0, 1, 0); PG8_LDB(B1, 1, 1); PG8_SCHED; PG8_LDA(At, 1, 0); PG8_STAGE(PG8_SA(0, 1), a2 + hstep, voffA);
            PG8_WAIT_V(8); PG8_WAIT_L(0); PG8_BAR; PG8_MMA(0, 0, At, B0); PG8_MMA(0, 1, At, B1); PG8_BAR; PG8_SCHED;
            PG8_LDA(At, 1, 1); PG8_STAGE(PG8_SB(1, 0), b3, voffB); PG8_STAGE(PG8_SB(1, 1), b3 + hstep, voffB); PG8_STAGE(PG8_SA(1, 0), a3, voffA);
            PG8_WAIT_V(8); PG8_WAIT_L(0); PG8_BAR; PG8_MMA(1, 0, At, B0); PG8_MMA(1, 1, At, B1); PG8_BAR; PG8_SCHED;
            } else {
            PG8_LDB(B0, 0, 0); PG8_SCHED; PG8_LDA(At, 0, 0); PG8_STAGE(PG8_SA(1, 1), a1 + hstep, voffA);
            PG8_WAIT_L(8); PG8_BAR; PG8_WAIT_L(0); PG8_MMA(0, 0, At, B0); PG8_BAR; PG8_SCHED;
            PG8_LDB(B1, 0, 1); PG8_STAGE(PG8_SB(0, 0), b2, voffB);
            PG8_BAR; PG8_WAIT_L(0); PG8_MMA(0, 1, At, B1); PG8_BAR;
            PG8_LDA(At, 0, 1); PG8_STAGE(PG8_SA(0, 0), a2, voffA);
            PG8_BAR; PG8_WAIT_L(0); PG8_MMA(1, 0, At, B0); PG8_BAR; PG8_SCHED;
            PG8_STAGE(PG8_SB(0, 1), b2 + hstep, voffB);
            PG8_WAIT_V(6); PG8_BAR; PG8_MMA(1, 1, At, B1); PG8_BAR;
            PG8_LDB(B0, 1, 0); PG8_SCHED; PG8_LDA(At, 1, 0); PG8_STAGE(PG8_SA(0, 1), a2 + hstep, voffA);
            PG8_WAIT_L(8); PG8_BAR; PG8_WAIT_L(0); PG8_MMA(0, 0, At, B0); PG8_BAR; PG8_SCHED;
            PG8_LDB(B1, 1, 1); PG8_STAGE(PG8_SB(1, 0), b3, voffB);
            PG8_BAR; PG8_WAIT_L(0); PG8_MMA(0, 1, At, B1); PG8_BAR;
            PG8_LDA(At, 1, 1); PG8_STAGE(PG8_SA(1, 0), a3, voffA);
            PG8_BAR; PG8_WAIT_L(0); PG8_MMA(1, 0, At, B0); PG8_BAR; PG8_SCHED;
            PG8_STAGE(PG8_SB(1, 1), b3 + hstep, voffB);
            PG8_WAIT_V(6); PG8_BAR; PG8_MMA(1, 1, At, B1); PG8_BAR;
            }
        }
        if constexpr (ALIGN_EPI) { if (wr == 0) PG8_BAR; }
        E(acc, cur, wr, wc, fr, fq);
        if (!has_next) break;
#pragma unroll
        for (int a = 0; a < 2; ++a)
#pragma unroll
            for (int b = 0; b < 2; ++b)
#pragma unroll
                for (int m = 0; m < 4; ++m)
#pragma unroll
                    for (int n = 0; n < 2; ++n) acc[a][b][m][n] = (f32x4){0.f, 0.f, 0.f, 0.f};
        cur = nxt; cA = nA; cB = nB; ++ui;
        if constexpr (ALIGN_EPI) { if (wr == 1) PG8_BAR; }
    }
    PG8_WAIT_V(0);
    if constexpr (!ALIGN_EPI) { if (wr == 0) PG8_BAR; }
    PG8_BAR;
#undef PG8_SA
#undef PG8_SB
#undef PG8_STAGE
#undef PG8_LDA
#undef PG8_LDB
#undef PG8_MMA
#undef PG8_WAIT_V
#undef PG8_WAIT_L
#undef PG8_BAR
#undef PG8_SCHED
}
}

typedef int i32x4q __attribute__((ext_vector_type(4)));
struct EpiPtrs {
    const GAS float* biasp; const GAS float* lb; const GAS float* x; GAS float* out; GAS unsigned char* ws; int round;
    const GAS float* sa; const GAS float* sb; const GAS float* sym; const GAS float* syg;
};
template <int MODE> struct EpiX {
    static constexpr bool PERM = true, AFTER_DRAIN = false;
    EpiPtrs P;
    __device__ __forceinline__ void operator()(const f32x4 (&acc)[2][2][4][2], const pg8::Unit& u, int wr, int wc, int fr, int fq) const {
        const int upn = u.pn + (MODE == 1 ? 16 : 0);
        const int row0 = u.pm * 256 + wr * 64 + fr;
        const int colt = upn * 256 + wc * 32 + 8 * fq;
        GAS unsigned char* ws = P.ws;
        bf16_t* dst = nullptr; int ld = 0, coff = 0, act = 0; const GAS float* bias = nullptr;
        if (MODE == 1 || MODE == 7) {
            bias = P.biasp;
            if (upn < 8) { dst = (bf16_t*)(ws + WS_QKPRE); ld = 2048; coff = 0; act = 0; }
            else if (upn < 16) { dst = (bf16_t*)(ws + WS_V); ld = 2048; coff = 2048; act = 0; }
            else if (upn < 20) { dst = (bf16_t*)(ws + WS_GFLOG); ld = 1024; coff = 4096; act = 3; }
            else if (upn < 24) { dst = (bf16_t*)(ws + WS_GI); ld = 1024; coff = 5120; act = 0; }
            else { dst = (bf16_t*)(ws + WS_GQ); ld = 1024; coff = 6144; act = 2; }
        } else if (MODE == 2) {
            bias = P.biasp + N1;
            if (u.pn < 8) { dst = (bf16_t*)(ws + WS_SIGO); ld = 2048; coff = 0; act = 1; }
            else if (u.pn < 12) { dst = (bf16_t*)(ws + WS_SGG); ld = 1024; coff = 2048; act = 2; }
            else if (u.pn < 16) { dst = (bf16_t*)(ws + WS_SAM); ld = 1024; coff = 3072; act = 1; }
            else { dst = (bf16_t*)(ws + WS_SAG); ld = 1024; coff = 4096; act = 1; }
        } else if (MODE == 6) { dst = (bf16_t*)(ws + WS_QP); ld = 2048; coff = 0; act = 0; }
#pragma unroll
        for (int bj = 0; bj < 2; ++bj) {
            const int col = colt + bj * 128;
            f32x4 b0 = (f32x4){0.f, 0.f, 0.f, 0.f}, b1 = b0, l0 = b0, l1 = b0;
            if (MODE == 1 || MODE == 2 || MODE == 7) { b0 = *(const f32x4*)(bias + col); b1 = *(const f32x4*)(bias + col + 4); }
            f32x4 s0 = (f32x4){1.f, 1.f, 1.f, 1.f}, s1 = s0;
            if (MODE == 2) { s0 = *(const GAS f32x4*)(P.sb + 4096 + col); s1 = *(const GAS f32x4*)(P.sb + 4096 + col + 4); }
            if (MODE == 7) { s0 = *(const GAS f32x4*)(P.sb + col); s1 = *(const GAS f32x4*)(P.sb + col + 4); }
            if (MODE == 3) { s0 = *(const GAS f32x4*)(P.sb + 9216 + col); s1 = *(const GAS f32x4*)(P.sb + 9216 + col + 4); }
            if (MODE == 4) { s0 = *(const GAS f32x4*)(P.sb + 10240 + col); s1 = *(const GAS f32x4*)(P.sb + 10240 + col + 4); }
            if (MODE == 1) { if (act == 3) { l0 = *(const f32x4*)(P.lb + (col - coff)); l1 = *(const f32x4*)(P.lb + (col - coff) + 4); } }
#pragma unroll
            for (int ai = 0; ai < 2; ++ai)
#pragma unroll
                for (int m = 0; m < 4; ++m) {
                    const int row = row0 + ai * 128 + m * 16;
                    f32x4 v0, v1;
                    if (MODE == 2 || MODE == 7 || MODE == 3 || MODE == 4) { const float sr = (MODE == 3) ? P.sym[row] : (MODE == 4) ? P.syg[row] : P.sa[(size_t)P.round * RT + row]; const i32x4q q0 = __builtin_bit_cast(i32x4q, acc[ai][bj][m][0]), q1 = __builtin_bit_cast(i32x4q, acc[ai][bj][m][1]);
                        v0 = (f32x4){(float)q0[0], (float)q0[1], (float)q0[2], (float)q0[3]} * (s0 * sr) + b0; v1 = (f32x4){(float)q1[0], (float)q1[1], (float)q1[2], (float)q1[3]} * (s1 * sr) + b1; }
                    else { v0 = acc[ai][bj][m][0] + b0; v1 = acc[ai][bj][m][1] + b1; }
                    if (MODE == 1 || MODE == 2 || MODE == 6 || MODE == 7) {
                        if (act == 1) {
#pragma unroll
                            for (int j = 0; j < 4; ++j) { v0[j] = sigmoidf_(v0[j]); v1[j] = sigmoidf_(v1[j]); }
                        } else if (act == 2) {
#pragma unroll
                            for (int j = 0; j < 4; ++j) { v0[j] = siluf_(v0[j]); v1[j] = siluf_(v1[j]); }
                        } else if (act == 3) {
#pragma unroll
                            for (int j = 0; j < 4; ++j) { v0[j] = __logf(l0[j] + (1.0f - l0[j]) * sigmoidf_(v0[j])); v1[j] = __logf(l1[j] + (1.0f - l1[j]) * sigmoidf_(v1[j])); }
                        }
                        u32x4 w; w.x = pk2(v0[0], v0[1]); w.y = pk2(v0[2], v0[3]); w.z = pk2(v1[0], v1[1]); w.w = pk2(v1[2], v1[3]);
                        *(u32x4*)(dst + (size_t)row * ld + (col - coff)) = w;
                    } else if (MODE == 3) {
                        const u32x4 g = *(const u32x4*)((const bf16_t*)(ws + WS_SAM) + (size_t)row * 1024 + col);
                        GAS bf16_t* o = (GAS bf16_t*)P.out + (size_t)T * 1024 + ((size_t)P.round * RT + row) * 1024 + col;
                        f32x4 r0, r1;
                        r0[0] = v0[0] * bf_lo(g.x); r0[1] = v0[1] * bf_hi(g.x); r0[2] = v0[2] * bf_lo(g.y); r0[3] = v0[3] * bf_hi(g.y);
                        r1[0] = v1[0] * bf_lo(g.z); r1[1] = v1[1] * bf_hi(g.z); r1[2] = v1[2] * bf_lo(g.w); r1[3] = v1[3] * bf_hi(g.w);
                        u32x4 w; w.x = pk2(r0[0], r0[1]); w.y = pk2(r0[2], r0[3]); w.z = pk2(r1[0], r1[1]); w.w = pk2(r1[2], r1[3]);
                        *(GAS u32x4*)o = w;
                    } else if (MODE == 4) {
                        const u32x4 g = *(const u32x4*)((const bf16_t*)(ws + WS_SAG) + (size_t)row * 1024 + col);
                        const u32x4 zv = *(const GAS u32x4*)((const GAS bf16_t*)P.out + (size_t)T * 1024 + ((size_t)P.round * RT + row) * 1024 + col);
                        const f32x4 p0 = (f32x4){bf_lo(zv.x), bf_hi(zv.x), bf_lo(zv.y), bf_hi(zv.y)}, p1 = (f32x4){bf_lo(zv.z), bf_hi(zv.z), bf_lo(zv.w), bf_hi(zv.w)};
                        f32x4 r0, r1;
                        r0[0] = p0[0] + v0[0] * bf_lo(g.x); r0[1] = p0[1] + v0[1] * bf_hi(g.x); r0[2] = p0[2] + v0[2] * bf_lo(g.y); r0[3] = p0[3] + v0[3] * bf_hi(g.y);
                        r1[0] = p1[0] + v1[0] * bf_lo(g.z); r1[1] = p1[1] + v1[1] * bf_hi(g.z); r1[2] = p1[2] + v1[2] * bf_lo(g.w); r1[3] = p1[3] + v1[3] * bf_hi(g.w);
                        u32x4 w; w.x = pk2(r0[0], r0[1]); w.y = pk2(r0[2], r0[3]); w.z = pk2(r1[0], r1[1]); w.w = pk2(r1[2], r1[3]);
                        *(u32x4*)((bf16_t*)(ws + WS_GFLOG) + (size_t)row * 1024 + col) = w;
                    } else if (MODE == 5) {
                        const size_t off = ((size_t)P.round * RT + row) * 1024 + col;
                        const f32x4 x0 = *(const f32x4*)(P.x + off) + v0, x1 = *(const f32x4*)(P.x + off + 4) + v1;
                        u32x4 w; w.x = pk2(x0[0], x0[1]); w.y = pk2(x0[2], x0[3]); w.z = pk2(x1[0], x1[1]); w.w = pk2(x1[2], x1[3]);
                        *(GAS u32x4*)((GAS bf16_t*)P.out + off) = w;
                    }
                }
        }
    }
};

__device__ __forceinline__ void p0_transpose_item(const GAS float* W, int ldw, int K, int k0, int scol, GAS bf16_t* WT, int drow, LAS float* scr, int lane) {
#pragma unroll 8
    for (int i = 0; i < 32; ++i) { const int kk = 2 * i + (lane >> 5); scr[kk * 33 + (lane & 31)] = W[(size_t)(k0 + kk) * ldw + scol + (lane & 31)]; }
    LDS_WAIT(); asm volatile("" ::: "memory");
    const int c = lane & 7;
#pragma unroll
    for (int j = 0; j < 4; ++j) { const int n = (lane >> 3) + 8 * j; const LAS float* s = scr + (8 * c) * 33 + n;
        u32x4 o; o.x = pk2(s[0 * 33], s[1 * 33]); o.y = pk2(s[2 * 33], s[3 * 33]); o.z = pk2(s[4 * 33], s[5 * 33]); o.w = pk2(s[6 * 33], s[7 * 33]);
        *(u32x4*)(WT + (size_t)(drow + n) * K + k0 + 8 * c) = o; }
    LDS_WAIT(); asm volatile("" ::: "memory");
}
__device__ __forceinline__ void p0_colmax_item(const GAS float* W, int ldw, int k0, int scol, GAS unsigned* colmax, int lane) {
    float mx = 0.f;
#pragma unroll 8
    for (int i = 0; i < 32; ++i) { const int kk = 2 * i + (lane >> 5); mx = fmaxf(mx, fabsf(W[(size_t)(k0 + kk) * ldw + scol + (lane & 31)])); }
    mx = fmaxf(mx, __builtin_bit_cast(float, xor32u_(__builtin_bit_cast(unsigned, mx), lane >= 32)));
    if (lane < 32) atomicMax((unsigned*)colmax + lane, __builtin_bit_cast(unsigned, mx));
}
__device__ __forceinline__ void p0_cvt8_item(const GAS float* W, int ldw, int k0, int scol, const GAS unsigned* colmax, GAS unsigned char* WT8, int pitch, GAS float* sb, int drow, LAS float* scr, int lane) {
    const float cm = __builtin_bit_cast(float, colmax[lane & 31]);
    const float qs = cm > 0.f ? 127.0f / cm : 0.f;
    if (k0 == 0 && lane < 32) sb[lane] = cm * (1.0f / 127.0f);
#pragma unroll 8
    for (int i = 0; i < 32; ++i) { const int kk = 2 * i + (lane >> 5); scr[kk * 33 + (lane & 31)] = W[(size_t)(k0 + kk) * ldw + scol + (lane & 31)] * qs; }
    LDS_WAIT(); asm volatile("" ::: "memory");
    const int n = lane >> 1, kh = lane & 1;
    const LAS float* sp = scr + (kh * 32) * 33 + n;
    u32x4 o0, o1;
#pragma unroll
    for (int q = 0; q < 8; ++q) { const unsigned p = pack_i8x4(sp[(4 * q) * 33], sp[(4 * q + 1) * 33], sp[(4 * q + 2) * 33], sp[(4 * q + 3) * 33]);
        if (q < 4) o0[q] = p; else o1[q - 4] = p; }
    GAS unsigned char* dst = WT8 + (size_t)(drow + n) * pitch + k0 + kh * 32;
    *(GAS u32x4*)dst = o0; *(GAS u32x4*)(dst + 16) = o1;
    LDS_WAIT(); asm volatile("" ::: "memory");
}
__device__ __forceinline__ int i8_cid_block(int nb) { return nb < 128 ? nb : (nb >= 224 ? nb - 96 : -1); }
__device__ __forceinline__ int win_src_col(int n) {
    if (n < 4096) return n;
    if (n < 7168) return n - 4096 + 6152;
    if (n < 9216) return n - 7168 + 4096;
    return n - 9216 + 9224;
}

__device__ __forceinline__ void phase_p0(const DArgs& a, LAS unsigned char* lds, int vcu, int G) {
    const int tid = tid_(), lane = tid & 63, wave = tid >> 6;
    const int gw = vcu * NWAVES + wave, NGW = G * NWAVES;
    GAS unsigned char* ws = a.ws;
    LAS float* scr = (LAS float*)(lds + wave * 16384);
    constexpr int I_IN = 16 * 384, I_M = 32 * 32, I_G = 16 * 32, I_O = 16 * 32, I_PQ = 16 * 64;
    constexpr int NITEMS = I_IN + I_M + I_G + I_O + I_PQ;
    for (int it = gw; it < NITEMS; it += NGW) {
        int r = it;
        if (r < I_IN) { const int kb = r / 384, nb = r % 384; const int cb = i8_cid_block(nb);
            if (cb < 0) p0_transpose_item(a.w_in, IN_COLS, 1024, kb * 64, win_src_col(nb * 32), (GAS bf16_t*)(ws + WS_WIN), nb * 32, scr, lane);
            else p0_colmax_item(a.w_in, IN_COLS, kb * 64, win_src_col(nb * 32), (GAS unsigned*)(ws + WS_CTL) + CW_COLMAX + cb * 32, lane);
            continue; } r -= I_IN;
        if (r < I_M) { const int kb = r / 32, nb = r % 32; p0_colmax_item(a.w_br_m, 1024, kb * 64, nb * 32, (GAS unsigned*)(ws + WS_CTL) + CW_COLMAX + 9216 + nb * 32, lane); continue; } r -= I_M;
        if (r < I_G) { const int kb = r / 32, nb = r % 32; p0_colmax_item(a.w_br_g, 1024, kb * 64, nb * 32, (GAS unsigned*)(ws + WS_CTL) + CW_COLMAX + 10240 + nb * 32, lane); continue; } r -= I_G;
        if (r < I_O) { const int kb = r / 32, nb = r % 32; p0_transpose_item(a.w_out, 1024, 1024, kb * 64, nb * 32, (GAS bf16_t*)(ws + WS_WO), nb * 32, scr, lane); continue; } r -= I_O;
        { const int kb = r / 64, nb = r % 64; p0_transpose_item(a.w_pq, 2048, 1024, kb * 64, nb * 32, (GAS bf16_t*)(ws + WS_WPQ), nb * 32, scr, lane); }
    }
    const int gt = vcu * NTHR + tid, NGT = G * NTHR;
    for (int i = gt; i < NP; i += NGT) ((float*)(ws + WS_BIASP))[i] = a.b_in[win_src_col(i)];
    for (int i = gt; i < 1024; i += NGT) { const float t0 = a.lb_table[i], t1 = a.lb_table[1024 + i]; ((float*)(ws + WS_LB))[i] = 1.0f / (1.0f + __expf(t1 - t0)); }
    for (int i = gt; i < 8 * 2 * 128 * 128 / 4; i += NGT) { const f32x4 v = ((const f32x4*)a.sub_keys)[i]; u32x2 o; o.x = pk2(v[0], v[1]); o.y = pk2(v[2], v[3]); ((u32x2*)(ws + WS_SK))[i] = o; }
    f32x4 g1[4];
#pragma unroll
    for (int j = 0; j < 4; ++j) g1[j] = ((const GAS f32x4*)a.norm1_g)[64 * j + lane];
    f32x4 gw0[16], gw1[16];
#pragma unroll
    for (int j = 0; j < 4; ++j)
#pragma unroll
        for (int e = 0; e < 4; ++e) { const int k = 256 * j + 4 * lane + e; gw0[4 * j + e] = *(const GAS f32x4*)(a.w_in + (size_t)k * IN_COLS + 6144); gw1[4 * j + e] = *(const GAS f32x4*)(a.w_in + (size_t)k * IN_COLS + 6148); }
    const float gbias = lane < 8 ? a.b_in[6144 + lane] : 0.f;
    for (int m = gw; m < T; m += NGW) {
        const GAS f32x4* xr = (const GAS f32x4*)(a.x + (size_t)m * D) + lane;
        f32x4 v[4]; float s = 0.f;
#pragma unroll
        for (int j = 0; j < 4; ++j) { v[j] = xr[64 * j]; s += (v[j][0] * v[j][0] + v[j][1] * v[j][1]) + (v[j][2] * v[j][2] + v[j][3] * v[j][3]); }
        const float rstd = rsqrtf(wave_sum(s, lane) * (1.f / D) + EPS);
        GAS unsigned long long* o8 = (GAS unsigned long long*)((GAS bf16_t*)(ws + WS_XN) + (size_t)m * D) + lane;
        f32x4 ga0 = (f32x4){0.f, 0.f, 0.f, 0.f}, ga1 = ga0;
#pragma unroll
        for (int j = 0; j < 4; ++j) {
            v[j] = v[j] * rstd * g1[j];
            o8[64 * j] = (unsigned long long)pk2(v[j][0], v[j][1]) | ((unsigned long long)pk2(v[j][2], v[j][3]) << 32);
#pragma unroll
            for (int e = 0; e < 4; ++e) { ga0 += gw0[4 * j + e] * v[j][e]; ga1 += gw1[4 * j + e] * v[j][e]; }
        }
        if (m < RT) {
            float mx = 0.f;
#pragma unroll
            for (int jq = 0; jq < 4; ++jq) mx = fmaxf(mx, fmaxf(fmaxf(fabsf(v[jq][0]), fabsf(v[jq][1])), fmaxf(fabsf(v[jq][2]), fabsf(v[jq][3]))));
            mx = wave_max(mx);
            const float qs = mx > 0.f ? 127.0f / mx : 0.f;
#pragma unroll
            for (int jq = 0; jq < 4; ++jq) ((GAS unsigned*)(ws + WS_XN8 + (size_t)m * 1024))[64 * jq + lane] = pack_i8x4(v[jq][0] * qs, v[jq][1] * qs, v[jq][2] * qs, v[jq][3] * qs);
            if (lane == 0) ((GAS float*)(ws + WS_SA8))[m] = mx * (1.0f / 127.0f);
        }
        float ga[8] = {ga0[0], ga0[1], ga0[2], ga0[3], ga1[0], ga1[1], ga1[2], ga1[3]};
#pragma unroll
        for (int q = 0; q < 8; ++q) ga[q] = wave_sum(ga[q], lane);
        if (lane < 8) { float r = ga[0];
#pragma unroll
            for (int q = 1; q < 8; ++q) r = (lane == q) ? ga[q] : r;
            ((GAS float*)(ws + WS_GATES))[(size_t)m * 8 + lane] = r + gbias; }
    }
}

__device__ __forceinline__ float logsigf_(float x) { return fminf(x, 0.f) - log1pf(__expf(-fabsf(x))); }
#define LDS_BAR() do { asm volatile("s_waitcnt lgkmcnt(0)" ::: "memory"); __builtin_amdgcn_s_barrier(); asm volatile("" ::: "memory"); } while (0)
#define MFMA16(a, b, c) __builtin_amdgcn_mfma_f32_16x16x32_bf16((a), (b), (c), 0, 0, 0)
__device__ __forceinline__ bf16x8 lfrag(const LAS unsigned char* base, int pitch, int row, int k0, int fq) { return *(const LAS bf16x8*)(base + row * pitch + (k0 + 8 * fq) * 2); }
__device__ __forceinline__ int fm_off(int r, int k, int KB) { return (((r >> 4) * KB + (k >> 5)) << 10) + (((((k >> 3) & 3) << 4) + (r & 15)) << 4) + ((k & 7) << 1); }
__device__ __forceinline__ bf16x8 gfrag(const bf16_t* base, int ld, int row, int k0, int fq) { return *(const bf16x8*)(base + (size_t)row * ld + k0 + 8 * fq); }

__device__ __forceinline__ void phase_p0c(const DArgs& a, LAS unsigned char* lds, int vcu, int G) {
    const int tid = tid_(), lane = tid & 63, wave = tid >> 6;
    const int gw = vcu * NWAVES + wave, NGW = G * NWAVES;
    GAS unsigned char* ws = a.ws;
    LAS float* scr = (LAS float*)(lds + wave * 16384);
    constexpr int J_IN = 16 * 288, J_M = 32 * 32, J_G = 16 * 32;
    const GAS unsigned* cmx = (const GAS unsigned*)(ws + WS_CTL) + CW_COLMAX; GAS float* sb = (GAS float*)(ws + WS_SB8);
    for (int it = gw; it < J_IN + J_M + J_G; it += NGW) {
        int r = it;
        if (r < J_IN) { const int kb = r / 288, cb = r % 288, nb = cb < 128 ? cb : cb + 96;
            GAS unsigned char* dst = cb < 128 ? ws + WS_W8A : ws + WS_W8; const int drow = (cb < 128 ? cb : cb - 128) * 32;
            p0_cvt8_item(a.w_in, IN_COLS, kb * 64, win_src_col(nb * 32), cmx + cb * 32, dst, 1024, sb + cb * 32, drow, scr, lane); continue; } r -= J_IN;
        if (r < J_M) { const int kb = r / 32, nb = r % 32; p0_cvt8_item(a.w_br_m, 1024, kb * 64, nb * 32, cmx + 9216 + nb * 32, ws + WS_WM, 2048, sb + 9216 + nb * 32, nb * 32, scr, lane); continue; } r -= J_M;
        { const int kb = r / 32, nb = r % 32; p0_cvt8_item(a.w_br_g, 1024, kb * 64, nb * 32, cmx + 10240 + nb * 32, ws + WS_WG, 1024, sb + 10240 + nb * 32, nb * 32, scr, lane); }
    }
}
__device__ __forceinline__ void mscan_pair(const DArgs& a, LAS unsigned char* lds, int round, int p) {
    const int tid = tid_(), lane = tid & 63, part = tid >> 6;
    const int bl = p >> 2, h = p & 3, b = round * 2 + bl;
    const GAS float* g = (const GAS float*)(a.ws + WS_GATES) + ((size_t)b * SEQ + (size_t)lane * 128 + part * 16) * 8;
    float bsum = 0.f, gm = -INFINITY;
#pragma unroll 4
    for (int s = 0; s < 16; ++s) { const float ip = g[s * 8 + h], fp = g[s * 8 + 4 + h]; bsum += logsigf_(fp); gm = fmaxf(gm, ip - bsum); }
    LAS float* PS = (LAS float*)lds; LAS float* PM = PS + 512;
    PS[part * 64 + lane] = bsum; PM[part * 64 + lane] = gm;
    __syncthreads();
    if (tid < 64) {
        float bs = 0.f, g2 = -INFINITY;
#pragma unroll
        for (int q = 0; q < 8; ++q) { g2 = fmaxf(g2, PM[q * 64 + lane] - bs); bs += PS[q * 64 + lane]; }
        float mprev = 0.f, mine = 0.f;
        for (int c = 0; c < 64; ++c) {
            const float bc = rdlane(bs, c), gc = rdlane(g2, c);
            if (lane == c) mine = mprev; mprev = bc + fmaxf(mprev, gc); }
        ((GAS float*)(a.ws + WS_MPREV))[(round * 8 + p) * 64 + lane] = mine;
    }
    __syncthreads();
}

constexpr int PQ_PITCH = 528, PS_PITCH = 272;
__device__ __forceinline__ void mlstm_pre_item(const DArgs& a, LAS unsigned char* lds, int round, int item) {
    const int tid = tid_(), lane = tid & 63, wave = __builtin_amdgcn_readfirstlane(tid >> 6), fr = lane & 15, fq = lane >> 4;
    const int p = item >> 6, c = item & 63, bl = p >> 2, h = p & 3, b = round * 2 + bl;
    const int tl0 = bl * SEQ + c * 128; const size_t tg0 = (size_t)b * SEQ + c * 128;
    GAS unsigned char* ws = a.ws;
    LAS unsigned char* QL = lds; LAS unsigned char* KL = lds + 67584;
    LAS float* AS = (LAS float*)(lds + 135168); LAS float* MS = AS + 128; LAS float* SC = AS + 256;
    if (wave == 0) {
        const float mprev = ((const float*)(ws + WS_MPREV))[(round * 8 + p) * 64 + c];
        const float* g = (const float*)(ws + WS_GATES) + (tg0 + 2 * lane) * 8;
        const float ip0 = g[h], fp0 = g[4 + h], ip1 = g[8 + h], fp1 = g[12 + h];
        const float lf0 = logsigf_(fp0), lf1 = logsigf_(fp1), pp = lf0 + lf1;
        float incl = pp;
#pragma unroll
        for (int o = 1; o < 64; o <<= 1) { const float t = shup(incl, o, lane); if (lane >= o) incl += t; }
        const float excl = incl - pp, b0 = excl + lf0, b1 = incl;
        const float a0 = ip0 - b0, a1 = ip1 - b1;
        float inclm = fmaxf(a0, a1);
#pragma unroll
        for (int o = 1; o < 64; o <<= 1) { const float t = shup(inclm, o, lane); if (lane >= o) inclm = fmaxf(inclm, t); }
        float exclm = shup(inclm, 1, lane); if (lane == 0) exclm = -INFINITY;
        const float M0 = fmaxf(mprev, fmaxf(exclm, a0)), M1 = fmaxf(mprev, inclm);
        AS[2 * lane] = a0; AS[2 * lane + 1] = a1; MS[2 * lane] = M0; MS[2 * lane + 1] = M1;
        float* mt = (float*)(ws + WS_MT) + (tg0 + 2 * lane) * 4 + h;
        mt[0] = b0 + M0; mt[4] = b1 + M1;
        const float Mlast = rdlane(M1, 63);
        if (lane == 0) { SC[0] = mprev; SC[1] = Mlast; ((float*)(ws + WS_MDEC))[item] = __expf(mprev - Mlast); }
    }
    {
        const int cgp = tid & 63, strip = tid >> 6;
        const int col = (cgp < 32) ? (h * 256 + cgp * 8) : (1024 + h * 256 + (cgp - 32) * 8);
        float w[4][8], bb[8];
#pragma unroll
        for (int j = 0; j < 4; ++j) { const f32x4 w0 = *(const f32x4*)(a.conv_w + j * 2048 + col), w1 = *(const f32x4*)(a.conv_w + j * 2048 + col + 4);
#pragma unroll
            for (int e = 0; e < 4; ++e) { w[j][e] = w0[e]; w[j][4 + e] = w1[e]; } }
        { const f32x4 b0 = *(const f32x4*)(a.conv_b + col), b1 = *(const f32x4*)(a.conv_b + col + 4);
#pragma unroll
            for (int e = 0; e < 4; ++e) { bb[e] = b0[e]; bb[4 + e] = b1[e]; } }
        const bf16_t* src = (const bf16_t*)(ws + WS_QKPRE) + (size_t)(tl0 + 16 * strip) * 2048 + col;
        const float qs = (cgp < 32) ? 0.0625f : 1.0f;
        LAS unsigned char* dstt = ((cgp < 32) ? QL : KL) + (cgp & 31) * 16;
#pragma unroll 1
        for (int half = 0; half < 2; ++half) {
            u32x4 xr[11];
#pragma unroll
            for (int r = 0; r < 11; ++r) {
                const int sl = c * 128 + 16 * strip + 8 * half + r - 3;
                xr[r] = (sl >= 0) ? *(const u32x4*)(src + (ptrdiff_t)(8 * half + r - 3) * 2048) : (u32x4){0u, 0u, 0u, 0u};
            }
#pragma unroll
            for (int r = 0; r < 8; ++r) {
                float y[8];
#pragma unroll
                for (int e = 0; e < 8; ++e) y[e] = bb[e];
#pragma unroll
                for (int j = 0; j < 4; ++j) { const u32x4 xv = xr[r + j];
                    y[0] += w[j][0] * bf_lo(xv.x); y[1] += w[j][1] * bf_hi(xv.x); y[2] += w[j][2] * bf_lo(xv.y); y[3] += w[j][3] * bf_hi(xv.y);
                    y[4] += w[j][4] * bf_lo(xv.z); y[5] += w[j][5] * bf_hi(xv.z); y[6] += w[j][6] * bf_lo(xv.w); y[7] += w[j][7] * bf_hi(xv.w); }
#pragma unroll
                for (int e = 0; e < 8; ++e) y[e] = siluf_(y[e]) * qs;
                u32x4 o; o.x = pk2(y[0], y[1]); o.y = pk2(y[2], y[3]); o.z = pk2(y[4], y[5]); o.w = pk2(y[6], y[7]);
                *(LAS u32x4*)(dstt + (16 * strip + 8 * half + r) * PQ_PITCH) = o;
            }
        }
    }
    __syncthreads();
    const float mprev = SC[0], Mlast = SC[1];
    {
        bf16_t* Sg = (bf16_t*)(ws + WS_S) + (size_t)item * 128 * 128;
        const int t = wave * 16 + fr; const float Mt = MS[t];
        for (int st = 0; st < 8; ++st) {
            u32x2 o = (u32x2){0u, 0u};
            if (st <= wave) {
                f32x4 acc = (f32x4){0.f, 0.f, 0.f, 0.f};
#pragma unroll
                for (int ks = 0; ks < 8; ++ks) acc = MFMA16(lfrag(KL, PQ_PITCH, st * 16 + fr, ks * 32, fq), lfrag(QL, PQ_PITCH, wave * 16 + fr, ks * 32, fq), acc);
                float v[4];
#pragma unroll
                for (int j = 0; j < 4; ++j) { const int s = st * 16 + 4 * fq + j; v[j] = (s <= t) ? acc[j] * __expf(AS[s] - Mt) : 0.f; }
                o.x = pk2(v[0], v[1]); o.y = pk2(v[2], v[3]);
            }
            *(u32x2*)((unsigned char*)Sg + fm_off(t, st * 16 + 4 * fq, 4)) = o;
        }
    }
    {
        bf16_t* Qg = (bf16_t*)(ws + WS_QT) + (size_t)item * 128 * 256;
#pragma unroll
        for (int i = 0; i < 8; ++i) { const int idx = tid + 512 * i, blk = idx >> 6, t = (blk >> 3) * 16 + (idx & 15), ch = (blk & 7) * 4 + ((idx >> 4) & 3);
            const u32x4 v = *(const LAS u32x4*)(QL + t * PQ_PITCH + ch * 16); const float s = __expf(mprev - MS[t]);
            u32x4 o; o.x = pk2(bf_lo(v.x) * s, bf_hi(v.x) * s); o.y = pk2(bf_lo(v.y) * s, bf_hi(v.y) * s); o.z = pk2(bf_lo(v.z) * s, bf_hi(v.z) * s); o.w = pk2(bf_lo(v.w) * s, bf_hi(v.w) * s);
            *(u32x4*)((unsigned char*)Qg + fm_off(t, ch * 8, 8)) = o; }
    }
    {
        bf16_t* Kg = (bf16_t*)(ws + WS_KWT) + (size_t)item * 256 * 128;
        const int dlo = lane & 15, sglo = lane >> 4;
#pragma unroll
        for (int i = 0; i < 8; ++i) { const int combo = wave * 8 + i, d = (combo >> 2) * 16 + dlo, s0 = ((combo & 3) * 4 + sglo) * 8;
            float v[8];
#pragma unroll
            for (int e = 0; e < 8; ++e) v[e] = bf2f(*(const LAS bf16_t*)(KL + (s0 + e) * PQ_PITCH + d * 2)) * __expf(AS[s0 + e] - Mlast);
            u32x4 o; o.x = pk2(v[0], v[1]); o.y = pk2(v[2], v[3]); o.z = pk2(v[4], v[5]); o.w = pk2(v[6], v[7]);
            *(u32x4*)((unsigned char*)Kg + fm_off(d, s0, 4)) = o; }
    }
    __syncthreads();
}

__device__ __forceinline__ void hgrn_pre_load(const DArgs& a, int round, int item, u32x4 (&gq)[4]) {
    const int tid = tid_();
    const int p = item >> 7, c = item & 127, bl = p >> 3, h = p & 7;
    const int tl0 = bl * SEQ + c * 64;
    GAS unsigned char* ws = a.ws;
#pragma unroll
    for (int i = 0; i < 2; ++i) { const int idx = tid + 512 * i, s = idx >> 4, ch = idx & 15;
        gq[2 * i] = *(const GAS u32x4*)((const GAS bf16_t*)(ws + WS_GFLOG) + (size_t)(tl0 + s) * 1024 + h * 128 + ch * 8);
        gq[2 * i + 1] = *(const GAS u32x4*)((const GAS bf16_t*)(ws + WS_GQ) + (size_t)(tl0 + s) * 1024 + h * 128 + ch * 8); }
}
__device__ __forceinline__ void hgrn_pre_item(const DArgs& a, LAS unsigned char* lds, int round, int item, u32x4 (&gq)[4], int next_item) {
    const int tid = tid_(), lane = tid & 63, wave = __builtin_amdgcn_readfirstlane(tid >> 6), fr = lane & 15, fq = lane >> 4;
    const int p = item >> 7, c = item & 127, bl = p >> 3, h = p & 7;
    const int tl0 = bl * SEQ + c * 64;
    GAS unsigned char* ws = a.ws;
    LAS float* CUM = (LAS float*)lds;
    LAS float* GL = (LAS float*)(lds + 32768);
    LAS unsigned char* QH = lds + 65536;
    LAS unsigned char* KE = lds + 65536 + 64 * PS_PITCH;
    LAS float* QF = (LAS float*)(lds + 65536 + 128 * PS_PITCH);
#pragma unroll
    for (int i = 0; i < 2; ++i) { const int idx = tid + 512 * i, s = idx >> 4, ch = idx & 15;
        const u32x4 gv = gq[2 * i], qv = gq[2 * i + 1];
        LAS float* gd = GL + s * 128 + ch * 8; LAS float* qd = QF + s * 128 + ch * 8;
        gd[0] = bf_lo(gv.x); gd[1] = bf_hi(gv.x); gd[2] = bf_lo(gv.y); gd[3] = bf_hi(gv.y); gd[4] = bf_lo(gv.z); gd[5] = bf_hi(gv.z); gd[6] = bf_lo(gv.w); gd[7] = bf_hi(gv.w);
        qd[0] = bf_lo(qv.x); qd[1] = bf_hi(qv.x); qd[2] = bf_lo(qv.y); qd[3] = bf_hi(qv.y); qd[4] = bf_lo(qv.z); qd[5] = bf_hi(qv.z); qd[6] = bf_lo(qv.w); qd[7] = bf_hi(qv.w); }
    if (next_item < 2048) hgrn_pre_load(a, round, next_item, gq);
    LDS_BAR();
    {
        const int d = tid & 127, qt = tid >> 7; float cs = 0.f;
#pragma unroll 4
        for (int s = 0; s < 16; ++s) { cs += GL[(qt * 16 + s) * 128 + d]; CUM[(qt * 16 + s) * 128 + d] = cs; }
        LDS_BAR();
        float off = 0.f;
#pragma unroll
        for (int q = 0; q < 3; ++q) off += (q < qt) ? CUM[(q * 16 + 15) * 128 + d] : 0.f;
        LDS_BAR();
#pragma unroll 4
        for (int s = 0; s < 16; ++s) CUM[(qt * 16 + s) * 128 + d] += off;
        if (qt == 3) ((GAS float*)(ws + WS_HGDEC))[(size_t)item * 128 + d] = __expf(cs + off);
    }
    LDS_BAR();
    {
        bf16_t* Qg = (bf16_t*)(ws + WS_QTG) + (size_t)item * 64 * 128;
#pragma unroll
        for (int i = 0; i < 2; ++i) { const int idx = tid + 512 * i, s = idx >> 4, ch = idx & 15;
            float qt[8], qh[8], ke[8];
#pragma unroll
            for (int e = 0; e < 8; ++e) { const int d = ch * 8 + e; const float cm = CUM[s * 128 + d], last = CUM[63 * 128 + d], q = QF[s * 128 + d], g = GL[s * 128 + d];
                qt[e] = q * __expf(cm); qh[e] = q * __expf(cm - last); ke[e] = (1.0f - __expf(g)) * __expf(last - cm); }
            u32x4 o; o.x = pk2(qt[0], qt[1]); o.y = pk2(qt[2], qt[3]); o.z = pk2(qt[4], qt[5]); o.w = pk2(qt[6], qt[7]);
            *(u32x4*)((unsigned char*)Qg + fm_off(s, ch * 8, 4)) = o;
            o.x = pk2(qh[0], qh[1]); o.y = pk2(qh[2], qh[3]); o.z = pk2(qh[4], qh[5]); o.w = pk2(qh[6], qh[7]);
            *(LAS u32x4*)(QH + s * PS_PITCH + ch * 16) = o;
            o.x = pk2(ke[0], ke[1]); o.y = pk2(ke[2], ke[3]); o.z = pk2(ke[4], ke[5]); o.w = pk2(ke[6], ke[7]);
            *(LAS u32x4*)(KE + s * PS_PITCH + ch * 16) = o; }
    }
    LDS_BAR();
    {
        bf16_t* Ag = (bf16_t*)(ws + WS_ATT) + (size_t)item * 64 * 64;
#pragma unroll
        for (int i = 0; i < 2; ++i) { const int tile = wave * 2 + i, tt = tile >> 2, st = tile & 3; const int t = tt * 16 + fr;
            u32x2 o = (u32x2){0u, 0u};
            if (st <= tt) { f32x4 acc = (f32x4){0.f, 0.f, 0.f, 0.f};
#pragma unroll
                for (int ks = 0; ks < 4; ++ks) acc = MFMA16(lfrag(KE, PS_PITCH, st * 16 + fr, ks * 32, fq), lfrag(QH, PS_PITCH, tt * 16 + fr, ks * 32, fq), acc);
                float v[4];
#pragma unroll
                for (int j = 0; j < 4; ++j) { const int s = st * 16 + 4 * fq + j; v[j] = (s <= t) ? acc[j] : 0.f; }
                o.x = pk2(v[0], v[1]); o.y = pk2(v[2], v[3]); }
            *(u32x2*)((unsigned char*)Ag + fm_off(t, st * 16 + 4 * fq, 2)) = o; }
    }
    {
        bf16_t* Kg = (bf16_t*)(ws + WS_KENDT) + (size_t)item * 128 * 64;
        const int dlo = lane & 15, sglo = lane >> 4;
#pragma unroll
        for (int i = 0; i < 2; ++i) { const int combo = wave * 2 + i, d = (combo >> 1) * 16 + dlo, s0 = ((combo & 1) * 4 + sglo) * 8;
            unsigned v[8];
#pragma unroll
            for (int e = 0; e < 8; ++e) v[e] = *(const LAS bf16_t*)(KE + (s0 + e) * PS_PITCH + d * 2);
            u32x4 o; o.x = v[0] | (v[1] << 16); o.y = v[2] | (v[3] << 16); o.z = v[4] | (v[5] << 16); o.w = v[6] | (v[7] << 16);
            *(u32x4*)((unsigned char*)Kg + fm_off(d, s0, 2)) = o; }
    }
    LDS_BAR();
}

template <int NVT, bool DEN>
__device__ __forceinline__ void mlstm_scan(const DArgs& a, LAS unsigned char* lds, int round, int p, int sl) {
    const int tid = tid_(), lane = tid & 63, wave = __builtin_amdgcn_readfirstlane(tid >> 6), fr = lane & 15, fq = lane >> 4;
    const int bl = p >> 2, h = p & 3, b = round * 2 + bl;
    GAS unsigned char* ws = a.ws;
    constexpr int VTB = NVT * 16 * PS_PITCH, CTB = NVT * 16 * PQ_PITCH;
    LAS unsigned char* VT = lds; LAS unsigned char* CT = lds + 2 * VTB; LAS float* DEC = (LAS float*)(lds + 2 * VTB + 2 * CTB);
    for (int i = tid; i < (2 * VTB + 2 * CTB) / 4; i += NTHR) ((LAS unsigned*)lds)[i] = 0u;
    if (tid < 64) DEC[tid] = ((const GAS float*)(ws + WS_MDEC))[p * 64 + tid];
    __syncthreads();
    if (DEN) { if (tid < 256) { const int bufi = tid >> 7, s = tid & 127; *(LAS bf16_t*)(VT + bufi * VTB + s * 2) = (bf16_t)0x3F80; } }
    f32x4 st[2][NVT];
#pragma unroll
    for (int dt = 0; dt < 2; ++dt)
#pragma unroll
        for (int vt = 0; vt < NVT; ++vt) st[dt][vt] = (f32x4){0.f, 0.f, 0.f, 0.f};
    const int vcol = h * 512 + sl * 32;
    const int vs = tid >> 2, vpart = tid & 3;
    const GAS unsigned char* Sg0 = ws + WS_S + (size_t)(p * 64) * 32768 + wave * 4096 + lane * 16;
    const GAS unsigned char* Qg0 = ws + WS_QT + (size_t)(p * 64) * 65536 + wave * 8192 + lane * 16;
    const GAS unsigned char* Kg0 = ws + WS_KWT + (size_t)(p * 64) * 65536 + wave * 8192 + lane * 16;
    const GAS bf16_t* Vg0 = (const GAS bf16_t*)(ws + WS_V) + (size_t)(bl * SEQ + vs) * 2048 + vcol + vpart * 8;
    bf16x8 bS[4], bQ[8], aK[2][4]; u32x4 vreg = (u32x4){0u, 0u, 0u, 0u};
#define V_STAGE(cc_) do { LAS unsigned char* d0_ = VT + ((cc_) & 1) * VTB + (vpart * 8) * PS_PITCH + vs * 2; \
        *(LAS bf16_t*)(d0_ + 0 * PS_PITCH) = (bf16_t)(vreg.x & 0xffffu); *(LAS bf16_t*)(d0_ + 1 * PS_PITCH) = (bf16_t)(vreg.x >> 16); \
        *(LAS bf16_t*)(d0_ + 2 * PS_PITCH) = (bf16_t)(vreg.y & 0xffffu); *(LAS bf16_t*)(d0_ + 3 * PS_PITCH) = (bf16_t)(vreg.y >> 16); \
        *(LAS bf16_t*)(d0_ + 4 * PS_PITCH) = (bf16_t)(vreg.z & 0xffffu); *(LAS bf16_t*)(d0_ + 5 * PS_PITCH) = (bf16_t)(vreg.z >> 16); \
        *(LAS bf16_t*)(d0_ + 6 * PS_PITCH) = (bf16_t)(vreg.w & 0xffffu); *(LAS bf16_t*)(d0_ + 7 * PS_PITCH) = (bf16_t)(vreg.w >> 16); } while (0)
    if (!DEN) { vreg = *(const GAS u32x4*)Vg0; V_STAGE(0); }
    __builtin_amdgcn_sched_barrier(0);
#pragma unroll
    for (int ks = 0; ks < 4; ++ks)
#pragma unroll
        for (int dt = 0; dt < 2; ++dt) aK[dt][ks] = *(const GAS bf16x8*)(Kg0 + (dt * 4 + ks) * 1024);
    __builtin_amdgcn_sched_barrier(0);
#pragma unroll
    for (int ks = 0; ks < 4; ++ks) bS[ks] = *(const GAS bf16x8*)(Sg0 + ks * 1024);
    __builtin_amdgcn_sched_barrier(0);
#pragma unroll
    for (int ks = 0; ks < 8; ++ks) bQ[ks] = *(const GAS bf16x8*)(Qg0 + ks * 1024);
    __builtin_amdgcn_sched_barrier(0);
    if (!DEN) vreg = *(const GAS u32x4*)(Vg0 + (size_t)128 * 2048);
    __builtin_amdgcn_sched_barrier(0);
    const GAS unsigned char* pfp; unsigned pfstride;
    { const int tt = (wave * 64 + lane) < 160 ? wave * 64 + lane : 159; const int idx = sl * 10 + (tt >> 4), off = (tt & 15) * 64;
      pfp = (idx < 32 ? ws + WS_S + (size_t)(p * 64) * 32768 + idx * 1024 : idx < 96 ? ws + WS_QT + (size_t)(p * 64) * 65536 + (idx - 32) * 1024 : ws + WS_KWT + (size_t)(p * 64) * 65536 + (idx - 96) * 1024) + off;
      pfstride = idx < 32 ? 32768u : 65536u; }
    unsigned pfv = 0u;
#pragma unroll 1
    for (int c = 0; c < 64; ++c) {
        const int tl0 = bl * SEQ + c * 128; const size_t tg0 = (size_t)b * SEQ + c * 128;
        const int cn = c < 63 ? c + 1 : 63, cn2 = c < 62 ? c + 2 : 63;
        LAS unsigned char* vt_ = VT + (c & 1) * VTB; LAS unsigned char* ct_ = CT + (c & 1) * CTB; LAS unsigned char* ctn = CT + ((c + 1) & 1) * CTB;
        LDS_BAR();
        if (!DEN && wave < 3) { asm volatile("" :: "v"(pfv)); const int c3 = c < 60 ? c + 3 : 63; pfv = *(const GAS unsigned*)(pfp + (size_t)c3 * pfstride); }
        bf16x8 vf[NVT][4], cf[NVT][4];
#pragma unroll
        for (int vt = 0; vt < NVT; ++vt)
#pragma unroll
            for (int ks = 0; ks < 4; ++ks) vf[vt][ks] = lfrag(vt_, PS_PITCH, vt * 16 + fr, ks * 32, fq);
        const float dec = DEC[c];
        __builtin_amdgcn_sched_barrier(0);
#pragma unroll
        for (int dt = 0; dt < 2; ++dt)
#pragma unroll
            for (int vt = 0; vt < NVT; ++vt) st[dt][vt] = st[dt][vt] * dec;
#pragma unroll
        for (int ks = 0; ks < 4; ++ks) {
#pragma unroll
            for (int vt = 0; vt < NVT; ++vt) cf[vt][ks] = lfrag(ct_, PQ_PITCH, vt * 16 + fr, ks * 32, fq);
#pragma unroll
            for (int dt = 0; dt < 2; ++dt) {
#pragma unroll
                for (int vt = 0; vt < NVT; ++vt) st[dt][vt] = MFMA16(aK[dt][ks], vf[vt][ks], st[dt][vt]);
                aK[dt][ks] = *(const GAS bf16x8*)(Kg0 + (size_t)cn * 65536 + (dt * 4 + ks) * 1024);
            }
            __builtin_amdgcn_sched_barrier(0);
        }
#pragma unroll
        for (int dt = 0; dt < 2; ++dt)
#pragma unroll
            for (int vt = 0; vt < NVT; ++vt) { u32x2 o; o.x = pk2(st[dt][vt][0], st[dt][vt][1]); o.y = pk2(st[dt][vt][2], st[dt][vt][3]);
                *(LAS u32x2*)(ctn + (vt * 16 + fr) * PQ_PITCH + (wave * 32 + dt * 16 + 4 * fq) * 2) = o; }
        __builtin_amdgcn_sched_barrier(0);
        f32x4 acc[NVT];
#pragma unroll
        for (int vt = 0; vt < NVT; ++vt) acc[vt] = (f32x4){0.f, 0.f, 0.f, 0.f};
#pragma unroll
        for (int ks = 0; ks < 4; ++ks) {
#pragma unroll
            for (int vt = 0; vt < NVT; ++vt) acc[vt] = MFMA16(vf[vt][ks], bS[ks], acc[vt]);
            bS[ks] = *(const GAS bf16x8*)(Sg0 + (size_t)cn * 32768 + ks * 1024);
            __builtin_amdgcn_sched_barrier(0);
        }
#pragma unroll
        for (int ks = 0; ks < 8; ++ks) {
#pragma unroll
            for (int vt = 0; vt < NVT; ++vt) acc[vt] = MFMA16(cf[vt][ks & 3], bQ[ks], acc[vt]);
            if (ks < 4) {
#pragma unroll
                for (int vt = 0; vt < NVT; ++vt) cf[vt][ks] = lfrag(ct_, PQ_PITCH, vt * 16 + fr, 128 + ks * 32, fq);
            }
            bQ[ks] = *(const GAS bf16x8*)(Qg0 + (size_t)cn * 65536 + ks * 1024);
            __builtin_amdgcn_sched_barrier(0);
        }
        const int t = wave * 16 + fr;
        if (!DEN) {
            GAS bf16_t* hn = (GAS bf16_t*)(ws + WS_QKPRE) + (size_t)(tl0 + t) * 2048 + vcol + 4 * fq;
#pragma unroll
            for (int vt = 0; vt < NVT; ++vt) { u32x2 o; o.x = pk2(acc[vt][0], acc[vt][1]); o.y = pk2(acc[vt][2], acc[vt][3]); *(GAS u32x2*)(hn + vt * 16) = o; }
            V_STAGE(c + 1); vreg = *(const GAS u32x4*)(Vg0 + (size_t)cn2 * 128 * 2048);
        } else {
            if (fq == 0) ((GAS float*)(ws + WS_DEN))[(tg0 + t) * 4 + h] = acc[0][0];
        }
    }
    asm volatile("" :: "v"(pfv));
    __syncthreads();
#undef V_STAGE
}

constexpr int HG_PD = 4;
__device__ __forceinline__ void hgrn_scan(const DArgs& a, LAS unsigned char* lds, int round, int p, int sl) {
    const int tid = tid_(), lane = tid & 63, wave = __builtin_amdgcn_readfirstlane(tid >> 6), fr = lane & 15, fq = lane >> 4;
    const int bl = p >> 3, h = p & 7;
    GAS unsigned char* ws = a.ws;
    constexpr int IP = 144, ITB = 32 * IP, STB = 32 * PS_PITCH;
    LAS unsigned char* IT = lds; LAS unsigned char* ST = lds + 2 * ITB;
    for (int i = tid; i < (2 * ITB + 2 * STB) / 4; i += NTHR) ((LAS unsigned*)lds)[i] = 0u;
    __syncthreads();
    f32x4 st[2][2];
#pragma unroll
    for (int i = 0; i < 2; ++i) { st[i][0] = (f32x4){0.f, 0.f, 0.f, 0.f}; st[i][1] = st[i][0]; }
    const int vcol = h * 128 + sl * 32;
    const int is = (tid & 255) >> 2, ipart = tid & 3;
    const bool outw = wave < 4;
    const int w4 = wave & 3;
    const GAS unsigned char* Ag0 = ws + WS_ATT + (size_t)(p * 128) * 8192 + w4 * 2048 + lane * 16;
    const GAS unsigned char* Qg0 = ws + WS_QTG + (size_t)(p * 128) * 16384 + w4 * 4096 + lane * 16;
    const GAS unsigned char* Kg0 = ws + WS_KENDT + (size_t)(p * 128) * 16384 + w4 * 4096 + lane * 16;
    const GAS unsigned char* Dg0 = ws + WS_HGDEC + ((size_t)(p * 128) * 128 + w4 * 32 + 4 * fq) * 4;
    const GAS unsigned char* Ig0 = ws + WS_GI + ((size_t)(bl * SEQ + is) * 1024 + vcol + ipart * 8) * 2;
    const GAS unsigned char* gb0 = outw ? Ag0 : Kg0;          const unsigned gs0 = outw ? 8192u : 16384u;
    const GAS unsigned char* gb1 = outw ? Qg0 : Kg0 + 2048;   const unsigned gs1 = 16384u;
    const GAS unsigned char* gb2 = outw ? Qg0 + 2048 : Dg0;   const unsigned gs2 = outw ? 16384u : 512u, gt2 = outw ? 1024u : 64u;
    const GAS unsigned char* gb3 = outw ? Ig0 : Dg0;          const unsigned gs3 = outw ? 131072u : 512u;
    u32x4 pf[HG_PD][7];
#define HG_LD01(k_, cc_) do { _Pragma("unroll") for (int j_ = 0; j_ < 2; ++j_) pf[k_][j_] = *(const GAS u32x4*)(gb0 + (size_t)(cc_) * gs0 + j_ * 1024); } while (0)
#define HG_LD23(k_, cc_) do { _Pragma("unroll") for (int j_ = 0; j_ < 2; ++j_) pf[k_][2 + j_] = *(const GAS u32x4*)(gb1 + (size_t)(cc_) * gs1 + j_ * 1024); } while (0)
#define HG_LD45(k_, cc_) do { _Pragma("unroll") for (int j_ = 0; j_ < 2; ++j_) pf[k_][4 + j_] = *(const GAS u32x4*)(gb2 + (size_t)(cc_) * gs2 + j_ * gt2); } while (0)
#define HG_LD6(k_, cc_) do { pf[k_][6] = *(const GAS u32x4*)(gb3 + (size_t)(cc_) * gs3); } while (0)
#pragma unroll
    for (int k = 0; k < HG_PD; ++k) { HG_LD01(k, k); HG_LD23(k, k); HG_LD45(k, k); __builtin_amdgcn_sched_barrier(0); HG_LD6((k + 1) % HG_PD, (k + 1 < HG_PD ? k + 1 : HG_PD)); __builtin_amdgcn_sched_barrier(0); }
    const GAS unsigned char* pfp; unsigned pfstride;
    { const int tt = (wave * 64 + lane) < 160 ? wave * 64 + lane : 159; const int idx = sl * 10 + (tt >> 4), off = (tt & 15) * 64;
      pfp = (idx < 8 ? ws + WS_ATT + (size_t)(p * 128) * 8192 + idx * 1024 : idx < 24 ? ws + WS_QTG + (size_t)(p * 128) * 16384 + (idx - 8) * 1024 : ws + WS_KENDT + (size_t)(p * 128) * 16384 + (idx - 24) * 1024) + off;
      pfstride = idx < 8 ? 8192u : 16384u; }
    unsigned pfv[HG_PD];
#pragma unroll
    for (int k = 0; k < HG_PD; ++k) pfv[k] = 0u;
#define HG_STAGE(dst_, iv_) do { LAS unsigned char* d0_ = (dst_) + (ipart * 8) * IP + is * 2; \
        *(LAS bf16_t*)(d0_ + 0 * IP) = (bf16_t)((iv_).x & 0xffffu); *(LAS bf16_t*)(d0_ + 1 * IP) = (bf16_t)((iv_).x >> 16); \
        *(LAS bf16_t*)(d0_ + 2 * IP) = (bf16_t)((iv_).y & 0xffffu); *(LAS bf16_t*)(d0_ + 3 * IP) = (bf16_t)((iv_).y >> 16); \
        *(LAS bf16_t*)(d0_ + 4 * IP) = (bf16_t)((iv_).z & 0xffffu); *(LAS bf16_t*)(d0_ + 5 * IP) = (bf16_t)((iv_).z >> 16); \
        *(LAS bf16_t*)(d0_ + 6 * IP) = (bf16_t)((iv_).w & 0xffffu); *(LAS bf16_t*)(d0_ + 7 * IP) = (bf16_t)((iv_).w >> 16); } while (0)
    if (outw) { const u32x4 iv = *(const GAS u32x4*)Ig0; HG_STAGE(IT, iv); }
#pragma unroll 1
    for (int c0 = 0; c0 < 128; c0 += HG_PD) {
#pragma unroll
      for (int k = 0; k < HG_PD; ++k) {
        const int c = c0 + k;
        const int tl0 = bl * SEQ + c * 64;
        const int cn = (c + HG_PD < 128) ? c + HG_PD : 127;
        LAS unsigned char* it_ = IT + (k & 1) * ITB; LAS unsigned char* itn = IT + ((k + 1) & 1) * ITB; LAS unsigned char* st_ = ST + (k & 1) * STB; LAS unsigned char* stn = ST + ((k + 1) & 1) * STB;
        LDS_BAR();
        if (wave < 3) { asm volatile("" :: "v"(pfv[k])); const int c7 = (c + HG_PD + 3 < 128) ? c + HG_PD + 3 : 127; pfv[k] = *(const GAS unsigned*)(pfp + (size_t)c7 * pfstride); }
        bf16x8 itf[2][2];
#pragma unroll
        for (int vt = 0; vt < 2; ++vt)
#pragma unroll
            for (int ks = 0; ks < 2; ++ks) itf[vt][ks] = lfrag(it_, IP, vt * 16 + fr, ks * 32, fq);
        bf16x8 sf[2][4];
        f32x4 acc[2];
        acc[0] = (f32x4){0.f, 0.f, 0.f, 0.f}; acc[1] = acc[0];
        if (outw) {
#pragma unroll
            for (int vt = 0; vt < 2; ++vt)
#pragma unroll
                for (int ks = 0; ks < 4; ++ks) sf[vt][ks] = lfrag(st_, PS_PITCH, vt * 16 + fr, ks * 32, fq);
#pragma unroll
            for (int ks = 0; ks < 2; ++ks)
#pragma unroll
                for (int vt = 0; vt < 2; ++vt) acc[vt] = MFMA16(itf[vt][ks], __builtin_bit_cast(bf16x8, pf[k][ks]), acc[vt]);
        } else {
            const f32x4 dec = __builtin_bit_cast(f32x4, pf[k][4]);
#pragma unroll
            for (int vt = 0; vt < 2; ++vt) { st[0][vt] = st[0][vt] * dec;
#pragma unroll
                for (int ks = 0; ks < 2; ++ks) st[0][vt] = MFMA16(__builtin_bit_cast(bf16x8, pf[k][ks]), itf[vt][ks], st[0][vt]); }
        }
        __builtin_amdgcn_sched_barrier(0);
        HG_LD01(k, cn);
        __builtin_amdgcn_sched_barrier(0);
        if (outw) {
#pragma unroll
            for (int ks = 0; ks < 2; ++ks)
#pragma unroll
                for (int vt = 0; vt < 2; ++vt) acc[vt] = MFMA16(sf[vt][ks], __builtin_bit_cast(bf16x8, pf[k][2 + ks]), acc[vt]);
        } else {
            const f32x4 dec = __builtin_bit_cast(f32x4, pf[k][5]);
#pragma unroll
            for (int vt = 0; vt < 2; ++vt) { st[1][vt] = st[1][vt] * dec;
#pragma unroll
                for (int ks = 0; ks < 2; ++ks) st[1][vt] = MFMA16(__builtin_bit_cast(bf16x8, pf[k][2 + ks]), itf[vt][ks], st[1][vt]); }
        }
        __builtin_amdgcn_sched_barrier(0);
        HG_LD23(k, cn);
        __builtin_amdgcn_sched_barrier(0);
        if (outw) {
#pragma unroll
            for (int ks = 2; ks < 4; ++ks)
#pragma unroll
                for (int vt = 0; vt < 2; ++vt) acc[vt] = MFMA16(sf[vt][ks], __builtin_bit_cast(bf16x8, pf[k][2 + ks]), acc[vt]);
        } else {
#pragma unroll
            for (int dtile = 0; dtile < 2; ++dtile)
#pragma unroll
                for (int vt = 0; vt < 2; ++vt) { u32x2 o; o.x = pk2(st[dtile][vt][0], st[dtile][vt][1]); o.y = pk2(st[dtile][vt][2], st[dtile][vt][3]);
                    *(LAS u32x2*)(stn + (vt * 16 + fr) * PS_PITCH + (w4 * 32 + dtile * 16 + 4 * fq) * 2) = o; }
        }
        __builtin_amdgcn_sched_barrier(0);
        HG_LD45(k, cn);
        __builtin_amdgcn_sched_barrier(0);
        if (outw) {
            HG_STAGE(itn, pf[(k + 1) % HG_PD][6]);
            GAS bf16_t* og = (GAS bf16_t*)(ws + WS_GQ) + (size_t)(tl0 + w4 * 16 + fr) * 1024 + vcol + 4 * fq;
#pragma unroll
            for (int vt = 0; vt < 2; ++vt) { u32x2 o; o.x = pk2(acc[vt][0], acc[vt][1]); o.y = pk2(acc[vt][2], acc[vt][3]); *(GAS u32x2*)(og + vt * 16) = o; }
        }
        __builtin_amdgcn_sched_barrier(0);
        { const int cni = (c + 1 + HG_PD < 128) ? c + 1 + HG_PD : 127; HG_LD6((k + 1) % HG_PD, cni); }
        __builtin_amdgcn_sched_barrier(0);
      }
    }
#pragma unroll
    for (int k = 0; k < HG_PD; ++k) asm volatile("" :: "v"(pfv[k]));
    __syncthreads();
#undef HG_LD01
#undef HG_LD23
#undef HG_LD45
#undef HG_LD6
#undef HG_STAGE
}

__device__ __forceinline__ void xn8_convert(const DArgs& a, int round, int vcu, int G) {
    const int tid = tid_(), lane = tid & 63, wave = tid >> 6;
    const int gw = vcu * NWAVES + wave, NGW = G * NWAVES;
    GAS unsigned char* ws = a.ws;
    for (int tl = gw; tl < RT; tl += NGW) {
        const size_t tg = (size_t)round * RT + tl;
        const GAS u32x2* xr = (const GAS u32x2*)((const GAS bf16_t*)(ws + WS_XN) + tg * D) + lane;
        f32x4 v[4]; float mx = 0.f;
#pragma unroll
        for (int j = 0; j < 4; ++j) { const u32x2 xv = xr[64 * j]; v[j][0] = bf_lo(xv.x); v[j][1] = bf_hi(xv.x); v[j][2] = bf_lo(xv.y); v[j][3] = bf_hi(xv.y);
            mx = fmaxf(mx, fmaxf(fmaxf(fabsf(v[j][0]), fabsf(v[j][1])), fmaxf(fabsf(v[j][2]), fabsf(v[j][3])))); }
        mx = wave_max(mx);
        const float qs = mx > 0.f ? 127.0f / mx : 0.f;
#pragma unroll
        for (int j = 0; j < 4; ++j) ((GAS unsigned*)(ws + WS_XN8 + (size_t)tl * 1024))[64 * j + lane] = pack_i8x4(v[j][0] * qs, v[j][1] * qs, v[j][2] * qs, v[j][3] * qs);
        if (lane == 0) ((GAS float*)(ws + WS_SA8))[tg] = mx * (1.0f / 127.0f);
    }
}

__device__ __forceinline__ void phase_ypass(const DArgs& a, int round, int vcu, int G) {
    const int tid = tid_(), lane = tid & 63, wave = tid >> 6;
    const int gw = vcu * NWAVES + wave, NGW = G * NWAVES;
    GAS unsigned char* ws = a.ws;
    f32x4 mg0[4], mg1[4], gg4[4];
#pragma unroll
    for (int j = 0; j < 4; ++j) { mg0[j] = *(const GAS f32x4*)(a.m_head_g + j * 512 + lane * 8); mg1[j] = *(const GAS f32x4*)(a.m_head_g + j * 512 + lane * 8 + 4); gg4[j] = *(const GAS f32x4*)(a.g_head_g + lane * 16 + 4 * j); }
    for (int tl = gw; tl < RT; tl += NGW) {
        const size_t tg = (size_t)round * RT + tl;
        const f32x4 den4 = *(const f32x4*)((const float*)(ws + WS_DEN) + tg * 4), mt4 = *(const f32x4*)((const float*)(ws + WS_MT) + tg * 4);
        float ym[4][8];
#pragma unroll
        for (int j = 0; j < 4; ++j) {
            const int col = j * 512 + lane * 8;
            const u32x4 nv = *(const u32x4*)((const bf16_t*)(ws + WS_QKPRE) + (size_t)tl * 2048 + col);
            const u32x4 ov = *(const u32x4*)((const bf16_t*)(ws + WS_SIGO) + (size_t)tl * 2048 + col);
            const float inv = 1.0f / fmaxf(fabsf(den4[j]), __expf(-mt4[j]));
            float hv[8] = {bf_lo(nv.x) * inv, bf_hi(nv.x) * inv, bf_lo(nv.y) * inv, bf_hi(nv.y) * inv, bf_lo(nv.z) * inv, bf_hi(nv.z) * inv, bf_lo(nv.w) * inv, bf_hi(nv.w) * inv};
            float ss = 0.f;
#pragma unroll
            for (int e = 0; e < 8; ++e) ss += hv[e] * hv[e];
            const float r = rsqrtf(wave_sum(ss, lane) * (1.f / 512.f) + EPS);
            const f32x4 g0 = mg0[j], g1 = mg1[j];
            const float og[8] = {bf_lo(ov.x), bf_hi(ov.x), bf_lo(ov.y), bf_hi(ov.y), bf_lo(ov.z), bf_hi(ov.z), bf_lo(ov.w), bf_hi(ov.w)};
#pragma unroll
            for (int e = 0; e < 8; ++e) ym[j][e] = og[e] * hv[e] * r * (e < 4 ? g0[e] : g1[e - 4]);
        }
        {
            float mx = 0.f;
#pragma unroll
            for (int j = 0; j < 4; ++j)
#pragma unroll
                for (int e = 0; e < 8; ++e) mx = fmaxf(mx, fabsf(ym[j][e]));
            mx = wave_max(mx);
            const float qs = mx > 0.f ? 127.0f / mx : 0.f;
#pragma unroll
            for (int j = 0; j < 4; ++j) { u32x2 o; o.x = pack_i8x4(ym[j][0] * qs, ym[j][1] * qs, ym[j][2] * qs, ym[j][3] * qs); o.y = pack_i8x4(ym[j][4] * qs, ym[j][5] * qs, ym[j][6] * qs, ym[j][7] * qs);
                *(GAS u32x2*)(ws + WS_V + (size_t)tl * 2048 + j * 512 + lane * 8) = o; }
            if (lane == 0) ((GAS float*)(ws + WS_SYM))[tl] = mx * (1.0f / 127.0f);
        }
        {
            const int col = lane * 16;
            const u32x4 n0 = *(const u32x4*)((const bf16_t*)(ws + WS_GQ) + (size_t)tl * 1024 + col), n1 = *(const u32x4*)((const bf16_t*)(ws + WS_GQ) + (size_t)tl * 1024 + col + 8);
            const u32x4 s0 = *(const u32x4*)((const bf16_t*)(ws + WS_SGG) + (size_t)tl * 1024 + col), s1 = *(const u32x4*)((const bf16_t*)(ws + WS_SGG) + (size_t)tl * 1024 + col + 8);
            float ov[16] = {bf_lo(n0.x), bf_hi(n0.x), bf_lo(n0.y), bf_hi(n0.y), bf_lo(n0.z), bf_hi(n0.z), bf_lo(n0.w), bf_hi(n0.w), bf_lo(n1.x), bf_hi(n1.x), bf_lo(n1.y), bf_hi(n1.y), bf_lo(n1.z), bf_hi(n1.z), bf_lo(n1.w), bf_hi(n1.w)};
            const float sg[16] = {bf_lo(s0.x), bf_hi(s0.x), bf_lo(s0.y), bf_hi(s0.y), bf_lo(s0.z), bf_hi(s0.z), bf_lo(s0.w), bf_hi(s0.w), bf_lo(s1.x), bf_hi(s1.x), bf_lo(s1.y), bf_hi(s1.y), bf_lo(s1.z), bf_hi(s1.z), bf_lo(s1.w), bf_hi(s1.w)};
            float ss = 0.f;
#pragma unroll
            for (int e = 0; e < 16; ++e) ss += ov[e] * ov[e];
            ss += DPP_(ss, 0xB1); ss += DPP_(ss, 0x4E); ss += DPP_(ss, 0x141);
            const float r = rsqrtf(ss * (1.f / 128.f) + EPS);
            float y[16];
#pragma unroll
            for (int e = 0; e < 16; ++e) y[e] = ov[e] * r * gg4[e >> 2][e & 3] * sg[e];
            float mx = 0.f;
#pragma unroll
            for (int e = 0; e < 16; ++e) mx = fmaxf(mx, fabsf(y[e]));
            mx = wave_max(mx);
            const float qs = mx > 0.f ? 127.0f / mx : 0.f;
            u32x4 o; o.x = pack_i8x4(y[0] * qs, y[1] * qs, y[2] * qs, y[3] * qs); o.y = pack_i8x4(y[4] * qs, y[5] * qs, y[6] * qs, y[7] * qs);
            o.z = pack_i8x4(y[8] * qs, y[9] * qs, y[10] * qs, y[11] * qs); o.w = pack_i8x4(y[12] * qs, y[13] * qs, y[14] * qs, y[15] * qs);
            *(GAS u32x4*)(ws + WS_GI + (size_t)tl * 1024 + col) = o;
            if (lane == 0) ((GAS float*)(ws + WS_SYG))[tl] = mx * (1.0f / 127.0f);
        }
    }
}


#define XB_TMO      128
#define XB_XCNT(j)  (256  + 64 * (j))
#define XB_XSUB(j)  (1280 + 64 * (j))
#define XB_XGEN(j)  (2304 + 64 * (j))
#define XB_TOP      3328
#define XB_TOPGEN   3392
#define XB_SPIN_CAP (1u << 22)
constexpr int CW_BAR = 4096;
constexpr int LDS_BARST = LDS_BYTES - 64;
__device__ __forceinline__ unsigned xb_ld(unsigned* p)              { return __hip_atomic_load(p, __ATOMIC_RELAXED, __HIP_MEMORY_SCOPE_AGENT); }
__device__ __forceinline__ unsigned xb_add(unsigned* p, unsigned v) { return __hip_atomic_fetch_add(p, v, __ATOMIC_RELAXED, __HIP_MEMORY_SCOPE_AGENT); }
__device__ __forceinline__ unsigned xb_xcc_id() { return (unsigned)__builtin_amdgcn_s_getreg((3 << 11) | 20) & 0xFu; }
#define XB_SPIN(cond, bar) do { unsigned _sp = 0; while (cond) { __builtin_amdgcn_s_sleep(1); \
    if ((++_sp & 255u) == 0u) { if (xb_ld(&(bar)[XB_TMO])) break; if (_sp > XB_SPIN_CAP) { atomicAdd(&(bar)[XB_TMO], 1u); break; } } } } while (0)
__device__ __forceinline__ void xcd_barrier_post(unsigned* bar, volatile LAS unsigned* st) { if (tid_() == 0) st[2] = xb_add(&bar[XB_XCNT(xb_xcc_id())], 1u); }
__device__ __forceinline__ void xcd_barrier_complete(unsigned* bar, unsigned x, unsigned& nloc, unsigned& nx) {
    const unsigned G = gridDim.x;
    unsigned sum, cnt, mine, sp = 0u;
    for (;;) {
        sum = 0u; cnt = 0u; mine = 0u;
#pragma unroll
        for (unsigned j = 0; j < 16; ++j) { const unsigned c = xb_ld(&bar[XB_XCNT(j)]); sum += c; cnt += (c > 0u) ? 1u : 0u; mine = (j == x) ? c : mine; }
        if (sum == G) break;
        __builtin_amdgcn_s_sleep(1);
        if ((++sp & 255u) == 0u) { if (xb_ld(&bar[XB_TMO])) break; if (sp > XB_SPIN_CAP) { atomicAdd(&bar[XB_TMO], 1u); break; } }
    }
    nloc = mine > 0u ? mine : 1u; nx = cnt > 0u ? cnt : 1u;
}
__device__ __forceinline__ void xcd_barrier(unsigned* bar, volatile LAS unsigned* st) {
    asm volatile("s_waitcnt vmcnt(0)" ::: "memory");
    __syncthreads();
    if (tid_() == 0) {
        const unsigned x = xb_xcc_id();
        __builtin_amdgcn_s_waitcnt(0);
        unsigned nloc = st[0], nx = st[1];
        if (nloc == 0u) { xcd_barrier_complete(bar, x, nloc, nx); st[0] = nloc; st[1] = nx; }
        const unsigned old = xb_add(&bar[XB_XSUB(x)], 1u);
        const unsigned gen = old / nloc;
        if (old + 1u == (gen + 1u) * nloc) {
            __builtin_amdgcn_fence(__ATOMIC_RELEASE, "agent");
            asm volatile("s_waitcnt vmcnt(0)" ::: "memory");
            const unsigned og = xb_add(&bar[XB_TOP], 1u);
            const unsigned tg = og / nx;
            if (og + 1u == (tg + 1u) * nx) xb_add(&bar[XB_TOPGEN], 1u);
            else XB_SPIN(xb_ld(&bar[XB_TOPGEN]) == tg, bar);
            __builtin_amdgcn_fence(__ATOMIC_ACQUIRE, "agent");
            xb_add(&bar[XB_XGEN(x)], 1u);
            asm volatile("s_waitcnt vmcnt(0)" ::: "memory");
        } else {
            XB_SPIN(xb_ld(&bar[XB_XGEN(x)]) == gen, bar);
            __builtin_amdgcn_fence(__ATOMIC_ACQUIRE, "agent");
            asm volatile("s_waitcnt vmcnt(0)" ::: "memory");
        }
    }
    __syncthreads();
}

__device__ __forceinline__ void phase_p8(const DArgs& a, int vcu, int G) {
    const int tid = tid_(), lane = tid & 63, wave = tid >> 6;
    const int gw = vcu * NWAVES + wave, NGW = G * NWAVES;
    GAS unsigned char* ws = a.ws;
    f32x4 g2[4];
#pragma unroll
    for (int j = 0; j < 4; ++j) g2[j] = ((const f32x4*)a.norm2_g)[64 * j + lane];
    for (int m = gw; m < T; m += NGW) {
        const GAS u32x2* xr = (const GAS u32x2*)((const GAS bf16_t*)a.out + (size_t)m * D) + lane;
        f32x4 v[4]; float s = 0.f;
#pragma unroll
        for (int j = 0; j < 4; ++j) { const u32x2 xv = xr[64 * j]; v[j][0] = bf_lo(xv.x); v[j][1] = bf_hi(xv.x); v[j][2] = bf_lo(xv.y); v[j][3] = bf_hi(xv.y); s += (v[j][0] * v[j][0] + v[j][1] * v[j][1]) + (v[j][2] * v[j][2] + v[j][3] * v[j][3]); }
        const float rstd = rsqrtf(wave_sum(s, lane) * (1.f / D) + EPS);
        unsigned long long* o8 = (unsigned long long*)((bf16_t*)(ws + WS_XN) + (size_t)m * D) + lane;
#pragma unroll
        for (int j = 0; j < 4; ++j) { v[j] = v[j] * rstd * g2[j]; o8[64 * j] = (unsigned long long)pk2(v[j][0], v[j][1]) | ((unsigned long long)pk2(v[j][2], v[j][3]) << 32); }
        float mx = 0.f;
#pragma unroll
        for (int j = 0; j < 4; ++j) mx = fmaxf(mx, fmaxf(fmaxf(fabsf(v[j][0]), fabsf(v[j][1])), fmaxf(fabsf(v[j][2]), fabsf(v[j][3]))));
        mx = wave_max(mx);
        const float qs = mx > 0.f ? 127.0f / mx : 0.f;
#pragma unroll
        for (int j = 0; j < 4; ++j) ((GAS unsigned*)(ws + WS_XQ + (size_t)m * 1024))[64 * j + lane] = pack_i8x4(v[j][0] * qs, v[j][1] * qs, v[j][2] * qs, v[j][3] * qs);
        if (lane == 0) ((GAS float*)(ws + WS_XQS))[m] = mx * (1.0f / 127.0f);
    }
    for (int e = gw; e < 16384; e += NGW) {
        f32x4 uv[4], vv[4]; float mu = 0.f, mv = 0.f;
#pragma unroll
        for (int j = 0; j < 4; ++j) { uv[j] = ((const GAS f32x4*)(a.u_emb + (size_t)e * 1024))[64 * j + lane]; vv[j] = ((const GAS f32x4*)(a.v_emb + (size_t)e * 1024))[64 * j + lane];
            mu = fmaxf(mu, fmaxf(fmaxf(fabsf(uv[j][0]), fabsf(uv[j][1])), fmaxf(fabsf(uv[j][2]), fabsf(uv[j][3]))));
            mv = fmaxf(mv, fmaxf(fmaxf(fabsf(vv[j][0]), fabsf(vv[j][1])), fmaxf(fabsf(vv[j][2]), fabsf(vv[j][3])))); }
        mu = wave_max(mu); mv = wave_max(mv);
        const float su = mu > 0.f ? 127.0f / mu : 0.f, sv = mv > 0.f ? 448.0f / mv : 0.f;
        if (lane == 0) { ((GAS float*)(ws + WS_USC))[e] = mu * (1.0f / 127.0f); ((GAS float*)(ws + WS_VSC))[e] = mv * (1.0f / 448.0f); }
#pragma unroll
        for (int j = 0; j < 4; ++j) {
            const size_t ob = (size_t)(2 * j + (lane >> 5)) * 2097152 + (size_t)e * 128 + ((4 * lane) & 127);
            *(GAS unsigned*)(ws + WS_UB + ob) = pack_i8x4(uv[j][0] * su, uv[j][1] * su, uv[j][2] * su, uv[j][3] * su);
            int p = __builtin_amdgcn_cvt_pk_fp8_f32(vv[j][0] * sv, vv[j][1] * sv, 0, false); p = __builtin_amdgcn_cvt_pk_fp8_f32(vv[j][2] * sv, vv[j][3] * sv, p, true);
            *(GAS unsigned*)(ws + WS_VB + ob) = (unsigned)p; }
    }
}

__device__ __forceinline__ unsigned f2ord(float f) { const unsigned u = __builtin_bit_cast(unsigned, f); return (u & 0x80000000u) ? ~u : (u | 0x80000000u); }
__device__ __forceinline__ float ord2f(unsigned k) { const unsigned u = (k & 0x80000000u) ? (k & 0x7fffffffu) : ~k; return __builtin_bit_cast(float, u); }
__device__ __forceinline__ unsigned umax_(unsigned a, unsigned b) { return a > b ? a : b; }
__device__ __forceinline__ unsigned shxu(unsigned v, int o, int lane) { return (unsigned)__builtin_amdgcn_ds_bpermute((lane ^ o) << 2, (int)v); }

__device__ __forceinline__ void phase_topk(const DArgs& a, LAS unsigned char* lds, int bx, int G) {
    const int tid = tid_(), lane = tid & 63, wave = __builtin_amdgcn_readfirstlane(tid >> 6), fr = lane & 15, fq = lane >> 4;
    GAS unsigned char* ws = a.ws;
    const int h = bx & 7;
    LAS unsigned char* KY = lds;
    LAS unsigned char* QL = lds + 2 * 128 * PS_PITCH;
    LAS unsigned* TOP = (LAS unsigned*)(lds + 2 * 128 * PS_PITCH + 64 * PQ_PITCH);
#pragma unroll
    for (int i = 0; i < 8; ++i) { const int idx = tid + 512 * i, row = idx >> 4, ch = idx & 15;
        *(LAS u32x4*)(KY + row * PS_PITCH + ch * 16) = *(const u32x4*)((const bf16_t*)(ws + WS_SK) + ((size_t)h * 256 + row) * 128 + ch * 8); }
    const int ntile = T / 64;
    u32x4 qpre[4];
    { const int tile0 = bx >> 3; if (tile0 < ntile) {
#pragma unroll
        for (int i = 0; i < 4; ++i) { const int idx = tid + 512 * i, row = idx >> 5, ch = idx & 31;
            qpre[i] = *(const GAS u32x4*)((const GAS bf16_t*)(ws + WS_QP) + ((size_t)tile0 * 64 + row) * 2048 + h * 256 + ch * 8); } } }
    __syncthreads();
    for (int tile = bx >> 3; tile < ntile; tile += (G >> 3)) {
        const size_t t0 = (size_t)tile * 64;
        LDS_BAR();
#pragma unroll
        for (int i = 0; i < 4; ++i) { const int idx = tid + 512 * i, row = idx >> 5, ch = idx & 31;
            *(LAS u32x4*)(QL + row * PQ_PITCH + ch * 16) = qpre[i]; }
        { const int tn = tile + (G >> 3); if (tn < ntile) {
#pragma unroll
            for (int i = 0; i < 4; ++i) { const int idx = tid + 512 * i, row = idx >> 5, ch = idx & 31;
                qpre[i] = *(const GAS u32x4*)((const GAS bf16_t*)(ws + WS_QP) + ((size_t)tn * 64 + row) * 2048 + h * 256 + ch * 8); } } }
        LDS_BAR();
        {
            const int mt = wave & 3, p = wave >> 2;
            unsigned key[32];
#pragma unroll
            for (int nt = 0; nt < 8; ++nt) { f32x4 acc = (f32x4){0.f, 0.f, 0.f, 0.f};
#pragma unroll
                for (int ks = 0; ks < 4; ++ks) acc = MFMA16(lfrag(KY + p * 128 * PS_PITCH, PS_PITCH, nt * 16 + fr, ks * 32, fq), lfrag(QL, PQ_PITCH, mt * 16 + fr, p * 128 + ks * 32, fq), acc);
#pragma unroll
                for (int j = 0; j < 4; ++j) { const int n = nt * 16 + 4 * fq + j; key[nt * 4 + j] = (f2ord(acc[j]) & ~127u) | (unsigned)(127 - n); } }
#pragma unroll 1
            for (int k = 0; k < 16; ++k) {
                unsigned t3[11];
#pragma unroll
                for (int e = 0; e < 10; ++e) t3[e] = umax_(umax_(key[3 * e], key[3 * e + 1]), key[3 * e + 2]);
                t3[10] = umax_(key[30], key[31]);
                const unsigned u0 = umax_(umax_(t3[0], t3[1]), t3[2]), u1 = umax_(umax_(t3[3], t3[4]), t3[5]), u2 = umax_(umax_(t3[6], t3[7]), t3[8]), u3 = umax_(t3[9], t3[10]);
                unsigned m = umax_(umax_(u0, u1), umax_(u2, u3));
                m = umax_(m, (unsigned)SWZI_(m, 0x401F)); m = umax_(m, xor32u_(m, lane >= 32));
#pragma unroll
                for (int e = 0; e < 32; ++e) key[e] = (key[e] == m) ? 0u : key[e];
                if (fq == (k & 3)) TOP[(p * 64 + mt * 16 + fr) * 16 + k] = m;
            }
        }
        LDS_BAR();
        {
            const int t = tid >> 3, sub = tid & 7;
            unsigned ck[7];
#pragma unroll
            for (int e = 0; e < 7; ++e) {
                const int ci = sub + 8 * e;
                int i = 0, base = 0; bool ok = ci < 50;
                if (ci >= 42) { i = 8 + (ci - 42); base = ci; } else if (ci >= 40) { i = 7; base = 40; } else if (ci >= 38) { i = 6; base = 38; } else if (ci >= 36) { i = 5; base = 36; }
                else if (ci >= 33) { i = 4; base = 33; } else if (ci >= 29) { i = 3; base = 29; } else if (ci >= 24) { i = 2; base = 24; } else if (ci >= 16) { i = 1; base = 16; }
                const int j = ci - base;
                unsigned kk = 0u;
                if (ok) { const float s0 = ord2f(TOP[(0 * 64 + t) * 16 + i] & ~127u), s1 = ord2f(TOP[(1 * 64 + t) * 16 + j] & ~127u);
                    kk = (f2ord(s0 + s1) & ~255u) | (unsigned)(255 - (i * 16 + j)); }
                ck[e] = kk;
            }
            unsigned w0 = 0u, w1 = 0u;
#pragma unroll 1
            for (int k = 0; k < 16; ++k) {
                unsigned m = umax_(umax_(umax_(ck[0], ck[1]), ck[2]), umax_(umax_(umax_(ck[3], ck[4]), ck[5]), ck[6]));
                m = umax_(m, (unsigned)DPPI_(m, 0xB1)); m = umax_(m, (unsigned)DPPI_(m, 0x4E)); m = umax_(m, (unsigned)DPPI_(m, 0x141));
#pragma unroll
                for (int e = 0; e < 7; ++e) ck[e] = (ck[e] == m) ? 0u : ck[e];
                if (k == sub) w0 = m; if (k == sub + 8) w1 = m;
            }
            const int f0 = 255 - (int)(w0 & 255u), f1 = 255 - (int)(w1 & 255u);
            const float sc0 = ord2f(w0 & ~255u), sc1 = ord2f(w1 & ~255u);
            float mx = fmaxf(sc0, sc1); mx = fmaxf(mx, DPP_(mx, 0xB1)); mx = fmaxf(mx, DPP_(mx, 0x4E)); mx = fmaxf(mx, DPP_(mx, 0x141));
            const float e0 = __expf(sc0 - mx), e1 = __expf(sc1 - mx);
            float sm = e0 + e1; sm += DPP_(sm, 0xB1); sm += DPP_(sm, 0x4E); sm += DPP_(sm, 0x141);
            const float inv = 1.0f / sm;
            const int i0 = 127 - (int)(TOP[(0 * 64 + t) * 16 + (f0 >> 4)] & 127u), j0 = 127 - (int)(TOP[(1 * 64 + t) * 16 + (f0 & 15)] & 127u);
            const int i1 = 127 - (int)(TOP[(0 * 64 + t) * 16 + (f1 >> 4)] & 127u), j1 = 127 - (int)(TOP[(1 * 64 + t) * 16 + (f1 & 15)] & 127u);
            unsigned short* ei = (unsigned short*)(ws + WS_EIDX) + ((t0 + t) * 8 + h) * 16; float* gp = (float*)(ws + WS_GATE) + ((t0 + t) * 8 + h) * 16;
            ei[sub] = (unsigned short)(i0 * 128 + j0); ei[sub + 8] = (unsigned short)(i1 * 128 + j1); gp[sub] = e0 * inv; gp[sub + 8] = e1 * inv;
        }
    }
    __syncthreads();
}

__device__ __forceinline__ void ins16(float (&v)[16], int (&id)[16], float x, int n) {
    if (x > v[15]) { v[15] = x; id[15] = n;
#pragma unroll
        for (int i = 15; i >= 1; --i) { if (v[i] > v[i - 1]) { const float tv = v[i]; v[i] = v[i - 1]; v[i - 1] = tv; const int ti = id[i]; id[i] = id[i - 1]; id[i - 1] = ti; } } }
}
__device__ __forceinline__ void phase_topk_ref(const DArgs& a, int vcu, int G) {
    const int tid = tid_();
    GAS unsigned char* ws = a.ws;
    const int gt = vcu * NTHR + tid, NGT = G * NTHR;
    for (int pair = gt; pair < T * 8; pair += NGT) {
        const int t = pair >> 3, h = pair & 7;
        float sv[2][16]; int si[2][16];
#pragma unroll
        for (int p = 0; p < 2; ++p) {
#pragma unroll
            for (int i = 0; i < 16; ++i) { sv[p][i] = -INFINITY; si[p][i] = 0; }
            const bf16_t* qp = (const bf16_t*)(ws + WS_QP) + (size_t)t * 2048 + h * 256 + p * 128;
            for (int n = 0; n < 128; ++n) {
                const bf16_t* kp = (const bf16_t*)(ws + WS_SK) + ((size_t)(h * 2 + p) * 128 + n) * 128;
                float s = 0.f;
                for (int c = 0; c < 128; c += 8) { const u32x4 qv = *(const u32x4*)(qp + c), kv = *(const u32x4*)(kp + c);
                    s += bf_lo(qv.x) * bf_lo(kv.x) + bf_hi(qv.x) * bf_hi(kv.x) + bf_lo(qv.y) * bf_lo(kv.y) + bf_hi(qv.y) * bf_hi(kv.y)
                       + bf_lo(qv.z) * bf_lo(kv.z) + bf_hi(qv.z) * bf_hi(kv.z) + bf_lo(qv.w) * bf_lo(kv.w) + bf_hi(qv.w) * bf_hi(kv.w); }
                ins16(sv[p], si[p], s, n);
            }
        }
        float tv[16]; int ti[16];
#pragma unroll
        for (int i = 0; i < 16; ++i) { tv[i] = -INFINITY; ti[i] = 0; }
#pragma unroll
        for (int i = 0; i < 16; ++i)
#pragma unroll
            for (int j = 0; j < 16; ++j) ins16(tv, ti, sv[0][i] + sv[1][j], i * 16 + j);
        float sm = 0.f, ex[16];
#pragma unroll
        for (int k = 0; k < 16; ++k) { ex[k] = __expf(tv[k] - tv[0]); sm += ex[k]; }
        int* ei = (int*)(ws + WS_EIDX) + (size_t)pair * 16; float* gp = (float*)(ws + WS_GATE) + (size_t)pair * 16;
#pragma unroll
        for (int k = 0; k < 16; ++k) {
            int e0 = 0, e1 = 0;
#pragma unroll
            for (int i = 0; i < 16; ++i) { e0 = ((ti[k] >> 4) == i) ? si[0][i] : e0; e1 = ((ti[k] & 15) == i) ? si[1][i] : e1; }
            ei[k] = e0 * 128 + e1; gp[k] = ex[k] / sm; }
    }
}

#define FP8LO(w) __builtin_amdgcn_cvt_pk_f32_fp8((int)(w), false)
#define FP8HI(w) __builtin_amdgcn_cvt_pk_f32_fp8((int)(w), true)
__device__ __forceinline__ float dot16_fp8(const u32x4 r, const float (&x)[16]) {
    float c = 0.f;
#pragma unroll
    for (int j = 0; j < 4; ++j) { const f32x2 lo = FP8LO(r[j]), hi = FP8HI(r[j]); c += lo[0] * x[4 * j] + lo[1] * x[4 * j + 1] + hi[0] * x[4 * j + 2] + hi[1] * x[4 * j + 3]; }
    return c;
}
__device__ __forceinline__ float dot16_fp8p(const u32x4 r, const f32x2 (&xp)[8]) {
    f32x2 c2 = (f32x2){0.f, 0.f};
#pragma unroll
    for (int j = 0; j < 4; ++j) { c2 += FP8LO(r[j]) * xp[2 * j]; c2 += FP8HI(r[j]) * xp[2 * j + 1]; }
    return c2[0] + c2[1];
}
__device__ __forceinline__ float gelu_erf(float d) {
    const float ad = fabsf(d), t = __builtin_amdgcn_rcpf(ad * 0.2316418882f + 1.0f);
    float q = t * 0.5307027145f + (-0.7265760135f); q = q * t + 0.7107068705f; q = q * t + (-0.142248368f); q = q * t + 0.127414796f; q = q * t;
    const float m = d * (q * __builtin_amdgcn_exp2f(d * d * (-0.72134752044f)));
    return d < 0.f ? m : d - m;
}
__device__ __forceinline__ float bperm(float v, int srclane) { return __builtin_bit_cast(float, __builtin_amdgcn_ds_bpermute(srclane << 2, __builtin_bit_cast(int, v))); }
#define SWZ_(v, pat) __builtin_bit_cast(float, __builtin_amdgcn_ds_swizzle(__builtin_bit_cast(int, (v)), (pat)))
__device__ __forceinline__ float rs32_(float a, float b) {
#if defined(__HIP_DEVICE_COMPILE__)
    asm volatile("s_nop 1\n\tv_permlane32_swap_b32 %0, %1" : "+v"(a), "+v"(b));
#endif
    return a + b;
}
__device__ __forceinline__ float rs16_(float a, float b) {
#if defined(__HIP_DEVICE_COMPILE__)
    asm volatile("s_nop 1\n\tv_permlane16_swap_b32 %0, %1" : "+v"(a), "+v"(b));
#endif
    return a + b;
}
__device__ __forceinline__ float rs8_(float a, float b, bool bit3) {
    const float send = bit3 ? a : b, keep = bit3 ? b : a;
    return keep + DPP_(send, 0x128);
}
__device__ __forceinline__ float xor32_(float v, bool hi) {
#if defined(__HIP_DEVICE_COMPILE__)
    const auto r = __builtin_amdgcn_permlane32_swap(__builtin_bit_cast(unsigned, v), __builtin_bit_cast(unsigned, v), false, false);
    return __builtin_bit_cast(float, hi ? r[0] : r[1]);
#else
    (void)hi; return v;
#endif
}
__device__ __forceinline__ float reduce8(const float (&p)[8], int lane) {
    float q4[4], q2[2];
    const bool b5 = lane & 32, b4 = lane & 16, b3 = lane & 8;
#pragma unroll
    for (int i = 0; i < 4; ++i) { const float send = b5 ? p[i] : p[i + 4], keep = b5 ? p[i + 4] : p[i]; q4[i] = keep + xor32_(send, b5); }
#pragma unroll
    for (int i = 0; i < 2; ++i) { const float send = b4 ? q4[i] : q4[i + 2], keep = b4 ? q4[i + 2] : q4[i]; q2[i] = keep + SWZ_(send, 0x401F); }
    const float send = b3 ? q2[0] : q2[1], keep = b3 ? q2[1] : q2[0];
    float q1 = keep + SWZ_(send, 0x201F);
    q1 += DPP_(q1, 0xB1); q1 += DPP_(q1, 0x4E); q1 += DPP_(q1, 0x141);
    return q1;
}
__device__ __forceinline__ void phase_udots(const DArgs& a, LAS unsigned char* lds) {
    const int tid = tid_(), lane = tid & 63, wave = __builtin_amdgcn_readfirstlane(tid >> 6);
    GAS unsigned char* ws = a.ws;
    volatile LAS unsigned* bst = (volatile LAS unsigned*)(lds + LDS_BARST);
    const int nloc = (int)bst[0], nx = (int)bst[1], rank = (int)bst[2];
    unsigned* bar = (unsigned*)(ws + WS_CTL) + CW_BAR;
    const unsigned myx = xb_xcc_id();
    int q = 0;
    for (unsigned j = 0; j < 16; ++j) { const unsigned c = xb_ld(&bar[XB_XCNT(j)]); if (c > 0u && j < myx) ++q; }
    LAS int* LE = (LAS int*)(lds + wave * 2048);
    LAS int* LP = LE + 128; LAS float* LG = (LAS float*)(LE + 256);
    const GAS unsigned char* UB = ws + WS_UB;
    const int g8 = lane >> 3;
    const float usc = ((const GAS float*)(ws + WS_USC))[0], vsc = ((const GAS float*)(ws + WS_USC))[1];
    for (int s = q; s < 8; s += nx) {
        int tok = rank * 8 + wave;
        u32x4 xq0 = (u32x4){0u, 0u, 0u, 0u}, xq1 = xq0; u32x2 e2 = (u32x2){0u, 0u}; f32x2 g2 = (f32x2){0.f, 0.f};
#define U_INFO(t_) do { xq0 = *(const u32x4*)((const GAS bf16_t*)(ws + WS_XN) + (size_t)(t_) * D + lane * 16); xq1 = *(const u32x4*)((const GAS bf16_t*)(ws + WS_XN) + (size_t)(t_) * D + lane * 16 + 8); \
        e2 = *(const u32x2*)((const GAS int*)(ws + WS_EIDX) + (size_t)(t_) * 128 + 2 * lane); g2 = *(const f32x2*)((const GAS float*)(ws + WS_GATE) + (size_t)(t_) * 128 + 2 * lane); } while (0)
        if (tok < T) U_INFO(tok);
        for (; tok < T; tok += nloc * 8) {
            const bool in0 = (int)(e2.x >> 11) == s, in1 = (int)(e2.y >> 11) == s;
            const unsigned long long m0 = __ballot(in0), m1 = __ballot(in1);
            const unsigned long long lt = (1ull << lane) - 1ull;
            const int n0 = __popcll(m0), n = n0 + __popcll(m1);
            if (in0) { const int pos = __popcll(m0 & lt); LE[pos] = (int)e2.x; LP[pos] = 2 * lane; LG[pos] = g2[0]; }
            if (in1) { const int pos = n0 + __popcll(m1 & lt); LE[pos] = (int)e2.y; LP[pos] = 2 * lane + 1; LG[pos] = g2[1]; }
            const float xf[16] = {bf_lo(xq0.x), bf_hi(xq0.x), bf_lo(xq0.y), bf_hi(xq0.y), bf_lo(xq0.z), bf_hi(xq0.z), bf_lo(xq0.w), bf_hi(xq0.w),
                                  bf_lo(xq1.x), bf_hi(xq1.x), bf_lo(xq1.y), bf_hi(xq1.y), bf_lo(xq1.z), bf_hi(xq1.z), bf_lo(xq1.w), bf_hi(xq1.w)};
            asm volatile("s_waitcnt lgkmcnt(0)" ::: "memory");
            u32x4 R0[8], R1[8], R2[8];
#define U_ISSUE(R_, g0_) do { _Pragma("unroll") for (int k = 0; k < 8; ++k) { const int slot_ = ((g0_) + k < n) ? (g0_) + k : n - 1; const int e_ = LE[slot_]; R_[k] = *(const u32x4*)(UB + (size_t)e_ * 1024 + lane * 16); } } while (0)
#define U_DOTS(R_, g0_) do { float pp_[8]; _Pragma("unroll") for (int k = 0; k < 8; ++k) pp_[k] = dot16_fp8(R_[k], xf); const float dsum_ = reduce8(pp_, lane); const int slot_ = (g0_) + g8; \
            if (slot_ < n && (lane & 7) == 0) { const float d_ = dsum_ * usc; \
                ((GAS float*)(ws + WS_PW))[(size_t)tok * 128 + LP[slot_]] = 0.5f * d_ * (1.0f + erff(d_ * 0.70710678118654752f)) * LG[slot_] * vsc; } } while (0)
            if (n > 0) U_ISSUE(R0, 0);
            if (n > 8) U_ISSUE(R1, 8);
            if (n > 16) U_ISSUE(R2, 16);
            const int tokN = tok + nloc * 8;
            if (tokN < T) U_INFO(tokN);
            if (n > 0) U_DOTS(R0, 0);
            if (n > 8) U_DOTS(R1, 8);
            if (n > 16) U_DOTS(R2, 16);
            for (int g0 = 24; g0 < n; g0 += 8) { U_ISSUE(R0, g0); U_DOTS(R0, g0); }
            asm volatile("s_waitcnt lgkmcnt(0)" ::: "memory");
        }
#undef U_INFO
#undef U_ISSUE
#undef U_DOTS
    }
}

#define EV_OFF(ev_, g_) (((g_) & 1) ? ((ev_[(g_) >> 3][((g_) >> 1) & 3] >> 9) & 0x7fff80u) : ((ev_[(g_) >> 3][((g_) >> 1) & 3] << 7) & 0x7fff80u))
struct XcdSlice { int nloc, nx, rank, q; };
__device__ __forceinline__ XcdSlice xcd_slice_setup(const DArgs& a, LAS unsigned char* lds) {
    volatile LAS unsigned* bst = (volatile LAS unsigned*)(lds + LDS_BARST);
    XcdSlice x; x.nloc = __builtin_amdgcn_readfirstlane((int)bst[0]); x.nx = __builtin_amdgcn_readfirstlane((int)bst[1]); x.rank = __builtin_amdgcn_readfirstlane((int)bst[2]);
    unsigned* bar = (unsigned*)(a.ws + WS_CTL) + CW_BAR; const unsigned myx = xb_xcc_id();
    x.q = 0; for (unsigned j = 0; j < 16; ++j) { const unsigned c = xb_ld(&bar[XB_XCNT(j)]); if (c > 0u && j < myx) ++x.q; }
    x.q = __builtin_amdgcn_readfirstlane(x.q);
    return x;
}
__device__ __forceinline__ void phase_ua(const DArgs& a, LAS unsigned char* lds) {
    const int tid = tid_(), lane = tid & 63, wave = __builtin_amdgcn_readfirstlane(tid >> 6), k = lane >> 3, c = lane & 7;
    GAS unsigned char* ws = a.ws;
    const XcdSlice X = xcd_slice_setup(a, lds);
    const int tstride = X.nloc * 8;
    for (int sl = X.q; sl < 8; sl += X.nx) {
        const GAS unsigned char* UBs = ws + WS_UB + (size_t)sl * 2097152;
        const unsigned coff = (unsigned)c * 16u;
        GAS unsigned char* PU = ws + WS_PARTU + (size_t)sl * T * 256;
        u32x4 evA[2], evB[2], RA[16], RB[16], xa, xb; float sa, sb;
#define A_TOK(t_) ((t_) < T ? (t_) : T - 1)
#define A_INFO(ev_, t_) do { const int tq_ = A_TOK(t_); _Pragma("unroll") for (int j_ = 0; j_ < 2; ++j_) ev_[j_] = *(const GAS u32x4*)(ws + WS_EIDX + (size_t)tq_ * 256 + (unsigned)(32 * k + 16 * j_)); } while (0)
#define A_ISSUE(R_, x_, s_, ev_, t_) do { const int tq_ = A_TOK(t_); _Pragma("unroll") for (int g_ = 0; g_ < 16; ++g_) R_[g_] = *(const GAS u32x4*)(UBs + (EV_OFF(ev_, g_) | coff)); \
        x_ = *(const GAS u32x4*)(ws + WS_XQ + (size_t)tq_ * 1024 + sl * 128 + coff); s_ = ((const GAS float*)(ws + WS_XQS))[tq_]; } while (0)
#define A_DOTS(R_, x_, s_, t_) do { \
        int ir0_ = 0, ir1_ = 0; \
        _Pragma("unroll") for (int gg_ = 0; gg_ < 4; ++gg_) {           \
            int d_[4]; _Pragma("unroll") for (int q_ = 0; q_ < 4; ++q_) d_[q_] = 0; \
            _Pragma("unroll") for (int j_ = 0; j_ < 4; ++j_) { _Pragma("unroll") for (int q_ = 0; q_ < 4; ++q_) d_[q_] = __builtin_amdgcn_sdot4((int)R_[4 * gg_ + q_][j_], (int)x_[j_], d_[q_], false); } \
            _Pragma("unroll") for (int q_ = 0; q_ < 4; ++q_) d_[q_] += DPPI_(d_[q_], 0xB1); \
            _Pragma("unroll") for (int q_ = 0; q_ < 4; ++q_) d_[q_] += DPPI_(d_[q_], 0x4E); \
            _Pragma("unroll") for (int q_ = 0; q_ < 4; ++q_) d_[q_] += DPPI_(d_[q_], 0x141);          \
            _Pragma("unroll") for (int q_ = 0; q_ < 4; ++q_) { if (c == ((4 * gg_ + q_) >> 1)) { if (q_ & 1) ir1_ = d_[q_]; else ir0_ = d_[q_]; } }          \
            __builtin_amdgcn_sched_barrier(0); } \
        if ((t_) < T) *(GAS unsigned*)(PU + (size_t)(t_) * 256 + (unsigned)(4 * lane)) = pk2((float)ir0_ * s_, (float)ir1_ * s_); } while (0)
        const int n0 = X.rank * 8 + wave;
        A_INFO(evA, n0); A_INFO(evB, n0 + tstride);
        __builtin_amdgcn_sched_barrier(0);
        A_ISSUE(RA, xa, sa, evA, n0);
        __builtin_amdgcn_sched_barrier(0);
#pragma unroll 1
        for (int n = n0; n < T; n += 2 * tstride) {
            A_INFO(evA, n + 2 * tstride);
            __builtin_amdgcn_sched_barrier(0);
            A_ISSUE(RB, xb, sb, evB, n + tstride);
            __builtin_amdgcn_sched_barrier(0);
            A_DOTS(RA, xa, sa, n);
            __builtin_amdgcn_sched_barrier(0);
            A_INFO(evB, n + 3 * tstride);
            __builtin_amdgcn_sched_barrier(0);
            A_ISSUE(RA, xa, sa, evA, n + 2 * tstride);
            __builtin_amdgcn_sched_barrier(0);
            A_DOTS(RB, xb, sb, n + tstride);
            __builtin_amdgcn_sched_barrier(0);
        }
#undef A_TOK
#undef A_INFO
#undef A_ISSUE
#undef A_DOTS
    }
}
__device__ __forceinline__ void phase_ua2(const DArgs& a, int vcu, int G) {
    const int tid = tid_();
    GAS unsigned char* ws = a.ws;
    const GAS float* USC = (const GAS float*)(ws + WS_USC); const GAS float* VSC = (const GAS float*)(ws + WS_VSC);
    const GAS unsigned char* PU = ws + WS_PARTU;
    const size_t N4 = (size_t)T * 128 / 4, stride = (size_t)G * NTHR;
    for (size_t i = (size_t)vcu * NTHR + tid; i < N4; i += 2 * stride) {
        const size_t i1 = (i + stride < N4) ? i + stride : i;
        u32x2 pv0[8], pv1[8];
#pragma unroll
        for (int sl = 0; sl < 8; ++sl) { pv0[sl] = ((const GAS u32x2*)(PU + (size_t)sl * T * 256))[i]; pv1[sl] = ((const GAS u32x2*)(PU + (size_t)sl * T * 256))[i1]; }
        const f32x4 gt0 = ((const GAS f32x4*)(ws + WS_GATE))[i], gt1 = ((const GAS f32x4*)(ws + WS_GATE))[i1];
        const u32x2 ep0 = ((const GAS u32x2*)(ws + WS_EIDX))[i], ep1 = ((const GAS u32x2*)(ws + WS_EIDX))[i1];
        const unsigned e0[4] = {ep0.x & 0xffffu, ep0.x >> 16, ep0.y & 0xffffu, ep0.y >> 16}, e1[4] = {ep1.x & 0xffffu, ep1.x >> 16, ep1.y & 0xffffu, ep1.y >> 16};
        float us0[4], vs0[4], us1[4], vs1[4];
#pragma unroll
        for (int e = 0; e < 4; ++e) { us0[e] = USC[e0[e]]; vs0[e] = VSC[e0[e]]; us1[e] = USC[e1[e]]; vs1[e] = VSC[e1[e]]; }
        f32x4 d0 = (f32x4){0.f, 0.f, 0.f, 0.f}, d1 = d0;
#pragma unroll
        for (int sl = 0; sl < 8; ++sl) { d0[0] += bf_lo(pv0[sl].x); d0[1] += bf_hi(pv0[sl].x); d0[2] += bf_lo(pv0[sl].y); d0[3] += bf_hi(pv0[sl].y);
                                         d1[0] += bf_lo(pv1[sl].x); d1[1] += bf_hi(pv1[sl].x); d1[2] += bf_lo(pv1[sl].y); d1[3] += bf_hi(pv1[sl].y); }
        f32x4 w0, w1;
#pragma unroll
        for (int e = 0; e < 4; ++e) { w0[e] = gelu_erf(d0[e] * us0[e]) * gt0[e] * vs0[e]; w1[e] = gelu_erf(d1[e] * us1[e]) * gt1[e] * vs1[e]; }
        u32x2 wo; wo.x = pk2(w0[0], w0[1]); wo.y = pk2(w0[2], w0[3]); ((GAS u32x2*)(ws + WS_PW))[i] = wo;
        if (i + stride < N4) { wo.x = pk2(w1[0], w1[1]); wo.y = pk2(w1[2], w1[3]); ((GAS u32x2*)(ws + WS_PW))[i1] = wo; }
    }
}
__device__ __forceinline__ void phase_vb(const DArgs& a, LAS unsigned char* lds) {
    const int tid = tid_(), lane = tid & 63, wave = __builtin_amdgcn_readfirstlane(tid >> 6), k = lane >> 3, c = lane & 7;
    GAS unsigned char* ws = a.ws;
    const XcdSlice X = xcd_slice_setup(a, lds);
    const int tstride = X.nloc * 8;
    const bool bit3 = (lane & 8) != 0;
    for (int sl = X.q; sl < 8; sl += X.nx) {
        const GAS unsigned char* VBs = ws + WS_VB + (size_t)sl * 2097152;
        const unsigned coff = (unsigned)c * 16u;
        const unsigned xoff = (unsigned)(sl * 128 + c * 16 + 2 * k) * 4u;
        u32x4 evA[2], evB[2], RA[16], RB[16], wa[2], wb[2]; unsigned xa, xb;
#define B_TOK(t_) ((t_) < T ? (t_) : T - 1)
#define B_INFO(ev_, t_) do { const int tq_ = B_TOK(t_); _Pragma("unroll") for (int j_ = 0; j_ < 2; ++j_) ev_[j_] = *(const GAS u32x4*)(ws + WS_EIDX + (size_t)tq_ * 256 + (unsigned)(32 * k + 16 * j_)); } while (0)
#define B_ISSUE(R_, w_, x_, ev_, t_) do { const int tq_ = B_TOK(t_); _Pragma("unroll") for (int g_ = 0; g_ < 16; ++g_) R_[g_] = *(const GAS u32x4*)(VBs + (EV_OFF(ev_, g_) | coff)); \
        _Pragma("unroll") for (int j_ = 0; j_ < 2; ++j_) w_[j_] = *(const GAS u32x4*)(ws + WS_PW + (size_t)tq_ * 256 + (unsigned)(32 * k + 16 * j_)); \
        x_ = *(const GAS unsigned*)((const GAS unsigned char*)a.out + (size_t)tq_ * (D * 2) + (xoff >> 1)); } while (0)
#define B_DOTS(R_, w_, x_, t_) do { \
        f32x2 acc2_[8]; _Pragma("unroll") for (int e_ = 0; e_ < 8; ++e_) acc2_[e_] = (f32x2){0.f, 0.f}; \
        _Pragma("unroll") for (int g_ = 0; g_ < 16; ++g_) { const unsigned ww_ = w_[g_ >> 3][(g_ >> 1) & 3]; const float wk_ = (g_ & 1) ? bf_hi(ww_) : bf_lo(ww_); const f32x2 wp_ = (f32x2){wk_, wk_}; \
            _Pragma("unroll") for (int jj_ = 0; jj_ < 4; ++jj_) { acc2_[2 * jj_] += wp_ * FP8LO(R_[g_][jj_]); acc2_[2 * jj_ + 1] += wp_ * FP8HI(R_[g_][jj_]); } \
            if (g_ & 1) __builtin_amdgcn_sched_barrier(0); } \
        f32x2 w2_[4], x2_[2], y_; \
        _Pragma("unroll") for (int i_ = 0; i_ < 4; ++i_) { w2_[i_][0] = rs32_(acc2_[i_][0], acc2_[i_ + 4][0]); w2_[i_][1] = rs32_(acc2_[i_][1], acc2_[i_ + 4][1]); } \
        _Pragma("unroll") for (int i_ = 0; i_ < 2; ++i_) { x2_[i_][0] = rs16_(w2_[i_][0], w2_[i_ + 2][0]); x2_[i_][1] = rs16_(w2_[i_][1], w2_[i_ + 2][1]); } \
        y_[0] = rs8_(x2_[0][0], x2_[1][0], bit3) + bf_lo(x_); y_[1] = rs8_(x2_[0][1], x2_[1][1], bit3) + bf_hi(x_); \
        const float ss_ = wave_sum(y_[0] * y_[0] + y_[1] * y_[1], lane); \
        if ((t_) < T) { *(GAS unsigned*)(ws + WS_PARTU + (size_t)(t_) * (D * 2) + (xoff >> 1)) = pk2(y_[0], y_[1]);       \
            if (lane == 0) ((GAS float*)(ws + WS_SS))[(size_t)(t_) * 8 + sl] = ss_; } } while (0)
        const int n0 = X.rank * 8 + wave;
        B_INFO(evA, n0); B_INFO(evB, n0 + tstride);
        __builtin_amdgcn_sched_barrier(0);
        B_ISSUE(RA, wa, xa, evA, n0);
        __builtin_amdgcn_sched_barrier(0);
#pragma unroll 1
        for (int n = n0; n < T; n += 2 * tstride) {
            B_INFO(evA, n + 2 * tstride);
            __builtin_amdgcn_sched_barrier(0);
            B_ISSUE(RB, wb, xb, evB, n + tstride);
            __builtin_amdgcn_sched_barrier(0);
            B_DOTS(RA, wa, xa, n);
            __builtin_amdgcn_sched_barrier(0);
            B_INFO(evB, n + 3 * tstride);
            __builtin_amdgcn_sched_barrier(0);
            B_ISSUE(RA, wa, xa, evA, n + 2 * tstride);
            __builtin_amdgcn_sched_barrier(0);
            B_DOTS(RB, wb, xb, n + tstride);
            __builtin_amdgcn_sched_barrier(0);
        }
#undef B_TOK
#undef B_INFO
#undef B_ISSUE
#undef B_DOTS
    }
}
__device__ __forceinline__ void phase_vc(const DArgs& a, int vcu, int G) {
    const int tid = tid_(), lane = tid & 63, wave = tid >> 6;
    const int gw = vcu * NWAVES + wave, NGW = G * NWAVES;
    GAS unsigned char* ws = a.ws;
    f32x4 gf[4];
#pragma unroll
    for (int j = 0; j < 4; ++j) gf[j] = ((const GAS f32x4*)a.final_g)[64 * j + lane];
    for (int m = gw; m < T; m += NGW) {
        const f32x4 s0 = *(const GAS f32x4*)((const GAS float*)(ws + WS_SS) + (size_t)m * 8), s1 = *(const GAS f32x4*)((const GAS float*)(ws + WS_SS) + (size_t)m * 8 + 4);
        const float rstd = rsqrtf(((s0[0] + s0[1]) + (s0[2] + s0[3]) + (s1[0] + s1[1]) + (s1[2] + s1[3])) * (1.f / D) + EPS);
        const GAS u32x2* xi = (const GAS u32x2*)(ws + WS_PARTU + (size_t)m * (D * 2)) + lane;
        GAS f32x4* o = (GAS f32x4*)(a.out + (size_t)m * D) + lane;
#pragma unroll
        for (int j = 0; j < 4; ++j) { const u32x2 xv = xi[64 * j]; f32x4 v; v[0] = bf_lo(xv.x); v[1] = bf_hi(xv.x); v[2] = bf_lo(xv.y); v[3] = bf_hi(xv.y); o[64 * j] = v * rstd * gf[j]; }
    }
}

__device__ __forceinline__ void phase_final_plain(const DArgs& a, const float* src, int vcu, int G) {
    const int tid = tid_(), lane = tid & 63, wave = tid >> 6;
    const int gw = vcu * NWAVES + wave, NGW = G * NWAVES;
    f32x4 gf[4];
#pragma unroll
    for (int j = 0; j < 4; ++j) gf[j] = ((const f32x4*)a.final_g)[64 * j + lane];
    for (int m = gw; m < T; m += NGW) {
        const f32x4* xr = (const f32x4*)(src + (size_t)m * D) + lane;
        f32x4 v[4]; float s = 0.f;
#pragma unroll
        for (int j = 0; j < 4; ++j) { v[j] = xr[64 * j]; s += (v[j][0] * v[j][0] + v[j][1] * v[j][1]) + (v[j][2] * v[j][2] + v[j][3] * v[j][3]); }
        const float rstd = rsqrtf(wave_sum(s, lane) * (1.f / D) + EPS);
        f32x4* o = (f32x4*)(a.out + (size_t)m * D) + lane;
#pragma unroll
        for (int j = 0; j < 4; ++j) o[64 * j] = v[j] * rstd * gf[j];
    }
}


__device__ __forceinline__ DArgs load_args() {
    DArgs r;
#if defined(__HIP_DEVICE_COMPILE__)
    typedef const DArgs __attribute__((address_space(4))) KArgs;
    KArgs* p = (KArgs*)__builtin_amdgcn_kernarg_segment_ptr();
    asm volatile("" : "+s"(p));
    r.x = p->x; r.norm1_g = p->norm1_g; r.w_in = p->w_in; r.b_in = p->b_in; r.conv_w = p->conv_w; r.conv_b = p->conv_b; r.m_head_g = p->m_head_g; r.lb_table = p->lb_table;
    r.g_head_g = p->g_head_g; r.w_br_m = p->w_br_m; r.w_br_g = p->w_br_g; r.w_out = p->w_out; r.norm2_g = p->norm2_g; r.w_pq = p->w_pq; r.sub_keys = p->sub_keys;
    r.u_emb = p->u_emb; r.v_emb = p->v_emb; r.final_g = p->final_g; r.out = p->out; r.ws = p->ws;
#else
    r = DArgs{};
#endif
    return r;
}
__device__ __forceinline__ EpiPtrs make_ep(const DArgs& a, int round) {
    EpiPtrs ep; ep.biasp = (const GAS float*)(a.ws + WS_BIASP); ep.lb = (const GAS float*)(a.ws + WS_LB); ep.x = a.x; ep.out = a.out; ep.ws = a.ws; ep.round = round; ep.sa = (const GAS float*)(a.ws + WS_SA8); ep.sb = (const GAS float*)(a.ws + WS_SB8); ep.sym = (const GAS float*)(a.ws + WS_SYM); ep.syg = (const GAS float*)(a.ws + WS_SYG); return ep;
}
#define GRID_SYNC() do { const DArgs a_ = load_args(); xcd_barrier((unsigned*)(a_.ws + WS_CTL) + CW_BAR, (volatile LAS unsigned*)(lds + LDS_BARST)); } while (0)

__device__ __forceinline__ int bx_() { int t = blockIdx.x; asm volatile("" : "+s"(t)); return t; }
__device__ __forceinline__ int gd_() { int t = gridDim.x; asm volatile("" : "+s"(t)); return t; }
#define PH_BEGIN const DArgs a = load_args(); const int bx = bx_(), G = gd_(); const int vcu = (G % 8 == 0) ? (bx % 8) * (G / 8) + bx / 8 : bx; (void)vcu; (void)bx;

__global__ void __launch_bounds__(NTHR, 2) fwd_megakernel(Args a_unused) {
    extern __shared__ __attribute__((aligned(16))) unsigned char lds_raw[];
    LAS unsigned char* lds = (LAS unsigned char*)lds_raw;
    cg::grid_group grid = cg::this_grid();

    { const int t_ = tid_(); if (t_ < 16) ((LAS unsigned*)(lds + LDS_BARST))[t_] = 0u; __syncthreads();
      const DArgs a_ = load_args(); xcd_barrier_post((unsigned*)(a_.ws + WS_CTL) + CW_BAR, (volatile LAS unsigned*)(lds + LDS_BARST)); }
    { PH_BEGIN phase_p0(a, lds, vcu, G); }
    grid.sync();
    { PH_BEGIN phase_p0c(a, lds, vcu, G); }
    GRID_SYNC();
#pragma unroll 1
    for (int round = 0; round < NROUND; ++round) {
        {
            PH_BEGIN
            {
                pg8::Gemm g{(const bf16_t*)(a.ws + WS_XN8), (const bf16_t*)(a.ws + WS_W8A), RT, 4096, D / 2};
                pg8::StaticOrder S; S.init(RT, 4096, G, bx);
                EpiX<7> E{make_ep(a, round)};
                pg8::gemm_phase<EpiX<7>, pg8::StaticOrder, true, true, true>(lds, g, S, E);
            }
            {
                pg8::Gemm g{(const bf16_t*)(a.ws + WS_XN) + (size_t)round * RT * D, (const bf16_t*)(a.ws + WS_WIN) + (size_t)4096 * D, RT, N1 - 4096, D};
                pg8::StaticOrder S; S.init(RT, N1 - 4096, G, bx);
                EpiX<1> E{make_ep(a, round)};
                pg8::gemm_phase<EpiX<1>, pg8::StaticOrder, true, true>(lds, g, S, E);
            }
        }
        { PH_BEGIN if (bx < 8) mscan_pair(a, lds, round, bx); }
        GRID_SYNC();
        { PH_BEGIN for (int it = bx; it < 512; it += G) mlstm_pre_item(a, lds, round, it); }
        { PH_BEGIN u32x4 gq[4]; int it = bx; if (it < 2048) hgrn_pre_load(a, round, it, gq);
          for (; it < 2048; it += G) hgrn_pre_item(a, lds, round, it, gq, it + G); }
        GRID_SYNC();
        { PH_BEGIN
          if (bx < 128) mlstm_scan<2, false>(a, lds, round, bx & 7, bx >> 3);
          else if (bx >= 192 && bx < 200) mlstm_scan<1, true>(a, lds, round, bx - 192, 0);
          else if (bx < 192) { const int id2 = bx - 128; hgrn_scan(a, lds, round, (id2 & 7) * 2 + ((id2 >> 3) & 1), id2 >> 4); } }
        GRID_SYNC();
        {
            PH_BEGIN
            pg8::Gemm g{(const bf16_t*)(a.ws + WS_XN8), (const bf16_t*)(a.ws + WS_W8), RT, N2, D / 2};
            pg8::StaticOrder S; S.init(RT, N2, G, bx);
            EpiX<2> E{make_ep(a, round)};
            pg8::gemm_phase<EpiX<2>, pg8::StaticOrder, true, true, true>(lds, g, S, E);
        }
        GRID_SYNC();
        { PH_BEGIN phase_ypass(a, round, vcu, G); }
        if (round + 1 < NROUND) { PH_BEGIN xn8_convert(a, round + 1, vcu, G); }
        GRID_SYNC();
        {
            { PH_BEGIN pg8::StaticOrder S; S.init(RT, D, G, bx);
              pg8::Gemm g{(const bf16_t*)(a.ws + WS_V), (const bf16_t*)(a.ws + WS_WM), RT, D, 2048 / 2}; EpiX<3> E{make_ep(a, round)}; pg8::gemm_phase<EpiX<3>, pg8::StaticOrder, true, true, true>(lds, g, S, E); }
            { PH_BEGIN pg8::StaticOrder S; S.init(RT, D, G, bx);
              pg8::Gemm g{(const bf16_t*)(a.ws + WS_GI), (const bf16_t*)(a.ws + WS_WG), RT, D, D / 2}; EpiX<4> E{make_ep(a, round)}; pg8::gemm_phase<EpiX<4>, pg8::StaticOrder, true, true, true>(lds, g, S, E); }
        }
        GRID_SYNC();
        {
            PH_BEGIN pg8::StaticOrder S; S.init(RT, D, G, bx);
            pg8::Gemm g{(const bf16_t*)(a.ws + WS_GFLOG), (const bf16_t*)(a.ws + WS_WO), RT, D, D}; EpiX<5> E{make_ep(a, round)}; pg8::gemm_phase<EpiX<5>, pg8::StaticOrder, true, true>(lds, g, S, E);
        }
        GRID_SYNC();
    }
    { PH_BEGIN phase_p8(a, vcu, G); }
    GRID_SYNC();
    {
        PH_BEGIN pg8::StaticOrder S; S.init(T, 2048, G, bx);
        pg8::Gemm g{(const bf16_t*)(a.ws + WS_XN), (const bf16_t*)(a.ws + WS_WPQ), T, 2048, D}; EpiX<6> E{make_ep(a, 0)}; pg8::gemm_phase<EpiX<6>, pg8::StaticOrder, true, true>(lds, g, S, E);
    }
    GRID_SYNC();
#ifdef TOPK_REF
    { PH_BEGIN phase_topk_ref(a, vcu, G); }
#else
    { PH_BEGIN phase_topk(a, lds, bx, G); }
#endif
    GRID_SYNC();
    { PH_BEGIN phase_ua(a, lds); }
    GRID_SYNC();
    { PH_BEGIN phase_ua2(a, vcu, G); }
    GRID_SYNC();
    { PH_BEGIN phase_vb(a, lds); }
    GRID_SYNC();
    { PH_BEGIN phase_vc(a, vcu, G); }
}

extern "C" void kernel_launch(void* const* d_in, const int* in_sizes, int n_in, void* d_out, int out_size, void* d_ws, size_t ws_size, hipStream_t stream) {
    static int grid = 0;
    if (grid == 0) {
        if (n_in != 18 || in_sizes[0] != T * D || out_size != T * D || ws_size < WS_END) {
            fprintf(stderr, "kernel_launch: unexpected shapes/workspace (n_in %d, in0 %d, out %d, ws %zu, need %zu)\n", n_in, n_in > 0 ? in_sizes[0] : -1, out_size, ws_size, (size_t)WS_END);
            grid = -1; return; }
        int dev = 0, cus = 0, per_cu = 0;
        hipGetDevice(&dev);
        hipDeviceGetAttribute(&cus, hipDeviceAttributeMultiprocessorCount, dev);
        hipFuncSetAttribute((const void*)fwd_megakernel, hipFuncAttributeMaxDynamicSharedMemorySize, LDS_BYTES);
        hipOccupancyMaxActiveBlocksPerMultiprocessor(&per_cu, (const void*)fwd_megakernel, NTHR, LDS_BYTES);
        if (per_cu < 1) { fprintf(stderr, "kernel_launch: occupancy query says %d blocks/CU\n", per_cu); per_cu = 1; }
        grid = cus;
        (void)hipGetLastError();
    }
    if (grid < 0) return;
    hipMemsetAsync((char*)d_ws + WS_CTL, 0, 131072, stream);
    Args a{};
    a.x = (const float*)d_in[0]; a.norm1_g = (const float*)d_in[1]; a.w_in = (const float*)d_in[2]; a.b_in = (const float*)d_in[3];
    a.conv_w = (const float*)d_in[4]; a.conv_b = (const float*)d_in[5]; a.m_head_g = (const float*)d_in[6]; a.lb_table = (const float*)d_in[7];
    a.g_head_g = (const float*)d_in[8]; a.w_br_m = (const float*)d_in[9]; a.w_br_g = (const float*)d_in[10]; a.w_out = (const float*)d_in[11];
    a.norm2_g = (const float*)d_in[12]; a.w_pq = (const float*)d_in[13]; a.sub_keys = (const float*)d_in[14]; a.u_emb = (const float*)d_in[15];
    a.v_emb = (const float*)d_in[16]; a.final_g = (const float*)d_in[17];
    a.out = (float*)d_out; a.ws = (unsigned char*)d_ws;
    void* args[] = {&a};
    hipError_t e = hipLaunchCooperativeKernel((const void*)fwd_megakernel, dim3(grid), dim3(NTHR), args, LDS_BYTES, stream);
    if (e != hipSuccess) fprintf(stderr, "cooperative launch failed: %s (grid %d)\n", hipGetErrorString(e), grid);
}
```

```cpp
#include <hip/hip_runtime.h>
#include <hip/hip_cooperative_groups.h>
#include <cstdio>
#include <cstdint>
namespace cg = cooperative_groups;

#define LAS __attribute__((address_space(3)))
typedef unsigned short bf16_t;
typedef short bf16x8 __attribute__((ext_vector_type(8)));
typedef float f32x4 __attribute__((ext_vector_type(4)));
typedef float f32x2 __attribute__((ext_vector_type(2)));
typedef unsigned u32x4 __attribute__((ext_vector_type(4)));
typedef unsigned u32x2 __attribute__((ext_vector_type(2)));

constexpr int D = 1024, BATCH = 4, SEQ = 8192, T = BATCH * SEQ;
constexpr int IN_COLS = 12296, NP = 12288;
constexpr int RT = 16384, NROUND = 2;
constexpr int N1 = 7168, N2 = 5120;
constexpr float EPS = 1e-6f;
constexpr int NWAVES = 8, NTHR = 512;

constexpr size_t MiB = 1u << 20;
constexpr size_t WS_CTL = 0;
constexpr size_t WS_WIN = 1 * MiB;
constexpr size_t WS_WM = 25 * MiB;
constexpr size_t WS_WG = 29 * MiB;
constexpr size_t WS_WO = 31 * MiB;
constexpr size_t WS_WPQ = 33 * MiB;
constexpr size_t WS_SK = 37 * MiB;
constexpr size_t WS_BIASP = 37 * MiB + 512 * 1024;
constexpr size_t WS_LB = WS_BIASP + 64 * 1024;
constexpr size_t WS_GATES = 38 * MiB;
constexpr size_t WS_MPREV = 39 * MiB;
constexpr size_t WS_DEN = 40 * MiB;
constexpr size_t WS_MT = 40 * MiB + 512 * 1024;
constexpr size_t WS_HGDEC = 41 * MiB;
constexpr size_t WS_MDEC = 43 * MiB;
constexpr size_t WS_XN = 44 * MiB;
constexpr size_t WS_QKPRE = 108 * MiB;
constexpr size_t WS_V = 172 * MiB;
constexpr size_t WS_GFLOG = 236 * MiB;
constexpr size_t WS_GI = 268 * MiB;
constexpr size_t WS_GQ = 300 * MiB;
constexpr size_t WS_S = 332 * MiB;
constexpr size_t WS_QT = 348 * MiB;
constexpr size_t WS_KWT = 380 * MiB;
constexpr size_t WS_ATT = 412 * MiB;
constexpr size_t WS_QTG = 428 * MiB;
constexpr size_t WS_KENDT = 460 * MiB;
constexpr size_t WS_SIGO = 332 * MiB;
constexpr size_t WS_SGG = 396 * MiB;
constexpr size_t WS_SAM = 428 * MiB;
constexpr size_t WS_SAG = 460 * MiB;
constexpr size_t WS_XN8 = 44 * MiB;
constexpr size_t WS_SA8 = 508 * MiB;
constexpr size_t WS_SB8 = 508 * MiB + 262144;
constexpr size_t WS_W8A = WS_WIN;
constexpr size_t WS_W8 = WS_WIN + (size_t)7168 * 1024;
constexpr int NI8 = 12288 + 1024 + 1024;
constexpr size_t WS_SYM = 508 * MiB + 524288;
constexpr size_t WS_SYG = 508 * MiB + 655360;
constexpr int CW_COLMAX = 16384;
constexpr size_t WS_END = 510 * MiB;
constexpr size_t WS_QP = 108 * MiB;
constexpr size_t WS_UB = 236 * MiB;
constexpr size_t WS_VB = 252 * MiB;
constexpr size_t WS_USC = 268 * MiB;
constexpr size_t WS_VSC = 268 * MiB + 65536;
constexpr size_t WS_EIDX = 300 * MiB;
constexpr size_t WS_GATE = 316 * MiB;
constexpr size_t WS_XQ = 380 * MiB;
constexpr size_t WS_XQS = 412 * MiB;
constexpr size_t WS_PARTU = 108 * MiB;
constexpr size_t WS_SS = 348 * MiB;
constexpr size_t WS_PW = 332 * MiB;

constexpr int CW_TMAX = 64;
constexpr int LDS_BYTES = 147456;

__device__ __forceinline__ unsigned f2bf(float f) { unsigned u = __builtin_bit_cast(unsigned, f); return (u + 0x7fffu + ((u >> 16) & 1u)) >> 16; }
typedef __bf16 bf16x2_t __attribute__((ext_vector_type(2)));
__device__ __forceinline__ unsigned pk2(float lo, float hi) { bf16x2_t v; v[0] = (__bf16)lo; v[1] = (__bf16)hi; return __builtin_bit_cast(unsigned, v); }
__device__ __forceinline__ float bf_lo(unsigned w) { return __builtin_bit_cast(float, w << 16); }
__device__ __forceinline__ float bf_hi(unsigned w) { return __builtin_bit_cast(float, w & 0xffff0000u); }
__device__ __forceinline__ float bf2f(bf16_t h) { return __builtin_bit_cast(float, ((unsigned)h) << 16); }
__device__ __forceinline__ float shx(float v, int o, int lane) { return __builtin_bit_cast(float, __builtin_amdgcn_ds_bpermute((lane ^ o) << 2, __builtin_bit_cast(int, v))); }
__device__ __forceinline__ float shup(float v, int o, int lane) { return __builtin_bit_cast(float, __builtin_amdgcn_ds_bpermute(((lane - o) & 63) << 2, __builtin_bit_cast(int, v))); }
__device__ __forceinline__ float rdlane(float v, int l) { return __builtin_bit_cast(float, __builtin_amdgcn_readlane(__builtin_bit_cast(int, v), l)); }
#define DPP_(v, ctrl) __builtin_bit_cast(float, __builtin_amdgcn_update_dpp(0, __builtin_bit_cast(int, (v)), (ctrl), 0xF, 0xF, false))
__device__ __forceinline__ float wave_sum(float v, int lane) {
    (void)lane;
    v += DPP_(v, 0xB1); v += DPP_(v, 0x4E); v += DPP_(v, 0x141); v += DPP_(v, 0x140);
    return (rdlane(v, 0) + rdlane(v, 16)) + (rdlane(v, 32) + rdlane(v, 48));
}
__device__ __forceinline__ float wave_max(float v) {
    v = fmaxf(v, DPP_(v, 0xB1)); v = fmaxf(v, DPP_(v, 0x4E)); v = fmaxf(v, DPP_(v, 0x141)); v = fmaxf(v, DPP_(v, 0x140));
    return fmaxf(fmaxf(rdlane(v, 0), rdlane(v, 16)), fmaxf(rdlane(v, 32), rdlane(v, 48)));
}
__device__ __forceinline__ unsigned pack_i8x4(float a, float b, float c, float d) {
    const int ia = (int)__builtin_rintf(a), ib = (int)__builtin_rintf(b), ic = (int)__builtin_rintf(c), id = (int)__builtin_rintf(d);
    return ((unsigned)ia & 255u) | (((unsigned)ib & 255u) << 8) | (((unsigned)ic & 255u) << 16) | ((unsigned)id << 24);
}
#define SWZI_(v, pat) __builtin_amdgcn_ds_swizzle((int)(v), (pat))
#define DPPI_(v, ctrl) __builtin_amdgcn_update_dpp(0, (int)(v), (ctrl), 0xF, 0xF, false)
__device__ __forceinline__ unsigned xor32u_(unsigned v, bool hi) {
#if defined(__HIP_DEVICE_COMPILE__)
    const auto r = __builtin_amdgcn_permlane32_swap(v, v, false, false);
    return hi ? r[0] : r[1];
#else
    (void)hi; return v;
#endif
}
__device__ __forceinline__ float sigmoidf_(float x) { return __builtin_amdgcn_rcpf(1.0f + __expf(-x)); }
__device__ __forceinline__ float siluf_(float x) { return x * __builtin_amdgcn_rcpf(1.0f + __expf(-x)); }
#define LDS_WAIT() asm volatile("s_waitcnt lgkmcnt(0)" ::: "memory")
__device__ __forceinline__ int tid_() { int t = threadIdx.x; asm volatile("" : "+v"(t)); return t; }

#define GAS __attribute__((address_space(1)))
struct DArgs {
    const GAS float* x; const GAS float* norm1_g; const GAS float* w_in; const GAS float* b_in; const GAS float* conv_w; const GAS float* conv_b;
    const GAS float* m_head_g; const GAS float* lb_table; const GAS float* g_head_g; const GAS float* w_br_m; const GAS float* w_br_g; const GAS float* w_out;
    const GAS float* norm2_g; const GAS float* w_pq; const GAS float* sub_keys; const GAS float* u_emb; const GAS float* v_emb; const GAS float* final_g;
    GAS float* out; GAS unsigned char* ws;
};
struct Args {
    const float* x; const float* norm1_g; const float* w_in; const float* b_in; const float* conv_w; const float* conv_b;
    const float* m_head_g; const float* lb_table; const float* g_head_g; const float* w_br_m; const float* w_br_g; const float* w_out;
    const float* norm2_g; const float* w_pq; const float* sub_keys; const float* u_emb; const float* v_emb; const float* final_g;
    float* out; unsigned char* ws;
};

namespace pg8 {
constexpr int BM = 256, BK = 64, HALF = 128, HTB = HALF * BK * 2, STAGE_BYTES = 8 * HTB, NXCD = 8, WGM = 8;
__host__ __device__ __forceinline__ int lds_byte(int r, int c) { const int st = (r >> 4) * 2 + (c >> 5), rr = r & 15, cc = c & 31, ob = rr * 64 + cc * 2; return st * 1024 + (ob ^ (((ob >> 9) & 1) << 5)); }
__host__ __device__ __forceinline__ void stage_rc(int b, int& R, int& C) { const int st = b / 1024, sb = b % 1024, swz = sb ^ (((sb >> 9) & 1) << 5); R = (st >> 1) * 16 + swz / 64; C = (st & 1) * 32 + (swz % 64) / 2; }
__host__ __device__ __forceinline__ int perm32(int rho) { const int n = rho >> 4, i = rho & 15; return 8 * (i >> 2) + 4 * n + (i & 3); }
struct Unit { int pm, pn; };
struct Gemm { const bf16_t* A; const bf16_t* Bt; int M, N, K; };
struct StaticOrder {
    int nM, nN, nwg, G, c;
    __host__ __device__ void init(int M, int N, int G_, int c_) { nM = M / BM; nN = N / BM; nwg = nM * nN; G = G_; c = c_; }
    __host__ __device__ bool next(int i, Unit& u) const {
        const long L = (long)i * G + c; if (L >= nwg) return false;
        int wgid = (int)L; { const int q = nwg / NXCD, r = nwg % NXCD, xcd = wgid % NXCD, off = wgid / NXCD; wgid = (xcd < r ? xcd * (q + 1) : r * (q + 1) + (xcd - r) * q) + off; }
        const int nig = WGM * nN, gid = wgid / nig, fm = gid * WGM, gsz = (nM - fm) < WGM ? (nM - fm) : WGM;
        u.pm = fm + ((wgid % nig) % gsz); u.pn = (wgid % nig) / gsz; return true;
    }
    __device__ __forceinline__ void a_ready(const Unit&) const {}
    __device__ __forceinline__ void done(const Unit&) const {}
};

typedef int i32x8 __attribute__((ext_vector_type(8)));
typedef int i32x4 __attribute__((ext_vector_type(4)));
template <class Epi, class Sched, bool ALIGN_EPI = false, bool SP2 = false, bool I8 = false>
__device__ __forceinline__ void gemm_phase(LAS unsigned char* lds, const Gemm g, const Sched& S, const Epi& E) {
    const int tid = tid_(), wid = __builtin_amdgcn_readfirstlane(tid >> 6), lane = tid & 63, wr = wid >> 2, wc = wid & 3, fr = lane & 15, fq = lane >> 4;
    const int K = g.K, nt = K / BK;
    unsigned voffA[2], voffB[2];
#pragma unroll
    for (int i = 0; i < 2; ++i) { int R, C; stage_rc(tid * 16 + i * 8192, R, C); const int Rb = Epi::PERM ? ((R & ~31) + perm32(R & 31)) : R;
        voffA[i] = (unsigned)(R * K + C) * 2u; voffB[i] = (unsigned)(Rb * K + C) * 2u; }
    const size_t kstep = (size_t)(BK * 2);
    const size_t hstep = (size_t)HALF * K * 2;
    const size_t tstep = 2 * hstep;
    const unsigned ldsw = (unsigned)wid * 1024u;
    const int aoff = lds_byte(wr * 64 + fr, fq * 8), boff = lds_byte(wc * 32 + fr, fq * 8);
#define PG8_SA(b, h) (((b) * 2 + (h)) * HTB)
#define PG8_SB(b, h) ((4 + (b) * 2 + (h)) * HTB)
#define PG8_STAGE(bufoff, gbase, voff) do { _Pragma("unroll") for (int _i = 0; _i < 2; ++_i) \
        __builtin_amdgcn_global_load_lds((const unsigned*)((const char*)(gbase) + (voff)[_i]), (LAS unsigned*)(lds + (bufoff) + ldsw + _i * 8192), 16, 0, 0); } while (0)
#define PG8_LDA(dst, b, h) do { _Pragma("unroll") for (int m = 0; m < 4; ++m) _Pragma("unroll") for (int k = 0; k < 2; ++k) dst[m][k] = *(const LAS bf16x8*)(lds + PG8_SA(b, h) + aoff + m * 2048 + k * 1024); } while (0)
#define PG8_LDB(dst, b, h) do { _Pragma("unroll") for (int n = 0; n < 2; ++n) _Pragma("unroll") for (int k = 0; k < 2; ++k) dst[n][k] = *(const LAS bf16x8*)(lds + PG8_SB(b, h) + boff + n * 2048 + k * 1024); } while (0)
#define PG8_MMA(ai, bj, At, Bt) do { __builtin_amdgcn_s_setprio(1); _Pragma("unroll") for (int m = 0; m < 4; ++m) _Pragma("unroll") for (int n = 0; n < 2; ++n) _Pragma("unroll") for (int k = 0; k < 2; ++k) { \
        if constexpr (I8) acc[ai][bj][m][n] = __builtin_bit_cast(f32x4, __builtin_amdgcn_mfma_i32_16x16x64_i8(__builtin_bit_cast(i32x4, Bt[n][k]), __builtin_bit_cast(i32x4, At[m][k]), __builtin_bit_cast(i32x4, acc[ai][bj][m][n]), 0, 0, 0)); \
        else acc[ai][bj][m][n] = __builtin_amdgcn_mfma_f32_16x16x32_bf16(Bt[n][k], At[m][k], acc[ai][bj][m][n], 0, 0, 0); } __builtin_amdgcn_s_setprio(0); } while (0)
#define PG8_WAIT_V(n) asm volatile("s_waitcnt vmcnt(" #n ")" ::: "memory")
#define PG8_WAIT_L(n) asm volatile("s_waitcnt lgkmcnt(" #n ")" ::: "memory")
#define PG8_BAR __builtin_amdgcn_s_barrier()
#define PG8_SCHED __builtin_amdgcn_sched_barrier(0)
    Unit cur, nxt; int ui = 0;
    if (!S.next(0, cur)) return;
    f32x4 acc[2][2][4][2];
#pragma unroll
    for (int a = 0; a < 2; ++a)
#pragma unroll
        for (int b = 0; b < 2; ++b)
#pragma unroll
            for (int m = 0; m < 4; ++m)
#pragma unroll
                for (int n = 0; n < 2; ++n) acc[a][b][m][n] = (f32x4){0.f, 0.f, 0.f, 0.f};
    bf16x8 At[4][2], B0[2][2], B1[2][2];
    const char* cA = (const char*)g.A + (size_t)cur.pm * tstep; const char* cB = (const char*)g.Bt + (size_t)cur.pn * tstep;
    S.a_ready(cur);
    if constexpr (SP2) {
        PG8_STAGE(PG8_SB(0, 0), cB, voffB); PG8_STAGE(PG8_SB(0, 1), cB + hstep, voffB); PG8_STAGE(PG8_SA(0, 0), cA, voffA); PG8_STAGE(PG8_SA(0, 1), cA + hstep, voffA);
        if (wr == 1) PG8_BAR;
        PG8_WAIT_V(2); PG8_BAR;
        PG8_STAGE(PG8_SB(1, 0), cB + kstep, voffB); PG8_STAGE(PG8_SA(1, 0), cA + kstep, voffA); PG8_STAGE(PG8_SB(1, 1), cB + hstep + kstep, voffB);
        PG8_WAIT_V(6); PG8_BAR;
    } else {
        PG8_STAGE(PG8_SB(0, 0), cB, voffB); PG8_STAGE(PG8_SA(0, 0), cA, voffA); PG8_STAGE(PG8_SB(0, 1), cB + hstep, voffB); PG8_STAGE(PG8_SA(0, 1), cA + hstep, voffA);
        if (wr == 1) PG8_BAR;
        PG8_WAIT_V(4); PG8_BAR;
        PG8_STAGE(PG8_SB(1, 0), cB + kstep, voffB); PG8_STAGE(PG8_SA(1, 0), cA + kstep, voffA); PG8_STAGE(PG8_SB(1, 1), cB + hstep + kstep, voffB);
        PG8_WAIT_V(6); PG8_BAR;
    }
    for (;;) {
        const bool has_next = S.next(ui + 1, nxt);
        const char* nA = has_next ? (const char*)g.A + (size_t)nxt.pm * tstep : cA; const char* nB = has_next ? (const char*)g.Bt + (size_t)nxt.pn * tstep : cB;
#pragma unroll 1
        for (int t = 0; t < nt; t += 2) {
            const bool last = (t == nt - 2);
            const char* a1 = cA + (size_t)(t + 1) * kstep;
            const char* a2 = last ? nA : cA + (size_t)(t + 2) * kstep; const char* b2 = last ? nB : cB + (size_t)(t + 2) * kstep;
            const char* a3 = a2 + kstep; const char* b3 = b2 + kstep;
            if (last && has_next) S.a_ready(nxt);
            if constexpr (SP2) {
            PG8_LDB(B0, 0, 0); PG8_LDB(B1, 0, 1); PG8_SCHED; PG8_LDA(At, 0, 0); PG8_STAGE(PG8_SA(1, 1), a1 + hstep, voffA);
            PG8_WAIT_V(8); PG8_WAIT_L(0); PG8_BAR; PG8_MMA(0, 0, At, B0); PG8_MMA(0, 1, At, B1); PG8_BAR; PG8_SCHED;
            PG8_LDA(At, 0, 1); PG8_STAGE(PG8_SB(0, 0), b2, voffB); PG8_STAGE(PG8_SB(0, 1), b2 + hstep, voffB); PG8_STAGE(PG8_SA(0, 0), a2, voffA);
            PG8_WAIT_V(8); PG8_WAIT_L(0); PG8_BAR; PG8_MMA(1, 0, At, B0); PG8_MMA(1, 1, At, B1); PG8_BAR; PG8_SCHED;
            PG8_LDB(B0, 1, 0); PG8_LDB(B1, 1, 1); PG8_SCHED; PG8_LDA(At, 1, 0); PG8_STAGE(PG8_SA(0, 1), a2 + hstep, voffA);
            PG8_WAIT_V(8); PG8_WAIT_L(0); PG8_BAR; PG8_MMA(0, 0, At, B0); PG8_MMA(0, 1, At, B1); PG8_BAR; PG8_SCHED;
            PG8_LDA(At, 1, 1); PG8_STAGE(PG8_SB(1, 0), b3, voffB); PG8_STAGE(PG8_SB(1, 1), b3 + hstep, voffB); PG8_STAGE(PG8_SA(1, 0), a3, voffA);
            PG8_WAIT_V(8); PG8_WAIT_L(0); PG8_BAR; PG8_MMA(1, 0, At, B0); PG8_MMA(1, 1, At, B1); PG8_BAR; PG8_SCHED;
            } else {
            PG8_LDB(B0, 0, 0); PG8_SCHED; PG8_LDA(At, 0, 0); PG8_STAGE(PG8_SA(1, 1), a1 + hstep, voffA);
            PG8_WAIT_L(8); PG8_BAR; PG8_WAIT_L(0); PG8_MMA(0, 0, At, B0); PG8_BAR; PG8_SCHED;
            PG8_LDB(B1, 0, 1); PG8_STAGE(PG8_SB(0, 0), b2, voffB);
            PG8_BAR; PG8_WAIT_L(0); PG8_MMA(0, 1, At, B1); PG8_BAR;
            PG8_LDA(At, 0, 1); PG8_STAGE(PG8_SA(0, 0), a2, voffA);
            PG8_BAR; PG8_WAIT_L(0); PG8_MMA(1, 0, At, B0); PG8_BAR; PG8_SCHED;
            PG8_STAGE(PG8_SB(0, 1), b2 + hstep, voffB);
            PG8_WAIT_V(6); PG8_BAR; PG8_MMA(1, 1, At, B1); PG8_BAR;
            PG8_LDB(B0, 1, 0); PG8_SCHED; PG8_LDA(At, 1, 0); PG8_STAGE(PG8_SA(0, 1), a2 + hstep, voffA);
            PG8_WAIT_L(8); PG8_BAR; PG8_WAIT_L(0); PG8_MMA(0, 0, At, B0); PG8_BAR; PG8_SCHED;
            PG8_LDB(B1, 1, 1); PG8_STAGE(PG8_SB(1, 0), b3, voffB);
            PG8_BAR; PG8_WAIT_L(0); PG8_MMA(0, 1, At, B1); PG8_BAR;
            PG8_LDA(At, 1, 1); PG8_STAGE(PG8_SA(1, 0), a3, voffA);
            PG8_BAR; PG8_WAIT_L(0); PG8_MMA(1, 0, At, B0); PG8_BAR; PG8_SCHED;
            PG8_STAGE(PG8_SB(1, 1), b3 + hstep, voffB);
            PG8_WAIT_V(6); PG8_BAR; PG8_MMA(1, 1, At, B1); PG8_BAR;
            }
        }
        if constexpr (ALIGN_EPI) { if (wr == 0) PG8_BAR; }
        E(acc, cur, wr, wc, fr, fq);
        if (!has_next) break;
#pragma unroll
        for (int a = 0; a < 2; ++a)
#pragma unroll
            for (int b = 0; b < 2; ++b)
#pragma unroll
                for (int m = 0; m < 4; ++m)
#pragma unroll
                    for (int n = 0; n < 2; ++n) acc[a][b][m][n] = (f32x4){0.f, 0.f, 0.f, 0.f};
        cur = nxt; cA = nA; cB = nB; ++ui;
        if constexpr (ALIGN_EPI) { if (wr == 1) PG8_BAR; }
    }
    PG8_WAIT_V(0);
    if constexpr (!ALIGN_EPI) { if (wr == 0) PG8_BAR; }
    PG8_BAR;
#undef PG8_SA
#undef PG8_SB
#undef PG8_STAGE
#undef PG8_LDA
#undef PG8_LDB
#undef PG8_MMA
#undef PG8_WAIT_V
#undef PG8_WAIT_L
#undef PG8_BAR
#undef PG8_SCHED
}
}

typedef int i32x4q __attribute__((ext_vector_type(4)));
struct EpiPtrs {
    const GAS float* biasp; const GAS float* lb; const GAS float* x; GAS float* out; GAS unsigned char* ws; int round;
    const GAS float* sa; const GAS float* sb; const GAS float* sym; const GAS float* syg;
};
template <int MODE> struct EpiX {
    static constexpr bool PERM = true, AFTER_DRAIN = false;
    EpiPtrs P;
    __device__ __forceinline__ void operator()(const f32x4 (&acc)[2][2][4][2], const pg8::Unit& u, int wr, int wc, int fr, int fq) const {
        const int upn = u.pn;
        const int row0 = u.pm * 256 + wr * 64 + fr;
        const int colt = upn * 256 + wc * 32 + 8 * fq;
        GAS unsigned char* ws = P.ws;
        bf16_t* dst = nullptr; int ld = 0, coff = 0, act = 0; const GAS float* bias = nullptr;
        if (MODE == 1 || MODE == 7) {
            bias = P.biasp;
            if (upn < 8) { dst = (bf16_t*)(ws + WS_QKPRE); ld = 2048; coff = 0; act = 0; }
            else if (upn < 16) { dst = (bf16_t*)(ws + WS_V); ld = 2048; coff = 2048; act = 0; }
            else if (upn < 20) { dst = (bf16_t*)(ws + WS_GFLOG); ld = 1024; coff = 4096; act = 3; }
            else if (upn < 24) { dst = (bf16_t*)(ws + WS_GI); ld = 1024; coff = 5120; act = 0; }
            else { dst = (bf16_t*)(ws + WS_GQ); ld = 1024; coff = 6144; act = 2; }
        } else if (MODE == 2) {
            bias = P.biasp + N1;
            if (u.pn < 8) { dst = (bf16_t*)(ws + WS_SIGO); ld = 2048; coff = 0; act = 1; }
            else if (u.pn < 12) { dst = (bf16_t*)(ws + WS_SGG); ld = 1024; coff = 2048; act = 2; }
            else if (u.pn < 16) { dst = (bf16_t*)(ws + WS_SAM); ld = 1024; coff = 3072; act = 1; }
            else { dst = (bf16_t*)(ws + WS_SAG); ld = 1024; coff = 4096; act = 1; }
        } else if (MODE == 6) { dst = (bf16_t*)(ws + WS_QP); ld = 2048; coff = 0; act = 0; }
#pragma unroll
        for (int bj = 0; bj < 2; ++bj) {
            const int col = colt + bj * 128;
            f32x4 b0 = (f32x4){0.f, 0.f, 0.f, 0.f}, b1 = b0, l0 = b0, l1 = b0;
            if (MODE == 1 || MODE == 2 || MODE == 7) { b0 = *(const f32x4*)(bias + col); b1 = *(const f32x4*)(bias + col + 4); }
            f32x4 s0 = (f32x4){1.f, 1.f, 1.f, 1.f}, s1 = s0;
            if (MODE == 2) { s0 = *(const GAS f32x4*)(P.sb + 7168 + col); s1 = *(const GAS f32x4*)(P.sb + 7168 + col + 4); }
            if (MODE == 7) { s0 = *(const GAS f32x4*)(P.sb + col); s1 = *(const GAS f32x4*)(P.sb + col + 4); }
            if (MODE == 3) { s0 = *(const GAS f32x4*)(P.sb + 12288 + col); s1 = *(const GAS f32x4*)(P.sb + 12288 + col + 4); }
            if (MODE == 4) { s0 = *(const GAS f32x4*)(P.sb + 13312 + col); s1 = *(const GAS f32x4*)(P.sb + 13312 + col + 4); }
            if (MODE == 1 || MODE == 7) { if (act == 3) { l0 = *(const f32x4*)(P.lb + (col - coff)); l1 = *(const f32x4*)(P.lb + (col - coff) + 4); } }
#pragma unroll
            for (int ai = 0; ai < 2; ++ai)
#pragma unroll
                for (int m = 0; m < 4; ++m) {
                    const int row = row0 + ai * 128 + m * 16;
                    f32x4 v0, v1;
                    if (MODE == 2 || MODE == 7 || MODE == 3 || MODE == 4) { const float sr = (MODE == 3) ? P.sym[row] : (MODE == 4) ? P.syg[row] : P.sa[(size_t)P.round * RT + row]; const i32x4q q0 = __builtin_bit_cast(i32x4q, acc[ai][bj][m][0]), q1 = __builtin_bit_cast(i32x4q, acc[ai][bj][m][1]);
                        v0 = (f32x4){(float)q0[0], (float)q0[1], (float)q0[2], (float)q0[3]} * (s0 * sr) + b0; v1 = (f32x4){(float)q1[0], (float)q1[1], (float)q1[2], (float)q1[3]} * (s1 * sr) + b1; }
                    else { v0 = acc[ai][bj][m][0] + b0; v1 = acc[ai][bj][m][1] + b1; }
                    if (MODE == 1 || MODE == 2 || MODE == 6 || MODE == 7) {
                        if (act == 1) {
#pragma unroll
                            for (int j = 0; j < 4; ++j) { v0[j] = sigmoidf_(v0[j]); v1[j] = sigmoidf_(v1[j]); }
                        } else if (act == 2) {
#pragma unroll
                            for (int j = 0; j < 4; ++j) { v0[j] = siluf_(v0[j]); v1[j] = siluf_(v1[j]); }
                        } else if (act == 3) {
#pragma unroll
                            for (int j = 0; j < 4; ++j) { v0[j] = __logf(l0[j] + (1.0f - l0[j]) * sigmoidf_(v0[j])); v1[j] = __logf(l1[j] + (1.0f - l1[j]) * sigmoidf_(v1[j])); }
                        }
                        u32x4 w; w.x = pk2(v0[0], v0[1]); w.y = pk2(v0[2], v0[3]); w.z = pk2(v1[0], v1[1]); w.w = pk2(v1[2], v1[3]);
                        *(u32x4*)(dst + (size_t)row * ld + (col - coff)) = w;
                    } else if (MODE == 3) {
                        const u32x4 g = *(const u32x4*)((const bf16_t*)(ws + WS_SAM) + (size_t)row * 1024 + col);
                        GAS bf16_t* o = (GAS bf16_t*)P.out + (size_t)T * 1024 + ((size_t)P.round * RT + row) * 1024 + col;
                        f32x4 r0, r1;
                        r0[0] = v0[0] * bf_lo(g.x); r0[1] = v0[1] * bf_hi(g.x); r0[2] = v0[2] * bf_lo(g.y); r0[3] = v0[3] * bf_hi(g.y);
                        r1[0] = v1[0] * bf_lo(g.z); r1[1] = v1[1] * bf_hi(g.z); r1[2] = v1[2] * bf_lo(g.w); r1[3] = v1[3] * bf_hi(g.w);
                        u32x4 w; w.x = pk2(r0[0], r0[1]); w.y = pk2(r0[2], r0[3]); w.z = pk2(r1[0], r1[1]); w.w = pk2(r1[2], r1[3]);
                        *(GAS u32x4*)o = w;
                    } else if (MODE == 4) {
                        const u32x4 g = *(const u32x4*)((const bf16_t*)(ws + WS_SAG) + (size_t)row * 1024 + col);
                        const u32x4 zv = *(const GAS u32x4*)((const GAS bf16_t*)P.out + (size_t)T * 1024 + ((size_t)P.round * RT + row) * 1024 + col);
                        const f32x4 p0 = (f32x4){bf_lo(zv.x), bf_hi(zv.x), bf_lo(zv.y), bf_hi(zv.y)}, p1 = (f32x4){bf_lo(zv.z), bf_hi(zv.z), bf_lo(zv.w), bf_hi(zv.w)};
                        f32x4 r0, r1;
                        r0[0] = p0[0] + v0[0] * bf_lo(g.x); r0[1] = p0[1] + v0[1] * bf_hi(g.x); r0[2] = p0[2] + v0[2] * bf_lo(g.y); r0[3] = p0[3] + v0[3] * bf_hi(g.y);
                        r1[0] = p1[0] + v1[0] * bf_lo(g.z); r1[1] = p1[1] + v1[1] * bf_hi(g.z); r1[2] = p1[2] + v1[2] * bf_lo(g.w); r1[3] = p1[3] + v1[3] * bf_hi(g.w);
                        u32x4 w; w.x = pk2(r0[0], r0[1]); w.y = pk2(r0[2], r0[3]); w.z = pk2(r1[0], r1[1]); w.w = pk2(r1[2], r1[3]);
                        *(u32x4*)((bf16_t*)(ws + WS_GFLOG) + (size_t)row * 1024 + col) = w;
                    } else if (MODE == 5) {
                        const size_t off = ((size_t)P.round * RT + row) * 1024 + col;
                        const f32x4 x0 = *(const f32x4*)(P.x + off) + v0, x1 = *(const f32x4*)(P.x + off + 4) + v1;
                        u32x4 w; w.x = pk2(x0[0], x0[1]); w.y = pk2(x0[2], x0[3]); w.z = pk2(x1[0], x1[1]); w.w = pk2(x1[2], x1[3]);
                        *(GAS u32x4*)((GAS bf16_t*)P.out + off) = w;
                    }
                }
        }
    }
};

__device__ __forceinline__ void p0_transpose_item(const GAS float* W, int ldw, int K, int k0, int scol, GAS bf16_t* WT, int drow, LAS float* scr, int lane) {
#pragma unroll 8
    for (int i = 0; i < 32; ++i) { const int kk = 2 * i + (lane >> 5); scr[kk * 33 + (lane & 31)] = W[(size_t)(k0 + kk) * ldw + scol + (lane & 31)]; }
    LDS_WAIT(); asm volatile("" ::: "memory");
    const int c = lane & 7;
#pragma unroll
    for (int j = 0; j < 4; ++j) { const int n = (lane >> 3) + 8 * j; const LAS float* s = scr + (8 * c) * 33 + n;
        u32x4 o; o.x = pk2(s[0 * 33], s[1 * 33]); o.y = pk2(s[2 * 33], s[3 * 33]); o.z = pk2(s[4 * 33], s[5 * 33]); o.w = pk2(s[6 * 33], s[7 * 33]);
        *(u32x4*)(WT + (size_t)(drow + n) * K + k0 + 8 * c) = o; }
    LDS_WAIT(); asm volatile("" ::: "memory");
}
__device__ __forceinline__ void p0_colmax_item(const GAS float* W, int ldw, int k0, int scol, GAS unsigned* colmax, int lane) {
    float mx = 0.f;
#pragma unroll 8
    for (int i = 0; i < 32; ++i) { const int kk = 2 * i + (lane >> 5); mx = fmaxf(mx, fabsf(W[(size_t)(k0 + kk) * ldw + scol + (lane & 31)])); }
    mx = fmaxf(mx, __builtin_bit_cast(float, xor32u_(__builtin_bit_cast(unsigned, mx), lane >= 32)));
    if (lane < 32) atomicMax((unsigned*)colmax + lane, __builtin_bit_cast(unsigned, mx));
}
__device__ __forceinline__ void p0_cvt8_item(const GAS float* W, int ldw, int k0, int scol, const GAS unsigned* colmax, GAS unsigned char* WT8, int pitch, GAS float* sb, int drow, LAS float* scr, int lane) {
    const float cm = __builtin_bit_cast(float, colmax[lane & 31]);
    const float qs = cm > 0.f ? 127.0f / cm : 0.f;
    if (k0 == 0 && lane < 32) sb[lane] = cm * (1.0f / 127.0f);
#pragma unroll 8
    for (int i = 0; i < 32; ++i) { const int kk = 2 * i + (lane >> 5); scr[kk * 33 + (lane & 31)] = W[(size_t)(k0 + kk) * ldw + scol + (lane & 31)] * qs; }
    LDS_WAIT(); asm volatile("" ::: "memory");
    const int n = lane >> 1, kh = lane & 1;
    const LAS float* sp = scr + (kh * 32) * 33 + n;
    u32x4 o0, o1;
#pragma unroll
    for (int q = 0; q < 8; ++q) { const unsigned p = pack_i8x4(sp[(4 * q) * 33], sp[(4 * q + 1) * 33], sp[(4 * q + 2) * 33], sp[(4 * q + 3) * 33]);
        if (q < 4) o0[q] = p; else o1[q - 4] = p; }
    GAS unsigned char* dst = WT8 + (size_t)(drow + n) * pitch + k0 + kh * 32;
    *(GAS u32x4*)dst = o0; *(GAS u32x4*)(dst + 16) = o1;
    LDS_WAIT(); asm volatile("" ::: "memory");
}
__device__ __forceinline__ int win_src_col(int n) {
    if (n < 4096) return n;
    if (n < 7168) return n - 4096 + 6152;
    if (n < 9216) return n - 7168 + 4096;
    return n - 9216 + 9224;
}

__device__ __forceinline__ void phase_p0(const DArgs& a, LAS unsigned char* lds, int vcu, int G) {
    const int tid = tid_(), lane = tid & 63, wave = tid >> 6;
    const int gw = vcu * NWAVES + wave, NGW = G * NWAVES;
    GAS unsigned char* ws = a.ws;
    LAS float* scr = (LAS float*)(lds + wave * 16384);
    constexpr int I_IN = 16 * 384, I_M = 32 * 32, I_G = 16 * 32, I_O = 16 * 32, I_PQ = 16 * 64;
    constexpr int NITEMS = I_IN + I_M + I_G + I_O + I_PQ;
    for (int it = gw; it < NITEMS; it += NGW) {
        int r = it;
        if (r < I_IN) { const int kb = r / 384, nb = r % 384;
            p0_colmax_item(a.w_in, IN_COLS, kb * 64, win_src_col(nb * 32), (GAS unsigned*)(ws + WS_CTL) + CW_COLMAX + nb * 32, lane);
            continue; } r -= I_IN;
        if (r < I_M) { const int kb = r / 32, nb = r % 32; p0_colmax_item(a.w_br_m, 1024, kb * 64, nb * 32, (GAS unsigned*)(ws + WS_CTL) + CW_COLMAX + 12288 + nb * 32, lane); continue; } r -= I_M;
        if (r < I_G) { const int kb = r / 32, nb = r % 32; p0_colmax_item(a.w_br_g, 1024, kb * 64, nb * 32, (GAS unsigned*)(ws + WS_CTL) + CW_COLMAX + 13312 + nb * 32, lane); continue; } r -= I_G;
        if (r < I_O) { const int kb = r / 32, nb = r % 32; p0_transpose_item(a.w_out, 1024, 1024, kb * 64, nb * 32, (GAS bf16_t*)(ws + WS_WO), nb * 32, scr, lane); continue; } r -= I_O;
        { const int kb = r / 64, nb = r % 64; p0_transpose_item(a.w_pq, 2048, 1024, kb * 64, nb * 32, (GAS bf16_t*)(ws + WS_WPQ), nb * 32, scr, lane); }
    }
    const int gt = vcu * NTHR + tid, NGT = G * NTHR;
    for (int i = gt; i < NP; i += NGT) ((float*)(ws + WS_BIASP))[i] = a.b_in[win_src_col(i)];
    for (int i = gt; i < 1024; i += NGT) { const float t0 = a.lb_table[i], t1 = a.lb_table[1024 + i]; ((float*)(ws + WS_LB))[i] = 1.0f / (1.0f + __expf(t1 - t0)); }
    for (int i = gt; i < 8 * 2 * 128 * 128 / 4; i += NGT) { const f32x4 v = ((const f32x4*)a.sub_keys)[i]; u32x2 o; o.x = pk2(v[0], v[1]); o.y = pk2(v[2], v[3]); ((u32x2*)(ws + WS_SK))[i] = o; }
    f32x4 g1[4];
#pragma unroll
    for (int j = 0; j < 4; ++j) g1[j] = ((const GAS f32x4*)a.norm1_g)[64 * j + lane];
    f32x4 gw0[16], gw1[16];
#pragma unroll
    for (int j = 0; j < 4; ++j)
#pragma unroll
        for (int e = 0; e < 4; ++e) { const int k = 256 * j + 4 * lane + e; gw0[4 * j + e] = *(const GAS f32x4*)(a.w_in + (size_t)k * IN_COLS + 6144); gw1[4 * j + e] = *(const GAS f32x4*)(a.w_in + (size_t)k * IN_COLS + 6148); }
    const float gbias = lane < 8 ? a.b_in[6144 + lane] : 0.f;
    for (int m = gw; m < T; m += NGW) {
        const GAS f32x4* xr = (const GAS f32x4*)(a.x + (size_t)m * D) + lane;
        f32x4 v[4]; float s = 0.f;
#pragma unroll
        for (int j = 0; j < 4; ++j) { v[j] = xr[64 * j]; s += (v[j][0] * v[j][0] + v[j][1] * v[j][1]) + (v[j][2] * v[j][2] + v[j][3] * v[j][3]); }
        const float rstd = rsqrtf(wave_sum(s, lane) * (1.f / D) + EPS);
        f32x4 ga0 = (f32x4){0.f, 0.f, 0.f, 0.f}, ga1 = ga0;
        float mx = 0.f;
#pragma unroll
        for (int j = 0; j < 4; ++j) {
            v[j] = v[j] * rstd * g1[j];
            mx = fmaxf(mx, fmaxf(fmaxf(fabsf(v[j][0]), fabsf(v[j][1])), fmaxf(fabsf(v[j][2]), fabsf(v[j][3]))));
#pragma unroll
            for (int e = 0; e < 4; ++e) { ga0 += gw0[4 * j + e] * v[j][e]; ga1 += gw1[4 * j + e] * v[j][e]; }
        }
        {
            mx = wave_max(mx);
            const float qs = mx > 0.f ? 127.0f / mx : 0.f;
#pragma unroll
            for (int jq = 0; jq < 4; ++jq) ((GAS unsigned*)(ws + WS_XN8 + (size_t)m * 1024))[64 * jq + lane] = pack_i8x4(v[jq][0] * qs, v[jq][1] * qs, v[jq][2] * qs, v[jq][3] * qs);
            if (lane == 0) ((GAS float*)(ws + WS_SA8))[m] = mx * (1.0f / 127.0f);
        }
        float ga[8] = {ga0[0], ga0[1], ga0[2], ga0[3], ga1[0], ga1[1], ga1[2], ga1[3]};
#pragma unroll
        for (int q = 0; q < 8; ++q) ga[q] = wave_sum(ga[q], lane);
        if (lane < 8) { float r = ga[0];
#pragma unroll
            for (int q = 1; q < 8; ++q) r = (lane == q) ? ga[q] : r;
            ((GAS float*)(ws + WS_GATES))[(size_t)m * 8 + lane] = r + gbias; }
    }
}

__device__ __forceinline__ float logsigf_(float x) { return fminf(x, 0.f) - log1pf(__expf(-fabsf(x))); }
#define LDS_BAR() do { asm volatile("s_waitcnt lgkmcnt(0)" ::: "memory"); __builtin_amdgcn_s_barrier(); asm volatile("" ::: "memory"); } while (0)
#define MFMA16(a, b, c) __builtin_amdgcn_mfma_f32_16x16x32_bf16((a), (b), (c), 0, 0, 0)
__device__ __forceinline__ bf16x8 lfrag(const LAS unsigned char* base, int pitch, int row, int k0, int fq) { return *(const LAS bf16x8*)(base + row * pitch + (k0 + 8 * fq) * 2); }
__device__ __forceinline__ int fm_off(int r, int k, int KB) { return (((r >> 4) * KB + (k >> 5)) << 10) + (((((k >> 3) & 3) << 4) + (r & 15)) << 4) + ((k & 7) << 1); }
__device__ __forceinline__ bf16x8 gfrag(const bf16_t* base, int ld, int row, int k0, int fq) { return *(const bf16x8*)(base + (size_t)row * ld + k0 + 8 * fq); }

__device__ __forceinline__ void phase_p0c(const DArgs& a, LAS unsigned char* lds, int vcu, int G) {
    const int tid = tid_(), lane = tid & 63, wave = tid >> 6;
    const int gw = vcu * NWAVES + wave, NGW = G * NWAVES;
    GAS unsigned char* ws = a.ws;
    LAS float* scr = (LAS float*)(lds + wave * 16384);
    constexpr int J_IN = 16 * 384, J_M = 32 * 32, J_G = 16 * 32;
    const GAS unsigned* cmx = (const GAS unsigned*)(ws + WS_CTL) + CW_COLMAX; GAS float* sb = (GAS float*)(ws + WS_SB8);
    for (int it = gw; it < J_IN + J_M + J_G; it += NGW) {
        int r = it;
        if (r < J_IN) { const int kb = r / 384, nb = r % 384;
            p0_cvt8_item(a.w_in, IN_COLS, kb * 64, win_src_col(nb * 32), cmx + nb * 32, ws + WS_W8A, 1024, sb + nb * 32, nb * 32, scr, lane); continue; } r -= J_IN;
        if (r < J_M) { const int kb = r / 32, nb = r % 32; p0_cvt8_item(a.w_br_m, 1024, kb * 64, nb * 32, cmx + 12288 + nb * 32, ws + WS_WM, 2048, sb + 12288 + nb * 32, nb * 32, scr, lane); continue; } r -= J_M;
        { const int kb = r / 32, nb = r % 32; p0_cvt8_item(a.w_br_g, 1024, kb * 64, nb * 32, cmx + 13312 + nb * 32, ws + WS_WG, 1024, sb + 13312 + nb * 32, nb * 32, scr, lane); }
    }
}
__device__ __forceinline__ void mscan_pair(const DArgs& a, LAS unsigned char* lds, int round, int p) {
    const int tid = tid_(), lane = tid & 63, part = tid >> 6;
    const int bl = p >> 2, h = p & 3, b = round * 2 + bl;
    const GAS float* g = (const GAS float*)(a.ws + WS_GATES) + ((size_t)b * SEQ + (size_t)lane * 128 + part * 16) * 8;
    float bsum = 0.f, gm = -INFINITY;
#pragma unroll 4
    for (int s = 0; s < 16; ++s) { const float ip = g[s * 8 + h], fp = g[s * 8 + 4 + h]; bsum += logsigf_(fp); gm = fmaxf(gm, ip - bsum); }
    LAS float* PS = (LAS float*)lds; LAS float* PM = PS + 512;
    PS[part * 64 + lane] = bsum; PM[part * 64 + lane] = gm;
    __syncthreads();
    if (tid < 64) {
        float bs = 0.f, g2 = -INFINITY;
#pragma unroll
        for (int q = 0; q < 8; ++q) { g2 = fmaxf(g2, PM[q * 64 + lane] - bs); bs += PS[q * 64 + lane]; }
        float mprev = 0.f, mine = 0.f;
        for (int c = 0; c < 64; ++c) {
            const float bc = rdlane(bs, c), gc = rdlane(g2, c);
            if (lane == c) mine = mprev; mprev = bc + fmaxf(mprev, gc); }
        ((GAS float*)(a.ws + WS_MPREV))[(round * 8 + p) * 64 + lane] = mine;
    }
    __syncthreads();
}

constexpr int PQ_PITCH = 528, PS_PITCH = 272;
__device__ __forceinline__ void mlstm_pre_item(const DArgs& a, LAS unsigned char* lds, int round, int item) {
    const int tid = tid_(), lane = tid & 63, wave = __builtin_amdgcn_readfirstlane(tid >> 6), fr = lane & 15, fq = lane >> 4;
    const int p = item >> 6, c = item & 63, bl = p >> 2, h = p & 3, b = round * 2 + bl;
    const int tl0 = bl * SEQ + c * 128; const size_t tg0 = (size_t)b * SEQ + c * 128;
    GAS unsigned char* ws = a.ws;
    LAS unsigned char* QL = lds; LAS unsigned char* KL = lds + 67584;
    LAS float* AS = (LAS float*)(lds + 135168); LAS float* MS = AS + 128; LAS float* SC = AS + 256;
    if (wave == 0) {
        const float mprev = ((const float*)(ws + WS_MPREV))[(round * 8 + p) * 64 + c];
        const float* g = (const float*)(ws + WS_GATES) + (tg0 + 2 * lane) * 8;
        const float ip0 = g[h], fp0 = g[4 + h], ip1 = g[8 + h], fp1 = g[12 + h];
        const float lf0 = logsigf_(fp0), lf1 = logsigf_(fp1), pp = lf0 + lf1;
        float incl = pp;
#pragma unroll
        for (int o = 1; o < 64; o <<= 1) { const float t = shup(incl, o, lane); if (lane >= o) incl += t; }
        const float excl = incl - pp, b0 = excl + lf0, b1 = incl;
        const float a0 = ip0 - b0, a1 = ip1 - b1;
        float inclm = fmaxf(a0, a1);
#pragma unroll
        for (int o = 1; o < 64; o <<= 1) { const float t = shup(inclm, o, lane); if (lane >= o) inclm = fmaxf(inclm, t); }
        float exclm = shup(inclm, 1, lane); if (lane == 0) exclm = -INFINITY;
        const float M0 = fmaxf(mprev, fmaxf(exclm, a0)), M1 = fmaxf(mprev, inclm);
        AS[2 * lane] = a0; AS[2 * lane + 1] = a1; MS[2 * lane] = M0; MS[2 * lane + 1] = M1;
        float* mt = (float*)(ws + WS_MT) + (tg0 + 2 * lane) * 4 + h;
        mt[0] = b0 + M0; mt[4] = b1 + M1;
        const float Mlast = rdlane(M1, 63);
        if (lane == 0) { SC[0] = mprev; SC[1] = Mlast; ((float*)(ws + WS_MDEC))[item] = __expf(mprev - Mlast); }
    }
    {
        const int cgp = tid & 63, strip = tid >> 6;
        const int col = (cgp < 32) ? (h * 256 + cgp * 8) : (1024 + h * 256 + (cgp - 32) * 8);
        float w[4][8], bb[8];
#pragma unroll
        for (int j = 0; j < 4; ++j) { const f32x4 w0 = *(const f32x4*)(a.conv_w + j * 2048 + col), w1 = *(const f32x4*)(a.conv_w + j * 2048 + col + 4);
#pragma unroll
            for (int e = 0; e < 4; ++e) { w[j][e] = w0[e]; w[j][4 + e] = w1[e]; } }
        { const f32x4 b0 = *(const f32x4*)(a.conv_b + col), b1 = *(const f32x4*)(a.conv_b + col + 4);
#pragma unroll
            for (int e = 0; e < 4; ++e) { bb[e] = b0[e]; bb[4 + e] = b1[e]; } }
        const bf16_t* src = (const bf16_t*)(ws + WS_QKPRE) + (size_t)(tl0 + 16 * strip) * 2048 + col;
        const float qs = (cgp < 32) ? 0.0625f : 1.0f;
        LAS unsigned char* dstt = ((cgp < 32) ? QL : KL) + (cgp & 31) * 16;
#pragma unroll 1
        for (int half = 0; half < 2; ++half) {
            u32x4 xr[11];
#pragma unroll
            for (int r = 0; r < 11; ++r) {
                const int sl = c * 128 + 16 * strip + 8 * half + r - 3;
                xr[r] = (sl >= 0) ? *(const u32x4*)(src + (ptrdiff_t)(8 * half + r - 3) * 2048) : (u32x4){0u, 0u, 0u, 0u};
            }
#pragma unroll
            for (int r = 0; r < 8; ++r) {
                float y[8];
#pragma unroll
                for (int e = 0; e < 8; ++e) y[e] = bb[e];
#pragma unroll
                for (int j = 0; j < 4; ++j) { const u32x4 xv = xr[r + j];
                    y[0] += w[j][0] * bf_lo(xv.x); y[1] += w[j][1] * bf_hi(xv.x); y[2] += w[j][2] * bf_lo(xv.y); y[3] += w[j][3] * bf_hi(xv.y);
                    y[4] += w[j][4] * bf_lo(xv.z); y[5] += w[j][5] * bf_hi(xv.z); y[6] += w[j][6] * bf_lo(xv.w); y[7] += w[j][7] * bf_hi(xv.w); }
#pragma unroll
                for (int e = 0; e < 8; ++e) y[e] = siluf_(y[e]) * qs;
                u32x4 o; o.x = pk2(y[0], y[1]); o.y = pk2(y[2], y[3]); o.z = pk2(y[4], y[5]); o.w = pk2(y[6], y[7]);
                *(LAS u32x4*)(dstt + (16 * strip + 8 * half + r) * PQ_PITCH) = o;
            }
        }
    }
    __syncthreads();
    const float mprev = SC[0], Mlast = SC[1];
    {
        bf16_t* Sg = (bf16_t*)(ws + WS_S) + (size_t)item * 128 * 128;
        const int t = wave * 16 + fr; const float Mt = MS[t];
        for (int st = 0; st < 8; ++st) {
            u32x2 o = (u32x2){0u, 0u};
            if (st <= wave) {
                f32x4 acc = (f32x4){0.f, 0.f, 0.f, 0.f};
#pragma unroll
                for (int ks = 0; ks < 8; ++ks) acc = MFMA16(lfrag(KL, PQ_PITCH, st * 16 + fr, ks * 32, fq), lfrag(QL, PQ_PITCH, wave * 16 + fr, ks * 32, fq), acc);
                float v[4];
#pragma unroll
                for (int j = 0; j < 4; ++j) { const int s = st * 16 + 4 * fq + j; v[j] = (s <= t) ? acc[j] * __expf(AS[s] - Mt) : 0.f; }
                o.x = pk2(v[0], v[1]); o.y = pk2(v[2], v[3]);
            }
            *(u32x2*)((unsigned char*)Sg + fm_off(t, st * 16 + 4 * fq, 4)) = o;
        }
    }
    {
        bf16_t* Qg = (bf16_t*)(ws + WS_QT) + (size_t)item * 128 * 256;
#pragma unroll
        for (int i = 0; i < 8; ++i) { const int idx = tid + 512 * i, blk = idx >> 6, t = (blk >> 3) * 16 + (idx & 15), ch = (blk & 7) * 4 + ((idx >> 4) & 3);
            const u32x4 v = *(const LAS u32x4*)(QL + t * PQ_PITCH + ch * 16); const float s = __expf(mprev - MS[t]);
            u32x4 o; o.x = pk2(bf_lo(v.x) * s, bf_hi(v.x) * s); o.y = pk2(bf_lo(v.y) * s, bf_hi(v.y) * s); o.z = pk2(bf_lo(v.z) * s, bf_hi(v.z) * s); o.w = pk2(bf_lo(v.w) * s, bf_hi(v.w) * s);
            *(u32x4*)((unsigned char*)Qg + fm_off(t, ch * 8, 8)) = o; }
    }
    {
        bf16_t* Kg = (bf16_t*)(ws + WS_KWT) + (size_t)item * 256 * 128;
        const int dlo = lane & 15, sglo = lane >> 4;
#pragma unroll
        for (int i = 0; i < 8; ++i) { const int combo = wave * 8 + i, d = (combo >> 2) * 16 + dlo, s0 = ((combo & 3) * 4 + sglo) * 8;
            float v[8];
#pragma unroll
            for (int e = 0; e < 8; ++e) v[e] = bf2f(*(const LAS bf16_t*)(KL + (s0 + e) * PQ_PITCH + d * 2)) * __expf(AS[s0 + e] - Mlast);
            u32x4 o; o.x = pk2(v[0], v[1]); o.y = pk2(v[2], v[3]); o.z = pk2(v[4], v[5]); o.w = pk2(v[6], v[7]);
            *(u32x4*)((unsigned char*)Kg + fm_off(d, s0, 4)) = o; }
    }
    __syncthreads();
}

__device__ __forceinline__ void hgrn_pre_load(const DArgs& a, int round, int item, u32x4 (&gq)[4]) {
    const int tid = tid_();
    const int p = item >> 7, c = item & 127, bl = p >> 3, h = p & 7;
    const int tl0 = bl * SEQ + c * 64;
    GAS unsigned char* ws = a.ws;
#pragma unroll
    for (int i = 0; i < 2; ++i) { const int idx = tid + 512 * i, s = idx >> 4, ch = idx & 15;
        gq[2 * i] = *(const GAS u32x4*)((const GAS bf16_t*)(ws + WS_GFLOG) + (size_t)(tl0 + s) * 1024 + h * 128 + ch * 8);
        gq[2 * i + 1] = *(const GAS u32x4*)((const GAS bf16_t*)(ws + WS_GQ) + (size_t)(tl0 + s) * 1024 + h * 128 + ch * 8); }
}
__device__ __forceinline__ void hgrn_pre_item(const DArgs& a, LAS unsigned char* lds, int round, int item, u32x4 (&gq)[4], int next_item) {
    const int tid = tid_(), lane = tid & 63, wave = __builtin_amdgcn_readfirstlane(tid >> 6), fr = lane & 15, fq = lane >> 4;
    const int p = item >> 7, c = item & 127, bl = p >> 3, h = p & 7;
    const int tl0 = bl * SEQ + c * 64;
    GAS unsigned char* ws = a.ws;
    LAS float* CUM = (LAS float*)lds;
    LAS float* GL = (LAS float*)(lds + 32768);
    LAS unsigned char* QH = lds + 65536;
    LAS unsigned char* KE = lds + 65536 + 64 * PS_PITCH;
    LAS float* QF = (LAS float*)(lds + 65536 + 128 * PS_PITCH);
#pragma unroll
    for (int i = 0; i < 2; ++i) { const int idx = tid + 512 * i, s = idx >> 4, ch = idx & 15;
        const u32x4 gv = gq[2 * i], qv = gq[2 * i + 1];
        LAS float* gd = GL + s * 128 + ch * 8; LAS float* qd = QF + s * 128 + ch * 8;
        gd[0] = bf_lo(gv.x); gd[1] = bf_hi(gv.x); gd[2] = bf_lo(gv.y); gd[3] = bf_hi(gv.y); gd[4] = bf_lo(gv.z); gd[5] = bf_hi(gv.z); gd[6] = bf_lo(gv.w); gd[7] = bf_hi(gv.w);
        qd[0] = bf_lo(qv.x); qd[1] = bf_hi(qv.x); qd[2] = bf_lo(qv.y); qd[3] = bf_hi(qv.y); qd[4] = bf_lo(qv.z); qd[5] = bf_hi(qv.z); qd[6] = bf_lo(qv.w); qd[7] = bf_hi(qv.w); }
    if (next_item < 2048) hgrn_pre_load(a, round, next_item, gq);
    LDS_BAR();
    {
        const int d = tid & 127, qt = tid >> 7; float cs = 0.f;
#pragma unroll 4
        for (int s = 0; s < 16; ++s) { cs += GL[(qt * 16 + s) * 128 + d]; CUM[(qt * 16 + s) * 128 + d] = cs; }
        LDS_BAR();
        float off = 0.f;
#pragma unroll
        for (int q = 0; q < 3; ++q) off += (q < qt) ? CUM[(q * 16 + 15) * 128 + d] : 0.f;
        LDS_BAR();
#pragma unroll 4
        for (int s = 0; s < 16; ++s) CUM[(qt * 16 + s) * 128 + d] += off;
        if (qt == 3) ((GAS float*)(ws + WS_HGDEC))[(size_t)item * 128 + d] = __expf(cs + off);
    }
    LDS_BAR();
    {
        bf16_t* Qg = (bf16_t*)(ws + WS_QTG) + (size_t)item * 64 * 128;
#pragma unroll
        for (int i = 0; i < 2; ++i) { const int idx = tid + 512 * i, s = idx >> 4, ch = idx & 15;
            float qt[8], qh[8], ke[8];
#pragma unroll
            for (int e = 0; e < 8; ++e) { const int d = ch * 8 + e; const float cm = CUM[s * 128 + d], last = CUM[63 * 128 + d], q = QF[s * 128 + d], g = GL[s * 128 + d];
                qt[e] = q * __expf(cm); qh[e] = q * __expf(cm - last); ke[e] = (1.0f - __expf(g)) * __expf(last - cm); }
            u32x4 o; o.x = pk2(qt[0], qt[1]); o.y = pk2(qt[2], qt[3]); o.z = pk2(qt[4], qt[5]); o.w = pk2(qt[6], qt[7]);
            *(u32x4*)((unsigned char*)Qg + fm_off(s, ch * 8, 4)) = o;
            o.x = pk2(qh[0], qh[1]); o.y = pk2(qh[2], qh[3]); o.z = pk2(qh[4], qh[5]); o.w = pk2(qh[6], qh[7]);
            *(LAS u32x4*)(QH + s * PS_PITCH + ch * 16) = o;
            o.x = pk2(ke[0], ke[1]); o.y = pk2(ke[2], ke[3]); o.z = pk2(ke[4], ke[5]); o.w = pk2(ke[6], ke[7]);
            *(LAS u32x4*)(KE + s * PS_PITCH + ch * 16) = o; }
    }
    LDS_BAR();
    {
        bf16_t* Ag = (bf16_t*)(ws + WS_ATT) + (size_t)item * 64 * 64;
#pragma unroll
        for (int i = 0; i < 2; ++i) { const int tile = wave * 2 + i, tt = tile >> 2, st = tile & 3; const int t = tt * 16 + fr;
            u32x2 o = (u32x2){0u, 0u};
            if (st <= tt) { f32x4 acc = (f32x4){0.f, 0.f, 0.f, 0.f};
#pragma unroll
                for (int ks = 0; ks < 4; ++ks) acc = MFMA16(lfrag(KE, PS_PITCH, st * 16 + fr, ks * 32, fq), lfrag(QH, PS_PITCH, tt * 16 + fr, ks * 32, fq), acc);
                float v[4];
#pragma unroll
                for (int j = 0; j < 4; ++j) { const int s = st * 16 + 4 * fq + j; v[j] = (s <= t) ? acc[j] : 0.f; }
                o.x = pk2(v[0], v[1]); o.y = pk2(v[2], v[3]); }
            *(u32x2*)((unsigned char*)Ag + fm_off(t, st * 16 + 4 * fq, 2)) = o; }
    }
    {
        bf16_t* Kg = (bf16_t*)(ws + WS_KENDT) + (size_t)item * 128 * 64;
        const int dlo = lane & 15, sglo = lane >> 4;
#pragma unroll
        for (int i = 0; i < 2; ++i) { const int combo = wave * 2 + i, d = (combo >> 1) * 16 + dlo, s0 = ((combo & 1) * 4 + sglo) * 8;
            unsigned v[8];
#pragma unroll
            for (int e = 0; e < 8; ++e) v[e] = *(const LAS bf16_t*)(KE + (s0 + e) * PS_PITCH + d * 2);
            u32x4 o; o.x = v[0] | (v[1] << 16); o.y = v[2] | (v[3] << 16); o.z = v[4] | (v[5] << 16); o.w = v[6] | (v[7] << 16);
            *(u32x4*)((unsigned char*)Kg + fm_off(d, s0, 2)) = o; }
    }
    LDS_BAR();
}

template <int NVT, bool DEN>
__device__ __forceinline__ void mlstm_scan(const DArgs& a, LAS unsigned char* lds, int round, int p, int sl) {
    const int tid = tid_(), lane = tid & 63, wave = __builtin_amdgcn_readfirstlane(tid >> 6), fr = lane & 15, fq = lane >> 4;
    const int bl = p >> 2, h = p & 3, b = round * 2 + bl;
    GAS unsigned char* ws = a.ws;
    constexpr int VTB = NVT * 16 * PS_PITCH, CTB = NVT * 16 * PQ_PITCH;
    LAS unsigned char* VT = lds; LAS unsigned char* CT = lds + 2 * VTB; LAS float* DEC = (LAS float*)(lds + 2 * VTB + 2 * CTB);
    for (int i = tid; i < (2 * VTB + 2 * CTB) / 4; i += NTHR) ((LAS unsigned*)lds)[i] = 0u;
    if (tid < 64) DEC[tid] = ((const GAS float*)(ws + WS_MDEC))[p * 64 + tid];
    __syncthreads();
    if (DEN) { if (tid < 256) { const int bufi = tid >> 7, s = tid & 127; *(LAS bf16_t*)(VT + bufi * VTB + s * 2) = (bf16_t)0x3F80; } }
    f32x4 st[2][NVT];
#pragma unroll
    for (int dt = 0; dt < 2; ++dt)
#pragma unroll
        for (int vt = 0; vt < NVT; ++vt) st[dt][vt] = (f32x4){0.f, 0.f, 0.f, 0.f};
    const int vcol = h * 512 + sl * 32;
    const int vs = tid >> 2, vpart = tid & 3;
    const GAS unsigned char* Sg0 = ws + WS_S + (size_t)(p * 64) * 32768 + wave * 4096 + lane * 16;
    const GAS unsigned char* Qg0 = ws + WS_QT + (size_t)(p * 64) * 65536 + wave * 8192 + lane * 16;
    const GAS unsigned char* Kg0 = ws + WS_KWT + (size_t)(p * 64) * 65536 + wave * 8192 + lane * 16;
    const GAS bf16_t* Vg0 = (const GAS bf16_t*)(ws + WS_V) + (size_t)(bl * SEQ + vs) * 2048 + vcol + vpart * 8;
    bf16x8 bS[4], bQ[8], aK[2][4]; u32x4 vreg = (u32x4){0u, 0u, 0u, 0u};
#define V_STAGE(cc_) do { LAS unsigned char* d0_ = VT + ((cc_) & 1) * VTB + (vpart * 8) * PS_PITCH + vs * 2; \
        *(LAS bf16_t*)(d0_ + 0 * PS_PITCH) = (bf16_t)(vreg.x & 0xffffu); *(LAS bf16_t*)(d0_ + 1 * PS_PITCH) = (bf16_t)(vreg.x >> 16); \
        *(LAS bf16_t*)(d0_ + 2 * PS_PITCH) = (bf16_t)(vreg.y & 0xffffu); *(LAS bf16_t*)(d0_ + 3 * PS_PITCH) = (bf16_t)(vreg.y >> 16); \
        *(LAS bf16_t*)(d0_ + 4 * PS_PITCH) = (bf16_t)(vreg.z & 0xffffu); *(LAS bf16_t*)(d0_ + 5 * PS_PITCH) = (bf16_t)(vreg.z >> 16); \
        *(LAS bf16_t*)(d0_ + 6 * PS_PITCH) = (bf16_t)(vreg.w & 0xffffu); *(LAS bf16_t*)(d0_ + 7 * PS_PITCH) = (bf16_t)(vreg.w >> 16); } while (0)
    if (!DEN) { vreg = *(const GAS u32x4*)Vg0; V_STAGE(0); }
    __builtin_amdgcn_sched_barrier(0);
#pragma unroll
    for (int ks = 0; ks < 4; ++ks)
#pragma unroll
        for (int dt = 0; dt < 2; ++dt) aK[dt][ks] = *(const GAS bf16x8*)(Kg0 + (dt * 4 + ks) * 1024);
    __builtin_amdgcn_sched_barrier(0);
#pragma unroll
    for (int ks = 0; ks < 4; ++ks) bS[ks] = *(const GAS bf16x8*)(Sg0 + ks * 1024);
    __builtin_amdgcn_sched_barrier(0);
#pragma unroll
    for (int ks = 0; ks < 8; ++ks) bQ[ks] = *(const GAS bf16x8*)(Qg0 + ks * 1024);
    __builtin_amdgcn_sched_barrier(0);
    if (!DEN) vreg = *(const GAS u32x4*)(Vg0 + (size_t)128 * 2048);
    __builtin_amdgcn_sched_barrier(0);
    const GAS unsigned char* pfp; unsigned pfstride;
    { const int tt = (wave * 64 + lane) < 160 ? wave * 64 + lane : 159; const int idx = sl * 10 + (tt >> 4), off = (tt & 15) * 64;
      pfp = (idx < 32 ? ws + WS_S + (size_t)(p * 64) * 32768 + idx * 1024 : idx < 96 ? ws + WS_QT + (size_t)(p * 64) * 65536 + (idx - 32) * 1024 : ws + WS_KWT + (size_t)(p * 64) * 65536 + (idx - 96) * 1024) + off;
      pfstride = idx < 32 ? 32768u : 65536u; }
    unsigned pfv = 0u;
#pragma unroll 1
    for (int c = 0; c < 64; ++c) {
        const int tl0 = bl * SEQ + c * 128; const size_t tg0 = (size_t)b * SEQ + c * 128;
        const int cn = c < 63 ? c + 1 : 63, cn2 = c < 62 ? c + 2 : 63;
        LAS unsigned char* vt_ = VT + (c & 1) * VTB; LAS unsigned char* ct_ = CT + (c & 1) * CTB; LAS unsigned char* ctn = CT + ((c + 1) & 1) * CTB;
        LDS_BAR();
        if (!DEN && wave < 3) { asm volatile("" :: "v"(pfv)); const int c3 = c < 60 ? c + 3 : 63; pfv = *(const GAS unsigned*)(pfp + (size_t)c3 * pfstride); }
        bf16x8 vf[NVT][4], cf[NVT][4];
#pragma unroll
        for (int vt = 0; vt < NVT; ++vt)
#pragma unroll
            for (int ks = 0; ks < 4; ++ks) vf[vt][ks] = lfrag(vt_, PS_PITCH, vt * 16 + fr, ks * 32, fq);
        const float dec = DEC[c];
        __builtin_amdgcn_sched_barrier(0);
#pragma unroll
        for (int dt = 0; dt < 2; ++dt)
#pragma unroll
            for (int vt = 0; vt < NVT; ++vt) st[dt][vt] = st[dt][vt] * dec;
#pragma unroll
        for (int ks = 0; ks < 4; ++ks) {
#pragma unroll
            for (int vt = 0; vt < NVT; ++vt) cf[vt][ks] = lfrag(ct_, PQ_PITCH, vt * 16 + fr, ks * 32, fq);
#pragma unroll
            for (int dt = 0; dt < 2; ++dt) {
#pragma unroll
                for (int vt = 0; vt < NVT; ++vt) st[dt][vt] = MFMA16(aK[dt][ks], vf[vt][ks], st[dt][vt]);
                aK[dt][ks] = *(const GAS bf16x8*)(Kg0 + (size_t)cn * 65536 + (dt * 4 + ks) * 1024);
            }
            __builtin_amdgcn_sched_barrier(0);
        }
#pragma unroll
        for (int dt = 0; dt < 2; ++dt)
#pragma unroll
            for (int vt = 0; vt < NVT; ++vt) { u32x2 o; o.x = pk2(st[dt][vt][0], st[dt][vt][1]); o.y = pk2(st[dt][vt][2], st[dt][vt][3]);
                *(LAS u32x2*)(ctn + (vt * 16 + fr) * PQ_PITCH + (wave * 32 + dt * 16 + 4 * fq) * 2) = o; }
        __builtin_amdgcn_sched_barrier(0);
        f32x4 acc[NVT];
#pragma unroll
        for (int vt = 0; vt < NVT; ++vt) acc[vt] = (f32x4){0.f, 0.f, 0.f, 0.f};
#pragma unroll
        for (int ks = 0; ks < 4; ++ks) {
#pragma unroll
            for (int vt = 0; vt < NVT; ++vt) acc[vt] = MFMA16(vf[vt][ks], bS[ks], acc[vt]);
            bS[ks] = *(const GAS bf16x8*)(Sg0 + (size_t)cn * 32768 + ks * 1024);
            __builtin_amdgcn_sched_barrier(0);
        }
#pragma unroll
        for (int ks = 0; ks < 8; ++ks) {
#pragma unroll
            for (int vt = 0; vt < NVT; ++vt) acc[vt] = MFMA16(cf[vt][ks & 3], bQ[ks], acc[vt]);
            if (ks < 4) {
#pragma unroll
                for (int vt = 0; vt < NVT; ++vt) cf[vt][ks] = lfrag(ct_, PQ_PITCH, vt * 16 + fr, 128 + ks * 32, fq);
            }
            bQ[ks] = *(const GAS bf16x8*)(Qg0 + (size_t)cn * 65536 + ks * 1024);
            __builtin_amdgcn_sched_barrier(0);
        }
        const int t = wave * 16 + fr;
        if (!DEN) {
            GAS bf16_t* hn = (GAS bf16_t*)(ws + WS_QKPRE) + (size_t)(tl0 + t) * 2048 + vcol + 4 * fq;
#pragma unroll
            for (int vt = 0; vt < NVT; ++vt) { u32x2 o; o.x = pk2(acc[vt][0], acc[vt][1]); o.y = pk2(acc[vt][2], acc[vt][3]); *(GAS u32x2*)(hn + vt * 16) = o; }
            V_STAGE(c + 1); vreg = *(const GAS u32x4*)(Vg0 + (size_t)cn2 * 128 * 2048);
        } else {
            if (fq == 0) ((GAS float*)(ws + WS_DEN))[(tg0 + t) * 4 + h] = acc[0][0];
        }
    }
    asm volatile("" :: "v"(pfv));
    __syncthreads();
#undef V_STAGE
}

constexpr int HG_PD = 4;
__device__ __forceinline__ void hgrn_scan(const DArgs& a, LAS unsigned char* lds, int round, int p, int sl) {
    const int tid = tid_(), lane = tid & 63, wave = __builtin_amdgcn_readfirstlane(tid >> 6), fr = lane & 15, fq = lane >> 4;
    const int bl = p >> 3, h = p & 7;
    GAS unsigned char* ws = a.ws;
    constexpr int IP = 144, ITB = 32 * IP, STB = 32 * PS_PITCH;
    LAS unsigned char* IT = lds; LAS unsigned char* ST = lds + 2 * ITB;
    for (int i = tid; i < (2 * ITB + 2 * STB) / 4; i += NTHR) ((LAS unsigned*)lds)[i] = 0u;
    __syncthreads();
    f32x4 st[2][2];
#pragma unroll
    for (int i = 0; i < 2; ++i) { st[i][0] = (f32x4){0.f, 0.f, 0.f, 0.f}; st[i][1] = st[i][0]; }
    const int vcol = h * 128 + sl * 32;
    const int is = (tid & 255) >> 2, ipart = tid & 3;
    const bool outw = wave < 4;
    const int w4 = wave & 3;
    const GAS unsigned char* Ag0 = ws + WS_ATT + (size_t)(p * 128) * 8192 + w4 * 2048 + lane * 16;
    const GAS unsigned char* Qg0 = ws + WS_QTG + (size_t)(p * 128) * 16384 + w4 * 4096 + lane * 16;
    const GAS unsigned char* Kg0 = ws + WS_KENDT + (size_t)(p * 128) * 16384 + w4 * 4096 + lane * 16;
    const GAS unsigned char* Dg0 = ws + WS_HGDEC + ((size_t)(p * 128) * 128 + w4 * 32 + 4 * fq) * 4;
    const GAS unsigned char* Ig0 = ws + WS_GI + ((size_t)(bl * SEQ + is) * 1024 + vcol + ipart * 8) * 2;
    const GAS unsigned char* gb0 = outw ? Ag0 : Kg0;          const unsigned gs0 = outw ? 8192u : 16384u;
    const GAS unsigned char* gb1 = outw ? Qg0 : Kg0 + 2048;   const unsigned gs1 = 16384u;
    const GAS unsigned char* gb2 = outw ? Qg0 + 2048 : Dg0;   const unsigned gs2 = outw ? 16384u : 512u, gt2 = outw ? 1024u : 64u;
    const GAS unsigned char* gb3 = outw ? Ig0 : Dg0;          const unsigned gs3 = outw ? 131072u : 512u;
    u32x4 pf[HG_PD][7];
#define HG_LD01(k_, cc_) do { _Pragma("unroll") for (int j_ = 0; j_ < 2; ++j_) pf[k_][j_] = *(const GAS u32x4*)(gb0 + (size_t)(cc_) * gs0 + j_ * 1024); } while (0)
#define HG_LD23(k_, cc_) do { _Pragma("unroll") for (int j_ = 0; j_ < 2; ++j_) pf[k_][2 + j_] = *(const GAS u32x4*)(gb1 + (size_t)(cc_) * gs1 + j_ * 1024); } while (0)
#define HG_LD45(k_, cc_) do { _Pragma("unroll") for (int j_ = 0; j_ < 2; ++j_) pf[k_][4 + j_] = *(const GAS u32x4*)(gb2 + (size_t)(cc_) * gs2 + j_ * gt2); } while (0)
#define HG_LD6(k_, cc_) do { pf[k_][6] = *(const GAS u32x4*)(gb3 + (size_t)(cc_) * gs3); } while (0)
#pragma unroll
    for (int k = 0; k < HG_PD; ++k) { HG_LD01(k, k); HG_LD23(k, k); HG_LD45(k, k); __builtin_amdgcn_sched_barrier(0); HG_LD6((k + 1) % HG_PD, (k + 1 < HG_PD ? k + 1 : HG_PD)); __builtin_amdgcn_sched_barrier(0); }
    const GAS unsigned char* pfp; unsigned pfstride;
    { const int tt = (wave * 64 + lane) < 160 ? wave * 64 + lane : 159; const int idx = sl * 10 + (tt >> 4), off = (tt & 15) * 64;
      pfp = (idx < 8 ? ws + WS_ATT + (size_t)(p * 128) * 8192 + idx * 1024 : idx < 24 ? ws + WS_QTG + (size_t)(p * 128) * 16384 + (idx - 8) * 1024 : ws + WS_KENDT + (size_t)(p * 128) * 16384 + (idx - 24) * 1024) + off;
      pfstride = idx < 8 ? 8192u : 16384u; }
    unsigned pfv[HG_PD];
#pragma unroll
    for (int k = 0; k < HG_PD; ++k) pfv[k] = 0u;
#define HG_STAGE(dst_, iv_) do { LAS unsigned char* d0_ = (dst_) + (ipart * 8) * IP + is * 2; \
        *(LAS bf16_t*)(d0_ + 0 * IP) = (bf16_t)((iv_).x & 0xffffu); *(LAS bf16_t*)(d0_ + 1 * IP) = (bf16_t)((iv_).x >> 16); \
        *(LAS bf16_t*)(d0_ + 2 * IP) = (bf16_t)((iv_).y & 0xffffu); *(LAS bf16_t*)(d0_ + 3 * IP) = (bf16_t)((iv_).y >> 16); \
        *(LAS bf16_t*)(d0_ + 4 * IP) = (bf16_t)((iv_).z & 0xffffu); *(LAS bf16_t*)(d0_ + 5 * IP) = (bf16_t)((iv_).z >> 16); \
        *(LAS bf16_t*)(d0_ + 6 * IP) = (bf16_t)((iv_).w & 0xffffu); *(LAS bf16_t*)(d0_ + 7 * IP) = (bf16_t)((iv_).w >> 16); } while (0)
    if (outw) { const u32x4 iv = *(const GAS u32x4*)Ig0; HG_STAGE(IT, iv); }
#pragma unroll 1
    for (int c0 = 0; c0 < 128; c0 += HG_PD) {
#pragma unroll
      for (int k = 0; k < HG_PD; ++k) {
        const int c = c0 + k;
        const int tl0 = bl * SEQ + c * 64;
        const int cn = (c + HG_PD < 128) ? c + HG_PD : 127;
        LAS unsigned char* it_ = IT + (k & 1) * ITB; LAS unsigned char* itn = IT + ((k + 1) & 1) * ITB; LAS unsigned char* st_ = ST + (k & 1) * STB; LAS unsigned char* stn = ST + ((k + 1) & 1) * STB;
        LDS_BAR();
        if (wave < 3) { asm volatile("" :: "v"(pfv[k])); const int c7 = (c + HG_PD + 3 < 128) ? c + HG_PD + 3 : 127; pfv[k] = *(const GAS unsigned*)(pfp + (size_t)c7 * pfstride); }
        bf16x8 itf[2][2];
#pragma unroll
        for (int vt = 0; vt < 2; ++vt)
#pragma unroll
            for (int ks = 0; ks < 2; ++ks) itf[vt][ks] = lfrag(it_, IP, vt * 16 + fr, ks * 32, fq);
        bf16x8 sf[2][4];
        f32x4 acc[2];
        acc[0] = (f32x4){0.f, 0.f, 0.f, 0.f}; acc[1] = acc[0];
        if (outw) {
#pragma unroll
            for (int vt = 0; vt < 2; ++vt)
#pragma unroll
                for (int ks = 0; ks < 4; ++ks) sf[vt][ks] = lfrag(st_, PS_PITCH, vt * 16 + fr, ks * 32, fq);
#pragma unroll
            for (int ks = 0; ks < 2; ++ks)
#pragma unroll
                for (int vt = 0; vt < 2; ++vt) acc[vt] = MFMA16(itf[vt][ks], __builtin_bit_cast(bf16x8, pf[k][ks]), acc[vt]);
        } else {
            const f32x4 dec = __builtin_bit_cast(f32x4, pf[k][4]);
#pragma unroll
            for (int vt = 0; vt < 2; ++vt) { st[0][vt] = st[0][vt] * dec;
#pragma unroll
                for (int ks = 0; ks < 2; ++ks) st[0][vt] = MFMA16(__builtin_bit_cast(bf16x8, pf[k][ks]), itf[vt][ks], st[0][vt]); }
        }
        __builtin_amdgcn_sched_barrier(0);
        HG_LD01(k, cn);
        __builtin_amdgcn_sched_barrier(0);
        if (outw) {
#pragma unroll
            for (int ks = 0; ks < 2; ++ks)
#pragma unroll
                for (int vt = 0; vt < 2; ++vt) acc[vt] = MFMA16(sf[vt][ks], __builtin_bit_cast(bf16x8, pf[k][2 + ks]), acc[vt]);
        } else {
            const f32x4 dec = __builtin_bit_cast(f32x4, pf[k][5]);
#pragma unroll
            for (int vt = 0; vt < 2; ++vt) { st[1][vt] = st[1][vt] * dec;
#pragma unroll
                for (int ks = 0; ks < 2; ++ks) st[1][vt] = MFMA16(__builtin_bit_cast(bf16x8, pf[k][2 + ks]), itf[vt][ks], st[1][vt]); }
        }
        __builtin_amdgcn_sched_barrier(0);
        HG_LD23(k, cn);
        __builtin_amdgcn_sched_barrier(0);
        if (outw) {
#pragma unroll
            for (int ks = 2; ks < 4; ++ks)
#pragma unroll
                for (int vt = 0; vt < 2; ++vt) acc[vt] = MFMA16(sf[vt][ks], __builtin_bit_cast(bf16x8, pf[k][2 + ks]), acc[vt]);
        } else {
#pragma unroll
            for (int dtile = 0; dtile < 2; ++dtile)
#pragma unroll
                for (int vt = 0; vt < 2; ++vt) { u32x2 o; o.x = pk2(st[dtile][vt][0], st[dtile][vt][1]); o.y = pk2(st[dtile][vt][2], st[dtile][vt][3]);
                    *(LAS u32x2*)(stn + (vt * 16 + fr) * PS_PITCH + (w4 * 32 + dtile * 16 + 4 * fq) * 2) = o; }
        }
        __builtin_amdgcn_sched_barrier(0);
        HG_LD45(k, cn);
        __builtin_amdgcn_sched_barrier(0);
        if (outw) {
            HG_STAGE(itn, pf[(k + 1) % HG_PD][6]);
            GAS bf16_t* og = (GAS bf16_t*)(ws + WS_GQ) + (size_t)(tl0 + w4 * 16 + fr) * 1024 + vcol + 4 * fq;
#pragma unroll
            for (int vt = 0; vt < 2; ++vt) { u32x2 o; o.x = pk2(acc[vt][0], acc[vt][1]); o.y = pk2(acc[vt][2], acc[vt][3]); *(GAS u32x2*)(og + vt * 16) = o; }
        }
        __builtin_amdgcn_sched_barrier(0);
        { const int cni = (c + 1 + HG_PD < 128) ? c + 1 + HG_PD : 127; HG_LD6((k + 1) % HG_PD, cni); }
        __builtin_amdgcn_sched_barrier(0);
      }
    }
#pragma unroll
    for (int k = 0; k < HG_PD; ++k) asm volatile("" :: "v"(pfv[k]));
    __syncthreads();
#undef HG_LD01
#undef HG_LD23
#undef HG_LD45
#undef HG_LD6
#undef HG_STAGE
}

__device__ __forceinline__ void xn8_convert(const DArgs& a, int round, int vcu, int G) {
    const int tid = tid_(), lane = tid & 63, wave = tid >> 6;
    const int gw = vcu * NWAVES + wave, NGW = G * NWAVES;
    GAS unsigned char* ws = a.ws;
    for (int tl = gw; tl < RT; tl += NGW) {
        const size_t tg = (size_t)round * RT + tl;
        const GAS u32x2* xr = (const GAS u32x2*)((const GAS bf16_t*)(ws + WS_XN) + tg * D) + lane;
        f32x4 v[4]; float mx = 0.f;
#pragma unroll
        for (int j = 0; j < 4; ++j) { const u32x2 xv = xr[64 * j]; v[j][0] = bf_lo(xv.x); v[j][1] = bf_hi(xv.x); v[j][2] = bf_lo(xv.y); v[j][3] = bf_hi(xv.y);
            mx = fmaxf(mx, fmaxf(fmaxf(fabsf(v[j][0]), fabsf(v[j][1])), fmaxf(fabsf(v[j][2]), fabsf(v[j][3])))); }
        mx = wave_max(mx);
        const float qs = mx > 0.f ? 127.0f / mx : 0.f;
#pragma unroll
        for (int j = 0; j < 4; ++j) ((GAS unsigned*)(ws + WS_XN8 + (size_t)tl * 1024))[64 * j + lane] = pack_i8x4(v[j][0] * qs, v[j][1] * qs, v[j][2] * qs, v[j][3] * qs);
        if (lane == 0) ((GAS float*)(ws + WS_SA8))[tg] = mx * (1.0f / 127.0f);
    }
}

__device__ __forceinline__ void phase_ypass(const DArgs& a, int round, int vcu, int G) {
    const int tid = tid_(), lane = tid & 63, wave = tid >> 6;
    const int gw = vcu * NWAVES + wave, NGW = G * NWAVES;
    GAS unsigned char* ws = a.ws;
    f32x4 mg0[4], mg1[4], gg4[4];
#pragma unroll
    for (int j = 0; j < 4; ++j) { mg0[j] = *(const GAS f32x4*)(a.m_head_g + j * 512 + lane * 8); mg1[j] = *(const GAS f32x4*)(a.m_head_g + j * 512 + lane * 8 + 4); gg4[j] = *(const GAS f32x4*)(a.g_head_g + lane * 16 + 4 * j); }
    for (int tl = gw; tl < RT; tl += NGW) {
        const size_t tg = (size_t)round * RT + tl;
        const f32x4 den4 = *(const f32x4*)((const float*)(ws + WS_DEN) + tg * 4), mt4 = *(const f32x4*)((const float*)(ws + WS_MT) + tg * 4);
        float ym[4][8];
#pragma unroll
        for (int j = 0; j < 4; ++j) {
            const int col = j * 512 + lane * 8;
            const u32x4 nv = *(const u32x4*)((const bf16_t*)(ws + WS_QKPRE) + (size_t)tl * 2048 + col);
            const u32x4 ov = *(const u32x4*)((const bf16_t*)(ws + WS_SIGO) + (size_t)tl * 2048 + col);
            const float inv = 1.0f / fmaxf(fabsf(den4[j]), __expf(-mt4[j]));
            float hv[8] = {bf_lo(nv.x) * inv, bf_hi(nv.x) * inv, bf_lo(nv.y) * inv, bf_hi(nv.y) * inv, bf_lo(nv.z) * inv, bf_hi(nv.z) * inv, bf_lo(nv.w) * inv, bf_hi(nv.w) * inv};
            float ss = 0.f;
#pragma unroll
            for (int e = 0; e < 8; ++e) ss += hv[e] * hv[e];
            const float r = rsqrtf(wave_sum(ss, lane) * (1.f / 512.f) + EPS);
            const f32x4 g0 = mg0[j], g1 = mg1[j];
            const float og[8] = {bf_lo(ov.x), bf_hi(ov.x), bf_lo(ov.y), bf_hi(ov.y), bf_lo(ov.z), bf_hi(ov.z), bf_lo(ov.w), bf_hi(ov.w)};
#pragma unroll
            for (int e = 0; e < 8; ++e) ym[j][e] = og[e] * hv[e] * r * (e < 4 ? g0[e] : g1[e - 4]);
        }
        {
            float mx = 0.f;
#pragma unroll
            for (int j = 0; j < 4; ++j)
#pragma unroll
                for (int e = 0; e < 8; ++e) mx = fmaxf(mx, fabsf(ym[j][e]));
            mx = wave_max(mx);
            const float qs = mx > 0.f ? 127.0f / mx : 0.f;
#pragma unroll
            for (int j = 0; j < 4; ++j) { u32x2 o; o.x = pack_i8x4(ym[j][0] * qs, ym[j][1] * qs, ym[j][2] * qs, ym[j][3] * qs); o.y = pack_i8x4(ym[j][4] * qs, ym[j][5] * qs, ym[j][6] * qs, ym[j][7] * qs);
                *(GAS u32x2*)(ws + WS_V + (size_t)tl * 2048 + j * 512 + lane * 8) = o; }
            if (lane == 0) ((GAS float*)(ws + WS_SYM))[tl] = mx * (1.0f / 127.0f);
        }
        {
            const int col = lane * 16;
            const u32x4 n0 = *(const u32x4*)((const bf16_t*)(ws + WS_GQ) + (size_t)tl * 1024 + col), n1 = *(const u32x4*)((const bf16_t*)(ws + WS_GQ) + (size_t)tl * 1024 + col + 8);
            const u32x4 s0 = *(const u32x4*)((const bf16_t*)(ws + WS_SGG) + (size_t)tl * 1024 + col), s1 = *(const u32x4*)((const bf16_t*)(ws + WS_SGG) + (size_t)tl * 1024 + col + 8);
            float ov[16] = {bf_lo(n0.x), bf_hi(n0.x), bf_lo(n0.y), bf_hi(n0.y), bf_lo(n0.z), bf_hi(n0.z), bf_lo(n0.w), bf_hi(n0.w), bf_lo(n1.x), bf_hi(n1.x), bf_lo(n1.y), bf_hi(n1.y), bf_lo(n1.z), bf_hi(n1.z), bf_lo(n1.w), bf_hi(n1.w)};
            const float sg[16] = {bf_lo(s0.x), bf_hi(s0.x), bf_lo(s0.y), bf_hi(s0.y), bf_lo(s0.z), bf_hi(s0.z), bf_lo(s0.w), bf_hi(s0.w), bf_lo(s1.x), bf_hi(s1.x), bf_lo(s1.y), bf_hi(s1.y), bf_lo(s1.z), bf_hi(s1.z), bf_lo(s1.w), bf_hi(s1.w)};
            float ss = 0.f;
#pragma unroll
            for (int e = 0; e < 16; ++e) ss += ov[e] * ov[e];
            ss += DPP_(ss, 0xB1); ss += DPP_(ss, 0x4E); ss += DPP_(ss, 0x141);
            const float r = rsqrtf(ss * (1.f / 128.f) + EPS);
            float y[16];
#pragma unroll
            for (int e = 0; e < 16; ++e) y[e] = ov[e] * r * gg4[e >> 2][e & 3] * sg[e];
            float mx = 0.f;
#pragma unroll
            for (int e = 0; e < 16; ++e) mx = fmaxf(mx, fabsf(y[e]));
            mx = wave_max(mx);
            const float qs = mx > 0.f ? 127.0f / mx : 0.f;
            u32x4 o; o.x = pack_i8x4(y[0] * qs, y[1] * qs, y[2] * qs, y[3] * qs); o.y = pack_i8x4(y[4] * qs, y[5] * qs, y[6] * qs, y[7] * qs);
            o.z = pack_i8x4(y[8] * qs, y[9] * qs, y[10] * qs, y[11] * qs); o.w = pack_i8x4(y[12] * qs, y[13] * qs, y[14] * qs, y[15] * qs);
            *(GAS u32x4*)(ws + WS_GI + (size_t)tl * 1024 + col) = o;
            if (lane == 0) ((GAS float*)(ws + WS_SYG))[tl] = mx * (1.0f / 127.0f);
        }
    }
}


#define XB_TMO      128
#define XB_XCNT(j)  (256  + 64 * (j))
#define XB_XSUB(j)  (1280 + 64 * (j))
#define XB_XGEN(j)  (2304 + 64 * (j))
#define XB_TOP      3328
#define XB_TOPGEN   3392
#define XB_SPIN_CAP (1u << 22)
constexpr int CW_BAR = 4096;
constexpr int LDS_BARST = LDS_BYTES - 64;
__device__ __forceinline__ unsigned xb_ld(unsigned* p)              { return __hip_atomic_load(p, __ATOMIC_RELAXED, __HIP_MEMORY_SCOPE_AGENT); }
__device__ __forceinline__ unsigned xb_add(unsigned* p, unsigned v) { return __hip_atomic_fetch_add(p, v, __ATOMIC_RELAXED, __HIP_MEMORY_SCOPE_AGENT); }
__device__ __forceinline__ unsigned xb_xcc_id() { return (unsigned)__builtin_amdgcn_s_getreg((3 << 11) | 20) & 0xFu; }
#define XB_SPIN(cond, bar) do { unsigned _sp = 0; while (cond) { __builtin_amdgcn_s_sleep(1); \
    if ((++_sp & 255u) == 0u) { if (xb_ld(&(bar)[XB_TMO])) break; if (_sp > XB_SPIN_CAP) { atomicAdd(&(bar)[XB_TMO], 1u); break; } } } } while (0)
__device__ __forceinline__ void xcd_barrier_post(unsigned* bar, volatile LAS unsigned* st) { if (tid_() == 0) st[2] = xb_add(&bar[XB_XCNT(xb_xcc_id())], 1u); }
__device__ __forceinline__ void xcd_barrier_complete(unsigned* bar, unsigned x, unsigned& nloc, unsigned& nx) {
    const unsigned G = gridDim.x;
    unsigned sum, cnt, mine, sp = 0u;
    for (;;) {
        sum = 0u; cnt = 0u; mine = 0u;
#pragma unroll
        for (unsigned j = 0; j < 16; ++j) { const unsigned c = xb_ld(&bar[XB_XCNT(j)]); sum += c; cnt += (c > 0u) ? 1u : 0u; mine = (j == x) ? c : mine; }
        if (sum == G) break;
        __builtin_amdgcn_s_sleep(1);
        if ((++sp & 255u) == 0u) { if (xb_ld(&bar[XB_TMO])) break; if (sp > XB_SPIN_CAP) { atomicAdd(&bar[XB_TMO], 1u); break; } }
    }
    nloc = mine > 0u ? mine : 1u; nx = cnt > 0u ? cnt : 1u;
}
__device__ __forceinline__ void xcd_barrier(unsigned* bar, volatile LAS unsigned* st) {
    asm volatile("s_waitcnt vmcnt(0)" ::: "memory");
    __syncthreads();
    if (tid_() == 0) {
        const unsigned x = xb_xcc_id();
        __builtin_amdgcn_s_waitcnt(0);
        unsigned nloc = st[0], nx = st[1];
        if (nloc == 0u) { xcd_barrier_complete(bar, x, nloc, nx); st[0] = nloc; st[1] = nx; }
        const unsigned old = xb_add(&bar[XB_XSUB(x)], 1u);
        const unsigned gen = old / nloc;
        if (old + 1u == (gen + 1u) * nloc) {
            __builtin_amdgcn_fence(__ATOMIC_RELEASE, "agent");
            asm volatile("s_waitcnt vmcnt(0)" ::: "memory");
            const unsigned og = xb_add(&bar[XB_TOP], 1u);
            const unsigned tg = og / nx;
            if (og + 1u == (tg + 1u) * nx) xb_add(&bar[XB_TOPGEN], 1u);
            else XB_SPIN(xb_ld(&bar[XB_TOPGEN]) == tg, bar);
            __builtin_amdgcn_fence(__ATOMIC_ACQUIRE, "agent");
            xb_add(&bar[XB_XGEN(x)], 1u);
            asm volatile("s_waitcnt vmcnt(0)" ::: "memory");
        } else {
            XB_SPIN(xb_ld(&bar[XB_XGEN(x)]) == gen, bar);
            __builtin_amdgcn_fence(__ATOMIC_ACQUIRE, "agent");
            asm volatile("s_waitcnt vmcnt(0)" ::: "memory");
        }
    }
    __syncthreads();
}

__device__ __forceinline__ void phase_p8(const DArgs& a, int vcu, int G) {
    const int tid = tid_(), lane = tid & 63, wave = tid >> 6;
    const int gw = vcu * NWAVES + wave, NGW = G * NWAVES;
    GAS unsigned char* ws = a.ws;
    f32x4 g2[4];
#pragma unroll
    for (int j = 0; j < 4; ++j) g2[j] = ((const f32x4*)a.norm2_g)[64 * j + lane];
    for (int m = gw; m < T; m += NGW) {
        const GAS u32x2* xr = (const GAS u32x2*)((const GAS bf16_t*)a.out + (size_t)m * D) + lane;
        f32x4 v[4]; float s = 0.f;
#pragma unroll
        for (int j = 0; j < 4; ++j) { const u32x2 xv = xr[64 * j]; v[j][0] = bf_lo(xv.x); v[j][1] = bf_hi(xv.x); v[j][2] = bf_lo(xv.y); v[j][3] = bf_hi(xv.y); s += (v[j][0] * v[j][0] + v[j][1] * v[j][1]) + (v[j][2] * v[j][2] + v[j][3] * v[j][3]); }
        const float rstd = rsqrtf(wave_sum(s, lane) * (1.f / D) + EPS);
        unsigned long long* o8 = (unsigned long long*)((bf16_t*)(ws + WS_XN) + (size_t)m * D) + lane;
#pragma unroll
        for (int j = 0; j < 4; ++j) { v[j] = v[j] * rstd * g2[j]; o8[64 * j] = (unsigned long long)pk2(v[j][0], v[j][1]) | ((unsigned long long)pk2(v[j][2], v[j][3]) << 32); }
        float mx = 0.f;
#pragma unroll
        for (int j = 0; j < 4; ++j) mx = fmaxf(mx, fmaxf(fmaxf(fabsf(v[j][0]), fabsf(v[j][1])), fmaxf(fabsf(v[j][2]), fabsf(v[j][3]))));
        mx = wave_max(mx);
        const float qs = mx > 0.f ? 127.0f / mx : 0.f;
#pragma unroll
        for (int j = 0; j < 4; ++j) ((GAS unsigned*)(ws + WS_XQ + (size_t)m * 1024))[64 * j + lane] = pack_i8x4(v[j][0] * qs, v[j][1] * qs, v[j][2] * qs, v[j][3] * qs);
        if (lane == 0) ((GAS float*)(ws + WS_XQS))[m] = mx * (1.0f / 127.0f);
    }
    for (int e = gw; e < 16384; e += NGW) {
        f32x4 uv[4], vv[4]; float mu = 0.f, mv = 0.f;
#pragma unroll
        for (int j = 0; j < 4; ++j) { uv[j] = ((const GAS f32x4*)(a.u_emb + (size_t)e * 1024))[64 * j + lane]; vv[j] = ((const GAS f32x4*)(a.v_emb + (size_t)e * 1024))[64 * j + lane];
            mu = fmaxf(mu, fmaxf(fmaxf(fabsf(uv[j][0]), fabsf(uv[j][1])), fmaxf(fabsf(uv[j][2]), fabsf(uv[j][3]))));
            mv = fmaxf(mv, fmaxf(fmaxf(fabsf(vv[j][0]), fabsf(vv[j][1])), fmaxf(fabsf(vv[j][2]), fabsf(vv[j][3])))); }
        mu = wave_max(mu); mv = wave_max(mv);
        const float su = mu > 0.f ? 127.0f / mu : 0.f, sv = mv > 0.f ? 448.0f / mv : 0.f;
        if (lane == 0) { ((GAS float*)(ws + WS_USC))[e] = mu * (1.0f / 127.0f); ((GAS float*)(ws + WS_VSC))[e] = mv * (1.0f / 448.0f); }
#pragma unroll
        for (int j = 0; j < 4; ++j) {
            const size_t ob = (size_t)(2 * j + (lane >> 5)) * 2097152 + (size_t)e * 128 + ((4 * lane) & 127);
            *(GAS unsigned*)(ws + WS_UB + ob) = pack_i8x4(uv[j][0] * su, uv[j][1] * su, uv[j][2] * su, uv[j][3] * su);
            int p = __builtin_amdgcn_cvt_pk_fp8_f32(vv[j][0] * sv, vv[j][1] * sv, 0, false); p = __builtin_amdgcn_cvt_pk_fp8_f32(vv[j][2] * sv, vv[j][3] * sv, p, true);
            *(GAS unsigned*)(ws + WS_VB + ob) = (unsigned)p; }
    }
}

__device__ __forceinline__ unsigned f2ord(float f) { const unsigned u = __builtin_bit_cast(unsigned, f); return (u & 0x80000000u) ? ~u : (u | 0x80000000u); }
__device__ __forceinline__ float ord2f(unsigned k) { const unsigned u = (k & 0x80000000u) ? (k & 0x7fffffffu) : ~k; return __builtin_bit_cast(float, u); }
__device__ __forceinline__ unsigned umax_(unsigned a, unsigned b) { return a > b ? a : b; }
__device__ __forceinline__ unsigned shxu(unsigned v, int o, int lane) { return (unsigned)__builtin_amdgcn_ds_bpermute((lane ^ o) << 2, (int)v); }

__device__ __forceinline__ void phase_topk(const DArgs& a, LAS unsigned char* lds, int bx, int G) {
    const int tid = tid_(), lane = tid & 63, wave = __builtin_amdgcn_readfirstlane(tid >> 6), fr = lane & 15, fq = lane >> 4;
    GAS unsigned char* ws = a.ws;
    const int h = bx & 7;
    LAS unsigned char* KY = lds;
    LAS unsigned char* QL = lds + 2 * 128 * PS_PITCH;
    LAS unsigned* TOP = (LAS unsigned*)(lds + 2 * 128 * PS_PITCH + 64 * PQ_PITCH);
#pragma unroll
    for (int i = 0; i < 8; ++i) { const int idx = tid + 512 * i, row = idx >> 4, ch = idx & 15;
        *(LAS u32x4*)(KY + row * PS_PITCH + ch * 16) = *(const u32x4*)((const bf16_t*)(ws + WS_SK) + ((size_t)h * 256 + row) * 128 + ch * 8); }
    const int ntile = T / 64;
    u32x4 qpre[4];
    { const int tile0 = bx >> 3; if (tile0 < ntile) {
#pragma unroll
        for (int i = 0; i < 4; ++i) { const int idx = tid + 512 * i, row = idx >> 5, ch = idx & 31;
            qpre[i] = *(const GAS u32x4*)((const GAS bf16_t*)(ws + WS_QP) + ((size_t)tile0 * 64 + row) * 2048 + h * 256 + ch * 8); } } }
    __syncthreads();
    for (int tile = bx >> 3; tile < ntile; tile += (G >> 3)) {
        const size_t t0 = (size_t)tile * 64;
        LDS_BAR();
#pragma unroll
        for (int i = 0; i < 4; ++i) { const int idx = tid + 512 * i, row = idx >> 5, ch = idx & 31;
            *(LAS u32x4*)(QL + row * PQ_PITCH + ch * 16) = qpre[i]; }
        { const int tn = tile + (G >> 3); if (tn < ntile) {
#pragma unroll
            for (int i = 0; i < 4; ++i) { const int idx = tid + 512 * i, row = idx >> 5, ch = idx & 31;
                qpre[i] = *(const GAS u32x4*)((const GAS bf16_t*)(ws + WS_QP) + ((size_t)tn * 64 + row) * 2048 + h * 256 + ch * 8); } } }
        LDS_BAR();
        {
            const int mt = wave & 3, p = wave >> 2;
            unsigned key[32];
#pragma unroll
            for (int nt = 0; nt < 8; ++nt) { f32x4 acc = (f32x4){0.f, 0.f, 0.f, 0.f};
#pragma unroll
                for (int ks = 0; ks < 4; ++ks) acc = MFMA16(lfrag(KY + p * 128 * PS_PITCH, PS_PITCH, nt * 16 + fr, ks * 32, fq), lfrag(QL, PQ_PITCH, mt * 16 + fr, p * 128 + ks * 32, fq), acc);
#pragma unroll
                for (int j = 0; j < 4; ++j) { const int n = nt * 16 + 4 * fq + j; key[nt * 4 + j] = (f2ord(acc[j]) & ~127u) | (unsigned)(127 - n); } }
#pragma unroll 1
            for (int k = 0; k < 16; ++k) {
                unsigned t3[11];
#pragma unroll
                for (int e = 0; e < 10; ++e) t3[e] = umax_(umax_(key[3 * e], key[3 * e + 1]), key[3 * e + 2]);
                t3[10] = umax_(key[30], key[31]);
                const unsigned u0 = umax_(umax_(t3[0], t3[1]), t3[2]), u1 = umax_(umax_(t3[3], t3[4]), t3[5]), u2 = umax_(umax_(t3[6], t3[7]), t3[8]), u3 = umax_(t3[9], t3[10]);
                unsigned m = umax_(umax_(u0, u1), umax_(u2, u3));
                m = umax_(m, (unsigned)SWZI_(m, 0x401F)); m = umax_(m, xor32u_(m, lane >= 32));
#pragma unroll
                for (int e = 0; e < 32; ++e) key[e] = (key[e] == m) ? 0u : key[e];
                if (fq == (k & 3)) TOP[(p * 64 + mt * 16 + fr) * 16 + k] = m;
            }
        }
        LDS_BAR();
        {
            const int t = tid >> 3, sub = tid & 7;
            unsigned ck[7];
#pragma unroll
            for (int e = 0; e < 7; ++e) {
                const int ci = sub + 8 * e;
                int i = 0, base = 0; bool ok = ci < 50;
                if (ci >= 42) { i = 8 + (ci - 42); base = ci; } else if (ci >= 40) { i = 7; base = 40; } else if (ci >= 38) { i = 6; base = 38; } else if (ci >= 36) { i = 5; base = 36; }
                else if (ci >= 33) { i = 4; base = 33; } else if (ci >= 29) { i = 3; base = 29; } else if (ci >= 24) { i = 2; base = 24; } else if (ci >= 16) { i = 1; base = 16; }
                const int j = ci - base;
                unsigned kk = 0u;
                if (ok) { const float s0 = ord2f(TOP[(0 * 64 + t) * 16 + i] & ~127u), s1 = ord2f(TOP[(1 * 64 + t) * 16 + j] & ~127u);
                    kk = (f2ord(s0 + s1) & ~255u) | (unsigned)(255 - (i * 16 + j)); }
                ck[e] = kk;
            }
            unsigned w0 = 0u, w1 = 0u;
#pragma unroll 1
            for (int k = 0; k < 16; ++k) {
                unsigned m = umax_(umax_(umax_(ck[0], ck[1]), ck[2]), umax_(umax_(umax_(ck[3], ck[4]), ck[5]), ck[6]));
                m = umax_(m, (unsigned)DPPI_(m, 0xB1)); m = umax_(m, (unsigned)DPPI_(m, 0x4E)); m = umax_(m, (unsigned)DPPI_(m, 0x141));
#pragma unroll
                for (int e = 0; e < 7; ++e) ck[e] = (ck[e] == m) ? 0u : ck[e];
                if (k == sub) w0 = m; if (k == sub + 8) w1 = m;
            }
            const int f0 = 255 - (int)(w0 & 255u), f1 = 255 - (int)(w1 & 255u);
            const float sc0 = ord2f(w0 & ~255u), sc1 = ord2f(w1 & ~255u);
            float mx = fmaxf(sc0, sc1); mx = fmaxf(mx, DPP_(mx, 0xB1)); mx = fmaxf(mx, DPP_(mx, 0x4E)); mx = fmaxf(mx, DPP_(mx, 0x141));
            const float e0 = __expf(sc0 - mx), e1 = __expf(sc1 - mx);
            float sm = e0 + e1; sm += DPP_(sm, 0xB1); sm += DPP_(sm, 0x4E); sm += DPP_(sm, 0x141);
            const float inv = 1.0f / sm;
            const int i0 = 127 - (int)(TOP[(0 * 64 + t) * 16 + (f0 >> 4)] & 127u), j0 = 127 - (int)(TOP[(1 * 64 + t) * 16 + (f0 & 15)] & 127u);
            const int i1 = 127 - (int)(TOP[(0 * 64 + t) * 16 + (f1 >> 4)] & 127u), j1 = 127 - (int)(TOP[(1 * 64 + t) * 16 + (f1 & 15)] & 127u);
            unsigned short* ei = (unsigned short*)(ws + WS_EIDX) + ((t0 + t) * 8 + h) * 16; float* gp = (float*)(ws + WS_GATE) + ((t0 + t) * 8 + h) * 16;
            ei[sub] = (unsigned short)(i0 * 128 + j0); ei[sub + 8] = (unsigned short)(i1 * 128 + j1); gp[sub] = e0 * inv; gp[sub + 8] = e1 * inv;
        }
    }
    __syncthreads();
}

__device__ __forceinline__ void ins16(float (&v)[16], int (&id)[16], float x, int n) {
    if (x > v[15]) { v[15] = x; id[15] = n;
#pragma unroll
        for (int i = 15; i >= 1; --i) { if (v[i] > v[i - 1]) { const float tv = v[i]; v[i] = v[i - 1]; v[i - 1] = tv; const int ti = id[i]; id[i] = id[i - 1]; id[i - 1] = ti; } } }
}
__device__ __forceinline__ void phase_topk_ref(const DArgs& a, int vcu, int G) {
    const int tid = tid_();
    GAS unsigned char* ws = a.ws;
    const int gt = vcu * NTHR + tid, NGT = G * NTHR;
    for (int pair = gt; pair < T * 8; pair += NGT) {
        const int t = pair >> 3, h = pair & 7;
        float sv[2][16]; int si[2][16];
#pragma unroll
        for (int p = 0; p < 2; ++p) {
#pragma unroll
            for (int i = 0; i < 16; ++i) { sv[p][i] = -INFINITY; si[p][i] = 0; }
            const bf16_t* qp = (const bf16_t*)(ws + WS_QP) + (size_t)t * 2048 + h * 256 + p * 128;
            for (int n = 0; n < 128; ++n) {
                const bf16_t* kp = (const bf16_t*)(ws + WS_SK) + ((size_t)(h * 2 + p) * 128 + n) * 128;
                float s = 0.f;
                for (int c = 0; c < 128; c += 8) { const u32x4 qv = *(const u32x4*)(qp + c), kv = *(const u32x4*)(kp + c);
                    s += bf_lo(qv.x) * bf_lo(kv.x) + bf_hi(qv.x) * bf_hi(kv.x) + bf_lo(qv.y) * bf_lo(kv.y) + bf_hi(qv.y) * bf_hi(kv.y)
                       + bf_lo(qv.z) * bf_lo(kv.z) + bf_hi(qv.z) * bf_hi(kv.z) + bf_lo(qv.w) * bf_lo(kv.w) + bf_hi(qv.w) * bf_hi(kv.w); }
                ins16(sv[p], si[p], s, n);
            }
        }
        float tv[16]; int ti[16];
#pragma unroll
        for (int i = 0; i < 16; ++i) { tv[i] = -INFINITY; ti[i] = 0; }
#pragma unroll
        for (int i = 0; i < 16; ++i)
#pragma unroll
            for (int j = 0; j < 16; ++j) ins16(tv, ti, sv[0][i] + sv[1][j], i * 16 + j);
        float sm = 0.f, ex[16];
#pragma unroll
        for (int k = 0; k < 16; ++k) { ex[k] = __expf(tv[k] - tv[0]); sm += ex[k]; }
        int* ei = (int*)(ws + WS_EIDX) + (size_t)pair * 16; float* gp = (float*)(ws + WS_GATE) + (size_t)pair * 16;
#pragma unroll
        for (int k = 0; k < 16; ++k) {
            int e0 = 0, e1 = 0;
#pragma unroll
            for (int i = 0; i < 16; ++i) { e0 = ((ti[k] >> 4) == i) ? si[0][i] : e0; e1 = ((ti[k] & 15) == i) ? si[1][i] : e1; }
            ei[k] = e0 * 128 + e1; gp[k] = ex[k] / sm; }
    }
}

#define FP8LO(w) __builtin_amdgcn_cvt_pk_f32_fp8((int)(w), false)
#define FP8HI(w) __builtin_amdgcn_cvt_pk_f32_fp8((int)(w), true)
__device__ __forceinline__ float dot16_fp8(const u32x4 r, const float (&x)[16]) {
    float c = 0.f;
#pragma unroll
    for (int j = 0; j < 4; ++j) { const f32x2 lo = FP8LO(r[j]), hi = FP8HI(r[j]); c += lo[0] * x[4 * j] + lo[1] * x[4 * j + 1] + hi[0] * x[4 * j + 2] + hi[1] * x[4 * j + 3]; }
    return c;
}
__device__ __forceinline__ float dot16_fp8p(const u32x4 r, const f32x2 (&xp)[8]) {
    f32x2 c2 = (f32x2){0.f, 0.f};
#pragma unroll
    for (int j = 0; j < 4; ++j) { c2 += FP8LO(r[j]) * xp[2 * j]; c2 += FP8HI(r[j]) * xp[2 * j + 1]; }
    return c2[0] + c2[1];
}
__device__ __forceinline__ float gelu_erf(float d) {
    const float ad = fabsf(d), t = __builtin_amdgcn_rcpf(ad * 0.2316418882f + 1.0f);
    float q = t * 0.5307027145f + (-0.7265760135f); q = q * t + 0.7107068705f; q = q * t + (-0.142248368f); q = q * t + 0.127414796f; q = q * t;
    const float m = d * (q * __builtin_amdgcn_exp2f(d * d * (-0.72134752044f)));
    return d < 0.f ? m : d - m;
}
__device__ __forceinline__ float bperm(float v, int srclane) { return __builtin_bit_cast(float, __builtin_amdgcn_ds_bpermute(srclane << 2, __builtin_bit_cast(int, v))); }
#define SWZ_(v, pat) __builtin_bit_cast(float, __builtin_amdgcn_ds_swizzle(__builtin_bit_cast(int, (v)), (pat)))
__device__ __forceinline__ float rs32_(float a, float b) {
#if defined(__HIP_DEVICE_COMPILE__)
    asm volatile("s_nop 1\n\tv_permlane32_swap_b32 %0, %1" : "+v"(a), "+v"(b));
#endif
    return a + b;
}
__device__ __forceinline__ float rs16_(float a, float b) {
#if defined(__HIP_DEVICE_COMPILE__)
    asm volatile("s_nop 1\n\tv_permlane16_swap_b32 %0, %1" : "+v"(a), "+v"(b));
#endif
    return a + b;
}
__device__ __forceinline__ float rs8_(float a, float b, bool bit3) {
    const float send = bit3 ? a : b, keep = bit3 ? b : a;
    return keep + DPP_(send, 0x128);
}
__device__ __forceinline__ float xor32_(float v, bool hi) {
#if defined(__HIP_DEVICE_COMPILE__)
    const auto r = __builtin_amdgcn_permlane32_swap(__builtin_bit_cast(unsigned, v), __builtin_bit_cast(unsigned, v), false, false);
    return __builtin_bit_cast(float, hi ? r[0] : r[1]);
#else
    (void)hi; return v;
#endif
}
__device__ __forceinline__ float reduce8(const float (&p)[8], int lane) {
    float q4[4], q2[2];
    const bool b5 = lane & 32, b4 = lane & 16, b3 = lane & 8;
#pragma unroll
    for (int i = 0; i < 4; ++i) { const float send = b5 ? p[i] : p[i + 4], keep = b5 ? p[i + 4] : p[i]; q4[i] = keep + xor32_(send, b5); }
#pragma unroll
    for (int i = 0; i < 2; ++i) { const float send = b4 ? q4[i] : q4[i + 2], keep = b4 ? q4[i + 2] : q4[i]; q2[i] = keep + SWZ_(send, 0x401F); }
    const float send = b3 ? q2[0] : q2[1], keep = b3 ? q2[1] : q2[0];
    float q1 = keep + SWZ_(send, 0x201F);
    q1 += DPP_(q1, 0xB1); q1 += DPP_(q1, 0x4E); q1 += DPP_(q1, 0x141);
    return q1;
}
__device__ __forceinline__ void phase_udots(const DArgs& a, LAS unsigned char* lds) {
    const int tid = tid_(), lane = tid & 63, wave = __builtin_amdgcn_readfirstlane(tid >> 6);
    GAS unsigned char* ws = a.ws;
    volatile LAS unsigned* bst = (volatile LAS unsigned*)(lds + LDS_BARST);
    const int nloc = (int)bst[0], nx = (int)bst[1], rank = (int)bst[2];
    unsigned* bar = (unsigned*)(ws + WS_CTL) + CW_BAR;
    const unsigned myx = xb_xcc_id();
    int q = 0;
    for (unsigned j = 0; j < 16; ++j) { const unsigned c = xb_ld(&bar[XB_XCNT(j)]); if (c > 0u && j < myx) ++q; }
    LAS int* LE = (LAS int*)(lds + wave * 2048);
    LAS int* LP = LE + 128; LAS float* LG = (LAS float*)(LE + 256);
    const GAS unsigned char* UB = ws + WS_UB;
    const int g8 = lane >> 3;
    const float usc = ((const GAS float*)(ws + WS_USC))[0], vsc = ((const GAS float*)(ws + WS_USC))[1];
    for (int s = q; s < 8; s += nx) {
        int tok = rank * 8 + wave;
        u32x4 xq0 = (u32x4){0u, 0u, 0u, 0u}, xq1 = xq0; u32x2 e2 = (u32x2){0u, 0u}; f32x2 g2 = (f32x2){0.f, 0.f};
#define U_INFO(t_) do { xq0 = *(const u32x4*)((const GAS bf16_t*)(ws + WS_XN) + (size_t)(t_) * D + lane * 16); xq1 = *(const u32x4*)((const GAS bf16_t*)(ws + WS_XN) + (size_t)(t_) * D + lane * 16 + 8); \
        e2 = *(const u32x2*)((const GAS int*)(ws + WS_EIDX) + (size_t)(t_) * 128 + 2 * lane); g2 = *(const f32x2*)((const GAS float*)(ws + WS_GATE) + (size_t)(t_) * 128 + 2 * lane); } while (0)
        if (tok < T) U_INFO(tok);
        for (; tok < T; tok += nloc * 8) {
            const bool in0 = (int)(e2.x >> 11) == s, in1 = (int)(e2.y >> 11) == s;
            const unsigned long long m0 = __ballot(in0), m1 = __ballot(in1);
            const unsigned long long lt = (1ull << lane) - 1ull;
            const int n0 = __popcll(m0), n = n0 + __popcll(m1);
            if (in0) { const int pos = __popcll(m0 & lt); LE[pos] = (int)e2.x; LP[pos] = 2 * lane; LG[pos] = g2[0]; }
            if (in1) { const int pos = n0 + __popcll(m1 & lt); LE[pos] = (int)e2.y; LP[pos] = 2 * lane + 1; LG[pos] = g2[1]; }
            const float xf[16] = {bf_lo(xq0.x), bf_hi(xq0.x), bf_lo(xq0.y), bf_hi(xq0.y), bf_lo(xq0.z), bf_hi(xq0.z), bf_lo(xq0.w), bf_hi(xq0.w),
                                  bf_lo(xq1.x), bf_hi(xq1.x), bf_lo(xq1.y), bf_hi(xq1.y), bf_lo(xq1.z), bf_hi(xq1.z), bf_lo(xq1.w), bf_hi(xq1.w)};
            asm volatile("s_waitcnt lgkmcnt(0)" ::: "memory");
            u32x4 R0[8], R1[8], R2[8];
#define U_ISSUE(R_, g0_) do { _Pragma("unroll") for (int k = 0; k < 8; ++k) { const int slot_ = ((g0_) + k < n) ? (g0_) + k : n - 1; const int e_ = LE[slot_]; R_[k] = *(const u32x4*)(UB + (size_t)e_ * 1024 + lane * 16); } } while (0)
#define U_DOTS(R_, g0_) do { float pp_[8]; _Pragma("unroll") for (int k = 0; k < 8; ++k) pp_[k] = dot16_fp8(R_[k], xf); const float dsum_ = reduce8(pp_, lane); const int slot_ = (g0_) + g8; \
            if (slot_ < n && (lane & 7) == 0) { const float d_ = dsum_ * usc; \
                ((GAS float*)(ws + WS_PW))[(size_t)tok * 128 + LP[slot_]] = 0.5f * d_ * (1.0f + erff(d_ * 0.70710678118654752f)) * LG[slot_] * vsc; } } while (0)
            if (n > 0) U_ISSUE(R0, 0);
            if (n > 8) U_ISSUE(R1, 8);
            if (n > 16) U_ISSUE(R2, 16);
            const int tokN = tok + nloc * 8;
            if (tokN < T) U_INFO(tokN);
            if (n > 0) U_DOTS(R0, 0);
            if (n > 8) U_DOTS(R1, 8);
            if (n > 16) U_DOTS(R2, 16);
            for (int g0 = 24; g0 < n; g0 += 8) { U_ISSUE(R0, g0); U_DOTS(R0, g0); }
            asm volatile("s_waitcnt lgkmcnt(0)" ::: "memory");
        }
#undef U_INFO
#undef U_ISSUE
#undef U_DOTS
    }
}

#define EV_OFF(ev_, g_) (((g_) & 1) ? ((ev_[(g_) >> 3][((g_) >> 1) & 3] >> 9) & 0x7fff80u) : ((ev_[(g_) >> 3][((g_) >> 1) & 3] << 7) & 0x7fff80u))
struct XcdSlice { int nloc, nx, rank, q; };
__device__ __forceinline__ XcdSlice xcd_slice_setup(const DArgs& a, LAS unsigned char* lds) {
    volatile LAS unsigned* bst = (volatile LAS unsigned*)(lds + LDS_BARST);
    XcdSlice x; x.nloc = __builtin_amdgcn_readfirstlane((int)bst[0]); x.nx = __builtin_amdgcn_readfirstlane((int)bst[1]); x.rank = __builtin_amdgcn_readfirstlane((int)bst[2]);
    unsigned* bar = (unsigned*)(a.ws + WS_CTL) + CW_BAR; const unsigned myx = xb_xcc_id();
    x.q = 0; for (unsigned j = 0; j < 16; ++j) { const unsigned c = xb_ld(&bar[XB_XCNT(j)]); if (c > 0u && j < myx) ++x.q; }
    x.q = __builtin_amdgcn_readfirstlane(x.q);
    return x;
}
__device__ __forceinline__ void phase_ua(const DArgs& a, LAS unsigned char* lds) {
    const int tid = tid_(), lane = tid & 63, wave = __builtin_amdgcn_readfirstlane(tid >> 6), k = lane >> 3, c = lane & 7;
    GAS unsigned char* ws = a.ws;
    const XcdSlice X = xcd_slice_setup(a, lds);
    const int tstride = X.nloc * 8;
    for (int sl = X.q; sl < 8; sl += X.nx) {
        const GAS unsigned char* UBs = ws + WS_UB + (size_t)sl * 2097152;
        const unsigned coff = (unsigned)c * 16u;
        GAS unsigned char* PU = ws + WS_PARTU + (size_t)sl * T * 256;
        u32x4 evA[2], evB[2], RA[16], RB[16], xa, xb; float sa, sb;
#define A_TOK(t_) ((t_) < T ? (t_) : T - 1)
#define A_INFO(ev_, t_) do { const int tq_ = A_TOK(t_); _Pragma("unroll") for (int j_ = 0; j_ < 2; ++j_) ev_[j_] = *(const GAS u32x4*)(ws + WS_EIDX + (size_t)tq_ * 256 + (unsigned)(32 * k + 16 * j_)); } while (0)
#define A_ISSUE(R_, x_, s_, ev_, t_) do { const int tq_ = A_TOK(t_); _Pragma("unroll") for (int g_ = 0; g_ < 16; ++g_) R_[g_] = *(const GAS u32x4*)(UBs + (EV_OFF(ev_, g_) | coff)); \
        x_ = *(const GAS u32x4*)(ws + WS_XQ + (size_t)tq_ * 1024 + sl * 128 + coff); s_ = ((const GAS float*)(ws + WS_XQS))[tq_]; } while (0)
#define A_DOTS(R_, x_, s_, t_) do { \
        int ir0_ = 0, ir1_ = 0; \
        _Pragma("unroll") for (int gg_ = 0; gg_ < 4; ++gg_) {           \
            int d_[4]; _Pragma("unroll") for (int q_ = 0; q_ < 4; ++q_) d_[q_] = 0; \
            _Pragma("unroll") for (int j_ = 0; j_ < 4; ++j_) { _Pragma("unroll") for (int q_ = 0; q_ < 4; ++q_) d_[q_] = __builtin_amdgcn_sdot4((int)R_[4 * gg_ + q_][j_], (int)x_[j_], d_[q_], false); } \
            _Pragma("unroll") for (int q_ = 0; q_ < 4; ++q_) d_[q_] += DPPI_(d_[q_], 0xB1); \
            _Pragma("unroll") for (int q_ = 0; q_ < 4; ++q_) d_[q_] += DPPI_(d_[q_], 0x4E); \
            _Pragma("unroll") for (int q_ = 0; q_ < 4; ++q_) d_[q_] += DPPI_(d_[q_], 0x141);          \
            _Pragma("unroll") for (int q_ = 0; q_ < 4; ++q_) { if (c == ((4 * gg_ + q_) >> 1)) { if (q_ & 1) ir1_ = d_[q_]; else ir0_ = d_[q_]; } }          \
            __builtin_amdgcn_sched_barrier(0); } \
        if ((t_) < T) *(GAS unsigned*)(PU + (size_t)(t_) * 256 + (unsigned)(4 * lane)) = pk2((float)ir0_ * s_, (float)ir1_ * s_); } while (0)
        const int n0 = X.rank * 8 + wave;
        A_INFO(evA, n0); A_INFO(evB, n0 + tstride);
        __builtin_amdgcn_sched_barrier(0);
        A_ISSUE(RA, xa, sa, evA, n0);
        __builtin_amdgcn_sched_barrier(0);
#pragma unroll 1
        for (int n = n0; n < T; n += 2 * tstride) {
            A_INFO(evA, n + 2 * tstride);
            __builtin_amdgcn_sched_barrier(0);
            A_ISSUE(RB, xb, sb, evB, n + tstride);
            __builtin_amdgcn_sched_barrier(0);
            A_DOTS(RA, xa, sa, n);
            __builtin_amdgcn_sched_barrier(0);
            A_INFO(evB, n + 3 * tstride);
            __builtin_amdgcn_sched_barrier(0);
            A_ISSUE(RA, xa, sa, evA, n + 2 * tstride);
            __builtin_amdgcn_sched_barrier(0);
            A_DOTS(RB, xb, sb, n + tstride);
            __builtin_amdgcn_sched_barrier(0);
        }
#undef A_TOK
#undef A_INFO
#undef A_ISSUE
#undef A_DOTS
    }
}
__device__ __forceinline__ void phase_ua2(const DArgs& a, int vcu, int G) {
    const int tid = tid_();
    GAS unsigned char* ws = a.ws;
    const GAS float* USC = (const GAS float*)(ws + WS_USC); const GAS float* VSC = (const GAS float*)(ws + WS_VSC);
    const GAS unsigned char* PU = ws + WS_PARTU;
    const size_t N4 = (size_t)T * 128 / 4, stride = (size_t)G * NTHR;
    for (size_t i = (size_t)vcu * NTHR + tid; i < N4; i += 2 * stride) {
        const size_t i1 = (i + stride < N4) ? i + stride : i;
        u32x2 pv0[8], pv1[8];
#pragma unroll
        for (int sl = 0; sl < 8; ++sl) { pv0[sl] = ((const GAS u32x2*)(PU + (size_t)sl * T * 256))[i]; pv1[sl] = ((const GAS u32x2*)(PU + (size_t)sl * T * 256))[i1]; }
        const f32x4 gt0 = ((const GAS f32x4*)(ws + WS_GATE))[i], gt1 = ((const GAS f32x4*)(ws + WS_GATE))[i1];
        const u32x2 ep0 = ((const GAS u32x2*)(ws + WS_EIDX))[i], ep1 = ((const GAS u32x2*)(ws + WS_EIDX))[i1];
        const unsigned e0[4] = {ep0.x & 0xffffu, ep0.x >> 16, ep0.y & 0xffffu, ep0.y >> 16}, e1[4] = {ep1.x & 0xffffu, ep1.x >> 16, ep1.y & 0xffffu, ep1.y >> 16};
        float us0[4], vs0[4], us1[4], vs1[4];
#pragma unroll
        for (int e = 0; e < 4; ++e) { us0[e] = USC[e0[e]]; vs0[e] = VSC[e0[e]]; us1[e] = USC[e1[e]]; vs1[e] = VSC[e1[e]]; }
        f32x4 d0 = (f32x4){0.f, 0.f, 0.f, 0.f}, d1 = d0;
#pragma unroll
        for (int sl = 0; sl < 8; ++sl) { d0[0] += bf_lo(pv0[sl].x); d0[1] += bf_hi(pv0[sl].x); d0[2] += bf_lo(pv0[sl].y); d0[3] += bf_hi(pv0[sl].y);
                                         d1[0] += bf_lo(pv1[sl].x); d1[1] += bf_hi(pv1[sl].x); d1[2] += bf_lo(pv1[sl].y); d1[3] += bf_hi(pv1[sl].y); }
        f32x4 w0, w1;
#pragma unroll
        for (int e = 0; e < 4; ++e) { w0[e] = gelu_erf(d0[e] * us0[e]) * gt0[e] * vs0[e]; w1[e] = gelu_erf(d1[e] * us1[e]) * gt1[e] * vs1[e]; }
        u32x2 wo; wo.x = pk2(w0[0], w0[1]); wo.y = pk2(w0[2], w0[3]); ((GAS u32x2*)(ws + WS_PW))[i] = wo;
        if (i + stride < N4) { wo.x = pk2(w1[0], w1[1]); wo.y = pk2(w1[2], w1[3]); ((GAS u32x2*)(ws + WS_PW))[i1] = wo; }
    }
}
__device__ __forceinline__ void phase_vb(const DArgs& a, LAS unsigned char* lds) {
    const int tid = tid_(), lane = tid & 63, wave = __builtin_amdgcn_readfirstlane(tid >> 6), k = lane >> 3, c = lane & 7;
    GAS unsigned char* ws = a.ws;
    const XcdSlice X = xcd_slice_setup(a, lds);
    const int tstride = X.nloc * 8;
    const bool bit3 = (lane & 8) != 0;
    for (int sl = X.q; sl < 8; sl += X.nx) {
        const GAS unsigned char* VBs = ws + WS_VB + (size_t)sl * 2097152;
        const unsigned coff = (unsigned)c * 16u;
        const unsigned xoff = (unsigned)(sl * 128 + c * 16 + 2 * k) * 4u;
        u32x4 evA[2], evB[2], RA[16], RB[16], wa[2], wb[2]; unsigned xa, xb;
#define B_TOK(t_) ((t_) < T ? (t_) : T - 1)
#define B_INFO(ev_, t_) do { const int tq_ = B_TOK(t_); _Pragma("unroll") for (int j_ = 0; j_ < 2; ++j_) ev_[j_] = *(const GAS u32x4*)(ws + WS_EIDX + (size_t)tq_ * 256 + (unsigned)(32 * k + 16 * j_)); } while (0)
#define B_ISSUE(R_, w_, x_, ev_, t_) do { const int tq_ = B_TOK(t_); _Pragma("unroll") for (int g_ = 0; g_ < 16; ++g_) R_[g_] = *(const GAS u32x4*)(VBs + (EV_OFF(ev_, g_) | coff)); \
        _Pragma("unroll") for (int j_ = 0; j_ < 2; ++j_) w_[j_] = *(const GAS u32x4*)(ws + WS_PW + (size_t)tq_ * 256 + (unsigned)(32 * k + 16 * j_)); \
        x_ = *(const GAS unsigned*)((const GAS unsigned char*)a.out + (size_t)tq_ * (D * 2) + (xoff >> 1)); } while (0)
#define B_DOTS(R_, w_, x_, t_) do { \
        f32x2 acc2_[8]; _Pragma("unroll") for (int e_ = 0; e_ < 8; ++e_) acc2_[e_] = (f32x2){0.f, 0.f}; \
        _Pragma("unroll") for (int g_ = 0; g_ < 16; ++g_) { const unsigned ww_ = w_[g_ >> 3][(g_ >> 1) & 3]; const float wk_ = (g_ & 1) ? bf_hi(ww_) : bf_lo(ww_); const f32x2 wp_ = (f32x2){wk_, wk_}; \
            _Pragma("unroll") for (int jj_ = 0; jj_ < 4; ++jj_) { acc2_[2 * jj_] += wp_ * FP8LO(R_[g_][jj_]); acc2_[2 * jj_ + 1] += wp_ * FP8HI(R_[g_][jj_]); } \
            if (g_ & 1) __builtin_amdgcn_sched_barrier(0); } \
        f32x2 w2_[4], x2_[2], y_; \
        _Pragma("unroll") for (int i_ = 0; i_ < 4; ++i_) { w2_[i_][0] = rs32_(acc2_[i_][0], acc2_[i_ + 4][0]); w2_[i_][1] = rs32_(acc2_[i_][1], acc2_[i_ + 4][1]); } \
        _Pragma("unroll") for (int i_ = 0; i_ < 2; ++i_) { x2_[i_][0] = rs16_(w2_[i_][0], w2_[i_ + 2][0]); x2_[i_][1] = rs16_(w2_[i_][1], w2_[i_ + 2][1]); } \
        y_[0] = rs8_(x2_[0][0], x2_[1][0], bit3) + bf_lo(x_); y_[1] = rs8_(x2_[0][1], x2_[1][1], bit3) + bf_hi(x_); \
        const float ss_ = wave_sum(y_[0] * y_[0] + y_[1] * y_[1], lane); \
        if ((t_) < T) { *(GAS unsigned*)(ws + WS_PARTU + (size_t)(t_) * (D * 2) + (xoff >> 1)) = pk2(y_[0], y_[1]);       \
            if (lane == 0) ((GAS float*)(ws + WS_SS))[(size_t)(t_) * 8 + sl] = ss_; } } while (0)
        const int n0 = X.rank * 8 + wave;
        B_INFO(evA, n0); B_INFO(evB, n0 + tstride);
        __builtin_amdgcn_sched_barrier(0);
        B_ISSUE(RA, wa, xa, evA, n0);
        __builtin_amdgcn_sched_barrier(0);
#pragma unroll 1
        for (int n = n0; n < T; n += 2 * tstride) {
            B_INFO(evA, n + 2 * tstride);
            __builtin_amdgcn_sched_barrier(0);
            B_ISSUE(RB, wb, xb, evB, n + tstride);
            __builtin_amdgcn_sched_barrier(0);
            B_DOTS(RA, wa, xa, n);
            __builtin_amdgcn_sched_barrier(0);
            B_INFO(evB, n + 3 * tstride);
            __builtin_amdgcn_sched_barrier(0);
            B_ISSUE(RA, wa, xa, evA, n + 2 * tstride);
            __builtin_amdgcn_sched_barrier(0);
            B_DOTS(RB, wb, xb, n + tstride);
            __builtin_amdgcn_sched_barrier(0);
        }
#undef B_TOK
#undef B_INFO
#undef B_ISSUE
#undef B_DOTS
    }
}
__device__ __forceinline__ void phase_vc(const DArgs& a, int vcu, int G) {
    const int tid = tid_(), lane = tid & 63, wave = tid >> 6;
    const int gw = vcu * NWAVES + wave, NGW = G * NWAVES;
    GAS unsigned char* ws = a.ws;
    f32x4 gf[4];
#pragma unroll
    for (int j = 0; j < 4; ++j) gf[j] = ((const GAS f32x4*)a.final_g)[64 * j + lane];
    for (int m = gw; m < T; m += NGW) {
        const f32x4 s0 = *(const GAS f32x4*)((const GAS float*)(ws + WS_SS) + (size_t)m * 8), s1 = *(const GAS f32x4*)((const GAS float*)(ws + WS_SS) + (size_t)m * 8 + 4);
        const float rstd = rsqrtf(((s0[0] + s0[1]) + (s0[2] + s0[3]) + (s1[0] + s1[1]) + (s1[2] + s1[3])) * (1.f / D) + EPS);
        const GAS u32x2* xi = (const GAS u32x2*)(ws + WS_PARTU + (size_t)m * (D * 2)) + lane;
        GAS f32x4* o = (GAS f32x4*)(a.out + (size_t)m * D) + lane;
#pragma unroll
        for (int j = 0; j < 4; ++j) { const u32x2 xv = xi[64 * j]; f32x4 v; v[0] = bf_lo(xv.x); v[1] = bf_hi(xv.x); v[2] = bf_lo(xv.y); v[3] = bf_hi(xv.y); o[64 * j] = v * rstd * gf[j]; }
    }
}

__device__ __forceinline__ void phase_final_plain(const DArgs& a, const float* src, int vcu, int G) {
    const int tid = tid_(), lane = tid & 63, wave = tid >> 6;
    const int gw = vcu * NWAVES + wave, NGW = G * NWAVES;
    f32x4 gf[4];
#pragma unroll
    for (int j = 0; j < 4; ++j) gf[j] = ((const f32x4*)a.final_g)[64 * j + lane];
    for (int m = gw; m < T; m += NGW) {
        const f32x4* xr = (const f32x4*)(src + (size_t)m * D) + lane;
        f32x4 v[4]; float s = 0.f;
#pragma unroll
        for (int j = 0; j < 4; ++j) { v[j] = xr[64 * j]; s += (v[j][0] * v[j][0] + v[j][1] * v[j][1]) + (v[j][2] * v[j][2] + v[j][3] * v[j][3]); }
        const float rstd = rsqrtf(wave_sum(s, lane) * (1.f / D) + EPS);
        f32x4* o = (f32x4*)(a.out + (size_t)m * D) + lane;
#pragma unroll
        for (int j = 0; j < 4; ++j) o[64 * j] = v[j] * rstd * gf[j];
    }
}


__device__ __forceinline__ DArgs load_args() {
    DArgs r;
#if defined(__HIP_DEVICE_COMPILE__)
    typedef const DArgs __attribute__((address_space(4))) KArgs;
    KArgs* p = (KArgs*)__builtin_amdgcn_kernarg_segment_ptr();
    asm volatile("" : "+s"(p));
    r.x = p->x; r.norm1_g = p->norm1_g; r.w_in = p->w_in; r.b_in = p->b_in; r.conv_w = p->conv_w; r.conv_b = p->conv_b; r.m_head_g = p->m_head_g; r.lb_table = p->lb_table;
    r.g_head_g = p->g_head_g; r.w_br_m = p->w_br_m; r.w_br_g = p->w_br_g; r.w_out = p->w_out; r.norm2_g = p->norm2_g; r.w_pq = p->w_pq; r.sub_keys = p->sub_keys;
    r.u_emb = p->u_emb; r.v_emb = p->v_emb; r.final_g = p->final_g; r.out = p->out; r.ws = p->ws;
#else
    r = DArgs{};
#endif
    return r;
}
__device__ __forceinline__ EpiPtrs make_ep(const DArgs& a, int round) {
    EpiPtrs ep; ep.biasp = (const GAS float*)(a.ws + WS_BIASP); ep.lb = (const GAS float*)(a.ws + WS_LB); ep.x = a.x; ep.out = a.out; ep.ws = a.ws; ep.round = round; ep.sa = (const GAS float*)(a.ws + WS_SA8); ep.sb = (const GAS float*)(a.ws + WS_SB8); ep.sym = (const GAS float*)(a.ws + WS_SYM); ep.syg = (const GAS float*)(a.ws + WS_SYG); return ep;
}
#define GRID_SYNC() do { const DArgs a_ = load_args(); xcd_barrier((unsigned*)(a_.ws + WS_CTL) + CW_BAR, (volatile LAS unsigned*)(lds + LDS_BARST)); } while (0)

__device__ __forceinline__ int bx_() { int t = blockIdx.x; asm volatile("" : "+s"(t)); return t; }
__device__ __forceinline__ int gd_() { int t = gridDim.x; asm volatile("" : "+s"(t)); return t; }
#define PH_BEGIN const DArgs a = load_args(); const int bx = bx_(), G = gd_(); const int vcu = (G % 8 == 0) ? (bx % 8) * (G / 8) + bx / 8 : bx; (void)vcu; (void)bx;

__global__ void __launch_bounds__(NTHR, 2) fwd_megakernel(Args a_unused) {
    extern __shared__ __attribute__((aligned(16))) unsigned char lds_raw[];
    LAS unsigned char* lds = (LAS unsigned char*)lds_raw;
    cg::grid_group grid = cg::this_grid();

    { const int t_ = tid_(); if (t_ < 16) ((LAS unsigned*)(lds + LDS_BARST))[t_] = 0u; __syncthreads();
      const DArgs a_ = load_args(); xcd_barrier_post((unsigned*)(a_.ws + WS_CTL) + CW_BAR, (volatile LAS unsigned*)(lds + LDS_BARST)); }
    { PH_BEGIN phase_p0(a, lds, vcu, G); }
    grid.sync();
    { PH_BEGIN phase_p0c(a, lds, vcu, G); }
    GRID_SYNC();
#pragma unroll 1
    for (int round = 0; round < NROUND; ++round) {
        {
            PH_BEGIN
            pg8::Gemm g{(const bf16_t*)(a.ws + WS_XN8 + (size_t)round * RT * 1024), (const bf16_t*)(a.ws + WS_W8A), RT, N1, D / 2};
            pg8::StaticOrder S; S.init(RT, N1, G, bx);
            EpiX<7> E{make_ep(a, round)};
            pg8::gemm_phase<EpiX<7>, pg8::StaticOrder, true, true, true>(lds, g, S, E);
        }
        { PH_BEGIN if (bx < 8) mscan_pair(a, lds, round, bx); }
        GRID_SYNC();
        { PH_BEGIN for (int it = bx; it < 512; it += G) mlstm_pre_item(a, lds, round, it); }
        { PH_BEGIN u32x4 gq[4]; int it = bx; if (it < 2048) hgrn_pre_load(a, round, it, gq);
          for (; it < 2048; it += G) hgrn_pre_item(a, lds, round, it, gq, it + G); }
        GRID_SYNC();
        { PH_BEGIN
          if (bx < 128) mlstm_scan<2, false>(a, lds, round, bx & 7, bx >> 3);
          else if (bx >= 192 && bx < 200) mlstm_scan<1, true>(a, lds, round, bx - 192, 0);
          else if (bx < 192) { const int id2 = bx - 128; hgrn_scan(a, lds, round, (id2 & 7) * 2 + ((id2 >> 3) & 1), id2 >> 4); } }
        GRID_SYNC();
        {
            PH_BEGIN
            pg8::Gemm g{(const bf16_t*)(a.ws + WS_XN8 + (size_t)round * RT * 1024), (const bf16_t*)(a.ws + WS_W8), RT, N2, D / 2};
            pg8::StaticOrder S; S.init(RT, N2, G, bx);
            EpiX<2> E{make_ep(a, round)};
            pg8::gemm_phase<EpiX<2>, pg8::StaticOrder, true, true, true>(lds, g, S, E);
        }
        GRID_SYNC();
        { PH_BEGIN phase_ypass(a, round, vcu, G); }
        GRID_SYNC();
        {
            { PH_BEGIN pg8::StaticOrder S; S.init(RT, D, G, bx);
              pg8::Gemm g{(const bf16_t*)(a.ws + WS_V), (const bf16_t*)(a.ws + WS_WM), RT, D, 2048 / 2}; EpiX<3> E{make_ep(a, round)}; pg8::gemm_phase<EpiX<3>, pg8::StaticOrder, true, true, true>(lds, g, S, E); }
            { PH_BEGIN pg8::StaticOrder S; S.init(RT, D, G, bx);
              pg8::Gemm g{(const bf16_t*)(a.ws + WS_GI), (const bf16_t*)(a.ws + WS_WG), RT, D, D / 2}; EpiX<4> E{make_ep(a, round)}; pg8::gemm_phase<EpiX<4>, pg8::StaticOrder, true, true, true>(lds, g, S, E); }
        }
        GRID_SYNC();
        {
            PH_BEGIN pg8::StaticOrder S; S.init(RT, D, G, bx);
            pg8::Gemm g{(const bf16_t*)(a.ws + WS_GFLOG), (const bf16_t*)(a.ws + WS_WO), RT, D, D}; EpiX<5> E{make_ep(a, round)}; pg8::gemm_phase<EpiX<5>, pg8::StaticOrder, true, true>(lds, g, S, E);
        }
        GRID_SYNC();
    }
    { PH_BEGIN phase_p8(a, vcu, G); }
    GRID_SYNC();
    {
        PH_BEGIN pg8::StaticOrder S; S.init(T, 2048, G, bx);
        pg8::Gemm g{(const bf16_t*)(a.ws + WS_XN), (const bf16_t*)(a.ws + WS_WPQ), T, 2048, D}; EpiX<6> E{make_ep(a, 0)}; pg8::gemm_phase<EpiX<6>, pg8::StaticOrder, true, true>(lds, g, S, E);
    }
    GRID_SYNC();
#ifdef TOPK_REF
    { PH_BEGIN phase_topk_ref(a, vcu, G); }
#else
    { PH_BEGIN phase_topk(a, lds, bx, G); }
#endif
    GRID_SYNC();
    { PH_BEGIN phase_ua(a, lds); }
    GRID_SYNC();
    { PH_BEGIN phase_ua2(a, vcu, G); }
    GRID_SYNC();
    { PH_BEGIN phase_vb(a, lds); }
    GRID_SYNC();
    { PH_BEGIN phase_vc(a, vcu, G); }
}

extern "C" void kernel_launch(void* const* d_in, const int* in_sizes, int n_in, void* d_out, int out_size, void* d_ws, size_t ws_size, hipStream_t stream) {
    static int grid = 0;
    if (grid == 0) {
        if (n_in != 18 || in_sizes[0] != T * D || out_size != T * D || ws_size < WS_END) {
            fprintf(stderr, "kernel_launch: unexpected shapes/workspace (n_in %d, in0 %d, out %d, ws %zu, need %zu)\n", n_in, n_in > 0 ? in_sizes[0] : -1, out_size, ws_size, (size_t)WS_END);
            grid = -1; return; }
        int dev = 0, cus = 0, per_cu = 0;
        hipGetDevice(&dev);
        hipDeviceGetAttribute(&cus, hipDeviceAttributeMultiprocessorCount, dev);
        hipFuncSetAttribute((const void*)fwd_megakernel, hipFuncAttributeMaxDynamicSharedMemorySize, LDS_BYTES);
        hipOccupancyMaxActiveBlocksPerMultiprocessor(&per_cu, (const void*)fwd_megakernel, NTHR, LDS_BYTES);
        if (per_cu < 1) { fprintf(stderr, "kernel_launch: occupancy query says %d blocks/CU\n", per_cu); per_cu = 1; }
        grid = cus;
        (void)hipGetLastError();
    }
    if (grid < 0) return;
    hipMemsetAsync((char*)d_ws + WS_CTL, 0, 131072, stream);
    Args a{};
    a.x = (const float*)d_in[0]; a.norm1_g = (const float*)d_in[1]; a.w_in = (const float*)d_in[2]; a.b_in = (const float*)d_in[3];
    a.conv_w = (const float*)d_in[4]; a.conv_b = (const float*)d_in[5]; a.m_head_g = (const float*)d_in[6]; a.lb_table = (const float*)d_in[7];
    a.g_head_g = (const float*)d_in[8]; a.w_br_m = (const float*)d_in[9]; a.w_br_g = (const float*)d_in[10]; a.w_out = (const float*)d_in[11];
    a.norm2_g = (const float*)d_in[12]; a.w_pq = (const float*)d_in[13]; a.sub_keys = (const float*)d_in[14]; a.u_emb = (const float*)d_in[15];
    a.v_emb = (const float*)d_in[16]; a.final_g = (const float*)d_in[17];
    a.out = (float*)d_out; a.ws = (unsigned char*)d_ws;
    void* args[] = {&a};
    hipError_t e = hipLaunchCooperativeKernel((const void*)fwd_megakernel, dim3(grid), dim3(NTHR), args, LDS_BYTES, stream);
    if (e != hipSuccess) fprintf(stderr, "cooperative launch failed: %s (grid %d)\n", hipGetErrorString(e), grid);
}
```

```cpp
#include <hip/hip_runtime.h>
#include <hip/hip_cooperative_groups.h>
#include <cstdio>
#include <cstdint>
namespace cg = cooperative_groups;

#define LAS __attribute__((address_space(3)))
typedef unsigned short bf16_t;
typedef short bf16x8 __attribute__((ext_vector_type(8)));
typedef float f32x4 __attribute__((ext_vector_type(4)));
typedef float f32x2 __attribute__((ext_vector_type(2)));
typedef unsigned u32x4 __attribute__((ext_vector_type(4)));
typedef unsigned u32x2 __attribute__((ext_vector_type(2)));

constexpr int D = 1024, BATCH = 4, SEQ = 8192, T = BATCH * SEQ;
constexpr int IN_COLS = 12296, NP = 12288;
constexpr int RT = 16384, NROUND = 2;
constexpr int N1 = 7168, N2 = 5120;
constexpr float EPS = 1e-6f;
constexpr int NWAVES = 8, NTHR = 512;

constexpr size_t MiB = 1u << 20;
constexpr size_t WS_CTL = 0;
constexpr size_t WS_WIN = 1 * MiB;
constexpr size_t WS_WM = 25 * MiB;
constexpr size_t WS_WG = 29 * MiB;
constexpr size_t WS_WO = 31 * MiB;
constexpr size_t WS_WPQ = 33 * MiB;
constexpr size_t WS_SK = 37 * MiB;
constexpr size_t WS_BIASP = 37 * MiB + 512 * 1024;
constexpr size_t WS_LB = WS_BIASP + 64 * 1024;
constexpr size_t WS_GATES = 38 * MiB;
constexpr size_t WS_MPREV = 39 * MiB;
constexpr size_t WS_DEN = 40 * MiB;
constexpr size_t WS_MT = 40 * MiB + 512 * 1024;
constexpr size_t WS_HGDEC = 41 * MiB;
constexpr size_t WS_MDEC = 43 * MiB;
constexpr size_t WS_XN = 44 * MiB;
constexpr size_t WS_QKPRE = 108 * MiB;
constexpr size_t WS_V = 172 * MiB;
constexpr size_t WS_GFLOG = 236 * MiB;
constexpr size_t WS_GI = 268 * MiB;
constexpr size_t WS_GQ = 300 * MiB;
constexpr size_t WS_S = 332 * MiB;
constexpr size_t WS_QT = 348 * MiB;
constexpr size_t WS_KWT = 380 * MiB;
constexpr size_t WS_ATT = 412 * MiB;
constexpr size_t WS_QTG = 428 * MiB;
constexpr size_t WS_KENDT = 460 * MiB;
constexpr size_t WS_SIGO = 332 * MiB;
constexpr size_t WS_SGG = 396 * MiB;
constexpr size_t WS_SAM = 428 * MiB;
constexpr size_t WS_SAG = 460 * MiB;
constexpr size_t WS_XN8 = 44 * MiB;
constexpr size_t WS_SA8 = 508 * MiB;
constexpr size_t WS_SB8 = 508 * MiB + 262144;
constexpr size_t WS_W8A = WS_WIN;
constexpr size_t WS_W8 = WS_WIN + (size_t)7168 * 1024;
constexpr int NI8 = 12288 + 1024 + 1024 + 2048;
constexpr size_t WS_SYM = 508 * MiB + 524288;
constexpr size_t WS_SYG = 508 * MiB + 655360;
constexpr int CW_COLMAX = 16384;
constexpr size_t WS_END = 510 * MiB;
constexpr size_t WS_QP = 108 * MiB;
constexpr size_t WS_UB = 236 * MiB;
constexpr size_t WS_VB = 252 * MiB;
constexpr size_t WS_USC = 268 * MiB;
constexpr size_t WS_VSC = 268 * MiB + 65536;
constexpr size_t WS_EIDX = 300 * MiB;
constexpr size_t WS_GATE = 316 * MiB;
constexpr size_t WS_XQ = 380 * MiB;
constexpr size_t WS_XQS = 412 * MiB;
constexpr size_t WS_PARTU = 108 * MiB;
constexpr size_t WS_SS = 348 * MiB;
constexpr size_t WS_PW = 332 * MiB;

constexpr int CW_TMAX = 64;
constexpr int LDS_BYTES = 147456;

__device__ __forceinline__ unsigned f2bf(float f) { unsigned u = __builtin_bit_cast(unsigned, f); return (u + 0x7fffu + ((u >> 16) & 1u)) >> 16; }
typedef __bf16 bf16x2_t __attribute__((ext_vector_type(2)));
__device__ __forceinline__ unsigned pk2(float lo, float hi) { bf16x2_t v; v[0] = (__bf16)lo; v[1] = (__bf16)hi; return __builtin_bit_cast(unsigned, v); }
__device__ __forceinline__ float bf_lo(unsigned w) { return __builtin_bit_cast(float, w << 16); }
__device__ __forceinline__ float bf_hi(unsigned w) { return __builtin_bit_cast(float, w & 0xffff0000u); }
__device__ __forceinline__ float bf2f(bf16_t h) { return __builtin_bit_cast(float, ((unsigned)h) << 16); }
__device__ __forceinline__ float shx(float v, int o, int lane) { return __builtin_bit_cast(float, __builtin_amdgcn_ds_bpermute((lane ^ o) << 2, __builtin_bit_cast(int, v))); }
__device__ __forceinline__ float shup(float v, int o, int lane) { return __builtin_bit_cast(float, __builtin_amdgcn_ds_bpermute(((lane - o) & 63) << 2, __builtin_bit_cast(int, v))); }
__device__ __forceinline__ float rdlane(float v, int l) { return __builtin_bit_cast(float, __builtin_amdgcn_readlane(__builtin_bit_cast(int, v), l)); }
#define DPP_(v, ctrl) __builtin_bit_cast(float, __builtin_amdgcn_update_dpp(0, __builtin_bit_cast(int, (v)), (ctrl), 0xF, 0xF, false))
__device__ __forceinline__ float wave_sum(float v, int lane) {
    (void)lane;
    v += DPP_(v, 0xB1); v += DPP_(v, 0x4E); v += DPP_(v, 0x141); v += DPP_(v, 0x140);
    return (rdlane(v, 0) + rdlane(v, 16)) + (rdlane(v, 32) + rdlane(v, 48));
}
__device__ __forceinline__ float wave_max(float v) {
    v = fmaxf(v, DPP_(v, 0xB1)); v = fmaxf(v, DPP_(v, 0x4E)); v = fmaxf(v, DPP_(v, 0x141)); v = fmaxf(v, DPP_(v, 0x140));
    return fmaxf(fmaxf(rdlane(v, 0), rdlane(v, 16)), fmaxf(rdlane(v, 32), rdlane(v, 48)));
}
__device__ __forceinline__ unsigned pack_i8x4(float a, float b, float c, float d) {
    const int ia = (int)__builtin_rintf(a), ib = (int)__builtin_rintf(b), ic = (int)__builtin_rintf(c), id = (int)__builtin_rintf(d);
    return ((unsigned)ia & 255u) | (((unsigned)ib & 255u) << 8) | (((unsigned)ic & 255u) << 16) | ((unsigned)id << 24);
}
#define SWZI_(v, pat) __builtin_amdgcn_ds_swizzle((int)(v), (pat))
#define DPPI_(v, ctrl) __builtin_amdgcn_update_dpp(0, (int)(v), (ctrl), 0xF, 0xF, false)
__device__ __forceinline__ unsigned xor32u_(unsigned v, bool hi) {
#if defined(__HIP_DEVICE_COMPILE__)
    const auto r = __builtin_amdgcn_permlane32_swap(v, v, false, false);
    return hi ? r[0] : r[1];
#else
    (void)hi; return v;
#endif
}
__device__ __forceinline__ float sigmoidf_(float x) { return __builtin_amdgcn_rcpf(1.0f + __expf(-x)); }
__device__ __forceinline__ float siluf_(float x) { return x * __builtin_amdgcn_rcpf(1.0f + __expf(-x)); }
#define LDS_WAIT() asm volatile("s_waitcnt lgkmcnt(0)" ::: "memory")
__device__ __forceinline__ int tid_() { int t = threadIdx.x; asm volatile("" : "+v"(t)); return t; }

#define GAS __attribute__((address_space(1)))
struct DArgs {
    const GAS float* x; const GAS float* norm1_g; const GAS float* w_in; const GAS float* b_in; const GAS float* conv_w; const GAS float* conv_b;
    const GAS float* m_head_g; const GAS float* lb_table; const GAS float* g_head_g; const GAS float* w_br_m; const GAS float* w_br_g; const GAS float* w_out;
    const GAS float* norm2_g; const GAS float* w_pq; const GAS float* sub_keys; const GAS float* u_emb; const GAS float* v_emb; const GAS float* final_g;
    GAS float* out; GAS unsigned char* ws;
};
struct Args {
    const float* x; const float* norm1_g; const float* w_in; const float* b_in; const float* conv_w; const float* conv_b;
    const float* m_head_g; const float* lb_table; const float* g_head_g; const float* w_br_m; const float* w_br_g; const float* w_out;
    const float* norm2_g; const float* w_pq; const float* sub_keys; const float* u_emb; const float* v_emb; const float* final_g;
    float* out; unsigned char* ws;
};

namespace pg8 {
constexpr int BM = 256, BK = 64, HALF = 128, HTB = HALF * BK * 2, STAGE_BYTES = 8 * HTB, NXCD = 8, WGM = 8;
__host__ __device__ __forceinline__ int lds_byte(int r, int c) { const int st = (r >> 4) * 2 + (c >> 5), rr = r & 15, cc = c & 31, ob = rr * 64 + cc * 2; return st * 1024 + (ob ^ (((ob >> 9) & 1) << 5)); }
__host__ __device__ __forceinline__ void stage_rc(int b, int& R, int& C) { const int st = b / 1024, sb = b % 1024, swz = sb ^ (((sb >> 9) & 1) << 5); R = (st >> 1) * 16 + swz / 64; C = (st & 1) * 32 + (swz % 64) / 2; }
__host__ __device__ __forceinline__ int perm32(int rho) { const int n = rho >> 4, i = rho & 15; return 8 * (i >> 2) + 4 * n + (i & 3); }
struct Unit { int pm, pn; };
struct Gemm { const bf16_t* A; const bf16_t* Bt; int M, N, K; };
struct StaticOrder {
    int nM, nN, nwg, G, c;
    __host__ __device__ void init(int M, int N, int G_, int c_) { nM = M / BM; nN = N / BM; nwg = nM * nN; G = G_; c = c_; }
    __host__ __device__ bool next(int i, Unit& u) const {
        const long L = (long)i * G + c; if (L >= nwg) return false;
        int wgid = (int)L; { const int q = nwg / NXCD, r = nwg % NXCD, xcd = wgid % NXCD, off = wgid / NXCD; wgid = (xcd < r ? xcd * (q + 1) : r * (q + 1) + (xcd - r) * q) + off; }
        const int nig = WGM * nN, gid = wgid / nig, fm = gid * WGM, gsz = (nM - fm) < WGM ? (nM - fm) : WGM;
        u.pm = fm + ((wgid % nig) % gsz); u.pn = (wgid % nig) / gsz; return true;
    }
    __device__ __forceinline__ void a_ready(const Unit&) const {}
    __device__ __forceinline__ void done(const Unit&) const {}
};

typedef int i32x8 __attribute__((ext_vector_type(8)));
typedef int i32x4 __attribute__((ext_vector_type(4)));
template <class Epi, class Sched, bool ALIGN_EPI = false, bool SP2 = false, bool I8 = false>
__device__ __forceinline__ void gemm_phase(LAS unsigned char* lds, const Gemm g, const Sched& S, const Epi& E) {
    const int tid = tid_(), wid = __builtin_amdgcn_readfirstlane(tid >> 6), lane = tid & 63, wr = wid >> 2, wc = wid & 3, fr = lane & 15, fq = lane >> 4;
    const int K = g.K, nt = K / BK;
    unsigned voffA[2], voffB[2];
#pragma unroll
    for (int i = 0; i < 2; ++i) { int R, C; stage_rc(tid * 16 + i * 8192, R, C); const int Rb = Epi::PERM ? ((R & ~31) + perm32(R & 31)) : R;
        voffA[i] = (unsigned)(R * K + C) * 2u; voffB[i] = (unsigned)(Rb * K + C) * 2u; }
    const size_t kstep = (size_t)(BK * 2);
    const size_t hstep = (size_t)HALF * K * 2;
    const size_t tstep = 2 * hstep;
    const unsigned ldsw = (unsigned)wid * 1024u;
    const int aoff = lds_byte(wr * 64 + fr, fq * 8), boff = lds_byte(wc * 32 + fr, fq * 8);
#define PG8_SA(b, h) (((b) * 2 + (h)) * HTB)
#define PG8_SB(b, h) ((4 + (b) * 2 + (h)) * HTB)
#define PG8_STAGE(bufoff, gbase, voff) do { _Pragma("unroll") for (int _i = 0; _i < 2; ++_i) \
        __builtin_amdgcn_global_load_lds((const unsigned*)((const char*)(gbase) + (voff)[_i]), (LAS unsigned*)(lds + (bufoff) + ldsw + _i * 8192), 16, 0, 0); } while (0)
#define PG8_LDA(dst, b, h) do { _Pragma("unroll") for (int m = 0; m < 4; ++m) _Pragma("unroll") for (int k = 0; k < 2; ++k) dst[m][k] = *(const LAS bf16x8*)(lds + PG8_SA(b, h) + aoff + m * 2048 + k * 1024); } while (0)
#define PG8_LDB(dst, b, h) do { _Pragma("unroll") for (int n = 0; n < 2; ++n) _Pragma("unroll") for (int k = 0; k < 2; ++k) dst[n][k] = *(const LAS bf16x8*)(lds + PG8_SB(b, h) + boff + n * 2048 + k * 1024); } while (0)
#define PG8_MMA(ai, bj, At, Bt) do { __builtin_amdgcn_s_setprio(1); _Pragma("unroll") for (int m = 0; m < 4; ++m) _Pragma("unroll") for (int n = 0; n < 2; ++n) _Pragma("unroll") for (int k = 0; k < 2; ++k) { \
        if constexpr (I8) acc[ai][bj][m][n] = __builtin_bit_cast(f32x4, __builtin_amdgcn_mfma_i32_16x16x64_i8(__builtin_bit_cast(i32x4, Bt[n][k]), __builtin_bit_cast(i32x4, At[m][k]), __builtin_bit_cast(i32x4, acc[ai][bj][m][n]), 0, 0, 0)); \
        else acc[ai][bj][m][n] = __builtin_amdgcn_mfma_f32_16x16x32_bf16(Bt[n][k], At[m][k], acc[ai][bj][m][n], 0, 0, 0); } __builtin_amdgcn_s_setprio(0); } while (0)
#define PG8_WAIT_V(n) asm volatile("s_waitcnt vmcnt(" #n ")" ::: "memory")
#define PG8_WAIT_L(n) asm volatile("s_waitcnt lgkmcnt(" #n ")" ::: "memory")
#define PG8_BAR __builtin_amdgcn_s_barrier()
#define PG8_SCHED __builtin_amdgcn_sched_barrier(0)
    Unit cur, nxt; int ui = 0;
    if (!S.next(0, cur)) return;
    f32x4 acc[2][2][4][2];
#pragma unroll
    for (int a = 0; a < 2; ++a)
#pragma unroll
        for (int b = 0; b < 2; ++b)
#pragma unroll
            for (int m = 0; m < 4; ++m)
#pragma unroll
                for (int n = 0; n < 2; ++n) acc[a][b][m][n] = (f32x4){0.f, 0.f, 0.f, 0.f};
    bf16x8 At[4][2], B0[2][2], B1[2][2];
    const char* cA = (const char*)g.A + (size_t)cur.pm * tstep; const char* cB = (const char*)g.Bt + (size_t)cur.pn * tstep;
    S.a_ready(cur);
    if constexpr (SP2) {
        PG8_STAGE(PG8_SB(0, 0), cB, voffB); PG8_STAGE(PG8_SB(0, 1), cB + hstep, voffB); PG8_STAGE(PG8_SA(0, 0), cA, voffA); PG8_STAGE(PG8_SA(0, 1), cA + hstep, voffA);
        if (wr == 1) PG8_BAR;
        PG8_WAIT_V(2); PG8_BAR;
        PG8_STAGE(PG8_SB(1, 0), cB + kstep, voffB); PG8_STAGE(PG8_SA(1, 0), cA + kstep, voffA); PG8_STAGE(PG8_SB(1, 1), cB + hstep + kstep, voffB);
        PG8_WAIT_V(6); PG8_BAR;
    } else {
        PG8_STAGE(PG8_SB(0, 0), cB, voffB); PG8_STAGE(PG8_SA(0, 0), cA, voffA); PG8_STAGE(PG8_SB(0, 1), cB + hstep, voffB); PG8_STAGE(PG8_SA(0, 1), cA + hstep, voffA);
        if (wr == 1) PG8_BAR;
        PG8_WAIT_V(4); PG8_BAR;
        PG8_STAGE(PG8_SB(1, 0), cB + kstep, voffB); PG8_STAGE(PG8_SA(1, 0), cA + kstep, voffA); PG8_STAGE(PG8_SB(1, 1), cB + hstep + kstep, voffB);
        PG8_WAIT_V(6); PG8_BAR;
    }
    for (;;) {
        const bool has_next = S.next(ui + 1, nxt);
        const char* nA = has_next ? (const char*)g.A + (size_t)nxt.pm * tstep : cA; const char* nB = has_next ? (const char*)g.Bt + (size_t)nxt.pn * tstep : cB;
#pragma unroll 1
        for (int t = 0; t < nt; t += 2) {
            const bool last = (t == nt - 2);
            const char* a1 = cA + (size_t)(t + 1) * kstep;
            const char* a2 = last ? nA : cA + (size_t)(t + 2) * kstep; const char* b2 = last ? nB : cB + (size_t)(t + 2) * kstep;
            const char* a3 = a2 + kstep; const char* b3 = b2 + kstep;
            if (last && has_next) S.a_ready(nxt);
            if constexpr (SP2) {
            PG8_LDB(B0, 0, 0); PG8_LDB(B1, 0, 1); PG8_SCHED; PG8_LDA(At, 0, 0); PG8_STAGE(PG8_SA(1, 1), a1 + hstep, voffA);
            PG8_WAIT_V(8); PG8_WAIT_L(0); PG8_BAR; PG8_MMA(0, 0, At, B0); PG8_MMA(0, 1, At, B1); PG8_BAR; PG8_SCHED;
            PG8_LDA(At, 0, 1); PG8_STAGE(PG8_SB(0, 0), b2, voffB); PG8_STAGE(PG8_SB(0, 1), b2 + hstep, voffB); PG8_STAGE(PG8_SA(0, 0), a2, voffA);
            PG8_WAIT_V(8); PG8_WAIT_L(0); PG8_BAR; PG8_MMA(1, 0, At, B0); PG8_MMA(1, 1, At, B1); PG8_BAR; PG8_SCHED;
            PG8_LDB(B0, 1, 0); PG8_LDB(B1, 1, 1); PG8_SCHED; PG8_LDA(At, 1, 0); PG8_STAGE(PG8_SA(0, 1), a2 + hstep, voffA);
            PG8_WAIT_V(8); PG8_WAIT_L(0); PG8_BAR; PG8_MMA(0, 0, At, B0); PG8_MMA(0, 1, At, B1); PG8_BAR; PG8_SCHED;
            PG8_LDA(At, 1, 1); PG8_STAGE(PG8_SB(1, 0), b3, voffB); PG8_STAGE(PG8_SB(1, 1), b3 + hstep, voffB); PG8_STAGE(PG8_SA(1, 0), a3, voffA);
            PG8_WAIT_V(8); PG8_WAIT_L(0); PG8_BAR; PG8_MMA(1, 0, At, B0); PG8_MMA(1, 1, At, B1); PG8_BAR; PG8_SCHED;
            } else {
            PG8_LDB(B0, 0, 0); PG8_SCHED; PG8_LDA(At, 0, 0); PG8_STAGE(PG8_SA(1, 1), a1 + hstep, voffA);
            PG8_WAIT_L(8); PG8_BAR; PG8_WAIT_L(0); PG8_MMA(0, 0, At, B0); PG8_BAR; PG8_SCHED;
            PG8_LDB(B1, 0, 1); PG8_STAGE(PG8_SB(0, 0), b2, voffB);
            PG8_BAR; PG8_WAIT_L(0); PG8_MMA(0, 1, At, B1); PG8_BAR;
            PG8_LDA(At, 0, 1); PG8_STAGE(PG8_SA(0, 0), a2, voffA);
            PG8_BAR; PG8_WAIT_L(0); PG8_MMA(1, 0, At, B0); PG8_BAR; PG8_SCHED;
            PG8_STAGE(PG8_SB(0, 1), b2 + hstep, voffB);
            PG8_WAIT_V(6); PG8_BAR; PG8_MMA(1, 1, At, B1); PG8_BAR;
            PG8_LDB(B0, 1, 0); PG8_SCHED; PG8_LDA(At, 1, 0); PG8_STAGE(PG8_SA(0, 1), a2 + hstep, voffA);
            PG8_WAIT_L(8); PG8_BAR; PG8_WAIT_L(0); PG8_MMA(0, 0, At, B0); PG8_BAR; PG8_SCHED;
            PG8_LDB(B1, 1, 1); PG8_STAGE(PG8_SB(1, 0), b3, voffB);
            PG8_BAR; PG8_WAIT_L(0); PG8_MMA(0, 1, At, B1); PG8_BAR;
            PG8_LDA(At, 1, 1); PG8_STAGE(PG8_SA(1, 0), a3, voffA);
            PG8_BAR; PG8_WAIT_L(0); PG8_MMA(1, 0, At, B0); PG8_BAR; PG8_SCHED;
            PG8_STAGE(PG8_SB(1, 1), b3 + hstep, voffB);
            PG8_WAIT_V(6); PG8_BAR; PG8_MMA(1, 1, At, B1); PG8_BAR;
            }
        }
        if constexpr (ALIGN_EPI) { if (wr == 0) PG8_BAR; }
        E(acc, cur, wr, wc, fr, fq);
        if (!has_next) break;
#pragma unroll
        for (int a = 0; a < 2; ++a)
#pragma unroll
            for (int b = 0; b < 2; ++b)
#pragma unroll
                for (int m = 0; m < 4; ++m)
#pragma unroll
                    for (int n = 0; n < 2; ++n) acc[a][b][m][n] = (f32x4){0.f, 0.f, 0.f, 0.f};
        cur = nxt; cA = nA; cB = nB; ++ui;
        if constexpr (ALIGN_EPI) { if (wr == 1) PG8_BAR; }
    }
    PG8_WAIT_V(0);
    if constexpr (!ALIGN_EPI) { if (wr == 0) PG8_BAR; }
    PG8_BAR;
#undef PG8_SA
#undef PG8_SB
#undef PG8_STAGE
#undef PG8_LDA
#undef PG8_LDB
#undef PG8_MMA
#undef PG8_WAIT_V
#undef PG8_WAIT_L
#undef PG8_BAR
#undef PG8_SCHED
}
}

typedef int i32x4q __attribute__((ext_vector_type(4)));
struct EpiPtrs {
    const GAS float* biasp; const GAS float* lb; const GAS float* x; GAS float* out; GAS unsigned char* ws; int round;
    const GAS float* sa; const GAS float* sb; const GAS float* sym; const GAS float* syg; const GAS float* sxq;
};
template <int MODE> struct EpiX {
    static constexpr bool PERM = true, AFTER_DRAIN = false;
    EpiPtrs P;
    __device__ __forceinline__ void operator()(const f32x4 (&acc)[2][2][4][2], const pg8::Unit& u, int wr, int wc, int fr, int fq) const {
        const int upn = u.pn;
        const int row0 = u.pm * 256 + wr * 64 + fr;
        const int colt = upn * 256 + wc * 32 + 8 * fq;
        GAS unsigned char* ws = P.ws;
        bf16_t* dst = nullptr; int ld = 0, coff = 0, act = 0; const GAS float* bias = nullptr;
        if (MODE == 1 || MODE == 7) {
            bias = P.biasp;
            if (upn < 8) { dst = (bf16_t*)(ws + WS_QKPRE); ld = 2048; coff = 0; act = 0; }
            else if (upn < 16) { dst = (bf16_t*)(ws + WS_V); ld = 2048; coff = 2048; act = 0; }
            else if (upn < 20) { dst = (bf16_t*)(ws + WS_GFLOG); ld = 1024; coff = 4096; act = 3; }
            else if (upn < 24) { dst = (bf16_t*)(ws + WS_GI); ld = 1024; coff = 5120; act = 0; }
            else { dst = (bf16_t*)(ws + WS_GQ); ld = 1024; coff = 6144; act = 2; }
        } else if (MODE == 2) {
            bias = P.biasp + N1;
            if (u.pn < 8) { dst = (bf16_t*)(ws + WS_SIGO); ld = 2048; coff = 0; act = 1; }
            else if (u.pn < 12) { dst = (bf16_t*)(ws + WS_SGG); ld = 1024; coff = 2048; act = 2; }
            else if (u.pn < 16) { dst = (bf16_t*)(ws + WS_SAM); ld = 1024; coff = 3072; act = 1; }
            else { dst = (bf16_t*)(ws + WS_SAG); ld = 1024; coff = 4096; act = 1; }
        } else if (MODE == 6) { dst = (bf16_t*)(ws + WS_QP); ld = 2048; coff = 0; act = 0; }
#pragma unroll
        for (int bj = 0; bj < 2; ++bj) {
            const int col = colt + bj * 128;
            f32x4 b0 = (f32x4){0.f, 0.f, 0.f, 0.f}, b1 = b0, l0 = b0, l1 = b0;
            if (MODE == 1 || MODE == 2 || MODE == 7) { b0 = *(const f32x4*)(bias + col); b1 = *(const f32x4*)(bias + col + 4); }
            f32x4 s0 = (f32x4){1.f, 1.f, 1.f, 1.f}, s1 = s0;
            if (MODE == 2) { s0 = *(const GAS f32x4*)(P.sb + 7168 + col); s1 = *(const GAS f32x4*)(P.sb + 7168 + col + 4); }
            if (MODE == 7) { s0 = *(const GAS f32x4*)(P.sb + col); s1 = *(const GAS f32x4*)(P.sb + col + 4); }
            if (MODE == 3) { s0 = *(const GAS f32x4*)(P.sb + 12288 + col); s1 = *(const GAS f32x4*)(P.sb + 12288 + col + 4); }
            if (MODE == 4) { s0 = *(const GAS f32x4*)(P.sb + 13312 + col); s1 = *(const GAS f32x4*)(P.sb + 13312 + col + 4); }
            if (MODE == 6) { s0 = *(const GAS f32x4*)(P.sb + 14336 + col); s1 = *(const GAS f32x4*)(P.sb + 14336 + col + 4); }
            if (MODE == 1 || MODE == 7) { if (act == 3) { l0 = *(const f32x4*)(P.lb + (col - coff)); l1 = *(const f32x4*)(P.lb + (col - coff) + 4); } }
#pragma unroll
            for (int ai = 0; ai < 2; ++ai)
#pragma unroll
                for (int m = 0; m < 4; ++m) {
                    const int row = row0 + ai * 128 + m * 16;
                    f32x4 v0, v1;
                    if (MODE == 2 || MODE == 7 || MODE == 3 || MODE == 4 || MODE == 6) { const float sr = (MODE == 3) ? P.sym[row] : (MODE == 4) ? P.syg[row] : (MODE == 6) ? P.sxq[row] : P.sa[(size_t)P.round * RT + row]; const i32x4q q0 = __builtin_bit_cast(i32x4q, acc[ai][bj][m][0]), q1 = __builtin_bit_cast(i32x4q, acc[ai][bj][m][1]);
                        v0 = (f32x4){(float)q0[0], (float)q0[1], (float)q0[2], (float)q0[3]} * (s0 * sr) + b0; v1 = (f32x4){(float)q1[0], (float)q1[1], (float)q1[2], (float)q1[3]} * (s1 * sr) + b1; }
                    else { v0 = acc[ai][bj][m][0] + b0; v1 = acc[ai][bj][m][1] + b1; }
                    if (MODE == 1 || MODE == 2 || MODE == 6 || MODE == 7) {
                        if (act == 1) {
#pragma unroll
                            for (int j = 0; j < 4; ++j) { v0[j] = sigmoidf_(v0[j]); v1[j] = sigmoidf_(v1[j]); }
                        } else if (act == 2) {
#pragma unroll
                            for (int j = 0; j < 4; ++j) { v0[j] = siluf_(v0[j]); v1[j] = siluf_(v1[j]); }
                        } else if (act == 3) {
#pragma unroll
                            for (int j = 0; j < 4; ++j) { v0[j] = __logf(l0[j] + (1.0f - l0[j]) * sigmoidf_(v0[j])); v1[j] = __logf(l1[j] + (1.0f - l1[j]) * sigmoidf_(v1[j])); }
                        }
                        u32x4 w; w.x = pk2(v0[0], v0[1]); w.y = pk2(v0[2], v0[3]); w.z = pk2(v1[0], v1[1]); w.w = pk2(v1[2], v1[3]);
                        *(u32x4*)(dst + (size_t)row * ld + (col - coff)) = w;
                    } else if (MODE == 3) {
                        const u32x4 g = *(const u32x4*)((const bf16_t*)(ws + WS_SAM) + (size_t)row * 1024 + col);
                        GAS bf16_t* o = (GAS bf16_t*)P.out + (size_t)T * 1024 + ((size_t)P.round * RT + row) * 1024 + col;
                        f32x4 r0, r1;
                        r0[0] = v0[0] * bf_lo(g.x); r0[1] = v0[1] * bf_hi(g.x); r0[2] = v0[2] * bf_lo(g.y); r0[3] = v0[3] * bf_hi(g.y);
                        r1[0] = v1[0] * bf_lo(g.z); r1[1] = v1[1] * bf_hi(g.z); r1[2] = v1[2] * bf_lo(g.w); r1[3] = v1[3] * bf_hi(g.w);
                        u32x4 w; w.x = pk2(r0[0], r0[1]); w.y = pk2(r0[2], r0[3]); w.z = pk2(r1[0], r1[1]); w.w = pk2(r1[2], r1[3]);
                        *(GAS u32x4*)o = w;
                    } else if (MODE == 4) {
                        const u32x4 g = *(const u32x4*)((const bf16_t*)(ws + WS_SAG) + (size_t)row * 1024 + col);
                        const u32x4 zv = *(const GAS u32x4*)((const GAS bf16_t*)P.out + (size_t)T * 1024 + ((size_t)P.round * RT + row) * 1024 + col);
                        const f32x4 p0 = (f32x4){bf_lo(zv.x), bf_hi(zv.x), bf_lo(zv.y), bf_hi(zv.y)}, p1 = (f32x4){bf_lo(zv.z), bf_hi(zv.z), bf_lo(zv.w), bf_hi(zv.w)};
                        f32x4 r0, r1;
                        r0[0] = p0[0] + v0[0] * bf_lo(g.x); r0[1] = p0[1] + v0[1] * bf_hi(g.x); r0[2] = p0[2] + v0[2] * bf_lo(g.y); r0[3] = p0[3] + v0[3] * bf_hi(g.y);
                        r1[0] = p1[0] + v1[0] * bf_lo(g.z); r1[1] = p1[1] + v1[1] * bf_hi(g.z); r1[2] = p1[2] + v1[2] * bf_lo(g.w); r1[3] = p1[3] + v1[3] * bf_hi(g.w);
                        u32x4 w; w.x = pk2(r0[0], r0[1]); w.y = pk2(r0[2], r0[3]); w.z = pk2(r1[0], r1[1]); w.w = pk2(r1[2], r1[3]);
                        *(u32x4*)((bf16_t*)(ws + WS_GFLOG) + (size_t)row * 1024 + col) = w;
                    } else if (MODE == 5) {
                        const size_t off = ((size_t)P.round * RT + row) * 1024 + col;
                        const f32x4 x0 = *(const f32x4*)(P.x + off) + v0, x1 = *(const f32x4*)(P.x + off + 4) + v1;
                        u32x4 w; w.x = pk2(x0[0], x0[1]); w.y = pk2(x0[2], x0[3]); w.z = pk2(x1[0], x1[1]); w.w = pk2(x1[2], x1[3]);
                        *(GAS u32x4*)((GAS bf16_t*)P.out + off) = w;
                    }
                }
        }
    }
};

__device__ __forceinline__ void p0_transpose_item(const GAS float* W, int ldw, int K, int k0, int scol, GAS bf16_t* WT, int drow, LAS float* scr, int lane) {
#pragma unroll 8
    for (int i = 0; i < 32; ++i) { const int kk = 2 * i + (lane >> 5); scr[kk * 33 + (lane & 31)] = W[(size_t)(k0 + kk) * ldw + scol + (lane & 31)]; }
    LDS_WAIT(); asm volatile("" ::: "memory");
    const int c = lane & 7;
#pragma unroll
    for (int j = 0; j < 4; ++j) { const int n = (lane >> 3) + 8 * j; const LAS float* s = scr + (8 * c) * 33 + n;
        u32x4 o; o.x = pk2(s[0 * 33], s[1 * 33]); o.y = pk2(s[2 * 33], s[3 * 33]); o.z = pk2(s[4 * 33], s[5 * 33]); o.w = pk2(s[6 * 33], s[7 * 33]);
        *(u32x4*)(WT + (size_t)(drow + n) * K + k0 + 8 * c) = o; }
    LDS_WAIT(); asm volatile("" ::: "memory");
}
__device__ __forceinline__ void p0_colmax_item(const GAS float* W, int ldw, int k0, int scol, GAS unsigned* colmax, int lane) {
    float mx = 0.f;
#pragma unroll 8
    for (int i = 0; i < 32; ++i) { const int kk = 2 * i + (lane >> 5); mx = fmaxf(mx, fabsf(W[(size_t)(k0 + kk) * ldw + scol + (lane & 31)])); }
    mx = fmaxf(mx, __builtin_bit_cast(float, xor32u_(__builtin_bit_cast(unsigned, mx), lane >= 32)));
    if (lane < 32) atomicMax((unsigned*)colmax + lane, __builtin_bit_cast(unsigned, mx));
}
__device__ __forceinline__ void p0_cvt8_item(const GAS float* W, int ldw, int k0, int scol, const GAS unsigned* colmax, GAS unsigned char* WT8, int pitch, GAS float* sb, int drow, LAS float* scr, int lane) {
    const float cm = __builtin_bit_cast(float, colmax[lane & 31]);
    const float qs = cm > 0.f ? 127.0f / cm : 0.f;
    if (k0 == 0 && lane < 32) sb[lane] = cm * (1.0f / 127.0f);
#pragma unroll 8
    for (int i = 0; i < 32; ++i) { const int kk = 2 * i + (lane >> 5); scr[kk * 33 + (lane & 31)] = W[(size_t)(k0 + kk) * ldw + scol + (lane & 31)] * qs; }
    LDS_WAIT(); asm volatile("" ::: "memory");
    const int n = lane >> 1, kh = lane & 1;
    const LAS float* sp = scr + (kh * 32) * 33 + n;
    u32x4 o0, o1;
#pragma unroll
    for (int q = 0; q < 8; ++q) { const unsigned p = pack_i8x4(sp[(4 * q) * 33], sp[(4 * q + 1) * 33], sp[(4 * q + 2) * 33], sp[(4 * q + 3) * 33]);
        if (q < 4) o0[q] = p; else o1[q - 4] = p; }
    GAS unsigned char* dst = WT8 + (size_t)(drow + n) * pitch + k0 + kh * 32;
    *(GAS u32x4*)dst = o0; *(GAS u32x4*)(dst + 16) = o1;
    LDS_WAIT(); asm volatile("" ::: "memory");
}
__device__ __forceinline__ int win_src_col(int n) {
    if (n < 4096) return n;
    if (n < 7168) return n - 4096 + 6152;
    if (n < 9216) return n - 7168 + 4096;
    return n - 9216 + 9224;
}

__device__ __forceinline__ void phase_p0(const DArgs& a, LAS unsigned char* lds, int vcu, int G) {
    const int tid = tid_(), lane = tid & 63, wave = tid >> 6;
    const int gw = vcu * NWAVES + wave, NGW = G * NWAVES;
    GAS unsigned char* ws = a.ws;
    LAS float* scr = (LAS float*)(lds + wave * 16384);
    constexpr int I_IN = 16 * 384, I_M = 32 * 32, I_G = 16 * 32, I_O = 16 * 32, I_PQ = 16 * 64;
    constexpr int NITEMS = I_IN + I_M + I_G + I_O + I_PQ;
    for (int it = gw; it < NITEMS; it += NGW) {
        int r = it;
        if (r < I_IN) { const int kb = r / 384, nb = r % 384;
            p0_colmax_item(a.w_in, IN_COLS, kb * 64, win_src_col(nb * 32), (GAS unsigned*)(ws + WS_CTL) + CW_COLMAX + nb * 32, lane);
            continue; } r -= I_IN;
        if (r < I_M) { const int kb = r / 32, nb = r % 32; p0_colmax_item(a.w_br_m, 1024, kb * 64, nb * 32, (GAS unsigned*)(ws + WS_CTL) + CW_COLMAX + 12288 + nb * 32, lane); continue; } r -= I_M;
        if (r < I_G) { const int kb = r / 32, nb = r % 32; p0_colmax_item(a.w_br_g, 1024, kb * 64, nb * 32, (GAS unsigned*)(ws + WS_CTL) + CW_COLMAX + 13312 + nb * 32, lane); continue; } r -= I_G;
        if (r < I_O) { const int kb = r / 32, nb = r % 32; p0_transpose_item(a.w_out, 1024, 1024, kb * 64, nb * 32, (GAS bf16_t*)(ws + WS_WO), nb * 32, scr, lane); continue; } r -= I_O;
        { const int kb = r / 64, nb = r % 64; p0_colmax_item(a.w_pq, 2048, kb * 64, nb * 32, (GAS unsigned*)(ws + WS_CTL) + CW_COLMAX + 14336 + nb * 32, lane); }
    }
    const int gt = vcu * NTHR + tid, NGT = G * NTHR;
    for (int i = gt; i < NP; i += NGT) ((float*)(ws + WS_BIASP))[i] = a.b_in[win_src_col(i)];
    for (int i = gt; i < 1024; i += NGT) { const float t0 = a.lb_table[i], t1 = a.lb_table[1024 + i]; ((float*)(ws + WS_LB))[i] = 1.0f / (1.0f + __expf(t1 - t0)); }
    for (int i = gt; i < 8 * 2 * 128 * 128 / 4; i += NGT) { const f32x4 v = ((const f32x4*)a.sub_keys)[i]; u32x2 o; o.x = pk2(v[0], v[1]); o.y = pk2(v[2], v[3]); ((u32x2*)(ws + WS_SK))[i] = o; }
    f32x4 g1[4];
#pragma unroll
    for (int j = 0; j < 4; ++j) g1[j] = ((const GAS f32x4*)a.norm1_g)[64 * j + lane];
    f32x4 gw0[16], gw1[16];
#pragma unroll
    for (int j = 0; j < 4; ++j)
#pragma unroll
        for (int e = 0; e < 4; ++e) { const int k = 256 * j + 4 * lane + e; gw0[4 * j + e] = *(const GAS f32x4*)(a.w_in + (size_t)k * IN_COLS + 6144); gw1[4 * j + e] = *(const GAS f32x4*)(a.w_in + (size_t)k * IN_COLS + 6148); }
    const float gbias = lane < 8 ? a.b_in[6144 + lane] : 0.f;
    for (int m = gw; m < T; m += NGW) {
        const GAS f32x4* xr = (const GAS f32x4*)(a.x + (size_t)m * D) + lane;
        f32x4 v[4]; float s = 0.f;
#pragma unroll
        for (int j = 0; j < 4; ++j) { v[j] = xr[64 * j]; s += (v[j][0] * v[j][0] + v[j][1] * v[j][1]) + (v[j][2] * v[j][2] + v[j][3] * v[j][3]); }
        const float rstd = rsqrtf(wave_sum(s, lane) * (1.f / D) + EPS);
        f32x4 ga0 = (f32x4){0.f, 0.f, 0.f, 0.f}, ga1 = ga0;
        float mx = 0.f;
#pragma unroll
        for (int j = 0; j < 4; ++j) {
            v[j] = v[j] * rstd * g1[j];
            mx = fmaxf(mx, fmaxf(fmaxf(fabsf(v[j][0]), fabsf(v[j][1])), fmaxf(fabsf(v[j][2]), fabsf(v[j][3]))));
#pragma unroll
            for (int e = 0; e < 4; ++e) { ga0 += gw0[4 * j + e] * v[j][e]; ga1 += gw1[4 * j + e] * v[j][e]; }
        }
        {
            mx = wave_max(mx);
            const float qs = mx > 0.f ? 127.0f / mx : 0.f;
#pragma unroll
            for (int jq = 0; jq < 4; ++jq) ((GAS unsigned*)(ws + WS_XN8 + (size_t)m * 1024))[64 * jq + lane] = pack_i8x4(v[jq][0] * qs, v[jq][1] * qs, v[jq][2] * qs, v[jq][3] * qs);
            if (lane == 0) ((GAS float*)(ws + WS_SA8))[m] = mx * (1.0f / 127.0f);
        }
        float ga[8] = {ga0[0], ga0[1], ga0[2], ga0[3], ga1[0], ga1[1], ga1[2], ga1[3]};
#pragma unroll
        for (int q = 0; q < 8; ++q) ga[q] = wave_sum(ga[q], lane);
        if (lane < 8) { float r = ga[0];
#pragma unroll
            for (int q = 1; q < 8; ++q) r = (lane == q) ? ga[q] : r;
            ((GAS float*)(ws + WS_GATES))[(size_t)m * 8 + lane] = r + gbias; }
    }
}

__device__ __forceinline__ float logsigf_(float x) { return fminf(x, 0.f) - log1pf(__expf(-fabsf(x))); }
#define LDS_BAR() do { asm volatile("s_waitcnt lgkmcnt(0)" ::: "memory"); __builtin_amdgcn_s_barrier(); asm volatile("" ::: "memory"); } while (0)
#define MFMA16(a, b, c) __builtin_amdgcn_mfma_f32_16x16x32_bf16((a), (b), (c), 0, 0, 0)
__device__ __forceinline__ bf16x8 lfrag(const LAS unsigned char* base, int pitch, int row, int k0, int fq) { return *(const LAS bf16x8*)(base + row * pitch + (k0 + 8 * fq) * 2); }
__device__ __forceinline__ int fm_off(int r, int k, int KB) { return (((r >> 4) * KB + (k >> 5)) << 10) + (((((k >> 3) & 3) << 4) + (r & 15)) << 4) + ((k & 7) << 1); }
__device__ __forceinline__ bf16x8 gfrag(const bf16_t* base, int ld, int row, int k0, int fq) { return *(const bf16x8*)(base + (size_t)row * ld + k0 + 8 * fq); }

__device__ __forceinline__ void phase_p0c(const DArgs& a, LAS unsigned char* lds, int vcu, int G) {
    const int tid = tid_(), lane = tid & 63, wave = tid >> 6;
    const int gw = vcu * NWAVES + wave, NGW = G * NWAVES;
    GAS unsigned char* ws = a.ws;
    LAS float* scr = (LAS float*)(lds + wave * 16384);
    constexpr int J_IN = 16 * 384, J_M = 32 * 32, J_G = 16 * 32, J_PQ = 16 * 64;
    const GAS unsigned* cmx = (const GAS unsigned*)(ws + WS_CTL) + CW_COLMAX; GAS float* sb = (GAS float*)(ws + WS_SB8);
    for (int it = gw; it < J_IN + J_M + J_G + J_PQ; it += NGW) {
        int r = it;
        if (r < J_IN) { const int kb = r / 384, nb = r % 384;
            p0_cvt8_item(a.w_in, IN_COLS, kb * 64, win_src_col(nb * 32), cmx + nb * 32, ws + WS_W8A, 1024, sb + nb * 32, nb * 32, scr, lane); continue; } r -= J_IN;
        if (r < J_M) { const int kb = r / 32, nb = r % 32; p0_cvt8_item(a.w_br_m, 1024, kb * 64, nb * 32, cmx + 12288 + nb * 32, ws + WS_WM, 2048, sb + 12288 + nb * 32, nb * 32, scr, lane); continue; } r -= J_M;
        if (r < J_G) { const int kb = r / 32, nb = r % 32; p0_cvt8_item(a.w_br_g, 1024, kb * 64, nb * 32, cmx + 13312 + nb * 32, ws + WS_WG, 1024, sb + 13312 + nb * 32, nb * 32, scr, lane); continue; } r -= J_G;
        { const int kb = r / 64, nb = r % 64; p0_cvt8_item(a.w_pq, 2048, kb * 64, nb * 32, cmx + 14336 + nb * 32, ws + WS_WPQ, 1024, sb + 14336 + nb * 32, nb * 32, scr, lane); }
    }
}
__device__ __forceinline__ void mscan_pair(const DArgs& a, LAS unsigned char* lds, int round, int p) {
    const int tid = tid_(), lane = tid & 63, part = tid >> 6;
    const int bl = p >> 2, h = p & 3, b = round * 2 + bl;
    const GAS float* g = (const GAS float*)(a.ws + WS_GATES) + ((size_t)b * SEQ + (size_t)lane * 128 + part * 16) * 8;
    float bsum = 0.f, gm = -INFINITY;
#pragma unroll 4
    for (int s = 0; s < 16; ++s) { const float ip = g[s * 8 + h], fp = g[s * 8 + 4 + h]; bsum += logsigf_(fp); gm = fmaxf(gm, ip - bsum); }
    LAS float* PS = (LAS float*)lds; LAS float* PM = PS + 512;
    PS[part * 64 + lane] = bsum; PM[part * 64 + lane] = gm;
    __syncthreads();
    if (tid < 64) {
        float bs = 0.f, g2 = -INFINITY;
#pragma unroll
        for (int q = 0; q < 8; ++q) { g2 = fmaxf(g2, PM[q * 64 + lane] - bs); bs += PS[q * 64 + lane]; }
        float mprev = 0.f, mine = 0.f;
        for (int c = 0; c < 64; ++c) {
            const float bc = rdlane(bs, c), gc = rdlane(g2, c);
            if (lane == c) mine = mprev; mprev = bc + fmaxf(mprev, gc); }
        ((GAS float*)(a.ws + WS_MPREV))[(round * 8 + p) * 64 + lane] = mine;
    }
    __syncthreads();
}

constexpr int PQ_PITCH = 528, PS_PITCH = 272;
__device__ __forceinline__ void mlstm_pre_item(const DArgs& a, LAS unsigned char* lds, int round, int item) {
    const int tid = tid_(), lane = tid & 63, wave = __builtin_amdgcn_readfirstlane(tid >> 6), fr = lane & 15, fq = lane >> 4;
    const int p = item >> 6, c = item & 63, bl = p >> 2, h = p & 3, b = round * 2 + bl;
    const int tl0 = bl * SEQ + c * 128; const size_t tg0 = (size_t)b * SEQ + c * 128;
    GAS unsigned char* ws = a.ws;
    LAS unsigned char* QL = lds; LAS unsigned char* KL = lds + 67584;
    LAS float* AS = (LAS float*)(lds + 135168); LAS float* MS = AS + 128; LAS float* SC = AS + 256;
    if (wave == 0) {
        const float mprev = ((const float*)(ws + WS_MPREV))[(round * 8 + p) * 64 + c];
        const float* g = (const float*)(ws + WS_GATES) + (tg0 + 2 * lane) * 8;
        const float ip0 = g[h], fp0 = g[4 + h], ip1 = g[8 + h], fp1 = g[12 + h];
        const float lf0 = logsigf_(fp0), lf1 = logsigf_(fp1), pp = lf0 + lf1;
        float incl = pp;
#pragma unroll
        for (int o = 1; o < 64; o <<= 1) { const float t = shup(incl, o, lane); if (lane >= o) incl += t; }
        const float excl = incl - pp, b0 = excl + lf0, b1 = incl;
        const float a0 = ip0 - b0, a1 = ip1 - b1;
        float inclm = fmaxf(a0, a1);
#pragma unroll
        for (int o = 1; o < 64; o <<= 1) { const float t = shup(inclm, o, lane); if (lane >= o) inclm = fmaxf(inclm, t); }
        float exclm = shup(inclm, 1, lane); if (lane == 0) exclm = -INFINITY;
        const float M0 = fmaxf(mprev, fmaxf(exclm, a0)), M1 = fmaxf(mprev, inclm);
        AS[2 * lane] = a0; AS[2 * lane + 1] = a1; MS[2 * lane] = M0; MS[2 * lane + 1] = M1;
        float* mt = (float*)(ws + WS_MT) + (tg0 + 2 * lane) * 4 + h;
        mt[0] = b0 + M0; mt[4] = b1 + M1;
        const float Mlast = rdlane(M1, 63);
        if (lane == 0) { SC[0] = mprev; SC[1] = Mlast; ((float*)(ws + WS_MDEC))[item] = __expf(mprev - Mlast); }
    }
    {
        const int cgp = tid & 63, strip = tid >> 6;
        const int col = (cgp < 32) ? (h * 256 + cgp * 8) : (1024 + h * 256 + (cgp - 32) * 8);
        float w[4][8], bb[8];
#pragma unroll
        for (int j = 0; j < 4; ++j) { const f32x4 w0 = *(const f32x4*)(a.conv_w + j * 2048 + col), w1 = *(const f32x4*)(a.conv_w + j * 2048 + col + 4);
#pragma unroll
            for (int e = 0; e < 4; ++e) { w[j][e] = w0[e]; w[j][4 + e] = w1[e]; } }
        { const f32x4 b0 = *(const f32x4*)(a.conv_b + col), b1 = *(const f32x4*)(a.conv_b + col + 4);
#pragma unroll
            for (int e = 0; e < 4; ++e) { bb[e] = b0[e]; bb[4 + e] = b1[e]; } }
        const bf16_t* src = (const bf16_t*)(ws + WS_QKPRE) + (size_t)(tl0 + 16 * strip) * 2048 + col;
        const float qs = (cgp < 32) ? 0.0625f : 1.0f;
        LAS unsigned char* dstt = ((cgp < 32) ? QL : KL) + (cgp & 31) * 16;
#pragma unroll 1
        for (int half = 0; half < 2; ++half) {
            u32x4 xr[11];
#pragma unroll
            for (int r = 0; r < 11; ++r) {
                const int sl = c * 128 + 16 * strip + 8 * half + r - 3;
                xr[r] = (sl >= 0) ? *(const u32x4*)(src + (ptrdiff_t)(8 * half + r - 3) * 2048) : (u32x4){0u, 0u, 0u, 0u};
            }
#pragma unroll
            for (int r = 0; r < 8; ++r) {
                float y[8];
#pragma unroll
                for (int e = 0; e < 8; ++e) y[e] = bb[e];
#pragma unroll
                for (int j = 0; j < 4; ++j) { const u32x4 xv = xr[r + j];
                    y[0] += w[j][0] * bf_lo(xv.x); y[1] += w[j][1] * bf_hi(xv.x); y[2] += w[j][2] * bf_lo(xv.y); y[3] += w[j][3] * bf_hi(xv.y);
                    y[4] += w[j][4] * bf_lo(xv.z); y[5] += w[j][5] * bf_hi(xv.z); y[6] += w[j][6] * bf_lo(xv.w); y[7] += w[j][7] * bf_hi(xv.w); }
#pragma unroll
                for (int e = 0; e < 8; ++e) y[e] = siluf_(y[e]) * qs;
                u32x4 o; o.x = pk2(y[0], y[1]); o.y = pk2(y[2], y[3]); o.z = pk2(y[4], y[5]); o.w = pk2(y[6], y[7]);
                *(LAS u32x4*)(dstt + (16 * strip + 8 * half + r) * PQ_PITCH) = o;
            }
        }
    }
    __syncthreads();
    const float mprev = SC[0], Mlast = SC[1];
    {
        bf16_t* Sg = (bf16_t*)(ws + WS_S) + (size_t)item * 128 * 128;
        const int t = wave * 16 + fr; const float Mt = MS[t];
        for (int st = 0; st < 8; ++st) {
            u32x2 o = (u32x2){0u, 0u};
            if (st <= wave) {
                f32x4 acc = (f32x4){0.f, 0.f, 0.f, 0.f};
#pragma unroll
                for (int ks = 0; ks < 8; ++ks) acc = MFMA16(lfrag(KL, PQ_PITCH, st * 16 + fr, ks * 32, fq), lfrag(QL, PQ_PITCH, wave * 16 + fr, ks * 32, fq), acc);
                float v[4];
#pragma unroll
                for (int j = 0; j < 4; ++j) { const int s = st * 16 + 4 * fq + j; v[j] = (s <= t) ? acc[j] * __expf(AS[s] - Mt) : 0.f; }
                o.x = pk2(v[0], v[1]); o.y = pk2(v[2], v[3]);
            }
            *(u32x2*)((unsigned char*)Sg + fm_off(t, st * 16 + 4 * fq, 4)) = o;
        }
    }
    {
        bf16_t* Qg = (bf16_t*)(ws + WS_QT) + (size_t)item * 128 * 256;
#pragma unroll
        for (int i = 0; i < 8; ++i) { const int idx = tid + 512 * i, blk = idx >> 6, t = (blk >> 3) * 16 + (idx & 15), ch = (blk & 7) * 4 + ((idx >> 4) & 3);
            const u32x4 v = *(const LAS u32x4*)(QL + t * PQ_PITCH + ch * 16); const float s = __expf(mprev - MS[t]);
            u32x4 o; o.x = pk2(bf_lo(v.x) * s, bf_hi(v.x) * s); o.y = pk2(bf_lo(v.y) * s, bf_hi(v.y) * s); o.z = pk2(bf_lo(v.z) * s, bf_hi(v.z) * s); o.w = pk2(bf_lo(v.w) * s, bf_hi(v.w) * s);
            *(u32x4*)((unsigned char*)Qg + fm_off(t, ch * 8, 8)) = o; }
    }
    {
        bf16_t* Kg = (bf16_t*)(ws + WS_KWT) + (size_t)item * 256 * 128;
        const int dlo = lane & 15, sglo = lane >> 4;
#pragma unroll
        for (int i = 0; i < 8; ++i) { const int combo = wave * 8 + i, d = (combo >> 2) * 16 + dlo, s0 = ((combo & 3) * 4 + sglo) * 8;
            float v[8];
#pragma unroll
            for (int e = 0; e < 8; ++e) v[e] = bf2f(*(const LAS bf16_t*)(KL + (s0 + e) * PQ_PITCH + d * 2)) * __expf(AS[s0 + e] - Mlast);
            u32x4 o; o.x = pk2(v[0], v[1]); o.y = pk2(v[2], v[3]); o.z = pk2(v[4], v[5]); o.w = pk2(v[6], v[7]);
            *(u32x4*)((unsigned char*)Kg + fm_off(d, s0, 4)) = o; }
    }
    __syncthreads();
}

__device__ __forceinline__ void hgrn_pre_load(const DArgs& a, int round, int item, u32x4 (&gq)[4]) {
    const int tid = tid_();
    const int p = item >> 7, c = item & 127, bl = p >> 3, h = p & 7;
    const int tl0 = bl * SEQ + c * 64;
    GAS unsigned char* ws = a.ws;
#pragma unroll
    for (int i = 0; i < 2; ++i) { const int idx = tid + 512 * i, s = idx >> 4, ch = idx & 15;
        gq[2 * i] = *(const GAS u32x4*)((const GAS bf16_t*)(ws + WS_GFLOG) + (size_t)(tl0 + s) * 1024 + h * 128 + ch * 8);
        gq[2 * i + 1] = *(const GAS u32x4*)((const GAS bf16_t*)(ws + WS_GQ) + (size_t)(tl0 + s) * 1024 + h * 128 + ch * 8); }
}
__device__ __forceinline__ void hgrn_pre_item(const DArgs& a, LAS unsigned char* lds, int round, int item, u32x4 (&gq)[4], int next_item) {
    const int tid = tid_(), lane = tid & 63, wave = __builtin_amdgcn_readfirstlane(tid >> 6), fr = lane & 15, fq = lane >> 4;
    const int p = item >> 7, c = item & 127, bl = p >> 3, h = p & 7;
    const int tl0 = bl * SEQ + c * 64;
    GAS unsigned char* ws = a.ws;
    LAS float* CUM = (LAS float*)lds;
    LAS float* GL = (LAS float*)(lds + 32768);
    LAS unsigned char* QH = lds + 65536;
    LAS unsigned char* KE = lds + 65536 + 64 * PS_PITCH;
    LAS float* QF = (LAS float*)(lds + 65536 + 128 * PS_PITCH);
#pragma unroll
    for (int i = 0; i < 2; ++i) { const int idx = tid + 512 * i, s = idx >> 4, ch = idx & 15;
        const u32x4 gv = gq[2 * i], qv = gq[2 * i + 1];
        LAS float* gd = GL + s * 128 + ch * 8; LAS float* qd = QF + s * 128 + ch * 8;
        gd[0] = bf_lo(gv.x); gd[1] = bf_hi(gv.x); gd[2] = bf_lo(gv.y); gd[3] = bf_hi(gv.y); gd[4] = bf_lo(gv.z); gd[5] = bf_hi(gv.z); gd[6] = bf_lo(gv.w); gd[7] = bf_hi(gv.w);
        qd[0] = bf_lo(qv.x); qd[1] = bf_hi(qv.x); qd[2] = bf_lo(qv.y); qd[3] = bf_hi(qv.y); qd[4] = bf_lo(qv.z); qd[5] = bf_hi(qv.z); qd[6] = bf_lo(qv.w); qd[7] = bf_hi(qv.w); }
    if (next_item < 2048) hgrn_pre_load(a, round, next_item, gq);
    LDS_BAR();
    {
        const int d = tid & 127, qt = tid >> 7; float cs = 0.f;
#pragma unroll 4
        for (int s = 0; s < 16; ++s) { cs += GL[(qt * 16 + s) * 128 + d]; CUM[(qt * 16 + s) * 128 + d] = cs; }
        LDS_BAR();
        float off = 0.f;
#pragma unroll
        for (int q = 0; q < 3; ++q) off += (q < qt) ? CUM[(q * 16 + 15) * 128 + d] : 0.f;
        LDS_BAR();
#pragma unroll 4
        for (int s = 0; s < 16; ++s) CUM[(qt * 16 + s) * 128 + d] += off;
        if (qt == 3) ((GAS float*)(ws + WS_HGDEC))[(size_t)item * 128 + d] = __expf(cs + off);
    }
    LDS_BAR();
    {
        bf16_t* Qg = (bf16_t*)(ws + WS_QTG) + (size_t)item * 64 * 128;
#pragma unroll
        for (int i = 0; i < 2; ++i) { const int idx = tid + 512 * i, s = idx >> 4, ch = idx & 15;
            float qt[8], qh[8], ke[8];
#pragma unroll
            for (int e = 0; e < 8; ++e) { const int d = ch * 8 + e; const float cm = CUM[s * 128 + d], last = CUM[63 * 128 + d], q = QF[s * 128 + d], g = GL[s * 128 + d];
                qt[e] = q * __expf(cm); qh[e] = q * __expf(cm - last); ke[e] = (1.0f - __expf(g)) * __expf(last - cm); }
            u32x4 o; o.x = pk2(qt[0], qt[1]); o.y = pk2(qt[2], qt[3]); o.z = pk2(qt[4], qt[5]); o.w = pk2(qt[6], qt[7]);
            *(u32x4*)((unsigned char*)Qg + fm_off(s, ch * 8, 4)) = o;
            o.x = pk2(qh[0], qh[1]); o.y = pk2(qh[2], qh[3]); o.z = pk2(qh[4], qh[5]); o.w = pk2(qh[6], qh[7]);
            *(LAS u32x4*)(QH + s * PS_PITCH + ch * 16) = o;
            o.x = pk2(ke[0], ke[1]); o.y = pk2(ke[2], ke[3]); o.z = pk2(ke[4], ke[5]); o.w = pk2(ke[6], ke[7]);
            *(LAS u32x4*)(KE + s * PS_PITCH + ch * 16) = o; }
    }
    LDS_BAR();
    {
        bf16_t* Ag = (bf16_t*)(ws + WS_ATT) + (size_t)item * 64 * 64;
#pragma unroll
        for (int i = 0; i < 2; ++i) { const int tile = wave * 2 + i, tt = tile >> 2, st = tile & 3; const int t = tt * 16 + fr;
            u32x2 o = (u32x2){0u, 0u};
            if (st <= tt) { f32x4 acc = (f32x4){0.f, 0.f, 0.f, 0.f};
#pragma unroll
                for (int ks = 0; ks < 4; ++ks) acc = MFMA16(lfrag(KE, PS_PITCH, st * 16 + fr, ks * 32, fq), lfrag(QH, PS_PITCH, tt * 16 + fr, ks * 32, fq), acc);
                float v[4];
#pragma unroll
                for (int j = 0; j < 4; ++j) { const int s = st * 16 + 4 * fq + j; v[j] = (s <= t) ? acc[j] : 0.f; }
                o.x = pk2(v[0], v[1]); o.y = pk2(v[2], v[3]); }
            *(u32x2*)((unsigned char*)Ag + fm_off(t, st * 16 + 4 * fq, 2)) = o; }
    }
    {
        bf16_t* Kg = (bf16_t*)(ws + WS_KENDT) + (size_t)item * 128 * 64;
        const int dlo = lane & 15, sglo = lane >> 4;
#pragma unroll
        for (int i = 0; i < 2; ++i) { const int combo = wave * 2 + i, d = (combo >> 1) * 16 + dlo, s0 = ((combo & 1) * 4 + sglo) * 8;
            unsigned v[8];
#pragma unroll
            for (int e = 0; e < 8; ++e) v[e] = *(const LAS bf16_t*)(KE + (s0 + e) * PS_PITCH + d * 2);
            u32x4 o; o.x = v[0] | (v[1] << 16); o.y = v[2] | (v[3] << 16); o.z = v[4] | (v[5] << 16); o.w = v[6] | (v[7] << 16);
            *(u32x4*)((unsigned char*)Kg + fm_off(d, s0, 2)) = o; }
    }
    LDS_BAR();
}

template <int NVT, bool DEN>
__device__ __forceinline__ void mlstm_scan(const DArgs& a, LAS unsigned char* lds, int round, int p, int sl) {
    const int tid = tid_(), lane = tid & 63, wave = __builtin_amdgcn_readfirstlane(tid >> 6), fr = lane & 15, fq = lane >> 4;
    const int bl = p >> 2, h = p & 3, b = round * 2 + bl;
    GAS unsigned char* ws = a.ws;
    constexpr int VTB = NVT * 16 * PS_PITCH, CTB = NVT * 16 * PQ_PITCH;
    LAS unsigned char* VT = lds; LAS unsigned char* CT = lds + 2 * VTB; LAS float* DEC = (LAS float*)(lds + 2 * VTB + 2 * CTB);
    for (int i = tid; i < (2 * VTB + 2 * CTB) / 4; i += NTHR) ((LAS unsigned*)lds)[i] = 0u;
    if (tid < 64) DEC[tid] = ((const GAS float*)(ws + WS_MDEC))[p * 64 + tid];
    __syncthreads();
    if (DEN) { if (tid < 256) { const int bufi = tid >> 7, s = tid & 127; *(LAS bf16_t*)(VT + bufi * VTB + s * 2) = (bf16_t)0x3F80; } }
    f32x4 st[2][NVT];
#pragma unroll
    for (int dt = 0; dt < 2; ++dt)
#pragma unroll
        for (int vt = 0; vt < NVT; ++vt) st[dt][vt] = (f32x4){0.f, 0.f, 0.f, 0.f};
    const int vcol = h * 512 + sl * 32;
    const int vs = tid >> 2, vpart = tid & 3;
    const GAS unsigned char* Sg0 = ws + WS_S + (size_t)(p * 64) * 32768 + wave * 4096 + lane * 16;
    const GAS unsigned char* Qg0 = ws + WS_QT + (size_t)(p * 64) * 65536 + wave * 8192 + lane * 16;
    const GAS unsigned char* Kg0 = ws + WS_KWT + (size_t)(p * 64) * 65536 + wave * 8192 + lane * 16;
    const GAS bf16_t* Vg0 = (const GAS bf16_t*)(ws + WS_V) + (size_t)(bl * SEQ + vs) * 2048 + vcol + vpart * 8;
    bf16x8 bS[4], bQ[8], aK[2][4]; u32x4 vreg = (u32x4){0u, 0u, 0u, 0u};
#define V_STAGE(cc_) do { LAS unsigned char* d0_ = VT + ((cc_) & 1) * VTB + (vpart * 8) * PS_PITCH + vs * 2; \
        *(LAS bf16_t*)(d0_ + 0 * PS_PITCH) = (bf16_t)(vreg.x & 0xffffu); *(LAS bf16_t*)(d0_ + 1 * PS_PITCH) = (bf16_t)(vreg.x >> 16); \
        *(LAS bf16_t*)(d0_ + 2 * PS_PITCH) = (bf16_t)(vreg.y & 0xffffu); *(LAS bf16_t*)(d0_ + 3 * PS_PITCH) = (bf16_t)(vreg.y >> 16); \
        *(LAS bf16_t*)(d0_ + 4 * PS_PITCH) = (bf16_t)(vreg.z & 0xffffu); *(LAS bf16_t*)(d0_ + 5 * PS_PITCH) = (bf16_t)(vreg.z >> 16); \
        *(LAS bf16_t*)(d0_ + 6 * PS_PITCH) = (bf16_t)(vreg.w & 0xffffu); *(LAS bf16_t*)(d0_ + 7 * PS_PITCH) = (bf16_t)(vreg.w >> 16); } while (0)
    if (!DEN) { vreg = *(const GAS u32x4*)Vg0; V_STAGE(0); }
    __builtin_amdgcn_sched_barrier(0);
#pragma unroll
    for (int ks = 0; ks < 4; ++ks)
#pragma unroll
        for (int dt = 0; dt < 2; ++dt) aK[dt][ks] = *(const GAS bf16x8*)(Kg0 + (dt * 4 + ks) * 1024);
    __builtin_amdgcn_sched_barrier(0);
#pragma unroll
    for (int ks = 0; ks < 4; ++ks) bS[ks] = *(const GAS bf16x8*)(Sg0 + ks * 1024);
    __builtin_amdgcn_sched_barrier(0);
#pragma unroll
    for (int ks = 0; ks < 8; ++ks) bQ[ks] = *(const GAS bf16x8*)(Qg0 + ks * 1024);
    __builtin_amdgcn_sched_barrier(0);
    if (!DEN) vreg = *(const GAS u32x4*)(Vg0 + (size_t)128 * 2048);
    __builtin_amdgcn_sched_barrier(0);
    const GAS unsigned char* pfp; unsigned pfstride;
    { const int tt = (wave * 64 + lane) < 160 ? wave * 64 + lane : 159; const int idx = sl * 10 + (tt >> 4), off = (tt & 15) * 64;
      pfp = (idx < 32 ? ws + WS_S + (size_t)(p * 64) * 32768 + idx * 1024 : idx < 96 ? ws + WS_QT + (size_t)(p * 64) * 65536 + (idx - 32) * 1024 : ws + WS_KWT + (size_t)(p * 64) * 65536 + (idx - 96) * 1024) + off;
      pfstride = idx < 32 ? 32768u : 65536u; }
    unsigned pfv = 0u;
#pragma unroll 1
    for (int c = 0; c < 64; ++c) {
        const int tl0 = bl * SEQ + c * 128; const size_t tg0 = (size_t)b * SEQ + c * 128;
        const int cn = c < 63 ? c + 1 : 63, cn2 = c < 62 ? c + 2 : 63;
        LAS unsigned char* vt_ = VT + (c & 1) * VTB; LAS unsigned char* ct_ = CT + (c & 1) * CTB; LAS unsigned char* ctn = CT + ((c + 1) & 1) * CTB;
        LDS_BAR();
        if (!DEN && wave < 3) { asm volatile("" :: "v"(pfv)); const int c3 = c < 60 ? c + 3 : 63; pfv = *(const GAS unsigned*)(pfp + (size_t)c3 * pfstride); }
        bf16x8 vf[NVT][4], cf[NVT][4];
#pragma unroll
        for (int vt = 0; vt < NVT; ++vt)
#pragma unroll
            for (int ks = 0; ks < 4; ++ks) vf[vt][ks] = lfrag(vt_, PS_PITCH, vt * 16 + fr, ks * 32, fq);
        const float dec = DEC[c];
        __builtin_amdgcn_sched_barrier(0);
#pragma unroll
        for (int dt = 0; dt < 2; ++dt)
#pragma unroll
            for (int vt = 0; vt < NVT; ++vt) st[dt][vt] = st[dt][vt] * dec;
#pragma unroll
        for (int ks = 0; ks < 4; ++ks) {
#pragma unroll
            for (int vt = 0; vt < NVT; ++vt) cf[vt][ks] = lfrag(ct_, PQ_PITCH, vt * 16 + fr, ks * 32, fq);
#pragma unroll
            for (int dt = 0; dt < 2; ++dt) {
#pragma unroll
                for (int vt = 0; vt < NVT; ++vt) st[dt][vt] = MFMA16(aK[dt][ks], vf[vt][ks], st[dt][vt]);
                aK[dt][ks] = *(const GAS bf16x8*)(Kg0 + (size_t)cn * 65536 + (dt * 4 + ks) * 1024);
            }
            __builtin_amdgcn_sched_barrier(0);
        }
#pragma unroll
        for (int dt = 0; dt < 2; ++dt)
#pragma unroll
            for (int vt = 0; vt < NVT; ++vt) { u32x2 o; o.x = pk2(st[dt][vt][0], st[dt][vt][1]); o.y = pk2(st[dt][vt][2], st[dt][vt][3]);
                *(LAS u32x2*)(ctn + (vt * 16 + fr) * PQ_PITCH + (wave * 32 + dt * 16 + 4 * fq) * 2) = o; }
        __builtin_amdgcn_sched_barrier(0);
        f32x4 acc[NVT];
#pragma unroll
        for (int vt = 0; vt < NVT; ++vt) acc[vt] = (f32x4){0.f, 0.f, 0.f, 0.f};
#pragma unroll
        for (int ks = 0; ks < 4; ++ks) {
#pragma unroll
            for (int vt = 0; vt < NVT; ++vt) acc[vt] = MFMA16(vf[vt][ks], bS[ks], acc[vt]);
            bS[ks] = *(const GAS bf16x8*)(Sg0 + (size_t)cn * 32768 + ks * 1024);
            __builtin_amdgcn_sched_barrier(0);
        }
#pragma unroll
        for (int ks = 0; ks < 8; ++ks) {
#pragma unroll
            for (int vt = 0; vt < NVT; ++vt) acc[vt] = MFMA16(cf[vt][ks & 3], bQ[ks], acc[vt]);
            if (ks < 4) {
#pragma unroll
                for (int vt = 0; vt < NVT; ++vt) cf[vt][ks] = lfrag(ct_, PQ_PITCH, vt * 16 + fr, 128 + ks * 32, fq);
            }
            bQ[ks] = *(const GAS bf16x8*)(Qg0 + (size_t)cn * 65536 + ks * 1024);
            __builtin_amdgcn_sched_barrier(0);
        }
        const int t = wave * 16 + fr;
        if (!DEN) {
            GAS bf16_t* hn = (GAS bf16_t*)(ws + WS_QKPRE) + (size_t)(tl0 + t) * 2048 + vcol + 4 * fq;
#pragma unroll
            for (int vt = 0; vt < NVT; ++vt) { u32x2 o; o.x = pk2(acc[vt][0], acc[vt][1]); o.y = pk2(acc[vt][2], acc[vt][3]); *(GAS u32x2*)(hn + vt * 16) = o; }
            V_STAGE(c + 1); vreg = *(const GAS u32x4*)(Vg0 + (size_t)cn2 * 128 * 2048);
        } else {
            if (fq == 0) ((GAS float*)(ws + WS_DEN))[(tg0 + t) * 4 + h] = acc[0][0];
        }
    }
    asm volatile("" :: "v"(pfv));
    __syncthreads();
#undef V_STAGE
}

constexpr int HG_PD = 4;
__device__ __forceinline__ void hgrn_scan(const DArgs& a, LAS unsigned char* lds, int round, int p, int sl) {
    const int tid = tid_(), lane = tid & 63, wave = __builtin_amdgcn_readfirstlane(tid >> 6), fr = lane & 15, fq = lane >> 4;
    const int bl = p >> 3, h = p & 7;
    GAS unsigned char* ws = a.ws;
    constexpr int IP = 144, ITB = 32 * IP, STB = 32 * PS_PITCH;
    LAS unsigned char* IT = lds; LAS unsigned char* ST = lds + 2 * ITB;
    for (int i = tid; i < (2 * ITB + 2 * STB) / 4; i += NTHR) ((LAS unsigned*)lds)[i] = 0u;
    __syncthreads();
    f32x4 st[2][2];
#pragma unroll
    for (int i = 0; i < 2; ++i) { st[i][0] = (f32x4){0.f, 0.f, 0.f, 0.f}; st[i][1] = st[i][0]; }
    const int vcol = h * 128 + sl * 32;
    const int is = (tid & 255) >> 2, ipart = tid & 3;
    const bool outw = wave < 4;
    const int w4 = wave & 3;
    const GAS unsigned char* Ag0 = ws + WS_ATT + (size_t)(p * 128) * 8192 + w4 * 2048 + lane * 16;
    const GAS unsigned char* Qg0 = ws + WS_QTG + (size_t)(p * 128) * 16384 + w4 * 4096 + lane * 16;
    const GAS unsigned char* Kg0 = ws + WS_KENDT + (size_t)(p * 128) * 16384 + w4 * 4096 + lane * 16;
    const GAS unsigned char* Dg0 = ws + WS_HGDEC + ((size_t)(p * 128) * 128 + w4 * 32 + 4 * fq) * 4;
    const GAS unsigned char* Ig0 = ws + WS_GI + ((size_t)(bl * SEQ + is) * 1024 + vcol + ipart * 8) * 2;
    const GAS unsigned char* gb0 = outw ? Ag0 : Kg0;          const unsigned gs0 = outw ? 8192u : 16384u;
    const GAS unsigned char* gb1 = outw ? Qg0 : Kg0 + 2048;   const unsigned gs1 = 16384u;
    const GAS unsigned char* gb2 = outw ? Qg0 + 2048 : Dg0;   const unsigned gs2 = outw ? 16384u : 512u, gt2 = outw ? 1024u : 64u;
    const GAS unsigned char* gb3 = outw ? Ig0 : Dg0;          const unsigned gs3 = outw ? 131072u : 512u;
    u32x4 pf[HG_PD][7];
#define HG_LD01(k_, cc_) do { _Pragma("unroll") for (int j_ = 0; j_ < 2; ++j_) pf[k_][j_] = *(const GAS u32x4*)(gb0 + (size_t)(cc_) * gs0 + j_ * 1024); } while (0)
#define HG_LD23(k_, cc_) do { _Pragma("unroll") for (int j_ = 0; j_ < 2; ++j_) pf[k_][2 + j_] = *(const GAS u32x4*)(gb1 + (size_t)(cc_) * gs1 + j_ * 1024); } while (0)
#define HG_LD45(k_, cc_) do { _Pragma("unroll") for (int j_ = 0; j_ < 2; ++j_) pf[k_][4 + j_] = *(const GAS u32x4*)(gb2 + (size_t)(cc_) * gs2 + j_ * gt2); } while (0)
#define HG_LD6(k_, cc_) do { pf[k_][6] = *(const GAS u32x4*)(gb3 + (size_t)(cc_) * gs3); } while (0)
#pragma unroll
    for (int k = 0; k < HG_PD; ++k) { HG_LD01(k, k); HG_LD23(k, k); HG_LD45(k, k); __builtin_amdgcn_sched_barrier(0); HG_LD6((k + 1) % HG_PD, (k + 1 < HG_PD ? k + 1 : HG_PD)); __builtin_amdgcn_sched_barrier(0); }
    const GAS unsigned char* pfp; unsigned pfstride;
    { const int tt = (wave * 64 + lane) < 160 ? wave * 64 + lane : 159; const int idx = sl * 10 + (tt >> 4), off = (tt & 15) * 64;
      pfp = (idx < 8 ? ws + WS_ATT + (size_t)(p * 128) * 8192 + idx * 1024 : idx < 24 ? ws + WS_QTG + (size_t)(p * 128) * 16384 + (idx - 8) * 1024 : ws + WS_KENDT + (size_t)(p * 128) * 16384 + (idx - 24) * 1024) + off;
      pfstride = idx < 8 ? 8192u : 16384u; }
    unsigned pfv[HG_PD];
#pragma unroll
    for (int k = 0; k < HG_PD; ++k) pfv[k] = 0u;
#define HG_STAGE(dst_, iv_) do { LAS unsigned char* d0_ = (dst_) + (ipart * 8) * IP + is * 2; \
        *(LAS bf16_t*)(d0_ + 0 * IP) = (bf16_t)((iv_).x & 0xffffu); *(LAS bf16_t*)(d0_ + 1 * IP) = (bf16_t)((iv_).x >> 16); \
        *(LAS bf16_t*)(d0_ + 2 * IP) = (bf16_t)((iv_).y & 0xffffu); *(LAS bf16_t*)(d0_ + 3 * IP) = (bf16_t)((iv_).y >> 16); \
        *(LAS bf16_t*)(d0_ + 4 * IP) = (bf16_t)((iv_).z & 0xffffu); *(LAS bf16_t*)(d0_ + 5 * IP) = (bf16_t)((iv_).z >> 16); \
        *(LAS bf16_t*)(d0_ + 6 * IP) = (bf16_t)((iv_).w & 0xffffu); *(LAS bf16_t*)(d0_ + 7 * IP) = (bf16_t)((iv_).w >> 16); } while (0)
    if (outw) { const u32x4 iv = *(const GAS u32x4*)Ig0; HG_STAGE(IT, iv); }
#pragma unroll 1
    for (int c0 = 0; c0 < 128; c0 += HG_PD) {
#pragma unroll
      for (int k = 0; k < HG_PD; ++k) {
        const int c = c0 + k;
        const int tl0 = bl * SEQ + c * 64;
        const int cn = (c + HG_PD < 128) ? c + HG_PD : 127;
        LAS unsigned char* it_ = IT + (k & 1) * ITB; LAS unsigned char* itn = IT + ((k + 1) & 1) * ITB; LAS unsigned char* st_ = ST + (k & 1) * STB; LAS unsigned char* stn = ST + ((k + 1) & 1) * STB;
        LDS_BAR();
        if (wave < 3) { asm volatile("" :: "v"(pfv[k])); const int c7 = (c + HG_PD + 3 < 128) ? c + HG_PD + 3 : 127; pfv[k] = *(const GAS unsigned*)(pfp + (size_t)c7 * pfstride); }
        bf16x8 itf[2][2];
#pragma unroll
        for (int vt = 0; vt < 2; ++vt)
#pragma unroll
            for (int ks = 0; ks < 2; ++ks) itf[vt][ks] = lfrag(it_, IP, vt * 16 + fr, ks * 32, fq);
        bf16x8 sf[2][4];
        f32x4 acc[2];
        acc[0] = (f32x4){0.f, 0.f, 0.f, 0.f}; acc[1] = acc[0];
        if (outw) {
#pragma unroll
            for (int vt = 0; vt < 2; ++vt)
#pragma unroll
                for (int ks = 0; ks < 4; ++ks) sf[vt][ks] = lfrag(st_, PS_PITCH, vt * 16 + fr, ks * 32, fq);
#pragma unroll
            for (int ks = 0; ks < 2; ++ks)
#pragma unroll
                for (int vt = 0; vt < 2; ++vt) acc[vt] = MFMA16(itf[vt][ks], __builtin_bit_cast(bf16x8, pf[k][ks]), acc[vt]);
        } else {
            const f32x4 dec = __builtin_bit_cast(f32x4, pf[k][4]);
#pragma unroll
            for (int vt = 0; vt < 2; ++vt) { st[0][vt] = st[0][vt] * dec;
#pragma unroll
                for (int ks = 0; ks < 2; ++ks) st[0][vt] = MFMA16(__builtin_bit_cast(bf16x8, pf[k][ks]), itf[vt][ks], st[0][vt]); }
        }
        __builtin_amdgcn_sched_barrier(0);
        HG_LD01(k, cn);
        __builtin_amdgcn_sched_barrier(0);
        if (outw) {
#pragma unroll
            for (int ks = 0; ks < 2; ++ks)
#pragma unroll
                for (int vt = 0; vt < 2; ++vt) acc[vt] = MFMA16(sf[vt][ks], __builtin_bit_cast(bf16x8, pf[k][2 + ks]), acc[vt]);
        } else {
            const f32x4 dec = __builtin_bit_cast(f32x4, pf[k][5]);
#pragma unroll
            for (int vt = 0; vt < 2; ++vt) { st[1][vt] = st[1][vt] * dec;
#pragma unroll
                for (int ks = 0; ks < 2; ++ks) st[1][vt] = MFMA16(__builtin_bit_cast(bf16x8, pf[k][2 + ks]), itf[vt][ks], st[1][vt]); }
        }
        __builtin_amdgcn_sched_barrier(0);
        HG_LD23(k, cn);
        __builtin_amdgcn_sched_barrier(0);
        if (outw) {
#pragma unroll
            for (int ks = 2; ks < 4; ++ks)
#pragma unroll
                for (int vt = 0; vt < 2; ++vt) acc[vt] = MFMA16(sf[vt][ks], __builtin_bit_cast(bf16x8, pf[k][2 + ks]), acc[vt]);
        } else {
#pragma unroll
            for (int dtile = 0; dtile < 2; ++dtile)
#pragma unroll
                for (int vt = 0; vt < 2; ++vt) { u32x2 o; o.x = pk2(st[dtile][vt][0], st[dtile][vt][1]); o.y = pk2(st[dtile][vt][2], st[dtile][vt][3]);
                    *(LAS u32x2*)(stn + (vt * 16 + fr) * PS_PITCH + (w4 * 32 + dtile * 16 + 4 * fq) * 2) = o; }
        }
        __builtin_amdgcn_sched_barrier(0);
        HG_LD45(k, cn);
        __builtin_amdgcn_sched_barrier(0);
        if (outw) {
            HG_STAGE(itn, pf[(k + 1) % HG_PD][6]);
            GAS bf16_t* og = (GAS bf16_t*)(ws + WS_GQ) + (size_t)(tl0 + w4 * 16 + fr) * 1024 + vcol + 4 * fq;
#pragma unroll
            for (int vt = 0; vt < 2; ++vt) { u32x2 o; o.x = pk2(acc[vt][0], acc[vt][1]); o.y = pk2(acc[vt][2], acc[vt][3]); *(GAS u32x2*)(og + vt * 16) = o; }
        }
        __builtin_amdgcn_sched_barrier(0);
        { const int cni = (c + 1 + HG_PD < 128) ? c + 1 + HG_PD : 127; HG_LD6((k + 1) % HG_PD, cni); }
        __builtin_amdgcn_sched_barrier(0);
      }
    }
#pragma unroll
    for (int k = 0; k < HG_PD; ++k) asm volatile("" :: "v"(pfv[k]));
    __syncthreads();
#undef HG_LD01
#undef HG_LD23
#undef HG_LD45
#undef HG_LD6
#undef HG_STAGE
}

__device__ __forceinline__ void xn8_convert(const DArgs& a, int round, int vcu, int G) {
    const int tid = tid_(), lane = tid & 63, wave = tid >> 6;
    const int gw = vcu * NWAVES + wave, NGW = G * NWAVES;
    GAS unsigned char* ws = a.ws;
    for (int tl = gw; tl < RT; tl += NGW) {
        const size_t tg = (size_t)round * RT + tl;
        const GAS u32x2* xr = (const GAS u32x2*)((const GAS bf16_t*)(ws + WS_XN) + tg * D) + lane;
        f32x4 v[4]; float mx = 0.f;
#pragma unroll
        for (int j = 0; j < 4; ++j) { const u32x2 xv = xr[64 * j]; v[j][0] = bf_lo(xv.x); v[j][1] = bf_hi(xv.x); v[j][2] = bf_lo(xv.y); v[j][3] = bf_hi(xv.y);
            mx = fmaxf(mx, fmaxf(fmaxf(fabsf(v[j][0]), fabsf(v[j][1])), fmaxf(fabsf(v[j][2]), fabsf(v[j][3])))); }
        mx = wave_max(mx);
        const float qs = mx > 0.f ? 127.0f / mx : 0.f;
#pragma unroll
        for (int j = 0; j < 4; ++j) ((GAS unsigned*)(ws + WS_XN8 + (size_t)tl * 1024))[64 * j + lane] = pack_i8x4(v[j][0] * qs, v[j][1] * qs, v[j][2] * qs, v[j][3] * qs);
        if (lane == 0) ((GAS float*)(ws + WS_SA8))[tg] = mx * (1.0f / 127.0f);
    }
}

__device__ __forceinline__ void phase_ypass(const DArgs& a, int round, int vcu, int G) {
    const int tid = tid_(), lane = tid & 63, wave = tid >> 6;
    const int gw = vcu * NWAVES + wave, NGW = G * NWAVES;
    GAS unsigned char* ws = a.ws;
    f32x4 mg0[4], mg1[4], gg4[4];
#pragma unroll
    for (int j = 0; j < 4; ++j) { mg0[j] = *(const GAS f32x4*)(a.m_head_g + j * 512 + lane * 8); mg1[j] = *(const GAS f32x4*)(a.m_head_g + j * 512 + lane * 8 + 4); gg4[j] = *(const GAS f32x4*)(a.g_head_g + lane * 16 + 4 * j); }
    for (int tl = gw; tl < RT; tl += NGW) {
        const size_t tg = (size_t)round * RT + tl;
        const f32x4 den4 = *(const f32x4*)((const float*)(ws + WS_DEN) + tg * 4), mt4 = *(const f32x4*)((const float*)(ws + WS_MT) + tg * 4);
        float ym[4][8];
#pragma unroll
        for (int j = 0; j < 4; ++j) {
            const int col = j * 512 + lane * 8;
            const u32x4 nv = *(const u32x4*)((const bf16_t*)(ws + WS_QKPRE) + (size_t)tl * 2048 + col);
            const u32x4 ov = *(const u32x4*)((const bf16_t*)(ws + WS_SIGO) + (size_t)tl * 2048 + col);
            const float inv = 1.0f / fmaxf(fabsf(den4[j]), __expf(-mt4[j]));
            float hv[8] = {bf_lo(nv.x) * inv, bf_hi(nv.x) * inv, bf_lo(nv.y) * inv, bf_hi(nv.y) * inv, bf_lo(nv.z) * inv, bf_hi(nv.z) * inv, bf_lo(nv.w) * inv, bf_hi(nv.w) * inv};
            float ss = 0.f;
#pragma unroll
            for (int e = 0; e < 8; ++e) ss += hv[e] * hv[e];
            const float r = rsqrtf(wave_sum(ss, lane) * (1.f / 512.f) + EPS);
            const f32x4 g0 = mg0[j], g1 = mg1[j];
            const float og[8] = {bf_lo(ov.x), bf_hi(ov.x), bf_lo(ov.y), bf_hi(ov.y), bf_lo(ov.z), bf_hi(ov.z), bf_lo(ov.w), bf_hi(ov.w)};
#pragma unroll
            for (int e = 0; e < 8; ++e) ym[j][e] = og[e] * hv[e] * r * (e < 4 ? g0[e] : g1[e - 4]);
        }
        {
            float mx = 0.f;
#pragma unroll
            for (int j = 0; j < 4; ++j)
#pragma unroll
                for (int e = 0; e < 8; ++e) mx = fmaxf(mx, fabsf(ym[j][e]));
            mx = wave_max(mx);
            const float qs = mx > 0.f ? 127.0f / mx : 0.f;
#pragma unroll
            for (int j = 0; j < 4; ++j) { u32x2 o; o.x = pack_i8x4(ym[j][0] * qs, ym[j][1] * qs, ym[j][2] * qs, ym[j][3] * qs); o.y = pack_i8x4(ym[j][4] * qs, ym[j][5] * qs, ym[j][6] * qs, ym[j][7] * qs);
                *(GAS u32x2*)(ws + WS_V + (size_t)tl * 2048 + j * 512 + lane * 8) = o; }
            if (lane == 0) ((GAS float*)(ws + WS_SYM))[tl] = mx * (1.0f / 127.0f);
        }
        {
            const int col = lane * 16;
            const u32x4 n0 = *(const u32x4*)((const bf16_t*)(ws + WS_GQ) + (size_t)tl * 1024 + col), n1 = *(const u32x4*)((const bf16_t*)(ws + WS_GQ) + (size_t)tl * 1024 + col + 8);
            const u32x4 s0 = *(const u32x4*)((const bf16_t*)(ws + WS_SGG) + (size_t)tl * 1024 + col), s1 = *(const u32x4*)((const bf16_t*)(ws + WS_SGG) + (size_t)tl * 1024 + col + 8);
            float ov[16] = {bf_lo(n0.x), bf_hi(n0.x), bf_lo(n0.y), bf_hi(n0.y), bf_lo(n0.z), bf_hi(n0.z), bf_lo(n0.w), bf_hi(n0.w), bf_lo(n1.x), bf_hi(n1.x), bf_lo(n1.y), bf_hi(n1.y), bf_lo(n1.z), bf_hi(n1.z), bf_lo(n1.w), bf_hi(n1.w)};
            const float sg[16] = {bf_lo(s0.x), bf_hi(s0.x), bf_lo(s0.y), bf_hi(s0.y), bf_lo(s0.z), bf_hi(s0.z), bf_lo(s0.w), bf_hi(s0.w), bf_lo(s1.x), bf_hi(s1.x), bf_lo(s1.y), bf_hi(s1.y), bf_lo(s1.z), bf_hi(s1.z), bf_lo(s1.w), bf_hi(s1.w)};
            float ss = 0.f;
#pragma unroll
            for (int e = 0; e < 16; ++e) ss += ov[e] * ov[e];
            ss += DPP_(ss, 0xB1); ss += DPP_(ss, 0x4E); ss += DPP_(ss, 0x141);
            const float r = rsqrtf(ss * (1.f / 128.f) + EPS);
            float y[16];
#pragma unroll
            for (int e = 0; e < 16; ++e) y[e] = ov[e] * r * gg4[e >> 2][e & 3] * sg[e];
            float mx = 0.f;
#pragma unroll
            for (int e = 0; e < 16; ++e) mx = fmaxf(mx, fabsf(y[e]));
            mx = wave_max(mx);
            const float qs = mx > 0.f ? 127.0f / mx : 0.f;
            u32x4 o; o.x = pack_i8x4(y[0] * qs, y[1] * qs, y[2] * qs, y[3] * qs); o.y = pack_i8x4(y[4] * qs, y[5] * qs, y[6] * qs, y[7] * qs);
            o.z = pack_i8x4(y[8] * qs, y[9] * qs, y[10] * qs, y[11] * qs); o.w = pack_i8x4(y[12] * qs, y[13] * qs, y[14] * qs, y[15] * qs);
            *(GAS u32x4*)(ws + WS_GI + (size_t)tl * 1024 + col) = o;
            if (lane == 0) ((GAS float*)(ws + WS_SYG))[tl] = mx * (1.0f / 127.0f);
        }
    }
}


#define XB_TMO      128
#define XB_XCNT(j)  (256  + 64 * (j))
#define XB_XSUB(j)  (1280 + 64 * (j))
#define XB_XGEN(j)  (2304 + 64 * (j))
#define XB_TOP      3328
#define XB_TOPGEN   3392
#define XB_SPIN_CAP (1u << 22)
constexpr int CW_BAR = 4096;
constexpr int LDS_BARST = LDS_BYTES - 64;
__device__ __forceinline__ unsigned xb_ld(unsigned* p)              { return __hip_atomic_load(p, __ATOMIC_RELAXED, __HIP_MEMORY_SCOPE_AGENT); }
__device__ __forceinline__ unsigned xb_add(unsigned* p, unsigned v) { return __hip_atomic_fetch_add(p, v, __ATOMIC_RELAXED, __HIP_MEMORY_SCOPE_AGENT); }
__device__ __forceinline__ unsigned xb_xcc_id() { return (unsigned)__builtin_amdgcn_s_getreg((3 << 11) | 20) & 0xFu; }
#define XB_SPIN(cond, bar) do { unsigned _sp = 0; while (cond) { __builtin_amdgcn_s_sleep(1); \
    if ((++_sp & 255u) == 0u) { if (xb_ld(&(bar)[XB_TMO])) break; if (_sp > XB_SPIN_CAP) { atomicAdd(&(bar)[XB_TMO], 1u); break; } } } } while (0)
__device__ __forceinline__ void xcd_barrier_post(unsigned* bar, volatile LAS unsigned* st) { if (tid_() == 0) st[2] = xb_add(&bar[XB_XCNT(xb_xcc_id())], 1u); }
__device__ __forceinline__ void xcd_barrier_complete(unsigned* bar, unsigned x, unsigned& nloc, unsigned& nx) {
    const unsigned G = gridDim.x;
    unsigned sum, cnt, mine, sp = 0u;
    for (;;) {
        sum = 0u; cnt = 0u; mine = 0u;
#pragma unroll
        for (unsigned j = 0; j < 16; ++j) { const unsigned c = xb_ld(&bar[XB_XCNT(j)]); sum += c; cnt += (c > 0u) ? 1u : 0u; mine = (j == x) ? c : mine; }
        if (sum == G) break;
        __builtin_amdgcn_s_sleep(1);
        if ((++sp & 255u) == 0u) { if (xb_ld(&bar[XB_TMO])) break; if (sp > XB_SPIN_CAP) { atomicAdd(&bar[XB_TMO], 1u); break; } }
    }
    nloc = mine > 0u ? mine : 1u; nx = cnt > 0u ? cnt : 1u;
}
__device__ __forceinline__ void xcd_barrier(unsigned* bar, volatile LAS unsigned* st) {
    asm volatile("s_waitcnt vmcnt(0)" ::: "memory");
    __syncthreads();
    if (tid_() == 0) {
        const unsigned x = xb_xcc_id();
        __builtin_amdgcn_s_waitcnt(0);
        unsigned nloc = st[0], nx = st[1];
        if (nloc == 0u) { xcd_barrier_complete(bar, x, nloc, nx); st[0] = nloc; st[1] = nx; }
        const unsigned old = xb_add(&bar[XB_XSUB(x)], 1u);
        const unsigned gen = old / nloc;
        if (old + 1u == (gen + 1u) * nloc) {
            __builtin_amdgcn_fence(__ATOMIC_RELEASE, "agent");
            asm volatile("s_waitcnt vmcnt(0)" ::: "memory");
            const unsigned og = xb_add(&bar[XB_TOP], 1u);
            const unsigned tg = og / nx;
            if (og + 1u == (tg + 1u) * nx) xb_add(&bar[XB_TOPGEN], 1u);
            else XB_SPIN(xb_ld(&bar[XB_TOPGEN]) == tg, bar);
            __builtin_amdgcn_fence(__ATOMIC_ACQUIRE, "agent");
            xb_add(&bar[XB_XGEN(x)], 1u);
            asm volatile("s_waitcnt vmcnt(0)" ::: "memory");
        } else {
            XB_SPIN(xb_ld(&bar[XB_XGEN(x)]) == gen, bar);
            __builtin_amdgcn_fence(__ATOMIC_ACQUIRE, "agent");
            asm volatile("s_waitcnt vmcnt(0)" ::: "memory");
        }
    }
    __syncthreads();
}

__device__ __forceinline__ void phase_p8(const DArgs& a, int vcu, int G) {
    const int tid = tid_(), lane = tid & 63, wave = tid >> 6;
    const int gw = vcu * NWAVES + wave, NGW = G * NWAVES;
    GAS unsigned char* ws = a.ws;
    f32x4 g2[4];
#pragma unroll
    for (int j = 0; j < 4; ++j) g2[j] = ((const f32x4*)a.norm2_g)[64 * j + lane];
    for (int m = gw; m < T; m += NGW) {
        const GAS u32x2* xr = (const GAS u32x2*)((const GAS bf16_t*)a.out + (size_t)m * D) + lane;
        f32x4 v[4]; float s = 0.f;
#pragma unroll
        for (int j = 0; j < 4; ++j) { const u32x2 xv = xr[64 * j]; v[j][0] = bf_lo(xv.x); v[j][1] = bf_hi(xv.x); v[j][2] = bf_lo(xv.y); v[j][3] = bf_hi(xv.y); s += (v[j][0] * v[j][0] + v[j][1] * v[j][1]) + (v[j][2] * v[j][2] + v[j][3] * v[j][3]); }
        const float rstd = rsqrtf(wave_sum(s, lane) * (1.f / D) + EPS);
#pragma unroll
        for (int j = 0; j < 4; ++j) v[j] = v[j] * rstd * g2[j];
        float mx = 0.f;
#pragma unroll
        for (int j = 0; j < 4; ++j) mx = fmaxf(mx, fmaxf(fmaxf(fabsf(v[j][0]), fabsf(v[j][1])), fmaxf(fabsf(v[j][2]), fabsf(v[j][3]))));
        mx = wave_max(mx);
        const float qs = mx > 0.f ? 127.0f / mx : 0.f;
#pragma unroll
        for (int j = 0; j < 4; ++j) ((GAS unsigned*)(ws + WS_XQ + (size_t)m * 1024))[64 * j + lane] = pack_i8x4(v[j][0] * qs, v[j][1] * qs, v[j][2] * qs, v[j][3] * qs);
        if (lane == 0) ((GAS float*)(ws + WS_XQS))[m] = mx * (1.0f / 127.0f);
    }
    for (int e = gw; e < 16384; e += NGW) {
        f32x4 uv[4], vv[4]; float mu = 0.f, mv = 0.f;
#pragma unroll
        for (int j = 0; j < 4; ++j) { uv[j] = ((const GAS f32x4*)(a.u_emb + (size_t)e * 1024))[64 * j + lane]; vv[j] = ((const GAS f32x4*)(a.v_emb + (size_t)e * 1024))[64 * j + lane];
            mu = fmaxf(mu, fmaxf(fmaxf(fabsf(uv[j][0]), fabsf(uv[j][1])), fmaxf(fabsf(uv[j][2]), fabsf(uv[j][3]))));
            mv = fmaxf(mv, fmaxf(fmaxf(fabsf(vv[j][0]), fabsf(vv[j][1])), fmaxf(fabsf(vv[j][2]), fabsf(vv[j][3])))); }
        mu = wave_max(mu); mv = wave_max(mv);
        const float su = mu > 0.f ? 127.0f / mu : 0.f, sv = mv > 0.f ? 448.0f / mv : 0.f;
        if (lane == 0) { ((GAS float*)(ws + WS_USC))[e] = mu * (1.0f / 127.0f); ((GAS float*)(ws + WS_VSC))[e] = mv * (1.0f / 448.0f); }
#pragma unroll
        for (int j = 0; j < 4; ++j) {
            const size_t ob = (size_t)(2 * j + (lane >> 5)) * 2097152 + (size_t)e * 128 + ((4 * lane) & 127);
            *(GAS unsigned*)(ws + WS_UB + ob) = pack_i8x4(uv[j][0] * su, uv[j][1] * su, uv[j][2] * su, uv[j][3] * su);
            int p = __builtin_amdgcn_cvt_pk_fp8_f32(vv[j][0] * sv, vv[j][1] * sv, 0, false); p = __builtin_amdgcn_cvt_pk_fp8_f32(vv[j][2] * sv, vv[j][3] * sv, p, true);
            *(GAS unsigned*)(ws + WS_VB + ob) = (unsigned)p; }
    }
}

__device__ __forceinline__ unsigned f2ord(float f) { const unsigned u = __builtin_bit_cast(unsigned, f); return (u & 0x80000000u) ? ~u : (u | 0x80000000u); }
__device__ __forceinline__ float ord2f(unsigned k) { const unsigned u = (k & 0x80000000u) ? (k & 0x7fffffffu) : ~k; return __builtin_bit_cast(float, u); }
__device__ __forceinline__ unsigned umax_(unsigned a, unsigned b) { return a > b ? a : b; }
__device__ __forceinline__ unsigned shxu(unsigned v, int o, int lane) { return (unsigned)__builtin_amdgcn_ds_bpermute((lane ^ o) << 2, (int)v); }

__device__ __forceinline__ void phase_topk(const DArgs& a, LAS unsigned char* lds, int bx, int G) {
    const int tid = tid_(), lane = tid & 63, wave = __builtin_amdgcn_readfirstlane(tid >> 6), fr = lane & 15, fq = lane >> 4;
    GAS unsigned char* ws = a.ws;
    const int h = bx & 7;
    LAS unsigned char* KY = lds;
    LAS unsigned char* QL = lds + 2 * 128 * PS_PITCH;
    LAS unsigned* TOP = (LAS unsigned*)(lds + 2 * 128 * PS_PITCH + 64 * PQ_PITCH);
#pragma unroll
    for (int i = 0; i < 8; ++i) { const int idx = tid + 512 * i, row = idx >> 4, ch = idx & 15;
        *(LAS u32x4*)(KY + row * PS_PITCH + ch * 16) = *(const u32x4*)((const bf16_t*)(ws + WS_SK) + ((size_t)h * 256 + row) * 128 + ch * 8); }
    const int ntile = T / 64;
    u32x4 qpre[4];
    { const int tile0 = bx >> 3; if (tile0 < ntile) {
#pragma unroll
        for (int i = 0; i < 4; ++i) { const int idx = tid + 512 * i, row = idx >> 5, ch = idx & 31;
            qpre[i] = *(const GAS u32x4*)((const GAS bf16_t*)(ws + WS_QP) + ((size_t)tile0 * 64 + row) * 2048 + h * 256 + ch * 8); } } }
    __syncthreads();
    for (int tile = bx >> 3; tile < ntile; tile += (G >> 3)) {
        const size_t t0 = (size_t)tile * 64;
        LDS_BAR();
#pragma unroll
        for (int i = 0; i < 4; ++i) { const int idx = tid + 512 * i, row = idx >> 5, ch = idx & 31;
            *(LAS u32x4*)(QL + row * PQ_PITCH + ch * 16) = qpre[i]; }
        { const int tn = tile + (G >> 3); if (tn < ntile) {
#pragma unroll
            for (int i = 0; i < 4; ++i) { const int idx = tid + 512 * i, row = idx >> 5, ch = idx & 31;
                qpre[i] = *(const GAS u32x4*)((const GAS bf16_t*)(ws + WS_QP) + ((size_t)tn * 64 + row) * 2048 + h * 256 + ch * 8); } } }
        LDS_BAR();
        {
            const int mt = wave & 3, p = wave >> 2;
            unsigned key[32];
#pragma unroll
            for (int nt = 0; nt < 8; ++nt) { f32x4 acc = (f32x4){0.f, 0.f, 0.f, 0.f};
#pragma unroll
                for (int ks = 0; ks < 4; ++ks) acc = MFMA16(lfrag(KY + p * 128 * PS_PITCH, PS_PITCH, nt * 16 + fr, ks * 32, fq), lfrag(QL, PQ_PITCH, mt * 16 + fr, p * 128 + ks * 32, fq), acc);
#pragma unroll
                for (int j = 0; j < 4; ++j) { const int n = nt * 16 + 4 * fq + j; key[nt * 4 + j] = (f2ord(acc[j]) & ~127u) | (unsigned)(127 - n); } }
#pragma unroll 1
            for (int k = 0; k < 16; ++k) {
                unsigned t3[11];
#pragma unroll
                for (int e = 0; e < 10; ++e) t3[e] = umax_(umax_(key[3 * e], key[3 * e + 1]), key[3 * e + 2]);
                t3[10] = umax_(key[30], key[31]);
                const unsigned u0 = umax_(umax_(t3[0], t3[1]), t3[2]), u1 = umax_(umax_(t3[3], t3[4]), t3[5]), u2 = umax_(umax_(t3[6], t3[7]), t3[8]), u3 = umax_(t3[9], t3[10]);
                unsigned m = umax_(umax_(u0, u1), umax_(u2, u3));
                m = umax_(m, (unsigned)SWZI_(m, 0x401F)); m = umax_(m, xor32u_(m, lane >= 32));
#pragma unroll
                for (int e = 0; e < 32; ++e) key[e] = (key[e] == m) ? 0u : key[e];
                if (fq == (k & 3)) TOP[(p * 64 + mt * 16 + fr) * 16 + k] = m;
            }
        }
        LDS_BAR();
        {
            const int t = tid >> 3, sub = tid & 7;
            unsigned ck[7];
#pragma unroll
            for (int e = 0; e < 7; ++e) {
                const int ci = sub + 8 * e;
                int i = 0, base = 0; bool ok = ci < 50;
                if (ci >= 42) { i = 8 + (ci - 42); base = ci; } else if (ci >= 40) { i = 7; base = 40; } else if (ci >= 38) { i = 6; base = 38; } else if (ci >= 36) { i = 5; base = 36; }
                else if (ci >= 33) { i = 4; base = 33; } else if (ci >= 29) { i = 3; base = 29; } else if (ci >= 24) { i = 2; base = 24; } else if (ci >= 16) { i = 1; base = 16; }
                const int j = ci - base;
                unsigned kk = 0u;
                if (ok) { const float s0 = ord2f(TOP[(0 * 64 + t) * 16 + i] & ~127u), s1 = ord2f(TOP[(1 * 64 + t) * 16 + j] & ~127u);
                    kk = (f2ord(s0 + s1) & ~255u) | (unsigned)(255 - (i * 16 + j)); }
                ck[e] = kk;
            }
            unsigned w0 = 0u, w1 = 0u;
#pragma unroll 1
            for (int k = 0; k < 16; ++k) {
                unsigned m = umax_(umax_(umax_(ck[0], ck[1]), ck[2]), umax_(umax_(umax_(ck[3], ck[4]), ck[5]), ck[6]));
                m = umax_(m, (unsigned)DPPI_(m, 0xB1)); m = umax_(m, (unsigned)DPPI_(m, 0x4E)); m = umax_(m, (unsigned)DPPI_(m, 0x141));
#pragma unroll
                for (int e = 0; e < 7; ++e) ck[e] = (ck[e] == m) ? 0u : ck[e];
                if (k == sub) w0 = m; if (k == sub + 8) w1 = m;
            }
            const int f0 = 255 - (int)(w0 & 255u), f1 = 255 - (int)(w1 & 255u);
            const float sc0 = ord2f(w0 & ~255u), sc1 = ord2f(w1 & ~255u);
            float mx = fmaxf(sc0, sc1); mx = fmaxf(mx, DPP_(mx, 0xB1)); mx = fmaxf(mx, DPP_(mx, 0x4E)); mx = fmaxf(mx, DPP_(mx, 0x141));
            const float e0 = __expf(sc0 - mx), e1 = __expf(sc1 - mx);
            float sm = e0 + e1; sm += DPP_(sm, 0xB1); sm += DPP_(sm, 0x4E); sm += DPP_(sm, 0x141);
            const float inv = 1.0f / sm;
            const int i0 = 127 - (int)(TOP[(0 * 64 + t) * 16 + (f0 >> 4)] & 127u), j0 = 127 - (int)(TOP[(1 * 64 + t) * 16 + (f0 & 15)] & 127u);
            const int i1 = 127 - (int)(TOP[(0 * 64 + t) * 16 + (f1 >> 4)] & 127u), j1 = 127 - (int)(TOP[(1 * 64 + t) * 16 + (f1 & 15)] & 127u);
            unsigned short* ei = (unsigned short*)(ws + WS_EIDX) + ((t0 + t) * 8 + h) * 16; float* gp = (float*)(ws + WS_GATE) + ((t0 + t) * 8 + h) * 16;
            ei[sub] = (unsigned short)(i0 * 128 + j0); ei[sub + 8] = (unsigned short)(i1 * 128 + j1); gp[sub] = e0 * inv; gp[sub + 8] = e1 * inv;
        }
    }
    __syncthreads();
}

__device__ __forceinline__ void ins16(float (&v)[16], int (&id)[16], float x, int n) {
    if (x > v[15]) { v[15] = x; id[15] = n;
#pragma unroll
        for (int i = 15; i >= 1; --i) { if (v[i] > v[i - 1]) { const float tv = v[i]; v[i] = v[i - 1]; v[i - 1] = tv; const int ti = id[i]; id[i] = id[i - 1]; id[i - 1] = ti; } } }
}
__device__ __forceinline__ void phase_topk_ref(const DArgs& a, int vcu, int G) {
    const int tid = tid_();
    GAS unsigned char* ws = a.ws;
    const int gt = vcu * NTHR + tid, NGT = G * NTHR;
    for (int pair = gt; pair < T * 8; pair += NGT) {
        const int t = pair >> 3, h = pair & 7;
        float sv[2][16]; int si[2][16];
#pragma unroll
        for (int p = 0; p < 2; ++p) {
#pragma unroll
            for (int i = 0; i < 16; ++i) { sv[p][i] = -INFINITY; si[p][i] = 0; }
            const bf16_t* qp = (const bf16_t*)(ws + WS_QP) + (size_t)t * 2048 + h * 256 + p * 128;
            for (int n = 0; n < 128; ++n) {
                const bf16_t* kp = (const bf16_t*)(ws + WS_SK) + ((size_t)(h * 2 + p) * 128 + n) * 128;
                float s = 0.f;
                for (int c = 0; c < 128; c += 8) { const u32x4 qv = *(const u32x4*)(qp + c), kv = *(const u32x4*)(kp + c);
                    s += bf_lo(qv.x) * bf_lo(kv.x) + bf_hi(qv.x) * bf_hi(kv.x) + bf_lo(qv.y) * bf_lo(kv.y) + bf_hi(qv.y) * bf_hi(kv.y)
                       + bf_lo(qv.z) * bf_lo(kv.z) + bf_hi(qv.z) * bf_hi(kv.z) + bf_lo(qv.w) * bf_lo(kv.w) + bf_hi(qv.w) * bf_hi(kv.w); }
                ins16(sv[p], si[p], s, n);
            }
        }
        float tv[16]; int ti[16];
#pragma unroll
        for (int i = 0; i < 16; ++i) { tv[i] = -INFINITY; ti[i] = 0; }
#pragma unroll
        for (int i = 0; i < 16; ++i)
#pragma unroll
            for (int j = 0; j < 16; ++j) ins16(tv, ti, sv[0][i] + sv[1][j], i * 16 + j);
        float sm = 0.f, ex[16];
#pragma unroll
        for (int k = 0; k < 16; ++k) { ex[k] = __expf(tv[k] - tv[0]); sm += ex[k]; }
        int* ei = (int*)(ws + WS_EIDX) + (size_t)pair * 16; float* gp = (float*)(ws + WS_GATE) + (size_t)pair * 16;
#pragma unroll
        for (int k = 0; k < 16; ++k) {
            int e0 = 0, e1 = 0;
#pragma unroll
            for (int i = 0; i < 16; ++i) { e0 = ((ti[k] >> 4) == i) ? si[0][i] : e0; e1 = ((ti[k] & 15) == i) ? si[1][i] : e1; }
            ei[k] = e0 * 128 + e1; gp[k] = ex[k] / sm; }
    }
}

#define FP8LO(w) __builtin_amdgcn_cvt_pk_f32_fp8((int)(w), false)
#define FP8HI(w) __builtin_amdgcn_cvt_pk_f32_fp8((int)(w), true)
__device__ __forceinline__ float dot16_fp8(const u32x4 r, const float (&x)[16]) {
    float c = 0.f;
#pragma unroll
    for (int j = 0; j < 4; ++j) { const f32x2 lo = FP8LO(r[j]), hi = FP8HI(r[j]); c += lo[0] * x[4 * j] + lo[1] * x[4 * j + 1] + hi[0] * x[4 * j + 2] + hi[1] * x[4 * j + 3]; }
    return c;
}
__device__ __forceinline__ float dot16_fp8p(const u32x4 r, const f32x2 (&xp)[8]) {
    f32x2 c2 = (f32x2){0.f, 0.f};
#pragma unroll
    for (int j = 0; j < 4; ++j) { c2 += FP8LO(r[j]) * xp[2 * j]; c2 += FP8HI(r[j]) * xp[2 * j + 1]; }
    return c2[0] + c2[1];
}
__device__ __forceinline__ float gelu_erf(float d) {
    const float ad = fabsf(d), t = __builtin_amdgcn_rcpf(ad * 0.2316418882f + 1.0f);
    float q = t * 0.5307027145f + (-0.7265760135f); q = q * t + 0.7107068705f; q = q * t + (-0.142248368f); q = q * t + 0.127414796f; q = q * t;
    const float m = d * (q * __builtin_amdgcn_exp2f(d * d * (-0.72134752044f)));
    return d < 0.f ? m : d - m;
}
__device__ __forceinline__ float bperm(float v, int srclane) { return __builtin_bit_cast(float, __builtin_amdgcn_ds_bpermute(srclane << 2, __builtin_bit_cast(int, v))); }
#define SWZ_(v, pat) __builtin_bit_cast(float, __builtin_amdgcn_ds_swizzle(__builtin_bit_cast(int, (v)), (pat)))
__device__ __forceinline__ float rs32_(float a, float b) {
#if defined(__HIP_DEVICE_COMPILE__)
    asm volatile("s_nop 1\n\tv_permlane32_swap_b32 %0, %1" : "+v"(a), "+v"(b));
#endif
    return a + b;
}
__device__ __forceinline__ float rs16_(float a, float b) {
#if defined(__HIP_DEVICE_COMPILE__)
    asm volatile("s_nop 1\n\tv_permlane16_swap_b32 %0, %1" : "+v"(a), "+v"(b));
#endif
    return a + b;
}
__device__ __forceinline__ float rs8_(float a, float b, bool bit3) {
    const float send = bit3 ? a : b, keep = bit3 ? b : a;
    return keep + DPP_(send, 0x128);
}
__device__ __forceinline__ float xor32_(float v, bool hi) {
#if defined(__HIP_DEVICE_COMPILE__)
    const auto r = __builtin_amdgcn_permlane32_swap(__builtin_bit_cast(unsigned, v), __builtin_bit_cast(unsigned, v), false, false);
    return __builtin_bit_cast(float, hi ? r[0] : r[1]);
#else
    (void)hi; return v;
#endif
}
__device__ __forceinline__ float reduce8(const float (&p)[8], int lane) {
    float q4[4], q2[2];
    const bool b5 = lane & 32, b4 = lane & 16, b3 = lane & 8;
#pragma unroll
    for (int i = 0; i < 4; ++i) { const float send = b5 ? p[i] : p[i + 4], keep = b5 ? p[i + 4] : p[i]; q4[i] = keep + xor32_(send, b5); }
#pragma unroll
    for (int i = 0; i < 2; ++i) { const float send = b4 ? q4[i] : q4[i + 2], keep = b4 ? q4[i + 2] : q4[i]; q2[i] = keep + SWZ_(send, 0x401F); }
    const float send = b3 ? q2[0] : q2[1], keep = b3 ? q2[1] : q2[0];
    float q1 = keep + SWZ_(send, 0x201F);
    q1 += DPP_(q1, 0xB1); q1 += DPP_(q1, 0x4E); q1 += DPP_(q1, 0x141);
    return q1;
}
__device__ __forceinline__ void phase_udots(const DArgs& a, LAS unsigned char* lds) {
    const int tid = tid_(), lane = tid & 63, wave = __builtin_amdgcn_readfirstlane(tid >> 6);
    GAS unsigned char* ws = a.ws;
    volatile LAS unsigned* bst = (volatile LAS unsigned*)(lds + LDS_BARST);
    const int nloc = (int)bst[0], nx = (int)bst[1], rank = (int)bst[2];
    unsigned* bar = (unsigned*)(ws + WS_CTL) + CW_BAR;
    const unsigned myx = xb_xcc_id();
    int q = 0;
    for (unsigned j = 0; j < 16; ++j) { const unsigned c = xb_ld(&bar[XB_XCNT(j)]); if (c > 0u && j < myx) ++q; }
    LAS int* LE = (LAS int*)(lds + wave * 2048);
    LAS int* LP = LE + 128; LAS float* LG = (LAS float*)(LE + 256);
    const GAS unsigned char* UB = ws + WS_UB;
    const int g8 = lane >> 3;
    const float usc = ((const GAS float*)(ws + WS_USC))[0], vsc = ((const GAS float*)(ws + WS_USC))[1];
    for (int s = q; s < 8; s += nx) {
        int tok = rank * 8 + wave;
        u32x4 xq0 = (u32x4){0u, 0u, 0u, 0u}, xq1 = xq0; u32x2 e2 = (u32x2){0u, 0u}; f32x2 g2 = (f32x2){0.f, 0.f};
#define U_INFO(t_) do { xq0 = *(const u32x4*)((const GAS bf16_t*)(ws + WS_XN) + (size_t)(t_) * D + lane * 16); xq1 = *(const u32x4*)((const GAS bf16_t*)(ws + WS_XN) + (size_t)(t_) * D + lane * 16 + 8); \
        e2 = *(const u32x2*)((const GAS int*)(ws + WS_EIDX) + (size_t)(t_) * 128 + 2 * lane); g2 = *(const f32x2*)((const GAS float*)(ws + WS_GATE) + (size_t)(t_) * 128 + 2 * lane); } while (0)
        if (tok < T) U_INFO(tok);
        for (; tok < T; tok += nloc * 8) {
            const bool in0 = (int)(e2.x >> 11) == s, in1 = (int)(e2.y >> 11) == s;
            const unsigned long long m0 = __ballot(in0), m1 = __ballot(in1);
            const unsigned long long lt = (1ull << lane) - 1ull;
            const int n0 = __popcll(m0), n = n0 + __popcll(m1);
            if (in0) { const int pos = __popcll(m0 & lt); LE[pos] = (int)e2.x; LP[pos] = 2 * lane; LG[pos] = g2[0]; }
            if (in1) { const int pos = n0 + __popcll(m1 & lt); LE[pos] = (int)e2.y; LP[pos] = 2 * lane + 1; LG[pos] = g2[1]; }
            const float xf[16] = {bf_lo(xq0.x), bf_hi(xq0.x), bf_lo(xq0.y), bf_hi(xq0.y), bf_lo(xq0.z), bf_hi(xq0.z), bf_lo(xq0.w), bf_hi(xq0.w),
                                  bf_lo(xq1.x), bf_hi(xq1.x), bf_lo(xq1.y), bf_hi(xq1.y), bf_lo(xq1.z), bf_hi(xq1.z), bf_lo(xq1.w), bf_hi(xq1.w)};
            asm volatile("s_waitcnt lgkmcnt(0)" ::: "memory");
            u32x4 R0[8], R1[8], R2[8];
#define U_ISSUE(R_, g0_) do { _Pragma("unroll") for (int k = 0; k < 8; ++k) { const int slot_ = ((g0_) + k < n) ? (g0_) + k : n - 1; const int e_ = LE[slot_]; R_[k] = *(const u32x4*)(UB + (size_t)e_ * 1024 + lane * 16); } } while (0)
#define U_DOTS(R_, g0_) do { float pp_[8]; _Pragma("unroll") for (int k = 0; k < 8; ++k) pp_[k] = dot16_fp8(R_[k], xf); const float dsum_ = reduce8(pp_, lane); const int slot_ = (g0_) + g8; \
            if (slot_ < n && (lane & 7) == 0) { const float d_ = dsum_ * usc; \
                ((GAS float*)(ws + WS_PW))[(size_t)tok * 128 + LP[slot_]] = 0.5f * d_ * (1.0f + erff(d_ * 0.70710678118654752f)) * LG[slot_] * vsc; } } while (0)
            if (n > 0) U_ISSUE(R0, 0);
            if (n > 8) U_ISSUE(R1, 8);
            if (n > 16) U_ISSUE(R2, 16);
            const int tokN = tok + nloc * 8;
            if (tokN < T) U_INFO(tokN);
            if (n > 0) U_DOTS(R0, 0);
            if (n > 8) U_DOTS(R1, 8);
            if (n > 16) U_DOTS(R2, 16);
            for (int g0 = 24; g0 < n; g0 += 8) { U_ISSUE(R0, g0); U_DOTS(R0, g0); }
            asm volatile("s_waitcnt lgkmcnt(0)" ::: "memory");
        }
#undef U_INFO
#undef U_ISSUE
#undef U_DOTS
    }
}

#define EV_OFF(ev_, g_) (((g_) & 1) ? ((ev_[(g_) >> 3][((g_) >> 1) & 3] >> 9) & 0x7fff80u) : ((ev_[(g_) >> 3][((g_) >> 1) & 3] << 7) & 0x7fff80u))
struct XcdSlice { int nloc, nx, rank, q; };
__device__ __forceinline__ XcdSlice xcd_slice_setup(const DArgs& a, LAS unsigned char* lds) {
    volatile LAS unsigned* bst = (volatile LAS unsigned*)(lds + LDS_BARST);
    XcdSlice x; x.nloc = __builtin_amdgcn_readfirstlane((int)bst[0]); x.nx = __builtin_amdgcn_readfirstlane((int)bst[1]); x.rank = __builtin_amdgcn_readfirstlane((int)bst[2]);
    unsigned* bar = (unsigned*)(a.ws + WS_CTL) + CW_BAR; const unsigned myx = xb_xcc_id();
    x.q = 0; for (unsigned j = 0; j < 16; ++j) { const unsigned c = xb_ld(&bar[XB_XCNT(j)]); if (c > 0u && j < myx) ++x.q; }
    x.q = __builtin_amdgcn_readfirstlane(x.q);
    return x;
}
__device__ __forceinline__ void phase_ua(const DArgs& a, LAS unsigned char* lds) {
    const int tid = tid_(), lane = tid & 63, wave = __builtin_amdgcn_readfirstlane(tid >> 6), k = lane >> 3, c = lane & 7;
    GAS unsigned char* ws = a.ws;
    const XcdSlice X = xcd_slice_setup(a, lds);
    const int tstride = X.nloc * 8;
    for (int sl = X.q; sl < 8; sl += X.nx) {
        const GAS unsigned char* UBs = ws + WS_UB + (size_t)sl * 2097152;
        const unsigned coff = (unsigned)c * 16u;
        GAS unsigned char* PU = ws + WS_PARTU + (size_t)sl * T * 256;
        u32x4 evA[2], evB[2], RA[16], RB[16], xa, xb; float sa, sb;
#define A_TOK(t_) ((t_) < T ? (t_) : T - 1)
#define A_INFO(ev_, t_) do { const int tq_ = A_TOK(t_); _Pragma("unroll") for (int j_ = 0; j_ < 2; ++j_) ev_[j_] = *(const GAS u32x4*)(ws + WS_EIDX + (size_t)tq_ * 256 + (unsigned)(32 * k + 16 * j_)); } while (0)
#define A_ISSUE(R_, x_, s_, ev_, t_) do { const int tq_ = A_TOK(t_); _Pragma("unroll") for (int g_ = 0; g_ < 16; ++g_) R_[g_] = *(const GAS u32x4*)(UBs + (EV_OFF(ev_, g_) | coff)); \
        x_ = *(const GAS u32x4*)(ws + WS_XQ + (size_t)tq_ * 1024 + sl * 128 + coff); s_ = ((const GAS float*)(ws + WS_XQS))[tq_]; } while (0)
#define A_DOTS(R_, x_, s_, t_) do { \
        int ir0_ = 0, ir1_ = 0; \
        _Pragma("unroll") for (int gg_ = 0; gg_ < 4; ++gg_) {           \
            int d_[4]; _Pragma("unroll") for (int q_ = 0; q_ < 4; ++q_) d_[q_] = 0; \
            _Pragma("unroll") for (int j_ = 0; j_ < 4; ++j_) { _Pragma("unroll") for (int q_ = 0; q_ < 4; ++q_) d_[q_] = __builtin_amdgcn_sdot4((int)R_[4 * gg_ + q_][j_], (int)x_[j_], d_[q_], false); } \
            _Pragma("unroll") for (int q_ = 0; q_ < 4; ++q_) d_[q_] += DPPI_(d_[q_], 0xB1); \
            _Pragma("unroll") for (int q_ = 0; q_ < 4; ++q_) d_[q_] += DPPI_(d_[q_], 0x4E); \
            _Pragma("unroll") for (int q_ = 0; q_ < 4; ++q_) d_[q_] += DPPI_(d_[q_], 0x141);          \
            _Pragma("unroll") for (int q_ = 0; q_ < 4; ++q_) { if (c == ((4 * gg_ + q_) >> 1)) { if (q_ & 1) ir1_ = d_[q_]; else ir0_ = d_[q_]; } }          \
            __builtin_amdgcn_sched_barrier(0); } \
        if ((t_) < T) *(GAS unsigned*)(PU + (size_t)(t_) * 256 + (unsigned)(4 * lane)) = pk2((float)ir0_ * s_, (float)ir1_ * s_); } while (0)
        const int n0 = X.rank * 8 + wave;
        A_INFO(evA, n0); A_INFO(evB, n0 + tstride);
        __builtin_amdgcn_sched_barrier(0);
        A_ISSUE(RA, xa, sa, evA, n0);
        __builtin_amdgcn_sched_barrier(0);
#pragma unroll 1
        for (int n = n0; n < T; n += 2 * tstride) {
            A_INFO(evA, n + 2 * tstride);
            __builtin_amdgcn_sched_barrier(0);
            A_ISSUE(RB, xb, sb, evB, n + tstride);
            __builtin_amdgcn_sched_barrier(0);
            A_DOTS(RA, xa, sa, n);
            __builtin_amdgcn_sched_barrier(0);
            A_INFO(evB, n + 3 * tstride);
            __builtin_amdgcn_sched_barrier(0);
            A_ISSUE(RA, xa, sa, evA, n + 2 * tstride);
            __builtin_amdgcn_sched_barrier(0);
            A_DOTS(RB, xb, sb, n + tstride);
            __builtin_amdgcn_sched_barrier(0);
        }
#undef A_TOK
#undef A_INFO
#undef A_ISSUE
#undef A_DOTS
    }
}
__device__ __forceinline__ void phase_ua2(const DArgs& a, int vcu, int G) {
    const int tid = tid_();
    GAS unsigned char* ws = a.ws;
    const GAS float* USC = (const GAS float*)(ws + WS_USC); const GAS float* VSC = (const GAS float*)(ws + WS_VSC);
    const GAS unsigned char* PU = ws + WS_PARTU;
    const size_t N4 = (size_t)T * 128 / 4, stride = (size_t)G * NTHR;
    for (size_t i = (size_t)vcu * NTHR + tid; i < N4; i += 2 * stride) {
        const size_t i1 = (i + stride < N4) ? i + stride : i;
        u32x2 pv0[8], pv1[8];
#pragma unroll
        for (int sl = 0; sl < 8; ++sl) { pv0[sl] = ((const GAS u32x2*)(PU + (size_t)sl * T * 256))[i]; pv1[sl] = ((const GAS u32x2*)(PU + (size_t)sl * T * 256))[i1]; }
        const f32x4 gt0 = ((const GAS f32x4*)(ws + WS_GATE))[i], gt1 = ((const GAS f32x4*)(ws + WS_GATE))[i1];
        const u32x2 ep0 = ((const GAS u32x2*)(ws + WS_EIDX))[i], ep1 = ((const GAS u32x2*)(ws + WS_EIDX))[i1];
        const unsigned e0[4] = {ep0.x & 0xffffu, ep0.x >> 16, ep0.y & 0xffffu, ep0.y >> 16}, e1[4] = {ep1.x & 0xffffu, ep1.x >> 16, ep1.y & 0xffffu, ep1.y >> 16};
        float us0[4], vs0[4], us1[4], vs1[4];
#pragma unroll
        for (int e = 0; e < 4; ++e) { us0[e] = USC[e0[e]]; vs0[e] = VSC[e0[e]]; us1[e] = USC[e1[e]]; vs1[e] = VSC[e1[e]]; }
        f32x4 d0 = (f32x4){0.f, 0.f, 0.f, 0.f}, d1 = d0;
#pragma unroll
        for (int sl = 0; sl < 8; ++sl) { d0[0] += bf_lo(pv0[sl].x); d0[1] += bf_hi(pv0[sl].x); d0[2] += bf_lo(pv0[sl].y); d0[3] += bf_hi(pv0[sl].y);
                                         d1[0] += bf_lo(pv1[sl].x); d1[1] += bf_hi(pv1[sl].x); d1[2] += bf_lo(pv1[sl].y); d1[3] += bf_hi(pv1[sl].y); }
        f32x4 w0, w1;
#pragma unroll
        for (int e = 0; e < 4; ++e) { w0[e] = gelu_erf(d0[e] * us0[e]) * gt0[e] * vs0[e]; w1[e] = gelu_erf(d1[e] * us1[e]) * gt1[e] * vs1[e]; }
        u32x2 wo; wo.x = pk2(w0[0], w0[1]); wo.y = pk2(w0[2], w0[3]); ((GAS u32x2*)(ws + WS_PW))[i] = wo;
        if (i + stride < N4) { wo.x = pk2(w1[0], w1[1]); wo.y = pk2(w1[2], w1[3]); ((GAS u32x2*)(ws + WS_PW))[i1] = wo; }
    }
}
__device__ __forceinline__ void phase_vb(const DArgs& a, LAS unsigned char* lds) {
    const int tid = tid_(), lane = tid & 63, wave = __builtin_amdgcn_readfirstlane(tid >> 6), k = lane >> 3, c = lane & 7;
    GAS unsigned char* ws = a.ws;
    const XcdSlice X = xcd_slice_setup(a, lds);
    const int tstride = X.nloc * 8;
    const bool bit3 = (lane & 8) != 0;
    for (int sl = X.q; sl < 8; sl += X.nx) {
        const GAS unsigned char* VBs = ws + WS_VB + (size_t)sl * 2097152;
        const unsigned coff = (unsigned)c * 16u;
        const unsigned xoff = (unsigned)(sl * 128 + c * 16 + 2 * k) * 4u;
        u32x4 evA[2], evB[2], RA[16], RB[16], wa[2], wb[2]; unsigned xa, xb;
#define B_TOK(t_) ((t_) < T ? (t_) : T - 1)
#define B_INFO(ev_, t_) do { const int tq_ = B_TOK(t_); _Pragma("unroll") for (int j_ = 0; j_ < 2; ++j_) ev_[j_] = *(const GAS u32x4*)(ws + WS_EIDX + (size_t)tq_ * 256 + (unsigned)(32 * k + 16 * j_)); } while (0)
#define B_ISSUE(R_, w_, x_, ev_, t_) do { const int tq_ = B_TOK(t_); _Pragma("unroll") for (int g_ = 0; g_ < 16; ++g_) R_[g_] = *(const GAS u32x4*)(VBs + (EV_OFF(ev_, g_) | coff)); \
        _Pragma("unroll") for (int j_ = 0; j_ < 2; ++j_) w_[j_] = *(const GAS u32x4*)(ws + WS_PW + (size_t)tq_ * 256 + (unsigned)(32 * k + 16 * j_)); \
        x_ = *(const GAS unsigned*)((const GAS unsigned char*)a.out + (size_t)tq_ * (D * 2) + (xoff >> 1)); } while (0)
#define B_DOTS(R_, w_, x_, t_) do { \
        f32x2 acc2_[8]; _Pragma("unroll") for (int e_ = 0; e_ < 8; ++e_) acc2_[e_] = (f32x2){0.f, 0.f}; \
        _Pragma("unroll") for (int g_ = 0; g_ < 16; ++g_) { const unsigned ww_ = w_[g_ >> 3][(g_ >> 1) & 3]; const float wk_ = (g_ & 1) ? bf_hi(ww_) : bf_lo(ww_); const f32x2 wp_ = (f32x2){wk_, wk_}; \
            _Pragma("unroll") for (int jj_ = 0; jj_ < 4; ++jj_) { acc2_[2 * jj_] += wp_ * FP8LO(R_[g_][jj_]); acc2_[2 * jj_ + 1] += wp_ * FP8HI(R_[g_][jj_]); } \
            if (g_ & 1) __builtin_amdgcn_sched_barrier(0); } \
        f32x2 w2_[4], x2_[2], y_; \
        _Pragma("unroll") for (int i_ = 0; i_ < 4; ++i_) { w2_[i_][0] = rs32_(acc2_[i_][0], acc2_[i_ + 4][0]); w2_[i_][1] = rs32_(acc2_[i_][1], acc2_[i_ + 4][1]); } \
        _Pragma("unroll") for (int i_ = 0; i_ < 2; ++i_) { x2_[i_][0] = rs16_(w2_[i_][0], w2_[i_ + 2][0]); x2_[i_][1] = rs16_(w2_[i_][1], w2_[i_ + 2][1]); } \
        y_[0] = rs8_(x2_[0][0], x2_[1][0], bit3) + bf_lo(x_); y_[1] = rs8_(x2_[0][1], x2_[1][1], bit3) + bf_hi(x_); \
        const float ss_ = wave_sum(y_[0] * y_[0] + y_[1] * y_[1], lane); \
        if ((t_) < T) { *(GAS unsigned*)(ws + WS_PARTU + (size_t)(t_) * (D * 2) + (xoff >> 1)) = pk2(y_[0], y_[1]);       \
            if (lane == 0) ((GAS float*)(ws + WS_SS))[(size_t)(t_) * 8 + sl] = ss_; } } while (0)
        const int n0 = X.rank * 8 + wave;
        B_INFO(evA, n0); B_INFO(evB, n0 + tstride);
        __builtin_amdgcn_sched_barrier(0);
        B_ISSUE(RA, wa, xa, evA, n0);
        __builtin_amdgcn_sched_barrier(0);
#pragma unroll 1
        for (int n = n0; n < T; n += 2 * tstride) {
            B_INFO(evA, n + 2 * tstride);
            __builtin_amdgcn_sched_barrier(0);
            B_ISSUE(RB, wb, xb, evB, n + tstride);
            __builtin_amdgcn_sched_barrier(0);
            B_DOTS(RA, wa, xa, n);
            __builtin_amdgcn_sched_barrier(0);
            B_INFO(evB, n + 3 * tstride);
            __builtin_amdgcn_sched_barrier(0);
            B_ISSUE(RA, wa, xa, evA, n + 2 * tstride);
            __builtin_amdgcn_sched_barrier(0);
            B_DOTS(RB, wb, xb, n + tstride);
            __builtin_amdgcn_sched_barrier(0);
        }
#undef B_TOK
#undef B_INFO
#undef B_ISSUE
#undef B_DOTS
    }
}
__device__ __forceinline__ void phase_vc(const DArgs& a, int vcu, int G) {
    const int tid = tid_(), lane = tid & 63, wave = tid >> 6;
    const int gw = vcu * NWAVES + wave, NGW = G * NWAVES;
    GAS unsigned char* ws = a.ws;
    f32x4 gf[4];
#pragma unroll
    for (int j = 0; j < 4; ++j) gf[j] = ((const GAS f32x4*)a.final_g)[64 * j + lane];
    for (int m = gw; m < T; m += NGW) {
        const f32x4 s0 = *(const GAS f32x4*)((const GAS float*)(ws + WS_SS) + (size_t)m * 8), s1 = *(const GAS f32x4*)((const GAS float*)(ws + WS_SS) + (size_t)m * 8 + 4);
        const float rstd = rsqrtf(((s0[0] + s0[1]) + (s0[2] + s0[3]) + (s1[0] + s1[1]) + (s1[2] + s1[3])) * (1.f / D) + EPS);
        const GAS u32x2* xi = (const GAS u32x2*)(ws + WS_PARTU + (size_t)m * (D * 2)) + lane;
        GAS f32x4* o = (GAS f32x4*)(a.out + (size_t)m * D) + lane;
#pragma unroll
        for (int j = 0; j < 4; ++j) { const u32x2 xv = xi[64 * j]; f32x4 v; v[0] = bf_lo(xv.x); v[1] = bf_hi(xv.x); v[2] = bf_lo(xv.y); v[3] = bf_hi(xv.y); o[64 * j] = v * rstd * gf[j]; }
    }
}

__device__ __forceinline__ void phase_final_plain(const DArgs& a, const float* src, int vcu, int G) {
    const int tid = tid_(), lane = tid & 63, wave = tid >> 6;
    const int gw = vcu * NWAVES + wave, NGW = G * NWAVES;
    f32x4 gf[4];
#pragma unroll
    for (int j = 0; j < 4; ++j) gf[j] = ((const f32x4*)a.final_g)[64 * j + lane];
    for (int m = gw; m < T; m += NGW) {
        const f32x4* xr = (const f32x4*)(src + (size_t)m * D) + lane;
        f32x4 v[4]; float s = 0.f;
#pragma unroll
        for (int j = 0; j < 4; ++j) { v[j] = xr[64 * j]; s += (v[j][0] * v[j][0] + v[j][1] * v[j][1]) + (v[j][2] * v[j][2] + v[j][3] * v[j][3]); }
        const float rstd = rsqrtf(wave_sum(s, lane) * (1.f / D) + EPS);
        f32x4* o = (f32x4*)(a.out + (size_t)m * D) + lane;
#pragma unroll
        for (int j = 0; j < 4; ++j) o[64 * j] = v[j] * rstd * gf[j];
    }
}


__device__ __forceinline__ DArgs load_args() {
    DArgs r;
#if defined(__HIP_DEVICE_COMPILE__)
    typedef const DArgs __attribute__((address_space(4))) KArgs;
    KArgs* p = (KArgs*)__builtin_amdgcn_kernarg_segment_ptr();
    asm volatile("" : "+s"(p));
    r.x = p->x; r.norm1_g = p->norm1_g; r.w_in = p->w_in; r.b_in = p->b_in; r.conv_w = p->conv_w; r.conv_b = p->conv_b; r.m_head_g = p->m_head_g; r.lb_table = p->lb_table;
    r.g_head_g = p->g_head_g; r.w_br_m = p->w_br_m; r.w_br_g = p->w_br_g; r.w_out = p->w_out; r.norm2_g = p->norm2_g; r.w_pq = p->w_pq; r.sub_keys = p->sub_keys;
    r.u_emb = p->u_emb; r.v_emb = p->v_emb; r.final_g = p->final_g; r.out = p->out; r.ws = p->ws;
#else
    r = DArgs{};
#endif
    return r;
}
__device__ __forceinline__ EpiPtrs make_ep(const DArgs& a, int round) {
    EpiPtrs ep; ep.biasp = (const GAS float*)(a.ws + WS_BIASP); ep.lb = (const GAS float*)(a.ws + WS_LB); ep.x = a.x; ep.out = a.out; ep.ws = a.ws; ep.round = round; ep.sa = (const GAS float*)(a.ws + WS_SA8); ep.sb = (const GAS float*)(a.ws + WS_SB8); ep.sym = (const GAS float*)(a.ws + WS_SYM); ep.syg = (const GAS float*)(a.ws + WS_SYG); ep.sxq = (const GAS float*)(a.ws + WS_XQS); return ep;
}
#define GRID_SYNC() do { const DArgs a_ = load_args(); xcd_barrier((unsigned*)(a_.ws + WS_CTL) + CW_BAR, (volatile LAS unsigned*)(lds + LDS_BARST)); } while (0)

__device__ __forceinline__ int bx_() { int t = blockIdx.x; asm volatile("" : "+s"(t)); return t; }
__device__ __forceinline__ int gd_() { int t = gridDim.x; asm volatile("" : "+s"(t)); return t; }
#define PH_BEGIN const DArgs a = load_args(); const int bx = bx_(), G = gd_(); const int vcu = (G % 8 == 0) ? (bx % 8) * (G / 8) + bx / 8 : bx; (void)vcu; (void)bx;

__global__ void __launch_bounds__(NTHR, 2) fwd_megakernel(Args a_unused) {
    extern __shared__ __attribute__((aligned(16))) unsigned char lds_raw[];
    LAS unsigned char* lds = (LAS unsigned char*)lds_raw;
    cg::grid_group grid = cg::this_grid();

    { const int t_ = tid_(); if (t_ < 16) ((LAS unsigned*)(lds + LDS_BARST))[t_] = 0u; __syncthreads();
      const DArgs a_ = load_args(); xcd_barrier_post((unsigned*)(a_.ws + WS_CTL) + CW_BAR, (volatile LAS unsigned*)(lds + LDS_BARST)); }
    { PH_BEGIN phase_p0(a, lds, vcu, G); }
    grid.sync();
    { PH_BEGIN phase_p0c(a, lds, vcu, G); }
    GRID_SYNC();
#pragma unroll 1
    for (int round = 0; round < NROUND; ++round) {
        {
            PH_BEGIN
            pg8::Gemm g{(const bf16_t*)(a.ws + WS_XN8 + (size_t)round * RT * 1024), (const bf16_t*)(a.ws + WS_W8A), RT, N1, D / 2};
            pg8::StaticOrder S; S.init(RT, N1, G, bx);
            EpiX<7> E{make_ep(a, round)};
            pg8::gemm_phase<EpiX<7>, pg8::StaticOrder, true, true, true>(lds, g, S, E);
        }
        { PH_BEGIN if (bx < 8) mscan_pair(a, lds, round, bx); }
        GRID_SYNC();
        { PH_BEGIN for (int it = bx; it < 512; it += G) mlstm_pre_item(a, lds, round, it); }
        { PH_BEGIN u32x4 gq[4]; int it = bx; if (it < 2048) hgrn_pre_load(a, round, it, gq);
          for (; it < 2048; it += G) hgrn_pre_item(a, lds, round, it, gq, it + G); }
        GRID_SYNC();
        { PH_BEGIN
          if (bx < 128) mlstm_scan<2, false>(a, lds, round, bx & 7, bx >> 3);
          else if (bx >= 192 && bx < 200) mlstm_scan<1, true>(a, lds, round, bx - 192, 0);
          else if (bx < 192) { const int id2 = bx - 128; hgrn_scan(a, lds, round, (id2 & 7) * 2 + ((id2 >> 3) & 1), id2 >> 4); } }
        GRID_SYNC();
        {
            PH_BEGIN
            pg8::Gemm g{(const bf16_t*)(a.ws + WS_XN8 + (size_t)round * RT * 1024), (const bf16_t*)(a.ws + WS_W8), RT, N2, D / 2};
            pg8::StaticOrder S; S.init(RT, N2, G, bx);
            EpiX<2> E{make_ep(a, round)};
            pg8::gemm_phase<EpiX<2>, pg8::StaticOrder, true, true, true>(lds, g, S, E);
        }
        GRID_SYNC();
        { PH_BEGIN phase_ypass(a, round, vcu, G); }
        GRID_SYNC();
        {
            { PH_BEGIN pg8::StaticOrder S; S.init(RT, D, G, bx);
              pg8::Gemm g{(const bf16_t*)(a.ws + WS_V), (const bf16_t*)(a.ws + WS_WM), RT, D, 2048 / 2}; EpiX<3> E{make_ep(a, round)}; pg8::gemm_phase<EpiX<3>, pg8::StaticOrder, true, true, true>(lds, g, S, E); }
            { PH_BEGIN pg8::StaticOrder S; S.init(RT, D, G, bx);
              pg8::Gemm g{(const bf16_t*)(a.ws + WS_GI), (const bf16_t*)(a.ws + WS_WG), RT, D, D / 2}; EpiX<4> E{make_ep(a, round)}; pg8::gemm_phase<EpiX<4>, pg8::StaticOrder, true, true, true>(lds, g, S, E); }
        }
        GRID_SYNC();
        {
            PH_BEGIN pg8::StaticOrder S; S.init(RT, D, G, bx);
            pg8::Gemm g{(const bf16_t*)(a.ws + WS_GFLOG), (const bf16_t*)(a.ws + WS_WO), RT, D, D}; EpiX<5> E{make_ep(a, round)}; pg8::gemm_phase<EpiX<5>, pg8::StaticOrder, true, true>(lds, g, S, E);
        }
        GRID_SYNC();
    }
    { PH_BEGIN phase_p8(a, vcu, G); }
    GRID_SYNC();
    {
        PH_BEGIN pg8::StaticOrder S; S.init(T, 2048, G, bx);
        pg8::Gemm g{(const bf16_t*)(a.ws + WS_XQ), (const bf16_t*)(a.ws + WS_WPQ), T, 2048, D / 2}; EpiX<6> E{make_ep(a, 0)}; pg8::gemm_phase<EpiX<6>, pg8::StaticOrder, true, true, true>(lds, g, S, E);
    }
    GRID_SYNC();
#ifdef TOPK_REF
    { PH_BEGIN phase_topk_ref(a, vcu, G); }
#else
    { PH_BEGIN phase_topk(a, lds, bx, G); }
#endif
    GRID_SYNC();
    { PH_BEGIN phase_ua(a, lds); }
    GRID_SYNC();
    { PH_BEGIN phase_ua2(a, vcu, G); }
    GRID_SYNC();
    { PH_BEGIN phase_vb(a, lds); }
    GRID_SYNC();
    { PH_BEGIN phase_vc(a, vcu, G); }
}

extern "C" void kernel_launch(void* const* d_in, const int* in_sizes, int n_in, void* d_out, int out_size, void* d_ws, size_t ws_size, hipStream_t stream) {
    static int grid = 0;
    if (grid == 0) {
        if (n_in != 18 || in_sizes[0] != T * D || out_size != T * D || ws_size < WS_END) {
            fprintf(stderr, "kernel_launch: unexpected shapes/workspace (n_in %d, in0 %d, out %d, ws %zu, need %zu)\n", n_in, n_in > 0 ? in_sizes[0] : -1, out_size, ws_size, (size_t)WS_END);
            grid = -1; return; }
        int dev = 0, cus = 0, per_cu = 0;
        hipGetDevice(&dev);
        hipDeviceGetAttribute(&cus, hipDeviceAttributeMultiprocessorCount, dev);
        hipFuncSetAttribute((const void*)fwd_megakernel, hipFuncAttributeMaxDynamicSharedMemorySize, LDS_BYTES);
        hipOccupancyMaxActiveBlocksPerMultiprocessor(&per_cu, (const void*)fwd_megakernel, NTHR, LDS_BYTES);
        if (per_cu < 1) { fprintf(stderr, "kernel_launch: occupancy query says %d blocks/CU\n", per_cu); per_cu = 1; }
        grid = cus;
        (void)hipGetLastError();
    }
    if (grid < 0) return;
    hipMemsetAsync((char*)d_ws + WS_CTL, 0, 131072, stream);
    Args a{};
    a.x = (const float*)d_in[0]; a.norm1_g = (const float*)d_in[1]; a.w_in = (const float*)d_in[2]; a.b_in = (const float*)d_in[3];
    a.conv_w = (const float*)d_in[4]; a.conv_b = (const float*)d_in[5]; a.m_head_g = (const float*)d_in[6]; a.lb_table = (const float*)d_in[7];
    a.g_head_g = (const float*)d_in[8]; a.w_br_m = (const float*)d_in[9]; a.w_br_g = (const float*)d_in[10]; a.w_out = (const float*)d_in[11];
    a.norm2_g = (const float*)d_in[12]; a.w_pq = (const float*)d_in[13]; a.sub_keys = (const float*)d_in[14]; a.u_emb = (const float*)d_in[15];
    a.v_emb = (const float*)d_in[16]; a.final_g = (const float*)d_in[17];
    a.out = (float*)d_out; a.ws = (unsigned char*)d_ws;
    void* args[] = {&a};
    hipError_t e = hipLaunchCooperativeKernel((const void*)fwd_megakernel, dim3(grid), dim3(NTHR), args, LDS_BYTES, stream);
    if (e != hipSuccess) fprintf(stderr, "cooperative launch failed: %s (grid %d)\n", hipGetErrorString(e), grid);
}
```

```cpp
#include <hip/hip_runtime.h>
#include <hip/hip_cooperative_groups.h>
#include <cstdio>
#include <cstdint>
namespace cg = cooperative_groups;

#define LAS __attribute__((address_space(3)))
typedef unsigned short bf16_t;
typedef short bf16x8 __attribute__((ext_vector_type(8)));
typedef float f32x4 __attribute__((ext_vector_type(4)));
typedef float f32x2 __attribute__((ext_vector_type(2)));
typedef unsigned u32x4 __attribute__((ext_vector_type(4)));
typedef unsigned u32x2 __attribute__((ext_vector_type(2)));

constexpr int D = 1024, BATCH = 4, SEQ = 8192, T = BATCH * SEQ;
constexpr int IN_COLS = 12296, NP = 12288;
constexpr int RT = 16384, NROUND = 2;
constexpr int N1 = 7168, N2 = 5120;
constexpr float EPS = 1e-6f;
constexpr int NWAVES = 8, NTHR = 512;

constexpr size_t MiB = 1u << 20;
constexpr size_t WS_CTL = 0;
constexpr size_t WS_WIN = 1 * MiB;
constexpr size_t WS_WM = 25 * MiB;
constexpr size_t WS_WG = 29 * MiB;
constexpr size_t WS_WO = 31 * MiB;
constexpr size_t WS_WPQ = 33 * MiB;
constexpr size_t WS_SK = 37 * MiB;
constexpr size_t WS_BIASP = 37 * MiB + 512 * 1024;
constexpr size_t WS_LB = WS_BIASP + 64 * 1024;
constexpr size_t WS_GATES = 38 * MiB;
constexpr size_t WS_MPREV = 39 * MiB;
constexpr size_t WS_DEN = 40 * MiB;
constexpr size_t WS_MT = 40 * MiB + 512 * 1024;
constexpr size_t WS_HGDEC = 41 * MiB;
constexpr size_t WS_MDEC = 43 * MiB;
constexpr size_t WS_XN = 44 * MiB;
constexpr size_t WS_QKPRE = 108 * MiB;
constexpr size_t WS_V = 172 * MiB;
constexpr size_t WS_GFLOG = 236 * MiB;
constexpr size_t WS_GI = 268 * MiB;
constexpr size_t WS_GQ = 300 * MiB;
constexpr size_t WS_S = 332 * MiB;
constexpr size_t WS_QT = 348 * MiB;
constexpr size_t WS_KWT = 380 * MiB;
constexpr size_t WS_ATT = 412 * MiB;
constexpr size_t WS_QTG = 428 * MiB;
constexpr size_t WS_KENDT = 460 * MiB;
constexpr size_t WS_SIGO = 332 * MiB;
constexpr size_t WS_SGG = 396 * MiB;
constexpr size_t WS_SAM = 428 * MiB;
constexpr size_t WS_SAG = 460 * MiB;
constexpr size_t WS_XN8 = 44 * MiB;
constexpr size_t WS_SA8 = 508 * MiB;
constexpr size_t WS_SB8 = 508 * MiB + 262144;
constexpr size_t WS_W8A = WS_WIN;
constexpr size_t WS_W8 = WS_WIN + (size_t)7168 * 1024;
constexpr int NI8 = 12288 + 1024 + 1024 + 2048;
constexpr size_t WS_SYM = 508 * MiB + 524288;
constexpr size_t WS_SYG = 508 * MiB + 655360;
constexpr int CW_COLMAX = 16384;
constexpr size_t WS_END = 510 * MiB;
constexpr size_t WS_QP = 108 * MiB;
constexpr size_t WS_UB = 236 * MiB;
constexpr size_t WS_VB = 252 * MiB;
constexpr size_t WS_USC = 268 * MiB;
constexpr size_t WS_VSC = 268 * MiB + 65536;
constexpr size_t WS_EIDX = 300 * MiB;
constexpr size_t WS_GATE = 316 * MiB;
constexpr size_t WS_XQ = 380 * MiB;
constexpr size_t WS_XQS = 412 * MiB;
constexpr size_t WS_PARTU = 108 * MiB;
constexpr size_t WS_SS = 348 * MiB;
constexpr size_t WS_PW = 332 * MiB;

constexpr int CW_TMAX = 64;
constexpr int LDS_BYTES = 147456;

__device__ __forceinline__ unsigned f2bf(float f) { unsigned u = __builtin_bit_cast(unsigned, f); return (u + 0x7fffu + ((u >> 16) & 1u)) >> 16; }
typedef __bf16 bf16x2_t __attribute__((ext_vector_type(2)));
__device__ __forceinline__ unsigned pk2(float lo, float hi) { bf16x2_t v; v[0] = (__bf16)lo; v[1] = (__bf16)hi; return __builtin_bit_cast(unsigned, v); }
__device__ __forceinline__ float bf_lo(unsigned w) { return __builtin_bit_cast(float, w << 16); }
__device__ __forceinline__ float bf_hi(unsigned w) { return __builtin_bit_cast(float, w & 0xffff0000u); }
__device__ __forceinline__ float bf2f(bf16_t h) { return __builtin_bit_cast(float, ((unsigned)h) << 16); }
__device__ __forceinline__ float shx(float v, int o, int lane) { return __builtin_bit_cast(float, __builtin_amdgcn_ds_bpermute((lane ^ o) << 2, __builtin_bit_cast(int, v))); }
__device__ __forceinline__ float shup(float v, int o, int lane) { return __builtin_bit_cast(float, __builtin_amdgcn_ds_bpermute(((lane - o) & 63) << 2, __builtin_bit_cast(int, v))); }
__device__ __forceinline__ float rdlane(float v, int l) { return __builtin_bit_cast(float, __builtin_amdgcn_readlane(__builtin_bit_cast(int, v), l)); }
#define DPP_(v, ctrl) __builtin_bit_cast(float, __builtin_amdgcn_update_dpp(0, __builtin_bit_cast(int, (v)), (ctrl), 0xF, 0xF, false))
__device__ __forceinline__ float wave_sum(float v, int lane) {
    (void)lane;
    v += DPP_(v, 0xB1); v += DPP_(v, 0x4E); v += DPP_(v, 0x141); v += DPP_(v, 0x140);
    return (rdlane(v, 0) + rdlane(v, 16)) + (rdlane(v, 32) + rdlane(v, 48));
}
__device__ __forceinline__ float wave_max(float v) {
    v = fmaxf(v, DPP_(v, 0xB1)); v = fmaxf(v, DPP_(v, 0x4E)); v = fmaxf(v, DPP_(v, 0x141)); v = fmaxf(v, DPP_(v, 0x140));
    return fmaxf(fmaxf(rdlane(v, 0), rdlane(v, 16)), fmaxf(rdlane(v, 32), rdlane(v, 48)));
}
__device__ __forceinline__ unsigned pack_i8x4(float a, float b, float c, float d) {
    const int ia = (int)__builtin_rintf(a), ib = (int)__builtin_rintf(b), ic = (int)__builtin_rintf(c), id = (int)__builtin_rintf(d);
    return ((unsigned)ia & 255u) | (((unsigned)ib & 255u) << 8) | (((unsigned)ic & 255u) << 16) | ((unsigned)id << 24);
}
#define SWZI_(v, pat) __builtin_amdgcn_ds_swizzle((int)(v), (pat))
#define DPPI_(v, ctrl) __builtin_amdgcn_update_dpp(0, (int)(v), (ctrl), 0xF, 0xF, false)
__device__ __forceinline__ unsigned xor32u_(unsigned v, bool hi) {
#if defined(__HIP_DEVICE_COMPILE__)
    const auto r = __builtin_amdgcn_permlane32_swap(v, v, false, false);
    return hi ? r[0] : r[1];
#else
    (void)hi; return v;
#endif
}
__device__ __forceinline__ float sigmoidf_(float x) { return __builtin_amdgcn_rcpf(1.0f + __expf(-x)); }
__device__ __forceinline__ float siluf_(float x) { return x * __builtin_amdgcn_rcpf(1.0f + __expf(-x)); }
#define LDS_WAIT() asm volatile("s_waitcnt lgkmcnt(0)" ::: "memory")
__device__ __forceinline__ int tid_() { int t = threadIdx.x; asm volatile("" : "+v"(t)); return t; }

#define GAS __attribute__((address_space(1)))
struct DArgs {
    const GAS float* x; const GAS float* norm1_g; const GAS float* w_in; const GAS float* b_in; const GAS float* conv_w; const GAS float* conv_b;
    const GAS float* m_head_g; const GAS float* lb_table; const GAS float* g_head_g; const GAS float* w_br_m; const GAS float* w_br_g; const GAS float* w_out;
    const GAS float* norm2_g; const GAS float* w_pq; const GAS float* sub_keys; const GAS float* u_emb; const GAS float* v_emb; const GAS float* final_g;
    GAS float* out; GAS unsigned char* ws;
};
struct Args {
    const float* x; const float* norm1_g; const float* w_in; const float* b_in; const float* conv_w; const float* conv_b;
    const float* m_head_g; const float* lb_table; const float* g_head_g; const float* w_br_m; const float* w_br_g; const float* w_out;
    const float* norm2_g; const float* w_pq; const float* sub_keys; const float* u_emb; const float* v_emb; const float* final_g;
    float* out; unsigned char* ws;
};

namespace pg8 {
constexpr int BM = 256, BK = 64, HALF = 128, HTB = HALF * BK * 2, STAGE_BYTES = 8 * HTB, NXCD = 8, WGM = 8;
__host__ __device__ __forceinline__ int lds_byte(int r, int c) { const int st = (r >> 4) * 2 + (c >> 5), rr = r & 15, cc = c & 31, ob = rr * 64 + cc * 2; return st * 1024 + (ob ^ (((ob >> 9) & 1) << 5)); }
__host__ __device__ __forceinline__ void stage_rc(int b, int& R, int& C) { const int st = b / 1024, sb = b % 1024, swz = sb ^ (((sb >> 9) & 1) << 5); R = (st >> 1) * 16 + swz / 64; C = (st & 1) * 32 + (swz % 64) / 2; }
__host__ __device__ __forceinline__ int perm32(int rho) { const int n = rho >> 4, i = rho & 15; return 8 * (i >> 2) + 4 * n + (i & 3); }
struct Unit { int pm, pn; };
struct Gemm { const bf16_t* A; const bf16_t* Bt; int M, N, K; };
struct StaticOrder {
    int nM, nN, nwg, G, c;
    __host__ __device__ void init(int M, int N, int G_, int c_) { nM = M / BM; nN = N / BM; nwg = nM * nN; G = G_; c = c_; }
    __host__ __device__ bool next(int i, Unit& u) const {
        const long L = (long)i * G + c; if (L >= nwg) return false;
        int wgid = (int)L; { const int q = nwg / NXCD, r = nwg % NXCD, xcd = wgid % NXCD, off = wgid / NXCD; wgid = (xcd < r ? xcd * (q + 1) : r * (q + 1) + (xcd - r) * q) + off; }
        const int nig = WGM * nN, gid = wgid / nig, fm = gid * WGM, gsz = (nM - fm) < WGM ? (nM - fm) : WGM;
        u.pm = fm + ((wgid % nig) % gsz); u.pn = (wgid % nig) / gsz; return true;
    }
    __device__ __forceinline__ void a_ready(const Unit&) const {}
    __device__ __forceinline__ void done(const Unit&) const {}
};

typedef int i32x8 __attribute__((ext_vector_type(8)));
typedef int i32x4 __attribute__((ext_vector_type(4)));
template <class Epi, class Sched, bool ALIGN_EPI = false, bool SP2 = false, bool I8 = false>
__device__ __forceinline__ void gemm_phase(LAS unsigned char* lds, const Gemm g, const Sched& S, const Epi& E) {
    const int tid = tid_(), wid = __builtin_amdgcn_readfirstlane(tid >> 6), lane = tid & 63, wr = wid >> 2, wc = wid & 3, fr = lane & 15, fq = lane >> 4;
    const int K = g.K, nt = K / BK;
    unsigned voffA[2], voffB[2];
#pragma unroll
    for (int i = 0; i < 2; ++i) { int R, C; stage_rc(tid * 16 + i * 8192, R, C); const int Rb = Epi::PERM ? ((R & ~31) + perm32(R & 31)) : R;
        voffA[i] = (unsigned)(R * K + C) * 2u; voffB[i] = (unsigned)(Rb * K + C) * 2u; }
    const size_t kstep = (size_t)(BK * 2);
    const size_t hstep = (size_t)HALF * K * 2;
    const size_t tstep = 2 * hstep;
    const unsigned ldsw = (unsigned)wid * 1024u;
    const int aoff = lds_byte(wr * 64 + fr, fq * 8), boff = lds_byte(wc * 32 + fr, fq * 8);
#define PG8_SA(b, h) (((b) * 2 + (h)) * HTB)
#define PG8_SB(b, h) ((4 + (b) * 2 + (h)) * HTB)
#define PG8_STAGE(bufoff, gbase, voff) do { _Pragma("unroll") for (int _i = 0; _i < 2; ++_i) \
        __builtin_amdgcn_global_load_lds((const unsigned*)((const char*)(gbase) + (voff)[_i]), (LAS unsigned*)(lds + (bufoff) + ldsw + _i * 8192), 16, 0, 0); } while (0)
#define PG8_LDA(dst, b, h) do { _Pragma("unroll") for (int m = 0; m < 4; ++m) _Pragma("unroll") for (int k = 0; k < 2; ++k) dst[m][k] = *(const LAS bf16x8*)(lds + PG8_SA(b, h) + aoff + m * 2048 + k * 1024); } while (0)
#define PG8_LDB(dst, b, h) do { _Pragma("unroll") for (int n = 0; n < 2; ++n) _Pragma("unroll") for (int k = 0; k < 2; ++k) dst[n][k] = *(const LAS bf16x8*)(lds + PG8_SB(b, h) + boff + n * 2048 + k * 1024); } while (0)
#define PG8_MMA(ai, bj, At, Bt) do { __builtin_amdgcn_s_setprio(1); _Pragma("unroll") for (int m = 0; m < 4; ++m) _Pragma("unroll") for (int n = 0; n < 2; ++n) _Pragma("unroll") for (int k = 0; k < 2; ++k) { \
        if constexpr (I8) acc[ai][bj][m][n] = __builtin_bit_cast(f32x4, __builtin_amdgcn_mfma_i32_16x16x64_i8(__builtin_bit_cast(i32x4, Bt[n][k]), __builtin_bit_cast(i32x4, At[m][k]), __builtin_bit_cast(i32x4, acc[ai][bj][m][n]), 0, 0, 0)); \
        else acc[ai][bj][m][n] = __builtin_amdgcn_mfma_f32_16x16x32_bf16(Bt[n][k], At[m][k], acc[ai][bj][m][n], 0, 0, 0); } __builtin_amdgcn_s_setprio(0); } while (0)
#define PG8_WAIT_V(n) asm volatile("s_waitcnt vmcnt(" #n ")" ::: "memory")
#define PG8_WAIT_L(n) asm volatile("s_waitcnt lgkmcnt(" #n ")" ::: "memory")
#define PG8_BAR __builtin_amdgcn_s_barrier()
#define PG8_SCHED __builtin_amdgcn_sched_barrier(0)
    Unit cur, nxt; int ui = 0;
    if (!S.next(0, cur)) return;
    f32x4 acc[2][2][4][2];
#pragma unroll
    for (int a = 0; a < 2; ++a)
#pragma unroll
        for (int b = 0; b < 2; ++b)
#pragma unroll
            for (int m = 0; m < 4; ++m)
#pragma unroll
                for (int n = 0; n < 2; ++n) acc[a][b][m][n] = (f32x4){0.f, 0.f, 0.f, 0.f};
    bf16x8 At[4][2], B0[2][2], B1[2][2];
    const char* cA = (const char*)g.A + (size_t)cur.pm * tstep; const char* cB = (const char*)g.Bt + (size_t)cur.pn * tstep;
    S.a_ready(cur);
    if constexpr (SP2) {
        PG8_STAGE(PG8_SB(0, 0), cB, voffB); PG8_STAGE(PG8_SB(0, 1), cB + hstep, voffB); PG8_STAGE(PG8_SA(0, 0), cA, voffA); PG8_STAGE(PG8_SA(0, 1), cA + hstep, voffA);
        if (wr == 1) PG8_BAR;
        PG8_WAIT_V(2); PG8_BAR;
        PG8_STAGE(PG8_SB(1, 0), cB + kstep, voffB); PG8_STAGE(PG8_SA(1, 0), cA + kstep, voffA); PG8_STAGE(PG8_SB(1, 1), cB + hstep + kstep, voffB);
        PG8_WAIT_V(6); PG8_BAR;
    } else {
        PG8_STAGE(PG8_SB(0, 0), cB, voffB); PG8_STAGE(PG8_SA(0, 0), cA, voffA); PG8_STAGE(PG8_SB(0, 1), cB + hstep, voffB); PG8_STAGE(PG8_SA(0, 1), cA + hstep, voffA);
        if (wr == 1) PG8_BAR;
        PG8_WAIT_V(4); PG8_BAR;
        PG8_STAGE(PG8_SB(1, 0), cB + kstep, voffB); PG8_STAGE(PG8_SA(1, 0), cA + kstep, voffA); PG8_STAGE(PG8_SB(1, 1), cB + hstep + kstep, voffB);
        PG8_WAIT_V(6); PG8_BAR;
    }
    for (;;) {
        const bool has_next = S.next(ui + 1, nxt);
        const char* nA = has_next ? (const char*)g.A + (size_t)nxt.pm * tstep : cA; const char* nB = has_next ? (const char*)g.Bt + (size_t)nxt.pn * tstep : cB;
#pragma unroll 1
        for (int t = 0; t < nt; t += 2) {
            const bool last = (t == nt - 2);
            const char* a1 = cA + (size_t)(t + 1) * kstep;
            const char* a2 = last ? nA : cA + (size_t)(t + 2) * kstep; const char* b2 = last ? nB : cB + (size_t)(t + 2) * kstep;
            const char* a3 = a2 + kstep; const char* b3 = b2 + kstep;
            if (last && has_next) S.a_ready(nxt);
            if constexpr (SP2) {
            PG8_LDB(B0, 0, 0); PG8_LDB(B1, 0, 1); PG8_SCHED; PG8_LDA(At, 0, 0); PG8_STAGE(PG8_SA(1, 1), a1 + hstep, voffA);
            PG8_WAIT_V(8); PG8_WAIT_L(0); PG8_BAR; PG8_MMA(0, 0, At, B0); PG8_MMA(0, 1, At, B1); PG8_BAR; PG8_SCHED;
            PG8_LDA(At, 0, 1); PG8_STAGE(PG8_SB(0, 0), b2, voffB); PG8_STAGE(PG8_SB(0, 1), b2 + hstep, voffB); PG8_STAGE(PG8_SA(0, 0), a2, voffA);
            PG8_WAIT_V(8); PG8_WAIT_L(0); PG8_BAR; PG8_MMA(1, 0, At, B0); PG8_MMA(1, 1, At, B1); PG8_BAR; PG8_SCHED;
            PG8_LDB(B0, 1, 0); PG8_LDB(B1, 1, 1); PG8_SCHED; PG8_LDA(At, 1, 0); PG8_STAGE(PG8_SA(0, 1), a2 + hstep, voffA);
            PG8_WAIT_V(8); PG8_WAIT_L(0); PG8_BAR; PG8_MMA(0, 0, At, B0); PG8_MMA(0, 1, At, B1); PG8_BAR; PG8_SCHED;
            PG8_LDA(At, 1, 1); PG8_STAGE(PG8_SB(1, 0), b3, voffB); PG8_STAGE(PG8_SB(1, 1), b3 + hstep, voffB); PG8_STAGE(PG8_SA(1, 0), a3, voffA);
            PG8_WAIT_V(8); PG8_WAIT_L(0); PG8_BAR; PG8_MMA(1, 0, At, B0); PG8_MMA(1, 1, At, B1); PG8_BAR; PG8_SCHED;
            } else {
            PG8_LDB(B0, 0, 0); PG8_SCHED; PG8_LDA(At, 0, 0); PG8_STAGE(PG8_SA(1, 1), a1 + hstep, voffA);
            PG8_WAIT_L(8); PG8_BAR; PG8_WAIT_L(0); PG8_MMA(0, 0, At, B0); PG8_BAR; PG8_SCHED;
            PG8_LDB(B1, 0, 1); PG8_STAGE(PG8_SB(0, 0), b2, voffB);
            PG8_BAR; PG8_WAIT_L(0); PG8_MMA(0, 1, At, B1); PG8_BAR;
            PG8_LDA(At, 0, 1); PG8_STAGE(PG8_SA(0, 0), a2, voffA);
            PG8_BAR; PG8_WAIT_L(0); PG8_MMA(1, 0, At, B0); PG8_BAR; PG8_SCHED;
            PG8_STAGE(PG8_SB(0, 1), b2 + hstep, voffB);
            PG8_WAIT_V(6); PG8_BAR; PG8_MMA(1, 1, At, B1); PG8_BAR;
            PG8_LDB(B0, 1, 0); PG8_SCHED; PG8_LDA(At, 1, 0); PG8_STAGE(PG8_SA(0, 1), a2 + hstep, voffA);
            PG8_WAIT_L(8); PG8_BAR; PG8_WAIT_L(0); PG8_MMA(0, 0, At, B0); PG8_BAR; PG8_SCHED;
            PG8_LDB(B1, 1, 1); PG8_STAGE(PG8_SB(1, 0), b3, voffB);
            PG8_BAR; PG8_WAIT_L(0); PG8_MMA(0, 1, At, B1); PG8_BAR;
            PG8_LDA(At, 1, 1); PG8_STAGE(PG8_SA(1, 0), a3, voffA);
            PG8_BAR; PG8_WAIT_L(0); PG8_MMA(1, 0, At, B0); PG8_BAR; PG8_SCHED;
            PG8_STAGE(PG8_SB(1, 1), b3 + hstep, voffB);
            PG8_WAIT_V(6); PG8_BAR; PG8_MMA(1, 1, At, B1); PG8_BAR;
            }
        }
        if constexpr (ALIGN_EPI) { if (wr == 0) PG8_BAR; }
        E(acc, cur, wr, wc, fr, fq);
        if (!has_next) break;
#pragma unroll
        for (int a = 0; a < 2; ++a)
#pragma unroll
            for (int b = 0; b < 2; ++b)
#pragma unroll
                for (int m = 0; m < 4; ++m)
#pragma unroll
                    for (int n = 0; n < 2; ++n) acc[a][b][m][n] = (f32x4){0.f, 0.f, 0.f, 0.f};
        cur = nxt; cA = nA; cB = nB; ++ui;
        if constexpr (ALIGN_EPI) { if (wr == 1) PG8_BAR; }
    }
    PG8_WAIT_V(0);
    if constexpr (!ALIGN_EPI) { if (wr == 0) PG8_BAR; }
    PG8_BAR;
#undef PG8_SA
#undef PG8_SB
#undef PG8_STAGE
#undef PG8_LDA
#undef PG8_LDB
#undef PG8_MMA
#undef PG8_WAIT_V
#undef PG8_WAIT_L
#undef PG8_BAR
#undef PG8_SCHED
}
}

typedef int i32x4q __attribute__((ext_vector_type(4)));
struct EpiPtrs {
    const GAS float* biasp; const GAS float* lb; const GAS float* x; GAS float* out; GAS unsigned char* ws; int round;
    const GAS float* sa; const GAS float* sb; const GAS float* sym; const GAS float* syg; const GAS float* sxq;
};
template <int MODE> struct EpiX {
    static constexpr bool PERM = true, AFTER_DRAIN = false;
    EpiPtrs P;
    __device__ __forceinline__ void operator()(const f32x4 (&acc)[2][2][4][2], const pg8::Unit& u, int wr, int wc, int fr, int fq) const {
        const int upn = u.pn;
        const int row0 = u.pm * 256 + wr * 64 + fr;
        const int colt = upn * 256 + wc * 32 + 8 * fq;
        GAS unsigned char* ws = P.ws;
        bf16_t* dst = nullptr; int ld = 0, coff = 0, act = 0; const GAS float* bias = nullptr;
        if (MODE == 1 || MODE == 7) {
            bias = P.biasp;
            if (upn < 8) { dst = (bf16_t*)(ws + WS_QKPRE); ld = 2048; coff = 0; act = 0; }
            else if (upn < 16) { dst = (bf16_t*)(ws + WS_V); ld = 2048; coff = 2048; act = 0; }
            else if (upn < 20) { dst = (bf16_t*)(ws + WS_GFLOG); ld = 1024; coff = 4096; act = 3; }
            else if (upn < 24) { dst = (bf16_t*)(ws + WS_GI); ld = 1024; coff = 5120; act = 0; }
            else { dst = (bf16_t*)(ws + WS_GQ); ld = 1024; coff = 6144; act = 2; }
        } else if (MODE == 2) {
            bias = P.biasp + N1;
            if (u.pn < 8) { dst = (bf16_t*)(ws + WS_SIGO); ld = 2048; coff = 0; act = 1; }
            else if (u.pn < 12) { dst = (bf16_t*)(ws + WS_SGG); ld = 1024; coff = 2048; act = 2; }
            else if (u.pn < 16) { dst = (bf16_t*)(ws + WS_SAM); ld = 1024; coff = 3072; act = 1; }
            else { dst = (bf16_t*)(ws + WS_SAG); ld = 1024; coff = 4096; act = 1; }
        } else if (MODE == 6) { dst = (bf16_t*)(ws + WS_QP); ld = 2048; coff = 0; act = 0; }
        float sr8[2][4];
#pragma unroll
        for (int ai = 0; ai < 2; ++ai)
#pragma unroll
            for (int m = 0; m < 4; ++m) { const int row = row0 + ai * 128 + m * 16;
                sr8[ai][m] = (MODE == 3) ? P.sym[row] : (MODE == 4) ? P.syg[row] : (MODE == 6) ? P.sxq[row] : (MODE == 2 || MODE == 7) ? P.sa[(size_t)P.round * RT + row] : 1.0f; }
#pragma unroll
        for (int bj = 0; bj < 2; ++bj) {
            const int col = colt + bj * 128;
            f32x4 b0 = (f32x4){0.f, 0.f, 0.f, 0.f}, b1 = b0, l0 = b0, l1 = b0;
            if (MODE == 1 || MODE == 2 || MODE == 7) { b0 = *(const f32x4*)(bias + col); b1 = *(const f32x4*)(bias + col + 4); }
            f32x4 s0 = (f32x4){1.f, 1.f, 1.f, 1.f}, s1 = s0;
            if (MODE == 2) { s0 = *(const GAS f32x4*)(P.sb + 7168 + col); s1 = *(const GAS f32x4*)(P.sb + 7168 + col + 4); }
            if (MODE == 7) { s0 = *(const GAS f32x4*)(P.sb + col); s1 = *(const GAS f32x4*)(P.sb + col + 4); }
            if (MODE == 3) { s0 = *(const GAS f32x4*)(P.sb + 12288 + col); s1 = *(const GAS f32x4*)(P.sb + 12288 + col + 4); }
            if (MODE == 4) { s0 = *(const GAS f32x4*)(P.sb + 13312 + col); s1 = *(const GAS f32x4*)(P.sb + 13312 + col + 4); }
            if (MODE == 6) { s0 = *(const GAS f32x4*)(P.sb + 14336 + col); s1 = *(const GAS f32x4*)(P.sb + 14336 + col + 4); }
            if (MODE == 1 || MODE == 7) { if (act == 3) { l0 = *(const f32x4*)(P.lb + (col - coff)); l1 = *(const f32x4*)(P.lb + (col - coff) + 4); } }
#pragma unroll
            for (int ai = 0; ai < 2; ++ai) {
                u32x4 gpre[4], zpre[4]; f32x4 xpre[4][2];
#pragma unroll
                for (int m = 0; m < 4; ++m) { const int row = row0 + ai * 128 + m * 16;
                    if (MODE == 3) gpre[m] = *(const GAS u32x4*)((const GAS bf16_t*)(ws + WS_SAM) + (size_t)row * 1024 + col);
                    if (MODE == 4) { gpre[m] = *(const GAS u32x4*)((const GAS bf16_t*)(ws + WS_SAG) + (size_t)row * 1024 + col);
                                     zpre[m] = *(const GAS u32x4*)((const GAS bf16_t*)P.out + (size_t)T * 1024 + ((size_t)P.round * RT + row) * 1024 + col); }
                    if (MODE == 5) { const size_t off = ((size_t)P.round * RT + row) * 1024 + col; xpre[m][0] = *(const GAS f32x4*)(P.x + off); xpre[m][1] = *(const GAS f32x4*)(P.x + off + 4); } }
#pragma unroll
                for (int m = 0; m < 4; ++m) {
                    const int row = row0 + ai * 128 + m * 16;
                    f32x4 v0, v1;
                    if (MODE == 2 || MODE == 7 || MODE == 3 || MODE == 4 || MODE == 6) { const float sr = sr8[ai][m]; const i32x4q q0 = __builtin_bit_cast(i32x4q, acc[ai][bj][m][0]), q1 = __builtin_bit_cast(i32x4q, acc[ai][bj][m][1]);
                        v0 = (f32x4){(float)q0[0], (float)q0[1], (float)q0[2], (float)q0[3]} * (s0 * sr) + b0; v1 = (f32x4){(float)q1[0], (float)q1[1], (float)q1[2], (float)q1[3]} * (s1 * sr) + b1; }
                    else { v0 = acc[ai][bj][m][0] + b0; v1 = acc[ai][bj][m][1] + b1; }
                    if (MODE == 1 || MODE == 2 || MODE == 6 || MODE == 7) {
                        if (act == 1) {
#pragma unroll
                            for (int j = 0; j < 4; ++j) { v0[j] = sigmoidf_(v0[j]); v1[j] = sigmoidf_(v1[j]); }
                        } else if (act == 2) {
#pragma unroll
                            for (int j = 0; j < 4; ++j) { v0[j] = siluf_(v0[j]); v1[j] = siluf_(v1[j]); }
                        } else if (act == 3) {
#pragma unroll
                            for (int j = 0; j < 4; ++j) { v0[j] = __logf(l0[j] + (1.0f - l0[j]) * sigmoidf_(v0[j])); v1[j] = __logf(l1[j] + (1.0f - l1[j]) * sigmoidf_(v1[j])); }
                        }
                        u32x4 w; w.x = pk2(v0[0], v0[1]); w.y = pk2(v0[2], v0[3]); w.z = pk2(v1[0], v1[1]); w.w = pk2(v1[2], v1[3]);
                        *(u32x4*)(dst + (size_t)row * ld + (col - coff)) = w;
                    } else if (MODE == 3) {
                        const u32x4 g = gpre[m];
                        GAS bf16_t* o = (GAS bf16_t*)P.out + (size_t)T * 1024 + ((size_t)P.round * RT + row) * 1024 + col;
                        f32x4 r0, r1;
                        r0[0] = v0[0] * bf_lo(g.x); r0[1] = v0[1] * bf_hi(g.x); r0[2] = v0[2] * bf_lo(g.y); r0[3] = v0[3] * bf_hi(g.y);
                        r1[0] = v1[0] * bf_lo(g.z); r1[1] = v1[1] * bf_hi(g.z); r1[2] = v1[2] * bf_lo(g.w); r1[3] = v1[3] * bf_hi(g.w);
                        u32x4 w; w.x = pk2(r0[0], r0[1]); w.y = pk2(r0[2], r0[3]); w.z = pk2(r1[0], r1[1]); w.w = pk2(r1[2], r1[3]);
                        *(GAS u32x4*)o = w;
                    } else if (MODE == 4) {
                        const u32x4 g = gpre[m], zv = zpre[m];
                        const f32x4 p0 = (f32x4){bf_lo(zv.x), bf_hi(zv.x), bf_lo(zv.y), bf_hi(zv.y)}, p1 = (f32x4){bf_lo(zv.z), bf_hi(zv.z), bf_lo(zv.w), bf_hi(zv.w)};
                        f32x4 r0, r1;
                        r0[0] = p0[0] + v0[0] * bf_lo(g.x); r0[1] = p0[1] + v0[1] * bf_hi(g.x); r0[2] = p0[2] + v0[2] * bf_lo(g.y); r0[3] = p0[3] + v0[3] * bf_hi(g.y);
                        r1[0] = p1[0] + v1[0] * bf_lo(g.z); r1[1] = p1[1] + v1[1] * bf_hi(g.z); r1[2] = p1[2] + v1[2] * bf_lo(g.w); r1[3] = p1[3] + v1[3] * bf_hi(g.w);
                        u32x4 w; w.x = pk2(r0[0], r0[1]); w.y = pk2(r0[2], r0[3]); w.z = pk2(r1[0], r1[1]); w.w = pk2(r1[2], r1[3]);
                        *(u32x4*)((bf16_t*)(ws + WS_GFLOG) + (size_t)row * 1024 + col) = w;
                    } else if (MODE == 5) {
                        const size_t off = ((size_t)P.round * RT + row) * 1024 + col;
                        const f32x4 x0 = xpre[m][0] + v0, x1 = xpre[m][1] + v1;
                        u32x4 w; w.x = pk2(x0[0], x0[1]); w.y = pk2(x0[2], x0[3]); w.z = pk2(x1[0], x1[1]); w.w = pk2(x1[2], x1[3]);
                        *(GAS u32x4*)((GAS bf16_t*)P.out + off) = w;
                    }
                }
            }
        }
    }
};

__device__ __forceinline__ void p0_transpose_item(const GAS float* W, int ldw, int K, int k0, int scol, GAS bf16_t* WT, int drow, LAS float* scr, int lane) {
#pragma unroll 8
    for (int i = 0; i < 32; ++i) { const int kk = 2 * i + (lane >> 5); scr[kk * 33 + (lane & 31)] = W[(size_t)(k0 + kk) * ldw + scol + (lane & 31)]; }
    LDS_WAIT(); asm volatile("" ::: "memory");
    const int c = lane & 7;
#pragma unroll
    for (int j = 0; j < 4; ++j) { const int n = (lane >> 3) + 8 * j; const LAS float* s = scr + (8 * c) * 33 + n;
        u32x4 o; o.x = pk2(s[0 * 33], s[1 * 33]); o.y = pk2(s[2 * 33], s[3 * 33]); o.z = pk2(s[4 * 33], s[5 * 33]); o.w = pk2(s[6 * 33], s[7 * 33]);
        *(u32x4*)(WT + (size_t)(drow + n) * K + k0 + 8 * c) = o; }
    LDS_WAIT(); asm volatile("" ::: "memory");
}
__device__ __forceinline__ void p0_colmax_item(const GAS float* W, int ldw, int k0, int scol, GAS unsigned* colmax, int lane) {
    float mx = 0.f;
#pragma unroll 8
    for (int i = 0; i < 32; ++i) { const int kk = 2 * i + (lane >> 5); mx = fmaxf(mx, fabsf(W[(size_t)(k0 + kk) * ldw + scol + (lane & 31)])); }
    mx = fmaxf(mx, __builtin_bit_cast(float, xor32u_(__builtin_bit_cast(unsigned, mx), lane >= 32)));
    if (lane < 32) atomicMax((unsigned*)colmax + lane, __builtin_bit_cast(unsigned, mx));
}
__device__ __forceinline__ void p0_cvt8_item(const GAS float* W, int ldw, int k0, int scol, const GAS unsigned* colmax, GAS unsigned char* WT8, int pitch, GAS float* sb, int drow, LAS float* scr, int lane) {
    const float cm = __builtin_bit_cast(float, colmax[lane & 31]);
    const float qs = cm > 0.f ? 127.0f / cm : 0.f;
    if (k0 == 0 && lane < 32) sb[lane] = cm * (1.0f / 127.0f);
#pragma unroll 8
    for (int i = 0; i < 32; ++i) { const int kk = 2 * i + (lane >> 5); scr[kk * 33 + (lane & 31)] = W[(size_t)(k0 + kk) * ldw + scol + (lane & 31)] * qs; }
    LDS_WAIT(); asm volatile("" ::: "memory");
    const int n = lane >> 1, kh = lane & 1;
    const LAS float* sp = scr + (kh * 32) * 33 + n;
    u32x4 o0, o1;
#pragma unroll
    for (int q = 0; q < 8; ++q) { const unsigned p = pack_i8x4(sp[(4 * q) * 33], sp[(4 * q + 1) * 33], sp[(4 * q + 2) * 33], sp[(4 * q + 3) * 33]);
        if (q < 4) o0[q] = p; else o1[q - 4] = p; }
    GAS unsigned char* dst = WT8 + (size_t)(drow + n) * pitch + k0 + kh * 32;
    *(GAS u32x4*)dst = o0; *(GAS u32x4*)(dst + 16) = o1;
    LDS_WAIT(); asm volatile("" ::: "memory");
}
__device__ __forceinline__ int win_src_col(int n) {
    if (n < 4096) return n;
    if (n < 7168) return n - 4096 + 6152;
    if (n < 9216) return n - 7168 + 4096;
    return n - 9216 + 9224;
}

__device__ __forceinline__ void phase_p0(const DArgs& a, LAS unsigned char* lds, int vcu, int G) {
    const int tid = tid_(), lane = tid & 63, wave = tid >> 6;
    const int gw = vcu * NWAVES + wave, NGW = G * NWAVES;
    GAS unsigned char* ws = a.ws;
    LAS float* scr = (LAS float*)(lds + wave * 16384);
    constexpr int I_IN = 16 * 384, I_M = 32 * 32, I_G = 16 * 32, I_O = 16 * 32, I_PQ = 16 * 64;
    constexpr int NITEMS = I_IN + I_M + I_G + I_O + I_PQ;
    for (int it = gw; it < NITEMS; it += NGW) {
        int r = it;
        if (r < I_IN) { const int kb = r / 384, nb = r % 384;
            p0_colmax_item(a.w_in, IN_COLS, kb * 64, win_src_col(nb * 32), (GAS unsigned*)(ws + WS_CTL) + CW_COLMAX + nb * 32, lane);
            continue; } r -= I_IN;
        if (r < I_M) { const int kb = r / 32, nb = r % 32; p0_colmax_item(a.w_br_m, 1024, kb * 64, nb * 32, (GAS unsigned*)(ws + WS_CTL) + CW_COLMAX + 12288 + nb * 32, lane); continue; } r -= I_M;
        if (r < I_G) { const int kb = r / 32, nb = r % 32; p0_colmax_item(a.w_br_g, 1024, kb * 64, nb * 32, (GAS unsigned*)(ws + WS_CTL) + CW_COLMAX + 13312 + nb * 32, lane); continue; } r -= I_G;
        if (r < I_O) { const int kb = r / 32, nb = r % 32; p0_transpose_item(a.w_out, 1024, 1024, kb * 64, nb * 32, (GAS bf16_t*)(ws + WS_WO), nb * 32, scr, lane); continue; } r -= I_O;
        { const int kb = r / 64, nb = r % 64; p0_colmax_item(a.w_pq, 2048, kb * 64, nb * 32, (GAS unsigned*)(ws + WS_CTL) + CW_COLMAX + 14336 + nb * 32, lane); }
    }
    const int gt = vcu * NTHR + tid, NGT = G * NTHR;
    for (int i = gt; i < NP; i += NGT) ((float*)(ws + WS_BIASP))[i] = a.b_in[win_src_col(i)];
    for (int i = gt; i < 1024; i += NGT) { const float t0 = a.lb_table[i], t1 = a.lb_table[1024 + i]; ((float*)(ws + WS_LB))[i] = 1.0f / (1.0f + __expf(t1 - t0)); }
    for (int i = gt; i < 8 * 2 * 128 * 128 / 4; i += NGT) { const f32x4 v = ((const f32x4*)a.sub_keys)[i]; u32x2 o; o.x = pk2(v[0], v[1]); o.y = pk2(v[2], v[3]); ((u32x2*)(ws + WS_SK))[i] = o; }
    f32x4 g1[4];
#pragma unroll
    for (int j = 0; j < 4; ++j) g1[j] = ((const GAS f32x4*)a.norm1_g)[64 * j + lane];
    f32x4 gw0[16], gw1[16];
#pragma unroll
    for (int j = 0; j < 4; ++j)
#pragma unroll
        for (int e = 0; e < 4; ++e) { const int k = 256 * j + 4 * lane + e; gw0[4 * j + e] = *(const GAS f32x4*)(a.w_in + (size_t)k * IN_COLS + 6144); gw1[4 * j + e] = *(const GAS f32x4*)(a.w_in + (size_t)k * IN_COLS + 6148); }
    const float gbias = lane < 8 ? a.b_in[6144 + lane] : 0.f;
    for (int m = gw; m < T; m += NGW) {
        const GAS f32x4* xr = (const GAS f32x4*)(a.x + (size_t)m * D) + lane;
        f32x4 v[4]; float s = 0.f;
#pragma unroll
        for (int j = 0; j < 4; ++j) { v[j] = xr[64 * j]; s += (v[j][0] * v[j][0] + v[j][1] * v[j][1]) + (v[j][2] * v[j][2] + v[j][3] * v[j][3]); }
        const float rstd = rsqrtf(wave_sum(s, lane) * (1.f / D) + EPS);
        f32x4 ga0 = (f32x4){0.f, 0.f, 0.f, 0.f}, ga1 = ga0;
        float mx = 0.f;
#pragma unroll
        for (int j = 0; j < 4; ++j) {
            v[j] = v[j] * rstd * g1[j];
            mx = fmaxf(mx, fmaxf(fmaxf(fabsf(v[j][0]), fabsf(v[j][1])), fmaxf(fabsf(v[j][2]), fabsf(v[j][3]))));
#pragma unroll
            for (int e = 0; e < 4; ++e) { ga0 += gw0[4 * j + e] * v[j][e]; ga1 += gw1[4 * j + e] * v[j][e]; }
        }
        {
            mx = wave_max(mx);
            const float qs = mx > 0.f ? 127.0f / mx : 0.f;
#pragma unroll
            for (int jq = 0; jq < 4; ++jq) ((GAS unsigned*)(ws + WS_XN8 + (size_t)m * 1024))[64 * jq + lane] = pack_i8x4(v[jq][0] * qs, v[jq][1] * qs, v[jq][2] * qs, v[jq][3] * qs);
            if (lane == 0) ((GAS float*)(ws + WS_SA8))[m] = mx * (1.0f / 127.0f);
        }
        float ga[8] = {ga0[0], ga0[1], ga0[2], ga0[3], ga1[0], ga1[1], ga1[2], ga1[3]};
#pragma unroll
        for (int q = 0; q < 8; ++q) ga[q] = wave_sum(ga[q], lane);
        if (lane < 8) { float r = ga[0];
#pragma unroll
            for (int q = 1; q < 8; ++q) r = (lane == q) ? ga[q] : r;
            ((GAS float*)(ws + WS_GATES))[(size_t)m * 8 + lane] = r + gbias; }
    }
}

__device__ __forceinline__ float logsigf_(float x) { return fminf(x, 0.f) - log1pf(__expf(-fabsf(x))); }
#define LDS_BAR() do { asm volatile("s_waitcnt lgkmcnt(0)" ::: "memory"); __builtin_amdgcn_s_barrier(); asm volatile("" ::: "memory"); } while (0)
#define MFMA16(a, b, c) __builtin_amdgcn_mfma_f32_16x16x32_bf16((a), (b), (c), 0, 0, 0)
__device__ __forceinline__ bf16x8 lfrag(const LAS unsigned char* base, int pitch, int row, int k0, int fq) { return *(const LAS bf16x8*)(base + row * pitch + (k0 + 8 * fq) * 2); }
__device__ __forceinline__ int fm_off(int r, int k, int KB) { return (((r >> 4) * KB + (k >> 5)) << 10) + (((((k >> 3) & 3) << 4) + (r & 15)) << 4) + ((k & 7) << 1); }
__device__ __forceinline__ bf16x8 gfrag(const bf16_t* base, int ld, int row, int k0, int fq) { return *(const bf16x8*)(base + (size_t)row * ld + k0 + 8 * fq); }

__device__ __forceinline__ void phase_p0c(const DArgs& a, LAS unsigned char* lds, int vcu, int G) {
    const int tid = tid_(), lane = tid & 63, wave = tid >> 6;
    const int gw = vcu * NWAVES + wave, NGW = G * NWAVES;
    GAS unsigned char* ws = a.ws;
    LAS float* scr = (LAS float*)(lds + wave * 16384);
    constexpr int J_IN = 16 * 384, J_M = 32 * 32, J_G = 16 * 32, J_PQ = 16 * 64;
    const GAS unsigned* cmx = (const GAS unsigned*)(ws + WS_CTL) + CW_COLMAX; GAS float* sb = (GAS float*)(ws + WS_SB8);
    for (int it = gw; it < J_IN + J_M + J_G + J_PQ; it += NGW) {
        int r = it;
        if (r < J_IN) { const int kb = r / 384, nb = r % 384;
            p0_cvt8_item(a.w_in, IN_COLS, kb * 64, win_src_col(nb * 32), cmx + nb * 32, ws + WS_W8A, 1024, sb + nb * 32, nb * 32, scr, lane); continue; } r -= J_IN;
        if (r < J_M) { const int kb = r / 32, nb = r % 32; p0_cvt8_item(a.w_br_m, 1024, kb * 64, nb * 32, cmx + 12288 + nb * 32, ws + WS_WM, 2048, sb + 12288 + nb * 32, nb * 32, scr, lane); continue; } r -= J_M;
        if (r < J_G) { const int kb = r / 32, nb = r % 32; p0_cvt8_item(a.w_br_g, 1024, kb * 64, nb * 32, cmx + 13312 + nb * 32, ws + WS_WG, 1024, sb + 13312 + nb * 32, nb * 32, scr, lane); continue; } r -= J_G;
        { const int kb = r / 64, nb = r % 64; p0_cvt8_item(a.w_pq, 2048, kb * 64, nb * 32, cmx + 14336 + nb * 32, ws + WS_WPQ, 1024, sb + 14336 + nb * 32, nb * 32, scr, lane); }
    }
}
__device__ __forceinline__ void mscan_pair(const DArgs& a, LAS unsigned char* lds, int round, int p) {
    const int tid = tid_(), lane = tid & 63, part = tid >> 6;
    const int bl = p >> 2, h = p & 3, b = round * 2 + bl;
    const GAS float* g = (const GAS float*)(a.ws + WS_GATES) + ((size_t)b * SEQ + (size_t)lane * 128 + part * 16) * 8;
    float bsum = 0.f, gm = -INFINITY;
#pragma unroll 4
    for (int s = 0; s < 16; ++s) { const float ip = g[s * 8 + h], fp = g[s * 8 + 4 + h]; bsum += logsigf_(fp); gm = fmaxf(gm, ip - bsum); }
    LAS float* PS = (LAS float*)lds; LAS float* PM = PS + 512;
    PS[part * 64 + lane] = bsum; PM[part * 64 + lane] = gm;
    __syncthreads();
    if (tid < 64) {
        float bs = 0.f, g2 = -INFINITY;
#pragma unroll
        for (int q = 0; q < 8; ++q) { g2 = fmaxf(g2, PM[q * 64 + lane] - bs); bs += PS[q * 64 + lane]; }
        float mprev = 0.f, mine = 0.f;
        for (int c = 0; c < 64; ++c) {
            const float bc = rdlane(bs, c), gc = rdlane(g2, c);
            if (lane == c) mine = mprev; mprev = bc + fmaxf(mprev, gc); }
        ((GAS float*)(a.ws + WS_MPREV))[(round * 8 + p) * 64 + lane] = mine;
    }
    __syncthreads();
}

constexpr int PQ_PITCH = 528, PS_PITCH = 272;
__device__ __forceinline__ void mlstm_pre_item(const DArgs& a, LAS unsigned char* lds, int round, int item) {
    const int tid = tid_(), lane = tid & 63, wave = __builtin_amdgcn_readfirstlane(tid >> 6), fr = lane & 15, fq = lane >> 4;
    const int p = item >> 6, c = item & 63, bl = p >> 2, h = p & 3, b = round * 2 + bl;
    const int tl0 = bl * SEQ + c * 128; const size_t tg0 = (size_t)b * SEQ + c * 128;
    GAS unsigned char* ws = a.ws;
    LAS unsigned char* QL = lds; LAS unsigned char* KL = lds + 67584;
    LAS float* AS = (LAS float*)(lds + 135168); LAS float* MS = AS + 128; LAS float* SC = AS + 256;
    if (wave == 0) {
        const float mprev = ((const float*)(ws + WS_MPREV))[(round * 8 + p) * 64 + c];
        const float* g = (const float*)(ws + WS_GATES) + (tg0 + 2 * lane) * 8;
        const float ip0 = g[h], fp0 = g[4 + h], ip1 = g[8 + h], fp1 = g[12 + h];
        const float lf0 = logsigf_(fp0), lf1 = logsigf_(fp1), pp = lf0 + lf1;
        float incl = pp;
#pragma unroll
        for (int o = 1; o < 64; o <<= 1) { const float t = shup(incl, o, lane); if (lane >= o) incl += t; }
        const float excl = incl - pp, b0 = excl + lf0, b1 = incl;
        const float a0 = ip0 - b0, a1 = ip1 - b1;
        float inclm = fmaxf(a0, a1);
#pragma unroll
        for (int o = 1; o < 64; o <<= 1) { const float t = shup(inclm, o, lane); if (lane >= o) inclm = fmaxf(inclm, t); }
        float exclm = shup(inclm, 1, lane); if (lane == 0) exclm = -INFINITY;
        const float M0 = fmaxf(mprev, fmaxf(exclm, a0)), M1 = fmaxf(mprev, inclm);
        AS[2 * lane] = a0; AS[2 * lane + 1] = a1; MS[2 * lane] = M0; MS[2 * lane + 1] = M1;
        float* mt = (float*)(ws + WS_MT) + (tg0 + 2 * lane) * 4 + h;
        mt[0] = b0 + M0; mt[4] = b1 + M1;
        const float Mlast = rdlane(M1, 63);
        if (lane == 0) { SC[0] = mprev; SC[1] = Mlast; ((float*)(ws + WS_MDEC))[item] = __expf(mprev - Mlast); }
    }
    {
        const int cgp = tid & 63, strip = tid >> 6;
        const int col = (cgp < 32) ? (h * 256 + cgp * 8) : (1024 + h * 256 + (cgp - 32) * 8);
        float w[4][8], bb[8];
#pragma unroll
        for (int j = 0; j < 4; ++j) { const f32x4 w0 = *(const f32x4*)(a.conv_w + j * 2048 + col), w1 = *(const f32x4*)(a.conv_w + j * 2048 + col + 4);
#pragma unroll
            for (int e = 0; e < 4; ++e) { w[j][e] = w0[e]; w[j][4 + e] = w1[e]; } }
        { const f32x4 b0 = *(const f32x4*)(a.conv_b + col), b1 = *(const f32x4*)(a.conv_b + col + 4);
#pragma unroll
            for (int e = 0; e < 4; ++e) { bb[e] = b0[e]; bb[4 + e] = b1[e]; } }
        const bf16_t* src = (const bf16_t*)(ws + WS_QKPRE) + (size_t)(tl0 + 16 * strip) * 2048 + col;
        const float qs = (cgp < 32) ? 0.0625f : 1.0f;
        LAS unsigned char* dstt = ((cgp < 32) ? QL : KL) + (cgp & 31) * 16;
#pragma unroll 1
        for (int half = 0; half < 2; ++half) {
            u32x4 xr[11];
#pragma unroll
            for (int r = 0; r < 11; ++r) {
                const int sl = c * 128 + 16 * strip + 8 * half + r - 3;
                xr[r] = (sl >= 0) ? *(const u32x4*)(src + (ptrdiff_t)(8 * half + r - 3) * 2048) : (u32x4){0u, 0u, 0u, 0u};
            }
#pragma unroll
            for (int r = 0; r < 8; ++r) {
                float y[8];
#pragma unroll
                for (int e = 0; e < 8; ++e) y[e] = bb[e];
#pragma unroll
                for (int j = 0; j < 4; ++j) { const u32x4 xv = xr[r + j];
                    y[0] += w[j][0] * bf_lo(xv.x); y[1] += w[j][1] * bf_hi(xv.x); y[2] += w[j][2] * bf_lo(xv.y); y[3] += w[j][3] * bf_hi(xv.y);
                    y[4] += w[j][4] * bf_lo(xv.z); y[5] += w[j][5] * bf_hi(xv.z); y[6] += w[j][6] * bf_lo(xv.w); y[7] += w[j][7] * bf_hi(xv.w); }
#pragma unroll
                for (int e = 0; e < 8; ++e) y[e] = siluf_(y[e]) * qs;
                u32x4 o; o.x = pk2(y[0], y[1]); o.y = pk2(y[2], y[3]); o.z = pk2(y[4], y[5]); o.w = pk2(y[6], y[7]);
                *(LAS u32x4*)(dstt + (16 * strip + 8 * half + r) * PQ_PITCH) = o;
            }
        }
    }
    __syncthreads();
    const float mprev = SC[0], Mlast = SC[1];
    {
        bf16_t* Sg = (bf16_t*)(ws + WS_S) + (size_t)item * 128 * 128;
        const int t = wave * 16 + fr; const float Mt = MS[t];
        for (int st = 0; st < 8; ++st) {
            u32x2 o = (u32x2){0u, 0u};
            if (st <= wave) {
                f32x4 acc = (f32x4){0.f, 0.f, 0.f, 0.f};
#pragma unroll
                for (int ks = 0; ks < 8; ++ks) acc = MFMA16(lfrag(KL, PQ_PITCH, st * 16 + fr, ks * 32, fq), lfrag(QL, PQ_PITCH, wave * 16 + fr, ks * 32, fq), acc);
                float v[4];
#pragma unroll
                for (int j = 0; j < 4; ++j) { const int s = st * 16 + 4 * fq + j; v[j] = (s <= t) ? acc[j] * __expf(AS[s] - Mt) : 0.f; }
                o.x = pk2(v[0], v[1]); o.y = pk2(v[2], v[3]);
            }
            *(u32x2*)((unsigned char*)Sg + fm_off(t, st * 16 + 4 * fq, 4)) = o;
        }
    }
    {
        bf16_t* Qg = (bf16_t*)(ws + WS_QT) + (size_t)item * 128 * 256;
#pragma unroll
        for (int i = 0; i < 8; ++i) { const int idx = tid + 512 * i, blk = idx >> 6, t = (blk >> 3) * 16 + (idx & 15), ch = (blk & 7) * 4 + ((idx >> 4) & 3);
            const u32x4 v = *(const LAS u32x4*)(QL + t * PQ_PITCH + ch * 16); const float s = __expf(mprev - MS[t]);
            u32x4 o; o.x = pk2(bf_lo(v.x) * s, bf_hi(v.x) * s); o.y = pk2(bf_lo(v.y) * s, bf_hi(v.y) * s); o.z = pk2(bf_lo(v.z) * s, bf_hi(v.z) * s); o.w = pk2(bf_lo(v.w) * s, bf_hi(v.w) * s);
            *(u32x4*)((unsigned char*)Qg + fm_off(t, ch * 8, 8)) = o; }
    }
    {
        bf16_t* Kg = (bf16_t*)(ws + WS_KWT) + (size_t)item * 256 * 128;
        const int dlo = lane & 15, sglo = lane >> 4;
#pragma unroll
        for (int i = 0; i < 8; ++i) { const int combo = wave * 8 + i, d = (combo >> 2) * 16 + dlo, s0 = ((combo & 3) * 4 + sglo) * 8;
            float v[8];
#pragma unroll
            for (int e = 0; e < 8; ++e) v[e] = bf2f(*(const LAS bf16_t*)(KL + (s0 + e) * PQ_PITCH + d * 2)) * __expf(AS[s0 + e] - Mlast);
            u32x4 o; o.x = pk2(v[0], v[1]); o.y = pk2(v[2], v[3]); o.z = pk2(v[4], v[5]); o.w = pk2(v[6], v[7]);
            *(u32x4*)((unsigned char*)Kg + fm_off(d, s0, 4)) = o; }
    }
    __syncthreads();
}

__device__ __forceinline__ void hgrn_pre_load(const DArgs& a, int round, int item, u32x4 (&gq)[4]) {
    const int tid = tid_();
    const int p = item >> 7, c = item & 127, bl = p >> 3, h = p & 7;
    const int tl0 = bl * SEQ + c * 64;
    GAS unsigned char* ws = a.ws;
#pragma unroll
    for (int i = 0; i < 2; ++i) { const int idx = tid + 512 * i, s = idx >> 4, ch = idx & 15;
        gq[2 * i] = *(const GAS u32x4*)((const GAS bf16_t*)(ws + WS_GFLOG) + (size_t)(tl0 + s) * 1024 + h * 128 + ch * 8);
        gq[2 * i + 1] = *(const GAS u32x4*)((const GAS bf16_t*)(ws + WS_GQ) + (size_t)(tl0 + s) * 1024 + h * 128 + ch * 8); }
}
__device__ __forceinline__ void hgrn_pre_item(const DArgs& a, LAS unsigned char* lds, int round, int item, u32x4 (&gq)[4], int next_item) {
    const int tid = tid_(), lane = tid & 63, wave = __builtin_amdgcn_readfirstlane(tid >> 6), fr = lane & 15, fq = lane >> 4;
    const int p = item >> 7, c = item & 127, bl = p >> 3, h = p & 7;
    const int tl0 = bl * SEQ + c * 64;
    GAS unsigned char* ws = a.ws;
    LAS float* CUM = (LAS float*)lds;
    LAS float* GL = (LAS float*)(lds + 32768);
    LAS unsigned char* QH = lds + 65536;
    LAS unsigned char* KE = lds + 65536 + 64 * PS_PITCH;
    LAS float* QF = (LAS float*)(lds + 65536 + 128 * PS_PITCH);
#pragma unroll
    for (int i = 0; i < 2; ++i) { const int idx = tid + 512 * i, s = idx >> 4, ch = idx & 15;
        const u32x4 gv = gq[2 * i], qv = gq[2 * i + 1];
        LAS float* gd = GL + s * 128 + ch * 8; LAS float* qd = QF + s * 128 + ch * 8;
        gd[0] = bf_lo(gv.x); gd[1] = bf_hi(gv.x); gd[2] = bf_lo(gv.y); gd[3] = bf_hi(gv.y); gd[4] = bf_lo(gv.z); gd[5] = bf_hi(gv.z); gd[6] = bf_lo(gv.w); gd[7] = bf_hi(gv.w);
        qd[0] = bf_lo(qv.x); qd[1] = bf_hi(qv.x); qd[2] = bf_lo(qv.y); qd[3] = bf_hi(qv.y); qd[4] = bf_lo(qv.z); qd[5] = bf_hi(qv.z); qd[6] = bf_lo(qv.w); qd[7] = bf_hi(qv.w); }
    if (next_item < 2048) hgrn_pre_load(a, round, next_item, gq);
    LDS_BAR();
    {
        const int d = tid & 127, qt = tid >> 7; float cs = 0.f;
#pragma unroll 4
        for (int s = 0; s < 16; ++s) { cs += GL[(qt * 16 + s) * 128 + d]; CUM[(qt * 16 + s) * 128 + d] = cs; }
        LDS_BAR();
        float off = 0.f;
#pragma unroll
        for (int q = 0; q < 3; ++q) off += (q < qt) ? CUM[(q * 16 + 15) * 128 + d] : 0.f;
        LDS_BAR();
#pragma unroll 4
        for (int s = 0; s < 16; ++s) CUM[(qt * 16 + s) * 128 + d] += off;
        if (qt == 3) ((GAS float*)(ws + WS_HGDEC))[(size_t)item * 128 + d] = __expf(cs + off);
    }
    LDS_BAR();
    {
        bf16_t* Qg = (bf16_t*)(ws + WS_QTG) + (size_t)item * 64 * 128;
#pragma unroll
        for (int i = 0; i < 2; ++i) { const int idx = tid + 512 * i, s = idx >> 4, ch = idx & 15;
            float qt[8], qh[8], ke[8];
#pragma unroll
            for (int e = 0; e < 8; ++e) { const int d = ch * 8 + e; const float cm = CUM[s * 128 + d], last = CUM[63 * 128 + d], q = QF[s * 128 + d], g = GL[s * 128 + d];
                qt[e] = q * __expf(cm); qh[e] = q * __expf(cm - last); ke[e] = (1.0f - __expf(g)) * __expf(last - cm); }
            u32x4 o; o.x = pk2(qt[0], qt[1]); o.y = pk2(qt[2], qt[3]); o.z = pk2(qt[4], qt[5]); o.w = pk2(qt[6], qt[7]);
            *(u32x4*)((unsigned char*)Qg + fm_off(s, ch * 8, 4)) = o;
            o.x = pk2(qh[0], qh[1]); o.y = pk2(qh[2], qh[3]); o.z = pk2(qh[4], qh[5]); o.w = pk2(qh[6], qh[7]);
            *(LAS u32x4*)(QH + s * PS_PITCH + ch * 16) = o;
            o.x = pk2(ke[0], ke[1]); o.y = pk2(ke[2], ke[3]); o.z = pk2(ke[4], ke[5]); o.w = pk2(ke[6], ke[7]);
            *(LAS u32x4*)(KE + s * PS_PITCH + ch * 16) = o; }
    }
    LDS_BAR();
    {
        bf16_t* Ag = (bf16_t*)(ws + WS_ATT) + (size_t)item * 64 * 64;
#pragma unroll
        for (int i = 0; i < 2; ++i) { const int tile = wave * 2 + i, tt = tile >> 2, st = tile & 3; const int t = tt * 16 + fr;
            u32x2 o = (u32x2){0u, 0u};
            if (st <= tt) { f32x4 acc = (f32x4){0.f, 0.f, 0.f, 0.f};
#pragma unroll
                for (int ks = 0; ks < 4; ++ks) acc = MFMA16(lfrag(KE, PS_PITCH, st * 16 + fr, ks * 32, fq), lfrag(QH, PS_PITCH, tt * 16 + fr, ks * 32, fq), acc);
                float v[4];
#pragma unroll
                for (int j = 0; j < 4; ++j) { const int s = st * 16 + 4 * fq + j; v[j] = (s <= t) ? acc[j] : 0.f; }
                o.x = pk2(v[0], v[1]); o.y = pk2(v[2], v[3]); }
            *(u32x2*)((unsigned char*)Ag + fm_off(t, st * 16 + 4 * fq, 2)) = o; }
    }
    {
        bf16_t* Kg = (bf16_t*)(ws + WS_KENDT) + (size_t)item * 128 * 64;
        const int dlo = lane & 15, sglo = lane >> 4;
#pragma unroll
        for (int i = 0; i < 2; ++i) { const int combo = wave * 2 + i, d = (combo >> 1) * 16 + dlo, s0 = ((combo & 1) * 4 + sglo) * 8;
            unsigned v[8];
#pragma unroll
            for (int e = 0; e < 8; ++e) v[e] = *(const LAS bf16_t*)(KE + (s0 + e) * PS_PITCH + d * 2);
            u32x4 o; o.x = v[0] | (v[1] << 16); o.y = v[2] | (v[3] << 16); o.z = v[4] | (v[5] << 16); o.w = v[6] | (v[7] << 16);
            *(u32x4*)((unsigned char*)Kg + fm_off(d, s0, 2)) = o; }
    }
    LDS_BAR();
}

template <int NVT, bool DEN>
__device__ __forceinline__ void mlstm_scan(const DArgs& a, LAS unsigned char* lds, int round, int p, int sl) {
    const int tid = tid_(), lane = tid & 63, wave = __builtin_amdgcn_readfirstlane(tid >> 6), fr = lane & 15, fq = lane >> 4;
    const int bl = p >> 2, h = p & 3, b = round * 2 + bl;
    GAS unsigned char* ws = a.ws;
    constexpr int VTB = NVT * 16 * PS_PITCH, CTB = NVT * 16 * PQ_PITCH;
    LAS unsigned char* VT = lds; LAS unsigned char* CT = lds + 2 * VTB; LAS float* DEC = (LAS float*)(lds + 2 * VTB + 2 * CTB);
    for (int i = tid; i < (2 * VTB + 2 * CTB) / 4; i += NTHR) ((LAS unsigned*)lds)[i] = 0u;
    if (tid < 64) DEC[tid] = ((const GAS float*)(ws + WS_MDEC))[p * 64 + tid];
    __syncthreads();
    if (DEN) { if (tid < 256) { const int bufi = tid >> 7, s = tid & 127; *(LAS bf16_t*)(VT + bufi * VTB + s * 2) = (bf16_t)0x3F80; } }
    f32x4 st[2][NVT];
#pragma unroll
    for (int dt = 0; dt < 2; ++dt)
#pragma unroll
        for (int vt = 0; vt < NVT; ++vt) st[dt][vt] = (f32x4){0.f, 0.f, 0.f, 0.f};
    const int vcol = h * 512 + sl * 32;
    const int vs = tid >> 2, vpart = tid & 3;
    const GAS unsigned char* Sg0 = ws + WS_S + (size_t)(p * 64) * 32768 + wave * 4096 + lane * 16;
    const GAS unsigned char* Qg0 = ws + WS_QT + (size_t)(p * 64) * 65536 + wave * 8192 + lane * 16;
    const GAS unsigned char* Kg0 = ws + WS_KWT + (size_t)(p * 64) * 65536 + wave * 8192 + lane * 16;
    const GAS bf16_t* Vg0 = (const GAS bf16_t*)(ws + WS_V) + (size_t)(bl * SEQ + vs) * 2048 + vcol + vpart * 8;
    bf16x8 bS[4], bQ[8], aK[2][4]; u32x4 vreg = (u32x4){0u, 0u, 0u, 0u};
#define V_STAGE(cc_) do { LAS unsigned char* d0_ = VT + ((cc_) & 1) * VTB + (vpart * 8) * PS_PITCH + vs * 2; \
        *(LAS bf16_t*)(d0_ + 0 * PS_PITCH) = (bf16_t)(vreg.x & 0xffffu); *(LAS bf16_t*)(d0_ + 1 * PS_PITCH) = (bf16_t)(vreg.x >> 16); \
        *(LAS bf16_t*)(d0_ + 2 * PS_PITCH) = (bf16_t)(vreg.y & 0xffffu); *(LAS bf16_t*)(d0_ + 3 * PS_PITCH) = (bf16_t)(vreg.y >> 16); \
        *(LAS bf16_t*)(d0_ + 4 * PS_PITCH) = (bf16_t)(vreg.z & 0xffffu); *(LAS bf16_t*)(d0_ + 5 * PS_PITCH) = (bf16_t)(vreg.z >> 16); \
        *(LAS bf16_t*)(d0_ + 6 * PS_PITCH) = (bf16_t)(vreg.w & 0xffffu); *(LAS bf16_t*)(d0_ + 7 * PS_PITCH) = (bf16_t)(vreg.w >> 16); } while (0)
    if (!DEN) { vreg = *(const GAS u32x4*)Vg0; V_STAGE(0); }
    __builtin_amdgcn_sched_barrier(0);
#pragma unroll
    for (int ks = 0; ks < 4; ++ks)
#pragma unroll
        for (int dt = 0; dt < 2; ++dt) aK[dt][ks] = *(const GAS bf16x8*)(Kg0 + (dt * 4 + ks) * 1024);
    __builtin_amdgcn_sched_barrier(0);
#pragma unroll
    for (int ks = 0; ks < 4; ++ks) bS[ks] = *(const GAS bf16x8*)(Sg0 + ks * 1024);
    __builtin_amdgcn_sched_barrier(0);
#pragma unroll
    for (int ks = 0; ks < 8; ++ks) bQ[ks] = *(const GAS bf16x8*)(Qg0 + ks * 1024);
    __builtin_amdgcn_sched_barrier(0);
    if (!DEN) vreg = *(const GAS u32x4*)(Vg0 + (size_t)128 * 2048);
    __builtin_amdgcn_sched_barrier(0);
    const GAS unsigned char* pfp; unsigned pfstride;
    { const int tt = (wave * 64 + lane) < 160 ? wave * 64 + lane : 159; const int idx = sl * 10 + (tt >> 4), off = (tt & 15) * 64;
      pfp = (idx < 32 ? ws + WS_S + (size_t)(p * 64) * 32768 + idx * 1024 : idx < 96 ? ws + WS_QT + (size_t)(p * 64) * 65536 + (idx - 32) * 1024 : ws + WS_KWT + (size_t)(p * 64) * 65536 + (idx - 96) * 1024) + off;
      pfstride = idx < 32 ? 32768u : 65536u; }
    unsigned pfv = 0u;
#pragma unroll 1
    for (int c = 0; c < 64; ++c) {
        const int tl0 = bl * SEQ + c * 128; const size_t tg0 = (size_t)b * SEQ + c * 128;
        const int cn = c < 63 ? c + 1 : 63, cn2 = c < 62 ? c + 2 : 63;
        LAS unsigned char* vt_ = VT + (c & 1) * VTB; LAS unsigned char* ct_ = CT + (c & 1) * CTB; LAS unsigned char* ctn = CT + ((c + 1) & 1) * CTB;
        LDS_BAR();
        if (!DEN && wave < 3) { asm volatile("" :: "v"(pfv)); const int c3 = c < 60 ? c + 3 : 63; pfv = *(const GAS unsigned*)(pfp + (size_t)c3 * pfstride); }
        bf16x8 vf[NVT][4], cf[NVT][4];
#pragma unroll
        for (int vt = 0; vt < NVT; ++vt)
#pragma unroll
            for (int ks = 0; ks < 4; ++ks) vf[vt][ks] = lfrag(vt_, PS_PITCH, vt * 16 + fr, ks * 32, fq);
        const float dec = DEC[c];
        __builtin_amdgcn_sched_barrier(0);
#pragma unroll
        for (int dt = 0; dt < 2; ++dt)
#pragma unroll
            for (int vt = 0; vt < NVT; ++vt) st[dt][vt] = st[dt][vt] * dec;
#pragma unroll
        for (int ks = 0; ks < 4; ++ks) {
#pragma unroll
            for (int vt = 0; vt < NVT; ++vt) cf[vt][ks] = lfrag(ct_, PQ_PITCH, vt * 16 + fr, ks * 32, fq);
#pragma unroll
            for (int dt = 0; dt < 2; ++dt) {
#pragma unroll
                for (int vt = 0; vt < NVT; ++vt) st[dt][vt] = MFMA16(aK[dt][ks], vf[vt][ks], st[dt][vt]);
                aK[dt][ks] = *(const GAS bf16x8*)(Kg0 + (size_t)cn * 65536 + (dt * 4 + ks) * 1024);
            }
            __builtin_amdgcn_sched_barrier(0);
        }
#pragma unroll
        for (int dt = 0; dt < 2; ++dt)
#pragma unroll
            for (int vt = 0; vt < NVT; ++vt) { u32x2 o; o.x = pk2(st[dt][vt][0], st[dt][vt][1]); o.y = pk2(st[dt][vt][2], st[dt][vt][3]);
                *(LAS u32x2*)(ctn + (vt * 16 + fr) * PQ_PITCH + (wave * 32 + dt * 16 + 4 * fq) * 2) = o; }
        __builtin_amdgcn_sched_barrier(0);
        f32x4 acc[NVT];
#pragma unroll
        for (int vt = 0; vt < NVT; ++vt) acc[vt] = (f32x4){0.f, 0.f, 0.f, 0.f};
#pragma unroll
        for (int ks = 0; ks < 4; ++ks) {
#pragma unroll
            for (int vt = 0; vt < NVT; ++vt) acc[vt] = MFMA16(vf[vt][ks], bS[ks], acc[vt]);
            bS[ks] = *(const GAS bf16x8*)(Sg0 + (size_t)cn * 32768 + ks * 1024);
            __builtin_amdgcn_sched_barrier(0);
        }
#pragma unroll
        for (int ks = 0; ks < 8; ++ks) {
#pragma unroll
            for (int vt = 0; vt < NVT; ++vt) acc[vt] = MFMA16(cf[vt][ks & 3], bQ[ks], acc[vt]);
            if (ks < 4) {
#pragma unroll
                for (int vt = 0; vt < NVT; ++vt) cf[vt][ks] = lfrag(ct_, PQ_PITCH, vt * 16 + fr, 128 + ks * 32, fq);
            }
            bQ[ks] = *(const GAS bf16x8*)(Qg0 + (size_t)cn * 65536 + ks * 1024);
            __builtin_amdgcn_sched_barrier(0);
        }
        const int t = wave * 16 + fr;
        if (!DEN) {
            GAS bf16_t* hn = (GAS bf16_t*)(ws + WS_QKPRE) + (size_t)(tl0 + t) * 2048 + vcol + 4 * fq;
#pragma unroll
            for (int vt = 0; vt < NVT; ++vt) { u32x2 o; o.x = pk2(acc[vt][0], acc[vt][1]); o.y = pk2(acc[vt][2], acc[vt][3]); *(GAS u32x2*)(hn + vt * 16) = o; }
            V_STAGE(c + 1); vreg = *(const GAS u32x4*)(Vg0 + (size_t)cn2 * 128 * 2048);
        } else {
            if (fq == 0) ((GAS float*)(ws + WS_DEN))[(tg0 + t) * 4 + h] = acc[0][0];
        }
    }
    asm volatile("" :: "v"(pfv));
    __syncthreads();
#undef V_STAGE
}

constexpr int HG_PD = 4;
__device__ __forceinline__ void hgrn_scan(const DArgs& a, LAS unsigned char* lds, int round, int p, int sl) {
    const int tid = tid_(), lane = tid & 63, wave = __builtin_amdgcn_readfirstlane(tid >> 6), fr = lane & 15, fq = lane >> 4;
    const int bl = p >> 3, h = p & 7;
    GAS unsigned char* ws = a.ws;
    constexpr int IP = 144, ITB = 32 * IP, STB = 32 * PS_PITCH;
    LAS unsigned char* IT = lds; LAS unsigned char* ST = lds + 2 * ITB;
    for (int i = tid; i < (2 * ITB + 2 * STB) / 4; i += NTHR) ((LAS unsigned*)lds)[i] = 0u;
    __syncthreads();
    f32x4 st[2][2];
#pragma unroll
    for (int i = 0; i < 2; ++i) { st[i][0] = (f32x4){0.f, 0.f, 0.f, 0.f}; st[i][1] = st[i][0]; }
    const int vcol = h * 128 + sl * 32;
    const int is = (tid & 255) >> 2, ipart = tid & 3;
    const bool outw = wave < 4;
    const int w4 = wave & 3;
    const GAS unsigned char* Ag0 = ws + WS_ATT + (size_t)(p * 128) * 8192 + w4 * 2048 + lane * 16;
    const GAS unsigned char* Qg0 = ws + WS_QTG + (size_t)(p * 128) * 16384 + w4 * 4096 + lane * 16;
    const GAS unsigned char* Kg0 = ws + WS_KENDT + (size_t)(p * 128) * 16384 + w4 * 4096 + lane * 16;
    const GAS unsigned char* Dg0 = ws + WS_HGDEC + ((size_t)(p * 128) * 128 + w4 * 32 + 4 * fq) * 4;
    const GAS unsigned char* Ig0 = ws + WS_GI + ((size_t)(bl * SEQ + is) * 1024 + vcol + ipart * 8) * 2;
    const GAS unsigned char* gb0 = outw ? Ag0 : Kg0;          const unsigned gs0 = outw ? 8192u : 16384u;
    const GAS unsigned char* gb1 = outw ? Qg0 : Kg0 + 2048;   const unsigned gs1 = 16384u;
    const GAS unsigned char* gb2 = outw ? Qg0 + 2048 : Dg0;   const unsigned gs2 = outw ? 16384u : 512u, gt2 = outw ? 1024u : 64u;
    const GAS unsigned char* gb3 = outw ? Ig0 : Dg0;          const unsigned gs3 = outw ? 131072u : 512u;
    u32x4 pf[HG_PD][7];
#define HG_LD01(k_, cc_) do { _Pragma("unroll") for (int j_ = 0; j_ < 2; ++j_) pf[k_][j_] = *(const GAS u32x4*)(gb0 + (size_t)(cc_) * gs0 + j_ * 1024); } while (0)
#define HG_LD23(k_, cc_) do { _Pragma("unroll") for (int j_ = 0; j_ < 2; ++j_) pf[k_][2 + j_] = *(const GAS u32x4*)(gb1 + (size_t)(cc_) * gs1 + j_ * 1024); } while (0)
#define HG_LD45(k_, cc_) do { _Pragma("unroll") for (int j_ = 0; j_ < 2; ++j_) pf[k_][4 + j_] = *(const GAS u32x4*)(gb2 + (size_t)(cc_) * gs2 + j_ * gt2); } while (0)
#define HG_LD6(k_, cc_) do { pf[k_][6] = *(const GAS u32x4*)(gb3 + (size_t)(cc_) * gs3); } while (0)
#pragma unroll
    for (int k = 0; k < HG_PD; ++k) { HG_LD01(k, k); HG_LD23(k, k); HG_LD45(k, k); __builtin_amdgcn_sched_barrier(0); HG_LD6((k + 1) % HG_PD, (k + 1 < HG_PD ? k + 1 : HG_PD)); __builtin_amdgcn_sched_barrier(0); }
    const GAS unsigned char* pfp; unsigned pfstride;
    { const int tt = (wave * 64 + lane) < 160 ? wave * 64 + lane : 159; const int idx = sl * 10 + (tt >> 4), off = (tt & 15) * 64;
      pfp = (idx < 8 ? ws + WS_ATT + (size_t)(p * 128) * 8192 + idx * 1024 : idx < 24 ? ws + WS_QTG + (size_t)(p * 128) * 16384 + (idx - 8) * 1024 : ws + WS_KENDT + (size_t)(p * 128) * 16384 + (idx - 24) * 1024) + off;
      pfstride = idx < 8 ? 8192u : 16384u; }
    unsigned pfv[HG_PD];
#pragma unroll
    for (int k = 0; k < HG_PD; ++k) pfv[k] = 0u;
#define HG_STAGE(dst_, iv_) do { LAS unsigned char* d0_ = (dst_) + (ipart * 8) * IP + is * 2; \
        *(LAS bf16_t*)(d0_ + 0 * IP) = (bf16_t)((iv_).x & 0xffffu); *(LAS bf16_t*)(d0_ + 1 * IP) = (bf16_t)((iv_).x >> 16); \
        *(LAS bf16_t*)(d0_ + 2 * IP) = (bf16_t)((iv_).y & 0xffffu); *(LAS bf16_t*)(d0_ + 3 * IP) = (bf16_t)((iv_).y >> 16); \
        *(LAS bf16_t*)(d0_ + 4 * IP) = (bf16_t)((iv_).z & 0xffffu); *(LAS bf16_t*)(d0_ + 5 * IP) = (bf16_t)((iv_).z >> 16); \
        *(LAS bf16_t*)(d0_ + 6 * IP) = (bf16_t)((iv_).w & 0xffffu); *(LAS bf16_t*)(d0_ + 7 * IP) = (bf16_t)((iv_).w >> 16); } while (0)
    if (outw) { const u32x4 iv = *(const GAS u32x4*)Ig0; HG_STAGE(IT, iv); }
#pragma unroll 1
    for (int c0 = 0; c0 < 128; c0 += HG_PD) {
#pragma unroll
      for (int k = 0; k < HG_PD; ++k) {
        const int c = c0 + k;
        const int tl0 = bl * SEQ + c * 64;
        const int cn = (c + HG_PD < 128) ? c + HG_PD : 127;
        LAS unsigned char* it_ = IT + (k & 1) * ITB; LAS unsigned char* itn = IT + ((k + 1) & 1) * ITB; LAS unsigned char* st_ = ST + (k & 1) * STB; LAS unsigned char* stn = ST + ((k + 1) & 1) * STB;
        LDS_BAR();
        if (wave < 3) { asm volatile("" :: "v"(pfv[k])); const int c7 = (c + HG_PD + 3 < 128) ? c + HG_PD + 3 : 127; pfv[k] = *(const GAS unsigned*)(pfp + (size_t)c7 * pfstride); }
        bf16x8 itf[2][2];
#pragma unroll
        for (int vt = 0; vt < 2; ++vt)
#pragma unroll
            for (int ks = 0; ks < 2; ++ks) itf[vt][ks] = lfrag(it_, IP, vt * 16 + fr, ks * 32, fq);
        bf16x8 sf[2][4];
        f32x4 acc[2];
        acc[0] = (f32x4){0.f, 0.f, 0.f, 0.f}; acc[1] = acc[0];
        if (outw) {
#pragma unroll
            for (int vt = 0; vt < 2; ++vt)
#pragma unroll
                for (int ks = 0; ks < 4; ++ks) sf[vt][ks] = lfrag(st_, PS_PITCH, vt * 16 + fr, ks * 32, fq);
#pragma unroll
            for (int ks = 0; ks < 2; ++ks)
#pragma unroll
                for (int vt = 0; vt < 2; ++vt) acc[vt] = MFMA16(itf[vt][ks], __builtin_bit_cast(bf16x8, pf[k][ks]), acc[vt]);
        } else {
            const f32x4 dec = __builtin_bit_cast(f32x4, pf[k][4]);
#pragma unroll
            for (int vt = 0; vt < 2; ++vt) { st[0][vt] = st[0][vt] * dec;
#pragma unroll
                for (int ks = 0; ks < 2; ++ks) st[0][vt] = MFMA16(__builtin_bit_cast(bf16x8, pf[k][ks]), itf[vt][ks], st[0][vt]); }
        }
        __builtin_amdgcn_sched_barrier(0);
        HG_LD01(k, cn);
        __builtin_amdgcn_sched_barrier(0);
        if (outw) {
#pragma unroll
            for (int ks = 0; ks < 2; ++ks)
#pragma unroll
                for (int vt = 0; vt < 2; ++vt) acc[vt] = MFMA16(sf[vt][ks], __builtin_bit_cast(bf16x8, pf[k][2 + ks]), acc[vt]);
        } else {
            const f32x4 dec = __builtin_bit_cast(f32x4, pf[k][5]);
#pragma unroll
            for (int vt = 0; vt < 2; ++vt) { st[1][vt] = st[1][vt] * dec;
#pragma unroll
                for (int ks = 0; ks < 2; ++ks) st[1][vt] = MFMA16(__builtin_bit_cast(bf16x8, pf[k][2 + ks]), itf[vt][ks], st[1][vt]); }
        }
        __builtin_amdgcn_sched_barrier(0);
        HG_LD23(k, cn);
        __builtin_amdgcn_sched_barrier(0);
        if (outw) {
#pragma unroll
            for (int ks = 2; ks < 4; ++ks)
#pragma unroll
                for (int vt = 0; vt < 2; ++vt) acc[vt] = MFMA16(sf[vt][ks], __builtin_bit_cast(bf16x8, pf[k][2 + ks]), acc[vt]);
        } else {
#pragma unroll
            for (int dtile = 0; dtile < 2; ++dtile)
#pragma unroll
                for (int vt = 0; vt < 2; ++vt) { u32x2 o; o.x = pk2(st[dtile][vt][0], st[dtile][vt][1]); o.y = pk2(st[dtile][vt][2], st[dtile][vt][3]);
                    *(LAS u32x2*)(stn + (vt * 16 + fr) * PS_PITCH + (w4 * 32 + dtile * 16 + 4 * fq) * 2) = o; }
        }
        __builtin_amdgcn_sched_barrier(0);
        HG_LD45(k, cn);
        __builtin_amdgcn_sched_barrier(0);
        if (outw) {
            HG_STAGE(itn, pf[(k + 1) % HG_PD][6]);
            GAS bf16_t* og = (GAS bf16_t*)(ws + WS_GQ) + (size_t)(tl0 + w4 * 16 + fr) * 1024 + vcol + 4 * fq;
#pragma unroll
            for (int vt = 0; vt < 2; ++vt) { u32x2 o; o.x = pk2(acc[vt][0], acc[vt][1]); o.y = pk2(acc[vt][2], acc[vt][3]); *(GAS u32x2*)(og + vt * 16) = o; }
        }
        __builtin_amdgcn_sched_barrier(0);
        { const int cni = (c + 1 + HG_PD < 128) ? c + 1 + HG_PD : 127; HG_LD6((k + 1) % HG_PD, cni); }
        __builtin_amdgcn_sched_barrier(0);
      }
    }
#pragma unroll
    for (int k = 0; k < HG_PD; ++k) asm volatile("" :: "v"(pfv[k]));
    __syncthreads();
#undef HG_LD01
#undef HG_LD23
#undef HG_LD45
#undef HG_LD6
#undef HG_STAGE
}

__device__ __forceinline__ void xn8_convert(const DArgs& a, int round, int vcu, int G) {
    const int tid = tid_(), lane = tid & 63, wave = tid >> 6;
    const int gw = vcu * NWAVES + wave, NGW = G * NWAVES;
    GAS unsigned char* ws = a.ws;
    for (int tl = gw; tl < RT; tl += NGW) {
        const size_t tg = (size_t)round * RT + tl;
        const GAS u32x2* xr = (const GAS u32x2*)((const GAS bf16_t*)(ws + WS_XN) + tg * D) + lane;
        f32x4 v[4]; float mx = 0.f;
#pragma unroll
        for (int j = 0; j < 4; ++j) { const u32x2 xv = xr[64 * j]; v[j][0] = bf_lo(xv.x); v[j][1] = bf_hi(xv.x); v[j][2] = bf_lo(xv.y); v[j][3] = bf_hi(xv.y);
            mx = fmaxf(mx, fmaxf(fmaxf(fabsf(v[j][0]), fabsf(v[j][1])), fmaxf(fabsf(v[j][2]), fabsf(v[j][3])))); }
        mx = wave_max(mx);
        const float qs = mx > 0.f ? 127.0f / mx : 0.f;
#pragma unroll
        for (int j = 0; j < 4; ++j) ((GAS unsigned*)(ws + WS_XN8 + (size_t)tl * 1024))[64 * j + lane] = pack_i8x4(v[j][0] * qs, v[j][1] * qs, v[j][2] * qs, v[j][3] * qs);
        if (lane == 0) ((GAS float*)(ws + WS_SA8))[tg] = mx * (1.0f / 127.0f);
    }
}

__device__ __forceinline__ void phase_ypass(const DArgs& a, int round, int vcu, int G) {
    const int tid = tid_(), lane = tid & 63, wave = tid >> 6;
    const int gw = vcu * NWAVES + wave, NGW = G * NWAVES;
    GAS unsigned char* ws = a.ws;
    f32x4 mg0[4], mg1[4], gg4[4];
#pragma unroll
    for (int j = 0; j < 4; ++j) { mg0[j] = *(const GAS f32x4*)(a.m_head_g + j * 512 + lane * 8); mg1[j] = *(const GAS f32x4*)(a.m_head_g + j * 512 + lane * 8 + 4); gg4[j] = *(const GAS f32x4*)(a.g_head_g + lane * 16 + 4 * j); }
    for (int tl = gw; tl < RT; tl += NGW) {
        const size_t tg = (size_t)round * RT + tl;
        const f32x4 den4 = *(const f32x4*)((const float*)(ws + WS_DEN) + tg * 4), mt4 = *(const f32x4*)((const float*)(ws + WS_MT) + tg * 4);
        float ym[4][8];
#pragma unroll
        for (int j = 0; j < 4; ++j) {
            const int col = j * 512 + lane * 8;
            const u32x4 nv = *(const u32x4*)((const bf16_t*)(ws + WS_QKPRE) + (size_t)tl * 2048 + col);
            const u32x4 ov = *(const u32x4*)((const bf16_t*)(ws + WS_SIGO) + (size_t)tl * 2048 + col);
            const float inv = 1.0f / fmaxf(fabsf(den4[j]), __expf(-mt4[j]));
            float hv[8] = {bf_lo(nv.x) * inv, bf_hi(nv.x) * inv, bf_lo(nv.y) * inv, bf_hi(nv.y) * inv, bf_lo(nv.z) * inv, bf_hi(nv.z) * inv, bf_lo(nv.w) * inv, bf_hi(nv.w) * inv};
            float ss = 0.f;
#pragma unroll
            for (int e = 0; e < 8; ++e) ss += hv[e] * hv[e];
            const float r = rsqrtf(wave_sum(ss, lane) * (1.f / 512.f) + EPS);
            const f32x4 g0 = mg0[j], g1 = mg1[j];
            const float og[8] = {bf_lo(ov.x), bf_hi(ov.x), bf_lo(ov.y), bf_hi(ov.y), bf_lo(ov.z), bf_hi(ov.z), bf_lo(ov.w), bf_hi(ov.w)};
#pragma unroll
            for (int e = 0; e < 8; ++e) ym[j][e] = og[e] * hv[e] * r * (e < 4 ? g0[e] : g1[e - 4]);
        }
        {
            float mx = 0.f;
#pragma unroll
            for (int j = 0; j < 4; ++j)
#pragma unroll
                for (int e = 0; e < 8; ++e) mx = fmaxf(mx, fabsf(ym[j][e]));
            mx = wave_max(mx);
            const float qs = mx > 0.f ? 127.0f / mx : 0.f;
#pragma unroll
            for (int j = 0; j < 4; ++j) { u32x2 o; o.x = pack_i8x4(ym[j][0] * qs, ym[j][1] * qs, ym[j][2] * qs, ym[j][3] * qs); o.y = pack_i8x4(ym[j][4] * qs, ym[j][5] * qs, ym[j][6] * qs, ym[j][7] * qs);
                *(GAS u32x2*)(ws + WS_V + (size_t)tl * 2048 + j * 512 + lane * 8) = o; }
            if (lane == 0) ((GAS float*)(ws + WS_SYM))[tl] = mx * (1.0f / 127.0f);
        }
        {
            const int col = lane * 16;
            const u32x4 n0 = *(const u32x4*)((const bf16_t*)(ws + WS_GQ) + (size_t)tl * 1024 + col), n1 = *(const u32x4*)((const bf16_t*)(ws + WS_GQ) + (size_t)tl * 1024 + col + 8);
            const u32x4 s0 = *(const u32x4*)((const bf16_t*)(ws + WS_SGG) + (size_t)tl * 1024 + col), s1 = *(const u32x4*)((const bf16_t*)(ws + WS_SGG) + (size_t)tl * 1024 + col + 8);
            float ov[16] = {bf_lo(n0.x), bf_hi(n0.x), bf_lo(n0.y), bf_hi(n0.y), bf_lo(n0.z), bf_hi(n0.z), bf_lo(n0.w), bf_hi(n0.w), bf_lo(n1.x), bf_hi(n1.x), bf_lo(n1.y), bf_hi(n1.y), bf_lo(n1.z), bf_hi(n1.z), bf_lo(n1.w), bf_hi(n1.w)};
            const float sg[16] = {bf_lo(s0.x), bf_hi(s0.x), bf_lo(s0.y), bf_hi(s0.y), bf_lo(s0.z), bf_hi(s0.z), bf_lo(s0.w), bf_hi(s0.w), bf_lo(s1.x), bf_hi(s1.x), bf_lo(s1.y), bf_hi(s1.y), bf_lo(s1.z), bf_hi(s1.z), bf_lo(s1.w), bf_hi(s1.w)};
            float ss = 0.f;
#pragma unroll
            for (int e = 0; e < 16; ++e) ss += ov[e] * ov[e];
            ss += DPP_(ss, 0xB1); ss += DPP_(ss, 0x4E); ss += DPP_(ss, 0x141);
            const float r = rsqrtf(ss * (1.f / 128.f) + EPS);
            float y[16];
#pragma unroll
            for (int e = 0; e < 16; ++e) y[e] = ov[e] * r * gg4[e >> 2][e & 3] * sg[e];
            float mx = 0.f;
#pragma unroll
            for (int e = 0; e < 16; ++e) mx = fmaxf(mx, fabsf(y[e]));
            mx = wave_max(mx);
            const float qs = mx > 0.f ? 127.0f / mx : 0.f;
            u32x4 o; o.x = pack_i8x4(y[0] * qs, y[1] * qs, y[2] * qs, y[3] * qs); o.y = pack_i8x4(y[4] * qs, y[5] * qs, y[6] * qs, y[7] * qs);
            o.z = pack_i8x4(y[8] * qs, y[9] * qs, y[10] * qs, y[11] * qs); o.w = pack_i8x4(y[12] * qs, y[13] * qs, y[14] * qs, y[15] * qs);
            *(GAS u32x4*)(ws + WS_GI + (size_t)tl * 1024 + col) = o;
            if (lane == 0) ((GAS float*)(ws + WS_SYG))[tl] = mx * (1.0f / 127.0f);
        }
    }
}


#define XB_TMO      128
#define XB_XCNT(j)  (256  + 64 * (j))
#define XB_XSUB(j)  (1280 + 64 * (j))
#define XB_XGEN(j)  (2304 + 64 * (j))
#define XB_TOP      3328
#define XB_TOPGEN   3392
#define XB_SPIN_CAP (1u << 22)
constexpr int CW_BAR = 4096;
constexpr int LDS_BARST = LDS_BYTES - 64;
__device__ __forceinline__ unsigned xb_ld(unsigned* p)              { return __hip_atomic_load(p, __ATOMIC_RELAXED, __HIP_MEMORY_SCOPE_AGENT); }
__device__ __forceinline__ unsigned xb_add(unsigned* p, unsigned v) { return __hip_atomic_fetch_add(p, v, __ATOMIC_RELAXED, __HIP_MEMORY_SCOPE_AGENT); }
__device__ __forceinline__ unsigned xb_xcc_id() { return (unsigned)__builtin_amdgcn_s_getreg((3 << 11) | 20) & 0xFu; }
#define XB_SPIN(cond, bar) do { unsigned _sp = 0; while (cond) { __builtin_amdgcn_s_sleep(1); \
    if ((++_sp & 255u) == 0u) { if (xb_ld(&(bar)[XB_TMO])) break; if (_sp > XB_SPIN_CAP) { atomicAdd(&(bar)[XB_TMO], 1u); break; } } } } while (0)
__device__ __forceinline__ void xcd_barrier_post(unsigned* bar, volatile LAS unsigned* st) { if (tid_() == 0) st[2] = xb_add(&bar[XB_XCNT(xb_xcc_id())], 1u); }
__device__ __forceinline__ void xcd_barrier_complete(unsigned* bar, unsigned x, unsigned& nloc, unsigned& nx) {
    const unsigned G = gridDim.x;
    unsigned sum, cnt, mine, sp = 0u;
    for (;;) {
        sum = 0u; cnt = 0u; mine = 0u;
#pragma unroll
        for (unsigned j = 0; j < 16; ++j) { const unsigned c = xb_ld(&bar[XB_XCNT(j)]); sum += c; cnt += (c > 0u) ? 1u : 0u; mine = (j == x) ? c : mine; }
        if (sum == G) break;
        __builtin_amdgcn_s_sleep(1);
        if ((++sp & 255u) == 0u) { if (xb_ld(&bar[XB_TMO])) break; if (sp > XB_SPIN_CAP) { atomicAdd(&bar[XB_TMO], 1u); break; } }
    }
    nloc = mine > 0u ? mine : 1u; nx = cnt > 0u ? cnt : 1u;
}
__device__ __forceinline__ void xcd_barrier(unsigned* bar, volatile LAS unsigned* st) {
    asm volatile("s_waitcnt vmcnt(0)" ::: "memory");
    __syncthreads();
    if (tid_() == 0) {
        const unsigned x = xb_xcc_id();
        __builtin_amdgcn_s_waitcnt(0);
        unsigned nloc = st[0], nx = st[1];
        if (nloc == 0u) { xcd_barrier_complete(bar, x, nloc, nx); st[0] = nloc; st[1] = nx; }
        const unsigned old = xb_add(&bar[XB_XSUB(x)], 1u);
        const unsigned gen = old / nloc;
        if (old + 1u == (gen + 1u) * nloc) {
            __builtin_amdgcn_fence(__ATOMIC_RELEASE, "agent");
            asm volatile("s_waitcnt vmcnt(0)" ::: "memory");
            const unsigned og = xb_add(&bar[XB_TOP], 1u);
            const unsigned tg = og / nx;
            if (og + 1u == (tg + 1u) * nx) xb_add(&bar[XB_TOPGEN], 1u);
            else XB_SPIN(xb_ld(&bar[XB_TOPGEN]) == tg, bar);
            __builtin_amdgcn_fence(__ATOMIC_ACQUIRE, "agent");
            xb_add(&bar[XB_XGEN(x)], 1u);
            asm volatile("s_waitcnt vmcnt(0)" ::: "memory");
        } else {
            XB_SPIN(xb_ld(&bar[XB_XGEN(x)]) == gen, bar);
            __builtin_amdgcn_fence(__ATOMIC_ACQUIRE, "agent");
            asm volatile("s_waitcnt vmcnt(0)" ::: "memory");
        }
    }
    __syncthreads();
}

__device__ __forceinline__ void phase_p8(const DArgs& a, int vcu, int G) {
    const int tid = tid_(), lane = tid & 63, wave = tid >> 6;
    const int gw = vcu * NWAVES + wave, NGW = G * NWAVES;
    GAS unsigned char* ws = a.ws;
    f32x4 g2[4];
#pragma unroll
    for (int j = 0; j < 4; ++j) g2[j] = ((const f32x4*)a.norm2_g)[64 * j + lane];
    for (int m = gw; m < T; m += NGW) {
        const GAS u32x2* xr = (const GAS u32x2*)((const GAS bf16_t*)a.out + (size_t)m * D) + lane;
        f32x4 v[4]; float s = 0.f;
#pragma unroll
        for (int j = 0; j < 4; ++j) { const u32x2 xv = xr[64 * j]; v[j][0] = bf_lo(xv.x); v[j][1] = bf_hi(xv.x); v[j][2] = bf_lo(xv.y); v[j][3] = bf_hi(xv.y); s += (v[j][0] * v[j][0] + v[j][1] * v[j][1]) + (v[j][2] * v[j][2] + v[j][3] * v[j][3]); }
        const float rstd = rsqrtf(wave_sum(s, lane) * (1.f / D) + EPS);
#pragma unroll
        for (int j = 0; j < 4; ++j) v[j] = v[j] * rstd * g2[j];
        float mx = 0.f;
#pragma unroll
        for (int j = 0; j < 4; ++j) mx = fmaxf(mx, fmaxf(fmaxf(fabsf(v[j][0]), fabsf(v[j][1])), fmaxf(fabsf(v[j][2]), fabsf(v[j][3]))));
        mx = wave_max(mx);
        const float qs = mx > 0.f ? 127.0f / mx : 0.f;
#pragma unroll
        for (int j = 0; j < 4; ++j) ((GAS unsigned*)(ws + WS_XQ + (size_t)m * 1024))[64 * j + lane] = pack_i8x4(v[j][0] * qs, v[j][1] * qs, v[j][2] * qs, v[j][3] * qs);
        if (lane == 0) ((GAS float*)(ws + WS_XQS))[m] = mx * (1.0f / 127.0f);
    }
    for (int e = gw; e < 16384; e += NGW) {
        f32x4 uv[4], vv[4]; float mu = 0.f, mv = 0.f;
#pragma unroll
        for (int j = 0; j < 4; ++j) { uv[j] = ((const GAS f32x4*)(a.u_emb + (size_t)e * 1024))[64 * j + lane]; vv[j] = ((const GAS f32x4*)(a.v_emb + (size_t)e * 1024))[64 * j + lane];
            mu = fmaxf(mu, fmaxf(fmaxf(fabsf(uv[j][0]), fabsf(uv[j][1])), fmaxf(fabsf(uv[j][2]), fabsf(uv[j][3]))));
            mv = fmaxf(mv, fmaxf(fmaxf(fabsf(vv[j][0]), fabsf(vv[j][1])), fmaxf(fabsf(vv[j][2]), fabsf(vv[j][3])))); }
        mu = wave_max(mu); mv = wave_max(mv);
        const float su = mu > 0.f ? 127.0f / mu : 0.f, sv = mv > 0.f ? 448.0f / mv : 0.f;
        if (lane == 0) { ((GAS float*)(ws + WS_USC))[e] = mu * (1.0f / 127.0f); ((GAS float*)(ws + WS_VSC))[e] = mv * (1.0f / 448.0f); }
#pragma unroll
        for (int j = 0; j < 4; ++j) {
            const size_t ob = (size_t)(2 * j + (lane >> 5)) * 2097152 + (size_t)e * 128 + ((4 * lane) & 127);
            *(GAS unsigned*)(ws + WS_UB + ob) = pack_i8x4(uv[j][0] * su, uv[j][1] * su, uv[j][2] * su, uv[j][3] * su);
            int p = __builtin_amdgcn_cvt_pk_fp8_f32(vv[j][0] * sv, vv[j][1] * sv, 0, false); p = __builtin_amdgcn_cvt_pk_fp8_f32(vv[j][2] * sv, vv[j][3] * sv, p, true);
            *(GAS unsigned*)(ws + WS_VB + ob) = (unsigned)p; }
    }
}

__device__ __forceinline__ unsigned f2ord(float f) { const unsigned u = __builtin_bit_cast(unsigned, f); return (u & 0x80000000u) ? ~u : (u | 0x80000000u); }
__device__ __forceinline__ float ord2f(unsigned k) { const unsigned u = (k & 0x80000000u) ? (k & 0x7fffffffu) : ~k; return __builtin_bit_cast(float, u); }
__device__ __forceinline__ unsigned umax_(unsigned a, unsigned b) { return a > b ? a : b; }
__device__ __forceinline__ unsigned shxu(unsigned v, int o, int lane) { return (unsigned)__builtin_amdgcn_ds_bpermute((lane ^ o) << 2, (int)v); }

__device__ __forceinline__ void phase_topk(const DArgs& a, LAS unsigned char* lds, int bx, int G) {
    const int tid = tid_(), lane = tid & 63, wave = __builtin_amdgcn_readfirstlane(tid >> 6), fr = lane & 15, fq = lane >> 4;
    GAS unsigned char* ws = a.ws;
    const int h = bx & 7;
    LAS unsigned char* KY = lds;
    LAS unsigned char* QL = lds + 2 * 128 * PS_PITCH;
    LAS unsigned* TOP = (LAS unsigned*)(lds + 2 * 128 * PS_PITCH + 64 * PQ_PITCH);
#pragma unroll
    for (int i = 0; i < 8; ++i) { const int idx = tid + 512 * i, row = idx >> 4, ch = idx & 15;
        *(LAS u32x4*)(KY + row * PS_PITCH + ch * 16) = *(const u32x4*)((const bf16_t*)(ws + WS_SK) + ((size_t)h * 256 + row) * 128 + ch * 8); }
    const int ntile = T / 64;
    u32x4 qpre[4];
    { const int tile0 = bx >> 3; if (tile0 < ntile) {
#pragma unroll
        for (int i = 0; i < 4; ++i) { const int idx = tid + 512 * i, row = idx >> 5, ch = idx & 31;
            qpre[i] = *(const GAS u32x4*)((const GAS bf16_t*)(ws + WS_QP) + ((size_t)tile0 * 64 + row) * 2048 + h * 256 + ch * 8); } } }
    __syncthreads();
    for (int tile = bx >> 3; tile < ntile; tile += (G >> 3)) {
        const size_t t0 = (size_t)tile * 64;
        LDS_BAR();
#pragma unroll
        for (int i = 0; i < 4; ++i) { const int idx = tid + 512 * i, row = idx >> 5, ch = idx & 31;
            *(LAS u32x4*)(QL + row * PQ_PITCH + ch * 16) = qpre[i]; }
        { const int tn = tile + (G >> 3); if (tn < ntile) {
#pragma unroll
            for (int i = 0; i < 4; ++i) { const int idx = tid + 512 * i, row = idx >> 5, ch = idx & 31;
                qpre[i] = *(const GAS u32x4*)((const GAS bf16_t*)(ws + WS_QP) + ((size_t)tn * 64 + row) * 2048 + h * 256 + ch * 8); } } }
        LDS_BAR();
        {
            const int mt = wave & 3, p = wave >> 2;
            unsigned key[32];
#pragma unroll
            for (int nt = 0; nt < 8; ++nt) { f32x4 acc = (f32x4){0.f, 0.f, 0.f, 0.f};
#pragma unroll
                for (int ks = 0; ks < 4; ++ks) acc = MFMA16(lfrag(KY + p * 128 * PS_PITCH, PS_PITCH, nt * 16 + fr, ks * 32, fq), lfrag(QL, PQ_PITCH, mt * 16 + fr, p * 128 + ks * 32, fq), acc);
#pragma unroll
                for (int j = 0; j < 4; ++j) { const int n = nt * 16 + 4 * fq + j; key[nt * 4 + j] = (f2ord(acc[j]) & ~127u) | (unsigned)(127 - n); } }
#pragma unroll 1
            for (int k = 0; k < 16; ++k) {
                unsigned t3[11];
#pragma unroll
                for (int e = 0; e < 10; ++e) t3[e] = umax_(umax_(key[3 * e], key[3 * e + 1]), key[3 * e + 2]);
                t3[10] = umax_(key[30], key[31]);
                const unsigned u0 = umax_(umax_(t3[0], t3[1]), t3[2]), u1 = umax_(umax_(t3[3], t3[4]), t3[5]), u2 = umax_(umax_(t3[6], t3[7]), t3[8]), u3 = umax_(t3[9], t3[10]);
                unsigned m = umax_(umax_(u0, u1), umax_(u2, u3));
                m = umax_(m, (unsigned)SWZI_(m, 0x401F)); m = umax_(m, xor32u_(m, lane >= 32));
#pragma unroll
                for (int e = 0; e < 32; ++e) key[e] = (key[e] == m) ? 0u : key[e];
                if (fq == (k & 3)) TOP[(p * 64 + mt * 16 + fr) * 16 + k] = m;
            }
        }
        LDS_BAR();
        {
            const int t = tid >> 3, sub = tid & 7;
            unsigned ck[7];
#pragma unroll
            for (int e = 0; e < 7; ++e) {
                const int ci = sub + 8 * e;
                int i = 0, base = 0; bool ok = ci < 50;
                if (ci >= 42) { i = 8 + (ci - 42); base = ci; } else if (ci >= 40) { i = 7; base = 40; } else if (ci >= 38) { i = 6; base = 38; } else if (ci >= 36) { i = 5; base = 36; }
                else if (ci >= 33) { i = 4; base = 33; } else if (ci >= 29) { i = 3; base = 29; } else if (ci >= 24) { i = 2; base = 24; } else if (ci >= 16) { i = 1; base = 16; }
                const int j = ci - base;
                unsigned kk = 0u;
                if (ok) { const float s0 = ord2f(TOP[(0 * 64 + t) * 16 + i] & ~127u), s1 = ord2f(TOP[(1 * 64 + t) * 16 + j] & ~127u);
                    kk = (f2ord(s0 + s1) & ~255u) | (unsigned)(255 - (i * 16 + j)); }
                ck[e] = kk;
            }
            unsigned w0 = 0u, w1 = 0u;
#pragma unroll 1
            for (int k = 0; k < 16; ++k) {
                unsigned m = umax_(umax_(umax_(ck[0], ck[1]), ck[2]), umax_(umax_(umax_(ck[3], ck[4]), ck[5]), ck[6]));
                m = umax_(m, (unsigned)DPPI_(m, 0xB1)); m = umax_(m, (unsigned)DPPI_(m, 0x4E)); m = umax_(m, (unsigned)DPPI_(m, 0x141));
#pragma unroll
                for (int e = 0; e < 7; ++e) ck[e] = (ck[e] == m) ? 0u : ck[e];
                if (k == sub) w0 = m; if (k == sub + 8) w1 = m;
            }
            const int f0 = 255 - (int)(w0 & 255u), f1 = 255 - (int)(w1 & 255u);
            const float sc0 = ord2f(w0 & ~255u), sc1 = ord2f(w1 & ~255u);
            float mx = fmaxf(sc0, sc1); mx = fmaxf(mx, DPP_(mx, 0xB1)); mx = fmaxf(mx, DPP_(mx, 0x4E)); mx = fmaxf(mx, DPP_(mx, 0x141));
            const float e0 = __expf(sc0 - mx), e1 = __expf(sc1 - mx);
            float sm = e0 + e1; sm += DPP_(sm, 0xB1); sm += DPP_(sm, 0x4E); sm += DPP_(sm, 0x141);
            const float inv = 1.0f / sm;
            const int i0 = 127 - (int)(TOP[(0 * 64 + t) * 16 + (f0 >> 4)] & 127u), j0 = 127 - (int)(TOP[(1 * 64 + t) * 16 + (f0 & 15)] & 127u);
            const int i1 = 127 - (int)(TOP[(0 * 64 + t) * 16 + (f1 >> 4)] & 127u), j1 = 127 - (int)(TOP[(1 * 64 + t) * 16 + (f1 & 15)] & 127u);
            unsigned short* ei = (unsigned short*)(ws + WS_EIDX) + ((t0 + t) * 8 + h) * 16; float* gp = (float*)(ws + WS_GATE) + ((t0 + t) * 8 + h) * 16;
            ei[sub] = (unsigned short)(i0 * 128 + j0); ei[sub + 8] = (unsigned short)(i1 * 128 + j1); gp[sub] = e0 * inv; gp[sub + 8] = e1 * inv;
        }
    }
    __syncthreads();
}

__device__ __forceinline__ void ins16(float (&v)[16], int (&id)[16], float x, int n) {
    if (x > v[15]) { v[15] = x; id[15] = n;
#pragma unroll
        for (int i = 15; i >= 1; --i) { if (v[i] > v[i - 1]) { const float tv = v[i]; v[i] = v[i - 1]; v[i - 1] = tv; const int ti = id[i]; id[i] = id[i - 1]; id[i - 1] = ti; } } }
}
__device__ __forceinline__ void phase_topk_ref(const DArgs& a, int vcu, int G) {
    const int tid = tid_();
    GAS unsigned char* ws = a.ws;
    const int gt = vcu * NTHR + tid, NGT = G * NTHR;
    for (int pair = gt; pair < T * 8; pair += NGT) {
        const int t = pair >> 3, h = pair & 7;
        float sv[2][16]; int si[2][16];
#pragma unroll
        for (int p = 0; p < 2; ++p) {
#pragma unroll
            for (int i = 0; i < 16; ++i) { sv[p][i] = -INFINITY; si[p][i] = 0; }
            const bf16_t* qp = (const bf16_t*)(ws + WS_QP) + (size_t)t * 2048 + h * 256 + p * 128;
            for (int n = 0; n < 128; ++n) {
                const bf16_t* kp = (const bf16_t*)(ws + WS_SK) + ((size_t)(h * 2 + p) * 128 + n) * 128;
                float s = 0.f;
                for (int c = 0; c < 128; c += 8) { const u32x4 qv = *(const u32x4*)(qp + c), kv = *(const u32x4*)(kp + c);
                    s += bf_lo(qv.x) * bf_lo(kv.x) + bf_hi(qv.x) * bf_hi(kv.x) + bf_lo(qv.y) * bf_lo(kv.y) + bf_hi(qv.y) * bf_hi(kv.y)
                       + bf_lo(qv.z) * bf_lo(kv.z) + bf_hi(qv.z) * bf_hi(kv.z) + bf_lo(qv.w) * bf_lo(kv.w) + bf_hi(qv.w) * bf_hi(kv.w); }
                ins16(sv[p], si[p], s, n);
            }
        }
        float tv[16]; int ti[16];
#pragma unroll
        for (int i = 0; i < 16; ++i) { tv[i] = -INFINITY; ti[i] = 0; }
#pragma unroll
        for (int i = 0; i < 16; ++i)
#pragma unroll
            for (int j = 0; j < 16; ++j) ins16(tv, ti, sv[0][i] + sv[1][j], i * 16 + j);
        float sm = 0.f, ex[16];
#pragma unroll
        for (int k = 0; k < 16; ++k) { ex[k] = __expf(tv[k] - tv[0]); sm += ex[k]; }
        int* ei = (int*)(ws + WS_EIDX) + (size_t)pair * 16; float* gp = (float*)(ws + WS_GATE) + (size_t)pair * 16;
#pragma unroll
        for (int k = 0; k < 16; ++k) {
            int e0 = 0, e1 = 0;
#pragma unroll
            for (int i = 0; i < 16; ++i) { e0 = ((ti[k] >> 4) == i) ? si[0][i] : e0; e1 = ((ti[k] & 15) == i) ? si[1][i] : e1; }
            ei[k] = e0 * 128 + e1; gp[k] = ex[k] / sm; }
    }
}

#define FP8LO(w) __builtin_amdgcn_cvt_pk_f32_fp8((int)(w), false)
#define FP8HI(w) __builtin_amdgcn_cvt_pk_f32_fp8((int)(w), true)
__device__ __forceinline__ float dot16_fp8(const u32x4 r, const float (&x)[16]) {
    float c = 0.f;
#pragma unroll
    for (int j = 0; j < 4; ++j) { const f32x2 lo = FP8LO(r[j]), hi = FP8HI(r[j]); c += lo[0] * x[4 * j] + lo[1] * x[4 * j + 1] + hi[0] * x[4 * j + 2] + hi[1] * x[4 * j + 3]; }
    return c;
}
__device__ __forceinline__ float dot16_fp8p(const u32x4 r, const f32x2 (&xp)[8]) {
    f32x2 c2 = (f32x2){0.f, 0.f};
#pragma unroll
    for (int j = 0; j < 4; ++j) { c2 += FP8LO(r[j]) * xp[2 * j]; c2 += FP8HI(r[j]) * xp[2 * j + 1]; }
    return c2[0] + c2[1];
}
__device__ __forceinline__ float gelu_erf(float d) {
    const float ad = fabsf(d), t = __builtin_amdgcn_rcpf(ad * 0.2316418882f + 1.0f);
    float q = t * 0.5307027145f + (-0.7265760135f); q = q * t + 0.7107068705f; q = q * t + (-0.142248368f); q = q * t + 0.127414796f; q = q * t;
    const float m = d * (q * __builtin_amdgcn_exp2f(d * d * (-0.72134752044f)));
    return d < 0.f ? m : d - m;
}
__device__ __forceinline__ float bperm(float v, int srclane) { return __builtin_bit_cast(float, __builtin_amdgcn_ds_bpermute(srclane << 2, __builtin_bit_cast(int, v))); }
#define SWZ_(v, pat) __builtin_bit_cast(float, __builtin_amdgcn_ds_swizzle(__builtin_bit_cast(int, (v)), (pat)))
__device__ __forceinline__ float rs32_(float a, float b) {
#if defined(__HIP_DEVICE_COMPILE__)
    asm volatile("s_nop 1\n\tv_permlane32_swap_b32 %0, %1" : "+v"(a), "+v"(b));
#endif
    return a + b;
}
__device__ __forceinline__ float rs16_(float a, float b) {
#if defined(__HIP_DEVICE_COMPILE__)
    asm volatile("s_nop 1\n\tv_permlane16_swap_b32 %0, %1" : "+v"(a), "+v"(b));
#endif
    return a + b;
}
__device__ __forceinline__ float rs8_(float a, float b, bool bit3) {
    const float send = bit3 ? a : b, keep = bit3 ? b : a;
    return keep + DPP_(send, 0x128);
}
__device__ __forceinline__ float xor32_(float v, bool hi) {
#if defined(__HIP_DEVICE_COMPILE__)
    const auto r = __builtin_amdgcn_permlane32_swap(__builtin_bit_cast(unsigned, v), __builtin_bit_cast(unsigned, v), false, false);
    return __builtin_bit_cast(float, hi ? r[0] : r[1]);
#else
    (void)hi; return v;
#endif
}
__device__ __forceinline__ float reduce8(const float (&p)[8], int lane) {
    float q4[4], q2[2];
    const bool b5 = lane & 32, b4 = lane & 16, b3 = lane & 8;
#pragma unroll
    for (int i = 0; i < 4; ++i) { const float send = b5 ? p[i] : p[i + 4], keep = b5 ? p[i + 4] : p[i]; q4[i] = keep + xor32_(send, b5); }
#pragma unroll
    for (int i = 0; i < 2; ++i) { const float send = b4 ? q4[i] : q4[i + 2], keep = b4 ? q4[i + 2] : q4[i]; q2[i] = keep + SWZ_(send, 0x401F); }
    const float send = b3 ? q2[0] : q2[1], keep = b3 ? q2[1] : q2[0];
    float q1 = keep + SWZ_(send, 0x201F);
    q1 += DPP_(q1, 0xB1); q1 += DPP_(q1, 0x4E); q1 += DPP_(q1, 0x141);
    return q1;
}
__device__ __forceinline__ void phase_udots(const DArgs& a, LAS unsigned char* lds) {
    const int tid = tid_(), lane = tid & 63, wave = __builtin_amdgcn_readfirstlane(tid >> 6);
    GAS unsigned char* ws = a.ws;
    volatile LAS unsigned* bst = (volatile LAS unsigned*)(lds + LDS_BARST);
    const int nloc = (int)bst[0], nx = (int)bst[1], rank = (int)bst[2];
    unsigned* bar = (unsigned*)(ws + WS_CTL) + CW_BAR;
    const unsigned myx = xb_xcc_id();
    int q = 0;
    for (unsigned j = 0; j < 16; ++j) { const unsigned c = xb_ld(&bar[XB_XCNT(j)]); if (c > 0u && j < myx) ++q; }
    LAS int* LE = (LAS int*)(lds + wave * 2048);
    LAS int* LP = LE + 128; LAS float* LG = (LAS float*)(LE + 256);
    const GAS unsigned char* UB = ws + WS_UB;
    const int g8 = lane >> 3;
    const float usc = ((const GAS float*)(ws + WS_USC))[0], vsc = ((const GAS float*)(ws + WS_USC))[1];
    for (int s = q; s < 8; s += nx) {
        int tok = rank * 8 + wave;
        u32x4 xq0 = (u32x4){0u, 0u, 0u, 0u}, xq1 = xq0; u32x2 e2 = (u32x2){0u, 0u}; f32x2 g2 = (f32x2){0.f, 0.f};
#define U_INFO(t_) do { xq0 = *(const u32x4*)((const GAS bf16_t*)(ws + WS_XN) + (size_t)(t_) * D + lane * 16); xq1 = *(const u32x4*)((const GAS bf16_t*)(ws + WS_XN) + (size_t)(t_) * D + lane * 16 + 8); \
        e2 = *(const u32x2*)((const GAS int*)(ws + WS_EIDX) + (size_t)(t_) * 128 + 2 * lane); g2 = *(const f32x2*)((const GAS float*)(ws + WS_GATE) + (size_t)(t_) * 128 + 2 * lane); } while (0)
        if (tok < T) U_INFO(tok);
        for (; tok < T; tok += nloc * 8) {
            const bool in0 = (int)(e2.x >> 11) == s, in1 = (int)(e2.y >> 11) == s;
            const unsigned long long m0 = __ballot(in0), m1 = __ballot(in1);
            const unsigned long long lt = (1ull << lane) - 1ull;
            const int n0 = __popcll(m0), n = n0 + __popcll(m1);
            if (in0) { const int pos = __popcll(m0 & lt); LE[pos] = (int)e2.x; LP[pos] = 2 * lane; LG[pos] = g2[0]; }
            if (in1) { const int pos = n0 + __popcll(m1 & lt); LE[pos] = (int)e2.y; LP[pos] = 2 * lane + 1; LG[pos] = g2[1]; }
            const float xf[16] = {bf_lo(xq0.x), bf_hi(xq0.x), bf_lo(xq0.y), bf_hi(xq0.y), bf_lo(xq0.z), bf_hi(xq0.z), bf_lo(xq0.w), bf_hi(xq0.w),
                                  bf_lo(xq1.x), bf_hi(xq1.x), bf_lo(xq1.y), bf_hi(xq1.y), bf_lo(xq1.z), bf_hi(xq1.z), bf_lo(xq1.w), bf_hi(xq1.w)};
            asm volatile("s_waitcnt lgkmcnt(0)" ::: "memory");
            u32x4 R0[8], R1[8], R2[8];
#define U_ISSUE(R_, g0_) do { _Pragma("unroll") for (int k = 0; k < 8; ++k) { const int slot_ = ((g0_) + k < n) ? (g0_) + k : n - 1; const int e_ = LE[slot_]; R_[k] = *(const u32x4*)(UB + (size_t)e_ * 1024 + lane * 16); } } while (0)
#define U_DOTS(R_, g0_) do { float pp_[8]; _Pragma("unroll") for (int k = 0; k < 8; ++k) pp_[k] = dot16_fp8(R_[k], xf); const float dsum_ = reduce8(pp_, lane); const int slot_ = (g0_) + g8; \
            if (slot_ < n && (lane & 7) == 0) { const float d_ = dsum_ * usc; \
                ((GAS float*)(ws + WS_PW))[(size_t)tok * 128 + LP[slot_]] = 0.5f * d_ * (1.0f + erff(d_ * 0.70710678118654752f)) * LG[slot_] * vsc; } } while (0)
            if (n > 0) U_ISSUE(R0, 0);
            if (n > 8) U_ISSUE(R1, 8);
            if (n > 16) U_ISSUE(R2, 16);
            const int tokN = tok + nloc * 8;
            if (tokN < T) U_INFO(tokN);
            if (n > 0) U_DOTS(R0, 0);
            if (n > 8) U_DOTS(R1, 8);
            if (n > 16) U_DOTS(R2, 16);
            for (int g0 = 24; g0 < n; g0 += 8) { U_ISSUE(R0, g0); U_DOTS(R0, g0); }
            asm volatile("s_waitcnt lgkmcnt(0)" ::: "memory");
        }
#undef U_INFO
#undef U_ISSUE
#undef U_DOTS
    }
}

#define EV_OFF(ev_, g_) (((g_) & 1) ? ((ev_[(g_) >> 3][((g_) >> 1) & 3] >> 9) & 0x7fff80u) : ((ev_[(g_) >> 3][((g_) >> 1) & 3] << 7) & 0x7fff80u))
struct XcdSlice { int nloc, nx, rank, q; };
__device__ __forceinline__ XcdSlice xcd_slice_setup(const DArgs& a, LAS unsigned char* lds) {
    volatile LAS unsigned* bst = (volatile LAS unsigned*)(lds + LDS_BARST);
    XcdSlice x; x.nloc = __builtin_amdgcn_readfirstlane((int)bst[0]); x.nx = __builtin_amdgcn_readfirstlane((int)bst[1]); x.rank = __builtin_amdgcn_readfirstlane((int)bst[2]);
    unsigned* bar = (unsigned*)(a.ws + WS_CTL) + CW_BAR; const unsigned myx = xb_xcc_id();
    x.q = 0; for (unsigned j = 0; j < 16; ++j) { const unsigned c = xb_ld(&bar[XB_XCNT(j)]); if (c > 0u && j < myx) ++x.q; }
    x.q = __builtin_amdgcn_readfirstlane(x.q);
    return x;
}
__device__ __forceinline__ void phase_ua(const DArgs& a, LAS unsigned char* lds) {
    const int tid = tid_(), lane = tid & 63, wave = __builtin_amdgcn_readfirstlane(tid >> 6), k = lane >> 3, c = lane & 7;
    GAS unsigned char* ws = a.ws;
    const XcdSlice X = xcd_slice_setup(a, lds);
    const int tstride = X.nloc * 8;
    for (int sl = X.q; sl < 8; sl += X.nx) {
        const GAS unsigned char* UBs = ws + WS_UB + (size_t)sl * 2097152;
        const unsigned coff = (unsigned)c * 16u;
        GAS unsigned char* PU = ws + WS_PARTU + (size_t)sl * T * 256;
        u32x4 evA[2], evB[2], RA[16], RB[16], xa, xb; float sa, sb;
#define A_TOK(t_) ((t_) < T ? (t_) : T - 1)
#define A_INFO(ev_, t_) do { const int tq_ = A_TOK(t_); _Pragma("unroll") for (int j_ = 0; j_ < 2; ++j_) ev_[j_] = *(const GAS u32x4*)(ws + WS_EIDX + (size_t)tq_ * 256 + (unsigned)(32 * k + 16 * j_)); } while (0)
#define A_ISSUE(R_, x_, s_, ev_, t_) do { const int tq_ = A_TOK(t_); _Pragma("unroll") for (int g_ = 0; g_ < 16; ++g_) R_[g_] = *(const GAS u32x4*)(UBs + (EV_OFF(ev_, g_) | coff)); \
        x_ = *(const GAS u32x4*)(ws + WS_XQ + (size_t)tq_ * 1024 + sl * 128 + coff); s_ = ((const GAS float*)(ws + WS_XQS))[tq_]; } while (0)
#define A_DOTS(R_, x_, s_, t_) do { \
        int ir0_ = 0, ir1_ = 0; \
        _Pragma("unroll") for (int gg_ = 0; gg_ < 4; ++gg_) {           \
            int d_[4]; _Pragma("unroll") for (int q_ = 0; q_ < 4; ++q_) d_[q_] = 0; \
            _Pragma("unroll") for (int j_ = 0; j_ < 4; ++j_) { _Pragma("unroll") for (int q_ = 0; q_ < 4; ++q_) d_[q_] = __builtin_amdgcn_sdot4((int)R_[4 * gg_ + q_][j_], (int)x_[j_], d_[q_], false); } \
            _Pragma("unroll") for (int q_ = 0; q_ < 4; ++q_) d_[q_] += DPPI_(d_[q_], 0xB1); \
            _Pragma("unroll") for (int q_ = 0; q_ < 4; ++q_) d_[q_] += DPPI_(d_[q_], 0x4E); \
            _Pragma("unroll") for (int q_ = 0; q_ < 4; ++q_) d_[q_] += DPPI_(d_[q_], 0x141);          \
            _Pragma("unroll") for (int q_ = 0; q_ < 4; ++q_) { if (c == ((4 * gg_ + q_) >> 1)) { if (q_ & 1) ir1_ = d_[q_]; else ir0_ = d_[q_]; } }          \
            __builtin_amdgcn_sched_barrier(0); } \
        if ((t_) < T) *(GAS unsigned*)(PU + (size_t)(t_) * 256 + (unsigned)(4 * lane)) = pk2((float)ir0_ * s_, (float)ir1_ * s_); } while (0)
        const int n0 = X.rank * 8 + wave;
        A_INFO(evA, n0); A_INFO(evB, n0 + tstride);
        __builtin_amdgcn_sched_barrier(0);
        A_ISSUE(RA, xa, sa, evA, n0);
        __builtin_amdgcn_sched_barrier(0);
#pragma unroll 1
        for (int n = n0; n < T; n += 2 * tstride) {
            A_INFO(evA, n + 2 * tstride);
            __builtin_amdgcn_sched_barrier(0);
            A_ISSUE(RB, xb, sb, evB, n + tstride);
            __builtin_amdgcn_sched_barrier(0);
            A_DOTS(RA, xa, sa, n);
            __builtin_amdgcn_sched_barrier(0);
            A_INFO(evB, n + 3 * tstride);
            __builtin_amdgcn_sched_barrier(0);
            A_ISSUE(RA, xa, sa, evA, n + 2 * tstride);
            __builtin_amdgcn_sched_barrier(0);
            A_DOTS(RB, xb, sb, n + tstride);
            __builtin_amdgcn_sched_barrier(0);
        }
#undef A_TOK
#undef A_INFO
#undef A_ISSUE
#undef A_DOTS
    }
}
__device__ __forceinline__ void phase_ua2(const DArgs& a, int vcu, int G) {
    const int tid = tid_();
    GAS unsigned char* ws = a.ws;
    const GAS float* USC = (const GAS float*)(ws + WS_USC); const GAS float* VSC = (const GAS float*)(ws + WS_VSC);
    const GAS unsigned char* PU = ws + WS_PARTU;
    const size_t N4 = (size_t)T * 128 / 4, stride = (size_t)G * NTHR;
    for (size_t i = (size_t)vcu * NTHR + tid; i < N4; i += 2 * stride) {
        const size_t i1 = (i + stride < N4) ? i + stride : i;
        u32x2 pv0[8], pv1[8];
#pragma unroll
        for (int sl = 0; sl < 8; ++sl) { pv0[sl] = ((const GAS u32x2*)(PU + (size_t)sl * T * 256))[i]; pv1[sl] = ((const GAS u32x2*)(PU + (size_t)sl * T * 256))[i1]; }
        const f32x4 gt0 = ((const GAS f32x4*)(ws + WS_GATE))[i], gt1 = ((const GAS f32x4*)(ws + WS_GATE))[i1];
        const u32x2 ep0 = ((const GAS u32x2*)(ws + WS_EIDX))[i], ep1 = ((const GAS u32x2*)(ws + WS_EIDX))[i1];
        const unsigned e0[4] = {ep0.x & 0xffffu, ep0.x >> 16, ep0.y & 0xffffu, ep0.y >> 16}, e1[4] = {ep1.x & 0xffffu, ep1.x >> 16, ep1.y & 0xffffu, ep1.y >> 16};
        float us0[4], vs0[4], us1[4], vs1[4];
#pragma unroll
        for (int e = 0; e < 4; ++e) { us0[e] = USC[e0[e]]; vs0[e] = VSC[e0[e]]; us1[e] = USC[e1[e]]; vs1[e] = VSC[e1[e]]; }
        f32x4 d0 = (f32x4){0.f, 0.f, 0.f, 0.f}, d1 = d0;
#pragma unroll
        for (int sl = 0; sl < 8; ++sl) { d0[0] += bf_lo(pv0[sl].x); d0[1] += bf_hi(pv0[sl].x); d0[2] += bf_lo(pv0[sl].y); d0[3] += bf_hi(pv0[sl].y);
                                         d1[0] += bf_lo(pv1[sl].x); d1[1] += bf_hi(pv1[sl].x); d1[2] += bf_lo(pv1[sl].y); d1[3] += bf_hi(pv1[sl].y); }
        f32x4 w0, w1;
#pragma unroll
        for (int e = 0; e < 4; ++e) { w0[e] = gelu_erf(d0[e] * us0[e]) * gt0[e] * vs0[e]; w1[e] = gelu_erf(d1[e] * us1[e]) * gt1[e] * vs1[e]; }
        u32x2 wo; wo.x = pk2(w0[0], w0[1]); wo.y = pk2(w0[2], w0[3]); ((GAS u32x2*)(ws + WS_PW))[i] = wo;
        if (i + stride < N4) { wo.x = pk2(w1[0], w1[1]); wo.y = pk2(w1[2], w1[3]); ((GAS u32x2*)(ws + WS_PW))[i1] = wo; }
    }
}
__device__ __forceinline__ void phase_vb(const DArgs& a, LAS unsigned char* lds) {
    const int tid = tid_(), lane = tid & 63, wave = __builtin_amdgcn_readfirstlane(tid >> 6), k = lane >> 3, c = lane & 7;
    GAS unsigned char* ws = a.ws;
    const XcdSlice X = xcd_slice_setup(a, lds);
    const int tstride = X.nloc * 8;
    const bool bit3 = (lane & 8) != 0;
    for (int sl = X.q; sl < 8; sl += X.nx) {
        const GAS unsigned char* VBs = ws + WS_VB + (size_t)sl * 2097152;
        const unsigned coff = (unsigned)c * 16u;
        const unsigned xoff = (unsigned)(sl * 128 + c * 16 + 2 * k) * 4u;
        u32x4 evA[2], evB[2], RA[16], RB[16], wa[2], wb[2]; unsigned xa, xb;
#define B_TOK(t_) ((t_) < T ? (t_) : T - 1)
#define B_INFO(ev_, t_) do { const int tq_ = B_TOK(t_); _Pragma("unroll") for (int j_ = 0; j_ < 2; ++j_) ev_[j_] = *(const GAS u32x4*)(ws + WS_EIDX + (size_t)tq_ * 256 + (unsigned)(32 * k + 16 * j_)); } while (0)
#define B_ISSUE(R_, w_, x_, ev_, t_) do { const int tq_ = B_TOK(t_); _Pragma("unroll") for (int g_ = 0; g_ < 16; ++g_) R_[g_] = *(const GAS u32x4*)(VBs + (EV_OFF(ev_, g_) | coff)); \
        _Pragma("unroll") for (int j_ = 0; j_ < 2; ++j_) w_[j_] = *(const GAS u32x4*)(ws + WS_PW + (size_t)tq_ * 256 + (unsigned)(32 * k + 16 * j_)); \
        x_ = *(const GAS unsigned*)((const GAS unsigned char*)a.out + (size_t)tq_ * (D * 2) + (xoff >> 1)); } while (0)
#define B_DOTS(R_, w_, x_, t_) do { \
        f32x2 acc2_[8]; _Pragma("unroll") for (int e_ = 0; e_ < 8; ++e_) acc2_[e_] = (f32x2){0.f, 0.f}; \
        _Pragma("unroll") for (int g_ = 0; g_ < 16; ++g_) { const unsigned ww_ = w_[g_ >> 3][(g_ >> 1) & 3]; const float wk_ = (g_ & 1) ? bf_hi(ww_) : bf_lo(ww_); const f32x2 wp_ = (f32x2){wk_, wk_}; \
            _Pragma("unroll") for (int jj_ = 0; jj_ < 4; ++jj_) { acc2_[2 * jj_] += wp_ * FP8LO(R_[g_][jj_]); acc2_[2 * jj_ + 1] += wp_ * FP8HI(R_[g_][jj_]); } \
            if (g_ & 1) __builtin_amdgcn_sched_barrier(0); } \
        f32x2 w2_[4], x2_[2], y_; \
        _Pragma("unroll") for (int i_ = 0; i_ < 4; ++i_) { w2_[i_][0] = rs32_(acc2_[i_][0], acc2_[i_ + 4][0]); w2_[i_][1] = rs32_(acc2_[i_][1], acc2_[i_ + 4][1]); } \
        _Pragma("unroll") for (int i_ = 0; i_ < 2; ++i_) { x2_[i_][0] = rs16_(w2_[i_][0], w2_[i_ + 2][0]); x2_[i_][1] = rs16_(w2_[i_][1], w2_[i_ + 2][1]); } \
        y_[0] = rs8_(x2_[0][0], x2_[1][0], bit3) + bf_lo(x_); y_[1] = rs8_(x2_[0][1], x2_[1][1], bit3) + bf_hi(x_); \
        const float ss_ = wave_sum(y_[0] * y_[0] + y_[1] * y_[1], lane); \
        if ((t_) < T) { *(GAS unsigned*)(ws + WS_PARTU + (size_t)(t_) * (D * 2) + (xoff >> 1)) = pk2(y_[0], y_[1]);       \
            if (lane == 0) ((GAS float*)(ws + WS_SS))[(size_t)(t_) * 8 + sl] = ss_; } } while (0)
        const int n0 = X.rank * 8 + wave;
        B_INFO(evA, n0); B_INFO(evB, n0 + tstride);
        __builtin_amdgcn_sched_barrier(0);
        B_ISSUE(RA, wa, xa, evA, n0);
        __builtin_amdgcn_sched_barrier(0);
#pragma unroll 1
        for (int n = n0; n < T; n += 2 * tstride) {
            B_INFO(evA, n + 2 * tstride);
            __builtin_amdgcn_sched_barrier(0);
            B_ISSUE(RB, wb, xb, evB, n + tstride);
            __builtin_amdgcn_sched_barrier(0);
            B_DOTS(RA, wa, xa, n);
            __builtin_amdgcn_sched_barrier(0);
            B_INFO(evB, n + 3 * tstride);
            __builtin_amdgcn_sched_barrier(0);
            B_ISSUE(RA, wa, xa, evA, n + 2 * tstride);
            __builtin_amdgcn_sched_barrier(0);
            B_DOTS(RB, wb, xb, n + tstride);
            __builtin_amdgcn_sched_barrier(0);
        }
#undef B_TOK
#undef B_INFO
#undef B_ISSUE
#undef B_DOTS
    }
}
__device__ __forceinline__ void phase_vc(const DArgs& a, int vcu, int G) {
    const int tid = tid_(), lane = tid & 63, wave = tid >> 6;
    const int gw = vcu * NWAVES + wave, NGW = G * NWAVES;
    GAS unsigned char* ws = a.ws;
    f32x4 gf[4];
#pragma unroll
    for (int j = 0; j < 4; ++j) gf[j] = ((const GAS f32x4*)a.final_g)[64 * j + lane];
    for (int m = gw; m < T; m += NGW) {
        const f32x4 s0 = *(const GAS f32x4*)((const GAS float*)(ws + WS_SS) + (size_t)m * 8), s1 = *(const GAS f32x4*)((const GAS float*)(ws + WS_SS) + (size_t)m * 8 + 4);
        const float rstd = rsqrtf(((s0[0] + s0[1]) + (s0[2] + s0[3]) + (s1[0] + s1[1]) + (s1[2] + s1[3])) * (1.f / D) + EPS);
        const GAS u32x2* xi = (const GAS u32x2*)(ws + WS_PARTU + (size_t)m * (D * 2)) + lane;
        GAS f32x4* o = (GAS f32x4*)(a.out + (size_t)m * D) + lane;
#pragma unroll
        for (int j = 0; j < 4; ++j) { const u32x2 xv = xi[64 * j]; f32x4 v; v[0] = bf_lo(xv.x); v[1] = bf_hi(xv.x); v[2] = bf_lo(xv.y); v[3] = bf_hi(xv.y); o[64 * j] = v * rstd * gf[j]; }
    }
}

__device__ __forceinline__ void phase_final_plain(const DArgs& a, const float* src, int vcu, int G) {
    const int tid = tid_(), lane = tid & 63, wave = tid >> 6;
    const int gw = vcu * NWAVES + wave, NGW = G * NWAVES;
    f32x4 gf[4];
#pragma unroll
    for (int j = 0; j < 4; ++j) gf[j] = ((const f32x4*)a.final_g)[64 * j + lane];
    for (int m = gw; m < T; m += NGW) {
        const f32x4* xr = (const f32x4*)(src + (size_t)m * D) + lane;
        f32x4 v[4]; float s = 0.f;
#pragma unroll
        for (int j = 0; j < 4; ++j) { v[j] = xr[64 * j]; s += (v[j][0] * v[j][0] + v[j][1] * v[j][1]) + (v[j][2] * v[j][2] + v[j][3] * v[j][3]); }
        const float rstd = rsqrtf(wave_sum(s, lane) * (1.f / D) + EPS);
        f32x4* o = (f32x4*)(a.out + (size_t)m * D) + lane;
#pragma unroll
        for (int j = 0; j < 4; ++j) o[64 * j] = v[j] * rstd * gf[j];
    }
}


__device__ __forceinline__ DArgs load_args() {
    DArgs r;
#if defined(__HIP_DEVICE_COMPILE__)
    typedef const DArgs __attribute__((address_space(4))) KArgs;
    KArgs* p = (KArgs*)__builtin_amdgcn_kernarg_segment_ptr();
    asm volatile("" : "+s"(p));
    r.x = p->x; r.norm1_g = p->norm1_g; r.w_in = p->w_in; r.b_in = p->b_in; r.conv_w = p->conv_w; r.conv_b = p->conv_b; r.m_head_g = p->m_head_g; r.lb_table = p->lb_table;
    r.g_head_g = p->g_head_g; r.w_br_m = p->w_br_m; r.w_br_g = p->w_br_g; r.w_out = p->w_out; r.norm2_g = p->norm2_g; r.w_pq = p->w_pq; r.sub_keys = p->sub_keys;
    r.u_emb = p->u_emb; r.v_emb = p->v_emb; r.final_g = p->final_g; r.out = p->out; r.ws = p->ws;
#else
    r = DArgs{};
#endif
    return r;
}
__device__ __forceinline__ EpiPtrs make_ep(const DArgs& a, int round) {
    EpiPtrs ep; ep.biasp = (const GAS float*)(a.ws + WS_BIASP); ep.lb = (const GAS float*)(a.ws + WS_LB); ep.x = a.x; ep.out = a.out; ep.ws = a.ws; ep.round = round; ep.sa = (const GAS float*)(a.ws + WS_SA8); ep.sb = (const GAS float*)(a.ws + WS_SB8); ep.sym = (const GAS float*)(a.ws + WS_SYM); ep.syg = (const GAS float*)(a.ws + WS_SYG); ep.sxq = (const GAS float*)(a.ws + WS_XQS); return ep;
}
#define GRID_SYNC() do { const DArgs a_ = load_args(); xcd_barrier((unsigned*)(a_.ws + WS_CTL) + CW_BAR, (volatile LAS unsigned*)(lds + LDS_BARST)); } while (0)

__device__ __forceinline__ int bx_() { int t = blockIdx.x; asm volatile("" : "+s"(t)); return t; }
__device__ __forceinline__ int gd_() { int t = gridDim.x; asm volatile("" : "+s"(t)); return t; }
#define PH_BEGIN const DArgs a = load_args(); const int bx = bx_(), G = gd_(); const int vcu = (G % 8 == 0) ? (bx % 8) * (G / 8) + bx / 8 : bx; (void)vcu; (void)bx;

__global__ void __launch_bounds__(NTHR, 2) fwd_megakernel(Args a_unused) {
    extern __shared__ __attribute__((aligned(16))) unsigned char lds_raw[];
    LAS unsigned char* lds = (LAS unsigned char*)lds_raw;
    cg::grid_group grid = cg::this_grid();

    { const int t_ = tid_(); if (t_ < 16) ((LAS unsigned*)(lds + LDS_BARST))[t_] = 0u; __syncthreads();
      const DArgs a_ = load_args(); xcd_barrier_post((unsigned*)(a_.ws + WS_CTL) + CW_BAR, (volatile LAS unsigned*)(lds + LDS_BARST)); }
    { PH_BEGIN phase_p0(a, lds, vcu, G); }
    grid.sync();
    { PH_BEGIN phase_p0c(a, lds, vcu, G); }
    GRID_SYNC();
#pragma unroll 1
    for (int round = 0; round < NROUND; ++round) {
        {
            PH_BEGIN
            pg8::Gemm g{(const bf16_t*)(a.ws + WS_XN8 + (size_t)round * RT * 1024), (const bf16_t*)(a.ws + WS_W8A), RT, N1, D / 2};
            pg8::StaticOrder S; S.init(RT, N1, G, bx);
            EpiX<7> E{make_ep(a, round)};
            pg8::gemm_phase<EpiX<7>, pg8::StaticOrder, true, true, true>(lds, g, S, E);
        }
        { PH_BEGIN if (bx < 8) mscan_pair(a, lds, round, bx); }
        GRID_SYNC();
        { PH_BEGIN for (int it = bx; it < 512; it += G) mlstm_pre_item(a, lds, round, it); }
        { PH_BEGIN u32x4 gq[4]; int it = bx; if (it < 2048) hgrn_pre_load(a, round, it, gq);
          for (; it < 2048; it += G) hgrn_pre_item(a, lds, round, it, gq, it + G); }
        GRID_SYNC();
        { PH_BEGIN
          if (bx < 128) mlstm_scan<2, false>(a, lds, round, bx & 7, bx >> 3);
          else if (bx >= 192 && bx < 200) mlstm_scan<1, true>(a, lds, round, bx - 192, 0);
          else if (bx < 192) { const int id2 = bx - 128; hgrn_scan(a, lds, round, (id2 & 7) * 2 + ((id2 >> 3) & 1), id2 >> 4); } }
        GRID_SYNC();
        {
            PH_BEGIN
            pg8::Gemm g{(const bf16_t*)(a.ws + WS_XN8 + (size_t)round * RT * 1024), (const bf16_t*)(a.ws + WS_W8), RT, N2, D / 2};
            pg8::StaticOrder S; S.init(RT, N2, G, bx);
            EpiX<2> E{make_ep(a, round)};
            pg8::gemm_phase<EpiX<2>, pg8::StaticOrder, true, true, true>(lds, g, S, E);
        }
        GRID_SYNC();
        { PH_BEGIN phase_ypass(a, round, vcu, G); }
        GRID_SYNC();
        {
            { PH_BEGIN pg8::StaticOrder S; S.init(RT, D, G, bx);
              pg8::Gemm g{(const bf16_t*)(a.ws + WS_V), (const bf16_t*)(a.ws + WS_WM), RT, D, 2048 / 2}; EpiX<3> E{make_ep(a, round)}; pg8::gemm_phase<EpiX<3>, pg8::StaticOrder, true, true, true>(lds, g, S, E); }
            { PH_BEGIN pg8::StaticOrder S; S.init(RT, D, G, bx);
              pg8::Gemm g{(const bf16_t*)(a.ws + WS_GI), (const bf16_t*)(a.ws + WS_WG), RT, D, D / 2}; EpiX<4> E{make_ep(a, round)}; pg8::gemm_phase<EpiX<4>, pg8::StaticOrder, true, true, true>(lds, g, S, E); }
        }
        GRID_SYNC();
        {
            PH_BEGIN pg8::StaticOrder S; S.init(RT, D, G, bx);
            pg8::Gemm g{(const bf16_t*)(a.ws + WS_GFLOG), (const bf16_t*)(a.ws + WS_WO), RT, D, D}; EpiX<5> E{make_ep(a, round)}; pg8::gemm_phase<EpiX<5>, pg8::StaticOrder, true, true>(lds, g, S, E);
        }
        GRID_SYNC();
    }
    { PH_BEGIN phase_p8(a, vcu, G); }
    GRID_SYNC();
    {
        PH_BEGIN pg8::StaticOrder S; S.init(T, 2048, G, bx);
        pg8::Gemm g{(const bf16_t*)(a.ws + WS_XQ), (const bf16_t*)(a.ws + WS_WPQ), T, 2048, D / 2}; EpiX<6> E{make_ep(a, 0)}; pg8::gemm_phase<EpiX<6>, pg8::StaticOrder, true, true, true>(lds, g, S, E);
    }
    GRID_SYNC();
#ifdef TOPK_REF
    { PH_BEGIN phase_topk_ref(a, vcu, G); }
#else
    { PH_BEGIN phase_topk(a, lds, bx, G); }
#endif
    GRID_SYNC();
    { PH_BEGIN phase_ua(a, lds); }
    GRID_SYNC();
    { PH_BEGIN phase_ua2(a, vcu, G); }
    GRID_SYNC();
    { PH_BEGIN phase_vb(a, lds); }
    GRID_SYNC();
    { PH_BEGIN phase_vc(a, vcu, G); }
}

extern "C" void kernel_launch(void* const* d_in, const int* in_sizes, int n_in, void* d_out, int out_size, void* d_ws, size_t ws_size, hipStream_t stream) {
    static int grid = 0;
    if (grid == 0) {
        if (n_in != 18 || in_sizes[0] != T * D || out_size != T * D || ws_size < WS_END) {
            fprintf(stderr, "kernel_launch: unexpected shapes/workspace (n_in %d, in0 %d, out %d, ws %zu, need %zu)\n", n_in, n_in > 0 ? in_sizes[0] : -1, out_size, ws_size, (size_t)WS_END);
            grid = -1; return; }
        int dev = 0, cus = 0, per_cu = 0;
        hipGetDevice(&dev);
        hipDeviceGetAttribute(&cus, hipDeviceAttributeMultiprocessorCount, dev);
        hipFuncSetAttribute((const void*)fwd_megakernel, hipFuncAttributeMaxDynamicSharedMemorySize, LDS_BYTES);
        hipOccupancyMaxActiveBlocksPerMultiprocessor(&per_cu, (const void*)fwd_megakernel, NTHR, LDS_BYTES);
        if (per_cu < 1) { fprintf(stderr, "kernel_launch: occupancy query says %d blocks/CU\n", per_cu); per_cu = 1; }
        grid = cus;
        (void)hipGetLastError();
    }
    if (grid < 0) return;
    hipMemsetAsync((char*)d_ws + WS_CTL, 0, 131072, stream);
    Args a{};
    a.x = (const float*)d_in[0]; a.norm1_g = (const float*)d_in[1]; a.w_in = (const float*)d_in[2]; a.b_in = (const float*)d_in[3];
    a.conv_w = (const float*)d_in[4]; a.conv_b = (const float*)d_in[5]; a.m_head_g = (const float*)d_in[6]; a.lb_table = (const float*)d_in[7];
    a.g_head_g = (const float*)d_in[8]; a.w_br_m = (const float*)d_in[9]; a.w_br_g = (const float*)d_in[10]; a.w_out = (const float*)d_in[11];
    a.norm2_g = (const float*)d_in[12]; a.w_pq = (const float*)d_in[13]; a.sub_keys = (const float*)d_in[14]; a.u_emb = (const float*)d_in[15];
    a.v_emb = (const float*)d_in[16]; a.final_g = (const float*)d_in[17];
    a.out = (float*)d_out; a.ws = (unsigned char*)d_ws;
    void* args[] = {&a};
    hipError_t e = hipLaunchCooperativeKernel((const void*)fwd_megakernel, dim3(grid), dim3(NTHR), args, LDS_BYTES, stream);
    if (e != hipSuccess) fprintf(stderr, "cooperative launch failed: %s (grid %d)\n", hipGetErrorString(e), grid);
}
```

```cpp
#include <hip/hip_runtime.h>
#include <hip/hip_cooperative_groups.h>
#include <cstdio>
#include <cstdint>
namespace cg = cooperative_groups;

#define LAS __attribute__((address_space(3)))
typedef unsigned short bf16_t;
typedef short bf16x8 __attribute__((ext_vector_type(8)));
typedef float f32x4 __attribute__((ext_vector_type(4)));
typedef float f32x2 __attribute__((ext_vector_type(2)));
typedef unsigned u32x4 __attribute__((ext_vector_type(4)));
typedef unsigned u32x2 __attribute__((ext_vector_type(2)));

constexpr int D = 1024, BATCH = 4, SEQ = 8192, T = BATCH * SEQ;
constexpr int IN_COLS = 12296, NP = 12288;
constexpr int RT = 16384, NROUND = 2;
constexpr int N1 = 7168, N2 = 5120;
constexpr float EPS = 1e-6f;
constexpr int NWAVES = 8, NTHR = 512;

constexpr size_t MiB = 1u << 20;
constexpr size_t WS_CTL = 0;
constexpr size_t WS_WIN = 1 * MiB;
constexpr size_t WS_WM = 25 * MiB;
constexpr size_t WS_WG = 29 * MiB;
constexpr size_t WS_WO = 31 * MiB;
constexpr size_t WS_WPQ = 33 * MiB;
constexpr size_t WS_SK = 37 * MiB;
constexpr size_t WS_BIASP = 37 * MiB + 512 * 1024;
constexpr size_t WS_LB = WS_BIASP + 64 * 1024;
constexpr size_t WS_GATES = 38 * MiB;
constexpr size_t WS_MPREV = 39 * MiB;
constexpr size_t WS_DEN = 40 * MiB;
constexpr size_t WS_MT = 40 * MiB + 512 * 1024;
constexpr size_t WS_HGDEC = 41 * MiB;
constexpr size_t WS_MDEC = 43 * MiB;
constexpr size_t WS_XN = 44 * MiB;
constexpr size_t WS_QKPRE = 108 * MiB;
constexpr size_t WS_V = 172 * MiB;
constexpr size_t WS_GFLOG = 236 * MiB;
constexpr size_t WS_GI = 268 * MiB;
constexpr size_t WS_GQ = 300 * MiB;
constexpr size_t WS_S = 332 * MiB;
constexpr size_t WS_QT = 348 * MiB;
constexpr size_t WS_KWT = 380 * MiB;
constexpr size_t WS_ATT = 412 * MiB;
constexpr size_t WS_QTG = 428 * MiB;
constexpr size_t WS_KENDT = 460 * MiB;
constexpr size_t WS_SIGO = 332 * MiB;
constexpr size_t WS_SGG = 76 * MiB;
constexpr size_t WS_SAM = 428 * MiB;
constexpr size_t WS_SAG = 460 * MiB;
constexpr size_t WS_XN8 = 44 * MiB;
constexpr size_t WS_SA8 = 508 * MiB;
constexpr size_t WS_SB8 = 508 * MiB + 262144;
constexpr size_t WS_W8A = WS_WIN;
constexpr size_t WS_W8 = WS_WIN + (size_t)7168 * 1024;
constexpr int NI8 = 12288 + 1024 + 1024 + 2048;
constexpr size_t WS_SYM = 508 * MiB + 524288;
constexpr size_t WS_SYG = 508 * MiB + 655360;
constexpr int CW_COLMAX = 16384;
constexpr size_t WS_END = 510 * MiB;
constexpr size_t WS_QP = 108 * MiB;
constexpr size_t WS_UB = 236 * MiB;
constexpr size_t WS_VB = 252 * MiB;
constexpr size_t WS_USC = 268 * MiB;
constexpr size_t WS_VSC = 268 * MiB + 65536;
constexpr size_t WS_EIDX = 300 * MiB;
constexpr size_t WS_GATE = 316 * MiB;
constexpr size_t WS_XQ = 380 * MiB;
constexpr size_t WS_XQS = 412 * MiB;
constexpr size_t WS_PARTU = 108 * MiB;
constexpr size_t WS_SS = 348 * MiB;
constexpr size_t WS_PW = 332 * MiB;

constexpr int CW_TMAX = 64;
constexpr int LDS_BYTES = 147456;

__device__ __forceinline__ unsigned f2bf(float f) { unsigned u = __builtin_bit_cast(unsigned, f); return (u + 0x7fffu + ((u >> 16) & 1u)) >> 16; }
typedef __bf16 bf16x2_t __attribute__((ext_vector_type(2)));
__device__ __forceinline__ unsigned pk2(float lo, float hi) { bf16x2_t v; v[0] = (__bf16)lo; v[1] = (__bf16)hi; return __builtin_bit_cast(unsigned, v); }
__device__ __forceinline__ float bf_lo(unsigned w) { return __builtin_bit_cast(float, w << 16); }
__device__ __forceinline__ float bf_hi(unsigned w) { return __builtin_bit_cast(float, w & 0xffff0000u); }
__device__ __forceinline__ float bf2f(bf16_t h) { return __builtin_bit_cast(float, ((unsigned)h) << 16); }
__device__ __forceinline__ float shx(float v, int o, int lane) { return __builtin_bit_cast(float, __builtin_amdgcn_ds_bpermute((lane ^ o) << 2, __builtin_bit_cast(int, v))); }
__device__ __forceinline__ float shup(float v, int o, int lane) { return __builtin_bit_cast(float, __builtin_amdgcn_ds_bpermute(((lane - o) & 63) << 2, __builtin_bit_cast(int, v))); }
__device__ __forceinline__ float rdlane(float v, int l) { return __builtin_bit_cast(float, __builtin_amdgcn_readlane(__builtin_bit_cast(int, v), l)); }
#define DPP_(v, ctrl) __builtin_bit_cast(float, __builtin_amdgcn_update_dpp(0, __builtin_bit_cast(int, (v)), (ctrl), 0xF, 0xF, false))
__device__ __forceinline__ float wave_sum(float v, int lane) {
    (void)lane;
    v += DPP_(v, 0xB1); v += DPP_(v, 0x4E); v += DPP_(v, 0x141); v += DPP_(v, 0x140);
    return (rdlane(v, 0) + rdlane(v, 16)) + (rdlane(v, 32) + rdlane(v, 48));
}
__device__ __forceinline__ float wave_max(float v) {
    v = fmaxf(v, DPP_(v, 0xB1)); v = fmaxf(v, DPP_(v, 0x4E)); v = fmaxf(v, DPP_(v, 0x141)); v = fmaxf(v, DPP_(v, 0x140));
    return fmaxf(fmaxf(rdlane(v, 0), rdlane(v, 16)), fmaxf(rdlane(v, 32), rdlane(v, 48)));
}
__device__ __forceinline__ unsigned pack_i8x4(float a, float b, float c, float d) {
    const int ia = (int)__builtin_rintf(a), ib = (int)__builtin_rintf(b), ic = (int)__builtin_rintf(c), id = (int)__builtin_rintf(d);
    return ((unsigned)ia & 255u) | (((unsigned)ib & 255u) << 8) | (((unsigned)ic & 255u) << 16) | ((unsigned)id << 24);
}
#define SWZI_(v, pat) __builtin_amdgcn_ds_swizzle((int)(v), (pat))
#define DPPI_(v, ctrl) __builtin_amdgcn_update_dpp(0, (int)(v), (ctrl), 0xF, 0xF, false)
__device__ __forceinline__ unsigned xor32u_(unsigned v, bool hi) {
#if defined(__HIP_DEVICE_COMPILE__)
    const auto r = __builtin_amdgcn_permlane32_swap(v, v, false, false);
    return hi ? r[0] : r[1];
#else
    (void)hi; return v;
#endif
}
__device__ __forceinline__ float sigmoidf_(float x) { return __builtin_amdgcn_rcpf(1.0f + __expf(-x)); }
__device__ __forceinline__ float siluf_(float x) { return x * __builtin_amdgcn_rcpf(1.0f + __expf(-x)); }
#define LDS_WAIT() asm volatile("s_waitcnt lgkmcnt(0)" ::: "memory")
__device__ __forceinline__ int tid_() { int t = threadIdx.x; asm volatile("" : "+v"(t)); return t; }

#define GAS __attribute__((address_space(1)))
struct DArgs {
    const GAS float* x; const GAS float* norm1_g; const GAS float* w_in; const GAS float* b_in; const GAS float* conv_w; const GAS float* conv_b;
    const GAS float* m_head_g; const GAS float* lb_table; const GAS float* g_head_g; const GAS float* w_br_m; const GAS float* w_br_g; const GAS float* w_out;
    const GAS float* norm2_g; const GAS float* w_pq; const GAS float* sub_keys; const GAS float* u_emb; const GAS float* v_emb; const GAS float* final_g;
    GAS float* out; GAS unsigned char* ws;
};
struct Args {
    const float* x; const float* norm1_g; const float* w_in; const float* b_in; const float* conv_w; const float* conv_b;
    const float* m_head_g; const float* lb_table; const float* g_head_g; const float* w_br_m; const float* w_br_g; const float* w_out;
    const float* norm2_g; const float* w_pq; const float* sub_keys; const float* u_emb; const float* v_emb; const float* final_g;
    float* out; unsigned char* ws;
};

namespace pg8 {
constexpr int BM = 256, BK = 64, HALF = 128, HTB = HALF * BK * 2, STAGE_BYTES = 8 * HTB, NXCD = 8, WGM = 8;
__host__ __device__ __forceinline__ int lds_byte(int r, int c) { const int st = (r >> 4) * 2 + (c >> 5), rr = r & 15, cc = c & 31, ob = rr * 64 + cc * 2; return st * 1024 + (ob ^ (((ob >> 9) & 1) << 5)); }
__host__ __device__ __forceinline__ void stage_rc(int b, int& R, int& C) { const int st = b / 1024, sb = b % 1024, swz = sb ^ (((sb >> 9) & 1) << 5); R = (st >> 1) * 16 + swz / 64; C = (st & 1) * 32 + (swz % 64) / 2; }
__host__ __device__ __forceinline__ int perm32(int rho) { const int n = rho >> 4, i = rho & 15; return 8 * (i >> 2) + 4 * n + (i & 3); }
struct Unit { int pm, pn; };
struct Gemm { const bf16_t* A; const bf16_t* Bt; int M, N, K; };
struct StaticOrder {
    int nM, nN, nwg, G, c;
    __host__ __device__ void init(int M, int N, int G_, int c_) { nM = M / BM; nN = N / BM; nwg = nM * nN; G = G_; c = c_; }
    __host__ __device__ bool next(int i, Unit& u) const {
        const long L = (long)i * G + c; if (L >= nwg) return false;
        int wgid = (int)L; { const int q = nwg / NXCD, r = nwg % NXCD, xcd = wgid % NXCD, off = wgid / NXCD; wgid = (xcd < r ? xcd * (q + 1) : r * (q + 1) + (xcd - r) * q) + off; }
        const int nig = WGM * nN, gid = wgid / nig, fm = gid * WGM, gsz = (nM - fm) < WGM ? (nM - fm) : WGM;
        u.pm = fm + ((wgid % nig) % gsz); u.pn = (wgid % nig) / gsz; return true;
    }
    __device__ __forceinline__ void a_ready(const Unit&) const {}
    __device__ __forceinline__ void done(const Unit&) const {}
};

typedef int i32x8 __attribute__((ext_vector_type(8)));
typedef int i32x4 __attribute__((ext_vector_type(4)));
template <class Epi, class Sched, bool ALIGN_EPI = false, bool SP2 = false, bool I8 = false>
__device__ __forceinline__ void gemm_phase(LAS unsigned char* lds, const Gemm g, const Sched& S, const Epi& E) {
    const int tid = tid_(), wid = __builtin_amdgcn_readfirstlane(tid >> 6), lane = tid & 63, wr = wid >> 2, wc = wid & 3, fr = lane & 15, fq = lane >> 4;
    const int K = g.K, nt = K / BK;
    unsigned voffA[2], voffB[2];
#pragma unroll
    for (int i = 0; i < 2; ++i) { int R, C; stage_rc(tid * 16 + i * 8192, R, C); const int Rb = Epi::PERM ? ((R & ~31) + perm32(R & 31)) : R;
        voffA[i] = (unsigned)(R * K + C) * 2u; voffB[i] = (unsigned)(Rb * K + C) * 2u; }
    const size_t kstep = (size_t)(BK * 2);
    const size_t hstep = (size_t)HALF * K * 2;
    const size_t tstep = 2 * hstep;
    const unsigned ldsw = (unsigned)wid * 1024u;
    const int aoff = lds_byte(wr * 64 + fr, fq * 8), boff = lds_byte(wc * 32 + fr, fq * 8);
#define PG8_SA(b, h) (((b) * 2 + (h)) * HTB)
#define PG8_SB(b, h) ((4 + (b) * 2 + (h)) * HTB)
#define PG8_STAGE(bufoff, gbase, voff) do { _Pragma("unroll") for (int _i = 0; _i < 2; ++_i) \
        __builtin_amdgcn_global_load_lds((const unsigned*)((const char*)(gbase) + (voff)[_i]), (LAS unsigned*)(lds + (bufoff) + ldsw + _i * 8192), 16, 0, 0); } while (0)
#define PG8_LDA(dst, b, h) do { _Pragma("unroll") for (int m = 0; m < 4; ++m) _Pragma("unroll") for (int k = 0; k < 2; ++k) dst[m][k] = *(const LAS bf16x8*)(lds + PG8_SA(b, h) + aoff + m * 2048 + k * 1024); } while (0)
#define PG8_LDB(dst, b, h) do { _Pragma("unroll") for (int n = 0; n < 2; ++n) _Pragma("unroll") for (int k = 0; k < 2; ++k) dst[n][k] = *(const LAS bf16x8*)(lds + PG8_SB(b, h) + boff + n * 2048 + k * 1024); } while (0)
#define PG8_MMA(ai, bj, At, Bt) do { __builtin_amdgcn_s_setprio(1); _Pragma("unroll") for (int m = 0; m < 4; ++m) _Pragma("unroll") for (int n = 0; n < 2; ++n) _Pragma("unroll") for (int k = 0; k < 2; ++k) { \
        if constexpr (I8) acc[ai][bj][m][n] = __builtin_bit_cast(f32x4, __builtin_amdgcn_mfma_i32_16x16x64_i8(__builtin_bit_cast(i32x4, Bt[n][k]), __builtin_bit_cast(i32x4, At[m][k]), __builtin_bit_cast(i32x4, acc[ai][bj][m][n]), 0, 0, 0)); \
        else acc[ai][bj][m][n] = __builtin_amdgcn_mfma_f32_16x16x32_bf16(Bt[n][k], At[m][k], acc[ai][bj][m][n], 0, 0, 0); } __builtin_amdgcn_s_setprio(0); } while (0)
#define PG8_WAIT_V(n) asm volatile("s_waitcnt vmcnt(" #n ")" ::: "memory")
#define PG8_WAIT_L(n) asm volatile("s_waitcnt lgkmcnt(" #n ")" ::: "memory")
#define PG8_BAR __builtin_amdgcn_s_barrier()
#define PG8_SCHED __builtin_amdgcn_sched_barrier(0)
    Unit cur, nxt; int ui = 0;
    if (!S.next(0, cur)) return;
    f32x4 acc[2][2][4][2];
#pragma unroll
    for (int a = 0; a < 2; ++a)
#pragma unroll
        for (int b = 0; b < 2; ++b)
#pragma unroll
            for (int m = 0; m < 4; ++m)
#pragma unroll
                for (int n = 0; n < 2; ++n) acc[a][b][m][n] = (f32x4){0.f, 0.f, 0.f, 0.f};
    bf16x8 At[4][2], B0[2][2], B1[2][2];
    const char* cA = (const char*)g.A + (size_t)cur.pm * tstep; const char* cB = (const char*)g.Bt + (size_t)cur.pn * tstep;
    S.a_ready(cur);
    if constexpr (SP2) {
        PG8_STAGE(PG8_SB(0, 0), cB, voffB); PG8_STAGE(PG8_SB(0, 1), cB + hstep, voffB); PG8_STAGE(PG8_SA(0, 0), cA, voffA); PG8_STAGE(PG8_SA(0, 1), cA + hstep, voffA);
        if (wr == 1) PG8_BAR;
        PG8_WAIT_V(2); PG8_BAR;
        PG8_STAGE(PG8_SB(1, 0), cB + kstep, voffB); PG8_STAGE(PG8_SA(1, 0), cA + kstep, voffA); PG8_STAGE(PG8_SB(1, 1), cB + hstep + kstep, voffB);
        PG8_WAIT_V(6); PG8_BAR;
    } else {
        PG8_STAGE(PG8_SB(0, 0), cB, voffB); PG8_STAGE(PG8_SA(0, 0), cA, voffA); PG8_STAGE(PG8_SB(0, 1), cB + hstep, voffB); PG8_STAGE(PG8_SA(0, 1), cA + hstep, voffA);
        if (wr == 1) PG8_BAR;
        PG8_WAIT_V(4); PG8_BAR;
        PG8_STAGE(PG8_SB(1, 0), cB + kstep, voffB); PG8_STAGE(PG8_SA(1, 0), cA + kstep, voffA); PG8_STAGE(PG8_SB(1, 1), cB + hstep + kstep, voffB);
        PG8_WAIT_V(6); PG8_BAR;
    }
    for (;;) {
        const bool has_next = S.next(ui + 1, nxt);
        const char* nA = has_next ? (const char*)g.A + (size_t)nxt.pm * tstep : cA; const char* nB = has_next ? (const char*)g.Bt + (size_t)nxt.pn * tstep : cB;
#pragma unroll 1
        for (int t = 0; t < nt; t += 2) {
            const bool last = (t == nt - 2);
            const char* a1 = cA + (size_t)(t + 1) * kstep;
            const char* a2 = last ? nA : cA + (size_t)(t + 2) * kstep; const char* b2 = last ? nB : cB + (size_t)(t + 2) * kstep;
            const char* a3 = a2 + kstep; const char* b3 = b2 + kstep;
            if (last && has_next) S.a_ready(nxt);
            if constexpr (SP2) {
            PG8_LDB(B0, 0, 0); PG8_LDB(B1, 0, 1); PG8_SCHED; PG8_LDA(At, 0, 0); PG8_STAGE(PG8_SA(1, 1), a1 + hstep, voffA);
            PG8_WAIT_V(8); PG8_WAIT_L(0); PG8_BAR; PG8_MMA(0, 0, At, B0); PG8_MMA(0, 1, At, B1); PG8_BAR; PG8_SCHED;
            PG8_LDA(At, 0, 1); PG8_STAGE(PG8_SB(0, 0), b2, voffB); PG8_STAGE(PG8_SB(0, 1), b2 + hstep, voffB); PG8_STAGE(PG8_SA(0, 0), a2, voffA);
            PG8_WAIT_V(8); PG8_WAIT_L(0); PG8_BAR; PG8_MMA(1, 0, At, B0); PG8_MMA(1, 1, At, B1); PG8_BAR; PG8_SCHED;
            PG8_LDB(B0, 1, 0); PG8_LDB(B1, 1, 1); PG8_SCHED; PG8_LDA(At, 1, 0); PG8_STAGE(PG8_SA(0, 1), a2 + hstep, voffA);
            PG8_WAIT_V(8); PG8_WAIT_L(0); PG8_BAR; PG8_MMA(0, 0, At, B0); PG8_MMA(0, 1, At, B1); PG8_BAR; PG8_SCHED;
            PG8_LDA(At, 1, 1); PG8_STAGE(PG8_SB(1, 0), b3, voffB); PG8_STAGE(PG8_SB(1, 1), b3 + hstep, voffB); PG8_STAGE(PG8_SA(1, 0), a3, voffA);
            PG8_WAIT_V(8); PG8_WAIT_L(0); PG8_BAR; PG8_MMA(1, 0, At, B0); PG8_MMA(1, 1, At, B1); PG8_BAR; PG8_SCHED;
            } else {
            PG8_LDB(B0, 0, 0); PG8_SCHED; PG8_LDA(At, 0, 0); PG8_STAGE(PG8_SA(1, 1), a1 + hstep, voffA);
            PG8_WAIT_L(8); PG8_BAR; PG8_WAIT_L(0); PG8_MMA(0, 0, At, B0); PG8_BAR; PG8_SCHED;
            PG8_LDB(B1, 0, 1); PG8_STAGE(PG8_SB(0, 0), b2, voffB);
            PG8_BAR; PG8_WAIT_L(0); PG8_MMA(0, 1, At, B1); PG8_BAR;
            PG8_LDA(At, 0, 1); PG8_STAGE(PG8_SA(0, 0), a2, voffA);
            PG8_BAR; PG8_WAIT_L(0); PG8_MMA(1, 0, At, B0); PG8_BAR; PG8_SCHED;
            PG8_STAGE(PG8_SB(0, 1), b2 + hstep, voffB);
            PG8_WAIT_V(6); PG8_BAR; PG8_MMA(1, 1, At, B1); PG8_BAR;
            PG8_LDB(B0, 1, 0); PG8_SCHED; PG8_LDA(At, 1, 0); PG8_STAGE(PG8_SA(0, 1), a2 + hstep, voffA);
            PG8_WAIT_L(8); PG8_BAR; PG8_WAIT_L(0); PG8_MMA(0, 0, At, B0); PG8_BAR; PG8_SCHED;
            PG8_LDB(B1, 1, 1); PG8_STAGE(PG8_SB(1, 0), b3, voffB);
            PG8_BAR; PG8_WAIT_L(0); PG8_MMA(0, 1, At, B1); PG8_BAR;
            PG8_LDA(At, 1, 1); PG8_STAGE(PG8_SA(1, 0), a3, voffA);
            PG8_BAR; PG8_WAIT_L(0); PG8_MMA(1, 0, At, B0); PG8_BAR; PG8_SCHED;
            PG8_STAGE(PG8_SB(1, 1), b3 + hstep, voffB);
            PG8_WAIT_V(6); PG8_BAR; PG8_MMA(1, 1, At, B1); PG8_BAR;
            }
        }
        if constexpr (ALIGN_EPI) { if (wr == 0) PG8_BAR; }
        E(acc, cur, wr, wc, fr, fq);
        if (!has_next) break;
#pragma unroll
        for (int a = 0; a < 2; ++a)
#pragma unroll
            for (int b = 0; b < 2; ++b)
#pragma unroll
                for (int m = 0; m < 4; ++m)
#pragma unroll
                    for (int n = 0; n < 2; ++n) acc[a][b][m][n] = (f32x4){0.f, 0.f, 0.f, 0.f};
        cur = nxt; cA = nA; cB = nB; ++ui;
        if constexpr (ALIGN_EPI) { if (wr == 1) PG8_BAR; }
    }
    PG8_WAIT_V(0);
    if constexpr (!ALIGN_EPI) { if (wr == 0) PG8_BAR; }
    PG8_BAR;
#undef PG8_SA
#undef PG8_SB
#undef PG8_STAGE
#undef PG8_LDA
#undef PG8_LDB
#undef PG8_MMA
#undef PG8_WAIT_V
#undef PG8_WAIT_L
#undef PG8_BAR
#undef PG8_SCHED
}
}

typedef int i32x4q __attribute__((ext_vector_type(4)));
struct EpiPtrs {
    const GAS float* biasp; const GAS float* lb; const GAS float* x; GAS float* out; GAS unsigned char* ws; int round;
    int pn0;
    const GAS float* sa; const GAS float* sb; const GAS float* sym; const GAS float* syg; const GAS float* sxq;
};
template <int MODE> struct EpiX {
    static constexpr bool PERM = true, AFTER_DRAIN = false;
    EpiPtrs P;
    __device__ __forceinline__ void operator()(const f32x4 (&acc)[2][2][4][2], const pg8::Unit& u, int wr, int wc, int fr, int fq) const {
        const int upn = u.pn + (MODE == 2 ? P.pn0 : 0);
        const int row0 = u.pm * 256 + wr * 64 + fr;
        const int colt = upn * 256 + wc * 32 + 8 * fq;
        GAS unsigned char* ws = P.ws;
        bf16_t* dst = nullptr; int ld = 0, coff = 0, act = 0; const GAS float* bias = nullptr;
        if (MODE == 1 || MODE == 7) {
            bias = P.biasp;
            if (upn < 8) { dst = (bf16_t*)(ws + WS_QKPRE); ld = 2048; coff = 0; act = 0; }
            else if (upn < 16) { dst = (bf16_t*)(ws + WS_V); ld = 2048; coff = 2048; act = 0; }
            else if (upn < 20) { dst = (bf16_t*)(ws + WS_GFLOG); ld = 1024; coff = 4096; act = 3; }
            else if (upn < 24) { dst = (bf16_t*)(ws + WS_GI); ld = 1024; coff = 5120; act = 0; }
            else { dst = (bf16_t*)(ws + WS_GQ); ld = 1024; coff = 6144; act = 2; }
        } else if (MODE == 2) {
            bias = P.biasp + N1;
            if (upn < 8) { dst = (bf16_t*)(ws + WS_SIGO); ld = 2048; coff = 0; act = 1; }
            else if (upn < 12) { dst = (bf16_t*)(ws + WS_SGG); ld = 1024; coff = 2048; act = 2; }
            else if (upn < 16) { dst = (bf16_t*)(ws + WS_SAM); ld = 1024; coff = 3072; act = 1; }
            else { dst = (bf16_t*)(ws + WS_SAG); ld = 1024; coff = 4096; act = 1; }
        } else if (MODE == 6) { dst = (bf16_t*)(ws + WS_QP); ld = 2048; coff = 0; act = 0; }
        float sr8[2][4];
#pragma unroll
        for (int ai = 0; ai < 2; ++ai)
#pragma unroll
            for (int m = 0; m < 4; ++m) { const int row = row0 + ai * 128 + m * 16;
                sr8[ai][m] = (MODE == 3) ? P.sym[row] : (MODE == 4) ? P.syg[row] : (MODE == 6) ? P.sxq[row] : (MODE == 2 || MODE == 7) ? P.sa[(size_t)P.round * RT + row] : 1.0f; }
#pragma unroll
        for (int bj = 0; bj < 2; ++bj) {
            const int col = colt + bj * 128;
            f32x4 b0 = (f32x4){0.f, 0.f, 0.f, 0.f}, b1 = b0, l0 = b0, l1 = b0;
            if (MODE == 1 || MODE == 2 || MODE == 7) { b0 = *(const f32x4*)(bias + col); b1 = *(const f32x4*)(bias + col + 4); }
            f32x4 s0 = (f32x4){1.f, 1.f, 1.f, 1.f}, s1 = s0;
            if (MODE == 2) { s0 = *(const GAS f32x4*)(P.sb + 7168 + col); s1 = *(const GAS f32x4*)(P.sb + 7168 + col + 4); }
            if (MODE == 7) { s0 = *(const GAS f32x4*)(P.sb + col); s1 = *(const GAS f32x4*)(P.sb + col + 4); }
            if (MODE == 3) { s0 = *(const GAS f32x4*)(P.sb + 12288 + col); s1 = *(const GAS f32x4*)(P.sb + 12288 + col + 4); }
            if (MODE == 4) { s0 = *(const GAS f32x4*)(P.sb + 13312 + col); s1 = *(const GAS f32x4*)(P.sb + 13312 + col + 4); }
            if (MODE == 6) { s0 = *(const GAS f32x4*)(P.sb + 14336 + col); s1 = *(const GAS f32x4*)(P.sb + 14336 + col + 4); }
            if (MODE == 1 || MODE == 7) { if (act == 3) { l0 = *(const f32x4*)(P.lb + (col - coff)); l1 = *(const f32x4*)(P.lb + (col - coff) + 4); } }
#pragma unroll
            for (int ai = 0; ai < 2; ++ai) {
                u32x4 gpre[4], zpre[4]; f32x4 xpre[4][2];
#pragma unroll
                for (int m = 0; m < 4; ++m) { const int row = row0 + ai * 128 + m * 16;
                    if (MODE == 3) gpre[m] = *(const GAS u32x4*)((const GAS bf16_t*)(ws + WS_SAM) + (size_t)row * 1024 + col);
                    if (MODE == 4) { gpre[m] = *(const GAS u32x4*)((const GAS bf16_t*)(ws + WS_SAG) + (size_t)row * 1024 + col);
                                     zpre[m] = *(const GAS u32x4*)((const GAS bf16_t*)P.out + (size_t)T * 1024 + ((size_t)P.round * RT + row) * 1024 + col); }
                    if (MODE == 5) { const size_t off = ((size_t)P.round * RT + row) * 1024 + col; xpre[m][0] = *(const GAS f32x4*)(P.x + off); xpre[m][1] = *(const GAS f32x4*)(P.x + off + 4); } }
#pragma unroll
                for (int m = 0; m < 4; ++m) {
                    const int row = row0 + ai * 128 + m * 16;
                    f32x4 v0, v1;
                    if (MODE == 2 || MODE == 7 || MODE == 3 || MODE == 4 || MODE == 6) { const float sr = sr8[ai][m]; const i32x4q q0 = __builtin_bit_cast(i32x4q, acc[ai][bj][m][0]), q1 = __builtin_bit_cast(i32x4q, acc[ai][bj][m][1]);
                        v0 = (f32x4){(float)q0[0], (float)q0[1], (float)q0[2], (float)q0[3]} * (s0 * sr) + b0; v1 = (f32x4){(float)q1[0], (float)q1[1], (float)q1[2], (float)q1[3]} * (s1 * sr) + b1; }
                    else { v0 = acc[ai][bj][m][0] + b0; v1 = acc[ai][bj][m][1] + b1; }
                    if (MODE == 1 || MODE == 2 || MODE == 6 || MODE == 7) {
                        if (act == 1) {
#pragma unroll
                            for (int j = 0; j < 4; ++j) { v0[j] = sigmoidf_(v0[j]); v1[j] = sigmoidf_(v1[j]); }
                        } else if (act == 2) {
#pragma unroll
                            for (int j = 0; j < 4; ++j) { v0[j] = siluf_(v0[j]); v1[j] = siluf_(v1[j]); }
                        } else if (act == 3) {
#pragma unroll
                            for (int j = 0; j < 4; ++j) { v0[j] = __logf(l0[j] + (1.0f - l0[j]) * sigmoidf_(v0[j])); v1[j] = __logf(l1[j] + (1.0f - l1[j]) * sigmoidf_(v1[j])); }
                        }
                        u32x4 w; w.x = pk2(v0[0], v0[1]); w.y = pk2(v0[2], v0[3]); w.z = pk2(v1[0], v1[1]); w.w = pk2(v1[2], v1[3]);
                        *(u32x4*)(dst + (size_t)row * ld + (col - coff)) = w;
                    } else if (MODE == 3) {
                        const u32x4 g = gpre[m];
                        GAS bf16_t* o = (GAS bf16_t*)P.out + (size_t)T * 1024 + ((size_t)P.round * RT + row) * 1024 + col;
                        f32x4 r0, r1;
                        r0[0] = v0[0] * bf_lo(g.x); r0[1] = v0[1] * bf_hi(g.x); r0[2] = v0[2] * bf_lo(g.y); r0[3] = v0[3] * bf_hi(g.y);
                        r1[0] = v1[0] * bf_lo(g.z); r1[1] = v1[1] * bf_hi(g.z); r1[2] = v1[2] * bf_lo(g.w); r1[3] = v1[3] * bf_hi(g.w);
                        u32x4 w; w.x = pk2(r0[0], r0[1]); w.y = pk2(r0[2], r0[3]); w.z = pk2(r1[0], r1[1]); w.w = pk2(r1[2], r1[3]);
                        *(GAS u32x4*)o = w;
                    } else if (MODE == 4) {
                        const u32x4 g = gpre[m], zv = zpre[m];
                        const f32x4 p0 = (f32x4){bf_lo(zv.x), bf_hi(zv.x), bf_lo(zv.y), bf_hi(zv.y)}, p1 = (f32x4){bf_lo(zv.z), bf_hi(zv.z), bf_lo(zv.w), bf_hi(zv.w)};
                        f32x4 r0, r1;
                        r0[0] = p0[0] + v0[0] * bf_lo(g.x); r0[1] = p0[1] + v0[1] * bf_hi(g.x); r0[2] = p0[2] + v0[2] * bf_lo(g.y); r0[3] = p0[3] + v0[3] * bf_hi(g.y);
                        r1[0] = p1[0] + v1[0] * bf_lo(g.z); r1[1] = p1[1] + v1[1] * bf_hi(g.z); r1[2] = p1[2] + v1[2] * bf_lo(g.w); r1[3] = p1[3] + v1[3] * bf_hi(g.w);
                        u32x4 w; w.x = pk2(r0[0], r0[1]); w.y = pk2(r0[2], r0[3]); w.z = pk2(r1[0], r1[1]); w.w = pk2(r1[2], r1[3]);
                        *(u32x4*)((bf16_t*)(ws + WS_GFLOG) + (size_t)row * 1024 + col) = w;
                    } else if (MODE == 5) {
                        const size_t off = ((size_t)P.round * RT + row) * 1024 + col;
                        const f32x4 x0 = xpre[m][0] + v0, x1 = xpre[m][1] + v1;
                        u32x4 w; w.x = pk2(x0[0], x0[1]); w.y = pk2(x0[2], x0[3]); w.z = pk2(x1[0], x1[1]); w.w = pk2(x1[2], x1[3]);
                        *(GAS u32x4*)((GAS bf16_t*)P.out + off) = w;
                    }
                }
            }
        }
    }
};

__device__ __forceinline__ void p0_transpose_item(const GAS float* W, int ldw, int K, int k0, int scol, GAS bf16_t* WT, int drow, LAS float* scr, int lane) {
#pragma unroll 8
    for (int i = 0; i < 32; ++i) { const int kk = 2 * i + (lane >> 5); scr[kk * 33 + (lane & 31)] = W[(size_t)(k0 + kk) * ldw + scol + (lane & 31)]; }
    LDS_WAIT(); asm volatile("" ::: "memory");
    const int c = lane & 7;
#pragma unroll
    for (int j = 0; j < 4; ++j) { const int n = (lane >> 3) + 8 * j; const LAS float* s = scr + (8 * c) * 33 + n;
        u32x4 o; o.x = pk2(s[0 * 33], s[1 * 33]); o.y = pk2(s[2 * 33], s[3 * 33]); o.z = pk2(s[4 * 33], s[5 * 33]); o.w = pk2(s[6 * 33], s[7 * 33]);
        *(u32x4*)(WT + (size_t)(drow + n) * K + k0 + 8 * c) = o; }
    LDS_WAIT(); asm volatile("" ::: "memory");
}
__device__ __forceinline__ void p0_colmax_item(const GAS float* W, int ldw, int k0, int scol, GAS unsigned* colmax, int lane) {
    float mx = 0.f;
#pragma unroll 8
    for (int i = 0; i < 32; ++i) { const int kk = 2 * i + (lane >> 5); mx = fmaxf(mx, fabsf(W[(size_t)(k0 + kk) * ldw + scol + (lane & 31)])); }
    mx = fmaxf(mx, __builtin_bit_cast(float, xor32u_(__builtin_bit_cast(unsigned, mx), lane >= 32)));
    if (lane < 32) atomicMax((unsigned*)colmax + lane, __builtin_bit_cast(unsigned, mx));
}
__device__ __forceinline__ void p0_cvt8_item(const GAS float* W, int ldw, int k0, int scol, const GAS unsigned* colmax, GAS unsigned char* WT8, int pitch, GAS float* sb, int drow, LAS float* scr, int lane) {
    const float cm = __builtin_bit_cast(float, colmax[lane & 31]);
    const float qs = cm > 0.f ? 127.0f / cm : 0.f;
    if (k0 == 0 && lane < 32) sb[lane] = cm * (1.0f / 127.0f);
#pragma unroll 8
    for (int i = 0; i < 32; ++i) { const int kk = 2 * i + (lane >> 5); scr[kk * 33 + (lane & 31)] = W[(size_t)(k0 + kk) * ldw + scol + (lane & 31)] * qs; }
    LDS_WAIT(); asm volatile("" ::: "memory");
    const int n = lane >> 1, kh = lane & 1;
    const LAS float* sp = scr + (kh * 32) * 33 + n;
    u32x4 o0, o1;
#pragma unroll
    for (int q = 0; q < 8; ++q) { const unsigned p = pack_i8x4(sp[(4 * q) * 33], sp[(4 * q + 1) * 33], sp[(4 * q + 2) * 33], sp[(4 * q + 3) * 33]);
        if (q < 4) o0[q] = p; else o1[q - 4] = p; }
    GAS unsigned char* dst = WT8 + (size_t)(drow + n) * pitch + k0 + kh * 32;
    *(GAS u32x4*)dst = o0; *(GAS u32x4*)(dst + 16) = o1;
    LDS_WAIT(); asm volatile("" ::: "memory");
}
__device__ __forceinline__ int win_src_col(int n) {
    if (n < 4096) return n;
    if (n < 7168) return n - 4096 + 6152;
    if (n < 9216) return n - 7168 + 4096;
    return n - 9216 + 9224;
}

__device__ __forceinline__ void phase_p0(const DArgs& a, LAS unsigned char* lds, int vcu, int G) {
    const int tid = tid_(), lane = tid & 63, wave = tid >> 6;
    const int gw = vcu * NWAVES + wave, NGW = G * NWAVES;
    GAS unsigned char* ws = a.ws;
    LAS float* scr = (LAS float*)(lds + wave * 16384);
    constexpr int I_IN = 16 * 384, I_M = 32 * 32, I_G = 16 * 32, I_O = 16 * 32, I_PQ = 16 * 64;
    constexpr int NITEMS = I_IN + I_M + I_G + I_O + I_PQ;
    for (int it = gw; it < NITEMS; it += NGW) {
        int r = it;
        if (r < I_IN) { const int kb = r / 384, nb = r % 384;
            p0_colmax_item(a.w_in, IN_COLS, kb * 64, win_src_col(nb * 32), (GAS unsigned*)(ws + WS_CTL) + CW_COLMAX + nb * 32, lane);
            continue; } r -= I_IN;
        if (r < I_M) { const int kb = r / 32, nb = r % 32; p0_colmax_item(a.w_br_m, 1024, kb * 64, nb * 32, (GAS unsigned*)(ws + WS_CTL) + CW_COLMAX + 12288 + nb * 32, lane); continue; } r -= I_M;
        if (r < I_G) { const int kb = r / 32, nb = r % 32; p0_colmax_item(a.w_br_g, 1024, kb * 64, nb * 32, (GAS unsigned*)(ws + WS_CTL) + CW_COLMAX + 13312 + nb * 32, lane); continue; } r -= I_G;
        if (r < I_O) { const int kb = r / 32, nb = r % 32; p0_transpose_item(a.w_out, 1024, 1024, kb * 64, nb * 32, (GAS bf16_t*)(ws + WS_WO), nb * 32, scr, lane); continue; } r -= I_O;
        { const int kb = r / 64, nb = r % 64; p0_colmax_item(a.w_pq, 2048, kb * 64, nb * 32, (GAS unsigned*)(ws + WS_CTL) + CW_COLMAX + 14336 + nb * 32, lane); }
    }
    const int gt = vcu * NTHR + tid, NGT = G * NTHR;
    for (int i = gt; i < NP; i += NGT) ((float*)(ws + WS_BIASP))[i] = a.b_in[win_src_col(i)];
    for (int i = gt; i < 1024; i += NGT) { const float t0 = a.lb_table[i], t1 = a.lb_table[1024 + i]; ((float*)(ws + WS_LB))[i] = 1.0f / (1.0f + __expf(t1 - t0)); }
    for (int i = gt; i < 8 * 2 * 128 * 128 / 4; i += NGT) { const f32x4 v = ((const f32x4*)a.sub_keys)[i]; u32x2 o; o.x = pk2(v[0], v[1]); o.y = pk2(v[2], v[3]); ((u32x2*)(ws + WS_SK))[i] = o; }
    f32x4 g1[4];
#pragma unroll
    for (int j = 0; j < 4; ++j) g1[j] = ((const GAS f32x4*)a.norm1_g)[64 * j + lane];
    f32x4 gw0[16], gw1[16];
#pragma unroll
    for (int j = 0; j < 4; ++j)
#pragma unroll
        for (int e = 0; e < 4; ++e) { const int k = 256 * j + 4 * lane + e; gw0[4 * j + e] = *(const GAS f32x4*)(a.w_in + (size_t)k * IN_COLS + 6144); gw1[4 * j + e] = *(const GAS f32x4*)(a.w_in + (size_t)k * IN_COLS + 6148); }
    const float gbias = lane < 8 ? a.b_in[6144 + lane] : 0.f;
    for (int m = gw; m < T; m += NGW) {
        const GAS f32x4* xr = (const GAS f32x4*)(a.x + (size_t)m * D) + lane;
        f32x4 v[4]; float s = 0.f;
#pragma unroll
        for (int j = 0; j < 4; ++j) { v[j] = xr[64 * j]; s += (v[j][0] * v[j][0] + v[j][1] * v[j][1]) + (v[j][2] * v[j][2] + v[j][3] * v[j][3]); }
        const float rstd = rsqrtf(wave_sum(s, lane) * (1.f / D) + EPS);
        f32x4 ga0 = (f32x4){0.f, 0.f, 0.f, 0.f}, ga1 = ga0;
        float mx = 0.f;
#pragma unroll
        for (int j = 0; j < 4; ++j) {
            v[j] = v[j] * rstd * g1[j];
            mx = fmaxf(mx, fmaxf(fmaxf(fabsf(v[j][0]), fabsf(v[j][1])), fmaxf(fabsf(v[j][2]), fabsf(v[j][3]))));
#pragma unroll
            for (int e = 0; e < 4; ++e) { ga0 += gw0[4 * j + e] * v[j][e]; ga1 += gw1[4 * j + e] * v[j][e]; }
        }
        {
            mx = wave_max(mx);
            const float qs = mx > 0.f ? 127.0f / mx : 0.f;
#pragma unroll
            for (int jq = 0; jq < 4; ++jq) ((GAS unsigned*)(ws + WS_XN8 + (size_t)m * 1024))[64 * jq + lane] = pack_i8x4(v[jq][0] * qs, v[jq][1] * qs, v[jq][2] * qs, v[jq][3] * qs);
            if (lane == 0) ((GAS float*)(ws + WS_SA8))[m] = mx * (1.0f / 127.0f);
        }
        float ga[8] = {ga0[0], ga0[1], ga0[2], ga0[3], ga1[0], ga1[1], ga1[2], ga1[3]};
#pragma unroll
        for (int q = 0; q < 8; ++q) ga[q] = wave_sum(ga[q], lane);
        if (lane < 8) { float r = ga[0];
#pragma unroll
            for (int q = 1; q < 8; ++q) r = (lane == q) ? ga[q] : r;
            ((GAS float*)(ws + WS_GATES))[(size_t)m * 8 + lane] = r + gbias; }
    }
}

__device__ __forceinline__ float logsigf_(float x) { return fminf(x, 0.f) - log1pf(__expf(-fabsf(x))); }
#define LDS_BAR() do { asm volatile("s_waitcnt lgkmcnt(0)" ::: "memory"); __builtin_amdgcn_s_barrier(); asm volatile("" ::: "memory"); } while (0)
#define MFMA16(a, b, c) __builtin_amdgcn_mfma_f32_16x16x32_bf16((a), (b), (c), 0, 0, 0)
__device__ __forceinline__ bf16x8 lfrag(const LAS unsigned char* base, int pitch, int row, int k0, int fq) { return *(const LAS bf16x8*)(base + row * pitch + (k0 + 8 * fq) * 2); }
__device__ __forceinline__ int fm_off(int r, int k, int KB) { return (((r >> 4) * KB + (k >> 5)) << 10) + (((((k >> 3) & 3) << 4) + (r & 15)) << 4) + ((k & 7) << 1); }
__device__ __forceinline__ bf16x8 gfrag(const bf16_t* base, int ld, int row, int k0, int fq) { return *(const bf16x8*)(base + (size_t)row * ld + k0 + 8 * fq); }

__device__ __forceinline__ void phase_p0c(const DArgs& a, LAS unsigned char* lds, int vcu, int G) {
    const int tid = tid_(), lane = tid & 63, wave = tid >> 6;
    const int gw = vcu * NWAVES + wave, NGW = G * NWAVES;
    GAS unsigned char* ws = a.ws;
    LAS float* scr = (LAS float*)(lds + wave * 16384);
    constexpr int J_IN = 16 * 384, J_M = 32 * 32, J_G = 16 * 32, J_PQ = 16 * 64;
    const GAS unsigned* cmx = (const GAS unsigned*)(ws + WS_CTL) + CW_COLMAX; GAS float* sb = (GAS float*)(ws + WS_SB8);
    for (int it = gw; it < J_IN + J_M + J_G + J_PQ; it += NGW) {
        int r = it;
        if (r < J_IN) { const int kb = r / 384, nb = r % 384;
            p0_cvt8_item(a.w_in, IN_COLS, kb * 64, win_src_col(nb * 32), cmx + nb * 32, ws + WS_W8A, 1024, sb + nb * 32, nb * 32, scr, lane); continue; } r -= J_IN;
        if (r < J_M) { const int kb = r / 32, nb = r % 32; p0_cvt8_item(a.w_br_m, 1024, kb * 64, nb * 32, cmx + 12288 + nb * 32, ws + WS_WM, 2048, sb + 12288 + nb * 32, nb * 32, scr, lane); continue; } r -= J_M;
        if (r < J_G) { const int kb = r / 32, nb = r % 32; p0_cvt8_item(a.w_br_g, 1024, kb * 64, nb * 32, cmx + 13312 + nb * 32, ws + WS_WG, 1024, sb + 13312 + nb * 32, nb * 32, scr, lane); continue; } r -= J_G;
        { const int kb = r / 64, nb = r % 64; p0_cvt8_item(a.w_pq, 2048, kb * 64, nb * 32, cmx + 14336 + nb * 32, ws + WS_WPQ, 1024, sb + 14336 + nb * 32, nb * 32, scr, lane); }
    }
}
__device__ __forceinline__ void mscan_pair(const DArgs& a, LAS unsigned char* lds, int round, int p) {
    const int tid = tid_(), lane = tid & 63, part = tid >> 6;
    const int bl = p >> 2, h = p & 3, b = round * 2 + bl;
    const GAS float* g = (const GAS float*)(a.ws + WS_GATES) + ((size_t)b * SEQ + (size_t)lane * 128 + part * 16) * 8;
    float bsum = 0.f, gm = -INFINITY;
#pragma unroll 4
    for (int s = 0; s < 16; ++s) { const float ip = g[s * 8 + h], fp = g[s * 8 + 4 + h]; bsum += logsigf_(fp); gm = fmaxf(gm, ip - bsum); }
    LAS float* PS = (LAS float*)lds; LAS float* PM = PS + 512;
    PS[part * 64 + lane] = bsum; PM[part * 64 + lane] = gm;
    __syncthreads();
    if (tid < 64) {
        float bs = 0.f, g2 = -INFINITY;
#pragma unroll
        for (int q = 0; q < 8; ++q) { g2 = fmaxf(g2, PM[q * 64 + lane] - bs); bs += PS[q * 64 + lane]; }
        float mprev = 0.f, mine = 0.f;
        for (int c = 0; c < 64; ++c) {
            const float bc = rdlane(bs, c), gc = rdlane(g2, c);
            if (lane == c) mine = mprev; mprev = bc + fmaxf(mprev, gc); }
        ((GAS float*)(a.ws + WS_MPREV))[(round * 8 + p) * 64 + lane] = mine;
    }
    __syncthreads();
}

constexpr int PQ_PITCH = 528, PS_PITCH = 272;
__device__ __forceinline__ void mlstm_pre_item(const DArgs& a, LAS unsigned char* lds, int round, int item) {
    const int tid = tid_(), lane = tid & 63, wave = __builtin_amdgcn_readfirstlane(tid >> 6), fr = lane & 15, fq = lane >> 4;
    const int p = item >> 6, c = item & 63, bl = p >> 2, h = p & 3, b = round * 2 + bl;
    const int tl0 = bl * SEQ + c * 128; const size_t tg0 = (size_t)b * SEQ + c * 128;
    GAS unsigned char* ws = a.ws;
    LAS unsigned char* QL = lds; LAS unsigned char* KL = lds + 67584;
    LAS float* AS = (LAS float*)(lds + 135168); LAS float* MS = AS + 128; LAS float* SC = AS + 256;
    if (wave == 0) {
        const float mprev = ((const float*)(ws + WS_MPREV))[(round * 8 + p) * 64 + c];
        const float* g = (const float*)(ws + WS_GATES) + (tg0 + 2 * lane) * 8;
        const float ip0 = g[h], fp0 = g[4 + h], ip1 = g[8 + h], fp1 = g[12 + h];
        const float lf0 = logsigf_(fp0), lf1 = logsigf_(fp1), pp = lf0 + lf1;
        float incl = pp;
#pragma unroll
        for (int o = 1; o < 64; o <<= 1) { const float t = shup(incl, o, lane); if (lane >= o) incl += t; }
        const float excl = incl - pp, b0 = excl + lf0, b1 = incl;
        const float a0 = ip0 - b0, a1 = ip1 - b1;
        float inclm = fmaxf(a0, a1);
#pragma unroll
        for (int o = 1; o < 64; o <<= 1) { const float t = shup(inclm, o, lane); if (lane >= o) inclm = fmaxf(inclm, t); }
        float exclm = shup(inclm, 1, lane); if (lane == 0) exclm = -INFINITY;
        const float M0 = fmaxf(mprev, fmaxf(exclm, a0)), M1 = fmaxf(mprev, inclm);
        AS[2 * lane] = a0; AS[2 * lane + 1] = a1; MS[2 * lane] = M0; MS[2 * lane + 1] = M1;
        float* mt = (float*)(ws + WS_MT) + (tg0 + 2 * lane) * 4 + h;
        mt[0] = b0 + M0; mt[4] = b1 + M1;
        const float Mlast = rdlane(M1, 63);
        if (lane == 0) { SC[0] = mprev; SC[1] = Mlast; ((float*)(ws + WS_MDEC))[item] = __expf(mprev - Mlast); }
    }
    {
        const int cgp = tid & 63, strip = tid >> 6;
        const int col = (cgp < 32) ? (h * 256 + cgp * 8) : (1024 + h * 256 + (cgp - 32) * 8);
        float w[4][8], bb[8];
#pragma unroll
        for (int j = 0; j < 4; ++j) { const f32x4 w0 = *(const f32x4*)(a.conv_w + j * 2048 + col), w1 = *(const f32x4*)(a.conv_w + j * 2048 + col + 4);
#pragma unroll
            for (int e = 0; e < 4; ++e) { w[j][e] = w0[e]; w[j][4 + e] = w1[e]; } }
        { const f32x4 b0 = *(const f32x4*)(a.conv_b + col), b1 = *(const f32x4*)(a.conv_b + col + 4);
#pragma unroll
            for (int e = 0; e < 4; ++e) { bb[e] = b0[e]; bb[4 + e] = b1[e]; } }
        const bf16_t* src = (const bf16_t*)(ws + WS_QKPRE) + (size_t)(tl0 + 16 * strip) * 2048 + col;
        const float qs = (cgp < 32) ? 0.0625f : 1.0f;
        LAS unsigned char* dstt = ((cgp < 32) ? QL : KL) + (cgp & 31) * 16;
#pragma unroll 1
        for (int half = 0; half < 2; ++half) {
            u32x4 xr[11];
#pragma unroll
            for (int r = 0; r < 11; ++r) {
                const int sl = c * 128 + 16 * strip + 8 * half + r - 3;
                xr[r] = (sl >= 0) ? *(const u32x4*)(src + (ptrdiff_t)(8 * half + r - 3) * 2048) : (u32x4){0u, 0u, 0u, 0u};
            }
#pragma unroll
            for (int r = 0; r < 8; ++r) {
                float y[8];
#pragma unroll
                for (int e = 0; e < 8; ++e) y[e] = bb[e];
#pragma unroll
                for (int j = 0; j < 4; ++j) { const u32x4 xv = xr[r + j];
                    y[0] += w[j][0] * bf_lo(xv.x); y[1] += w[j][1] * bf_hi(xv.x); y[2] += w[j][2] * bf_lo(xv.y); y[3] += w[j][3] * bf_hi(xv.y);
                    y[4] += w[j][4] * bf_lo(xv.z); y[5] += w[j][5] * bf_hi(xv.z); y[6] += w[j][6] * bf_lo(xv.w); y[7] += w[j][7] * bf_hi(xv.w); }
#pragma unroll
                for (int e = 0; e < 8; ++e) y[e] = siluf_(y[e]) * qs;
                u32x4 o; o.x = pk2(y[0], y[1]); o.y = pk2(y[2], y[3]); o.z = pk2(y[4], y[5]); o.w = pk2(y[6], y[7]);
                *(LAS u32x4*)(dstt + (16 * strip + 8 * half + r) * PQ_PITCH) = o;
            }
        }
    }
    __syncthreads();
    const float mprev = SC[0], Mlast = SC[1];
    {
        bf16_t* Sg = (bf16_t*)(ws + WS_S) + (size_t)item * 128 * 128;
        const int t = wave * 16 + fr; const float Mt = MS[t];
        for (int st = 0; st < 8; ++st) {
            u32x2 o = (u32x2){0u, 0u};
            if (st <= wave) {
                f32x4 acc = (f32x4){0.f, 0.f, 0.f, 0.f};
#pragma unroll
                for (int ks = 0; ks < 8; ++ks) acc = MFMA16(lfrag(KL, PQ_PITCH, st * 16 + fr, ks * 32, fq), lfrag(QL, PQ_PITCH, wave * 16 + fr, ks * 32, fq), acc);
                float v[4];
#pragma unroll
                for (int j = 0; j < 4; ++j) { const int s = st * 16 + 4 * fq + j; v[j] = (s <= t) ? acc[j] * __expf(AS[s] - Mt) : 0.f; }
                o.x = pk2(v[0], v[1]); o.y = pk2(v[2], v[3]);
            }
            *(u32x2*)((unsigned char*)Sg + fm_off(t, st * 16 + 4 * fq, 4)) = o;
        }
    }
    {
        bf16_t* Qg = (bf16_t*)(ws + WS_QT) + (size_t)item * 128 * 256;
#pragma unroll
        for (int i = 0; i < 8; ++i) { const int idx = tid + 512 * i, blk = idx >> 6, t = (blk >> 3) * 16 + (idx & 15), ch = (blk & 7) * 4 + ((idx >> 4) & 3);
            const u32x4 v = *(const LAS u32x4*)(QL + t * PQ_PITCH + ch * 16); const float s = __expf(mprev - MS[t]);
            u32x4 o; o.x = pk2(bf_lo(v.x) * s, bf_hi(v.x) * s); o.y = pk2(bf_lo(v.y) * s, bf_hi(v.y) * s); o.z = pk2(bf_lo(v.z) * s, bf_hi(v.z) * s); o.w = pk2(bf_lo(v.w) * s, bf_hi(v.w) * s);
            *(u32x4*)((unsigned char*)Qg + fm_off(t, ch * 8, 8)) = o; }
    }
    {
        bf16_t* Kg = (bf16_t*)(ws + WS_KWT) + (size_t)item * 256 * 128;
        const int dlo = lane & 15, sglo = lane >> 4;
#pragma unroll
        for (int i = 0; i < 8; ++i) { const int combo = wave * 8 + i, d = (combo >> 2) * 16 + dlo, s0 = ((combo & 3) * 4 + sglo) * 8;
            float v[8];
#pragma unroll
            for (int e = 0; e < 8; ++e) v[e] = bf2f(*(const LAS bf16_t*)(KL + (s0 + e) * PQ_PITCH + d * 2)) * __expf(AS[s0 + e] - Mlast);
            u32x4 o; o.x = pk2(v[0], v[1]); o.y = pk2(v[2], v[3]); o.z = pk2(v[4], v[5]); o.w = pk2(v[6], v[7]);
            *(u32x4*)((unsigned char*)Kg + fm_off(d, s0, 4)) = o; }
    }
    __syncthreads();
}

__device__ __forceinline__ void hgrn_pre_load(const DArgs& a, int round, int item, u32x4 (&gq)[4]) {
    const int tid = tid_();
    const int p = item >> 7, c = item & 127, bl = p >> 3, h = p & 7;
    const int tl0 = bl * SEQ + c * 64;
    GAS unsigned char* ws = a.ws;
#pragma unroll
    for (int i = 0; i < 2; ++i) { const int idx = tid + 512 * i, s = idx >> 4, ch = idx & 15;
        gq[2 * i] = *(const GAS u32x4*)((const GAS bf16_t*)(ws + WS_GFLOG) + (size_t)(tl0 + s) * 1024 + h * 128 + ch * 8);
        gq[2 * i + 1] = *(const GAS u32x4*)((const GAS bf16_t*)(ws + WS_GQ) + (size_t)(tl0 + s) * 1024 + h * 128 + ch * 8); }
}
__device__ __forceinline__ void hgrn_pre_item(const DArgs& a, LAS unsigned char* lds, int round, int item, u32x4 (&gq)[4], int next_item) {
    const int tid = tid_(), lane = tid & 63, wave = __builtin_amdgcn_readfirstlane(tid >> 6), fr = lane & 15, fq = lane >> 4;
    const int p = item >> 7, c = item & 127, bl = p >> 3, h = p & 7;
    const int tl0 = bl * SEQ + c * 64;
    GAS unsigned char* ws = a.ws;
    LAS float* CUM = (LAS float*)lds;
    LAS float* GL = (LAS float*)(lds + 32768);
    LAS unsigned char* QH = lds + 65536;
    LAS unsigned char* KE = lds + 65536 + 64 * PS_PITCH;
    LAS float* QF = (LAS float*)(lds + 65536 + 128 * PS_PITCH);
#pragma unroll
    for (int i = 0; i < 2; ++i) { const int idx = tid + 512 * i, s = idx >> 4, ch = idx & 15;
        const u32x4 gv = gq[2 * i], qv = gq[2 * i + 1];
        LAS float* gd = GL + s * 128 + ch * 8; LAS float* qd = QF + s * 128 + ch * 8;
        gd[0] = bf_lo(gv.x); gd[1] = bf_hi(gv.x); gd[2] = bf_lo(gv.y); gd[3] = bf_hi(gv.y); gd[4] = bf_lo(gv.z); gd[5] = bf_hi(gv.z); gd[6] = bf_lo(gv.w); gd[7] = bf_hi(gv.w);
        qd[0] = bf_lo(qv.x); qd[1] = bf_hi(qv.x); qd[2] = bf_lo(qv.y); qd[3] = bf_hi(qv.y); qd[4] = bf_lo(qv.z); qd[5] = bf_hi(qv.z); qd[6] = bf_lo(qv.w); qd[7] = bf_hi(qv.w); }
    if (next_item < 2048) hgrn_pre_load(a, round, next_item, gq);
    LDS_BAR();
    {
        const int d = tid & 127, qt = tid >> 7; float cs = 0.f;
#pragma unroll 4
        for (int s = 0; s < 16; ++s) { cs += GL[(qt * 16 + s) * 128 + d]; CUM[(qt * 16 + s) * 128 + d] = cs; }
        LDS_BAR();
        float off = 0.f;
#pragma unroll
        for (int q = 0; q < 3; ++q) off += (q < qt) ? CUM[(q * 16 + 15) * 128 + d] : 0.f;
        LDS_BAR();
#pragma unroll 4
        for (int s = 0; s < 16; ++s) CUM[(qt * 16 + s) * 128 + d] += off;
        if (qt == 3) ((GAS float*)(ws + WS_HGDEC))[(size_t)item * 128 + d] = __expf(cs + off);
    }
    LDS_BAR();
    {
        bf16_t* Qg = (bf16_t*)(ws + WS_QTG) + (size_t)item * 64 * 128;
#pragma unroll
        for (int i = 0; i < 2; ++i) { const int idx = tid + 512 * i, s = idx >> 4, ch = idx & 15;
            float qt[8], qh[8], ke[8];
#pragma unroll
            for (int e = 0; e < 8; ++e) { const int d = ch * 8 + e; const float cm = CUM[s * 128 + d], last = CUM[63 * 128 + d], q = QF[s * 128 + d], g = GL[s * 128 + d];
                qt[e] = q * __expf(cm); qh[e] = q * __expf(cm - last); ke[e] = (1.0f - __expf(g)) * __expf(last - cm); }
            u32x4 o; o.x = pk2(qt[0], qt[1]); o.y = pk2(qt[2], qt[3]); o.z = pk2(qt[4], qt[5]); o.w = pk2(qt[6], qt[7]);
            *(u32x4*)((unsigned char*)Qg + fm_off(s, ch * 8, 4)) = o;
            o.x = pk2(qh[0], qh[1]); o.y = pk2(qh[2], qh[3]); o.z = pk2(qh[4], qh[5]); o.w = pk2(qh[6], qh[7]);
            *(LAS u32x4*)(QH + s * PS_PITCH + ch * 16) = o;
            o.x = pk2(ke[0], ke[1]); o.y = pk2(ke[2], ke[3]); o.z = pk2(ke[4], ke[5]); o.w = pk2(ke[6], ke[7]);
            *(LAS u32x4*)(KE + s * PS_PITCH + ch * 16) = o; }
    }
    LDS_BAR();
    {
        bf16_t* Ag = (bf16_t*)(ws + WS_ATT) + (size_t)item * 64 * 64;
#pragma unroll
        for (int i = 0; i < 2; ++i) { const int tile = wave * 2 + i, tt = tile >> 2, st = tile & 3; const int t = tt * 16 + fr;
            u32x2 o = (u32x2){0u, 0u};
            if (st <= tt) { f32x4 acc = (f32x4){0.f, 0.f, 0.f, 0.f};
#pragma unroll
                for (int ks = 0; ks < 4; ++ks) acc = MFMA16(lfrag(KE, PS_PITCH, st * 16 + fr, ks * 32, fq), lfrag(QH, PS_PITCH, tt * 16 + fr, ks * 32, fq), acc);
                float v[4];
#pragma unroll
                for (int j = 0; j < 4; ++j) { const int s = st * 16 + 4 * fq + j; v[j] = (s <= t) ? acc[j] : 0.f; }
                o.x = pk2(v[0], v[1]); o.y = pk2(v[2], v[3]); }
            *(u32x2*)((unsigned char*)Ag + fm_off(t, st * 16 + 4 * fq, 2)) = o; }
    }
    {
        bf16_t* Kg = (bf16_t*)(ws + WS_KENDT) + (size_t)item * 128 * 64;
        const int dlo = lane & 15, sglo = lane >> 4;
#pragma unroll
        for (int i = 0; i < 2; ++i) { const int combo = wave * 2 + i, d = (combo >> 1) * 16 + dlo, s0 = ((combo & 1) * 4 + sglo) * 8;
            unsigned v[8];
#pragma unroll
            for (int e = 0; e < 8; ++e) v[e] = *(const LAS bf16_t*)(KE + (s0 + e) * PS_PITCH + d * 2);
            u32x4 o; o.x = v[0] | (v[1] << 16); o.y = v[2] | (v[3] << 16); o.z = v[4] | (v[5] << 16); o.w = v[6] | (v[7] << 16);
            *(u32x4*)((unsigned char*)Kg + fm_off(d, s0, 2)) = o; }
    }
    LDS_BAR();
}

template <int NVT, bool DEN>
__device__ __forceinline__ void mlstm_scan(const DArgs& a, LAS unsigned char* lds, int round, int p, int sl) {
    const int tid = tid_(), lane = tid & 63, wave = __builtin_amdgcn_readfirstlane(tid >> 6), fr = lane & 15, fq = lane >> 4;
    const int bl = p >> 2, h = p & 3, b = round * 2 + bl;
    GAS unsigned char* ws = a.ws;
    constexpr int VTB = NVT * 16 * PS_PITCH, CTB = NVT * 16 * PQ_PITCH;
    LAS unsigned char* VT = lds; LAS unsigned char* CT = lds + 2 * VTB; LAS float* DEC = (LAS float*)(lds + 2 * VTB + 2 * CTB);
    for (int i = tid; i < (2 * VTB + 2 * CTB) / 4; i += NTHR) ((LAS unsigned*)lds)[i] = 0u;
    if (tid < 64) DEC[tid] = ((const GAS float*)(ws + WS_MDEC))[p * 64 + tid];
    __syncthreads();
    if (DEN) { if (tid < 256) { const int bufi = tid >> 7, s = tid & 127; *(LAS bf16_t*)(VT + bufi * VTB + s * 2) = (bf16_t)0x3F80; } }
    f32x4 st[2][NVT];
#pragma unroll
    for (int dt = 0; dt < 2; ++dt)
#pragma unroll
        for (int vt = 0; vt < NVT; ++vt) st[dt][vt] = (f32x4){0.f, 0.f, 0.f, 0.f};
    const int vcol = h * 512 + sl * 32;
    const int vs = tid >> 2, vpart = tid & 3;
    const GAS unsigned char* Sg0 = ws + WS_S + (size_t)(p * 64) * 32768 + wave * 4096 + lane * 16;
    const GAS unsigned char* Qg0 = ws + WS_QT + (size_t)(p * 64) * 65536 + wave * 8192 + lane * 16;
    const GAS unsigned char* Kg0 = ws + WS_KWT + (size_t)(p * 64) * 65536 + wave * 8192 + lane * 16;
    const GAS bf16_t* Vg0 = (const GAS bf16_t*)(ws + WS_V) + (size_t)(bl * SEQ + vs) * 2048 + vcol + vpart * 8;
    bf16x8 bS[4], bQ[8], aK[2][4]; u32x4 vreg = (u32x4){0u, 0u, 0u, 0u};
#define V_STAGE(cc_) do { LAS unsigned char* d0_ = VT + ((cc_) & 1) * VTB + (vpart * 8) * PS_PITCH + vs * 2; \
        *(LAS bf16_t*)(d0_ + 0 * PS_PITCH) = (bf16_t)(vreg.x & 0xffffu); *(LAS bf16_t*)(d0_ + 1 * PS_PITCH) = (bf16_t)(vreg.x >> 16); \
        *(LAS bf16_t*)(d0_ + 2 * PS_PITCH) = (bf16_t)(vreg.y & 0xffffu); *(LAS bf16_t*)(d0_ + 3 * PS_PITCH) = (bf16_t)(vreg.y >> 16); \
        *(LAS bf16_t*)(d0_ + 4 * PS_PITCH) = (bf16_t)(vreg.z & 0xffffu); *(LAS bf16_t*)(d0_ + 5 * PS_PITCH) = (bf16_t)(vreg.z >> 16); \
        *(LAS bf16_t*)(d0_ + 6 * PS_PITCH) = (bf16_t)(vreg.w & 0xffffu); *(LAS bf16_t*)(d0_ + 7 * PS_PITCH) = (bf16_t)(vreg.w >> 16); } while (0)
    if (!DEN) { vreg = *(const GAS u32x4*)Vg0; V_STAGE(0); }
    __builtin_amdgcn_sched_barrier(0);
#pragma unroll
    for (int ks = 0; ks < 4; ++ks)
#pragma unroll
        for (int dt = 0; dt < 2; ++dt) aK[dt][ks] = *(const GAS bf16x8*)(Kg0 + (dt * 4 + ks) * 1024);
    __builtin_amdgcn_sched_barrier(0);
#pragma unroll
    for (int ks = 0; ks < 4; ++ks) bS[ks] = *(const GAS bf16x8*)(Sg0 + ks * 1024);
    __builtin_amdgcn_sched_barrier(0);
#pragma unroll
    for (int ks = 0; ks < 8; ++ks) bQ[ks] = *(const GAS bf16x8*)(Qg0 + ks * 1024);
    __builtin_amdgcn_sched_barrier(0);
    if (!DEN) vreg = *(const GAS u32x4*)(Vg0 + (size_t)128 * 2048);
    __builtin_amdgcn_sched_barrier(0);
    const GAS unsigned char* pfp; unsigned pfstride;
    { const int tt = (wave * 64 + lane) < 160 ? wave * 64 + lane : 159; const int idx = sl * 10 + (tt >> 4), off = (tt & 15) * 64;
      pfp = (idx < 32 ? ws + WS_S + (size_t)(p * 64) * 32768 + idx * 1024 : idx < 96 ? ws + WS_QT + (size_t)(p * 64) * 65536 + (idx - 32) * 1024 : ws + WS_KWT + (size_t)(p * 64) * 65536 + (idx - 96) * 1024) + off;
      pfstride = idx < 32 ? 32768u : 65536u; }
    unsigned pfv = 0u;
#pragma unroll 1
    for (int c = 0; c < 64; ++c) {
        const int tl0 = bl * SEQ + c * 128; const size_t tg0 = (size_t)b * SEQ + c * 128;
        const int cn = c < 63 ? c + 1 : 63, cn2 = c < 62 ? c + 2 : 63;
        LAS unsigned char* vt_ = VT + (c & 1) * VTB; LAS unsigned char* ct_ = CT + (c & 1) * CTB; LAS unsigned char* ctn = CT + ((c + 1) & 1) * CTB;
        LDS_BAR();
        if (!DEN && wave < 3) { asm volatile("" :: "v"(pfv)); const int c3 = c < 60 ? c + 3 : 63; pfv = *(const GAS unsigned*)(pfp + (size_t)c3 * pfstride); }
        bf16x8 vf[NVT][4], cf[NVT][4];
#pragma unroll
        for (int vt = 0; vt < NVT; ++vt)
#pragma unroll
            for (int ks = 0; ks < 4; ++ks) vf[vt][ks] = lfrag(vt_, PS_PITCH, vt * 16 + fr, ks * 32, fq);
        const float dec = DEC[c];
        __builtin_amdgcn_sched_barrier(0);
#pragma unroll
        for (int dt = 0; dt < 2; ++dt)
#pragma unroll
            for (int vt = 0; vt < NVT; ++vt) st[dt][vt] = st[dt][vt] * dec;
#pragma unroll
        for (int ks = 0; ks < 4; ++ks) {
#pragma unroll
            for (int vt = 0; vt < NVT; ++vt) cf[vt][ks] = lfrag(ct_, PQ_PITCH, vt * 16 + fr, ks * 32, fq);
#pragma unroll
            for (int dt = 0; dt < 2; ++dt) {
#pragma unroll
                for (int vt = 0; vt < NVT; ++vt) st[dt][vt] = MFMA16(aK[dt][ks], vf[vt][ks], st[dt][vt]);
                aK[dt][ks] = *(const GAS bf16x8*)(Kg0 + (size_t)cn * 65536 + (dt * 4 + ks) * 1024);
            }
            __builtin_amdgcn_sched_barrier(0);
        }
#pragma unroll
        for (int dt = 0; dt < 2; ++dt)
#pragma unroll
            for (int vt = 0; vt < NVT; ++vt) { u32x2 o; o.x = pk2(st[dt][vt][0], st[dt][vt][1]); o.y = pk2(st[dt][vt][2], st[dt][vt][3]);
                *(LAS u32x2*)(ctn + (vt * 16 + fr) * PQ_PITCH + (wave * 32 + dt * 16 + 4 * fq) * 2) = o; }
        __builtin_amdgcn_sched_barrier(0);
        f32x4 acc[NVT];
#pragma unroll
        for (int vt = 0; vt < NVT; ++vt) acc[vt] = (f32x4){0.f, 0.f, 0.f, 0.f};
#pragma unroll
        for (int ks = 0; ks < 4; ++ks) {
#pragma unroll
            for (int vt = 0; vt < NVT; ++vt) acc[vt] = MFMA16(vf[vt][ks], bS[ks], acc[vt]);
            bS[ks] = *(const GAS bf16x8*)(Sg0 + (size_t)cn * 32768 + ks * 1024);
            __builtin_amdgcn_sched_barrier(0);
        }
#pragma unroll
        for (int ks = 0; ks < 8; ++ks) {
#pragma unroll
            for (int vt = 0; vt < NVT; ++vt) acc[vt] = MFMA16(cf[vt][ks & 3], bQ[ks], acc[vt]);
            if (ks < 4) {
#pragma unroll
                for (int vt = 0; vt < NVT; ++vt) cf[vt][ks] = lfrag(ct_, PQ_PITCH, vt * 16 + fr, 128 + ks * 32, fq);
            }
            bQ[ks] = *(const GAS bf16x8*)(Qg0 + (size_t)cn * 65536 + ks * 1024);
            __builtin_amdgcn_sched_barrier(0);
        }
        const int t = wave * 16 + fr;
        if (!DEN) {
            GAS bf16_t* hn = (GAS bf16_t*)(ws + WS_QKPRE) + (size_t)(tl0 + t) * 2048 + vcol + 4 * fq;
#pragma unroll
            for (int vt = 0; vt < NVT; ++vt) { u32x2 o; o.x = pk2(acc[vt][0], acc[vt][1]); o.y = pk2(acc[vt][2], acc[vt][3]); *(GAS u32x2*)(hn + vt * 16) = o; }
            V_STAGE(c + 1); vreg = *(const GAS u32x4*)(Vg0 + (size_t)cn2 * 128 * 2048);
        } else {
            if (fq == 0) ((GAS float*)(ws + WS_DEN))[(tg0 + t) * 4 + h] = acc[0][0];
        }
    }
    asm volatile("" :: "v"(pfv));
    __syncthreads();
#undef V_STAGE
}

constexpr int HG_PD = 4;
__device__ __forceinline__ void hgrn_scan(const DArgs& a, LAS unsigned char* lds, int round, int p, int sl) {
    const int tid = tid_(), lane = tid & 63, wave = __builtin_amdgcn_readfirstlane(tid >> 6), fr = lane & 15, fq = lane >> 4;
    const int bl = p >> 3, h = p & 7;
    GAS unsigned char* ws = a.ws;
    constexpr int IP = 144, ITB = 32 * IP, STB = 32 * PS_PITCH;
    LAS unsigned char* IT = lds; LAS unsigned char* ST = lds + 2 * ITB;
    for (int i = tid; i < (2 * ITB + 2 * STB) / 4; i += NTHR) ((LAS unsigned*)lds)[i] = 0u;
    __syncthreads();
    f32x4 st[2][2];
#pragma unroll
    for (int i = 0; i < 2; ++i) { st[i][0] = (f32x4){0.f, 0.f, 0.f, 0.f}; st[i][1] = st[i][0]; }
    const int vcol = h * 128 + sl * 32;
    const int is = (tid & 255) >> 2, ipart = tid & 3;
    const bool outw = wave < 4;
    const int w4 = wave & 3;
    const GAS unsigned char* Ag0 = ws + WS_ATT + (size_t)(p * 128) * 8192 + w4 * 2048 + lane * 16;
    const GAS unsigned char* Qg0 = ws + WS_QTG + (size_t)(p * 128) * 16384 + w4 * 4096 + lane * 16;
    const GAS unsigned char* Kg0 = ws + WS_KENDT + (size_t)(p * 128) * 16384 + w4 * 4096 + lane * 16;
    const GAS unsigned char* Dg0 = ws + WS_HGDEC + ((size_t)(p * 128) * 128 + w4 * 32 + 4 * fq) * 4;
    const GAS unsigned char* Ig0 = ws + WS_GI + ((size_t)(bl * SEQ + is) * 1024 + vcol + ipart * 8) * 2;
    const GAS unsigned char* gb0 = outw ? Ag0 : Kg0;          const unsigned gs0 = outw ? 8192u : 16384u;
    const GAS unsigned char* gb1 = outw ? Qg0 : Kg0 + 2048;   const unsigned gs1 = 16384u;
    const GAS unsigned char* gb2 = outw ? Qg0 + 2048 : Dg0;   const unsigned gs2 = outw ? 16384u : 512u, gt2 = outw ? 1024u : 64u;
    const GAS unsigned char* gb3 = outw ? Ig0 : Dg0;          const unsigned gs3 = outw ? 131072u : 512u;
    u32x4 pf[HG_PD][7];
#define HG_LD01(k_, cc_) do { _Pragma("unroll") for (int j_ = 0; j_ < 2; ++j_) pf[k_][j_] = *(const GAS u32x4*)(gb0 + (size_t)(cc_) * gs0 + j_ * 1024); } while (0)
#define HG_LD23(k_, cc_) do { _Pragma("unroll") for (int j_ = 0; j_ < 2; ++j_) pf[k_][2 + j_] = *(const GAS u32x4*)(gb1 + (size_t)(cc_) * gs1 + j_ * 1024); } while (0)
#define HG_LD45(k_, cc_) do { _Pragma("unroll") for (int j_ = 0; j_ < 2; ++j_) pf[k_][4 + j_] = *(const GAS u32x4*)(gb2 + (size_t)(cc_) * gs2 + j_ * gt2); } while (0)
#define HG_LD6(k_, cc_) do { pf[k_][6] = *(const GAS u32x4*)(gb3 + (size_t)(cc_) * gs3); } while (0)
#pragma unroll
    for (int k = 0; k < HG_PD; ++k) { HG_LD01(k, k); HG_LD23(k, k); HG_LD45(k, k); __builtin_amdgcn_sched_barrier(0); HG_LD6((k + 1) % HG_PD, (k + 1 < HG_PD ? k + 1 : HG_PD)); __builtin_amdgcn_sched_barrier(0); }
    const GAS unsigned char* pfp; unsigned pfstride;
    { const int tt = (wave * 64 + lane) < 160 ? wave * 64 + lane : 159; const int idx = sl * 10 + (tt >> 4), off = (tt & 15) * 64;
      pfp = (idx < 8 ? ws + WS_ATT + (size_t)(p * 128) * 8192 + idx * 1024 : idx < 24 ? ws + WS_QTG + (size_t)(p * 128) * 16384 + (idx - 8) * 1024 : ws + WS_KENDT + (size_t)(p * 128) * 16384 + (idx - 24) * 1024) + off;
      pfstride = idx < 8 ? 8192u : 16384u; }
    unsigned pfv[HG_PD];
#pragma unroll
    for (int k = 0; k < HG_PD; ++k) pfv[k] = 0u;
#define HG_STAGE(dst_, iv_) do { LAS unsigned char* d0_ = (dst_) + (ipart * 8) * IP + is * 2; \
        *(LAS bf16_t*)(d0_ + 0 * IP) = (bf16_t)((iv_).x & 0xffffu); *(LAS bf16_t*)(d0_ + 1 * IP) = (bf16_t)((iv_).x >> 16); \
        *(LAS bf16_t*)(d0_ + 2 * IP) = (bf16_t)((iv_).y & 0xffffu); *(LAS bf16_t*)(d0_ + 3 * IP) = (bf16_t)((iv_).y >> 16); \
        *(LAS bf16_t*)(d0_ + 4 * IP) = (bf16_t)((iv_).z & 0xffffu); *(LAS bf16_t*)(d0_ + 5 * IP) = (bf16_t)((iv_).z >> 16); \
        *(LAS bf16_t*)(d0_ + 6 * IP) = (bf16_t)((iv_).w & 0xffffu); *(LAS bf16_t*)(d0_ + 7 * IP) = (bf16_t)((iv_).w >> 16); } while (0)
    if (outw) { const u32x4 iv = *(const GAS u32x4*)Ig0; HG_STAGE(IT, iv); }
#pragma unroll 1
    for (int c0 = 0; c0 < 128; c0 += HG_PD) {
#pragma unroll
      for (int k = 0; k < HG_PD; ++k) {
        const int c = c0 + k;
        const int tl0 = bl * SEQ + c * 64;
        const int cn = (c + HG_PD < 128) ? c + HG_PD : 127;
        LAS unsigned char* it_ = IT + (k & 1) * ITB; LAS unsigned char* itn = IT + ((k + 1) & 1) * ITB; LAS unsigned char* st_ = ST + (k & 1) * STB; LAS unsigned char* stn = ST + ((k + 1) & 1) * STB;
        LDS_BAR();
        if (wave < 3) { asm volatile("" :: "v"(pfv[k])); const int c7 = (c + HG_PD + 3 < 128) ? c + HG_PD + 3 : 127; pfv[k] = *(const GAS unsigned*)(pfp + (size_t)c7 * pfstride); }
        bf16x8 itf[2][2];
#pragma unroll
        for (int vt = 0; vt < 2; ++vt)
#pragma unroll
            for (int ks = 0; ks < 2; ++ks) itf[vt][ks] = lfrag(it_, IP, vt * 16 + fr, ks * 32, fq);
        bf16x8 sf[2][4];
        f32x4 acc[2];
        acc[0] = (f32x4){0.f, 0.f, 0.f, 0.f}; acc[1] = acc[0];
        if (outw) {
#pragma unroll
            for (int vt = 0; vt < 2; ++vt)
#pragma unroll
                for (int ks = 0; ks < 4; ++ks) sf[vt][ks] = lfrag(st_, PS_PITCH, vt * 16 + fr, ks * 32, fq);
#pragma unroll
            for (int ks = 0; ks < 2; ++ks)
#pragma unroll
                for (int vt = 0; vt < 2; ++vt) acc[vt] = MFMA16(itf[vt][ks], __builtin_bit_cast(bf16x8, pf[k][ks]), acc[vt]);
        } else {
            const f32x4 dec = __builtin_bit_cast(f32x4, pf[k][4]);
#pragma unroll
            for (int vt = 0; vt < 2; ++vt) { st[0][vt] = st[0][vt] * dec;
#pragma unroll
                for (int ks = 0; ks < 2; ++ks) st[0][vt] = MFMA16(__builtin_bit_cast(bf16x8, pf[k][ks]), itf[vt][ks], st[0][vt]); }
        }
        __builtin_amdgcn_sched_barrier(0);
        HG_LD01(k, cn);
        __builtin_amdgcn_sched_barrier(0);
        if (outw) {
#pragma unroll
            for (int ks = 0; ks < 2; ++ks)
#pragma unroll
                for (int vt = 0; vt < 2; ++vt) acc[vt] = MFMA16(sf[vt][ks], __builtin_bit_cast(bf16x8, pf[k][2 + ks]), acc[vt]);
        } else {
            const f32x4 dec = __builtin_bit_cast(f32x4, pf[k][5]);
#pragma unroll
            for (int vt = 0; vt < 2; ++vt) { st[1][vt] = st[1][vt] * dec;
#pragma unroll
                for (int ks = 0; ks < 2; ++ks) st[1][vt] = MFMA16(__builtin_bit_cast(bf16x8, pf[k][2 + ks]), itf[vt][ks], st[1][vt]); }
        }
        __builtin_amdgcn_sched_barrier(0);
        HG_LD23(k, cn);
        __builtin_amdgcn_sched_barrier(0);
        if (outw) {
#pragma unroll
            for (int ks = 2; ks < 4; ++ks)
#pragma unroll
                for (int vt = 0; vt < 2; ++vt) acc[vt] = MFMA16(sf[vt][ks], __builtin_bit_cast(bf16x8, pf[k][2 + ks]), acc[vt]);
        } else {
#pragma unroll
            for (int dtile = 0; dtile < 2; ++dtile)
#pragma unroll
                for (int vt = 0; vt < 2; ++vt) { u32x2 o; o.x = pk2(st[dtile][vt][0], st[dtile][vt][1]); o.y = pk2(st[dtile][vt][2], st[dtile][vt][3]);
                    *(LAS u32x2*)(stn + (vt * 16 + fr) * PS_PITCH + (w4 * 32 + dtile * 16 + 4 * fq) * 2) = o; }
        }
        __builtin_amdgcn_sched_barrier(0);
        HG_LD45(k, cn);
        __builtin_amdgcn_sched_barrier(0);
        if (outw) {
            HG_STAGE(itn, pf[(k + 1) % HG_PD][6]);
            GAS bf16_t* og = (GAS bf16_t*)(ws + WS_GQ) + (size_t)(tl0 + w4 * 16 + fr) * 1024 + vcol + 4 * fq;
#pragma unroll
            for (int vt = 0; vt < 2; ++vt) { u32x2 o; o.x = pk2(acc[vt][0], acc[vt][1]); o.y = pk2(acc[vt][2], acc[vt][3]); *(GAS u32x2*)(og + vt * 16) = o; }
        }
        __builtin_amdgcn_sched_barrier(0);
        { const int cni = (c + 1 + HG_PD < 128) ? c + 1 + HG_PD : 127; HG_LD6((k + 1) % HG_PD, cni); }
        __builtin_amdgcn_sched_barrier(0);
      }
    }
#pragma unroll
    for (int k = 0; k < HG_PD; ++k) asm volatile("" :: "v"(pfv[k]));
    __syncthreads();
#undef HG_LD01
#undef HG_LD23
#undef HG_LD45
#undef HG_LD6
#undef HG_STAGE
}

__device__ __forceinline__ void xn8_convert(const DArgs& a, int round, int vcu, int G) {
    const int tid = tid_(), lane = tid & 63, wave = tid >> 6;
    const int gw = vcu * NWAVES + wave, NGW = G * NWAVES;
    GAS unsigned char* ws = a.ws;
    for (int tl = gw; tl < RT; tl += NGW) {
        const size_t tg = (size_t)round * RT + tl;
        const GAS u32x2* xr = (const GAS u32x2*)((const GAS bf16_t*)(ws + WS_XN) + tg * D) + lane;
        f32x4 v[4]; float mx = 0.f;
#pragma unroll
        for (int j = 0; j < 4; ++j) { const u32x2 xv = xr[64 * j]; v[j][0] = bf_lo(xv.x); v[j][1] = bf_hi(xv.x); v[j][2] = bf_lo(xv.y); v[j][3] = bf_hi(xv.y);
            mx = fmaxf(mx, fmaxf(fmaxf(fabsf(v[j][0]), fabsf(v[j][1])), fmaxf(fabsf(v[j][2]), fabsf(v[j][3])))); }
        mx = wave_max(mx);
        const float qs = mx > 0.f ? 127.0f / mx : 0.f;
#pragma unroll
        for (int j = 0; j < 4; ++j) ((GAS unsigned*)(ws + WS_XN8 + (size_t)tl * 1024))[64 * j + lane] = pack_i8x4(v[j][0] * qs, v[j][1] * qs, v[j][2] * qs, v[j][3] * qs);
        if (lane == 0) ((GAS float*)(ws + WS_SA8))[tg] = mx * (1.0f / 127.0f);
    }
}

__device__ __forceinline__ void phase_ypass(const DArgs& a, int round, int vcu, int G) {
    const int tid = tid_(), lane = tid & 63, wave = tid >> 6;
    const int gw = vcu * NWAVES + wave, NGW = G * NWAVES;
    GAS unsigned char* ws = a.ws;
    f32x4 mg0[4], mg1[4], gg4[4];
#pragma unroll
    for (int j = 0; j < 4; ++j) { mg0[j] = *(const GAS f32x4*)(a.m_head_g + j * 512 + lane * 8); mg1[j] = *(const GAS f32x4*)(a.m_head_g + j * 512 + lane * 8 + 4); gg4[j] = *(const GAS f32x4*)(a.g_head_g + lane * 16 + 4 * j); }
    for (int tl = gw; tl < RT; tl += NGW) {
        const size_t tg = (size_t)round * RT + tl;
        const f32x4 den4 = *(const f32x4*)((const float*)(ws + WS_DEN) + tg * 4), mt4 = *(const f32x4*)((const float*)(ws + WS_MT) + tg * 4);
        float ym[4][8];
#pragma unroll
        for (int j = 0; j < 4; ++j) {
            const int col = j * 512 + lane * 8;
            const u32x4 nv = *(const u32x4*)((const bf16_t*)(ws + WS_QKPRE) + (size_t)tl * 2048 + col);
            const u32x4 ov = *(const u32x4*)((const bf16_t*)(ws + WS_SIGO) + (size_t)tl * 2048 + col);
            const float inv = 1.0f / fmaxf(fabsf(den4[j]), __expf(-mt4[j]));
            float hv[8] = {bf_lo(nv.x) * inv, bf_hi(nv.x) * inv, bf_lo(nv.y) * inv, bf_hi(nv.y) * inv, bf_lo(nv.z) * inv, bf_hi(nv.z) * inv, bf_lo(nv.w) * inv, bf_hi(nv.w) * inv};
            float ss = 0.f;
#pragma unroll
            for (int e = 0; e < 8; ++e) ss += hv[e] * hv[e];
            const float r = rsqrtf(wave_sum(ss, lane) * (1.f / 512.f) + EPS);
            const f32x4 g0 = mg0[j], g1 = mg1[j];
            const float og[8] = {bf_lo(ov.x), bf_hi(ov.x), bf_lo(ov.y), bf_hi(ov.y), bf_lo(ov.z), bf_hi(ov.z), bf_lo(ov.w), bf_hi(ov.w)};
#pragma unroll
            for (int e = 0; e < 8; ++e) ym[j][e] = og[e] * hv[e] * r * (e < 4 ? g0[e] : g1[e - 4]);
        }
        {
            float mx = 0.f;
#pragma unroll
            for (int j = 0; j < 4; ++j)
#pragma unroll
                for (int e = 0; e < 8; ++e) mx = fmaxf(mx, fabsf(ym[j][e]));
            mx = wave_max(mx);
            const float qs = mx > 0.f ? 127.0f / mx : 0.f;
#pragma unroll
            for (int j = 0; j < 4; ++j) { u32x2 o; o.x = pack_i8x4(ym[j][0] * qs, ym[j][1] * qs, ym[j][2] * qs, ym[j][3] * qs); o.y = pack_i8x4(ym[j][4] * qs, ym[j][5] * qs, ym[j][6] * qs, ym[j][7] * qs);
                *(GAS u32x2*)(ws + WS_V + (size_t)tl * 2048 + j * 512 + lane * 8) = o; }
            if (lane == 0) ((GAS float*)(ws + WS_SYM))[tl] = mx * (1.0f / 127.0f);
        }
        {
            const int col = lane * 16;
            const u32x4 n0 = *(const u32x4*)((const bf16_t*)(ws + WS_GQ) + (size_t)tl * 1024 + col), n1 = *(const u32x4*)((const bf16_t*)(ws + WS_GQ) + (size_t)tl * 1024 + col + 8);
            const u32x4 s0 = *(const u32x4*)((const bf16_t*)(ws + WS_SGG) + (size_t)tl * 1024 + col), s1 = *(const u32x4*)((const bf16_t*)(ws + WS_SGG) + (size_t)tl * 1024 + col + 8);
            float ov[16] = {bf_lo(n0.x), bf_hi(n0.x), bf_lo(n0.y), bf_hi(n0.y), bf_lo(n0.z), bf_hi(n0.z), bf_lo(n0.w), bf_hi(n0.w), bf_lo(n1.x), bf_hi(n1.x), bf_lo(n1.y), bf_hi(n1.y), bf_lo(n1.z), bf_hi(n1.z), bf_lo(n1.w), bf_hi(n1.w)};
            const float sg[16] = {bf_lo(s0.x), bf_hi(s0.x), bf_lo(s0.y), bf_hi(s0.y), bf_lo(s0.z), bf_hi(s0.z), bf_lo(s0.w), bf_hi(s0.w), bf_lo(s1.x), bf_hi(s1.x), bf_lo(s1.y), bf_hi(s1.y), bf_lo(s1.z), bf_hi(s1.z), bf_lo(s1.w), bf_hi(s1.w)};
            float ss = 0.f;
#pragma unroll
            for (int e = 0; e < 16; ++e) ss += ov[e] * ov[e];
            ss += DPP_(ss, 0xB1); ss += DPP_(ss, 0x4E); ss += DPP_(ss, 0x141);
            const float r = rsqrtf(ss * (1.f / 128.f) + EPS);
            float y[16];
#pragma unroll
            for (int e = 0; e < 16; ++e) y[e] = ov[e] * r * gg4[e >> 2][e & 3] * sg[e];
            float mx = 0.f;
#pragma unroll
            for (int e = 0; e < 16; ++e) mx = fmaxf(mx, fabsf(y[e]));
            mx = wave_max(mx);
            const float qs = mx > 0.f ? 127.0f / mx : 0.f;
            u32x4 o; o.x = pack_i8x4(y[0] * qs, y[1] * qs, y[2] * qs, y[3] * qs); o.y = pack_i8x4(y[4] * qs, y[5] * qs, y[6] * qs, y[7] * qs);
            o.z = pack_i8x4(y[8] * qs, y[9] * qs, y[10] * qs, y[11] * qs); o.w = pack_i8x4(y[12] * qs, y[13] * qs, y[14] * qs, y[15] * qs);
            *(GAS u32x4*)(ws + WS_GI + (size_t)tl * 1024 + col) = o;
            if (lane == 0) ((GAS float*)(ws + WS_SYG))[tl] = mx * (1.0f / 127.0f);
        }
    }
}


#define XB_TMO      128
#define XB_XCNT(j)  (256  + 64 * (j))
#define XB_XSUB(j)  (1280 + 64 * (j))
#define XB_XGEN(j)  (2304 + 64 * (j))
#define XB_TOP      3328
#define XB_TOPGEN   3392
#define XB_SPIN_CAP (1u << 22)
constexpr int CW_BAR = 4096;
constexpr int LDS_BARST = LDS_BYTES - 64;
__device__ __forceinline__ unsigned xb_ld(unsigned* p)              { return __hip_atomic_load(p, __ATOMIC_RELAXED, __HIP_MEMORY_SCOPE_AGENT); }
__device__ __forceinline__ unsigned xb_add(unsigned* p, unsigned v) { return __hip_atomic_fetch_add(p, v, __ATOMIC_RELAXED, __HIP_MEMORY_SCOPE_AGENT); }
__device__ __forceinline__ unsigned xb_xcc_id() { return (unsigned)__builtin_amdgcn_s_getreg((3 << 11) | 20) & 0xFu; }
#define XB_SPIN(cond, bar) do { unsigned _sp = 0; while (cond) { __builtin_amdgcn_s_sleep(1); \
    if ((++_sp & 255u) == 0u) { if (xb_ld(&(bar)[XB_TMO])) break; if (_sp > XB_SPIN_CAP) { atomicAdd(&(bar)[XB_TMO], 1u); break; } } } } while (0)
__device__ __forceinline__ void xcd_barrier_post(unsigned* bar, volatile LAS unsigned* st) { if (tid_() == 0) st[2] = xb_add(&bar[XB_XCNT(xb_xcc_id())], 1u); }
__device__ __forceinline__ void xcd_barrier_complete(unsigned* bar, unsigned x, unsigned& nloc, unsigned& nx) {
    const unsigned G = gridDim.x;
    unsigned sum, cnt, mine, sp = 0u;
    for (;;) {
        sum = 0u; cnt = 0u; mine = 0u;
#pragma unroll
        for (unsigned j = 0; j < 16; ++j) { const unsigned c = xb_ld(&bar[XB_XCNT(j)]); sum += c; cnt += (c > 0u) ? 1u : 0u; mine = (j == x) ? c : mine; }
        if (sum == G) break;
        __builtin_amdgcn_s_sleep(1);
        if ((++sp & 255u) == 0u) { if (xb_ld(&bar[XB_TMO])) break; if (sp > XB_SPIN_CAP) { atomicAdd(&bar[XB_TMO], 1u); break; } }
    }
    nloc = mine > 0u ? mine : 1u; nx = cnt > 0u ? cnt : 1u;
}
__device__ __forceinline__ void xcd_barrier(unsigned* bar, volatile LAS unsigned* st) {
    asm volatile("s_waitcnt vmcnt(0)" ::: "memory");
    __syncthreads();
    if (tid_() == 0) {
        const unsigned x = xb_xcc_id();
        __builtin_amdgcn_s_waitcnt(0);
        unsigned nloc = st[0], nx = st[1];
        if (nloc == 0u) { xcd_barrier_complete(bar, x, nloc, nx); st[0] = nloc; st[1] = nx; }
        const unsigned old = xb_add(&bar[XB_XSUB(x)], 1u);
        const unsigned gen = old / nloc;
        if (old + 1u == (gen + 1u) * nloc) {
            __builtin_amdgcn_fence(__ATOMIC_RELEASE, "agent");
            asm volatile("s_waitcnt vmcnt(0)" ::: "memory");
            const unsigned og = xb_add(&bar[XB_TOP], 1u);
            const unsigned tg = og / nx;
            if (og + 1u == (tg + 1u) * nx) xb_add(&bar[XB_TOPGEN], 1u);
            else XB_SPIN(xb_ld(&bar[XB_TOPGEN]) == tg, bar);
            __builtin_amdgcn_fence(__ATOMIC_ACQUIRE, "agent");
            xb_add(&bar[XB_XGEN(x)], 1u);
            asm volatile("s_waitcnt vmcnt(0)" ::: "memory");
        } else {
            XB_SPIN(xb_ld(&bar[XB_XGEN(x)]) == gen, bar);
            __builtin_amdgcn_fence(__ATOMIC_ACQUIRE, "agent");
            asm volatile("s_waitcnt vmcnt(0)" ::: "memory");
        }
    }
    __syncthreads();
}

__device__ __forceinline__ void phase_p8(const DArgs& a, int vcu, int G) {
    const int tid = tid_(), lane = tid & 63, wave = tid >> 6;
    const int gw = vcu * NWAVES + wave, NGW = G * NWAVES;
    GAS unsigned char* ws = a.ws;
    f32x4 g2[4];
#pragma unroll
    for (int j = 0; j < 4; ++j) g2[j] = ((const f32x4*)a.norm2_g)[64 * j + lane];
    for (int m = gw; m < T; m += NGW) {
        const GAS u32x2* xr = (const GAS u32x2*)((const GAS bf16_t*)a.out + (size_t)m * D) + lane;
        f32x4 v[4]; float s = 0.f;
#pragma unroll
        for (int j = 0; j < 4; ++j) { const u32x2 xv = xr[64 * j]; v[j][0] = bf_lo(xv.x); v[j][1] = bf_hi(xv.x); v[j][2] = bf_lo(xv.y); v[j][3] = bf_hi(xv.y); s += (v[j][0] * v[j][0] + v[j][1] * v[j][1]) + (v[j][2] * v[j][2] + v[j][3] * v[j][3]); }
        const float rstd = rsqrtf(wave_sum(s, lane) * (1.f / D) + EPS);
#pragma unroll
        for (int j = 0; j < 4; ++j) v[j] = v[j] * rstd * g2[j];
        float mx = 0.f;
#pragma unroll
        for (int j = 0; j < 4; ++j) mx = fmaxf(mx, fmaxf(fmaxf(fabsf(v[j][0]), fabsf(v[j][1])), fmaxf(fabsf(v[j][2]), fabsf(v[j][3]))));
        mx = wave_max(mx);
        const float qs = mx > 0.f ? 127.0f / mx : 0.f;
#pragma unroll
        for (int j = 0; j < 4; ++j) ((GAS unsigned*)(ws + WS_XQ + (size_t)m * 1024))[64 * j + lane] = pack_i8x4(v[j][0] * qs, v[j][1] * qs, v[j][2] * qs, v[j][3] * qs);
        if (lane == 0) ((GAS float*)(ws + WS_XQS))[m] = mx * (1.0f / 127.0f);
    }
    for (int e = gw; e < 16384; e += NGW) {
        f32x4 uv[4], vv[4]; float mu = 0.f, mv = 0.f;
#pragma unroll
        for (int j = 0; j < 4; ++j) { uv[j] = ((const GAS f32x4*)(a.u_emb + (size_t)e * 1024))[64 * j + lane]; vv[j] = ((const GAS f32x4*)(a.v_emb + (size_t)e * 1024))[64 * j + lane];
            mu = fmaxf(mu, fmaxf(fmaxf(fabsf(uv[j][0]), fabsf(uv[j][1])), fmaxf(fabsf(uv[j][2]), fabsf(uv[j][3]))));
            mv = fmaxf(mv, fmaxf(fmaxf(fabsf(vv[j][0]), fabsf(vv[j][1])), fmaxf(fabsf(vv[j][2]), fabsf(vv[j][3])))); }
        mu = wave_max(mu); mv = wave_max(mv);
        const float su = mu > 0.f ? 127.0f / mu : 0.f, sv = mv > 0.f ? 448.0f / mv : 0.f;
        if (lane == 0) { ((GAS float*)(ws + WS_USC))[e] = mu * (1.0f / 127.0f); ((GAS float*)(ws + WS_VSC))[e] = mv * (1.0f / 448.0f); }
#pragma unroll
        for (int j = 0; j < 4; ++j) {
            const size_t ob = (size_t)(2 * j + (lane >> 5)) * 2097152 + (size_t)e * 128 + ((4 * lane) & 127);
            *(GAS unsigned*)(ws + WS_UB + ob) = pack_i8x4(uv[j][0] * su, uv[j][1] * su, uv[j][2] * su, uv[j][3] * su);
            int p = __builtin_amdgcn_cvt_pk_fp8_f32(vv[j][0] * sv, vv[j][1] * sv, 0, false); p = __builtin_amdgcn_cvt_pk_fp8_f32(vv[j][2] * sv, vv[j][3] * sv, p, true);
            *(GAS unsigned*)(ws + WS_VB + ob) = (unsigned)p; }
    }
}

__device__ __forceinline__ unsigned f2ord(float f) { const unsigned u = __builtin_bit_cast(unsigned, f); return (u & 0x80000000u) ? ~u : (u | 0x80000000u); }
__device__ __forceinline__ float ord2f(unsigned k) { const unsigned u = (k & 0x80000000u) ? (k & 0x7fffffffu) : ~k; return __builtin_bit_cast(float, u); }
__device__ __forceinline__ unsigned umax_(unsigned a, unsigned b) { return a > b ? a : b; }
__device__ __forceinline__ unsigned shxu(unsigned v, int o, int lane) { return (unsigned)__builtin_amdgcn_ds_bpermute((lane ^ o) << 2, (int)v); }

__device__ __forceinline__ void phase_topk(const DArgs& a, LAS unsigned char* lds, int bx, int G) {
    const int tid = tid_(), lane = tid & 63, wave = __builtin_amdgcn_readfirstlane(tid >> 6), fr = lane & 15, fq = lane >> 4;
    GAS unsigned char* ws = a.ws;
    const int h = bx & 7;
    LAS unsigned char* KY = lds;
    LAS unsigned char* QL = lds + 2 * 128 * PS_PITCH;
    LAS unsigned* TOP = (LAS unsigned*)(lds + 2 * 128 * PS_PITCH + 64 * PQ_PITCH);
#pragma unroll
    for (int i = 0; i < 8; ++i) { const int idx = tid + 512 * i, row = idx >> 4, ch = idx & 15;
        *(LAS u32x4*)(KY + row * PS_PITCH + ch * 16) = *(const u32x4*)((const bf16_t*)(ws + WS_SK) + ((size_t)h * 256 + row) * 128 + ch * 8); }
    const int ntile = T / 64;
    u32x4 qpre[4];
    { const int tile0 = bx >> 3; if (tile0 < ntile) {
#pragma unroll
        for (int i = 0; i < 4; ++i) { const int idx = tid + 512 * i, row = idx >> 5, ch = idx & 31;
            qpre[i] = *(const GAS u32x4*)((const GAS bf16_t*)(ws + WS_QP) + ((size_t)tile0 * 64 + row) * 2048 + h * 256 + ch * 8); } } }
    __syncthreads();
    for (int tile = bx >> 3; tile < ntile; tile += (G >> 3)) {
        const size_t t0 = (size_t)tile * 64;
        LDS_BAR();
#pragma unroll
        for (int i = 0; i < 4; ++i) { const int idx = tid + 512 * i, row = idx >> 5, ch = idx & 31;
            *(LAS u32x4*)(QL + row * PQ_PITCH + ch * 16) = qpre[i]; }
        { const int tn = tile + (G >> 3); if (tn < ntile) {
#pragma unroll
            for (int i = 0; i < 4; ++i) { const int idx = tid + 512 * i, row = idx >> 5, ch = idx & 31;
                qpre[i] = *(const GAS u32x4*)((const GAS bf16_t*)(ws + WS_QP) + ((size_t)tn * 64 + row) * 2048 + h * 256 + ch * 8); } } }
        LDS_BAR();
        {
            const int mt = wave & 3, p = wave >> 2;
            unsigned key[32];
#pragma unroll
            for (int nt = 0; nt < 8; ++nt) { f32x4 acc = (f32x4){0.f, 0.f, 0.f, 0.f};
#pragma unroll
                for (int ks = 0; ks < 4; ++ks) acc = MFMA16(lfrag(KY + p * 128 * PS_PITCH, PS_PITCH, nt * 16 + fr, ks * 32, fq), lfrag(QL, PQ_PITCH, mt * 16 + fr, p * 128 + ks * 32, fq), acc);
#pragma unroll
                for (int j = 0; j < 4; ++j) { const int n = nt * 16 + 4 * fq + j; key[nt * 4 + j] = (f2ord(acc[j]) & ~127u) | (unsigned)(127 - n); } }
#pragma unroll 1
            for (int k = 0; k < 16; ++k) {
                unsigned t3[11];
#pragma unroll
                for (int e = 0; e < 10; ++e) t3[e] = umax_(umax_(key[3 * e], key[3 * e + 1]), key[3 * e + 2]);
                t3[10] = umax_(key[30], key[31]);
                const unsigned u0 = umax_(umax_(t3[0], t3[1]), t3[2]), u1 = umax_(umax_(t3[3], t3[4]), t3[5]), u2 = umax_(umax_(t3[6], t3[7]), t3[8]), u3 = umax_(t3[9], t3[10]);
                unsigned m = umax_(umax_(u0, u1), umax_(u2, u3));
                m = umax_(m, (unsigned)SWZI_(m, 0x401F)); m = umax_(m, xor32u_(m, lane >= 32));
#pragma unroll
                for (int e = 0; e < 32; ++e) key[e] = (key[e] == m) ? 0u : key[e];
                if (fq == (k & 3)) TOP[(p * 64 + mt * 16 + fr) * 16 + k] = m;
            }
        }
        LDS_BAR();
        {
            const int t = tid >> 3, sub = tid & 7;
            unsigned ck[7];
#pragma unroll
            for (int e = 0; e < 7; ++e) {
                const int ci = sub + 8 * e;
                int i = 0, base = 0; bool ok = ci < 50;
                if (ci >= 42) { i = 8 + (ci - 42); base = ci; } else if (ci >= 40) { i = 7; base = 40; } else if (ci >= 38) { i = 6; base = 38; } else if (ci >= 36) { i = 5; base = 36; }
                else if (ci >= 33) { i = 4; base = 33; } else if (ci >= 29) { i = 3; base = 29; } else if (ci >= 24) { i = 2; base = 24; } else if (ci >= 16) { i = 1; base = 16; }
                const int j = ci - base;
                unsigned kk = 0u;
                if (ok) { const float s0 = ord2f(TOP[(0 * 64 + t) * 16 + i] & ~127u), s1 = ord2f(TOP[(1 * 64 + t) * 16 + j] & ~127u);
                    kk = (f2ord(s0 + s1) & ~255u) | (unsigned)(255 - (i * 16 + j)); }
                ck[e] = kk;
            }
            unsigned w0 = 0u, w1 = 0u;
#pragma unroll 1
            for (int k = 0; k < 16; ++k) {
                unsigned m = umax_(umax_(umax_(ck[0], ck[1]), ck[2]), umax_(umax_(umax_(ck[3], ck[4]), ck[5]), ck[6]));
                m = umax_(m, (unsigned)DPPI_(m, 0xB1)); m = umax_(m, (unsigned)DPPI_(m, 0x4E)); m = umax_(m, (unsigned)DPPI_(m, 0x141));
#pragma unroll
                for (int e = 0; e < 7; ++e) ck[e] = (ck[e] == m) ? 0u : ck[e];
                if (k == sub) w0 = m; if (k == sub + 8) w1 = m;
            }
            const int f0 = 255 - (int)(w0 & 255u), f1 = 255 - (int)(w1 & 255u);
            const float sc0 = ord2f(w0 & ~255u), sc1 = ord2f(w1 & ~255u);
            float mx = fmaxf(sc0, sc1); mx = fmaxf(mx, DPP_(mx, 0xB1)); mx = fmaxf(mx, DPP_(mx, 0x4E)); mx = fmaxf(mx, DPP_(mx, 0x141));
            const float e0 = __expf(sc0 - mx), e1 = __expf(sc1 - mx);
            float sm = e0 + e1; sm += DPP_(sm, 0xB1); sm += DPP_(sm, 0x4E); sm += DPP_(sm, 0x141);
            const float inv = 1.0f / sm;
            const int i0 = 127 - (int)(TOP[(0 * 64 + t) * 16 + (f0 >> 4)] & 127u), j0 = 127 - (int)(TOP[(1 * 64 + t) * 16 + (f0 & 15)] & 127u);
            const int i1 = 127 - (int)(TOP[(0 * 64 + t) * 16 + (f1 >> 4)] & 127u), j1 = 127 - (int)(TOP[(1 * 64 + t) * 16 + (f1 & 15)] & 127u);
            unsigned short* ei = (unsigned short*)(ws + WS_EIDX) + ((t0 + t) * 8 + h) * 16; float* gp = (float*)(ws + WS_GATE) + ((t0 + t) * 8 + h) * 16;
            ei[sub] = (unsigned short)(i0 * 128 + j0); ei[sub + 8] = (unsigned short)(i1 * 128 + j1); gp[sub] = e0 * inv; gp[sub + 8] = e1 * inv;
        }
    }
    __syncthreads();
}

__device__ __forceinline__ void ins16(float (&v)[16], int (&id)[16], float x, int n) {
    if (x > v[15]) { v[15] = x; id[15] = n;
#pragma unroll
        for (int i = 15; i >= 1; --i) { if (v[i] > v[i - 1]) { const float tv = v[i]; v[i] = v[i - 1]; v[i - 1] = tv; const int ti = id[i]; id[i] = id[i - 1]; id[i - 1] = ti; } } }
}
__device__ __forceinline__ void phase_topk_ref(const DArgs& a, int vcu, int G) {
    const int tid = tid_();
    GAS unsigned char* ws = a.ws;
    const int gt = vcu * NTHR + tid, NGT = G * NTHR;
    for (int pair = gt; pair < T * 8; pair += NGT) {
        const int t = pair >> 3, h = pair & 7;
        float sv[2][16]; int si[2][16];
#pragma unroll
        for (int p = 0; p < 2; ++p) {
#pragma unroll
            for (int i = 0; i < 16; ++i) { sv[p][i] = -INFINITY; si[p][i] = 0; }
            const bf16_t* qp = (const bf16_t*)(ws + WS_QP) + (size_t)t * 2048 + h * 256 + p * 128;
            for (int n = 0; n < 128; ++n) {
                const bf16_t* kp = (const bf16_t*)(ws + WS_SK) + ((size_t)(h * 2 + p) * 128 + n) * 128;
                float s = 0.f;
                for (int c = 0; c < 128; c += 8) { const u32x4 qv = *(const u32x4*)(qp + c), kv = *(const u32x4*)(kp + c);
                    s += bf_lo(qv.x) * bf_lo(kv.x) + bf_hi(qv.x) * bf_hi(kv.x) + bf_lo(qv.y) * bf_lo(kv.y) + bf_hi(qv.y) * bf_hi(kv.y)
                       + bf_lo(qv.z) * bf_lo(kv.z) + bf_hi(qv.z) * bf_hi(kv.z) + bf_lo(qv.w) * bf_lo(kv.w) + bf_hi(qv.w) * bf_hi(kv.w); }
                ins16(sv[p], si[p], s, n);
            }
        }
        float tv[16]; int ti[16];
#pragma unroll
        for (int i = 0; i < 16; ++i) { tv[i] = -INFINITY; ti[i] = 0; }
#pragma unroll
        for (int i = 0; i < 16; ++i)
#pragma unroll
            for (int j = 0; j < 16; ++j) ins16(tv, ti, sv[0][i] + sv[1][j], i * 16 + j);
        float sm = 0.f, ex[16];
#pragma unroll
        for (int k = 0; k < 16; ++k) { ex[k] = __expf(tv[k] - tv[0]); sm += ex[k]; }
        int* ei = (int*)(ws + WS_EIDX) + (size_t)pair * 16; float* gp = (float*)(ws + WS_GATE) + (size_t)pair * 16;
#pragma unroll
        for (int k = 0; k < 16; ++k) {
            int e0 = 0, e1 = 0;
#pragma unroll
            for (int i = 0; i < 16; ++i) { e0 = ((ti[k] >> 4) == i) ? si[0][i] : e0; e1 = ((ti[k] & 15) == i) ? si[1][i] : e1; }
            ei[k] = e0 * 128 + e1; gp[k] = ex[k] / sm; }
    }
}

#define FP8LO(w) __builtin_amdgcn_cvt_pk_f32_fp8((int)(w), false)
#define FP8HI(w) __builtin_amdgcn_cvt_pk_f32_fp8((int)(w), true)
__device__ __forceinline__ float dot16_fp8(const u32x4 r, const float (&x)[16]) {
    float c = 0.f;
#pragma unroll
    for (int j = 0; j < 4; ++j) { const f32x2 lo = FP8LO(r[j]), hi = FP8HI(r[j]); c += lo[0] * x[4 * j] + lo[1] * x[4 * j + 1] + hi[0] * x[4 * j + 2] + hi[1] * x[4 * j + 3]; }
    return c;
}
__device__ __forceinline__ float dot16_fp8p(const u32x4 r, const f32x2 (&xp)[8]) {
    f32x2 c2 = (f32x2){0.f, 0.f};
#pragma unroll
    for (int j = 0; j < 4; ++j) { c2 += FP8LO(r[j]) * xp[2 * j]; c2 += FP8HI(r[j]) * xp[2 * j + 1]; }
    return c2[0] + c2[1];
}
__device__ __forceinline__ float gelu_erf(float d) {
    const float ad = fabsf(d), t = __builtin_amdgcn_rcpf(ad * 0.2316418882f + 1.0f);
    float q = t * 0.5307027145f + (-0.7265760135f); q = q * t + 0.7107068705f; q = q * t + (-0.142248368f); q = q * t + 0.127414796f; q = q * t;
    const float m = d * (q * __builtin_amdgcn_exp2f(d * d * (-0.72134752044f)));
    return d < 0.f ? m : d - m;
}
__device__ __forceinline__ float bperm(float v, int srclane) { return __builtin_bit_cast(float, __builtin_amdgcn_ds_bpermute(srclane << 2, __builtin_bit_cast(int, v))); }
#define SWZ_(v, pat) __builtin_bit_cast(float, __builtin_amdgcn_ds_swizzle(__builtin_bit_cast(int, (v)), (pat)))
__device__ __forceinline__ float rs32_(float a, float b) {
#if defined(__HIP_DEVICE_COMPILE__)
    asm volatile("s_nop 1\n\tv_permlane32_swap_b32 %0, %1" : "+v"(a), "+v"(b));
#endif
    return a + b;
}
__device__ __forceinline__ float rs16_(float a, float b) {
#if defined(__HIP_DEVICE_COMPILE__)
    asm volatile("s_nop 1\n\tv_permlane16_swap_b32 %0, %1" : "+v"(a), "+v"(b));
#endif
    return a + b;
}
__device__ __forceinline__ float rs8_(float a, float b, bool bit3) {
    const float send = bit3 ? a : b, keep = bit3 ? b : a;
    return keep + DPP_(send, 0x128);
}
__device__ __forceinline__ float xor32_(float v, bool hi) {
#if defined(__HIP_DEVICE_COMPILE__)
    const auto r = __builtin_amdgcn_permlane32_swap(__builtin_bit_cast(unsigned, v), __builtin_bit_cast(unsigned, v), false, false);
    return __builtin_bit_cast(float, hi ? r[0] : r[1]);
#else
    (void)hi; return v;
#endif
}
__device__ __forceinline__ float reduce8(const float (&p)[8], int lane) {
    float q4[4], q2[2];
    const bool b5 = lane & 32, b4 = lane & 16, b3 = lane & 8;
#pragma unroll
    for (int i = 0; i < 4; ++i) { const float send = b5 ? p[i] : p[i + 4], keep = b5 ? p[i + 4] : p[i]; q4[i] = keep + xor32_(send, b5); }
#pragma unroll
    for (int i = 0; i < 2; ++i) { const float send = b4 ? q4[i] : q4[i + 2], keep = b4 ? q4[i + 2] : q4[i]; q2[i] = keep + SWZ_(send, 0x401F); }
    const float send = b3 ? q2[0] : q2[1], keep = b3 ? q2[1] : q2[0];
    float q1 = keep + SWZ_(send, 0x201F);
    q1 += DPP_(q1, 0xB1); q1 += DPP_(q1, 0x4E); q1 += DPP_(q1, 0x141);
    return q1;
}
__device__ __forceinline__ void phase_udots(const DArgs& a, LAS unsigned char* lds) {
    const int tid = tid_(), lane = tid & 63, wave = __builtin_amdgcn_readfirstlane(tid >> 6);
    GAS unsigned char* ws = a.ws;
    volatile LAS unsigned* bst = (volatile LAS unsigned*)(lds + LDS_BARST);
    const int nloc = (int)bst[0], nx = (int)bst[1], rank = (int)bst[2];
    unsigned* bar = (unsigned*)(ws + WS_CTL) + CW_BAR;
    const unsigned myx = xb_xcc_id();
    int q = 0;
    for (unsigned j = 0; j < 16; ++j) { const unsigned c = xb_ld(&bar[XB_XCNT(j)]); if (c > 0u && j < myx) ++q; }
    LAS int* LE = (LAS int*)(lds + wave * 2048);
    LAS int* LP = LE + 128; LAS float* LG = (LAS float*)(LE + 256);
    const GAS unsigned char* UB = ws + WS_UB;
    const int g8 = lane >> 3;
    const float usc = ((const GAS float*)(ws + WS_USC))[0], vsc = ((const GAS float*)(ws + WS_USC))[1];
    for (int s = q; s < 8; s += nx) {
        int tok = rank * 8 + wave;
        u32x4 xq0 = (u32x4){0u, 0u, 0u, 0u}, xq1 = xq0; u32x2 e2 = (u32x2){0u, 0u}; f32x2 g2 = (f32x2){0.f, 0.f};
#define U_INFO(t_) do { xq0 = *(const u32x4*)((const GAS bf16_t*)(ws + WS_XN) + (size_t)(t_) * D + lane * 16); xq1 = *(const u32x4*)((const GAS bf16_t*)(ws + WS_XN) + (size_t)(t_) * D + lane * 16 + 8); \
        e2 = *(const u32x2*)((const GAS int*)(ws + WS_EIDX) + (size_t)(t_) * 128 + 2 * lane); g2 = *(const f32x2*)((const GAS float*)(ws + WS_GATE) + (size_t)(t_) * 128 + 2 * lane); } while (0)
        if (tok < T) U_INFO(tok);
        for (; tok < T; tok += nloc * 8) {
            const bool in0 = (int)(e2.x >> 11) == s, in1 = (int)(e2.y >> 11) == s;
            const unsigned long long m0 = __ballot(in0), m1 = __ballot(in1);
            const unsigned long long lt = (1ull << lane) - 1ull;
            const int n0 = __popcll(m0), n = n0 + __popcll(m1);
            if (in0) { const int pos = __popcll(m0 & lt); LE[pos] = (int)e2.x; LP[pos] = 2 * lane; LG[pos] = g2[0]; }
            if (in1) { const int pos = n0 + __popcll(m1 & lt); LE[pos] = (int)e2.y; LP[pos] = 2 * lane + 1; LG[pos] = g2[1]; }
            const float xf[16] = {bf_lo(xq0.x), bf_hi(xq0.x), bf_lo(xq0.y), bf_hi(xq0.y), bf_lo(xq0.z), bf_hi(xq0.z), bf_lo(xq0.w), bf_hi(xq0.w),
                                  bf_lo(xq1.x), bf_hi(xq1.x), bf_lo(xq1.y), bf_hi(xq1.y), bf_lo(xq1.z), bf_hi(xq1.z), bf_lo(xq1.w), bf_hi(xq1.w)};
            asm volatile("s_waitcnt lgkmcnt(0)" ::: "memory");
            u32x4 R0[8], R1[8], R2[8];
#define U_ISSUE(R_, g0_) do { _Pragma("unroll") for (int k = 0; k < 8; ++k) { const int slot_ = ((g0_) + k < n) ? (g0_) + k : n - 1; const int e_ = LE[slot_]; R_[k] = *(const u32x4*)(UB + (size_t)e_ * 1024 + lane * 16); } } while (0)
#define U_DOTS(R_, g0_) do { float pp_[8]; _Pragma("unroll") for (int k = 0; k < 8; ++k) pp_[k] = dot16_fp8(R_[k], xf); const float dsum_ = reduce8(pp_, lane); const int slot_ = (g0_) + g8; \
            if (slot_ < n && (lane & 7) == 0) { const float d_ = dsum_ * usc; \
                ((GAS float*)(ws + WS_PW))[(size_t)tok * 128 + LP[slot_]] = 0.5f * d_ * (1.0f + erff(d_ * 0.70710678118654752f)) * LG[slot_] * vsc; } } while (0)
            if (n > 0) U_ISSUE(R0, 0);
            if (n > 8) U_ISSUE(R1, 8);
            if (n > 16) U_ISSUE(R2, 16);
            const int tokN = tok + nloc * 8;
            if (tokN < T) U_INFO(tokN);
            if (n > 0) U_DOTS(R0, 0);
            if (n > 8) U_DOTS(R1, 8);
            if (n > 16) U_DOTS(R2, 16);
            for (int g0 = 24; g0 < n; g0 += 8) { U_ISSUE(R0, g0); U_DOTS(R0, g0); }
            asm volatile("s_waitcnt lgkmcnt(0)" ::: "memory");
        }
#undef U_INFO
#undef U_ISSUE
#undef U_DOTS
    }
}

#define EV_OFF(ev_, g_) (((g_) & 1) ? ((ev_[(g_) >> 3][((g_) >> 1) & 3] >> 9) & 0x7fff80u) : ((ev_[(g_) >> 3][((g_) >> 1) & 3] << 7) & 0x7fff80u))
struct XcdSlice { int nloc, nx, rank, q; };
__device__ __forceinline__ XcdSlice xcd_slice_setup(const DArgs& a, LAS unsigned char* lds) {
    volatile LAS unsigned* bst = (volatile LAS unsigned*)(lds + LDS_BARST);
    XcdSlice x; x.nloc = __builtin_amdgcn_readfirstlane((int)bst[0]); x.nx = __builtin_amdgcn_readfirstlane((int)bst[1]); x.rank = __builtin_amdgcn_readfirstlane((int)bst[2]);
    unsigned* bar = (unsigned*)(a.ws + WS_CTL) + CW_BAR; const unsigned myx = xb_xcc_id();
    x.q = 0; for (unsigned j = 0; j < 16; ++j) { const unsigned c = xb_ld(&bar[XB_XCNT(j)]); if (c > 0u && j < myx) ++x.q; }
    x.q = __builtin_amdgcn_readfirstlane(x.q);
    return x;
}
__device__ __forceinline__ void phase_ua(const DArgs& a, LAS unsigned char* lds) {
    const int tid = tid_(), lane = tid & 63, wave = __builtin_amdgcn_readfirstlane(tid >> 6), k = lane >> 3, c = lane & 7;
    GAS unsigned char* ws = a.ws;
    const XcdSlice X = xcd_slice_setup(a, lds);
    const int tstride = X.nloc * 8;
    for (int sl = X.q; sl < 8; sl += X.nx) {
        const GAS unsigned char* UBs = ws + WS_UB + (size_t)sl * 2097152;
        const unsigned coff = (unsigned)c * 16u;
        GAS unsigned char* PU = ws + WS_PARTU + (size_t)sl * T * 256;
        u32x4 evA[2], evB[2], RA[16], RB[16], xa, xb; float sa, sb;
#define A_TOK(t_) ((t_) < T ? (t_) : T - 1)
#define A_INFO(ev_, t_) do { const int tq_ = A_TOK(t_); _Pragma("unroll") for (int j_ = 0; j_ < 2; ++j_) ev_[j_] = *(const GAS u32x4*)(ws + WS_EIDX + (size_t)tq_ * 256 + (unsigned)(32 * k + 16 * j_)); } while (0)
#define A_ISSUE(R_, x_, s_, ev_, t_) do { const int tq_ = A_TOK(t_); _Pragma("unroll") for (int g_ = 0; g_ < 16; ++g_) R_[g_] = *(const GAS u32x4*)(UBs + (EV_OFF(ev_, g_) | coff)); \
        x_ = *(const GAS u32x4*)(ws + WS_XQ + (size_t)tq_ * 1024 + sl * 128 + coff); s_ = ((const GAS float*)(ws + WS_XQS))[tq_]; } while (0)
#define A_DOTS(R_, x_, s_, t_) do { \
        int ir0_ = 0, ir1_ = 0; \
        _Pragma("unroll") for (int gg_ = 0; gg_ < 4; ++gg_) {           \
            int d_[4]; _Pragma("unroll") for (int q_ = 0; q_ < 4; ++q_) d_[q_] = 0; \
            _Pragma("unroll") for (int j_ = 0; j_ < 4; ++j_) { _Pragma("unroll") for (int q_ = 0; q_ < 4; ++q_) d_[q_] = __builtin_amdgcn_sdot4((int)R_[4 * gg_ + q_][j_], (int)x_[j_], d_[q_], false); } \
            _Pragma("unroll") for (int q_ = 0; q_ < 4; ++q_) d_[q_] += DPPI_(d_[q_], 0xB1); \
            _Pragma("unroll") for (int q_ = 0; q_ < 4; ++q_) d_[q_] += DPPI_(d_[q_], 0x4E); \
            _Pragma("unroll") for (int q_ = 0; q_ < 4; ++q_) d_[q_] += DPPI_(d_[q_], 0x141);          \
            _Pragma("unroll") for (int q_ = 0; q_ < 4; ++q_) { if (c == ((4 * gg_ + q_) >> 1)) { if (q_ & 1) ir1_ = d_[q_]; else ir0_ = d_[q_]; } }          \
            __builtin_amdgcn_sched_barrier(0); } \
        if ((t_) < T) *(GAS unsigned*)(PU + (size_t)(t_) * 256 + (unsigned)(4 * lane)) = pk2((float)ir0_ * s_, (float)ir1_ * s_); } while (0)
        const int n0 = X.rank * 8 + wave;
        A_INFO(evA, n0); A_INFO(evB, n0 + tstride);
        __builtin_amdgcn_sched_barrier(0);
        A_ISSUE(RA, xa, sa, evA, n0);
        __builtin_amdgcn_sched_barrier(0);
#pragma unroll 1
        for (int n = n0; n < T; n += 2 * tstride) {
            A_INFO(evA, n + 2 * tstride);
            __builtin_amdgcn_sched_barrier(0);
            A_ISSUE(RB, xb, sb, evB, n + tstride);
            __builtin_amdgcn_sched_barrier(0);
            A_DOTS(RA, xa, sa, n);
            __builtin_amdgcn_sched_barrier(0);
            A_INFO(evB, n + 3 * tstride);
            __builtin_amdgcn_sched_barrier(0);
            A_ISSUE(RA, xa, sa, evA, n + 2 * tstride);
            __builtin_amdgcn_sched_barrier(0);
            A_DOTS(RB, xb, sb, n + tstride);
            __builtin_amdgcn_sched_barrier(0);
        }
#undef A_TOK
#undef A_INFO
#undef A_ISSUE
#undef A_DOTS
    }
}
__device__ __forceinline__ void phase_ua2(const DArgs& a, int vcu, int G) {
    const int tid = tid_();
    GAS unsigned char* ws = a.ws;
    const GAS float* USC = (const GAS float*)(ws + WS_USC); const GAS float* VSC = (const GAS float*)(ws + WS_VSC);
    const GAS unsigned char* PU = ws + WS_PARTU;
    const size_t N4 = (size_t)T * 128 / 4, stride = (size_t)G * NTHR;
    for (size_t i = (size_t)vcu * NTHR + tid; i < N4; i += 2 * stride) {
        const size_t i1 = (i + stride < N4) ? i + stride : i;
        u32x2 pv0[8], pv1[8];
#pragma unroll
        for (int sl = 0; sl < 8; ++sl) { pv0[sl] = ((const GAS u32x2*)(PU + (size_t)sl * T * 256))[i]; pv1[sl] = ((const GAS u32x2*)(PU + (size_t)sl * T * 256))[i1]; }
        const f32x4 gt0 = ((const GAS f32x4*)(ws + WS_GATE))[i], gt1 = ((const GAS f32x4*)(ws + WS_GATE))[i1];
        const u32x2 ep0 = ((const GAS u32x2*)(ws + WS_EIDX))[i], ep1 = ((const GAS u32x2*)(ws + WS_EIDX))[i1];
        const unsigned e0[4] = {ep0.x & 0xffffu, ep0.x >> 16, ep0.y & 0xffffu, ep0.y >> 16}, e1[4] = {ep1.x & 0xffffu, ep1.x >> 16, ep1.y & 0xffffu, ep1.y >> 16};
        float us0[4], vs0[4], us1[4], vs1[4];
#pragma unroll
        for (int e = 0; e < 4; ++e) { us0[e] = USC[e0[e]]; vs0[e] = VSC[e0[e]]; us1[e] = USC[e1[e]]; vs1[e] = VSC[e1[e]]; }
        f32x4 d0 = (f32x4){0.f, 0.f, 0.f, 0.f}, d1 = d0;
#pragma unroll
        for (int sl = 0; sl < 8; ++sl) { d0[0] += bf_lo(pv0[sl].x); d0[1] += bf_hi(pv0[sl].x); d0[2] += bf_lo(pv0[sl].y); d0[3] += bf_hi(pv0[sl].y);
                                         d1[0] += bf_lo(pv1[sl].x); d1[1] += bf_hi(pv1[sl].x); d1[2] += bf_lo(pv1[sl].y); d1[3] += bf_hi(pv1[sl].y); }
        f32x4 w0, w1;
#pragma unroll
        for (int e = 0; e < 4; ++e) { w0[e] = gelu_erf(d0[e] * us0[e]) * gt0[e] * vs0[e]; w1[e] = gelu_erf(d1[e] * us1[e]) * gt1[e] * vs1[e]; }
        u32x2 wo; wo.x = pk2(w0[0], w0[1]); wo.y = pk2(w0[2], w0[3]); ((GAS u32x2*)(ws + WS_PW))[i] = wo;
        if (i + stride < N4) { wo.x = pk2(w1[0], w1[1]); wo.y = pk2(w1[2], w1[3]); ((GAS u32x2*)(ws + WS_PW))[i1] = wo; }
    }
}
__device__ __forceinline__ void phase_vb(const DArgs& a, LAS unsigned char* lds) {
    const int tid = tid_(), lane = tid & 63, wave = __builtin_amdgcn_readfirstlane(tid >> 6), k = lane >> 3, c = lane & 7;
    GAS unsigned char* ws = a.ws;
    const XcdSlice X = xcd_slice_setup(a, lds);
    const int tstride = X.nloc * 8;
    const bool bit3 = (lane & 8) != 0;
    for (int sl = X.q; sl < 8; sl += X.nx) {
        const GAS unsigned char* VBs = ws + WS_VB + (size_t)sl * 2097152;
        const unsigned coff = (unsigned)c * 16u;
        const unsigned xoff = (unsigned)(sl * 128 + c * 16 + 2 * k) * 4u;
        u32x4 evA[2], evB[2], RA[16], RB[16], wa[2], wb[2]; unsigned xa, xb;
#define B_TOK(t_) ((t_) < T ? (t_) : T - 1)
#define B_INFO(ev_, t_) do { const int tq_ = B_TOK(t_); _Pragma("unroll") for (int j_ = 0; j_ < 2; ++j_) ev_[j_] = *(const GAS u32x4*)(ws + WS_EIDX + (size_t)tq_ * 256 + (unsigned)(32 * k + 16 * j_)); } while (0)
#define B_ISSUE(R_, w_, x_, ev_, t_) do { const int tq_ = B_TOK(t_); _Pragma("unroll") for (int g_ = 0; g_ < 16; ++g_) R_[g_] = *(const GAS u32x4*)(VBs + (EV_OFF(ev_, g_) | coff)); \
        _Pragma("unroll") for (int j_ = 0; j_ < 2; ++j_) w_[j_] = *(const GAS u32x4*)(ws + WS_PW + (size_t)tq_ * 256 + (unsigned)(32 * k + 16 * j_)); \
        x_ = *(const GAS unsigned*)((const GAS unsigned char*)a.out + (size_t)tq_ * (D * 2) + (xoff >> 1)); } while (0)
#define B_DOTS(R_, w_, x_, t_) do { \
        f32x2 acc2_[8]; _Pragma("unroll") for (int e_ = 0; e_ < 8; ++e_) acc2_[e_] = (f32x2){0.f, 0.f}; \
        _Pragma("unroll") for (int g_ = 0; g_ < 16; ++g_) { const unsigned ww_ = w_[g_ >> 3][(g_ >> 1) & 3]; const float wk_ = (g_ & 1) ? bf_hi(ww_) : bf_lo(ww_); const f32x2 wp_ = (f32x2){wk_, wk_}; \
            _Pragma("unroll") for (int jj_ = 0; jj_ < 4; ++jj_) { acc2_[2 * jj_] += wp_ * FP8LO(R_[g_][jj_]); acc2_[2 * jj_ + 1] += wp_ * FP8HI(R_[g_][jj_]); } \
            if (g_ & 1) __builtin_amdgcn_sched_barrier(0); } \
        f32x2 w2_[4], x2_[2], y_; \
        _Pragma("unroll") for (int i_ = 0; i_ < 4; ++i_) { w2_[i_][0] = rs32_(acc2_[i_][0], acc2_[i_ + 4][0]); w2_[i_][1] = rs32_(acc2_[i_][1], acc2_[i_ + 4][1]); } \
        _Pragma("unroll") for (int i_ = 0; i_ < 2; ++i_) { x2_[i_][0] = rs16_(w2_[i_][0], w2_[i_ + 2][0]); x2_[i_][1] = rs16_(w2_[i_][1], w2_[i_ + 2][1]); } \
        y_[0] = rs8_(x2_[0][0], x2_[1][0], bit3) + bf_lo(x_); y_[1] = rs8_(x2_[0][1], x2_[1][1], bit3) + bf_hi(x_); \
        const float ss_ = wave_sum(y_[0] * y_[0] + y_[1] * y_[1], lane); \
        if ((t_) < T) { *(GAS unsigned*)(ws + WS_PARTU + (size_t)(t_) * (D * 2) + (xoff >> 1)) = pk2(y_[0], y_[1]);       \
            if (lane == 0) ((GAS float*)(ws + WS_SS))[(size_t)(t_) * 8 + sl] = ss_; } } while (0)
        const int n0 = X.rank * 8 + wave;
        B_INFO(evA, n0); B_INFO(evB, n0 + tstride);
        __builtin_amdgcn_sched_barrier(0);
        B_ISSUE(RA, wa, xa, evA, n0);
        __builtin_amdgcn_sched_barrier(0);
#pragma unroll 1
        for (int n = n0; n < T; n += 2 * tstride) {
            B_INFO(evA, n + 2 * tstride);
            __builtin_amdgcn_sched_barrier(0);
            B_ISSUE(RB, wb, xb, evB, n + tstride);
            __builtin_amdgcn_sched_barrier(0);
            B_DOTS(RA, wa, xa, n);
            __builtin_amdgcn_sched_barrier(0);
            B_INFO(evB, n + 3 * tstride);
            __builtin_amdgcn_sched_barrier(0);
            B_ISSUE(RA, wa, xa, evA, n + 2 * tstride);
            __builtin_amdgcn_sched_barrier(0);
            B_DOTS(RB, wb, xb, n + tstride);
            __builtin_amdgcn_sched_barrier(0);
        }
#undef B_TOK
#undef B_INFO
#undef B_ISSUE
#undef B_DOTS
    }
}
__device__ __forceinline__ void phase_vc(const DArgs& a, int vcu, int G) {
    const int tid = tid_(), lane = tid & 63, wave = tid >> 6;
    const int gw = vcu * NWAVES + wave, NGW = G * NWAVES;
    GAS unsigned char* ws = a.ws;
    f32x4 gf[4];
#pragma unroll
    for (int j = 0; j < 4; ++j) gf[j] = ((const GAS f32x4*)a.final_g)[64 * j + lane];
    for (int m = gw; m < T; m += NGW) {
        const f32x4 s0 = *(const GAS f32x4*)((const GAS float*)(ws + WS_SS) + (size_t)m * 8), s1 = *(const GAS f32x4*)((const GAS float*)(ws + WS_SS) + (size_t)m * 8 + 4);
        const float rstd = rsqrtf(((s0[0] + s0[1]) + (s0[2] + s0[3]) + (s1[0] + s1[1]) + (s1[2] + s1[3])) * (1.f / D) + EPS);
        const GAS u32x2* xi = (const GAS u32x2*)(ws + WS_PARTU + (size_t)m * (D * 2)) + lane;
        GAS f32x4* o = (GAS f32x4*)(a.out + (size_t)m * D) + lane;
#pragma unroll
        for (int j = 0; j < 4; ++j) { const u32x2 xv = xi[64 * j]; f32x4 v; v[0] = bf_lo(xv.x); v[1] = bf_hi(xv.x); v[2] = bf_lo(xv.y); v[3] = bf_hi(xv.y); o[64 * j] = v * rstd * gf[j]; }
    }
}

__device__ __forceinline__ void phase_final_plain(const DArgs& a, const float* src, int vcu, int G) {
    const int tid = tid_(), lane = tid & 63, wave = tid >> 6;
    const int gw = vcu * NWAVES + wave, NGW = G * NWAVES;
    f32x4 gf[4];
#pragma unroll
    for (int j = 0; j < 4; ++j) gf[j] = ((const f32x4*)a.final_g)[64 * j + lane];
    for (int m = gw; m < T; m += NGW) {
        const f32x4* xr = (const f32x4*)(src + (size_t)m * D) + lane;
        f32x4 v[4]; float s = 0.f;
#pragma unroll
        for (int j = 0; j < 4; ++j) { v[j] = xr[64 * j]; s += (v[j][0] * v[j][0] + v[j][1] * v[j][1]) + (v[j][2] * v[j][2] + v[j][3] * v[j][3]); }
        const float rstd = rsqrtf(wave_sum(s, lane) * (1.f / D) + EPS);
        f32x4* o = (f32x4*)(a.out + (size_t)m * D) + lane;
#pragma unroll
        for (int j = 0; j < 4; ++j) o[64 * j] = v[j] * rstd * gf[j];
    }
}


__device__ __forceinline__ DArgs load_args() {
    DArgs r;
#if defined(__HIP_DEVICE_COMPILE__)
    typedef const DArgs __attribute__((address_space(4))) KArgs;
    KArgs* p = (KArgs*)__builtin_amdgcn_kernarg_segment_ptr();
    asm volatile("" : "+s"(p));
    r.x = p->x; r.norm1_g = p->norm1_g; r.w_in = p->w_in; r.b_in = p->b_in; r.conv_w = p->conv_w; r.conv_b = p->conv_b; r.m_head_g = p->m_head_g; r.lb_table = p->lb_table;
    r.g_head_g = p->g_head_g; r.w_br_m = p->w_br_m; r.w_br_g = p->w_br_g; r.w_out = p->w_out; r.norm2_g = p->norm2_g; r.w_pq = p->w_pq; r.sub_keys = p->sub_keys;
    r.u_emb = p->u_emb; r.v_emb = p->v_emb; r.final_g = p->final_g; r.out = p->out; r.ws = p->ws;
#else
    r = DArgs{};
#endif
    return r;
}
__device__ __forceinline__ EpiPtrs make_ep(const DArgs& a, int round) {
    EpiPtrs ep; ep.biasp = (const GAS float*)(a.ws + WS_BIASP); ep.lb = (const GAS float*)(a.ws + WS_LB); ep.x = a.x; ep.out = a.out; ep.ws = a.ws; ep.round = round; ep.pn0 = 0; ep.sa = (const GAS float*)(a.ws + WS_SA8); ep.sb = (const GAS float*)(a.ws + WS_SB8); ep.sym = (const GAS float*)(a.ws + WS_SYM); ep.syg = (const GAS float*)(a.ws + WS_SYG); ep.sxq = (const GAS float*)(a.ws + WS_XQS); return ep;
}
#define GRID_SYNC() do { const DArgs a_ = load_args(); xcd_barrier((unsigned*)(a_.ws + WS_CTL) + CW_BAR, (volatile LAS unsigned*)(lds + LDS_BARST)); } while (0)

__device__ __forceinline__ int bx_() { int t = blockIdx.x; asm volatile("" : "+s"(t)); return t; }
__device__ __forceinline__ int gd_() { int t = gridDim.x; asm volatile("" : "+s"(t)); return t; }
#define PH_BEGIN const DArgs a = load_args(); const int bx = bx_(), G = gd_(); const int vcu = (G % 8 == 0) ? (bx % 8) * (G / 8) + bx / 8 : bx; (void)vcu; (void)bx;

__global__ void __launch_bounds__(NTHR, 2) fwd_megakernel(Args a_unused) {
    extern __shared__ __attribute__((aligned(16))) unsigned char lds_raw[];
    LAS unsigned char* lds = (LAS unsigned char*)lds_raw;
    cg::grid_group grid = cg::this_grid();

    { const int t_ = tid_(); if (t_ < 16) ((LAS unsigned*)(lds + LDS_BARST))[t_] = 0u; __syncthreads();
      const DArgs a_ = load_args(); xcd_barrier_post((unsigned*)(a_.ws + WS_CTL) + CW_BAR, (volatile LAS unsigned*)(lds + LDS_BARST)); }
    { PH_BEGIN phase_p0(a, lds, vcu, G); }
    grid.sync();
    { PH_BEGIN phase_p0c(a, lds, vcu, G); }
    GRID_SYNC();
#pragma unroll 1
    for (int round = 0; round < NROUND; ++round) {
        {
            PH_BEGIN
            pg8::Gemm g{(const bf16_t*)(a.ws + WS_XN8 + (size_t)round * RT * 1024), (const bf16_t*)(a.ws + WS_W8A), RT, N1, D / 2};
            pg8::StaticOrder S; S.init(RT, N1, G, bx);
            EpiX<7> E{make_ep(a, round)};
            pg8::gemm_phase<EpiX<7>, pg8::StaticOrder, true, true, true>(lds, g, S, E);
        }
        { PH_BEGIN if (bx < 8) mscan_pair(a, lds, round, bx); }
        GRID_SYNC();
        { PH_BEGIN for (int it = bx; it < 512; it += G) mlstm_pre_item(a, lds, round, it); }
        { PH_BEGIN u32x4 gq[4]; int it = bx; if (it < 2048) hgrn_pre_load(a, round, it, gq);
          for (; it < 2048; it += G) hgrn_pre_item(a, lds, round, it, gq, it + G); }
        GRID_SYNC();
        { PH_BEGIN
          if (bx < 128) mlstm_scan<2, false>(a, lds, round, bx & 7, bx >> 3);
          else if (bx >= 192 && bx < 200) mlstm_scan<1, true>(a, lds, round, bx - 192, 0);
          else if (bx < 192) { const int id2 = bx - 128; hgrn_scan(a, lds, round, (id2 & 7) * 2 + ((id2 >> 3) & 1), id2 >> 4); }
          else if (G >= 232) {
              pg8::Gemm g{(const bf16_t*)(a.ws + WS_XN8 + (size_t)round * RT * 1024), (const bf16_t*)(a.ws + WS_W8 + (size_t)2048 * 1024), RT, 1024, D / 2};
              pg8::StaticOrder S; S.init(RT, 1024, G - 200, bx - 200);
              EpiPtrs ep = make_ep(a, round); ep.pn0 = 8; EpiX<2> E{ep};
              pg8::gemm_phase<EpiX<2>, pg8::StaticOrder, true, true, true>(lds, g, S, E); } }
        GRID_SYNC();
#define G2_PART(pn0_, ncol_) { PH_BEGIN \
            pg8::Gemm g{(const bf16_t*)(a.ws + WS_XN8 + (size_t)round * RT * 1024), (const bf16_t*)(a.ws + WS_W8 + (size_t)(pn0_) * 256 * 1024), RT, (ncol_), D / 2};       \
            pg8::StaticOrder S; S.init(RT, (ncol_), G, bx); \
            EpiPtrs ep = make_ep(a, round); ep.pn0 = (pn0_); EpiX<2> E{ep}; \
            pg8::gemm_phase<EpiX<2>, pg8::StaticOrder, true, true, true>(lds, g, S, E); }
        G2_PART(0, 2048)
        G2_PART(12, 2048)
        if (gd_() < 232) G2_PART(8, 1024)
#undef G2_PART
        GRID_SYNC();
        { PH_BEGIN phase_ypass(a, round, vcu, G); }
        GRID_SYNC();
        {
            { PH_BEGIN pg8::StaticOrder S; S.init(RT, D, G, bx);
              pg8::Gemm g{(const bf16_t*)(a.ws + WS_V), (const bf16_t*)(a.ws + WS_WM), RT, D, 2048 / 2}; EpiX<3> E{make_ep(a, round)}; pg8::gemm_phase<EpiX<3>, pg8::StaticOrder, true, true, true>(lds, g, S, E); }
            { PH_BEGIN pg8::StaticOrder S; S.init(RT, D, G, bx);
              pg8::Gemm g{(const bf16_t*)(a.ws + WS_GI), (const bf16_t*)(a.ws + WS_WG), RT, D, D / 2}; EpiX<4> E{make_ep(a, round)}; pg8::gemm_phase<EpiX<4>, pg8::StaticOrder, true, true, true>(lds, g, S, E); }
        }
        GRID_SYNC();
        {
            PH_BEGIN pg8::StaticOrder S; S.init(RT, D, G, bx);
            pg8::Gemm g{(const bf16_t*)(a.ws + WS_GFLOG), (const bf16_t*)(a.ws + WS_WO), RT, D, D}; EpiX<5> E{make_ep(a, round)}; pg8::gemm_phase<EpiX<5>, pg8::StaticOrder, true, true>(lds, g, S, E);
        }
        GRID_SYNC();
    }
    { PH_BEGIN phase_p8(a, vcu, G); }
    GRID_SYNC();
    {
        PH_BEGIN pg8::StaticOrder S; S.init(T, 2048, G, bx);
        pg8::Gemm g{(const bf16_t*)(a.ws + WS_XQ), (const bf16_t*)(a.ws + WS_WPQ), T, 2048, D / 2}; EpiX<6> E{make_ep(a, 0)}; pg8::gemm_phase<EpiX<6>, pg8::StaticOrder, true, true, true>(lds, g, S, E);
    }
    GRID_SYNC();
#ifdef TOPK_REF
    { PH_BEGIN phase_topk_ref(a, vcu, G); }
#else
    { PH_BEGIN phase_topk(a, lds, bx, G); }
#endif
    GRID_SYNC();
    { PH_BEGIN phase_ua(a, lds); }
    GRID_SYNC();
    { PH_BEGIN phase_ua2(a, vcu, G); }
    GRID_SYNC();
    { PH_BEGIN phase_vb(a, lds); }
    GRID_SYNC();
    { PH_BEGIN phase_vc(a, vcu, G); }
}

extern "C" void kernel_launch(void* const* d_in, const int* in_sizes, int n_in, void* d_out, int out_size, void* d_ws, size_t ws_size, hipStream_t stream) {
    static int grid = 0;
    if (grid == 0) {
        if (n_in != 18 || in_sizes[0] != T * D || out_size != T * D || ws_size < WS_END) {
            fprintf(stderr, "kernel_launch: unexpected shapes/workspace (n_in %d, in0 %d, out %d, ws %zu, need %zu)\n", n_in, n_in > 0 ? in_sizes[0] : -1, out_size, ws_size, (size_t)WS_END);
            grid = -1; return; }
        int dev = 0, cus = 0, per_cu = 0;
        hipGetDevice(&dev);
        hipDeviceGetAttribute(&cus, hipDeviceAttributeMultiprocessorCount, dev);
        hipFuncSetAttribute((const void*)fwd_megakernel, hipFuncAttributeMaxDynamicSharedMemorySize, LDS_BYTES);
        hipOccupancyMaxActiveBlocksPerMultiprocessor(&per_cu, (const void*)fwd_megakernel, NTHR, LDS_BYTES);
        if (per_cu < 1) { fprintf(stderr, "kernel_launch: occupancy query says %d blocks/CU\n", per_cu); per_cu = 1; }
        grid = cus;
        (void)hipGetLastError();
    }
    if (grid < 0) return;
    hipMemsetAsync((char*)d_ws + WS_CTL, 0, 131072, stream);
    Args a{};
    a.x = (const float*)d_in[0]; a.norm1_g = (const float*)d_in[1]; a.w_in = (const float*)d_in[2]; a.b_in = (const float*)d_in[3];
    a.conv_w = (const float*)d_in[4]; a.conv_b = (const float*)d_in[5]; a.m_head_g = (const float*)d_in[6]; a.lb_table = (const float*)d_in[7];
    a.g_head_g = (const float*)d_in[8]; a.w_br_m = (const float*)d_in[9]; a.w_br_g = (const float*)d_in[10]; a.w_out = (const float*)d_in[11];
    a.norm2_g = (const float*)d_in[12]; a.w_pq = (const float*)d_in[13]; a.sub_keys = (const float*)d_in[14]; a.u_emb = (const float*)d_in[15];
    a.v_emb = (const float*)d_in[16]; a.final_g = (const float*)d_in[17];
    a.out = (float*)d_out; a.ws = (unsigned char*)d_ws;
    void* args[] = {&a};
    hipError_t e = hipLaunchCooperativeKernel((const void*)fwd_megakernel, dim3(grid), dim3(NTHR), args, LDS_BYTES, stream);
    if (e != hipSuccess) fprintf(stderr, "cooperative launch failed: %s (grid %d)\n", hipGetErrorString(e), grid);
}
```

```cpp
#include <hip/hip_runtime.h>
#include <hip/hip_cooperative_groups.h>
#include <cstdio>
#include <cstdint>
namespace cg = cooperative_groups;

#define LAS __attribute__((address_space(3)))
typedef unsigned short bf16_t;
typedef short bf16x8 __attribute__((ext_vector_type(8)));
typedef float f32x4 __attribute__((ext_vector_type(4)));
typedef float f32x2 __attribute__((ext_vector_type(2)));
typedef unsigned u32x4 __attribute__((ext_vector_type(4)));
typedef unsigned u32x2 __attribute__((ext_vector_type(2)));

constexpr int D = 1024, BATCH = 4, SEQ = 8192, T = BATCH * SEQ;
constexpr int IN_COLS = 12296, NP = 12288;
constexpr int RT = 16384, NROUND = 2;
constexpr int N1 = 7168, N2 = 5120;
constexpr float EPS = 1e-6f;
constexpr int NWAVES = 8, NTHR = 512;

constexpr size_t MiB = 1u << 20;
constexpr size_t WS_CTL = 0;
constexpr size_t WS_WIN = 1 * MiB;
constexpr size_t WS_WM = 25 * MiB;
constexpr size_t WS_WG = 29 * MiB;
constexpr size_t WS_WO = 31 * MiB;
constexpr size_t WS_WPQ = 33 * MiB;
constexpr size_t WS_SK = 37 * MiB;
constexpr size_t WS_BIASP = 37 * MiB + 512 * 1024;
constexpr size_t WS_LB = WS_BIASP + 64 * 1024;
constexpr size_t WS_GATES = 38 * MiB;
constexpr size_t WS_MPREV = 39 * MiB;
constexpr size_t WS_DEN = 40 * MiB;
constexpr size_t WS_MT = 40 * MiB + 512 * 1024;
constexpr size_t WS_HGDEC = 41 * MiB;
constexpr size_t WS_MDEC = 43 * MiB;
constexpr size_t WS_XN = 44 * MiB;
constexpr size_t WS_QKPRE = 108 * MiB;
constexpr size_t WS_V = 172 * MiB;
constexpr size_t WS_GFLOG = 236 * MiB;
constexpr size_t WS_GI = 268 * MiB;
constexpr size_t WS_GQ = 300 * MiB;
constexpr size_t WS_S = 332 * MiB;
constexpr size_t WS_QT = 348 * MiB;
constexpr size_t WS_KWT = 380 * MiB;
constexpr size_t WS_ATT = 412 * MiB;
constexpr size_t WS_QTG = 428 * MiB;
constexpr size_t WS_KENDT = 460 * MiB;
constexpr size_t WS_SIGO = 332 * MiB;
constexpr size_t WS_SGG = 76 * MiB;
constexpr size_t WS_SAM = 428 * MiB;
constexpr size_t WS_SAG = 460 * MiB;
constexpr size_t WS_XN8 = 44 * MiB;
constexpr size_t WS_SA8 = 508 * MiB;
constexpr size_t WS_SB8 = 508 * MiB + 262144;
constexpr size_t WS_W8A = WS_WIN;
constexpr size_t WS_W8 = WS_WIN + (size_t)7168 * 1024;
constexpr int NI8 = 12288 + 1024 + 1024 + 2048;
constexpr size_t WS_SYM = 508 * MiB + 524288;
constexpr size_t WS_SYG = 508 * MiB + 655360;
constexpr int CW_COLMAX = 16384;
constexpr size_t WS_END = 510 * MiB;
constexpr size_t WS_QP = 108 * MiB;
constexpr size_t WS_UB = 236 * MiB;
constexpr size_t WS_VB = 252 * MiB;
constexpr size_t WS_USC = 268 * MiB;
constexpr size_t WS_VSC = 268 * MiB + 65536;
constexpr size_t WS_EIDX = 300 * MiB;
constexpr size_t WS_GATE = 316 * MiB;
constexpr size_t WS_XQ = 380 * MiB;
constexpr size_t WS_XQS = 412 * MiB;
constexpr size_t WS_PARTU = 108 * MiB;
constexpr size_t WS_SS = 348 * MiB;
constexpr size_t WS_PW = 332 * MiB;

constexpr int CW_TMAX = 64;
constexpr int LDS_BYTES = 147456;

__device__ __forceinline__ unsigned f2bf(float f) { unsigned u = __builtin_bit_cast(unsigned, f); return (u + 0x7fffu + ((u >> 16) & 1u)) >> 16; }
typedef __bf16 bf16x2_t __attribute__((ext_vector_type(2)));
__device__ __forceinline__ unsigned pk2(float lo, float hi) { bf16x2_t v; v[0] = (__bf16)lo; v[1] = (__bf16)hi; return __builtin_bit_cast(unsigned, v); }
__device__ __forceinline__ float bf_lo(unsigned w) { return __builtin_bit_cast(float, w << 16); }
__device__ __forceinline__ float bf_hi(unsigned w) { return __builtin_bit_cast(float, w & 0xffff0000u); }
__device__ __forceinline__ float bf2f(bf16_t h) { return __builtin_bit_cast(float, ((unsigned)h) << 16); }
__device__ __forceinline__ float shx(float v, int o, int lane) { return __builtin_bit_cast(float, __builtin_amdgcn_ds_bpermute((lane ^ o) << 2, __builtin_bit_cast(int, v))); }
__device__ __forceinline__ float shup(float v, int o, int lane) { return __builtin_bit_cast(float, __builtin_amdgcn_ds_bpermute(((lane - o) & 63) << 2, __builtin_bit_cast(int, v))); }
__device__ __forceinline__ float rdlane(float v, int l) { return __builtin_bit_cast(float, __builtin_amdgcn_readlane(__builtin_bit_cast(int, v), l)); }
#define DPP_(v, ctrl) __builtin_bit_cast(float, __builtin_amdgcn_update_dpp(0, __builtin_bit_cast(int, (v)), (ctrl), 0xF, 0xF, false))
__device__ __forceinline__ float wave_sum(float v, int lane) {
    (void)lane;
    v += DPP_(v, 0xB1); v += DPP_(v, 0x4E); v += DPP_(v, 0x141); v += DPP_(v, 0x140);
    return (rdlane(v, 0) + rdlane(v, 16)) + (rdlane(v, 32) + rdlane(v, 48));
}
__device__ __forceinline__ float wave_max(float v) {
    v = fmaxf(v, DPP_(v, 0xB1)); v = fmaxf(v, DPP_(v, 0x4E)); v = fmaxf(v, DPP_(v, 0x141)); v = fmaxf(v, DPP_(v, 0x140));
    return fmaxf(fmaxf(rdlane(v, 0), rdlane(v, 16)), fmaxf(rdlane(v, 32), rdlane(v, 48)));
}
__device__ __forceinline__ unsigned pack_i8x4(float a, float b, float c, float d) {
    const int ia = (int)__builtin_rintf(a), ib = (int)__builtin_rintf(b), ic = (int)__builtin_rintf(c), id = (int)__builtin_rintf(d);
    return ((unsigned)ia & 255u) | (((unsigned)ib & 255u) << 8) | (((unsigned)ic & 255u) << 16) | ((unsigned)id << 24);
}
#define SWZI_(v, pat) __builtin_amdgcn_ds_swizzle((int)(v), (pat))
#define DPPI_(v, ctrl) __builtin_amdgcn_update_dpp(0, (int)(v), (ctrl), 0xF, 0xF, false)
__device__ __forceinline__ unsigned xor32u_(unsigned v, bool hi) {
#if defined(__HIP_DEVICE_COMPILE__)
    const auto r = __builtin_amdgcn_permlane32_swap(v, v, false, false);
    return hi ? r[0] : r[1];
#else
    (void)hi; return v;
#endif
}
__device__ __forceinline__ float sigmoidf_(float x) { return __builtin_amdgcn_rcpf(1.0f + __expf(-x)); }
__device__ __forceinline__ float siluf_(float x) { return x * __builtin_amdgcn_rcpf(1.0f + __expf(-x)); }
#define LDS_WAIT() asm volatile("s_waitcnt lgkmcnt(0)" ::: "memory")
__device__ __forceinline__ int tid_() { int t = threadIdx.x; asm volatile("" : "+v"(t)); return t; }

#define GAS __attribute__((address_space(1)))
struct DArgs {
    const GAS float* x; const GAS float* norm1_g; const GAS float* w_in; const GAS float* b_in; const GAS float* conv_w; const GAS float* conv_b;
    const GAS float* m_head_g; const GAS float* lb_table; const GAS float* g_head_g; const GAS float* w_br_m; const GAS float* w_br_g; const GAS float* w_out;
    const GAS float* norm2_g; const GAS float* w_pq; const GAS float* sub_keys; const GAS float* u_emb; const GAS float* v_emb; const GAS float* final_g;
    GAS float* out; GAS unsigned char* ws;
};
struct Args {
    const float* x; const float* norm1_g; const float* w_in; const float* b_in; const float* conv_w; const float* conv_b;
    const float* m_head_g; const float* lb_table; const float* g_head_g; const float* w_br_m; const float* w_br_g; const float* w_out;
    const float* norm2_g; const float* w_pq; const float* sub_keys; const float* u_emb; const float* v_emb; const float* final_g;
    float* out; unsigned char* ws;
};

namespace pg8 {
constexpr int BM = 256, BK = 64, HALF = 128, HTB = HALF * BK * 2, STAGE_BYTES = 8 * HTB, NXCD = 8, WGM = 8;
__host__ __device__ __forceinline__ int lds_byte(int r, int c) { const int st = (r >> 4) * 2 + (c >> 5), rr = r & 15, cc = c & 31, ob = rr * 64 + cc * 2; return st * 1024 + (ob ^ (((ob >> 9) & 1) << 5)); }
__host__ __device__ __forceinline__ void stage_rc(int b, int& R, int& C) { const int st = b / 1024, sb = b % 1024, swz = sb ^ (((sb >> 9) & 1) << 5); R = (st >> 1) * 16 + swz / 64; C = (st & 1) * 32 + (swz % 64) / 2; }
__host__ __device__ __forceinline__ int perm32(int rho) { const int n = rho >> 4, i = rho & 15; return 8 * (i >> 2) + 4 * n + (i & 3); }
struct Unit { int pm, pn; };
struct Gemm { const bf16_t* A; const bf16_t* Bt; int M, N, K; };
struct StaticOrder {
    int nM, nN, nwg, G, c;
    __host__ __device__ void init(int M, int N, int G_, int c_) { nM = M / BM; nN = N / BM; nwg = nM * nN; G = G_; c = c_; }
    __host__ __device__ bool next(int i, Unit& u) const {
        const long L = (long)i * G + c; if (L >= nwg) return false;
        int wgid = (int)L; { const int q = nwg / NXCD, r = nwg % NXCD, xcd = wgid % NXCD, off = wgid / NXCD; wgid = (xcd < r ? xcd * (q + 1) : r * (q + 1) + (xcd - r) * q) + off; }
        const int nig = WGM * nN, gid = wgid / nig, fm = gid * WGM, gsz = (nM - fm) < WGM ? (nM - fm) : WGM;
        u.pm = fm + ((wgid % nig) % gsz); u.pn = (wgid % nig) / gsz; return true;
    }
    __device__ __forceinline__ void a_ready(const Unit&) const {}
    __device__ __forceinline__ void done(const Unit&) const {}
};

typedef int i32x8 __attribute__((ext_vector_type(8)));
typedef int i32x4 __attribute__((ext_vector_type(4)));
template <class Epi, class Sched, bool ALIGN_EPI = false, bool SP2 = false, bool I8 = false>
__device__ __forceinline__ void gemm_phase(LAS unsigned char* lds, const Gemm g, const Sched& S, const Epi& E) {
    const int tid = tid_(), wid = __builtin_amdgcn_readfirstlane(tid >> 6), lane = tid & 63, wr = wid >> 2, wc = wid & 3, fr = lane & 15, fq = lane >> 4;
    const int K = g.K, nt = K / BK;
    unsigned voffA[2], voffB[2];
#pragma unroll
    for (int i = 0; i < 2; ++i) { int R, C; stage_rc(tid * 16 + i * 8192, R, C); const int Rb = Epi::PERM ? ((R & ~31) + perm32(R & 31)) : R;
        voffA[i] = (unsigned)(R * K + C) * 2u; voffB[i] = (unsigned)(Rb * K + C) * 2u; }
    const size_t kstep = (size_t)(BK * 2);
    const size_t hstep = (size_t)HALF * K * 2;
    const size_t tstep = 2 * hstep;
    const unsigned ldsw = (unsigned)wid * 1024u;
    const int aoff = lds_byte(wr * 64 + fr, fq * 8), boff = lds_byte(wc * 32 + fr, fq * 8);
#define PG8_SA(b, h) (((b) * 2 + (h)) * HTB)
#define PG8_SB(b, h) ((4 + (b) * 2 + (h)) * HTB)
#define PG8_STAGE(bufoff, gbase, voff) do { _Pragma("unroll") for (int _i = 0; _i < 2; ++_i) \
        __builtin_amdgcn_global_load_lds((const unsigned*)((const char*)(gbase) + (voff)[_i]), (LAS unsigned*)(lds + (bufoff) + ldsw + _i * 8192), 16, 0, 0); } while (0)
#define PG8_LDA(dst, b, h) do { _Pragma("unroll") for (int m = 0; m < 4; ++m) _Pragma("unroll") for (int k = 0; k < 2; ++k) dst[m][k] = *(const LAS bf16x8*)(lds + PG8_SA(b, h) + aoff + m * 2048 + k * 1024); } while (0)
#define PG8_LDB(dst, b, h) do { _Pragma("unroll") for (int n = 0; n < 2; ++n) _Pragma("unroll") for (int k = 0; k < 2; ++k) dst[n][k] = *(const LAS bf16x8*)(lds + PG8_SB(b, h) + boff + n * 2048 + k * 1024); } while (0)
#define PG8_MMA(ai, bj, At, Bt) do { __builtin_amdgcn_s_setprio(1); _Pragma("unroll") for (int m = 0; m < 4; ++m) _Pragma("unroll") for (int n = 0; n < 2; ++n) _Pragma("unroll") for (int k = 0; k < 2; ++k) { \
        if constexpr (I8) acc[ai][bj][m][n] = __builtin_bit_cast(f32x4, __builtin_amdgcn_mfma_i32_16x16x64_i8(__builtin_bit_cast(i32x4, Bt[n][k]), __builtin_bit_cast(i32x4, At[m][k]), __builtin_bit_cast(i32x4, acc[ai][bj][m][n]), 0, 0, 0)); \
        else acc[ai][bj][m][n] = __builtin_amdgcn_mfma_f32_16x16x32_bf16(Bt[n][k], At[m][k], acc[ai][bj][m][n], 0, 0, 0); } __builtin_amdgcn_s_setprio(0); } while (0)
#define PG8_WAIT_V(n) asm volatile("s_waitcnt vmcnt(" #n ")" ::: "memory")
#define PG8_WAIT_L(n) asm volatile("s_waitcnt lgkmcnt(" #n ")" ::: "memory")
#define PG8_BAR __builtin_amdgcn_s_barrier()
#define PG8_SCHED __builtin_amdgcn_sched_barrier(0)
    Unit cur, nxt; int ui = 0;
    if (!S.next(0, cur)) return;
    f32x4 acc[2][2][4][2];
#pragma unroll
    for (int a = 0; a < 2; ++a)
#pragma unroll
        for (int b = 0; b < 2; ++b)
#pragma unroll
            for (int m = 0; m < 4; ++m)
#pragma unroll
                for (int n = 0; n < 2; ++n) acc[a][b][m][n] = (f32x4){0.f, 0.f, 0.f, 0.f};
    bf16x8 At[4][2], B0[2][2], B1[2][2];
    const char* cA = (const char*)g.A + (size_t)cur.pm * tstep; const char* cB = (const char*)g.Bt + (size_t)cur.pn * tstep;
    S.a_ready(cur);
    if constexpr (SP2) {
        PG8_STAGE(PG8_SB(0, 0), cB, voffB); PG8_STAGE(PG8_SB(0, 1), cB + hstep, voffB); PG8_STAGE(PG8_SA(0, 0), cA, voffA); PG8_STAGE(PG8_SA(0, 1), cA + hstep, voffA);
        if (wr == 1) PG8_BAR;
        PG8_WAIT_V(2); PG8_BAR;
        PG8_STAGE(PG8_SB(1, 0), cB + kstep, voffB); PG8_STAGE(PG8_SA(1, 0), cA + kstep, voffA); PG8_STAGE(PG8_SB(1, 1), cB + hstep + kstep, voffB);
        PG8_WAIT_V(6); PG8_BAR;
    } else {
        PG8_STAGE(PG8_SB(0, 0), cB, voffB); PG8_STAGE(PG8_SA(0, 0), cA, voffA); PG8_STAGE(PG8_SB(0, 1), cB + hstep, voffB); PG8_STAGE(PG8_SA(0, 1), cA + hstep, voffA);
        if (wr == 1) PG8_BAR;
        PG8_WAIT_V(4); PG8_BAR;
        PG8_STAGE(PG8_SB(1, 0), cB + kstep, voffB); PG8_STAGE(PG8_SA(1, 0), cA + kstep, voffA); PG8_STAGE(PG8_SB(1, 1), cB + hstep + kstep, voffB);
        PG8_WAIT_V(6); PG8_BAR;
    }
    for (;;) {
        const bool has_next = S.next(ui + 1, nxt);
        const char* nA = has_next ? (const char*)g.A + (size_t)nxt.pm * tstep : cA; const char* nB = has_next ? (const char*)g.Bt + (size_t)nxt.pn * tstep : cB;
#pragma unroll 1
        for (int t = 0; t < nt; t += 2) {
            const bool last = (t == nt - 2);
            const char* a1 = cA + (size_t)(t + 1) * kstep;
            const char* a2 = last ? nA : cA + (size_t)(t + 2) * kstep; const char* b2 = last ? nB : cB + (size_t)(t + 2) * kstep;
            const char* a3 = a2 + kstep; const char* b3 = b2 + kstep;
            if (last && has_next) S.a_ready(nxt);
            if constexpr (SP2) {
            PG8_LDB(B0, 0, 0); PG8_LDB(B1, 0, 1); PG8_SCHED; PG8_LDA(At, 0, 0); PG8_STAGE(PG8_SA(1, 1), a1 + hstep, voffA);
            PG8_WAIT_V(8); PG8_WAIT_L(0); PG8_BAR; PG8_MMA(0, 0, At, B0); PG8_MMA(0, 1, At, B1); PG8_BAR; PG8_SCHED;
            PG8_LDA(At, 0, 1); PG8_STAGE(PG8_SB(0, 0), b2, voffB); PG8_STAGE(PG8_SB(0, 1), b2 + hstep, voffB); PG8_STAGE(PG8_SA(0, 0), a2, voffA);
            PG8_WAIT_V(8); PG8_WAIT_L(0); PG8_BAR; PG8_MMA(1, 0, At, B0); PG8_MMA(1, 1, At, B1); PG8_BAR; PG8_SCHED;
            PG8_LDB(B0, 1, 0); PG8_LDB(B1, 1, 1); PG8_SCHED; PG8_LDA(At, 1, 0); PG8_STAGE(PG8_SA(0, 1), a2 + hstep, voffA);
            PG8_WAIT_V(8); PG8_WAIT_L(0); PG8_BAR; PG8_MMA(0, 0, At, B0); PG8_MMA(0, 1, At, B1); PG8_BAR; PG8_SCHED;
            PG8_LDA(At, 1, 1); PG8_STAGE(PG8_SB(1, 0), b3, voffB); PG8_STAGE(PG8_SB(1, 1), b3 + hstep, voffB); PG8_STAGE(PG8_SA(1, 0), a3, voffA);
            PG8_WAIT_V(8); PG8_WAIT_L(0); PG8_BAR; PG8_MMA(1, 0, At, B0); PG8_MMA(1, 1, At, B1); PG8_BAR; PG8_SCHED;
            } else {
            PG8_LDB(B0, 0, 0); PG8_SCHED; PG8_LDA(At, 0, 0); PG8_STAGE(PG8_SA(1, 1), a1 + hstep, voffA);
            PG8_WAIT_L(8); PG8_BAR; PG8_WAIT_L(0); PG8_MMA(0, 0, At, B0); PG8_BAR; PG8_SCHED;
            PG8_LDB(B1, 0, 1); PG8_STAGE(PG8_SB(0, 0), b2, voffB);
            PG8_BAR; PG8_WAIT_L(0); PG8_MMA(0, 1, At, B1); PG8_BAR;
            PG8_LDA(At, 0, 1); PG8_STAGE(PG8_SA(0, 0), a2, voffA);
            PG8_BAR; PG8_WAIT_L(0); PG8_MMA(1, 0, At, B0); PG8_BAR; PG8_SCHED;
            PG8_STAGE(PG8_SB(0, 1), b2 + hstep, voffB);
            PG8_WAIT_V(6); PG8_BAR; PG8_MMA(1, 1, At, B1); PG8_BAR;
            PG8_LDB(B0, 1, 0); PG8_SCHED; PG8_LDA(At, 1, 0); PG8_STAGE(PG8_SA(0, 1), a2 + hstep, voffA);
            PG8_WAIT_L(8); PG8_BAR; PG8_WAIT_L(0); PG8_MMA(0, 0, At, B0); PG8_BAR; PG8_SCHED;
            PG8_LDB(B1, 1, 1); PG8_STAGE(PG8_SB(1, 0), b3, voffB);
            PG8_BAR; PG8_WAIT_L(0); PG8_MMA(0, 1, At, B1); PG8_BAR;
            PG8_LDA(At, 1, 1); PG8_STAGE(PG8_SA(1, 0), a3, voffA);
            PG8_BAR; PG8_WAIT_L(0); PG8_MMA(1, 0, At, B0); PG8_BAR; PG8_SCHED;
            PG8_STAGE(PG8_SB(1, 1), b3 + hstep, voffB);
            PG8_WAIT_V(6); PG8_BAR; PG8_MMA(1, 1, At, B1); PG8_BAR;
            }
        }
        if constexpr (ALIGN_EPI) { if (wr == 0) PG8_BAR; }
        E(acc, cur, wr, wc, fr, fq);
        if (!has_next) break;
#pragma unroll
        for (int a = 0; a < 2; ++a)
#pragma unroll
            for (int b = 0; b < 2; ++b)
#pragma unroll
                for (int m = 0; m < 4; ++m)
#pragma unroll
                    for (int n = 0; n < 2; ++n) acc[a][b][m][n] = (f32x4){0.f, 0.f, 0.f, 0.f};
        cur = nxt; cA = nA; cB = nB; ++ui;
        if constexpr (ALIGN_EPI) { if (wr == 1) PG8_BAR; }
    }
    PG8_WAIT_V(0);
    if constexpr (!ALIGN_EPI) { if (wr == 0) PG8_BAR; }
    PG8_BAR;
#undef PG8_SA
#undef PG8_SB
#undef PG8_STAGE
#undef PG8_LDA
#undef PG8_LDB
#undef PG8_MMA
#undef PG8_WAIT_V
#undef PG8_WAIT_L
#undef PG8_BAR
#undef PG8_SCHED
}
}

typedef int i32x4q __attribute__((ext_vector_type(4)));
struct EpiPtrs {
    const GAS float* biasp; const GAS float* lb; const GAS float* x; GAS float* out; GAS unsigned char* ws; int round;
    int pn0;
    const GAS float* sa; const GAS float* sb; const GAS float* sym; const GAS float* syg; const GAS float* sxq;
};
template <int MODE> struct EpiX {
    static constexpr bool PERM = true, AFTER_DRAIN = false;
    EpiPtrs P;
    __device__ __forceinline__ void operator()(const f32x4 (&acc)[2][2][4][2], const pg8::Unit& u, int wr, int wc, int fr, int fq) const {
        const int upn = u.pn + (MODE == 2 ? P.pn0 : 0);
        const int row0 = u.pm * 256 + wr * 64 + fr;
        const int colt = upn * 256 + wc * 32 + 8 * fq;
        GAS unsigned char* ws = P.ws;
        bf16_t* dst = nullptr; int ld = 0, coff = 0, act = 0; const GAS float* bias = nullptr;
        if (MODE == 1 || MODE == 7) {
            bias = P.biasp;
            if (upn < 8) { dst = (bf16_t*)(ws + WS_QKPRE); ld = 2048; coff = 0; act = 0; }
            else if (upn < 16) { dst = (bf16_t*)(ws + WS_V); ld = 2048; coff = 2048; act = 0; }
            else if (upn < 20) { dst = (bf16_t*)(ws + WS_GFLOG); ld = 1024; coff = 4096; act = 3; }
            else if (upn < 24) { dst = (bf16_t*)(ws + WS_GI); ld = 1024; coff = 5120; act = 0; }
            else { dst = (bf16_t*)(ws + WS_GQ); ld = 1024; coff = 6144; act = 2; }
        } else if (MODE == 2) {
            bias = P.biasp + N1;
            if (upn < 8) { dst = (bf16_t*)(ws + WS_SIGO); ld = 2048; coff = 0; act = 1; }
            else if (upn < 12) { dst = (bf16_t*)(ws + WS_SGG); ld = 1024; coff = 2048; act = 2; }
            else if (upn < 16) { dst = (bf16_t*)(ws + WS_SAM); ld = 1024; coff = 3072; act = 1; }
            else { dst = (bf16_t*)(ws + WS_SAG); ld = 1024; coff = 4096; act = 1; }
        } else if (MODE == 6) { dst = (bf16_t*)(ws + WS_QP); ld = 2048; coff = 0; act = 0; }
        float sr8[2][4];
#pragma unroll
        for (int ai = 0; ai < 2; ++ai)
#pragma unroll
            for (int m = 0; m < 4; ++m) { const int row = row0 + ai * 128 + m * 16;
                sr8[ai][m] = (MODE == 3) ? P.sym[row] : (MODE == 4) ? P.syg[row] : (MODE == 6) ? P.sxq[row] : (MODE == 2 || MODE == 7) ? P.sa[(size_t)P.round * RT + row] : 1.0f; }
#pragma unroll
        for (int bj = 0; bj < 2; ++bj) {
            const int col = colt + bj * 128;
            f32x4 b0 = (f32x4){0.f, 0.f, 0.f, 0.f}, b1 = b0, l0 = b0, l1 = b0;
            if (MODE == 1 || MODE == 2 || MODE == 7) { b0 = *(const f32x4*)(bias + col); b1 = *(const f32x4*)(bias + col + 4); }
            f32x4 s0 = (f32x4){1.f, 1.f, 1.f, 1.f}, s1 = s0;
            if (MODE == 2) { s0 = *(const GAS f32x4*)(P.sb + 7168 + col); s1 = *(const GAS f32x4*)(P.sb + 7168 + col + 4); }
            if (MODE == 7) { s0 = *(const GAS f32x4*)(P.sb + col); s1 = *(const GAS f32x4*)(P.sb + col + 4); }
            if (MODE == 3) { s0 = *(const GAS f32x4*)(P.sb + 12288 + col); s1 = *(const GAS f32x4*)(P.sb + 12288 + col + 4); }
            if (MODE == 4) { s0 = *(const GAS f32x4*)(P.sb + 13312 + col); s1 = *(const GAS f32x4*)(P.sb + 13312 + col + 4); }
            if (MODE == 6) { s0 = *(const GAS f32x4*)(P.sb + 14336 + col); s1 = *(const GAS f32x4*)(P.sb + 14336 + col + 4); }
            if (MODE == 1 || MODE == 7) { if (act == 3) { l0 = *(const f32x4*)(P.lb + (col - coff)); l1 = *(const f32x4*)(P.lb + (col - coff) + 4); } }
#pragma unroll
            for (int ai = 0; ai < 2; ++ai) {
                u32x4 gpre[4], zpre[4]; f32x4 xpre[4][2];
#pragma unroll
                for (int m = 0; m < 4; ++m) { const int row = row0 + ai * 128 + m * 16;
                    if (MODE == 3) gpre[m] = *(const GAS u32x4*)((const GAS bf16_t*)(ws + WS_SAM) + (size_t)row * 1024 + col);
                    if (MODE == 4) { gpre[m] = *(const GAS u32x4*)((const GAS bf16_t*)(ws + WS_SAG) + (size_t)row * 1024 + col);
                                     zpre[m] = *(const GAS u32x4*)((const GAS bf16_t*)P.out + (size_t)T * 1024 + ((size_t)P.round * RT + row) * 1024 + col); }
                    if (MODE == 5) { const size_t off = ((size_t)P.round * RT + row) * 1024 + col; xpre[m][0] = *(const GAS f32x4*)(P.x + off); xpre[m][1] = *(const GAS f32x4*)(P.x + off + 4); } }
#pragma unroll
                for (int m = 0; m < 4; ++m) {
                    const int row = row0 + ai * 128 + m * 16;
                    f32x4 v0, v1;
                    if (MODE == 2 || MODE == 7 || MODE == 3 || MODE == 4 || MODE == 6) { const float sr = sr8[ai][m]; const i32x4q q0 = __builtin_bit_cast(i32x4q, acc[ai][bj][m][0]), q1 = __builtin_bit_cast(i32x4q, acc[ai][bj][m][1]);
                        v0 = (f32x4){(float)q0[0], (float)q0[1], (float)q0[2], (float)q0[3]} * (s0 * sr) + b0; v1 = (f32x4){(float)q1[0], (float)q1[1], (float)q1[2], (float)q1[3]} * (s1 * sr) + b1; }
                    else { v0 = acc[ai][bj][m][0] + b0; v1 = acc[ai][bj][m][1] + b1; }
                    if (MODE == 1 || MODE == 2 || MODE == 6 || MODE == 7) {
                        if (act == 1) {
#pragma unroll
                            for (int j = 0; j < 4; ++j) { v0[j] = sigmoidf_(v0[j]); v1[j] = sigmoidf_(v1[j]); }
                        } else if (act == 2) {
#pragma unroll
                            for (int j = 0; j < 4; ++j) { v0[j] = siluf_(v0[j]); v1[j] = siluf_(v1[j]); }
                        } else if (act == 3) {
#pragma unroll
                            for (int j = 0; j < 4; ++j) { v0[j] = __logf(l0[j] + (1.0f - l0[j]) * sigmoidf_(v0[j])); v1[j] = __logf(l1[j] + (1.0f - l1[j]) * sigmoidf_(v1[j])); }
                        }
                        u32x4 w; w.x = pk2(v0[0], v0[1]); w.y = pk2(v0[2], v0[3]); w.z = pk2(v1[0], v1[1]); w.w = pk2(v1[2], v1[3]);
                        *(u32x4*)(dst + (size_t)row * ld + (col - coff)) = w;
                    } else if (MODE == 3) {
                        const u32x4 g = gpre[m];
                        GAS bf16_t* o = (GAS bf16_t*)P.out + (size_t)T * 1024 + ((size_t)P.round * RT + row) * 1024 + col;
                        f32x4 r0, r1;
                        r0[0] = v0[0] * bf_lo(g.x); r0[1] = v0[1] * bf_hi(g.x); r0[2] = v0[2] * bf_lo(g.y); r0[3] = v0[3] * bf_hi(g.y);
                        r1[0] = v1[0] * bf_lo(g.z); r1[1] = v1[1] * bf_hi(g.z); r1[2] = v1[2] * bf_lo(g.w); r1[3] = v1[3] * bf_hi(g.w);
                        u32x4 w; w.x = pk2(r0[0], r0[1]); w.y = pk2(r0[2], r0[3]); w.z = pk2(r1[0], r1[1]); w.w = pk2(r1[2], r1[3]);
                        *(GAS u32x4*)o = w;
                    } else if (MODE == 4) {
                        const u32x4 g = gpre[m], zv = zpre[m];
                        const f32x4 p0 = (f32x4){bf_lo(zv.x), bf_hi(zv.x), bf_lo(zv.y), bf_hi(zv.y)}, p1 = (f32x4){bf_lo(zv.z), bf_hi(zv.z), bf_lo(zv.w), bf_hi(zv.w)};
                        f32x4 r0, r1;
                        r0[0] = p0[0] + v0[0] * bf_lo(g.x); r0[1] = p0[1] + v0[1] * bf_hi(g.x); r0[2] = p0[2] + v0[2] * bf_lo(g.y); r0[3] = p0[3] + v0[3] * bf_hi(g.y);
                        r1[0] = p1[0] + v1[0] * bf_lo(g.z); r1[1] = p1[1] + v1[1] * bf_hi(g.z); r1[2] = p1[2] + v1[2] * bf_lo(g.w); r1[3] = p1[3] + v1[3] * bf_hi(g.w);
                        u32x4 w; w.x = pk2(r0[0], r0[1]); w.y = pk2(r0[2], r0[3]); w.z = pk2(r1[0], r1[1]); w.w = pk2(r1[2], r1[3]);
                        *(u32x4*)((bf16_t*)(ws + WS_GFLOG) + (size_t)row * 1024 + col) = w;
                    } else if (MODE == 5) {
                        const size_t off = ((size_t)P.round * RT + row) * 1024 + col;
                        const f32x4 x0 = xpre[m][0] + v0, x1 = xpre[m][1] + v1;
                        u32x4 w; w.x = pk2(x0[0], x0[1]); w.y = pk2(x0[2], x0[3]); w.z = pk2(x1[0], x1[1]); w.w = pk2(x1[2], x1[3]);
                        *(GAS u32x4*)((GAS bf16_t*)P.out + off) = w;
                    }
                }
            }
        }
    }
};

__device__ __forceinline__ void p0_transpose_item(const GAS float* W, int ldw, int K, int k0, int scol, GAS bf16_t* WT, int drow, LAS float* scr, int lane) {
#pragma unroll 8
    for (int i = 0; i < 32; ++i) { const int kk = 2 * i + (lane >> 5); scr[kk * 33 + (lane & 31)] = W[(size_t)(k0 + kk) * ldw + scol + (lane & 31)]; }
    LDS_WAIT(); asm volatile("" ::: "memory");
    const int c = lane & 7;
#pragma unroll
    for (int j = 0; j < 4; ++j) { const int n = (lane >> 3) + 8 * j; const LAS float* s = scr + (8 * c) * 33 + n;
        u32x4 o; o.x = pk2(s[0 * 33], s[1 * 33]); o.y = pk2(s[2 * 33], s[3 * 33]); o.z = pk2(s[4 * 33], s[5 * 33]); o.w = pk2(s[6 * 33], s[7 * 33]);
        *(u32x4*)(WT + (size_t)(drow + n) * K + k0 + 8 * c) = o; }
    LDS_WAIT(); asm volatile("" ::: "memory");
}
__device__ __forceinline__ void p0_colmax_item(const GAS float* W, int ldw, int k0, int scol, GAS unsigned* colmax, int lane) {
    float mx = 0.f;
#pragma unroll 8
    for (int i = 0; i < 32; ++i) { const int kk = 2 * i + (lane >> 5); mx = fmaxf(mx, fabsf(W[(size_t)(k0 + kk) * ldw + scol + (lane & 31)])); }
    mx = fmaxf(mx, __builtin_bit_cast(float, xor32u_(__builtin_bit_cast(unsigned, mx), lane >= 32)));
    if (lane < 32) atomicMax((unsigned*)colmax + lane, __builtin_bit_cast(unsigned, mx));
}
__device__ __forceinline__ void p0_cvt8_item(const GAS float* W, int ldw, int k0, int scol, const GAS unsigned* colmax, GAS unsigned char* WT8, int pitch, GAS float* sb, int drow, LAS float* scr, int lane) {
    const float cm = __builtin_bit_cast(float, colmax[lane & 31]);
    const float qs = cm > 0.f ? 127.0f / cm : 0.f;
    if (k0 == 0 && lane < 32) sb[lane] = cm * (1.0f / 127.0f);
#pragma unroll 8
    for (int i = 0; i < 32; ++i) { const int kk = 2 * i + (lane >> 5); scr[kk * 33 + (lane & 31)] = W[(size_t)(k0 + kk) * ldw + scol + (lane & 31)] * qs; }
    LDS_WAIT(); asm volatile("" ::: "memory");
    const int n = lane >> 1, kh = lane & 1;
    const LAS float* sp = scr + (kh * 32) * 33 + n;
    u32x4 o0, o1;
#pragma unroll
    for (int q = 0; q < 8; ++q) { const unsigned p = pack_i8x4(sp[(4 * q) * 33], sp[(4 * q + 1) * 33], sp[(4 * q + 2) * 33], sp[(4 * q + 3) * 33]);
        if (q < 4) o0[q] = p; else o1[q - 4] = p; }
    GAS unsigned char* dst = WT8 + (size_t)(drow + n) * pitch + k0 + kh * 32;
    *(GAS u32x4*)dst = o0; *(GAS u32x4*)(dst + 16) = o1;
    LDS_WAIT(); asm volatile("" ::: "memory");
}
__device__ __forceinline__ int win_src_col(int n) {
    if (n < 4096) return n;
    if (n < 7168) return n - 4096 + 6152;
    if (n < 9216) return n - 7168 + 4096;
    return n - 9216 + 9224;
}

__device__ __forceinline__ void phase_p0(const DArgs& a, LAS unsigned char* lds, int vcu, int G) {
    const int tid = tid_(), lane = tid & 63, wave = tid >> 6;
    const int gw = vcu * NWAVES + wave, NGW = G * NWAVES;
    GAS unsigned char* ws = a.ws;
    LAS float* scr = (LAS float*)(lds + wave * 16384);
    constexpr int I_IN = 16 * 384, I_M = 32 * 32, I_G = 16 * 32, I_O = 16 * 32, I_PQ = 16 * 64;
    constexpr int NITEMS = I_IN + I_M + I_G + I_O + I_PQ;
    for (int it = gw; it < NITEMS; it += NGW) {
        int r = it;
        if (r < I_IN) { const int kb = r / 384, nb = r % 384;
            p0_colmax_item(a.w_in, IN_COLS, kb * 64, win_src_col(nb * 32), (GAS unsigned*)(ws + WS_CTL) + CW_COLMAX + nb * 32, lane);
            continue; } r -= I_IN;
        if (r < I_M) { const int kb = r / 32, nb = r % 32; p0_colmax_item(a.w_br_m, 1024, kb * 64, nb * 32, (GAS unsigned*)(ws + WS_CTL) + CW_COLMAX + 12288 + nb * 32, lane); continue; } r -= I_M;
        if (r < I_G) { const int kb = r / 32, nb = r % 32; p0_colmax_item(a.w_br_g, 1024, kb * 64, nb * 32, (GAS unsigned*)(ws + WS_CTL) + CW_COLMAX + 13312 + nb * 32, lane); continue; } r -= I_G;
        if (r < I_O) { const int kb = r / 32, nb = r % 32; p0_transpose_item(a.w_out, 1024, 1024, kb * 64, nb * 32, (GAS bf16_t*)(ws + WS_WO), nb * 32, scr, lane); continue; } r -= I_O;
        { const int kb = r / 64, nb = r % 64; p0_colmax_item(a.w_pq, 2048, kb * 64, nb * 32, (GAS unsigned*)(ws + WS_CTL) + CW_COLMAX + 14336 + nb * 32, lane); }
    }
    const int gt = vcu * NTHR + tid, NGT = G * NTHR;
    for (int i = gt; i < NP; i += NGT) ((float*)(ws + WS_BIASP))[i] = a.b_in[win_src_col(i)];
    for (int i = gt; i < 1024; i += NGT) { const float t0 = a.lb_table[i], t1 = a.lb_table[1024 + i]; ((float*)(ws + WS_LB))[i] = 1.0f / (1.0f + __expf(t1 - t0)); }
    for (int i = gt; i < 8 * 2 * 128 * 128 / 4; i += NGT) { const f32x4 v = ((const f32x4*)a.sub_keys)[i]; u32x2 o; o.x = pk2(v[0], v[1]); o.y = pk2(v[2], v[3]); ((u32x2*)(ws + WS_SK))[i] = o; }
    f32x4 g1[4];
#pragma unroll
    for (int j = 0; j < 4; ++j) g1[j] = ((const GAS f32x4*)a.norm1_g)[64 * j + lane];
    f32x4 gw0[16], gw1[16];
#pragma unroll
    for (int j = 0; j < 4; ++j)
#pragma unroll
        for (int e = 0; e < 4; ++e) { const int k = 256 * j + 4 * lane + e; gw0[4 * j + e] = *(const GAS f32x4*)(a.w_in + (size_t)k * IN_COLS + 6144); gw1[4 * j + e] = *(const GAS f32x4*)(a.w_in + (size_t)k * IN_COLS + 6148); }
    const float gbias = lane < 8 ? a.b_in[6144 + lane] : 0.f;
    for (int m = gw; m < T; m += NGW) {
        const GAS f32x4* xr = (const GAS f32x4*)(a.x + (size_t)m * D) + lane;
        f32x4 v[4]; float s = 0.f;
#pragma unroll
        for (int j = 0; j < 4; ++j) { v[j] = xr[64 * j]; s += (v[j][0] * v[j][0] + v[j][1] * v[j][1]) + (v[j][2] * v[j][2] + v[j][3] * v[j][3]); }
        const float rstd = rsqrtf(wave_sum(s, lane) * (1.f / D) + EPS);
        f32x4 ga0 = (f32x4){0.f, 0.f, 0.f, 0.f}, ga1 = ga0;
        float mx = 0.f;
#pragma unroll
        for (int j = 0; j < 4; ++j) {
            v[j] = v[j] * rstd * g1[j];
            mx = fmaxf(mx, fmaxf(fmaxf(fabsf(v[j][0]), fabsf(v[j][1])), fmaxf(fabsf(v[j][2]), fabsf(v[j][3]))));
#pragma unroll
            for (int e = 0; e < 4; ++e) { ga0 += gw0[4 * j + e] * v[j][e]; ga1 += gw1[4 * j + e] * v[j][e]; }
        }
        {
            mx = wave_max(mx);
            const float qs = mx > 0.f ? 127.0f / mx : 0.f;
#pragma unroll
            for (int jq = 0; jq < 4; ++jq) ((GAS unsigned*)(ws + WS_XN8 + (size_t)m * 1024))[64 * jq + lane] = pack_i8x4(v[jq][0] * qs, v[jq][1] * qs, v[jq][2] * qs, v[jq][3] * qs);
            if (lane == 0) ((GAS float*)(ws + WS_SA8))[m] = mx * (1.0f / 127.0f);
        }
        float ga[8] = {ga0[0], ga0[1], ga0[2], ga0[3], ga1[0], ga1[1], ga1[2], ga1[3]};
#pragma unroll
        for (int q = 0; q < 8; ++q) ga[q] = wave_sum(ga[q], lane);
        if (lane < 8) { float r = ga[0];
#pragma unroll
            for (int q = 1; q < 8; ++q) r = (lane == q) ? ga[q] : r;
            ((GAS float*)(ws + WS_GATES))[(size_t)m * 8 + lane] = r + gbias; }
    }
}

__device__ __forceinline__ float logsigf_(float x) { return fminf(x, 0.f) - log1pf(__expf(-fabsf(x))); }
#define LDS_BAR() do { asm volatile("s_waitcnt lgkmcnt(0)" ::: "memory"); __builtin_amdgcn_s_barrier(); asm volatile("" ::: "memory"); } while (0)
#define MFMA16(a, b, c) __builtin_amdgcn_mfma_f32_16x16x32_bf16((a), (b), (c), 0, 0, 0)
__device__ __forceinline__ bf16x8 lfrag(const LAS unsigned char* base, int pitch, int row, int k0, int fq) { return *(const LAS bf16x8*)(base + row * pitch + (k0 + 8 * fq) * 2); }
__device__ __forceinline__ int fm_off(int r, int k, int KB) { return (((r >> 4) * KB + (k >> 5)) << 10) + (((((k >> 3) & 3) << 4) + (r & 15)) << 4) + ((k & 7) << 1); }
__device__ __forceinline__ bf16x8 gfrag(const bf16_t* base, int ld, int row, int k0, int fq) { return *(const bf16x8*)(base + (size_t)row * ld + k0 + 8 * fq); }

__device__ __forceinline__ void phase_p0c(const DArgs& a, LAS unsigned char* lds, int vcu, int G) {
    const int tid = tid_(), lane = tid & 63, wave = tid >> 6;
    const int gw = vcu * NWAVES + wave, NGW = G * NWAVES;
    GAS unsigned char* ws = a.ws;
    LAS float* scr = (LAS float*)(lds + wave * 16384);
    constexpr int J_IN = 16 * 384, J_M = 32 * 32, J_G = 16 * 32, J_PQ = 16 * 64;
    const GAS unsigned* cmx = (const GAS unsigned*)(ws + WS_CTL) + CW_COLMAX; GAS float* sb = (GAS float*)(ws + WS_SB8);
    for (int it = gw; it < J_IN + J_M + J_G + J_PQ; it += NGW) {
        int r = it;
        if (r < J_IN) { const int kb = r / 384, nb = r % 384;
            p0_cvt8_item(a.w_in, IN_COLS, kb * 64, win_src_col(nb * 32), cmx + nb * 32, ws + WS_W8A, 1024, sb + nb * 32, nb * 32, scr, lane); continue; } r -= J_IN;
        if (r < J_M) { const int kb = r / 32, nb = r % 32; p0_cvt8_item(a.w_br_m, 1024, kb * 64, nb * 32, cmx + 12288 + nb * 32, ws + WS_WM, 2048, sb + 12288 + nb * 32, nb * 32, scr, lane); continue; } r -= J_M;
        if (r < J_G) { const int kb = r / 32, nb = r % 32; p0_cvt8_item(a.w_br_g, 1024, kb * 64, nb * 32, cmx + 13312 + nb * 32, ws + WS_WG, 1024, sb + 13312 + nb * 32, nb * 32, scr, lane); continue; } r -= J_G;
        { const int kb = r / 64, nb = r % 64; p0_cvt8_item(a.w_pq, 2048, kb * 64, nb * 32, cmx + 14336 + nb * 32, ws + WS_WPQ, 1024, sb + 14336 + nb * 32, nb * 32, scr, lane); }
    }
}
__device__ __forceinline__ void mscan_pair(const DArgs& a, LAS unsigned char* lds, int round, int p) {
    const int tid = tid_(), lane = tid & 63, part = tid >> 6;
    const int bl = p >> 2, h = p & 3, b = round * 2 + bl;
    const GAS float* g = (const GAS float*)(a.ws + WS_GATES) + ((size_t)b * SEQ + (size_t)lane * 128 + part * 16) * 8;
    float bsum = 0.f, gm = -INFINITY;
#pragma unroll 4
    for (int s = 0; s < 16; ++s) { const float ip = g[s * 8 + h], fp = g[s * 8 + 4 + h]; bsum += logsigf_(fp); gm = fmaxf(gm, ip - bsum); }
    LAS float* PS = (LAS float*)lds; LAS float* PM = PS + 512;
    PS[part * 64 + lane] = bsum; PM[part * 64 + lane] = gm;
    __syncthreads();
    if (tid < 64) {
        float bs = 0.f, g2 = -INFINITY;
#pragma unroll
        for (int q = 0; q < 8; ++q) { g2 = fmaxf(g2, PM[q * 64 + lane] - bs); bs += PS[q * 64 + lane]; }
        float mprev = 0.f, mine = 0.f;
        for (int c = 0; c < 64; ++c) {
            const float bc = rdlane(bs, c), gc = rdlane(g2, c);
            if (lane == c) mine = mprev; mprev = bc + fmaxf(mprev, gc); }
        ((GAS float*)(a.ws + WS_MPREV))[(round * 8 + p) * 64 + lane] = mine;
    }
    __syncthreads();
}

constexpr int PQ_PITCH = 528, PS_PITCH = 272;
__device__ __forceinline__ void mlstm_pre_item(const DArgs& a, LAS unsigned char* lds, int round, int item) {
    const int tid = tid_(), lane = tid & 63, wave = __builtin_amdgcn_readfirstlane(tid >> 6), fr = lane & 15, fq = lane >> 4;
    const int p = item >> 6, c = item & 63, bl = p >> 2, h = p & 3, b = round * 2 + bl;
    const int tl0 = bl * SEQ + c * 128; const size_t tg0 = (size_t)b * SEQ + c * 128;
    GAS unsigned char* ws = a.ws;
    LAS unsigned char* QL = lds; LAS unsigned char* KL = lds + 67584;
    LAS float* AS = (LAS float*)(lds + 135168); LAS float* MS = AS + 128; LAS float* SC = AS + 256;
    if (wave == 0) {
        const float mprev = ((const float*)(ws + WS_MPREV))[(round * 8 + p) * 64 + c];
        const float* g = (const float*)(ws + WS_GATES) + (tg0 + 2 * lane) * 8;
        const float ip0 = g[h], fp0 = g[4 + h], ip1 = g[8 + h], fp1 = g[12 + h];
        const float lf0 = logsigf_(fp0), lf1 = logsigf_(fp1), pp = lf0 + lf1;
        float incl = pp;
#pragma unroll
        for (int o = 1; o < 64; o <<= 1) { const float t = shup(incl, o, lane); if (lane >= o) incl += t; }
        const float excl = incl - pp, b0 = excl + lf0, b1 = incl;
        const float a0 = ip0 - b0, a1 = ip1 - b1;
        float inclm = fmaxf(a0, a1);
#pragma unroll
        for (int o = 1; o < 64; o <<= 1) { const float t = shup(inclm, o, lane); if (lane >= o) inclm = fmaxf(inclm, t); }
        float exclm = shup(inclm, 1, lane); if (lane == 0) exclm = -INFINITY;
        const float M0 = fmaxf(mprev, fmaxf(exclm, a0)), M1 = fmaxf(mprev, inclm);
        AS[2 * lane] = a0; AS[2 * lane + 1] = a1; MS[2 * lane] = M0; MS[2 * lane + 1] = M1;
        float* mt = (float*)(ws + WS_MT) + (tg0 + 2 * lane) * 4 + h;
        mt[0] = b0 + M0; mt[4] = b1 + M1;
        const float Mlast = rdlane(M1, 63);
        if (lane == 0) { SC[0] = mprev; SC[1] = Mlast; ((float*)(ws + WS_MDEC))[item] = __expf(mprev - Mlast); }
    }
    {
        const int cgp = tid & 63, strip = tid >> 6;
        const int col = (cgp < 32) ? (h * 256 + cgp * 8) : (1024 + h * 256 + (cgp - 32) * 8);
        float w[4][8], bb[8];
#pragma unroll
        for (int j = 0; j < 4; ++j) { const f32x4 w0 = *(const f32x4*)(a.conv_w + j * 2048 + col), w1 = *(const f32x4*)(a.conv_w + j * 2048 + col + 4);
#pragma unroll
            for (int e = 0; e < 4; ++e) { w[j][e] = w0[e]; w[j][4 + e] = w1[e]; } }
        { const f32x4 b0 = *(const f32x4*)(a.conv_b + col), b1 = *(const f32x4*)(a.conv_b + col + 4);
#pragma unroll
            for (int e = 0; e < 4; ++e) { bb[e] = b0[e]; bb[4 + e] = b1[e]; } }
        const bf16_t* src = (const bf16_t*)(ws + WS_QKPRE) + (size_t)(tl0 + 16 * strip) * 2048 + col;
        const float qs = (cgp < 32) ? 0.0625f : 1.0f;
        LAS unsigned char* dstt = ((cgp < 32) ? QL : KL) + (cgp & 31) * 16;
#pragma unroll 1
        for (int half = 0; half < 2; ++half) {
            u32x4 xr[11];
#pragma unroll
            for (int r = 0; r < 11; ++r) {
                const int sl = c * 128 + 16 * strip + 8 * half + r - 3;
                xr[r] = (sl >= 0) ? *(const u32x4*)(src + (ptrdiff_t)(8 * half + r - 3) * 2048) : (u32x4){0u, 0u, 0u, 0u};
            }
#pragma unroll
            for (int r = 0; r < 8; ++r) {
                float y[8];
#pragma unroll
                for (int e = 0; e < 8; ++e) y[e] = bb[e];
#pragma unroll
                for (int j = 0; j < 4; ++j) { const u32x4 xv = xr[r + j];
                    y[0] += w[j][0] * bf_lo(xv.x); y[1] += w[j][1] * bf_hi(xv.x); y[2] += w[j][2] * bf_lo(xv.y); y[3] += w[j][3] * bf_hi(xv.y);
                    y[4] += w[j][4] * bf_lo(xv.z); y[5] += w[j][5] * bf_hi(xv.z); y[6] += w[j][6] * bf_lo(xv.w); y[7] += w[j][7] * bf_hi(xv.w); }
#pragma unroll
                for (int e = 0; e < 8; ++e) y[e] = siluf_(y[e]) * qs;
                u32x4 o; o.x = pk2(y[0], y[1]); o.y = pk2(y[2], y[3]); o.z = pk2(y[4], y[5]); o.w = pk2(y[6], y[7]);
                *(LAS u32x4*)(dstt + (16 * strip + 8 * half + r) * PQ_PITCH) = o;
            }
        }
    }
    __syncthreads();
    const float mprev = SC[0], Mlast = SC[1];
    {
        bf16_t* Sg = (bf16_t*)(ws + WS_S) + (size_t)item * 128 * 128;
        const int t = wave * 16 + fr; const float Mt = MS[t];
        for (int st = 0; st < 8; ++st) {
            u32x2 o = (u32x2){0u, 0u};
            if (st <= wave) {
                f32x4 acc = (f32x4){0.f, 0.f, 0.f, 0.f};
#pragma unroll
                for (int ks = 0; ks < 8; ++ks) acc = MFMA16(lfrag(KL, PQ_PITCH, st * 16 + fr, ks * 32, fq), lfrag(QL, PQ_PITCH, wave * 16 + fr, ks * 32, fq), acc);
                float v[4];
#pragma unroll
                for (int j = 0; j < 4; ++j) { const int s = st * 16 + 4 * fq + j; v[j] = (s <= t) ? acc[j] * __expf(AS[s] - Mt) : 0.f; }
                o.x = pk2(v[0], v[1]); o.y = pk2(v[2], v[3]);
            }
            *(u32x2*)((unsigned char*)Sg + fm_off(t, st * 16 + 4 * fq, 4)) = o;
        }
    }
    {
        bf16_t* Qg = (bf16_t*)(ws + WS_QT) + (size_t)item * 128 * 256;
#pragma unroll
        for (int i = 0; i < 8; ++i) { const int idx = tid + 512 * i, blk = idx >> 6, t = (blk >> 3) * 16 + (idx & 15), ch = (blk & 7) * 4 + ((idx >> 4) & 3);
            const u32x4 v = *(const LAS u32x4*)(QL + t * PQ_PITCH + ch * 16); const float s = __expf(mprev - MS[t]);
            u32x4 o; o.x = pk2(bf_lo(v.x) * s, bf_hi(v.x) * s); o.y = pk2(bf_lo(v.y) * s, bf_hi(v.y) * s); o.z = pk2(bf_lo(v.z) * s, bf_hi(v.z) * s); o.w = pk2(bf_lo(v.w) * s, bf_hi(v.w) * s);
            *(u32x4*)((unsigned char*)Qg + fm_off(t, ch * 8, 8)) = o; }
    }
    {
        bf16_t* Kg = (bf16_t*)(ws + WS_KWT) + (size_t)item * 256 * 128;
        const int dlo = lane & 15, sglo = lane >> 4;
#pragma unroll
        for (int i = 0; i < 8; ++i) { const int combo = wave * 8 + i, d = (combo >> 2) * 16 + dlo, s0 = ((combo & 3) * 4 + sglo) * 8;
            float v[8];
#pragma unroll
            for (int e = 0; e < 8; ++e) v[e] = bf2f(*(const LAS bf16_t*)(KL + (s0 + e) * PQ_PITCH + d * 2)) * __expf(AS[s0 + e] - Mlast);
            u32x4 o; o.x = pk2(v[0], v[1]); o.y = pk2(v[2], v[3]); o.z = pk2(v[4], v[5]); o.w = pk2(v[6], v[7]);
            *(u32x4*)((unsigned char*)Kg + fm_off(d, s0, 4)) = o; }
    }
    __syncthreads();
}

__device__ __forceinline__ void hgrn_pre_load(const DArgs& a, int round, int item, u32x4 (&gq)[4]) {
    const int tid = tid_();
    const int p = item >> 7, c = item & 127, bl = p >> 3, h = p & 7;
    const int tl0 = bl * SEQ + c * 64;
    GAS unsigned char* ws = a.ws;
#pragma unroll
    for (int i = 0; i < 2; ++i) { const int idx = tid + 512 * i, s = idx >> 4, ch = idx & 15;
        gq[2 * i] = *(const GAS u32x4*)((const GAS bf16_t*)(ws + WS_GFLOG) + (size_t)(tl0 + s) * 1024 + h * 128 + ch * 8);
        gq[2 * i + 1] = *(const GAS u32x4*)((const GAS bf16_t*)(ws + WS_GQ) + (size_t)(tl0 + s) * 1024 + h * 128 + ch * 8); }
}
__device__ __forceinline__ void hgrn_pre_item(const DArgs& a, LAS unsigned char* lds, int round, int item, u32x4 (&gq)[4], int next_item) {
    const int tid = tid_(), lane = tid & 63, wave = __builtin_amdgcn_readfirstlane(tid >> 6), fr = lane & 15, fq = lane >> 4;
    const int p = item >> 7, c = item & 127, bl = p >> 3, h = p & 7;
    const int tl0 = bl * SEQ + c * 64;
    GAS unsigned char* ws = a.ws;
    LAS float* CUM = (LAS float*)lds;
    LAS float* GL = (LAS float*)(lds + 32768);
    LAS unsigned char* QH = lds + 65536;
    LAS unsigned char* KE = lds + 65536 + 64 * PS_PITCH;
    LAS float* QF = (LAS float*)(lds + 65536 + 128 * PS_PITCH);
#pragma unroll
    for (int i = 0; i < 2; ++i) { const int idx = tid + 512 * i, s = idx >> 4, ch = idx & 15;
        const u32x4 gv = gq[2 * i], qv = gq[2 * i + 1];
        LAS float* gd = GL + s * 128 + ch * 8; LAS float* qd = QF + s * 128 + ch * 8;
        gd[0] = bf_lo(gv.x); gd[1] = bf_hi(gv.x); gd[2] = bf_lo(gv.y); gd[3] = bf_hi(gv.y); gd[4] = bf_lo(gv.z); gd[5] = bf_hi(gv.z); gd[6] = bf_lo(gv.w); gd[7] = bf_hi(gv.w);
        qd[0] = bf_lo(qv.x); qd[1] = bf_hi(qv.x); qd[2] = bf_lo(qv.y); qd[3] = bf_hi(qv.y); qd[4] = bf_lo(qv.z); qd[5] = bf_hi(qv.z); qd[6] = bf_lo(qv.w); qd[7] = bf_hi(qv.w); }
    if (next_item < 2048) hgrn_pre_load(a, round, next_item, gq);
    LDS_BAR();
    {
        const int d = tid & 127, qt = tid >> 7; float cs = 0.f;
#pragma unroll 4
        for (int s = 0; s < 16; ++s) { cs += GL[(qt * 16 + s) * 128 + d]; CUM[(qt * 16 + s) * 128 + d] = cs; }
        LDS_BAR();
        float off = 0.f;
#pragma unroll
        for (int q = 0; q < 3; ++q) off += (q < qt) ? CUM[(q * 16 + 15) * 128 + d] : 0.f;
        LDS_BAR();
#pragma unroll 4
        for (int s = 0; s < 16; ++s) CUM[(qt * 16 + s) * 128 + d] += off;
        if (qt == 3) ((GAS float*)(ws + WS_HGDEC))[(size_t)item * 128 + d] = __expf(cs + off);
    }
    LDS_BAR();
    {
        bf16_t* Qg = (bf16_t*)(ws + WS_QTG) + (size_t)item * 64 * 128;
#pragma unroll
        for (int i = 0; i < 2; ++i) { const int idx = tid + 512 * i, s = idx >> 4, ch = idx & 15;
            float qt[8], qh[8], ke[8];
#pragma unroll
            for (int e = 0; e < 8; ++e) { const int d = ch * 8 + e; const float cm = CUM[s * 128 + d], last = CUM[63 * 128 + d], q = QF[s * 128 + d], g = GL[s * 128 + d];
                qt[e] = q * __expf(cm); qh[e] = q * __expf(cm - last); ke[e] = (1.0f - __expf(g)) * __expf(last - cm); }
            u32x4 o; o.x = pk2(qt[0], qt[1]); o.y = pk2(qt[2], qt[3]); o.z = pk2(qt[4], qt[5]); o.w = pk2(qt[6], qt[7]);
            *(u32x4*)((unsigned char*)Qg + fm_off(s, ch * 8, 4)) = o;
            o.x = pk2(qh[0], qh[1]); o.y = pk2(qh[2], qh[3]); o.z = pk2(qh[4], qh[5]); o.w = pk2(qh[6], qh[7]);
            *(LAS u32x4*)(QH + s * PS_PITCH + ch * 16) = o;
            o.x = pk2(ke[0], ke[1]); o.y = pk2(ke[2], ke[3]); o.z = pk2(ke[4], ke[5]); o.w = pk2(ke[6], ke[7]);
            *(LAS u32x4*)(KE + s * PS_PITCH + ch * 16) = o; }
    }
    LDS_BAR();
    {
        bf16_t* Ag = (bf16_t*)(ws + WS_ATT) + (size_t)item * 64 * 64;
#pragma unroll
        for (int i = 0; i < 2; ++i) { const int tile = wave * 2 + i, tt = tile >> 2, st = tile & 3; const int t = tt * 16 + fr;
            u32x2 o = (u32x2){0u, 0u};
            if (st <= tt) { f32x4 acc = (f32x4){0.f, 0.f, 0.f, 0.f};
#pragma unroll
                for (int ks = 0; ks < 4; ++ks) acc = MFMA16(lfrag(KE, PS_PITCH, st * 16 + fr, ks * 32, fq), lfrag(QH, PS_PITCH, tt * 16 + fr, ks * 32, fq), acc);
                float v[4];
#pragma unroll
                for (int j = 0; j < 4; ++j) { const int s = st * 16 + 4 * fq + j; v[j] = (s <= t) ? acc[j] : 0.f; }
                o.x = pk2(v[0], v[1]); o.y = pk2(v[2], v[3]); }
            *(u32x2*)((unsigned char*)Ag + fm_off(t, st * 16 + 4 * fq, 2)) = o; }
    }
    {
        bf16_t* Kg = (bf16_t*)(ws + WS_KENDT) + (size_t)item * 128 * 64;
        const int dlo = lane & 15, sglo = lane >> 4;
#pragma unroll
        for (int i = 0; i < 2; ++i) { const int combo = wave * 2 + i, d = (combo >> 1) * 16 + dlo, s0 = ((combo & 1) * 4 + sglo) * 8;
            unsigned v[8];
#pragma unroll
            for (int e = 0; e < 8; ++e) v[e] = *(const LAS bf16_t*)(KE + (s0 + e) * PS_PITCH + d * 2);
            u32x4 o; o.x = v[0] | (v[1] << 16); o.y = v[2] | (v[3] << 16); o.z = v[4] | (v[5] << 16); o.w = v[6] | (v[7] << 16);
            *(u32x4*)((unsigned char*)Kg + fm_off(d, s0, 2)) = o; }
    }
    LDS_BAR();
}

template <int NVT, bool DEN>
__device__ __forceinline__ void mlstm_scan(const DArgs& a, LAS unsigned char* lds, int round, int p, int sl) {
    const int tid = tid_(), lane = tid & 63, wave = __builtin_amdgcn_readfirstlane(tid >> 6), fr = lane & 15, fq = lane >> 4;
    const int bl = p >> 2, h = p & 3, b = round * 2 + bl;
    GAS unsigned char* ws = a.ws;
    constexpr int VTB = NVT * 16 * PS_PITCH, CTB = NVT * 16 * PQ_PITCH;
    LAS unsigned char* VT = lds; LAS unsigned char* CT = lds + 2 * VTB; LAS float* DEC = (LAS float*)(lds + 2 * VTB + 2 * CTB);
    for (int i = tid; i < (2 * VTB + 2 * CTB) / 4; i += NTHR) ((LAS unsigned*)lds)[i] = 0u;
    if (tid < 64) DEC[tid] = ((const GAS float*)(ws + WS_MDEC))[p * 64 + tid];
    __syncthreads();
    if (DEN) { if (tid < 256) { const int bufi = tid >> 7, s = tid & 127; *(LAS bf16_t*)(VT + bufi * VTB + s * 2) = (bf16_t)0x3F80; } }
    f32x4 st[2][NVT];
#pragma unroll
    for (int dt = 0; dt < 2; ++dt)
#pragma unroll
        for (int vt = 0; vt < NVT; ++vt) st[dt][vt] = (f32x4){0.f, 0.f, 0.f, 0.f};
    const int vcol = h * 512 + sl * 32;
    const int vs = tid >> 2, vpart = tid & 3;
    const GAS unsigned char* Sg0 = ws + WS_S + (size_t)(p * 64) * 32768 + wave * 4096 + lane * 16;
    const GAS unsigned char* Qg0 = ws + WS_QT + (size_t)(p * 64) * 65536 + wave * 8192 + lane * 16;
    const GAS unsigned char* Kg0 = ws + WS_KWT + (size_t)(p * 64) * 65536 + wave * 8192 + lane * 16;
    const GAS bf16_t* Vg0 = (const GAS bf16_t*)(ws + WS_V) + (size_t)(bl * SEQ + vs) * 2048 + vcol + vpart * 8;
    bf16x8 bS[4], bQ[8], aK[2][4]; u32x4 vreg = (u32x4){0u, 0u, 0u, 0u};
#define V_STAGE(cc_) do { LAS unsigned char* d0_ = VT + ((cc_) & 1) * VTB + (vpart * 8) * PS_PITCH + vs * 2; \
        *(LAS bf16_t*)(d0_ + 0 * PS_PITCH) = (bf16_t)(vreg.x & 0xffffu); *(LAS bf16_t*)(d0_ + 1 * PS_PITCH) = (bf16_t)(vreg.x >> 16); \
        *(LAS bf16_t*)(d0_ + 2 * PS_PITCH) = (bf16_t)(vreg.y & 0xffffu); *(LAS bf16_t*)(d0_ + 3 * PS_PITCH) = (bf16_t)(vreg.y >> 16); \
        *(LAS bf16_t*)(d0_ + 4 * PS_PITCH) = (bf16_t)(vreg.z & 0xffffu); *(LAS bf16_t*)(d0_ + 5 * PS_PITCH) = (bf16_t)(vreg.z >> 16); \
        *(LAS bf16_t*)(d0_ + 6 * PS_PITCH) = (bf16_t)(vreg.w & 0xffffu); *(LAS bf16_t*)(d0_ + 7 * PS_PITCH) = (bf16_t)(vreg.w >> 16); } while (0)
    if (!DEN) { vreg = *(const GAS u32x4*)Vg0; V_STAGE(0); }
    __builtin_amdgcn_sched_barrier(0);
#pragma unroll
    for (int ks = 0; ks < 4; ++ks)
#pragma unroll
        for (int dt = 0; dt < 2; ++dt) aK[dt][ks] = *(const GAS bf16x8*)(Kg0 + (dt * 4 + ks) * 1024);
    __builtin_amdgcn_sched_barrier(0);
#pragma unroll
    for (int ks = 0; ks < 4; ++ks) bS[ks] = *(const GAS bf16x8*)(Sg0 + ks * 1024);
    __builtin_amdgcn_sched_barrier(0);
#pragma unroll
    for (int ks = 0; ks < 8; ++ks) bQ[ks] = *(const GAS bf16x8*)(Qg0 + ks * 1024);
    __builtin_amdgcn_sched_barrier(0);
    if (!DEN) vreg = *(const GAS u32x4*)(Vg0 + (size_t)128 * 2048);
    __builtin_amdgcn_sched_barrier(0);
    const GAS unsigned char* pfp; unsigned pfstride;
    { const int tt = (wave * 64 + lane) < 160 ? wave * 64 + lane : 159; const int idx = sl * 10 + (tt >> 4), off = (tt & 15) * 64;
      pfp = (idx < 32 ? ws + WS_S + (size_t)(p * 64) * 32768 + idx * 1024 : idx < 96 ? ws + WS_QT + (size_t)(p * 64) * 65536 + (idx - 32) * 1024 : ws + WS_KWT + (size_t)(p * 64) * 65536 + (idx - 96) * 1024) + off;
      pfstride = idx < 32 ? 32768u : 65536u; }
    unsigned pfv = 0u;
#pragma unroll 1
    for (int c = 0; c < 64; ++c) {
        const int tl0 = bl * SEQ + c * 128; const size_t tg0 = (size_t)b * SEQ + c * 128;
        const int cn = c < 63 ? c + 1 : 63, cn2 = c < 62 ? c + 2 : 63;
        LAS unsigned char* vt_ = VT + (c & 1) * VTB; LAS unsigned char* ct_ = CT + (c & 1) * CTB; LAS unsigned char* ctn = CT + ((c + 1) & 1) * CTB;
        LDS_BAR();
        if (!DEN && wave < 3) { asm volatile("" :: "v"(pfv)); const int c3 = c < 60 ? c + 3 : 63; pfv = *(const GAS unsigned*)(pfp + (size_t)c3 * pfstride); }
        bf16x8 vf[NVT][4], cf[NVT][4];
#pragma unroll
        for (int vt = 0; vt < NVT; ++vt)
#pragma unroll
            for (int ks = 0; ks < 4; ++ks) vf[vt][ks] = lfrag(vt_, PS_PITCH, vt * 16 + fr, ks * 32, fq);
        const float dec = DEC[c];
        __builtin_amdgcn_sched_barrier(0);
#pragma unroll
        for (int dt = 0; dt < 2; ++dt)
#pragma unroll
            for (int vt = 0; vt < NVT; ++vt) st[dt][vt] = st[dt][vt] * dec;
#pragma unroll
        for (int ks = 0; ks < 4; ++ks) {
#pragma unroll
            for (int vt = 0; vt < NVT; ++vt) cf[vt][ks] = lfrag(ct_, PQ_PITCH, vt * 16 + fr, ks * 32, fq);
#pragma unroll
            for (int dt = 0; dt < 2; ++dt) {
#pragma unroll
                for (int vt = 0; vt < NVT; ++vt) st[dt][vt] = MFMA16(aK[dt][ks], vf[vt][ks], st[dt][vt]);
                aK[dt][ks] = *(const GAS bf16x8*)(Kg0 + (size_t)cn * 65536 + (dt * 4 + ks) * 1024);
            }
            __builtin_amdgcn_sched_barrier(0);
        }
#pragma unroll
        for (int dt = 0; dt < 2; ++dt)
#pragma unroll
            for (int vt = 0; vt < NVT; ++vt) { u32x2 o; o.x = pk2(st[dt][vt][0], st[dt][vt][1]); o.y = pk2(st[dt][vt][2], st[dt][vt][3]);
                *(LAS u32x2*)(ctn + (vt * 16 + fr) * PQ_PITCH + (wave * 32 + dt * 16 + 4 * fq) * 2) = o; }
        __builtin_amdgcn_sched_barrier(0);
        f32x4 acc[NVT];
#pragma unroll
        for (int vt = 0; vt < NVT; ++vt) acc[vt] = (f32x4){0.f, 0.f, 0.f, 0.f};
#pragma unroll
        for (int ks = 0; ks < 4; ++ks) {
#pragma unroll
            for (int vt = 0; vt < NVT; ++vt) acc[vt] = MFMA16(vf[vt][ks], bS[ks], acc[vt]);
            bS[ks] = *(const GAS bf16x8*)(Sg0 + (size_t)cn * 32768 + ks * 1024);
            __builtin_amdgcn_sched_barrier(0);
        }
#pragma unroll
        for (int ks = 0; ks < 8; ++ks) {
#pragma unroll
            for (int vt = 0; vt < NVT; ++vt) acc[vt] = MFMA16(cf[vt][ks & 3], bQ[ks], acc[vt]);
            if (ks < 4) {
#pragma unroll
                for (int vt = 0; vt < NVT; ++vt) cf[vt][ks] = lfrag(ct_, PQ_PITCH, vt * 16 + fr, 128 + ks * 32, fq);
            }
            bQ[ks] = *(const GAS bf16x8*)(Qg0 + (size_t)cn * 65536 + ks * 1024);
            __builtin_amdgcn_sched_barrier(0);
        }
        const int t = wave * 16 + fr;
        if (!DEN) {
            GAS bf16_t* hn = (GAS bf16_t*)(ws + WS_QKPRE) + (size_t)(tl0 + t) * 2048 + vcol + 4 * fq;
#pragma unroll
            for (int vt = 0; vt < NVT; ++vt) { u32x2 o; o.x = pk2(acc[vt][0], acc[vt][1]); o.y = pk2(acc[vt][2], acc[vt][3]); *(GAS u32x2*)(hn + vt * 16) = o; }
            V_STAGE(c + 1); vreg = *(const GAS u32x4*)(Vg0 + (size_t)cn2 * 128 * 2048);
        } else {
            if (fq == 0) ((GAS float*)(ws + WS_DEN))[(tg0 + t) * 4 + h] = acc[0][0];
        }
    }
    asm volatile("" :: "v"(pfv));
    __syncthreads();
#undef V_STAGE
}

constexpr int HG_PD = 4;
__device__ __forceinline__ void hgrn_scan(const DArgs& a, LAS unsigned char* lds, int round, int p, int sl) {
    const int tid = tid_(), lane = tid & 63, wave = __builtin_amdgcn_readfirstlane(tid >> 6), fr = lane & 15, fq = lane >> 4;
    const int bl = p >> 3, h = p & 7;
    GAS unsigned char* ws = a.ws;
    constexpr int IP = 144, ITB = 32 * IP, STB = 32 * PS_PITCH;
    LAS unsigned char* IT = lds; LAS unsigned char* ST = lds + 2 * ITB;
    for (int i = tid; i < (2 * ITB + 2 * STB) / 4; i += NTHR) ((LAS unsigned*)lds)[i] = 0u;
    __syncthreads();
    f32x4 st[2][2];
#pragma unroll
    for (int i = 0; i < 2; ++i) { st[i][0] = (f32x4){0.f, 0.f, 0.f, 0.f}; st[i][1] = st[i][0]; }
    const int vcol = h * 128 + sl * 32;
    const int is = (tid & 255) >> 2, ipart = tid & 3;
    const bool outw = wave < 4;
    const int w4 = wave & 3;
    const GAS unsigned char* Ag0 = ws + WS_ATT + (size_t)(p * 128) * 8192 + w4 * 2048 + lane * 16;
    const GAS unsigned char* Qg0 = ws + WS_QTG + (size_t)(p * 128) * 16384 + w4 * 4096 + lane * 16;
    const GAS unsigned char* Kg0 = ws + WS_KENDT + (size_t)(p * 128) * 16384 + w4 * 4096 + lane * 16;
    const GAS unsigned char* Dg0 = ws + WS_HGDEC + ((size_t)(p * 128) * 128 + w4 * 32 + 4 * fq) * 4;
    const GAS unsigned char* Ig0 = ws + WS_GI + ((size_t)(bl * SEQ + is) * 1024 + vcol + ipart * 8) * 2;
    const GAS unsigned char* gb0 = outw ? Ag0 : Kg0;          const unsigned gs0 = outw ? 8192u : 16384u;
    const GAS unsigned char* gb1 = outw ? Qg0 : Kg0 + 2048;   const unsigned gs1 = 16384u;
    const GAS unsigned char* gb2 = outw ? Qg0 + 2048 : Dg0;   const unsigned gs2 = outw ? 16384u : 512u, gt2 = outw ? 1024u : 64u;
    const GAS unsigned char* gb3 = outw ? Ig0 : Dg0;          const unsigned gs3 = outw ? 131072u : 512u;
    u32x4 pf[HG_PD][7];
#define HG_LD01(k_, cc_) do { _Pragma("unroll") for (int j_ = 0; j_ < 2; ++j_) pf[k_][j_] = *(const GAS u32x4*)(gb0 + (size_t)(cc_) * gs0 + j_ * 1024); } while (0)
#define HG_LD23(k_, cc_) do { _Pragma("unroll") for (int j_ = 0; j_ < 2; ++j_) pf[k_][2 + j_] = *(const GAS u32x4*)(gb1 + (size_t)(cc_) * gs1 + j_ * 1024); } while (0)
#define HG_LD45(k_, cc_) do { _Pragma("unroll") for (int j_ = 0; j_ < 2; ++j_) pf[k_][4 + j_] = *(const GAS u32x4*)(gb2 + (size_t)(cc_) * gs2 + j_ * gt2); } while (0)
#define HG_LD6(k_, cc_) do { pf[k_][6] = *(const GAS u32x4*)(gb3 + (size_t)(cc_) * gs3); } while (0)
#pragma unroll
    for (int k = 0; k < HG_PD; ++k) { HG_LD01(k, k); HG_LD23(k, k); HG_LD45(k, k); __builtin_amdgcn_sched_barrier(0); HG_LD6((k + 1) % HG_PD, (k + 1 < HG_PD ? k + 1 : HG_PD)); __builtin_amdgcn_sched_barrier(0); }
    const GAS unsigned char* pfp; unsigned pfstride;
    { const int tt = (wave * 64 + lane) < 160 ? wave * 64 + lane : 159; const int idx = sl * 10 + (tt >> 4), off = (tt & 15) * 64;
      pfp = (idx < 8 ? ws + WS_ATT + (size_t)(p * 128) * 8192 + idx * 1024 : idx < 24 ? ws + WS_QTG + (size_t)(p * 128) * 16384 + (idx - 8) * 1024 : ws + WS_KENDT + (size_t)(p * 128) * 16384 + (idx - 24) * 1024) + off;
      pfstride = idx < 8 ? 8192u : 16384u; }
    unsigned pfv[HG_PD];
#pragma unroll
    for (int k = 0; k < HG_PD; ++k) pfv[k] = 0u;
#define HG_STAGE(dst_, iv_) do { LAS unsigned char* d0_ = (dst_) + (ipart * 8) * IP + is * 2; \
        *(LAS bf16_t*)(d0_ + 0 * IP) = (bf16_t)((iv_).x & 0xffffu); *(LAS bf16_t*)(d0_ + 1 * IP) = (bf16_t)((iv_).x >> 16); \
        *(LAS bf16_t*)(d0_ + 2 * IP) = (bf16_t)((iv_).y & 0xffffu); *(LAS bf16_t*)(d0_ + 3 * IP) = (bf16_t)((iv_).y >> 16); \
        *(LAS bf16_t*)(d0_ + 4 * IP) = (bf16_t)((iv_).z & 0xffffu); *(LAS bf16_t*)(d0_ + 5 * IP) = (bf16_t)((iv_).z >> 16); \
        *(LAS bf16_t*)(d0_ + 6 * IP) = (bf16_t)((iv_).w & 0xffffu); *(LAS bf16_t*)(d0_ + 7 * IP) = (bf16_t)((iv_).w >> 16); } while (0)
    if (outw) { const u32x4 iv = *(const GAS u32x4*)Ig0; HG_STAGE(IT, iv); }
#pragma unroll 1
    for (int c0 = 0; c0 < 128; c0 += HG_PD) {
#pragma unroll
      for (int k = 0; k < HG_PD; ++k) {
        const int c = c0 + k;
        const int tl0 = bl * SEQ + c * 64;
        const int cn = (c + HG_PD < 128) ? c + HG_PD : 127;
        LAS unsigned char* it_ = IT + (k & 1) * ITB; LAS unsigned char* itn = IT + ((k + 1) & 1) * ITB; LAS unsigned char* st_ = ST + (k & 1) * STB; LAS unsigned char* stn = ST + ((k + 1) & 1) * STB;
        LDS_BAR();
        if (wave < 3) { asm volatile("" :: "v"(pfv[k])); const int c7 = (c + HG_PD + 3 < 128) ? c + HG_PD + 3 : 127; pfv[k] = *(const GAS unsigned*)(pfp + (size_t)c7 * pfstride); }
        bf16x8 itf[2][2];
#pragma unroll
        for (int vt = 0; vt < 2; ++vt)
#pragma unroll
            for (int ks = 0; ks < 2; ++ks) itf[vt][ks] = lfrag(it_, IP, vt * 16 + fr, ks * 32, fq);
        bf16x8 sf[2][4];
        f32x4 acc[2];
        acc[0] = (f32x4){0.f, 0.f, 0.f, 0.f}; acc[1] = acc[0];
        if (outw) {
#pragma unroll
            for (int vt = 0; vt < 2; ++vt)
#pragma unroll
                for (int ks = 0; ks < 4; ++ks) sf[vt][ks] = lfrag(st_, PS_PITCH, vt * 16 + fr, ks * 32, fq);
#pragma unroll
            for (int ks = 0; ks < 2; ++ks)
#pragma unroll
                for (int vt = 0; vt < 2; ++vt) acc[vt] = MFMA16(itf[vt][ks], __builtin_bit_cast(bf16x8, pf[k][ks]), acc[vt]);
        } else {
            const f32x4 dec = __builtin_bit_cast(f32x4, pf[k][4]);
#pragma unroll
            for (int vt = 0; vt < 2; ++vt) { st[0][vt] = st[0][vt] * dec;
#pragma unroll
                for (int ks = 0; ks < 2; ++ks) st[0][vt] = MFMA16(__builtin_bit_cast(bf16x8, pf[k][ks]), itf[vt][ks], st[0][vt]); }
        }
        __builtin_amdgcn_sched_barrier(0);
        HG_LD01(k, cn);
        __builtin_amdgcn_sched_barrier(0);
        if (outw) {
#pragma unroll
            for (int ks = 0; ks < 2; ++ks)
#pragma unroll
                for (int vt = 0; vt < 2; ++vt) acc[vt] = MFMA16(sf[vt][ks], __builtin_bit_cast(bf16x8, pf[k][2 + ks]), acc[vt]);
        } else {
            const f32x4 dec = __builtin_bit_cast(f32x4, pf[k][5]);
#pragma unroll
            for (int vt = 0; vt < 2; ++vt) { st[1][vt] = st[1][vt] * dec;
#pragma unroll
                for (int ks = 0; ks < 2; ++ks) st[1][vt] = MFMA16(__builtin_bit_cast(bf16x8, pf[k][2 + ks]), itf[vt][ks], st[1][vt]); }
        }
        __builtin_amdgcn_sched_barrier(0);
        HG_LD23(k, cn);
        __builtin_amdgcn_sched_barrier(0);
        if (outw) {
#pragma unroll
            for (int ks = 2; ks < 4; ++ks)
#pragma unroll
                for (int vt = 0; vt < 2; ++vt) acc[vt] = MFMA16(sf[vt][ks], __builtin_bit_cast(bf16x8, pf[k][2 + ks]), acc[vt]);
        } else {
#pragma unroll
            for (int dtile = 0; dtile < 2; ++dtile)
#pragma unroll
                for (int vt = 0; vt < 2; ++vt) { u32x2 o; o.x = pk2(st[dtile][vt][0], st[dtile][vt][1]); o.y = pk2(st[dtile][vt][2], st[dtile][vt][3]);
                    *(LAS u32x2*)(stn + (vt * 16 + fr) * PS_PITCH + (w4 * 32 + dtile * 16 + 4 * fq) * 2) = o; }
        }
        __builtin_amdgcn_sched_barrier(0);
        HG_LD45(k, cn);
        __builtin_amdgcn_sched_barrier(0);
        if (outw) {
            HG_STAGE(itn, pf[(k + 1) % HG_PD][6]);
            GAS bf16_t* og = (GAS bf16_t*)(ws + WS_GQ) + (size_t)(tl0 + w4 * 16 + fr) * 1024 + vcol + 4 * fq;
#pragma unroll
            for (int vt = 0; vt < 2; ++vt) { u32x2 o; o.x = pk2(acc[vt][0], acc[vt][1]); o.y = pk2(acc[vt][2], acc[vt][3]); *(GAS u32x2*)(og + vt * 16) = o; }
        }
        __builtin_amdgcn_sched_barrier(0);
        { const int cni = (c + 1 + HG_PD < 128) ? c + 1 + HG_PD : 127; HG_LD6((k + 1) % HG_PD, cni); }
        __builtin_amdgcn_sched_barrier(0);
      }
    }
#pragma unroll
    for (int k = 0; k < HG_PD; ++k) asm volatile("" :: "v"(pfv[k]));
    __syncthreads();
#undef HG_LD01
#undef HG_LD23
#undef HG_LD45
#undef HG_LD6
#undef HG_STAGE
}

__device__ __forceinline__ void xn8_convert(const DArgs& a, int round, int vcu, int G) {
    const int tid = tid_(), lane = tid & 63, wave = tid >> 6;
    const int gw = vcu * NWAVES + wave, NGW = G * NWAVES;
    GAS unsigned char* ws = a.ws;
    for (int tl = gw; tl < RT; tl += NGW) {
        const size_t tg = (size_t)round * RT + tl;
        const GAS u32x2* xr = (const GAS u32x2*)((const GAS bf16_t*)(ws + WS_XN) + tg * D) + lane;
        f32x4 v[4]; float mx = 0.f;
#pragma unroll
        for (int j = 0; j < 4; ++j) { const u32x2 xv = xr[64 * j]; v[j][0] = bf_lo(xv.x); v[j][1] = bf_hi(xv.x); v[j][2] = bf_lo(xv.y); v[j][3] = bf_hi(xv.y);
            mx = fmaxf(mx, fmaxf(fmaxf(fabsf(v[j][0]), fabsf(v[j][1])), fmaxf(fabsf(v[j][2]), fabsf(v[j][3])))); }
        mx = wave_max(mx);
        const float qs = mx > 0.f ? 127.0f / mx : 0.f;
#pragma unroll
        for (int j = 0; j < 4; ++j) ((GAS unsigned*)(ws + WS_XN8 + (size_t)tl * 1024))[64 * j + lane] = pack_i8x4(v[j][0] * qs, v[j][1] * qs, v[j][2] * qs, v[j][3] * qs);
        if (lane == 0) ((GAS float*)(ws + WS_SA8))[tg] = mx * (1.0f / 127.0f);
    }
}

__device__ __forceinline__ void phase_ypass(const DArgs& a, int round, int vcu, int G) {
    const int tid = tid_(), lane = tid & 63, wave = tid >> 6;
    const int gw = vcu * NWAVES + wave, NGW = G * NWAVES;
    GAS unsigned char* ws = a.ws;
    f32x4 mg0[4], mg1[4], gg4[4];
#pragma unroll
    for (int j = 0; j < 4; ++j) { mg0[j] = *(const GAS f32x4*)(a.m_head_g + j * 512 + lane * 8); mg1[j] = *(const GAS f32x4*)(a.m_head_g + j * 512 + lane * 8 + 4); gg4[j] = *(const GAS f32x4*)(a.g_head_g + lane * 16 + 4 * j); }
    for (int tl = gw; tl < RT; tl += NGW) {
        const size_t tg = (size_t)round * RT + tl;
        const f32x4 den4 = *(const f32x4*)((const float*)(ws + WS_DEN) + tg * 4), mt4 = *(const f32x4*)((const float*)(ws + WS_MT) + tg * 4);
        float ym[4][8];
#pragma unroll
        for (int j = 0; j < 4; ++j) {
            const int col = j * 512 + lane * 8;
            const u32x4 nv = *(const u32x4*)((const bf16_t*)(ws + WS_QKPRE) + (size_t)tl * 2048 + col);
            const u32x4 ov = *(const u32x4*)((const bf16_t*)(ws + WS_SIGO) + (size_t)tl * 2048 + col);
            const float inv = 1.0f / fmaxf(fabsf(den4[j]), __expf(-mt4[j]));
            float hv[8] = {bf_lo(nv.x) * inv, bf_hi(nv.x) * inv, bf_lo(nv.y) * inv, bf_hi(nv.y) * inv, bf_lo(nv.z) * inv, bf_hi(nv.z) * inv, bf_lo(nv.w) * inv, bf_hi(nv.w) * inv};
            float ss = 0.f;
#pragma unroll
            for (int e = 0; e < 8; ++e) ss += hv[e] * hv[e];
            const float r = rsqrtf(wave_sum(ss, lane) * (1.f / 512.f) + EPS);
            const f32x4 g0 = mg0[j], g1 = mg1[j];
            const float og[8] = {bf_lo(ov.x), bf_hi(ov.x), bf_lo(ov.y), bf_hi(ov.y), bf_lo(ov.z), bf_hi(ov.z), bf_lo(ov.w), bf_hi(ov.w)};
#pragma unroll
            for (int e = 0; e < 8; ++e) ym[j][e] = og[e] * hv[e] * r * (e < 4 ? g0[e] : g1[e - 4]);
        }
        {
            float mx = 0.f;
#pragma unroll
            for (int j = 0; j < 4; ++j)
#pragma unroll
                for (int e = 0; e < 8; ++e) mx = fmaxf(mx, fabsf(ym[j][e]));
            mx = wave_max(mx);
            const float qs = mx > 0.f ? 127.0f / mx : 0.f;
#pragma unroll
            for (int j = 0; j < 4; ++j) { u32x2 o; o.x = pack_i8x4(ym[j][0] * qs, ym[j][1] * qs, ym[j][2] * qs, ym[j][3] * qs); o.y = pack_i8x4(ym[j][4] * qs, ym[j][5] * qs, ym[j][6] * qs, ym[j][7] * qs);
                *(GAS u32x2*)(ws + WS_V + (size_t)tl * 2048 + j * 512 + lane * 8) = o; }
            if (lane == 0) ((GAS float*)(ws + WS_SYM))[tl] = mx * (1.0f / 127.0f);
        }
        {
            const int col = lane * 16;
            const u32x4 n0 = *(const u32x4*)((const bf16_t*)(ws + WS_GQ) + (size_t)tl * 1024 + col), n1 = *(const u32x4*)((const bf16_t*)(ws + WS_GQ) + (size_t)tl * 1024 + col + 8);
            const u32x4 s0 = *(const u32x4*)((const bf16_t*)(ws + WS_SGG) + (size_t)tl * 1024 + col), s1 = *(const u32x4*)((const bf16_t*)(ws + WS_SGG) + (size_t)tl * 1024 + col + 8);
            float ov[16] = {bf_lo(n0.x), bf_hi(n0.x), bf_lo(n0.y), bf_hi(n0.y), bf_lo(n0.z), bf_hi(n0.z), bf_lo(n0.w), bf_hi(n0.w), bf_lo(n1.x), bf_hi(n1.x), bf_lo(n1.y), bf_hi(n1.y), bf_lo(n1.z), bf_hi(n1.z), bf_lo(n1.w), bf_hi(n1.w)};
            const float sg[16] = {bf_lo(s0.x), bf_hi(s0.x), bf_lo(s0.y), bf_hi(s0.y), bf_lo(s0.z), bf_hi(s0.z), bf_lo(s0.w), bf_hi(s0.w), bf_lo(s1.x), bf_hi(s1.x), bf_lo(s1.y), bf_hi(s1.y), bf_lo(s1.z), bf_hi(s1.z), bf_lo(s1.w), bf_hi(s1.w)};
            float ss = 0.f;
#pragma unroll
            for (int e = 0; e < 16; ++e) ss += ov[e] * ov[e];
            ss += DPP_(ss, 0xB1); ss += DPP_(ss, 0x4E); ss += DPP_(ss, 0x141);
            const float r = rsqrtf(ss * (1.f / 128.f) + EPS);
            float y[16];
#pragma unroll
            for (int e = 0; e < 16; ++e) y[e] = ov[e] * r * gg4[e >> 2][e & 3] * sg[e];
            float mx = 0.f;
#pragma unroll
            for (int e = 0; e < 16; ++e) mx = fmaxf(mx, fabsf(y[e]));
            mx = wave_max(mx);
            const float qs = mx > 0.f ? 127.0f / mx : 0.f;
            u32x4 o; o.x = pack_i8x4(y[0] * qs, y[1] * qs, y[2] * qs, y[3] * qs); o.y = pack_i8x4(y[4] * qs, y[5] * qs, y[6] * qs, y[7] * qs);
            o.z = pack_i8x4(y[8] * qs, y[9] * qs, y[10] * qs, y[11] * qs); o.w = pack_i8x4(y[12] * qs, y[13] * qs, y[14] * qs, y[15] * qs);
            *(GAS u32x4*)(ws + WS_GI + (size_t)tl * 1024 + col) = o;
            if (lane == 0) ((GAS float*)(ws + WS_SYG))[tl] = mx * (1.0f / 127.0f);
        }
    }
}


#define XB_TMO      128
#define XB_XCNT(j)  (256  + 64 * (j))
#define XB_XSUB(j)  (1280 + 64 * (j))
#define XB_XGEN(j)  (2304 + 64 * (j))
#define XB_TOP      3328
#define XB_TOPGEN   3392
#define XB_SPIN_CAP (1u << 22)
constexpr int CW_BAR = 4096;
constexpr int LDS_BARST = LDS_BYTES - 64;
__device__ __forceinline__ unsigned xb_ld(unsigned* p)              { return __hip_atomic_load(p, __ATOMIC_RELAXED, __HIP_MEMORY_SCOPE_AGENT); }
__device__ __forceinline__ unsigned xb_add(unsigned* p, unsigned v) { return __hip_atomic_fetch_add(p, v, __ATOMIC_RELAXED, __HIP_MEMORY_SCOPE_AGENT); }
__device__ __forceinline__ unsigned xb_xcc_id() { return (unsigned)__builtin_amdgcn_s_getreg((3 << 11) | 20) & 0xFu; }
#define XB_SPIN(cond, bar) do { unsigned _sp = 0; while (cond) { __builtin_amdgcn_s_sleep(1); \
    if ((++_sp & 255u) == 0u) { if (xb_ld(&(bar)[XB_TMO])) break; if (_sp > XB_SPIN_CAP) { atomicAdd(&(bar)[XB_TMO], 1u); break; } } } } while (0)
__device__ __forceinline__ void xcd_barrier_post(unsigned* bar, volatile LAS unsigned* st) { if (tid_() == 0) st[2] = xb_add(&bar[XB_XCNT(xb_xcc_id())], 1u); }
__device__ __forceinline__ void xcd_barrier_complete(unsigned* bar, unsigned x, unsigned& nloc, unsigned& nx) {
    const unsigned G = gridDim.x;
    unsigned sum, cnt, mine, sp = 0u;
    for (;;) {
        sum = 0u; cnt = 0u; mine = 0u;
#pragma unroll
        for (unsigned j = 0; j < 16; ++j) { const unsigned c = xb_ld(&bar[XB_XCNT(j)]); sum += c; cnt += (c > 0u) ? 1u : 0u; mine = (j == x) ? c : mine; }
        if (sum == G) break;
        __builtin_amdgcn_s_sleep(1);
        if ((++sp & 255u) == 0u) { if (xb_ld(&bar[XB_TMO])) break; if (sp > XB_SPIN_CAP) { atomicAdd(&bar[XB_TMO], 1u); break; } }
    }
    nloc = mine > 0u ? mine : 1u; nx = cnt > 0u ? cnt : 1u;
}
__device__ __forceinline__ void xcd_barrier(unsigned* bar, volatile LAS unsigned* st) {
    asm volatile("s_waitcnt vmcnt(0)" ::: "memory");
    __syncthreads();
    if (tid_() == 0) {
        const unsigned x = xb_xcc_id();
        __builtin_amdgcn_s_waitcnt(0);
        unsigned nloc = st[0], nx = st[1];
        if (nloc == 0u) { xcd_barrier_complete(bar, x, nloc, nx); st[0] = nloc; st[1] = nx; }
        const unsigned old = xb_add(&bar[XB_XSUB(x)], 1u);
        const unsigned gen = old / nloc;
        if (old + 1u == (gen + 1u) * nloc) {
            __builtin_amdgcn_fence(__ATOMIC_RELEASE, "agent");
            asm volatile("s_waitcnt vmcnt(0)" ::: "memory");
            const unsigned og = xb_add(&bar[XB_TOP], 1u);
            const unsigned tg = og / nx;
            if (og + 1u == (tg + 1u) * nx) xb_add(&bar[XB_TOPGEN], 1u);
            else XB_SPIN(xb_ld(&bar[XB_TOPGEN]) == tg, bar);
            __builtin_amdgcn_fence(__ATOMIC_ACQUIRE, "agent");
            xb_add(&bar[XB_XGEN(x)], 1u);
            asm volatile("s_waitcnt vmcnt(0)" ::: "memory");
        } else {
            XB_SPIN(xb_ld(&bar[XB_XGEN(x)]) == gen, bar);
            __builtin_amdgcn_fence(__ATOMIC_ACQUIRE, "agent");
            asm volatile("s_waitcnt vmcnt(0)" ::: "memory");
        }
    }
    __syncthreads();
}

__device__ __forceinline__ void phase_p8(const DArgs& a, int vcu, int G) {
    const int tid = tid_(), lane = tid & 63, wave = tid >> 6;
    const int gw = vcu * NWAVES + wave, NGW = G * NWAVES;
    GAS unsigned char* ws = a.ws;
    f32x4 g2[4];
#pragma unroll
    for (int j = 0; j < 4; ++j) g2[j] = ((const f32x4*)a.norm2_g)[64 * j + lane];
    for (int m = gw; m < T; m += NGW) {
        const GAS u32x2* xr = (const GAS u32x2*)((const GAS bf16_t*)a.out + (size_t)m * D) + lane;
        f32x4 v[4]; float s = 0.f;
#pragma unroll
        for (int j = 0; j < 4; ++j) { const u32x2 xv = xr[64 * j]; v[j][0] = bf_lo(xv.x); v[j][1] = bf_hi(xv.x); v[j][2] = bf_lo(xv.y); v[j][3] = bf_hi(xv.y); s += (v[j][0] * v[j][0] + v[j][1] * v[j][1]) + (v[j][2] * v[j][2] + v[j][3] * v[j][3]); }
        const float rstd = rsqrtf(wave_sum(s, lane) * (1.f / D) + EPS);
#pragma unroll
        for (int j = 0; j < 4; ++j) v[j] = v[j] * rstd * g2[j];
        float mx = 0.f;
#pragma unroll
        for (int j = 0; j < 4; ++j) mx = fmaxf(mx, fmaxf(fmaxf(fabsf(v[j][0]), fabsf(v[j][1])), fmaxf(fabsf(v[j][2]), fabsf(v[j][3]))));
        mx = wave_max(mx);
        const float qs = mx > 0.f ? 127.0f / mx : 0.f;
#pragma unroll
        for (int j = 0; j < 4; ++j) ((GAS unsigned*)(ws + WS_XQ + (size_t)m * 1024))[64 * j + lane] = pack_i8x4(v[j][0] * qs, v[j][1] * qs, v[j][2] * qs, v[j][3] * qs);
        if (lane == 0) ((GAS float*)(ws + WS_XQS))[m] = mx * (1.0f / 127.0f);
    }
    for (int e = gw; e < 16384; e += NGW) {
        f32x4 uv[4], vv[4]; float mu = 0.f, mv = 0.f;
#pragma unroll
        for (int j = 0; j < 4; ++j) { uv[j] = ((const GAS f32x4*)(a.u_emb + (size_t)e * 1024))[64 * j + lane]; vv[j] = ((const GAS f32x4*)(a.v_emb + (size_t)e * 1024))[64 * j + lane];
            mu = fmaxf(mu, fmaxf(fmaxf(fabsf(uv[j][0]), fabsf(uv[j][1])), fmaxf(fabsf(uv[j][2]), fabsf(uv[j][3]))));
            mv = fmaxf(mv, fmaxf(fmaxf(fabsf(vv[j][0]), fabsf(vv[j][1])), fmaxf(fabsf(vv[j][2]), fabsf(vv[j][3])))); }
        mu = wave_max(mu); mv = wave_max(mv);
        const float su = mu > 0.f ? 127.0f / mu : 0.f, sv = mv > 0.f ? 448.0f / mv : 0.f;
        if (lane == 0) { ((GAS float*)(ws + WS_USC))[e] = mu * (1.0f / 127.0f); ((GAS float*)(ws + WS_VSC))[e] = mv * (1.0f / 448.0f); }
#pragma unroll
        for (int j = 0; j < 4; ++j) {
            const size_t ob = (size_t)(2 * j + (lane >> 5)) * 2097152 + (size_t)e * 128 + ((4 * lane) & 127);
            *(GAS unsigned*)(ws + WS_UB + ob) = pack_i8x4(uv[j][0] * su, uv[j][1] * su, uv[j][2] * su, uv[j][3] * su);
            int p = __builtin_amdgcn_cvt_pk_fp8_f32(vv[j][0] * sv, vv[j][1] * sv, 0, false); p = __builtin_amdgcn_cvt_pk_fp8_f32(vv[j][2] * sv, vv[j][3] * sv, p, true);
            *(GAS unsigned*)(ws + WS_VB + ob) = (unsigned)p; }
    }
}

__device__ __forceinline__ unsigned f2ord(float f) { const unsigned u = __builtin_bit_cast(unsigned, f); return (u & 0x80000000u) ? ~u : (u | 0x80000000u); }
__device__ __forceinline__ float ord2f(unsigned k) { const unsigned u = (k & 0x80000000u) ? (k & 0x7fffffffu) : ~k; return __builtin_bit_cast(float, u); }
__device__ __forceinline__ unsigned umax_(unsigned a, unsigned b) { return a > b ? a : b; }
__device__ __forceinline__ unsigned shxu(unsigned v, int o, int lane) { return (unsigned)__builtin_amdgcn_ds_bpermute((lane ^ o) << 2, (int)v); }

__device__ __forceinline__ unsigned umin_(unsigned a, unsigned b) { return a < b ? a : b; }
#define TK_CE(a_, b_) do { const unsigned hi_ = umax_((a_), (b_)), lo_ = umin_((a_), (b_)); (a_) = hi_; (b_) = lo_; } while (0)
__device__ __forceinline__ void tk_sort16(unsigned (&x)[32], int o) {
#pragma unroll
    for (int k = 2; k <= 16; k <<= 1)
#pragma unroll
        for (int j = k >> 1; j > 0; j >>= 1)
#pragma unroll
            for (int i = 0; i < 16; ++i) { const int l = i ^ j; if (l > i) { if ((i & k) == 0) TK_CE(x[o + i], x[o + l]); else TK_CE(x[o + l], x[o + i]); } }
}
__device__ __forceinline__ void tk_merge16(unsigned (&t)[16]) {
#pragma unroll
    for (int j = 8; j > 0; j >>= 1)
#pragma unroll
        for (int i = 0; i < 16; ++i) { const int l = i ^ j; if (l > i) TK_CE(t[i], t[l]); }
}
__device__ __forceinline__ void phase_topk(const DArgs& a, LAS unsigned char* lds, int bx, int G) {
    const int tid = tid_(), lane = tid & 63, wave = __builtin_amdgcn_readfirstlane(tid >> 6), fr = lane & 15, fq = lane >> 4;
    GAS unsigned char* ws = a.ws;
    const int h = bx & 7;
    LAS unsigned char* KY = lds;
    LAS unsigned char* QL = lds + 2 * 128 * PS_PITCH;
    LAS unsigned* TOP = (LAS unsigned*)(lds + 2 * 128 * PS_PITCH + 64 * PQ_PITCH);
#pragma unroll
    for (int i = 0; i < 8; ++i) { const int idx = tid + 512 * i, row = idx >> 4, ch = idx & 15;
        *(LAS u32x4*)(KY + row * PS_PITCH + ch * 16) = *(const u32x4*)((const bf16_t*)(ws + WS_SK) + ((size_t)h * 256 + row) * 128 + ch * 8); }
    const int ntile = T / 64;
    u32x4 qpre[4];
    { const int tile0 = bx >> 3; if (tile0 < ntile) {
#pragma unroll
        for (int i = 0; i < 4; ++i) { const int idx = tid + 512 * i, row = idx >> 5, ch = idx & 31;
            qpre[i] = *(const GAS u32x4*)((const GAS bf16_t*)(ws + WS_QP) + ((size_t)tile0 * 64 + row) * 2048 + h * 256 + ch * 8); } } }
    __syncthreads();
    for (int tile = bx >> 3; tile < ntile; tile += (G >> 3)) {
        const size_t t0 = (size_t)tile * 64;
        LDS_BAR();
#pragma unroll
        for (int i = 0; i < 4; ++i) { const int idx = tid + 512 * i, row = idx >> 5, ch = idx & 31;
            *(LAS u32x4*)(QL + row * PQ_PITCH + ch * 16) = qpre[i]; }
        { const int tn = tile + (G >> 3); if (tn < ntile) {
#pragma unroll
            for (int i = 0; i < 4; ++i) { const int idx = tid + 512 * i, row = idx >> 5, ch = idx & 31;
                qpre[i] = *(const GAS u32x4*)((const GAS bf16_t*)(ws + WS_QP) + ((size_t)tn * 64 + row) * 2048 + h * 256 + ch * 8); } } }
        LDS_BAR();
        {
            const int mt = wave & 3, p = wave >> 2;
            unsigned key[32];
#pragma unroll
            for (int nt = 0; nt < 8; ++nt) { f32x4 acc = (f32x4){0.f, 0.f, 0.f, 0.f};
#pragma unroll
                for (int ks = 0; ks < 4; ++ks) acc = MFMA16(lfrag(KY + p * 128 * PS_PITCH, PS_PITCH, nt * 16 + fr, ks * 32, fq), lfrag(QL, PQ_PITCH, mt * 16 + fr, p * 128 + ks * 32, fq), acc);
#pragma unroll
                for (int j = 0; j < 4; ++j) { const int n = nt * 16 + 4 * fq + j; key[nt * 4 + j] = (f2ord(acc[j]) & ~127u) | (unsigned)(127 - n); } }
            tk_sort16(key, 0); tk_sort16(key, 16);
            unsigned t[16];
#pragma unroll
            for (int i = 0; i < 16; ++i) t[i] = umax_(key[i], key[31 - i]);
            tk_merge16(t);
            {   unsigned pv[16];
#pragma unroll
                for (int i = 0; i < 16; ++i) pv[i] = (unsigned)SWZI_(t[15 - i], 0x401F);
#pragma unroll
                for (int i = 0; i < 16; ++i) t[i] = umax_(t[i], pv[i]);
                tk_merge16(t);
#pragma unroll
                for (int i = 0; i < 16; ++i) pv[i] = xor32u_(t[15 - i], lane >= 32);
#pragma unroll
                for (int i = 0; i < 16; ++i) t[i] = umax_(t[i], pv[i]);
                tk_merge16(t); }
#pragma unroll
            for (int k = 0; k < 16; ++k) { if (fq == (k & 3)) TOP[(p * 64 + mt * 16 + fr) * 16 + k] = t[k]; }
        }
        LDS_BAR();
        {
            const int t = tid >> 3, sub = tid & 7;
            unsigned ck[7];
#pragma unroll
            for (int e = 0; e < 7; ++e) {
                const int ci = sub + 8 * e;
                int i = 0, base = 0; bool ok = ci < 50;
                if (ci >= 42) { i = 8 + (ci - 42); base = ci; } else if (ci >= 40) { i = 7; base = 40; } else if (ci >= 38) { i = 6; base = 38; } else if (ci >= 36) { i = 5; base = 36; }
                else if (ci >= 33) { i = 4; base = 33; } else if (ci >= 29) { i = 3; base = 29; } else if (ci >= 24) { i = 2; base = 24; } else if (ci >= 16) { i = 1; base = 16; }
                const int j = ci - base;
                unsigned kk = 0u;
                if (ok) { const float s0 = ord2f(TOP[(0 * 64 + t) * 16 + i] & ~127u), s1 = ord2f(TOP[(1 * 64 + t) * 16 + j] & ~127u);
                    kk = (f2ord(s0 + s1) & ~255u) | (unsigned)(255 - (i * 16 + j)); }
                ck[e] = kk;
            }
            unsigned w0 = 0u, w1 = 0u;
#pragma unroll 1
            for (int k = 0; k < 16; ++k) {
                unsigned m = umax_(umax_(umax_(ck[0], ck[1]), ck[2]), umax_(umax_(umax_(ck[3], ck[4]), ck[5]), ck[6]));
                m = umax_(m, (unsigned)DPPI_(m, 0xB1)); m = umax_(m, (unsigned)DPPI_(m, 0x4E)); m = umax_(m, (unsigned)DPPI_(m, 0x141));
#pragma unroll
                for (int e = 0; e < 7; ++e) ck[e] = (ck[e] == m) ? 0u : ck[e];
                if (k == sub) w0 = m; if (k == sub + 8) w1 = m;
            }
            const int f0 = 255 - (int)(w0 & 255u), f1 = 255 - (int)(w1 & 255u);
            const float sc0 = ord2f(w0 & ~255u), sc1 = ord2f(w1 & ~255u);
            float mx = fmaxf(sc0, sc1); mx = fmaxf(mx, DPP_(mx, 0xB1)); mx = fmaxf(mx, DPP_(mx, 0x4E)); mx = fmaxf(mx, DPP_(mx, 0x141));
            const float e0 = __expf(sc0 - mx), e1 = __expf(sc1 - mx);
            float sm = e0 + e1; sm += DPP_(sm, 0xB1); sm += DPP_(sm, 0x4E); sm += DPP_(sm, 0x141);
            const float inv = 1.0f / sm;
            const int i0 = 127 - (int)(TOP[(0 * 64 + t) * 16 + (f0 >> 4)] & 127u), j0 = 127 - (int)(TOP[(1 * 64 + t) * 16 + (f0 & 15)] & 127u);
            const int i1 = 127 - (int)(TOP[(0 * 64 + t) * 16 + (f1 >> 4)] & 127u), j1 = 127 - (int)(TOP[(1 * 64 + t) * 16 + (f1 & 15)] & 127u);
            unsigned short* ei = (unsigned short*)(ws + WS_EIDX) + ((t0 + t) * 8 + h) * 16; float* gp = (float*)(ws + WS_GATE) + ((t0 + t) * 8 + h) * 16;
            ei[sub] = (unsigned short)(i0 * 128 + j0); ei[sub + 8] = (unsigned short)(i1 * 128 + j1); gp[sub] = e0 * inv; gp[sub + 8] = e1 * inv;
        }
    }
    __syncthreads();
}

__device__ __forceinline__ void ins16(float (&v)[16], int (&id)[16], float x, int n) {
    if (x > v[15]) { v[15] = x; id[15] = n;
#pragma unroll
        for (int i = 15; i >= 1; --i) { if (v[i] > v[i - 1]) { const float tv = v[i]; v[i] = v[i - 1]; v[i - 1] = tv; const int ti = id[i]; id[i] = id[i - 1]; id[i - 1] = ti; } } }
}
__device__ __forceinline__ void phase_topk_ref(const DArgs& a, int vcu, int G) {
    const int tid = tid_();
    GAS unsigned char* ws = a.ws;
    const int gt = vcu * NTHR + tid, NGT = G * NTHR;
    for (int pair = gt; pair < T * 8; pair += NGT) {
        const int t = pair >> 3, h = pair & 7;
        float sv[2][16]; int si[2][16];
#pragma unroll
        for (int p = 0; p < 2; ++p) {
#pragma unroll
            for (int i = 0; i < 16; ++i) { sv[p][i] = -INFINITY; si[p][i] = 0; }
            const bf16_t* qp = (const bf16_t*)(ws + WS_QP) + (size_t)t * 2048 + h * 256 + p * 128;
            for (int n = 0; n < 128; ++n) {
                const bf16_t* kp = (const bf16_t*)(ws + WS_SK) + ((size_t)(h * 2 + p) * 128 + n) * 128;
                float s = 0.f;
                for (int c = 0; c < 128; c += 8) { const u32x4 qv = *(const u32x4*)(qp + c), kv = *(const u32x4*)(kp + c);
                    s += bf_lo(qv.x) * bf_lo(kv.x) + bf_hi(qv.x) * bf_hi(kv.x) + bf_lo(qv.y) * bf_lo(kv.y) + bf_hi(qv.y) * bf_hi(kv.y)
                       + bf_lo(qv.z) * bf_lo(kv.z) + bf_hi(qv.z) * bf_hi(kv.z) + bf_lo(qv.w) * bf_lo(kv.w) + bf_hi(qv.w) * bf_hi(kv.w); }
                ins16(sv[p], si[p], s, n);
            }
        }
        float tv[16]; int ti[16];
#pragma unroll
        for (int i = 0; i < 16; ++i) { tv[i] = -INFINITY; ti[i] = 0; }
#pragma unroll
        for (int i = 0; i < 16; ++i)
#pragma unroll
            for (int j = 0; j < 16; ++j) ins16(tv, ti, sv[0][i] + sv[1][j], i * 16 + j);
        float sm = 0.f, ex[16];
#pragma unroll
        for (int k = 0; k < 16; ++k) { ex[k] = __expf(tv[k] - tv[0]); sm += ex[k]; }
        int* ei = (int*)(ws + WS_EIDX) + (size_t)pair * 16; float* gp = (float*)(ws + WS_GATE) + (size_t)pair * 16;
#pragma unroll
        for (int k = 0; k < 16; ++k) {
            int e0 = 0, e1 = 0;
#pragma unroll
            for (int i = 0; i < 16; ++i) { e0 = ((ti[k] >> 4) == i) ? si[0][i] : e0; e1 = ((ti[k] & 15) == i) ? si[1][i] : e1; }
            ei[k] = e0 * 128 + e1; gp[k] = ex[k] / sm; }
    }
}

#define FP8LO(w) __builtin_amdgcn_cvt_pk_f32_fp8((int)(w), false)
#define FP8HI(w) __builtin_amdgcn_cvt_pk_f32_fp8((int)(w), true)
__device__ __forceinline__ float dot16_fp8(const u32x4 r, const float (&x)[16]) {
    float c = 0.f;
#pragma unroll
    for (int j = 0; j < 4; ++j) { const f32x2 lo = FP8LO(r[j]), hi = FP8HI(r[j]); c += lo[0] * x[4 * j] + lo[1] * x[4 * j + 1] + hi[0] * x[4 * j + 2] + hi[1] * x[4 * j + 3]; }
    return c;
}
__device__ __forceinline__ float dot16_fp8p(const u32x4 r, const f32x2 (&xp)[8]) {
    f32x2 c2 = (f32x2){0.f, 0.f};
#pragma unroll
    for (int j = 0; j < 4; ++j) { c2 += FP8LO(r[j]) * xp[2 * j]; c2 += FP8HI(r[j]) * xp[2 * j + 1]; }
    return c2[0] + c2[1];
}
__device__ __forceinline__ float gelu_erf(float d) {
    const float ad = fabsf(d), t = __builtin_amdgcn_rcpf(ad * 0.2316418882f + 1.0f);
    float q = t * 0.5307027145f + (-0.7265760135f); q = q * t + 0.7107068705f; q = q * t + (-0.142248368f); q = q * t + 0.127414796f; q = q * t;
    const float m = d * (q * __builtin_amdgcn_exp2f(d * d * (-0.72134752044f)));
    return d < 0.f ? m : d - m;
}
__device__ __forceinline__ float bperm(float v, int srclane) { return __builtin_bit_cast(float, __builtin_amdgcn_ds_bpermute(srclane << 2, __builtin_bit_cast(int, v))); }
#define SWZ_(v, pat) __builtin_bit_cast(float, __builtin_amdgcn_ds_swizzle(__builtin_bit_cast(int, (v)), (pat)))
__device__ __forceinline__ float rs32_(float a, float b) {
#if defined(__HIP_DEVICE_COMPILE__)
    asm volatile("s_nop 1\n\tv_permlane32_swap_b32 %0, %1" : "+v"(a), "+v"(b));
#endif
    return a + b;
}
__device__ __forceinline__ float rs16_(float a, float b) {
#if defined(__HIP_DEVICE_COMPILE__)
    asm volatile("s_nop 1\n\tv_permlane16_swap_b32 %0, %1" : "+v"(a), "+v"(b));
#endif
    return a + b;
}
__device__ __forceinline__ float rs8_(float a, float b, bool bit3) {
    const float send = bit3 ? a : b, keep = bit3 ? b : a;
    return keep + DPP_(send, 0x128);
}
__device__ __forceinline__ float xor32_(float v, bool hi) {
#if defined(__HIP_DEVICE_COMPILE__)
    const auto r = __builtin_amdgcn_permlane32_swap(__builtin_bit_cast(unsigned, v), __builtin_bit_cast(unsigned, v), false, false);
    return __builtin_bit_cast(float, hi ? r[0] : r[1]);
#else
    (void)hi; return v;
#endif
}
__device__ __forceinline__ float reduce8(const float (&p)[8], int lane) {
    float q4[4], q2[2];
    const bool b5 = lane & 32, b4 = lane & 16, b3 = lane & 8;
#pragma unroll
    for (int i = 0; i < 4; ++i) { const float send = b5 ? p[i] : p[i + 4], keep = b5 ? p[i + 4] : p[i]; q4[i] = keep + xor32_(send, b5); }
#pragma unroll
    for (int i = 0; i < 2; ++i) { const float send = b4 ? q4[i] : q4[i + 2], keep = b4 ? q4[i + 2] : q4[i]; q2[i] = keep + SWZ_(send, 0x401F); }
    const float send = b3 ? q2[0] : q2[1], keep = b3 ? q2[1] : q2[0];
    float q1 = keep + SWZ_(send, 0x201F);
    q1 += DPP_(q1, 0xB1); q1 += DPP_(q1, 0x4E); q1 += DPP_(q1, 0x141);
    return q1;
}
__device__ __forceinline__ void phase_udots(const DArgs& a, LAS unsigned char* lds) {
    const int tid = tid_(), lane = tid & 63, wave = __builtin_amdgcn_readfirstlane(tid >> 6);
    GAS unsigned char* ws = a.ws;
    volatile LAS unsigned* bst = (volatile LAS unsigned*)(lds + LDS_BARST);
    const int nloc = (int)bst[0], nx = (int)bst[1], rank = (int)bst[2];
    unsigned* bar = (unsigned*)(ws + WS_CTL) + CW_BAR;
    const unsigned myx = xb_xcc_id();
    int q = 0;
    for (unsigned j = 0; j < 16; ++j) { const unsigned c = xb_ld(&bar[XB_XCNT(j)]); if (c > 0u && j < myx) ++q; }
    LAS int* LE = (LAS int*)(lds + wave * 2048);
    LAS int* LP = LE + 128; LAS float* LG = (LAS float*)(LE + 256);
    const GAS unsigned char* UB = ws + WS_UB;
    const int g8 = lane >> 3;
    const float usc = ((const GAS float*)(ws + WS_USC))[0], vsc = ((const GAS float*)(ws + WS_USC))[1];
    for (int s = q; s < 8; s += nx) {
        int tok = rank * 8 + wave;
        u32x4 xq0 = (u32x4){0u, 0u, 0u, 0u}, xq1 = xq0; u32x2 e2 = (u32x2){0u, 0u}; f32x2 g2 = (f32x2){0.f, 0.f};
#define U_INFO(t_) do { xq0 = *(const u32x4*)((const GAS bf16_t*)(ws + WS_XN) + (size_t)(t_) * D + lane * 16); xq1 = *(const u32x4*)((const GAS bf16_t*)(ws + WS_XN) + (size_t)(t_) * D + lane * 16 + 8); \
        e2 = *(const u32x2*)((const GAS int*)(ws + WS_EIDX) + (size_t)(t_) * 128 + 2 * lane); g2 = *(const f32x2*)((const GAS float*)(ws + WS_GATE) + (size_t)(t_) * 128 + 2 * lane); } while (0)
        if (tok < T) U_INFO(tok);
        for (; tok < T; tok += nloc * 8) {
            const bool in0 = (int)(e2.x >> 11) == s, in1 = (int)(e2.y >> 11) == s;
            const unsigned long long m0 = __ballot(in0), m1 = __ballot(in1);
            const unsigned long long lt = (1ull << lane) - 1ull;
            const int n0 = __popcll(m0), n = n0 + __popcll(m1);
            if (in0) { const int pos = __popcll(m0 & lt); LE[pos] = (int)e2.x; LP[pos] = 2 * lane; LG[pos] = g2[0]; }
            if (in1) { const int pos = n0 + __popcll(m1 & lt); LE[pos] = (int)e2.y; LP[pos] = 2 * lane + 1; LG[pos] = g2[1]; }
            const float xf[16] = {bf_lo(xq0.x), bf_hi(xq0.x), bf_lo(xq0.y), bf_hi(xq0.y), bf_lo(xq0.z), bf_hi(xq0.z), bf_lo(xq0.w), bf_hi(xq0.w),
                                  bf_lo(xq1.x), bf_hi(xq1.x), bf_lo(xq1.y), bf_hi(xq1.y), bf_lo(xq1.z), bf_hi(xq1.z), bf_lo(xq1.w), bf_hi(xq1.w)};
            asm volatile("s_waitcnt lgkmcnt(0)" ::: "memory");
            u32x4 R0[8], R1[8], R2[8];
#define U_ISSUE(R_, g0_) do { _Pragma("unroll") for (int k = 0; k < 8; ++k) { const int slot_ = ((g0_) + k < n) ? (g0_) + k : n - 1; const int e_ = LE[slot_]; R_[k] = *(const u32x4*)(UB + (size_t)e_ * 1024 + lane * 16); } } while (0)
#define U_DOTS(R_, g0_) do { float pp_[8]; _Pragma("unroll") for (int k = 0; k < 8; ++k) pp_[k] = dot16_fp8(R_[k], xf); const float dsum_ = reduce8(pp_, lane); const int slot_ = (g0_) + g8; \
            if (slot_ < n && (lane & 7) == 0) { const float d_ = dsum_ * usc; \
                ((GAS float*)(ws + WS_PW))[(size_t)tok * 128 + LP[slot_]] = 0.5f * d_ * (1.0f + erff(d_ * 0.70710678118654752f)) * LG[slot_] * vsc; } } while (0)
            if (n > 0) U_ISSUE(R0, 0);
            if (n > 8) U_ISSUE(R1, 8);
            if (n > 16) U_ISSUE(R2, 16);
            const int tokN = tok + nloc * 8;
            if (tokN < T) U_INFO(tokN);
            if (n > 0) U_DOTS(R0, 0);
            if (n > 8) U_DOTS(R1, 8);
            if (n > 16) U_DOTS(R2, 16);
            for (int g0 = 24; g0 < n; g0 += 8) { U_ISSUE(R0, g0); U_DOTS(R0, g0); }
            asm volatile("s_waitcnt lgkmcnt(0)" ::: "memory");
        }
#undef U_INFO
#undef U_ISSUE
#undef U_DOTS
    }
}

#define EV_OFF(ev_, g_) (((g_) & 1) ? ((ev_[(g_) >> 3][((g_) >> 1) & 3] >> 9) & 0x7fff80u) : ((ev_[(g_) >> 3][((g_) >> 1) & 3] << 7) & 0x7fff80u))
struct XcdSlice { int nloc, nx, rank, q; };
__device__ __forceinline__ XcdSlice xcd_slice_setup(const DArgs& a, LAS unsigned char* lds) {
    volatile LAS unsigned* bst = (volatile LAS unsigned*)(lds + LDS_BARST);
    XcdSlice x; x.nloc = __builtin_amdgcn_readfirstlane((int)bst[0]); x.nx = __builtin_amdgcn_readfirstlane((int)bst[1]); x.rank = __builtin_amdgcn_readfirstlane((int)bst[2]);
    unsigned* bar = (unsigned*)(a.ws + WS_CTL) + CW_BAR; const unsigned myx = xb_xcc_id();
    x.q = 0; for (unsigned j = 0; j < 16; ++j) { const unsigned c = xb_ld(&bar[XB_XCNT(j)]); if (c > 0u && j < myx) ++x.q; }
    x.q = __builtin_amdgcn_readfirstlane(x.q);
    return x;
}
__device__ __forceinline__ void phase_ua(const DArgs& a, LAS unsigned char* lds) {
    const int tid = tid_(), lane = tid & 63, wave = __builtin_amdgcn_readfirstlane(tid >> 6), k = lane >> 3, c = lane & 7;
    GAS unsigned char* ws = a.ws;
    const XcdSlice X = xcd_slice_setup(a, lds);
    const int tstride = X.nloc * 8;
    for (int sl = X.q; sl < 8; sl += X.nx) {
        const GAS unsigned char* UBs = ws + WS_UB + (size_t)sl * 2097152;
        const unsigned coff = (unsigned)c * 16u;
        GAS unsigned char* PU = ws + WS_PARTU + (size_t)sl * T * 256;
        u32x4 evA[2], evB[2], RA[16], RB[16], xa, xb; float sa, sb;
#define A_TOK(t_) ((t_) < T ? (t_) : T - 1)
#define A_INFO(ev_, t_) do { const int tq_ = A_TOK(t_); _Pragma("unroll") for (int j_ = 0; j_ < 2; ++j_) ev_[j_] = *(const GAS u32x4*)(ws + WS_EIDX + (size_t)tq_ * 256 + (unsigned)(32 * k + 16 * j_)); } while (0)
#define A_ISSUE(R_, x_, s_, ev_, t_) do { const int tq_ = A_TOK(t_); _Pragma("unroll") for (int g_ = 0; g_ < 16; ++g_) R_[g_] = *(const GAS u32x4*)(UBs + (EV_OFF(ev_, g_) | coff)); \
        x_ = *(const GAS u32x4*)(ws + WS_XQ + (size_t)tq_ * 1024 + sl * 128 + coff); s_ = ((const GAS float*)(ws + WS_XQS))[tq_]; } while (0)
#define A_DOTS(R_, x_, s_, t_) do { \
        int ir0_ = 0, ir1_ = 0; \
        _Pragma("unroll") for (int gg_ = 0; gg_ < 4; ++gg_) {           \
            int d_[4]; _Pragma("unroll") for (int q_ = 0; q_ < 4; ++q_) d_[q_] = 0; \
            _Pragma("unroll") for (int j_ = 0; j_ < 4; ++j_) { _Pragma("unroll") for (int q_ = 0; q_ < 4; ++q_) d_[q_] = __builtin_amdgcn_sdot4((int)R_[4 * gg_ + q_][j_], (int)x_[j_], d_[q_], false); } \
            _Pragma("unroll") for (int q_ = 0; q_ < 4; ++q_) d_[q_] += DPPI_(d_[q_], 0xB1); \
            _Pragma("unroll") for (int q_ = 0; q_ < 4; ++q_) d_[q_] += DPPI_(d_[q_], 0x4E); \
            _Pragma("unroll") for (int q_ = 0; q_ < 4; ++q_) d_[q_] += DPPI_(d_[q_], 0x141);          \
            _Pragma("unroll") for (int q_ = 0; q_ < 4; ++q_) { if (c == ((4 * gg_ + q_) >> 1)) { if (q_ & 1) ir1_ = d_[q_]; else ir0_ = d_[q_]; } }          \
            __builtin_amdgcn_sched_barrier(0); } \
        if ((t_) < T) *(GAS unsigned*)(PU + (size_t)(t_) * 256 + (unsigned)(4 * lane)) = pk2((float)ir0_ * s_, (float)ir1_ * s_); } while (0)
        const int n0 = X.rank * 8 + wave;
        A_INFO(evA, n0); A_INFO(evB, n0 + tstride);
        __builtin_amdgcn_sched_barrier(0);
        A_ISSUE(RA, xa, sa, evA, n0);
        __builtin_amdgcn_sched_barrier(0);
#pragma unroll 1
        for (int n = n0; n < T; n += 2 * tstride) {
            A_INFO(evA, n + 2 * tstride);
            __builtin_amdgcn_sched_barrier(0);
            A_ISSUE(RB, xb, sb, evB, n + tstride);
            __builtin_amdgcn_sched_barrier(0);
            A_DOTS(RA, xa, sa, n);
            __builtin_amdgcn_sched_barrier(0);
            A_INFO(evB, n + 3 * tstride);
            __builtin_amdgcn_sched_barrier(0);
            A_ISSUE(RA, xa, sa, evA, n + 2 * tstride);
            __builtin_amdgcn_sched_barrier(0);
            A_DOTS(RB, xb, sb, n + tstride);
            __builtin_amdgcn_sched_barrier(0);
        }
#undef A_TOK
#undef A_INFO
#undef A_ISSUE
#undef A_DOTS
    }
}
__device__ __forceinline__ void phase_ua2(const DArgs& a, int vcu, int G) {
    const int tid = tid_();
    GAS unsigned char* ws = a.ws;
    const GAS float* USC = (const GAS float*)(ws + WS_USC); const GAS float* VSC = (const GAS float*)(ws + WS_VSC);
    const GAS unsigned char* PU = ws + WS_PARTU;
    const size_t N4 = (size_t)T * 128 / 4, stride = (size_t)G * NTHR;
    for (size_t i = (size_t)vcu * NTHR + tid; i < N4; i += 2 * stride) {
        const size_t i1 = (i + stride < N4) ? i + stride : i;
        u32x2 pv0[8], pv1[8];
#pragma unroll
        for (int sl = 0; sl < 8; ++sl) { pv0[sl] = ((const GAS u32x2*)(PU + (size_t)sl * T * 256))[i]; pv1[sl] = ((const GAS u32x2*)(PU + (size_t)sl * T * 256))[i1]; }
        const f32x4 gt0 = ((const GAS f32x4*)(ws + WS_GATE))[i], gt1 = ((const GAS f32x4*)(ws + WS_GATE))[i1];
        const u32x2 ep0 = ((const GAS u32x2*)(ws + WS_EIDX))[i], ep1 = ((const GAS u32x2*)(ws + WS_EIDX))[i1];
        const unsigned e0[4] = {ep0.x & 0xffffu, ep0.x >> 16, ep0.y & 0xffffu, ep0.y >> 16}, e1[4] = {ep1.x & 0xffffu, ep1.x >> 16, ep1.y & 0xffffu, ep1.y >> 16};
        float us0[4], vs0[4], us1[4], vs1[4];
#pragma unroll
        for (int e = 0; e < 4; ++e) { us0[e] = USC[e0[e]]; vs0[e] = VSC[e0[e]]; us1[e] = USC[e1[e]]; vs1[e] = VSC[e1[e]]; }
        f32x4 d0 = (f32x4){0.f, 0.f, 0.f, 0.f}, d1 = d0;
#pragma unroll
        for (int sl = 0; sl < 8; ++sl) { d0[0] += bf_lo(pv0[sl].x); d0[1] += bf_hi(pv0[sl].x); d0[2] += bf_lo(pv0[sl].y); d0[3] += bf_hi(pv0[sl].y);
                                         d1[0] += bf_lo(pv1[sl].x); d1[1] += bf_hi(pv1[sl].x); d1[2] += bf_lo(pv1[sl].y); d1[3] += bf_hi(pv1[sl].y); }
        f32x4 w0, w1;
#pragma unroll
        for (int e = 0; e < 4; ++e) { w0[e] = gelu_erf(d0[e] * us0[e]) * gt0[e] * vs0[e]; w1[e] = gelu_erf(d1[e] * us1[e]) * gt1[e] * vs1[e]; }
        u32x2 wo; wo.x = pk2(w0[0], w0[1]); wo.y = pk2(w0[2], w0[3]); ((GAS u32x2*)(ws + WS_PW))[i] = wo;
        if (i + stride < N4) { wo.x = pk2(w1[0], w1[1]); wo.y = pk2(w1[2], w1[3]); ((GAS u32x2*)(ws + WS_PW))[i1] = wo; }
    }
}
__device__ __forceinline__ void phase_vb(const DArgs& a, LAS unsigned char* lds) {
    const int tid = tid_(), lane = tid & 63, wave = __builtin_amdgcn_readfirstlane(tid >> 6), k = lane >> 3, c = lane & 7;
    GAS unsigned char* ws = a.ws;
    const XcdSlice X = xcd_slice_setup(a, lds);
    const int tstride = X.nloc * 8;
    const bool bit3 = (lane & 8) != 0;
    for (int sl = X.q; sl < 8; sl += X.nx) {
        const GAS unsigned char* VBs = ws + WS_VB + (size_t)sl * 2097152;
        const unsigned coff = (unsigned)c * 16u;
        const unsigned xoff = (unsigned)(sl * 128 + c * 16 + 2 * k) * 4u;
        u32x4 evA[2], evB[2], RA[16], RB[16], wa[2], wb[2]; unsigned xa, xb;
#define B_TOK(t_) ((t_) < T ? (t_) : T - 1)
#define B_INFO(ev_, t_) do { const int tq_ = B_TOK(t_); _Pragma("unroll") for (int j_ = 0; j_ < 2; ++j_) ev_[j_] = *(const GAS u32x4*)(ws + WS_EIDX + (size_t)tq_ * 256 + (unsigned)(32 * k + 16 * j_)); } while (0)
#define B_ISSUE(R_, w_, x_, ev_, t_) do { const int tq_ = B_TOK(t_); _Pragma("unroll") for (int g_ = 0; g_ < 16; ++g_) R_[g_] = *(const GAS u32x4*)(VBs + (EV_OFF(ev_, g_) | coff)); \
        _Pragma("unroll") for (int j_ = 0; j_ < 2; ++j_) w_[j_] = *(const GAS u32x4*)(ws + WS_PW + (size_t)tq_ * 256 + (unsigned)(32 * k + 16 * j_)); \
        x_ = *(const GAS unsigned*)((const GAS unsigned char*)a.out + (size_t)tq_ * (D * 2) + (xoff >> 1)); } while (0)
#define B_DOTS(R_, w_, x_, t_) do { \
        f32x2 acc2_[8]; _Pragma("unroll") for (int e_ = 0; e_ < 8; ++e_) acc2_[e_] = (f32x2){0.f, 0.f}; \
        _Pragma("unroll") for (int g_ = 0; g_ < 16; ++g_) { const unsigned ww_ = w_[g_ >> 3][(g_ >> 1) & 3]; const float wk_ = (g_ & 1) ? bf_hi(ww_) : bf_lo(ww_); const f32x2 wp_ = (f32x2){wk_, wk_}; \
            _Pragma("unroll") for (int jj_ = 0; jj_ < 4; ++jj_) { acc2_[2 * jj_] += wp_ * FP8LO(R_[g_][jj_]); acc2_[2 * jj_ + 1] += wp_ * FP8HI(R_[g_][jj_]); } \
            if (g_ & 1) __builtin_amdgcn_sched_barrier(0); } \
        f32x2 w2_[4], x2_[2], y_; \
        _Pragma("unroll") for (int i_ = 0; i_ < 4; ++i_) { w2_[i_][0] = rs32_(acc2_[i_][0], acc2_[i_ + 4][0]); w2_[i_][1] = rs32_(acc2_[i_][1], acc2_[i_ + 4][1]); } \
        _Pragma("unroll") for (int i_ = 0; i_ < 2; ++i_) { x2_[i_][0] = rs16_(w2_[i_][0], w2_[i_ + 2][0]); x2_[i_][1] = rs16_(w2_[i_][1], w2_[i_ + 2][1]); } \
        y_[0] = rs8_(x2_[0][0], x2_[1][0], bit3) + bf_lo(x_); y_[1] = rs8_(x2_[0][1], x2_[1][1], bit3) + bf_hi(x_); \
        const float ss_ = wave_sum(y_[0] * y_[0] + y_[1] * y_[1], lane); \
        if ((t_) < T) { *(GAS unsigned*)(ws + WS_PARTU + (size_t)(t_) * (D * 2) + (xoff >> 1)) = pk2(y_[0], y_[1]);       \
            if (lane == 0) ((GAS float*)(ws + WS_SS))[(size_t)(t_) * 8 + sl] = ss_; } } while (0)
        const int n0 = X.rank * 8 + wave;
        B_INFO(evA, n0); B_INFO(evB, n0 + tstride);
        __builtin_amdgcn_sched_barrier(0);
        B_ISSUE(RA, wa, xa, evA, n0);
        __builtin_amdgcn_sched_barrier(0);
#pragma unroll 1
        for (int n = n0; n < T; n += 2 * tstride) {
            B_INFO(evA, n + 2 * tstride);
            __builtin_amdgcn_sched_barrier(0);
            B_ISSUE(RB, wb, xb, evB, n + tstride);
            __builtin_amdgcn_sched_barrier(0);
            B_DOTS(RA, wa, xa, n);
            __builtin_amdgcn_sched_barrier(0);
            B_INFO(evB, n + 3 * tstride);
            __builtin_amdgcn_sched_barrier(0);
            B_ISSUE(RA, wa, xa, evA, n + 2 * tstride);
            __builtin_amdgcn_sched_barrier(0);
            B_DOTS(RB, wb, xb, n + tstride);
            __builtin_amdgcn_sched_barrier(0);
        }
#undef B_TOK
#undef B_INFO
#undef B_ISSUE
#undef B_DOTS
    }
}
__device__ __forceinline__ void phase_vc(const DArgs& a, int vcu, int G) {
    const int tid = tid_(), lane = tid & 63, wave = tid >> 6;
    const int gw = vcu * NWAVES + wave, NGW = G * NWAVES;
    GAS unsigned char* ws = a.ws;
    f32x4 gf[4];
#pragma unroll
    for (int j = 0; j < 4; ++j) gf[j] = ((const GAS f32x4*)a.final_g)[64 * j + lane];
    for (int m = gw; m < T; m += NGW) {
        const f32x4 s0 = *(const GAS f32x4*)((const GAS float*)(ws + WS_SS) + (size_t)m * 8), s1 = *(const GAS f32x4*)((const GAS float*)(ws + WS_SS) + (size_t)m * 8 + 4);
        const float rstd = rsqrtf(((s0[0] + s0[1]) + (s0[2] + s0[3]) + (s1[0] + s1[1]) + (s1[2] + s1[3])) * (1.f / D) + EPS);
        const GAS u32x2* xi = (const GAS u32x2*)(ws + WS_PARTU + (size_t)m * (D * 2)) + lane;
        GAS f32x4* o = (GAS f32x4*)(a.out + (size_t)m * D) + lane;
#pragma unroll
        for (int j = 0; j < 4; ++j) { const u32x2 xv = xi[64 * j]; f32x4 v; v[0] = bf_lo(xv.x); v[1] = bf_hi(xv.x); v[2] = bf_lo(xv.y); v[3] = bf_hi(xv.y); o[64 * j] = v * rstd * gf[j]; }
    }
}

__device__ __forceinline__ void phase_final_plain(const DArgs& a, const float* src, int vcu, int G) {
    const int tid = tid_(), lane = tid & 63, wave = tid >> 6;
    const int gw = vcu * NWAVES + wave, NGW = G * NWAVES;
    f32x4 gf[4];
#pragma unroll
    for (int j = 0; j < 4; ++j) gf[j] = ((const f32x4*)a.final_g)[64 * j + lane];
    for (int m = gw; m < T; m += NGW) {
        const f32x4* xr = (const f32x4*)(src + (size_t)m * D) + lane;
        f32x4 v[4]; float s = 0.f;
#pragma unroll
        for (int j = 0; j < 4; ++j) { v[j] = xr[64 * j]; s += (v[j][0] * v[j][0] + v[j][1] * v[j][1]) + (v[j][2] * v[j][2] + v[j][3] * v[j][3]); }
        const float rstd = rsqrtf(wave_sum(s, lane) * (1.f / D) + EPS);
        f32x4* o = (f32x4*)(a.out + (size_t)m * D) + lane;
#pragma unroll
        for (int j = 0; j < 4; ++j) o[64 * j] = v[j] * rstd * gf[j];
    }
}


__device__ __forceinline__ DArgs load_args() {
    DArgs r;
#if defined(__HIP_DEVICE_COMPILE__)
    typedef const DArgs __attribute__((address_space(4))) KArgs;
    KArgs* p = (KArgs*)__builtin_amdgcn_kernarg_segment_ptr();
    asm volatile("" : "+s"(p));
    r.x = p->x; r.norm1_g = p->norm1_g; r.w_in = p->w_in; r.b_in = p->b_in; r.conv_w = p->conv_w; r.conv_b = p->conv_b; r.m_head_g = p->m_head_g; r.lb_table = p->lb_table;
    r.g_head_g = p->g_head_g; r.w_br_m = p->w_br_m; r.w_br_g = p->w_br_g; r.w_out = p->w_out; r.norm2_g = p->norm2_g; r.w_pq = p->w_pq; r.sub_keys = p->sub_keys;
    r.u_emb = p->u_emb; r.v_emb = p->v_emb; r.final_g = p->final_g; r.out = p->out; r.ws = p->ws;
#else
    r = DArgs{};
#endif
    return r;
}
__device__ __forceinline__ EpiPtrs make_ep(const DArgs& a, int round) {
    EpiPtrs ep; ep.biasp = (const GAS float*)(a.ws + WS_BIASP); ep.lb = (const GAS float*)(a.ws + WS_LB); ep.x = a.x; ep.out = a.out; ep.ws = a.ws; ep.round = round; ep.pn0 = 0; ep.sa = (const GAS float*)(a.ws + WS_SA8); ep.sb = (const GAS float*)(a.ws + WS_SB8); ep.sym = (const GAS float*)(a.ws + WS_SYM); ep.syg = (const GAS float*)(a.ws + WS_SYG); ep.sxq = (const GAS float*)(a.ws + WS_XQS); return ep;
}
#define GRID_SYNC() do { const DArgs a_ = load_args(); xcd_barrier((unsigned*)(a_.ws + WS_CTL) + CW_BAR, (volatile LAS unsigned*)(lds + LDS_BARST)); } while (0)

__device__ __forceinline__ int bx_() { int t = blockIdx.x; asm volatile("" : "+s"(t)); return t; }
__device__ __forceinline__ int gd_() { int t = gridDim.x; asm volatile("" : "+s"(t)); return t; }
#define PH_BEGIN const DArgs a = load_args(); const int bx = bx_(), G = gd_(); const int vcu = (G % 8 == 0) ? (bx % 8) * (G / 8) + bx / 8 : bx; (void)vcu; (void)bx;

__global__ void __launch_bounds__(NTHR, 2) fwd_megakernel(Args a_unused) {
    extern __shared__ __attribute__((aligned(16))) unsigned char lds_raw[];
    LAS unsigned char* lds = (LAS unsigned char*)lds_raw;
    cg::grid_group grid = cg::this_grid();

    { const int t_ = tid_(); if (t_ < 16) ((LAS unsigned*)(lds + LDS_BARST))[t_] = 0u; __syncthreads();
      const DArgs a_ = load_args(); xcd_barrier_post((unsigned*)(a_.ws + WS_CTL) + CW_BAR, (volatile LAS unsigned*)(lds + LDS_BARST)); }
    { PH_BEGIN phase_p0(a, lds, vcu, G); }
    grid.sync();
    { PH_BEGIN phase_p0c(a, lds, vcu, G); }
    GRID_SYNC();
#pragma unroll 1
    for (int round = 0; round < NROUND; ++round) {
        {
            PH_BEGIN
            pg8::Gemm g{(const bf16_t*)(a.ws + WS_XN8 + (size_t)round * RT * 1024), (const bf16_t*)(a.ws + WS_W8A), RT, N1, D / 2};
            pg8::StaticOrder S; S.init(RT, N1, G, bx);
            EpiX<7> E{make_ep(a, round)};
            pg8::gemm_phase<EpiX<7>, pg8::StaticOrder, true, true, true>(lds, g, S, E);
        }
        { PH_BEGIN if (bx < 8) mscan_pair(a, lds, round, bx); }
        GRID_SYNC();
        { PH_BEGIN for (int it = bx; it < 512; it += G) mlstm_pre_item(a, lds, round, it); }
        { PH_BEGIN u32x4 gq[4]; int it = bx; if (it < 2048) hgrn_pre_load(a, round, it, gq);
          for (; it < 2048; it += G) hgrn_pre_item(a, lds, round, it, gq, it + G); }
        GRID_SYNC();
        { PH_BEGIN
          if (bx < 128) mlstm_scan<2, false>(a, lds, round, bx & 7, bx >> 3);
          else if (bx >= 192 && bx < 200) mlstm_scan<1, true>(a, lds, round, bx - 192, 0);
          else if (bx < 192) { const int id2 = bx - 128; hgrn_scan(a, lds, round, (id2 & 7) * 2 + ((id2 >> 3) & 1), id2 >> 4); }
          else if (G >= 232) {
              pg8::Gemm g{(const bf16_t*)(a.ws + WS_XN8 + (size_t)round * RT * 1024), (const bf16_t*)(a.ws + WS_W8 + (size_t)2048 * 1024), RT, 1024, D / 2};
              pg8::StaticOrder S; S.init(RT, 1024, G - 200, bx - 200);
              EpiPtrs ep = make_ep(a, round); ep.pn0 = 8; EpiX<2> E{ep};
              pg8::gemm_phase<EpiX<2>, pg8::StaticOrder, true, true, true>(lds, g, S, E); } }
        GRID_SYNC();
#define G2_PART(pn0_, ncol_) { PH_BEGIN \
            pg8::Gemm g{(const bf16_t*)(a.ws + WS_XN8 + (size_t)round * RT * 1024), (const bf16_t*)(a.ws + WS_W8 + (size_t)(pn0_) * 256 * 1024), RT, (ncol_), D / 2};       \
            pg8::StaticOrder S; S.init(RT, (ncol_), G, bx); \
            EpiPtrs ep = make_ep(a, round); ep.pn0 = (pn0_); EpiX<2> E{ep}; \
            pg8::gemm_phase<EpiX<2>, pg8::StaticOrder, true, true, true>(lds, g, S, E); }
        G2_PART(0, 2048)
        G2_PART(12, 2048)
        if (gd_() < 232) G2_PART(8, 1024)
#undef G2_PART
        GRID_SYNC();
        { PH_BEGIN phase_ypass(a, round, vcu, G); }
        GRID_SYNC();
        {
            { PH_BEGIN pg8::StaticOrder S; S.init(RT, D, G, bx);
              pg8::Gemm g{(const bf16_t*)(a.ws + WS_V), (const bf16_t*)(a.ws + WS_WM), RT, D, 2048 / 2}; EpiX<3> E{make_ep(a, round)}; pg8::gemm_phase<EpiX<3>, pg8::StaticOrder, true, true, true>(lds, g, S, E); }
            { PH_BEGIN pg8::StaticOrder S; S.init(RT, D, G, bx);
              pg8::Gemm g{(const bf16_t*)(a.ws + WS_GI), (const bf16_t*)(a.ws + WS_WG), RT, D, D / 2}; EpiX<4> E{make_ep(a, round)}; pg8::gemm_phase<EpiX<4>, pg8::StaticOrder, true, true, true>(lds, g, S, E); }
        }
        GRID_SYNC();
        {
            PH_BEGIN pg8::StaticOrder S; S.init(RT, D, G, bx);
            pg8::Gemm g{(const bf16_t*)(a.ws + WS_GFLOG), (const bf16_t*)(a.ws + WS_WO), RT, D, D}; EpiX<5> E{make_ep(a, round)}; pg8::gemm_phase<EpiX<5>, pg8::StaticOrder, true, true>(lds, g, S, E);
        }
        GRID_SYNC();
    }
    { PH_BEGIN phase_p8(a, vcu, G); }
    GRID_SYNC();
    {
        PH_BEGIN pg8::StaticOrder S; S.init(T, 2048, G, bx);
        pg8::Gemm g{(const bf16_t*)(a.ws + WS_XQ), (const bf16_t*)(a.ws + WS_WPQ), T, 2048, D / 2}; EpiX<6> E{make_ep(a, 0)}; pg8::gemm_phase<EpiX<6>, pg8::StaticOrder, true, true, true>(lds, g, S, E);
    }
    GRID_SYNC();
#ifdef TOPK_REF
    { PH_BEGIN phase_topk_ref(a, vcu, G); }
#else
    { PH_BEGIN phase_topk(a, lds, bx, G); }
#endif
    GRID_SYNC();
    { PH_BEGIN phase_ua(a, lds); }
    GRID_SYNC();
    { PH_BEGIN phase_ua2(a, vcu, G); }
    GRID_SYNC();
    { PH_BEGIN phase_vb(a, lds); }
    GRID_SYNC();
    { PH_BEGIN phase_vc(a, vcu, G); }
}

extern "C" void kernel_launch(void* const* d_in, const int* in_sizes, int n_in, void* d_out, int out_size, void* d_ws, size_t ws_size, hipStream_t stream) {
    static int grid = 0;
    if (grid == 0) {
        if (n_in != 18 || in_sizes[0] != T * D || out_size != T * D || ws_size < WS_END) {
            fprintf(stderr, "kernel_launch: unexpected shapes/workspace (n_in %d, in0 %d, out %d, ws %zu, need %zu)\n", n_in, n_in > 0 ? in_sizes[0] : -1, out_size, ws_size, (size_t)WS_END);
            grid = -1; return; }
        int dev = 0, cus = 0, per_cu = 0;
        hipGetDevice(&dev);
        hipDeviceGetAttribute(&cus, hipDeviceAttributeMultiprocessorCount, dev);
        hipFuncSetAttribute((const void*)fwd_megakernel, hipFuncAttributeMaxDynamicSharedMemorySize, LDS_BYTES);
        hipOccupancyMaxActiveBlocksPerMultiprocessor(&per_cu, (const void*)fwd_megakernel, NTHR, LDS_BYTES);
        if (per_cu < 1) { fprintf(stderr, "kernel_launch: occupancy query says %d blocks/CU\n", per_cu); per_cu = 1; }
        grid = cus;
        (void)hipGetLastError();
    }
    if (grid < 0) return;
    hipMemsetAsync((char*)d_ws + WS_CTL, 0, 131072, stream);
    Args a{};
    a.x = (const float*)d_in[0]; a.norm1_g = (const float*)d_in[1]; a.w_in = (const float*)d_in[2]; a.b_in = (const float*)d_in[3];
    a.conv_w = (const float*)d_in[4]; a.conv_b = (const float*)d_in[5]; a.m_head_g = (const float*)d_in[6]; a.lb_table = (const float*)d_in[7];
    a.g_head_g = (const float*)d_in[8]; a.w_br_m = (const float*)d_in[9]; a.w_br_g = (const float*)d_in[10]; a.w_out = (const float*)d_in[11];
    a.norm2_g = (const float*)d_in[12]; a.w_pq = (const float*)d_in[13]; a.sub_keys = (const float*)d_in[14]; a.u_emb = (const float*)d_in[15];
    a.v_emb = (const float*)d_in[16]; a.final_g = (const float*)d_in[17];
    a.out = (float*)d_out; a.ws = (unsigned char*)d_ws;
    void* args[] = {&a};
    hipError_t e = hipLaunchCooperativeKernel((const void*)fwd_megakernel, dim3(grid), dim3(NTHR), args, LDS_BYTES, stream);
    if (e != hipSuccess) fprintf(stderr, "cooperative launch failed: %s (grid %d)\n", hipGetErrorString(e), grid);
}
```

```cpp
#include <hip/hip_runtime.h>
#include <hip/hip_cooperative_groups.h>
#include <cstdio>
#include <cstdint>
namespace cg = cooperative_groups;

#define LAS __attribute__((address_space(3)))
typedef unsigned short bf16_t;
typedef short bf16x8 __attribute__((ext_vector_type(8)));
typedef float f32x4 __attribute__((ext_vector_type(4)));
typedef float f32x2 __attribute__((ext_vector_type(2)));
typedef unsigned u32x4 __attribute__((ext_vector_type(4)));
typedef unsigned u32x2 __attribute__((ext_vector_type(2)));

constexpr int D = 1024, BATCH = 4, SEQ = 8192, T = BATCH * SEQ;
constexpr int IN_COLS = 12296, NP = 12288;
constexpr int RT = 16384, NROUND = 2;
constexpr int N1 = 7168, N2 = 5120;
constexpr float EPS = 1e-6f;
constexpr int NWAVES = 8, NTHR = 512;

constexpr size_t MiB = 1u << 20;
constexpr size_t WS_CTL = 0;
constexpr size_t WS_WIN = 1 * MiB;
constexpr size_t WS_WM = 25 * MiB;
constexpr size_t WS_WG = 29 * MiB;
constexpr size_t WS_WO = 31 * MiB;
constexpr size_t WS_WPQ = 33 * MiB;
constexpr size_t WS_SK = 37 * MiB;
constexpr size_t WS_BIASP = 37 * MiB + 512 * 1024;
constexpr size_t WS_LB = WS_BIASP + 64 * 1024;
constexpr size_t WS_GATES = 38 * MiB;
constexpr size_t WS_MPREV = 39 * MiB;
constexpr size_t WS_DEN = 40 * MiB;
constexpr size_t WS_MT = 40 * MiB + 512 * 1024;
constexpr size_t WS_HGDEC = 41 * MiB;
constexpr size_t WS_MDEC = 43 * MiB;
constexpr size_t WS_XN = 44 * MiB;
constexpr size_t WS_QKPRE = 108 * MiB;
constexpr size_t WS_V = 172 * MiB;
constexpr size_t WS_GFLOG = 236 * MiB;
constexpr size_t WS_GI = 268 * MiB;
constexpr size_t WS_GQ = 300 * MiB;
constexpr size_t WS_S = 332 * MiB;
constexpr size_t WS_QT = 348 * MiB;
constexpr size_t WS_KWT = 380 * MiB;
constexpr size_t WS_ATT = 412 * MiB;
constexpr size_t WS_QTG = 428 * MiB;
constexpr size_t WS_KENDT = 460 * MiB;
constexpr size_t WS_SIGO = 332 * MiB;
constexpr size_t WS_SGG = 76 * MiB;
constexpr size_t WS_SAM = 428 * MiB;
constexpr size_t WS_SAG = 460 * MiB;
constexpr size_t WS_XN8 = 44 * MiB;
constexpr size_t WS_SA8 = 508 * MiB;
constexpr size_t WS_SB8 = 508 * MiB + 262144;
constexpr size_t WS_W8A = WS_WIN;
constexpr size_t WS_W8 = WS_WIN + (size_t)7168 * 1024;
constexpr int NI8 = 12288 + 1024 + 1024 + 2048;
constexpr size_t WS_SYM = 508 * MiB + 524288;
constexpr size_t WS_SYG = 508 * MiB + 655360;
constexpr int CW_COLMAX = 16384;
constexpr size_t WS_END = 510 * MiB;
constexpr size_t WS_QP = 108 * MiB;
constexpr size_t WS_UB = 236 * MiB;
constexpr size_t WS_VB = 252 * MiB;
constexpr size_t WS_USC = 268 * MiB;
constexpr size_t WS_VSC = 268 * MiB + 65536;
constexpr size_t WS_EIDX = 300 * MiB;
constexpr size_t WS_GATE = 316 * MiB;
constexpr size_t WS_XQ = 380 * MiB;
constexpr size_t WS_XQS = 412 * MiB;
constexpr size_t WS_PARTU = 108 * MiB;
constexpr size_t WS_SS = 348 * MiB;
constexpr size_t WS_PW = 332 * MiB;

constexpr int CW_TMAX = 64;
constexpr int LDS_BYTES = 147456;

__device__ __forceinline__ unsigned f2bf(float f) { unsigned u = __builtin_bit_cast(unsigned, f); return (u + 0x7fffu + ((u >> 16) & 1u)) >> 16; }
typedef __bf16 bf16x2_t __attribute__((ext_vector_type(2)));
__device__ __forceinline__ unsigned pk2(float lo, float hi) { bf16x2_t v; v[0] = (__bf16)lo; v[1] = (__bf16)hi; return __builtin_bit_cast(unsigned, v); }
__device__ __forceinline__ float bf_lo(unsigned w) { return __builtin_bit_cast(float, w << 16); }
__device__ __forceinline__ float bf_hi(unsigned w) { return __builtin_bit_cast(float, w & 0xffff0000u); }
__device__ __forceinline__ float bf2f(bf16_t h) { return __builtin_bit_cast(float, ((unsigned)h) << 16); }
__device__ __forceinline__ float shx(float v, int o, int lane) { return __builtin_bit_cast(float, __builtin_amdgcn_ds_bpermute((lane ^ o) << 2, __builtin_bit_cast(int, v))); }
__device__ __forceinline__ float shup(float v, int o, int lane) { return __builtin_bit_cast(float, __builtin_amdgcn_ds_bpermute(((lane - o) & 63) << 2, __builtin_bit_cast(int, v))); }
__device__ __forceinline__ float rdlane(float v, int l) { return __builtin_bit_cast(float, __builtin_amdgcn_readlane(__builtin_bit_cast(int, v), l)); }
#define DPP_(v, ctrl) __builtin_bit_cast(float, __builtin_amdgcn_update_dpp(0, __builtin_bit_cast(int, (v)), (ctrl), 0xF, 0xF, false))
__device__ __forceinline__ float wave_sum(float v, int lane) {
    (void)lane;
    v += DPP_(v, 0xB1); v += DPP_(v, 0x4E); v += DPP_(v, 0x141); v += DPP_(v, 0x140);
    return (rdlane(v, 0) + rdlane(v, 16)) + (rdlane(v, 32) + rdlane(v, 48));
}
__device__ __forceinline__ float wave_max(float v) {
    v = fmaxf(v, DPP_(v, 0xB1)); v = fmaxf(v, DPP_(v, 0x4E)); v = fmaxf(v, DPP_(v, 0x141)); v = fmaxf(v, DPP_(v, 0x140));
    return fmaxf(fmaxf(rdlane(v, 0), rdlane(v, 16)), fmaxf(rdlane(v, 32), rdlane(v, 48)));
}
__device__ __forceinline__ unsigned pack_i8x4(float a, float b, float c, float d) {
    const int ia = (int)__builtin_rintf(a), ib = (int)__builtin_rintf(b), ic = (int)__builtin_rintf(c), id = (int)__builtin_rintf(d);
    return ((unsigned)ia & 255u) | (((unsigned)ib & 255u) << 8) | (((unsigned)ic & 255u) << 16) | ((unsigned)id << 24);
}
#define SWZI_(v, pat) __builtin_amdgcn_ds_swizzle((int)(v), (pat))
#define DPPI_(v, ctrl) __builtin_amdgcn_update_dpp(0, (int)(v), (ctrl), 0xF, 0xF, false)
__device__ __forceinline__ unsigned xor32u_(unsigned v, bool hi) {
#if defined(__HIP_DEVICE_COMPILE__)
    const auto r = __builtin_amdgcn_permlane32_swap(v, v, false, false);
    return hi ? r[0] : r[1];
#else
    (void)hi; return v;
#endif
}
__device__ __forceinline__ float sigmoidf_(float x) { return __builtin_amdgcn_rcpf(1.0f + __expf(-x)); }
__device__ __forceinline__ float siluf_(float x) { return x * __builtin_amdgcn_rcpf(1.0f + __expf(-x)); }
#define LDS_WAIT() asm volatile("s_waitcnt lgkmcnt(0)" ::: "memory")
__device__ __forceinline__ int tid_() { int t = threadIdx.x; asm volatile("" : "+v"(t)); return t; }

#define GAS __attribute__((address_space(1)))
struct DArgs {
    const GAS float* x; const GAS float* norm1_g; const GAS float* w_in; const GAS float* b_in; const GAS float* conv_w; const GAS float* conv_b;
    const GAS float* m_head_g; const GAS float* lb_table; const GAS float* g_head_g; const GAS float* w_br_m; const GAS float* w_br_g; const GAS float* w_out;
    const GAS float* norm2_g; const GAS float* w_pq; const GAS float* sub_keys; const GAS float* u_emb; const GAS float* v_emb; const GAS float* final_g;
    GAS float* out; GAS unsigned char* ws;
};
struct Args {
    const float* x; const float* norm1_g; const float* w_in; const float* b_in; const float* conv_w; const float* conv_b;
    const float* m_head_g; const float* lb_table; const float* g_head_g; const float* w_br_m; const float* w_br_g; const float* w_out;
    const float* norm2_g; const float* w_pq; const float* sub_keys; const float* u_emb; const float* v_emb; const float* final_g;
    float* out; unsigned char* ws;
};

namespace pg8 {
constexpr int BM = 256, BK = 64, HALF = 128, HTB = HALF * BK * 2, STAGE_BYTES = 8 * HTB, NXCD = 8, WGM = 8;
__host__ __device__ __forceinline__ int lds_byte(int r, int c) { const int st = (r >> 4) * 2 + (c >> 5), rr = r & 15, cc = c & 31, ob = rr * 64 + cc * 2; return st * 1024 + (ob ^ (((ob >> 9) & 1) << 5)); }
__host__ __device__ __forceinline__ void stage_rc(int b, int& R, int& C) { const int st = b / 1024, sb = b % 1024, swz = sb ^ (((sb >> 9) & 1) << 5); R = (st >> 1) * 16 + swz / 64; C = (st & 1) * 32 + (swz % 64) / 2; }
__host__ __device__ __forceinline__ int perm32(int rho) { const int n = rho >> 4, i = rho & 15; return 8 * (i >> 2) + 4 * n + (i & 3); }
struct Unit { int pm, pn; };
struct Gemm { const bf16_t* A; const bf16_t* Bt; int M, N, K; };
struct StaticOrder {
    int nM, nN, nwg, G, c;
    __host__ __device__ void init(int M, int N, int G_, int c_) { nM = M / BM; nN = N / BM; nwg = nM * nN; G = G_; c = c_; }
    __host__ __device__ bool next(int i, Unit& u) const {
        const long L = (long)i * G + c; if (L >= nwg) return false;
        int wgid = (int)L; { const int q = nwg / NXCD, r = nwg % NXCD, xcd = wgid % NXCD, off = wgid / NXCD; wgid = (xcd < r ? xcd * (q + 1) : r * (q + 1) + (xcd - r) * q) + off; }
        const int nig = WGM * nN, gid = wgid / nig, fm = gid * WGM, gsz = (nM - fm) < WGM ? (nM - fm) : WGM;
        u.pm = fm + ((wgid % nig) % gsz); u.pn = (wgid % nig) / gsz; return true;
    }
    __device__ __forceinline__ void a_ready(const Unit&) const {}
    __device__ __forceinline__ void done(const Unit&) const {}
};

typedef int i32x8 __attribute__((ext_vector_type(8)));
typedef int i32x4 __attribute__((ext_vector_type(4)));
template <class Epi, class Sched, bool ALIGN_EPI = false, bool SP2 = false, bool I8 = false>
__device__ __forceinline__ void gemm_phase(LAS unsigned char* lds, const Gemm g, const Sched& S, const Epi& E) {
    const int tid = tid_(), wid = __builtin_amdgcn_readfirstlane(tid >> 6), lane = tid & 63, wr = wid >> 2, wc = wid & 3, fr = lane & 15, fq = lane >> 4;
    const int K = g.K, nt = K / BK;
    unsigned voffA[2], voffB[2];
#pragma unroll
    for (int i = 0; i < 2; ++i) { int R, C; stage_rc(tid * 16 + i * 8192, R, C); const int Rb = Epi::PERM ? ((R & ~31) + perm32(R & 31)) : R;
        voffA[i] = (unsigned)(R * K + C) * 2u; voffB[i] = (unsigned)(Rb * K + C) * 2u; }
    const size_t kstep = (size_t)(BK * 2);
    const size_t hstep = (size_t)HALF * K * 2;
    const size_t tstep = 2 * hstep;
    const unsigned ldsw = (unsigned)wid * 1024u;
    const int aoff = lds_byte(wr * 64 + fr, fq * 8), boff = lds_byte(wc * 32 + fr, fq * 8);
#define PG8_SA(b, h) (((b) * 2 + (h)) * HTB)
#define PG8_SB(b, h) ((4 + (b) * 2 + (h)) * HTB)
#define PG8_STAGE(bufoff, gbase, voff) do { _Pragma("unroll") for (int _i = 0; _i < 2; ++_i) \
        __builtin_amdgcn_global_load_lds((const unsigned*)((const char*)(gbase) + (voff)[_i]), (LAS unsigned*)(lds + (bufoff) + ldsw + _i * 8192), 16, 0, 0); } while (0)
#define PG8_LDA(dst, b, h) do { _Pragma("unroll") for (int m = 0; m < 4; ++m) _Pragma("unroll") for (int k = 0; k < 2; ++k) dst[m][k] = *(const LAS bf16x8*)(lds + PG8_SA(b, h) + aoff + m * 2048 + k * 1024); } while (0)
#define PG8_LDB(dst, b, h) do { _Pragma("unroll") for (int n = 0; n < 2; ++n) _Pragma("unroll") for (int k = 0; k < 2; ++k) dst[n][k] = *(const LAS bf16x8*)(lds + PG8_SB(b, h) + boff + n * 2048 + k * 1024); } while (0)
#define PG8_MMA(ai, bj, At, Bt) do { __builtin_amdgcn_s_setprio(1); _Pragma("unroll") for (int m = 0; m < 4; ++m) _Pragma("unroll") for (int n = 0; n < 2; ++n) _Pragma("unroll") for (int k = 0; k < 2; ++k) { \
        if constexpr (I8) acc[ai][bj][m][n] = __builtin_bit_cast(f32x4, __builtin_amdgcn_mfma_i32_16x16x64_i8(__builtin_bit_cast(i32x4, Bt[n][k]), __builtin_bit_cast(i32x4, At[m][k]), __builtin_bit_cast(i32x4, acc[ai][bj][m][n]), 0, 0, 0)); \
        else acc[ai][bj][m][n] = __builtin_amdgcn_mfma_f32_16x16x32_bf16(Bt[n][k], At[m][k], acc[ai][bj][m][n], 0, 0, 0); } __builtin_amdgcn_s_setprio(0); } while (0)
#define PG8_WAIT_V(n) asm volatile("s_waitcnt vmcnt(" #n ")" ::: "memory")
#define PG8_WAIT_L(n) asm volatile("s_waitcnt lgkmcnt(" #n ")" ::: "memory")
#define PG8_BAR __builtin_amdgcn_s_barrier()
#define PG8_SCHED __builtin_amdgcn_sched_barrier(0)
    Unit cur, nxt; int ui = 0;
    if (!S.next(0, cur)) return;
    f32x4 acc[2][2][4][2];
#pragma unroll
    for (int a = 0; a < 2; ++a)
#pragma unroll
        for (int b = 0; b < 2; ++b)
#pragma unroll
            for (int m = 0; m < 4; ++m)
#pragma unroll
                for (int n = 0; n < 2; ++n) acc[a][b][m][n] = (f32x4){0.f, 0.f, 0.f, 0.f};
    bf16x8 At[4][2], B0[2][2], B1[2][2];
    const char* cA = (const char*)g.A + (size_t)cur.pm * tstep; const char* cB = (const char*)g.Bt + (size_t)cur.pn * tstep;
    S.a_ready(cur);
    if constexpr (SP2) {
        PG8_STAGE(PG8_SB(0, 0), cB, voffB); PG8_STAGE(PG8_SB(0, 1), cB + hstep, voffB); PG8_STAGE(PG8_SA(0, 0), cA, voffA); PG8_STAGE(PG8_SA(0, 1), cA + hstep, voffA);
        if (wr == 1) PG8_BAR;
        PG8_WAIT_V(2); PG8_BAR;
        PG8_STAGE(PG8_SB(1, 0), cB + kstep, voffB); PG8_STAGE(PG8_SA(1, 0), cA + kstep, voffA); PG8_STAGE(PG8_SB(1, 1), cB + hstep + kstep, voffB);
        PG8_WAIT_V(6); PG8_BAR;
    } else {
        PG8_STAGE(PG8_SB(0, 0), cB, voffB); PG8_STAGE(PG8_SA(0, 0), cA, voffA); PG8_STAGE(PG8_SB(0, 1), cB + hstep, voffB); PG8_STAGE(PG8_SA(0, 1), cA + hstep, voffA);
        if (wr == 1) PG8_BAR;
        PG8_WAIT_V(4); PG8_BAR;
        PG8_STAGE(PG8_SB(1, 0), cB + kstep, voffB); PG8_STAGE(PG8_SA(1, 0), cA + kstep, voffA); PG8_STAGE(PG8_SB(1, 1), cB + hstep + kstep, voffB);
        PG8_WAIT_V(6); PG8_BAR;
    }
    for (;;) {
        const bool has_next = S.next(ui + 1, nxt);
        const char* nA = has_next ? (const char*)g.A + (size_t)nxt.pm * tstep : cA; const char* nB = has_next ? (const char*)g.Bt + (size_t)nxt.pn * tstep : cB;
#pragma unroll 1
        for (int t = 0; t < nt; t += 2) {
            const bool last = (t == nt - 2);
            const char* a1 = cA + (size_t)(t + 1) * kstep;
            const char* a2 = last ? nA : cA + (size_t)(t + 2) * kstep; const char* b2 = last ? nB : cB + (size_t)(t + 2) * kstep;
            const char* a3 = a2 + kstep; const char* b3 = b2 + kstep;
            if (last && has_next) S.a_ready(nxt);
            if constexpr (SP2) {
            PG8_LDB(B0, 0, 0); PG8_LDB(B1, 0, 1); PG8_SCHED; PG8_LDA(At, 0, 0); PG8_STAGE(PG8_SA(1, 1), a1 + hstep, voffA);
            PG8_WAIT_V(8); PG8_WAIT_L(0); PG8_BAR; PG8_MMA(0, 0, At, B0); PG8_MMA(0, 1, At, B1); PG8_BAR; PG8_SCHED;
            PG8_LDA(At, 0, 1); PG8_STAGE(PG8_SB(0, 0), b2, voffB); PG8_STAGE(PG8_SB(0, 1), b2 + hstep, voffB); PG8_STAGE(PG8_SA(0, 0), a2, voffA);
            PG8_WAIT_V(8); PG8_WAIT_L(0); PG8_BAR; PG8_MMA(1, 0, At, B0); PG8_MMA(1, 1, At, B1); PG8_BAR; PG8_SCHED;
            PG8_LDB(B0, 1, 0); PG8_LDB(B1, 1, 1); PG8_SCHED; PG8_LDA(At, 1, 0); PG8_STAGE(PG8_SA(0, 1), a2 + hstep, voffA);
            PG8_WAIT_V(8); PG8_WAIT_L(0); PG8_BAR; PG8_MMA(0, 0, At, B0); PG8_MMA(0, 1, At, B1); PG8_BAR; PG8_SCHED;
            PG8_LDA(At, 1, 1); PG8_STAGE(PG8_SB(1, 0), b3, voffB); PG8_STAGE(PG8_SB(1, 1), b3 + hstep, voffB); PG8_STAGE(PG8_SA(1, 0), a3, voffA);
            PG8_WAIT_V(8); PG8_WAIT_L(0); PG8_BAR; PG8_MMA(1, 0, At, B0); PG8_MMA(1, 1, At, B1); PG8_BAR; PG8_SCHED;
            } else {
            PG8_LDB(B0, 0, 0); PG8_SCHED; PG8_LDA(At, 0, 0); PG8_STAGE(PG8_SA(1, 1), a1 + hstep, voffA);
            PG8_WAIT_L(8); PG8_BAR; PG8_WAIT_L(0); PG8_MMA(0, 0, At, B0); PG8_BAR; PG8_SCHED;
            PG8_LDB(B1, 0, 1); PG8_STAGE(PG8_SB(0, 0), b2, voffB);
            PG8_BAR; PG8_WAIT_L(0); PG8_MMA(0, 1, At, B1); PG8_BAR;
            PG8_LDA(At, 0, 1); PG8_STAGE(PG8_SA(0, 0), a2, voffA);
            PG8_BAR; PG8_WAIT_L(0); PG8_MMA(1, 0, At, B0); PG8_BAR; PG8_SCHED;
            PG8_STAGE(PG8_SB(0, 1), b2 + hstep, voffB);
            PG8_WAIT_V(6); PG8_BAR; PG8_MMA(1, 1, At, B1); PG8_BAR;
            PG8_LDB(B0, 1, 0); PG8_SCHED; PG8_LDA(At, 1, 0); PG8_STAGE(PG8_SA(0, 1), a2 + hstep, voffA);
            PG8_WAIT_L(8); PG8_BAR; PG8_WAIT_L(0); PG8_MMA(0, 0, At, B0); PG8_BAR; PG8_SCHED;
            PG8_LDB(B1, 1, 1); PG8_STAGE(PG8_SB(1, 0), b3, voffB);
            PG8_BAR; PG8_WAIT_L(0); PG8_MMA(0, 1, At, B1); PG8_BAR;
            PG8_LDA(At, 1, 1); PG8_STAGE(PG8_SA(1, 0), a3, voffA);
            PG8_BAR; PG8_WAIT_L(0); PG8_MMA(1, 0, At, B0); PG8_BAR; PG8_SCHED;
            PG8_STAGE(PG8_SB(1, 1), b3 + hstep, voffB);
            PG8_WAIT_V(6); PG8_BAR; PG8_MMA(1, 1, At, B1); PG8_BAR;
            }
        }
        if constexpr (ALIGN_EPI) { if (wr == 0) PG8_BAR; }
        E(acc, cur, wr, wc, fr, fq);
        if (!has_next) break;
#pragma unroll
        for (int a = 0; a < 2; ++a)
#pragma unroll
            for (int b = 0; b < 2; ++b)
#pragma unroll
                for (int m = 0; m < 4; ++m)
#pragma unroll
                    for (int n = 0; n < 2; ++n) acc[a][b][m][n] = (f32x4){0.f, 0.f, 0.f, 0.f};
        cur = nxt; cA = nA; cB = nB; ++ui;
        if constexpr (ALIGN_EPI) { if (wr == 1) PG8_BAR; }
    }
    PG8_WAIT_V(0);
    if constexpr (!ALIGN_EPI) { if (wr == 0) PG8_BAR; }
    PG8_BAR;
#undef PG8_SA
#undef PG8_SB
#undef PG8_STAGE
#undef PG8_LDA
#undef PG8_LDB
#undef PG8_MMA
#undef PG8_WAIT_V
#undef PG8_WAIT_L
#undef PG8_BAR
#undef PG8_SCHED
}
}

typedef int i32x4q __attribute__((ext_vector_type(4)));
struct EpiPtrs {
    const GAS float* biasp; const GAS float* lb; const GAS float* x; GAS float* out; GAS unsigned char* ws; int round;
    int pn0;
    const GAS float* sa; const GAS float* sb; const GAS float* sym; const GAS float* syg; const GAS float* sxq;
};
template <int MODE> struct EpiX {
    static constexpr bool PERM = true, AFTER_DRAIN = false;
    EpiPtrs P;
    __device__ __forceinline__ void operator()(const f32x4 (&acc)[2][2][4][2], const pg8::Unit& u, int wr, int wc, int fr, int fq) const {
        const int upn = u.pn + (MODE == 2 ? P.pn0 : 0);
        const int row0 = u.pm * 256 + wr * 64 + fr;
        const int colt = upn * 256 + wc * 32 + 8 * fq;
        GAS unsigned char* ws = P.ws;
        bf16_t* dst = nullptr; int ld = 0, coff = 0, act = 0; const GAS float* bias = nullptr;
        if (MODE == 1 || MODE == 7) {
            bias = P.biasp;
            if (upn < 8) { dst = (bf16_t*)(ws + WS_QKPRE); ld = 2048; coff = 0; act = 0; }
            else if (upn < 16) { dst = (bf16_t*)(ws + WS_V); ld = 2048; coff = 2048; act = 0; }
            else if (upn < 20) { dst = (bf16_t*)(ws + WS_GFLOG); ld = 1024; coff = 4096; act = 3; }
            else if (upn < 24) { dst = (bf16_t*)(ws + WS_GI); ld = 1024; coff = 5120; act = 0; }
            else { dst = (bf16_t*)(ws + WS_GQ); ld = 1024; coff = 6144; act = 2; }
        } else if (MODE == 2) {
            bias = P.biasp + N1;
            if (upn < 8) { dst = (bf16_t*)(ws + WS_SIGO); ld = 2048; coff = 0; act = 1; }
            else if (upn < 12) { dst = (bf16_t*)(ws + WS_SGG); ld = 1024; coff = 2048; act = 2; }
            else if (upn < 16) { dst = (bf16_t*)(ws + WS_SAM); ld = 1024; coff = 3072; act = 1; }
            else { dst = (bf16_t*)(ws + WS_SAG); ld = 1024; coff = 4096; act = 1; }
        } else if (MODE == 6) { dst = (bf16_t*)(ws + WS_QP); ld = 2048; coff = 0; act = 0; }
        float sr8[2][4];
#pragma unroll
        for (int ai = 0; ai < 2; ++ai)
#pragma unroll
            for (int m = 0; m < 4; ++m) { const int row = row0 + ai * 128 + m * 16;
                sr8[ai][m] = (MODE == 3) ? P.sym[row] : (MODE == 4) ? P.syg[row] : (MODE == 6) ? P.sxq[row] : (MODE == 2 || MODE == 7) ? P.sa[(size_t)P.round * RT + row] : 1.0f; }
#pragma unroll
        for (int bj = 0; bj < 2; ++bj) {
            const int col = colt + bj * 128;
            f32x4 b0 = (f32x4){0.f, 0.f, 0.f, 0.f}, b1 = b0, l0 = b0, l1 = b0;
            if (MODE == 1 || MODE == 2 || MODE == 7) { b0 = *(const f32x4*)(bias + col); b1 = *(const f32x4*)(bias + col + 4); }
            f32x4 s0 = (f32x4){1.f, 1.f, 1.f, 1.f}, s1 = s0;
            if (MODE == 2) { s0 = *(const GAS f32x4*)(P.sb + 7168 + col); s1 = *(const GAS f32x4*)(P.sb + 7168 + col + 4); }
            if (MODE == 7) { s0 = *(const GAS f32x4*)(P.sb + col); s1 = *(const GAS f32x4*)(P.sb + col + 4); }
            if (MODE == 3) { s0 = *(const GAS f32x4*)(P.sb + 12288 + col); s1 = *(const GAS f32x4*)(P.sb + 12288 + col + 4); }
            if (MODE == 4) { s0 = *(const GAS f32x4*)(P.sb + 13312 + col); s1 = *(const GAS f32x4*)(P.sb + 13312 + col + 4); }
            if (MODE == 6) { s0 = *(const GAS f32x4*)(P.sb + 14336 + col); s1 = *(const GAS f32x4*)(P.sb + 14336 + col + 4); }
            if (MODE == 1 || MODE == 7) { if (act == 3) { l0 = *(const f32x4*)(P.lb + (col - coff)); l1 = *(const f32x4*)(P.lb + (col - coff) + 4); } }
#pragma unroll
            for (int ai = 0; ai < 2; ++ai) {
                u32x4 gpre[4], zpre[4]; f32x4 xpre[4][2];
#pragma unroll
                for (int m = 0; m < 4; ++m) { const int row = row0 + ai * 128 + m * 16;
                    if (MODE == 3) gpre[m] = *(const GAS u32x4*)((const GAS bf16_t*)(ws + WS_SAM) + (size_t)row * 1024 + col);
                    if (MODE == 4) { gpre[m] = *(const GAS u32x4*)((const GAS bf16_t*)(ws + WS_SAG) + (size_t)row * 1024 + col);
                                     zpre[m] = *(const GAS u32x4*)((const GAS bf16_t*)P.out + (size_t)T * 1024 + ((size_t)P.round * RT + row) * 1024 + col); }
                    if (MODE == 5) { const size_t off = ((size_t)P.round * RT + row) * 1024 + col; xpre[m][0] = *(const GAS f32x4*)(P.x + off); xpre[m][1] = *(const GAS f32x4*)(P.x + off + 4); } }
#pragma unroll
                for (int m = 0; m < 4; ++m) {
                    const int row = row0 + ai * 128 + m * 16;
                    f32x4 v0, v1;
                    if (MODE == 2 || MODE == 7 || MODE == 3 || MODE == 4 || MODE == 6) { const float sr = sr8[ai][m]; const i32x4q q0 = __builtin_bit_cast(i32x4q, acc[ai][bj][m][0]), q1 = __builtin_bit_cast(i32x4q, acc[ai][bj][m][1]);
                        v0 = (f32x4){(float)q0[0], (float)q0[1], (float)q0[2], (float)q0[3]} * (s0 * sr) + b0; v1 = (f32x4){(float)q1[0], (float)q1[1], (float)q1[2], (float)q1[3]} * (s1 * sr) + b1; }
                    else { v0 = acc[ai][bj][m][0] + b0; v1 = acc[ai][bj][m][1] + b1; }
                    if (MODE == 1 || MODE == 2 || MODE == 6 || MODE == 7) {
                        if (act == 1) {
#pragma unroll
                            for (int j = 0; j < 4; ++j) { v0[j] = sigmoidf_(v0[j]); v1[j] = sigmoidf_(v1[j]); }
                        } else if (act == 2) {
#pragma unroll
                            for (int j = 0; j < 4; ++j) { v0[j] = siluf_(v0[j]); v1[j] = siluf_(v1[j]); }
                        } else if (act == 3) {
#pragma unroll
                            for (int j = 0; j < 4; ++j) { v0[j] = __logf(l0[j] + (1.0f - l0[j]) * sigmoidf_(v0[j])); v1[j] = __logf(l1[j] + (1.0f - l1[j]) * sigmoidf_(v1[j])); }
                        }
                        u32x4 w; w.x = pk2(v0[0], v0[1]); w.y = pk2(v0[2], v0[3]); w.z = pk2(v1[0], v1[1]); w.w = pk2(v1[2], v1[3]);
                        *(u32x4*)(dst + (size_t)row * ld + (col - coff)) = w;
                    } else if (MODE == 3) {
                        const u32x4 g = gpre[m];
                        GAS bf16_t* o = (GAS bf16_t*)P.out + (size_t)T * 1024 + ((size_t)P.round * RT + row) * 1024 + col;
                        f32x4 r0, r1;
                        r0[0] = v0[0] * bf_lo(g.x); r0[1] = v0[1] * bf_hi(g.x); r0[2] = v0[2] * bf_lo(g.y); r0[3] = v0[3] * bf_hi(g.y);
                        r1[0] = v1[0] * bf_lo(g.z); r1[1] = v1[1] * bf_hi(g.z); r1[2] = v1[2] * bf_lo(g.w); r1[3] = v1[3] * bf_hi(g.w);
                        u32x4 w; w.x = pk2(r0[0], r0[1]); w.y = pk2(r0[2], r0[3]); w.z = pk2(r1[0], r1[1]); w.w = pk2(r1[2], r1[3]);
                        *(GAS u32x4*)o = w;
                    } else if (MODE == 4) {
                        const u32x4 g = gpre[m], zv = zpre[m];
                        const f32x4 p0 = (f32x4){bf_lo(zv.x), bf_hi(zv.x), bf_lo(zv.y), bf_hi(zv.y)}, p1 = (f32x4){bf_lo(zv.z), bf_hi(zv.z), bf_lo(zv.w), bf_hi(zv.w)};
                        f32x4 r0, r1;
                        r0[0] = p0[0] + v0[0] * bf_lo(g.x); r0[1] = p0[1] + v0[1] * bf_hi(g.x); r0[2] = p0[2] + v0[2] * bf_lo(g.y); r0[3] = p0[3] + v0[3] * bf_hi(g.y);
                        r1[0] = p1[0] + v1[0] * bf_lo(g.z); r1[1] = p1[1] + v1[1] * bf_hi(g.z); r1[2] = p1[2] + v1[2] * bf_lo(g.w); r1[3] = p1[3] + v1[3] * bf_hi(g.w);
                        u32x4 w; w.x = pk2(r0[0], r0[1]); w.y = pk2(r0[2], r0[3]); w.z = pk2(r1[0], r1[1]); w.w = pk2(r1[2], r1[3]);
                        *(u32x4*)((bf16_t*)(ws + WS_GFLOG) + (size_t)row * 1024 + col) = w;
                    } else if (MODE == 5) {
                        const size_t off = ((size_t)P.round * RT + row) * 1024 + col;
                        const f32x4 x0 = xpre[m][0] + v0, x1 = xpre[m][1] + v1;
                        u32x4 w; w.x = pk2(x0[0], x0[1]); w.y = pk2(x0[2], x0[3]); w.z = pk2(x1[0], x1[1]); w.w = pk2(x1[2], x1[3]);
                        *(GAS u32x4*)((GAS bf16_t*)P.out + off) = w;
                    }
                }
            }
        }
    }
};

__device__ __forceinline__ void p0_transpose_item(const GAS float* W, int ldw, int K, int k0, int scol, GAS bf16_t* WT, int drow, LAS float* scr, int lane) {
#pragma unroll 8
    for (int i = 0; i < 32; ++i) { const int kk = 2 * i + (lane >> 5); scr[kk * 33 + (lane & 31)] = W[(size_t)(k0 + kk) * ldw + scol + (lane & 31)]; }
    LDS_WAIT(); asm volatile("" ::: "memory");
    const int c = lane & 7;
#pragma unroll
    for (int j = 0; j < 4; ++j) { const int n = (lane >> 3) + 8 * j; const LAS float* s = scr + (8 * c) * 33 + n;
        u32x4 o; o.x = pk2(s[0 * 33], s[1 * 33]); o.y = pk2(s[2 * 33], s[3 * 33]); o.z = pk2(s[4 * 33], s[5 * 33]); o.w = pk2(s[6 * 33], s[7 * 33]);
        *(u32x4*)(WT + (size_t)(drow + n) * K + k0 + 8 * c) = o; }
    LDS_WAIT(); asm volatile("" ::: "memory");
}
__device__ __forceinline__ void p0_colmax_item(const GAS float* W, int ldw, int k0, int scol, GAS unsigned* colmax, int lane) {
    float mx = 0.f;
#pragma unroll 8
    for (int i = 0; i < 32; ++i) { const int kk = 2 * i + (lane >> 5); mx = fmaxf(mx, fabsf(W[(size_t)(k0 + kk) * ldw + scol + (lane & 31)])); }
    mx = fmaxf(mx, __builtin_bit_cast(float, xor32u_(__builtin_bit_cast(unsigned, mx), lane >= 32)));
    if (lane < 32) atomicMax((unsigned*)colmax + lane, __builtin_bit_cast(unsigned, mx));
}
__device__ __forceinline__ void p0_cvt8_item(const GAS float* W, int ldw, int k0, int scol, const GAS unsigned* colmax, GAS unsigned char* WT8, int pitch, GAS float* sb, int drow, LAS float* scr, int lane) {
    const float cm = __builtin_bit_cast(float, colmax[lane & 31]);
    const float qs = cm > 0.f ? 127.0f / cm : 0.f;
    if (k0 == 0 && lane < 32) sb[lane] = cm * (1.0f / 127.0f);
#pragma unroll 8
    for (int i = 0; i < 32; ++i) { const int kk = 2 * i + (lane >> 5); scr[kk * 33 + (lane & 31)] = W[(size_t)(k0 + kk) * ldw + scol + (lane & 31)] * qs; }
    LDS_WAIT(); asm volatile("" ::: "memory");
    const int n = lane >> 1, kh = lane & 1;
    const LAS float* sp = scr + (kh * 32) * 33 + n;
    u32x4 o0, o1;
#pragma unroll
    for (int q = 0; q < 8; ++q) { const unsigned p = pack_i8x4(sp[(4 * q) * 33], sp[(4 * q + 1) * 33], sp[(4 * q + 2) * 33], sp[(4 * q + 3) * 33]);
        if (q < 4) o0[q] = p; else o1[q - 4] = p; }
    GAS unsigned char* dst = WT8 + (size_t)(drow + n) * pitch + k0 + kh * 32;
    *(GAS u32x4*)dst = o0; *(GAS u32x4*)(dst + 16) = o1;
    LDS_WAIT(); asm volatile("" ::: "memory");
}
__device__ __forceinline__ int win_src_col(int n) {
    if (n < 4096) return n;
    if (n < 7168) return n - 4096 + 6152;
    if (n < 9216) return n - 7168 + 4096;
    return n - 9216 + 9224;
}

__device__ __forceinline__ void phase_p0(const DArgs& a, LAS unsigned char* lds, int vcu, int G) {
    const int tid = tid_(), lane = tid & 63, wave = tid >> 6;
    const int gw = vcu * NWAVES + wave, NGW = G * NWAVES;
    GAS unsigned char* ws = a.ws;
    LAS float* scr = (LAS float*)(lds + wave * 16384);
    constexpr int I_IN = 16 * 384, I_M = 32 * 32, I_G = 16 * 32, I_O = 16 * 32, I_PQ = 16 * 64;
    constexpr int NITEMS = I_IN + I_M + I_G + I_O + I_PQ;
    for (int it = gw; it < NITEMS; it += NGW) {
        int r = it;
        if (r < I_IN) { const int kb = r / 384, nb = r % 384;
            p0_colmax_item(a.w_in, IN_COLS, kb * 64, win_src_col(nb * 32), (GAS unsigned*)(ws + WS_CTL) + CW_COLMAX + nb * 32, lane);
            continue; } r -= I_IN;
        if (r < I_M) { const int kb = r / 32, nb = r % 32; p0_colmax_item(a.w_br_m, 1024, kb * 64, nb * 32, (GAS unsigned*)(ws + WS_CTL) + CW_COLMAX + 12288 + nb * 32, lane); continue; } r -= I_M;
        if (r < I_G) { const int kb = r / 32, nb = r % 32; p0_colmax_item(a.w_br_g, 1024, kb * 64, nb * 32, (GAS unsigned*)(ws + WS_CTL) + CW_COLMAX + 13312 + nb * 32, lane); continue; } r -= I_G;
        if (r < I_O) { const int kb = r / 32, nb = r % 32; p0_transpose_item(a.w_out, 1024, 1024, kb * 64, nb * 32, (GAS bf16_t*)(ws + WS_WO), nb * 32, scr, lane); continue; } r -= I_O;
        { const int kb = r / 64, nb = r % 64; p0_colmax_item(a.w_pq, 2048, kb * 64, nb * 32, (GAS unsigned*)(ws + WS_CTL) + CW_COLMAX + 14336 + nb * 32, lane); }
    }
    const int gt = vcu * NTHR + tid, NGT = G * NTHR;
    for (int i = gt; i < NP; i += NGT) ((float*)(ws + WS_BIASP))[i] = a.b_in[win_src_col(i)];
    for (int i = gt; i < 1024; i += NGT) { const float t0 = a.lb_table[i], t1 = a.lb_table[1024 + i]; ((float*)(ws + WS_LB))[i] = 1.0f / (1.0f + __expf(t1 - t0)); }
    for (int i = gt; i < 8 * 2 * 128 * 128 / 4; i += NGT) { const f32x4 v = ((const f32x4*)a.sub_keys)[i]; u32x2 o; o.x = pk2(v[0], v[1]); o.y = pk2(v[2], v[3]); ((u32x2*)(ws + WS_SK))[i] = o; }
    f32x4 g1[4];
#pragma unroll
    for (int j = 0; j < 4; ++j) g1[j] = ((const GAS f32x4*)a.norm1_g)[64 * j + lane];
    f32x4 gw0[16], gw1[16];
#pragma unroll
    for (int j = 0; j < 4; ++j)
#pragma unroll
        for (int e = 0; e < 4; ++e) { const int k = 256 * j + 4 * lane + e; gw0[4 * j + e] = *(const GAS f32x4*)(a.w_in + (size_t)k * IN_COLS + 6144); gw1[4 * j + e] = *(const GAS f32x4*)(a.w_in + (size_t)k * IN_COLS + 6148); }
    const float gbias = lane < 8 ? a.b_in[6144 + lane] : 0.f;
    for (int m = gw; m < T; m += NGW) {
        const GAS f32x4* xr = (const GAS f32x4*)(a.x + (size_t)m * D) + lane;
        f32x4 v[4]; float s = 0.f;
#pragma unroll
        for (int j = 0; j < 4; ++j) { v[j] = xr[64 * j]; s += (v[j][0] * v[j][0] + v[j][1] * v[j][1]) + (v[j][2] * v[j][2] + v[j][3] * v[j][3]); }
        const float rstd = rsqrtf(wave_sum(s, lane) * (1.f / D) + EPS);
        f32x4 ga0 = (f32x4){0.f, 0.f, 0.f, 0.f}, ga1 = ga0;
        float mx = 0.f;
#pragma unroll
        for (int j = 0; j < 4; ++j) {
            v[j] = v[j] * rstd * g1[j];
            mx = fmaxf(mx, fmaxf(fmaxf(fabsf(v[j][0]), fabsf(v[j][1])), fmaxf(fabsf(v[j][2]), fabsf(v[j][3]))));
#pragma unroll
            for (int e = 0; e < 4; ++e) { ga0 += gw0[4 * j + e] * v[j][e]; ga1 += gw1[4 * j + e] * v[j][e]; }
        }
        {
            mx = wave_max(mx);
            const float qs = mx > 0.f ? 127.0f / mx : 0.f;
#pragma unroll
            for (int jq = 0; jq < 4; ++jq) ((GAS unsigned*)(ws + WS_XN8 + (size_t)m * 1024))[64 * jq + lane] = pack_i8x4(v[jq][0] * qs, v[jq][1] * qs, v[jq][2] * qs, v[jq][3] * qs);
            if (lane == 0) ((GAS float*)(ws + WS_SA8))[m] = mx * (1.0f / 127.0f);
        }
        float ga[8] = {ga0[0], ga0[1], ga0[2], ga0[3], ga1[0], ga1[1], ga1[2], ga1[3]};
#pragma unroll
        for (int q = 0; q < 8; ++q) ga[q] = wave_sum(ga[q], lane);
        if (lane < 8) { float r = ga[0];
#pragma unroll
            for (int q = 1; q < 8; ++q) r = (lane == q) ? ga[q] : r;
            ((GAS float*)(ws + WS_GATES))[(size_t)m * 8 + lane] = r + gbias; }
    }
}

__device__ __forceinline__ float logsigf_(float x) { return fminf(x, 0.f) - log1pf(__expf(-fabsf(x))); }
#define LDS_BAR() do { asm volatile("s_waitcnt lgkmcnt(0)" ::: "memory"); __builtin_amdgcn_s_barrier(); asm volatile("" ::: "memory"); } while (0)
#define MFMA16(a, b, c) __builtin_amdgcn_mfma_f32_16x16x32_bf16((a), (b), (c), 0, 0, 0)
__device__ __forceinline__ bf16x8 lfrag(const LAS unsigned char* base, int pitch, int row, int k0, int fq) { return *(const LAS bf16x8*)(base + row * pitch + (k0 + 8 * fq) * 2); }
__device__ __forceinline__ int fm_off(int r, int k, int KB) { return (((r >> 4) * KB + (k >> 5)) << 10) + (((((k >> 3) & 3) << 4) + (r & 15)) << 4) + ((k & 7) << 1); }
__device__ __forceinline__ bf16x8 gfrag(const bf16_t* base, int ld, int row, int k0, int fq) { return *(const bf16x8*)(base + (size_t)row * ld + k0 + 8 * fq); }

__device__ __forceinline__ void phase_p0c(const DArgs& a, LAS unsigned char* lds, int vcu, int G) {
    const int tid = tid_(), lane = tid & 63, wave = tid >> 6;
    const int gw = vcu * NWAVES + wave, NGW = G * NWAVES;
    GAS unsigned char* ws = a.ws;
    LAS float* scr = (LAS float*)(lds + wave * 16384);
    constexpr int J_IN = 16 * 384, J_M = 32 * 32, J_G = 16 * 32, J_PQ = 16 * 64;
    const GAS unsigned* cmx = (const GAS unsigned*)(ws + WS_CTL) + CW_COLMAX; GAS float* sb = (GAS float*)(ws + WS_SB8);
    for (int it = gw; it < J_IN + J_M + J_G + J_PQ; it += NGW) {
        int r = it;
        if (r < J_IN) { const int kb = r / 384, nb = r % 384;
            p0_cvt8_item(a.w_in, IN_COLS, kb * 64, win_src_col(nb * 32), cmx + nb * 32, ws + WS_W8A, 1024, sb + nb * 32, nb * 32, scr, lane); continue; } r -= J_IN;
        if (r < J_M) { const int kb = r / 32, nb = r % 32; p0_cvt8_item(a.w_br_m, 1024, kb * 64, nb * 32, cmx + 12288 + nb * 32, ws + WS_WM, 2048, sb + 12288 + nb * 32, nb * 32, scr, lane); continue; } r -= J_M;
        if (r < J_G) { const int kb = r / 32, nb = r % 32; p0_cvt8_item(a.w_br_g, 1024, kb * 64, nb * 32, cmx + 13312 + nb * 32, ws + WS_WG, 1024, sb + 13312 + nb * 32, nb * 32, scr, lane); continue; } r -= J_G;
        { const int kb = r / 64, nb = r % 64; p0_cvt8_item(a.w_pq, 2048, kb * 64, nb * 32, cmx + 14336 + nb * 32, ws + WS_WPQ, 1024, sb + 14336 + nb * 32, nb * 32, scr, lane); }
    }
}
__device__ __forceinline__ void mscan_pair(const DArgs& a, LAS unsigned char* lds, int round, int p) {
    const int tid = tid_(), lane = tid & 63, part = tid >> 6;
    const int bl = p >> 2, h = p & 3, b = round * 2 + bl;
    const GAS float* g = (const GAS float*)(a.ws + WS_GATES) + ((size_t)b * SEQ + (size_t)lane * 128 + part * 16) * 8;
    float bsum = 0.f, gm = -INFINITY;
#pragma unroll 4
    for (int s = 0; s < 16; ++s) { const float ip = g[s * 8 + h], fp = g[s * 8 + 4 + h]; bsum += logsigf_(fp); gm = fmaxf(gm, ip - bsum); }
    LAS float* PS = (LAS float*)lds; LAS float* PM = PS + 512;
    PS[part * 64 + lane] = bsum; PM[part * 64 + lane] = gm;
    __syncthreads();
    if (tid < 64) {
        float bs = 0.f, g2 = -INFINITY;
#pragma unroll
        for (int q = 0; q < 8; ++q) { g2 = fmaxf(g2, PM[q * 64 + lane] - bs); bs += PS[q * 64 + lane]; }
        float mprev = 0.f, mine = 0.f;
        for (int c = 0; c < 64; ++c) {
            const float bc = rdlane(bs, c), gc = rdlane(g2, c);
            if (lane == c) mine = mprev; mprev = bc + fmaxf(mprev, gc); }
        ((GAS float*)(a.ws + WS_MPREV))[(round * 8 + p) * 64 + lane] = mine;
    }
    __syncthreads();
}

constexpr int PQ_PITCH = 528, PS_PITCH = 272;
__device__ __forceinline__ void mlstm_pre_item(const DArgs& a, LAS unsigned char* lds, int round, int item) {
    const int tid = tid_(), lane = tid & 63, wave = __builtin_amdgcn_readfirstlane(tid >> 6), fr = lane & 15, fq = lane >> 4;
    const int p = item >> 6, c = item & 63, bl = p >> 2, h = p & 3, b = round * 2 + bl;
    const int tl0 = bl * SEQ + c * 128; const size_t tg0 = (size_t)b * SEQ + c * 128;
    GAS unsigned char* ws = a.ws;
    LAS unsigned char* QL = lds; LAS unsigned char* KL = lds + 67584;
    LAS float* AS = (LAS float*)(lds + 135168); LAS float* MS = AS + 128; LAS float* SC = AS + 256;
    if (wave == 0) {
        const float mprev = ((const float*)(ws + WS_MPREV))[(round * 8 + p) * 64 + c];
        const float* g = (const float*)(ws + WS_GATES) + (tg0 + 2 * lane) * 8;
        const float ip0 = g[h], fp0 = g[4 + h], ip1 = g[8 + h], fp1 = g[12 + h];
        const float lf0 = logsigf_(fp0), lf1 = logsigf_(fp1), pp = lf0 + lf1;
        float incl = pp;
#pragma unroll
        for (int o = 1; o < 64; o <<= 1) { const float t = shup(incl, o, lane); if (lane >= o) incl += t; }
        const float excl = incl - pp, b0 = excl + lf0, b1 = incl;
        const float a0 = ip0 - b0, a1 = ip1 - b1;
        float inclm = fmaxf(a0, a1);
#pragma unroll
        for (int o = 1; o < 64; o <<= 1) { const float t = shup(inclm, o, lane); if (lane >= o) inclm = fmaxf(inclm, t); }
        float exclm = shup(inclm, 1, lane); if (lane == 0) exclm = -INFINITY;
        const float M0 = fmaxf(mprev, fmaxf(exclm, a0)), M1 = fmaxf(mprev, inclm);
        AS[2 * lane] = a0; AS[2 * lane + 1] = a1; MS[2 * lane] = M0; MS[2 * lane + 1] = M1;
        float* mt = (float*)(ws + WS_MT) + (tg0 + 2 * lane) * 4 + h;
        mt[0] = b0 + M0; mt[4] = b1 + M1;
        const float Mlast = rdlane(M1, 63);
        if (lane == 0) { SC[0] = mprev; SC[1] = Mlast; ((float*)(ws + WS_MDEC))[item] = __expf(mprev - Mlast); }
    }
    {
        const int cgp = tid & 63, strip = tid >> 6;
        const int col = (cgp < 32) ? (h * 256 + cgp * 8) : (1024 + h * 256 + (cgp - 32) * 8);
        float w[4][8], bb[8];
#pragma unroll
        for (int j = 0; j < 4; ++j) { const f32x4 w0 = *(const f32x4*)(a.conv_w + j * 2048 + col), w1 = *(const f32x4*)(a.conv_w + j * 2048 + col + 4);
#pragma unroll
            for (int e = 0; e < 4; ++e) { w[j][e] = w0[e]; w[j][4 + e] = w1[e]; } }
        { const f32x4 b0 = *(const f32x4*)(a.conv_b + col), b1 = *(const f32x4*)(a.conv_b + col + 4);
#pragma unroll
            for (int e = 0; e < 4; ++e) { bb[e] = b0[e]; bb[4 + e] = b1[e]; } }
        const bf16_t* src = (const bf16_t*)(ws + WS_QKPRE) + (size_t)(tl0 + 16 * strip) * 2048 + col;
        const float qs = (cgp < 32) ? 0.0625f : 1.0f;
        LAS unsigned char* dstt = ((cgp < 32) ? QL : KL) + (cgp & 31) * 16;
#pragma unroll 1
        for (int half = 0; half < 2; ++half) {
            u32x4 xr[11];
#pragma unroll
            for (int r = 0; r < 11; ++r) {
                const int sl = c * 128 + 16 * strip + 8 * half + r - 3;
                xr[r] = (sl >= 0) ? *(const u32x4*)(src + (ptrdiff_t)(8 * half + r - 3) * 2048) : (u32x4){0u, 0u, 0u, 0u};
            }
#pragma unroll
            for (int r = 0; r < 8; ++r) {
                float y[8];
#pragma unroll
                for (int e = 0; e < 8; ++e) y[e] = bb[e];
#pragma unroll
                for (int j = 0; j < 4; ++j) { const u32x4 xv = xr[r + j];
                    y[0] += w[j][0] * bf_lo(xv.x); y[1] += w[j][1] * bf_hi(xv.x); y[2] += w[j][2] * bf_lo(xv.y); y[3] += w[j][3] * bf_hi(xv.y);
                    y[4] += w[j][4] * bf_lo(xv.z); y[5] += w[j][5] * bf_hi(xv.z); y[6] += w[j][6] * bf_lo(xv.w); y[7] += w[j][7] * bf_hi(xv.w); }
#pragma unroll
                for (int e = 0; e < 8; ++e) y[e] = siluf_(y[e]) * qs;
                u32x4 o; o.x = pk2(y[0], y[1]); o.y = pk2(y[2], y[3]); o.z = pk2(y[4], y[5]); o.w = pk2(y[6], y[7]);
                *(LAS u32x4*)(dstt + (16 * strip + 8 * half + r) * PQ_PITCH) = o;
            }
        }
    }
    __syncthreads();
    const float mprev = SC[0], Mlast = SC[1];
    {
        bf16_t* Sg = (bf16_t*)(ws + WS_S) + (size_t)item * 128 * 128;
        const int t = wave * 16 + fr; const float Mt = MS[t];
        for (int st = 0; st < 8; ++st) {
            u32x2 o = (u32x2){0u, 0u};
            if (st <= wave) {
                f32x4 acc = (f32x4){0.f, 0.f, 0.f, 0.f};
#pragma unroll
                for (int ks = 0; ks < 8; ++ks) acc = MFMA16(lfrag(KL, PQ_PITCH, st * 16 + fr, ks * 32, fq), lfrag(QL, PQ_PITCH, wave * 16 + fr, ks * 32, fq), acc);
                float v[4];
#pragma unroll
                for (int j = 0; j < 4; ++j) { const int s = st * 16 + 4 * fq + j; v[j] = (s <= t) ? acc[j] * __expf(AS[s] - Mt) : 0.f; }
                o.x = pk2(v[0], v[1]); o.y = pk2(v[2], v[3]);
            }
            *(u32x2*)((unsigned char*)Sg + fm_off(t, st * 16 + 4 * fq, 4)) = o;
        }
    }
    {
        bf16_t* Qg = (bf16_t*)(ws + WS_QT) + (size_t)item * 128 * 256;
#pragma unroll
        for (int i = 0; i < 8; ++i) { const int idx = tid + 512 * i, blk = idx >> 6, t = (blk >> 3) * 16 + (idx & 15), ch = (blk & 7) * 4 + ((idx >> 4) & 3);
            const u32x4 v = *(const LAS u32x4*)(QL + t * PQ_PITCH + ch * 16); const float s = __expf(mprev - MS[t]);
            u32x4 o; o.x = pk2(bf_lo(v.x) * s, bf_hi(v.x) * s); o.y = pk2(bf_lo(v.y) * s, bf_hi(v.y) * s); o.z = pk2(bf_lo(v.z) * s, bf_hi(v.z) * s); o.w = pk2(bf_lo(v.w) * s, bf_hi(v.w) * s);
            *(u32x4*)((unsigned char*)Qg + fm_off(t, ch * 8, 8)) = o; }
    }
    {
        bf16_t* Kg = (bf16_t*)(ws + WS_KWT) + (size_t)item * 256 * 128;
        const int dlo = lane & 15, sglo = lane >> 4;
#pragma unroll
        for (int i = 0; i < 8; ++i) { const int combo = wave * 8 + i, d = (combo >> 2) * 16 + dlo, s0 = ((combo & 3) * 4 + sglo) * 8;
            float v[8];
#pragma unroll
            for (int e = 0; e < 8; ++e) v[e] = bf2f(*(const LAS bf16_t*)(KL + (s0 + e) * PQ_PITCH + d * 2)) * __expf(AS[s0 + e] - Mlast);
            u32x4 o; o.x = pk2(v[0], v[1]); o.y = pk2(v[2], v[3]); o.z = pk2(v[4], v[5]); o.w = pk2(v[6], v[7]);
            *(u32x4*)((unsigned char*)Kg + fm_off(d, s0, 4)) = o; }
    }
    __syncthreads();
}

__device__ __forceinline__ void hgrn_pre_load(const DArgs& a, int round, int item, u32x4 (&gq)[4]) {
    const int tid = tid_();
    const int p = item >> 7, c = item & 127, bl = p >> 3, h = p & 7;
    const int tl0 = bl * SEQ + c * 64;
    GAS unsigned char* ws = a.ws;
#pragma unroll
    for (int i = 0; i < 2; ++i) { const int idx = tid + 512 * i, s = idx >> 4, ch = idx & 15;
        gq[2 * i] = *(const GAS u32x4*)((const GAS bf16_t*)(ws + WS_GFLOG) + (size_t)(tl0 + s) * 1024 + h * 128 + ch * 8);
        gq[2 * i + 1] = *(const GAS u32x4*)((const GAS bf16_t*)(ws + WS_GQ) + (size_t)(tl0 + s) * 1024 + h * 128 + ch * 8); }
}
__device__ __forceinline__ void hgrn_pre_item(const DArgs& a, LAS unsigned char* lds, int round, int item, u32x4 (&gq)[4], int next_item) {
    const int tid = tid_(), lane = tid & 63, wave = __builtin_amdgcn_readfirstlane(tid >> 6), fr = lane & 15, fq = lane >> 4;
    const int p = item >> 7, c = item & 127, bl = p >> 3, h = p & 7;
    const int tl0 = bl * SEQ + c * 64;
    GAS unsigned char* ws = a.ws;
    LAS float* CUM = (LAS float*)lds;
    LAS float* GL = (LAS float*)(lds + 32768);
    LAS unsigned char* QH = lds + 65536;
    LAS unsigned char* KE = lds + 65536 + 64 * PS_PITCH;
    LAS float* QF = (LAS float*)(lds + 65536 + 128 * PS_PITCH);
#pragma unroll
    for (int i = 0; i < 2; ++i) { const int idx = tid + 512 * i, s = idx >> 4, ch = idx & 15;
        const u32x4 gv = gq[2 * i], qv = gq[2 * i + 1];
        LAS float* gd = GL + s * 128 + ch * 8; LAS float* qd = QF + s * 128 + ch * 8;
        gd[0] = bf_lo(gv.x); gd[1] = bf_hi(gv.x); gd[2] = bf_lo(gv.y); gd[3] = bf_hi(gv.y); gd[4] = bf_lo(gv.z); gd[5] = bf_hi(gv.z); gd[6] = bf_lo(gv.w); gd[7] = bf_hi(gv.w);
        qd[0] = bf_lo(qv.x); qd[1] = bf_hi(qv.x); qd[2] = bf_lo(qv.y); qd[3] = bf_hi(qv.y); qd[4] = bf_lo(qv.z); qd[5] = bf_hi(qv.z); qd[6] = bf_lo(qv.w); qd[7] = bf_hi(qv.w); }
    if (next_item < 2048) hgrn_pre_load(a, round, next_item, gq);
    LDS_BAR();
    {
        const int d = tid & 127, qt = tid >> 7; float cs = 0.f;
#pragma unroll 4
        for (int s = 0; s < 16; ++s) { cs += GL[(qt * 16 + s) * 128 + d]; CUM[(qt * 16 + s) * 128 + d] = cs; }
        LDS_BAR();
        float off = 0.f;
#pragma unroll
        for (int q = 0; q < 3; ++q) off += (q < qt) ? CUM[(q * 16 + 15) * 128 + d] : 0.f;
        LDS_BAR();
#pragma unroll 4
        for (int s = 0; s < 16; ++s) CUM[(qt * 16 + s) * 128 + d] += off;
        if (qt == 3) ((GAS float*)(ws + WS_HGDEC))[(size_t)item * 128 + d] = __expf(cs + off);
    }
    LDS_BAR();
    {
        bf16_t* Qg = (bf16_t*)(ws + WS_QTG) + (size_t)item * 64 * 128;
#pragma unroll
        for (int i = 0; i < 2; ++i) { const int idx = tid + 512 * i, s = idx >> 4, ch = idx & 15;
            float qt[8], qh[8], ke[8];
#pragma unroll
            for (int e = 0; e < 8; ++e) { const int d = ch * 8 + e; const float cm = CUM[s * 128 + d], last = CUM[63 * 128 + d], q = QF[s * 128 + d], g = GL[s * 128 + d];
                qt[e] = q * __expf(cm); qh[e] = q * __expf(cm - last); ke[e] = (1.0f - __expf(g)) * __expf(last - cm); }
            u32x4 o; o.x = pk2(qt[0], qt[1]); o.y = pk2(qt[2], qt[3]); o.z = pk2(qt[4], qt[5]); o.w = pk2(qt[6], qt[7]);
            *(u32x4*)((unsigned char*)Qg + fm_off(s, ch * 8, 4)) = o;
            o.x = pk2(qh[0], qh[1]); o.y = pk2(qh[2], qh[3]); o.z = pk2(qh[4], qh[5]); o.w = pk2(qh[6], qh[7]);
            *(LAS u32x4*)(QH + s * PS_PITCH + ch * 16) = o;
            o.x = pk2(ke[0], ke[1]); o.y = pk2(ke[2], ke[3]); o.z = pk2(ke[4], ke[5]); o.w = pk2(ke[6], ke[7]);
            *(LAS u32x4*)(KE + s * PS_PITCH + ch * 16) = o; }
    }
    LDS_BAR();
    {
        bf16_t* Ag = (bf16_t*)(ws + WS_ATT) + (size_t)item * 64 * 64;
#pragma unroll
        for (int i = 0; i < 2; ++i) { const int tile = wave * 2 + i, tt = tile >> 2, st = tile & 3; const int t = tt * 16 + fr;
            u32x2 o = (u32x2){0u, 0u};
            if (st <= tt) { f32x4 acc = (f32x4){0.f, 0.f, 0.f, 0.f};
#pragma unroll
                for (int ks = 0; ks < 4; ++ks) acc = MFMA16(lfrag(KE, PS_PITCH, st * 16 + fr, ks * 32, fq), lfrag(QH, PS_PITCH, tt * 16 + fr, ks * 32, fq), acc);
                float v[4];
#pragma unroll
                for (int j = 0; j < 4; ++j) { const int s = st * 16 + 4 * fq + j; v[j] = (s <= t) ? acc[j] : 0.f; }
                o.x = pk2(v[0], v[1]); o.y = pk2(v[2], v[3]); }
            *(u32x2*)((unsigned char*)Ag + fm_off(t, st * 16 + 4 * fq, 2)) = o; }
    }
    {
        bf16_t* Kg = (bf16_t*)(ws + WS_KENDT) + (size_t)item * 128 * 64;
        const int dlo = lane & 15, sglo = lane >> 4;
#pragma unroll
        for (int i = 0; i < 2; ++i) { const int combo = wave * 2 + i, d = (combo >> 1) * 16 + dlo, s0 = ((combo & 1) * 4 + sglo) * 8;
            unsigned v[8];
#pragma unroll
            for (int e = 0; e < 8; ++e) v[e] = *(const LAS bf16_t*)(KE + (s0 + e) * PS_PITCH + d * 2);
            u32x4 o; o.x = v[0] | (v[1] << 16); o.y = v[2] | (v[3] << 16); o.z = v[4] | (v[5] << 16); o.w = v[6] | (v[7] << 16);
            *(u32x4*)((unsigned char*)Kg + fm_off(d, s0, 2)) = o; }
    }
    LDS_BAR();
}

template <int NVT, bool DEN>
__device__ __forceinline__ void mlstm_scan(const DArgs& a, LAS unsigned char* lds, int round, int p, int sl) {
    const int tid = tid_(), lane = tid & 63, wave = __builtin_amdgcn_readfirstlane(tid >> 6), fr = lane & 15, fq = lane >> 4;
    const int bl = p >> 2, h = p & 3, b = round * 2 + bl;
    GAS unsigned char* ws = a.ws;
    constexpr int VTB = NVT * 16 * PS_PITCH, CTB = NVT * 16 * PQ_PITCH;
    LAS unsigned char* VT = lds; LAS unsigned char* CT = lds + 2 * VTB; LAS float* DEC = (LAS float*)(lds + 2 * VTB + 2 * CTB);
    for (int i = tid; i < (2 * VTB + 2 * CTB) / 4; i += NTHR) ((LAS unsigned*)lds)[i] = 0u;
    if (tid < 64) DEC[tid] = ((const GAS float*)(ws + WS_MDEC))[p * 64 + tid];
    __syncthreads();
    if (DEN) { if (tid < 256) { const int bufi = tid >> 7, s = tid & 127; *(LAS bf16_t*)(VT + bufi * VTB + s * 2) = (bf16_t)0x3F80; } }
    f32x4 st[2][NVT];
#pragma unroll
    for (int dt = 0; dt < 2; ++dt)
#pragma unroll
        for (int vt = 0; vt < NVT; ++vt) st[dt][vt] = (f32x4){0.f, 0.f, 0.f, 0.f};
    const int vcol = h * 512 + sl * 32;
    const int vs = tid >> 2, vpart = tid & 3;
    const GAS unsigned char* Sg0 = ws + WS_S + (size_t)(p * 64) * 32768 + wave * 4096 + lane * 16;
    const GAS unsigned char* Qg0 = ws + WS_QT + (size_t)(p * 64) * 65536 + wave * 8192 + lane * 16;
    const GAS unsigned char* Kg0 = ws + WS_KWT + (size_t)(p * 64) * 65536 + wave * 8192 + lane * 16;
    const GAS bf16_t* Vg0 = (const GAS bf16_t*)(ws + WS_V) + (size_t)(bl * SEQ + vs) * 2048 + vcol + vpart * 8;
    bf16x8 bS[4], bQ[8], aK[2][4]; u32x4 vreg = (u32x4){0u, 0u, 0u, 0u};
#define V_STAGE(cc_) do { LAS unsigned char* d0_ = VT + ((cc_) & 1) * VTB + (vpart * 8) * PS_PITCH + vs * 2; \
        *(LAS bf16_t*)(d0_ + 0 * PS_PITCH) = (bf16_t)(vreg.x & 0xffffu); *(LAS bf16_t*)(d0_ + 1 * PS_PITCH) = (bf16_t)(vreg.x >> 16); \
        *(LAS bf16_t*)(d0_ + 2 * PS_PITCH) = (bf16_t)(vreg.y & 0xffffu); *(LAS bf16_t*)(d0_ + 3 * PS_PITCH) = (bf16_t)(vreg.y >> 16); \
        *(LAS bf16_t*)(d0_ + 4 * PS_PITCH) = (bf16_t)(vreg.z & 0xffffu); *(LAS bf16_t*)(d0_ + 5 * PS_PITCH) = (bf16_t)(vreg.z >> 16); \
        *(LAS bf16_t*)(d0_ + 6 * PS_PITCH) = (bf16_t)(vreg.w & 0xffffu); *(LAS bf16_t*)(d0_ + 7 * PS_PITCH) = (bf16_t)(vreg.w >> 16); } while (0)
    if (!DEN) { vreg = *(const GAS u32x4*)Vg0; V_STAGE(0); }
    __builtin_amdgcn_sched_barrier(0);
#pragma unroll
    for (int ks = 0; ks < 4; ++ks)
#pragma unroll
        for (int dt = 0; dt < 2; ++dt) aK[dt][ks] = *(const GAS bf16x8*)(Kg0 + (dt * 4 + ks) * 1024);
    __builtin_amdgcn_sched_barrier(0);
#pragma unroll
    for (int ks = 0; ks < 4; ++ks) bS[ks] = *(const GAS bf16x8*)(Sg0 + ks * 1024);
    __builtin_amdgcn_sched_barrier(0);
#pragma unroll
    for (int ks = 0; ks < 8; ++ks) bQ[ks] = *(const GAS bf16x8*)(Qg0 + ks * 1024);
    __builtin_amdgcn_sched_barrier(0);
    if (!DEN) vreg = *(const GAS u32x4*)(Vg0 + (size_t)128 * 2048);
    __builtin_amdgcn_sched_barrier(0);
    const GAS unsigned char* pfp; unsigned pfstride;
    { const int tt = (wave * 64 + lane) < 160 ? wave * 64 + lane : 159; const int idx = sl * 10 + (tt >> 4), off = (tt & 15) * 64;
      pfp = (idx < 32 ? ws + WS_S + (size_t)(p * 64) * 32768 + idx * 1024 : idx < 96 ? ws + WS_QT + (size_t)(p * 64) * 65536 + (idx - 32) * 1024 : ws + WS_KWT + (size_t)(p * 64) * 65536 + (idx - 96) * 1024) + off;
      pfstride = idx < 32 ? 32768u : 65536u; }
    unsigned pfv = 0u;
#pragma unroll 1
    for (int c = 0; c < 64; ++c) {
        const int tl0 = bl * SEQ + c * 128; const size_t tg0 = (size_t)b * SEQ + c * 128;
        const int cn = c < 63 ? c + 1 : 63, cn2 = c < 62 ? c + 2 : 63;
        LAS unsigned char* vt_ = VT + (c & 1) * VTB; LAS unsigned char* ct_ = CT + (c & 1) * CTB; LAS unsigned char* ctn = CT + ((c + 1) & 1) * CTB;
        LDS_BAR();
        if (!DEN && wave < 3) { asm volatile("" :: "v"(pfv)); const int c3 = c < 60 ? c + 3 : 63; pfv = *(const GAS unsigned*)(pfp + (size_t)c3 * pfstride); }
        bf16x8 vf[NVT][4], cf[NVT][4];
#pragma unroll
        for (int vt = 0; vt < NVT; ++vt)
#pragma unroll
            for (int ks = 0; ks < 4; ++ks) vf[vt][ks] = lfrag(vt_, PS_PITCH, vt * 16 + fr, ks * 32, fq);
        const float dec = DEC[c];
        __builtin_amdgcn_sched_barrier(0);
#pragma unroll
        for (int dt = 0; dt < 2; ++dt)
#pragma unroll
            for (int vt = 0; vt < NVT; ++vt) st[dt][vt] = st[dt][vt] * dec;
#pragma unroll
        for (int ks = 0; ks < 4; ++ks) {
#pragma unroll
            for (int vt = 0; vt < NVT; ++vt) cf[vt][ks] = lfrag(ct_, PQ_PITCH, vt * 16 + fr, ks * 32, fq);
#pragma unroll
            for (int dt = 0; dt < 2; ++dt) {
#pragma unroll
                for (int vt = 0; vt < NVT; ++vt) st[dt][vt] = MFMA16(aK[dt][ks], vf[vt][ks], st[dt][vt]);
                aK[dt][ks] = *(const GAS bf16x8*)(Kg0 + (size_t)cn * 65536 + (dt * 4 + ks) * 1024);
            }
            __builtin_amdgcn_sched_barrier(0);
        }
#pragma unroll
        for (int dt = 0; dt < 2; ++dt)
#pragma unroll
            for (int vt = 0; vt < NVT; ++vt) { u32x2 o; o.x = pk2(st[dt][vt][0], st[dt][vt][1]); o.y = pk2(st[dt][vt][2], st[dt][vt][3]);
                *(LAS u32x2*)(ctn + (vt * 16 + fr) * PQ_PITCH + (wave * 32 + dt * 16 + 4 * fq) * 2) = o; }
        __builtin_amdgcn_sched_barrier(0);
        f32x4 acc[NVT];
#pragma unroll
        for (int vt = 0; vt < NVT; ++vt) acc[vt] = (f32x4){0.f, 0.f, 0.f, 0.f};
#pragma unroll
        for (int ks = 0; ks < 4; ++ks) {
#pragma unroll
            for (int vt = 0; vt < NVT; ++vt) acc[vt] = MFMA16(vf[vt][ks], bS[ks], acc[vt]);
            bS[ks] = *(const GAS bf16x8*)(Sg0 + (size_t)cn * 32768 + ks * 1024);
            __builtin_amdgcn_sched_barrier(0);
        }
#pragma unroll
        for (int ks = 0; ks < 8; ++ks) {
#pragma unroll
            for (int vt = 0; vt < NVT; ++vt) acc[vt] = MFMA16(cf[vt][ks & 3], bQ[ks], acc[vt]);
            if (ks < 4) {
#pragma unroll
                for (int vt = 0; vt < NVT; ++vt) cf[vt][ks] = lfrag(ct_, PQ_PITCH, vt * 16 + fr, 128 + ks * 32, fq);
            }
            bQ[ks] = *(const GAS bf16x8*)(Qg0 + (size_t)cn * 65536 + ks * 1024);
            __builtin_amdgcn_sched_barrier(0);
        }
        const int t = wave * 16 + fr;
        if (!DEN) {
            GAS bf16_t* hn = (GAS bf16_t*)(ws + WS_QKPRE) + (size_t)(tl0 + t) * 2048 + vcol + 4 * fq;
#pragma unroll
            for (int vt = 0; vt < NVT; ++vt) { u32x2 o; o.x = pk2(acc[vt][0], acc[vt][1]); o.y = pk2(acc[vt][2], acc[vt][3]); *(GAS u32x2*)(hn + vt * 16) = o; }
            V_STAGE(c + 1); vreg = *(const GAS u32x4*)(Vg0 + (size_t)cn2 * 128 * 2048);
        } else {
            if (fq == 0) ((GAS float*)(ws + WS_DEN))[(tg0 + t) * 4 + h] = acc[0][0];
        }
    }
    asm volatile("" :: "v"(pfv));
    __syncthreads();
#undef V_STAGE
}

constexpr int HG_PD = 4;
__device__ __forceinline__ void hgrn_scan(const DArgs& a, LAS unsigned char* lds, int round, int p, int sl) {
    const int tid = tid_(), lane = tid & 63, wave = __builtin_amdgcn_readfirstlane(tid >> 6), fr = lane & 15, fq = lane >> 4;
    const int bl = p >> 3, h = p & 7;
    GAS unsigned char* ws = a.ws;
    constexpr int IP = 144, ITB = 32 * IP, STB = 32 * PS_PITCH;
    LAS unsigned char* IT = lds; LAS unsigned char* ST = lds + 2 * ITB;
    for (int i = tid; i < (2 * ITB + 2 * STB) / 4; i += NTHR) ((LAS unsigned*)lds)[i] = 0u;
    __syncthreads();
    f32x4 st[2][2];
#pragma unroll
    for (int i = 0; i < 2; ++i) { st[i][0] = (f32x4){0.f, 0.f, 0.f, 0.f}; st[i][1] = st[i][0]; }
    const int vcol = h * 128 + sl * 32;
    const int is = (tid & 255) >> 2, ipart = tid & 3;
    const bool outw = wave < 4;
    const int w4 = wave & 3;
    const GAS unsigned char* Ag0 = ws + WS_ATT + (size_t)(p * 128) * 8192 + w4 * 2048 + lane * 16;
    const GAS unsigned char* Qg0 = ws + WS_QTG + (size_t)(p * 128) * 16384 + w4 * 4096 + lane * 16;
    const GAS unsigned char* Kg0 = ws + WS_KENDT + (size_t)(p * 128) * 16384 + w4 * 4096 + lane * 16;
    const GAS unsigned char* Dg0 = ws + WS_HGDEC + ((size_t)(p * 128) * 128 + w4 * 32 + 4 * fq) * 4;
    const GAS unsigned char* Ig0 = ws + WS_GI + ((size_t)(bl * SEQ + is) * 1024 + vcol + ipart * 8) * 2;
    const GAS unsigned char* gb0 = outw ? Ag0 : Kg0;          const unsigned gs0 = outw ? 8192u : 16384u;
    const GAS unsigned char* gb1 = outw ? Qg0 : Kg0 + 2048;   const unsigned gs1 = 16384u;
    const GAS unsigned char* gb2 = outw ? Qg0 + 2048 : Dg0;   const unsigned gs2 = outw ? 16384u : 512u, gt2 = outw ? 1024u : 64u;
    const GAS unsigned char* gb3 = outw ? Ig0 : Dg0;          const unsigned gs3 = outw ? 131072u : 512u;
    u32x4 pf[HG_PD][7];
#define HG_LD01(k_, cc_) do { _Pragma("unroll") for (int j_ = 0; j_ < 2; ++j_) pf[k_][j_] = *(const GAS u32x4*)(gb0 + (size_t)(cc_) * gs0 + j_ * 1024); } while (0)
#define HG_LD23(k_, cc_) do { _Pragma("unroll") for (int j_ = 0; j_ < 2; ++j_) pf[k_][2 + j_] = *(const GAS u32x4*)(gb1 + (size_t)(cc_) * gs1 + j_ * 1024); } while (0)
#define HG_LD45(k_, cc_) do { _Pragma("unroll") for (int j_ = 0; j_ < 2; ++j_) pf[k_][4 + j_] = *(const GAS u32x4*)(gb2 + (size_t)(cc_) * gs2 + j_ * gt2); } while (0)
#define HG_LD6(k_, cc_) do { pf[k_][6] = *(const GAS u32x4*)(gb3 + (size_t)(cc_) * gs3); } while (0)
#pragma unroll
    for (int k = 0; k < HG_PD; ++k) { HG_LD01(k, k); HG_LD23(k, k); HG_LD45(k, k); __builtin_amdgcn_sched_barrier(0); HG_LD6((k + 1) % HG_PD, (k + 1 < HG_PD ? k + 1 : HG_PD)); __builtin_amdgcn_sched_barrier(0); }
    const GAS unsigned char* pfp; unsigned pfstride;
    { const int tt = (wave * 64 + lane) < 160 ? wave * 64 + lane : 159; const int idx = sl * 10 + (tt >> 4), off = (tt & 15) * 64;
      pfp = (idx < 8 ? ws + WS_ATT + (size_t)(p * 128) * 8192 + idx * 1024 : idx < 24 ? ws + WS_QTG + (size_t)(p * 128) * 16384 + (idx - 8) * 1024 : ws + WS_KENDT + (size_t)(p * 128) * 16384 + (idx - 24) * 1024) + off;
      pfstride = idx < 8 ? 8192u : 16384u; }
    unsigned pfv[HG_PD];
#pragma unroll
    for (int k = 0; k < HG_PD; ++k) pfv[k] = 0u;
#define HG_STAGE(dst_, iv_) do { LAS unsigned char* d0_ = (dst_) + (ipart * 8) * IP + is * 2; \
        *(LAS bf16_t*)(d0_ + 0 * IP) = (bf16_t)((iv_).x & 0xffffu); *(LAS bf16_t*)(d0_ + 1 * IP) = (bf16_t)((iv_).x >> 16); \
        *(LAS bf16_t*)(d0_ + 2 * IP) = (bf16_t)((iv_).y & 0xffffu); *(LAS bf16_t*)(d0_ + 3 * IP) = (bf16_t)((iv_).y >> 16); \
        *(LAS bf16_t*)(d0_ + 4 * IP) = (bf16_t)((iv_).z & 0xffffu); *(LAS bf16_t*)(d0_ + 5 * IP) = (bf16_t)((iv_).z >> 16); \
        *(LAS bf16_t*)(d0_ + 6 * IP) = (bf16_t)((iv_).w & 0xffffu); *(LAS bf16_t*)(d0_ + 7 * IP) = (bf16_t)((iv_).w >> 16); } while (0)
    if (outw) { const u32x4 iv = *(const GAS u32x4*)Ig0; HG_STAGE(IT, iv); }
#pragma unroll 1
    for (int c0 = 0; c0 < 128; c0 += HG_PD) {
#pragma unroll
      for (int k = 0; k < HG_PD; ++k) {
        const int c = c0 + k;
        const int tl0 = bl * SEQ + c * 64;
        const int cn = (c + HG_PD < 128) ? c + HG_PD : 127;
        LAS unsigned char* it_ = IT + (k & 1) * ITB; LAS unsigned char* itn = IT + ((k + 1) & 1) * ITB; LAS unsigned char* st_ = ST + (k & 1) * STB; LAS unsigned char* stn = ST + ((k + 1) & 1) * STB;
        LDS_BAR();
        if (wave < 3) { asm volatile("" :: "v"(pfv[k])); const int c7 = (c + HG_PD + 3 < 128) ? c + HG_PD + 3 : 127; pfv[k] = *(const GAS unsigned*)(pfp + (size_t)c7 * pfstride); }
        bf16x8 itf[2][2];
#pragma unroll
        for (int vt = 0; vt < 2; ++vt)
#pragma unroll
            for (int ks = 0; ks < 2; ++ks) itf[vt][ks] = lfrag(it_, IP, vt * 16 + fr, ks * 32, fq);
        bf16x8 sf[2][4];
        f32x4 acc[2];
        acc[0] = (f32x4){0.f, 0.f, 0.f, 0.f}; acc[1] = acc[0];
        if (outw) {
#pragma unroll
            for (int vt = 0; vt < 2; ++vt)
#pragma unroll
                for (int ks = 0; ks < 4; ++ks) sf[vt][ks] = lfrag(st_, PS_PITCH, vt * 16 + fr, ks * 32, fq);
#pragma unroll
            for (int ks = 0; ks < 2; ++ks)
#pragma unroll
                for (int vt = 0; vt < 2; ++vt) acc[vt] = MFMA16(itf[vt][ks], __builtin_bit_cast(bf16x8, pf[k][ks]), acc[vt]);
        } else {
            const f32x4 dec = __builtin_bit_cast(f32x4, pf[k][4]);
#pragma unroll
            for (int vt = 0; vt < 2; ++vt) { st[0][vt] = st[0][vt] * dec;
#pragma unroll
                for (int ks = 0; ks < 2; ++ks) st[0][vt] = MFMA16(__builtin_bit_cast(bf16x8, pf[k][ks]), itf[vt][ks], st[0][vt]); }
        }
        __builtin_amdgcn_sched_barrier(0);
        HG_LD01(k, cn);
        __builtin_amdgcn_sched_barrier(0);
        if (outw) {
#pragma unroll
            for (int ks = 0; ks < 2; ++ks)
#pragma unroll
                for (int vt = 0; vt < 2; ++vt) acc[vt] = MFMA16(sf[vt][ks], __builtin_bit_cast(bf16x8, pf[k][2 + ks]), acc[vt]);
        } else {
            const f32x4 dec = __builtin_bit_cast(f32x4, pf[k][5]);
#pragma unroll
            for (int vt = 0; vt < 2; ++vt) { st[1][vt] = st[1][vt] * dec;
#pragma unroll
                for (int ks = 0; ks < 2; ++ks) st[1][vt] = MFMA16(__builtin_bit_cast(bf16x8, pf[k][2 + ks]), itf[vt][ks], st[1][vt]); }
        }
        __builtin_amdgcn_sched_barrier(0);
        HG_LD23(k, cn);
        __builtin_amdgcn_sched_barrier(0);
        if (outw) {
#pragma unroll
            for (int ks = 2; ks < 4; ++ks)
#pragma unroll
                for (int vt = 0; vt < 2; ++vt) acc[vt] = MFMA16(sf[vt][ks], __builtin_bit_cast(bf16x8, pf[k][2 + ks]), acc[vt]);
        } else {
#pragma unroll
            for (int dtile = 0; dtile < 2; ++dtile)
#pragma unroll
                for (int vt = 0; vt < 2; ++vt) { u32x2 o; o.x = pk2(st[dtile][vt][0], st[dtile][vt][1]); o.y = pk2(st[dtile][vt][2], st[dtile][vt][3]);
                    *(LAS u32x2*)(stn + (vt * 16 + fr) * PS_PITCH + (w4 * 32 + dtile * 16 + 4 * fq) * 2) = o; }
        }
        __builtin_amdgcn_sched_barrier(0);
        HG_LD45(k, cn);
        __builtin_amdgcn_sched_barrier(0);
        if (outw) {
            HG_STAGE(itn, pf[(k + 1) % HG_PD][6]);
            GAS bf16_t* og = (GAS bf16_t*)(ws + WS_GQ) + (size_t)(tl0 + w4 * 16 + fr) * 1024 + vcol + 4 * fq;
#pragma unroll
            for (int vt = 0; vt < 2; ++vt) { u32x2 o; o.x = pk2(acc[vt][0], acc[vt][1]); o.y = pk2(acc[vt][2], acc[vt][3]); *(GAS u32x2*)(og + vt * 16) = o; }
        }
        __builtin_amdgcn_sched_barrier(0);
        { const int cni = (c + 1 + HG_PD < 128) ? c + 1 + HG_PD : 127; HG_LD6((k + 1) % HG_PD, cni); }
        __builtin_amdgcn_sched_barrier(0);
      }
    }
#pragma unroll
    for (int k = 0; k < HG_PD; ++k) asm volatile("" :: "v"(pfv[k]));
    __syncthreads();
#undef HG_LD01
#undef HG_LD23
#undef HG_LD45
#undef HG_LD6
#undef HG_STAGE
}

__device__ __forceinline__ void xn8_convert(const DArgs& a, int round, int vcu, int G) {
    const int tid = tid_(), lane = tid & 63, wave = tid >> 6;
    const int gw = vcu * NWAVES + wave, NGW = G * NWAVES;
    GAS unsigned char* ws = a.ws;
    for (int tl = gw; tl < RT; tl += NGW) {
        const size_t tg = (size_t)round * RT + tl;
        const GAS u32x2* xr = (const GAS u32x2*)((const GAS bf16_t*)(ws + WS_XN) + tg * D) + lane;
        f32x4 v[4]; float mx = 0.f;
#pragma unroll
        for (int j = 0; j < 4; ++j) { const u32x2 xv = xr[64 * j]; v[j][0] = bf_lo(xv.x); v[j][1] = bf_hi(xv.x); v[j][2] = bf_lo(xv.y); v[j][3] = bf_hi(xv.y);
            mx = fmaxf(mx, fmaxf(fmaxf(fabsf(v[j][0]), fabsf(v[j][1])), fmaxf(fabsf(v[j][2]), fabsf(v[j][3])))); }
        mx = wave_max(mx);
        const float qs = mx > 0.f ? 127.0f / mx : 0.f;
#pragma unroll
        for (int j = 0; j < 4; ++j) ((GAS unsigned*)(ws + WS_XN8 + (size_t)tl * 1024))[64 * j + lane] = pack_i8x4(v[j][0] * qs, v[j][1] * qs, v[j][2] * qs, v[j][3] * qs);
        if (lane == 0) ((GAS float*)(ws + WS_SA8))[tg] = mx * (1.0f / 127.0f);
    }
}

__device__ __forceinline__ void phase_ypass(const DArgs& a, int round, int vcu, int G) {
    const int tid = tid_(), lane = tid & 63, wave = tid >> 6;
    const int gw = vcu * NWAVES + wave, NGW = G * NWAVES;
    GAS unsigned char* ws = a.ws;
    f32x4 mg0[4], mg1[4], gg4[4];
#pragma unroll
    for (int j = 0; j < 4; ++j) { mg0[j] = *(const GAS f32x4*)(a.m_head_g + j * 512 + lane * 8); mg1[j] = *(const GAS f32x4*)(a.m_head_g + j * 512 + lane * 8 + 4); gg4[j] = *(const GAS f32x4*)(a.g_head_g + lane * 16 + 4 * j); }
    for (int tl = gw; tl < RT; tl += NGW) {
        const size_t tg = (size_t)round * RT + tl;
        const f32x4 den4 = *(const f32x4*)((const float*)(ws + WS_DEN) + tg * 4), mt4 = *(const f32x4*)((const float*)(ws + WS_MT) + tg * 4);
        float ym[4][8];
#pragma unroll
        for (int j = 0; j < 4; ++j) {
            const int col = j * 512 + lane * 8;
            const u32x4 nv = *(const u32x4*)((const bf16_t*)(ws + WS_QKPRE) + (size_t)tl * 2048 + col);
            const u32x4 ov = *(const u32x4*)((const bf16_t*)(ws + WS_SIGO) + (size_t)tl * 2048 + col);
            const float inv = 1.0f / fmaxf(fabsf(den4[j]), __expf(-mt4[j]));
            float hv[8] = {bf_lo(nv.x) * inv, bf_hi(nv.x) * inv, bf_lo(nv.y) * inv, bf_hi(nv.y) * inv, bf_lo(nv.z) * inv, bf_hi(nv.z) * inv, bf_lo(nv.w) * inv, bf_hi(nv.w) * inv};
            float ss = 0.f;
#pragma unroll
            for (int e = 0; e < 8; ++e) ss += hv[e] * hv[e];
            const float r = rsqrtf(wave_sum(ss, lane) * (1.f / 512.f) + EPS);
            const f32x4 g0 = mg0[j], g1 = mg1[j];
            const float og[8] = {bf_lo(ov.x), bf_hi(ov.x), bf_lo(ov.y), bf_hi(ov.y), bf_lo(ov.z), bf_hi(ov.z), bf_lo(ov.w), bf_hi(ov.w)};
#pragma unroll
            for (int e = 0; e < 8; ++e) ym[j][e] = og[e] * hv[e] * r * (e < 4 ? g0[e] : g1[e - 4]);
        }
        {
            float mx = 0.f;
#pragma unroll
            for (int j = 0; j < 4; ++j)
#pragma unroll
                for (int e = 0; e < 8; ++e) mx = fmaxf(mx, fabsf(ym[j][e]));
            mx = wave_max(mx);
            const float qs = mx > 0.f ? 127.0f / mx : 0.f;
#pragma unroll
            for (int j = 0; j < 4; ++j) { u32x2 o; o.x = pack_i8x4(ym[j][0] * qs, ym[j][1] * qs, ym[j][2] * qs, ym[j][3] * qs); o.y = pack_i8x4(ym[j][4] * qs, ym[j][5] * qs, ym[j][6] * qs, ym[j][7] * qs);
                *(GAS u32x2*)(ws + WS_V + (size_t)tl * 2048 + j * 512 + lane * 8) = o; }
            if (lane == 0) ((GAS float*)(ws + WS_SYM))[tl] = mx * (1.0f / 127.0f);
        }
        {
            const int col = lane * 16;
            const u32x4 n0 = *(const u32x4*)((const bf16_t*)(ws + WS_GQ) + (size_t)tl * 1024 + col), n1 = *(const u32x4*)((const bf16_t*)(ws + WS_GQ) + (size_t)tl * 1024 + col + 8);
            const u32x4 s0 = *(const u32x4*)((const bf16_t*)(ws + WS_SGG) + (size_t)tl * 1024 + col), s1 = *(const u32x4*)((const bf16_t*)(ws + WS_SGG) + (size_t)tl * 1024 + col + 8);
            float ov[16] = {bf_lo(n0.x), bf_hi(n0.x), bf_lo(n0.y), bf_hi(n0.y), bf_lo(n0.z), bf_hi(n0.z), bf_lo(n0.w), bf_hi(n0.w), bf_lo(n1.x), bf_hi(n1.x), bf_lo(n1.y), bf_hi(n1.y), bf_lo(n1.z), bf_hi(n1.z), bf_lo(n1.w), bf_hi(n1.w)};
            const float sg[16] = {bf_lo(s0.x), bf_hi(s0.x), bf_lo(s0.y), bf_hi(s0.y), bf_lo(s0.z), bf_hi(s0.z), bf_lo(s0.w), bf_hi(s0.w), bf_lo(s1.x), bf_hi(s1.x), bf_lo(s1.y), bf_hi(s1.y), bf_lo(s1.z), bf_hi(s1.z), bf_lo(s1.w), bf_hi(s1.w)};
            float ss = 0.f;
#pragma unroll
            for (int e = 0; e < 16; ++e) ss += ov[e] * ov[e];
            ss += DPP_(ss, 0xB1); ss += DPP_(ss, 0x4E); ss += DPP_(ss, 0x141);
            const float r = rsqrtf(ss * (1.f / 128.f) + EPS);
            float y[16];
#pragma unroll
            for (int e = 0; e < 16; ++e) y[e] = ov[e] * r * gg4[e >> 2][e & 3] * sg[e];
            float mx = 0.f;
#pragma unroll
            for (int e = 0; e < 16; ++e) mx = fmaxf(mx, fabsf(y[e]));
            mx = wave_max(mx);
            const float qs = mx > 0.f ? 127.0f / mx : 0.f;
            u32x4 o; o.x = pack_i8x4(y[0] * qs, y[1] * qs, y[2] * qs, y[3] * qs); o.y = pack_i8x4(y[4] * qs, y[5] * qs, y[6] * qs, y[7] * qs);
            o.z = pack_i8x4(y[8] * qs, y[9] * qs, y[10] * qs, y[11] * qs); o.w = pack_i8x4(y[12] * qs, y[13] * qs, y[14] * qs, y[15] * qs);
            *(GAS u32x4*)(ws + WS_GI + (size_t)tl * 1024 + col) = o;
            if (lane == 0) ((GAS float*)(ws + WS_SYG))[tl] = mx * (1.0f / 127.0f);
        }
    }
}


#define XB_TMO      128
#define XB_XCNT(j)  (256  + 64 * (j))
#define XB_XSUB(j)  (1280 + 64 * (j))
#define XB_XGEN(j)  (2304 + 64 * (j))
#define XB_TOP      3328
#define XB_TOPGEN   3392
#define XB_SPIN_CAP (1u << 22)
constexpr int CW_BAR = 4096;
constexpr int LDS_BARST = LDS_BYTES - 64;
__device__ __forceinline__ unsigned xb_ld(unsigned* p)              { return __hip_atomic_load(p, __ATOMIC_RELAXED, __HIP_MEMORY_SCOPE_AGENT); }
__device__ __forceinline__ unsigned xb_add(unsigned* p, unsigned v) { return __hip_atomic_fetch_add(p, v, __ATOMIC_RELAXED, __HIP_MEMORY_SCOPE_AGENT); }
__device__ __forceinline__ unsigned xb_xcc_id() { return (unsigned)__builtin_amdgcn_s_getreg((3 << 11) | 20) & 0xFu; }
#define XB_SPIN(cond, bar) do { unsigned _sp = 0; while (cond) { __builtin_amdgcn_s_sleep(1); \
    if ((++_sp & 255u) == 0u) { if (xb_ld(&(bar)[XB_TMO])) break; if (_sp > XB_SPIN_CAP) { atomicAdd(&(bar)[XB_TMO], 1u); break; } } } } while (0)
__device__ __forceinline__ void xcd_barrier_post(unsigned* bar, volatile LAS unsigned* st) { if (tid_() == 0) st[2] = xb_add(&bar[XB_XCNT(xb_xcc_id())], 1u); }
__device__ __forceinline__ void xcd_barrier_complete(unsigned* bar, unsigned x, unsigned& nloc, unsigned& nx) {
    const unsigned G = gridDim.x;
    unsigned sum, cnt, mine, sp = 0u;
    for (;;) {
        sum = 0u; cnt = 0u; mine = 0u;
#pragma unroll
        for (unsigned j = 0; j < 16; ++j) { const unsigned c = xb_ld(&bar[XB_XCNT(j)]); sum += c; cnt += (c > 0u) ? 1u : 0u; mine = (j == x) ? c : mine; }
        if (sum == G) break;
        __builtin_amdgcn_s_sleep(1);
        if ((++sp & 255u) == 0u) { if (xb_ld(&bar[XB_TMO])) break; if (sp > XB_SPIN_CAP) { atomicAdd(&bar[XB_TMO], 1u); break; } }
    }
    nloc = mine > 0u ? mine : 1u; nx = cnt > 0u ? cnt : 1u;
}
__device__ __forceinline__ void xcd_barrier(unsigned* bar, volatile LAS unsigned* st) {
    asm volatile("s_waitcnt vmcnt(0)" ::: "memory");
    __syncthreads();
    if (tid_() == 0) {
        const unsigned x = xb_xcc_id();
        __builtin_amdgcn_s_waitcnt(0);
        unsigned nloc = st[0], nx = st[1];
        if (nloc == 0u) { xcd_barrier_complete(bar, x, nloc, nx); st[0] = nloc; st[1] = nx; }
        const unsigned old = xb_add(&bar[XB_XSUB(x)], 1u);
        const unsigned gen = old / nloc;
        if (old + 1u == (gen + 1u) * nloc) {
            __builtin_amdgcn_fence(__ATOMIC_RELEASE, "agent");
            asm volatile("s_waitcnt vmcnt(0)" ::: "memory");
            const unsigned og = xb_add(&bar[XB_TOP], 1u);
            const unsigned tg = og / nx;
            if (og + 1u == (tg + 1u) * nx) xb_add(&bar[XB_TOPGEN], 1u);
            else XB_SPIN(xb_ld(&bar[XB_TOPGEN]) == tg, bar);
            __builtin_amdgcn_fence(__ATOMIC_ACQUIRE, "agent");
            xb_add(&bar[XB_XGEN(x)], 1u);
            asm volatile("s_waitcnt vmcnt(0)" ::: "memory");
        } else {
            XB_SPIN(xb_ld(&bar[XB_XGEN(x)]) == gen, bar);
            __builtin_amdgcn_fence(__ATOMIC_ACQUIRE, "agent");
            asm volatile("s_waitcnt vmcnt(0)" ::: "memory");
        }
    }
    __syncthreads();
}

__device__ __forceinline__ void phase_p8(const DArgs& a, int vcu, int G) {
    const int tid = tid_(), lane = tid & 63, wave = tid >> 6;
    const int gw = vcu * NWAVES + wave, NGW = G * NWAVES;
    GAS unsigned char* ws = a.ws;
    f32x4 g2[4];
#pragma unroll
    for (int j = 0; j < 4; ++j) g2[j] = ((const f32x4*)a.norm2_g)[64 * j + lane];
    for (int m = gw; m < T; m += NGW) {
        const GAS u32x2* xr = (const GAS u32x2*)((const GAS bf16_t*)a.out + (size_t)m * D) + lane;
        f32x4 v[4]; float s = 0.f;
#pragma unroll
        for (int j = 0; j < 4; ++j) { const u32x2 xv = xr[64 * j]; v[j][0] = bf_lo(xv.x); v[j][1] = bf_hi(xv.x); v[j][2] = bf_lo(xv.y); v[j][3] = bf_hi(xv.y); s += (v[j][0] * v[j][0] + v[j][1] * v[j][1]) + (v[j][2] * v[j][2] + v[j][3] * v[j][3]); }
        const float rstd = rsqrtf(wave_sum(s, lane) * (1.f / D) + EPS);
#pragma unroll
        for (int j = 0; j < 4; ++j) v[j] = v[j] * rstd * g2[j];
        float mx = 0.f;
#pragma unroll
        for (int j = 0; j < 4; ++j) mx = fmaxf(mx, fmaxf(fmaxf(fabsf(v[j][0]), fabsf(v[j][1])), fmaxf(fabsf(v[j][2]), fabsf(v[j][3]))));
        mx = wave_max(mx);
        const float qs = mx > 0.f ? 127.0f / mx : 0.f;
#pragma unroll
        for (int j = 0; j < 4; ++j) ((GAS unsigned*)(ws + WS_XQ + (size_t)m * 1024))[64 * j + lane] = pack_i8x4(v[j][0] * qs, v[j][1] * qs, v[j][2] * qs, v[j][3] * qs);
        if (lane == 0) ((GAS float*)(ws + WS_XQS))[m] = mx * (1.0f / 127.0f);
    }
    for (int e = gw; e < 16384; e += NGW) {
        f32x4 uv[4], vv[4]; float mu = 0.f, mv = 0.f;
#pragma unroll
        for (int j = 0; j < 4; ++j) { uv[j] = ((const GAS f32x4*)(a.u_emb + (size_t)e * 1024))[64 * j + lane]; vv[j] = ((const GAS f32x4*)(a.v_emb + (size_t)e * 1024))[64 * j + lane];
            mu = fmaxf(mu, fmaxf(fmaxf(fabsf(uv[j][0]), fabsf(uv[j][1])), fmaxf(fabsf(uv[j][2]), fabsf(uv[j][3]))));
            mv = fmaxf(mv, fmaxf(fmaxf(fabsf(vv[j][0]), fabsf(vv[j][1])), fmaxf(fabsf(vv[j][2]), fabsf(vv[j][3])))); }
        mu = wave_max(mu); mv = wave_max(mv);
        const float su = mu > 0.f ? 127.0f / mu : 0.f, sv = mv > 0.f ? 448.0f / mv : 0.f;
        if (lane == 0) { ((GAS float*)(ws + WS_USC))[e] = mu * (1.0f / 127.0f); ((GAS float*)(ws + WS_VSC))[e] = mv * (1.0f / 448.0f); }
#pragma unroll
        for (int j = 0; j < 4; ++j) {
            const size_t ob = (size_t)(2 * j + (lane >> 5)) * 2097152 + (size_t)e * 128 + ((4 * lane) & 127);
            *(GAS unsigned*)(ws + WS_UB + ob) = pack_i8x4(uv[j][0] * su, uv[j][1] * su, uv[j][2] * su, uv[j][3] * su);
            int p = __builtin_amdgcn_cvt_pk_fp8_f32(vv[j][0] * sv, vv[j][1] * sv, 0, false); p = __builtin_amdgcn_cvt_pk_fp8_f32(vv[j][2] * sv, vv[j][3] * sv, p, true);
            *(GAS unsigned*)(ws + WS_VB + ob) = (unsigned)p; }
    }
}

__device__ __forceinline__ unsigned f2ord(float f) { const unsigned u = __builtin_bit_cast(unsigned, f); return (u & 0x80000000u) ? ~u : (u | 0x80000000u); }
__device__ __forceinline__ float ord2f(unsigned k) { const unsigned u = (k & 0x80000000u) ? (k & 0x7fffffffu) : ~k; return __builtin_bit_cast(float, u); }
__device__ __forceinline__ unsigned umax_(unsigned a, unsigned b) { return a > b ? a : b; }
__device__ __forceinline__ unsigned shxu(unsigned v, int o, int lane) { return (unsigned)__builtin_amdgcn_ds_bpermute((lane ^ o) << 2, (int)v); }

__device__ __forceinline__ unsigned umin_(unsigned a, unsigned b) { return a < b ? a : b; }
#define TK_CE(a_, b_) do { const unsigned hi_ = umax_((a_), (b_)), lo_ = umin_((a_), (b_)); (a_) = hi_; (b_) = lo_; } while (0)
__device__ __forceinline__ void tk_sort16(unsigned (&x)[32], int o) {
#pragma unroll
    for (int k = 2; k <= 16; k <<= 1)
#pragma unroll
        for (int j = k >> 1; j > 0; j >>= 1)
#pragma unroll
            for (int i = 0; i < 16; ++i) { const int l = i ^ j; if (l > i) { if ((i & k) == 0) TK_CE(x[o + i], x[o + l]); else TK_CE(x[o + l], x[o + i]); } }
}
__device__ __forceinline__ void tk_merge16(unsigned (&t)[16]) {
#pragma unroll
    for (int j = 8; j > 0; j >>= 1)
#pragma unroll
        for (int i = 0; i < 16; ++i) { const int l = i ^ j; if (l > i) TK_CE(t[i], t[l]); }
}
__device__ __forceinline__ void phase_topk(const DArgs& a, LAS unsigned char* lds, int bx, int G) {
    const int tid = tid_(), lane = tid & 63, wave = __builtin_amdgcn_readfirstlane(tid >> 6), fr = lane & 15, fq = lane >> 4;
    GAS unsigned char* ws = a.ws;
    const int h = bx & 7;
    LAS unsigned char* KY = lds;
    LAS unsigned char* QL = lds + 2 * 128 * PS_PITCH;
    LAS unsigned* TOP = (LAS unsigned*)(lds + 2 * 128 * PS_PITCH + 64 * PQ_PITCH);
#pragma unroll
    for (int i = 0; i < 8; ++i) { const int idx = tid + 512 * i, row = idx >> 4, ch = idx & 15;
        *(LAS u32x4*)(KY + row * PS_PITCH + ch * 16) = *(const u32x4*)((const bf16_t*)(ws + WS_SK) + ((size_t)h * 256 + row) * 128 + ch * 8); }
    const int ntile = T / 64;
    u32x4 qpre[4];
    { const int tile0 = bx >> 3; if (tile0 < ntile) {
#pragma unroll
        for (int i = 0; i < 4; ++i) { const int idx = tid + 512 * i, row = idx >> 5, ch = idx & 31;
            qpre[i] = *(const GAS u32x4*)((const GAS bf16_t*)(ws + WS_QP) + ((size_t)tile0 * 64 + row) * 2048 + h * 256 + ch * 8); } } }
    __syncthreads();
    for (int tile = bx >> 3; tile < ntile; tile += (G >> 3)) {
        const size_t t0 = (size_t)tile * 64;
        LDS_BAR();
#pragma unroll
        for (int i = 0; i < 4; ++i) { const int idx = tid + 512 * i, row = idx >> 5, ch = idx & 31;
            *(LAS u32x4*)(QL + row * PQ_PITCH + ch * 16) = qpre[i]; }
        { const int tn = tile + (G >> 3); if (tn < ntile) {
#pragma unroll
            for (int i = 0; i < 4; ++i) { const int idx = tid + 512 * i, row = idx >> 5, ch = idx & 31;
                qpre[i] = *(const GAS u32x4*)((const GAS bf16_t*)(ws + WS_QP) + ((size_t)tn * 64 + row) * 2048 + h * 256 + ch * 8); } } }
        LDS_BAR();
        {
            const int mt = wave & 3, p = wave >> 2;
            unsigned key[32];
#pragma unroll
            for (int nt = 0; nt < 8; ++nt) { f32x4 acc = (f32x4){0.f, 0.f, 0.f, 0.f};
#pragma unroll
                for (int ks = 0; ks < 4; ++ks) acc = MFMA16(lfrag(KY + p * 128 * PS_PITCH, PS_PITCH, nt * 16 + fr, ks * 32, fq), lfrag(QL, PQ_PITCH, mt * 16 + fr, p * 128 + ks * 32, fq), acc);
#pragma unroll
                for (int j = 0; j < 4; ++j) { const int n = nt * 16 + 4 * fq + j; key[nt * 4 + j] = (f2ord(acc[j]) & ~127u) | (unsigned)(127 - n); } }
            tk_sort16(key, 0); tk_sort16(key, 16);
            unsigned t[16];
#pragma unroll
            for (int i = 0; i < 16; ++i) t[i] = umax_(key[i], key[31 - i]);
            tk_merge16(t);
            {   unsigned pv[16];
#pragma unroll
                for (int i = 0; i < 16; ++i) pv[i] = (unsigned)SWZI_(t[15 - i], 0x401F);
#pragma unroll
                for (int i = 0; i < 16; ++i) t[i] = umax_(t[i], pv[i]);
                tk_merge16(t);
#pragma unroll
                for (int i = 0; i < 16; ++i) pv[i] = xor32u_(t[15 - i], lane >= 32);
#pragma unroll
                for (int i = 0; i < 16; ++i) t[i] = umax_(t[i], pv[i]);
                tk_merge16(t); }
#pragma unroll
            for (int k = 0; k < 16; ++k) { if (fq == (k & 3)) TOP[(p * 64 + mt * 16 + fr) * 16 + k] = t[k]; }
        }
        LDS_BAR();
        {
            const int t = tid >> 3, sub = tid & 7;
            unsigned ck[7];
#pragma unroll
            for (int e = 0; e < 7; ++e) {
                const int ci = sub + 8 * e;
                int i = 0, base = 0; bool ok = ci < 50;
                if (ci >= 42) { i = 8 + (ci - 42); base = ci; } else if (ci >= 40) { i = 7; base = 40; } else if (ci >= 38) { i = 6; base = 38; } else if (ci >= 36) { i = 5; base = 36; }
                else if (ci >= 33) { i = 4; base = 33; } else if (ci >= 29) { i = 3; base = 29; } else if (ci >= 24) { i = 2; base = 24; } else if (ci >= 16) { i = 1; base = 16; }
                const int j = ci - base;
                unsigned kk = 0u;
                if (ok) { const float s0 = ord2f(TOP[(0 * 64 + t) * 16 + i] & ~127u), s1 = ord2f(TOP[(1 * 64 + t) * 16 + j] & ~127u);
                    kk = (f2ord(s0 + s1) & ~255u) | (unsigned)(255 - (i * 16 + j)); }
                ck[e] = kk;
            }
            unsigned x[16];
#pragma unroll
            for (int e = 0; e < 7; ++e) x[e] = ck[e];
            x[7] = 0u;
#pragma unroll
            for (int k = 2; k <= 8; k <<= 1)
#pragma unroll
                for (int j = k >> 1; j > 0; j >>= 1)
#pragma unroll
                    for (int i = 0; i < 8; ++i) { const int l = i ^ j; if (l > i) { if ((i & k) == 0) TK_CE(x[i], x[l]); else TK_CE(x[l], x[i]); } }
#pragma unroll
            for (int i = 0; i < 8; ++i) x[8 + i] = (unsigned)DPPI_(x[7 - i], 0xB1);
            tk_merge16(x);
            {   unsigned pv[16];
#pragma unroll
                for (int i = 0; i < 16; ++i) pv[i] = (unsigned)DPPI_(x[15 - i], 0x4E);
#pragma unroll
                for (int i = 0; i < 16; ++i) x[i] = umax_(x[i], pv[i]);
                tk_merge16(x);
#pragma unroll
                for (int i = 0; i < 16; ++i) pv[i] = (unsigned)DPPI_(x[15 - i], 0x141);
#pragma unroll
                for (int i = 0; i < 16; ++i) x[i] = umax_(x[i], pv[i]);
                tk_merge16(x); }
            unsigned w0 = x[0], w1 = x[8];
#pragma unroll
            for (int e = 1; e < 8; ++e) { w0 = (sub == e) ? x[e] : w0; w1 = (sub == e) ? x[8 + e] : w1; }
            const int f0 = 255 - (int)(w0 & 255u), f1 = 255 - (int)(w1 & 255u);
            const float sc0 = ord2f(w0 & ~255u), sc1 = ord2f(w1 & ~255u);
            float mx = fmaxf(sc0, sc1); mx = fmaxf(mx, DPP_(mx, 0xB1)); mx = fmaxf(mx, DPP_(mx, 0x4E)); mx = fmaxf(mx, DPP_(mx, 0x141));
            const float e0 = __expf(sc0 - mx), e1 = __expf(sc1 - mx);
            float sm = e0 + e1; sm += DPP_(sm, 0xB1); sm += DPP_(sm, 0x4E); sm += DPP_(sm, 0x141);
            const float inv = 1.0f / sm;
            const int i0 = 127 - (int)(TOP[(0 * 64 + t) * 16 + (f0 >> 4)] & 127u), j0 = 127 - (int)(TOP[(1 * 64 + t) * 16 + (f0 & 15)] & 127u);
            const int i1 = 127 - (int)(TOP[(0 * 64 + t) * 16 + (f1 >> 4)] & 127u), j1 = 127 - (int)(TOP[(1 * 64 + t) * 16 + (f1 & 15)] & 127u);
            unsigned short* ei = (unsigned short*)(ws + WS_EIDX) + ((t0 + t) * 8 + h) * 16; float* gp = (float*)(ws + WS_GATE) + ((t0 + t) * 8 + h) * 16;
            ei[sub] = (unsigned short)(i0 * 128 + j0); ei[sub + 8] = (unsigned short)(i1 * 128 + j1); gp[sub] = e0 * inv; gp[sub + 8] = e1 * inv;
        }
    }
    __syncthreads();
}

__device__ __forceinline__ void ins16(float (&v)[16], int (&id)[16], float x, int n) {
    if (x > v[15]) { v[15] = x; id[15] = n;
#pragma unroll
        for (int i = 15; i >= 1; --i) { if (v[i] > v[i - 1]) { const float tv = v[i]; v[i] = v[i - 1]; v[i - 1] = tv; const int ti = id[i]; id[i] = id[i - 1]; id[i - 1] = ti; } } }
}
__device__ __forceinline__ void phase_topk_ref(const DArgs& a, int vcu, int G) {
    const int tid = tid_();
    GAS unsigned char* ws = a.ws;
    const int gt = vcu * NTHR + tid, NGT = G * NTHR;
    for (int pair = gt; pair < T * 8; pair += NGT) {
        const int t = pair >> 3, h = pair & 7;
        float sv[2][16]; int si[2][16];
#pragma unroll
        for (int p = 0; p < 2; ++p) {
#pragma unroll
            for (int i = 0; i < 16; ++i) { sv[p][i] = -INFINITY; si[p][i] = 0; }
            const bf16_t* qp = (const bf16_t*)(ws + WS_QP) + (size_t)t * 2048 + h * 256 + p * 128;
            for (int n = 0; n < 128; ++n) {
                const bf16_t* kp = (const bf16_t*)(ws + WS_SK) + ((size_t)(h * 2 + p) * 128 + n) * 128;
                float s = 0.f;
                for (int c = 0; c < 128; c += 8) { const u32x4 qv = *(const u32x4*)(qp + c), kv = *(const u32x4*)(kp + c);
                    s += bf_lo(qv.x) * bf_lo(kv.x) + bf_hi(qv.x) * bf_hi(kv.x) + bf_lo(qv.y) * bf_lo(kv.y) + bf_hi(qv.y) * bf_hi(kv.y)
                       + bf_lo(qv.z) * bf_lo(kv.z) + bf_hi(qv.z) * bf_hi(kv.z) + bf_lo(qv.w) * bf_lo(kv.w) + bf_hi(qv.w) * bf_hi(kv.w); }
                ins16(sv[p], si[p], s, n);
            }
        }
        float tv[16]; int ti[16];
#pragma unroll
        for (int i = 0; i < 16; ++i) { tv[i] = -INFINITY; ti[i] = 0; }
#pragma unroll
        for (int i = 0; i < 16; ++i)
#pragma unroll
            for (int j = 0; j < 16; ++j) ins16(tv, ti, sv[0][i] + sv[1][j], i * 16 + j);
        float sm = 0.f, ex[16];
#pragma unroll
        for (int k = 0; k < 16; ++k) { ex[k] = __expf(tv[k] - tv[0]); sm += ex[k]; }
        int* ei = (int*)(ws + WS_EIDX) + (size_t)pair * 16; float* gp = (float*)(ws + WS_GATE) + (size_t)pair * 16;
#pragma unroll
        for (int k = 0; k < 16; ++k) {
            int e0 = 0, e1 = 0;
#pragma unroll
            for (int i = 0; i < 16; ++i) { e0 = ((ti[k] >> 4) == i) ? si[0][i] : e0; e1 = ((ti[k] & 15) == i) ? si[1][i] : e1; }
            ei[k] = e0 * 128 + e1; gp[k] = ex[k] / sm; }
    }
}

#define FP8LO(w) __builtin_amdgcn_cvt_pk_f32_fp8((int)(w), false)
#define FP8HI(w) __builtin_amdgcn_cvt_pk_f32_fp8((int)(w), true)
__device__ __forceinline__ float dot16_fp8(const u32x4 r, const float (&x)[16]) {
    float c = 0.f;
#pragma unroll
    for (int j = 0; j < 4; ++j) { const f32x2 lo = FP8LO(r[j]), hi = FP8HI(r[j]); c += lo[0] * x[4 * j] + lo[1] * x[4 * j + 1] + hi[0] * x[4 * j + 2] + hi[1] * x[4 * j + 3]; }
    return c;
}
__device__ __forceinline__ float dot16_fp8p(const u32x4 r, const f32x2 (&xp)[8]) {
    f32x2 c2 = (f32x2){0.f, 0.f};
#pragma unroll
    for (int j = 0; j < 4; ++j) { c2 += FP8LO(r[j]) * xp[2 * j]; c2 += FP8HI(r[j]) * xp[2 * j + 1]; }
    return c2[0] + c2[1];
}
__device__ __forceinline__ float gelu_erf(float d) {
    const float ad = fabsf(d), t = __builtin_amdgcn_rcpf(ad * 0.2316418882f + 1.0f);
    float q = t * 0.5307027145f + (-0.7265760135f); q = q * t + 0.7107068705f; q = q * t + (-0.142248368f); q = q * t + 0.127414796f; q = q * t;
    const float m = d * (q * __builtin_amdgcn_exp2f(d * d * (-0.72134752044f)));
    return d < 0.f ? m : d - m;
}
__device__ __forceinline__ float bperm(float v, int srclane) { return __builtin_bit_cast(float, __builtin_amdgcn_ds_bpermute(srclane << 2, __builtin_bit_cast(int, v))); }
#define SWZ_(v, pat) __builtin_bit_cast(float, __builtin_amdgcn_ds_swizzle(__builtin_bit_cast(int, (v)), (pat)))
__device__ __forceinline__ float rs32_(float a, float b) {
#if defined(__HIP_DEVICE_COMPILE__)
    asm volatile("s_nop 1\n\tv_permlane32_swap_b32 %0, %1" : "+v"(a), "+v"(b));
#endif
    return a + b;
}
__device__ __forceinline__ float rs16_(float a, float b) {
#if defined(__HIP_DEVICE_COMPILE__)
    asm volatile("s_nop 1\n\tv_permlane16_swap_b32 %0, %1" : "+v"(a), "+v"(b));
#endif
    return a + b;
}
__device__ __forceinline__ float rs8_(float a, float b, bool bit3) {
    const float send = bit3 ? a : b, keep = bit3 ? b : a;
    return keep + DPP_(send, 0x128);
}
__device__ __forceinline__ float xor32_(float v, bool hi) {
#if defined(__HIP_DEVICE_COMPILE__)
    const auto r = __builtin_amdgcn_permlane32_swap(__builtin_bit_cast(unsigned, v), __builtin_bit_cast(unsigned, v), false, false);
    return __builtin_bit_cast(float, hi ? r[0] : r[1]);
#else
    (void)hi; return v;
#endif
}
__device__ __forceinline__ float reduce8(const float (&p)[8], int lane) {
    float q4[4], q2[2];
    const bool b5 = lane & 32, b4 = lane & 16, b3 = lane & 8;
#pragma unroll
    for (int i = 0; i < 4; ++i) { const float send = b5 ? p[i] : p[i + 4], keep = b5 ? p[i + 4] : p[i]; q4[i] = keep + xor32_(send, b5); }
#pragma unroll
    for (int i = 0; i < 2; ++i) { const float send = b4 ? q4[i] : q4[i + 2], keep = b4 ? q4[i + 2] : q4[i]; q2[i] = keep + SWZ_(send, 0x401F); }
    const float send = b3 ? q2[0] : q2[1], keep = b3 ? q2[1] : q2[0];
    float q1 = keep + SWZ_(send, 0x201F);
    q1 += DPP_(q1, 0xB1); q1 += DPP_(q1, 0x4E); q1 += DPP_(q1, 0x141);
    return q1;
}
__device__ __forceinline__ void phase_udots(const DArgs& a, LAS unsigned char* lds) {
    const int tid = tid_(), lane = tid & 63, wave = __builtin_amdgcn_readfirstlane(tid >> 6);
    GAS unsigned char* ws = a.ws;
    volatile LAS unsigned* bst = (volatile LAS unsigned*)(lds + LDS_BARST);
    const int nloc = (int)bst[0], nx = (int)bst[1], rank = (int)bst[2];
    unsigned* bar = (unsigned*)(ws + WS_CTL) + CW_BAR;
    const unsigned myx = xb_xcc_id();
    int q = 0;
    for (unsigned j = 0; j < 16; ++j) { const unsigned c = xb_ld(&bar[XB_XCNT(j)]); if (c > 0u && j < myx) ++q; }
    LAS int* LE = (LAS int*)(lds + wave * 2048);
    LAS int* LP = LE + 128; LAS float* LG = (LAS float*)(LE + 256);
    const GAS unsigned char* UB = ws + WS_UB;
    const int g8 = lane >> 3;
    const float usc = ((const GAS float*)(ws + WS_USC))[0], vsc = ((const GAS float*)(ws + WS_USC))[1];
    for (int s = q; s < 8; s += nx) {
        int tok = rank * 8 + wave;
        u32x4 xq0 = (u32x4){0u, 0u, 0u, 0u}, xq1 = xq0; u32x2 e2 = (u32x2){0u, 0u}; f32x2 g2 = (f32x2){0.f, 0.f};
#define U_INFO(t_) do { xq0 = *(const u32x4*)((const GAS bf16_t*)(ws + WS_XN) + (size_t)(t_) * D + lane * 16); xq1 = *(const u32x4*)((const GAS bf16_t*)(ws + WS_XN) + (size_t)(t_) * D + lane * 16 + 8); \
        e2 = *(const u32x2*)((const GAS int*)(ws + WS_EIDX) + (size_t)(t_) * 128 + 2 * lane); g2 = *(const f32x2*)((const GAS float*)(ws + WS_GATE) + (size_t)(t_) * 128 + 2 * lane); } while (0)
        if (tok < T) U_INFO(tok);
        for (; tok < T; tok += nloc * 8) {
            const bool in0 = (int)(e2.x >> 11) == s, in1 = (int)(e2.y >> 11) == s;
            const unsigned long long m0 = __ballot(in0), m1 = __ballot(in1);
            const unsigned long long lt = (1ull << lane) - 1ull;
            const int n0 = __popcll(m0), n = n0 + __popcll(m1);
            if (in0) { const int pos = __popcll(m0 & lt); LE[pos] = (int)e2.x; LP[pos] = 2 * lane; LG[pos] = g2[0]; }
            if (in1) { const int pos = n0 + __popcll(m1 & lt); LE[pos] = (int)e2.y; LP[pos] = 2 * lane + 1; LG[pos] = g2[1]; }
            const float xf[16] = {bf_lo(xq0.x), bf_hi(xq0.x), bf_lo(xq0.y), bf_hi(xq0.y), bf_lo(xq0.z), bf_hi(xq0.z), bf_lo(xq0.w), bf_hi(xq0.w),
                                  bf_lo(xq1.x), bf_hi(xq1.x), bf_lo(xq1.y), bf_hi(xq1.y), bf_lo(xq1.z), bf_hi(xq1.z), bf_lo(xq1.w), bf_hi(xq1.w)};
            asm volatile("s_waitcnt lgkmcnt(0)" ::: "memory");
            u32x4 R0[8], R1[8], R2[8];
#define U_ISSUE(R_, g0_) do { _Pragma("unroll") for (int k = 0; k < 8; ++k) { const int slot_ = ((g0_) + k < n) ? (g0_) + k : n - 1; const int e_ = LE[slot_]; R_[k] = *(const u32x4*)(UB + (size_t)e_ * 1024 + lane * 16); } } while (0)
#define U_DOTS(R_, g0_) do { float pp_[8]; _Pragma("unroll") for (int k = 0; k < 8; ++k) pp_[k] = dot16_fp8(R_[k], xf); const float dsum_ = reduce8(pp_, lane); const int slot_ = (g0_) + g8; \
            if (slot_ < n && (lane & 7) == 0) { const float d_ = dsum_ * usc; \
                ((GAS float*)(ws + WS_PW))[(size_t)tok * 128 + LP[slot_]] = 0.5f * d_ * (1.0f + erff(d_ * 0.70710678118654752f)) * LG[slot_] * vsc; } } while (0)
            if (n > 0) U_ISSUE(R0, 0);
            if (n > 8) U_ISSUE(R1, 8);
            if (n > 16) U_ISSUE(R2, 16);
            const int tokN = tok + nloc * 8;
            if (tokN < T) U_INFO(tokN);
            if (n > 0) U_DOTS(R0, 0);
            if (n > 8) U_DOTS(R1, 8);
            if (n > 16) U_DOTS(R2, 16);
            for (int g0 = 24; g0 < n; g0 += 8) { U_ISSUE(R0, g0); U_DOTS(R0, g0); }
            asm volatile("s_waitcnt lgkmcnt(0)" ::: "memory");
        }
#undef U_INFO
#undef U_ISSUE
#undef U_DOTS
    }
}

#define EV_OFF(ev_, g_) (((g_) & 1) ? ((ev_[(g_) >> 3][((g_) >> 1) & 3] >> 9) & 0x7fff80u) : ((ev_[(g_) >> 3][((g_) >> 1) & 3] << 7) & 0x7fff80u))
struct XcdSlice { int nloc, nx, rank, q; };
__device__ __forceinline__ XcdSlice xcd_slice_setup(const DArgs& a, LAS unsigned char* lds) {
    volatile LAS unsigned* bst = (volatile LAS unsigned*)(lds + LDS_BARST);
    XcdSlice x; x.nloc = __builtin_amdgcn_readfirstlane((int)bst[0]); x.nx = __builtin_amdgcn_readfirstlane((int)bst[1]); x.rank = __builtin_amdgcn_readfirstlane((int)bst[2]);
    unsigned* bar = (unsigned*)(a.ws + WS_CTL) + CW_BAR; const unsigned myx = xb_xcc_id();
    x.q = 0; for (unsigned j = 0; j < 16; ++j) { const unsigned c = xb_ld(&bar[XB_XCNT(j)]); if (c > 0u && j < myx) ++x.q; }
    x.q = __builtin_amdgcn_readfirstlane(x.q);
    return x;
}
__device__ __forceinline__ void phase_ua(const DArgs& a, LAS unsigned char* lds) {
    const int tid = tid_(), lane = tid & 63, wave = __builtin_amdgcn_readfirstlane(tid >> 6), k = lane >> 3, c = lane & 7;
    GAS unsigned char* ws = a.ws;
    const XcdSlice X = xcd_slice_setup(a, lds);
    const int tstride = X.nloc * 8;
    for (int sl = X.q; sl < 8; sl += X.nx) {
        const GAS unsigned char* UBs = ws + WS_UB + (size_t)sl * 2097152;
        const unsigned coff = (unsigned)c * 16u;
        GAS unsigned char* PU = ws + WS_PARTU + (size_t)sl * T * 256;
        u32x4 evA[2], evB[2], RA[16], RB[16], xa, xb; float sa, sb;
#define A_TOK(t_) ((t_) < T ? (t_) : T - 1)
#define A_INFO(ev_, t_) do { const int tq_ = A_TOK(t_); _Pragma("unroll") for (int j_ = 0; j_ < 2; ++j_) ev_[j_] = *(const GAS u32x4*)(ws + WS_EIDX + (size_t)tq_ * 256 + (unsigned)(32 * k + 16 * j_)); } while (0)
#define A_ISSUE(R_, x_, s_, ev_, t_) do { const int tq_ = A_TOK(t_); _Pragma("unroll") for (int g_ = 0; g_ < 16; ++g_) R_[g_] = *(const GAS u32x4*)(UBs + (EV_OFF(ev_, g_) | coff)); \
        x_ = *(const GAS u32x4*)(ws + WS_XQ + (size_t)tq_ * 1024 + sl * 128 + coff); s_ = ((const GAS float*)(ws + WS_XQS))[tq_]; } while (0)
#define A_DOTS(R_, x_, s_, t_) do { \
        int ir0_ = 0, ir1_ = 0; \
        _Pragma("unroll") for (int gg_ = 0; gg_ < 4; ++gg_) {           \
            int d_[4]; _Pragma("unroll") for (int q_ = 0; q_ < 4; ++q_) d_[q_] = 0; \
            _Pragma("unroll") for (int j_ = 0; j_ < 4; ++j_) { _Pragma("unroll") for (int q_ = 0; q_ < 4; ++q_) d_[q_] = __builtin_amdgcn_sdot4((int)R_[4 * gg_ + q_][j_], (int)x_[j_], d_[q_], false); } \
            _Pragma("unroll") for (int q_ = 0; q_ < 4; ++q_) d_[q_] += DPPI_(d_[q_], 0xB1); \
            _Pragma("unroll") for (int q_ = 0; q_ < 4; ++q_) d_[q_] += DPPI_(d_[q_], 0x4E); \
            _Pragma("unroll") for (int q_ = 0; q_ < 4; ++q_) d_[q_] += DPPI_(d_[q_], 0x141);          \
            _Pragma("unroll") for (int q_ = 0; q_ < 4; ++q_) { if (c == ((4 * gg_ + q_) >> 1)) { if (q_ & 1) ir1_ = d_[q_]; else ir0_ = d_[q_]; } }          \
            __builtin_amdgcn_sched_barrier(0); } \
        if ((t_) < T) *(GAS unsigned*)(PU + (size_t)(t_) * 256 + (unsigned)(4 * lane)) = pk2((float)ir0_ * s_, (float)ir1_ * s_); } while (0)
        const int n0 = X.rank * 8 + wave;
        A_INFO(evA, n0); A_INFO(evB, n0 + tstride);
        __builtin_amdgcn_sched_barrier(0);
        A_ISSUE(RA, xa, sa, evA, n0);
        __builtin_amdgcn_sched_barrier(0);
#pragma unroll 1
        for (int n = n0; n < T; n += 2 * tstride) {
            A_INFO(evA, n + 2 * tstride);
            __builtin_amdgcn_sched_barrier(0);
            A_ISSUE(RB, xb, sb, evB, n + tstride);
            __builtin_amdgcn_sched_barrier(0);
            A_DOTS(RA, xa, sa, n);
            __builtin_amdgcn_sched_barrier(0);
            A_INFO(evB, n + 3 * tstride);
            __builtin_amdgcn_sched_barrier(0);
            A_ISSUE(RA, xa, sa, evA, n + 2 * tstride);
            __builtin_amdgcn_sched_barrier(0);
            A_DOTS(RB, xb, sb, n + tstride);
            __builtin_amdgcn_sched_barrier(0);
        }
#undef A_TOK
#undef A_INFO
#undef A_ISSUE
#undef A_DOTS
    }
}
__device__ __forceinline__ void phase_ua2(const DArgs& a, int vcu, int G) {
    const int tid = tid_();
    GAS unsigned char* ws = a.ws;
    const GAS float* USC = (const GAS float*)(ws + WS_USC); const GAS float* VSC = (const GAS float*)(ws + WS_VSC);
    const GAS unsigned char* PU = ws + WS_PARTU;
    const size_t N4 = (size_t)T * 128 / 4, stride = (size_t)G * NTHR;
    for (size_t i = (size_t)vcu * NTHR + tid; i < N4; i += 2 * stride) {
        const size_t i1 = (i + stride < N4) ? i + stride : i;
        u32x2 pv0[8], pv1[8];
#pragma unroll
        for (int sl = 0; sl < 8; ++sl) { pv0[sl] = ((const GAS u32x2*)(PU + (size_t)sl * T * 256))[i]; pv1[sl] = ((const GAS u32x2*)(PU + (size_t)sl * T * 256))[i1]; }
        const f32x4 gt0 = ((const GAS f32x4*)(ws + WS_GATE))[i], gt1 = ((const GAS f32x4*)(ws + WS_GATE))[i1];
        const u32x2 ep0 = ((const GAS u32x2*)(ws + WS_EIDX))[i], ep1 = ((const GAS u32x2*)(ws + WS_EIDX))[i1];
        const unsigned e0[4] = {ep0.x & 0xffffu, ep0.x >> 16, ep0.y & 0xffffu, ep0.y >> 16}, e1[4] = {ep1.x & 0xffffu, ep1.x >> 16, ep1.y & 0xffffu, ep1.y >> 16};
        float us0[4], vs0[4], us1[4], vs1[4];
#pragma unroll
        for (int e = 0; e < 4; ++e) { us0[e] = USC[e0[e]]; vs0[e] = VSC[e0[e]]; us1[e] = USC[e1[e]]; vs1[e] = VSC[e1[e]]; }
        f32x4 d0 = (f32x4){0.f, 0.f, 0.f, 0.f}, d1 = d0;
#pragma unroll
        for (int sl = 0; sl < 8; ++sl) { d0[0] += bf_lo(pv0[sl].x); d0[1] += bf_hi(pv0[sl].x); d0[2] += bf_lo(pv0[sl].y); d0[3] += bf_hi(pv0[sl].y);
                                         d1[0] += bf_lo(pv1[sl].x); d1[1] += bf_hi(pv1[sl].x); d1[2] += bf_lo(pv1[sl].y); d1[3] += bf_hi(pv1[sl].y); }
        f32x4 w0, w1;
#pragma unroll
        for (int e = 0; e < 4; ++e) { w0[e] = gelu_erf(d0[e] * us0[e]) * gt0[e] * vs0[e]; w1[e] = gelu_erf(d1[e] * us1[e]) * gt1[e] * vs1[e]; }
        u32x2 wo; wo.x = pk2(w0[0], w0[1]); wo.y = pk2(w0[2], w0[3]); ((GAS u32x2*)(ws + WS_PW))[i] = wo;
        if (i + stride < N4) { wo.x = pk2(w1[0], w1[1]); wo.y = pk2(w1[2], w1[3]); ((GAS u32x2*)(ws + WS_PW))[i1] = wo; }
    }
}
__device__ __forceinline__ void phase_vb(const DArgs& a, LAS unsigned char* lds) {
    const int tid = tid_(), lane = tid & 63, wave = __builtin_amdgcn_readfirstlane(tid >> 6), k = lane >> 3, c = lane & 7;
    GAS unsigned char* ws = a.ws;
    const XcdSlice X = xcd_slice_setup(a, lds);
    const int tstride = X.nloc * 8;
    const bool bit3 = (lane & 8) != 0;
    for (int sl = X.q; sl < 8; sl += X.nx) {
        const GAS unsigned char* VBs = ws + WS_VB + (size_t)sl * 2097152;
        const unsigned coff = (unsigned)c * 16u;
        const unsigned xoff = (unsigned)(sl * 128 + c * 16 + 2 * k) * 4u;
        u32x4 evA[2], evB[2], RA[16], RB[16], wa[2], wb[2]; unsigned xa, xb;
#define B_TOK(t_) ((t_) < T ? (t_) : T - 1)
#define B_INFO(ev_, t_) do { const int tq_ = B_TOK(t_); _Pragma("unroll") for (int j_ = 0; j_ < 2; ++j_) ev_[j_] = *(const GAS u32x4*)(ws + WS_EIDX + (size_t)tq_ * 256 + (unsigned)(32 * k + 16 * j_)); } while (0)
#define B_ISSUE(R_, w_, x_, ev_, t_) do { const int tq_ = B_TOK(t_); _Pragma("unroll") for (int g_ = 0; g_ < 16; ++g_) R_[g_] = *(const GAS u32x4*)(VBs + (EV_OFF(ev_, g_) | coff)); \
        _Pragma("unroll") for (int j_ = 0; j_ < 2; ++j_) w_[j_] = *(const GAS u32x4*)(ws + WS_PW + (size_t)tq_ * 256 + (unsigned)(32 * k + 16 * j_)); \
        x_ = *(const GAS unsigned*)((const GAS unsigned char*)a.out + (size_t)tq_ * (D * 2) + (xoff >> 1)); } while (0)
#define B_DOTS(R_, w_, x_, t_) do { \
        f32x2 acc2_[8]; _Pragma("unroll") for (int e_ = 0; e_ < 8; ++e_) acc2_[e_] = (f32x2){0.f, 0.f}; \
        _Pragma("unroll") for (int g_ = 0; g_ < 16; ++g_) { const unsigned ww_ = w_[g_ >> 3][(g_ >> 1) & 3]; const float wk_ = (g_ & 1) ? bf_hi(ww_) : bf_lo(ww_); const f32x2 wp_ = (f32x2){wk_, wk_}; \
            _Pragma("unroll") for (int jj_ = 0; jj_ < 4; ++jj_) { acc2_[2 * jj_] += wp_ * FP8LO(R_[g_][jj_]); acc2_[2 * jj_ + 1] += wp_ * FP8HI(R_[g_][jj_]); } \
            if (g_ & 1) __builtin_amdgcn_sched_barrier(0); } \
        f32x2 w2_[4], x2_[2], y_; \
        _Pragma("unroll") for (int i_ = 0; i_ < 4; ++i_) { w2_[i_][0] = rs32_(acc2_[i_][0], acc2_[i_ + 4][0]); w2_[i_][1] = rs32_(acc2_[i_][1], acc2_[i_ + 4][1]); } \
        _Pragma("unroll") for (int i_ = 0; i_ < 2; ++i_) { x2_[i_][0] = rs16_(w2_[i_][0], w2_[i_ + 2][0]); x2_[i_][1] = rs16_(w2_[i_][1], w2_[i_ + 2][1]); } \
        y_[0] = rs8_(x2_[0][0], x2_[1][0], bit3) + bf_lo(x_); y_[1] = rs8_(x2_[0][1], x2_[1][1], bit3) + bf_hi(x_); \
        const float ss_ = wave_sum(y_[0] * y_[0] + y_[1] * y_[1], lane); \
        if ((t_) < T) { *(GAS unsigned*)(ws + WS_PARTU + (size_t)(t_) * (D * 2) + (xoff >> 1)) = pk2(y_[0], y_[1]);       \
            if (lane == 0) ((GAS float*)(ws + WS_SS))[(size_t)(t_) * 8 + sl] = ss_; } } while (0)
        const int n0 = X.rank * 8 + wave;
        B_INFO(evA, n0); B_INFO(evB, n0 + tstride);
        __builtin_amdgcn_sched_barrier(0);
        B_ISSUE(RA, wa, xa, evA, n0);
        __builtin_amdgcn_sched_barrier(0);
#pragma unroll 1
        for (int n = n0; n < T; n += 2 * tstride) {
            B_INFO(evA, n + 2 * tstride);
            __builtin_amdgcn_sched_barrier(0);
            B_ISSUE(RB, wb, xb, evB, n + tstride);
            __builtin_amdgcn_sched_barrier(0);
            B_DOTS(RA, wa, xa, n);
            __builtin_amdgcn_sched_barrier(0);
            B_INFO(evB, n + 3 * tstride);
            __builtin_amdgcn_sched_barrier(0);
            B_ISSUE(RA, wa, xa, evA, n + 2 * tstride);
            __builtin_amdgcn_sched_barrier(0);
            B_DOTS(RB, wb, xb, n + tstride);
            __builtin_amdgcn_sched_barrier(0);
        }
#undef B_TOK
#undef B_INFO
#undef B_ISSUE
#undef B_DOTS
    }
}
__device__ __forceinline__ void phase_vc(const DArgs& a, int vcu, int G) {
    const int tid = tid_(), lane = tid & 63, wave = tid >> 6;
    const int gw = vcu * NWAVES + wave, NGW = G * NWAVES;
    GAS unsigned char* ws = a.ws;
    f32x4 gf[4];
#pragma unroll
    for (int j = 0; j < 4; ++j) gf[j] = ((const GAS f32x4*)a.final_g)[64 * j + lane];
    for (int m = gw; m < T; m += NGW) {
        const f32x4 s0 = *(const GAS f32x4*)((const GAS float*)(ws + WS_SS) + (size_t)m * 8), s1 = *(const GAS f32x4*)((const GAS float*)(ws + WS_SS) + (size_t)m * 8 + 4);
        const float rstd = rsqrtf(((s0[0] + s0[1]) + (s0[2] + s0[3]) + (s1[0] + s1[1]) + (s1[2] + s1[3])) * (1.f / D) + EPS);
        const GAS u32x2* xi = (const GAS u32x2*)(ws + WS_PARTU + (size_t)m * (D * 2)) + lane;
        GAS f32x4* o = (GAS f32x4*)(a.out + (size_t)m * D) + lane;
#pragma unroll
        for (int j = 0; j < 4; ++j) { const u32x2 xv = xi[64 * j]; f32x4 v; v[0] = bf_lo(xv.x); v[1] = bf_hi(xv.x); v[2] = bf_lo(xv.y); v[3] = bf_hi(xv.y); o[64 * j] = v * rstd * gf[j]; }
    }
}

__device__ __forceinline__ void phase_final_plain(const DArgs& a, const float* src, int vcu, int G) {
    const int tid = tid_(), lane = tid & 63, wave = tid >> 6;
    const int gw = vcu * NWAVES + wave, NGW = G * NWAVES;
    f32x4 gf[4];
#pragma unroll
    for (int j = 0; j < 4; ++j) gf[j] = ((const f32x4*)a.final_g)[64 * j + lane];
    for (int m = gw; m < T; m += NGW) {
        const f32x4* xr = (const f32x4*)(src + (size_t)m * D) + lane;
        f32x4 v[4]; float s = 0.f;
#pragma unroll
        for (int j = 0; j < 4; ++j) { v[j] = xr[64 * j]; s += (v[j][0] * v[j][0] + v[j][1] * v[j][1]) + (v[j][2] * v[j][2] + v[j][3] * v[j][3]); }
        const float rstd = rsqrtf(wave_sum(s, lane) * (1.f / D) + EPS);
        f32x4* o = (f32x4*)(a.out + (size_t)m * D) + lane;
#pragma unroll
        for (int j = 0; j < 4; ++j) o[64 * j] = v[j] * rstd * gf[j];
    }
}


__device__ __forceinline__ DArgs load_args() {
    DArgs r;
#if defined(__HIP_DEVICE_COMPILE__)
    typedef const DArgs __attribute__((address_space(4))) KArgs;
    KArgs* p = (KArgs*)__builtin_amdgcn_kernarg_segment_ptr();
    asm volatile("" : "+s"(p));
    r.x = p->x; r.norm1_g = p->norm1_g; r.w_in = p->w_in; r.b_in = p->b_in; r.conv_w = p->conv_w; r.conv_b = p->conv_b; r.m_head_g = p->m_head_g; r.lb_table = p->lb_table;
    r.g_head_g = p->g_head_g; r.w_br_m = p->w_br_m; r.w_br_g = p->w_br_g; r.w_out = p->w_out; r.norm2_g = p->norm2_g; r.w_pq = p->w_pq; r.sub_keys = p->sub_keys;
    r.u_emb = p->u_emb; r.v_emb = p->v_emb; r.final_g = p->final_g; r.out = p->out; r.ws = p->ws;
#else
    r = DArgs{};
#endif
    return r;
}
__device__ __forceinline__ EpiPtrs make_ep(const DArgs& a, int round) {
    EpiPtrs ep; ep.biasp = (const GAS float*)(a.ws + WS_BIASP); ep.lb = (const GAS float*)(a.ws + WS_LB); ep.x = a.x; ep.out = a.out; ep.ws = a.ws; ep.round = round; ep.pn0 = 0; ep.sa = (const GAS float*)(a.ws + WS_SA8); ep.sb = (const GAS float*)(a.ws + WS_SB8); ep.sym = (const GAS float*)(a.ws + WS_SYM); ep.syg = (const GAS float*)(a.ws + WS_SYG); ep.sxq = (const GAS float*)(a.ws + WS_XQS); return ep;
}
#define GRID_SYNC() do { const DArgs a_ = load_args(); xcd_barrier((unsigned*)(a_.ws + WS_CTL) + CW_BAR, (volatile LAS unsigned*)(lds + LDS_BARST)); } while (0)

__device__ __forceinline__ int bx_() { int t = blockIdx.x; asm volatile("" : "+s"(t)); return t; }
__device__ __forceinline__ int gd_() { int t = gridDim.x; asm volatile("" : "+s"(t)); return t; }
#define PH_BEGIN const DArgs a = load_args(); const int bx = bx_(), G = gd_(); const int vcu = (G % 8 == 0) ? (bx % 8) * (G / 8) + bx / 8 : bx; (void)vcu; (void)bx;

__global__ void __launch_bounds__(NTHR, 2) fwd_megakernel(Args a_unused) {
    extern __shared__ __attribute__((aligned(16))) unsigned char lds_raw[];
    LAS unsigned char* lds = (LAS unsigned char*)lds_raw;
    cg::grid_group grid = cg::this_grid();

    { const int t_ = tid_(); if (t_ < 16) ((LAS unsigned*)(lds + LDS_BARST))[t_] = 0u; __syncthreads();
      const DArgs a_ = load_args(); xcd_barrier_post((unsigned*)(a_.ws + WS_CTL) + CW_BAR, (volatile LAS unsigned*)(lds + LDS_BARST)); }
    { PH_BEGIN phase_p0(a, lds, vcu, G); }
    grid.sync();
    { PH_BEGIN phase_p0c(a, lds, vcu, G); }
    GRID_SYNC();
#pragma unroll 1
    for (int round = 0; round < NROUND; ++round) {
        {
            PH_BEGIN
            pg8::Gemm g{(const bf16_t*)(a.ws + WS_XN8 + (size_t)round * RT * 1024), (const bf16_t*)(a.ws + WS_W8A), RT, N1, D / 2};
            pg8::StaticOrder S; S.init(RT, N1, G, bx);
            EpiX<7> E{make_ep(a, round)};
            pg8::gemm_phase<EpiX<7>, pg8::StaticOrder, true, true, true>(lds, g, S, E);
        }
        { PH_BEGIN if (bx < 8) mscan_pair(a, lds, round, bx); }
        GRID_SYNC();
        { PH_BEGIN for (int it = bx; it < 512; it += G) mlstm_pre_item(a, lds, round, it); }
        { PH_BEGIN u32x4 gq[4]; int it = bx; if (it < 2048) hgrn_pre_load(a, round, it, gq);
          for (; it < 2048; it += G) hgrn_pre_item(a, lds, round, it, gq, it + G); }
        GRID_SYNC();
        { PH_BEGIN
          if (bx < 128) mlstm_scan<2, false>(a, lds, round, bx & 7, bx >> 3);
          else if (bx >= 192 && bx < 200) mlstm_scan<1, true>(a, lds, round, bx - 192, 0);
          else if (bx < 192) { const int id2 = bx - 128; hgrn_scan(a, lds, round, (id2 & 7) * 2 + ((id2 >> 3) & 1), id2 >> 4); }
          else if (G >= 232) {
              pg8::Gemm g{(const bf16_t*)(a.ws + WS_XN8 + (size_t)round * RT * 1024), (const bf16_t*)(a.ws + WS_W8 + (size_t)2048 * 1024), RT, 1024, D / 2};
              pg8::StaticOrder S; S.init(RT, 1024, G - 200, bx - 200);
              EpiPtrs ep = make_ep(a, round); ep.pn0 = 8; EpiX<2> E{ep};
              pg8::gemm_phase<EpiX<2>, pg8::StaticOrder, true, true, true>(lds, g, S, E); } }
        GRID_SYNC();
#define G2_PART(pn0_, ncol_) { PH_BEGIN \
            pg8::Gemm g{(const bf16_t*)(a.ws + WS_XN8 + (size_t)round * RT * 1024), (const bf16_t*)(a.ws + WS_W8 + (size_t)(pn0_) * 256 * 1024), RT, (ncol_), D / 2};       \
            pg8::StaticOrder S; S.init(RT, (ncol_), G, bx); \
            EpiPtrs ep = make_ep(a, round); ep.pn0 = (pn0_); EpiX<2> E{ep}; \
            pg8::gemm_phase<EpiX<2>, pg8::StaticOrder, true, true, true>(lds, g, S, E); }
        G2_PART(0, 2048)
        G2_PART(12, 2048)
        if (gd_() < 232) G2_PART(8, 1024)
#undef G2_PART
        GRID_SYNC();
        { PH_BEGIN phase_ypass(a, round, vcu, G); }
        GRID_SYNC();
        {
            { PH_BEGIN pg8::StaticOrder S; S.init(RT, D, G, bx);
              pg8::Gemm g{(const bf16_t*)(a.ws + WS_V), (const bf16_t*)(a.ws + WS_WM), RT, D, 2048 / 2}; EpiX<3> E{make_ep(a, round)}; pg8::gemm_phase<EpiX<3>, pg8::StaticOrder, true, true, true>(lds, g, S, E); }
            { PH_BEGIN pg8::StaticOrder S; S.init(RT, D, G, bx);
              pg8::Gemm g{(const bf16_t*)(a.ws + WS_GI), (const bf16_t*)(a.ws + WS_WG), RT, D, D / 2}; EpiX<4> E{make_ep(a, round)}; pg8::gemm_phase<EpiX<4>, pg8::StaticOrder, true, true, true>(lds, g, S, E); }
        }
        GRID_SYNC();
        {
            PH_BEGIN pg8::StaticOrder S; S.init(RT, D, G, bx);
            pg8::Gemm g{(const bf16_t*)(a.ws + WS_GFLOG), (const bf16_t*)(a.ws + WS_WO), RT, D, D}; EpiX<5> E{make_ep(a, round)}; pg8::gemm_phase<EpiX<5>, pg8::StaticOrder, true, true>(lds, g, S, E);
        }
        GRID_SYNC();
    }
    { PH_BEGIN phase_p8(a, vcu, G); }
    GRID_SYNC();
    {
        PH_BEGIN pg8::StaticOrder S; S.init(T, 2048, G, bx);
        pg8::Gemm g{(const bf16_t*)(a.ws + WS_XQ), (const bf16_t*)(a.ws + WS_WPQ), T, 2048, D / 2}; EpiX<6> E{make_ep(a, 0)}; pg8::gemm_phase<EpiX<6>, pg8::StaticOrder, true, true, true>(lds, g, S, E);
    }
    GRID_SYNC();
#ifdef TOPK_REF
    { PH_BEGIN phase_topk_ref(a, vcu, G); }
#else
    { PH_BEGIN phase_topk(a, lds, bx, G); }
#endif
    GRID_SYNC();
    { PH_BEGIN phase_ua(a, lds); }
    GRID_SYNC();
    { PH_BEGIN phase_ua2(a, vcu, G); }
    GRID_SYNC();
    { PH_BEGIN phase_vb(a, lds); }
    GRID_SYNC();
    { PH_BEGIN phase_vc(a, vcu, G); }
}

extern "C" void kernel_launch(void* const* d_in, const int* in_sizes, int n_in, void* d_out, int out_size, void* d_ws, size_t ws_size, hipStream_t stream) {
    static int grid = 0;
    if (grid == 0) {
        if (n_in != 18 || in_sizes[0] != T * D || out_size != T * D || ws_size < WS_END) {
            fprintf(stderr, "kernel_launch: unexpected shapes/workspace (n_in %d, in0 %d, out %d, ws %zu, need %zu)\n", n_in, n_in > 0 ? in_sizes[0] : -1, out_size, ws_size, (size_t)WS_END);
            grid = -1; return; }
        int dev = 0, cus = 0, per_cu = 0;
        hipGetDevice(&dev);
        hipDeviceGetAttribute(&cus, hipDeviceAttributeMultiprocessorCount, dev);
        hipFuncSetAttribute((const void*)fwd_megakernel, hipFuncAttributeMaxDynamicSharedMemorySize, LDS_BYTES);
        hipOccupancyMaxActiveBlocksPerMultiprocessor(&per_cu, (const void*)fwd_megakernel, NTHR, LDS_BYTES);
        if (per_cu < 1) { fprintf(stderr, "kernel_launch: occupancy query says %d blocks/CU\n", per_cu); per_cu = 1; }
        grid = cus;
        (void)hipGetLastError();
    }
    if (grid < 0) return;
    hipMemsetAsync((char*)d_ws + WS_CTL, 0, 131072, stream);
    Args a{};
    a.x = (const float*)d_in[0]; a.norm1_g = (const float*)d_in[1]; a.w_in = (const float*)d_in[2]; a.b_in = (const float*)d_in[3];
    a.conv_w = (const float*)d_in[4]; a.conv_b = (const float*)d_in[5]; a.m_head_g = (const float*)d_in[6]; a.lb_table = (const float*)d_in[7];
    a.g_head_g = (const float*)d_in[8]; a.w_br_m = (const float*)d_in[9]; a.w_br_g = (const float*)d_in[10]; a.w_out = (const float*)d_in[11];
    a.norm2_g = (const float*)d_in[12]; a.w_pq = (const float*)d_in[13]; a.sub_keys = (const float*)d_in[14]; a.u_emb = (const float*)d_in[15];
    a.v_emb = (const float*)d_in[16]; a.final_g = (const float*)d_in[17];
    a.out = (float*)d_out; a.ws = (unsigned char*)d_ws;
    void* args[] = {&a};
    hipError_t e = hipLaunchCooperativeKernel((const void*)fwd_megakernel, dim3(grid), dim3(NTHR), args, LDS_BYTES, stream);
    if (e != hipSuccess) fprintf(stderr, "cooperative launch failed: %s (grid %d)\n", hipGetErrorString(e), grid);
}
```

```cpp
#include <hip/hip_runtime.h>
#include <hip/hip_cooperative_groups.h>
#include <cstdio>
#include <cstdint>
namespace cg = cooperative_groups;

#define LAS __attribute__((address_space(3)))
typedef unsigned short bf16_t;
typedef short bf16x8 __attribute__((ext_vector_type(8)));
typedef float f32x4 __attribute__((ext_vector_type(4)));
typedef float f32x2 __attribute__((ext_vector_type(2)));
typedef unsigned u32x4 __attribute__((ext_vector_type(4)));
typedef unsigned u32x2 __attribute__((ext_vector_type(2)));

constexpr int D = 1024, BATCH = 4, SEQ = 8192, T = BATCH * SEQ;
constexpr int IN_COLS = 12296, NP = 12288;
constexpr int RT = 16384, NROUND = 2;
constexpr int N1 = 7168, N2 = 5120;
constexpr float EPS = 1e-6f;
constexpr int NWAVES = 8, NTHR = 512;

constexpr size_t MiB = 1u << 20;
constexpr size_t WS_CTL = 0;
constexpr size_t WS_WIN = 1 * MiB;
constexpr size_t WS_WM = 25 * MiB;
constexpr size_t WS_WG = 29 * MiB;
constexpr size_t WS_WO = 31 * MiB;
constexpr size_t WS_WPQ = 33 * MiB;
constexpr size_t WS_SK = 37 * MiB;
constexpr size_t WS_BIASP = 37 * MiB + 512 * 1024;
constexpr size_t WS_LB = WS_BIASP + 64 * 1024;
constexpr size_t WS_GATES = 38 * MiB;
constexpr size_t WS_MPREV = 39 * MiB;
constexpr size_t WS_DEN = 40 * MiB;
constexpr size_t WS_MT = 40 * MiB + 512 * 1024;
constexpr size_t WS_HGDEC = 41 * MiB;
constexpr size_t WS_MDEC = 43 * MiB;
constexpr size_t WS_XN = 44 * MiB;
constexpr size_t WS_QKPRE = 108 * MiB;
constexpr size_t WS_V = 172 * MiB;
constexpr size_t WS_GFLOG = 236 * MiB;
constexpr size_t WS_GI = 268 * MiB;
constexpr size_t WS_GQ = 300 * MiB;
constexpr size_t WS_S = 332 * MiB;
constexpr size_t WS_QT = 348 * MiB;
constexpr size_t WS_KWT = 380 * MiB;
constexpr size_t WS_ATT = 412 * MiB;
constexpr size_t WS_QTG = 428 * MiB;
constexpr size_t WS_KENDT = 460 * MiB;
constexpr size_t WS_SIGO = 332 * MiB;
constexpr size_t WS_SGG = 76 * MiB;
constexpr size_t WS_SAM = 428 * MiB;
constexpr size_t WS_SAG = 460 * MiB;
constexpr size_t WS_XN8 = 44 * MiB;
constexpr size_t WS_SA8 = 508 * MiB;
constexpr size_t WS_SB8 = 508 * MiB + 262144;
constexpr size_t WS_W8A = WS_WIN;
constexpr size_t WS_W8 = WS_WIN + (size_t)7168 * 1024;
constexpr int NI8 = 12288 + 1024 + 1024 + 2048;
constexpr size_t WS_SYM = 508 * MiB + 524288;
constexpr size_t WS_SYG = 508 * MiB + 655360;
constexpr int CW_COLMAX = 16384;
constexpr size_t WS_END = 510 * MiB;
constexpr size_t WS_QP = 108 * MiB;
constexpr size_t WS_UB = 236 * MiB;
constexpr size_t WS_VB = 252 * MiB;
constexpr size_t WS_USC = 268 * MiB;
constexpr size_t WS_VSC = 268 * MiB + 65536;
constexpr size_t WS_EIDX = 300 * MiB;
constexpr size_t WS_GATE = 316 * MiB;
constexpr size_t WS_XQ = 380 * MiB;
constexpr size_t WS_XQS = 412 * MiB;
constexpr size_t WS_PARTU = 108 * MiB;
constexpr size_t WS_SS = 348 * MiB;
constexpr size_t WS_PW = 332 * MiB;

constexpr int CW_TMAX = 64;
constexpr int LDS_BYTES = 147456;

__device__ __forceinline__ unsigned f2bf(float f) { unsigned u = __builtin_bit_cast(unsigned, f); return (u + 0x7fffu + ((u >> 16) & 1u)) >> 16; }
typedef __bf16 bf16x2_t __attribute__((ext_vector_type(2)));
__device__ __forceinline__ unsigned pk2(float lo, float hi) { bf16x2_t v; v[0] = (__bf16)lo; v[1] = (__bf16)hi; return __builtin_bit_cast(unsigned, v); }
__device__ __forceinline__ float bf_lo(unsigned w) { return __builtin_bit_cast(float, w << 16); }
__device__ __forceinline__ float bf_hi(unsigned w) { return __builtin_bit_cast(float, w & 0xffff0000u); }
__device__ __forceinline__ float bf2f(bf16_t h) { return __builtin_bit_cast(float, ((unsigned)h) << 16); }
__device__ __forceinline__ float shx(float v, int o, int lane) { return __builtin_bit_cast(float, __builtin_amdgcn_ds_bpermute((lane ^ o) << 2, __builtin_bit_cast(int, v))); }
__device__ __forceinline__ float shup(float v, int o, int lane) { return __builtin_bit_cast(float, __builtin_amdgcn_ds_bpermute(((lane - o) & 63) << 2, __builtin_bit_cast(int, v))); }
__device__ __forceinline__ float rdlane(float v, int l) { return __builtin_bit_cast(float, __builtin_amdgcn_readlane(__builtin_bit_cast(int, v), l)); }
#define DPP_(v, ctrl) __builtin_bit_cast(float, __builtin_amdgcn_update_dpp(0, __builtin_bit_cast(int, (v)), (ctrl), 0xF, 0xF, false))
__device__ __forceinline__ float wave_sum(float v, int lane) {
    (void)lane;
    v += DPP_(v, 0xB1); v += DPP_(v, 0x4E); v += DPP_(v, 0x141); v += DPP_(v, 0x140);
    return (rdlane(v, 0) + rdlane(v, 16)) + (rdlane(v, 32) + rdlane(v, 48));
}
__device__ __forceinline__ float wave_max(float v) {
    v = fmaxf(v, DPP_(v, 0xB1)); v = fmaxf(v, DPP_(v, 0x4E)); v = fmaxf(v, DPP_(v, 0x141)); v = fmaxf(v, DPP_(v, 0x140));
    return fmaxf(fmaxf(rdlane(v, 0), rdlane(v, 16)), fmaxf(rdlane(v, 32), rdlane(v, 48)));
}
__device__ __forceinline__ unsigned pack_i8x4(float a, float b, float c, float d) {
    const int ia = (int)__builtin_rintf(a), ib = (int)__builtin_rintf(b), ic = (int)__builtin_rintf(c), id = (int)__builtin_rintf(d);
    return ((unsigned)ia & 255u) | (((unsigned)ib & 255u) << 8) | (((unsigned)ic & 255u) << 16) | ((unsigned)id << 24);
}
#define SWZI_(v, pat) __builtin_amdgcn_ds_swizzle((int)(v), (pat))
#define DPPI_(v, ctrl) __builtin_amdgcn_update_dpp(0, (int)(v), (ctrl), 0xF, 0xF, false)
__device__ __forceinline__ unsigned xor32u_(unsigned v, bool hi) {
#if defined(__HIP_DEVICE_COMPILE__)
    const auto r = __builtin_amdgcn_permlane32_swap(v, v, false, false);
    return hi ? r[0] : r[1];
#else
    (void)hi; return v;
#endif
}
__device__ __forceinline__ float sigmoidf_(float x) { return __builtin_amdgcn_rcpf(1.0f + __expf(-x)); }
__device__ __forceinline__ float siluf_(float x) { return x * __builtin_amdgcn_rcpf(1.0f + __expf(-x)); }
#define LDS_WAIT() asm volatile("s_waitcnt lgkmcnt(0)" ::: "memory")
__device__ __forceinline__ int tid_() { int t = threadIdx.x; asm volatile("" : "+v"(t)); return t; }

#define GAS __attribute__((address_space(1)))
struct DArgs {
    const GAS float* x; const GAS float* norm1_g; const GAS float* w_in; const GAS float* b_in; const GAS float* conv_w; const GAS float* conv_b;
    const GAS float* m_head_g; const GAS float* lb_table; const GAS float* g_head_g; const GAS float* w_br_m; const GAS float* w_br_g; const GAS float* w_out;
    const GAS float* norm2_g; const GAS float* w_pq; const GAS float* sub_keys; const GAS float* u_emb; const GAS float* v_emb; const GAS float* final_g;
    GAS float* out; GAS unsigned char* ws;
};
struct Args {
    const float* x; const float* norm1_g; const float* w_in; const float* b_in; const float* conv_w; const float* conv_b;
    const float* m_head_g; const float* lb_table; const float* g_head_g; const float* w_br_m; const float* w_br_g; const float* w_out;
    const float* norm2_g; const float* w_pq; const float* sub_keys; const float* u_emb; const float* v_emb; const float* final_g;
    float* out; unsigned char* ws;
};

namespace pg8 {
constexpr int BM = 256, BK = 64, HALF = 128, HTB = HALF * BK * 2, STAGE_BYTES = 8 * HTB, NXCD = 8, WGM = 8;
__host__ __device__ __forceinline__ int lds_byte(int r, int c) { const int st = (r >> 4) * 2 + (c >> 5), rr = r & 15, cc = c & 31, ob = rr * 64 + cc * 2; return st * 1024 + (ob ^ (((ob >> 9) & 1) << 5)); }
__host__ __device__ __forceinline__ void stage_rc(int b, int& R, int& C) { const int st = b / 1024, sb = b % 1024, swz = sb ^ (((sb >> 9) & 1) << 5); R = (st >> 1) * 16 + swz / 64; C = (st & 1) * 32 + (swz % 64) / 2; }
__host__ __device__ __forceinline__ int perm32(int rho) { const int n = rho >> 4, i = rho & 15; return 8 * (i >> 2) + 4 * n + (i & 3); }
struct Unit { int pm, pn; };
struct Gemm { const bf16_t* A; const bf16_t* Bt; int M, N, K; };
struct StaticOrder {
    int nM, nN, nwg, G, c;
    __host__ __device__ void init(int M, int N, int G_, int c_) { nM = M / BM; nN = N / BM; nwg = nM * nN; G = G_; c = c_; }
    __host__ __device__ bool next(int i, Unit& u) const {
        const long L = (long)i * G + c; if (L >= nwg) return false;
        int wgid = (int)L; { const int q = nwg / NXCD, r = nwg % NXCD, xcd = wgid % NXCD, off = wgid / NXCD; wgid = (xcd < r ? xcd * (q + 1) : r * (q + 1) + (xcd - r) * q) + off; }
        const int nig = WGM * nN, gid = wgid / nig, fm = gid * WGM, gsz = (nM - fm) < WGM ? (nM - fm) : WGM;
        u.pm = fm + ((wgid % nig) % gsz); u.pn = (wgid % nig) / gsz; return true;
    }
    __device__ __forceinline__ void a_ready(const Unit&) const {}
    __device__ __forceinline__ void done(const Unit&) const {}
};

typedef int i32x8 __attribute__((ext_vector_type(8)));
typedef int i32x4 __attribute__((ext_vector_type(4)));
template <class Epi, class Sched, bool ALIGN_EPI = false, bool SP2 = false, bool I8 = false>
__device__ __forceinline__ void gemm_phase(LAS unsigned char* lds, const Gemm g, const Sched& S, const Epi& E) {
    const int tid = tid_(), wid = __builtin_amdgcn_readfirstlane(tid >> 6), lane = tid & 63, wr = wid >> 2, wc = wid & 3, fr = lane & 15, fq = lane >> 4;
    const int K = g.K, nt = K / BK;
    unsigned voffA[2], voffB[2];
#pragma unroll
    for (int i = 0; i < 2; ++i) { int R, C; stage_rc(tid * 16 + i * 8192, R, C); const int Rb = Epi::PERM ? ((R & ~31) + perm32(R & 31)) : R;
        voffA[i] = (unsigned)(R * K + C) * 2u; voffB[i] = (unsigned)(Rb * K + C) * 2u; }
    const size_t kstep = (size_t)(BK * 2);
    const size_t hstep = (size_t)HALF * K * 2;
    const size_t tstep = 2 * hstep;
    const unsigned ldsw = (unsigned)wid * 1024u;
    const int aoff = lds_byte(wr * 64 + fr, fq * 8), boff = lds_byte(wc * 32 + fr, fq * 8);
#define PG8_SA(b, h) (((b) * 2 + (h)) * HTB)
#define PG8_SB(b, h) ((4 + (b) * 2 + (h)) * HTB)
#define PG8_STAGE(bufoff, gbase, voff) do { _Pragma("unroll") for (int _i = 0; _i < 2; ++_i) \
        __builtin_amdgcn_global_load_lds((const unsigned*)((const char*)(gbase) + (voff)[_i]), (LAS unsigned*)(lds + (bufoff) + ldsw + _i * 8192), 16, 0, 0); } while (0)
#define PG8_LDA(dst, b, h) do { _Pragma("unroll") for (int m = 0; m < 4; ++m) _Pragma("unroll") for (int k = 0; k < 2; ++k) dst[m][k] = *(const LAS bf16x8*)(lds + PG8_SA(b, h) + aoff + m * 2048 + k * 1024); } while (0)
#define PG8_LDB(dst, b, h) do { _Pragma("unroll") for (int n = 0; n < 2; ++n) _Pragma("unroll") for (int k = 0; k < 2; ++k) dst[n][k] = *(const LAS bf16x8*)(lds + PG8_SB(b, h) + boff + n * 2048 + k * 1024); } while (0)
#define PG8_MMA(ai, bj, At, Bt) do { __builtin_amdgcn_s_setprio(1); _Pragma("unroll") for (int m = 0; m < 4; ++m) _Pragma("unroll") for (int n = 0; n < 2; ++n) _Pragma("unroll") for (int k = 0; k < 2; ++k) { \
        if constexpr (I8) acc[ai][bj][m][n] = __builtin_bit_cast(f32x4, __builtin_amdgcn_mfma_i32_16x16x64_i8(__builtin_bit_cast(i32x4, Bt[n][k]), __builtin_bit_cast(i32x4, At[m][k]), __builtin_bit_cast(i32x4, acc[ai][bj][m][n]), 0, 0, 0)); \
        else acc[ai][bj][m][n] = __builtin_amdgcn_mfma_f32_16x16x32_bf16(Bt[n][k], At[m][k], acc[ai][bj][m][n], 0, 0, 0); } __builtin_amdgcn_s_setprio(0); } while (0)
#define PG8_WAIT_V(n) asm volatile("s_waitcnt vmcnt(" #n ")" ::: "memory")
#define PG8_WAIT_L(n) asm volatile("s_waitcnt lgkmcnt(" #n ")" ::: "memory")
#define PG8_BAR __builtin_amdgcn_s_barrier()
#define PG8_SCHED __builtin_amdgcn_sched_barrier(0)
    Unit cur, nxt; int ui = 0;
    if (!S.next(0, cur)) return;
    f32x4 acc[2][2][4][2];
#pragma unroll
    for (int a = 0; a < 2; ++a)
#pragma unroll
        for (int b = 0; b < 2; ++b)
#pragma unroll
            for (int m = 0; m < 4; ++m)
#pragma unroll
                for (int n = 0; n < 2; ++n) acc[a][b][m][n] = (f32x4){0.f, 0.f, 0.f, 0.f};
    bf16x8 At[4][2], B0[2][2], B1[2][2];
    const char* cA = (const char*)g.A + (size_t)cur.pm * tstep; const char* cB = (const char*)g.Bt + (size_t)cur.pn * tstep;
    S.a_ready(cur);
    if constexpr (SP2) {
        PG8_STAGE(PG8_SB(0, 0), cB, voffB); PG8_STAGE(PG8_SB(0, 1), cB + hstep, voffB); PG8_STAGE(PG8_SA(0, 0), cA, voffA); PG8_STAGE(PG8_SA(0, 1), cA + hstep, voffA);
        if (wr == 1) PG8_BAR;
        PG8_WAIT_V(2); PG8_BAR;
        PG8_STAGE(PG8_SB(1, 0), cB + kstep, voffB); PG8_STAGE(PG8_SA(1, 0), cA + kstep, voffA); PG8_STAGE(PG8_SB(1, 1), cB + hstep + kstep, voffB);
        PG8_WAIT_V(6); PG8_BAR;
    } else {
        PG8_STAGE(PG8_SB(0, 0), cB, voffB); PG8_STAGE(PG8_SA(0, 0), cA, voffA); PG8_STAGE(PG8_SB(0, 1), cB + hstep, voffB); PG8_STAGE(PG8_SA(0, 1), cA + hstep, voffA);
        if (wr == 1) PG8_BAR;
        PG8_WAIT_V(4); PG8_BAR;
        PG8_STAGE(PG8_SB(1, 0), cB + kstep, voffB); PG8_STAGE(PG8_SA(1, 0), cA + kstep, voffA); PG8_STAGE(PG8_SB(1, 1), cB + hstep + kstep, voffB);
        PG8_WAIT_V(6); PG8_BAR;
    }
    for (;;) {
        const bool has_next = S.next(ui + 1, nxt);
        const char* nA = has_next ? (const char*)g.A + (size_t)nxt.pm * tstep : cA; const char* nB = has_next ? (const char*)g.Bt + (size_t)nxt.pn * tstep : cB;
#pragma unroll 1
        for (int t = 0; t < nt; t += 2) {
            const bool last = (t == nt - 2);
            const char* a1 = cA + (size_t)(t + 1) * kstep;
            const char* a2 = last ? nA : cA + (size_t)(t + 2) * kstep; const char* b2 = last ? nB : cB + (size_t)(t + 2) * kstep;
            const char* a3 = a2 + kstep; const char* b3 = b2 + kstep;
            if (last && has_next) S.a_ready(nxt);
            if constexpr (SP2) {
            PG8_LDB(B0, 0, 0); PG8_LDB(B1, 0, 1); PG8_SCHED; PG8_LDA(At, 0, 0); PG8_STAGE(PG8_SA(1, 1), a1 + hstep, voffA);
            PG8_WAIT_V(8); PG8_WAIT_L(0); PG8_BAR; PG8_MMA(0, 0, At, B0); PG8_MMA(0, 1, At, B1); PG8_BAR; PG8_SCHED;
            PG8_LDA(At, 0, 1); PG8_STAGE(PG8_SB(0, 0), b2, voffB); PG8_STAGE(PG8_SB(0, 1), b2 + hstep, voffB); PG8_STAGE(PG8_SA(0, 0), a2, voffA);
            PG8_WAIT_V(8); PG8_WAIT_L(0); PG8_BAR; PG8_MMA(1, 0, At, B0); PG8_MMA(1, 1, At, B1); PG8_BAR; PG8_SCHED;
            PG8_LDB(B0, 1, 0); PG8_LDB(B1, 1, 1); PG8_SCHED; PG8_LDA(At, 1, 0); PG8_STAGE(PG8_SA(0, 1), a2 + hstep, voffA);
            PG8_WAIT_V(8); PG8_WAIT_L(0); PG8_BAR; PG8_MMA(0, 0, At, B0); PG8_MMA(0, 1, At, B1); PG8_BAR; PG8_SCHED;
            PG8_LDA(At, 1, 1); PG8_STAGE(PG8_SB(1, 0), b3, voffB); PG8_STAGE(PG8_SB(1, 1), b3 + hstep, voffB); PG8_STAGE(PG8_SA(1, 0), a3, voffA);
            PG8_WAIT_V(8); PG8_WAIT_L(0); PG8_BAR; PG8_MMA(1, 0, At, B0); PG8_MMA(1, 1, At, B1); PG8_BAR; PG8_SCHED;
            } else {
            PG8_LDB(B0, 0, 0); PG8_SCHED; PG8_LDA(At, 0, 0); PG8_STAGE(PG8_SA(1, 1), a1 + hstep, voffA);
            PG8_WAIT_L(8); PG8_BAR; PG8_WAIT_L(0); PG8_MMA(0, 0, At, B0); PG8_BAR; PG8_SCHED;
            PG8_LDB(B1, 0, 1); PG8_STAGE(PG8_SB(0, 0), b2, voffB);
            PG8_BAR; PG8_WAIT_L(0); PG8_MMA(0, 1, At, B1); PG8_BAR;
            PG8_LDA(At, 0, 1); PG8_STAGE(PG8_SA(0, 0), a2, voffA);
            PG8_BAR; PG8_WAIT_L(0); PG8_MMA(1, 0, At, B0); PG8_BAR; PG8_SCHED;
            PG8_STAGE(PG8_SB(0, 1), b2 + hstep, voffB);
            PG8_WAIT_V(6); PG8_BAR; PG8_MMA(1, 1, At, B1); PG8_BAR;
            PG8_LDB(B0, 1, 0); PG8_SCHED; PG8_LDA(At, 1, 0); PG8_STAGE(PG8_SA(0, 1), a2 + hstep, voffA);
            PG8_WAIT_L(8); PG8_BAR; PG8_WAIT_L(0); PG8_MMA(0, 0, At, B0); PG8_BAR; PG8_SCHED;
            PG8_LDB(B1, 1, 1); PG8_STAGE(PG8_SB(1, 0), b3, voffB);
            PG8_BAR; PG8_WAIT_L(0); PG8_MMA(0, 1, At, B1); PG8_BAR;
            PG8_LDA(At, 1, 1); PG8_STAGE(PG8_SA(1, 0), a3, voffA);
            PG8_BAR; PG8_WAIT_L(0); PG8_MMA(1, 0, At, B0); PG8_BAR; PG8_SCHED;
            PG8_STAGE(PG8_SB(1, 1), b3 + hstep, voffB);
            PG8_WAIT_V(6); PG8_BAR; PG8_MMA(1, 1, At, B1); PG8_BAR;
            }
        }
        if constexpr (ALIGN_EPI) { if (wr == 0) PG8_BAR; }
        E(acc, cur, wr, wc, fr, fq);
        if (!has_next) break;
#pragma unroll
        for (int a = 0; a < 2; ++a)
#pragma unroll
            for (int b = 0; b < 2; ++b)
#pragma unroll
                for (int m = 0; m < 4; ++m)
#pragma unroll
                    for (int n = 0; n < 2; ++n) acc[a][b][m][n] = (f32x4){0.f, 0.f, 0.f, 0.f};
        cur = nxt; cA = nA; cB = nB; ++ui;
        if constexpr (ALIGN_EPI) { if (wr == 1) PG8_BAR; }
    }
    PG8_WAIT_V(0);
    if constexpr (!ALIGN_EPI) { if (wr == 0) PG8_BAR; }
    PG8_BAR;
#undef PG8_SA
#undef PG8_SB
#undef PG8_STAGE
#undef PG8_LDA
#undef PG8_LDB
#undef PG8_MMA
#undef PG8_WAIT_V
#undef PG8_WAIT_L
#undef PG8_BAR
#undef PG8_SCHED
}
}

typedef int i32x4q __attribute__((ext_vector_type(4)));
struct EpiPtrs {
    const GAS float* biasp; const GAS float* lb; const GAS float* x; GAS float* out; GAS unsigned char* ws; int round;
    int pn0;
    const GAS float* sa; const GAS float* sb; const GAS float* sym; const GAS float* syg; const GAS float* sxq;
};
template <int MODE> struct EpiX {
    static constexpr bool PERM = true, AFTER_DRAIN = false;
    EpiPtrs P;
    __device__ __forceinline__ void operator()(const f32x4 (&acc)[2][2][4][2], const pg8::Unit& u, int wr, int wc, int fr, int fq) const {
        const int upn = u.pn + (MODE == 2 ? P.pn0 : 0);
        const int row0 = u.pm * 256 + wr * 64 + fr;
        const int colt = upn * 256 + wc * 32 + 8 * fq;
        GAS unsigned char* ws = P.ws;
        bf16_t* dst = nullptr; int ld = 0, coff = 0, act = 0; const GAS float* bias = nullptr;
        if (MODE == 1 || MODE == 7) {
            bias = P.biasp;
            if (upn < 8) { dst = (bf16_t*)(ws + WS_QKPRE); ld = 2048; coff = 0; act = 0; }
            else if (upn < 16) { dst = (bf16_t*)(ws + WS_V); ld = 2048; coff = 2048; act = 0; }
            else if (upn < 20) { dst = (bf16_t*)(ws + WS_GFLOG); ld = 1024; coff = 4096; act = 3; }
            else if (upn < 24) { dst = (bf16_t*)(ws + WS_GI); ld = 1024; coff = 5120; act = 0; }
            else { dst = (bf16_t*)(ws + WS_GQ); ld = 1024; coff = 6144; act = 2; }
        } else if (MODE == 2) {
            bias = P.biasp + N1;
            if (upn < 8) { dst = (bf16_t*)(ws + WS_SIGO); ld = 2048; coff = 0; act = 1; }
            else if (upn < 12) { dst = (bf16_t*)(ws + WS_SGG); ld = 1024; coff = 2048; act = 2; }
            else if (upn < 16) { dst = (bf16_t*)(ws + WS_SAM); ld = 1024; coff = 3072; act = 1; }
            else { dst = (bf16_t*)(ws + WS_SAG); ld = 1024; coff = 4096; act = 1; }
        } else if (MODE == 6) { dst = (bf16_t*)(ws + WS_QP); ld = 2048; coff = 0; act = 0; }
        float sr8[2][4];
#pragma unroll
        for (int ai = 0; ai < 2; ++ai)
#pragma unroll
            for (int m = 0; m < 4; ++m) { const int row = row0 + ai * 128 + m * 16;
                sr8[ai][m] = (MODE == 3) ? P.sym[row] : (MODE == 4) ? P.syg[row] : (MODE == 6) ? P.sxq[row] : (MODE == 2 || MODE == 7) ? P.sa[(size_t)P.round * RT + row] : 1.0f; }
#pragma unroll
        for (int bj = 0; bj < 2; ++bj) {
            const int col = colt + bj * 128;
            f32x4 b0 = (f32x4){0.f, 0.f, 0.f, 0.f}, b1 = b0, l0 = b0, l1 = b0;
            if (MODE == 1 || MODE == 2 || MODE == 7) { b0 = *(const f32x4*)(bias + col); b1 = *(const f32x4*)(bias + col + 4); }
            f32x4 s0 = (f32x4){1.f, 1.f, 1.f, 1.f}, s1 = s0;
            if (MODE == 2) { s0 = *(const GAS f32x4*)(P.sb + 7168 + col); s1 = *(const GAS f32x4*)(P.sb + 7168 + col + 4); }
            if (MODE == 7) { s0 = *(const GAS f32x4*)(P.sb + col); s1 = *(const GAS f32x4*)(P.sb + col + 4); }
            if (MODE == 3) { s0 = *(const GAS f32x4*)(P.sb + 12288 + col); s1 = *(const GAS f32x4*)(P.sb + 12288 + col + 4); }
            if (MODE == 4) { s0 = *(const GAS f32x4*)(P.sb + 13312 + col); s1 = *(const GAS f32x4*)(P.sb + 13312 + col + 4); }
            if (MODE == 6) { s0 = *(const GAS f32x4*)(P.sb + 14336 + col); s1 = *(const GAS f32x4*)(P.sb + 14336 + col + 4); }
            if (MODE == 1 || MODE == 7) { if (act == 3) { l0 = *(const f32x4*)(P.lb + (col - coff)); l1 = *(const f32x4*)(P.lb + (col - coff) + 4); } }
#pragma unroll
            for (int ai = 0; ai < 2; ++ai) {
                u32x4 gpre[4], zpre[4]; f32x4 xpre[4][2];
#pragma unroll
                for (int m = 0; m < 4; ++m) { const int row = row0 + ai * 128 + m * 16;
                    if (MODE == 3) gpre[m] = *(const GAS u32x4*)((const GAS bf16_t*)(ws + WS_SAM) + (size_t)row * 1024 + col);
                    if (MODE == 4) { gpre[m] = *(const GAS u32x4*)((const GAS bf16_t*)(ws + WS_SAG) + (size_t)row * 1024 + col);
                                     zpre[m] = *(const GAS u32x4*)((const GAS bf16_t*)P.out + (size_t)T * 1024 + ((size_t)P.round * RT + row) * 1024 + col); }
                    if (MODE == 5) { const size_t off = ((size_t)P.round * RT + row) * 1024 + col; xpre[m][0] = *(const GAS f32x4*)(P.x + off); xpre[m][1] = *(const GAS f32x4*)(P.x + off + 4); } }
#pragma unroll
                for (int m = 0; m < 4; ++m) {
                    const int row = row0 + ai * 128 + m * 16;
                    f32x4 v0, v1;
                    if (MODE == 2 || MODE == 7 || MODE == 3 || MODE == 4 || MODE == 6) { const float sr = sr8[ai][m]; const i32x4q q0 = __builtin_bit_cast(i32x4q, acc[ai][bj][m][0]), q1 = __builtin_bit_cast(i32x4q, acc[ai][bj][m][1]);
                        v0 = (f32x4){(float)q0[0], (float)q0[1], (float)q0[2], (float)q0[3]} * (s0 * sr) + b0; v1 = (f32x4){(float)q1[0], (float)q1[1], (float)q1[2], (float)q1[3]} * (s1 * sr) + b1; }
                    else { v0 = acc[ai][bj][m][0] + b0; v1 = acc[ai][bj][m][1] + b1; }
                    if (MODE == 1 || MODE == 2 || MODE == 6 || MODE == 7) {
                        if (act == 1) {
#pragma unroll
                            for (int j = 0; j < 4; ++j) { v0[j] = sigmoidf_(v0[j]); v1[j] = sigmoidf_(v1[j]); }
                        } else if (act == 2) {
#pragma unroll
                            for (int j = 0; j < 4; ++j) { v0[j] = siluf_(v0[j]); v1[j] = siluf_(v1[j]); }
                        } else if (act == 3) {
#pragma unroll
                            for (int j = 0; j < 4; ++j) { v0[j] = __logf(l0[j] + (1.0f - l0[j]) * sigmoidf_(v0[j])); v1[j] = __logf(l1[j] + (1.0f - l1[j]) * sigmoidf_(v1[j])); }
                        }
                        u32x4 w; w.x = pk2(v0[0], v0[1]); w.y = pk2(v0[2], v0[3]); w.z = pk2(v1[0], v1[1]); w.w = pk2(v1[2], v1[3]);
                        *(u32x4*)(dst + (size_t)row * ld + (col - coff)) = w;
                    } else if (MODE == 3) {
                        const u32x4 g = gpre[m];
                        GAS bf16_t* o = (GAS bf16_t*)P.out + (size_t)T * 1024 + ((size_t)P.round * RT + row) * 1024 + col;
                        f32x4 r0, r1;
                        r0[0] = v0[0] * bf_lo(g.x); r0[1] = v0[1] * bf_hi(g.x); r0[2] = v0[2] * bf_lo(g.y); r0[3] = v0[3] * bf_hi(g.y);
                        r1[0] = v1[0] * bf_lo(g.z); r1[1] = v1[1] * bf_hi(g.z); r1[2] = v1[2] * bf_lo(g.w); r1[3] = v1[3] * bf_hi(g.w);
                        u32x4 w; w.x = pk2(r0[0], r0[1]); w.y = pk2(r0[2], r0[3]); w.z = pk2(r1[0], r1[1]); w.w = pk2(r1[2], r1[3]);
                        *(GAS u32x4*)o = w;
                    } else if (MODE == 4) {
                        const u32x4 g = gpre[m], zv = zpre[m];
                        const f32x4 p0 = (f32x4){bf_lo(zv.x), bf_hi(zv.x), bf_lo(zv.y), bf_hi(zv.y)}, p1 = (f32x4){bf_lo(zv.z), bf_hi(zv.z), bf_lo(zv.w), bf_hi(zv.w)};
                        f32x4 r0, r1;
                        r0[0] = p0[0] + v0[0] * bf_lo(g.x); r0[1] = p0[1] + v0[1] * bf_hi(g.x); r0[2] = p0[2] + v0[2] * bf_lo(g.y); r0[3] = p0[3] + v0[3] * bf_hi(g.y);
                        r1[0] = p1[0] + v1[0] * bf_lo(g.z); r1[1] = p1[1] + v1[1] * bf_hi(g.z); r1[2] = p1[2] + v1[2] * bf_lo(g.w); r1[3] = p1[3] + v1[3] * bf_hi(g.w);
                        u32x4 w; w.x = pk2(r0[0], r0[1]); w.y = pk2(r0[2], r0[3]); w.z = pk2(r1[0], r1[1]); w.w = pk2(r1[2], r1[3]);
                        *(u32x4*)((bf16_t*)(ws + WS_GFLOG) + (size_t)row * 1024 + col) = w;
                    } else if (MODE == 5) {
                        const size_t off = ((size_t)P.round * RT + row) * 1024 + col;
                        const f32x4 x0 = xpre[m][0] + v0, x1 = xpre[m][1] + v1;
                        u32x4 w; w.x = pk2(x0[0], x0[1]); w.y = pk2(x0[2], x0[3]); w.z = pk2(x1[0], x1[1]); w.w = pk2(x1[2], x1[3]);
                        *(GAS u32x4*)((GAS bf16_t*)P.out + off) = w;
                    }
                }
            }
        }
    }
};

__device__ __forceinline__ void p0_transpose_item(const GAS float* W, int ldw, int K, int k0, int scol, GAS bf16_t* WT, int drow, LAS float* scr, int lane) {
#pragma unroll 8
    for (int i = 0; i < 32; ++i) { const int kk = 2 * i + (lane >> 5); scr[kk * 33 + (lane & 31)] = W[(size_t)(k0 + kk) * ldw + scol + (lane & 31)]; }
    LDS_WAIT(); asm volatile("" ::: "memory");
    const int c = lane & 7;
#pragma unroll
    for (int j = 0; j < 4; ++j) { const int n = (lane >> 3) + 8 * j; const LAS float* s = scr + (8 * c) * 33 + n;
        u32x4 o; o.x = pk2(s[0 * 33], s[1 * 33]); o.y = pk2(s[2 * 33], s[3 * 33]); o.z = pk2(s[4 * 33], s[5 * 33]); o.w = pk2(s[6 * 33], s[7 * 33]);
        *(u32x4*)(WT + (size_t)(drow + n) * K + k0 + 8 * c) = o; }
    LDS_WAIT(); asm volatile("" ::: "memory");
}
__device__ __forceinline__ void p0_colmax_item(const GAS float* W, int ldw, int k0, int scol, GAS unsigned* colmax, int lane) {
    float mx = 0.f;
#pragma unroll 8
    for (int i = 0; i < 32; ++i) { const int kk = 2 * i + (lane >> 5); mx = fmaxf(mx, fabsf(W[(size_t)(k0 + kk) * ldw + scol + (lane & 31)])); }
    mx = fmaxf(mx, __builtin_bit_cast(float, xor32u_(__builtin_bit_cast(unsigned, mx), lane >= 32)));
    if (lane < 32) atomicMax((unsigned*)colmax + lane, __builtin_bit_cast(unsigned, mx));
}
__device__ __forceinline__ void p0_cvt8_item(const GAS float* W, int ldw, int k0, int scol, const GAS unsigned* colmax, GAS unsigned char* WT8, int pitch, GAS float* sb, int drow, LAS float* scr, int lane) {
    const float cm = __builtin_bit_cast(float, colmax[lane & 31]);
    const float qs = cm > 0.f ? 127.0f / cm : 0.f;
    if (k0 == 0 && lane < 32) sb[lane] = cm * (1.0f / 127.0f);
#pragma unroll 8
    for (int i = 0; i < 32; ++i) { const int kk = 2 * i + (lane >> 5); scr[kk * 33 + (lane & 31)] = W[(size_t)(k0 + kk) * ldw + scol + (lane & 31)] * qs; }
    LDS_WAIT(); asm volatile("" ::: "memory");
    const int n = lane >> 1, kh = lane & 1;
    const LAS float* sp = scr + (kh * 32) * 33 + n;
    u32x4 o0, o1;
#pragma unroll
    for (int q = 0; q < 8; ++q) { const unsigned p = pack_i8x4(sp[(4 * q) * 33], sp[(4 * q + 1) * 33], sp[(4 * q + 2) * 33], sp[(4 * q + 3) * 33]);
        if (q < 4) o0[q] = p; else o1[q - 4] = p; }
    GAS unsigned char* dst = WT8 + (size_t)(drow + n) * pitch + k0 + kh * 32;
    *(GAS u32x4*)dst = o0; *(GAS u32x4*)(dst + 16) = o1;
    LDS_WAIT(); asm volatile("" ::: "memory");
}
__device__ __forceinline__ int win_src_col(int n) {
    if (n < 4096) return n;
    if (n < 7168) return n - 4096 + 6152;
    if (n < 9216) return n - 7168 + 4096;
    return n - 9216 + 9224;
}

__device__ __forceinline__ void phase_p0(const DArgs& a, LAS unsigned char* lds, int vcu, int G) {
    const int tid = tid_(), lane = tid & 63, wave = tid >> 6;
    const int gw = vcu * NWAVES + wave, NGW = G * NWAVES;
    GAS unsigned char* ws = a.ws;
    LAS float* scr = (LAS float*)(lds + wave * 16384);
    constexpr int I_IN = 16 * 384, I_M = 32 * 32, I_G = 16 * 32, I_O = 16 * 32, I_PQ = 16 * 64;
    constexpr int NITEMS = I_IN + I_M + I_G + I_O + I_PQ;
    for (int it = gw; it < NITEMS; it += NGW) {
        int r = it;
        if (r < I_IN) { const int kb = r / 384, nb = r % 384;
            p0_colmax_item(a.w_in, IN_COLS, kb * 64, win_src_col(nb * 32), (GAS unsigned*)(ws + WS_CTL) + CW_COLMAX + nb * 32, lane);
            continue; } r -= I_IN;
        if (r < I_M) { const int kb = r / 32, nb = r % 32; p0_colmax_item(a.w_br_m, 1024, kb * 64, nb * 32, (GAS unsigned*)(ws + WS_CTL) + CW_COLMAX + 12288 + nb * 32, lane); continue; } r -= I_M;
        if (r < I_G) { const int kb = r / 32, nb = r % 32; p0_colmax_item(a.w_br_g, 1024, kb * 64, nb * 32, (GAS unsigned*)(ws + WS_CTL) + CW_COLMAX + 13312 + nb * 32, lane); continue; } r -= I_G;
        if (r < I_O) { const int kb = r / 32, nb = r % 32; p0_transpose_item(a.w_out, 1024, 1024, kb * 64, nb * 32, (GAS bf16_t*)(ws + WS_WO), nb * 32, scr, lane); continue; } r -= I_O;
        { const int kb = r / 64, nb = r % 64; p0_colmax_item(a.w_pq, 2048, kb * 64, nb * 32, (GAS unsigned*)(ws + WS_CTL) + CW_COLMAX + 14336 + nb * 32, lane); }
    }
    const int gt = vcu * NTHR + tid, NGT = G * NTHR;
    for (int i = gt; i < NP; i += NGT) ((float*)(ws + WS_BIASP))[i] = a.b_in[win_src_col(i)];
    for (int i = gt; i < 1024; i += NGT) { const float t0 = a.lb_table[i], t1 = a.lb_table[1024 + i]; ((float*)(ws + WS_LB))[i] = 1.0f / (1.0f + __expf(t1 - t0)); }
    for (int i = gt; i < 8 * 2 * 128 * 128 / 4; i += NGT) { const f32x4 v = ((const f32x4*)a.sub_keys)[i]; u32x2 o; o.x = pk2(v[0], v[1]); o.y = pk2(v[2], v[3]); ((u32x2*)(ws + WS_SK))[i] = o; }
    f32x4 g1[4];
#pragma unroll
    for (int j = 0; j < 4; ++j) g1[j] = ((const GAS f32x4*)a.norm1_g)[64 * j + lane];
    f32x4 gw0[16], gw1[16];
#pragma unroll
    for (int j = 0; j < 4; ++j)
#pragma unroll
        for (int e = 0; e < 4; ++e) { const int k = 256 * j + 4 * lane + e; gw0[4 * j + e] = *(const GAS f32x4*)(a.w_in + (size_t)k * IN_COLS + 6144); gw1[4 * j + e] = *(const GAS f32x4*)(a.w_in + (size_t)k * IN_COLS + 6148); }
    const float gbias = lane < 8 ? a.b_in[6144 + lane] : 0.f;
    for (int m = gw; m < T; m += NGW) {
        const GAS f32x4* xr = (const GAS f32x4*)(a.x + (size_t)m * D) + lane;
        f32x4 v[4]; float s = 0.f;
#pragma unroll
        for (int j = 0; j < 4; ++j) { v[j] = xr[64 * j]; s += (v[j][0] * v[j][0] + v[j][1] * v[j][1]) + (v[j][2] * v[j][2] + v[j][3] * v[j][3]); }
        const float rstd = rsqrtf(wave_sum(s, lane) * (1.f / D) + EPS);
        f32x4 ga0 = (f32x4){0.f, 0.f, 0.f, 0.f}, ga1 = ga0;
        float mx = 0.f;
#pragma unroll
        for (int j = 0; j < 4; ++j) {
            v[j] = v[j] * rstd * g1[j];
            mx = fmaxf(mx, fmaxf(fmaxf(fabsf(v[j][0]), fabsf(v[j][1])), fmaxf(fabsf(v[j][2]), fabsf(v[j][3]))));
#pragma unroll
            for (int e = 0; e < 4; ++e) { ga0 += gw0[4 * j + e] * v[j][e]; ga1 += gw1[4 * j + e] * v[j][e]; }
        }
        {
            mx = wave_max(mx);
            const float qs = mx > 0.f ? 127.0f / mx : 0.f;
#pragma unroll
            for (int jq = 0; jq < 4; ++jq) ((GAS unsigned*)(ws + WS_XN8 + (size_t)m * 1024))[64 * jq + lane] = pack_i8x4(v[jq][0] * qs, v[jq][1] * qs, v[jq][2] * qs, v[jq][3] * qs);
            if (lane == 0) ((GAS float*)(ws + WS_SA8))[m] = mx * (1.0f / 127.0f);
        }
        float ga[8] = {ga0[0], ga0[1], ga0[2], ga0[3], ga1[0], ga1[1], ga1[2], ga1[3]};
#pragma unroll
        for (int q = 0; q < 8; ++q) ga[q] = wave_sum(ga[q], lane);
        if (lane < 8) { float r = ga[0];
#pragma unroll
            for (int q = 1; q < 8; ++q) r = (lane == q) ? ga[q] : r;
            ((GAS float*)(ws + WS_GATES))[(size_t)m * 8 + lane] = r + gbias; }
    }
}

__device__ __forceinline__ float logsigf_(float x) { return fminf(x, 0.f) - log1pf(__expf(-fabsf(x))); }
#define LDS_BAR() do { asm volatile("s_waitcnt lgkmcnt(0)" ::: "memory"); __builtin_amdgcn_s_barrier(); asm volatile("" ::: "memory"); } while (0)
#define MFMA16(a, b, c) __builtin_amdgcn_mfma_f32_16x16x32_bf16((a), (b), (c), 0, 0, 0)
__device__ __forceinline__ bf16x8 lfrag(const LAS unsigned char* base, int pitch, int row, int k0, int fq) { return *(const LAS bf16x8*)(base + row * pitch + (k0 + 8 * fq) * 2); }
__device__ __forceinline__ int fm_off(int r, int k, int KB) { return (((r >> 4) * KB + (k >> 5)) << 10) + (((((k >> 3) & 3) << 4) + (r & 15)) << 4) + ((k & 7) << 1); }
__device__ __forceinline__ int fm8_off(int r, int k, int KP) { return (((r >> 4) * KP + (k >> 6)) << 10) + (((((k >> 3) & 3) << 4) + (r & 15)) << 4) + (((k >> 5) & 1) << 3) + (k & 7); }
__device__ __forceinline__ unsigned pack_fp8x4(float a, float b, float c, float d) { int p = __builtin_amdgcn_cvt_pk_fp8_f32(a, b, 0, false); p = __builtin_amdgcn_cvt_pk_fp8_f32(c, d, p, true); return (unsigned)p; }
__device__ __forceinline__ bf16x8 fp8_frag(unsigned a, unsigned b) {
    const f32x2 f0 = __builtin_amdgcn_cvt_pk_f32_fp8((int)a, false), f1 = __builtin_amdgcn_cvt_pk_f32_fp8((int)a, true), f2 = __builtin_amdgcn_cvt_pk_f32_fp8((int)b, false), f3 = __builtin_amdgcn_cvt_pk_f32_fp8((int)b, true);
    u32x4 o; o.x = pk2(f0[0], f0[1]); o.y = pk2(f1[0], f1[1]); o.z = pk2(f2[0], f2[1]); o.w = pk2(f3[0], f3[1]);
    return __builtin_bit_cast(bf16x8, o);
}
constexpr float MS_SQ = 64.0f, MS_K = 8.0f;
__device__ __forceinline__ bf16x8 gfrag(const bf16_t* base, int ld, int row, int k0, int fq) { return *(const bf16x8*)(base + (size_t)row * ld + k0 + 8 * fq); }

__device__ __forceinline__ void phase_p0c(const DArgs& a, LAS unsigned char* lds, int vcu, int G) {
    const int tid = tid_(), lane = tid & 63, wave = tid >> 6;
    const int gw = vcu * NWAVES + wave, NGW = G * NWAVES;
    GAS unsigned char* ws = a.ws;
    LAS float* scr = (LAS float*)(lds + wave * 16384);
    constexpr int J_IN = 16 * 384, J_M = 32 * 32, J_G = 16 * 32, J_PQ = 16 * 64;
    const GAS unsigned* cmx = (const GAS unsigned*)(ws + WS_CTL) + CW_COLMAX; GAS float* sb = (GAS float*)(ws + WS_SB8);
    for (int it = gw; it < J_IN + J_M + J_G + J_PQ; it += NGW) {
        int r = it;
        if (r < J_IN) { const int kb = r / 384, nb = r % 384;
            p0_cvt8_item(a.w_in, IN_COLS, kb * 64, win_src_col(nb * 32), cmx + nb * 32, ws + WS_W8A, 1024, sb + nb * 32, nb * 32, scr, lane); continue; } r -= J_IN;
        if (r < J_M) { const int kb = r / 32, nb = r % 32; p0_cvt8_item(a.w_br_m, 1024, kb * 64, nb * 32, cmx + 12288 + nb * 32, ws + WS_WM, 2048, sb + 12288 + nb * 32, nb * 32, scr, lane); continue; } r -= J_M;
        if (r < J_G) { const int kb = r / 32, nb = r % 32; p0_cvt8_item(a.w_br_g, 1024, kb * 64, nb * 32, cmx + 13312 + nb * 32, ws + WS_WG, 1024, sb + 13312 + nb * 32, nb * 32, scr, lane); continue; } r -= J_G;
        { const int kb = r / 64, nb = r % 64; p0_cvt8_item(a.w_pq, 2048, kb * 64, nb * 32, cmx + 14336 + nb * 32, ws + WS_WPQ, 1024, sb + 14336 + nb * 32, nb * 32, scr, lane); }
    }
}
__device__ __forceinline__ void mscan_pair(const DArgs& a, LAS unsigned char* lds, int round, int p) {
    const int tid = tid_(), lane = tid & 63, part = tid >> 6;
    const int bl = p >> 2, h = p & 3, b = round * 2 + bl;
    const GAS float* g = (const GAS float*)(a.ws + WS_GATES) + ((size_t)b * SEQ + (size_t)lane * 128 + part * 16) * 8;
    float bsum = 0.f, gm = -INFINITY;
#pragma unroll 4
    for (int s = 0; s < 16; ++s) { const float ip = g[s * 8 + h], fp = g[s * 8 + 4 + h]; bsum += logsigf_(fp); gm = fmaxf(gm, ip - bsum); }
    LAS float* PS = (LAS float*)lds; LAS float* PM = PS + 512;
    PS[part * 64 + lane] = bsum; PM[part * 64 + lane] = gm;
    __syncthreads();
    if (tid < 64) {
        float bs = 0.f, g2 = -INFINITY;
#pragma unroll
        for (int q = 0; q < 8; ++q) { g2 = fmaxf(g2, PM[q * 64 + lane] - bs); bs += PS[q * 64 + lane]; }
        float mprev = 0.f, mine = 0.f;
        for (int c = 0; c < 64; ++c) {
            const float bc = rdlane(bs, c), gc = rdlane(g2, c);
            if (lane == c) mine = mprev; mprev = bc + fmaxf(mprev, gc); }
        ((GAS float*)(a.ws + WS_MPREV))[(round * 8 + p) * 64 + lane] = mine;
    }
    __syncthreads();
}

constexpr int PQ_PITCH = 528, PS_PITCH = 272;
__device__ __forceinline__ void mlstm_pre_item(const DArgs& a, LAS unsigned char* lds, int round, int item) {
    const int tid = tid_(), lane = tid & 63, wave = __builtin_amdgcn_readfirstlane(tid >> 6), fr = lane & 15, fq = lane >> 4;
    const int p = item >> 6, c = item & 63, bl = p >> 2, h = p & 3, b = round * 2 + bl;
    const int tl0 = bl * SEQ + c * 128; const size_t tg0 = (size_t)b * SEQ + c * 128;
    GAS unsigned char* ws = a.ws;
    LAS unsigned char* QL = lds; LAS unsigned char* KL = lds + 67584;
    LAS float* AS = (LAS float*)(lds + 135168); LAS float* MS = AS + 128; LAS float* SC = AS + 256;
    if (wave == 0) {
        const float mprev = ((const float*)(ws + WS_MPREV))[(round * 8 + p) * 64 + c];
        const float* g = (const float*)(ws + WS_GATES) + (tg0 + 2 * lane) * 8;
        const float ip0 = g[h], fp0 = g[4 + h], ip1 = g[8 + h], fp1 = g[12 + h];
        const float lf0 = logsigf_(fp0), lf1 = logsigf_(fp1), pp = lf0 + lf1;
        float incl = pp;
#pragma unroll
        for (int o = 1; o < 64; o <<= 1) { const float t = shup(incl, o, lane); if (lane >= o) incl += t; }
        const float excl = incl - pp, b0 = excl + lf0, b1 = incl;
        const float a0 = ip0 - b0, a1 = ip1 - b1;
        float inclm = fmaxf(a0, a1);
#pragma unroll
        for (int o = 1; o < 64; o <<= 1) { const float t = shup(inclm, o, lane); if (lane >= o) inclm = fmaxf(inclm, t); }
        float exclm = shup(inclm, 1, lane); if (lane == 0) exclm = -INFINITY;
        const float M0 = fmaxf(mprev, fmaxf(exclm, a0)), M1 = fmaxf(mprev, inclm);
        AS[2 * lane] = a0; AS[2 * lane + 1] = a1; MS[2 * lane] = M0; MS[2 * lane + 1] = M1;
        float* mt = (float*)(ws + WS_MT) + (tg0 + 2 * lane) * 4 + h;
        mt[0] = b0 + M0; mt[4] = b1 + M1;
        const float Mlast = rdlane(M1, 63);
        if (lane == 0) { SC[0] = mprev; SC[1] = Mlast; ((float*)(ws + WS_MDEC))[item] = __expf(mprev - Mlast); }
    }
    {
        const int cgp = tid & 63, strip = tid >> 6;
        const int col = (cgp < 32) ? (h * 256 + cgp * 8) : (1024 + h * 256 + (cgp - 32) * 8);
        float w[4][8], bb[8];
#pragma unroll
        for (int j = 0; j < 4; ++j) { const f32x4 w0 = *(const f32x4*)(a.conv_w + j * 2048 + col), w1 = *(const f32x4*)(a.conv_w + j * 2048 + col + 4);
#pragma unroll
            for (int e = 0; e < 4; ++e) { w[j][e] = w0[e]; w[j][4 + e] = w1[e]; } }
        { const f32x4 b0 = *(const f32x4*)(a.conv_b + col), b1 = *(const f32x4*)(a.conv_b + col + 4);
#pragma unroll
            for (int e = 0; e < 4; ++e) { bb[e] = b0[e]; bb[4 + e] = b1[e]; } }
        const bf16_t* src = (const bf16_t*)(ws + WS_QKPRE) + (size_t)(tl0 + 16 * strip) * 2048 + col;
        const float qs = (cgp < 32) ? 0.0625f : 1.0f;
        LAS unsigned char* dstt = ((cgp < 32) ? QL : KL) + (cgp & 31) * 16;
#pragma unroll 1
        for (int half = 0; half < 2; ++half) {
            u32x4 xr[11];
#pragma unroll
            for (int r = 0; r < 11; ++r) {
                const int sl = c * 128 + 16 * strip + 8 * half + r - 3;
                xr[r] = (sl >= 0) ? *(const u32x4*)(src + (ptrdiff_t)(8 * half + r - 3) * 2048) : (u32x4){0u, 0u, 0u, 0u};
            }
#pragma unroll
            for (int r = 0; r < 8; ++r) {
                float y[8];
#pragma unroll
                for (int e = 0; e < 8; ++e) y[e] = bb[e];
#pragma unroll
                for (int j = 0; j < 4; ++j) { const u32x4 xv = xr[r + j];
                    y[0] += w[j][0] * bf_lo(xv.x); y[1] += w[j][1] * bf_hi(xv.x); y[2] += w[j][2] * bf_lo(xv.y); y[3] += w[j][3] * bf_hi(xv.y);
                    y[4] += w[j][4] * bf_lo(xv.z); y[5] += w[j][5] * bf_hi(xv.z); y[6] += w[j][6] * bf_lo(xv.w); y[7] += w[j][7] * bf_hi(xv.w); }
#pragma unroll
                for (int e = 0; e < 8; ++e) y[e] = siluf_(y[e]) * qs;
                u32x4 o; o.x = pk2(y[0], y[1]); o.y = pk2(y[2], y[3]); o.z = pk2(y[4], y[5]); o.w = pk2(y[6], y[7]);
                *(LAS u32x4*)(dstt + (16 * strip + 8 * half + r) * PQ_PITCH) = o;
            }
        }
    }
    __syncthreads();
    const float mprev = SC[0], Mlast = SC[1];
    {
        GAS unsigned char* Sg = ws + WS_S + (size_t)item * 16384;
        const int t = wave * 16 + fr; const float Mt = MS[t];
        for (int st = 0; st < 8; ++st) {
            unsigned o = 0u;
            if (st <= wave) {
                f32x4 acc = (f32x4){0.f, 0.f, 0.f, 0.f};
#pragma unroll
                for (int ks = 0; ks < 8; ++ks) acc = MFMA16(lfrag(KL, PQ_PITCH, st * 16 + fr, ks * 32, fq), lfrag(QL, PQ_PITCH, wave * 16 + fr, ks * 32, fq), acc);
                float v[4];
#pragma unroll
                for (int j = 0; j < 4; ++j) { const int s = st * 16 + 4 * fq + j; v[j] = (s <= t) ? acc[j] * __expf(AS[s] - Mt) : 0.f; }
                o = pack_fp8x4(v[0] * MS_SQ, v[1] * MS_SQ, v[2] * MS_SQ, v[3] * MS_SQ);
            }
            *(GAS unsigned*)(Sg + fm8_off(t, st * 16 + 4 * fq, 2)) = o;
        }
    }
    {
        GAS unsigned char* Qg = ws + WS_QT + (size_t)item * 32768;
#pragma unroll
        for (int i = 0; i < 8; ++i) { const int idx = tid + 512 * i, blk = idx >> 6, t = (blk >> 3) * 16 + (idx & 15), ch = (blk & 7) * 4 + ((idx >> 4) & 3);
            const u32x4 v = *(const LAS u32x4*)(QL + t * PQ_PITCH + ch * 16); const float s = __expf(mprev - MS[t]) * MS_SQ;
            u32x2 o; o.x = pack_fp8x4(bf_lo(v.x) * s, bf_hi(v.x) * s, bf_lo(v.y) * s, bf_hi(v.y) * s); o.y = pack_fp8x4(bf_lo(v.z) * s, bf_hi(v.z) * s, bf_lo(v.w) * s, bf_hi(v.w) * s);
            *(GAS u32x2*)(Qg + fm8_off(t, ch * 8, 4)) = o; }
    }
    {
        GAS unsigned char* Kg = ws + WS_KWT + (size_t)item * 32768;
        const int dlo = lane & 15, sglo = lane >> 4;
#pragma unroll
        for (int i = 0; i < 8; ++i) { const int combo = wave * 8 + i, d = (combo >> 2) * 16 + dlo, s0 = ((combo & 3) * 4 + sglo) * 8;
            float v[8];
#pragma unroll
            for (int e = 0; e < 8; ++e) v[e] = bf2f(*(const LAS bf16_t*)(KL + (s0 + e) * PQ_PITCH + d * 2)) * (__expf(AS[s0 + e] - Mlast) * MS_K);
            u32x2 o; o.x = pack_fp8x4(v[0], v[1], v[2], v[3]); o.y = pack_fp8x4(v[4], v[5], v[6], v[7]);
            *(GAS u32x2*)(Kg + fm8_off(d, s0, 2)) = o; }
    }
    __syncthreads();
}

__device__ __forceinline__ void hgrn_pre_load(const DArgs& a, int round, int item, u32x4 (&gq)[4]) {
    const int tid = tid_();
    const int p = item >> 7, c = item & 127, bl = p >> 3, h = p & 7;
    const int tl0 = bl * SEQ + c * 64;
    GAS unsigned char* ws = a.ws;
#pragma unroll
    for (int i = 0; i < 2; ++i) { const int idx = tid + 512 * i, s = idx >> 4, ch = idx & 15;
        gq[2 * i] = *(const GAS u32x4*)((const GAS bf16_t*)(ws + WS_GFLOG) + (size_t)(tl0 + s) * 1024 + h * 128 + ch * 8);
        gq[2 * i + 1] = *(const GAS u32x4*)((const GAS bf16_t*)(ws + WS_GQ) + (size_t)(tl0 + s) * 1024 + h * 128 + ch * 8); }
}
__device__ __forceinline__ void hgrn_pre_item(const DArgs& a, LAS unsigned char* lds, int round, int item, u32x4 (&gq)[4], int next_item) {
    const int tid = tid_(), lane = tid & 63, wave = __builtin_amdgcn_readfirstlane(tid >> 6), fr = lane & 15, fq = lane >> 4;
    const int p = item >> 7, c = item & 127, bl = p >> 3, h = p & 7;
    const int tl0 = bl * SEQ + c * 64;
    GAS unsigned char* ws = a.ws;
    LAS float* CUM = (LAS float*)lds;
    LAS float* GL = (LAS float*)(lds + 32768);
    LAS unsigned char* QH = lds + 65536;
    LAS unsigned char* KE = lds + 65536 + 64 * PS_PITCH;
    LAS float* QF = (LAS float*)(lds + 65536 + 128 * PS_PITCH);
#pragma unroll
    for (int i = 0; i < 2; ++i) { const int idx = tid + 512 * i, s = idx >> 4, ch = idx & 15;
        const u32x4 gv = gq[2 * i], qv = gq[2 * i + 1];
        LAS float* gd = GL + s * 128 + ch * 8; LAS float* qd = QF + s * 128 + ch * 8;
        gd[0] = bf_lo(gv.x); gd[1] = bf_hi(gv.x); gd[2] = bf_lo(gv.y); gd[3] = bf_hi(gv.y); gd[4] = bf_lo(gv.z); gd[5] = bf_hi(gv.z); gd[6] = bf_lo(gv.w); gd[7] = bf_hi(gv.w);
        qd[0] = bf_lo(qv.x); qd[1] = bf_hi(qv.x); qd[2] = bf_lo(qv.y); qd[3] = bf_hi(qv.y); qd[4] = bf_lo(qv.z); qd[5] = bf_hi(qv.z); qd[6] = bf_lo(qv.w); qd[7] = bf_hi(qv.w); }
    if (next_item < 2048) hgrn_pre_load(a, round, next_item, gq);
    LDS_BAR();
    {
        const int d = tid & 127, qt = tid >> 7; float cs = 0.f;
#pragma unroll 4
        for (int s = 0; s < 16; ++s) { cs += GL[(qt * 16 + s) * 128 + d]; CUM[(qt * 16 + s) * 128 + d] = cs; }
        LDS_BAR();
        float off = 0.f;
#pragma unroll
        for (int q = 0; q < 3; ++q) off += (q < qt) ? CUM[(q * 16 + 15) * 128 + d] : 0.f;
        LDS_BAR();
#pragma unroll 4
        for (int s = 0; s < 16; ++s) CUM[(qt * 16 + s) * 128 + d] += off;
        if (qt == 3) ((GAS float*)(ws + WS_HGDEC))[(size_t)item * 128 + d] = __expf(cs + off);
    }
    LDS_BAR();
    {
        bf16_t* Qg = (bf16_t*)(ws + WS_QTG) + (size_t)item * 64 * 128;
#pragma unroll
        for (int i = 0; i < 2; ++i) { const int idx = tid + 512 * i, s = idx >> 4, ch = idx & 15;
            float qt[8], qh[8], ke[8];
#pragma unroll
            for (int e = 0; e < 8; ++e) { const int d = ch * 8 + e; const float cm = CUM[s * 128 + d], last = CUM[63 * 128 + d], q = QF[s * 128 + d], g = GL[s * 128 + d];
                qt[e] = q * __expf(cm); qh[e] = q * __expf(cm - last); ke[e] = (1.0f - __expf(g)) * __expf(last - cm); }
            u32x4 o; o.x = pk2(qt[0], qt[1]); o.y = pk2(qt[2], qt[3]); o.z = pk2(qt[4], qt[5]); o.w = pk2(qt[6], qt[7]);
            *(u32x4*)((unsigned char*)Qg + fm_off(s, ch * 8, 4)) = o;
            o.x = pk2(qh[0], qh[1]); o.y = pk2(qh[2], qh[3]); o.z = pk2(qh[4], qh[5]); o.w = pk2(qh[6], qh[7]);
            *(LAS u32x4*)(QH + s * PS_PITCH + ch * 16) = o;
            o.x = pk2(ke[0], ke[1]); o.y = pk2(ke[2], ke[3]); o.z = pk2(ke[4], ke[5]); o.w = pk2(ke[6], ke[7]);
            *(LAS u32x4*)(KE + s * PS_PITCH + ch * 16) = o; }
    }
    LDS_BAR();
    {
        bf16_t* Ag = (bf16_t*)(ws + WS_ATT) + (size_t)item * 64 * 64;
#pragma unroll
        for (int i = 0; i < 2; ++i) { const int tile = wave * 2 + i, tt = tile >> 2, st = tile & 3; const int t = tt * 16 + fr;
            u32x2 o = (u32x2){0u, 0u};
            if (st <= tt) { f32x4 acc = (f32x4){0.f, 0.f, 0.f, 0.f};
#pragma unroll
                for (int ks = 0; ks < 4; ++ks) acc = MFMA16(lfrag(KE, PS_PITCH, st * 16 + fr, ks * 32, fq), lfrag(QH, PS_PITCH, tt * 16 + fr, ks * 32, fq), acc);
                float v[4];
#pragma unroll
                for (int j = 0; j < 4; ++j) { const int s = st * 16 + 4 * fq + j; v[j] = (s <= t) ? acc[j] : 0.f; }
                o.x = pk2(v[0], v[1]); o.y = pk2(v[2], v[3]); }
            *(u32x2*)((unsigned char*)Ag + fm_off(t, st * 16 + 4 * fq, 2)) = o; }
    }
    {
        bf16_t* Kg = (bf16_t*)(ws + WS_KENDT) + (size_t)item * 128 * 64;
        const int dlo = lane & 15, sglo = lane >> 4;
#pragma unroll
        for (int i = 0; i < 2; ++i) { const int combo = wave * 2 + i, d = (combo >> 1) * 16 + dlo, s0 = ((combo & 1) * 4 + sglo) * 8;
            unsigned v[8];
#pragma unroll
            for (int e = 0; e < 8; ++e) v[e] = *(const LAS bf16_t*)(KE + (s0 + e) * PS_PITCH + d * 2);
            u32x4 o; o.x = v[0] | (v[1] << 16); o.y = v[2] | (v[3] << 16); o.z = v[4] | (v[5] << 16); o.w = v[6] | (v[7] << 16);
            *(u32x4*)((unsigned char*)Kg + fm_off(d, s0, 2)) = o; }
    }
    LDS_BAR();
}

template <int NVT, bool DEN>
__device__ __forceinline__ void mlstm_scan(const DArgs& a, LAS unsigned char* lds, int round, int p, int sl) {
    const int tid = tid_(), lane = tid & 63, wave = __builtin_amdgcn_readfirstlane(tid >> 6), fr = lane & 15, fq = lane >> 4;
    const int bl = p >> 2, h = p & 3, b = round * 2 + bl;
    GAS unsigned char* ws = a.ws;
    constexpr int VTB = NVT * 16 * PS_PITCH, CTB = NVT * 16 * PQ_PITCH;
    LAS unsigned char* VT = lds; LAS unsigned char* CT = lds + 2 * VTB; LAS float* DEC = (LAS float*)(lds + 2 * VTB + 2 * CTB);
    for (int i = tid; i < (2 * VTB + 2 * CTB) / 4; i += NTHR) ((LAS unsigned*)lds)[i] = 0u;
    if (tid < 64) DEC[tid] = ((const GAS float*)(ws + WS_MDEC))[p * 64 + tid];
    __syncthreads();
    if (DEN) { if (tid < 256) { const int bufi = tid >> 7, s = tid & 127; *(LAS bf16_t*)(VT + bufi * VTB + s * 2) = (bf16_t)0x3F80; } }
    f32x4 st[2][NVT];
#pragma unroll
    for (int dt = 0; dt < 2; ++dt)
#pragma unroll
        for (int vt = 0; vt < NVT; ++vt) st[dt][vt] = (f32x4){0.f, 0.f, 0.f, 0.f};
    const int vcol = h * 512 + sl * 32;
    const int vs = tid >> 2, vpart = tid & 3;
    const GAS unsigned char* Sg0 = ws + WS_S + (size_t)(p * 64) * 16384 + wave * 2048 + lane * 16;
    const GAS unsigned char* Qg0 = ws + WS_QT + (size_t)(p * 64) * 32768 + wave * 4096 + lane * 16;
    const GAS unsigned char* Kg0 = ws + WS_KWT + (size_t)(p * 64) * 32768 + wave * 4096 + lane * 16;
    const GAS bf16_t* Vg0 = (const GAS bf16_t*)(ws + WS_V) + (size_t)(bl * SEQ + vs) * 2048 + vcol + vpart * 8;
    u32x4 rS[2], rQ[4], rK[2][2]; u32x4 vreg = (u32x4){0u, 0u, 0u, 0u};
#define V_STAGE(cc_) do { LAS unsigned char* d0_ = VT + ((cc_) & 1) * VTB + (vpart * 8) * PS_PITCH + vs * 2; \
        *(LAS bf16_t*)(d0_ + 0 * PS_PITCH) = (bf16_t)(vreg.x & 0xffffu); *(LAS bf16_t*)(d0_ + 1 * PS_PITCH) = (bf16_t)(vreg.x >> 16); \
        *(LAS bf16_t*)(d0_ + 2 * PS_PITCH) = (bf16_t)(vreg.y & 0xffffu); *(LAS bf16_t*)(d0_ + 3 * PS_PITCH) = (bf16_t)(vreg.y >> 16); \
        *(LAS bf16_t*)(d0_ + 4 * PS_PITCH) = (bf16_t)(vreg.z & 0xffffu); *(LAS bf16_t*)(d0_ + 5 * PS_PITCH) = (bf16_t)(vreg.z >> 16); \
        *(LAS bf16_t*)(d0_ + 6 * PS_PITCH) = (bf16_t)(vreg.w & 0xffffu); *(LAS bf16_t*)(d0_ + 7 * PS_PITCH) = (bf16_t)(vreg.w >> 16); } while (0)
    if (!DEN) { vreg = *(const GAS u32x4*)Vg0; V_STAGE(0); }
    __builtin_amdgcn_sched_barrier(0);
#pragma unroll
    for (int kp = 0; kp < 2; ++kp)
#pragma unroll
        for (int dt = 0; dt < 2; ++dt) rK[dt][kp] = *(const GAS u32x4*)(Kg0 + (dt * 2 + kp) * 1024);
    __builtin_amdgcn_sched_barrier(0);
#pragma unroll
    for (int kp = 0; kp < 2; ++kp) rS[kp] = *(const GAS u32x4*)(Sg0 + kp * 1024);
    __builtin_amdgcn_sched_barrier(0);
#pragma unroll
    for (int kp = 0; kp < 4; ++kp) rQ[kp] = *(const GAS u32x4*)(Qg0 + kp * 1024);
    __builtin_amdgcn_sched_barrier(0);
    if (!DEN) vreg = *(const GAS u32x4*)(Vg0 + (size_t)128 * 2048);
    __builtin_amdgcn_sched_barrier(0);
    const GAS unsigned char* pfp; unsigned pfstride;
    { const int tt = (wave * 64 + lane) < 80 ? wave * 64 + lane : 79; const int idx = sl * 5 + (tt >> 4), off = (tt & 15) * 64;
      pfp = (idx < 16 ? ws + WS_S + (size_t)(p * 64) * 16384 + idx * 1024 : idx < 48 ? ws + WS_QT + (size_t)(p * 64) * 32768 + (idx - 16) * 1024 : ws + WS_KWT + (size_t)(p * 64) * 32768 + (idx - 48) * 1024) + off;
      pfstride = idx < 16 ? 16384u : 32768u; }
    unsigned pfv = 0u;
#pragma unroll 1
    for (int c = 0; c < 64; ++c) {
        const int tl0 = bl * SEQ + c * 128; const size_t tg0 = (size_t)b * SEQ + c * 128;
        const int cn = c < 63 ? c + 1 : 63, cn2 = c < 62 ? c + 2 : 63;
        LAS unsigned char* vt_ = VT + (c & 1) * VTB; LAS unsigned char* ct_ = CT + (c & 1) * CTB; LAS unsigned char* ctn = CT + ((c + 1) & 1) * CTB;
        LDS_BAR();
        if (!DEN && wave < 2) { asm volatile("" :: "v"(pfv)); const int c3 = c < 60 ? c + 3 : 63; pfv = *(const GAS unsigned*)(pfp + (size_t)c3 * pfstride); }
        bf16x8 vf[NVT][4], cf[NVT][4];
#pragma unroll
        for (int vt = 0; vt < NVT; ++vt)
#pragma unroll
            for (int ks = 0; ks < 4; ++ks) vf[vt][ks] = lfrag(vt_, PS_PITCH, vt * 16 + fr, ks * 32, fq);
        const float dec = DEC[c];
        __builtin_amdgcn_sched_barrier(0);
#pragma unroll
        for (int dt = 0; dt < 2; ++dt)
#pragma unroll
            for (int vt = 0; vt < NVT; ++vt) st[dt][vt] = st[dt][vt] * dec;
#pragma unroll
        for (int ks = 0; ks < 4; ++ks) {
#pragma unroll
            for (int vt = 0; vt < NVT; ++vt) cf[vt][ks] = lfrag(ct_, PQ_PITCH, vt * 16 + fr, ks * 32, fq);
#pragma unroll
            for (int dt = 0; dt < 2; ++dt) {
                const bf16x8 aK = (ks & 1) ? fp8_frag(rK[dt][ks >> 1].z, rK[dt][ks >> 1].w) : fp8_frag(rK[dt][ks >> 1].x, rK[dt][ks >> 1].y);
#pragma unroll
                for (int vt = 0; vt < NVT; ++vt) st[dt][vt] = MFMA16(aK, vf[vt][ks], st[dt][vt]);
                if (ks & 1) rK[dt][ks >> 1] = *(const GAS u32x4*)(Kg0 + (size_t)cn * 32768 + (dt * 2 + (ks >> 1)) * 1024);
            }
            __builtin_amdgcn_sched_barrier(0);
        }
#pragma unroll
        for (int dt = 0; dt < 2; ++dt)
#pragma unroll
            for (int vt = 0; vt < NVT; ++vt) { const f32x4 sp = st[dt][vt] * (1.0f / MS_K); u32x2 o; o.x = pk2(sp[0], sp[1]); o.y = pk2(sp[2], sp[3]);
                *(LAS u32x2*)(ctn + (vt * 16 + fr) * PQ_PITCH + (wave * 32 + dt * 16 + 4 * fq) * 2) = o; }
        __builtin_amdgcn_sched_barrier(0);
        f32x4 acc[NVT];
#pragma unroll
        for (int vt = 0; vt < NVT; ++vt) acc[vt] = (f32x4){0.f, 0.f, 0.f, 0.f};
#pragma unroll
        for (int ks = 0; ks < 4; ++ks) {
            { const bf16x8 bS = (ks & 1) ? fp8_frag(rS[ks >> 1].z, rS[ks >> 1].w) : fp8_frag(rS[ks >> 1].x, rS[ks >> 1].y);
#pragma unroll
              for (int vt = 0; vt < NVT; ++vt) acc[vt] = MFMA16(vf[vt][ks], bS, acc[vt]); }
            if (ks & 1) rS[ks >> 1] = *(const GAS u32x4*)(Sg0 + (size_t)cn * 16384 + (ks >> 1) * 1024);
            __builtin_amdgcn_sched_barrier(0);
        }
#pragma unroll
        for (int ks = 0; ks < 8; ++ks) {
            { const bf16x8 bQ = (ks & 1) ? fp8_frag(rQ[ks >> 1].z, rQ[ks >> 1].w) : fp8_frag(rQ[ks >> 1].x, rQ[ks >> 1].y);
#pragma unroll
              for (int vt = 0; vt < NVT; ++vt) acc[vt] = MFMA16(cf[vt][ks & 3], bQ, acc[vt]); }
            if (ks < 4) {
#pragma unroll
                for (int vt = 0; vt < NVT; ++vt) cf[vt][ks] = lfrag(ct_, PQ_PITCH, vt * 16 + fr, 128 + ks * 32, fq);
            }
            if (ks & 1) rQ[ks >> 1] = *(const GAS u32x4*)(Qg0 + (size_t)cn * 32768 + (ks >> 1) * 1024);
            __builtin_amdgcn_sched_barrier(0);
        }
        const int t = wave * 16 + fr;
        if (!DEN) {
            GAS bf16_t* hn = (GAS bf16_t*)(ws + WS_QKPRE) + (size_t)(tl0 + t) * 2048 + vcol + 4 * fq;
#pragma unroll
            for (int vt = 0; vt < NVT; ++vt) { const f32x4 av = acc[vt] * (1.0f / MS_SQ); u32x2 o; o.x = pk2(av[0], av[1]); o.y = pk2(av[2], av[3]); *(GAS u32x2*)(hn + vt * 16) = o; }
            V_STAGE(c + 1); vreg = *(const GAS u32x4*)(Vg0 + (size_t)cn2 * 128 * 2048);
        } else {
            if (fq == 0) ((GAS float*)(ws + WS_DEN))[(tg0 + t) * 4 + h] = acc[0][0] * (1.0f / MS_SQ);
        }
    }
    asm volatile("" :: "v"(pfv));
    __syncthreads();
#undef V_STAGE
}

constexpr int HG_PD = 4;
__device__ __forceinline__ void hgrn_scan(const DArgs& a, LAS unsigned char* lds, int round, int p, int sl) {
    const int tid = tid_(), lane = tid & 63, wave = __builtin_amdgcn_readfirstlane(tid >> 6), fr = lane & 15, fq = lane >> 4;
    const int bl = p >> 3, h = p & 7;
    GAS unsigned char* ws = a.ws;
    constexpr int IP = 144, ITB = 32 * IP, STB = 32 * PS_PITCH;
    LAS unsigned char* IT = lds; LAS unsigned char* ST = lds + 2 * ITB;
    for (int i = tid; i < (2 * ITB + 2 * STB) / 4; i += NTHR) ((LAS unsigned*)lds)[i] = 0u;
    __syncthreads();
    f32x4 st[2][2];
#pragma unroll
    for (int i = 0; i < 2; ++i) { st[i][0] = (f32x4){0.f, 0.f, 0.f, 0.f}; st[i][1] = st[i][0]; }
    const int vcol = h * 128 + sl * 32;
    const int is = (tid & 255) >> 2, ipart = tid & 3;
    const bool outw = wave < 4;
    const int w4 = wave & 3;
    const GAS unsigned char* Ag0 = ws + WS_ATT + (size_t)(p * 128) * 8192 + w4 * 2048 + lane * 16;
    const GAS unsigned char* Qg0 = ws + WS_QTG + (size_t)(p * 128) * 16384 + w4 * 4096 + lane * 16;
    const GAS unsigned char* Kg0 = ws + WS_KENDT + (size_t)(p * 128) * 16384 + w4 * 4096 + lane * 16;
    const GAS unsigned char* Dg0 = ws + WS_HGDEC + ((size_t)(p * 128) * 128 + w4 * 32 + 4 * fq) * 4;
    const GAS unsigned char* Ig0 = ws + WS_GI + ((size_t)(bl * SEQ + is) * 1024 + vcol + ipart * 8) * 2;
    const GAS unsigned char* gb0 = outw ? Ag0 : Kg0;          const unsigned gs0 = outw ? 8192u : 16384u;
    const GAS unsigned char* gb1 = outw ? Qg0 : Kg0 + 2048;   const unsigned gs1 = 16384u;
    const GAS unsigned char* gb2 = outw ? Qg0 + 2048 : Dg0;   const unsigned gs2 = outw ? 16384u : 512u, gt2 = outw ? 1024u : 64u;
    const GAS unsigned char* gb3 = outw ? Ig0 : Dg0;          const unsigned gs3 = outw ? 131072u : 512u;
    u32x4 pf[HG_PD][7];
#define HG_LD01(k_, cc_) do { _Pragma("unroll") for (int j_ = 0; j_ < 2; ++j_) pf[k_][j_] = *(const GAS u32x4*)(gb0 + (size_t)(cc_) * gs0 + j_ * 1024); } while (0)
#define HG_LD23(k_, cc_) do { _Pragma("unroll") for (int j_ = 0; j_ < 2; ++j_) pf[k_][2 + j_] = *(const GAS u32x4*)(gb1 + (size_t)(cc_) * gs1 + j_ * 1024); } while (0)
#define HG_LD45(k_, cc_) do { _Pragma("unroll") for (int j_ = 0; j_ < 2; ++j_) pf[k_][4 + j_] = *(const GAS u32x4*)(gb2 + (size_t)(cc_) * gs2 + j_ * gt2); } while (0)
#define HG_LD6(k_, cc_) do { pf[k_][6] = *(const GAS u32x4*)(gb3 + (size_t)(cc_) * gs3); } while (0)
#pragma unroll
    for (int k = 0; k < HG_PD; ++k) { HG_LD01(k, k); HG_LD23(k, k); HG_LD45(k, k); __builtin_amdgcn_sched_barrier(0); HG_LD6((k + 1) % HG_PD, (k + 1 < HG_PD ? k + 1 : HG_PD)); __builtin_amdgcn_sched_barrier(0); }
    const GAS unsigned char* pfp; unsigned pfstride;
    { const int tt = (wave * 64 + lane) < 160 ? wave * 64 + lane : 159; const int idx = sl * 10 + (tt >> 4), off = (tt & 15) * 64;
      pfp = (idx < 8 ? ws + WS_ATT + (size_t)(p * 128) * 8192 + idx * 1024 : idx < 24 ? ws + WS_QTG + (size_t)(p * 128) * 16384 + (idx - 8) * 1024 : ws + WS_KENDT + (size_t)(p * 128) * 16384 + (idx - 24) * 1024) + off;
      pfstride = idx < 8 ? 8192u : 16384u; }
    unsigned pfv[HG_PD];
#pragma unroll
    for (int k = 0; k < HG_PD; ++k) pfv[k] = 0u;
#define HG_STAGE(dst_, iv_) do { LAS unsigned char* d0_ = (dst_) + (ipart * 8) * IP + is * 2; \
        *(LAS bf16_t*)(d0_ + 0 * IP) = (bf16_t)((iv_).x & 0xffffu); *(LAS bf16_t*)(d0_ + 1 * IP) = (bf16_t)((iv_).x >> 16); \
        *(LAS bf16_t*)(d0_ + 2 * IP) = (bf16_t)((iv_).y & 0xffffu); *(LAS bf16_t*)(d0_ + 3 * IP) = (bf16_t)((iv_).y >> 16); \
        *(LAS bf16_t*)(d0_ + 4 * IP) = (bf16_t)((iv_).z & 0xffffu); *(LAS bf16_t*)(d0_ + 5 * IP) = (bf16_t)((iv_).z >> 16); \
        *(LAS bf16_t*)(d0_ + 6 * IP) = (bf16_t)((iv_).w & 0xffffu); *(LAS bf16_t*)(d0_ + 7 * IP) = (bf16_t)((iv_).w >> 16); } while (0)
    if (outw) { const u32x4 iv = *(const GAS u32x4*)Ig0; HG_STAGE(IT, iv); }
#pragma unroll 1
    for (int c0 = 0; c0 < 128; c0 += HG_PD) {
#pragma unroll
      for (int k = 0; k < HG_PD; ++k) {
        const int c = c0 + k;
        const int tl0 = bl * SEQ + c * 64;
        const int cn = (c + HG_PD < 128) ? c + HG_PD : 127;
        LAS unsigned char* it_ = IT + (k & 1) * ITB; LAS unsigned char* itn = IT + ((k + 1) & 1) * ITB; LAS unsigned char* st_ = ST + (k & 1) * STB; LAS unsigned char* stn = ST + ((k + 1) & 1) * STB;
        LDS_BAR();
        if (wave < 3) { asm volatile("" :: "v"(pfv[k])); const int c7 = (c + HG_PD + 3 < 128) ? c + HG_PD + 3 : 127; pfv[k] = *(const GAS unsigned*)(pfp + (size_t)c7 * pfstride); }
        bf16x8 itf[2][2];
#pragma unroll
        for (int vt = 0; vt < 2; ++vt)
#pragma unroll
            for (int ks = 0; ks < 2; ++ks) itf[vt][ks] = lfrag(it_, IP, vt * 16 + fr, ks * 32, fq);
        bf16x8 sf[2][4];
        f32x4 acc[2];
        acc[0] = (f32x4){0.f, 0.f, 0.f, 0.f}; acc[1] = acc[0];
        if (outw) {
#pragma unroll
            for (int vt = 0; vt < 2; ++vt)
#pragma unroll
                for (int ks = 0; ks < 4; ++ks) sf[vt][ks] = lfrag(st_, PS_PITCH, vt * 16 + fr, ks * 32, fq);
#pragma unroll
            for (int ks = 0; ks < 2; ++ks)
#pragma unroll
                for (int vt = 0; vt < 2; ++vt) acc[vt] = MFMA16(itf[vt][ks], __builtin_bit_cast(bf16x8, pf[k][ks]), acc[vt]);
        } else {
            const f32x4 dec = __builtin_bit_cast(f32x4, pf[k][4]);
#pragma unroll
            for (int vt = 0; vt < 2; ++vt) { st[0][vt] = st[0][vt] * dec;
#pragma unroll
                for (int ks = 0; ks < 2; ++ks) st[0][vt] = MFMA16(__builtin_bit_cast(bf16x8, pf[k][ks]), itf[vt][ks], st[0][vt]); }
        }
        __builtin_amdgcn_sched_barrier(0);
        HG_LD01(k, cn);
        __builtin_amdgcn_sched_barrier(0);
        if (outw) {
#pragma unroll
            for (int ks = 0; ks < 2; ++ks)
#pragma unroll
                for (int vt = 0; vt < 2; ++vt) acc[vt] = MFMA16(sf[vt][ks], __builtin_bit_cast(bf16x8, pf[k][2 + ks]), acc[vt]);
        } else {
            const f32x4 dec = __builtin_bit_cast(f32x4, pf[k][5]);
#pragma unroll
            for (int vt = 0; vt < 2; ++vt) { st[1][vt] = st[1][vt] * dec;
#pragma unroll
                for (int ks = 0; ks < 2; ++ks) st[1][vt] = MFMA16(__builtin_bit_cast(bf16x8, pf[k][2 + ks]), itf[vt][ks], st[1][vt]); }
        }
        __builtin_amdgcn_sched_barrier(0);
        HG_LD23(k, cn);
        __builtin_amdgcn_sched_barrier(0);
        if (outw) {
#pragma unroll
            for (int ks = 2; ks < 4; ++ks)
#pragma unroll
                for (int vt = 0; vt < 2; ++vt) acc[vt] = MFMA16(sf[vt][ks], __builtin_bit_cast(bf16x8, pf[k][2 + ks]), acc[vt]);
        } else {
#pragma unroll
            for (int dtile = 0; dtile < 2; ++dtile)
#pragma unroll
                for (int vt = 0; vt < 2; ++vt) { u32x2 o; o.x = pk2(st[dtile][vt][0], st[dtile][vt][1]); o.y = pk2(st[dtile][vt][2], st[dtile][vt][3]);
                    *(LAS u32x2*)(stn + (vt * 16 + fr) * PS_PITCH + (w4 * 32 + dtile * 16 + 4 * fq) * 2) = o; }
        }
        __builtin_amdgcn_sched_barrier(0);
        HG_LD45(k, cn);
        __builtin_amdgcn_sched_barrier(0);
        if (outw) {
            HG_STAGE(itn, pf[(k + 1) % HG_PD][6]);
            GAS bf16_t* og = (GAS bf16_t*)(ws + WS_GQ) + (size_t)(tl0 + w4 * 16 + fr) * 1024 + vcol + 4 * fq;
#pragma unroll
            for (int vt = 0; vt < 2; ++vt) { u32x2 o; o.x = pk2(acc[vt][0], acc[vt][1]); o.y = pk2(acc[vt][2], acc[vt][3]); *(GAS u32x2*)(og + vt * 16) = o; }
        }
        __builtin_amdgcn_sched_barrier(0);
        { const int cni = (c + 1 + HG_PD < 128) ? c + 1 + HG_PD : 127; HG_LD6((k + 1) % HG_PD, cni); }
        __builtin_amdgcn_sched_barrier(0);
      }
    }
#pragma unroll
    for (int k = 0; k < HG_PD; ++k) asm volatile("" :: "v"(pfv[k]));
    __syncthreads();
#undef HG_LD01
#undef HG_LD23
#undef HG_LD45
#undef HG_LD6
#undef HG_STAGE
}

__device__ __forceinline__ void xn8_convert(const DArgs& a, int round, int vcu, int G) {
    const int tid = tid_(), lane = tid & 63, wave = tid >> 6;
    const int gw = vcu * NWAVES + wave, NGW = G * NWAVES;
    GAS unsigned char* ws = a.ws;
    for (int tl = gw; tl < RT; tl += NGW) {
        const size_t tg = (size_t)round * RT + tl;
        const GAS u32x2* xr = (const GAS u32x2*)((const GAS bf16_t*)(ws + WS_XN) + tg * D) + lane;
        f32x4 v[4]; float mx = 0.f;
#pragma unroll
        for (int j = 0; j < 4; ++j) { const u32x2 xv = xr[64 * j]; v[j][0] = bf_lo(xv.x); v[j][1] = bf_hi(xv.x); v[j][2] = bf_lo(xv.y); v[j][3] = bf_hi(xv.y);
            mx = fmaxf(mx, fmaxf(fmaxf(fabsf(v[j][0]), fabsf(v[j][1])), fmaxf(fabsf(v[j][2]), fabsf(v[j][3])))); }
        mx = wave_max(mx);
        const float qs = mx > 0.f ? 127.0f / mx : 0.f;
#pragma unroll
        for (int j = 0; j < 4; ++j) ((GAS unsigned*)(ws + WS_XN8 + (size_t)tl * 1024))[64 * j + lane] = pack_i8x4(v[j][0] * qs, v[j][1] * qs, v[j][2] * qs, v[j][3] * qs);
        if (lane == 0) ((GAS float*)(ws + WS_SA8))[tg] = mx * (1.0f / 127.0f);
    }
}

__device__ __forceinline__ void phase_ypass(const DArgs& a, int round, int vcu, int G) {
    const int tid = tid_(), lane = tid & 63, wave = tid >> 6;
    const int gw = vcu * NWAVES + wave, NGW = G * NWAVES;
    GAS unsigned char* ws = a.ws;
    f32x4 mg0[4], mg1[4], gg4[4];
#pragma unroll
    for (int j = 0; j < 4; ++j) { mg0[j] = *(const GAS f32x4*)(a.m_head_g + j * 512 + lane * 8); mg1[j] = *(const GAS f32x4*)(a.m_head_g + j * 512 + lane * 8 + 4); gg4[j] = *(const GAS f32x4*)(a.g_head_g + lane * 16 + 4 * j); }
    for (int tl = gw; tl < RT; tl += NGW) {
        const size_t tg = (size_t)round * RT + tl;
        const f32x4 den4 = *(const f32x4*)((const float*)(ws + WS_DEN) + tg * 4), mt4 = *(const f32x4*)((const float*)(ws + WS_MT) + tg * 4);
        float ym[4][8];
#pragma unroll
        for (int j = 0; j < 4; ++j) {
            const int col = j * 512 + lane * 8;
            const u32x4 nv = *(const u32x4*)((const bf16_t*)(ws + WS_QKPRE) + (size_t)tl * 2048 + col);
            const u32x4 ov = *(const u32x4*)((const bf16_t*)(ws + WS_SIGO) + (size_t)tl * 2048 + col);
            const float inv = 1.0f / fmaxf(fabsf(den4[j]), __expf(-mt4[j]));
            float hv[8] = {bf_lo(nv.x) * inv, bf_hi(nv.x) * inv, bf_lo(nv.y) * inv, bf_hi(nv.y) * inv, bf_lo(nv.z) * inv, bf_hi(nv.z) * inv, bf_lo(nv.w) * inv, bf_hi(nv.w) * inv};
            float ss = 0.f;
#pragma unroll
            for (int e = 0; e < 8; ++e) ss += hv[e] * hv[e];
            const float r = rsqrtf(wave_sum(ss, lane) * (1.f / 512.f) + EPS);
            const f32x4 g0 = mg0[j], g1 = mg1[j];
            const float og[8] = {bf_lo(ov.x), bf_hi(ov.x), bf_lo(ov.y), bf_hi(ov.y), bf_lo(ov.z), bf_hi(ov.z), bf_lo(ov.w), bf_hi(ov.w)};
#pragma unroll
            for (int e = 0; e < 8; ++e) ym[j][e] = og[e] * hv[e] * r * (e < 4 ? g0[e] : g1[e - 4]);
        }
        {
            float mx = 0.f;
#pragma unroll
            for (int j = 0; j < 4; ++j)
#pragma unroll
                for (int e = 0; e < 8; ++e) mx = fmaxf(mx, fabsf(ym[j][e]));
            mx = wave_max(mx);
            const float qs = mx > 0.f ? 127.0f / mx : 0.f;
#pragma unroll
            for (int j = 0; j < 4; ++j) { u32x2 o; o.x = pack_i8x4(ym[j][0] * qs, ym[j][1] * qs, ym[j][2] * qs, ym[j][3] * qs); o.y = pack_i8x4(ym[j][4] * qs, ym[j][5] * qs, ym[j][6] * qs, ym[j][7] * qs);
                *(GAS u32x2*)(ws + WS_V + (size_t)tl * 2048 + j * 512 + lane * 8) = o; }
            if (lane == 0) ((GAS float*)(ws + WS_SYM))[tl] = mx * (1.0f / 127.0f);
        }
        {
            const int col = lane * 16;
            const u32x4 n0 = *(const u32x4*)((const bf16_t*)(ws + WS_GQ) + (size_t)tl * 1024 + col), n1 = *(const u32x4*)((const bf16_t*)(ws + WS_GQ) + (size_t)tl * 1024 + col + 8);
            const u32x4 s0 = *(const u32x4*)((const bf16_t*)(ws + WS_SGG) + (size_t)tl * 1024 + col), s1 = *(const u32x4*)((const bf16_t*)(ws + WS_SGG) + (size_t)tl * 1024 + col + 8);
            float ov[16] = {bf_lo(n0.x), bf_hi(n0.x), bf_lo(n0.y), bf_hi(n0.y), bf_lo(n0.z), bf_hi(n0.z), bf_lo(n0.w), bf_hi(n0.w), bf_lo(n1.x), bf_hi(n1.x), bf_lo(n1.y), bf_hi(n1.y), bf_lo(n1.z), bf_hi(n1.z), bf_lo(n1.w), bf_hi(n1.w)};
            const float sg[16] = {bf_lo(s0.x), bf_hi(s0.x), bf_lo(s0.y), bf_hi(s0.y), bf_lo(s0.z), bf_hi(s0.z), bf_lo(s0.w), bf_hi(s0.w), bf_lo(s1.x), bf_hi(s1.x), bf_lo(s1.y), bf_hi(s1.y), bf_lo(s1.z), bf_hi(s1.z), bf_lo(s1.w), bf_hi(s1.w)};
            float ss = 0.f;
#pragma unroll
            for (int e = 0; e < 16; ++e) ss += ov[e] * ov[e];
            ss += DPP_(ss, 0xB1); ss += DPP_(ss, 0x4E); ss += DPP_(ss, 0x141);
            const float r = rsqrtf(ss * (1.f / 128.f) + EPS);
            float y[16];
#pragma unroll
            for (int e = 0; e < 16; ++e) y[e] = ov[e] * r * gg4[e >> 2][e & 3] * sg[e];
            float mx = 0.f;
#pragma unroll
            for (int e = 0; e < 16; ++e) mx = fmaxf(mx, fabsf(y[e]));
            mx = wave_max(mx);
            const float qs = mx > 0.f ? 127.0f / mx : 0.f;
            u32x4 o; o.x = pack_i8x4(y[0] * qs, y[1] * qs, y[2] * qs, y[3] * qs); o.y = pack_i8x4(y[4] * qs, y[5] * qs, y[6] * qs, y[7] * qs);
            o.z = pack_i8x4(y[8] * qs, y[9] * qs, y[10] * qs, y[11] * qs); o.w = pack_i8x4(y[12] * qs, y[13] * qs, y[14] * qs, y[15] * qs);
            *(GAS u32x4*)(ws + WS_GI + (size_t)tl * 1024 + col) = o;
            if (lane == 0) ((GAS float*)(ws + WS_SYG))[tl] = mx * (1.0f / 127.0f);
        }
    }
}


#define XB_TMO      128
#define XB_XCNT(j)  (256  + 64 * (j))
#define XB_XSUB(j)  (1280 + 64 * (j))
#define XB_XGEN(j)  (2304 + 64 * (j))
#define XB_TOP      3328
#define XB_TOPGEN   3392
#define XB_SPIN_CAP (1u << 22)
constexpr int CW_BAR = 4096;
constexpr int LDS_BARST = LDS_BYTES - 64;
__device__ __forceinline__ unsigned xb_ld(unsigned* p)              { return __hip_atomic_load(p, __ATOMIC_RELAXED, __HIP_MEMORY_SCOPE_AGENT); }
__device__ __forceinline__ unsigned xb_add(unsigned* p, unsigned v) { return __hip_atomic_fetch_add(p, v, __ATOMIC_RELAXED, __HIP_MEMORY_SCOPE_AGENT); }
__device__ __forceinline__ unsigned xb_xcc_id() { return (unsigned)__builtin_amdgcn_s_getreg((3 << 11) | 20) & 0xFu; }
#define XB_SPIN(cond, bar) do { unsigned _sp = 0; while (cond) { __builtin_amdgcn_s_sleep(1); \
    if ((++_sp & 255u) == 0u) { if (xb_ld(&(bar)[XB_TMO])) break; if (_sp > XB_SPIN_CAP) { atomicAdd(&(bar)[XB_TMO], 1u); break; } } } } while (0)
__device__ __forceinline__ void xcd_barrier_post(unsigned* bar, volatile LAS unsigned* st) { if (tid_() == 0) st[2] = xb_add(&bar[XB_XCNT(xb_xcc_id())], 1u); }
__device__ __forceinline__ void xcd_barrier_complete(unsigned* bar, unsigned x, unsigned& nloc, unsigned& nx) {
    const unsigned G = gridDim.x;
    unsigned sum, cnt, mine, sp = 0u;
    for (;;) {
        sum = 0u; cnt = 0u; mine = 0u;
#pragma unroll
        for (unsigned j = 0; j < 16; ++j) { const unsigned c = xb_ld(&bar[XB_XCNT(j)]); sum += c; cnt += (c > 0u) ? 1u : 0u; mine = (j == x) ? c : mine; }
        if (sum == G) break;
        __builtin_amdgcn_s_sleep(1);
        if ((++sp & 255u) == 0u) { if (xb_ld(&bar[XB_TMO])) break; if (sp > XB_SPIN_CAP) { atomicAdd(&bar[XB_TMO], 1u); break; } }
    }
    nloc = mine > 0u ? mine : 1u; nx = cnt > 0u ? cnt : 1u;
}
__device__ __forceinline__ void xcd_barrier(unsigned* bar, volatile LAS unsigned* st) {
    asm volatile("s_waitcnt vmcnt(0)" ::: "memory");
    __syncthreads();
    if (tid_() == 0) {
        const unsigned x = xb_xcc_id();
        __builtin_amdgcn_s_waitcnt(0);
        unsigned nloc = st[0], nx = st[1];
        if (nloc == 0u) { xcd_barrier_complete(bar, x, nloc, nx); st[0] = nloc; st[1] = nx; }
        const unsigned old = xb_add(&bar[XB_XSUB(x)], 1u);
        const unsigned gen = old / nloc;
        if (old + 1u == (gen + 1u) * nloc) {
            __builtin_amdgcn_fence(__ATOMIC_RELEASE, "agent");
            asm volatile("s_waitcnt vmcnt(0)" ::: "memory");
            const unsigned og = xb_add(&bar[XB_TOP], 1u);
            const unsigned tg = og / nx;
            if (og + 1u == (tg + 1u) * nx) xb_add(&bar[XB_TOPGEN], 1u);
            else XB_SPIN(xb_ld(&bar[XB_TOPGEN]) == tg, bar);
            __builtin_amdgcn_fence(__ATOMIC_ACQUIRE, "agent");
            xb_add(&bar[XB_XGEN(x)], 1u);
            asm volatile("s_waitcnt vmcnt(0)" ::: "memory");
        } else {
            XB_SPIN(xb_ld(&bar[XB_XGEN(x)]) == gen, bar);
            __builtin_amdgcn_fence(__ATOMIC_ACQUIRE, "agent");
            asm volatile("s_waitcnt vmcnt(0)" ::: "memory");
        }
    }
    __syncthreads();
}

__device__ __forceinline__ void phase_p8(const DArgs& a, int vcu, int G) {
    const int tid = tid_(), lane = tid & 63, wave = tid >> 6;
    const int gw = vcu * NWAVES + wave, NGW = G * NWAVES;
    GAS unsigned char* ws = a.ws;
    f32x4 g2[4];
#pragma unroll
    for (int j = 0; j < 4; ++j) g2[j] = ((const f32x4*)a.norm2_g)[64 * j + lane];
    for (int m = gw; m < T; m += NGW) {
        const GAS u32x2* xr = (const GAS u32x2*)((const GAS bf16_t*)a.out + (size_t)m * D) + lane;
        f32x4 v[4]; float s = 0.f;
#pragma unroll
        for (int j = 0; j < 4; ++j) { const u32x2 xv = xr[64 * j]; v[j][0] = bf_lo(xv.x); v[j][1] = bf_hi(xv.x); v[j][2] = bf_lo(xv.y); v[j][3] = bf_hi(xv.y); s += (v[j][0] * v[j][0] + v[j][1] * v[j][1]) + (v[j][2] * v[j][2] + v[j][3] * v[j][3]); }
        const float rstd = rsqrtf(wave_sum(s, lane) * (1.f / D) + EPS);
#pragma unroll
        for (int j = 0; j < 4; ++j) v[j] = v[j] * rstd * g2[j];
        float mx = 0.f;
#pragma unroll
        for (int j = 0; j < 4; ++j) mx = fmaxf(mx, fmaxf(fmaxf(fabsf(v[j][0]), fabsf(v[j][1])), fmaxf(fabsf(v[j][2]), fabsf(v[j][3]))));
        mx = wave_max(mx);
        const float qs = mx > 0.f ? 127.0f / mx : 0.f;
#pragma unroll
        for (int j = 0; j < 4; ++j) ((GAS unsigned*)(ws + WS_XQ + (size_t)m * 1024))[64 * j + lane] = pack_i8x4(v[j][0] * qs, v[j][1] * qs, v[j][2] * qs, v[j][3] * qs);
        if (lane == 0) ((GAS float*)(ws + WS_XQS))[m] = mx * (1.0f / 127.0f);
    }
    for (int e = gw; e < 16384; e += NGW) {
        f32x4 uv[4], vv[4]; float mu = 0.f, mv = 0.f;
#pragma unroll
        for (int j = 0; j < 4; ++j) { uv[j] = ((const GAS f32x4*)(a.u_emb + (size_t)e * 1024))[64 * j + lane]; vv[j] = ((const GAS f32x4*)(a.v_emb + (size_t)e * 1024))[64 * j + lane];
            mu = fmaxf(mu, fmaxf(fmaxf(fabsf(uv[j][0]), fabsf(uv[j][1])), fmaxf(fabsf(uv[j][2]), fabsf(uv[j][3]))));
            mv = fmaxf(mv, fmaxf(fmaxf(fabsf(vv[j][0]), fabsf(vv[j][1])), fmaxf(fabsf(vv[j][2]), fabsf(vv[j][3])))); }
        mu = wave_max(mu); mv = wave_max(mv);
        const float su = mu > 0.f ? 127.0f / mu : 0.f, sv = mv > 0.f ? 448.0f / mv : 0.f;
        if (lane == 0) { ((GAS float*)(ws + WS_USC))[e] = mu * (1.0f / 127.0f); ((GAS float*)(ws + WS_VSC))[e] = mv * (1.0f / 448.0f); }
#pragma unroll
        for (int j = 0; j < 4; ++j) {
            const size_t ob = (size_t)(2 * j + (lane >> 5)) * 2097152 + (size_t)e * 128 + ((4 * lane) & 127);
            *(GAS unsigned*)(ws + WS_UB + ob) = pack_i8x4(uv[j][0] * su, uv[j][1] * su, uv[j][2] * su, uv[j][3] * su);
            int p = __builtin_amdgcn_cvt_pk_fp8_f32(vv[j][0] * sv, vv[j][1] * sv, 0, false); p = __builtin_amdgcn_cvt_pk_fp8_f32(vv[j][2] * sv, vv[j][3] * sv, p, true);
            *(GAS unsigned*)(ws + WS_VB + ob) = (unsigned)p; }
    }
}

__device__ __forceinline__ unsigned f2ord(float f) { const unsigned u = __builtin_bit_cast(unsigned, f); return (u & 0x80000000u) ? ~u : (u | 0x80000000u); }
__device__ __forceinline__ float ord2f(unsigned k) { const unsigned u = (k & 0x80000000u) ? (k & 0x7fffffffu) : ~k; return __builtin_bit_cast(float, u); }
__device__ __forceinline__ unsigned umax_(unsigned a, unsigned b) { return a > b ? a : b; }
__device__ __forceinline__ unsigned shxu(unsigned v, int o, int lane) { return (unsigned)__builtin_amdgcn_ds_bpermute((lane ^ o) << 2, (int)v); }

__device__ __forceinline__ unsigned umin_(unsigned a, unsigned b) { return a < b ? a : b; }
#define TK_CE(a_, b_) do { const unsigned hi_ = umax_((a_), (b_)), lo_ = umin_((a_), (b_)); (a_) = hi_; (b_) = lo_; } while (0)
__device__ __forceinline__ void tk_sort16(unsigned (&x)[32], int o) {
#pragma unroll
    for (int k = 2; k <= 16; k <<= 1)
#pragma unroll
        for (int j = k >> 1; j > 0; j >>= 1)
#pragma unroll
            for (int i = 0; i < 16; ++i) { const int l = i ^ j; if (l > i) { if ((i & k) == 0) TK_CE(x[o + i], x[o + l]); else TK_CE(x[o + l], x[o + i]); } }
}
__device__ __forceinline__ void tk_merge16(unsigned (&t)[16]) {
#pragma unroll
    for (int j = 8; j > 0; j >>= 1)
#pragma unroll
        for (int i = 0; i < 16; ++i) { const int l = i ^ j; if (l > i) TK_CE(t[i], t[l]); }
}
__device__ __forceinline__ void phase_topk(const DArgs& a, LAS unsigned char* lds, int bx, int G) {
    const int tid = tid_(), lane = tid & 63, wave = __builtin_amdgcn_readfirstlane(tid >> 6), fr = lane & 15, fq = lane >> 4;
    GAS unsigned char* ws = a.ws;
    const int h = bx & 7;
    LAS unsigned char* KY = lds;
    LAS unsigned char* QL = lds + 2 * 128 * PS_PITCH;
    LAS unsigned* TOP = (LAS unsigned*)(lds + 2 * 128 * PS_PITCH + 64 * PQ_PITCH);
#pragma unroll
    for (int i = 0; i < 8; ++i) { const int idx = tid + 512 * i, row = idx >> 4, ch = idx & 15;
        *(LAS u32x4*)(KY + row * PS_PITCH + ch * 16) = *(const u32x4*)((const bf16_t*)(ws + WS_SK) + ((size_t)h * 256 + row) * 128 + ch * 8); }
    const int ntile = T / 64;
    u32x4 qpre[4];
    { const int tile0 = bx >> 3; if (tile0 < ntile) {
#pragma unroll
        for (int i = 0; i < 4; ++i) { const int idx = tid + 512 * i, row = idx >> 5, ch = idx & 31;
            qpre[i] = *(const GAS u32x4*)((const GAS bf16_t*)(ws + WS_QP) + ((size_t)tile0 * 64 + row) * 2048 + h * 256 + ch * 8); } } }
    __syncthreads();
    for (int tile = bx >> 3; tile < ntile; tile += (G >> 3)) {
        const size_t t0 = (size_t)tile * 64;
        LDS_BAR();
#pragma unroll
        for (int i = 0; i < 4; ++i) { const int idx = tid + 512 * i, row = idx >> 5, ch = idx & 31;
            *(LAS u32x4*)(QL + row * PQ_PITCH + ch * 16) = qpre[i]; }
        { const int tn = tile + (G >> 3); if (tn < ntile) {
#pragma unroll
            for (int i = 0; i < 4; ++i) { const int idx = tid + 512 * i, row = idx >> 5, ch = idx & 31;
                qpre[i] = *(const GAS u32x4*)((const GAS bf16_t*)(ws + WS_QP) + ((size_t)tn * 64 + row) * 2048 + h * 256 + ch * 8); } } }
        LDS_BAR();
        {
            const int mt = wave & 3, p = wave >> 2;
            unsigned key[32];
#pragma unroll
            for (int nt = 0; nt < 8; ++nt) { f32x4 acc = (f32x4){0.f, 0.f, 0.f, 0.f};
#pragma unroll
                for (int ks = 0; ks < 4; ++ks) acc = MFMA16(lfrag(KY + p * 128 * PS_PITCH, PS_PITCH, nt * 16 + fr, ks * 32, fq), lfrag(QL, PQ_PITCH, mt * 16 + fr, p * 128 + ks * 32, fq), acc);
#pragma unroll
                for (int j = 0; j < 4; ++j) { const int n = nt * 16 + 4 * fq + j; key[nt * 4 + j] = (f2ord(acc[j]) & ~127u) | (unsigned)(127 - n); } }
            tk_sort16(key, 0); tk_sort16(key, 16);
            unsigned t[16];
#pragma unroll
            for (int i = 0; i < 16; ++i) t[i] = umax_(key[i], key[31 - i]);
            tk_merge16(t);
            {   unsigned pv[16];
#pragma unroll
                for (int i = 0; i < 16; ++i) pv[i] = (unsigned)SWZI_(t[15 - i], 0x401F);
#pragma unroll
                for (int i = 0; i < 16; ++i) t[i] = umax_(t[i], pv[i]);
                tk_merge16(t);
#pragma unroll
                for (int i = 0; i < 16; ++i) pv[i] = xor32u_(t[15 - i], lane >= 32);
#pragma unroll
                for (int i = 0; i < 16; ++i) t[i] = umax_(t[i], pv[i]);
                tk_merge16(t); }
#pragma unroll
            for (int k = 0; k < 16; ++k) { if (fq == (k & 3)) TOP[(p * 64 + mt * 16 + fr) * 16 + k] = t[k]; }
        }
        LDS_BAR();
        {
            const int t = tid >> 3, sub = tid & 7;
            unsigned ck[7];
#pragma unroll
            for (int e = 0; e < 7; ++e) {
                const int ci = sub + 8 * e;
                int i = 0, base = 0; bool ok = ci < 50;
                if (ci >= 42) { i = 8 + (ci - 42); base = ci; } else if (ci >= 40) { i = 7; base = 40; } else if (ci >= 38) { i = 6; base = 38; } else if (ci >= 36) { i = 5; base = 36; }
                else if (ci >= 33) { i = 4; base = 33; } else if (ci >= 29) { i = 3; base = 29; } else if (ci >= 24) { i = 2; base = 24; } else if (ci >= 16) { i = 1; base = 16; }
                const int j = ci - base;
                unsigned kk = 0u;
                if (ok) { const float s0 = ord2f(TOP[(0 * 64 + t) * 16 + i] & ~127u), s1 = ord2f(TOP[(1 * 64 + t) * 16 + j] & ~127u);
                    kk = (f2ord(s0 + s1) & ~255u) | (unsigned)(255 - (i * 16 + j)); }
                ck[e] = kk;
            }
            unsigned x[16];
#pragma unroll
            for (int e = 0; e < 7; ++e) x[e] = ck[e];
            x[7] = 0u;
#pragma unroll
            for (int k = 2; k <= 8; k <<= 1)
#pragma unroll
                for (int j = k >> 1; j > 0; j >>= 1)
#pragma unroll
                    for (int i = 0; i < 8; ++i) { const int l = i ^ j; if (l > i) { if ((i & k) == 0) TK_CE(x[i], x[l]); else TK_CE(x[l], x[i]); } }
#pragma unroll
            for (int i = 0; i < 8; ++i) x[8 + i] = (unsigned)DPPI_(x[7 - i], 0xB1);
            tk_merge16(x);
            {   unsigned pv[16];
#pragma unroll
                for (int i = 0; i < 16; ++i) pv[i] = (unsigned)DPPI_(x[15 - i], 0x4E);
#pragma unroll
                for (int i = 0; i < 16; ++i) x[i] = umax_(x[i], pv[i]);
                tk_merge16(x);
#pragma unroll
                for (int i = 0; i < 16; ++i) pv[i] = (unsigned)DPPI_(x[15 - i], 0x141);
#pragma unroll
                for (int i = 0; i < 16; ++i) x[i] = umax_(x[i], pv[i]);
                tk_merge16(x); }
            unsigned w0 = x[0], w1 = x[8];
#pragma unroll
            for (int e = 1; e < 8; ++e) { w0 = (sub == e) ? x[e] : w0; w1 = (sub == e) ? x[8 + e] : w1; }
            const int f0 = 255 - (int)(w0 & 255u), f1 = 255 - (int)(w1 & 255u);
            const float sc0 = ord2f(w0 & ~255u), sc1 = ord2f(w1 & ~255u);
            float mx = fmaxf(sc0, sc1); mx = fmaxf(mx, DPP_(mx, 0xB1)); mx = fmaxf(mx, DPP_(mx, 0x4E)); mx = fmaxf(mx, DPP_(mx, 0x141));
            const float e0 = __expf(sc0 - mx), e1 = __expf(sc1 - mx);
            float sm = e0 + e1; sm += DPP_(sm, 0xB1); sm += DPP_(sm, 0x4E); sm += DPP_(sm, 0x141);
            const float inv = 1.0f / sm;
            const int i0 = 127 - (int)(TOP[(0 * 64 + t) * 16 + (f0 >> 4)] & 127u), j0 = 127 - (int)(TOP[(1 * 64 + t) * 16 + (f0 & 15)] & 127u);
            const int i1 = 127 - (int)(TOP[(0 * 64 + t) * 16 + (f1 >> 4)] & 127u), j1 = 127 - (int)(TOP[(1 * 64 + t) * 16 + (f1 & 15)] & 127u);
            unsigned short* ei = (unsigned short*)(ws + WS_EIDX) + ((t0 + t) * 8 + h) * 16; float* gp = (float*)(ws + WS_GATE) + ((t0 + t) * 8 + h) * 16;
            ei[sub] = (unsigned short)(i0 * 128 + j0); ei[sub + 8] = (unsigned short)(i1 * 128 + j1); gp[sub] = e0 * inv; gp[sub + 8] = e1 * inv;
        }
    }
    __syncthreads();
}

__device__ __forceinline__ void ins16(float (&v)[16], int (&id)[16], float x, int n) {
    if (x > v[15]) { v[15] = x; id[15] = n;
#pragma unroll
        for (int i = 15; i >= 1; --i) { if (v[i] > v[i - 1]) { const float tv = v[i]; v[i] = v[i - 1]; v[i - 1] = tv; const int ti = id[i]; id[i] = id[i - 1]; id[i - 1] = ti; } } }
}
__device__ __forceinline__ void phase_topk_ref(const DArgs& a, int vcu, int G) {
    const int tid = tid_();
    GAS unsigned char* ws = a.ws;
    const int gt = vcu * NTHR + tid, NGT = G * NTHR;
    for (int pair = gt; pair < T * 8; pair += NGT) {
        const int t = pair >> 3, h = pair & 7;
        float sv[2][16]; int si[2][16];
#pragma unroll
        for (int p = 0; p < 2; ++p) {
#pragma unroll
            for (int i = 0; i < 16; ++i) { sv[p][i] = -INFINITY; si[p][i] = 0; }
            const bf16_t* qp = (const bf16_t*)(ws + WS_QP) + (size_t)t * 2048 + h * 256 + p * 128;
            for (int n = 0; n < 128; ++n) {
                const bf16_t* kp = (const bf16_t*)(ws + WS_SK) + ((size_t)(h * 2 + p) * 128 + n) * 128;
                float s = 0.f;
                for (int c = 0; c < 128; c += 8) { const u32x4 qv = *(const u32x4*)(qp + c), kv = *(const u32x4*)(kp + c);
                    s += bf_lo(qv.x) * bf_lo(kv.x) + bf_hi(qv.x) * bf_hi(kv.x) + bf_lo(qv.y) * bf_lo(kv.y) + bf_hi(qv.y) * bf_hi(kv.y)
                       + bf_lo(qv.z) * bf_lo(kv.z) + bf_hi(qv.z) * bf_hi(kv.z) + bf_lo(qv.w) * bf_lo(kv.w) + bf_hi(qv.w) * bf_hi(kv.w); }
                ins16(sv[p], si[p], s, n);
            }
        }
        float tv[16]; int ti[16];
#pragma unroll
        for (int i = 0; i < 16; ++i) { tv[i] = -INFINITY; ti[i] = 0; }
#pragma unroll
        for (int i = 0; i < 16; ++i)
#pragma unroll
            for (int j = 0; j < 16; ++j) ins16(tv, ti, sv[0][i] + sv[1][j], i * 16 + j);
        float sm = 0.f, ex[16];
#pragma unroll
        for (int k = 0; k < 16; ++k) { ex[k] = __expf(tv[k] - tv[0]); sm += ex[k]; }
        int* ei = (int*)(ws + WS_EIDX) + (size_t)pair * 16; float* gp = (float*)(ws + WS_GATE) + (size_t)pair * 16;
#pragma unroll
        for (int k = 0; k < 16; ++k) {
            int e0 = 0, e1 = 0;
#pragma unroll
            for (int i = 0; i < 16; ++i) { e0 = ((ti[k] >> 4) == i) ? si[0][i] : e0; e1 = ((ti[k] & 15) == i) ? si[1][i] : e1; }
            ei[k] = e0 * 128 + e1; gp[k] = ex[k] / sm; }
    }
}

#define FP8LO(w) __builtin_amdgcn_cvt_pk_f32_fp8((int)(w), false)
#define FP8HI(w) __builtin_amdgcn_cvt_pk_f32_fp8((int)(w), true)
__device__ __forceinline__ float dot16_fp8(const u32x4 r, const float (&x)[16]) {
    float c = 0.f;
#pragma unroll
    for (int j = 0; j < 4; ++j) { const f32x2 lo = FP8LO(r[j]), hi = FP8HI(r[j]); c += lo[0] * x[4 * j] + lo[1] * x[4 * j + 1] + hi[0] * x[4 * j + 2] + hi[1] * x[4 * j + 3]; }
    return c;
}
__device__ __forceinline__ float dot16_fp8p(const u32x4 r, const f32x2 (&xp)[8]) {
    f32x2 c2 = (f32x2){0.f, 0.f};
#pragma unroll
    for (int j = 0; j < 4; ++j) { c2 += FP8LO(r[j]) * xp[2 * j]; c2 += FP8HI(r[j]) * xp[2 * j + 1]; }
    return c2[0] + c2[1];
}
__device__ __forceinline__ float gelu_erf(float d) {
    const float ad = fabsf(d), t = __builtin_amdgcn_rcpf(ad * 0.2316418882f + 1.0f);
    float q = t * 0.5307027145f + (-0.7265760135f); q = q * t + 0.7107068705f; q = q * t + (-0.142248368f); q = q * t + 0.127414796f; q = q * t;
    const float m = d * (q * __builtin_amdgcn_exp2f(d * d * (-0.72134752044f)));
    return d < 0.f ? m : d - m;
}
__device__ __forceinline__ float bperm(float v, int srclane) { return __builtin_bit_cast(float, __builtin_amdgcn_ds_bpermute(srclane << 2, __builtin_bit_cast(int, v))); }
#define SWZ_(v, pat) __builtin_bit_cast(float, __builtin_amdgcn_ds_swizzle(__builtin_bit_cast(int, (v)), (pat)))
__device__ __forceinline__ float rs32_(float a, float b) {
#if defined(__HIP_DEVICE_COMPILE__)
    asm volatile("s_nop 1\n\tv_permlane32_swap_b32 %0, %1" : "+v"(a), "+v"(b));
#endif
    return a + b;
}
__device__ __forceinline__ float rs16_(float a, float b) {
#if defined(__HIP_DEVICE_COMPILE__)
    asm volatile("s_nop 1\n\tv_permlane16_swap_b32 %0, %1" : "+v"(a), "+v"(b));
#endif
    return a + b;
}
__device__ __forceinline__ float rs8_(float a, float b, bool bit3) {
    const float send = bit3 ? a : b, keep = bit3 ? b : a;
    return keep + DPP_(send, 0x128);
}
__device__ __forceinline__ float xor32_(float v, bool hi) {
#if defined(__HIP_DEVICE_COMPILE__)
    const auto r = __builtin_amdgcn_permlane32_swap(__builtin_bit_cast(unsigned, v), __builtin_bit_cast(unsigned, v), false, false);
    return __builtin_bit_cast(float, hi ? r[0] : r[1]);
#else
    (void)hi; return v;
#endif
}
__device__ __forceinline__ float reduce8(const float (&p)[8], int lane) {
    float q4[4], q2[2];
    const bool b5 = lane & 32, b4 = lane & 16, b3 = lane & 8;
#pragma unroll
    for (int i = 0; i < 4; ++i) { const float send = b5 ? p[i] : p[i + 4], keep = b5 ? p[i + 4] : p[i]; q4[i] = keep + xor32_(send, b5); }
#pragma unroll
    for (int i = 0; i < 2; ++i) { const float send = b4 ? q4[i] : q4[i + 2], keep = b4 ? q4[i + 2] : q4[i]; q2[i] = keep + SWZ_(send, 0x401F); }
    const float send = b3 ? q2[0] : q2[1], keep = b3 ? q2[1] : q2[0];
    float q1 = keep + SWZ_(send, 0x201F);
    q1 += DPP_(q1, 0xB1); q1 += DPP_(q1, 0x4E); q1 += DPP_(q1, 0x141);
    return q1;
}
__device__ __forceinline__ void phase_udots(const DArgs& a, LAS unsigned char* lds) {
    const int tid = tid_(), lane = tid & 63, wave = __builtin_amdgcn_readfirstlane(tid >> 6);
    GAS unsigned char* ws = a.ws;
    volatile LAS unsigned* bst = (volatile LAS unsigned*)(lds + LDS_BARST);
    const int nloc = (int)bst[0], nx = (int)bst[1], rank = (int)bst[2];
    unsigned* bar = (unsigned*)(ws + WS_CTL) + CW_BAR;
    const unsigned myx = xb_xcc_id();
    int q = 0;
    for (unsigned j = 0; j < 16; ++j) { const unsigned c = xb_ld(&bar[XB_XCNT(j)]); if (c > 0u && j < myx) ++q; }
    LAS int* LE = (LAS int*)(lds + wave * 2048);
    LAS int* LP = LE + 128; LAS float* LG = (LAS float*)(LE + 256);
    const GAS unsigned char* UB = ws + WS_UB;
    const int g8 = lane >> 3;
    const float usc = ((const GAS float*)(ws + WS_USC))[0], vsc = ((const GAS float*)(ws + WS_USC))[1];
    for (int s = q; s < 8; s += nx) {
        int tok = rank * 8 + wave;
        u32x4 xq0 = (u32x4){0u, 0u, 0u, 0u}, xq1 = xq0; u32x2 e2 = (u32x2){0u, 0u}; f32x2 g2 = (f32x2){0.f, 0.f};
#define U_INFO(t_) do { xq0 = *(const u32x4*)((const GAS bf16_t*)(ws + WS_XN) + (size_t)(t_) * D + lane * 16); xq1 = *(const u32x4*)((const GAS bf16_t*)(ws + WS_XN) + (size_t)(t_) * D + lane * 16 + 8); \
        e2 = *(const u32x2*)((const GAS int*)(ws + WS_EIDX) + (size_t)(t_) * 128 + 2 * lane); g2 = *(const f32x2*)((const GAS float*)(ws + WS_GATE) + (size_t)(t_) * 128 + 2 * lane); } while (0)
        if (tok < T) U_INFO(tok);
        for (; tok < T; tok += nloc * 8) {
            const bool in0 = (int)(e2.x >> 11) == s, in1 = (int)(e2.y >> 11) == s;
            const unsigned long long m0 = __ballot(in0), m1 = __ballot(in1);
            const unsigned long long lt = (1ull << lane) - 1ull;
            const int n0 = __popcll(m0), n = n0 + __popcll(m1);
            if (in0) { const int pos = __popcll(m0 & lt); LE[pos] = (int)e2.x; LP[pos] = 2 * lane; LG[pos] = g2[0]; }
            if (in1) { const int pos = n0 + __popcll(m1 & lt); LE[pos] = (int)e2.y; LP[pos] = 2 * lane + 1; LG[pos] = g2[1]; }
            const float xf[16] = {bf_lo(xq0.x), bf_hi(xq0.x), bf_lo(xq0.y), bf_hi(xq0.y), bf_lo(xq0.z), bf_hi(xq0.z), bf_lo(xq0.w), bf_hi(xq0.w),
                                  bf_lo(xq1.x), bf_hi(xq1.x), bf_lo(xq1.y), bf_hi(xq1.y), bf_lo(xq1.z), bf_hi(xq1.z), bf_lo(xq1.w), bf_hi(xq1.w)};
            asm volatile("s_waitcnt lgkmcnt(0)" ::: "memory");
            u32x4 R0[8], R1[8], R2[8];
#define U_ISSUE(R_, g0_) do { _Pragma("unroll") for (int k = 0; k < 8; ++k) { const int slot_ = ((g0_) + k < n) ? (g0_) + k : n - 1; const int e_ = LE[slot_]; R_[k] = *(const u32x4*)(UB + (size_t)e_ * 1024 + lane * 16); } } while (0)
#define U_DOTS(R_, g0_) do { float pp_[8]; _Pragma("unroll") for (int k = 0; k < 8; ++k) pp_[k] = dot16_fp8(R_[k], xf); const float dsum_ = reduce8(pp_, lane); const int slot_ = (g0_) + g8; \
            if (slot_ < n && (lane & 7) == 0) { const float d_ = dsum_ * usc; \
                ((GAS float*)(ws + WS_PW))[(size_t)tok * 128 + LP[slot_]] = 0.5f * d_ * (1.0f + erff(d_ * 0.70710678118654752f)) * LG[slot_] * vsc; } } while (0)
            if (n > 0) U_ISSUE(R0, 0);
            if (n > 8) U_ISSUE(R1, 8);
            if (n > 16) U_ISSUE(R2, 16);
            const int tokN = tok + nloc * 8;
            if (tokN < T) U_INFO(tokN);
            if (n > 0) U_DOTS(R0, 0);
            if (n > 8) U_DOTS(R1, 8);
            if (n > 16) U_DOTS(R2, 16);
            for (int g0 = 24; g0 < n; g0 += 8) { U_ISSUE(R0, g0); U_DOTS(R0, g0); }
            asm volatile("s_waitcnt lgkmcnt(0)" ::: "memory");
        }
#undef U_INFO
#undef U_ISSUE
#undef U_DOTS
    }
}

#define EV_OFF(ev_, g_) (((g_) & 1) ? ((ev_[(g_) >> 3][((g_) >> 1) & 3] >> 9) & 0x7fff80u) : ((ev_[(g_) >> 3][((g_) >> 1) & 3] << 7) & 0x7fff80u))
struct XcdSlice { int nloc, nx, rank, q; };
__device__ __forceinline__ XcdSlice xcd_slice_setup(const DArgs& a, LAS unsigned char* lds) {
    volatile LAS unsigned* bst = (volatile LAS unsigned*)(lds + LDS_BARST);
    XcdSlice x; x.nloc = __builtin_amdgcn_readfirstlane((int)bst[0]); x.nx = __builtin_amdgcn_readfirstlane((int)bst[1]); x.rank = __builtin_amdgcn_readfirstlane((int)bst[2]);
    unsigned* bar = (unsigned*)(a.ws + WS_CTL) + CW_BAR; const unsigned myx = xb_xcc_id();
    x.q = 0; for (unsigned j = 0; j < 16; ++j) { const unsigned c = xb_ld(&bar[XB_XCNT(j)]); if (c > 0u && j < myx) ++x.q; }
    x.q = __builtin_amdgcn_readfirstlane(x.q);
    return x;
}
__device__ __forceinline__ void phase_ua(const DArgs& a, LAS unsigned char* lds) {
    const int tid = tid_(), lane = tid & 63, wave = __builtin_amdgcn_readfirstlane(tid >> 6), k = lane >> 3, c = lane & 7;
    GAS unsigned char* ws = a.ws;
    const XcdSlice X = xcd_slice_setup(a, lds);
    const int tstride = X.nloc * 8;
    for (int sl = X.q; sl < 8; sl += X.nx) {
        const GAS unsigned char* UBs = ws + WS_UB + (size_t)sl * 2097152;
        const unsigned coff = (unsigned)c * 16u;
        GAS unsigned char* PU = ws + WS_PARTU + (size_t)sl * T * 256;
        u32x4 evA[2], evB[2], RA[16], RB[16], xa, xb; float sa, sb;
#define A_TOK(t_) ((t_) < T ? (t_) : T - 1)
#define A_INFO(ev_, t_) do { const int tq_ = A_TOK(t_); _Pragma("unroll") for (int j_ = 0; j_ < 2; ++j_) ev_[j_] = *(const GAS u32x4*)(ws + WS_EIDX + (size_t)tq_ * 256 + (unsigned)(32 * k + 16 * j_)); } while (0)
#define A_ISSUE(R_, x_, s_, ev_, t_) do { const int tq_ = A_TOK(t_); _Pragma("unroll") for (int g_ = 0; g_ < 16; ++g_) R_[g_] = *(const GAS u32x4*)(UBs + (EV_OFF(ev_, g_) | coff)); \
        x_ = *(const GAS u32x4*)(ws + WS_XQ + (size_t)tq_ * 1024 + sl * 128 + coff); s_ = ((const GAS float*)(ws + WS_XQS))[tq_]; } while (0)
#define A_DOTS(R_, x_, s_, t_) do { \
        int ir0_ = 0, ir1_ = 0; \
        _Pragma("unroll") for (int gg_ = 0; gg_ < 4; ++gg_) {           \
            int d_[4]; _Pragma("unroll") for (int q_ = 0; q_ < 4; ++q_) d_[q_] = 0; \
            _Pragma("unroll") for (int j_ = 0; j_ < 4; ++j_) { _Pragma("unroll") for (int q_ = 0; q_ < 4; ++q_) d_[q_] = __builtin_amdgcn_sdot4((int)R_[4 * gg_ + q_][j_], (int)x_[j_], d_[q_], false); } \
            _Pragma("unroll") for (int q_ = 0; q_ < 4; ++q_) d_[q_] += DPPI_(d_[q_], 0xB1); \
            _Pragma("unroll") for (int q_ = 0; q_ < 4; ++q_) d_[q_] += DPPI_(d_[q_], 0x4E); \
            _Pragma("unroll") for (int q_ = 0; q_ < 4; ++q_) d_[q_] += DPPI_(d_[q_], 0x141);          \
            _Pragma("unroll") for (int q_ = 0; q_ < 4; ++q_) { if (c == ((4 * gg_ + q_) >> 1)) { if (q_ & 1) ir1_ = d_[q_]; else ir0_ = d_[q_]; } }          \
            __builtin_amdgcn_sched_barrier(0); } \
        if ((t_) < T) *(GAS unsigned*)(PU + (size_t)(t_) * 256 + (unsigned)(4 * lane)) = pk2((float)ir0_ * s_, (float)ir1_ * s_); } while (0)
        const int n0 = X.rank * 8 + wave;
        A_INFO(evA, n0); A_INFO(evB, n0 + tstride);
        __builtin_amdgcn_sched_barrier(0);
        A_ISSUE(RA, xa, sa, evA, n0);
        __builtin_amdgcn_sched_barrier(0);
#pragma unroll 1
        for (int n = n0; n < T; n += 2 * tstride) {
            A_INFO(evA, n + 2 * tstride);
            __builtin_amdgcn_sched_barrier(0);
            A_ISSUE(RB, xb, sb, evB, n + tstride);
            __builtin_amdgcn_sched_barrier(0);
            A_DOTS(RA, xa, sa, n);
            __builtin_amdgcn_sched_barrier(0);
            A_INFO(evB, n + 3 * tstride);
            __builtin_amdgcn_sched_barrier(0);
            A_ISSUE(RA, xa, sa, evA, n + 2 * tstride);
            __builtin_amdgcn_sched_barrier(0);
            A_DOTS(RB, xb, sb, n + tstride);
            __builtin_amdgcn_sched_barrier(0);
        }
#undef A_TOK
#undef A_INFO
#undef A_ISSUE
#undef A_DOTS
    }
}
__device__ __forceinline__ void phase_ua2(const DArgs& a, int vcu, int G) {
    const int tid = tid_();
    GAS unsigned char* ws = a.ws;
    const GAS float* USC = (const GAS float*)(ws + WS_USC); const GAS float* VSC = (const GAS float*)(ws + WS_VSC);
    const GAS unsigned char* PU = ws + WS_PARTU;
    const size_t N4 = (size_t)T * 128 / 4, stride = (size_t)G * NTHR;
    for (size_t i = (size_t)vcu * NTHR + tid; i < N4; i += 2 * stride) {
        const size_t i1 = (i + stride < N4) ? i + stride : i;
        u32x2 pv0[8], pv1[8];
#pragma unroll
        for (int sl = 0; sl < 8; ++sl) { pv0[sl] = ((const GAS u32x2*)(PU + (size_t)sl * T * 256))[i]; pv1[sl] = ((const GAS u32x2*)(PU + (size_t)sl * T * 256))[i1]; }
        const f32x4 gt0 = ((const GAS f32x4*)(ws + WS_GATE))[i], gt1 = ((const GAS f32x4*)(ws + WS_GATE))[i1];
        const u32x2 ep0 = ((const GAS u32x2*)(ws + WS_EIDX))[i], ep1 = ((const GAS u32x2*)(ws + WS_EIDX))[i1];
        const unsigned e0[4] = {ep0.x & 0xffffu, ep0.x >> 16, ep0.y & 0xffffu, ep0.y >> 16}, e1[4] = {ep1.x & 0xffffu, ep1.x >> 16, ep1.y & 0xffffu, ep1.y >> 16};
        float us0[4], vs0[4], us1[4], vs1[4];
#pragma unroll
        for (int e = 0; e < 4; ++e) { us0[e] = USC[e0[e]]; vs0[e] = VSC[e0[e]]; us1[e] = USC[e1[e]]; vs1[e] = VSC[e1[e]]; }
        f32x4 d0 = (f32x4){0.f, 0.f, 0.f, 0.f}, d1 = d0;
#pragma unroll
        for (int sl = 0; sl < 8; ++sl) { d0[0] += bf_lo(pv0[sl].x); d0[1] += bf_hi(pv0[sl].x); d0[2] += bf_lo(pv0[sl].y); d0[3] += bf_hi(pv0[sl].y);
                                         d1[0] += bf_lo(pv1[sl].x); d1[1] += bf_hi(pv1[sl].x); d1[2] += bf_lo(pv1[sl].y); d1[3] += bf_hi(pv1[sl].y); }
        f32x4 w0, w1;
#pragma unroll
        for (int e = 0; e < 4; ++e) { w0[e] = gelu_erf(d0[e] * us0[e]) * gt0[e] * vs0[e]; w1[e] = gelu_erf(d1[e] * us1[e]) * gt1[e] * vs1[e]; }
        u32x2 wo; wo.x = pk2(w0[0], w0[1]); wo.y = pk2(w0[2], w0[3]); ((GAS u32x2*)(ws + WS_PW))[i] = wo;
        if (i + stride < N4) { wo.x = pk2(w1[0], w1[1]); wo.y = pk2(w1[2], w1[3]); ((GAS u32x2*)(ws + WS_PW))[i1] = wo; }
    }
}
__device__ __forceinline__ void phase_vb(const DArgs& a, LAS unsigned char* lds) {
    const int tid = tid_(), lane = tid & 63, wave = __builtin_amdgcn_readfirstlane(tid >> 6), k = lane >> 3, c = lane & 7;
    GAS unsigned char* ws = a.ws;
    const XcdSlice X = xcd_slice_setup(a, lds);
    const int tstride = X.nloc * 8;
    const bool bit3 = (lane & 8) != 0;
    for (int sl = X.q; sl < 8; sl += X.nx) {
        const GAS unsigned char* VBs = ws + WS_VB + (size_t)sl * 2097152;
        const unsigned coff = (unsigned)c * 16u;
        const unsigned xoff = (unsigned)(sl * 128 + c * 16 + 2 * k) * 4u;
        u32x4 evA[2], evB[2], RA[16], RB[16], wa[2], wb[2]; unsigned xa, xb;
#define B_TOK(t_) ((t_) < T ? (t_) : T - 1)
#define B_INFO(ev_, t_) do { const int tq_ = B_TOK(t_); _Pragma("unroll") for (int j_ = 0; j_ < 2; ++j_) ev_[j_] = *(const GAS u32x4*)(ws + WS_EIDX + (size_t)tq_ * 256 + (unsigned)(32 * k + 16 * j_)); } while (0)
#define B_ISSUE(R_, w_, x_, ev_, t_) do { const int tq_ = B_TOK(t_); _Pragma("unroll") for (int g_ = 0; g_ < 16; ++g_) R_[g_] = *(const GAS u32x4*)(VBs + (EV_OFF(ev_, g_) | coff)); \
        _Pragma("unroll") for (int j_ = 0; j_ < 2; ++j_) w_[j_] = *(const GAS u32x4*)(ws + WS_PW + (size_t)tq_ * 256 + (unsigned)(32 * k + 16 * j_)); \
        x_ = *(const GAS unsigned*)((const GAS unsigned char*)a.out + (size_t)tq_ * (D * 2) + (xoff >> 1)); } while (0)
#define B_DOTS(R_, w_, x_, t_) do { \
        f32x2 acc2_[8]; _Pragma("unroll") for (int e_ = 0; e_ < 8; ++e_) acc2_[e_] = (f32x2){0.f, 0.f}; \
        _Pragma("unroll") for (int g_ = 0; g_ < 16; ++g_) { const unsigned ww_ = w_[g_ >> 3][(g_ >> 1) & 3]; const float wk_ = (g_ & 1) ? bf_hi(ww_) : bf_lo(ww_); const f32x2 wp_ = (f32x2){wk_, wk_}; \
            _Pragma("unroll") for (int jj_ = 0; jj_ < 4; ++jj_) { acc2_[2 * jj_] += wp_ * FP8LO(R_[g_][jj_]); acc2_[2 * jj_ + 1] += wp_ * FP8HI(R_[g_][jj_]); } \
            if (g_ & 1) __builtin_amdgcn_sched_barrier(0); } \
        f32x2 w2_[4], x2_[2], y_; \
        _Pragma("unroll") for (int i_ = 0; i_ < 4; ++i_) { w2_[i_][0] = rs32_(acc2_[i_][0], acc2_[i_ + 4][0]); w2_[i_][1] = rs32_(acc2_[i_][1], acc2_[i_ + 4][1]); } \
        _Pragma("unroll") for (int i_ = 0; i_ < 2; ++i_) { x2_[i_][0] = rs16_(w2_[i_][0], w2_[i_ + 2][0]); x2_[i_][1] = rs16_(w2_[i_][1], w2_[i_ + 2][1]); } \
        y_[0] = rs8_(x2_[0][0], x2_[1][0], bit3) + bf_lo(x_); y_[1] = rs8_(x2_[0][1], x2_[1][1], bit3) + bf_hi(x_); \
        const float ss_ = wave_sum(y_[0] * y_[0] + y_[1] * y_[1], lane); \
        if ((t_) < T) { *(GAS unsigned*)(ws + WS_PARTU + (size_t)(t_) * (D * 2) + (xoff >> 1)) = pk2(y_[0], y_[1]);       \
            if (lane == 0) ((GAS float*)(ws + WS_SS))[(size_t)(t_) * 8 + sl] = ss_; } } while (0)
        const int n0 = X.rank * 8 + wave;
        B_INFO(evA, n0); B_INFO(evB, n0 + tstride);
        __builtin_amdgcn_sched_barrier(0);
        B_ISSUE(RA, wa, xa, evA, n0);
        __builtin_amdgcn_sched_barrier(0);
#pragma unroll 1
        for (int n = n0; n < T; n += 2 * tstride) {
            B_INFO(evA, n + 2 * tstride);
            __builtin_amdgcn_sched_barrier(0);
            B_ISSUE(RB, wb, xb, evB, n + tstride);
            __builtin_amdgcn_sched_barrier(0);
            B_DOTS(RA, wa, xa, n);
            __builtin_amdgcn_sched_barrier(0);
            B_INFO(evB, n + 3 * tstride);
            __builtin_amdgcn_sched_barrier(0);
            B_ISSUE(RA, wa, xa, evA, n + 2 * tstride);
            __builtin_amdgcn_sched_barrier(0);
            B_DOTS(RB, wb, xb, n + tstride);
            __builtin_amdgcn_sched_barrier(0);
        }
#undef B_TOK
#undef B_INFO
#undef B_ISSUE
#undef B_DOTS
    }
}
__device__ __forceinline__ void phase_vc(const DArgs& a, int vcu, int G) {
    const int tid = tid_(), lane = tid & 63, wave = tid >> 6;
    const int gw = vcu * NWAVES + wave, NGW = G * NWAVES;
    GAS unsigned char* ws = a.ws;
    f32x4 gf[4];
#pragma unroll
    for (int j = 0; j < 4; ++j) gf[j] = ((const GAS f32x4*)a.final_g)[64 * j + lane];
    for (int m = gw; m < T; m += NGW) {
        const f32x4 s0 = *(const GAS f32x4*)((const GAS float*)(ws + WS_SS) + (size_t)m * 8), s1 = *(const GAS f32x4*)((const GAS float*)(ws + WS_SS) + (size_t)m * 8 + 4);
        const float rstd = rsqrtf(((s0[0] + s0[1]) + (s0[2] + s0[3]) + (s1[0] + s1[1]) + (s1[2] + s1[3])) * (1.f / D) + EPS);
        const GAS u32x2* xi = (const GAS u32x2*)(ws + WS_PARTU + (size_t)m * (D * 2)) + lane;
        GAS f32x4* o = (GAS f32x4*)(a.out + (size_t)m * D) + lane;
#pragma unroll
        for (int j = 0; j < 4; ++j) { const u32x2 xv = xi[64 * j]; f32x4 v; v[0] = bf_lo(xv.x); v[1] = bf_hi(xv.x); v[2] = bf_lo(xv.y); v[3] = bf_hi(xv.y); o[64 * j] = v * rstd * gf[j]; }
    }
}

__device__ __forceinline__ void phase_final_plain(const DArgs& a, const float* src, int vcu, int G) {
    const int tid = tid_(), lane = tid & 63, wave = tid >> 6;
    const int gw = vcu * NWAVES + wave, NGW = G * NWAVES;
    f32x4 gf[4];
#pragma unroll
    for (int j = 0; j < 4; ++j) gf[j] = ((const f32x4*)a.final_g)[64 * j + lane];
    for (int m = gw; m < T; m += NGW) {
        const f32x4* xr = (const f32x4*)(src + (size_t)m * D) + lane;
        f32x4 v[4]; float s = 0.f;
#pragma unroll
        for (int j = 0; j < 4; ++j) { v[j] = xr[64 * j]; s += (v[j][0] * v[j][0] + v[j][1] * v[j][1]) + (v[j][2] * v[j][2] + v[j][3] * v[j][3]); }
        const float rstd = rsqrtf(wave_sum(s, lane) * (1.f / D) + EPS);
        f32x4* o = (f32x4*)(a.out + (size_t)m * D) + lane;
#pragma unroll
        for (int j = 0; j < 4; ++j) o[64 * j] = v[j] * rstd * gf[j];
    }
}


__device__ __forceinline__ DArgs load_args() {
    DArgs r;
#if defined(__HIP_DEVICE_COMPILE__)
    typedef const DArgs __attribute__((address_space(4))) KArgs;
    KArgs* p = (KArgs*)__builtin_amdgcn_kernarg_segment_ptr();
    asm volatile("" : "+s"(p));
    r.x = p->x; r.norm1_g = p->norm1_g; r.w_in = p->w_in; r.b_in = p->b_in; r.conv_w = p->conv_w; r.conv_b = p->conv_b; r.m_head_g = p->m_head_g; r.lb_table = p->lb_table;
    r.g_head_g = p->g_head_g; r.w_br_m = p->w_br_m; r.w_br_g = p->w_br_g; r.w_out = p->w_out; r.norm2_g = p->norm2_g; r.w_pq = p->w_pq; r.sub_keys = p->sub_keys;
    r.u_emb = p->u_emb; r.v_emb = p->v_emb; r.final_g = p->final_g; r.out = p->out; r.ws = p->ws;
#else
    r = DArgs{};
#endif
    return r;
}
__device__ __forceinline__ EpiPtrs make_ep(const DArgs& a, int round) {
    EpiPtrs ep; ep.biasp = (const GAS float*)(a.ws + WS_BIASP); ep.lb = (const GAS float*)(a.ws + WS_LB); ep.x = a.x; ep.out = a.out; ep.ws = a.ws; ep.round = round; ep.pn0 = 0; ep.sa = (const GAS float*)(a.ws + WS_SA8); ep.sb = (const GAS float*)(a.ws + WS_SB8); ep.sym = (const GAS float*)(a.ws + WS_SYM); ep.syg = (const GAS float*)(a.ws + WS_SYG); ep.sxq = (const GAS float*)(a.ws + WS_XQS); return ep;
}
#define GRID_SYNC() do { const DArgs a_ = load_args(); xcd_barrier((unsigned*)(a_.ws + WS_CTL) + CW_BAR, (volatile LAS unsigned*)(lds + LDS_BARST)); } while (0)

__device__ __forceinline__ int bx_() { int t = blockIdx.x; asm volatile("" : "+s"(t)); return t; }
__device__ __forceinline__ int gd_() { int t = gridDim.x; asm volatile("" : "+s"(t)); return t; }
#define PH_BEGIN const DArgs a = load_args(); const int bx = bx_(), G = gd_(); const int vcu = (G % 8 == 0) ? (bx % 8) * (G / 8) + bx / 8 : bx; (void)vcu; (void)bx;

__global__ void __launch_bounds__(NTHR, 2) fwd_megakernel(Args a_unused) {
    extern __shared__ __attribute__((aligned(16))) unsigned char lds_raw[];
    LAS unsigned char* lds = (LAS unsigned char*)lds_raw;
    cg::grid_group grid = cg::this_grid();

    { const int t_ = tid_(); if (t_ < 16) ((LAS unsigned*)(lds + LDS_BARST))[t_] = 0u; __syncthreads();
      const DArgs a_ = load_args(); xcd_barrier_post((unsigned*)(a_.ws + WS_CTL) + CW_BAR, (volatile LAS unsigned*)(lds + LDS_BARST)); }
    { PH_BEGIN phase_p0(a, lds, vcu, G); }
    grid.sync();
    { PH_BEGIN phase_p0c(a, lds, vcu, G); }
    GRID_SYNC();
#pragma unroll 1
    for (int round = 0; round < NROUND; ++round) {
        {
            PH_BEGIN
            pg8::Gemm g{(const bf16_t*)(a.ws + WS_XN8 + (size_t)round * RT * 1024), (const bf16_t*)(a.ws + WS_W8A), RT, N1, D / 2};
            pg8::StaticOrder S; S.init(RT, N1, G, bx);
            EpiX<7> E{make_ep(a, round)};
            pg8::gemm_phase<EpiX<7>, pg8::StaticOrder, true, true, true>(lds, g, S, E);
        }
        { PH_BEGIN if (bx < 8) mscan_pair(a, lds, round, bx); }
        GRID_SYNC();
        { PH_BEGIN for (int it = bx; it < 512; it += G) mlstm_pre_item(a, lds, round, it); }
        { PH_BEGIN u32x4 gq[4]; int it = bx; if (it < 2048) hgrn_pre_load(a, round, it, gq);
          for (; it < 2048; it += G) hgrn_pre_item(a, lds, round, it, gq, it + G); }
        GRID_SYNC();
        { PH_BEGIN
          if (bx < 128) mlstm_scan<2, false>(a, lds, round, bx & 7, bx >> 3);
          else if (bx >= 192 && bx < 200) mlstm_scan<1, true>(a, lds, round, bx - 192, 0);
          else if (bx < 192) { const int id2 = bx - 128; hgrn_scan(a, lds, round, (id2 & 7) * 2 + ((id2 >> 3) & 1), id2 >> 4); }
          else if (G >= 232) {
              pg8::Gemm g{(const bf16_t*)(a.ws + WS_XN8 + (size_t)round * RT * 1024), (const bf16_t*)(a.ws + WS_W8 + (size_t)2048 * 1024), RT, 1024, D / 2};
              pg8::StaticOrder S; S.init(RT, 1024, G - 200, bx - 200);
              EpiPtrs ep = make_ep(a, round); ep.pn0 = 8; EpiX<2> E{ep};
              pg8::gemm_phase<EpiX<2>, pg8::StaticOrder, true, true, true>(lds, g, S, E); } }
        GRID_SYNC();
#define G2_PART(pn0_, ncol_) { PH_BEGIN \
            pg8::Gemm g{(const bf16_t*)(a.ws + WS_XN8 + (size_t)round * RT * 1024), (const bf16_t*)(a.ws + WS_W8 + (size_t)(pn0_) * 256 * 1024), RT, (ncol_), D / 2};       \
            pg8::StaticOrder S; S.init(RT, (ncol_), G, bx); \
            EpiPtrs ep = make_ep(a, round); ep.pn0 = (pn0_); EpiX<2> E{ep}; \
            pg8::gemm_phase<EpiX<2>, pg8::StaticOrder, true, true, true>(lds, g, S, E); }
        G2_PART(0, 2048)
        G2_PART(12, 2048)
        if (gd_() < 232) G2_PART(8, 1024)
#undef G2_PART
        GRID_SYNC();
        { PH_BEGIN phase_ypass(a, round, vcu, G); }
        GRID_SYNC();
        {
            { PH_BEGIN pg8::StaticOrder S; S.init(RT, D, G, bx);
              pg8::Gemm g{(const bf16_t*)(a.ws + WS_V), (const bf16_t*)(a.ws + WS_WM), RT, D, 2048 / 2}; EpiX<3> E{make_ep(a, round)}; pg8::gemm_phase<EpiX<3>, pg8::StaticOrder, true, true, true>(lds, g, S, E); }
            { PH_BEGIN pg8::StaticOrder S; S.init(RT, D, G, bx);
              pg8::Gemm g{(const bf16_t*)(a.ws + WS_GI), (const bf16_t*)(a.ws + WS_WG), RT, D, D / 2}; EpiX<4> E{make_ep(a, round)}; pg8::gemm_phase<EpiX<4>, pg8::StaticOrder, true, true, true>(lds, g, S, E); }
        }
        GRID_SYNC();
        {
            PH_BEGIN pg8::StaticOrder S; S.init(RT, D, G, bx);
            pg8::Gemm g{(const bf16_t*)(a.ws + WS_GFLOG), (const bf16_t*)(a.ws + WS_WO), RT, D, D}; EpiX<5> E{make_ep(a, round)}; pg8::gemm_phase<EpiX<5>, pg8::StaticOrder, true, true>(lds, g, S, E);
        }
        GRID_SYNC();
    }
    { PH_BEGIN phase_p8(a, vcu, G); }
    GRID_SYNC();
    {
        PH_BEGIN pg8::StaticOrder S; S.init(T, 2048, G, bx);
        pg8::Gemm g{(const bf16_t*)(a.ws + WS_XQ), (const bf16_t*)(a.ws + WS_WPQ), T, 2048, D / 2}; EpiX<6> E{make_ep(a, 0)}; pg8::gemm_phase<EpiX<6>, pg8::StaticOrder, true, true, true>(lds, g, S, E);
    }
    GRID_SYNC();
#ifdef TOPK_REF
    { PH_BEGIN phase_topk_ref(a, vcu, G); }
#else
    { PH_BEGIN phase_topk(a, lds, bx, G); }
#endif
    GRID_SYNC();
    { PH_BEGIN phase_ua(a, lds); }
    GRID_SYNC();
    { PH_BEGIN phase_ua2(a, vcu, G); }
    GRID_SYNC();
    { PH_BEGIN phase_vb(a, lds); }
    GRID_SYNC();
    { PH_BEGIN phase_vc(a, vcu, G); }
}

extern "C" void kernel_launch(void* const* d_in, const int* in_sizes, int n_in, void* d_out, int out_size, void* d_ws, size_t ws_size, hipStream_t stream) {
    static int grid = 0;
    if (grid == 0) {
        if (n_in != 18 || in_sizes[0] != T * D || out_size != T * D || ws_size < WS_END) {
            fprintf(stderr, "kernel_launch: unexpected shapes/workspace (n_in %d, in0 %d, out %d, ws %zu, need %zu)\n", n_in, n_in > 0 ? in_sizes[0] : -1, out_size, ws_size, (size_t)WS_END);
            grid = -1; return; }
        int dev = 0, cus = 0, per_cu = 0;
        hipGetDevice(&dev);
        hipDeviceGetAttribute(&cus, hipDeviceAttributeMultiprocessorCount, dev);
        hipFuncSetAttribute((const void*)fwd_megakernel, hipFuncAttributeMaxDynamicSharedMemorySize, LDS_BYTES);
        hipOccupancyMaxActiveBlocksPerMultiprocessor(&per_cu, (const void*)fwd_megakernel, NTHR, LDS_BYTES);
        if (per_cu < 1) { fprintf(stderr, "kernel_launch: occupancy query says %d blocks/CU\n", per_cu); per_cu = 1; }
        grid = cus;
        (void)hipGetLastError();
    }
    if (grid < 0) return;
    hipMemsetAsync((char*)d_ws + WS_CTL, 0, 131072, stream);
    Args a{};
    a.x = (const float*)d_in[0]; a.norm1_g = (const float*)d_in[1]; a.w_in = (const float*)d_in[2]; a.b_in = (const float*)d_in[3];
    a.conv_w = (const float*)d_in[4]; a.conv_b = (const float*)d_in[5]; a.m_head_g = (const float*)d_in[6]; a.lb_table = (const float*)d_in[7];
    a.g_head_g = (const float*)d_in[8]; a.w_br_m = (const float*)d_in[9]; a.w_br_g = (const float*)d_in[10]; a.w_out = (const float*)d_in[11];
    a.norm2_g = (const float*)d_in[12]; a.w_pq = (const float*)d_in[13]; a.sub_keys = (const float*)d_in[14]; a.u_emb = (const float*)d_in[15];
    a.v_emb = (const float*)d_in[16]; a.final_g = (const float*)d_in[17];
    a.out = (float*)d_out; a.ws = (unsigned char*)d_ws;
    void* args[] = {&a};
    hipError_t e = hipLaunchCooperativeKernel((const void*)fwd_megakernel, dim3(grid), dim3(NTHR), args, LDS_BYTES, stream);
    if (e != hipSuccess) fprintf(stderr, "cooperative launch failed: %s (grid %d)\n", hipGetErrorString(e), grid);
}
```

```cpp
#include <hip/hip_runtime.h>
#include <hip/hip_cooperative_groups.h>
#include <cstdio>
#include <cstdint>
namespace cg = cooperative_groups;

#define LAS __attribute__((address_space(3)))
typedef unsigned short bf16_t;
typedef short bf16x8 __attribute__((ext_vector_type(8)));
typedef float f32x4 __attribute__((ext_vector_type(4)));
typedef float f32x2 __attribute__((ext_vector_type(2)));
typedef unsigned u32x4 __attribute__((ext_vector_type(4)));
typedef unsigned u32x2 __attribute__((ext_vector_type(2)));

constexpr int D = 1024, BATCH = 4, SEQ = 8192, T = BATCH * SEQ;
constexpr int IN_COLS = 12296, NP = 12288;
constexpr int RT = 16384, NROUND = 2;
constexpr int N1 = 7168, N2 = 5120;
constexpr float EPS = 1e-6f;
constexpr int NWAVES = 8, NTHR = 512;

constexpr size_t MiB = 1u << 20;
constexpr size_t WS_CTL = 0;
constexpr size_t WS_WIN = 1 * MiB;
constexpr size_t WS_WM = 25 * MiB;
constexpr size_t WS_WG = 29 * MiB;
constexpr size_t WS_WO = 31 * MiB;
constexpr size_t WS_WPQ = 33 * MiB;
constexpr size_t WS_SK = 37 * MiB;
constexpr size_t WS_BIASP = 37 * MiB + 512 * 1024;
constexpr size_t WS_LB = WS_BIASP + 64 * 1024;
constexpr size_t WS_GATES = 38 * MiB;
constexpr size_t WS_MPREV = 39 * MiB;
constexpr size_t WS_DEN = 40 * MiB;
constexpr size_t WS_MT = 40 * MiB + 512 * 1024;
constexpr size_t WS_HGDEC = 41 * MiB;
constexpr size_t WS_MDEC = 43 * MiB;
constexpr size_t WS_XN = 44 * MiB;
constexpr size_t WS_QKPRE = 108 * MiB;
constexpr size_t WS_V = 172 * MiB;
constexpr size_t WS_GFLOG = 236 * MiB;
constexpr size_t WS_GI = 268 * MiB;
constexpr size_t WS_GQ = 300 * MiB;
constexpr size_t WS_S = 332 * MiB;
constexpr size_t WS_QT = 348 * MiB;
constexpr size_t WS_KWT = 380 * MiB;
constexpr size_t WS_ATT = 412 * MiB;
constexpr size_t WS_QTG = 428 * MiB;
constexpr size_t WS_KENDT = 460 * MiB;
constexpr size_t WS_SIGO = 332 * MiB;
constexpr size_t WS_SGG = 76 * MiB;
constexpr size_t WS_SAM = 428 * MiB;
constexpr size_t WS_SAG = 460 * MiB;
constexpr size_t WS_XN8 = 44 * MiB;
constexpr size_t WS_SA8 = 508 * MiB;
constexpr size_t WS_SB8 = 508 * MiB + 262144;
constexpr size_t WS_W8A = WS_WIN;
constexpr size_t WS_W8 = WS_WIN + (size_t)7168 * 1024;
constexpr int NI8 = 12288 + 1024 + 1024 + 2048;
constexpr size_t WS_SYM = 508 * MiB + 524288;
constexpr size_t WS_SYG = 508 * MiB + 655360;
constexpr int CW_COLMAX = 16384;
constexpr size_t WS_END = 510 * MiB;
constexpr size_t WS_QP = 108 * MiB;
constexpr size_t WS_UB = 236 * MiB;
constexpr size_t WS_VB = 252 * MiB;
constexpr size_t WS_USC = 268 * MiB;
constexpr size_t WS_VSC = 268 * MiB + 65536;
constexpr size_t WS_EIDX = 300 * MiB;
constexpr size_t WS_GATE = 316 * MiB;
constexpr size_t WS_XQ = 380 * MiB;
constexpr size_t WS_XQS = 412 * MiB;
constexpr size_t WS_PARTU = 108 * MiB;
constexpr size_t WS_SS = 348 * MiB;
constexpr size_t WS_PW = 332 * MiB;

constexpr int CW_TMAX = 64;
constexpr int LDS_BYTES = 147456;

__device__ __forceinline__ unsigned f2bf(float f) { unsigned u = __builtin_bit_cast(unsigned, f); return (u + 0x7fffu + ((u >> 16) & 1u)) >> 16; }
typedef __bf16 bf16x2_t __attribute__((ext_vector_type(2)));
__device__ __forceinline__ unsigned pk2(float lo, float hi) { bf16x2_t v; v[0] = (__bf16)lo; v[1] = (__bf16)hi; return __builtin_bit_cast(unsigned, v); }
__device__ __forceinline__ float bf_lo(unsigned w) { return __builtin_bit_cast(float, w << 16); }
__device__ __forceinline__ float bf_hi(unsigned w) { return __builtin_bit_cast(float, w & 0xffff0000u); }
__device__ __forceinline__ float bf2f(bf16_t h) { return __builtin_bit_cast(float, ((unsigned)h) << 16); }
__device__ __forceinline__ float shx(float v, int o, int lane) { return __builtin_bit_cast(float, __builtin_amdgcn_ds_bpermute((lane ^ o) << 2, __builtin_bit_cast(int, v))); }
__device__ __forceinline__ float shup(float v, int o, int lane) { return __builtin_bit_cast(float, __builtin_amdgcn_ds_bpermute(((lane - o) & 63) << 2, __builtin_bit_cast(int, v))); }
__device__ __forceinline__ float rdlane(float v, int l) { return __builtin_bit_cast(float, __builtin_amdgcn_readlane(__builtin_bit_cast(int, v), l)); }
#define DPP_(v, ctrl) __builtin_bit_cast(float, __builtin_amdgcn_update_dpp(0, __builtin_bit_cast(int, (v)), (ctrl), 0xF, 0xF, false))
__device__ __forceinline__ float wave_sum(float v, int lane) {
    (void)lane;
    v += DPP_(v, 0xB1); v += DPP_(v, 0x4E); v += DPP_(v, 0x141); v += DPP_(v, 0x140);
    return (rdlane(v, 0) + rdlane(v, 16)) + (rdlane(v, 32) + rdlane(v, 48));
}
__device__ __forceinline__ float wave_max(float v) {
    v = fmaxf(v, DPP_(v, 0xB1)); v = fmaxf(v, DPP_(v, 0x4E)); v = fmaxf(v, DPP_(v, 0x141)); v = fmaxf(v, DPP_(v, 0x140));
    return fmaxf(fmaxf(rdlane(v, 0), rdlane(v, 16)), fmaxf(rdlane(v, 32), rdlane(v, 48)));
}
__device__ __forceinline__ unsigned pack_i8x4(float a, float b, float c, float d) {
    const int ia = (int)__builtin_rintf(a), ib = (int)__builtin_rintf(b), ic = (int)__builtin_rintf(c), id = (int)__builtin_rintf(d);
    return ((unsigned)ia & 255u) | (((unsigned)ib & 255u) << 8) | (((unsigned)ic & 255u) << 16) | ((unsigned)id << 24);
}
#define SWZI_(v, pat) __builtin_amdgcn_ds_swizzle((int)(v), (pat))
#define DPPI_(v, ctrl) __builtin_amdgcn_update_dpp(0, (int)(v), (ctrl), 0xF, 0xF, false)
__device__ __forceinline__ unsigned xor32u_(unsigned v, bool hi) {
#if defined(__HIP_DEVICE_COMPILE__)
    const auto r = __builtin_amdgcn_permlane32_swap(v, v, false, false);
    return hi ? r[0] : r[1];
#else
    (void)hi; return v;
#endif
}
__device__ __forceinline__ float sigmoidf_(float x) { return __builtin_amdgcn_rcpf(1.0f + __expf(-x)); }
__device__ __forceinline__ float siluf_(float x) { return x * __builtin_amdgcn_rcpf(1.0f + __expf(-x)); }
#define LDS_WAIT() asm volatile("s_waitcnt lgkmcnt(0)" ::: "memory")
__device__ __forceinline__ int tid_() { int t = threadIdx.x; asm volatile("" : "+v"(t)); return t; }

#define GAS __attribute__((address_space(1)))
struct DArgs {
    const GAS float* x; const GAS float* norm1_g; const GAS float* w_in; const GAS float* b_in; const GAS float* conv_w; const GAS float* conv_b;
    const GAS float* m_head_g; const GAS float* lb_table; const GAS float* g_head_g; const GAS float* w_br_m; const GAS float* w_br_g; const GAS float* w_out;
    const GAS float* norm2_g; const GAS float* w_pq; const GAS float* sub_keys; const GAS float* u_emb; const GAS float* v_emb; const GAS float* final_g;
    GAS float* out; GAS unsigned char* ws;
};
struct Args {
    const float* x; const float* norm1_g; const float* w_in; const float* b_in; const float* conv_w; const float* conv_b;
    const float* m_head_g; const float* lb_table; const float* g_head_g; const float* w_br_m; const float* w_br_g; const float* w_out;
    const float* norm2_g; const float* w_pq; const float* sub_keys; const float* u_emb; const float* v_emb; const float* final_g;
    float* out; unsigned char* ws;
};

namespace pg8 {
constexpr int BM = 256, BK = 64, HALF = 128, HTB = HALF * BK * 2, STAGE_BYTES = 8 * HTB, NXCD = 8, WGM = 8;
__host__ __device__ __forceinline__ int lds_byte(int r, int c) { const int st = (r >> 4) * 2 + (c >> 5), rr = r & 15, cc = c & 31, ob = rr * 64 + cc * 2; return st * 1024 + (ob ^ (((ob >> 9) & 1) << 5)); }
__host__ __device__ __forceinline__ void stage_rc(int b, int& R, int& C) { const int st = b / 1024, sb = b % 1024, swz = sb ^ (((sb >> 9) & 1) << 5); R = (st >> 1) * 16 + swz / 64; C = (st & 1) * 32 + (swz % 64) / 2; }
__host__ __device__ __forceinline__ int perm32(int rho) { const int n = rho >> 4, i = rho & 15; return 8 * (i >> 2) + 4 * n + (i & 3); }
struct Unit { int pm, pn; };
struct Gemm { const bf16_t* A; const bf16_t* Bt; int M, N, K; };
struct StaticOrder {
    int nM, nN, nwg, G, c;
    __host__ __device__ void init(int M, int N, int G_, int c_) { nM = M / BM; nN = N / BM; nwg = nM * nN; G = G_; c = c_; }
    __host__ __device__ bool next(int i, Unit& u) const {
        const long L = (long)i * G + c; if (L >= nwg) return false;
        int wgid = (int)L; { const int q = nwg / NXCD, r = nwg % NXCD, xcd = wgid % NXCD, off = wgid / NXCD; wgid = (xcd < r ? xcd * (q + 1) : r * (q + 1) + (xcd - r) * q) + off; }
        const int nig = WGM * nN, gid = wgid / nig, fm = gid * WGM, gsz = (nM - fm) < WGM ? (nM - fm) : WGM;
        u.pm = fm + ((wgid % nig) % gsz); u.pn = (wgid % nig) / gsz; return true;
    }
    __device__ __forceinline__ void a_ready(const Unit&) const {}
    __device__ __forceinline__ void done(const Unit&) const {}
};

typedef int i32x8 __attribute__((ext_vector_type(8)));
typedef int i32x4 __attribute__((ext_vector_type(4)));
template <class Epi, class Sched, bool ALIGN_EPI = false, bool SP2 = false, bool I8 = false>
__device__ __forceinline__ void gemm_phase(LAS unsigned char* lds, const Gemm g, const Sched& S, const Epi& E) {
    const int tid = tid_(), wid = __builtin_amdgcn_readfirstlane(tid >> 6), lane = tid & 63, wr = wid >> 2, wc = wid & 3, fr = lane & 15, fq = lane >> 4;
    const int K = g.K, nt = K / BK;
    unsigned voffA[2], voffB[2];
#pragma unroll
    for (int i = 0; i < 2; ++i) { int R, C; stage_rc(tid * 16 + i * 8192, R, C); const int Rb = Epi::PERM ? ((R & ~31) + perm32(R & 31)) : R;
        voffA[i] = (unsigned)(R * K + C) * 2u; voffB[i] = (unsigned)(Rb * K + C) * 2u; }
    const size_t kstep = (size_t)(BK * 2);
    const size_t hstep = (size_t)HALF * K * 2;
    const size_t tstep = 2 * hstep;
    const unsigned ldsw = (unsigned)wid * 1024u;
    const int aoff = lds_byte(wr * 64 + fr, fq * 8), boff = lds_byte(wc * 32 + fr, fq * 8);
#define PG8_SA(b, h) (((b) * 2 + (h)) * HTB)
#define PG8_SB(b, h) ((4 + (b) * 2 + (h)) * HTB)
#define PG8_STAGE(bufoff, gbase, voff) do { _Pragma("unroll") for (int _i = 0; _i < 2; ++_i) \
        __builtin_amdgcn_global_load_lds((const unsigned*)((const char*)(gbase) + (voff)[_i]), (LAS unsigned*)(lds + (bufoff) + ldsw + _i * 8192), 16, 0, 0); } while (0)
#define PG8_LDA(dst, b, h) do { _Pragma("unroll") for (int m = 0; m < 4; ++m) _Pragma("unroll") for (int k = 0; k < 2; ++k) dst[m][k] = *(const LAS bf16x8*)(lds + PG8_SA(b, h) + aoff + m * 2048 + k * 1024); } while (0)
#define PG8_LDB(dst, b, h) do { _Pragma("unroll") for (int n = 0; n < 2; ++n) _Pragma("unroll") for (int k = 0; k < 2; ++k) dst[n][k] = *(const LAS bf16x8*)(lds + PG8_SB(b, h) + boff + n * 2048 + k * 1024); } while (0)
#define PG8_MMA(ai, bj, At, Bt) do { __builtin_amdgcn_s_setprio(1); _Pragma("unroll") for (int m = 0; m < 4; ++m) _Pragma("unroll") for (int n = 0; n < 2; ++n) _Pragma("unroll") for (int k = 0; k < 2; ++k) { \
        if constexpr (I8) acc[ai][bj][m][n] = __builtin_bit_cast(f32x4, __builtin_amdgcn_mfma_i32_16x16x64_i8(__builtin_bit_cast(i32x4, Bt[n][k]), __builtin_bit_cast(i32x4, At[m][k]), __builtin_bit_cast(i32x4, acc[ai][bj][m][n]), 0, 0, 0)); \
        else acc[ai][bj][m][n] = __builtin_amdgcn_mfma_f32_16x16x32_bf16(Bt[n][k], At[m][k], acc[ai][bj][m][n], 0, 0, 0); } __builtin_amdgcn_s_setprio(0); } while (0)
#define PG8_WAIT_V(n) asm volatile("s_waitcnt vmcnt(" #n ")" ::: "memory")
#define PG8_WAIT_L(n) asm volatile("s_waitcnt lgkmcnt(" #n ")" ::: "memory")
#define PG8_BAR __builtin_amdgcn_s_barrier()
#define PG8_SCHED __builtin_amdgcn_sched_barrier(0)
    Unit cur, nxt; int ui = 0;
    if (!S.next(0, cur)) return;
    f32x4 acc[2][2][4][2];
#pragma unroll
    for (int a = 0; a < 2; ++a)
#pragma unroll
        for (int b = 0; b < 2; ++b)
#pragma unroll
            for (int m = 0; m < 4; ++m)
#pragma unroll
                for (int n = 0; n < 2; ++n) acc[a][b][m][n] = (f32x4){0.f, 0.f, 0.f, 0.f};
    bf16x8 At[4][2], B0[2][2], B1[2][2];
    const char* cA = (const char*)g.A + (size_t)cur.pm * tstep; const char* cB = (const char*)g.Bt + (size_t)cur.pn * tstep;
    S.a_ready(cur);
    if constexpr (SP2) {
        PG8_STAGE(PG8_SB(0, 0), cB, voffB); PG8_STAGE(PG8_SB(0, 1), cB + hstep, voffB); PG8_STAGE(PG8_SA(0, 0), cA, voffA); PG8_STAGE(PG8_SA(0, 1), cA + hstep, voffA);
        if (wr == 1) PG8_BAR;
        PG8_WAIT_V(2); PG8_BAR;
        PG8_STAGE(PG8_SB(1, 0), cB + kstep, voffB); PG8_STAGE(PG8_SA(1, 0), cA + kstep, voffA); PG8_STAGE(PG8_SB(1, 1), cB + hstep + kstep, voffB);
        PG8_WAIT_V(6); PG8_BAR;
    } else {
        PG8_STAGE(PG8_SB(0, 0), cB, voffB); PG8_STAGE(PG8_SA(0, 0), cA, voffA); PG8_STAGE(PG8_SB(0, 1), cB + hstep, voffB); PG8_STAGE(PG8_SA(0, 1), cA + hstep, voffA);
        if (wr == 1) PG8_BAR;
        PG8_WAIT_V(4); PG8_BAR;
        PG8_STAGE(PG8_SB(1, 0), cB + kstep, voffB); PG8_STAGE(PG8_SA(1, 0), cA + kstep, voffA); PG8_STAGE(PG8_SB(1, 1), cB + hstep + kstep, voffB);
        PG8_WAIT_V(6); PG8_BAR;
    }
    for (;;) {
        const bool has_next = S.next(ui + 1, nxt);
        const char* nA = has_next ? (const char*)g.A + (size_t)nxt.pm * tstep : cA; const char* nB = has_next ? (const char*)g.Bt + (size_t)nxt.pn * tstep : cB;
#pragma unroll 1
        for (int t = 0; t < nt; t += 2) {
            const bool last = (t == nt - 2);
            const char* a1 = cA + (size_t)(t + 1) * kstep;
            const char* a2 = last ? nA : cA + (size_t)(t + 2) * kstep; const char* b2 = last ? nB : cB + (size_t)(t + 2) * kstep;
            const char* a3 = a2 + kstep; const char* b3 = b2 + kstep;
            if (last && has_next) S.a_ready(nxt);
            if constexpr (SP2) {
            PG8_LDB(B0, 0, 0); PG8_LDB(B1, 0, 1); PG8_SCHED; PG8_LDA(At, 0, 0); PG8_STAGE(PG8_SA(1, 1), a1 + hstep, voffA);
            PG8_WAIT_V(8); PG8_WAIT_L(0); PG8_BAR; PG8_MMA(0, 0, At, B0); PG8_MMA(0, 1, At, B1); PG8_BAR; PG8_SCHED;
            PG8_LDA(At, 0, 1); PG8_STAGE(PG8_SB(0, 0), b2, voffB); PG8_STAGE(PG8_SB(0, 1), b2 + hstep, voffB); PG8_STAGE(PG8_SA(0, 0), a2, voffA);
            PG8_WAIT_V(8); PG8_WAIT_L(0); PG8_BAR; PG8_MMA(1, 0, At, B0); PG8_MMA(1, 1, At, B1); PG8_BAR; PG8_SCHED;
            PG8_LDB(B0, 1, 0); PG8_LDB(B1, 1, 1); PG8_SCHED; PG8_LDA(At, 1, 0); PG8_STAGE(PG8_SA(0, 1), a2 + hstep, voffA);
            PG8_WAIT_V(8); PG8_WAIT_L(0); PG8_BAR; PG8_MMA(0, 0, At, B0); PG8_MMA(0, 1, At, B1); PG8_BAR; PG8_SCHED;
            PG8_LDA(At, 1, 1); PG8_STAGE(PG8_SB(1, 0), b3, voffB); PG8_STAGE(PG8_SB(1, 1), b3 + hstep, voffB); PG8_STAGE(PG8_SA(1, 0), a3, voffA);
            PG8_WAIT_V(8); PG8_WAIT_L(0); PG8_BAR; PG8_MMA(1, 0, At, B0); PG8_MMA(1, 1, At, B1); PG8_BAR; PG8_SCHED;
            } else {
            PG8_LDB(B0, 0, 0); PG8_SCHED; PG8_LDA(At, 0, 0); PG8_STAGE(PG8_SA(1, 1), a1 + hstep, voffA);
            PG8_WAIT_L(8); PG8_BAR; PG8_WAIT_L(0); PG8_MMA(0, 0, At, B0); PG8_BAR; PG8_SCHED;
            PG8_LDB(B1, 0, 1); PG8_STAGE(PG8_SB(0, 0), b2, voffB);
            PG8_BAR; PG8_WAIT_L(0); PG8_MMA(0, 1, At, B1); PG8_BAR;
            PG8_LDA(At, 0, 1); PG8_STAGE(PG8_SA(0, 0), a2, voffA);
            PG8_BAR; PG8_WAIT_L(0); PG8_MMA(1, 0, At, B0); PG8_BAR; PG8_SCHED;
            PG8_STAGE(PG8_SB(0, 1), b2 + hstep, voffB);
            PG8_WAIT_V(6); PG8_BAR; PG8_MMA(1, 1, At, B1); PG8_BAR;
            PG8_LDB(B0, 1, 0); PG8_SCHED; PG8_LDA(At, 1, 0); PG8_STAGE(PG8_SA(0, 1), a2 + hstep, voffA);
            PG8_WAIT_L(8); PG8_BAR; PG8_WAIT_L(0); PG8_MMA(0, 0, At, B0); PG8_BAR; PG8_SCHED;
            PG8_LDB(B1, 1, 1); PG8_STAGE(PG8_SB(1, 0), b3, voffB);
            PG8_BAR; PG8_WAIT_L(0); PG8_MMA(0, 1, At, B1); PG8_BAR;
            PG8_LDA(At, 1, 1); PG8_STAGE(PG8_SA(1, 0), a3, voffA);
            PG8_BAR; PG8_WAIT_L(0); PG8_MMA(1, 0, At, B0); PG8_BAR; PG8_SCHED;
            PG8_STAGE(PG8_SB(1, 1), b3 + hstep, voffB);
            PG8_WAIT_V(6); PG8_BAR; PG8_MMA(1, 1, At, B1); PG8_BAR;
            }
        }
        if constexpr (ALIGN_EPI) { if (wr == 0) PG8_BAR; }
        E(acc, cur, wr, wc, fr, fq);
        if (!has_next) break;
#pragma unroll
        for (int a = 0; a < 2; ++a)
#pragma unroll
            for (int b = 0; b < 2; ++b)
#pragma unroll
                for (int m = 0; m < 4; ++m)
#pragma unroll
                    for (int n = 0; n < 2; ++n) acc[a][b][m][n] = (f32x4){0.f, 0.f, 0.f, 0.f};
        cur = nxt; cA = nA; cB = nB; ++ui;
        if constexpr (ALIGN_EPI) { if (wr == 1) PG8_BAR; }
    }
    PG8_WAIT_V(0);
    if constexpr (!ALIGN_EPI) { if (wr == 0) PG8_BAR; }
    PG8_BAR;
#undef PG8_SA
#undef PG8_SB
#undef PG8_STAGE
#undef PG8_LDA
#undef PG8_LDB
#undef PG8_MMA
#undef PG8_WAIT_V
#undef PG8_WAIT_L
#undef PG8_BAR
#undef PG8_SCHED
}
}

typedef int i32x4q __attribute__((ext_vector_type(4)));
struct EpiPtrs {
    const GAS float* biasp; const GAS float* lb; const GAS float* x; GAS float* out; GAS unsigned char* ws; int round;
    int pn0;
    const GAS float* sa; const GAS float* sb; const GAS float* sym; const GAS float* syg; const GAS float* sxq;
};
template <int MODE> struct EpiX {
    static constexpr bool PERM = true, AFTER_DRAIN = false;
    EpiPtrs P;
    __device__ __forceinline__ void operator()(const f32x4 (&acc)[2][2][4][2], const pg8::Unit& u, int wr, int wc, int fr, int fq) const {
        const int upn = u.pn + (MODE == 2 ? P.pn0 : 0);
        const int row0 = u.pm * 256 + wr * 64 + fr;
        const int colt = upn * 256 + wc * 32 + 8 * fq;
        GAS unsigned char* ws = P.ws;
        bf16_t* dst = nullptr; int ld = 0, coff = 0, act = 0; const GAS float* bias = nullptr;
        if (MODE == 1 || MODE == 7) {
            bias = P.biasp;
            if (upn < 8) { dst = (bf16_t*)(ws + WS_QKPRE); ld = 2048; coff = 0; act = 0; }
            else if (upn < 16) { dst = (bf16_t*)(ws + WS_V); ld = 2048; coff = 2048; act = 0; }
            else if (upn < 20) { dst = (bf16_t*)(ws + WS_GFLOG); ld = 1024; coff = 4096; act = 3; }
            else if (upn < 24) { dst = (bf16_t*)(ws + WS_GI); ld = 1024; coff = 5120; act = 0; }
            else { dst = (bf16_t*)(ws + WS_GQ); ld = 1024; coff = 6144; act = 2; }
        } else if (MODE == 2) {
            bias = P.biasp + N1;
            if (upn < 8) { dst = (bf16_t*)(ws + WS_SIGO); ld = 2048; coff = 0; act = 1; }
            else if (upn < 12) { dst = (bf16_t*)(ws + WS_SGG); ld = 1024; coff = 2048; act = 2; }
            else if (upn < 16) { dst = (bf16_t*)(ws + WS_SAM); ld = 1024; coff = 3072; act = 1; }
            else { dst = (bf16_t*)(ws + WS_SAG); ld = 1024; coff = 4096; act = 1; }
        } else if (MODE == 6) { dst = (bf16_t*)(ws + WS_QP); ld = 2048; coff = 0; act = 0; }
        float sr8[2][4];
#pragma unroll
        for (int ai = 0; ai < 2; ++ai)
#pragma unroll
            for (int m = 0; m < 4; ++m) { const int row = row0 + ai * 128 + m * 16;
                sr8[ai][m] = (MODE == 3) ? P.sym[row] : (MODE == 4) ? P.syg[row] : (MODE == 6) ? P.sxq[row] : (MODE == 2 || MODE == 7) ? P.sa[(size_t)P.round * RT + row] : 1.0f; }
#pragma unroll
        for (int bj = 0; bj < 2; ++bj) {
            const int col = colt + bj * 128;
            f32x4 b0 = (f32x4){0.f, 0.f, 0.f, 0.f}, b1 = b0, l0 = b0, l1 = b0;
            if (MODE == 1 || MODE == 2 || MODE == 7) { b0 = *(const f32x4*)(bias + col); b1 = *(const f32x4*)(bias + col + 4); }
            f32x4 s0 = (f32x4){1.f, 1.f, 1.f, 1.f}, s1 = s0;
            if (MODE == 2) { s0 = *(const GAS f32x4*)(P.sb + 7168 + col); s1 = *(const GAS f32x4*)(P.sb + 7168 + col + 4); }
            if (MODE == 7) { s0 = *(const GAS f32x4*)(P.sb + col); s1 = *(const GAS f32x4*)(P.sb + col + 4); }
            if (MODE == 3) { s0 = *(const GAS f32x4*)(P.sb + 12288 + col); s1 = *(const GAS f32x4*)(P.sb + 12288 + col + 4); }
            if (MODE == 4) { s0 = *(const GAS f32x4*)(P.sb + 13312 + col); s1 = *(const GAS f32x4*)(P.sb + 13312 + col + 4); }
            if (MODE == 6) { s0 = *(const GAS f32x4*)(P.sb + 14336 + col); s1 = *(const GAS f32x4*)(P.sb + 14336 + col + 4); }
            if (MODE == 1 || MODE == 7) { if (act == 3) { l0 = *(const f32x4*)(P.lb + (col - coff)); l1 = *(const f32x4*)(P.lb + (col - coff) + 4); } }
#pragma unroll
            for (int ai = 0; ai < 2; ++ai) {
                u32x4 gpre[4], zpre[4]; f32x4 xpre[4][2];
#pragma unroll
                for (int m = 0; m < 4; ++m) { const int row = row0 + ai * 128 + m * 16;
                    if (MODE == 3) gpre[m] = *(const GAS u32x4*)((const GAS bf16_t*)(ws + WS_SAM) + (size_t)row * 1024 + col);
                    if (MODE == 4) { gpre[m] = *(const GAS u32x4*)((const GAS bf16_t*)(ws + WS_SAG) + (size_t)row * 1024 + col);
                                     zpre[m] = *(const GAS u32x4*)((const GAS bf16_t*)P.out + (size_t)T * 1024 + ((size_t)P.round * RT + row) * 1024 + col); }
                    if (MODE == 5) { const size_t off = ((size_t)P.round * RT + row) * 1024 + col; xpre[m][0] = *(const GAS f32x4*)(P.x + off); xpre[m][1] = *(const GAS f32x4*)(P.x + off + 4); } }
#pragma unroll
                for (int m = 0; m < 4; ++m) {
                    const int row = row0 + ai * 128 + m * 16;
                    f32x4 v0, v1;
                    if (MODE == 2 || MODE == 7 || MODE == 3 || MODE == 4 || MODE == 6) { const float sr = sr8[ai][m]; const i32x4q q0 = __builtin_bit_cast(i32x4q, acc[ai][bj][m][0]), q1 = __builtin_bit_cast(i32x4q, acc[ai][bj][m][1]);
                        v0 = (f32x4){(float)q0[0], (float)q0[1], (float)q0[2], (float)q0[3]} * (s0 * sr) + b0; v1 = (f32x4){(float)q1[0], (float)q1[1], (float)q1[2], (float)q1[3]} * (s1 * sr) + b1; }
                    else { v0 = acc[ai][bj][m][0] + b0; v1 = acc[ai][bj][m][1] + b1; }
                    if (MODE == 1 || MODE == 2 || MODE == 6 || MODE == 7) {
                        if (act == 1) {
#pragma unroll
                            for (int j = 0; j < 4; ++j) { v0[j] = sigmoidf_(v0[j]); v1[j] = sigmoidf_(v1[j]); }
                        } else if (act == 2) {
#pragma unroll
                            for (int j = 0; j < 4; ++j) { v0[j] = siluf_(v0[j]); v1[j] = siluf_(v1[j]); }
                        } else if (act == 3) {
#pragma unroll
                            for (int j = 0; j < 4; ++j) { v0[j] = __logf(l0[j] + (1.0f - l0[j]) * sigmoidf_(v0[j])); v1[j] = __logf(l1[j] + (1.0f - l1[j]) * sigmoidf_(v1[j])); }
                        }
                        u32x4 w; w.x = pk2(v0[0], v0[1]); w.y = pk2(v0[2], v0[3]); w.z = pk2(v1[0], v1[1]); w.w = pk2(v1[2], v1[3]);
                        *(u32x4*)(dst + (size_t)row * ld + (col - coff)) = w;
                    } else if (MODE == 3) {
                        const u32x4 g = gpre[m];
                        GAS bf16_t* o = (GAS bf16_t*)P.out + (size_t)T * 1024 + ((size_t)P.round * RT + row) * 1024 + col;
                        f32x4 r0, r1;
                        r0[0] = v0[0] * bf_lo(g.x); r0[1] = v0[1] * bf_hi(g.x); r0[2] = v0[2] * bf_lo(g.y); r0[3] = v0[3] * bf_hi(g.y);
                        r1[0] = v1[0] * bf_lo(g.z); r1[1] = v1[1] * bf_hi(g.z); r1[2] = v1[2] * bf_lo(g.w); r1[3] = v1[3] * bf_hi(g.w);
                        u32x4 w; w.x = pk2(r0[0], r0[1]); w.y = pk2(r0[2], r0[3]); w.z = pk2(r1[0], r1[1]); w.w = pk2(r1[2], r1[3]);
                        *(GAS u32x4*)o = w;
                    } else if (MODE == 4) {
                        const u32x4 g = gpre[m], zv = zpre[m];
                        const f32x4 p0 = (f32x4){bf_lo(zv.x), bf_hi(zv.x), bf_lo(zv.y), bf_hi(zv.y)}, p1 = (f32x4){bf_lo(zv.z), bf_hi(zv.z), bf_lo(zv.w), bf_hi(zv.w)};
                        f32x4 r0, r1;
                        r0[0] = p0[0] + v0[0] * bf_lo(g.x); r0[1] = p0[1] + v0[1] * bf_hi(g.x); r0[2] = p0[2] + v0[2] * bf_lo(g.y); r0[3] = p0[3] + v0[3] * bf_hi(g.y);
                        r1[0] = p1[0] + v1[0] * bf_lo(g.z); r1[1] = p1[1] + v1[1] * bf_hi(g.z); r1[2] = p1[2] + v1[2] * bf_lo(g.w); r1[3] = p1[3] + v1[3] * bf_hi(g.w);
                        u32x4 w; w.x = pk2(r0[0], r0[1]); w.y = pk2(r0[2], r0[3]); w.z = pk2(r1[0], r1[1]); w.w = pk2(r1[2], r1[3]);
                        *(u32x4*)((bf16_t*)(ws + WS_GFLOG) + (size_t)row * 1024 + col) = w;
                    } else if (MODE == 5) {
                        const size_t off = ((size_t)P.round * RT + row) * 1024 + col;
                        const f32x4 x0 = xpre[m][0] + v0, x1 = xpre[m][1] + v1;
                        u32x4 w; w.x = pk2(x0[0], x0[1]); w.y = pk2(x0[2], x0[3]); w.z = pk2(x1[0], x1[1]); w.w = pk2(x1[2], x1[3]);
                        *(GAS u32x4*)((GAS bf16_t*)P.out + off) = w;
                    }
                }
            }
        }
    }
};

__device__ __forceinline__ void p0_transpose_item(const GAS float* W, int ldw, int K, int k0, int scol, GAS bf16_t* WT, int drow, LAS float* scr, int lane) {
#pragma unroll 8
    for (int i = 0; i < 32; ++i) { const int kk = 2 * i + (lane >> 5); scr[kk * 33 + (lane & 31)] = W[(size_t)(k0 + kk) * ldw + scol + (lane & 31)]; }
    LDS_WAIT(); asm volatile("" ::: "memory");
    const int c = lane & 7;
#pragma unroll
    for (int j = 0; j < 4; ++j) { const int n = (lane >> 3) + 8 * j; const LAS float* s = scr + (8 * c) * 33 + n;
        u32x4 o; o.x = pk2(s[0 * 33], s[1 * 33]); o.y = pk2(s[2 * 33], s[3 * 33]); o.z = pk2(s[4 * 33], s[5 * 33]); o.w = pk2(s[6 * 33], s[7 * 33]);
        *(u32x4*)(WT + (size_t)(drow + n) * K + k0 + 8 * c) = o; }
    LDS_WAIT(); asm volatile("" ::: "memory");
}
__device__ __forceinline__ void p0_colmax_item(const GAS float* W, int ldw, int k0, int scol, GAS unsigned* colmax, int lane) {
    float mx = 0.f;
#pragma unroll 8
    for (int i = 0; i < 32; ++i) { const int kk = 2 * i + (lane >> 5); mx = fmaxf(mx, fabsf(W[(size_t)(k0 + kk) * ldw + scol + (lane & 31)])); }
    mx = fmaxf(mx, __builtin_bit_cast(float, xor32u_(__builtin_bit_cast(unsigned, mx), lane >= 32)));
    if (lane < 32) atomicMax((unsigned*)colmax + lane, __builtin_bit_cast(unsigned, mx));
}
__device__ __forceinline__ void p0_cvt8_item(const GAS float* W, int ldw, int k0, int scol, const GAS unsigned* colmax, GAS unsigned char* WT8, int pitch, GAS float* sb, int drow, LAS float* scr, int lane) {
    const float cm = __builtin_bit_cast(float, colmax[lane & 31]);
    const float qs = cm > 0.f ? 127.0f / cm : 0.f;
    if (k0 == 0 && lane < 32) sb[lane] = cm * (1.0f / 127.0f);
#pragma unroll 8
    for (int i = 0; i < 32; ++i) { const int kk = 2 * i + (lane >> 5); scr[kk * 33 + (lane & 31)] = W[(size_t)(k0 + kk) * ldw + scol + (lane & 31)] * qs; }
    LDS_WAIT(); asm volatile("" ::: "memory");
    const int n = lane >> 1, kh = lane & 1;
    const LAS float* sp = scr + (kh * 32) * 33 + n;
    u32x4 o0, o1;
#pragma unroll
    for (int q = 0; q < 8; ++q) { const unsigned p = pack_i8x4(sp[(4 * q) * 33], sp[(4 * q + 1) * 33], sp[(4 * q + 2) * 33], sp[(4 * q + 3) * 33]);
        if (q < 4) o0[q] = p; else o1[q - 4] = p; }
    GAS unsigned char* dst = WT8 + (size_t)(drow + n) * pitch + k0 + kh * 32;
    *(GAS u32x4*)dst = o0; *(GAS u32x4*)(dst + 16) = o1;
    LDS_WAIT(); asm volatile("" ::: "memory");
}
__device__ __forceinline__ int win_src_col(int n) {
    if (n < 4096) return n;
    if (n < 7168) return n - 4096 + 6152;
    if (n < 9216) return n - 7168 + 4096;
    return n - 9216 + 9224;
}

__device__ __forceinline__ void phase_p0(const DArgs& a, LAS unsigned char* lds, int vcu, int G) {
    const int tid = tid_(), lane = tid & 63, wave = tid >> 6;
    const int gw = vcu * NWAVES + wave, NGW = G * NWAVES;
    GAS unsigned char* ws = a.ws;
    LAS float* scr = (LAS float*)(lds + wave * 16384);
    constexpr int I_IN = 16 * 384, I_M = 32 * 32, I_G = 16 * 32, I_O = 16 * 32, I_PQ = 16 * 64;
    constexpr int NITEMS = I_IN + I_M + I_G + I_O + I_PQ;
    for (int it = gw; it < NITEMS; it += NGW) {
        int r = it;
        if (r < I_IN) { const int kb = r / 384, nb = r % 384;
            p0_colmax_item(a.w_in, IN_COLS, kb * 64, win_src_col(nb * 32), (GAS unsigned*)(ws + WS_CTL) + CW_COLMAX + nb * 32, lane);
            continue; } r -= I_IN;
        if (r < I_M) { const int kb = r / 32, nb = r % 32; p0_colmax_item(a.w_br_m, 1024, kb * 64, nb * 32, (GAS unsigned*)(ws + WS_CTL) + CW_COLMAX + 12288 + nb * 32, lane); continue; } r -= I_M;
        if (r < I_G) { const int kb = r / 32, nb = r % 32; p0_colmax_item(a.w_br_g, 1024, kb * 64, nb * 32, (GAS unsigned*)(ws + WS_CTL) + CW_COLMAX + 13312 + nb * 32, lane); continue; } r -= I_G;
        if (r < I_O) { const int kb = r / 32, nb = r % 32; p0_transpose_item(a.w_out, 1024, 1024, kb * 64, nb * 32, (GAS bf16_t*)(ws + WS_WO), nb * 32, scr, lane); continue; } r -= I_O;
        { const int kb = r / 64, nb = r % 64; p0_colmax_item(a.w_pq, 2048, kb * 64, nb * 32, (GAS unsigned*)(ws + WS_CTL) + CW_COLMAX + 14336 + nb * 32, lane); }
    }
    const int gt = vcu * NTHR + tid, NGT = G * NTHR;
    for (int i = gt; i < NP; i += NGT) ((float*)(ws + WS_BIASP))[i] = a.b_in[win_src_col(i)];
    for (int i = gt; i < 1024; i += NGT) { const float t0 = a.lb_table[i], t1 = a.lb_table[1024 + i]; ((float*)(ws + WS_LB))[i] = 1.0f / (1.0f + __expf(t1 - t0)); }
    for (int i = gt; i < 8 * 2 * 128 * 128 / 4; i += NGT) { const f32x4 v = ((const f32x4*)a.sub_keys)[i]; u32x2 o; o.x = pk2(v[0], v[1]); o.y = pk2(v[2], v[3]); ((u32x2*)(ws + WS_SK))[i] = o; }
    f32x4 g1[4];
#pragma unroll
    for (int j = 0; j < 4; ++j) g1[j] = ((const GAS f32x4*)a.norm1_g)[64 * j + lane];
    f32x4 gw0[16], gw1[16];
#pragma unroll
    for (int j = 0; j < 4; ++j)
#pragma unroll
        for (int e = 0; e < 4; ++e) { const int k = 256 * j + 4 * lane + e; gw0[4 * j + e] = *(const GAS f32x4*)(a.w_in + (size_t)k * IN_COLS + 6144); gw1[4 * j + e] = *(const GAS f32x4*)(a.w_in + (size_t)k * IN_COLS + 6148); }
    const float gbias = lane < 8 ? a.b_in[6144 + lane] : 0.f;
    for (int m = gw; m < T; m += NGW) {
        const GAS f32x4* xr = (const GAS f32x4*)(a.x + (size_t)m * D) + lane;
        f32x4 v[4]; float s = 0.f;
#pragma unroll
        for (int j = 0; j < 4; ++j) { v[j] = xr[64 * j]; s += (v[j][0] * v[j][0] + v[j][1] * v[j][1]) + (v[j][2] * v[j][2] + v[j][3] * v[j][3]); }
        const float rstd = rsqrtf(wave_sum(s, lane) * (1.f / D) + EPS);
        f32x4 ga0 = (f32x4){0.f, 0.f, 0.f, 0.f}, ga1 = ga0;
        float mx = 0.f;
#pragma unroll
        for (int j = 0; j < 4; ++j) {
            v[j] = v[j] * rstd * g1[j];
            mx = fmaxf(mx, fmaxf(fmaxf(fabsf(v[j][0]), fabsf(v[j][1])), fmaxf(fabsf(v[j][2]), fabsf(v[j][3]))));
#pragma unroll
            for (int e = 0; e < 4; ++e) { ga0 += gw0[4 * j + e] * v[j][e]; ga1 += gw1[4 * j + e] * v[j][e]; }
        }
        {
            mx = wave_max(mx);
            const float qs = mx > 0.f ? 127.0f / mx : 0.f;
#pragma unroll
            for (int jq = 0; jq < 4; ++jq) ((GAS unsigned*)(ws + WS_XN8 + (size_t)m * 1024))[64 * jq + lane] = pack_i8x4(v[jq][0] * qs, v[jq][1] * qs, v[jq][2] * qs, v[jq][3] * qs);
            if (lane == 0) ((GAS float*)(ws + WS_SA8))[m] = mx * (1.0f / 127.0f);
        }
        float ga[8] = {ga0[0], ga0[1], ga0[2], ga0[3], ga1[0], ga1[1], ga1[2], ga1[3]};
#pragma unroll
        for (int q = 0; q < 8; ++q) ga[q] = wave_sum(ga[q], lane);
        if (lane < 8) { float r = ga[0];
#pragma unroll
            for (int q = 1; q < 8; ++q) r = (lane == q) ? ga[q] : r;
            ((GAS float*)(ws + WS_GATES))[(size_t)m * 8 + lane] = r + gbias; }
    }
}

__device__ __forceinline__ float logsigf_(float x) { return fminf(x, 0.f) - log1pf(__expf(-fabsf(x))); }
#define LDS_BAR() do { asm volatile("s_waitcnt lgkmcnt(0)" ::: "memory"); __builtin_amdgcn_s_barrier(); asm volatile("" ::: "memory"); } while (0)
#define MFMA16(a, b, c) __builtin_amdgcn_mfma_f32_16x16x32_bf16((a), (b), (c), 0, 0, 0)
__device__ __forceinline__ bf16x8 lfrag(const LAS unsigned char* base, int pitch, int row, int k0, int fq) { return *(const LAS bf16x8*)(base + row * pitch + (k0 + 8 * fq) * 2); }
__device__ __forceinline__ int fm_off(int r, int k, int KB) { return (((r >> 4) * KB + (k >> 5)) << 10) + (((((k >> 3) & 3) << 4) + (r & 15)) << 4) + ((k & 7) << 1); }
__device__ __forceinline__ int fm8_off(int r, int k, int KP) { return (((r >> 4) * KP + (k >> 6)) << 10) + (((((k >> 3) & 3) << 4) + (r & 15)) << 4) + (((k >> 5) & 1) << 3) + (k & 7); }
__device__ __forceinline__ unsigned pack_fp8x4(float a, float b, float c, float d) { int p = __builtin_amdgcn_cvt_pk_fp8_f32(a, b, 0, false); p = __builtin_amdgcn_cvt_pk_fp8_f32(c, d, p, true); return (unsigned)p; }
__device__ __forceinline__ bf16x8 fp8_frag(unsigned a, unsigned b) {
    const f32x2 f0 = __builtin_amdgcn_cvt_pk_f32_fp8((int)a, false), f1 = __builtin_amdgcn_cvt_pk_f32_fp8((int)a, true), f2 = __builtin_amdgcn_cvt_pk_f32_fp8((int)b, false), f3 = __builtin_amdgcn_cvt_pk_f32_fp8((int)b, true);
    u32x4 o; o.x = pk2(f0[0], f0[1]); o.y = pk2(f1[0], f1[1]); o.z = pk2(f2[0], f2[1]); o.w = pk2(f3[0], f3[1]);
    return __builtin_bit_cast(bf16x8, o);
}
constexpr float MS_SQ = 64.0f, MS_K = 8.0f;
__device__ __forceinline__ bf16x8 gfrag(const bf16_t* base, int ld, int row, int k0, int fq) { return *(const bf16x8*)(base + (size_t)row * ld + k0 + 8 * fq); }

__device__ __forceinline__ void phase_p0c(const DArgs& a, LAS unsigned char* lds, int vcu, int G) {
    const int tid = tid_(), lane = tid & 63, wave = tid >> 6;
    const int gw = vcu * NWAVES + wave, NGW = G * NWAVES;
    GAS unsigned char* ws = a.ws;
    LAS float* scr = (LAS float*)(lds + wave * 16384);
    constexpr int J_IN = 16 * 384, J_M = 32 * 32, J_G = 16 * 32, J_PQ = 16 * 64;
    const GAS unsigned* cmx = (const GAS unsigned*)(ws + WS_CTL) + CW_COLMAX; GAS float* sb = (GAS float*)(ws + WS_SB8);
    for (int it = gw; it < J_IN + J_M + J_G + J_PQ; it += NGW) {
        int r = it;
        if (r < J_IN) { const int kb = r / 384, nb = r % 384;
            p0_cvt8_item(a.w_in, IN_COLS, kb * 64, win_src_col(nb * 32), cmx + nb * 32, ws + WS_W8A, 1024, sb + nb * 32, nb * 32, scr, lane); continue; } r -= J_IN;
        if (r < J_M) { const int kb = r / 32, nb = r % 32; p0_cvt8_item(a.w_br_m, 1024, kb * 64, nb * 32, cmx + 12288 + nb * 32, ws + WS_WM, 2048, sb + 12288 + nb * 32, nb * 32, scr, lane); continue; } r -= J_M;
        if (r < J_G) { const int kb = r / 32, nb = r % 32; p0_cvt8_item(a.w_br_g, 1024, kb * 64, nb * 32, cmx + 13312 + nb * 32, ws + WS_WG, 1024, sb + 13312 + nb * 32, nb * 32, scr, lane); continue; } r -= J_G;
        { const int kb = r / 64, nb = r % 64; p0_cvt8_item(a.w_pq, 2048, kb * 64, nb * 32, cmx + 14336 + nb * 32, ws + WS_WPQ, 1024, sb + 14336 + nb * 32, nb * 32, scr, lane); }
    }
}
__device__ __forceinline__ void mscan_pair(const DArgs& a, LAS unsigned char* lds, int round, int p) {
    const int tid = tid_(), lane = tid & 63, part = tid >> 6;
    const int bl = p >> 2, h = p & 3, b = round * 2 + bl;
    const GAS float* g = (const GAS float*)(a.ws + WS_GATES) + ((size_t)b * SEQ + (size_t)lane * 128 + part * 16) * 8;
    float bsum = 0.f, gm = -INFINITY;
#pragma unroll 4
    for (int s = 0; s < 16; ++s) { const float ip = g[s * 8 + h], fp = g[s * 8 + 4 + h]; bsum += logsigf_(fp); gm = fmaxf(gm, ip - bsum); }
    LAS float* PS = (LAS float*)lds; LAS float* PM = PS + 512;
    PS[part * 64 + lane] = bsum; PM[part * 64 + lane] = gm;
    __syncthreads();
    if (tid < 64) {
        float bs = 0.f, g2 = -INFINITY;
#pragma unroll
        for (int q = 0; q < 8; ++q) { g2 = fmaxf(g2, PM[q * 64 + lane] - bs); bs += PS[q * 64 + lane]; }
        float mprev = 0.f, mine = 0.f;
        for (int c = 0; c < 64; ++c) {
            const float bc = rdlane(bs, c), gc = rdlane(g2, c);
            if (lane == c) mine = mprev; mprev = bc + fmaxf(mprev, gc); }
        ((GAS float*)(a.ws + WS_MPREV))[(round * 8 + p) * 64 + lane] = mine;
    }
    __syncthreads();
}

constexpr int PQ_PITCH = 528, PS_PITCH = 272;
__device__ __forceinline__ void mlstm_pre_item(const DArgs& a, LAS unsigned char* lds, int round, int item) {
    const int tid = tid_(), lane = tid & 63, wave = __builtin_amdgcn_readfirstlane(tid >> 6), fr = lane & 15, fq = lane >> 4;
    const int p = item >> 6, c = item & 63, bl = p >> 2, h = p & 3, b = round * 2 + bl;
    const int tl0 = bl * SEQ + c * 128; const size_t tg0 = (size_t)b * SEQ + c * 128;
    GAS unsigned char* ws = a.ws;
    LAS unsigned char* QL = lds; LAS unsigned char* KL = lds + 67584;
    LAS float* AS = (LAS float*)(lds + 135168); LAS float* MS = AS + 128; LAS float* SC = AS + 256;
    if (wave == 0) {
        const float mprev = ((const float*)(ws + WS_MPREV))[(round * 8 + p) * 64 + c];
        const float* g = (const float*)(ws + WS_GATES) + (tg0 + 2 * lane) * 8;
        const float ip0 = g[h], fp0 = g[4 + h], ip1 = g[8 + h], fp1 = g[12 + h];
        const float lf0 = logsigf_(fp0), lf1 = logsigf_(fp1), pp = lf0 + lf1;
        float incl = pp;
#pragma unroll
        for (int o = 1; o < 64; o <<= 1) { const float t = shup(incl, o, lane); if (lane >= o) incl += t; }
        const float excl = incl - pp, b0 = excl + lf0, b1 = incl;
        const float a0 = ip0 - b0, a1 = ip1 - b1;
        float inclm = fmaxf(a0, a1);
#pragma unroll
        for (int o = 1; o < 64; o <<= 1) { const float t = shup(inclm, o, lane); if (lane >= o) inclm = fmaxf(inclm, t); }
        float exclm = shup(inclm, 1, lane); if (lane == 0) exclm = -INFINITY;
        const float M0 = fmaxf(mprev, fmaxf(exclm, a0)), M1 = fmaxf(mprev, inclm);
        AS[2 * lane] = a0; AS[2 * lane + 1] = a1; MS[2 * lane] = M0; MS[2 * lane + 1] = M1;
        float* mt = (float*)(ws + WS_MT) + (tg0 + 2 * lane) * 4 + h;
        mt[0] = b0 + M0; mt[4] = b1 + M1;
        const float Mlast = rdlane(M1, 63);
        if (lane == 0) { SC[0] = mprev; SC[1] = Mlast; ((float*)(ws + WS_MDEC))[item] = __expf(mprev - Mlast); }
    }
    {
        const int cgp = tid & 63, strip = tid >> 6;
        const int col = (cgp < 32) ? (h * 256 + cgp * 8) : (1024 + h * 256 + (cgp - 32) * 8);
        float w[4][8], bb[8];
#pragma unroll
        for (int j = 0; j < 4; ++j) { const f32x4 w0 = *(const f32x4*)(a.conv_w + j * 2048 + col), w1 = *(const f32x4*)(a.conv_w + j * 2048 + col + 4);
#pragma unroll
            for (int e = 0; e < 4; ++e) { w[j][e] = w0[e]; w[j][4 + e] = w1[e]; } }
        { const f32x4 b0 = *(const f32x4*)(a.conv_b + col), b1 = *(const f32x4*)(a.conv_b + col + 4);
#pragma unroll
            for (int e = 0; e < 4; ++e) { bb[e] = b0[e]; bb[4 + e] = b1[e]; } }
        const bf16_t* src = (const bf16_t*)(ws + WS_QKPRE) + (size_t)(tl0 + 16 * strip) * 2048 + col;
        const float qs = (cgp < 32) ? 0.0625f : 1.0f;
        LAS unsigned char* dstt = ((cgp < 32) ? QL : KL) + (cgp & 31) * 16;
#pragma unroll 1
        for (int half = 0; half < 2; ++half) {
            u32x4 xr[11];
#pragma unroll
            for (int r = 0; r < 11; ++r) {
                const int sl = c * 128 + 16 * strip + 8 * half + r - 3;
                xr[r] = (sl >= 0) ? *(const u32x4*)(src + (ptrdiff_t)(8 * half + r - 3) * 2048) : (u32x4){0u, 0u, 0u, 0u};
            }
#pragma unroll
            for (int r = 0; r < 8; ++r) {
                float y[8];
#pragma unroll
                for (int e = 0; e < 8; ++e) y[e] = bb[e];
#pragma unroll
                for (int j = 0; j < 4; ++j) { const u32x4 xv = xr[r + j];
                    y[0] += w[j][0] * bf_lo(xv.x); y[1] += w[j][1] * bf_hi(xv.x); y[2] += w[j][2] * bf_lo(xv.y); y[3] += w[j][3] * bf_hi(xv.y);
                    y[4] += w[j][4] * bf_lo(xv.z); y[5] += w[j][5] * bf_hi(xv.z); y[6] += w[j][6] * bf_lo(xv.w); y[7] += w[j][7] * bf_hi(xv.w); }
#pragma unroll
                for (int e = 0; e < 8; ++e) y[e] = siluf_(y[e]) * qs;
                u32x4 o; o.x = pk2(y[0], y[1]); o.y = pk2(y[2], y[3]); o.z = pk2(y[4], y[5]); o.w = pk2(y[6], y[7]);
                *(LAS u32x4*)(dstt + (16 * strip + 8 * half + r) * PQ_PITCH) = o;
            }
        }
    }
    __syncthreads();
    const float mprev = SC[0], Mlast = SC[1];
    {
        GAS unsigned char* Sg = ws + WS_S + (size_t)item * 16384;
        const int t = wave * 16 + fr; const float Mt = MS[t];
        for (int st = 0; st < 8; ++st) {
            unsigned o = 0u;
            if (st <= wave) {
                f32x4 acc = (f32x4){0.f, 0.f, 0.f, 0.f};
#pragma unroll
                for (int ks = 0; ks < 8; ++ks) acc = MFMA16(lfrag(KL, PQ_PITCH, st * 16 + fr, ks * 32, fq), lfrag(QL, PQ_PITCH, wave * 16 + fr, ks * 32, fq), acc);
                float v[4];
#pragma unroll
                for (int j = 0; j < 4; ++j) { const int s = st * 16 + 4 * fq + j; v[j] = (s <= t) ? acc[j] * __expf(AS[s] - Mt) : 0.f; }
                o = pack_fp8x4(v[0] * MS_SQ, v[1] * MS_SQ, v[2] * MS_SQ, v[3] * MS_SQ);
            }
            *(GAS unsigned*)(Sg + fm8_off(t, st * 16 + 4 * fq, 2)) = o;
        }
    }
    {
        GAS unsigned char* Qg = ws + WS_QT + (size_t)item * 32768;
#pragma unroll
        for (int i = 0; i < 8; ++i) { const int idx = tid + 512 * i, blk = idx >> 6, t = (blk >> 3) * 16 + (idx & 15), ch = (blk & 7) * 4 + ((idx >> 4) & 3);
            const u32x4 v = *(const LAS u32x4*)(QL + t * PQ_PITCH + ch * 16); const float s = __expf(mprev - MS[t]) * MS_SQ;
            u32x2 o; o.x = pack_fp8x4(bf_lo(v.x) * s, bf_hi(v.x) * s, bf_lo(v.y) * s, bf_hi(v.y) * s); o.y = pack_fp8x4(bf_lo(v.z) * s, bf_hi(v.z) * s, bf_lo(v.w) * s, bf_hi(v.w) * s);
            *(GAS u32x2*)(Qg + fm8_off(t, ch * 8, 4)) = o; }
    }
    {
        GAS unsigned char* Kg = ws + WS_KWT + (size_t)item * 32768;
        const int dlo = lane & 15, sglo = lane >> 4;
#pragma unroll
        for (int i = 0; i < 8; ++i) { const int combo = wave * 8 + i, d = (combo >> 2) * 16 + dlo, s0 = ((combo & 3) * 4 + sglo) * 8;
            float v[8];
#pragma unroll
            for (int e = 0; e < 8; ++e) v[e] = bf2f(*(const LAS bf16_t*)(KL + (s0 + e) * PQ_PITCH + d * 2)) * (__expf(AS[s0 + e] - Mlast) * MS_K);
            u32x2 o; o.x = pack_fp8x4(v[0], v[1], v[2], v[3]); o.y = pack_fp8x4(v[4], v[5], v[6], v[7]);
            *(GAS u32x2*)(Kg + fm8_off(d, s0, 2)) = o; }
    }
    __syncthreads();
}

__device__ __forceinline__ void hgrn_pre_load(const DArgs& a, int round, int item, u32x4 (&gq)[4]) {
    const int tid = tid_();
    const int p = item >> 7, c = item & 127, bl = p >> 3, h = p & 7;
    const int tl0 = bl * SEQ + c * 64;
    GAS unsigned char* ws = a.ws;
#pragma unroll
    for (int i = 0; i < 2; ++i) { const int idx = tid + 512 * i, s = idx >> 4, ch = idx & 15;
        gq[2 * i] = *(const GAS u32x4*)((const GAS bf16_t*)(ws + WS_GFLOG) + (size_t)(tl0 + s) * 1024 + h * 128 + ch * 8);
        gq[2 * i + 1] = *(const GAS u32x4*)((const GAS bf16_t*)(ws + WS_GQ) + (size_t)(tl0 + s) * 1024 + h * 128 + ch * 8); }
}
__device__ __forceinline__ void hgrn_pre_item(const DArgs& a, LAS unsigned char* lds, int round, int item, u32x4 (&gq)[4], int next_item) {
    const int tid = tid_(), lane = tid & 63, wave = __builtin_amdgcn_readfirstlane(tid >> 6), fr = lane & 15, fq = lane >> 4;
    const int p = item >> 7, c = item & 127, bl = p >> 3, h = p & 7;
    const int tl0 = bl * SEQ + c * 64;
    GAS unsigned char* ws = a.ws;
    LAS float* CUM = (LAS float*)lds;
    LAS float* GL = (LAS float*)(lds + 32768);
    LAS unsigned char* QH = lds + 65536;
    LAS unsigned char* KE = lds + 65536 + 64 * PS_PITCH;
    LAS float* QF = (LAS float*)(lds + 65536 + 128 * PS_PITCH);
#pragma unroll
    for (int i = 0; i < 2; ++i) { const int idx = tid + 512 * i, s = idx >> 4, ch = idx & 15;
        const u32x4 gv = gq[2 * i], qv = gq[2 * i + 1];
        LAS float* gd = GL + s * 128 + ch * 8; LAS float* qd = QF + s * 128 + ch * 8;
        gd[0] = bf_lo(gv.x); gd[1] = bf_hi(gv.x); gd[2] = bf_lo(gv.y); gd[3] = bf_hi(gv.y); gd[4] = bf_lo(gv.z); gd[5] = bf_hi(gv.z); gd[6] = bf_lo(gv.w); gd[7] = bf_hi(gv.w);
        qd[0] = bf_lo(qv.x); qd[1] = bf_hi(qv.x); qd[2] = bf_lo(qv.y); qd[3] = bf_hi(qv.y); qd[4] = bf_lo(qv.z); qd[5] = bf_hi(qv.z); qd[6] = bf_lo(qv.w); qd[7] = bf_hi(qv.w); }
    if (next_item < 2048) hgrn_pre_load(a, round, next_item, gq);
    LDS_BAR();
    {
        const int d = tid & 127, qt = tid >> 7; float cs = 0.f;
#pragma unroll 4
        for (int s = 0; s < 16; ++s) { cs += GL[(qt * 16 + s) * 128 + d]; CUM[(qt * 16 + s) * 128 + d] = cs; }
        LDS_BAR();
        float off = 0.f;
#pragma unroll
        for (int q = 0; q < 3; ++q) off += (q < qt) ? CUM[(q * 16 + 15) * 128 + d] : 0.f;
        LDS_BAR();
#pragma unroll 4
        for (int s = 0; s < 16; ++s) CUM[(qt * 16 + s) * 128 + d] += off;
        if (qt == 3) ((GAS float*)(ws + WS_HGDEC))[(size_t)item * 128 + d] = __expf(cs + off);
    }
    LDS_BAR();
    {
        GAS unsigned char* Qg = ws + WS_QTG + (size_t)item * 8192;
#pragma unroll
        for (int i = 0; i < 2; ++i) { const int idx = tid + 512 * i, s = idx >> 4, ch = idx & 15;
            float qt[8], qh[8], ke[8];
#pragma unroll
            for (int e = 0; e < 8; ++e) { const int d = ch * 8 + e; const float cm = CUM[s * 128 + d], last = CUM[63 * 128 + d], q = QF[s * 128 + d], g = GL[s * 128 + d];
                qt[e] = q * __expf(cm); qh[e] = q * __expf(cm - last); ke[e] = (1.0f - __expf(g)) * __expf(last - cm); }
            { u32x2 o8; o8.x = pack_fp8x4(qt[0] * 16.0f, qt[1] * 16.0f, qt[2] * 16.0f, qt[3] * 16.0f); o8.y = pack_fp8x4(qt[4] * 16.0f, qt[5] * 16.0f, qt[6] * 16.0f, qt[7] * 16.0f);
              *(GAS u32x2*)(Qg + fm8_off(s, ch * 8, 2)) = o8; }
            u32x4 o;
            o.x = pk2(qh[0], qh[1]); o.y = pk2(qh[2], qh[3]); o.z = pk2(qh[4], qh[5]); o.w = pk2(qh[6], qh[7]);
            *(LAS u32x4*)(QH + s * PS_PITCH + ch * 16) = o;
            o.x = pk2(ke[0], ke[1]); o.y = pk2(ke[2], ke[3]); o.z = pk2(ke[4], ke[5]); o.w = pk2(ke[6], ke[7]);
            *(LAS u32x4*)(KE + s * PS_PITCH + ch * 16) = o; }
    }
    LDS_BAR();
    {
        GAS unsigned char* Ag = ws + WS_ATT + (size_t)item * 4096;
#pragma unroll
        for (int i = 0; i < 2; ++i) { const int tile = wave * 2 + i, tt = tile >> 2, st = tile & 3; const int t = tt * 16 + fr;
            unsigned o = 0u;
            if (st <= tt) { f32x4 acc = (f32x4){0.f, 0.f, 0.f, 0.f};
#pragma unroll
                for (int ks = 0; ks < 4; ++ks) acc = MFMA16(lfrag(KE, PS_PITCH, st * 16 + fr, ks * 32, fq), lfrag(QH, PS_PITCH, tt * 16 + fr, ks * 32, fq), acc);
                float v[4];
#pragma unroll
                for (int j = 0; j < 4; ++j) { const int s = st * 16 + 4 * fq + j; v[j] = (s <= t) ? acc[j] : 0.f; }
                o = pack_fp8x4(v[0] * 16.0f, v[1] * 16.0f, v[2] * 16.0f, v[3] * 16.0f); }
            *(GAS unsigned*)(Ag + fm8_off(t, st * 16 + 4 * fq, 1)) = o; }
    }
    {
        GAS unsigned char* Kg = ws + WS_KENDT + (size_t)item * 8192;
        const int dlo = lane & 15, sglo = lane >> 4;
#pragma unroll
        for (int i = 0; i < 2; ++i) { const int combo = wave * 2 + i, d = (combo >> 1) * 16 + dlo, s0 = ((combo & 1) * 4 + sglo) * 8;
            unsigned v[8];
#pragma unroll
            for (int e = 0; e < 8; ++e) v[e] = *(const LAS bf16_t*)(KE + (s0 + e) * PS_PITCH + d * 2);
            u32x2 o; o.x = pack_fp8x4(bf_lo(v[0]) * 16.0f, bf_lo(v[1]) * 16.0f, bf_lo(v[2]) * 16.0f, bf_lo(v[3]) * 16.0f);
            o.y = pack_fp8x4(bf_lo(v[4]) * 16.0f, bf_lo(v[5]) * 16.0f, bf_lo(v[6]) * 16.0f, bf_lo(v[7]) * 16.0f);
            *(GAS u32x2*)(Kg + fm8_off(d, s0, 1)) = o; }
    }
    LDS_BAR();
}

template <int NVT, bool DEN>
__device__ __forceinline__ void mlstm_scan(const DArgs& a, LAS unsigned char* lds, int round, int p, int sl) {
    const int tid = tid_(), lane = tid & 63, wave = __builtin_amdgcn_readfirstlane(tid >> 6), fr = lane & 15, fq = lane >> 4;
    const int bl = p >> 2, h = p & 3, b = round * 2 + bl;
    GAS unsigned char* ws = a.ws;
    constexpr int VTB = NVT * 16 * PS_PITCH, CTB = NVT * 16 * PQ_PITCH;
    LAS unsigned char* VT = lds; LAS unsigned char* CT = lds + 2 * VTB; LAS float* DEC = (LAS float*)(lds + 2 * VTB + 2 * CTB);
    for (int i = tid; i < (2 * VTB + 2 * CTB) / 4; i += NTHR) ((LAS unsigned*)lds)[i] = 0u;
    if (tid < 64) DEC[tid] = ((const GAS float*)(ws + WS_MDEC))[p * 64 + tid];
    __syncthreads();
    if (DEN) { if (tid < 256) { const int bufi = tid >> 7, s = tid & 127; *(LAS bf16_t*)(VT + bufi * VTB + s * 2) = (bf16_t)0x3F80; } }
    f32x4 st[2][NVT];
#pragma unroll
    for (int dt = 0; dt < 2; ++dt)
#pragma unroll
        for (int vt = 0; vt < NVT; ++vt) st[dt][vt] = (f32x4){0.f, 0.f, 0.f, 0.f};
    const int vcol = h * 512 + sl * 32;
    const int vs = tid >> 2, vpart = tid & 3;
    const GAS unsigned char* Sg0 = ws + WS_S + (size_t)(p * 64) * 16384 + wave * 2048 + lane * 16;
    const GAS unsigned char* Qg0 = ws + WS_QT + (size_t)(p * 64) * 32768 + wave * 4096 + lane * 16;
    const GAS unsigned char* Kg0 = ws + WS_KWT + (size_t)(p * 64) * 32768 + wave * 4096 + lane * 16;
    const GAS bf16_t* Vg0 = (const GAS bf16_t*)(ws + WS_V) + (size_t)(bl * SEQ + vs) * 2048 + vcol + vpart * 8;
    u32x4 rS[2], rQ[4], rK[2][2]; u32x4 vreg = (u32x4){0u, 0u, 0u, 0u};
#define V_STAGE(cc_) do { LAS unsigned char* d0_ = VT + ((cc_) & 1) * VTB + (vpart * 8) * PS_PITCH + vs * 2; \
        *(LAS bf16_t*)(d0_ + 0 * PS_PITCH) = (bf16_t)(vreg.x & 0xffffu); *(LAS bf16_t*)(d0_ + 1 * PS_PITCH) = (bf16_t)(vreg.x >> 16); \
        *(LAS bf16_t*)(d0_ + 2 * PS_PITCH) = (bf16_t)(vreg.y & 0xffffu); *(LAS bf16_t*)(d0_ + 3 * PS_PITCH) = (bf16_t)(vreg.y >> 16); \
        *(LAS bf16_t*)(d0_ + 4 * PS_PITCH) = (bf16_t)(vreg.z & 0xffffu); *(LAS bf16_t*)(d0_ + 5 * PS_PITCH) = (bf16_t)(vreg.z >> 16); \
        *(LAS bf16_t*)(d0_ + 6 * PS_PITCH) = (bf16_t)(vreg.w & 0xffffu); *(LAS bf16_t*)(d0_ + 7 * PS_PITCH) = (bf16_t)(vreg.w >> 16); } while (0)
    if (!DEN) { vreg = *(const GAS u32x4*)Vg0; V_STAGE(0); }
    __builtin_amdgcn_sched_barrier(0);
#pragma unroll
    for (int kp = 0; kp < 2; ++kp)
#pragma unroll
        for (int dt = 0; dt < 2; ++dt) rK[dt][kp] = *(const GAS u32x4*)(Kg0 + (dt * 2 + kp) * 1024);
    __builtin_amdgcn_sched_barrier(0);
#pragma unroll
    for (int kp = 0; kp < 2; ++kp) rS[kp] = *(const GAS u32x4*)(Sg0 + kp * 1024);
    __builtin_amdgcn_sched_barrier(0);
#pragma unroll
    for (int kp = 0; kp < 4; ++kp) rQ[kp] = *(const GAS u32x4*)(Qg0 + kp * 1024);
    __builtin_amdgcn_sched_barrier(0);
    if (!DEN) vreg = *(const GAS u32x4*)(Vg0 + (size_t)128 * 2048);
    __builtin_amdgcn_sched_barrier(0);
    const GAS unsigned char* pfp; unsigned pfstride;
    { const int tt = (wave * 64 + lane) < 80 ? wave * 64 + lane : 79; const int idx = sl * 5 + (tt >> 4), off = (tt & 15) * 64;
      pfp = (idx < 16 ? ws + WS_S + (size_t)(p * 64) * 16384 + idx * 1024 : idx < 48 ? ws + WS_QT + (size_t)(p * 64) * 32768 + (idx - 16) * 1024 : ws + WS_KWT + (size_t)(p * 64) * 32768 + (idx - 48) * 1024) + off;
      pfstride = idx < 16 ? 16384u : 32768u; }
    unsigned pfv = 0u;
#pragma unroll 1
    for (int c = 0; c < 64; ++c) {
        const int tl0 = bl * SEQ + c * 128; const size_t tg0 = (size_t)b * SEQ + c * 128;
        const int cn = c < 63 ? c + 1 : 63, cn2 = c < 62 ? c + 2 : 63;
        LAS unsigned char* vt_ = VT + (c & 1) * VTB; LAS unsigned char* ct_ = CT + (c & 1) * CTB; LAS unsigned char* ctn = CT + ((c + 1) & 1) * CTB;
        LDS_BAR();
        if (!DEN && wave < 2) { asm volatile("" :: "v"(pfv)); const int c3 = c < 60 ? c + 3 : 63; pfv = *(const GAS unsigned*)(pfp + (size_t)c3 * pfstride); }
        bf16x8 vf[NVT][4], cf[NVT][4];
#pragma unroll
        for (int vt = 0; vt < NVT; ++vt)
#pragma unroll
            for (int ks = 0; ks < 4; ++ks) vf[vt][ks] = lfrag(vt_, PS_PITCH, vt * 16 + fr, ks * 32, fq);
        const float dec = DEC[c];
        __builtin_amdgcn_sched_barrier(0);
#pragma unroll
        for (int dt = 0; dt < 2; ++dt)
#pragma unroll
            for (int vt = 0; vt < NVT; ++vt) st[dt][vt] = st[dt][vt] * dec;
#pragma unroll
        for (int ks = 0; ks < 4; ++ks) {
#pragma unroll
            for (int vt = 0; vt < NVT; ++vt) cf[vt][ks] = lfrag(ct_, PQ_PITCH, vt * 16 + fr, ks * 32, fq);
#pragma unroll
            for (int dt = 0; dt < 2; ++dt) {
                const bf16x8 aK = (ks & 1) ? fp8_frag(rK[dt][ks >> 1].z, rK[dt][ks >> 1].w) : fp8_frag(rK[dt][ks >> 1].x, rK[dt][ks >> 1].y);
#pragma unroll
                for (int vt = 0; vt < NVT; ++vt) st[dt][vt] = MFMA16(aK, vf[vt][ks], st[dt][vt]);
                if (ks & 1) rK[dt][ks >> 1] = *(const GAS u32x4*)(Kg0 + (size_t)cn * 32768 + (dt * 2 + (ks >> 1)) * 1024);
            }
            __builtin_amdgcn_sched_barrier(0);
        }
#pragma unroll
        for (int dt = 0; dt < 2; ++dt)
#pragma unroll
            for (int vt = 0; vt < NVT; ++vt) { const f32x4 sp = st[dt][vt] * (1.0f / MS_K); u32x2 o; o.x = pk2(sp[0], sp[1]); o.y = pk2(sp[2], sp[3]);
                *(LAS u32x2*)(ctn + (vt * 16 + fr) * PQ_PITCH + (wave * 32 + dt * 16 + 4 * fq) * 2) = o; }
        __builtin_amdgcn_sched_barrier(0);
        f32x4 acc[NVT];
#pragma unroll
        for (int vt = 0; vt < NVT; ++vt) acc[vt] = (f32x4){0.f, 0.f, 0.f, 0.f};
#pragma unroll
        for (int ks = 0; ks < 4; ++ks) {
            { const bf16x8 bS = (ks & 1) ? fp8_frag(rS[ks >> 1].z, rS[ks >> 1].w) : fp8_frag(rS[ks >> 1].x, rS[ks >> 1].y);
#pragma unroll
              for (int vt = 0; vt < NVT; ++vt) acc[vt] = MFMA16(vf[vt][ks], bS, acc[vt]); }
            if (ks & 1) rS[ks >> 1] = *(const GAS u32x4*)(Sg0 + (size_t)cn * 16384 + (ks >> 1) * 1024);
            __builtin_amdgcn_sched_barrier(0);
        }
#pragma unroll
        for (int ks = 0; ks < 8; ++ks) {
            { const bf16x8 bQ = (ks & 1) ? fp8_frag(rQ[ks >> 1].z, rQ[ks >> 1].w) : fp8_frag(rQ[ks >> 1].x, rQ[ks >> 1].y);
#pragma unroll
              for (int vt = 0; vt < NVT; ++vt) acc[vt] = MFMA16(cf[vt][ks & 3], bQ, acc[vt]); }
            if (ks < 4) {
#pragma unroll
                for (int vt = 0; vt < NVT; ++vt) cf[vt][ks] = lfrag(ct_, PQ_PITCH, vt * 16 + fr, 128 + ks * 32, fq);
            }
            if (ks & 1) rQ[ks >> 1] = *(const GAS u32x4*)(Qg0 + (size_t)cn * 32768 + (ks >> 1) * 1024);
            __builtin_amdgcn_sched_barrier(0);
        }
        const int t = wave * 16 + fr;
        if (!DEN) {
            GAS bf16_t* hn = (GAS bf16_t*)(ws + WS_QKPRE) + (size_t)(tl0 + t) * 2048 + vcol + 4 * fq;
#pragma unroll
            for (int vt = 0; vt < NVT; ++vt) { const f32x4 av = acc[vt] * (1.0f / MS_SQ); u32x2 o; o.x = pk2(av[0], av[1]); o.y = pk2(av[2], av[3]); *(GAS u32x2*)(hn + vt * 16) = o; }
            V_STAGE(c + 1); vreg = *(const GAS u32x4*)(Vg0 + (size_t)cn2 * 128 * 2048);
        } else {
            if (fq == 0) ((GAS float*)(ws + WS_DEN))[(tg0 + t) * 4 + h] = acc[0][0] * (1.0f / MS_SQ);
        }
    }
    asm volatile("" :: "v"(pfv));
    __syncthreads();
#undef V_STAGE
}

constexpr int HG_PD = 4;
constexpr float HS = 16.0f;
__device__ __forceinline__ void hgrn_scan(const DArgs& a, LAS unsigned char* lds, int round, int p, int sl) {
    const int tid = tid_(), lane = tid & 63, wave = __builtin_amdgcn_readfirstlane(tid >> 6), fr = lane & 15, fq = lane >> 4;
    const int bl = p >> 3, h = p & 7;
    GAS unsigned char* ws = a.ws;
    constexpr int IP = 144, ITB = 32 * IP, STB = 32 * PS_PITCH;
    LAS unsigned char* IT = lds; LAS unsigned char* ST = lds + 2 * ITB;
    for (int i = tid; i < (2 * ITB + 2 * STB) / 4; i += NTHR) ((LAS unsigned*)lds)[i] = 0u;
    __syncthreads();
    f32x4 st[2][2];
#pragma unroll
    for (int i = 0; i < 2; ++i) { st[i][0] = (f32x4){0.f, 0.f, 0.f, 0.f}; st[i][1] = st[i][0]; }
    const int vcol = h * 128 + sl * 32;
    const int is = (tid & 255) >> 2, ipart = tid & 3;
    const bool outw = wave < 4;
    const int w4 = wave & 3;
    const GAS unsigned char* Ag0 = ws + WS_ATT + (size_t)(p * 128) * 4096 + w4 * 1024 + lane * 16;
    const GAS unsigned char* Qg0 = ws + WS_QTG + (size_t)(p * 128) * 8192 + w4 * 2048 + lane * 16;
    const GAS unsigned char* Kg0 = ws + WS_KENDT + (size_t)(p * 128) * 8192 + w4 * 2048 + lane * 16;
    const GAS unsigned char* Dg0 = ws + WS_HGDEC + ((size_t)(p * 128) * 128 + w4 * 32 + 4 * fq) * 4;
    const GAS unsigned char* Ig0 = ws + WS_GI + ((size_t)(bl * SEQ + is) * 1024 + vcol + ipart * 8) * 2;
    const GAS unsigned char* gb0 = outw ? Ag0 : Kg0;          const unsigned gs0 = outw ? 4096u : 8192u;
    const GAS unsigned char* gb1 = outw ? Qg0 : Kg0 + 1024;   const unsigned gs1 = 8192u;
    const GAS unsigned char* gb2 = outw ? Qg0 + 1024 : Dg0;   const unsigned gs2 = outw ? 8192u : 512u;
    const GAS unsigned char* gb3 = outw ? Ig0 : Dg0 + 64;     const unsigned gs3 = outw ? 131072u : 512u;
    u32x4 pf[HG_PD][4];
#define HG_LD(k_, j_, cc_) do { pf[k_][j_] = *(const GAS u32x4*)(((j_) == 0 ? gb0 : (j_) == 1 ? gb1 : (j_) == 2 ? gb2 : gb3) + (size_t)(cc_) * ((j_) == 0 ? gs0 : (j_) == 1 ? gs1 : (j_) == 2 ? gs2 : gs3)); } while (0)
#define HG_C3(cc_) (outw ? ((cc_) + 1 < 128 ? (cc_) + 1 : 127) : (cc_))
#pragma unroll
    for (int k = 0; k < HG_PD; ++k) { HG_LD(k, 0, k); HG_LD(k, 1, k); HG_LD(k, 2, k); HG_LD(k, 3, HG_C3(k)); __builtin_amdgcn_sched_barrier(0); }
    const GAS unsigned char* pfp; unsigned pfstride;
    { const int tt = (wave * 64 + lane) < 80 ? wave * 64 + lane : 79; const int idx = sl * 5 + (tt >> 4), off = (tt & 15) * 64;
      pfp = (idx < 4 ? ws + WS_ATT + (size_t)(p * 128) * 4096 + idx * 1024 : idx < 12 ? ws + WS_QTG + (size_t)(p * 128) * 8192 + (idx - 4) * 1024 : ws + WS_KENDT + (size_t)(p * 128) * 8192 + (idx - 12) * 1024) + off;
      pfstride = idx < 4 ? 4096u : 8192u; }
    unsigned pfv[HG_PD];
#pragma unroll
    for (int k = 0; k < HG_PD; ++k) pfv[k] = 0u;
#define HG_STAGE(dst_, iv_) do { LAS unsigned char* d0_ = (dst_) + (ipart * 8) * IP + is * 2; \
        *(LAS bf16_t*)(d0_ + 0 * IP) = (bf16_t)((iv_).x & 0xffffu); *(LAS bf16_t*)(d0_ + 1 * IP) = (bf16_t)((iv_).x >> 16); \
        *(LAS bf16_t*)(d0_ + 2 * IP) = (bf16_t)((iv_).y & 0xffffu); *(LAS bf16_t*)(d0_ + 3 * IP) = (bf16_t)((iv_).y >> 16); \
        *(LAS bf16_t*)(d0_ + 4 * IP) = (bf16_t)((iv_).z & 0xffffu); *(LAS bf16_t*)(d0_ + 5 * IP) = (bf16_t)((iv_).z >> 16); \
        *(LAS bf16_t*)(d0_ + 6 * IP) = (bf16_t)((iv_).w & 0xffffu); *(LAS bf16_t*)(d0_ + 7 * IP) = (bf16_t)((iv_).w >> 16); } while (0)
#define HG_F(reg_, half_) ((half_) ? fp8_frag((reg_).z, (reg_).w) : fp8_frag((reg_).x, (reg_).y))
    if (outw) { const u32x4 iv = *(const GAS u32x4*)Ig0; HG_STAGE(IT, iv); }
#pragma unroll 1
    for (int c0 = 0; c0 < 128; c0 += HG_PD) {
#pragma unroll
      for (int k = 0; k < HG_PD; ++k) {
        const int c = c0 + k;
        const int tl0 = bl * SEQ + c * 64;
        const int cn = (c + HG_PD < 128) ? c + HG_PD : 127;
        LAS unsigned char* it_ = IT + (k & 1) * ITB; LAS unsigned char* itn = IT + ((k + 1) & 1) * ITB; LAS unsigned char* st_ = ST + (k & 1) * STB; LAS unsigned char* stn = ST + ((k + 1) & 1) * STB;
        LDS_BAR();
        if (wave < 2) { asm volatile("" :: "v"(pfv[k])); const int c7 = (c + HG_PD + 3 < 128) ? c + HG_PD + 3 : 127; pfv[k] = *(const GAS unsigned*)(pfp + (size_t)c7 * pfstride); }
        bf16x8 itf[2][2];
#pragma unroll
        for (int vt = 0; vt < 2; ++vt)
#pragma unroll
            for (int ks = 0; ks < 2; ++ks) itf[vt][ks] = lfrag(it_, IP, vt * 16 + fr, ks * 32, fq);
        bf16x8 sf[2][4];
        f32x4 acc[2];
        acc[0] = (f32x4){0.f, 0.f, 0.f, 0.f}; acc[1] = acc[0];
        if (outw) {
#pragma unroll
            for (int vt = 0; vt < 2; ++vt)
#pragma unroll
                for (int ks = 0; ks < 4; ++ks) sf[vt][ks] = lfrag(st_, PS_PITCH, vt * 16 + fr, ks * 32, fq);
#pragma unroll
            for (int ks = 0; ks < 2; ++ks) { const bf16x8 bA = HG_F(pf[k][0], ks);
#pragma unroll
                for (int vt = 0; vt < 2; ++vt) acc[vt] = MFMA16(itf[vt][ks], bA, acc[vt]); }
        } else {
            const f32x4 dec = __builtin_bit_cast(f32x4, pf[k][2]);
#pragma unroll
            for (int vt = 0; vt < 2; ++vt) st[0][vt] = st[0][vt] * dec;
#pragma unroll
            for (int ks = 0; ks < 2; ++ks) { const bf16x8 aK = HG_F(pf[k][0], ks);
#pragma unroll
                for (int vt = 0; vt < 2; ++vt) st[0][vt] = MFMA16(aK, itf[vt][ks], st[0][vt]); }
        }
        __builtin_amdgcn_sched_barrier(0);
        HG_LD(k, 0, cn);
        __builtin_amdgcn_sched_barrier(0);
        if (outw) {
#pragma unroll
            for (int ks = 0; ks < 2; ++ks) { const bf16x8 bQ = HG_F(pf[k][1], ks);
#pragma unroll
                for (int vt = 0; vt < 2; ++vt) acc[vt] = MFMA16(sf[vt][ks], bQ, acc[vt]); }
        } else {
            const f32x4 dec = __builtin_bit_cast(f32x4, pf[k][3]);
#pragma unroll
            for (int vt = 0; vt < 2; ++vt) st[1][vt] = st[1][vt] * dec;
#pragma unroll
            for (int ks = 0; ks < 2; ++ks) { const bf16x8 aK = HG_F(pf[k][1], ks);
#pragma unroll
                for (int vt = 0; vt < 2; ++vt) st[1][vt] = MFMA16(aK, itf[vt][ks], st[1][vt]); }
        }
        __builtin_amdgcn_sched_barrier(0);
        HG_LD(k, 1, cn);
        __builtin_amdgcn_sched_barrier(0);
        if (outw) {
#pragma unroll
            for (int ks = 2; ks < 4; ++ks) { const bf16x8 bQ = HG_F(pf[k][2], ks & 1);
#pragma unroll
                for (int vt = 0; vt < 2; ++vt) acc[vt] = MFMA16(sf[vt][ks], bQ, acc[vt]); }
        } else {
#pragma unroll
            for (int dtile = 0; dtile < 2; ++dtile)
#pragma unroll
                for (int vt = 0; vt < 2; ++vt) { const f32x4 sp = st[dtile][vt] * (1.0f / HS); u32x2 o; o.x = pk2(sp[0], sp[1]); o.y = pk2(sp[2], sp[3]);
                    *(LAS u32x2*)(stn + (vt * 16 + fr) * PS_PITCH + (w4 * 32 + dtile * 16 + 4 * fq) * 2) = o; }
        }
        __builtin_amdgcn_sched_barrier(0);
        HG_LD(k, 2, cn);
        __builtin_amdgcn_sched_barrier(0);
        if (outw) {
            HG_STAGE(itn, pf[k][3]);
            GAS bf16_t* og = (GAS bf16_t*)(ws + WS_GQ) + (size_t)(tl0 + w4 * 16 + fr) * 1024 + vcol + 4 * fq;
#pragma unroll
            for (int vt = 0; vt < 2; ++vt) { const f32x4 av = acc[vt] * (1.0f / HS); u32x2 o; o.x = pk2(av[0], av[1]); o.y = pk2(av[2], av[3]); *(GAS u32x2*)(og + vt * 16) = o; }
        }
        __builtin_amdgcn_sched_barrier(0);
        HG_LD(k, 3, HG_C3(cn));
        __builtin_amdgcn_sched_barrier(0);
      }
    }
#pragma unroll
    for (int k = 0; k < HG_PD; ++k) asm volatile("" :: "v"(pfv[k]));
    __syncthreads();
#undef HG_LD
#undef HG_C3
#undef HG_F
#undef HG_STAGE
}

__device__ __forceinline__ void xn8_convert(const DArgs& a, int round, int vcu, int G) {
    const int tid = tid_(), lane = tid & 63, wave = tid >> 6;
    const int gw = vcu * NWAVES + wave, NGW = G * NWAVES;
    GAS unsigned char* ws = a.ws;
    for (int tl = gw; tl < RT; tl += NGW) {
        const size_t tg = (size_t)round * RT + tl;
        const GAS u32x2* xr = (const GAS u32x2*)((const GAS bf16_t*)(ws + WS_XN) + tg * D) + lane;
        f32x4 v[4]; float mx = 0.f;
#pragma unroll
        for (int j = 0; j < 4; ++j) { const u32x2 xv = xr[64 * j]; v[j][0] = bf_lo(xv.x); v[j][1] = bf_hi(xv.x); v[j][2] = bf_lo(xv.y); v[j][3] = bf_hi(xv.y);
            mx = fmaxf(mx, fmaxf(fmaxf(fabsf(v[j][0]), fabsf(v[j][1])), fmaxf(fabsf(v[j][2]), fabsf(v[j][3])))); }
        mx = wave_max(mx);
        const float qs = mx > 0.f ? 127.0f / mx : 0.f;
#pragma unroll
        for (int j = 0; j < 4; ++j) ((GAS unsigned*)(ws + WS_XN8 + (size_t)tl * 1024))[64 * j + lane] = pack_i8x4(v[j][0] * qs, v[j][1] * qs, v[j][2] * qs, v[j][3] * qs);
        if (lane == 0) ((GAS float*)(ws + WS_SA8))[tg] = mx * (1.0f / 127.0f);
    }
}

__device__ __forceinline__ void phase_ypass(const DArgs& a, int round, int vcu, int G) {
    const int tid = tid_(), lane = tid & 63, wave = tid >> 6;
    const int gw = vcu * NWAVES + wave, NGW = G * NWAVES;
    GAS unsigned char* ws = a.ws;
    f32x4 mg0[4], mg1[4], gg4[4];
#pragma unroll
    for (int j = 0; j < 4; ++j) { mg0[j] = *(const GAS f32x4*)(a.m_head_g + j * 512 + lane * 8); mg1[j] = *(const GAS f32x4*)(a.m_head_g + j * 512 + lane * 8 + 4); gg4[j] = *(const GAS f32x4*)(a.g_head_g + lane * 16 + 4 * j); }
    for (int tl = gw; tl < RT; tl += NGW) {
        const size_t tg = (size_t)round * RT + tl;
        const f32x4 den4 = *(const f32x4*)((const float*)(ws + WS_DEN) + tg * 4), mt4 = *(const f32x4*)((const float*)(ws + WS_MT) + tg * 4);
        float ym[4][8];
#pragma unroll
        for (int j = 0; j < 4; ++j) {
            const int col = j * 512 + lane * 8;
            const u32x4 nv = *(const u32x4*)((const bf16_t*)(ws + WS_QKPRE) + (size_t)tl * 2048 + col);
            const u32x4 ov = *(const u32x4*)((const bf16_t*)(ws + WS_SIGO) + (size_t)tl * 2048 + col);
            const float inv = 1.0f / fmaxf(fabsf(den4[j]), __expf(-mt4[j]));
            float hv[8] = {bf_lo(nv.x) * inv, bf_hi(nv.x) * inv, bf_lo(nv.y) * inv, bf_hi(nv.y) * inv, bf_lo(nv.z) * inv, bf_hi(nv.z) * inv, bf_lo(nv.w) * inv, bf_hi(nv.w) * inv};
            float ss = 0.f;
#pragma unroll
            for (int e = 0; e < 8; ++e) ss += hv[e] * hv[e];
            const float r = rsqrtf(wave_sum(ss, lane) * (1.f / 512.f) + EPS);
            const f32x4 g0 = mg0[j], g1 = mg1[j];
            const float og[8] = {bf_lo(ov.x), bf_hi(ov.x), bf_lo(ov.y), bf_hi(ov.y), bf_lo(ov.z), bf_hi(ov.z), bf_lo(ov.w), bf_hi(ov.w)};
#pragma unroll
            for (int e = 0; e < 8; ++e) ym[j][e] = og[e] * hv[e] * r * (e < 4 ? g0[e] : g1[e - 4]);
        }
        {
            float mx = 0.f;
#pragma unroll
            for (int j = 0; j < 4; ++j)
#pragma unroll
                for (int e = 0; e < 8; ++e) mx = fmaxf(mx, fabsf(ym[j][e]));
            mx = wave_max(mx);
            const float qs = mx > 0.f ? 127.0f / mx : 0.f;
#pragma unroll
            for (int j = 0; j < 4; ++j) { u32x2 o; o.x = pack_i8x4(ym[j][0] * qs, ym[j][1] * qs, ym[j][2] * qs, ym[j][3] * qs); o.y = pack_i8x4(ym[j][4] * qs, ym[j][5] * qs, ym[j][6] * qs, ym[j][7] * qs);
                *(GAS u32x2*)(ws + WS_V + (size_t)tl * 2048 + j * 512 + lane * 8) = o; }
            if (lane == 0) ((GAS float*)(ws + WS_SYM))[tl] = mx * (1.0f / 127.0f);
        }
        {
            const int col = lane * 16;
            const u32x4 n0 = *(const u32x4*)((const bf16_t*)(ws + WS_GQ) + (size_t)tl * 1024 + col), n1 = *(const u32x4*)((const bf16_t*)(ws + WS_GQ) + (size_t)tl * 1024 + col + 8);
            const u32x4 s0 = *(const u32x4*)((const bf16_t*)(ws + WS_SGG) + (size_t)tl * 1024 + col), s1 = *(const u32x4*)((const bf16_t*)(ws + WS_SGG) + (size_t)tl * 1024 + col + 8);
            float ov[16] = {bf_lo(n0.x), bf_hi(n0.x), bf_lo(n0.y), bf_hi(n0.y), bf_lo(n0.z), bf_hi(n0.z), bf_lo(n0.w), bf_hi(n0.w), bf_lo(n1.x), bf_hi(n1.x), bf_lo(n1.y), bf_hi(n1.y), bf_lo(n1.z), bf_hi(n1.z), bf_lo(n1.w), bf_hi(n1.w)};
            const float sg[16] = {bf_lo(s0.x), bf_hi(s0.x), bf_lo(s0.y), bf_hi(s0.y), bf_lo(s0.z), bf_hi(s0.z), bf_lo(s0.w), bf_hi(s0.w), bf_lo(s1.x), bf_hi(s1.x), bf_lo(s1.y), bf_hi(s1.y), bf_lo(s1.z), bf_hi(s1.z), bf_lo(s1.w), bf_hi(s1.w)};
            float ss = 0.f;
#pragma unroll
            for (int e = 0; e < 16; ++e) ss += ov[e] * ov[e];
            ss += DPP_(ss, 0xB1); ss += DPP_(ss, 0x4E); ss += DPP_(ss, 0x141);
            const float r = rsqrtf(ss * (1.f / 128.f) + EPS);
            float y[16];
#pragma unroll
            for (int e = 0; e < 16; ++e) y[e] = ov[e] * r * gg4[e >> 2][e & 3] * sg[e];
            float mx = 0.f;
#pragma unroll
            for (int e = 0; e < 16; ++e) mx = fmaxf(mx, fabsf(y[e]));
            mx = wave_max(mx);
            const float qs = mx > 0.f ? 127.0f / mx : 0.f;
            u32x4 o; o.x = pack_i8x4(y[0] * qs, y[1] * qs, y[2] * qs, y[3] * qs); o.y = pack_i8x4(y[4] * qs, y[5] * qs, y[6] * qs, y[7] * qs);
            o.z = pack_i8x4(y[8] * qs, y[9] * qs, y[10] * qs, y[11] * qs); o.w = pack_i8x4(y[12] * qs, y[13] * qs, y[14] * qs, y[15] * qs);
            *(GAS u32x4*)(ws + WS_GI + (size_t)tl * 1024 + col) = o;
            if (lane == 0) ((GAS float*)(ws + WS_SYG))[tl] = mx * (1.0f / 127.0f);
        }
    }
}


#define XB_TMO      128
#define XB_XCNT(j)  (256  + 64 * (j))
#define XB_XSUB(j)  (1280 + 64 * (j))
#define XB_XGEN(j)  (2304 + 64 * (j))
#define XB_TOP      3328
#define XB_TOPGEN   3392
#define XB_SPIN_CAP (1u << 22)
constexpr int CW_BAR = 4096;
constexpr int LDS_BARST = LDS_BYTES - 64;
__device__ __forceinline__ unsigned xb_ld(unsigned* p)              { return __hip_atomic_load(p, __ATOMIC_RELAXED, __HIP_MEMORY_SCOPE_AGENT); }
__device__ __forceinline__ unsigned xb_add(unsigned* p, unsigned v) { return __hip_atomic_fetch_add(p, v, __ATOMIC_RELAXED, __HIP_MEMORY_SCOPE_AGENT); }
__device__ __forceinline__ unsigned xb_xcc_id() { return (unsigned)__builtin_amdgcn_s_getreg((3 << 11) | 20) & 0xFu; }
#define XB_SPIN(cond, bar) do { unsigned _sp = 0; while (cond) { __builtin_amdgcn_s_sleep(1); \
    if ((++_sp & 255u) == 0u) { if (xb_ld(&(bar)[XB_TMO])) break; if (_sp > XB_SPIN_CAP) { atomicAdd(&(bar)[XB_TMO], 1u); break; } } } } while (0)
__device__ __forceinline__ void xcd_barrier_post(unsigned* bar, volatile LAS unsigned* st) { if (tid_() == 0) st[2] = xb_add(&bar[XB_XCNT(xb_xcc_id())], 1u); }
__device__ __forceinline__ void xcd_barrier_complete(unsigned* bar, unsigned x, unsigned& nloc, unsigned& nx) {
    const unsigned G = gridDim.x;
    unsigned sum, cnt, mine, sp = 0u;
    for (;;) {
        sum = 0u; cnt = 0u; mine = 0u;
#pragma unroll
        for (unsigned j = 0; j < 16; ++j) { const unsigned c = xb_ld(&bar[XB_XCNT(j)]); sum += c; cnt += (c > 0u) ? 1u : 0u; mine = (j == x) ? c : mine; }
        if (sum == G) break;
        __builtin_amdgcn_s_sleep(1);
        if ((++sp & 255u) == 0u) { if (xb_ld(&bar[XB_TMO])) break; if (sp > XB_SPIN_CAP) { atomicAdd(&bar[XB_TMO], 1u); break; } }
    }
    nloc = mine > 0u ? mine : 1u; nx = cnt > 0u ? cnt : 1u;
}
__device__ __forceinline__ void xcd_barrier(unsigned* bar, volatile LAS unsigned* st) {
    asm volatile("s_waitcnt vmcnt(0)" ::: "memory");
    __syncthreads();
    if (tid_() == 0) {
        const unsigned x = xb_xcc_id();
        __builtin_amdgcn_s_waitcnt(0);
        unsigned nloc = st[0], nx = st[1];
        if (nloc == 0u) { xcd_barrier_complete(bar, x, nloc, nx); st[0] = nloc; st[1] = nx; }
        const unsigned old = xb_add(&bar[XB_XSUB(x)], 1u);
        const unsigned gen = old / nloc;
        if (old + 1u == (gen + 1u) * nloc) {
            __builtin_amdgcn_fence(__ATOMIC_RELEASE, "agent");
            asm volatile("s_waitcnt vmcnt(0)" ::: "memory");
            const unsigned og = xb_add(&bar[XB_TOP], 1u);
            const unsigned tg = og / nx;
            if (og + 1u == (tg + 1u) * nx) xb_add(&bar[XB_TOPGEN], 1u);
            else XB_SPIN(xb_ld(&bar[XB_TOPGEN]) == tg, bar);
            __builtin_amdgcn_fence(__ATOMIC_ACQUIRE, "agent");
            xb_add(&bar[XB_XGEN(x)], 1u);
            asm volatile("s_waitcnt vmcnt(0)" ::: "memory");
        } else {
            XB_SPIN(xb_ld(&bar[XB_XGEN(x)]) == gen, bar);
            __builtin_amdgcn_fence(__ATOMIC_ACQUIRE, "agent");
            asm volatile("s_waitcnt vmcnt(0)" ::: "memory");
        }
    }
    __syncthreads();
}

__device__ __forceinline__ void phase_p8(const DArgs& a, int vcu, int G) {
    const int tid = tid_(), lane = tid & 63, wave = tid >> 6;
    const int gw = vcu * NWAVES + wave, NGW = G * NWAVES;
    GAS unsigned char* ws = a.ws;
    f32x4 g2[4];
#pragma unroll
    for (int j = 0; j < 4; ++j) g2[j] = ((const f32x4*)a.norm2_g)[64 * j + lane];
    for (int m = gw; m < T; m += NGW) {
        const GAS u32x2* xr = (const GAS u32x2*)((const GAS bf16_t*)a.out + (size_t)m * D) + lane;
        f32x4 v[4]; float s = 0.f;
#pragma unroll
        for (int j = 0; j < 4; ++j) { const u32x2 xv = xr[64 * j]; v[j][0] = bf_lo(xv.x); v[j][1] = bf_hi(xv.x); v[j][2] = bf_lo(xv.y); v[j][3] = bf_hi(xv.y); s += (v[j][0] * v[j][0] + v[j][1] * v[j][1]) + (v[j][2] * v[j][2] + v[j][3] * v[j][3]); }
        const float rstd = rsqrtf(wave_sum(s, lane) * (1.f / D) + EPS);
#pragma unroll
        for (int j = 0; j < 4; ++j) v[j] = v[j] * rstd * g2[j];
        float mx = 0.f;
#pragma unroll
        for (int j = 0; j < 4; ++j) mx = fmaxf(mx, fmaxf(fmaxf(fabsf(v[j][0]), fabsf(v[j][1])), fmaxf(fabsf(v[j][2]), fabsf(v[j][3]))));
        mx = wave_max(mx);
        const float qs = mx > 0.f ? 127.0f / mx : 0.f;
#pragma unroll
        for (int j = 0; j < 4; ++j) ((GAS unsigned*)(ws + WS_XQ + (size_t)m * 1024))[64 * j + lane] = pack_i8x4(v[j][0] * qs, v[j][1] * qs, v[j][2] * qs, v[j][3] * qs);
        if (lane == 0) ((GAS float*)(ws + WS_XQS))[m] = mx * (1.0f / 127.0f);
    }
    for (int e = gw; e < 16384; e += NGW) {
        f32x4 uv[4], vv[4]; float mu = 0.f, mv = 0.f;
#pragma unroll
        for (int j = 0; j < 4; ++j) { uv[j] = ((const GAS f32x4*)(a.u_emb + (size_t)e * 1024))[64 * j + lane]; vv[j] = ((const GAS f32x4*)(a.v_emb + (size_t)e * 1024))[64 * j + lane];
            mu = fmaxf(mu, fmaxf(fmaxf(fabsf(uv[j][0]), fabsf(uv[j][1])), fmaxf(fabsf(uv[j][2]), fabsf(uv[j][3]))));
            mv = fmaxf(mv, fmaxf(fmaxf(fabsf(vv[j][0]), fabsf(vv[j][1])), fmaxf(fabsf(vv[j][2]), fabsf(vv[j][3])))); }
        mu = wave_max(mu); mv = wave_max(mv);
        const float su = mu > 0.f ? 127.0f / mu : 0.f, sv = mv > 0.f ? 448.0f / mv : 0.f;
        if (lane == 0) { ((GAS float*)(ws + WS_USC))[e] = mu * (1.0f / 127.0f); ((GAS float*)(ws + WS_VSC))[e] = mv * (1.0f / 448.0f); }
#pragma unroll
        for (int j = 0; j < 4; ++j) {
            const size_t ob = (size_t)(2 * j + (lane >> 5)) * 2097152 + (size_t)e * 128 + ((4 * lane) & 127);
            *(GAS unsigned*)(ws + WS_UB + ob) = pack_i8x4(uv[j][0] * su, uv[j][1] * su, uv[j][2] * su, uv[j][3] * su);
            int p = __builtin_amdgcn_cvt_pk_fp8_f32(vv[j][0] * sv, vv[j][1] * sv, 0, false); p = __builtin_amdgcn_cvt_pk_fp8_f32(vv[j][2] * sv, vv[j][3] * sv, p, true);
            *(GAS unsigned*)(ws + WS_VB + ob) = (unsigned)p; }
    }
}

__device__ __forceinline__ unsigned f2ord(float f) { const unsigned u = __builtin_bit_cast(unsigned, f); return (u & 0x80000000u) ? ~u : (u | 0x80000000u); }
__device__ __forceinline__ float ord2f(unsigned k) { const unsigned u = (k & 0x80000000u) ? (k & 0x7fffffffu) : ~k; return __builtin_bit_cast(float, u); }
__device__ __forceinline__ unsigned umax_(unsigned a, unsigned b) { return a > b ? a : b; }
__device__ __forceinline__ unsigned shxu(unsigned v, int o, int lane) { return (unsigned)__builtin_amdgcn_ds_bpermute((lane ^ o) << 2, (int)v); }

__device__ __forceinline__ unsigned umin_(unsigned a, unsigned b) { return a < b ? a : b; }
#define TK_CE(a_, b_) do { const unsigned hi_ = umax_((a_), (b_)), lo_ = umin_((a_), (b_)); (a_) = hi_; (b_) = lo_; } while (0)
__device__ __forceinline__ void tk_sort16(unsigned (&x)[32], int o) {
#pragma unroll
    for (int k = 2; k <= 16; k <<= 1)
#pragma unroll
        for (int j = k >> 1; j > 0; j >>= 1)
#pragma unroll
            for (int i = 0; i < 16; ++i) { const int l = i ^ j; if (l > i) { if ((i & k) == 0) TK_CE(x[o + i], x[o + l]); else TK_CE(x[o + l], x[o + i]); } }
}
__device__ __forceinline__ void tk_merge16(unsigned (&t)[16]) {
#pragma unroll
    for (int j = 8; j > 0; j >>= 1)
#pragma unroll
        for (int i = 0; i < 16; ++i) { const int l = i ^ j; if (l > i) TK_CE(t[i], t[l]); }
}
__device__ __forceinline__ void phase_topk(const DArgs& a, LAS unsigned char* lds, int bx, int G) {
    const int tid = tid_(), lane = tid & 63, wave = __builtin_amdgcn_readfirstlane(tid >> 6), fr = lane & 15, fq = lane >> 4;
    GAS unsigned char* ws = a.ws;
    const int h = bx & 7;
    LAS unsigned char* KY = lds;
    LAS unsigned char* QL = lds + 2 * 128 * PS_PITCH;
    LAS unsigned* TOP = (LAS unsigned*)(lds + 2 * 128 * PS_PITCH + 64 * PQ_PITCH);
#pragma unroll
    for (int i = 0; i < 8; ++i) { const int idx = tid + 512 * i, row = idx >> 4, ch = idx & 15;
        *(LAS u32x4*)(KY + row * PS_PITCH + ch * 16) = *(const u32x4*)((const bf16_t*)(ws + WS_SK) + ((size_t)h * 256 + row) * 128 + ch * 8); }
    const int ntile = T / 64;
    u32x4 qpre[4];
    { const int tile0 = bx >> 3; if (tile0 < ntile) {
#pragma unroll
        for (int i = 0; i < 4; ++i) { const int idx = tid + 512 * i, row = idx >> 5, ch = idx & 31;
            qpre[i] = *(const GAS u32x4*)((const GAS bf16_t*)(ws + WS_QP) + ((size_t)tile0 * 64 + row) * 2048 + h * 256 + ch * 8); } } }
    __syncthreads();
    for (int tile = bx >> 3; tile < ntile; tile += (G >> 3)) {
        const size_t t0 = (size_t)tile * 64;
        LDS_BAR();
#pragma unroll
        for (int i = 0; i < 4; ++i) { const int idx = tid + 512 * i, row = idx >> 5, ch = idx & 31;
            *(LAS u32x4*)(QL + row * PQ_PITCH + ch * 16) = qpre[i]; }
        { const int tn = tile + (G >> 3); if (tn < ntile) {
#pragma unroll
            for (int i = 0; i < 4; ++i) { const int idx = tid + 512 * i, row = idx >> 5, ch = idx & 31;
                qpre[i] = *(const GAS u32x4*)((const GAS bf16_t*)(ws + WS_QP) + ((size_t)tn * 64 + row) * 2048 + h * 256 + ch * 8); } } }
        LDS_BAR();
        {
            const int mt = wave & 3, p = wave >> 2;
            unsigned key[32];
#pragma unroll
            for (int nt = 0; nt < 8; ++nt) { f32x4 acc = (f32x4){0.f, 0.f, 0.f, 0.f};
#pragma unroll
                for (int ks = 0; ks < 4; ++ks) acc = MFMA16(lfrag(KY + p * 128 * PS_PITCH, PS_PITCH, nt * 16 + fr, ks * 32, fq), lfrag(QL, PQ_PITCH, mt * 16 + fr, p * 128 + ks * 32, fq), acc);
#pragma unroll
                for (int j = 0; j < 4; ++j) { const int n = nt * 16 + 4 * fq + j; key[nt * 4 + j] = (f2ord(acc[j]) & ~127u) | (unsigned)(127 - n); } }
            tk_sort16(key, 0); tk_sort16(key, 16);
            unsigned t[16];
#pragma unroll
            for (int i = 0; i < 16; ++i) t[i] = umax_(key[i], key[31 - i]);
            tk_merge16(t);
            {   unsigned pv[16];
#pragma unroll
                for (int i = 0; i < 16; ++i) pv[i] = (unsigned)SWZI_(t[15 - i], 0x401F);
#pragma unroll
                for (int i = 0; i < 16; ++i) t[i] = umax_(t[i], pv[i]);
                tk_merge16(t);
#pragma unroll
                for (int i = 0; i < 16; ++i) pv[i] = xor32u_(t[15 - i], lane >= 32);
#pragma unroll
                for (int i = 0; i < 16; ++i) t[i] = umax_(t[i], pv[i]);
                tk_merge16(t); }
#pragma unroll
            for (int k = 0; k < 16; ++k) { if (fq == (k & 3)) TOP[(p * 64 + mt * 16 + fr) * 16 + k] = t[k]; }
        }
        LDS_BAR();
        {
            const int t = tid >> 3, sub = tid & 7;
            unsigned ck[7];
#pragma unroll
            for (int e = 0; e < 7; ++e) {
                const int ci = sub + 8 * e;
                int i = 0, base = 0; bool ok = ci < 50;
                if (ci >= 42) { i = 8 + (ci - 42); base = ci; } else if (ci >= 40) { i = 7; base = 40; } else if (ci >= 38) { i = 6; base = 38; } else if (ci >= 36) { i = 5; base = 36; }
                else if (ci >= 33) { i = 4; base = 33; } else if (ci >= 29) { i = 3; base = 29; } else if (ci >= 24) { i = 2; base = 24; } else if (ci >= 16) { i = 1; base = 16; }
                const int j = ci - base;
                unsigned kk = 0u;
                if (ok) { const float s0 = ord2f(TOP[(0 * 64 + t) * 16 + i] & ~127u), s1 = ord2f(TOP[(1 * 64 + t) * 16 + j] & ~127u);
                    kk = (f2ord(s0 + s1) & ~255u) | (unsigned)(255 - (i * 16 + j)); }
                ck[e] = kk;
            }
            unsigned x[16];
#pragma unroll
            for (int e = 0; e < 7; ++e) x[e] = ck[e];
            x[7] = 0u;
#pragma unroll
            for (int k = 2; k <= 8; k <<= 1)
#pragma unroll
                for (int j = k >> 1; j > 0; j >>= 1)
#pragma unroll
                    for (int i = 0; i < 8; ++i) { const int l = i ^ j; if (l > i) { if ((i & k) == 0) TK_CE(x[i], x[l]); else TK_CE(x[l], x[i]); } }
#pragma unroll
            for (int i = 0; i < 8; ++i) x[8 + i] = (unsigned)DPPI_(x[7 - i], 0xB1);
            tk_merge16(x);
            {   unsigned pv[16];
#pragma unroll
                for (int i = 0; i < 16; ++i) pv[i] = (unsigned)DPPI_(x[15 - i], 0x4E);
#pragma unroll
                for (int i = 0; i < 16; ++i) x[i] = umax_(x[i], pv[i]);
                tk_merge16(x);
#pragma unroll
                for (int i = 0; i < 16; ++i) pv[i] = (unsigned)DPPI_(x[15 - i], 0x141);
#pragma unroll
                for (int i = 0; i < 16; ++i) x[i] = umax_(x[i], pv[i]);
                tk_merge16(x); }
            unsigned w0 = x[0], w1 = x[8];
#pragma unroll
            for (int e = 1; e < 8; ++e) { w0 = (sub == e) ? x[e] : w0; w1 = (sub == e) ? x[8 + e] : w1; }
            const int f0 = 255 - (int)(w0 & 255u), f1 = 255 - (int)(w1 & 255u);
            const float sc0 = ord2f(w0 & ~255u), sc1 = ord2f(w1 & ~255u);
            float mx = fmaxf(sc0, sc1); mx = fmaxf(mx, DPP_(mx, 0xB1)); mx = fmaxf(mx, DPP_(mx, 0x4E)); mx = fmaxf(mx, DPP_(mx, 0x141));
            const float e0 = __expf(sc0 - mx), e1 = __expf(sc1 - mx);
            float sm = e0 + e1; sm += DPP_(sm, 0xB1); sm += DPP_(sm, 0x4E); sm += DPP_(sm, 0x141);
            const float inv = 1.0f / sm;
            const int i0 = 127 - (int)(TOP[(0 * 64 + t) * 16 + (f0 >> 4)] & 127u), j0 = 127 - (int)(TOP[(1 * 64 + t) * 16 + (f0 & 15)] & 127u);
            const int i1 = 127 - (int)(TOP[(0 * 64 + t) * 16 + (f1 >> 4)] & 127u), j1 = 127 - (int)(TOP[(1 * 64 + t) * 16 + (f1 & 15)] & 127u);
            unsigned short* ei = (unsigned short*)(ws + WS_EIDX) + ((t0 + t) * 8 + h) * 16; float* gp = (float*)(ws + WS_GATE) + ((t0 + t) * 8 + h) * 16;
            ei[sub] = (unsigned short)(i0 * 128 + j0); ei[sub + 8] = (unsigned short)(i1 * 128 + j1); gp[sub] = e0 * inv; gp[sub + 8] = e1 * inv;
        }
    }
    __syncthreads();
}

__device__ __forceinline__ void ins16(float (&v)[16], int (&id)[16], float x, int n) {
    if (x > v[15]) { v[15] = x; id[15] = n;
#pragma unroll
        for (int i = 15; i >= 1; --i) { if (v[i] > v[i - 1]) { const float tv = v[i]; v[i] = v[i - 1]; v[i - 1] = tv; const int ti = id[i]; id[i] = id[i - 1]; id[i - 1] = ti; } } }
}
__device__ __forceinline__ void phase_topk_ref(const DArgs& a, int vcu, int G) {
    const int tid = tid_();
    GAS unsigned char* ws = a.ws;
    const int gt = vcu * NTHR + tid, NGT = G * NTHR;
    for (int pair = gt; pair < T * 8; pair += NGT) {
        const int t = pair >> 3, h = pair & 7;
        float sv[2][16]; int si[2][16];
#pragma unroll
        for (int p = 0; p < 2; ++p) {
#pragma unroll
            for (int i = 0; i < 16; ++i) { sv[p][i] = -INFINITY; si[p][i] = 0; }
            const bf16_t* qp = (const bf16_t*)(ws + WS_QP) + (size_t)t * 2048 + h * 256 + p * 128;
            for (int n = 0; n < 128; ++n) {
                const bf16_t* kp = (const bf16_t*)(ws + WS_SK) + ((size_t)(h * 2 + p) * 128 + n) * 128;
                float s = 0.f;
                for (int c = 0; c < 128; c += 8) { const u32x4 qv = *(const u32x4*)(qp + c), kv = *(const u32x4*)(kp + c);
                    s += bf_lo(qv.x) * bf_lo(kv.x) + bf_hi(qv.x) * bf_hi(kv.x) + bf_lo(qv.y) * bf_lo(kv.y) + bf_hi(qv.y) * bf_hi(kv.y)
                       + bf_lo(qv.z) * bf_lo(kv.z) + bf_hi(qv.z) * bf_hi(kv.z) + bf_lo(qv.w) * bf_lo(kv.w) + bf_hi(qv.w) * bf_hi(kv.w); }
                ins16(sv[p], si[p], s, n);
            }
        }
        float tv[16]; int ti[16];
#pragma unroll
        for (int i = 0; i < 16; ++i) { tv[i] = -INFINITY; ti[i] = 0; }
#pragma unroll
        for (int i = 0; i < 16; ++i)
#pragma unroll
            for (int j = 0; j < 16; ++j) ins16(tv, ti, sv[0][i] + sv[1][j], i * 16 + j);
        float sm = 0.f, ex[16];
#pragma unroll
        for (int k = 0; k < 16; ++k) { ex[k] = __expf(tv[k] - tv[0]); sm += ex[k]; }
        int* ei = (int*)(ws + WS_EIDX) + (size_t)pair * 16; float* gp = (float*)(ws + WS_GATE) + (size_t)pair * 16;
#pragma unroll
        for (int k = 0; k < 16; ++k) {
            int e0 = 0, e1 = 0;
#pragma unroll
            for (int i = 0; i < 16; ++i) { e0 = ((ti[k] >> 4) == i) ? si[0][i] : e0; e1 = ((ti[k] & 15) == i) ? si[1][i] : e1; }
            ei[k] = e0 * 128 + e1; gp[k] = ex[k] / sm; }
    }
}

#define FP8LO(w) __builtin_amdgcn_cvt_pk_f32_fp8((int)(w), false)
#define FP8HI(w) __builtin_amdgcn_cvt_pk_f32_fp8((int)(w), true)
__device__ __forceinline__ float dot16_fp8(const u32x4 r, const float (&x)[16]) {
    float c = 0.f;
#pragma unroll
    for (int j = 0; j < 4; ++j) { const f32x2 lo = FP8LO(r[j]), hi = FP8HI(r[j]); c += lo[0] * x[4 * j] + lo[1] * x[4 * j + 1] + hi[0] * x[4 * j + 2] + hi[1] * x[4 * j + 3]; }
    return c;
}
__device__ __forceinline__ float dot16_fp8p(const u32x4 r, const f32x2 (&xp)[8]) {
    f32x2 c2 = (f32x2){0.f, 0.f};
#pragma unroll
    for (int j = 0; j < 4; ++j) { c2 += FP8LO(r[j]) * xp[2 * j]; c2 += FP8HI(r[j]) * xp[2 * j + 1]; }
    return c2[0] + c2[1];
}
__device__ __forceinline__ float gelu_erf(float d) {
    const float ad = fabsf(d), t = __builtin_amdgcn_rcpf(ad * 0.2316418882f + 1.0f);
    float q = t * 0.5307027145f + (-0.7265760135f); q = q * t + 0.7107068705f; q = q * t + (-0.142248368f); q = q * t + 0.127414796f; q = q * t;
    const float m = d * (q * __builtin_amdgcn_exp2f(d * d * (-0.72134752044f)));
    return d < 0.f ? m : d - m;
}
__device__ __forceinline__ float bperm(float v, int srclane) { return __builtin_bit_cast(float, __builtin_amdgcn_ds_bpermute(srclane << 2, __builtin_bit_cast(int, v))); }
#define SWZ_(v, pat) __builtin_bit_cast(float, __builtin_amdgcn_ds_swizzle(__builtin_bit_cast(int, (v)), (pat)))
__device__ __forceinline__ float rs32_(float a, float b) {
#if defined(__HIP_DEVICE_COMPILE__)
    asm volatile("s_nop 1\n\tv_permlane32_swap_b32 %0, %1" : "+v"(a), "+v"(b));
#endif
    return a + b;
}
__device__ __forceinline__ float rs16_(float a, float b) {
#if defined(__HIP_DEVICE_COMPILE__)
    asm volatile("s_nop 1\n\tv_permlane16_swap_b32 %0, %1" : "+v"(a), "+v"(b));
#endif
    return a + b;
}
__device__ __forceinline__ float rs8_(float a, float b, bool bit3) {
    const float send = bit3 ? a : b, keep = bit3 ? b : a;
    return keep + DPP_(send, 0x128);
}
__device__ __forceinline__ float xor32_(float v, bool hi) {
#if defined(__HIP_DEVICE_COMPILE__)
    const auto r = __builtin_amdgcn_permlane32_swap(__builtin_bit_cast(unsigned, v), __builtin_bit_cast(unsigned, v), false, false);
    return __builtin_bit_cast(float, hi ? r[0] : r[1]);
#else
    (void)hi; return v;
#endif
}
__device__ __forceinline__ float reduce8(const float (&p)[8], int lane) {
    float q4[4], q2[2];
    const bool b5 = lane & 32, b4 = lane & 16, b3 = lane & 8;
#pragma unroll
    for (int i = 0; i < 4; ++i) { const float send = b5 ? p[i] : p[i + 4], keep = b5 ? p[i + 4] : p[i]; q4[i] = keep + xor32_(send, b5); }
#pragma unroll
    for (int i = 0; i < 2; ++i) { const float send = b4 ? q4[i] : q4[i + 2], keep = b4 ? q4[i + 2] : q4[i]; q2[i] = keep + SWZ_(send, 0x401F); }
    const float send = b3 ? q2[0] : q2[1], keep = b3 ? q2[1] : q2[0];
    float q1 = keep + SWZ_(send, 0x201F);
    q1 += DPP_(q1, 0xB1); q1 += DPP_(q1, 0x4E); q1 += DPP_(q1, 0x141);
    return q1;
}
__device__ __forceinline__ void phase_udots(const DArgs& a, LAS unsigned char* lds) {
    const int tid = tid_(), lane = tid & 63, wave = __builtin_amdgcn_readfirstlane(tid >> 6);
    GAS unsigned char* ws = a.ws;
    volatile LAS unsigned* bst = (volatile LAS unsigned*)(lds + LDS_BARST);
    const int nloc = (int)bst[0], nx = (int)bst[1], rank = (int)bst[2];
    unsigned* bar = (unsigned*)(ws + WS_CTL) + CW_BAR;
    const unsigned myx = xb_xcc_id();
    int q = 0;
    for (unsigned j = 0; j < 16; ++j) { const unsigned c = xb_ld(&bar[XB_XCNT(j)]); if (c > 0u && j < myx) ++q; }
    LAS int* LE = (LAS int*)(lds + wave * 2048);
    LAS int* LP = LE + 128; LAS float* LG = (LAS float*)(LE + 256);
    const GAS unsigned char* UB = ws + WS_UB;
    const int g8 = lane >> 3;
    const float usc = ((const GAS float*)(ws + WS_USC))[0], vsc = ((const GAS float*)(ws + WS_USC))[1];
    for (int s = q; s < 8; s += nx) {
        int tok = rank * 8 + wave;
        u32x4 xq0 = (u32x4){0u, 0u, 0u, 0u}, xq1 = xq0; u32x2 e2 = (u32x2){0u, 0u}; f32x2 g2 = (f32x2){0.f, 0.f};
#define U_INFO(t_) do { xq0 = *(const u32x4*)((const GAS bf16_t*)(ws + WS_XN) + (size_t)(t_) * D + lane * 16); xq1 = *(const u32x4*)((const GAS bf16_t*)(ws + WS_XN) + (size_t)(t_) * D + lane * 16 + 8); \
        e2 = *(const u32x2*)((const GAS int*)(ws + WS_EIDX) + (size_t)(t_) * 128 + 2 * lane); g2 = *(const f32x2*)((const GAS float*)(ws + WS_GATE) + (size_t)(t_) * 128 + 2 * lane); } while (0)
        if (tok < T) U_INFO(tok);
        for (; tok < T; tok += nloc * 8) {
            const bool in0 = (int)(e2.x >> 11) == s, in1 = (int)(e2.y >> 11) == s;
            const unsigned long long m0 = __ballot(in0), m1 = __ballot(in1);
            const unsigned long long lt = (1ull << lane) - 1ull;
            const int n0 = __popcll(m0), n = n0 + __popcll(m1);
            if (in0) { const int pos = __popcll(m0 & lt); LE[pos] = (int)e2.x; LP[pos] = 2 * lane; LG[pos] = g2[0]; }
            if (in1) { const int pos = n0 + __popcll(m1 & lt); LE[pos] = (int)e2.y; LP[pos] = 2 * lane + 1; LG[pos] = g2[1]; }
            const float xf[16] = {bf_lo(xq0.x), bf_hi(xq0.x), bf_lo(xq0.y), bf_hi(xq0.y), bf_lo(xq0.z), bf_hi(xq0.z), bf_lo(xq0.w), bf_hi(xq0.w),
                                  bf_lo(xq1.x), bf_hi(xq1.x), bf_lo(xq1.y), bf_hi(xq1.y), bf_lo(xq1.z), bf_hi(xq1.z), bf_lo(xq1.w), bf_hi(xq1.w)};
            asm volatile("s_waitcnt lgkmcnt(0)" ::: "memory");
            u32x4 R0[8], R1[8], R2[8];
#define U_ISSUE(R_, g0_) do { _Pragma("unroll") for (int k = 0; k < 8; ++k) { const int slot_ = ((g0_) + k < n) ? (g0_) + k : n - 1; const int e_ = LE[slot_]; R_[k] = *(const u32x4*)(UB + (size_t)e_ * 1024 + lane * 16); } } while (0)
#define U_DOTS(R_, g0_) do { float pp_[8]; _Pragma("unroll") for (int k = 0; k < 8; ++k) pp_[k] = dot16_fp8(R_[k], xf); const float dsum_ = reduce8(pp_, lane); const int slot_ = (g0_) + g8; \
            if (slot_ < n && (lane & 7) == 0) { const float d_ = dsum_ * usc; \
                ((GAS float*)(ws + WS_PW))[(size_t)tok * 128 + LP[slot_]] = 0.5f * d_ * (1.0f + erff(d_ * 0.70710678118654752f)) * LG[slot_] * vsc; } } while (0)
            if (n > 0) U_ISSUE(R0, 0);
            if (n > 8) U_ISSUE(R1, 8);
            if (n > 16) U_ISSUE(R2, 16);
            const int tokN = tok + nloc * 8;
            if (tokN < T) U_INFO(tokN);
            if (n > 0) U_DOTS(R0, 0);
            if (n > 8) U_DOTS(R1, 8);
            if (n > 16) U_DOTS(R2, 16);
            for (int g0 = 24; g0 < n; g0 += 8) { U_ISSUE(R0, g0); U_DOTS(R0, g0); }
            asm volatile("s_waitcnt lgkmcnt(0)" ::: "memory");
        }
#undef U_INFO
#undef U_ISSUE
#undef U_DOTS
    }
}

#define EV_OFF(ev_, g_) (((g_) & 1) ? ((ev_[(g_) >> 3][((g_) >> 1) & 3] >> 9) & 0x7fff80u) : ((ev_[(g_) >> 3][((g_) >> 1) & 3] << 7) & 0x7fff80u))
struct XcdSlice { int nloc, nx, rank, q; };
__device__ __forceinline__ XcdSlice xcd_slice_setup(const DArgs& a, LAS unsigned char* lds) {
    volatile LAS unsigned* bst = (volatile LAS unsigned*)(lds + LDS_BARST);
    XcdSlice x; x.nloc = __builtin_amdgcn_readfirstlane((int)bst[0]); x.nx = __builtin_amdgcn_readfirstlane((int)bst[1]); x.rank = __builtin_amdgcn_readfirstlane((int)bst[2]);
    unsigned* bar = (unsigned*)(a.ws + WS_CTL) + CW_BAR; const unsigned myx = xb_xcc_id();
    x.q = 0; for (unsigned j = 0; j < 16; ++j) { const unsigned c = xb_ld(&bar[XB_XCNT(j)]); if (c > 0u && j < myx) ++x.q; }
    x.q = __builtin_amdgcn_readfirstlane(x.q);
    return x;
}
__device__ __forceinline__ void phase_ua(const DArgs& a, LAS unsigned char* lds) {
    const int tid = tid_(), lane = tid & 63, wave = __builtin_amdgcn_readfirstlane(tid >> 6), k = lane >> 3, c = lane & 7;
    GAS unsigned char* ws = a.ws;
    const XcdSlice X = xcd_slice_setup(a, lds);
    const int tstride = X.nloc * 8;
    for (int sl = X.q; sl < 8; sl += X.nx) {
        const GAS unsigned char* UBs = ws + WS_UB + (size_t)sl * 2097152;
        const unsigned coff = (unsigned)c * 16u;
        GAS unsigned char* PU = ws + WS_PARTU + (size_t)sl * T * 256;
        u32x4 evA[2], evB[2], RA[16], RB[16], xa, xb; float sa, sb;
#define A_TOK(t_) ((t_) < T ? (t_) : T - 1)
#define A_INFO(ev_, t_) do { const int tq_ = A_TOK(t_); _Pragma("unroll") for (int j_ = 0; j_ < 2; ++j_) ev_[j_] = *(const GAS u32x4*)(ws + WS_EIDX + (size_t)tq_ * 256 + (unsigned)(32 * k + 16 * j_)); } while (0)
#define A_ISSUE(R_, x_, s_, ev_, t_) do { const int tq_ = A_TOK(t_); _Pragma("unroll") for (int g_ = 0; g_ < 16; ++g_) R_[g_] = *(const GAS u32x4*)(UBs + (EV_OFF(ev_, g_) | coff)); \
        x_ = *(const GAS u32x4*)(ws + WS_XQ + (size_t)tq_ * 1024 + sl * 128 + coff); s_ = ((const GAS float*)(ws + WS_XQS))[tq_]; } while (0)
#define A_DOTS(R_, x_, s_, t_) do { \
        int ir0_ = 0, ir1_ = 0; \
        _Pragma("unroll") for (int gg_ = 0; gg_ < 4; ++gg_) {           \
            int d_[4]; _Pragma("unroll") for (int q_ = 0; q_ < 4; ++q_) d_[q_] = 0; \
            _Pragma("unroll") for (int j_ = 0; j_ < 4; ++j_) { _Pragma("unroll") for (int q_ = 0; q_ < 4; ++q_) d_[q_] = __builtin_amdgcn_sdot4((int)R_[4 * gg_ + q_][j_], (int)x_[j_], d_[q_], false); } \
            _Pragma("unroll") for (int q_ = 0; q_ < 4; ++q_) d_[q_] += DPPI_(d_[q_], 0xB1); \
            _Pragma("unroll") for (int q_ = 0; q_ < 4; ++q_) d_[q_] += DPPI_(d_[q_], 0x4E); \
            _Pragma("unroll") for (int q_ = 0; q_ < 4; ++q_) d_[q_] += DPPI_(d_[q_], 0x141);          \
            _Pragma("unroll") for (int q_ = 0; q_ < 4; ++q_) { if (c == ((4 * gg_ + q_) >> 1)) { if (q_ & 1) ir1_ = d_[q_]; else ir0_ = d_[q_]; } }          \
            __builtin_amdgcn_sched_barrier(0); } \
        if ((t_) < T) *(GAS unsigned*)(PU + (size_t)(t_) * 256 + (unsigned)(4 * lane)) = pk2((float)ir0_ * s_, (float)ir1_ * s_); } while (0)
        const int n0 = X.rank * 8 + wave;
        A_INFO(evA, n0); A_INFO(evB, n0 + tstride);
        __builtin_amdgcn_sched_barrier(0);
        A_ISSUE(RA, xa, sa, evA, n0);
        __builtin_amdgcn_sched_barrier(0);
#pragma unroll 1
        for (int n = n0; n < T; n += 2 * tstride) {
            A_INFO(evA, n + 2 * tstride);
            __builtin_amdgcn_sched_barrier(0);
            A_ISSUE(RB, xb, sb, evB, n + tstride);
            __builtin_amdgcn_sched_barrier(0);
            A_DOTS(RA, xa, sa, n);
            __builtin_amdgcn_sched_barrier(0);
            A_INFO(evB, n + 3 * tstride);
            __builtin_amdgcn_sched_barrier(0);
            A_ISSUE(RA, xa, sa, evA, n + 2 * tstride);
            __builtin_amdgcn_sched_barrier(0);
            A_DOTS(RB, xb, sb, n + tstride);
            __builtin_amdgcn_sched_barrier(0);
        }
#undef A_TOK
#undef A_INFO
#undef A_ISSUE
#undef A_DOTS
    }
}
__device__ __forceinline__ void phase_ua2(const DArgs& a, int vcu, int G) {
    const int tid = tid_();
    GAS unsigned char* ws = a.ws;
    const GAS float* USC = (const GAS float*)(ws + WS_USC); const GAS float* VSC = (const GAS float*)(ws + WS_VSC);
    const GAS unsigned char* PU = ws + WS_PARTU;
    const size_t N4 = (size_t)T * 128 / 4, stride = (size_t)G * NTHR;
    for (size_t i = (size_t)vcu * NTHR + tid; i < N4; i += 2 * stride) {
        const size_t i1 = (i + stride < N4) ? i + stride : i;
        u32x2 pv0[8], pv1[8];
#pragma unroll
        for (int sl = 0; sl < 8; ++sl) { pv0[sl] = ((const GAS u32x2*)(PU + (size_t)sl * T * 256))[i]; pv1[sl] = ((const GAS u32x2*)(PU + (size_t)sl * T * 256))[i1]; }
        const f32x4 gt0 = ((const GAS f32x4*)(ws + WS_GATE))[i], gt1 = ((const GAS f32x4*)(ws + WS_GATE))[i1];
        const u32x2 ep0 = ((const GAS u32x2*)(ws + WS_EIDX))[i], ep1 = ((const GAS u32x2*)(ws + WS_EIDX))[i1];
        const unsigned e0[4] = {ep0.x & 0xffffu, ep0.x >> 16, ep0.y & 0xffffu, ep0.y >> 16}, e1[4] = {ep1.x & 0xffffu, ep1.x >> 16, ep1.y & 0xffffu, ep1.y >> 16};
        float us0[4], vs0[4], us1[4], vs1[4];
#pragma unroll
        for (int e = 0; e < 4; ++e) { us0[e] = USC[e0[e]]; vs0[e] = VSC[e0[e]]; us1[e] = USC[e1[e]]; vs1[e] = VSC[e1[e]]; }
        f32x4 d0 = (f32x4){0.f, 0.f, 0.f, 0.f}, d1 = d0;
#pragma unroll
        for (int sl = 0; sl < 8; ++sl) { d0[0] += bf_lo(pv0[sl].x); d0[1] += bf_hi(pv0[sl].x); d0[2] += bf_lo(pv0[sl].y); d0[3] += bf_hi(pv0[sl].y);
                                         d1[0] += bf_lo(pv1[sl].x); d1[1] += bf_hi(pv1[sl].x); d1[2] += bf_lo(pv1[sl].y); d1[3] += bf_hi(pv1[sl].y); }
        f32x4 w0, w1;
#pragma unroll
        for (int e = 0; e < 4; ++e) { w0[e] = gelu_erf(d0[e] * us0[e]) * gt0[e] * vs0[e]; w1[e] = gelu_erf(d1[e] * us1[e]) * gt1[e] * vs1[e]; }
        u32x2 wo; wo.x = pk2(w0[0], w0[1]); wo.y = pk2(w0[2], w0[3]); ((GAS u32x2*)(ws + WS_PW))[i] = wo;
        if (i + stride < N4) { wo.x = pk2(w1[0], w1[1]); wo.y = pk2(w1[2], w1[3]); ((GAS u32x2*)(ws + WS_PW))[i1] = wo; }
    }
}
__device__ __forceinline__ void phase_vb(const DArgs& a, LAS unsigned char* lds) {
    const int tid = tid_(), lane = tid & 63, wave = __builtin_amdgcn_readfirstlane(tid >> 6), k = lane >> 3, c = lane & 7;
    GAS unsigned char* ws = a.ws;
    const XcdSlice X = xcd_slice_setup(a, lds);
    const int tstride = X.nloc * 8;
    const bool bit3 = (lane & 8) != 0;
    for (int sl = X.q; sl < 8; sl += X.nx) {
        const GAS unsigned char* VBs = ws + WS_VB + (size_t)sl * 2097152;
        const unsigned coff = (unsigned)c * 16u;
        const unsigned xoff = (unsigned)(sl * 128 + c * 16 + 2 * k) * 4u;
        u32x4 evA[2], evB[2], RA[16], RB[16], wa[2], wb[2]; unsigned xa, xb;
#define B_TOK(t_) ((t_) < T ? (t_) : T - 1)
#define B_INFO(ev_, t_) do { const int tq_ = B_TOK(t_); _Pragma("unroll") for (int j_ = 0; j_ < 2; ++j_) ev_[j_] = *(const GAS u32x4*)(ws + WS_EIDX + (size_t)tq_ * 256 + (unsigned)(32 * k + 16 * j_)); } while (0)
#define B_ISSUE(R_, w_, x_, ev_, t_) do { const int tq_ = B_TOK(t_); _Pragma("unroll") for (int g_ = 0; g_ < 16; ++g_) R_[g_] = *(const GAS u32x4*)(VBs + (EV_OFF(ev_, g_) | coff)); \
        _Pragma("unroll") for (int j_ = 0; j_ < 2; ++j_) w_[j_] = *(const GAS u32x4*)(ws + WS_PW + (size_t)tq_ * 256 + (unsigned)(32 * k + 16 * j_)); \
        x_ = *(const GAS unsigned*)((const GAS unsigned char*)a.out + (size_t)tq_ * (D * 2) + (xoff >> 1)); } while (0)
#define B_DOTS(R_, w_, x_, t_) do { \
        f32x2 acc2_[8]; _Pragma("unroll") for (int e_ = 0; e_ < 8; ++e_) acc2_[e_] = (f32x2){0.f, 0.f}; \
        _Pragma("unroll") for (int g_ = 0; g_ < 16; ++g_) { const unsigned ww_ = w_[g_ >> 3][(g_ >> 1) & 3]; const float wk_ = (g_ & 1) ? bf_hi(ww_) : bf_lo(ww_); const f32x2 wp_ = (f32x2){wk_, wk_}; \
            _Pragma("unroll") for (int jj_ = 0; jj_ < 4; ++jj_) { acc2_[2 * jj_] += wp_ * FP8LO(R_[g_][jj_]); acc2_[2 * jj_ + 1] += wp_ * FP8HI(R_[g_][jj_]); } \
            if (g_ & 1) __builtin_amdgcn_sched_barrier(0); } \
        f32x2 w2_[4], x2_[2], y_; \
        _Pragma("unroll") for (int i_ = 0; i_ < 4; ++i_) { w2_[i_][0] = rs32_(acc2_[i_][0], acc2_[i_ + 4][0]); w2_[i_][1] = rs32_(acc2_[i_][1], acc2_[i_ + 4][1]); } \
        _Pragma("unroll") for (int i_ = 0; i_ < 2; ++i_) { x2_[i_][0] = rs16_(w2_[i_][0], w2_[i_ + 2][0]); x2_[i_][1] = rs16_(w2_[i_][1], w2_[i_ + 2][1]); } \
        y_[0] = rs8_(x2_[0][0], x2_[1][0], bit3) + bf_lo(x_); y_[1] = rs8_(x2_[0][1], x2_[1][1], bit3) + bf_hi(x_); \
        const float ss_ = wave_sum(y_[0] * y_[0] + y_[1] * y_[1], lane); \
        if ((t_) < T) { *(GAS unsigned*)(ws + WS_PARTU + (size_t)(t_) * (D * 2) + (xoff >> 1)) = pk2(y_[0], y_[1]);       \
            if (lane == 0) ((GAS float*)(ws + WS_SS))[(size_t)(t_) * 8 + sl] = ss_; } } while (0)
        const int n0 = X.rank * 8 + wave;
        B_INFO(evA, n0); B_INFO(evB, n0 + tstride);
        __builtin_amdgcn_sched_barrier(0);
        B_ISSUE(RA, wa, xa, evA, n0);
        __builtin_amdgcn_sched_barrier(0);
#pragma unroll 1
        for (int n = n0; n < T; n += 2 * tstride) {
            B_INFO(evA, n + 2 * tstride);
            __builtin_amdgcn_sched_barrier(0);
            B_ISSUE(RB, wb, xb, evB, n + tstride);
            __builtin_amdgcn_sched_barrier(0);
            B_DOTS(RA, wa, xa, n);
            __builtin_amdgcn_sched_barrier(0);
            B_INFO(evB, n + 3 * tstride);
            __builtin_amdgcn_sched_barrier(0);
            B_ISSUE(RA, wa, xa, evA, n + 2 * tstride);
            __builtin_amdgcn_sched_barrier(0);
            B_DOTS(RB, wb, xb, n + tstride);
            __builtin_amdgcn_sched_barrier(0);
        }
#undef B_TOK
#undef B_INFO
#undef B_ISSUE
#undef B_DOTS
    }
}
__device__ __forceinline__ void phase_vc(const DArgs& a, int vcu, int G) {
    const int tid = tid_(), lane = tid & 63, wave = tid >> 6;
    const int gw = vcu * NWAVES + wave, NGW = G * NWAVES;
    GAS unsigned char* ws = a.ws;
    f32x4 gf[4];
#pragma unroll
    for (int j = 0; j < 4; ++j) gf[j] = ((const GAS f32x4*)a.final_g)[64 * j + lane];
    for (int m = gw; m < T; m += NGW) {
        const f32x4 s0 = *(const GAS f32x4*)((const GAS float*)(ws + WS_SS) + (size_t)m * 8), s1 = *(const GAS f32x4*)((const GAS float*)(ws + WS_SS) + (size_t)m * 8 + 4);
        const float rstd = rsqrtf(((s0[0] + s0[1]) + (s0[2] + s0[3]) + (s1[0] + s1[1]) + (s1[2] + s1[3])) * (1.f / D) + EPS);
        const GAS u32x2* xi = (const GAS u32x2*)(ws + WS_PARTU + (size_t)m * (D * 2)) + lane;
        GAS f32x4* o = (GAS f32x4*)(a.out + (size_t)m * D) + lane;
#pragma unroll
        for (int j = 0; j < 4; ++j) { const u32x2 xv = xi[64 * j]; f32x4 v; v[0] = bf_lo(xv.x); v[1] = bf_hi(xv.x); v[2] = bf_lo(xv.y); v[3] = bf_hi(xv.y); o[64 * j] = v * rstd * gf[j]; }
    }
}

__device__ __forceinline__ void phase_final_plain(const DArgs& a, const float* src, int vcu, int G) {
    const int tid = tid_(), lane = tid & 63, wave = tid >> 6;
    const int gw = vcu * NWAVES + wave, NGW = G * NWAVES;
    f32x4 gf[4];
#pragma unroll
    for (int j = 0; j < 4; ++j) gf[j] = ((const f32x4*)a.final_g)[64 * j + lane];
    for (int m = gw; m < T; m += NGW) {
        const f32x4* xr = (const f32x4*)(src + (size_t)m * D) + lane;
        f32x4 v[4]; float s = 0.f;
#pragma unroll
        for (int j = 0; j < 4; ++j) { v[j] = xr[64 * j]; s += (v[j][0] * v[j][0] + v[j][1] * v[j][1]) + (v[j][2] * v[j][2] + v[j][3] * v[j][3]); }
        const float rstd = rsqrtf(wave_sum(s, lane) * (1.f / D) + EPS);
        f32x4* o = (f32x4*)(a.out + (size_t)m * D) + lane;
#pragma unroll
        for (int j = 0; j < 4; ++j) o[64 * j] = v[j] * rstd * gf[j];
    }
}


__device__ __forceinline__ DArgs load_args() {
    DArgs r;
#if defined(__HIP_DEVICE_COMPILE__)
    typedef const DArgs __attribute__((address_space(4))) KArgs;
    KArgs* p = (KArgs*)__builtin_amdgcn_kernarg_segment_ptr();
    asm volatile("" : "+s"(p));
    r.x = p->x; r.norm1_g = p->norm1_g; r.w_in = p->w_in; r.b_in = p->b_in; r.conv_w = p->conv_w; r.conv_b = p->conv_b; r.m_head_g = p->m_head_g; r.lb_table = p->lb_table;
    r.g_head_g = p->g_head_g; r.w_br_m = p->w_br_m; r.w_br_g = p->w_br_g; r.w_out = p->w_out; r.norm2_g = p->norm2_g; r.w_pq = p->w_pq; r.sub_keys = p->sub_keys;
    r.u_emb = p->u_emb; r.v_emb = p->v_emb; r.final_g = p->final_g; r.out = p->out; r.ws = p->ws;
#else
    r = DArgs{};
#endif
    return r;
}
__device__ __forceinline__ EpiPtrs make_ep(const DArgs& a, int round) {
    EpiPtrs ep; ep.biasp = (const GAS float*)(a.ws + WS_BIASP); ep.lb = (const GAS float*)(a.ws + WS_LB); ep.x = a.x; ep.out = a.out; ep.ws = a.ws; ep.round = round; ep.pn0 = 0; ep.sa = (const GAS float*)(a.ws + WS_SA8); ep.sb = (const GAS float*)(a.ws + WS_SB8); ep.sym = (const GAS float*)(a.ws + WS_SYM); ep.syg = (const GAS float*)(a.ws + WS_SYG); ep.sxq = (const GAS float*)(a.ws + WS_XQS); return ep;
}
#define GRID_SYNC() do { const DArgs a_ = load_args(); xcd_barrier((unsigned*)(a_.ws + WS_CTL) + CW_BAR, (volatile LAS unsigned*)(lds + LDS_BARST)); } while (0)

__device__ __forceinline__ int bx_() { int t = blockIdx.x; asm volatile("" : "+s"(t)); return t; }
__device__ __forceinline__ int gd_() { int t = gridDim.x; asm volatile("" : "+s"(t)); return t; }
#define PH_BEGIN const DArgs a = load_args(); const int bx = bx_(), G = gd_(); const int vcu = (G % 8 == 0) ? (bx % 8) * (G / 8) + bx / 8 : bx; (void)vcu; (void)bx;

__global__ void __launch_bounds__(NTHR, 2) fwd_megakernel(Args a_unused) {
    extern __shared__ __attribute__((aligned(16))) unsigned char lds_raw[];
    LAS unsigned char* lds = (LAS unsigned char*)lds_raw;
    cg::grid_group grid = cg::this_grid();

    { const int t_ = tid_(); if (t_ < 16) ((LAS unsigned*)(lds + LDS_BARST))[t_] = 0u; __syncthreads();
      const DArgs a_ = load_args(); xcd_barrier_post((unsigned*)(a_.ws + WS_CTL) + CW_BAR, (volatile LAS unsigned*)(lds + LDS_BARST)); }
    { PH_BEGIN phase_p0(a, lds, vcu, G); }
    grid.sync();
    { PH_BEGIN phase_p0c(a, lds, vcu, G); }
    GRID_SYNC();
#pragma unroll 1
    for (int round = 0; round < NROUND; ++round) {
        {
            PH_BEGIN
            pg8::Gemm g{(const bf16_t*)(a.ws + WS_XN8 + (size_t)round * RT * 1024), (const bf16_t*)(a.ws + WS_W8A), RT, N1, D / 2};
            pg8::StaticOrder S; S.init(RT, N1, G, bx);
            EpiX<7> E{make_ep(a, round)};
            pg8::gemm_phase<EpiX<7>, pg8::StaticOrder, true, true, true>(lds, g, S, E);
        }
        { PH_BEGIN if (bx < 8) mscan_pair(a, lds, round, bx); }
        GRID_SYNC();
        { PH_BEGIN for (int it = bx; it < 512; it += G) mlstm_pre_item(a, lds, round, it); }
        { PH_BEGIN u32x4 gq[4]; int it = bx; if (it < 2048) hgrn_pre_load(a, round, it, gq);
          for (; it < 2048; it += G) hgrn_pre_item(a, lds, round, it, gq, it + G); }
        GRID_SYNC();
        { PH_BEGIN
          if (bx < 128) mlstm_scan<2, false>(a, lds, round, bx & 7, bx >> 3);
          else if (bx >= 192 && bx < 200) mlstm_scan<1, true>(a, lds, round, bx - 192, 0);
          else if (bx < 192) { const int id2 = bx - 128; hgrn_scan(a, lds, round, (id2 & 7) * 2 + ((id2 >> 3) & 1), id2 >> 4); }
          else if (G >= 232) {
              pg8::Gemm g{(const bf16_t*)(a.ws + WS_XN8 + (size_t)round * RT * 1024), (const bf16_t*)(a.ws + WS_W8 + (size_t)2048 * 1024), RT, 1024, D / 2};
              pg8::StaticOrder S; S.init(RT, 1024, G - 200, bx - 200);
              EpiPtrs ep = make_ep(a, round); ep.pn0 = 8; EpiX<2> E{ep};
              pg8::gemm_phase<EpiX<2>, pg8::StaticOrder, true, true, true>(lds, g, S, E); } }
        GRID_SYNC();
#define G2_PART(pn0_, ncol_) { PH_BEGIN \
            pg8::Gemm g{(const bf16_t*)(a.ws + WS_XN8 + (size_t)round * RT * 1024), (const bf16_t*)(a.ws + WS_W8 + (size_t)(pn0_) * 256 * 1024), RT, (ncol_), D / 2};       \
            pg8::StaticOrder S; S.init(RT, (ncol_), G, bx); \
            EpiPtrs ep = make_ep(a, round); ep.pn0 = (pn0_); EpiX<2> E{ep}; \
            pg8::gemm_phase<EpiX<2>, pg8::StaticOrder, true, true, true>(lds, g, S, E); }
        G2_PART(0, 2048)
        G2_PART(12, 2048)
        if (gd_() < 232) G2_PART(8, 1024)
#undef G2_PART
        GRID_SYNC();
        { PH_BEGIN phase_ypass(a, round, vcu, G); }
        GRID_SYNC();
        {
            { PH_BEGIN pg8::StaticOrder S; S.init(RT, D, G, bx);
              pg8::Gemm g{(const bf16_t*)(a.ws + WS_V), (const bf16_t*)(a.ws + WS_WM), RT, D, 2048 / 2}; EpiX<3> E{make_ep(a, round)}; pg8::gemm_phase<EpiX<3>, pg8::StaticOrder, true, true, true>(lds, g, S, E); }
            { PH_BEGIN pg8::StaticOrder S; S.init(RT, D, G, bx);
              pg8::Gemm g{(const bf16_t*)(a.ws + WS_GI), (const bf16_t*)(a.ws + WS_WG), RT, D, D / 2}; EpiX<4> E{make_ep(a, round)}; pg8::gemm_phase<EpiX<4>, pg8::StaticOrder, true, true, true>(lds, g, S, E); }
        }
        GRID_SYNC();
        {
            PH_BEGIN pg8::StaticOrder S; S.init(RT, D, G, bx);
            pg8::Gemm g{(const bf16_t*)(a.ws + WS_GFLOG), (const bf16_t*)(a.ws + WS_WO), RT, D, D}; EpiX<5> E{make_ep(a, round)}; pg8::gemm_phase<EpiX<5>, pg8::StaticOrder, true, true>(lds, g, S, E);
        }
        GRID_SYNC();
    }
    { PH_BEGIN phase_p8(a, vcu, G); }
    GRID_SYNC();
    {
        PH_BEGIN pg8::StaticOrder S; S.init(T, 2048, G, bx);
        pg8::Gemm g{(const bf16_t*)(a.ws + WS_XQ), (const bf16_t*)(a.ws + WS_WPQ), T, 2048, D / 2}; EpiX<6> E{make_ep(a, 0)}; pg8::gemm_phase<EpiX<6>, pg8::StaticOrder, true, true, true>(lds, g, S, E);
    }
    GRID_SYNC();
#ifdef TOPK_REF
    { PH_BEGIN phase_topk_ref(a, vcu, G); }
#else
    { PH_BEGIN phase_topk(a, lds, bx, G); }
#endif
    GRID_SYNC();
    { PH_BEGIN phase_ua(a, lds); }
    GRID_SYNC();
    { PH_BEGIN phase_ua2(a, vcu, G); }
    GRID_SYNC();
    { PH_BEGIN phase_vb(a, lds); }
    GRID_SYNC();
    { PH_BEGIN phase_vc(a, vcu, G); }
}

extern "C" void kernel_launch(void* const* d_in, const int* in_sizes, int n_in, void* d_out, int out_size, void* d_ws, size_t ws_size, hipStream_t stream) {
    static int grid = 0;
    if (grid == 0) {
        if (n_in != 18 || in_sizes[0] != T * D || out_size != T * D || ws_size < WS_END) {
            fprintf(stderr, "kernel_launch: unexpected shapes/workspace (n_in %d, in0 %d, out %d, ws %zu, need %zu)\n", n_in, n_in > 0 ? in_sizes[0] : -1, out_size, ws_size, (size_t)WS_END);
            grid = -1; return; }
        int dev = 0, cus = 0, per_cu = 0;
        hipGetDevice(&dev);
        hipDeviceGetAttribute(&cus, hipDeviceAttributeMultiprocessorCount, dev);
        hipFuncSetAttribute((const void*)fwd_megakernel, hipFuncAttributeMaxDynamicSharedMemorySize, LDS_BYTES);
        hipOccupancyMaxActiveBlocksPerMultiprocessor(&per_cu, (const void*)fwd_megakernel, NTHR, LDS_BYTES);
        if (per_cu < 1) { fprintf(stderr, "kernel_launch: occupancy query says %d blocks/CU\n", per_cu); per_cu = 1; }
        grid = cus;
        (void)hipGetLastError();
    }
    if (grid < 0) return;
    hipMemsetAsync((char*)d_ws + WS_CTL, 0, 131072, stream);
    Args a{};
    a.x = (const float*)d_in[0]; a.norm1_g = (const float*)d_in[1]; a.w_in = (const float*)d_in[2]; a.b_in = (const float*)d_in[3];
    a.conv_w = (const float*)d_in[4]; a.conv_b = (const float*)d_in[5]; a.m_head_g = (const float*)d_in[6]; a.lb_table = (const float*)d_in[7];
    a.g_head_g = (const float*)d_in[8]; a.w_br_m = (const float*)d_in[9]; a.w_br_g = (const float*)d_in[10]; a.w_out = (const float*)d_in[11];
    a.norm2_g = (const float*)d_in[12]; a.w_pq = (const float*)d_in[13]; a.sub_keys = (const float*)d_in[14]; a.u_emb = (const float*)d_in[15];
    a.v_emb = (const float*)d_in[16]; a.final_g = (const float*)d_in[17];
    a.out = (float*)d_out; a.ws = (unsigned char*)d_ws;
    void* args[] = {&a};
    hipError_t e = hipLaunchCooperativeKernel((const void*)fwd_megakernel, dim3(grid), dim3(NTHR), args, LDS_BYTES, stream);
    if (e != hipSuccess) fprintf(stderr, "cooperative launch failed: %s (grid %d)\n", hipGetErrorString(e), grid);
}
```

```cpp
#include <hip/hip_runtime.h>
#include <hip/hip_cooperative_groups.h>
#include <cstdio>
#include <cstdint>
namespace cg = cooperative_groups;

#define LAS __attribute__((address_space(3)))
typedef unsigned short bf16_t;
typedef short bf16x8 __attribute__((ext_vector_type(8)));
typedef float f32x4 __attribute__((ext_vector_type(4)));
typedef float f32x2 __attribute__((ext_vector_type(2)));
typedef unsigned u32x4 __attribute__((ext_vector_type(4)));
typedef unsigned u32x2 __attribute__((ext_vector_type(2)));

constexpr int D = 1024, BATCH = 4, SEQ = 8192, T = BATCH * SEQ;
constexpr int IN_COLS = 12296, NP = 12288;
constexpr int RT = 16384, NROUND = 2;
constexpr int N1 = 7168, N2 = 5120;
constexpr float EPS = 1e-6f;
constexpr int NWAVES = 8, NTHR = 512;

constexpr size_t MiB = 1u << 20;
constexpr size_t WS_CTL = 0;
constexpr size_t WS_WIN = 1 * MiB;
constexpr size_t WS_WM = 25 * MiB;
constexpr size_t WS_WG = 29 * MiB;
constexpr size_t WS_WO = 31 * MiB;
constexpr size_t WS_WPQ = 33 * MiB;
constexpr size_t WS_SK = 37 * MiB;
constexpr size_t WS_BIASP = 37 * MiB + 512 * 1024;
constexpr size_t WS_LB = WS_BIASP + 64 * 1024;
constexpr size_t WS_GATES = 38 * MiB;
constexpr size_t WS_MPREV = 39 * MiB;
constexpr size_t WS_DEN = 40 * MiB;
constexpr size_t WS_MT = 40 * MiB + 512 * 1024;
constexpr size_t WS_HGDEC = 41 * MiB;
constexpr size_t WS_MDEC = 43 * MiB;
constexpr size_t WS_XN = 44 * MiB;
constexpr size_t WS_QKPRE = 108 * MiB;
constexpr size_t WS_V = 172 * MiB;
constexpr size_t WS_GFLOG = 236 * MiB;
constexpr size_t WS_GI = 268 * MiB;
constexpr size_t WS_GQ = 300 * MiB;
constexpr size_t WS_S = 332 * MiB;
constexpr size_t WS_QT = 348 * MiB;
constexpr size_t WS_KWT = 380 * MiB;
constexpr size_t WS_ATT = 412 * MiB;
constexpr size_t WS_QTG = 428 * MiB;
constexpr size_t WS_KENDT = 460 * MiB;
constexpr size_t WS_SIGO = 332 * MiB;
constexpr size_t WS_SGG = 76 * MiB;
constexpr size_t WS_SAM = 428 * MiB;
constexpr size_t WS_SAG = 460 * MiB;
constexpr size_t WS_XN8 = 44 * MiB;
constexpr size_t WS_SA8 = 508 * MiB;
constexpr size_t WS_SB8 = 508 * MiB + 262144;
constexpr size_t WS_W8A = WS_WIN;
constexpr size_t WS_W8 = WS_WIN + (size_t)7168 * 1024;
constexpr int NI8 = 12288 + 1024 + 1024 + 2048;
constexpr size_t WS_SYM = 508 * MiB + 524288;
constexpr size_t WS_SYG = 508 * MiB + 655360;
constexpr int CW_COLMAX = 16384;
constexpr size_t WS_END = 510 * MiB;
constexpr size_t WS_QP = 108 * MiB;
constexpr size_t WS_UB = 236 * MiB;
constexpr size_t WS_VB = 252 * MiB;
constexpr size_t WS_USC = 268 * MiB;
constexpr size_t WS_VSC = 268 * MiB + 65536;
constexpr size_t WS_EIDX = 300 * MiB;
constexpr size_t WS_GATE = 316 * MiB;
constexpr size_t WS_XQ = 380 * MiB;
constexpr size_t WS_XQS = 412 * MiB;
constexpr size_t WS_PARTU = 108 * MiB;
constexpr size_t WS_SS = 348 * MiB;
constexpr size_t WS_PW = 332 * MiB;

constexpr int CW_TMAX = 64;
constexpr int LDS_BYTES = 147456;

__device__ __forceinline__ unsigned f2bf(float f) { unsigned u = __builtin_bit_cast(unsigned, f); return (u + 0x7fffu + ((u >> 16) & 1u)) >> 16; }
typedef __bf16 bf16x2_t __attribute__((ext_vector_type(2)));
__device__ __forceinline__ unsigned pk2(float lo, float hi) { bf16x2_t v; v[0] = (__bf16)lo; v[1] = (__bf16)hi; return __builtin_bit_cast(unsigned, v); }
__device__ __forceinline__ float bf_lo(unsigned w) { return __builtin_bit_cast(float, w << 16); }
__device__ __forceinline__ float bf_hi(unsigned w) { return __builtin_bit_cast(float, w & 0xffff0000u); }
__device__ __forceinline__ float bf2f(bf16_t h) { return __builtin_bit_cast(float, ((unsigned)h) << 16); }
__device__ __forceinline__ float shx(float v, int o, int lane) { return __builtin_bit_cast(float, __builtin_amdgcn_ds_bpermute((lane ^ o) << 2, __builtin_bit_cast(int, v))); }
__device__ __forceinline__ float shup(float v, int o, int lane) { return __builtin_bit_cast(float, __builtin_amdgcn_ds_bpermute(((lane - o) & 63) << 2, __builtin_bit_cast(int, v))); }
__device__ __forceinline__ float rdlane(float v, int l) { return __builtin_bit_cast(float, __builtin_amdgcn_readlane(__builtin_bit_cast(int, v), l)); }
#define DPP_(v, ctrl) __builtin_bit_cast(float, __builtin_amdgcn_update_dpp(0, __builtin_bit_cast(int, (v)), (ctrl), 0xF, 0xF, false))
__device__ __forceinline__ float wave_sum(float v, int lane) {
    (void)lane;
    v += DPP_(v, 0xB1); v += DPP_(v, 0x4E); v += DPP_(v, 0x141); v += DPP_(v, 0x140);
    return (rdlane(v, 0) + rdlane(v, 16)) + (rdlane(v, 32) + rdlane(v, 48));
}
__device__ __forceinline__ float wave_max(float v) {
    v = fmaxf(v, DPP_(v, 0xB1)); v = fmaxf(v, DPP_(v, 0x4E)); v = fmaxf(v, DPP_(v, 0x141)); v = fmaxf(v, DPP_(v, 0x140));
    return fmaxf(fmaxf(rdlane(v, 0), rdlane(v, 16)), fmaxf(rdlane(v, 32), rdlane(v, 48)));
}
__device__ __forceinline__ unsigned pack_i8x4(float a, float b, float c, float d) {
    const int ia = (int)__builtin_rintf(a), ib = (int)__builtin_rintf(b), ic = (int)__builtin_rintf(c), id = (int)__builtin_rintf(d);
    return ((unsigned)ia & 255u) | (((unsigned)ib & 255u) << 8) | (((unsigned)ic & 255u) << 16) | ((unsigned)id << 24);
}
#define SWZI_(v, pat) __builtin_amdgcn_ds_swizzle((int)(v), (pat))
#define DPPI_(v, ctrl) __builtin_amdgcn_update_dpp(0, (int)(v), (ctrl), 0xF, 0xF, false)
__device__ __forceinline__ unsigned xor32u_(unsigned v, bool hi) {
#if defined(__HIP_DEVICE_COMPILE__)
    const auto r = __builtin_amdgcn_permlane32_swap(v, v, false, false);
    return hi ? r[0] : r[1];
#else
    (void)hi; return v;
#endif
}
__device__ __forceinline__ float sigmoidf_(float x) { return __builtin_amdgcn_rcpf(1.0f + __expf(-x)); }
__device__ __forceinline__ float siluf_(float x) { return x * __builtin_amdgcn_rcpf(1.0f + __expf(-x)); }
#define LDS_WAIT() asm volatile("s_waitcnt lgkmcnt(0)" ::: "memory")
__device__ __forceinline__ int tid_() { int t = threadIdx.x; asm volatile("" : "+v"(t)); return t; }

#define GAS __attribute__((address_space(1)))
struct DArgs {
    const GAS float* x; const GAS float* norm1_g; const GAS float* w_in; const GAS float* b_in; const GAS float* conv_w; const GAS float* conv_b;
    const GAS float* m_head_g; const GAS float* lb_table; const GAS float* g_head_g; const GAS float* w_br_m; const GAS float* w_br_g; const GAS float* w_out;
    const GAS float* norm2_g; const GAS float* w_pq; const GAS float* sub_keys; const GAS float* u_emb; const GAS float* v_emb; const GAS float* final_g;
    GAS float* out; GAS unsigned char* ws;
};
struct Args {
    const float* x; const float* norm1_g; const float* w_in; const float* b_in; const float* conv_w; const float* conv_b;
    const float* m_head_g; const float* lb_table; const float* g_head_g; const float* w_br_m; const float* w_br_g; const float* w_out;
    const float* norm2_g; const float* w_pq; const float* sub_keys; const float* u_emb; const float* v_emb; const float* final_g;
    float* out; unsigned char* ws;
};

namespace pg8 {
constexpr int BM = 256, BK = 64, HALF = 128, HTB = HALF * BK * 2, STAGE_BYTES = 8 * HTB, NXCD = 8, WGM = 8;
__host__ __device__ __forceinline__ int lds_byte(int r, int c) { const int st = (r >> 4) * 2 + (c >> 5), rr = r & 15, cc = c & 31, ob = rr * 64 + cc * 2; return st * 1024 + (ob ^ (((ob >> 9) & 1) << 5)); }
__host__ __device__ __forceinline__ void stage_rc(int b, int& R, int& C) { const int st = b / 1024, sb = b % 1024, swz = sb ^ (((sb >> 9) & 1) << 5); R = (st >> 1) * 16 + swz / 64; C = (st & 1) * 32 + (swz % 64) / 2; }
__host__ __device__ __forceinline__ int perm32(int rho) { const int n = rho >> 4, i = rho & 15; return 8 * (i >> 2) + 4 * n + (i & 3); }
struct Unit { int pm, pn; };
struct Gemm { const bf16_t* A; const bf16_t* Bt; int M, N, K; };
struct StaticOrder {
    int nM, nN, nwg, G, c;
    __host__ __device__ void init(int M, int N, int G_, int c_) { nM = M / BM; nN = N / BM; nwg = nM * nN; G = G_; c = c_; }
    __host__ __device__ bool next(int i, Unit& u) const {
        const long L = (long)i * G + c; if (L >= nwg) return false;
        int wgid = (int)L; { const int q = nwg / NXCD, r = nwg % NXCD, xcd = wgid % NXCD, off = wgid / NXCD; wgid = (xcd < r ? xcd * (q + 1) : r * (q + 1) + (xcd - r) * q) + off; }
        const int nig = WGM * nN, gid = wgid / nig, fm = gid * WGM, gsz = (nM - fm) < WGM ? (nM - fm) : WGM;
        u.pm = fm + ((wgid % nig) % gsz); u.pn = (wgid % nig) / gsz; return true;
    }
    __device__ __forceinline__ void a_ready(const Unit&) const {}
    __device__ __forceinline__ void done(const Unit&) const {}
};

typedef int i32x8 __attribute__((ext_vector_type(8)));
typedef int i32x4 __attribute__((ext_vector_type(4)));
template <class Epi, class Sched, bool ALIGN_EPI = false, bool SP2 = false, bool I8 = false>
__device__ __forceinline__ void gemm_phase(LAS unsigned char* lds, const Gemm g, const Sched& S, const Epi& E) {
    const int tid = tid_(), wid = __builtin_amdgcn_readfirstlane(tid >> 6), lane = tid & 63, wr = wid >> 2, wc = wid & 3, fr = lane & 15, fq = lane >> 4;
    const int K = g.K, nt = K / BK;
    unsigned voffA[2], voffB[2];
#pragma unroll
    for (int i = 0; i < 2; ++i) { int R, C; stage_rc(tid * 16 + i * 8192, R, C); const int Rb = Epi::PERM ? ((R & ~31) + perm32(R & 31)) : R;
        voffA[i] = (unsigned)(R * K + C) * 2u; voffB[i] = (unsigned)(Rb * K + C) * 2u; }
    const size_t kstep = (size_t)(BK * 2);
    const size_t hstep = (size_t)HALF * K * 2;
    const size_t tstep = 2 * hstep;
    const unsigned ldsw = (unsigned)wid * 1024u;
    const int aoff = lds_byte(wr * 64 + fr, fq * 8), boff = lds_byte(wc * 32 + fr, fq * 8);
#define PG8_SA(b, h) (((b) * 2 + (h)) * HTB)
#define PG8_SB(b, h) ((4 + (b) * 2 + (h)) * HTB)
#define PG8_STAGE(bufoff, gbase, voff) do { _Pragma("unroll") for (int _i = 0; _i < 2; ++_i) \
        __builtin_amdgcn_global_load_lds((const unsigned*)((const char*)(gbase) + (voff)[_i]), (LAS unsigned*)(lds + (bufoff) + ldsw + _i * 8192), 16, 0, 0); } while (0)
#define PG8_LDA(dst, b, h) do { _Pragma("unroll") for (int m = 0; m < 4; ++m) _Pragma("unroll") for (int k = 0; k < 2; ++k) dst[m][k] = *(const LAS bf16x8*)(lds + PG8_SA(b, h) + aoff + m * 2048 + k * 1024); } while (0)
#define PG8_LDB(dst, b, h) do { _Pragma("unroll") for (int n = 0; n < 2; ++n) _Pragma("unroll") for (int k = 0; k < 2; ++k) dst[n][k] = *(const LAS bf16x8*)(lds + PG8_SB(b, h) + boff + n * 2048 + k * 1024); } while (0)
#define PG8_MMA(ai, bj, At, Bt) do { __builtin_amdgcn_s_setprio(1); _Pragma("unroll") for (int m = 0; m < 4; ++m) _Pragma("unroll") for (int n = 0; n < 2; ++n) _Pragma("unroll") for (int k = 0; k < 2; ++k) { \
        if constexpr (I8) acc[ai][bj][m][n] = __builtin_bit_cast(f32x4, __builtin_amdgcn_mfma_i32_16x16x64_i8(__builtin_bit_cast(i32x4, Bt[n][k]), __builtin_bit_cast(i32x4, At[m][k]), __builtin_bit_cast(i32x4, acc[ai][bj][m][n]), 0, 0, 0)); \
        else acc[ai][bj][m][n] = __builtin_amdgcn_mfma_f32_16x16x32_bf16(Bt[n][k], At[m][k], acc[ai][bj][m][n], 0, 0, 0); } __builtin_amdgcn_s_setprio(0); } while (0)
#define PG8_WAIT_V(n) asm volatile("s_waitcnt vmcnt(" #n ")" ::: "memory")
#define PG8_WAIT_L(n) asm volatile("s_waitcnt lgkmcnt(" #n ")" ::: "memory")
#define PG8_BAR __builtin_amdgcn_s_barrier()
#define PG8_SCHED __builtin_amdgcn_sched_barrier(0)
    Unit cur, nxt; int ui = 0;
    if (!S.next(0, cur)) return;
    f32x4 acc[2][2][4][2];
#pragma unroll
    for (int a = 0; a < 2; ++a)
#pragma unroll
        for (int b = 0; b < 2; ++b)
#pragma unroll
            for (int m = 0; m < 4; ++m)
#pragma unroll
                for (int n = 0; n < 2; ++n) acc[a][b][m][n] = (f32x4){0.f, 0.f, 0.f, 0.f};
    bf16x8 At[4][2], B0[2][2], B1[2][2];
    const char* cA = (const char*)g.A + (size_t)cur.pm * tstep; const char* cB = (const char*)g.Bt + (size_t)cur.pn * tstep;
    S.a_ready(cur);
    if constexpr (SP2) {
        PG8_STAGE(PG8_SB(0, 0), cB, voffB); PG8_STAGE(PG8_SB(0, 1), cB + hstep, voffB); PG8_STAGE(PG8_SA(0, 0), cA, voffA); PG8_STAGE(PG8_SA(0, 1), cA + hstep, voffA);
        if (wr == 1) PG8_BAR;
        PG8_WAIT_V(2); PG8_BAR;
        PG8_STAGE(PG8_SB(1, 0), cB + kstep, voffB); PG8_STAGE(PG8_SA(1, 0), cA + kstep, voffA); PG8_STAGE(PG8_SB(1, 1), cB + hstep + kstep, voffB);
        PG8_WAIT_V(6); PG8_BAR;
    } else {
        PG8_STAGE(PG8_SB(0, 0), cB, voffB); PG8_STAGE(PG8_SA(0, 0), cA, voffA); PG8_STAGE(PG8_SB(0, 1), cB + hstep, voffB); PG8_STAGE(PG8_SA(0, 1), cA + hstep, voffA);
        if (wr == 1) PG8_BAR;
        PG8_WAIT_V(4); PG8_BAR;
        PG8_STAGE(PG8_SB(1, 0), cB + kstep, voffB); PG8_STAGE(PG8_SA(1, 0), cA + kstep, voffA); PG8_STAGE(PG8_SB(1, 1), cB + hstep + kstep, voffB);
        PG8_WAIT_V(6); PG8_BAR;
    }
    for (;;) {
        const bool has_next = S.next(ui + 1, nxt);
        const char* nA = has_next ? (const char*)g.A + (size_t)nxt.pm * tstep : cA; const char* nB = has_next ? (const char*)g.Bt + (size_t)nxt.pn * tstep : cB;
#pragma unroll 1
        for (int t = 0; t < nt; t += 2) {
            const bool last = (t == nt - 2);
            const char* a1 = cA + (size_t)(t + 1) * kstep;
            const char* a2 = last ? nA : cA + (size_t)(t + 2) * kstep; const char* b2 = last ? nB : cB + (size_t)(t + 2) * kstep;
            const char* a3 = a2 + kstep; const char* b3 = b2 + kstep;
            if (last && has_next) S.a_ready(nxt);
            if constexpr (SP2) {
            PG8_LDB(B0, 0, 0); PG8_LDB(B1, 0, 1); PG8_SCHED; PG8_LDA(At, 0, 0); PG8_STAGE(PG8_SA(1, 1), a1 + hstep, voffA);
            PG8_WAIT_V(8); PG8_WAIT_L(0); PG8_BAR; PG8_MMA(0, 0, At, B0); PG8_MMA(0, 1, At, B1); PG8_BAR; PG8_SCHED;
            PG8_LDA(At, 0, 1); PG8_STAGE(PG8_SB(0, 0), b2, voffB); PG8_STAGE(PG8_SB(0, 1), b2 + hstep, voffB); PG8_STAGE(PG8_SA(0, 0), a2, voffA);
            PG8_WAIT_V(8); PG8_WAIT_L(0); PG8_BAR; PG8_MMA(1, 0, At, B0); PG8_MMA(1, 1, At, B1); PG8_BAR; PG8_SCHED;
            PG8_LDB(B0, 1, 0); PG8_LDB(B1, 1, 1); PG8_SCHED; PG8_LDA(At, 1, 0); PG8_STAGE(PG8_SA(0, 1), a2 + hstep, voffA);
            PG8_WAIT_V(8); PG8_WAIT_L(0); PG8_BAR; PG8_MMA(0, 0, At, B0); PG8_MMA(0, 1, At, B1); PG8_BAR; PG8_SCHED;
            PG8_LDA(At, 1, 1); PG8_STAGE(PG8_SB(1, 0), b3, voffB); PG8_STAGE(PG8_SB(1, 1), b3 + hstep, voffB); PG8_STAGE(PG8_SA(1, 0), a3, voffA);
            PG8_WAIT_V(8); PG8_WAIT_L(0); PG8_BAR; PG8_MMA(1, 0, At, B0); PG8_MMA(1, 1, At, B1); PG8_BAR; PG8_SCHED;
            } else {
            PG8_LDB(B0, 0, 0); PG8_SCHED; PG8_LDA(At, 0, 0); PG8_STAGE(PG8_SA(1, 1), a1 + hstep, voffA);
            PG8_WAIT_L(8); PG8_BAR; PG8_WAIT_L(0); PG8_MMA(0, 0, At, B0); PG8_BAR; PG8_SCHED;
            PG8_LDB(B1, 0, 1); PG8_STAGE(PG8_SB(0, 0), b2, voffB);
            PG8_BAR; PG8_WAIT_L(0); PG8_MMA(0, 1, At, B1); PG8_BAR;
            PG8_LDA(At, 0, 1); PG8_STAGE(PG8_SA(0, 0), a2, voffA);
            PG8_BAR; PG8_WAIT_L(0); PG8_MMA(1, 0, At, B0); PG8_BAR; PG8_SCHED;
            PG8_STAGE(PG8_SB(0, 1), b2 + hstep, voffB);
            PG8_WAIT_V(6); PG8_BAR; PG8_MMA(1, 1, At, B1); PG8_BAR;
            PG8_LDB(B0, 1, 0); PG8_SCHED; PG8_LDA(At, 1, 0); PG8_STAGE(PG8_SA(0, 1), a2 + hstep, voffA);
            PG8_WAIT_L(8); PG8_BAR; PG8_WAIT_L(0); PG8_MMA(0, 0, At, B0); PG8_BAR; PG8_SCHED;
            PG8_LDB(B1, 1, 1); PG8_STAGE(PG8_SB(1, 0), b3, voffB);
            PG8_BAR; PG8_WAIT_L(0); PG8_MMA(0, 1, At, B1); PG8_BAR;
            PG8_LDA(At, 1, 1); PG8_STAGE(PG8_SA(1, 0), a3, voffA);
            PG8_BAR; PG8_WAIT_L(0); PG8_MMA(1, 0, At, B0); PG8_BAR; PG8_SCHED;
            PG8_STAGE(PG8_SB(1, 1), b3 + hstep, voffB);
            PG8_WAIT_V(6); PG8_BAR; PG8_MMA(1, 1, At, B1); PG8_BAR;
            }
        }
        if constexpr (ALIGN_EPI) { if (wr == 0) PG8_BAR; }
        E(acc, cur, wr, wc, fr, fq);
        if (!has_next) break;
#pragma unroll
        for (int a = 0; a < 2; ++a)
#pragma unroll
            for (int b = 0; b < 2; ++b)
#pragma unroll
                for (int m = 0; m < 4; ++m)
#pragma unroll
                    for (int n = 0; n < 2; ++n) acc[a][b][m][n] = (f32x4){0.f, 0.f, 0.f, 0.f};
        cur = nxt; cA = nA; cB = nB; ++ui;
        if constexpr (ALIGN_EPI) { if (wr == 1) PG8_BAR; }
    }
    PG8_WAIT_V(0);
    if constexpr (!ALIGN_EPI) { if (wr == 0) PG8_BAR; }
    PG8_BAR;
#undef PG8_SA
#undef PG8_SB
#undef PG8_STAGE
#undef PG8_LDA
#undef PG8_LDB
#undef PG8_MMA
#undef PG8_WAIT_V
#undef PG8_WAIT_L
#undef PG8_BAR
#undef PG8_SCHED
}
}

typedef int i32x4q __attribute__((ext_vector_type(4)));
struct EpiPtrs {
    const GAS float* biasp; const GAS float* lb; const GAS float* x; GAS float* out; GAS unsigned char* ws; int round;
    int pn0;
    const GAS float* sa; const GAS float* sb; const GAS float* sym; const GAS float* syg; const GAS float* sxq;
};
template <int MODE> struct EpiX {
    static constexpr bool PERM = true, AFTER_DRAIN = false;
    EpiPtrs P;
    __device__ __forceinline__ void operator()(const f32x4 (&acc)[2][2][4][2], const pg8::Unit& u, int wr, int wc, int fr, int fq) const {
        const int upn = u.pn + (MODE == 2 ? P.pn0 : 0);
        const int row0 = u.pm * 256 + wr * 64 + fr;
        const int colt = upn * 256 + wc * 32 + 8 * fq;
        GAS unsigned char* ws = P.ws;
        bf16_t* dst = nullptr; int ld = 0, coff = 0, act = 0; const GAS float* bias = nullptr;
        if (MODE == 1 || MODE == 7) {
            bias = P.biasp;
            if (upn < 8) { dst = (bf16_t*)(ws + WS_QKPRE); ld = 2048; coff = 0; act = 0; }
            else if (upn < 16) { dst = (bf16_t*)(ws + WS_V); ld = 2048; coff = 2048; act = 0; }
            else if (upn < 20) { dst = (bf16_t*)(ws + WS_GFLOG); ld = 1024; coff = 4096; act = 3; }
            else if (upn < 24) { dst = (bf16_t*)(ws + WS_GI); ld = 1024; coff = 5120; act = 0; }
            else { dst = (bf16_t*)(ws + WS_GQ); ld = 1024; coff = 6144; act = 2; }
        } else if (MODE == 2) {
            bias = P.biasp + N1;
            if (upn < 8) { dst = (bf16_t*)(ws + WS_SIGO); ld = 2048; coff = 0; act = 1; }
            else if (upn < 12) { dst = (bf16_t*)(ws + WS_SGG); ld = 1024; coff = 2048; act = 2; }
            else if (upn < 16) { dst = (bf16_t*)(ws + WS_SAM); ld = 1024; coff = 3072; act = 1; }
            else { dst = (bf16_t*)(ws + WS_SAG); ld = 1024; coff = 4096; act = 1; }
        } else if (MODE == 6) { dst = (bf16_t*)(ws + WS_QP); ld = 2048; coff = 0; act = 0; }
        float sr8[2][4];
#pragma unroll
        for (int ai = 0; ai < 2; ++ai)
#pragma unroll
            for (int m = 0; m < 4; ++m) { const int row = row0 + ai * 128 + m * 16;
                sr8[ai][m] = (MODE == 3) ? P.sym[row] : (MODE == 4) ? P.syg[row] : (MODE == 6) ? P.sxq[row] : (MODE == 2 || MODE == 7) ? P.sa[(size_t)P.round * RT + row] : 1.0f; }
#pragma unroll
        for (int bj = 0; bj < 2; ++bj) {
            const int col = colt + bj * 128;
            f32x4 b0 = (f32x4){0.f, 0.f, 0.f, 0.f}, b1 = b0, l0 = b0, l1 = b0;
            if (MODE == 1 || MODE == 2 || MODE == 7) { b0 = *(const f32x4*)(bias + col); b1 = *(const f32x4*)(bias + col + 4); }
            f32x4 s0 = (f32x4){1.f, 1.f, 1.f, 1.f}, s1 = s0;
            if (MODE == 2) { s0 = *(const GAS f32x4*)(P.sb + 7168 + col); s1 = *(const GAS f32x4*)(P.sb + 7168 + col + 4); }
            if (MODE == 7) { s0 = *(const GAS f32x4*)(P.sb + col); s1 = *(const GAS f32x4*)(P.sb + col + 4); }
            if (MODE == 3) { s0 = *(const GAS f32x4*)(P.sb + 12288 + col); s1 = *(const GAS f32x4*)(P.sb + 12288 + col + 4); }
            if (MODE == 4) { s0 = *(const GAS f32x4*)(P.sb + 13312 + col); s1 = *(const GAS f32x4*)(P.sb + 13312 + col + 4); }
            if (MODE == 6) { s0 = *(const GAS f32x4*)(P.sb + 14336 + col); s1 = *(const GAS f32x4*)(P.sb + 14336 + col + 4); }
            if (MODE == 1 || MODE == 7) { if (act == 3) { l0 = *(const f32x4*)(P.lb + (col - coff)); l1 = *(const f32x4*)(P.lb + (col - coff) + 4); } }
#pragma unroll
            for (int ai = 0; ai < 2; ++ai) {
                u32x4 gpre[4], zpre[4]; f32x4 xpre[4][2];
#pragma unroll
                for (int m = 0; m < 4; ++m) { const int row = row0 + ai * 128 + m * 16;
                    if (MODE == 3) gpre[m] = *(const GAS u32x4*)((const GAS bf16_t*)(ws + WS_SAM) + (size_t)row * 1024 + col);
                    if (MODE == 4) { gpre[m] = *(const GAS u32x4*)((const GAS bf16_t*)(ws + WS_SAG) + (size_t)row * 1024 + col);
                                     zpre[m] = *(const GAS u32x4*)((const GAS bf16_t*)P.out + (size_t)T * 1024 + ((size_t)P.round * RT + row) * 1024 + col); }
                    if (MODE == 5) { const size_t off = ((size_t)P.round * RT + row) * 1024 + col; xpre[m][0] = *(const GAS f32x4*)(P.x + off); xpre[m][1] = *(const GAS f32x4*)(P.x + off + 4); } }
#pragma unroll
                for (int m = 0; m < 4; ++m) {
                    const int row = row0 + ai * 128 + m * 16;
                    f32x4 v0, v1;
                    if (MODE == 2 || MODE == 7 || MODE == 3 || MODE == 4 || MODE == 6) { const float sr = sr8[ai][m]; const i32x4q q0 = __builtin_bit_cast(i32x4q, acc[ai][bj][m][0]), q1 = __builtin_bit_cast(i32x4q, acc[ai][bj][m][1]);
                        v0 = (f32x4){(float)q0[0], (float)q0[1], (float)q0[2], (float)q0[3]} * (s0 * sr) + b0; v1 = (f32x4){(float)q1[0], (float)q1[1], (float)q1[2], (float)q1[3]} * (s1 * sr) + b1; }
                    else { v0 = acc[ai][bj][m][0] + b0; v1 = acc[ai][bj][m][1] + b1; }
                    if (MODE == 1 || MODE == 2 || MODE == 6 || MODE == 7) {
                        if (act == 1) {
#pragma unroll
                            for (int j = 0; j < 4; ++j) { v0[j] = sigmoidf_(v0[j]); v1[j] = sigmoidf_(v1[j]); }
                        } else if (act == 2) {
#pragma unroll
                            for (int j = 0; j < 4; ++j) { v0[j] = siluf_(v0[j]); v1[j] = siluf_(v1[j]); }
                        } else if (act == 3) {
#pragma unroll
                            for (int j = 0; j < 4; ++j) { v0[j] = __logf(l0[j] + (1.0f - l0[j]) * sigmoidf_(v0[j])); v1[j] = __logf(l1[j] + (1.0f - l1[j]) * sigmoidf_(v1[j])); }
                        }
                        u32x4 w; w.x = pk2(v0[0], v0[1]); w.y = pk2(v0[2], v0[3]); w.z = pk2(v1[0], v1[1]); w.w = pk2(v1[2], v1[3]);
                        *(u32x4*)(dst + (size_t)row * ld + (col - coff)) = w;
                    } else if (MODE == 3) {
                        const u32x4 g = gpre[m];
                        GAS bf16_t* o = (GAS bf16_t*)P.out + (size_t)T * 1024 + ((size_t)P.round * RT + row) * 1024 + col;
                        f32x4 r0, r1;
                        r0[0] = v0[0] * bf_lo(g.x); r0[1] = v0[1] * bf_hi(g.x); r0[2] = v0[2] * bf_lo(g.y); r0[3] = v0[3] * bf_hi(g.y);
                        r1[0] = v1[0] * bf_lo(g.z); r1[1] = v1[1] * bf_hi(g.z); r1[2] = v1[2] * bf_lo(g.w); r1[3] = v1[3] * bf_hi(g.w);
                        u32x4 w; w.x = pk2(r0[0], r0[1]); w.y = pk2(r0[2], r0[3]); w.z = pk2(r1[0], r1[1]); w.w = pk2(r1[2], r1[3]);
                        *(GAS u32x4*)o = w;
                    } else if (MODE == 4) {
                        const u32x4 g = gpre[m], zv = zpre[m];
                        const f32x4 p0 = (f32x4){bf_lo(zv.x), bf_hi(zv.x), bf_lo(zv.y), bf_hi(zv.y)}, p1 = (f32x4){bf_lo(zv.z), bf_hi(zv.z), bf_lo(zv.w), bf_hi(zv.w)};
                        f32x4 r0, r1;
                        r0[0] = p0[0] + v0[0] * bf_lo(g.x); r0[1] = p0[1] + v0[1] * bf_hi(g.x); r0[2] = p0[2] + v0[2] * bf_lo(g.y); r0[3] = p0[3] + v0[3] * bf_hi(g.y);
                        r1[0] = p1[0] + v1[0] * bf_lo(g.z); r1[1] = p1[1] + v1[1] * bf_hi(g.z); r1[2] = p1[2] + v1[2] * bf_lo(g.w); r1[3] = p1[3] + v1[3] * bf_hi(g.w);
                        u32x4 w; w.x = pk2(r0[0], r0[1]); w.y = pk2(r0[2], r0[3]); w.z = pk2(r1[0], r1[1]); w.w = pk2(r1[2], r1[3]);
                        *(u32x4*)((bf16_t*)(ws + WS_GFLOG) + (size_t)row * 1024 + col) = w;
                    } else if (MODE == 5) {
                        const size_t off = ((size_t)P.round * RT + row) * 1024 + col;
                        const f32x4 x0 = xpre[m][0] + v0, x1 = xpre[m][1] + v1;
                        u32x4 w; w.x = pk2(x0[0], x0[1]); w.y = pk2(x0[2], x0[3]); w.z = pk2(x1[0], x1[1]); w.w = pk2(x1[2], x1[3]);
                        *(GAS u32x4*)((GAS bf16_t*)P.out + off) = w;
                    }
                }
            }
        }
    }
};

__device__ __forceinline__ void p0_transpose_item(const GAS float* W, int ldw, int K, int k0, int scol, GAS bf16_t* WT, int drow, LAS float* scr, int lane) {
#pragma unroll 8
    for (int i = 0; i < 32; ++i) { const int kk = 2 * i + (lane >> 5); scr[kk * 33 + (lane & 31)] = W[(size_t)(k0 + kk) * ldw + scol + (lane & 31)]; }
    LDS_WAIT(); asm volatile("" ::: "memory");
    const int c = lane & 7;
#pragma unroll
    for (int j = 0; j < 4; ++j) { const int n = (lane >> 3) + 8 * j; const LAS float* s = scr + (8 * c) * 33 + n;
        u32x4 o; o.x = pk2(s[0 * 33], s[1 * 33]); o.y = pk2(s[2 * 33], s[3 * 33]); o.z = pk2(s[4 * 33], s[5 * 33]); o.w = pk2(s[6 * 33], s[7 * 33]);
        *(u32x4*)(WT + (size_t)(drow + n) * K + k0 + 8 * c) = o; }
    LDS_WAIT(); asm volatile("" ::: "memory");
}
__device__ __forceinline__ void p0_colmax_item(const GAS float* W, int ldw, int k0, int scol, GAS unsigned* colmax, int lane) {
    float mx = 0.f;
#pragma unroll 8
    for (int i = 0; i < 32; ++i) { const int kk = 2 * i + (lane >> 5); mx = fmaxf(mx, fabsf(W[(size_t)(k0 + kk) * ldw + scol + (lane & 31)])); }
    mx = fmaxf(mx, __builtin_bit_cast(float, xor32u_(__builtin_bit_cast(unsigned, mx), lane >= 32)));
    if (lane < 32) atomicMax((unsigned*)colmax + lane, __builtin_bit_cast(unsigned, mx));
}
__device__ __forceinline__ void p0_cvt8_item(const GAS float* W, int ldw, int k0, int scol, const GAS unsigned* colmax, GAS unsigned char* WT8, int pitch, GAS float* sb, int drow, LAS float* scr, int lane) {
    const float cm = __builtin_bit_cast(float, colmax[lane & 31]);
    const float qs = cm > 0.f ? 127.0f / cm : 0.f;
    if (k0 == 0 && lane < 32) sb[lane] = cm * (1.0f / 127.0f);
#pragma unroll 8
    for (int i = 0; i < 32; ++i) { const int kk = 2 * i + (lane >> 5); scr[kk * 33 + (lane & 31)] = W[(size_t)(k0 + kk) * ldw + scol + (lane & 31)] * qs; }
    LDS_WAIT(); asm volatile("" ::: "memory");
    const int n = lane >> 1, kh = lane & 1;
    const LAS float* sp = scr + (kh * 32) * 33 + n;
    u32x4 o0, o1;
#pragma unroll
    for (int q = 0; q < 8; ++q) { const unsigned p = pack_i8x4(sp[(4 * q) * 33], sp[(4 * q + 1) * 33], sp[(4 * q + 2) * 33], sp[(4 * q + 3) * 33]);
        if (q < 4) o0[q] = p; else o1[q - 4] = p; }
    GAS unsigned char* dst = WT8 + (size_t)(drow + n) * pitch + k0 + kh * 32;
    *(GAS u32x4*)dst = o0; *(GAS u32x4*)(dst + 16) = o1;
    LDS_WAIT(); asm volatile("" ::: "memory");
}
__device__ __forceinline__ int win_src_col(int n) {
    if (n < 4096) return n;
    if (n < 7168) return n - 4096 + 6152;
    if (n < 9216) return n - 7168 + 4096;
    return n - 9216 + 9224;
}

__device__ __forceinline__ void phase_p0(const DArgs& a, LAS unsigned char* lds, int vcu, int G) {
    const int tid = tid_(), lane = tid & 63, wave = tid >> 6;
    const int gw = vcu * NWAVES + wave, NGW = G * NWAVES;
    GAS unsigned char* ws = a.ws;
    LAS float* scr = (LAS float*)(lds + wave * 16384);
    constexpr int I_IN = 16 * 384, I_M = 32 * 32, I_G = 16 * 32, I_O = 16 * 32, I_PQ = 16 * 64;
    constexpr int NITEMS = I_IN + I_M + I_G + I_O + I_PQ;
    for (int it = gw; it < NITEMS; it += NGW) {
        int r = it;
        if (r < I_IN) { const int kb = r / 384, nb = r % 384;
            p0_colmax_item(a.w_in, IN_COLS, kb * 64, win_src_col(nb * 32), (GAS unsigned*)(ws + WS_CTL) + CW_COLMAX + nb * 32, lane);
            continue; } r -= I_IN;
        if (r < I_M) { const int kb = r / 32, nb = r % 32; p0_colmax_item(a.w_br_m, 1024, kb * 64, nb * 32, (GAS unsigned*)(ws + WS_CTL) + CW_COLMAX + 12288 + nb * 32, lane); continue; } r -= I_M;
        if (r < I_G) { const int kb = r / 32, nb = r % 32; p0_colmax_item(a.w_br_g, 1024, kb * 64, nb * 32, (GAS unsigned*)(ws + WS_CTL) + CW_COLMAX + 13312 + nb * 32, lane); continue; } r -= I_G;
        if (r < I_O) { const int kb = r / 32, nb = r % 32; p0_transpose_item(a.w_out, 1024, 1024, kb * 64, nb * 32, (GAS bf16_t*)(ws + WS_WO), nb * 32, scr, lane); continue; } r -= I_O;
        { const int kb = r / 64, nb = r % 64; p0_colmax_item(a.w_pq, 2048, kb * 64, nb * 32, (GAS unsigned*)(ws + WS_CTL) + CW_COLMAX + 14336 + nb * 32, lane); }
    }
    const int gt = vcu * NTHR + tid, NGT = G * NTHR;
    for (int i = gt; i < NP; i += NGT) ((float*)(ws + WS_BIASP))[i] = a.b_in[win_src_col(i)];
    for (int i = gt; i < 1024; i += NGT) { const float t0 = a.lb_table[i], t1 = a.lb_table[1024 + i]; ((float*)(ws + WS_LB))[i] = 1.0f / (1.0f + __expf(t1 - t0)); }
    for (int i = gt; i < 8 * 2 * 128 * 128 / 4; i += NGT) { const f32x4 v = ((const f32x4*)a.sub_keys)[i]; u32x2 o; o.x = pk2(v[0], v[1]); o.y = pk2(v[2], v[3]); ((u32x2*)(ws + WS_SK))[i] = o; }
    f32x4 g1[4];
#pragma unroll
    for (int j = 0; j < 4; ++j) g1[j] = ((const GAS f32x4*)a.norm1_g)[64 * j + lane];
    f32x4 gw0[16], gw1[16];
#pragma unroll
    for (int j = 0; j < 4; ++j)
#pragma unroll
        for (int e = 0; e < 4; ++e) { const int k = 256 * j + 4 * lane + e; gw0[4 * j + e] = *(const GAS f32x4*)(a.w_in + (size_t)k * IN_COLS + 6144); gw1[4 * j + e] = *(const GAS f32x4*)(a.w_in + (size_t)k * IN_COLS + 6148); }
    const float gbias = lane < 8 ? a.b_in[6144 + lane] : 0.f;
    for (int m = gw; m < T; m += NGW) {
        const GAS f32x4* xr = (const GAS f32x4*)(a.x + (size_t)m * D) + lane;
        f32x4 v[4]; float s = 0.f;
#pragma unroll
        for (int j = 0; j < 4; ++j) { v[j] = xr[64 * j]; s += (v[j][0] * v[j][0] + v[j][1] * v[j][1]) + (v[j][2] * v[j][2] + v[j][3] * v[j][3]); }
        const float rstd = rsqrtf(wave_sum(s, lane) * (1.f / D) + EPS);
        f32x4 ga0 = (f32x4){0.f, 0.f, 0.f, 0.f}, ga1 = ga0;
        float mx = 0.f;
#pragma unroll
        for (int j = 0; j < 4; ++j) {
            v[j] = v[j] * rstd * g1[j];
            mx = fmaxf(mx, fmaxf(fmaxf(fabsf(v[j][0]), fabsf(v[j][1])), fmaxf(fabsf(v[j][2]), fabsf(v[j][3]))));
#pragma unroll
            for (int e = 0; e < 4; ++e) { ga0 += gw0[4 * j + e] * v[j][e]; ga1 += gw1[4 * j + e] * v[j][e]; }
        }
        {
            mx = wave_max(mx);
            const float qs = mx > 0.f ? 127.0f / mx : 0.f;
#pragma unroll
            for (int jq = 0; jq < 4; ++jq) ((GAS unsigned*)(ws + WS_XN8 + (size_t)m * 1024))[64 * jq + lane] = pack_i8x4(v[jq][0] * qs, v[jq][1] * qs, v[jq][2] * qs, v[jq][3] * qs);
            if (lane == 0) ((GAS float*)(ws + WS_SA8))[m] = mx * (1.0f / 127.0f);
        }
        float ga[8] = {ga0[0], ga0[1], ga0[2], ga0[3], ga1[0], ga1[1], ga1[2], ga1[3]};
#pragma unroll
        for (int q = 0; q < 8; ++q) ga[q] = wave_sum(ga[q], lane);
        if (lane < 8) { float r = ga[0];
#pragma unroll
            for (int q = 1; q < 8; ++q) r = (lane == q) ? ga[q] : r;
            ((GAS float*)(ws + WS_GATES))[(size_t)m * 8 + lane] = r + gbias; }
    }
}

__device__ __forceinline__ float logsigf_(float x) { return fminf(x, 0.f) - log1pf(__expf(-fabsf(x))); }
#define LDS_BAR() do { asm volatile("s_waitcnt lgkmcnt(0)" ::: "memory"); __builtin_amdgcn_s_barrier(); asm volatile("" ::: "memory"); } while (0)
#define MFMA16(a, b, c) __builtin_amdgcn_mfma_f32_16x16x32_bf16((a), (b), (c), 0, 0, 0)
__device__ __forceinline__ bf16x8 lfrag(const LAS unsigned char* base, int pitch, int row, int k0, int fq) { return *(const LAS bf16x8*)(base + row * pitch + (k0 + 8 * fq) * 2); }
__device__ __forceinline__ int fm_off(int r, int k, int KB) { return (((r >> 4) * KB + (k >> 5)) << 10) + (((((k >> 3) & 3) << 4) + (r & 15)) << 4) + ((k & 7) << 1); }
__device__ __forceinline__ int fm8_off(int r, int k, int KP) { return (((r >> 4) * KP + (k >> 6)) << 10) + (((((k >> 3) & 3) << 4) + (r & 15)) << 4) + (((k >> 5) & 1) << 3) + (k & 7); }
__device__ __forceinline__ unsigned pack_fp8x4(float a, float b, float c, float d) { int p = __builtin_amdgcn_cvt_pk_fp8_f32(a, b, 0, false); p = __builtin_amdgcn_cvt_pk_fp8_f32(c, d, p, true); return (unsigned)p; }
__device__ __forceinline__ bf16x8 fp8_frag(unsigned a, unsigned b) {
    const f32x2 f0 = __builtin_amdgcn_cvt_pk_f32_fp8((int)a, false), f1 = __builtin_amdgcn_cvt_pk_f32_fp8((int)a, true), f2 = __builtin_amdgcn_cvt_pk_f32_fp8((int)b, false), f3 = __builtin_amdgcn_cvt_pk_f32_fp8((int)b, true);
    u32x4 o; o.x = pk2(f0[0], f0[1]); o.y = pk2(f1[0], f1[1]); o.z = pk2(f2[0], f2[1]); o.w = pk2(f3[0], f3[1]);
    return __builtin_bit_cast(bf16x8, o);
}
constexpr float MS_SQ = 64.0f, MS_K = 8.0f;
__device__ __forceinline__ bf16x8 gfrag(const bf16_t* base, int ld, int row, int k0, int fq) { return *(const bf16x8*)(base + (size_t)row * ld + k0 + 8 * fq); }

__device__ __forceinline__ void phase_p0c(const DArgs& a, LAS unsigned char* lds, int vcu, int G) {
    const int tid = tid_(), lane = tid & 63, wave = tid >> 6;
    const int gw = vcu * NWAVES + wave, NGW = G * NWAVES;
    GAS unsigned char* ws = a.ws;
    LAS float* scr = (LAS float*)(lds + wave * 16384);
    constexpr int J_IN = 16 * 384, J_M = 32 * 32, J_G = 16 * 32, J_PQ = 16 * 64;
    const GAS unsigned* cmx = (const GAS unsigned*)(ws + WS_CTL) + CW_COLMAX; GAS float* sb = (GAS float*)(ws + WS_SB8);
    for (int it = gw; it < J_IN + J_M + J_G + J_PQ; it += NGW) {
        int r = it;
        if (r < J_IN) { const int kb = r / 384, nb = r % 384;
            p0_cvt8_item(a.w_in, IN_COLS, kb * 64, win_src_col(nb * 32), cmx + nb * 32, ws + WS_W8A, 1024, sb + nb * 32, nb * 32, scr, lane); continue; } r -= J_IN;
        if (r < J_M) { const int kb = r / 32, nb = r % 32; p0_cvt8_item(a.w_br_m, 1024, kb * 64, nb * 32, cmx + 12288 + nb * 32, ws + WS_WM, 2048, sb + 12288 + nb * 32, nb * 32, scr, lane); continue; } r -= J_M;
        if (r < J_G) { const int kb = r / 32, nb = r % 32; p0_cvt8_item(a.w_br_g, 1024, kb * 64, nb * 32, cmx + 13312 + nb * 32, ws + WS_WG, 1024, sb + 13312 + nb * 32, nb * 32, scr, lane); continue; } r -= J_G;
        { const int kb = r / 64, nb = r % 64; p0_cvt8_item(a.w_pq, 2048, kb * 64, nb * 32, cmx + 14336 + nb * 32, ws + WS_WPQ, 1024, sb + 14336 + nb * 32, nb * 32, scr, lane); }
    }
}
__device__ __forceinline__ void mscan_pair(const DArgs& a, LAS unsigned char* lds, int round, int p) {
    const int tid = tid_(), lane = tid & 63, part = tid >> 6;
    const int bl = p >> 2, h = p & 3, b = round * 2 + bl;
    const GAS float* g = (const GAS float*)(a.ws + WS_GATES) + ((size_t)b * SEQ + (size_t)lane * 128 + part * 16) * 8;
    float bsum = 0.f, gm = -INFINITY;
#pragma unroll 4
    for (int s = 0; s < 16; ++s) { const float ip = g[s * 8 + h], fp = g[s * 8 + 4 + h]; bsum += logsigf_(fp); gm = fmaxf(gm, ip - bsum); }
    LAS float* PS = (LAS float*)lds; LAS float* PM = PS + 512;
    PS[part * 64 + lane] = bsum; PM[part * 64 + lane] = gm;
    __syncthreads();
    if (tid < 64) {
        float bs = 0.f, g2 = -INFINITY;
#pragma unroll
        for (int q = 0; q < 8; ++q) { g2 = fmaxf(g2, PM[q * 64 + lane] - bs); bs += PS[q * 64 + lane]; }
        float mprev = 0.f, mine = 0.f;
        for (int c = 0; c < 64; ++c) {
            const float bc = rdlane(bs, c), gc = rdlane(g2, c);
            if (lane == c) mine = mprev; mprev = bc + fmaxf(mprev, gc); }
        ((GAS float*)(a.ws + WS_MPREV))[(round * 8 + p) * 64 + lane] = mine;
    }
    __syncthreads();
}

constexpr int PQ_PITCH = 528, PS_PITCH = 272;
__device__ __forceinline__ void mlstm_pre_item(const DArgs& a, LAS unsigned char* lds, int round, int item) {
    const int tid = tid_(), lane = tid & 63, wave = __builtin_amdgcn_readfirstlane(tid >> 6), fr = lane & 15, fq = lane >> 4;
    const int p = item >> 6, c = item & 63, bl = p >> 2, h = p & 3, b = round * 2 + bl;
    const int tl0 = bl * SEQ + c * 128; const size_t tg0 = (size_t)b * SEQ + c * 128;
    GAS unsigned char* ws = a.ws;
    LAS unsigned char* QL = lds; LAS unsigned char* KL = lds + 67584;
    LAS float* AS = (LAS float*)(lds + 135168); LAS float* MS = AS + 128; LAS float* SC = AS + 256;
    if (wave == 0) {
        const float mprev = ((const float*)(ws + WS_MPREV))[(round * 8 + p) * 64 + c];
        const float* g = (const float*)(ws + WS_GATES) + (tg0 + 2 * lane) * 8;
        const float ip0 = g[h], fp0 = g[4 + h], ip1 = g[8 + h], fp1 = g[12 + h];
        const float lf0 = logsigf_(fp0), lf1 = logsigf_(fp1), pp = lf0 + lf1;
        float incl = pp;
#pragma unroll
        for (int o = 1; o < 64; o <<= 1) { const float t = shup(incl, o, lane); if (lane >= o) incl += t; }
        const float excl = incl - pp, b0 = excl + lf0, b1 = incl;
        const float a0 = ip0 - b0, a1 = ip1 - b1;
        float inclm = fmaxf(a0, a1);
#pragma unroll
        for (int o = 1; o < 64; o <<= 1) { const float t = shup(inclm, o, lane); if (lane >= o) inclm = fmaxf(inclm, t); }
        float exclm = shup(inclm, 1, lane); if (lane == 0) exclm = -INFINITY;
        const float M0 = fmaxf(mprev, fmaxf(exclm, a0)), M1 = fmaxf(mprev, inclm);
        AS[2 * lane] = a0; AS[2 * lane + 1] = a1; MS[2 * lane] = M0; MS[2 * lane + 1] = M1;
        float* mt = (float*)(ws + WS_MT) + (tg0 + 2 * lane) * 4 + h;
        mt[0] = b0 + M0; mt[4] = b1 + M1;
        const float Mlast = rdlane(M1, 63);
        if (lane == 0) { SC[0] = mprev; SC[1] = Mlast; ((float*)(ws + WS_MDEC))[item] = __expf(mprev - Mlast); }
    }
    {
        const int cgp = tid & 63, strip = tid >> 6;
        const int col = (cgp < 32) ? (h * 256 + cgp * 8) : (1024 + h * 256 + (cgp - 32) * 8);
        float w[4][8], bb[8];
#pragma unroll
        for (int j = 0; j < 4; ++j) { const f32x4 w0 = *(const f32x4*)(a.conv_w + j * 2048 + col), w1 = *(const f32x4*)(a.conv_w + j * 2048 + col + 4);
#pragma unroll
            for (int e = 0; e < 4; ++e) { w[j][e] = w0[e]; w[j][4 + e] = w1[e]; } }
        { const f32x4 b0 = *(const f32x4*)(a.conv_b + col), b1 = *(const f32x4*)(a.conv_b + col + 4);
#pragma unroll
            for (int e = 0; e < 4; ++e) { bb[e] = b0[e]; bb[4 + e] = b1[e]; } }
        const bf16_t* src = (const bf16_t*)(ws + WS_QKPRE) + (size_t)(tl0 + 16 * strip) * 2048 + col;
        const float qs = (cgp < 32) ? 0.0625f : 1.0f;
        LAS unsigned char* dstt = ((cgp < 32) ? QL : KL) + (cgp & 31) * 16;
#pragma unroll 1
        for (int half = 0; half < 2; ++half) {
            u32x4 xr[11];
#pragma unroll
            for (int r = 0; r < 11; ++r) {
                const int sl = c * 128 + 16 * strip + 8 * half + r - 3;
                xr[r] = (sl >= 0) ? *(const u32x4*)(src + (ptrdiff_t)(8 * half + r - 3) * 2048) : (u32x4){0u, 0u, 0u, 0u};
            }
#pragma unroll
            for (int r = 0; r < 8; ++r) {
                float y[8];
#pragma unroll
                for (int e = 0; e < 8; ++e) y[e] = bb[e];
#pragma unroll
                for (int j = 0; j < 4; ++j) { const u32x4 xv = xr[r + j];
                    y[0] += w[j][0] * bf_lo(xv.x); y[1] += w[j][1] * bf_hi(xv.x); y[2] += w[j][2] * bf_lo(xv.y); y[3] += w[j][3] * bf_hi(xv.y);
                    y[4] += w[j][4] * bf_lo(xv.z); y[5] += w[j][5] * bf_hi(xv.z); y[6] += w[j][6] * bf_lo(xv.w); y[7] += w[j][7] * bf_hi(xv.w); }
#pragma unroll
                for (int e = 0; e < 8; ++e) y[e] = siluf_(y[e]) * qs;
                u32x4 o; o.x = pk2(y[0], y[1]); o.y = pk2(y[2], y[3]); o.z = pk2(y[4], y[5]); o.w = pk2(y[6], y[7]);
                *(LAS u32x4*)(dstt + (16 * strip + 8 * half + r) * PQ_PITCH) = o;
            }
        }
    }
    __syncthreads();
    const float mprev = SC[0], Mlast = SC[1];
    {
        GAS unsigned char* Sg = ws + WS_S + (size_t)item * 16384;
        const int t = wave * 16 + fr; const float Mt = MS[t];
        for (int st = 0; st < 8; ++st) {
            unsigned o = 0u;
            if (st <= wave) {
                f32x4 acc = (f32x4){0.f, 0.f, 0.f, 0.f};
#pragma unroll
                for (int ks = 0; ks < 8; ++ks) acc = MFMA16(lfrag(KL, PQ_PITCH, st * 16 + fr, ks * 32, fq), lfrag(QL, PQ_PITCH, wave * 16 + fr, ks * 32, fq), acc);
                float v[4];
#pragma unroll
                for (int j = 0; j < 4; ++j) { const int s = st * 16 + 4 * fq + j; v[j] = (s <= t) ? acc[j] * __expf(AS[s] - Mt) : 0.f; }
                o = pack_fp8x4(fmaxf(fminf(v[0] * MS_SQ, 448.0f), -448.0f), fmaxf(fminf(v[1] * MS_SQ, 448.0f), -448.0f), fmaxf(fminf(v[2] * MS_SQ, 448.0f), -448.0f), fmaxf(fminf(v[3] * MS_SQ, 448.0f), -448.0f));
            }
            *(GAS unsigned*)(Sg + fm8_off(t, st * 16 + 4 * fq, 2)) = o;
        }
    }
    {
        GAS unsigned char* Qg = ws + WS_QT + (size_t)item * 32768;
#pragma unroll
        for (int i = 0; i < 8; ++i) { const int idx = tid + 512 * i, blk = idx >> 6, t = (blk >> 3) * 16 + (idx & 15), ch = (blk & 7) * 4 + ((idx >> 4) & 3);
            const u32x4 v = *(const LAS u32x4*)(QL + t * PQ_PITCH + ch * 16); const float s = __expf(mprev - MS[t]) * MS_SQ;
            u32x2 o; o.x = pack_fp8x4(bf_lo(v.x) * s, bf_hi(v.x) * s, bf_lo(v.y) * s, bf_hi(v.y) * s); o.y = pack_fp8x4(bf_lo(v.z) * s, bf_hi(v.z) * s, bf_lo(v.w) * s, bf_hi(v.w) * s);
            *(GAS u32x2*)(Qg + fm8_off(t, ch * 8, 4)) = o; }
    }
    {
        GAS unsigned char* Kg = ws + WS_KWT + (size_t)item * 32768;
        const int dlo = lane & 15, sglo = lane >> 4;
#pragma unroll
        for (int i = 0; i < 8; ++i) { const int combo = wave * 8 + i, d = (combo >> 2) * 16 + dlo, s0 = ((combo & 3) * 4 + sglo) * 8;
            float v[8];
#pragma unroll
            for (int e = 0; e < 8; ++e) v[e] = bf2f(*(const LAS bf16_t*)(KL + (s0 + e) * PQ_PITCH + d * 2)) * (__expf(AS[s0 + e] - Mlast) * MS_K);
            u32x2 o; o.x = pack_fp8x4(v[0], v[1], v[2], v[3]); o.y = pack_fp8x4(v[4], v[5], v[6], v[7]);
            *(GAS u32x2*)(Kg + fm8_off(d, s0, 2)) = o; }
    }
    __syncthreads();
}

__device__ __forceinline__ void hgrn_pre_load(const DArgs& a, int round, int item, u32x4 (&gq)[4]) {
    const int tid = tid_();
    const int p = item >> 7, c = item & 127, bl = p >> 3, h = p & 7;
    const int tl0 = bl * SEQ + c * 64;
    GAS unsigned char* ws = a.ws;
#pragma unroll
    for (int i = 0; i < 2; ++i) { const int idx = tid + 512 * i, s = idx >> 4, ch = idx & 15;
        gq[2 * i] = *(const GAS u32x4*)((const GAS bf16_t*)(ws + WS_GFLOG) + (size_t)(tl0 + s) * 1024 + h * 128 + ch * 8);
        gq[2 * i + 1] = *(const GAS u32x4*)((const GAS bf16_t*)(ws + WS_GQ) + (size_t)(tl0 + s) * 1024 + h * 128 + ch * 8); }
}
__device__ __forceinline__ void hgrn_pre_item(const DArgs& a, LAS unsigned char* lds, int round, int item, u32x4 (&gq)[4], int next_item) {
    const int tid = tid_(), lane = tid & 63, wave = __builtin_amdgcn_readfirstlane(tid >> 6), fr = lane & 15, fq = lane >> 4;
    const int p = item >> 7, c = item & 127, bl = p >> 3, h = p & 7;
    const int tl0 = bl * SEQ + c * 64;
    GAS unsigned char* ws = a.ws;
    LAS float* CUM = (LAS float*)lds;
    LAS float* GL = (LAS float*)(lds + 32768);
    LAS unsigned char* QH = lds + 65536;
    LAS unsigned char* KE = lds + 65536 + 64 * PS_PITCH;
    LAS float* QF = (LAS float*)(lds + 65536 + 128 * PS_PITCH);
#pragma unroll
    for (int i = 0; i < 2; ++i) { const int idx = tid + 512 * i, s = idx >> 4, ch = idx & 15;
        const u32x4 gv = gq[2 * i], qv = gq[2 * i + 1];
        LAS float* gd = GL + s * 128 + ch * 8; LAS float* qd = QF + s * 128 + ch * 8;
        gd[0] = bf_lo(gv.x); gd[1] = bf_hi(gv.x); gd[2] = bf_lo(gv.y); gd[3] = bf_hi(gv.y); gd[4] = bf_lo(gv.z); gd[5] = bf_hi(gv.z); gd[6] = bf_lo(gv.w); gd[7] = bf_hi(gv.w);
        qd[0] = bf_lo(qv.x); qd[1] = bf_hi(qv.x); qd[2] = bf_lo(qv.y); qd[3] = bf_hi(qv.y); qd[4] = bf_lo(qv.z); qd[5] = bf_hi(qv.z); qd[6] = bf_lo(qv.w); qd[7] = bf_hi(qv.w); }
    if (next_item < 2048) hgrn_pre_load(a, round, next_item, gq);
    LDS_BAR();
    {
        const int d = tid & 127, qt = tid >> 7; float cs = 0.f;
#pragma unroll 4
        for (int s = 0; s < 16; ++s) { cs += GL[(qt * 16 + s) * 128 + d]; CUM[(qt * 16 + s) * 128 + d] = cs; }
        LDS_BAR();
        float off = 0.f;
#pragma unroll
        for (int q = 0; q < 3; ++q) off += (q < qt) ? CUM[(q * 16 + 15) * 128 + d] : 0.f;
        LDS_BAR();
#pragma unroll 4
        for (int s = 0; s < 16; ++s) CUM[(qt * 16 + s) * 128 + d] += off;
        if (qt == 3) ((GAS float*)(ws + WS_HGDEC))[(size_t)item * 128 + d] = __expf(cs + off);
    }
    LDS_BAR();
    {
        GAS unsigned char* Qg = ws + WS_QTG + (size_t)item * 8192;
#pragma unroll
        for (int i = 0; i < 2; ++i) { const int idx = tid + 512 * i, s = idx >> 4, ch = idx & 15;
            float qt[8], qh[8], ke[8];
#pragma unroll
            for (int e = 0; e < 8; ++e) { const int d = ch * 8 + e; const float cm = CUM[s * 128 + d], last = CUM[63 * 128 + d], q = QF[s * 128 + d], g = GL[s * 128 + d];
                qt[e] = q * __expf(cm); qh[e] = q * __expf(cm - last); ke[e] = (1.0f - __expf(g)) * __expf(last - cm); }
            { u32x2 o8; o8.x = pack_fp8x4(qt[0] * 16.0f, qt[1] * 16.0f, qt[2] * 16.0f, qt[3] * 16.0f); o8.y = pack_fp8x4(qt[4] * 16.0f, qt[5] * 16.0f, qt[6] * 16.0f, qt[7] * 16.0f);
              *(GAS u32x2*)(Qg + fm8_off(s, ch * 8, 2)) = o8; }
            u32x4 o;
            o.x = pk2(qh[0], qh[1]); o.y = pk2(qh[2], qh[3]); o.z = pk2(qh[4], qh[5]); o.w = pk2(qh[6], qh[7]);
            *(LAS u32x4*)(QH + s * PS_PITCH + ch * 16) = o;
            o.x = pk2(ke[0], ke[1]); o.y = pk2(ke[2], ke[3]); o.z = pk2(ke[4], ke[5]); o.w = pk2(ke[6], ke[7]);
            *(LAS u32x4*)(KE + s * PS_PITCH + ch * 16) = o; }
    }
    LDS_BAR();
    {
        GAS unsigned char* Ag = ws + WS_ATT + (size_t)item * 4096;
#pragma unroll
        for (int i = 0; i < 2; ++i) { const int tile = wave * 2 + i, tt = tile >> 2, st = tile & 3; const int t = tt * 16 + fr;
            unsigned o = 0u;
            if (st <= tt) { f32x4 acc = (f32x4){0.f, 0.f, 0.f, 0.f};
#pragma unroll
                for (int ks = 0; ks < 4; ++ks) acc = MFMA16(lfrag(KE, PS_PITCH, st * 16 + fr, ks * 32, fq), lfrag(QH, PS_PITCH, tt * 16 + fr, ks * 32, fq), acc);
                float v[4];
#pragma unroll
                for (int j = 0; j < 4; ++j) { const int s = st * 16 + 4 * fq + j; v[j] = (s <= t) ? acc[j] : 0.f; }
                o = pack_fp8x4(fmaxf(fminf(v[0] * 16.0f, 448.0f), -448.0f), fmaxf(fminf(v[1] * 16.0f, 448.0f), -448.0f), fmaxf(fminf(v[2] * 16.0f, 448.0f), -448.0f), fmaxf(fminf(v[3] * 16.0f, 448.0f), -448.0f)); }
            *(GAS unsigned*)(Ag + fm8_off(t, st * 16 + 4 * fq, 1)) = o; }
    }
    {
        GAS unsigned char* Kg = ws + WS_KENDT + (size_t)item * 8192;
        const int dlo = lane & 15, sglo = lane >> 4;
#pragma unroll
        for (int i = 0; i < 2; ++i) { const int combo = wave * 2 + i, d = (combo >> 1) * 16 + dlo, s0 = ((combo & 1) * 4 + sglo) * 8;
            unsigned v[8];
#pragma unroll
            for (int e = 0; e < 8; ++e) v[e] = *(const LAS bf16_t*)(KE + (s0 + e) * PS_PITCH + d * 2);
            u32x2 o; o.x = pack_fp8x4(bf_lo(v[0]) * 16.0f, bf_lo(v[1]) * 16.0f, bf_lo(v[2]) * 16.0f, bf_lo(v[3]) * 16.0f);
            o.y = pack_fp8x4(bf_lo(v[4]) * 16.0f, bf_lo(v[5]) * 16.0f, bf_lo(v[6]) * 16.0f, bf_lo(v[7]) * 16.0f);
            *(GAS u32x2*)(Kg + fm8_off(d, s0, 1)) = o; }
    }
    LDS_BAR();
}

template <int NVT, bool DEN>
__device__ __forceinline__ void mlstm_scan(const DArgs& a, LAS unsigned char* lds, int round, int p, int sl) {
    const int tid = tid_(), lane = tid & 63, wave = __builtin_amdgcn_readfirstlane(tid >> 6), fr = lane & 15, fq = lane >> 4;
    const int bl = p >> 2, h = p & 3, b = round * 2 + bl;
    GAS unsigned char* ws = a.ws;
    constexpr int VTB = NVT * 16 * PS_PITCH, CTB = NVT * 16 * PQ_PITCH;
    LAS unsigned char* VT = lds; LAS unsigned char* CT = lds + 2 * VTB; LAS float* DEC = (LAS float*)(lds + 2 * VTB + 2 * CTB);
    for (int i = tid; i < (2 * VTB + 2 * CTB) / 4; i += NTHR) ((LAS unsigned*)lds)[i] = 0u;
    if (tid < 64) DEC[tid] = ((const GAS float*)(ws + WS_MDEC))[p * 64 + tid];
    __syncthreads();
    if (DEN) { if (tid < 256) { const int bufi = tid >> 7, s = tid & 127; *(LAS bf16_t*)(VT + bufi * VTB + s * 2) = (bf16_t)0x3F80; } }
    f32x4 st[2][NVT];
#pragma unroll
    for (int dt = 0; dt < 2; ++dt)
#pragma unroll
        for (int vt = 0; vt < NVT; ++vt) st[dt][vt] = (f32x4){0.f, 0.f, 0.f, 0.f};
    const int vcol = h * 512 + sl * 32;
    const int vs = tid >> 2, vpart = tid & 3;
    const GAS unsigned char* Sg0 = ws + WS_S + (size_t)(p * 64) * 16384 + wave * 2048 + lane * 16;
    const GAS unsigned char* Qg0 = ws + WS_QT + (size_t)(p * 64) * 32768 + wave * 4096 + lane * 16;
    const GAS unsigned char* Kg0 = ws + WS_KWT + (size_t)(p * 64) * 32768 + wave * 4096 + lane * 16;
    const GAS bf16_t* Vg0 = (const GAS bf16_t*)(ws + WS_V) + (size_t)(bl * SEQ + vs) * 2048 + vcol + vpart * 8;
    u32x4 rS[2], rQ[4], rK[2][2]; u32x4 vreg = (u32x4){0u, 0u, 0u, 0u};
#define V_STAGE(cc_) do { LAS unsigned char* d0_ = VT + ((cc_) & 1) * VTB + (vpart * 8) * PS_PITCH + vs * 2; \
        *(LAS bf16_t*)(d0_ + 0 * PS_PITCH) = (bf16_t)(vreg.x & 0xffffu); *(LAS bf16_t*)(d0_ + 1 * PS_PITCH) = (bf16_t)(vreg.x >> 16); \
        *(LAS bf16_t*)(d0_ + 2 * PS_PITCH) = (bf16_t)(vreg.y & 0xffffu); *(LAS bf16_t*)(d0_ + 3 * PS_PITCH) = (bf16_t)(vreg.y >> 16); \
        *(LAS bf16_t*)(d0_ + 4 * PS_PITCH) = (bf16_t)(vreg.z & 0xffffu); *(LAS bf16_t*)(d0_ + 5 * PS_PITCH) = (bf16_t)(vreg.z >> 16); \
        *(LAS bf16_t*)(d0_ + 6 * PS_PITCH) = (bf16_t)(vreg.w & 0xffffu); *(LAS bf16_t*)(d0_ + 7 * PS_PITCH) = (bf16_t)(vreg.w >> 16); } while (0)
    if (!DEN) { vreg = *(const GAS u32x4*)Vg0; V_STAGE(0); }
    __builtin_amdgcn_sched_barrier(0);
#pragma unroll
    for (int kp = 0; kp < 2; ++kp)
#pragma unroll
        for (int dt = 0; dt < 2; ++dt) rK[dt][kp] = *(const GAS u32x4*)(Kg0 + (dt * 2 + kp) * 1024);
    __builtin_amdgcn_sched_barrier(0);
#pragma unroll
    for (int kp = 0; kp < 2; ++kp) rS[kp] = *(const GAS u32x4*)(Sg0 + kp * 1024);
    __builtin_amdgcn_sched_barrier(0);
#pragma unroll
    for (int kp = 0; kp < 4; ++kp) rQ[kp] = *(const GAS u32x4*)(Qg0 + kp * 1024);
    __builtin_amdgcn_sched_barrier(0);
    if (!DEN) vreg = *(const GAS u32x4*)(Vg0 + (size_t)128 * 2048);
    __builtin_amdgcn_sched_barrier(0);
    const GAS unsigned char* pfp; unsigned pfstride;
    { const int tt = (wave * 64 + lane) < 80 ? wave * 64 + lane : 79; const int idx = sl * 5 + (tt >> 4), off = (tt & 15) * 64;
      pfp = (idx < 16 ? ws + WS_S + (size_t)(p * 64) * 16384 + idx * 1024 : idx < 48 ? ws + WS_QT + (size_t)(p * 64) * 32768 + (idx - 16) * 1024 : ws + WS_KWT + (size_t)(p * 64) * 32768 + (idx - 48) * 1024) + off;
      pfstride = idx < 16 ? 16384u : 32768u; }
    unsigned pfv = 0u;
#pragma unroll 1
    for (int c = 0; c < 64; ++c) {
        const int tl0 = bl * SEQ + c * 128; const size_t tg0 = (size_t)b * SEQ + c * 128;
        const int cn = c < 63 ? c + 1 : 63, cn2 = c < 62 ? c + 2 : 63;
        LAS unsigned char* vt_ = VT + (c & 1) * VTB; LAS unsigned char* ct_ = CT + (c & 1) * CTB; LAS unsigned char* ctn = CT + ((c + 1) & 1) * CTB;
        LDS_BAR();
        if (!DEN && wave < 2) { asm volatile("" :: "v"(pfv)); const int c3 = c < 60 ? c + 3 : 63; pfv = *(const GAS unsigned*)(pfp + (size_t)c3 * pfstride); }
        bf16x8 vf[NVT][4], cf[NVT][4];
#pragma unroll
        for (int vt = 0; vt < NVT; ++vt)
#pragma unroll
            for (int ks = 0; ks < 4; ++ks) vf[vt][ks] = lfrag(vt_, PS_PITCH, vt * 16 + fr, ks * 32, fq);
        const float dec = DEC[c];
        __builtin_amdgcn_sched_barrier(0);
#pragma unroll
        for (int dt = 0; dt < 2; ++dt)
#pragma unroll
            for (int vt = 0; vt < NVT; ++vt) st[dt][vt] = st[dt][vt] * dec;
#pragma unroll
        for (int ks = 0; ks < 4; ++ks) {
#pragma unroll
            for (int vt = 0; vt < NVT; ++vt) cf[vt][ks] = lfrag(ct_, PQ_PITCH, vt * 16 + fr, ks * 32, fq);
#pragma unroll
            for (int dt = 0; dt < 2; ++dt) {
                const bf16x8 aK = (ks & 1) ? fp8_frag(rK[dt][ks >> 1].z, rK[dt][ks >> 1].w) : fp8_frag(rK[dt][ks >> 1].x, rK[dt][ks >> 1].y);
#pragma unroll
                for (int vt = 0; vt < NVT; ++vt) st[dt][vt] = MFMA16(aK, vf[vt][ks], st[dt][vt]);
                if (ks & 1) rK[dt][ks >> 1] = *(const GAS u32x4*)(Kg0 + (size_t)cn * 32768 + (dt * 2 + (ks >> 1)) * 1024);
            }
            __builtin_amdgcn_sched_barrier(0);
        }
#pragma unroll
        for (int dt = 0; dt < 2; ++dt)
#pragma unroll
            for (int vt = 0; vt < NVT; ++vt) { const f32x4 sp = st[dt][vt] * (1.0f / MS_K); u32x2 o; o.x = pk2(sp[0], sp[1]); o.y = pk2(sp[2], sp[3]);
                *(LAS u32x2*)(ctn + (vt * 16 + fr) * PQ_PITCH + (wave * 32 + dt * 16 + 4 * fq) * 2) = o; }
        __builtin_amdgcn_sched_barrier(0);
        f32x4 acc[NVT];
#pragma unroll
        for (int vt = 0; vt < NVT; ++vt) acc[vt] = (f32x4){0.f, 0.f, 0.f, 0.f};
#pragma unroll
        for (int ks = 0; ks < 4; ++ks) {
            { const bf16x8 bS = (ks & 1) ? fp8_frag(rS[ks >> 1].z, rS[ks >> 1].w) : fp8_frag(rS[ks >> 1].x, rS[ks >> 1].y);
#pragma unroll
              for (int vt = 0; vt < NVT; ++vt) acc[vt] = MFMA16(vf[vt][ks], bS, acc[vt]); }
            if (ks & 1) rS[ks >> 1] = *(const GAS u32x4*)(Sg0 + (size_t)cn * 16384 + (ks >> 1) * 1024);
            __builtin_amdgcn_sched_barrier(0);
        }
#pragma unroll
        for (int ks = 0; ks < 8; ++ks) {
            { const bf16x8 bQ = (ks & 1) ? fp8_frag(rQ[ks >> 1].z, rQ[ks >> 1].w) : fp8_frag(rQ[ks >> 1].x, rQ[ks >> 1].y);
#pragma unroll
              for (int vt = 0; vt < NVT; ++vt) acc[vt] = MFMA16(cf[vt][ks & 3], bQ, acc[vt]); }
            if (ks < 4) {
#pragma unroll
                for (int vt = 0; vt < NVT; ++vt) cf[vt][ks] = lfrag(ct_, PQ_PITCH, vt * 16 + fr, 128 + ks * 32, fq);
            }
            if (ks & 1) rQ[ks >> 1] = *(const GAS u32x4*)(Qg0 + (size_t)cn * 32768 + (ks >> 1) * 1024);
            __builtin_amdgcn_sched_barrier(0);
        }
        const int t = wave * 16 + fr;
        if (!DEN) {
            GAS bf16_t* hn = (GAS bf16_t*)(ws + WS_QKPRE) + (size_t)(tl0 + t) * 2048 + vcol + 4 * fq;
#pragma unroll
            for (int vt = 0; vt < NVT; ++vt) { const f32x4 av = acc[vt] * (1.0f / MS_SQ); u32x2 o; o.x = pk2(av[0], av[1]); o.y = pk2(av[2], av[3]); *(GAS u32x2*)(hn + vt * 16) = o; }
            V_STAGE(c + 1); vreg = *(const GAS u32x4*)(Vg0 + (size_t)cn2 * 128 * 2048);
        } else {
            if (fq == 0) ((GAS float*)(ws + WS_DEN))[(tg0 + t) * 4 + h] = acc[0][0] * (1.0f / MS_SQ);
        }
    }
    asm volatile("" :: "v"(pfv));
    __syncthreads();
#undef V_STAGE
}

constexpr int HG_PD = 4;
constexpr float HS = 16.0f;
__device__ __forceinline__ void hgrn_scan(const DArgs& a, LAS unsigned char* lds, int round, int p, int sl) {
    const int tid = tid_(), lane = tid & 63, wave = __builtin_amdgcn_readfirstlane(tid >> 6), fr = lane & 15, fq = lane >> 4;
    const int bl = p >> 3, h = p & 7;
    GAS unsigned char* ws = a.ws;
    constexpr int IP = 144, ITB = 32 * IP, STB = 32 * PS_PITCH;
    LAS unsigned char* IT = lds; LAS unsigned char* ST = lds + 2 * ITB;
    for (int i = tid; i < (2 * ITB + 2 * STB) / 4; i += NTHR) ((LAS unsigned*)lds)[i] = 0u;
    __syncthreads();
    f32x4 st[2][2];
#pragma unroll
    for (int i = 0; i < 2; ++i) { st[i][0] = (f32x4){0.f, 0.f, 0.f, 0.f}; st[i][1] = st[i][0]; }
    const int vcol = h * 128 + sl * 32;
    const int is = (tid & 255) >> 2, ipart = tid & 3;
    const bool outw = wave < 4;
    const int w4 = wave & 3;
    const GAS unsigned char* Ag0 = ws + WS_ATT + (size_t)(p * 128) * 4096 + w4 * 1024 + lane * 16;
    const GAS unsigned char* Qg0 = ws + WS_QTG + (size_t)(p * 128) * 8192 + w4 * 2048 + lane * 16;
    const GAS unsigned char* Kg0 = ws + WS_KENDT + (size_t)(p * 128) * 8192 + w4 * 2048 + lane * 16;
    const GAS unsigned char* Dg0 = ws + WS_HGDEC + ((size_t)(p * 128) * 128 + w4 * 32 + 4 * fq) * 4;
    const GAS unsigned char* Ig0 = ws + WS_GI + ((size_t)(bl * SEQ + is) * 1024 + vcol + ipart * 8) * 2;
    const GAS unsigned char* gb0 = outw ? Ag0 : Kg0;          const unsigned gs0 = outw ? 4096u : 8192u;
    const GAS unsigned char* gb1 = outw ? Qg0 : Kg0 + 1024;   const unsigned gs1 = 8192u;
    const GAS unsigned char* gb2 = outw ? Qg0 + 1024 : Dg0;   const unsigned gs2 = outw ? 8192u : 512u;
    const GAS unsigned char* gb3 = outw ? Ig0 : Dg0 + 64;     const unsigned gs3 = outw ? 131072u : 512u;
    u32x4 pf[HG_PD][4];
#define HG_LD(k_, j_, cc_) do { pf[k_][j_] = *(const GAS u32x4*)(((j_) == 0 ? gb0 : (j_) == 1 ? gb1 : (j_) == 2 ? gb2 : gb3) + (size_t)(cc_) * ((j_) == 0 ? gs0 : (j_) == 1 ? gs1 : (j_) == 2 ? gs2 : gs3)); } while (0)
#define HG_C3(cc_) (outw ? ((cc_) + 1 < 128 ? (cc_) + 1 : 127) : (cc_))
#pragma unroll
    for (int k = 0; k < HG_PD; ++k) { HG_LD(k, 0, k); HG_LD(k, 1, k); HG_LD(k, 2, k); HG_LD(k, 3, HG_C3(k)); __builtin_amdgcn_sched_barrier(0); }
    const GAS unsigned char* pfp; unsigned pfstride;
    { const int tt = (wave * 64 + lane) < 80 ? wave * 64 + lane : 79; const int idx = sl * 5 + (tt >> 4), off = (tt & 15) * 64;
      pfp = (idx < 4 ? ws + WS_ATT + (size_t)(p * 128) * 4096 + idx * 1024 : idx < 12 ? ws + WS_QTG + (size_t)(p * 128) * 8192 + (idx - 4) * 1024 : ws + WS_KENDT + (size_t)(p * 128) * 8192 + (idx - 12) * 1024) + off;
      pfstride = idx < 4 ? 4096u : 8192u; }
    unsigned pfv[HG_PD];
#pragma unroll
    for (int k = 0; k < HG_PD; ++k) pfv[k] = 0u;
#define HG_STAGE(dst_, iv_) do { LAS unsigned char* d0_ = (dst_) + (ipart * 8) * IP + is * 2; \
        *(LAS bf16_t*)(d0_ + 0 * IP) = (bf16_t)((iv_).x & 0xffffu); *(LAS bf16_t*)(d0_ + 1 * IP) = (bf16_t)((iv_).x >> 16); \
        *(LAS bf16_t*)(d0_ + 2 * IP) = (bf16_t)((iv_).y & 0xffffu); *(LAS bf16_t*)(d0_ + 3 * IP) = (bf16_t)((iv_).y >> 16); \
        *(LAS bf16_t*)(d0_ + 4 * IP) = (bf16_t)((iv_).z & 0xffffu); *(LAS bf16_t*)(d0_ + 5 * IP) = (bf16_t)((iv_).z >> 16); \
        *(LAS bf16_t*)(d0_ + 6 * IP) = (bf16_t)((iv_).w & 0xffffu); *(LAS bf16_t*)(d0_ + 7 * IP) = (bf16_t)((iv_).w >> 16); } while (0)
#define HG_F(reg_, half_) ((half_) ? fp8_frag((reg_).z, (reg_).w) : fp8_frag((reg_).x, (reg_).y))
    if (outw) { const u32x4 iv = *(const GAS u32x4*)Ig0; HG_STAGE(IT, iv); }
#pragma unroll 1
    for (int c0 = 0; c0 < 128; c0 += HG_PD) {
#pragma unroll
      for (int k = 0; k < HG_PD; ++k) {
        const int c = c0 + k;
        const int tl0 = bl * SEQ + c * 64;
        const int cn = (c + HG_PD < 128) ? c + HG_PD : 127;
        LAS unsigned char* it_ = IT + (k & 1) * ITB; LAS unsigned char* itn = IT + ((k + 1) & 1) * ITB; LAS unsigned char* st_ = ST + (k & 1) * STB; LAS unsigned char* stn = ST + ((k + 1) & 1) * STB;
        LDS_BAR();
        if (wave < 2) { asm volatile("" :: "v"(pfv[k])); const int c7 = (c + HG_PD + 3 < 128) ? c + HG_PD + 3 : 127; pfv[k] = *(const GAS unsigned*)(pfp + (size_t)c7 * pfstride); }
        bf16x8 itf[2][2];
#pragma unroll
        for (int vt = 0; vt < 2; ++vt)
#pragma unroll
            for (int ks = 0; ks < 2; ++ks) itf[vt][ks] = lfrag(it_, IP, vt * 16 + fr, ks * 32, fq);
        bf16x8 sf[2][4];
        f32x4 acc[2];
        acc[0] = (f32x4){0.f, 0.f, 0.f, 0.f}; acc[1] = acc[0];
        if (outw) {
#pragma unroll
            for (int vt = 0; vt < 2; ++vt)
#pragma unroll
                for (int ks = 0; ks < 4; ++ks) sf[vt][ks] = lfrag(st_, PS_PITCH, vt * 16 + fr, ks * 32, fq);
#pragma unroll
            for (int ks = 0; ks < 2; ++ks) { const bf16x8 bA = HG_F(pf[k][0], ks);
#pragma unroll
                for (int vt = 0; vt < 2; ++vt) acc[vt] = MFMA16(itf[vt][ks], bA, acc[vt]); }
        } else {
            const f32x4 dec = __builtin_bit_cast(f32x4, pf[k][2]);
#pragma unroll
            for (int vt = 0; vt < 2; ++vt) st[0][vt] = st[0][vt] * dec;
#pragma unroll
            for (int ks = 0; ks < 2; ++ks) { const bf16x8 aK = HG_F(pf[k][0], ks);
#pragma unroll
                for (int vt = 0; vt < 2; ++vt) st[0][vt] = MFMA16(aK, itf[vt][ks], st[0][vt]); }
        }
        __builtin_amdgcn_sched_barrier(0);
        HG_LD(k, 0, cn);
        __builtin_amdgcn_sched_barrier(0);
        if (outw) {
#pragma unroll
            for (int ks = 0; ks < 2; ++ks) { const bf16x8 bQ = HG_F(pf[k][1], ks);
#pragma unroll
                for (int vt = 0; vt < 2; ++vt) acc[vt] = MFMA16(sf[vt][ks], bQ, acc[vt]); }
        } else {
            const f32x4 dec = __builtin_bit_cast(f32x4, pf[k][3]);
#pragma unroll
            for (int vt = 0; vt < 2; ++vt) st[1][vt] = st[1][vt] * dec;
#pragma unroll
            for (int ks = 0; ks < 2; ++ks) { const bf16x8 aK = HG_F(pf[k][1], ks);
#pragma unroll
                for (int vt = 0; vt < 2; ++vt) st[1][vt] = MFMA16(aK, itf[vt][ks], st[1][vt]); }
        }
        __builtin_amdgcn_sched_barrier(0);
        HG_LD(k, 1, cn);
        __builtin_amdgcn_sched_barrier(0);
        if (outw) {
#pragma unroll
            for (int ks = 2; ks < 4; ++ks) { const bf16x8 bQ = HG_F(pf[k][2], ks & 1);
#pragma unroll
                for (int vt = 0; vt < 2; ++vt) acc[vt] = MFMA16(sf[vt][ks], bQ, acc[vt]); }
        } else {
#pragma unroll
            for (int dtile = 0; dtile < 2; ++dtile)
#pragma unroll
                for (int vt = 0; vt < 2; ++vt) { const f32x4 sp = st[dtile][vt] * (1.0f / HS); u32x2 o; o.x = pk2(sp[0], sp[1]); o.y = pk2(sp[2], sp[3]);
                    *(LAS u32x2*)(stn + (vt * 16 + fr) * PS_PITCH + (w4 * 32 + dtile * 16 + 4 * fq) * 2) = o; }
        }
        __builtin_amdgcn_sched_barrier(0);
        HG_LD(k, 2, cn);
        __builtin_amdgcn_sched_barrier(0);
        if (outw) {
            HG_STAGE(itn, pf[k][3]);
            GAS bf16_t* og = (GAS bf16_t*)(ws + WS_GQ) + (size_t)(tl0 + w4 * 16 + fr) * 1024 + vcol + 4 * fq;
#pragma unroll
            for (int vt = 0; vt < 2; ++vt) { const f32x4 av = acc[vt] * (1.0f / HS); u32x2 o; o.x = pk2(av[0], av[1]); o.y = pk2(av[2], av[3]); *(GAS u32x2*)(og + vt * 16) = o; }
        }
        __builtin_amdgcn_sched_barrier(0);
        HG_LD(k, 3, HG_C3(cn));
        __builtin_amdgcn_sched_barrier(0);
      }
    }
#pragma unroll
    for (int k = 0; k < HG_PD; ++k) asm volatile("" :: "v"(pfv[k]));
    __syncthreads();
#undef HG_LD
#undef HG_C3
#undef HG_F
#undef HG_STAGE
}

__device__ __forceinline__ void xn8_convert(const DArgs& a, int round, int vcu, int G) {
    const int tid = tid_(), lane = tid & 63, wave = tid >> 6;
    const int gw = vcu * NWAVES + wave, NGW = G * NWAVES;
    GAS unsigned char* ws = a.ws;
    for (int tl = gw; tl < RT; tl += NGW) {
        const size_t tg = (size_t)round * RT + tl;
        const GAS u32x2* xr = (const GAS u32x2*)((const GAS bf16_t*)(ws + WS_XN) + tg * D) + lane;
        f32x4 v[4]; float mx = 0.f;
#pragma unroll
        for (int j = 0; j < 4; ++j) { const u32x2 xv = xr[64 * j]; v[j][0] = bf_lo(xv.x); v[j][1] = bf_hi(xv.x); v[j][2] = bf_lo(xv.y); v[j][3] = bf_hi(xv.y);
            mx = fmaxf(mx, fmaxf(fmaxf(fabsf(v[j][0]), fabsf(v[j][1])), fmaxf(fabsf(v[j][2]), fabsf(v[j][3])))); }
        mx = wave_max(mx);
        const float qs = mx > 0.f ? 127.0f / mx : 0.f;
#pragma unroll
        for (int j = 0; j < 4; ++j) ((GAS unsigned*)(ws + WS_XN8 + (size_t)tl * 1024))[64 * j + lane] = pack_i8x4(v[j][0] * qs, v[j][1] * qs, v[j][2] * qs, v[j][3] * qs);
        if (lane == 0) ((GAS float*)(ws + WS_SA8))[tg] = mx * (1.0f / 127.0f);
    }
}

__device__ __forceinline__ void phase_ypass(const DArgs& a, int round, int vcu, int G) {
    const int tid = tid_(), lane = tid & 63, wave = tid >> 6;
    const int gw = vcu * NWAVES + wave, NGW = G * NWAVES;
    GAS unsigned char* ws = a.ws;
    f32x4 mg0[4], mg1[4], gg4[4];
#pragma unroll
    for (int j = 0; j < 4; ++j) { mg0[j] = *(const GAS f32x4*)(a.m_head_g + j * 512 + lane * 8); mg1[j] = *(const GAS f32x4*)(a.m_head_g + j * 512 + lane * 8 + 4); gg4[j] = *(const GAS f32x4*)(a.g_head_g + lane * 16 + 4 * j); }
    for (int tl = gw; tl < RT; tl += NGW) {
        const size_t tg = (size_t)round * RT + tl;
        const f32x4 den4 = *(const f32x4*)((const float*)(ws + WS_DEN) + tg * 4), mt4 = *(const f32x4*)((const float*)(ws + WS_MT) + tg * 4);
        float ym[4][8];
#pragma unroll
        for (int j = 0; j < 4; ++j) {
            const int col = j * 512 + lane * 8;
            const u32x4 nv = *(const u32x4*)((const bf16_t*)(ws + WS_QKPRE) + (size_t)tl * 2048 + col);
            const u32x4 ov = *(const u32x4*)((const bf16_t*)(ws + WS_SIGO) + (size_t)tl * 2048 + col);
            const float inv = 1.0f / fmaxf(fabsf(den4[j]), __expf(-mt4[j]));
            float hv[8] = {bf_lo(nv.x) * inv, bf_hi(nv.x) * inv, bf_lo(nv.y) * inv, bf_hi(nv.y) * inv, bf_lo(nv.z) * inv, bf_hi(nv.z) * inv, bf_lo(nv.w) * inv, bf_hi(nv.w) * inv};
            float ss = 0.f;
#pragma unroll
            for (int e = 0; e < 8; ++e) ss += hv[e] * hv[e];
            const float r = rsqrtf(wave_sum(ss, lane) * (1.f / 512.f) + EPS);
            const f32x4 g0 = mg0[j], g1 = mg1[j];
            const float og[8] = {bf_lo(ov.x), bf_hi(ov.x), bf_lo(ov.y), bf_hi(ov.y), bf_lo(ov.z), bf_hi(ov.z), bf_lo(ov.w), bf_hi(ov.w)};
#pragma unroll
            for (int e = 0; e < 8; ++e) ym[j][e] = og[e] * hv[e] * r * (e < 4 ? g0[e] : g1[e - 4]);
        }
        {
            float mx = 0.f;
#pragma unroll
            for (int j = 0; j < 4; ++j)
#pragma unroll
                for (int e = 0; e < 8; ++e) mx = fmaxf(mx, fabsf(ym[j][e]));
            mx = wave_max(mx);
            const float qs = mx > 0.f ? 127.0f / mx : 0.f;
#pragma unroll
            for (int j = 0; j < 4; ++j) { u32x2 o; o.x = pack_i8x4(ym[j][0] * qs, ym[j][1] * qs, ym[j][2] * qs, ym[j][3] * qs); o.y = pack_i8x4(ym[j][4] * qs, ym[j][5] * qs, ym[j][6] * qs, ym[j][7] * qs);
                *(GAS u32x2*)(ws + WS_V + (size_t)tl * 2048 + j * 512 + lane * 8) = o; }
            if (lane == 0) ((GAS float*)(ws + WS_SYM))[tl] = mx * (1.0f / 127.0f);
        }
        {
            const int col = lane * 16;
            const u32x4 n0 = *(const u32x4*)((const bf16_t*)(ws + WS_GQ) + (size_t)tl * 1024 + col), n1 = *(const u32x4*)((const bf16_t*)(ws + WS_GQ) + (size_t)tl * 1024 + col + 8);
            const u32x4 s0 = *(const u32x4*)((const bf16_t*)(ws + WS_SGG) + (size_t)tl * 1024 + col), s1 = *(const u32x4*)((const bf16_t*)(ws + WS_SGG) + (size_t)tl * 1024 + col + 8);
            float ov[16] = {bf_lo(n0.x), bf_hi(n0.x), bf_lo(n0.y), bf_hi(n0.y), bf_lo(n0.z), bf_hi(n0.z), bf_lo(n0.w), bf_hi(n0.w), bf_lo(n1.x), bf_hi(n1.x), bf_lo(n1.y), bf_hi(n1.y), bf_lo(n1.z), bf_hi(n1.z), bf_lo(n1.w), bf_hi(n1.w)};
            const float sg[16] = {bf_lo(s0.x), bf_hi(s0.x), bf_lo(s0.y), bf_hi(s0.y), bf_lo(s0.z), bf_hi(s0.z), bf_lo(s0.w), bf_hi(s0.w), bf_lo(s1.x), bf_hi(s1.x), bf_lo(s1.y), bf_hi(s1.y), bf_lo(s1.z), bf_hi(s1.z), bf_lo(s1.w), bf_hi(s1.w)};
            float ss = 0.f;
#pragma unroll
            for (int e = 0; e < 16; ++e) ss += ov[e] * ov[e];
            ss += DPP_(ss, 0xB1); ss += DPP_(ss, 0x4E); ss += DPP_(ss, 0x141);
            const float r = rsqrtf(ss * (1.f / 128.f) + EPS);
            float y[16];
#pragma unroll
            for (int e = 0; e < 16; ++e) y[e] = ov[e] * r * gg4[e >> 2][e & 3] * sg[e];
            float mx = 0.f;
#pragma unroll
            for (int e = 0; e < 16; ++e) mx = fmaxf(mx, fabsf(y[e]));
            mx = wave_max(mx);
            const float qs = mx > 0.f ? 127.0f / mx : 0.f;
            u32x4 o; o.x = pack_i8x4(y[0] * qs, y[1] * qs, y[2] * qs, y[3] * qs); o.y = pack_i8x4(y[4] * qs, y[5] * qs, y[6] * qs, y[7] * qs);
            o.z = pack_i8x4(y[8] * qs, y[9] * qs, y[10] * qs, y[11] * qs); o.w = pack_i8x4(y[12] * qs, y[13] * qs, y[14] * qs, y[15] * qs);
            *(GAS u32x4*)(ws + WS_GI + (size_t)tl * 1024 + col) = o;
            if (lane == 0) ((GAS float*)(ws + WS_SYG))[tl] = mx * (1.0f / 127.0f);
        }
    }
}


#define XB_TMO      128
#define XB_XCNT(j)  (256  + 64 * (j))
#define XB_XSUB(j)  (1280 + 64 * (j))
#define XB_XGEN(j)  (2304 + 64 * (j))
#define XB_TOP      3328
#define XB_TOPGEN   3392
#define XB_SPIN_CAP (1u << 22)
constexpr int CW_BAR = 4096;
constexpr int LDS_BARST = LDS_BYTES - 64;
__device__ __forceinline__ unsigned xb_ld(unsigned* p)              { return __hip_atomic_load(p, __ATOMIC_RELAXED, __HIP_MEMORY_SCOPE_AGENT); }
__device__ __forceinline__ unsigned xb_add(unsigned* p, unsigned v) { return __hip_atomic_fetch_add(p, v, __ATOMIC_RELAXED, __HIP_MEMORY_SCOPE_AGENT); }
__device__ __forceinline__ unsigned xb_xcc_id() { return (unsigned)__builtin_amdgcn_s_getreg((3 << 11) | 20) & 0xFu; }
#define XB_SPIN(cond, bar) do { unsigned _sp = 0; while (cond) { __builtin_amdgcn_s_sleep(1); \
    if ((++_sp & 255u) == 0u) { if (xb_ld(&(bar)[XB_TMO])) break; if (_sp > XB_SPIN_CAP) { atomicAdd(&(bar)[XB_TMO], 1u); break; } } } } while (0)
__device__ __forceinline__ void xcd_barrier_post(unsigned* bar, volatile LAS unsigned* st) { if (tid_() == 0) st[2] = xb_add(&bar[XB_XCNT(xb_xcc_id())], 1u); }
__device__ __forceinline__ void xcd_barrier_complete(unsigned* bar, unsigned x, unsigned& nloc, unsigned& nx) {
    const unsigned G = gridDim.x;
    unsigned sum, cnt, mine, sp = 0u;
    for (;;) {
        sum = 0u; cnt = 0u; mine = 0u;
#pragma unroll
        for (unsigned j = 0; j < 16; ++j) { const unsigned c = xb_ld(&bar[XB_XCNT(j)]); sum += c; cnt += (c > 0u) ? 1u : 0u; mine = (j == x) ? c : mine; }
        if (sum == G) break;
        __builtin_amdgcn_s_sleep(1);
        if ((++sp & 255u) == 0u) { if (xb_ld(&bar[XB_TMO])) break; if (sp > XB_SPIN_CAP) { atomicAdd(&bar[XB_TMO], 1u); break; } }
    }
    nloc = mine > 0u ? mine : 1u; nx = cnt > 0u ? cnt : 1u;
}
__device__ __forceinline__ void xcd_barrier(unsigned* bar, volatile LAS unsigned* st) {
    asm volatile("s_waitcnt vmcnt(0)" ::: "memory");
    __syncthreads();
    if (tid_() == 0) {
        const unsigned x = xb_xcc_id();
        __builtin_amdgcn_s_waitcnt(0);
        unsigned nloc = st[0], nx = st[1];
        if (nloc == 0u) { xcd_barrier_complete(bar, x, nloc, nx); st[0] = nloc; st[1] = nx; }
        const unsigned old = xb_add(&bar[XB_XSUB(x)], 1u);
        const unsigned gen = old / nloc;
        if (old + 1u == (gen + 1u) * nloc) {
            __builtin_amdgcn_fence(__ATOMIC_RELEASE, "agent");
            asm volatile("s_waitcnt vmcnt(0)" ::: "memory");
            const unsigned og = xb_add(&bar[XB_TOP], 1u);
            const unsigned tg = og / nx;
            if (og + 1u == (tg + 1u) * nx) xb_add(&bar[XB_TOPGEN], 1u);
            else XB_SPIN(xb_ld(&bar[XB_TOPGEN]) == tg, bar);
            __builtin_amdgcn_fence(__ATOMIC_ACQUIRE, "agent");
            xb_add(&bar[XB_XGEN(x)], 1u);
            asm volatile("s_waitcnt vmcnt(0)" ::: "memory");
        } else {
            XB_SPIN(xb_ld(&bar[XB_XGEN(x)]) == gen, bar);
            __builtin_amdgcn_fence(__ATOMIC_ACQUIRE, "agent");
            asm volatile("s_waitcnt vmcnt(0)" ::: "memory");
        }
    }
    __syncthreads();
}

__device__ __forceinline__ void phase_p8(const DArgs& a, int vcu, int G) {
    const int tid = tid_(), lane = tid & 63, wave = tid >> 6;
    const int gw = vcu * NWAVES + wave, NGW = G * NWAVES;
    GAS unsigned char* ws = a.ws;
    f32x4 g2[4];
#pragma unroll
    for (int j = 0; j < 4; ++j) g2[j] = ((const f32x4*)a.norm2_g)[64 * j + lane];
    for (int m = gw; m < T; m += NGW) {
        const GAS u32x2* xr = (const GAS u32x2*)((const GAS bf16_t*)a.out + (size_t)m * D) + lane;
        f32x4 v[4]; float s = 0.f;
#pragma unroll
        for (int j = 0; j < 4; ++j) { const u32x2 xv = xr[64 * j]; v[j][0] = bf_lo(xv.x); v[j][1] = bf_hi(xv.x); v[j][2] = bf_lo(xv.y); v[j][3] = bf_hi(xv.y); s += (v[j][0] * v[j][0] + v[j][1] * v[j][1]) + (v[j][2] * v[j][2] + v[j][3] * v[j][3]); }
        const float rstd = rsqrtf(wave_sum(s, lane) * (1.f / D) + EPS);
#pragma unroll
        for (int j = 0; j < 4; ++j) v[j] = v[j] * rstd * g2[j];
        float mx = 0.f;
#pragma unroll
        for (int j = 0; j < 4; ++j) mx = fmaxf(mx, fmaxf(fmaxf(fabsf(v[j][0]), fabsf(v[j][1])), fmaxf(fabsf(v[j][2]), fabsf(v[j][3]))));
        mx = wave_max(mx);
        const float qs = mx > 0.f ? 127.0f / mx : 0.f;
#pragma unroll
        for (int j = 0; j < 4; ++j) ((GAS unsigned*)(ws + WS_XQ + (size_t)m * 1024))[64 * j + lane] = pack_i8x4(v[j][0] * qs, v[j][1] * qs, v[j][2] * qs, v[j][3] * qs);
        if (lane == 0) ((GAS float*)(ws + WS_XQS))[m] = mx * (1.0f / 127.0f);
    }
    for (int e = gw; e < 16384; e += NGW) {
        f32x4 uv[4], vv[4]; float mu = 0.f, mv = 0.f;
#pragma unroll
        for (int j = 0; j < 4; ++j) { uv[j] = ((const GAS f32x4*)(a.u_emb + (size_t)e * 1024))[64 * j + lane]; vv[j] = ((const GAS f32x4*)(a.v_emb + (size_t)e * 1024))[64 * j + lane];
            mu = fmaxf(mu, fmaxf(fmaxf(fabsf(uv[j][0]), fabsf(uv[j][1])), fmaxf(fabsf(uv[j][2]), fabsf(uv[j][3]))));
            mv = fmaxf(mv, fmaxf(fmaxf(fabsf(vv[j][0]), fabsf(vv[j][1])), fmaxf(fabsf(vv[j][2]), fabsf(vv[j][3])))); }
        mu = wave_max(mu); mv = wave_max(mv);
        const float su = mu > 0.f ? 127.0f / mu : 0.f, sv = mv > 0.f ? 448.0f / mv : 0.f;
        if (lane == 0) { ((GAS float*)(ws + WS_USC))[e] = mu * (1.0f / 127.0f); ((GAS float*)(ws + WS_VSC))[e] = mv * (1.0f / 448.0f); }
#pragma unroll
        for (int j = 0; j < 4; ++j) {
            const size_t ob = (size_t)(2 * j + (lane >> 5)) * 2097152 + (size_t)e * 128 + ((4 * lane) & 127);
            *(GAS unsigned*)(ws + WS_UB + ob) = pack_i8x4(uv[j][0] * su, uv[j][1] * su, uv[j][2] * su, uv[j][3] * su);
            int p = __builtin_amdgcn_cvt_pk_fp8_f32(vv[j][0] * sv, vv[j][1] * sv, 0, false); p = __builtin_amdgcn_cvt_pk_fp8_f32(vv[j][2] * sv, vv[j][3] * sv, p, true);
            *(GAS unsigned*)(ws + WS_VB + ob) = (unsigned)p; }
    }
}

__device__ __forceinline__ unsigned f2ord(float f) { const unsigned u = __builtin_bit_cast(unsigned, f); return (u & 0x80000000u) ? ~u : (u | 0x80000000u); }
__device__ __forceinline__ float ord2f(unsigned k) { const unsigned u = (k & 0x80000000u) ? (k & 0x7fffffffu) : ~k; return __builtin_bit_cast(float, u); }
__device__ __forceinline__ unsigned umax_(unsigned a, unsigned b) { return a > b ? a : b; }
__device__ __forceinline__ unsigned shxu(unsigned v, int o, int lane) { return (unsigned)__builtin_amdgcn_ds_bpermute((lane ^ o) << 2, (int)v); }

__device__ __forceinline__ unsigned umin_(unsigned a, unsigned b) { return a < b ? a : b; }
#define TK_CE(a_, b_) do { const unsigned hi_ = umax_((a_), (b_)), lo_ = umin_((a_), (b_)); (a_) = hi_; (b_) = lo_; } while (0)
__device__ __forceinline__ void tk_sort16(unsigned (&x)[32], int o) {
#pragma unroll
    for (int k = 2; k <= 16; k <<= 1)
#pragma unroll
        for (int j = k >> 1; j > 0; j >>= 1)
#pragma unroll
            for (int i = 0; i < 16; ++i) { const int l = i ^ j; if (l > i) { if ((i & k) == 0) TK_CE(x[o + i], x[o + l]); else TK_CE(x[o + l], x[o + i]); } }
}
__device__ __forceinline__ void tk_merge16(unsigned (&t)[16]) {
#pragma unroll
    for (int j = 8; j > 0; j >>= 1)
#pragma unroll
        for (int i = 0; i < 16; ++i) { const int l = i ^ j; if (l > i) TK_CE(t[i], t[l]); }
}
__device__ __forceinline__ void phase_topk(const DArgs& a, LAS unsigned char* lds, int bx, int G) {
    const int tid = tid_(), lane = tid & 63, wave = __builtin_amdgcn_readfirstlane(tid >> 6), fr = lane & 15, fq = lane >> 4;
    GAS unsigned char* ws = a.ws;
    const int h = bx & 7;
    LAS unsigned char* KY = lds;
    LAS unsigned char* QL = lds + 2 * 128 * PS_PITCH;
    LAS unsigned* TOP = (LAS unsigned*)(lds + 2 * 128 * PS_PITCH + 64 * PQ_PITCH);
#pragma unroll
    for (int i = 0; i < 8; ++i) { const int idx = tid + 512 * i, row = idx >> 4, ch = idx & 15;
        *(LAS u32x4*)(KY + row * PS_PITCH + ch * 16) = *(const u32x4*)((const bf16_t*)(ws + WS_SK) + ((size_t)h * 256 + row) * 128 + ch * 8); }
    const int ntile = T / 64;
    u32x4 qpre[4];
    { const int tile0 = bx >> 3; if (tile0 < ntile) {
#pragma unroll
        for (int i = 0; i < 4; ++i) { const int idx = tid + 512 * i, row = idx >> 5, ch = idx & 31;
            qpre[i] = *(const GAS u32x4*)((const GAS bf16_t*)(ws + WS_QP) + ((size_t)tile0 * 64 + row) * 2048 + h * 256 + ch * 8); } } }
    __syncthreads();
    for (int tile = bx >> 3; tile < ntile; tile += (G >> 3)) {
        const size_t t0 = (size_t)tile * 64;
        LDS_BAR();
#pragma unroll
        for (int i = 0; i < 4; ++i) { const int idx = tid + 512 * i, row = idx >> 5, ch = idx & 31;
            *(LAS u32x4*)(QL + row * PQ_PITCH + ch * 16) = qpre[i]; }
        { const int tn = tile + (G >> 3); if (tn < ntile) {
#pragma unroll
            for (int i = 0; i < 4; ++i) { const int idx = tid + 512 * i, row = idx >> 5, ch = idx & 31;
                qpre[i] = *(const GAS u32x4*)((const GAS bf16_t*)(ws + WS_QP) + ((size_t)tn * 64 + row) * 2048 + h * 256 + ch * 8); } } }
        LDS_BAR();
        {
            const int mt = wave & 3, p = wave >> 2;
            unsigned key[32];
#pragma unroll
            for (int nt = 0; nt < 8; ++nt) { f32x4 acc = (f32x4){0.f, 0.f, 0.f, 0.f};
#pragma unroll
                for (int ks = 0; ks < 4; ++ks) acc = MFMA16(lfrag(KY + p * 128 * PS_PITCH, PS_PITCH, nt * 16 + fr, ks * 32, fq), lfrag(QL, PQ_PITCH, mt * 16 + fr, p * 128 + ks * 32, fq), acc);
#pragma unroll
                for (int j = 0; j < 4; ++j) { const int n = nt * 16 + 4 * fq + j; key[nt * 4 + j] = (f2ord(acc[j]) & ~127u) | (unsigned)(127 - n); } }
            tk_sort16(key, 0); tk_sort16(key, 16);
            unsigned t[16];
#pragma unroll
            for (int i = 0; i < 16; ++i) t[i] = umax_(key[i], key[31 - i]);
            tk_merge16(t);
            {   unsigned pv[16];
#pragma unroll
                for (int i = 0; i < 16; ++i) pv[i] = (unsigned)SWZI_(t[15 - i], 0x401F);
#pragma unroll
                for (int i = 0; i < 16; ++i) t[i] = umax_(t[i], pv[i]);
                tk_merge16(t);
#pragma unroll
                for (int i = 0; i < 16; ++i) pv[i] = xor32u_(t[15 - i], lane >= 32);
#pragma unroll
                for (int i = 0; i < 16; ++i) t[i] = umax_(t[i], pv[i]);
                tk_merge16(t); }
#pragma unroll
            for (int k = 0; k < 16; ++k) { if (fq == (k & 3)) TOP[(p * 64 + mt * 16 + fr) * 16 + k] = t[k]; }
        }
        LDS_BAR();
        {
            const int t = tid >> 3, sub = tid & 7;
            unsigned ck[7];
#pragma unroll
            for (int e = 0; e < 7; ++e) {
                const int ci = sub + 8 * e;
                int i = 0, base = 0; bool ok = ci < 50;
                if (ci >= 42) { i = 8 + (ci - 42); base = ci; } else if (ci >= 40) { i = 7; base = 40; } else if (ci >= 38) { i = 6; base = 38; } else if (ci >= 36) { i = 5; base = 36; }
                else if (ci >= 33) { i = 4; base = 33; } else if (ci >= 29) { i = 3; base = 29; } else if (ci >= 24) { i = 2; base = 24; } else if (ci >= 16) { i = 1; base = 16; }
                const int j = ci - base;
                unsigned kk = 0u;
                if (ok) { const float s0 = ord2f(TOP[(0 * 64 + t) * 16 + i] & ~127u), s1 = ord2f(TOP[(1 * 64 + t) * 16 + j] & ~127u);
                    kk = (f2ord(s0 + s1) & ~255u) | (unsigned)(255 - (i * 16 + j)); }
                ck[e] = kk;
            }
            unsigned x[16];
#pragma unroll
            for (int e = 0; e < 7; ++e) x[e] = ck[e];
            x[7] = 0u;
#pragma unroll
            for (int k = 2; k <= 8; k <<= 1)
#pragma unroll
                for (int j = k >> 1; j > 0; j >>= 1)
#pragma unroll
                    for (int i = 0; i < 8; ++i) { const int l = i ^ j; if (l > i) { if ((i & k) == 0) TK_CE(x[i], x[l]); else TK_CE(x[l], x[i]); } }
#pragma unroll
            for (int i = 0; i < 8; ++i) x[8 + i] = (unsigned)DPPI_(x[7 - i], 0xB1);
            tk_merge16(x);
            {   unsigned pv[16];
#pragma unroll
                for (int i = 0; i < 16; ++i) pv[i] = (unsigned)DPPI_(x[15 - i], 0x4E);
#pragma unroll
                for (int i = 0; i < 16; ++i) x[i] = umax_(x[i], pv[i]);
                tk_merge16(x);
#pragma unroll
                for (int i = 0; i < 16; ++i) pv[i] = (unsigned)DPPI_(x[15 - i], 0x141);
#pragma unroll
                for (int i = 0; i < 16; ++i) x[i] = umax_(x[i], pv[i]);
                tk_merge16(x); }
            unsigned w0 = x[0], w1 = x[8];
#pragma unroll
            for (int e = 1; e < 8; ++e) { w0 = (sub == e) ? x[e] : w0; w1 = (sub == e) ? x[8 + e] : w1; }
            const int f0 = 255 - (int)(w0 & 255u), f1 = 255 - (int)(w1 & 255u);
            const float sc0 = ord2f(w0 & ~255u), sc1 = ord2f(w1 & ~255u);
            float mx = fmaxf(sc0, sc1); mx = fmaxf(mx, DPP_(mx, 0xB1)); mx = fmaxf(mx, DPP_(mx, 0x4E)); mx = fmaxf(mx, DPP_(mx, 0x141));
            const float e0 = __expf(sc0 - mx), e1 = __expf(sc1 - mx);
            float sm = e0 + e1; sm += DPP_(sm, 0xB1); sm += DPP_(sm, 0x4E); sm += DPP_(sm, 0x141);
            const float inv = 1.0f / sm;
            const int i0 = 127 - (int)(TOP[(0 * 64 + t) * 16 + (f0 >> 4)] & 127u), j0 = 127 - (int)(TOP[(1 * 64 + t) * 16 + (f0 & 15)] & 127u);
            const int i1 = 127 - (int)(TOP[(0 * 64 + t) * 16 + (f1 >> 4)] & 127u), j1 = 127 - (int)(TOP[(1 * 64 + t) * 16 + (f1 & 15)] & 127u);
            unsigned short* ei = (unsigned short*)(ws + WS_EIDX) + ((t0 + t) * 8 + h) * 16; float* gp = (float*)(ws + WS_GATE) + ((t0 + t) * 8 + h) * 16;
            ei[sub] = (unsigned short)(i0 * 128 + j0); ei[sub + 8] = (unsigned short)(i1 * 128 + j1); gp[sub] = e0 * inv; gp[sub + 8] = e1 * inv;
        }
    }
    __syncthreads();
}

__device__ __forceinline__ void ins16(float (&v)[16], int (&id)[16], float x, int n) {
    if (x > v[15]) { v[15] = x; id[15] = n;
#pragma unroll
        for (int i = 15; i >= 1; --i) { if (v[i] > v[i - 1]) { const float tv = v[i]; v[i] = v[i - 1]; v[i - 1] = tv; const int ti = id[i]; id[i] = id[i - 1]; id[i - 1] = ti; } } }
}
__device__ __forceinline__ void phase_topk_ref(const DArgs& a, int vcu, int G) {
    const int tid = tid_();
    GAS unsigned char* ws = a.ws;
    const int gt = vcu * NTHR + tid, NGT = G * NTHR;
    for (int pair = gt; pair < T * 8; pair += NGT) {
        const int t = pair >> 3, h = pair & 7;
        float sv[2][16]; int si[2][16];
#pragma unroll
        for (int p = 0; p < 2; ++p) {
#pragma unroll
            for (int i = 0; i < 16; ++i) { sv[p][i] = -INFINITY; si[p][i] = 0; }
            const bf16_t* qp = (const bf16_t*)(ws + WS_QP) + (size_t)t * 2048 + h * 256 + p * 128;
            for (int n = 0; n < 128; ++n) {
                const bf16_t* kp = (const bf16_t*)(ws + WS_SK) + ((size_t)(h * 2 + p) * 128 + n) * 128;
                float s = 0.f;
                for (int c = 0; c < 128; c += 8) { const u32x4 qv = *(const u32x4*)(qp + c), kv = *(const u32x4*)(kp + c);
                    s += bf_lo(qv.x) * bf_lo(kv.x) + bf_hi(qv.x) * bf_hi(kv.x) + bf_lo(qv.y) * bf_lo(kv.y) + bf_hi(qv.y) * bf_hi(kv.y)
                       + bf_lo(qv.z) * bf_lo(kv.z) + bf_hi(qv.z) * bf_hi(kv.z) + bf_lo(qv.w) * bf_lo(kv.w) + bf_hi(qv.w) * bf_hi(kv.w); }
                ins16(sv[p], si[p], s, n);
            }
        }
        float tv[16]; int ti[16];
#pragma unroll
        for (int i = 0; i < 16; ++i) { tv[i] = -INFINITY; ti[i] = 0; }
#pragma unroll
        for (int i = 0; i < 16; ++i)
#pragma unroll
            for (int j = 0; j < 16; ++j) ins16(tv, ti, sv[0][i] + sv[1][j], i * 16 + j);
        float sm = 0.f, ex[16];
#pragma unroll
        for (int k = 0; k < 16; ++k) { ex[k] = __expf(tv[k] - tv[0]); sm += ex[k]; }
        int* ei = (int*)(ws + WS_EIDX) + (size_t)pair * 16; float* gp = (float*)(ws + WS_GATE) + (size_t)pair * 16;
#pragma unroll
        for (int k = 0; k < 16; ++k) {
            int e0 = 0, e1 = 0;
#pragma unroll
            for (int i = 0; i < 16; ++i) { e0 = ((ti[k] >> 4) == i) ? si[0][i] : e0; e1 = ((ti[k] & 15) == i) ? si[1][i] : e1; }
            ei[k] = e0 * 128 + e1; gp[k] = ex[k] / sm; }
    }
}

#define FP8LO(w) __builtin_amdgcn_cvt_pk_f32_fp8((int)(w), false)
#define FP8HI(w) __builtin_amdgcn_cvt_pk_f32_fp8((int)(w), true)
__device__ __forceinline__ float dot16_fp8(const u32x4 r, const float (&x)[16]) {
    float c = 0.f;
#pragma unroll
    for (int j = 0; j < 4; ++j) { const f32x2 lo = FP8LO(r[j]), hi = FP8HI(r[j]); c += lo[0] * x[4 * j] + lo[1] * x[4 * j + 1] + hi[0] * x[4 * j + 2] + hi[1] * x[4 * j + 3]; }
    return c;
}
__device__ __forceinline__ float dot16_fp8p(const u32x4 r, const f32x2 (&xp)[8]) {
    f32x2 c2 = (f32x2){0.f, 0.f};
#pragma unroll
    for (int j = 0; j < 4; ++j) { c2 += FP8LO(r[j]) * xp[2 * j]; c2 += FP8HI(r[j]) * xp[2 * j + 1]; }
    return c2[0] + c2[1];
}
__device__ __forceinline__ float gelu_erf(float d) {
    const float ad = fabsf(d), t = __builtin_amdgcn_rcpf(ad * 0.2316418882f + 1.0f);
    float q = t * 0.5307027145f + (-0.7265760135f); q = q * t + 0.7107068705f; q = q * t + (-0.142248368f); q = q * t + 0.127414796f; q = q * t;
    const float m = d * (q * __builtin_amdgcn_exp2f(d * d * (-0.72134752044f)));
    return d < 0.f ? m : d - m;
}
__device__ __forceinline__ float bperm(float v, int srclane) { return __builtin_bit_cast(float, __builtin_amdgcn_ds_bpermute(srclane << 2, __builtin_bit_cast(int, v))); }
#define SWZ_(v, pat) __builtin_bit_cast(float, __builtin_amdgcn_ds_swizzle(__builtin_bit_cast(int, (v)), (pat)))
__device__ __forceinline__ float rs32_(float a, float b) {
#if defined(__HIP_DEVICE_COMPILE__)
    asm volatile("s_nop 1\n\tv_permlane32_swap_b32 %0, %1" : "+v"(a), "+v"(b));
#endif
    return a + b;
}
__device__ __forceinline__ float rs16_(float a, float b) {
#if defined(__HIP_DEVICE_COMPILE__)
    asm volatile("s_nop 1\n\tv_permlane16_swap_b32 %0, %1" : "+v"(a), "+v"(b));
#endif
    return a + b;
}
__device__ __forceinline__ float rs8_(float a, float b, bool bit3) {
    const float send = bit3 ? a : b, keep = bit3 ? b : a;
    return keep + DPP_(send, 0x128);
}
__device__ __forceinline__ float xor32_(float v, bool hi) {
#if defined(__HIP_DEVICE_COMPILE__)
    const auto r = __builtin_amdgcn_permlane32_swap(__builtin_bit_cast(unsigned, v), __builtin_bit_cast(unsigned, v), false, false);
    return __builtin_bit_cast(float, hi ? r[0] : r[1]);
#else
    (void)hi; return v;
#endif
}
__device__ __forceinline__ float reduce8(const float (&p)[8], int lane) {
    float q4[4], q2[2];
    const bool b5 = lane & 32, b4 = lane & 16, b3 = lane & 8;
#pragma unroll
    for (int i = 0; i < 4; ++i) { const float send = b5 ? p[i] : p[i + 4], keep = b5 ? p[i + 4] : p[i]; q4[i] = keep + xor32_(send, b5); }
#pragma unroll
    for (int i = 0; i < 2; ++i) { const float send = b4 ? q4[i] : q4[i + 2], keep = b4 ? q4[i + 2] : q4[i]; q2[i] = keep + SWZ_(send, 0x401F); }
    const float send = b3 ? q2[0] : q2[1], keep = b3 ? q2[1] : q2[0];
    float q1 = keep + SWZ_(send, 0x201F);
    q1 += DPP_(q1, 0xB1); q1 += DPP_(q1, 0x4E); q1 += DPP_(q1, 0x141);
    return q1;
}
__device__ __forceinline__ void phase_udots(const DArgs& a, LAS unsigned char* lds) {
    const int tid = tid_(), lane = tid & 63, wave = __builtin_amdgcn_readfirstlane(tid >> 6);
    GAS unsigned char* ws = a.ws;
    volatile LAS unsigned* bst = (volatile LAS unsigned*)(lds + LDS_BARST);
    const int nloc = (int)bst[0], nx = (int)bst[1], rank = (int)bst[2];
    unsigned* bar = (unsigned*)(ws + WS_CTL) + CW_BAR;
    const unsigned myx = xb_xcc_id();
    int q = 0;
    for (unsigned j = 0; j < 16; ++j) { const unsigned c = xb_ld(&bar[XB_XCNT(j)]); if (c > 0u && j < myx) ++q; }
    LAS int* LE = (LAS int*)(lds + wave * 2048);
    LAS int* LP = LE + 128; LAS float* LG = (LAS float*)(LE + 256);
    const GAS unsigned char* UB = ws + WS_UB;
    const int g8 = lane >> 3;
    const float usc = ((const GAS float*)(ws + WS_USC))[0], vsc = ((const GAS float*)(ws + WS_USC))[1];
    for (int s = q; s < 8; s += nx) {
        int tok = rank * 8 + wave;
        u32x4 xq0 = (u32x4){0u, 0u, 0u, 0u}, xq1 = xq0; u32x2 e2 = (u32x2){0u, 0u}; f32x2 g2 = (f32x2){0.f, 0.f};
#define U_INFO(t_) do { xq0 = *(const u32x4*)((const GAS bf16_t*)(ws + WS_XN) + (size_t)(t_) * D + lane * 16); xq1 = *(const u32x4*)((const GAS bf16_t*)(ws + WS_XN) + (size_t)(t_) * D + lane * 16 + 8); \
        e2 = *(const u32x2*)((const GAS int*)(ws + WS_EIDX) + (size_t)(t_) * 128 + 2 * lane); g2 = *(const f32x2*)((const GAS float*)(ws + WS_GATE) + (size_t)(t_) * 128 + 2 * lane); } while (0)
        if (tok < T) U_INFO(tok);
        for (; tok < T; tok += nloc * 8) {
            const bool in0 = (int)(e2.x >> 11) == s, in1 = (int)(e2.y >> 11) == s;
            const unsigned long long m0 = __ballot(in0), m1 = __ballot(in1);
            const unsigned long long lt = (1ull << lane) - 1ull;
            const int n0 = __popcll(m0), n = n0 + __popcll(m1);
            if (in0) { const int pos = __popcll(m0 & lt); LE[pos] = (int)e2.x; LP[pos] = 2 * lane; LG[pos] = g2[0]; }
            if (in1) { const int pos = n0 + __popcll(m1 & lt); LE[pos] = (int)e2.y; LP[pos] = 2 * lane + 1; LG[pos] = g2[1]; }
            const float xf[16] = {bf_lo(xq0.x), bf_hi(xq0.x), bf_lo(xq0.y), bf_hi(xq0.y), bf_lo(xq0.z), bf_hi(xq0.z), bf_lo(xq0.w), bf_hi(xq0.w),
                                  bf_lo(xq1.x), bf_hi(xq1.x), bf_lo(xq1.y), bf_hi(xq1.y), bf_lo(xq1.z), bf_hi(xq1.z), bf_lo(xq1.w), bf_hi(xq1.w)};
            asm volatile("s_waitcnt lgkmcnt(0)" ::: "memory");
            u32x4 R0[8], R1[8], R2[8];
#define U_ISSUE(R_, g0_) do { _Pragma("unroll") for (int k = 0; k < 8; ++k) { const int slot_ = ((g0_) + k < n) ? (g0_) + k : n - 1; const int e_ = LE[slot_]; R_[k] = *(const u32x4*)(UB + (size_t)e_ * 1024 + lane * 16); } } while (0)
#define U_DOTS(R_, g0_) do { float pp_[8]; _Pragma("unroll") for (int k = 0; k < 8; ++k) pp_[k] = dot16_fp8(R_[k], xf); const float dsum_ = reduce8(pp_, lane); const int slot_ = (g0_) + g8; \
            if (slot_ < n && (lane & 7) == 0) { const float d_ = dsum_ * usc; \
                ((GAS float*)(ws + WS_PW))[(size_t)tok * 128 + LP[slot_]] = 0.5f * d_ * (1.0f + erff(d_ * 0.70710678118654752f)) * LG[slot_] * vsc; } } while (0)
            if (n > 0) U_ISSUE(R0, 0);
            if (n > 8) U_ISSUE(R1, 8);
            if (n > 16) U_ISSUE(R2, 16);
            const int tokN = tok + nloc * 8;
            if (tokN < T) U_INFO(tokN);
            if (n > 0) U_DOTS(R0, 0);
            if (n > 8) U_DOTS(R1, 8);
            if (n > 16) U_DOTS(R2, 16);
            for (int g0 = 24; g0 < n; g0 += 8) { U_ISSUE(R0, g0); U_DOTS(R0, g0); }
            asm volatile("s_waitcnt lgkmcnt(0)" ::: "memory");
        }
#undef U_INFO
#undef U_ISSUE
#undef U_DOTS
    }
}

#define EV_OFF(ev_, g_) (((g_) & 1) ? ((ev_[(g_) >> 3][((g_) >> 1) & 3] >> 9) & 0x7fff80u) : ((ev_[(g_) >> 3][((g_) >> 1) & 3] << 7) & 0x7fff80u))
struct XcdSlice { int nloc, nx, rank, q; };
__device__ __forceinline__ XcdSlice xcd_slice_setup(const DArgs& a, LAS unsigned char* lds) {
    volatile LAS unsigned* bst = (volatile LAS unsigned*)(lds + LDS_BARST);
    XcdSlice x; x.nloc = __builtin_amdgcn_readfirstlane((int)bst[0]); x.nx = __builtin_amdgcn_readfirstlane((int)bst[1]); x.rank = __builtin_amdgcn_readfirstlane((int)bst[2]);
    unsigned* bar = (unsigned*)(a.ws + WS_CTL) + CW_BAR; const unsigned myx = xb_xcc_id();
    x.q = 0; for (unsigned j = 0; j < 16; ++j) { const unsigned c = xb_ld(&bar[XB_XCNT(j)]); if (c > 0u && j < myx) ++x.q; }
    x.q = __builtin_amdgcn_readfirstlane(x.q);
    return x;
}
__device__ __forceinline__ void phase_ua(const DArgs& a, LAS unsigned char* lds) {
    const int tid = tid_(), lane = tid & 63, wave = __builtin_amdgcn_readfirstlane(tid >> 6), k = lane >> 3, c = lane & 7;
    GAS unsigned char* ws = a.ws;
    const XcdSlice X = xcd_slice_setup(a, lds);
    const int tstride = X.nloc * 8;
    for (int sl = X.q; sl < 8; sl += X.nx) {
        const GAS unsigned char* UBs = ws + WS_UB + (size_t)sl * 2097152;
        const unsigned coff = (unsigned)c * 16u;
        GAS unsigned char* PU = ws + WS_PARTU + (size_t)sl * T * 256;
        u32x4 evA[2], evB[2], RA[16], RB[16], xa, xb; float sa, sb;
#define A_TOK(t_) ((t_) < T ? (t_) : T - 1)
#define A_INFO(ev_, t_) do { const int tq_ = A_TOK(t_); _Pragma("unroll") for (int j_ = 0; j_ < 2; ++j_) ev_[j_] = *(const GAS u32x4*)(ws + WS_EIDX + (size_t)tq_ * 256 + (unsigned)(32 * k + 16 * j_)); } while (0)
#define A_ISSUE(R_, x_, s_, ev_, t_) do { const int tq_ = A_TOK(t_); _Pragma("unroll") for (int g_ = 0; g_ < 16; ++g_) R_[g_] = *(const GAS u32x4*)(UBs + (EV_OFF(ev_, g_) | coff)); \
        x_ = *(const GAS u32x4*)(ws + WS_XQ + (size_t)tq_ * 1024 + sl * 128 + coff); s_ = ((const GAS float*)(ws + WS_XQS))[tq_]; } while (0)
#define A_DOTS(R_, x_, s_, t_) do { \
        int ir0_ = 0, ir1_ = 0; \
        _Pragma("unroll") for (int gg_ = 0; gg_ < 4; ++gg_) {           \
            int d_[4]; _Pragma("unroll") for (int q_ = 0; q_ < 4; ++q_) d_[q_] = 0; \
            _Pragma("unroll") for (int j_ = 0; j_ < 4; ++j_) { _Pragma("unroll") for (int q_ = 0; q_ < 4; ++q_) d_[q_] = __builtin_amdgcn_sdot4((int)R_[4 * gg_ + q_][j_], (int)x_[j_], d_[q_], false); } \
            _Pragma("unroll") for (int q_ = 0; q_ < 4; ++q_) d_[q_] += DPPI_(d_[q_], 0xB1); \
            _Pragma("unroll") for (int q_ = 0; q_ < 4; ++q_) d_[q_] += DPPI_(d_[q_], 0x4E); \
            _Pragma("unroll") for (int q_ = 0; q_ < 4; ++q_) d_[q_] += DPPI_(d_[q_], 0x141);          \
            _Pragma("unroll") for (int q_ = 0; q_ < 4; ++q_) { if (c == ((4 * gg_ + q_) >> 1)) { if (q_ & 1) ir1_ = d_[q_]; else ir0_ = d_[q_]; } }          \
            __builtin_amdgcn_sched_barrier(0); } \
        if ((t_) < T) *(GAS unsigned*)(PU + (size_t)(t_) * 256 + (unsigned)(4 * lane)) = pk2((float)ir0_ * s_, (float)ir1_ * s_); } while (0)
        const int n0 = X.rank * 8 + wave;
        A_INFO(evA, n0); A_INFO(evB, n0 + tstride);
        __builtin_amdgcn_sched_barrier(0);
        A_ISSUE(RA, xa, sa, evA, n0);
        __builtin_amdgcn_sched_barrier(0);
#pragma unroll 1
        for (int n = n0; n < T; n += 2 * tstride) {
            A_INFO(evA, n + 2 * tstride);
            __builtin_amdgcn_sched_barrier(0);
            A_ISSUE(RB, xb, sb, evB, n + tstride);
            __builtin_amdgcn_sched_barrier(0);
            A_DOTS(RA, xa, sa, n);
            __builtin_amdgcn_sched_barrier(0);
            A_INFO(evB, n + 3 * tstride);
            __builtin_amdgcn_sched_barrier(0);
            A_ISSUE(RA, xa, sa, evA, n + 2 * tstride);
            __builtin_amdgcn_sched_barrier(0);
            A_DOTS(RB, xb, sb, n + tstride);
            __builtin_amdgcn_sched_barrier(0);
        }
#undef A_TOK
#undef A_INFO
#undef A_ISSUE
#undef A_DOTS
    }
}
__device__ __forceinline__ void phase_ua2(const DArgs& a, int vcu, int G) {
    const int tid = tid_();
    GAS unsigned char* ws = a.ws;
    const GAS float* USC = (const GAS float*)(ws + WS_USC); const GAS float* VSC = (const GAS float*)(ws + WS_VSC);
    const GAS unsigned char* PU = ws + WS_PARTU;
    const size_t N4 = (size_t)T * 128 / 4, stride = (size_t)G * NTHR;
    for (size_t i = (size_t)vcu * NTHR + tid; i < N4; i += 2 * stride) {
        const size_t i1 = (i + stride < N4) ? i + stride : i;
        u32x2 pv0[8], pv1[8];
#pragma unroll
        for (int sl = 0; sl < 8; ++sl) { pv0[sl] = ((const GAS u32x2*)(PU + (size_t)sl * T * 256))[i]; pv1[sl] = ((const GAS u32x2*)(PU + (size_t)sl * T * 256))[i1]; }
        const f32x4 gt0 = ((const GAS f32x4*)(ws + WS_GATE))[i], gt1 = ((const GAS f32x4*)(ws + WS_GATE))[i1];
        const u32x2 ep0 = ((const GAS u32x2*)(ws + WS_EIDX))[i], ep1 = ((const GAS u32x2*)(ws + WS_EIDX))[i1];
        const unsigned e0[4] = {ep0.x & 0xffffu, ep0.x >> 16, ep0.y & 0xffffu, ep0.y >> 16}, e1[4] = {ep1.x & 0xffffu, ep1.x >> 16, ep1.y & 0xffffu, ep1.y >> 16};
        float us0[4], vs0[4], us1[4], vs1[4];
#pragma unroll
        for (int e = 0; e < 4; ++e) { us0[e] = USC[e0[e]]; vs0[e] = VSC[e0[e]]; us1[e] = USC[e1[e]]; vs1[e] = VSC[e1[e]]; }
        f32x4 d0 = (f32x4){0.f, 0.f, 0.f, 0.f}, d1 = d0;
#pragma unroll
        for (int sl = 0; sl < 8; ++sl) { d0[0] += bf_lo(pv0[sl].x); d0[1] += bf_hi(pv0[sl].x); d0[2] += bf_lo(pv0[sl].y); d0[3] += bf_hi(pv0[sl].y);
                                         d1[0] += bf_lo(pv1[sl].x); d1[1] += bf_hi(pv1[sl].x); d1[2] += bf_lo(pv1[sl].y); d1[3] += bf_hi(pv1[sl].y); }
        f32x4 w0, w1;
#pragma unroll
        for (int e = 0; e < 4; ++e) { w0[e] = gelu_erf(d0[e] * us0[e]) * gt0[e] * vs0[e]; w1[e] = gelu_erf(d1[e] * us1[e]) * gt1[e] * vs1[e]; }
        u32x2 wo; wo.x = pk2(w0[0], w0[1]); wo.y = pk2(w0[2], w0[3]); ((GAS u32x2*)(ws + WS_PW))[i] = wo;
        if (i + stride < N4) { wo.x = pk2(w1[0], w1[1]); wo.y = pk2(w1[2], w1[3]); ((GAS u32x2*)(ws + WS_PW))[i1] = wo; }
    }
}
__device__ __forceinline__ void phase_vb(const DArgs& a, LAS unsigned char* lds) {
    const int tid = tid_(), lane = tid & 63, wave = __builtin_amdgcn_readfirstlane(tid >> 6), k = lane >> 3, c = lane & 7;
    GAS unsigned char* ws = a.ws;
    const XcdSlice X = xcd_slice_setup(a, lds);
    const int tstride = X.nloc * 8;
    const bool bit3 = (lane & 8) != 0;
    for (int sl = X.q; sl < 8; sl += X.nx) {
        const GAS unsigned char* VBs = ws + WS_VB + (size_t)sl * 2097152;
        const unsigned coff = (unsigned)c * 16u;
        const unsigned xoff = (unsigned)(sl * 128 + c * 16 + 2 * k) * 4u;
        u32x4 evA[2], evB[2], RA[16], RB[16], wa[2], wb[2]; unsigned xa, xb;
#define B_TOK(t_) ((t_) < T ? (t_) : T - 1)
#define B_INFO(ev_, t_) do { const int tq_ = B_TOK(t_); _Pragma("unroll") for (int j_ = 0; j_ < 2; ++j_) ev_[j_] = *(const GAS u32x4*)(ws + WS_EIDX + (size_t)tq_ * 256 + (unsigned)(32 * k + 16 * j_)); } while (0)
#define B_ISSUE(R_, w_, x_, ev_, t_) do { const int tq_ = B_TOK(t_); _Pragma("unroll") for (int g_ = 0; g_ < 16; ++g_) R_[g_] = *(const GAS u32x4*)(VBs + (EV_OFF(ev_, g_) | coff)); \
        _Pragma("unroll") for (int j_ = 0; j_ < 2; ++j_) w_[j_] = *(const GAS u32x4*)(ws + WS_PW + (size_t)tq_ * 256 + (unsigned)(32 * k + 16 * j_)); \
        x_ = *(const GAS unsigned*)((const GAS unsigned char*)a.out + (size_t)tq_ * (D * 2) + (xoff >> 1)); } while (0)
#define B_DOTS(R_, w_, x_, t_) do { \
        f32x2 acc2_[8]; _Pragma("unroll") for (int e_ = 0; e_ < 8; ++e_) acc2_[e_] = (f32x2){0.f, 0.f}; \
        _Pragma("unroll") for (int g_ = 0; g_ < 16; ++g_) { const unsigned ww_ = w_[g_ >> 3][(g_ >> 1) & 3]; const float wk_ = (g_ & 1) ? bf_hi(ww_) : bf_lo(ww_); const f32x2 wp_ = (f32x2){wk_, wk_}; \
            _Pragma("unroll") for (int jj_ = 0; jj_ < 4; ++jj_) { acc2_[2 * jj_] += wp_ * FP8LO(R_[g_][jj_]); acc2_[2 * jj_ + 1] += wp_ * FP8HI(R_[g_][jj_]); } \
            if (g_ & 1) __builtin_amdgcn_sched_barrier(0); } \
        f32x2 w2_[4], x2_[2], y_; \
        _Pragma("unroll") for (int i_ = 0; i_ < 4; ++i_) { w2_[i_][0] = rs32_(acc2_[i_][0], acc2_[i_ + 4][0]); w2_[i_][1] = rs32_(acc2_[i_][1], acc2_[i_ + 4][1]); } \
        _Pragma("unroll") for (int i_ = 0; i_ < 2; ++i_) { x2_[i_][0] = rs16_(w2_[i_][0], w2_[i_ + 2][0]); x2_[i_][1] = rs16_(w2_[i_][1], w2_[i_ + 2][1]); } \
        y_[0] = rs8_(x2_[0][0], x2_[1][0], bit3) + bf_lo(x_); y_[1] = rs8_(x2_[0][1], x2_[1][1], bit3) + bf_hi(x_); \
        const float ss_ = wave_sum(y_[0] * y_[0] + y_[1] * y_[1], lane); \
        if ((t_) < T) { *(GAS unsigned*)(ws + WS_PARTU + (size_t)(t_) * (D * 2) + (xoff >> 1)) = pk2(y_[0], y_[1]);       \
            if (lane == 0) ((GAS float*)(ws + WS_SS))[(size_t)(t_) * 8 + sl] = ss_; } } while (0)
        const int n0 = X.rank * 8 + wave;
        B_INFO(evA, n0); B_INFO(evB, n0 + tstride);
        __builtin_amdgcn_sched_barrier(0);
        B_ISSUE(RA, wa, xa, evA, n0);
        __builtin_amdgcn_sched_barrier(0);
#pragma unroll 1
        for (int n = n0; n < T; n += 2 * tstride) {
            B_INFO(evA, n + 2 * tstride);
            __builtin_amdgcn_sched_barrier(0);
            B_ISSUE(RB, wb, xb, evB, n + tstride);
            __builtin_amdgcn_sched_barrier(0);
            B_DOTS(RA, wa, xa, n);
            __builtin_amdgcn_sched_barrier(0);
            B_INFO(evB, n + 3 * tstride);
            __builtin_amdgcn_sched_barrier(0);
            B_ISSUE(RA, wa, xa, evA, n + 2 * tstride);
            __builtin_amdgcn_sched_barrier(0);
            B_DOTS(RB, wb, xb, n + tstride);
            __builtin_amdgcn_sched_barrier(0);
        }
#undef B_TOK
#undef B_INFO
#undef B_ISSUE
#undef B_DOTS
    }
}
__device__ __forceinline__ void phase_vc(const DArgs& a, int vcu, int G) {
    const int tid = tid_(), lane = tid & 63, wave = tid >> 6;
    const int gw = vcu * NWAVES + wave, NGW = G * NWAVES;
    GAS unsigned char* ws = a.ws;
    f32x4 gf[4];
#pragma unroll
    for (int j = 0; j < 4; ++j) gf[j] = ((const GAS f32x4*)a.final_g)[64 * j + lane];
    for (int m = gw; m < T; m += NGW) {
        const f32x4 s0 = *(const GAS f32x4*)((const GAS float*)(ws + WS_SS) + (size_t)m * 8), s1 = *(const GAS f32x4*)((const GAS float*)(ws + WS_SS) + (size_t)m * 8 + 4);
        const float rstd = rsqrtf(((s0[0] + s0[1]) + (s0[2] + s0[3]) + (s1[0] + s1[1]) + (s1[2] + s1[3])) * (1.f / D) + EPS);
        const GAS u32x2* xi = (const GAS u32x2*)(ws + WS_PARTU + (size_t)m * (D * 2)) + lane;
        GAS f32x4* o = (GAS f32x4*)(a.out + (size_t)m * D) + lane;
#pragma unroll
        for (int j = 0; j < 4; ++j) { const u32x2 xv = xi[64 * j]; f32x4 v; v[0] = bf_lo(xv.x); v[1] = bf_hi(xv.x); v[2] = bf_lo(xv.y); v[3] = bf_hi(xv.y); o[64 * j] = v * rstd * gf[j]; }
    }
}

__device__ __forceinline__ void phase_final_plain(const DArgs& a, const float* src, int vcu, int G) {
    const int tid = tid_(), lane = tid & 63, wave = tid >> 6;
    const int gw = vcu * NWAVES + wave, NGW = G * NWAVES;
    f32x4 gf[4];
#pragma unroll
    for (int j = 0; j < 4; ++j) gf[j] = ((const f32x4*)a.final_g)[64 * j + lane];
    for (int m = gw; m < T; m += NGW) {
        const f32x4* xr = (const f32x4*)(src + (size_t)m * D) + lane;
        f32x4 v[4]; float s = 0.f;
#pragma unroll
        for (int j = 0; j < 4; ++j) { v[j] = xr[64 * j]; s += (v[j][0] * v[j][0] + v[j][1] * v[j][1]) + (v[j][2] * v[j][2] + v[j][3] * v[j][3]); }
        const float rstd = rsqrtf(wave_sum(s, lane) * (1.f / D) + EPS);
        f32x4* o = (f32x4*)(a.out + (size_t)m * D) + lane;
#pragma unroll
        for (int j = 0; j < 4; ++j) o[64 * j] = v[j] * rstd * gf[j];
    }
}


__device__ __forceinline__ DArgs load_args() {
    DArgs r;
#if defined(__HIP_DEVICE_COMPILE__)
    typedef const DArgs __attribute__((address_space(4))) KArgs;
    KArgs* p = (KArgs*)__builtin_amdgcn_kernarg_segment_ptr();
    asm volatile("" : "+s"(p));
    r.x = p->x; r.norm1_g = p->norm1_g; r.w_in = p->w_in; r.b_in = p->b_in; r.conv_w = p->conv_w; r.conv_b = p->conv_b; r.m_head_g = p->m_head_g; r.lb_table = p->lb_table;
    r.g_head_g = p->g_head_g; r.w_br_m = p->w_br_m; r.w_br_g = p->w_br_g; r.w_out = p->w_out; r.norm2_g = p->norm2_g; r.w_pq = p->w_pq; r.sub_keys = p->sub_keys;
    r.u_emb = p->u_emb; r.v_emb = p->v_emb; r.final_g = p->final_g; r.out = p->out; r.ws = p->ws;
#else
    r = DArgs{};
#endif
    return r;
}
__device__ __forceinline__ EpiPtrs make_ep(const DArgs& a, int round) {
    EpiPtrs ep; ep.biasp = (const GAS float*)(a.ws + WS_BIASP); ep.lb = (const GAS float*)(a.ws + WS_LB); ep.x = a.x; ep.out = a.out; ep.ws = a.ws; ep.round = round; ep.pn0 = 0; ep.sa = (const GAS float*)(a.ws + WS_SA8); ep.sb = (const GAS float*)(a.ws + WS_SB8); ep.sym = (const GAS float*)(a.ws + WS_SYM); ep.syg = (const GAS float*)(a.ws + WS_SYG); ep.sxq = (const GAS float*)(a.ws + WS_XQS); return ep;
}
#define GRID_SYNC() do { const DArgs a_ = load_args(); xcd_barrier((unsigned*)(a_.ws + WS_CTL) + CW_BAR, (volatile LAS unsigned*)(lds + LDS_BARST)); } while (0)

__device__ __forceinline__ int bx_() { int t = blockIdx.x; asm volatile("" : "+s"(t)); return t; }
__device__ __forceinline__ int gd_() { int t = gridDim.x; asm volatile("" : "+s"(t)); return t; }
#define PH_BEGIN const DArgs a = load_args(); const int bx = bx_(), G = gd_(); const int vcu = (G % 8 == 0) ? (bx % 8) * (G / 8) + bx / 8 : bx; (void)vcu; (void)bx;

__global__ void __launch_bounds__(NTHR, 2) fwd_megakernel(Args a_unused) {
    extern __shared__ __attribute__((aligned(16))) unsigned char lds_raw[];
    LAS unsigned char* lds = (LAS unsigned char*)lds_raw;
    cg::grid_group grid = cg::this_grid();

    { const int t_ = tid_(); if (t_ < 16) ((LAS unsigned*)(lds + LDS_BARST))[t_] = 0u; __syncthreads();
      const DArgs a_ = load_args(); xcd_barrier_post((unsigned*)(a_.ws + WS_CTL) + CW_BAR, (volatile LAS unsigned*)(lds + LDS_BARST)); }
    { PH_BEGIN phase_p0(a, lds, vcu, G); }
    grid.sync();
    { PH_BEGIN phase_p0c(a, lds, vcu, G); }
    GRID_SYNC();
#pragma unroll 1
    for (int round = 0; round < NROUND; ++round) {
        {
            PH_BEGIN
            pg8::Gemm g{(const bf16_t*)(a.ws + WS_XN8 + (size_t)round * RT * 1024), (const bf16_t*)(a.ws + WS_W8A), RT, N1, D / 2};
            pg8::StaticOrder S; S.init(RT, N1, G, bx);
            EpiX<7> E{make_ep(a, round)};
            pg8::gemm_phase<EpiX<7>, pg8::StaticOrder, true, true, true>(lds, g, S, E);
        }
        { PH_BEGIN if (bx < 8) mscan_pair(a, lds, round, bx); }
        GRID_SYNC();
        { PH_BEGIN for (int it = bx; it < 512; it += G) mlstm_pre_item(a, lds, round, it); }
        { PH_BEGIN u32x4 gq[4]; int it = bx; if (it < 2048) hgrn_pre_load(a, round, it, gq);
          for (; it < 2048; it += G) hgrn_pre_item(a, lds, round, it, gq, it + G); }
        GRID_SYNC();
        { PH_BEGIN
          if (bx < 128) mlstm_scan<2, false>(a, lds, round, bx & 7, bx >> 3);
          else if (bx >= 192 && bx < 200) mlstm_scan<1, true>(a, lds, round, bx - 192, 0);
          else if (bx < 192) { const int id2 = bx - 128; hgrn_scan(a, lds, round, (id2 & 7) * 2 + ((id2 >> 3) & 1), id2 >> 4); }
          else if (G >= 232) {
              pg8::Gemm g{(const bf16_t*)(a.ws + WS_XN8 + (size_t)round * RT * 1024), (const bf16_t*)(a.ws + WS_W8 + (size_t)2048 * 1024), RT, 1024, D / 2};
              pg8::StaticOrder S; S.init(RT, 1024, G - 200, bx - 200);
              EpiPtrs ep = make_ep(a, round); ep.pn0 = 8; EpiX<2> E{ep};
              pg8::gemm_phase<EpiX<2>, pg8::StaticOrder, true, true, true>(lds, g, S, E); } }
        GRID_SYNC();
#define G2_PART(pn0_, ncol_) { PH_BEGIN \
            pg8::Gemm g{(const bf16_t*)(a.ws + WS_XN8 + (size_t)round * RT * 1024), (const bf16_t*)(a.ws + WS_W8 + (size_t)(pn0_) * 256 * 1024), RT, (ncol_), D / 2};       \
            pg8::StaticOrder S; S.init(RT, (ncol_), G, bx); \
            EpiPtrs ep = make_ep(a, round); ep.pn0 = (pn0_); EpiX<2> E{ep}; \
            pg8::gemm_phase<EpiX<2>, pg8::StaticOrder, true, true, true>(lds, g, S, E); }
        G2_PART(0, 2048)
        G2_PART(12, 2048)
        if (gd_() < 232) G2_PART(8, 1024)
#undef G2_PART
        GRID_SYNC();
        { PH_BEGIN phase_ypass(a, round, vcu, G); }
        GRID_SYNC();
        {
            { PH_BEGIN pg8::StaticOrder S; S.init(RT, D, G, bx);
              pg8::Gemm g{(const bf16_t*)(a.ws + WS_V), (const bf16_t*)(a.ws + WS_WM), RT, D, 2048 / 2}; EpiX<3> E{make_ep(a, round)}; pg8::gemm_phase<EpiX<3>, pg8::StaticOrder, true, true, true>(lds, g, S, E); }
            { PH_BEGIN pg8::StaticOrder S; S.init(RT, D, G, bx);
              pg8::Gemm g{(const bf16_t*)(a.ws + WS_GI), (const bf16_t*)(a.ws + WS_WG), RT, D, D / 2}; EpiX<4> E{make_ep(a, round)}; pg8::gemm_phase<EpiX<4>, pg8::StaticOrder, true, true, true>(lds, g, S, E); }
        }
        GRID_SYNC();
        {
            PH_BEGIN pg8::StaticOrder S; S.init(RT, D, G, bx);
            pg8::Gemm g{(const bf16_t*)(a.ws + WS_GFLOG), (const bf16_t*)(a.ws + WS_WO), RT, D, D}; EpiX<5> E{make_ep(a, round)}; pg8::gemm_phase<EpiX<5>, pg8::StaticOrder, true, true>(lds, g, S, E);
        }
        GRID_SYNC();
    }
    { PH_BEGIN phase_p8(a, vcu, G); }
    GRID_SYNC();
    {
        PH_BEGIN pg8::StaticOrder S; S.init(T, 2048, G, bx);
        pg8::Gemm g{(const bf16_t*)(a.ws + WS_XQ), (const bf16_t*)(a.ws + WS_WPQ), T, 2048, D / 2}; EpiX<6> E{make_ep(a, 0)}; pg8::gemm_phase<EpiX<6>, pg8::StaticOrder, true, true, true>(lds, g, S, E);
    }
    GRID_SYNC();
#ifdef TOPK_REF
    { PH_BEGIN phase_topk_ref(a, vcu, G); }
#else
    { PH_BEGIN phase_topk(a, lds, bx, G); }
#endif
    GRID_SYNC();
    { PH_BEGIN phase_ua(a, lds); }
    GRID_SYNC();
    { PH_BEGIN phase_ua2(a, vcu, G); }
    GRID_SYNC();
    { PH_BEGIN phase_vb(a, lds); }
    GRID_SYNC();
    { PH_BEGIN phase_vc(a, vcu, G); }
}

extern "C" void kernel_launch(void* const* d_in, const int* in_sizes, int n_in, void* d_out, int out_size, void* d_ws, size_t ws_size, hipStream_t stream) {
    static int grid = 0;
    if (grid == 0) {
        if (n_in != 18 || in_sizes[0] != T * D || out_size != T * D || ws_size < WS_END) {
            fprintf(stderr, "kernel_launch: unexpected shapes/workspace (n_in %d, in0 %d, out %d, ws %zu, need %zu)\n", n_in, n_in > 0 ? in_sizes[0] : -1, out_size, ws_size, (size_t)WS_END);
            grid = -1; return; }
        int dev = 0, cus = 0, per_cu = 0;
        hipGetDevice(&dev);
        hipDeviceGetAttribute(&cus, hipDeviceAttributeMultiprocessorCount, dev);
        hipFuncSetAttribute((const void*)fwd_megakernel, hipFuncAttributeMaxDynamicSharedMemorySize, LDS_BYTES);
        hipOccupancyMaxActiveBlocksPerMultiprocessor(&per_cu, (const void*)fwd_megakernel, NTHR, LDS_BYTES);
        if (per_cu < 1) { fprintf(stderr, "kernel_launch: occupancy query says %d blocks/CU\n", per_cu); per_cu = 1; }
        grid = cus;
        (void)hipGetLastError();
    }
    if (grid < 0) return;
    hipMemsetAsync((char*)d_ws + WS_CTL, 0, 131072, stream);
    Args a{};
    a.x = (const float*)d_in[0]; a.norm1_g = (const float*)d_in[1]; a.w_in = (const float*)d_in[2]; a.b_in = (const float*)d_in[3];
    a.conv_w = (const float*)d_in[4]; a.conv_b = (const float*)d_in[5]; a.m_head_g = (const float*)d_in[6]; a.lb_table = (const float*)d_in[7];
    a.g_head_g = (const float*)d_in[8]; a.w_br_m = (const float*)d_in[9]; a.w_br_g = (const float*)d_in[10]; a.w_out = (const float*)d_in[11];
    a.norm2_g = (const float*)d_in[12]; a.w_pq = (const float*)d_in[13]; a.sub_keys = (const float*)d_in[14]; a.u_emb = (const float*)d_in[15];
    a.v_emb = (const float*)d_in[16]; a.final_g = (const float*)d_in[17];
    a.out = (float*)d_out; a.ws = (unsigned char*)d_ws;
    void* args[] = {&a};
    hipError_t e = hipLaunchCooperativeKernel((const void*)fwd_megakernel, dim3(grid), dim3(NTHR), args, LDS_BYTES, stream);
    if (e != hipSuccess) fprintf(stderr, "cooperative launch failed: %s (grid %d)\n", hipGetErrorString(e), grid);
}
```

```cpp
#include <hip/hip_runtime.h>
#include <hip/hip_cooperative_groups.h>
#include <cstdio>
#include <cstdint>
namespace cg = cooperative_groups;

#define LAS __attribute__((address_space(3)))
typedef unsigned short bf16_t;
typedef short bf16x8 __attribute__((ext_vector_type(8)));
typedef float f32x4 __attribute__((ext_vector_type(4)));
typedef float f32x2 __attribute__((ext_vector_type(2)));
typedef unsigned u32x4 __attribute__((ext_vector_type(4)));
typedef unsigned u32x2 __attribute__((ext_vector_type(2)));

constexpr int D = 1024, BATCH = 4, SEQ = 8192, T = BATCH * SEQ;
constexpr int IN_COLS = 12296, NP = 12288;
constexpr int RT = 16384, NROUND = 2;
constexpr int N1 = 7168, N2 = 5120;
constexpr float EPS = 1e-6f;
constexpr int NWAVES = 8, NTHR = 512;

constexpr size_t MiB = 1u << 20;
constexpr size_t WS_CTL = 0;
constexpr size_t WS_WIN = 1 * MiB;
constexpr size_t WS_WM = 25 * MiB;
constexpr size_t WS_WG = 29 * MiB;
constexpr size_t WS_WO = 31 * MiB;
constexpr size_t WS_WPQ = 33 * MiB;
constexpr size_t WS_SK = 37 * MiB;
constexpr size_t WS_BIASP = 37 * MiB + 512 * 1024;
constexpr size_t WS_LB = WS_BIASP + 64 * 1024;
constexpr size_t WS_GATES = 38 * MiB;
constexpr size_t WS_MPREV = 39 * MiB;
constexpr size_t WS_DEN = 40 * MiB;
constexpr size_t WS_MT = 40 * MiB + 512 * 1024;
constexpr size_t WS_HGDEC = 41 * MiB;
constexpr size_t WS_MDEC = 43 * MiB;
constexpr size_t WS_XN = 44 * MiB;
constexpr size_t WS_QKPRE = 108 * MiB;
constexpr size_t WS_V = 172 * MiB;
constexpr size_t WS_GFLOG = 236 * MiB;
constexpr size_t WS_GI = 268 * MiB;
constexpr size_t WS_GQ = 300 * MiB;
constexpr size_t WS_S = 332 * MiB;
constexpr size_t WS_QT = 348 * MiB;
constexpr size_t WS_KWT = 380 * MiB;
constexpr size_t WS_ATT = 412 * MiB;
constexpr size_t WS_QTG = 428 * MiB;
constexpr size_t WS_KENDT = 460 * MiB;
constexpr size_t WS_SIGO = 332 * MiB;
constexpr size_t WS_SGG = 76 * MiB;
constexpr size_t WS_SAM = 428 * MiB;
constexpr size_t WS_SAG = 460 * MiB;
constexpr size_t WS_XN8 = 44 * MiB;
constexpr size_t WS_SA8 = 508 * MiB;
constexpr size_t WS_SB8 = 508 * MiB + 262144;
constexpr size_t WS_W8A = WS_WIN;
constexpr size_t WS_W8 = WS_WIN + (size_t)7168 * 1024;
constexpr int NI8 = 12288 + 1024 + 1024 + 2048;
constexpr size_t WS_SYM = 508 * MiB + 524288;
constexpr size_t WS_SYG = 508 * MiB + 655360;
constexpr int CW_COLMAX = 16384;
constexpr size_t WS_END = 510 * MiB;
constexpr size_t WS_QP = 108 * MiB;
constexpr size_t WS_UB = 236 * MiB;
constexpr size_t WS_VB = 252 * MiB;
constexpr size_t WS_USC = 268 * MiB;
constexpr size_t WS_VSC = 268 * MiB + 65536;
constexpr size_t WS_EIDX = 300 * MiB;
constexpr size_t WS_GATE = 316 * MiB;
constexpr size_t WS_XQ = 380 * MiB;
constexpr size_t WS_XQS = 412 * MiB;
constexpr size_t WS_PARTU = 108 * MiB;
constexpr size_t WS_SS = 348 * MiB;
constexpr size_t WS_PW = 332 * MiB;

constexpr int CW_TMAX = 64;
constexpr int LDS_BYTES = 147456;
constexpr int XSPLIT = 392;

__device__ __forceinline__ unsigned f2bf(float f) { unsigned u = __builtin_bit_cast(unsigned, f); return (u + 0x7fffu + ((u >> 16) & 1u)) >> 16; }
typedef __bf16 bf16x2_t __attribute__((ext_vector_type(2)));
__device__ __forceinline__ unsigned pk2(float lo, float hi) { bf16x2_t v; v[0] = (__bf16)lo; v[1] = (__bf16)hi; return __builtin_bit_cast(unsigned, v); }
__device__ __forceinline__ float bf_lo(unsigned w) { return __builtin_bit_cast(float, w << 16); }
__device__ __forceinline__ float bf_hi(unsigned w) { return __builtin_bit_cast(float, w & 0xffff0000u); }
__device__ __forceinline__ float bf2f(bf16_t h) { return __builtin_bit_cast(float, ((unsigned)h) << 16); }
__device__ __forceinline__ float shx(float v, int o, int lane) { return __builtin_bit_cast(float, __builtin_amdgcn_ds_bpermute((lane ^ o) << 2, __builtin_bit_cast(int, v))); }
__device__ __forceinline__ float shup(float v, int o, int lane) { return __builtin_bit_cast(float, __builtin_amdgcn_ds_bpermute(((lane - o) & 63) << 2, __builtin_bit_cast(int, v))); }
__device__ __forceinline__ float rdlane(float v, int l) { return __builtin_bit_cast(float, __builtin_amdgcn_readlane(__builtin_bit_cast(int, v), l)); }
#define DPP_(v, ctrl) __builtin_bit_cast(float, __builtin_amdgcn_update_dpp(0, __builtin_bit_cast(int, (v)), (ctrl), 0xF, 0xF, false))
__device__ __forceinline__ float wave_sum(float v, int lane) {
    (void)lane;
    v += DPP_(v, 0xB1); v += DPP_(v, 0x4E); v += DPP_(v, 0x141); v += DPP_(v, 0x140);
    return (rdlane(v, 0) + rdlane(v, 16)) + (rdlane(v, 32) + rdlane(v, 48));
}
__device__ __forceinline__ float wave_max(float v) {
    v = fmaxf(v, DPP_(v, 0xB1)); v = fmaxf(v, DPP_(v, 0x4E)); v = fmaxf(v, DPP_(v, 0x141)); v = fmaxf(v, DPP_(v, 0x140));
    return fmaxf(fmaxf(rdlane(v, 0), rdlane(v, 16)), fmaxf(rdlane(v, 32), rdlane(v, 48)));
}
__device__ __forceinline__ unsigned pack_u8x4(float a, float b, float c, float d) {
    unsigned p = __builtin_amdgcn_cvt_pk_u8_f32(a * 255.0f, 0, 0u); p = __builtin_amdgcn_cvt_pk_u8_f32(b * 255.0f, 1, p); p = __builtin_amdgcn_cvt_pk_u8_f32(c * 255.0f, 2, p); return __builtin_amdgcn_cvt_pk_u8_f32(d * 255.0f, 3, p);
}
__device__ __forceinline__ unsigned pack_u8x4r(float a, float b, float c, float d) {
    unsigned p = __builtin_amdgcn_cvt_pk_u8_f32(a, 0, 0u); p = __builtin_amdgcn_cvt_pk_u8_f32(b, 1, p); p = __builtin_amdgcn_cvt_pk_u8_f32(c, 2, p); return __builtin_amdgcn_cvt_pk_u8_f32(d, 3, p);
}
__device__ __forceinline__ float u8r(unsigned w, int b) { return (float)((w >> (8 * b)) & 0xffu); }
__device__ __forceinline__ float u8f(unsigned w, int b) { return (float)((w >> (8 * b)) & 0xffu) * (1.0f / 255.0f); }
__device__ __forceinline__ unsigned pack_i8x4(float a, float b, float c, float d) {
    const int ia = (int)__builtin_rintf(a), ib = (int)__builtin_rintf(b), ic = (int)__builtin_rintf(c), id = (int)__builtin_rintf(d);
    return ((unsigned)ia & 255u) | (((unsigned)ib & 255u) << 8) | (((unsigned)ic & 255u) << 16) | ((unsigned)id << 24);
}
#define SWZI_(v, pat) __builtin_amdgcn_ds_swizzle((int)(v), (pat))
#define DPPI_(v, ctrl) __builtin_amdgcn_update_dpp(0, (int)(v), (ctrl), 0xF, 0xF, false)
__device__ __forceinline__ unsigned xor32u_(unsigned v, bool hi) {
#if defined(__HIP_DEVICE_COMPILE__)
    const auto r = __builtin_amdgcn_permlane32_swap(v, v, false, false);
    return hi ? r[0] : r[1];
#else
    (void)hi; return v;
#endif
}
__device__ __forceinline__ float sigmoidf_(float x) { return __builtin_amdgcn_rcpf(1.0f + __expf(-x)); }
__device__ __forceinline__ float siluf_(float x) { return x * __builtin_amdgcn_rcpf(1.0f + __expf(-x)); }
#define LDS_WAIT() asm volatile("s_waitcnt lgkmcnt(0)" ::: "memory")
__device__ __forceinline__ int tid_() { int t = threadIdx.x; asm volatile("" : "+v"(t)); return t; }

#define GAS __attribute__((address_space(1)))
struct DArgs {
    const GAS float* x; const GAS float* norm1_g; const GAS float* w_in; const GAS float* b_in; const GAS float* conv_w; const GAS float* conv_b;
    const GAS float* m_head_g; const GAS float* lb_table; const GAS float* g_head_g; const GAS float* w_br_m; const GAS float* w_br_g; const GAS float* w_out;
    const GAS float* norm2_g; const GAS float* w_pq; const GAS float* sub_keys; const GAS float* u_emb; const GAS float* v_emb; const GAS float* final_g;
    GAS float* out; GAS unsigned char* ws;
};
struct Args {
    const float* x; const float* norm1_g; const float* w_in; const float* b_in; const float* conv_w; const float* conv_b;
    const float* m_head_g; const float* lb_table; const float* g_head_g; const float* w_br_m; const float* w_br_g; const float* w_out;
    const float* norm2_g; const float* w_pq; const float* sub_keys; const float* u_emb; const float* v_emb; const float* final_g;
    float* out; unsigned char* ws;
};

namespace pg8 {
constexpr int BM = 256, BK = 64, HALF = 128, HTB = HALF * BK * 2, STAGE_BYTES = 8 * HTB, NXCD = 8, WGM = 8;
__host__ __device__ __forceinline__ int lds_byte(int r, int c) { const int st = (r >> 4) * 2 + (c >> 5), rr = r & 15, cc = c & 31, ob = rr * 64 + cc * 2; return st * 1024 + (ob ^ (((ob >> 9) & 1) << 5)); }
__host__ __device__ __forceinline__ void stage_rc(int b, int& R, int& C) { const int st = b / 1024, sb = b % 1024, swz = sb ^ (((sb >> 9) & 1) << 5); R = (st >> 1) * 16 + swz / 64; C = (st & 1) * 32 + (swz % 64) / 2; }
__host__ __device__ __forceinline__ int perm32(int rho) { const int n = rho >> 4, i = rho & 15; return 8 * (i >> 2) + 4 * n + (i & 3); }
struct Unit { int pm, pn; };
struct Gemm { const bf16_t* A; const bf16_t* Bt; int M, N, K; };
struct ExtraOrder {
    int lo, hi, nw, c;
    __device__ __forceinline__ bool next(int i, Unit& u) const { const int L = lo + i * nw + c; if (L >= hi) return false; const int t = L & 255; u.pm = t >> 2; u.pn = (L < 256 ? 8 : 16) + (t & 3); return true; }
    __device__ __forceinline__ void a_ready(const Unit&) const {}
    __device__ __forceinline__ void done(const Unit&) const {}
};
struct StaticOrder {
    int nM, nN, nwg, G, c;
    __host__ __device__ void init(int M, int N, int G_, int c_) { nM = M / BM; nN = N / BM; nwg = nM * nN; G = G_; c = c_; }
    __host__ __device__ bool next(int i, Unit& u) const {
        const long L = (long)i * G + c; if (L >= nwg) return false;
        int wgid = (int)L; { const int q = nwg / NXCD, r = nwg % NXCD, xcd = wgid % NXCD, off = wgid / NXCD; wgid = (xcd < r ? xcd * (q + 1) : r * (q + 1) + (xcd - r) * q) + off; }
        const int nig = WGM * nN, gid = wgid / nig, fm = gid * WGM, gsz = (nM - fm) < WGM ? (nM - fm) : WGM;
        u.pm = fm + ((wgid % nig) % gsz); u.pn = (wgid % nig) / gsz; return true;
    }
    __device__ __forceinline__ void a_ready(const Unit&) const {}
    __device__ __forceinline__ void done(const Unit&) const {}
};

typedef int i32x8 __attribute__((ext_vector_type(8)));
typedef int i32x4 __attribute__((ext_vector_type(4)));
template <class Epi, class Sched, bool ALIGN_EPI = false, bool SP2 = false, bool I8 = false>
__device__ __forceinline__ void gemm_phase(LAS unsigned char* lds, const Gemm g, const Sched& S, const Epi& E) {
    const int tid = tid_(), wid = __builtin_amdgcn_readfirstlane(tid >> 6), lane = tid & 63, wr = wid >> 2, wc = wid & 3, fr = lane & 15, fq = lane >> 4;
    const int K = g.K, nt = K / BK;
    unsigned voffA[2], voffB[2];
#pragma unroll
    for (int i = 0; i < 2; ++i) { int R, C; stage_rc(tid * 16 + i * 8192, R, C); const int Rb = Epi::PERM ? ((R & ~31) + perm32(R & 31)) : R;
        voffA[i] = (unsigned)(R * K + C) * 2u; voffB[i] = (unsigned)(Rb * K + C) * 2u; }
    const size_t kstep = (size_t)(BK * 2);
    const size_t hstep = (size_t)HALF * K * 2;
    const size_t tstep = 2 * hstep;
    const unsigned ldsw = (unsigned)wid * 1024u;
    const int aoff = lds_byte(wr * 64 + fr, fq * 8), boff = lds_byte(wc * 32 + fr, fq * 8);
#define PG8_SA(b, h) (((b) * 2 + (h)) * HTB)
#define PG8_SB(b, h) ((4 + (b) * 2 + (h)) * HTB)
#define PG8_STAGE(bufoff, gbase, voff) do { _Pragma("unroll") for (int _i = 0; _i < 2; ++_i) \
        __builtin_amdgcn_global_load_lds((const unsigned*)((const char*)(gbase) + (voff)[_i]), (LAS unsigned*)(lds + (bufoff) + ldsw + _i * 8192), 16, 0, 0); } while (0)
#define PG8_LDA(dst, b, h) do { _Pragma("unroll") for (int m = 0; m < 4; ++m) _Pragma("unroll") for (int k = 0; k < 2; ++k) dst[m][k] = *(const LAS bf16x8*)(lds + PG8_SA(b, h) + aoff + m * 2048 + k * 1024); } while (0)
#define PG8_LDB(dst, b, h) do { _Pragma("unroll") for (int n = 0; n < 2; ++n) _Pragma("unroll") for (int k = 0; k < 2; ++k) dst[n][k] = *(const LAS bf16x8*)(lds + PG8_SB(b, h) + boff + n * 2048 + k * 1024); } while (0)
#define PG8_MMA(ai, bj, At, Bt) do { __builtin_amdgcn_s_setprio(1); _Pragma("unroll") for (int m = 0; m < 4; ++m) _Pragma("unroll") for (int n = 0; n < 2; ++n) _Pragma("unroll") for (int k = 0; k < 2; ++k) { \
        if constexpr (I8) acc[ai][bj][m][n] = __builtin_bit_cast(f32x4, __builtin_amdgcn_mfma_i32_16x16x64_i8(__builtin_bit_cast(i32x4, Bt[n][k]), __builtin_bit_cast(i32x4, At[m][k]), __builtin_bit_cast(i32x4, acc[ai][bj][m][n]), 0, 0, 0)); \
        else acc[ai][bj][m][n] = __builtin_amdgcn_mfma_f32_16x16x32_bf16(Bt[n][k], At[m][k], acc[ai][bj][m][n], 0, 0, 0); } __builtin_amdgcn_s_setprio(0); } while (0)
#define PG8_WAIT_V(n) asm volatile("s_waitcnt vmcnt(" #n ")" ::: "memory")
#define PG8_WAIT_L(n) asm volatile("s_waitcnt lgkmcnt(" #n ")" ::: "memory")
#define PG8_BAR __builtin_amdgcn_s_barrier()
#define PG8_SCHED __builtin_amdgcn_sched_barrier(0)
    Unit cur, nxt; int ui = 0;
    if (!S.next(0, cur)) return;
    f32x4 acc[2][2][4][2];
#pragma unroll
    for (int a = 0; a < 2; ++a)
#pragma unroll
        for (int b = 0; b < 2; ++b)
#pragma unroll
            for (int m = 0; m < 4; ++m)
#pragma unroll
                for (int n = 0; n < 2; ++n) acc[a][b][m][n] = (f32x4){0.f, 0.f, 0.f, 0.f};
    bf16x8 At[4][2], B0[2][2], B1[2][2];
    const char* cA = (const char*)g.A + (size_t)cur.pm * tstep; const char* cB = (const char*)g.Bt + (size_t)cur.pn * tstep;
    S.a_ready(cur);
    if constexpr (SP2) {
        PG8_STAGE(PG8_SB(0, 0), cB, voffB); PG8_STAGE(PG8_SB(0, 1), cB + hstep, voffB); PG8_STAGE(PG8_SA(0, 0), cA, voffA); PG8_STAGE(PG8_SA(0, 1), cA + hstep, voffA);
        if (wr == 1) PG8_BAR;
        PG8_WAIT_V(2); PG8_BAR;
        PG8_STAGE(PG8_SB(1, 0), cB + kstep, voffB); PG8_STAGE(PG8_SA(1, 0), cA + kstep, voffA); PG8_STAGE(PG8_SB(1, 1), cB + hstep + kstep, voffB);
        PG8_WAIT_V(6); PG8_BAR;
    } else {
        PG8_STAGE(PG8_SB(0, 0), cB, voffB); PG8_STAGE(PG8_SA(0, 0), cA, voffA); PG8_STAGE(PG8_SB(0, 1), cB + hstep, voffB); PG8_STAGE(PG8_SA(0, 1), cA + hstep, voffA);
        if (wr == 1) PG8_BAR;
        PG8_WAIT_V(4); PG8_BAR;
        PG8_STAGE(PG8_SB(1, 0), cB + kstep, voffB); PG8_STAGE(PG8_SA(1, 0), cA + kstep, voffA); PG8_STAGE(PG8_SB(1, 1), cB + hstep + kstep, voffB);
        PG8_WAIT_V(6); PG8_BAR;
    }
    for (;;) {
        const bool has_next = S.next(ui + 1, nxt);
        const char* nA = has_next ? (const char*)g.A + (size_t)nxt.pm * tstep : cA; const char* nB = has_next ? (const char*)g.Bt + (size_t)nxt.pn * tstep : cB;
#pragma unroll 1
        for (int t = 0; t < nt; t += 2) {
            const bool last = (t == nt - 2);
            const char* a1 = cA + (size_t)(t + 1) * kstep;
            const char* a2 = last ? nA : cA + (size_t)(t + 2) * kstep; const char* b2 = last ? nB : cB + (size_t)(t + 2) * kstep;
            const char* a3 = a2 + kstep; const char* b3 = b2 + kstep;
            if (last && has_next) S.a_ready(nxt);
            if constexpr (SP2) {
            PG8_LDB(B0, 0, 0); PG8_LDB(B1, 0, 1); PG8_SCHED; PG8_LDA(At, 0, 0); PG8_STAGE(PG8_SA(1, 1), a1 + hstep, voffA);
            PG8_WAIT_V(8); PG8_WAIT_L(0); PG8_BAR; PG8_MMA(0, 0, At, B0); PG8_MMA(0, 1, At, B1); PG8_BAR; PG8_SCHED;
            PG8_LDA(At, 0, 1); PG8_STAGE(PG8_SB(0, 0), b2, voffB); PG8_STAGE(PG8_SB(0, 1), b2 + hstep, voffB); PG8_STAGE(PG8_SA(0, 0), a2, voffA);
            PG8_WAIT_V(8); PG8_WAIT_L(0); PG8_BAR; PG8_MMA(1, 0, At, B0); PG8_MMA(1, 1, At, B1); PG8_BAR; PG8_SCHED;
            PG8_LDB(B0, 1, 0); PG8_LDB(B1, 1, 1); PG8_SCHED; PG8_LDA(At, 1, 0); PG8_STAGE(PG8_SA(0, 1), a2 + hstep, voffA);
            PG8_WAIT_V(8); PG8_WAIT_L(0); PG8_BAR; PG8_MMA(0, 0, At, B0); PG8_MMA(0, 1, At, B1); PG8_BAR; PG8_SCHED;
            PG8_LDA(At, 1, 1); PG8_STAGE(PG8_SB(1, 0), b3, voffB); PG8_STAGE(PG8_SB(1, 1), b3 + hstep, voffB); PG8_STAGE(PG8_SA(1, 0), a3, voffA);
            PG8_WAIT_V(8); PG8_WAIT_L(0); PG8_BAR; PG8_MMA(1, 0, At, B0); PG8_MMA(1, 1, At, B1); PG8_BAR; PG8_SCHED;
            } else {
            PG8_LDB(B0, 0, 0); PG8_SCHED; PG8_LDA(At, 0, 0); PG8_STAGE(PG8_SA(1, 1), a1 + hstep, voffA);
            PG8_WAIT_L(8); PG8_BAR; PG8_WAIT_L(0); PG8_MMA(0, 0, At, B0); PG8_BAR; PG8_SCHED;
            PG8_LDB(B1, 0, 1); PG8_STAGE(PG8_SB(0, 0), b2, voffB);
            PG8_BAR; PG8_WAIT_L(0); PG8_MMA(0, 1, At, B1); PG8_BAR;
            PG8_LDA(At, 0, 1); PG8_STAGE(PG8_SA(0, 0), a2, voffA);
            PG8_BAR; PG8_WAIT_L(0); PG8_MMA(1, 0, At, B0); PG8_BAR; PG8_SCHED;
            PG8_STAGE(PG8_SB(0, 1), b2 + hstep, voffB);
            PG8_WAIT_V(6); PG8_BAR; PG8_MMA(1, 1, At, B1); PG8_BAR;
            PG8_LDB(B0, 1, 0); PG8_SCHED; PG8_LDA(At, 1, 0); PG8_STAGE(PG8_SA(0, 1), a2 + hstep, voffA);
            PG8_WAIT_L(8); PG8_BAR; PG8_WAIT_L(0); PG8_MMA(0, 0, At, B0); PG8_BAR; PG8_SCHED;
            PG8_LDB(B1, 1, 1); PG8_STAGE(PG8_SB(1, 0), b3, voffB);
            PG8_BAR; PG8_WAIT_L(0); PG8_MMA(0, 1, At, B1); PG8_BAR;
            PG8_LDA(At, 1, 1); PG8_STAGE(PG8_SA(1, 0), a3, voffA);
            PG8_BAR; PG8_WAIT_L(0); PG8_MMA(1, 0, At, B0); PG8_BAR; PG8_SCHED;
            PG8_STAGE(PG8_SB(1, 1), b3 + hstep, voffB);
            PG8_WAIT_V(6); PG8_BAR; PG8_MMA(1, 1, At, B1); PG8_BAR;
            }
        }
        if constexpr (ALIGN_EPI) { if (wr == 0) PG8_BAR; }
        E(acc, cur, wr, wc, fr, fq);
        if (!has_next) break;
#pragma unroll
        for (int a = 0; a < 2; ++a)
#pragma unroll
            for (int b = 0; b < 2; ++b)
#pragma unroll
                for (int m = 0; m < 4; ++m)
#pragma unroll
                    for (int n = 0; n < 2; ++n) acc[a][b][m][n] = (f32x4){0.f, 0.f, 0.f, 0.f};
        cur = nxt; cA = nA; cB = nB; ++ui;
        if constexpr (ALIGN_EPI) { if (wr == 1) PG8_BAR; }
    }
    PG8_WAIT_V(0);
    if constexpr (!ALIGN_EPI) { if (wr == 0) PG8_BAR; }
    PG8_BAR;
#undef PG8_SA
#undef PG8_SB
#undef PG8_STAGE
#undef PG8_LDA
#undef PG8_LDB
#undef PG8_MMA
#undef PG8_WAIT_V
#undef PG8_WAIT_L
#undef PG8_BAR
#undef PG8_SCHED
}
}

typedef int i32x4q __attribute__((ext_vector_type(4)));
struct EpiPtrs {
    const GAS float* biasp; const GAS float* lb; const GAS float* x; GAS float* out; GAS unsigned char* ws; int round;
    int pn0;
    const GAS float* sa; const GAS float* sb; const GAS float* sym; const GAS float* syg; const GAS float* sxq;
};
__device__ __forceinline__ GAS unsigned char* sag_ptr(GAS float* out, int round) { return (GAS unsigned char*)out + (size_t)T * 2048 + (size_t)(1 - round) * RT * 2048; }
template <int MODE> struct EpiX {
    static constexpr bool PERM = true, AFTER_DRAIN = false;
    EpiPtrs P;
    __device__ __forceinline__ void operator()(const f32x4 (&acc)[2][2][4][2], const pg8::Unit& u, int wr, int wc, int fr, int fq) const {
        const int upn = u.pn + (MODE == 2 ? P.pn0 : 0);
        const int row0 = u.pm * 256 + wr * 64 + fr;
        const int colt = upn * 256 + wc * 32 + 8 * fq;
        GAS unsigned char* ws = P.ws;
        bf16_t* dst = nullptr; int ld = 0, coff = 0, act = 0; const GAS float* bias = nullptr;
        if (MODE == 1 || MODE == 7) {
            bias = P.biasp;
            if (upn < 8) { dst = (bf16_t*)(ws + WS_QKPRE); ld = 2048; coff = 0; act = 0; }
            else if (upn < 16) { dst = (bf16_t*)(ws + WS_V); ld = 2048; coff = 2048; act = 0; }
            else if (upn < 20) { dst = (bf16_t*)(ws + WS_GFLOG); ld = 1024; coff = 4096; act = 3; }
            else if (upn < 24) { dst = (bf16_t*)(ws + WS_GI); ld = 1024; coff = 5120; act = 0; }
            else { dst = (bf16_t*)(ws + WS_GQ); ld = 1024; coff = 6144; act = 2; }
        } else if (MODE == 2) {
            bias = P.biasp + N1;
            if (upn < 8) { dst = (bf16_t*)(ws + WS_SIGO); ld = 2048; coff = 0; act = 1; }
            else if (upn < 12) { dst = (bf16_t*)(ws + WS_SGG); ld = 1024; coff = 2048; act = 2; }
            else if (upn < 16) { dst = (bf16_t*)(ws + WS_SAM); ld = 1024; coff = 3072; act = 1; }
            else { dst = (bf16_t*)sag_ptr(P.out, P.round); ld = 1024; coff = 4096; act = 1; }
        } else if (MODE == 6) { dst = (bf16_t*)(ws + WS_QP); ld = 2048; coff = 0; act = 0; }
        float sr8[2][4];
#pragma unroll
        for (int ai = 0; ai < 2; ++ai)
#pragma unroll
            for (int m = 0; m < 4; ++m) { const int row = row0 + ai * 128 + m * 16;
                sr8[ai][m] = (MODE == 3) ? P.sym[row] * (1.0f / 255.0f) : (MODE == 4) ? P.syg[row] * (1.0f / 255.0f) : (MODE == 6) ? P.sxq[row] : (MODE == 2 || MODE == 7) ? P.sa[(size_t)P.round * RT + row] : 1.0f; }
        constexpr bool HOISTC = (MODE == 2 || MODE == 6 || MODE == 7);
        constexpr int SBO = (MODE == 2) ? 7168 : (MODE == 3) ? 12288 : (MODE == 4) ? 13312 : (MODE == 6) ? 14336 : 0;
        f32x4 cb0[2], cb1[2], cs0[2], cs1[2];
        if (HOISTC) {
#pragma unroll
            for (int bj = 0; bj < 2; ++bj) {
                const int col = colt + bj * 128;
                cb0[bj] = (f32x4){0.f, 0.f, 0.f, 0.f}; cb1[bj] = cb0[bj];
                if (MODE == 2 || MODE == 7) { cb0[bj] = *(const f32x4*)(bias + col); cb1[bj] = *(const f32x4*)(bias + col + 4); }
                cs0[bj] = *(const GAS f32x4*)(P.sb + SBO + col); cs1[bj] = *(const GAS f32x4*)(P.sb + SBO + col + 4);
            }
        }
        f32x4 cl0[2], cl1[2];
        cl0[0] = (f32x4){0.f, 0.f, 0.f, 0.f}; cl0[1] = cl0[0]; cl1[0] = cl0[0]; cl1[1] = cl0[0];
        if (MODE == 7) { if (act == 3) {
#pragma unroll
            for (int bj = 0; bj < 2; ++bj) { cl0[bj] = *(const f32x4*)(P.lb + (colt + bj * 128 - coff)); cl1[bj] = *(const f32x4*)(P.lb + (colt + bj * 128 - coff) + 4); } } }
#pragma unroll
        for (int bj = 0; bj < 2; ++bj) {
            const int col = colt + bj * 128;
            f32x4 b0 = (f32x4){0.f, 0.f, 0.f, 0.f}, b1 = b0, l0 = b0, l1 = b0, s0 = (f32x4){1.f, 1.f, 1.f, 1.f}, s1 = s0;
            if (HOISTC) { b0 = cb0[bj]; b1 = cb1[bj]; s0 = cs0[bj]; s1 = cs1[bj]; }
            if (MODE == 2) { const float am = (act == 1) ? -1.4426950409f : 1.0f; s0 *= am; s1 *= am; b0 *= am; b1 *= am; }
            if (MODE == 7) { const float am = (act == 3) ? -1.4426950409f : 1.0f; s0 *= am; s1 *= am; b0 *= am; b1 *= am; }
            else {
                if (MODE == 1) { b0 = *(const f32x4*)(bias + col); b1 = *(const f32x4*)(bias + col + 4); }
                if (MODE == 3 || MODE == 4) { s0 = *(const GAS f32x4*)(P.sb + SBO + col); s1 = *(const GAS f32x4*)(P.sb + SBO + col + 4); }
            }
            if (MODE == 7) { l0 = cl0[bj]; l1 = cl1[bj]; }
            const f32x4 lm0 = 1.0f - l0, lm1 = 1.0f - l1;
            if (MODE == 1) { if (act == 3) { l0 = *(const f32x4*)(P.lb + (col - coff)); l1 = *(const f32x4*)(P.lb + (col - coff) + 4); } }
#pragma unroll
            for (int ai = 0; ai < 2; ++ai) {
                u32x4 gpre[4], zpre[4]; f32x4 xpre[4][2];
#pragma unroll
                for (int m = 0; m < 4; ++m) { const int row = row0 + ai * 128 + m * 16;
                    if (MODE == 3) { const u32x2 g8 = *(const GAS u32x2*)(ws + WS_SAM + (size_t)row * 1024 + col); gpre[m].x = g8.x; gpre[m].y = g8.y; }
                    if (MODE == 4) { { const u32x2 g8 = *(const GAS u32x2*)(sag_ptr(P.out, P.round) + (size_t)row * 1024 + col); gpre[m].x = g8.x; gpre[m].y = g8.y; }
                                     zpre[m] = *(const GAS u32x4*)((const GAS bf16_t*)P.out + (size_t)T * 1024 + ((size_t)P.round * RT + row) * 1024 + col); }
                    if (MODE == 5) { const size_t off = ((size_t)P.round * RT + row) * 1024 + col; xpre[m][0] = *(const GAS f32x4*)(P.x + off); xpre[m][1] = *(const GAS f32x4*)(P.x + off + 4); } }
#pragma unroll
                for (int m = 0; m < 4; ++m) {
                    const int row = row0 + ai * 128 + m * 16;
                    f32x4 v0, v1;
                    if (MODE == 2 || MODE == 7 || MODE == 3 || MODE == 4 || MODE == 6) { const float sr = sr8[ai][m]; const i32x4q q0 = __builtin_bit_cast(i32x4q, acc[ai][bj][m][0]), q1 = __builtin_bit_cast(i32x4q, acc[ai][bj][m][1]);
                        v0 = (f32x4){(float)q0[0], (float)q0[1], (float)q0[2], (float)q0[3]} * (s0 * sr) + b0; v1 = (f32x4){(float)q1[0], (float)q1[1], (float)q1[2], (float)q1[3]} * (s1 * sr) + b1; }
                    else { v0 = acc[ai][bj][m][0] + b0; v1 = acc[ai][bj][m][1] + b1; }
                    if (MODE == 1 || MODE == 2 || MODE == 6 || MODE == 7) {
                        if (act == 1) {
                            if (MODE == 2) {
#pragma unroll
                                for (int j = 0; j < 4; ++j) { v0[j] = __builtin_amdgcn_rcpf(__builtin_fmaf(__builtin_amdgcn_exp2f(v0[j]), 1.0f / 255.0f, 1.0f / 255.0f)); v1[j] = __builtin_amdgcn_rcpf(__builtin_fmaf(__builtin_amdgcn_exp2f(v1[j]), 1.0f / 255.0f, 1.0f / 255.0f)); }
                            } else {
#pragma unroll
                                for (int j = 0; j < 4; ++j) { v0[j] = sigmoidf_(v0[j]); v1[j] = sigmoidf_(v1[j]); }
                            }
                        } else if (act == 2) {
#pragma unroll
                            for (int j = 0; j < 4; ++j) { v0[j] = siluf_(v0[j]); v1[j] = siluf_(v1[j]); }
                        } else if (act == 3) {
#pragma unroll
                            for (int j = 0; j < 4; ++j) { v0[j] = __builtin_amdgcn_logf(l0[j] + lm0[j] * __builtin_amdgcn_rcpf(1.0f + __builtin_amdgcn_exp2f(v0[j]))) * 0.6931471806f; v1[j] = __builtin_amdgcn_logf(l1[j] + lm1[j] * __builtin_amdgcn_rcpf(1.0f + __builtin_amdgcn_exp2f(v1[j]))) * 0.6931471806f; }
                        }
                        if (MODE == 2 && act == 1) { u32x2 w8; w8.x = pack_u8x4r(v0[0], v0[1], v0[2], v0[3]); w8.y = pack_u8x4r(v1[0], v1[1], v1[2], v1[3]);
                            *(GAS u32x2*)((GAS unsigned char*)dst + (size_t)row * ld + (col - coff)) = w8; }
                        else {
                        u32x4 w; w.x = pk2(v0[0], v0[1]); w.y = pk2(v0[2], v0[3]); w.z = pk2(v1[0], v1[1]); w.w = pk2(v1[2], v1[3]);
                        *(u32x4*)(dst + (size_t)row * ld + (col - coff)) = w; }
                    } else if (MODE == 3) {
                        const u32x4 g = gpre[m];
                        GAS bf16_t* o = (GAS bf16_t*)P.out + (size_t)T * 1024 + ((size_t)P.round * RT + row) * 1024 + col;
                        f32x4 r0, r1;
                        r0[0] = v0[0] * u8r(g.x, 0); r0[1] = v0[1] * u8r(g.x, 1); r0[2] = v0[2] * u8r(g.x, 2); r0[3] = v0[3] * u8r(g.x, 3);
                        r1[0] = v1[0] * u8r(g.y, 0); r1[1] = v1[1] * u8r(g.y, 1); r1[2] = v1[2] * u8r(g.y, 2); r1[3] = v1[3] * u8r(g.y, 3);
                        u32x4 w; w.x = pk2(r0[0], r0[1]); w.y = pk2(r0[2], r0[3]); w.z = pk2(r1[0], r1[1]); w.w = pk2(r1[2], r1[3]);
                        *(GAS u32x4*)o = w;
                    } else if (MODE == 4) {
                        const u32x4 g = gpre[m], zv = zpre[m];
                        const f32x4 p0 = (f32x4){bf_lo(zv.x), bf_hi(zv.x), bf_lo(zv.y), bf_hi(zv.y)}, p1 = (f32x4){bf_lo(zv.z), bf_hi(zv.z), bf_lo(zv.w), bf_hi(zv.w)};
                        f32x4 r0, r1;
                        r0[0] = p0[0] + v0[0] * u8r(g.x, 0); r0[1] = p0[1] + v0[1] * u8r(g.x, 1); r0[2] = p0[2] + v0[2] * u8r(g.x, 2); r0[3] = p0[3] + v0[3] * u8r(g.x, 3);
                        r1[0] = p1[0] + v1[0] * u8r(g.y, 0); r1[1] = p1[1] + v1[1] * u8r(g.y, 1); r1[2] = p1[2] + v1[2] * u8r(g.y, 2); r1[3] = p1[3] + v1[3] * u8r(g.y, 3);
                        u32x4 w; w.x = pk2(r0[0], r0[1]); w.y = pk2(r0[2], r0[3]); w.z = pk2(r1[0], r1[1]); w.w = pk2(r1[2], r1[3]);
                        *(u32x4*)((bf16_t*)(ws + WS_GFLOG) + (size_t)row * 1024 + col) = w;
                    } else if (MODE == 5) {
                        const size_t off = ((size_t)P.round * RT + row) * 1024 + col;
                        const f32x4 x0 = xpre[m][0] + v0, x1 = xpre[m][1] + v1;
                        u32x4 w; w.x = pk2(x0[0], x0[1]); w.y = pk2(x0[2], x0[3]); w.z = pk2(x1[0], x1[1]); w.w = pk2(x1[2], x1[3]);
                        *(GAS u32x4*)((GAS bf16_t*)P.out + off) = w;
                    }
                }
            }
        }
    }
};

__device__ __forceinline__ void p0_transpose_item(const GAS float* W, int ldw, int K, int k0, int scol, GAS bf16_t* WT, int drow, LAS float* scr, int lane) {
#pragma unroll 8
    for (int i = 0; i < 32; ++i) { const int kk = 2 * i + (lane >> 5); scr[kk * 33 + (lane & 31)] = W[(size_t)(k0 + kk) * ldw + scol + (lane & 31)]; }
    LDS_WAIT(); asm volatile("" ::: "memory");
    const int c = lane & 7;
#pragma unroll
    for (int j = 0; j < 4; ++j) { const int n = (lane >> 3) + 8 * j; const LAS float* s = scr + (8 * c) * 33 + n;
        u32x4 o; o.x = pk2(s[0 * 33], s[1 * 33]); o.y = pk2(s[2 * 33], s[3 * 33]); o.z = pk2(s[4 * 33], s[5 * 33]); o.w = pk2(s[6 * 33], s[7 * 33]);
        *(u32x4*)(WT + (size_t)(drow + n) * K + k0 + 8 * c) = o; }
    LDS_WAIT(); asm volatile("" ::: "memory");
}
__device__ __forceinline__ void p0_colmax_item(const GAS float* W, int ldw, int k0, int scol, GAS unsigned* colmax, int lane) {
    float mx = 0.f;
#pragma unroll 8
    for (int i = 0; i < 32; ++i) { const int kk = 2 * i + (lane >> 5); mx = fmaxf(mx, fabsf(W[(size_t)(k0 + kk) * ldw + scol + (lane & 31)])); }
    mx = fmaxf(mx, __builtin_bit_cast(float, xor32u_(__builtin_bit_cast(unsigned, mx), lane >= 32)));
    if (lane < 32) atomicMax((unsigned*)colmax + lane, __builtin_bit_cast(unsigned, mx));
}
__device__ __forceinline__ void p0_cvt8_item(const GAS float* W, int ldw, int k0, int scol, const GAS unsigned* colmax, GAS unsigned char* WT8, int pitch, GAS float* sb, int drow, LAS float* scr, int lane) {
    const float cm = __builtin_bit_cast(float, colmax[lane & 31]);
    const float qs = cm > 0.f ? 127.0f / cm : 0.f;
    if (k0 == 0 && lane < 32) sb[lane] = cm * (1.0f / 127.0f);
#pragma unroll 8
    for (int i = 0; i < 32; ++i) { const int kk = 2 * i + (lane >> 5); scr[kk * 33 + (lane & 31)] = W[(size_t)(k0 + kk) * ldw + scol + (lane & 31)] * qs; }
    LDS_WAIT(); asm volatile("" ::: "memory");
    const int n = lane >> 1, kh = lane & 1;
    const LAS float* sp = scr + (kh * 32) * 33 + n;
    u32x4 o0, o1;
#pragma unroll
    for (int q = 0; q < 8; ++q) { const unsigned p = pack_i8x4(sp[(4 * q) * 33], sp[(4 * q + 1) * 33], sp[(4 * q + 2) * 33], sp[(4 * q + 3) * 33]);
        if (q < 4) o0[q] = p; else o1[q - 4] = p; }
    GAS unsigned char* dst = WT8 + (size_t)(drow + n) * pitch + k0 + kh * 32;
    *(GAS u32x4*)dst = o0; *(GAS u32x4*)(dst + 16) = o1;
    LDS_WAIT(); asm volatile("" ::: "memory");
}
__device__ __forceinline__ int win_src_col(int n) {
    if (n < 4096) return n;
    if (n < 7168) return n - 4096 + 6152;
    if (n < 9216) return n - 7168 + 4096;
    return n - 9216 + 9224;
}

__device__ __forceinline__ void phase_p0(const DArgs& a, LAS unsigned char* lds, int vcu, int G) {
    const int tid = tid_(), lane = tid & 63, wave = tid >> 6;
    const int gw = vcu * NWAVES + wave, NGW = G * NWAVES;
    GAS unsigned char* ws = a.ws;
    LAS float* scr = (LAS float*)(lds + wave * 16384);
    constexpr int I_IN = 16 * 384, I_M = 32 * 32, I_G = 16 * 32, I_O = 16 * 32, I_PQ = 16 * 64;
    constexpr int NITEMS = I_IN + I_M + I_G + I_O + I_PQ;
    for (int it = gw; it < NITEMS; it += NGW) {
        int r = it;
        if (r < I_IN) { const int kb = r / 384, nb = r % 384;
            p0_colmax_item(a.w_in, IN_COLS, kb * 64, win_src_col(nb * 32), (GAS unsigned*)(ws + WS_CTL) + CW_COLMAX + nb * 32, lane);
            continue; } r -= I_IN;
        if (r < I_M) { const int kb = r / 32, nb = r % 32; p0_colmax_item(a.w_br_m, 1024, kb * 64, nb * 32, (GAS unsigned*)(ws + WS_CTL) + CW_COLMAX + 12288 + nb * 32, lane); continue; } r -= I_M;
        if (r < I_G) { const int kb = r / 32, nb = r % 32; p0_colmax_item(a.w_br_g, 1024, kb * 64, nb * 32, (GAS unsigned*)(ws + WS_CTL) + CW_COLMAX + 13312 + nb * 32, lane); continue; } r -= I_G;
        if (r < I_O) { const int kb = r / 32, nb = r % 32; p0_transpose_item(a.w_out, 1024, 1024, kb * 64, nb * 32, (GAS bf16_t*)(ws + WS_WO), nb * 32, scr, lane); continue; } r -= I_O;
        { const int kb = r / 64, nb = r % 64; p0_colmax_item(a.w_pq, 2048, kb * 64, nb * 32, (GAS unsigned*)(ws + WS_CTL) + CW_COLMAX + 14336 + nb * 32, lane); }
    }
    const int gt = vcu * NTHR + tid, NGT = G * NTHR;
    for (int i = gt; i < NP; i += NGT) ((float*)(ws + WS_BIASP))[i] = a.b_in[win_src_col(i)];
    for (int i = gt; i < 1024; i += NGT) { const float t0 = a.lb_table[i], t1 = a.lb_table[1024 + i]; ((float*)(ws + WS_LB))[i] = 1.0f / (1.0f + __expf(t1 - t0)); }
    for (int i = gt; i < 8 * 2 * 128 * 128 / 4; i += NGT) { const f32x4 v = ((const f32x4*)a.sub_keys)[i]; u32x2 o; o.x = pk2(v[0], v[1]); o.y = pk2(v[2], v[3]); ((u32x2*)(ws + WS_SK))[i] = o; }
    f32x4 g1[4];
#pragma unroll
    for (int j = 0; j < 4; ++j) g1[j] = ((const GAS f32x4*)a.norm1_g)[64 * j + lane];
    f32x4 gw0[16], gw1[16];
#pragma unroll
    for (int j = 0; j < 4; ++j)
#pragma unroll
        for (int e = 0; e < 4; ++e) { const int k = 256 * j + 4 * lane + e; gw0[4 * j + e] = *(const GAS f32x4*)(a.w_in + (size_t)k * IN_COLS + 6144); gw1[4 * j + e] = *(const GAS f32x4*)(a.w_in + (size_t)k * IN_COLS + 6148); }
    const float gbias = lane < 8 ? a.b_in[6144 + lane] : 0.f;
    for (int m = gw; m < T; m += NGW) {
        const GAS f32x4* xr = (const GAS f32x4*)(a.x + (size_t)m * D) + lane;
        f32x4 v[4]; float s = 0.f;
#pragma unroll
        for (int j = 0; j < 4; ++j) { v[j] = xr[64 * j]; s += (v[j][0] * v[j][0] + v[j][1] * v[j][1]) + (v[j][2] * v[j][2] + v[j][3] * v[j][3]); }
        const float rstd = rsqrtf(wave_sum(s, lane) * (1.f / D) + EPS);
        f32x4 ga0 = (f32x4){0.f, 0.f, 0.f, 0.f}, ga1 = ga0;
        float mx = 0.f;
#pragma unroll
        for (int j = 0; j < 4; ++j) {
            v[j] = v[j] * rstd * g1[j];
            mx = fmaxf(mx, fmaxf(fmaxf(fabsf(v[j][0]), fabsf(v[j][1])), fmaxf(fabsf(v[j][2]), fabsf(v[j][3]))));
#pragma unroll
            for (int e = 0; e < 4; ++e) { ga0 += gw0[4 * j + e] * v[j][e]; ga1 += gw1[4 * j + e] * v[j][e]; }
        }
        {
            mx = wave_max(mx);
            const float qs = mx > 0.f ? 127.0f / mx : 0.f;
#pragma unroll
            for (int jq = 0; jq < 4; ++jq) ((GAS unsigned*)(ws + WS_XN8 + (size_t)m * 1024))[64 * jq + lane] = pack_i8x4(v[jq][0] * qs, v[jq][1] * qs, v[jq][2] * qs, v[jq][3] * qs);
            if (lane == 0) ((GAS float*)(ws + WS_SA8))[m] = mx * (1.0f / 127.0f);
        }
        float ga[8] = {ga0[0], ga0[1], ga0[2], ga0[3], ga1[0], ga1[1], ga1[2], ga1[3]};
#pragma unroll
        for (int q = 0; q < 8; ++q) ga[q] = wave_sum(ga[q], lane);
        if (lane < 8) { float r = ga[0];
#pragma unroll
            for (int q = 1; q < 8; ++q) r = (lane == q) ? ga[q] : r;
            ((GAS float*)(ws + WS_GATES))[(size_t)m * 8 + lane] = r + gbias; }
    }
}

__device__ __forceinline__ float logsigf_(float x) { return fminf(x, 0.f) - log1pf(__expf(-fabsf(x))); }
#define LDS_BAR() do { asm volatile("s_waitcnt lgkmcnt(0)" ::: "memory"); __builtin_amdgcn_s_barrier(); asm volatile("" ::: "memory"); } while (0)
#define MFMA16(a, b, c) __builtin_amdgcn_mfma_f32_16x16x32_bf16((a), (b), (c), 0, 0, 0)
__device__ __forceinline__ bf16x8 lfrag(const LAS unsigned char* base, int pitch, int row, int k0, int fq) { return *(const LAS bf16x8*)(base + row * pitch + (k0 + 8 * fq) * 2); }
__device__ __forceinline__ int fm_off(int r, int k, int KB) { return (((r >> 4) * KB + (k >> 5)) << 10) + (((((k >> 3) & 3) << 4) + (r & 15)) << 4) + ((k & 7) << 1); }
__device__ __forceinline__ int fm8_off(int r, int k, int KP) { return (((r >> 4) * KP + (k >> 6)) << 10) + (((((k >> 3) & 3) << 4) + (r & 15)) << 4) + (((k >> 5) & 1) << 3) + (k & 7); }
__device__ __forceinline__ unsigned pack_fp8x4(float a, float b, float c, float d) { int p = __builtin_amdgcn_cvt_pk_fp8_f32(a, b, 0, false); p = __builtin_amdgcn_cvt_pk_fp8_f32(c, d, p, true); return (unsigned)p; }
__device__ __forceinline__ bf16x8 fp8_frag(unsigned a, unsigned b, float sc) {
    typedef __bf16 bf16x2n_ __attribute__((ext_vector_type(2)));
    u32x4 o;
    o.x = __builtin_bit_cast(unsigned, (bf16x2n_)__builtin_amdgcn_cvt_scalef32_pk_bf16_fp8(a, sc, false)); o.y = __builtin_bit_cast(unsigned, (bf16x2n_)__builtin_amdgcn_cvt_scalef32_pk_bf16_fp8(a, sc, true));
    o.z = __builtin_bit_cast(unsigned, (bf16x2n_)__builtin_amdgcn_cvt_scalef32_pk_bf16_fp8(b, sc, false)); o.w = __builtin_bit_cast(unsigned, (bf16x2n_)__builtin_amdgcn_cvt_scalef32_pk_bf16_fp8(b, sc, true));
    return __builtin_bit_cast(bf16x8, o);
}
constexpr float MS_SQ = 64.0f, MS_K = 8.0f;
__device__ __forceinline__ bf16x8 gfrag(const bf16_t* base, int ld, int row, int k0, int fq) { return *(const bf16x8*)(base + (size_t)row * ld + k0 + 8 * fq); }

__device__ __forceinline__ void phase_p0c(const DArgs& a, LAS unsigned char* lds, int vcu, int G) {
    const int tid = tid_(), lane = tid & 63, wave = tid >> 6;
    const int gw = vcu * NWAVES + wave, NGW = G * NWAVES;
    GAS unsigned char* ws = a.ws;
    LAS float* scr = (LAS float*)(lds + wave * 16384);
    constexpr int J_IN = 16 * 384, J_M = 32 * 32, J_G = 16 * 32, J_PQ = 16 * 64;
    const GAS unsigned* cmx = (const GAS unsigned*)(ws + WS_CTL) + CW_COLMAX; GAS float* sb = (GAS float*)(ws + WS_SB8);
    for (int it = gw; it < J_IN + J_M + J_G + J_PQ; it += NGW) {
        int r = it;
        if (r < J_IN) { const int kb = r / 384, nb = r % 384;
            p0_cvt8_item(a.w_in, IN_COLS, kb * 64, win_src_col(nb * 32), cmx + nb * 32, ws + WS_W8A, 1024, sb + nb * 32, nb * 32, scr, lane); continue; } r -= J_IN;
        if (r < J_M) { const int kb = r / 32, nb = r % 32; p0_cvt8_item(a.w_br_m, 1024, kb * 64, nb * 32, cmx + 12288 + nb * 32, ws + WS_WM, 2048, sb + 12288 + nb * 32, nb * 32, scr, lane); continue; } r -= J_M;
        if (r < J_G) { const int kb = r / 32, nb = r % 32; p0_cvt8_item(a.w_br_g, 1024, kb * 64, nb * 32, cmx + 13312 + nb * 32, ws + WS_WG, 1024, sb + 13312 + nb * 32, nb * 32, scr, lane); continue; } r -= J_G;
        { const int kb = r / 64, nb = r % 64; p0_cvt8_item(a.w_pq, 2048, kb * 64, nb * 32, cmx + 14336 + nb * 32, ws + WS_WPQ, 1024, sb + 14336 + nb * 32, nb * 32, scr, lane); }
    }
}
__device__ __forceinline__ void mscan_pair(const DArgs& a, LAS unsigned char* lds, int round, int p) {
    const int tid = tid_(), lane = tid & 63, part = tid >> 6;
    const int bl = p >> 2, h = p & 3, b = round * 2 + bl;
    const GAS float* g = (const GAS float*)(a.ws + WS_GATES) + ((size_t)b * SEQ + (size_t)lane * 128 + part * 16) * 8;
    float bsum = 0.f, gm = -INFINITY;
#pragma unroll 4
    for (int s = 0; s < 16; ++s) { const float ip = g[s * 8 + h], fp = g[s * 8 + 4 + h]; bsum += logsigf_(fp); gm = fmaxf(gm, ip - bsum); }
    LAS float* PS = (LAS float*)lds; LAS float* PM = PS + 512;
    PS[part * 64 + lane] = bsum; PM[part * 64 + lane] = gm;
    __syncthreads();
    if (tid < 64) {
        float bs = 0.f, g2 = -INFINITY;
#pragma unroll
        for (int q = 0; q < 8; ++q) { g2 = fmaxf(g2, PM[q * 64 + lane] - bs); bs += PS[q * 64 + lane]; }
        float mprev = 0.f, mine = 0.f;
        for (int c = 0; c < 64; ++c) {
            const float bc = rdlane(bs, c), gc = rdlane(g2, c);
            if (lane == c) mine = mprev; mprev = bc + fmaxf(mprev, gc); }
        ((GAS float*)(a.ws + WS_MPREV))[(round * 8 + p) * 64 + lane] = mine;
    }
    __syncthreads();
}

constexpr int PQ_PITCH = 528, PS_PITCH = 272;
__device__ __forceinline__ void mlstm_pre_item(const DArgs& a, LAS unsigned char* lds, int round, int item) {
    const int tid = tid_(), lane = tid & 63, wave = __builtin_amdgcn_readfirstlane(tid >> 6), fr = lane & 15, fq = lane >> 4;
    const int p = item >> 6, c = item & 63, bl = p >> 2, h = p & 3, b = round * 2 + bl;
    const int tl0 = bl * SEQ + c * 128; const size_t tg0 = (size_t)b * SEQ + c * 128;
    GAS unsigned char* ws = a.ws;
    LAS unsigned char* QL = lds; LAS unsigned char* KL = lds + 67584;
    LAS float* AS = (LAS float*)(lds + 135168); LAS float* MS = AS + 128; LAS float* SC = AS + 256;
    if (wave == 0) {
        const float mprev = ((const float*)(ws + WS_MPREV))[(round * 8 + p) * 64 + c];
        const float* g = (const float*)(ws + WS_GATES) + (tg0 + 2 * lane) * 8;
        const float ip0 = g[h], fp0 = g[4 + h], ip1 = g[8 + h], fp1 = g[12 + h];
        const float lf0 = logsigf_(fp0), lf1 = logsigf_(fp1), pp = lf0 + lf1;
        float incl = pp;
#pragma unroll
        for (int o = 1; o < 64; o <<= 1) { const float t = shup(incl, o, lane); if (lane >= o) incl += t; }
        const float excl = incl - pp, b0 = excl + lf0, b1 = incl;
        const float a0 = ip0 - b0, a1 = ip1 - b1;
        float inclm = fmaxf(a0, a1);
#pragma unroll
        for (int o = 1; o < 64; o <<= 1) { const float t = shup(inclm, o, lane); if (lane >= o) inclm = fmaxf(inclm, t); }
        float exclm = shup(inclm, 1, lane); if (lane == 0) exclm = -INFINITY;
        const float M0 = fmaxf(mprev, fmaxf(exclm, a0)), M1 = fmaxf(mprev, inclm);
        AS[2 * lane] = a0; AS[2 * lane + 1] = a1; MS[2 * lane] = M0; MS[2 * lane + 1] = M1;
        float* mt = (float*)(ws + WS_MT) + (tg0 + 2 * lane) * 4 + h;
        mt[0] = b0 + M0; mt[4] = b1 + M1;
        const float Mlast = rdlane(M1, 63);
        if (lane == 0) { SC[0] = mprev; SC[1] = Mlast; ((float*)(ws + WS_MDEC))[item] = __expf(mprev - Mlast); }
    }
    {
        const int cgp = tid & 63, strip = tid >> 6;
        const int col = (cgp < 32) ? (h * 256 + cgp * 8) : (1024 + h * 256 + (cgp - 32) * 8);
        float w[4][8], bb[8];
#pragma unroll
        for (int j = 0; j < 4; ++j) { const f32x4 w0 = *(const f32x4*)(a.conv_w + j * 2048 + col), w1 = *(const f32x4*)(a.conv_w + j * 2048 + col + 4);
#pragma unroll
            for (int e = 0; e < 4; ++e) { w[j][e] = w0[e]; w[j][4 + e] = w1[e]; } }
        { const f32x4 b0 = *(const f32x4*)(a.conv_b + col), b1 = *(const f32x4*)(a.conv_b + col + 4);
#pragma unroll
            for (int e = 0; e < 4; ++e) { bb[e] = b0[e]; bb[4 + e] = b1[e]; } }
        const bf16_t* src = (const bf16_t*)(ws + WS_QKPRE) + (size_t)(tl0 + 16 * strip) * 2048 + col;
        const float qs = (cgp < 32) ? 0.0625f : 1.0f;
        LAS unsigned char* dstt = ((cgp < 32) ? QL : KL) + (cgp & 31) * 16;
#pragma unroll 1
        for (int half = 0; half < 2; ++half) {
            u32x4 xr[11];
#pragma unroll
            for (int r = 0; r < 11; ++r) {
                const int sl = c * 128 + 16 * strip + 8 * half + r - 3;
                xr[r] = (sl >= 0) ? *(const u32x4*)(src + (ptrdiff_t)(8 * half + r - 3) * 2048) : (u32x4){0u, 0u, 0u, 0u};
            }
#pragma unroll
            for (int r = 0; r < 8; ++r) {
                float y[8];
#pragma unroll
                for (int e = 0; e < 8; ++e) y[e] = bb[e];
#pragma unroll
                for (int j = 0; j < 4; ++j) { const u32x4 xv = xr[r + j];
                    y[0] += w[j][0] * bf_lo(xv.x); y[1] += w[j][1] * bf_hi(xv.x); y[2] += w[j][2] * bf_lo(xv.y); y[3] += w[j][3] * bf_hi(xv.y);
                    y[4] += w[j][4] * bf_lo(xv.z); y[5] += w[j][5] * bf_hi(xv.z); y[6] += w[j][6] * bf_lo(xv.w); y[7] += w[j][7] * bf_hi(xv.w); }
#pragma unroll
                for (int e = 0; e < 8; ++e) y[e] = siluf_(y[e]) * qs;
                u32x4 o; o.x = pk2(y[0], y[1]); o.y = pk2(y[2], y[3]); o.z = pk2(y[4], y[5]); o.w = pk2(y[6], y[7]);
                *(LAS u32x4*)(dstt + (16 * strip + 8 * half + r) * PQ_PITCH) = o;
            }
        }
    }
    __syncthreads();
    const float mprev = SC[0], Mlast = SC[1];
    {
        GAS unsigned char* Sg = ws + WS_S + (size_t)item * 16384;
        const int t = wave * 16 + fr; const float Mt = MS[t];
        for (int st = 0; st < 8; ++st) {
            unsigned o = 0u;
            if (st <= wave) {
                f32x4 acc = (f32x4){0.f, 0.f, 0.f, 0.f};
#pragma unroll
                for (int ks = 0; ks < 8; ++ks) acc = MFMA16(lfrag(KL, PQ_PITCH, st * 16 + fr, ks * 32, fq), lfrag(QL, PQ_PITCH, wave * 16 + fr, ks * 32, fq), acc);
                float v[4];
#pragma unroll
                for (int j = 0; j < 4; ++j) { const int s = st * 16 + 4 * fq + j; v[j] = (s <= t) ? acc[j] * __expf(AS[s] - Mt) : 0.f; }
                o = pack_fp8x4(fmaxf(fminf(v[0] * MS_SQ, 448.0f), -448.0f), fmaxf(fminf(v[1] * MS_SQ, 448.0f), -448.0f), fmaxf(fminf(v[2] * MS_SQ, 448.0f), -448.0f), fmaxf(fminf(v[3] * MS_SQ, 448.0f), -448.0f));
            }
            *(GAS unsigned*)(Sg + fm8_off(t, st * 16 + 4 * fq, 2)) = o;
        }
    }
    {
        GAS unsigned char* Qg = ws + WS_QT + (size_t)item * 32768;
#pragma unroll
        for (int i = 0; i < 8; ++i) { const int idx = tid + 512 * i, blk = idx >> 6, t = (blk >> 3) * 16 + (idx & 15), ch = (blk & 7) * 4 + ((idx >> 4) & 3);
            const u32x4 v = *(const LAS u32x4*)(QL + t * PQ_PITCH + ch * 16); const float s = __expf(mprev - MS[t]) * MS_SQ;
            u32x2 o; o.x = pack_fp8x4(bf_lo(v.x) * s, bf_hi(v.x) * s, bf_lo(v.y) * s, bf_hi(v.y) * s); o.y = pack_fp8x4(bf_lo(v.z) * s, bf_hi(v.z) * s, bf_lo(v.w) * s, bf_hi(v.w) * s);
            *(GAS u32x2*)(Qg + fm8_off(t, ch * 8, 4)) = o; }
    }
    {
        GAS unsigned char* Kg = ws + WS_KWT + (size_t)item * 32768;
        const int dlo = lane & 15, sglo = lane >> 4;
#pragma unroll
        for (int i = 0; i < 8; ++i) { const int combo = wave * 8 + i, d = (combo >> 2) * 16 + dlo, s0 = ((combo & 3) * 4 + sglo) * 8;
            float v[8];
#pragma unroll
            for (int e = 0; e < 8; ++e) v[e] = bf2f(*(const LAS bf16_t*)(KL + (s0 + e) * PQ_PITCH + d * 2)) * (__expf(AS[s0 + e] - Mlast) * MS_K);
#pragma unroll
            for (int e = 0; e < 8; ++e) v[e] = fmaxf(fminf(v[e], 448.0f), -448.0f);
            u32x2 o; o.x = pack_fp8x4(v[0], v[1], v[2], v[3]); o.y = pack_fp8x4(v[4], v[5], v[6], v[7]);
            *(GAS u32x2*)(Kg + fm8_off(d, s0, 2)) = o; }
    }
    __syncthreads();
}

__device__ __forceinline__ void hgrn_pre_load(const DArgs& a, int round, int item, u32x4 (&gq)[4]) {
    const int tid = tid_();
    const int p = item >> 7, c = item & 127, bl = p >> 3, h = p & 7;
    const int tl0 = bl * SEQ + c * 64;
    GAS unsigned char* ws = a.ws;
#pragma unroll
    for (int i = 0; i < 2; ++i) { const int idx = tid + 512 * i, s = idx >> 4, ch = idx & 15;
        gq[2 * i] = *(const GAS u32x4*)((const GAS bf16_t*)(ws + WS_GFLOG) + (size_t)(tl0 + s) * 1024 + h * 128 + ch * 8);
        gq[2 * i + 1] = *(const GAS u32x4*)((const GAS bf16_t*)(ws + WS_GQ) + (size_t)(tl0 + s) * 1024 + h * 128 + ch * 8); }
}
__device__ __forceinline__ void hgrn_pre_item(const DArgs& a, LAS unsigned char* lds, int round, int item, u32x4 (&gq)[4], int next_item) {
    const int tid = tid_(), lane = tid & 63, wave = __builtin_amdgcn_readfirstlane(tid >> 6), fr = lane & 15, fq = lane >> 4;
    const int p = item >> 7, c = item & 127, bl = p >> 3, h = p & 7;
    const int tl0 = bl * SEQ + c * 64;
    GAS unsigned char* ws = a.ws;
    LAS float* CUM = (LAS float*)lds;
    LAS float* GL = (LAS float*)(lds + 32768);
    LAS unsigned char* QH = lds + 65536;
    LAS unsigned char* KE = lds + 65536 + 64 * PS_PITCH;
    LAS float* QF = (LAS float*)(lds + 65536 + 128 * PS_PITCH);
#pragma unroll
    for (int i = 0; i < 2; ++i) { const int idx = tid + 512 * i, s = idx >> 4, ch = idx & 15;
        const u32x4 gv = gq[2 * i], qv = gq[2 * i + 1];
        LAS float* gd = GL + s * 128 + ch * 8; LAS float* qd = QF + s * 128 + ch * 8;
        gd[0] = bf_lo(gv.x); gd[1] = bf_hi(gv.x); gd[2] = bf_lo(gv.y); gd[3] = bf_hi(gv.y); gd[4] = bf_lo(gv.z); gd[5] = bf_hi(gv.z); gd[6] = bf_lo(gv.w); gd[7] = bf_hi(gv.w);
        qd[0] = bf_lo(qv.x); qd[1] = bf_hi(qv.x); qd[2] = bf_lo(qv.y); qd[3] = bf_hi(qv.y); qd[4] = bf_lo(qv.z); qd[5] = bf_hi(qv.z); qd[6] = bf_lo(qv.w); qd[7] = bf_hi(qv.w); }
    if (next_item < 2048) hgrn_pre_load(a, round, next_item, gq);
    LDS_BAR();
    {
        const int d = tid & 127, qt = tid >> 7; float cs = 0.f;
#pragma unroll 4
        for (int s = 0; s < 16; ++s) { cs += GL[(qt * 16 + s) * 128 + d]; CUM[(qt * 16 + s) * 128 + d] = cs; }
        LDS_BAR();
        float off = 0.f;
#pragma unroll
        for (int q = 0; q < 3; ++q) off += (q < qt) ? CUM[(q * 16 + 15) * 128 + d] : 0.f;
        LDS_BAR();
#pragma unroll 4
        for (int s = 0; s < 16; ++s) CUM[(qt * 16 + s) * 128 + d] += off;
        if (qt == 3) ((GAS float*)(ws + WS_HGDEC))[(size_t)item * 128 + d] = __expf(cs + off);
    }
    LDS_BAR();
    {
        GAS unsigned char* Qg = ws + WS_QTG + (size_t)item * 8192;
#pragma unroll
        for (int i = 0; i < 2; ++i) { const int idx = tid + 512 * i, s = idx >> 4, ch = idx & 15;
            float qt[8], qh[8], ke[8];
#pragma unroll
            for (int e = 0; e < 8; ++e) { const int d = ch * 8 + e; const float cm = CUM[s * 128 + d], last = CUM[63 * 128 + d], q = QF[s * 128 + d], g = GL[s * 128 + d];
                qt[e] = q * __expf(cm); qh[e] = q * __expf(cm - last); ke[e] = (1.0f - __expf(g)) * __expf(last - cm); }
            { u32x2 o8;
#pragma unroll
              for (int e = 0; e < 8; ++e) qt[e] = fmaxf(fminf(qt[e] * 16.0f, 448.0f), -448.0f);
              o8.x = pack_fp8x4(qt[0], qt[1], qt[2], qt[3]); o8.y = pack_fp8x4(qt[4], qt[5], qt[6], qt[7]);
              *(GAS u32x2*)(Qg + fm8_off(s, ch * 8, 2)) = o8; }
            u32x4 o;
            o.x = pk2(qh[0], qh[1]); o.y = pk2(qh[2], qh[3]); o.z = pk2(qh[4], qh[5]); o.w = pk2(qh[6], qh[7]);
            *(LAS u32x4*)(QH + s * PS_PITCH + ch * 16) = o;
            o.x = pk2(ke[0], ke[1]); o.y = pk2(ke[2], ke[3]); o.z = pk2(ke[4], ke[5]); o.w = pk2(ke[6], ke[7]);
            *(LAS u32x4*)(KE + s * PS_PITCH + ch * 16) = o; }
    }
    LDS_BAR();
    {
        GAS unsigned char* Ag = ws + WS_ATT + (size_t)item * 4096;
#pragma unroll
        for (int i = 0; i < 2; ++i) { const int tile = wave * 2 + i, tt = tile >> 2, st = tile & 3; const int t = tt * 16 + fr;
            unsigned o = 0u;
            if (st <= tt) { f32x4 acc = (f32x4){0.f, 0.f, 0.f, 0.f};
#pragma unroll
                for (int ks = 0; ks < 4; ++ks) acc = MFMA16(lfrag(KE, PS_PITCH, st * 16 + fr, ks * 32, fq), lfrag(QH, PS_PITCH, tt * 16 + fr, ks * 32, fq), acc);
                float v[4];
#pragma unroll
                for (int j = 0; j < 4; ++j) { const int s = st * 16 + 4 * fq + j; v[j] = (s <= t) ? acc[j] : 0.f; }
                o = pack_fp8x4(fmaxf(fminf(v[0] * 16.0f, 448.0f), -448.0f), fmaxf(fminf(v[1] * 16.0f, 448.0f), -448.0f), fmaxf(fminf(v[2] * 16.0f, 448.0f), -448.0f), fmaxf(fminf(v[3] * 16.0f, 448.0f), -448.0f)); }
            *(GAS unsigned*)(Ag + fm8_off(t, st * 16 + 4 * fq, 1)) = o; }
    }
    {
        GAS unsigned char* Kg = ws + WS_KENDT + (size_t)item * 8192;
        const int dlo = lane & 15, sglo = lane >> 4;
#pragma unroll
        for (int i = 0; i < 2; ++i) { const int combo = wave * 2 + i, d = (combo >> 1) * 16 + dlo, s0 = ((combo & 1) * 4 + sglo) * 8;
            unsigned v[8];
#pragma unroll
            for (int e = 0; e < 8; ++e) v[e] = *(const LAS bf16_t*)(KE + (s0 + e) * PS_PITCH + d * 2);
            u32x2 o; o.x = pack_fp8x4(bf_lo(v[0]) * 16.0f, bf_lo(v[1]) * 16.0f, bf_lo(v[2]) * 16.0f, bf_lo(v[3]) * 16.0f);
            o.y = pack_fp8x4(bf_lo(v[4]) * 16.0f, bf_lo(v[5]) * 16.0f, bf_lo(v[6]) * 16.0f, bf_lo(v[7]) * 16.0f);
            *(GAS u32x2*)(Kg + fm8_off(d, s0, 1)) = o; }
    }
    LDS_BAR();
}

template <int CTRL> __device__ __forceinline__ float dppf_(float x) { return __builtin_bit_cast(float, __builtin_amdgcn_update_dpp(0, __builtin_bit_cast(int, x), CTRL, 0xf, 0xf, true)); }
__device__ __forceinline__ void hgrn_pre_wave(const DArgs& a, int round, int item) {
    const int lane = tid_() & 63, fr = lane & 15, fq = lane >> 4;
    const int p = item >> 7, c = item & 127, bl = p >> 3, h = p & 7;
    const int tl0 = bl * SEQ + c * 64;
    GAS unsigned char* ws = a.ws;
    const size_t eoff = (size_t)(tl0 + fr) * 1024 + h * 128 + fq * 8;
    const GAS bf16_t* gsrc = (const GAS bf16_t*)(ws + WS_GFLOG) + eoff;
    const GAS bf16_t* qsrc = (const GAS bf16_t*)(ws + WS_GQ) + eoff;
    GAS unsigned char* Qg = ws + WS_QTG + (size_t)item * 8192;
    GAS unsigned char* Ag = ws + WS_ATT + (size_t)item * 4096;
    GAS unsigned char* Kg = ws + WS_KENDT + (size_t)item * 8192;
    u32x4 rg[4], rq[4];
#pragma unroll
    for (int tt = 0; tt < 4; ++tt) { rg[tt] = *(const GAS u32x4*)(gsrc + (size_t)tt * 16 * 1024); rq[tt] = *(const GAS u32x4*)(qsrc + (size_t)tt * 16 * 1024); }
    bf16x8 sel[2];
#pragma unroll
    for (int ds = 0; ds < 2; ++ds)
#pragma unroll
        for (int e = 0; e < 8; ++e) sel[ds][e] = (8 * fq + e == fr + 16 * ds) ? (short)0x3f80 : (short)0;
    f32x4 acc[10];
#pragma unroll
    for (int i = 0; i < 10; ++i) acc[i] = (f32x4){0.f, 0.f, 0.f, 0.f};
    u32x2 hold[4];
#pragma unroll
    for (int tt = 0; tt < 4; ++tt) hold[tt] = (u32x2){0u, 0u};
#pragma unroll 1
    for (int i = 0; i < 4; ++i) {
        u32x4 QHw[4], KEw[4]; u32x2 o8[4];
#pragma unroll
        for (int hh = 0; hh < 2; ++hh) {
            float g[4][4], q[4][4], eg[4][4];
#pragma unroll
            for (int tt = 0; tt < 4; ++tt) { const unsigned g0 = hh ? rg[tt].z : rg[tt].x, g1 = hh ? rg[tt].w : rg[tt].y, q0 = hh ? rq[tt].z : rq[tt].x, q1 = hh ? rq[tt].w : rq[tt].y;
                g[tt][0] = bf_lo(g0); g[tt][1] = bf_hi(g0); g[tt][2] = bf_lo(g1); g[tt][3] = bf_hi(g1); q[tt][0] = bf_lo(q0); q[tt][1] = bf_hi(q0); q[tt][2] = bf_lo(q1); q[tt][3] = bf_hi(q1); }
            if (hh == 1 && i < 3) {
                __builtin_amdgcn_sched_barrier(0);
#pragma unroll
                for (int tt = 0; tt < 4; ++tt) { rg[tt] = *(const GAS u32x4*)(gsrc + (size_t)tt * 16 * 1024 + 32 * (i + 1)); rq[tt] = *(const GAS u32x4*)(qsrc + (size_t)tt * 16 * 1024 + 32 * (i + 1)); }
                __builtin_amdgcn_sched_barrier(0);
            }
            float last[4];
#pragma unroll
            for (int e = 0; e < 4; ++e) {
#pragma unroll
                for (int tt = 0; tt < 4; ++tt) { float x = g[tt][e]; eg[tt][e] = 1.0f - __expf(x);
                    x += dppf_<0x111>(x); x += dppf_<0x112>(x); x += dppf_<0x114>(x); x += dppf_<0x118>(x); g[tt][e] = x; }
                float tot = dppf_<0x15f>(g[0][e]);
                g[1][e] += tot; tot = dppf_<0x15f>(g[1][e]); g[2][e] += tot; tot = dppf_<0x15f>(g[2][e]); g[3][e] += tot; last[e] = dppf_<0x15f>(g[3][e]);
            }
            if (fr == 0) *(GAS f32x4*)((GAS float*)(ws + WS_HGDEC) + (size_t)item * 128 + 32 * i + 8 * fq + 4 * hh) = (f32x4){__expf(last[0]), __expf(last[1]), __expf(last[2]), __expf(last[3])};
#pragma unroll
            for (int tt = 0; tt < 4; ++tt) {
                float qt[4], qh[4], ke[4];
#pragma unroll
                for (int e = 0; e < 4; ++e) { const float cm = g[tt][e], qq = q[tt][e];
                    qt[e] = fmaxf(fminf(qq * __expf(cm) * 16.0f, 448.0f), -448.0f); qh[e] = qq * __expf(cm - last[e]); ke[e] = eg[tt][e] * __expf(last[e] - cm); }
                const unsigned f8 = pack_fp8x4(qt[0], qt[1], qt[2], qt[3]), h0 = pk2(qh[0], qh[1]), h1 = pk2(qh[2], qh[3]), k0 = pk2(ke[0], ke[1]), k1 = pk2(ke[2], ke[3]);
                if (hh == 0) { o8[tt].x = f8; QHw[tt].x = h0; QHw[tt].y = h1; KEw[tt].x = k0; KEw[tt].y = k1; }
                else { o8[tt].y = f8; QHw[tt].z = h0; QHw[tt].w = h1; KEw[tt].z = k0; KEw[tt].w = k1; }
            }
        }
        bf16x8 QH[4], KE[4];
#pragma unroll
        for (int tt = 0; tt < 4; ++tt) { QH[tt] = __builtin_bit_cast(bf16x8, QHw[tt]); KE[tt] = __builtin_bit_cast(bf16x8, KEw[tt]);
            if (i & 1) { u32x4 w; w.x = hold[tt].x; w.y = hold[tt].y; w.z = o8[tt].x; w.w = o8[tt].y; *(GAS u32x4*)(Qg + (tt * 2 + (i >> 1)) * 1024 + lane * 16) = w; }
            else hold[tt] = o8[tt]; }
#pragma unroll
        for (int tt = 0; tt < 4; ++tt)
#pragma unroll
            for (int st = 0; st <= tt; ++st) acc[tt * (tt + 1) / 2 + st] = MFMA16(KE[st], QH[tt], acc[tt * (tt + 1) / 2 + st]);
        __builtin_amdgcn_sched_barrier(0);
#pragma unroll
        for (int st = 0; st < 4; ++st)
#pragma unroll
            for (int ds = 0; ds < 2; ++ds) { const f32x4 r = MFMA16(KE[st], sel[ds], ((f32x4){0.f, 0.f, 0.f, 0.f}));
                *(GAS unsigned*)(Kg + fm8_off(32 * i + 16 * ds + fr, 16 * st + 4 * fq, 1)) = pack_fp8x4(r[0] * 16.0f, r[1] * 16.0f, r[2] * 16.0f, r[3] * 16.0f); }
    }
#pragma unroll
    for (int tt = 0; tt < 4; ++tt)
#pragma unroll
        for (int st = 0; st < 4; ++st) { const int t = tt * 16 + fr; unsigned o = 0u;
            if (st <= tt) { const f32x4 r = acc[tt * (tt + 1) / 2 + (st <= tt ? st : 0)]; float v[4];
#pragma unroll
                for (int j = 0; j < 4; ++j) { const int s_ = st * 16 + 4 * fq + j; v[j] = (s_ <= t) ? r[j] : 0.f; }
                o = pack_fp8x4(fmaxf(fminf(v[0] * 16.0f, 448.0f), -448.0f), fmaxf(fminf(v[1] * 16.0f, 448.0f), -448.0f), fmaxf(fminf(v[2] * 16.0f, 448.0f), -448.0f), fmaxf(fminf(v[3] * 16.0f, 448.0f), -448.0f)); }
            *(GAS unsigned*)(Ag + fm8_off(t, st * 16 + 4 * fq, 1)) = o; }
}

template <int NVT, bool DEN>
__device__ __forceinline__ void mlstm_scan(const DArgs& a, LAS unsigned char* lds, int round, int p, int sl) {
    const int tid = tid_(), lane = tid & 63, wave = __builtin_amdgcn_readfirstlane(tid >> 6), fr = lane & 15, fq = lane >> 4;
    const int bl = p >> 2, h = p & 3, b = round * 2 + bl;
    GAS unsigned char* ws = a.ws;
    constexpr int VTB = NVT * 16 * PS_PITCH, CTB = NVT * 16 * PQ_PITCH;
    LAS unsigned char* VT = lds; LAS unsigned char* CT = lds + 2 * VTB; LAS float* DEC = (LAS float*)(lds + 2 * VTB + 2 * CTB);
    for (int i = tid; i < (2 * VTB + 2 * CTB) / 4; i += NTHR) ((LAS unsigned*)lds)[i] = 0u;
    if (tid < 64) DEC[tid] = ((const GAS float*)(ws + WS_MDEC))[p * 64 + tid];
    __syncthreads();
    if (DEN) { if (tid < 256) { const int bufi = tid >> 7, s = tid & 127; *(LAS bf16_t*)(VT + bufi * VTB + s * 2) = (bf16_t)0x3F80; } }
    f32x4 st[2][NVT];
#pragma unroll
    for (int dt = 0; dt < 2; ++dt)
#pragma unroll
        for (int vt = 0; vt < NVT; ++vt) st[dt][vt] = (f32x4){0.f, 0.f, 0.f, 0.f};
    const int vcol = h * 512 + sl * 32;
    const int vs = tid >> 2, vpart = tid & 3;
    const GAS unsigned char* Sg0 = ws + WS_S + (size_t)(p * 64) * 16384 + wave * 2048 + lane * 16;
    const GAS unsigned char* Qg0 = ws + WS_QT + (size_t)(p * 64) * 32768 + wave * 4096 + lane * 16;
    const GAS unsigned char* Kg0 = ws + WS_KWT + (size_t)(p * 64) * 32768 + wave * 4096 + lane * 16;
    const GAS bf16_t* Vg0 = (const GAS bf16_t*)(ws + WS_V) + (size_t)(bl * SEQ + vs) * 2048 + vcol + vpart * 8;
    u32x4 rS[2], rQ[4], rK[2][2]; u32x4 vreg = (u32x4){0u, 0u, 0u, 0u};
#define V_STAGE(cc_) do { LAS unsigned char* d0_ = VT + ((cc_) & 1) * VTB + (vpart * 8) * PS_PITCH + vs * 2; \
        *(LAS bf16_t*)(d0_ + 0 * PS_PITCH) = (bf16_t)(vreg.x & 0xffffu); *(LAS bf16_t*)(d0_ + 1 * PS_PITCH) = (bf16_t)(vreg.x >> 16); \
        *(LAS bf16_t*)(d0_ + 2 * PS_PITCH) = (bf16_t)(vreg.y & 0xffffu); *(LAS bf16_t*)(d0_ + 3 * PS_PITCH) = (bf16_t)(vreg.y >> 16); \
        *(LAS bf16_t*)(d0_ + 4 * PS_PITCH) = (bf16_t)(vreg.z & 0xffffu); *(LAS bf16_t*)(d0_ + 5 * PS_PITCH) = (bf16_t)(vreg.z >> 16); \
        *(LAS bf16_t*)(d0_ + 6 * PS_PITCH) = (bf16_t)(vreg.w & 0xffffu); *(LAS bf16_t*)(d0_ + 7 * PS_PITCH) = (bf16_t)(vreg.w >> 16); } while (0)
    if (!DEN) { vreg = *(const GAS u32x4*)Vg0; V_STAGE(0); }
    __builtin_amdgcn_sched_barrier(0);
#pragma unroll
    for (int kp = 0; kp < 2; ++kp)
#pragma unroll
        for (int dt = 0; dt < 2; ++dt) rK[dt][kp] = *(const GAS u32x4*)(Kg0 + (dt * 2 + kp) * 1024);
    __builtin_amdgcn_sched_barrier(0);
#pragma unroll
    for (int kp = 0; kp < 2; ++kp) rS[kp] = *(const GAS u32x4*)(Sg0 + kp * 1024);
    __builtin_amdgcn_sched_barrier(0);
#pragma unroll
    for (int kp = 0; kp < 4; ++kp) rQ[kp] = *(const GAS u32x4*)(Qg0 + kp * 1024);
    __builtin_amdgcn_sched_barrier(0);
    if (!DEN) vreg = *(const GAS u32x4*)(Vg0 + (size_t)128 * 2048);
    __builtin_amdgcn_sched_barrier(0);
    const GAS unsigned char* pfp; unsigned pfstride;
    { const int tt = (wave * 64 + lane) < 80 ? wave * 64 + lane : 79; const int idx = sl * 5 + (tt >> 4), off = (tt & 15) * 64;
      pfp = (idx < 16 ? ws + WS_S + (size_t)(p * 64) * 16384 + idx * 1024 : idx < 48 ? ws + WS_QT + (size_t)(p * 64) * 32768 + (idx - 16) * 1024 : ws + WS_KWT + (size_t)(p * 64) * 32768 + (idx - 48) * 1024) + off;
      pfstride = idx < 16 ? 16384u : 32768u; }
    unsigned pfv = 0u;
#pragma unroll 1
    for (int c = 0; c < 64; ++c) {
        const int tl0 = bl * SEQ + c * 128; const size_t tg0 = (size_t)b * SEQ + c * 128;
        const int cn = c < 63 ? c + 1 : 63, cn2 = c < 62 ? c + 2 : 63;
        LAS unsigned char* vt_ = VT + (c & 1) * VTB; LAS unsigned char* ct_ = CT + (c & 1) * CTB; LAS unsigned char* ctn = CT + ((c + 1) & 1) * CTB;
        LDS_BAR();
        if (!DEN && wave < 2) { asm volatile("" :: "v"(pfv)); const int c3 = c < 60 ? c + 3 : 63; pfv = *(const GAS unsigned*)(pfp + (size_t)c3 * pfstride); }
        bf16x8 vf[NVT][4], cf[NVT][4];
        const float dec = DEC[c];
#pragma unroll
        for (int ks = 0; ks < 4; ++ks)
#pragma unroll
            for (int vt = 0; vt < NVT; ++vt) vf[vt][ks] = lfrag(vt_, PS_PITCH, vt * 16 + fr, ks * 32, fq);
        __builtin_amdgcn_sched_barrier(0);
#pragma unroll
        for (int dt = 0; dt < 2; ++dt)
#pragma unroll
            for (int vt = 0; vt < NVT; ++vt) st[dt][vt] = st[dt][vt] * dec;
#pragma unroll
        for (int ks = 0; ks < 4; ++ks) {
#pragma unroll
            for (int vt = 0; vt < NVT; ++vt) cf[vt][ks] = lfrag(ct_, PQ_PITCH, vt * 16 + fr, ks * 32, fq);
#pragma unroll
            for (int dt = 0; dt < 2; ++dt) {
                const bf16x8 aK = (ks & 1) ? fp8_frag(rK[dt][ks >> 1].z, rK[dt][ks >> 1].w, 1.0f / MS_K) : fp8_frag(rK[dt][ks >> 1].x, rK[dt][ks >> 1].y, 1.0f / MS_K);
#pragma unroll
                for (int vt = 0; vt < NVT; ++vt) st[dt][vt] = MFMA16(aK, vf[vt][ks], st[dt][vt]);
                if (ks & 1) rK[dt][ks >> 1] = *(const GAS u32x4*)(Kg0 + (size_t)cn * 32768 + (dt * 2 + (ks >> 1)) * 1024);
            }
            __builtin_amdgcn_sched_barrier(0);
        }
#pragma unroll
        for (int dt = 0; dt < 2; ++dt)
#pragma unroll
            for (int vt = 0; vt < NVT; ++vt) { const f32x4 sp = st[dt][vt]; u32x2 o; o.x = pk2(sp[0], sp[1]); o.y = pk2(sp[2], sp[3]);
                *(LAS u32x2*)(ctn + (vt * 16 + fr) * PQ_PITCH + (wave * 32 + dt * 16 + 4 * fq) * 2) = o; }
        __builtin_amdgcn_sched_barrier(0);
        f32x4 acc[NVT];
#pragma unroll
        for (int vt = 0; vt < NVT; ++vt) acc[vt] = (f32x4){0.f, 0.f, 0.f, 0.f};
#pragma unroll
        for (int ks = 0; ks < 4; ++ks) {
            { const bf16x8 bS = (ks & 1) ? fp8_frag(rS[ks >> 1].z, rS[ks >> 1].w, 1.0f / MS_SQ) : fp8_frag(rS[ks >> 1].x, rS[ks >> 1].y, 1.0f / MS_SQ);
#pragma unroll
              for (int vt = 0; vt < NVT; ++vt) acc[vt] = MFMA16(vf[vt][ks], bS, acc[vt]); }
            if (ks & 1) rS[ks >> 1] = *(const GAS u32x4*)(Sg0 + (size_t)cn * 16384 + (ks >> 1) * 1024);
            __builtin_amdgcn_sched_barrier(0);
        }
#pragma unroll
        for (int ks = 0; ks < 8; ++ks) {
            { const bf16x8 bQ = (ks & 1) ? fp8_frag(rQ[ks >> 1].z, rQ[ks >> 1].w, 1.0f / MS_SQ) : fp8_frag(rQ[ks >> 1].x, rQ[ks >> 1].y, 1.0f / MS_SQ);
#pragma unroll
              for (int vt = 0; vt < NVT; ++vt) acc[vt] = MFMA16(cf[vt][ks & 3], bQ, acc[vt]); }
            if (ks < 4) {
#pragma unroll
                for (int vt = 0; vt < NVT; ++vt) cf[vt][ks] = lfrag(ct_, PQ_PITCH, vt * 16 + fr, 128 + ks * 32, fq);
            }
            if (ks & 1) rQ[ks >> 1] = *(const GAS u32x4*)(Qg0 + (size_t)cn * 32768 + (ks >> 1) * 1024);
            __builtin_amdgcn_sched_barrier(0);
        }
        const int t = wave * 16 + fr;
        if (!DEN) {
            GAS bf16_t* hn = (GAS bf16_t*)(ws + WS_QKPRE) + (size_t)(tl0 + t) * 2048 + vcol + 4 * fq;
#pragma unroll
            for (int vt = 0; vt < NVT; ++vt) { const f32x4 av = acc[vt]; u32x2 o; o.x = pk2(av[0], av[1]); o.y = pk2(av[2], av[3]); *(GAS u32x2*)(hn + vt * 16) = o; }
            V_STAGE(c + 1); vreg = *(const GAS u32x4*)(Vg0 + (size_t)cn2 * 128 * 2048);
        } else {
            if (fq == 0) ((GAS float*)(ws + WS_DEN))[(tg0 + t) * 4 + h] = acc[0][0];
        }
    }
    asm volatile("" :: "v"(pfv));
    __syncthreads();
#undef V_STAGE
}

constexpr int HG_PD = 4;
constexpr float HS = 16.0f;
__device__ __forceinline__ void hgrn_scan(const DArgs& a, LAS unsigned char* lds, int round, int p, int sl) {
    const int tid = tid_(), lane = tid & 63, wave = __builtin_amdgcn_readfirstlane(tid >> 6), fr = lane & 15, fq = lane >> 4;
    const int bl = p >> 3, h = p & 7;
    GAS unsigned char* ws = a.ws;
    constexpr int IP = 144, ITB = 32 * IP, STB = 32 * PS_PITCH;
    LAS unsigned char* IT = lds; LAS unsigned char* ST = lds + 2 * ITB;
    for (int i = tid; i < (2 * ITB + 2 * STB) / 4; i += NTHR) ((LAS unsigned*)lds)[i] = 0u;
    __syncthreads();
    f32x4 st[2][2];
#pragma unroll
    for (int i = 0; i < 2; ++i) { st[i][0] = (f32x4){0.f, 0.f, 0.f, 0.f}; st[i][1] = st[i][0]; }
    const int vcol = h * 128 + sl * 32;
    const int is = (tid & 255) >> 2, ipart = tid & 3;
    const bool outw = wave < 4;
    const int w4 = wave & 3;
    const GAS unsigned char* Ag0 = ws + WS_ATT + (size_t)(p * 128) * 4096 + w4 * 1024 + lane * 16;
    const GAS unsigned char* Qg0 = ws + WS_QTG + (size_t)(p * 128) * 8192 + w4 * 2048 + lane * 16;
    const GAS unsigned char* Kg0 = ws + WS_KENDT + (size_t)(p * 128) * 8192 + w4 * 2048 + lane * 16;
    const GAS unsigned char* Dg0 = ws + WS_HGDEC + ((size_t)(p * 128) * 128 + w4 * 32 + 4 * fq) * 4;
    const GAS unsigned char* Ig0 = ws + WS_GI + ((size_t)(bl * SEQ + is) * 1024 + vcol + ipart * 8) * 2;
    const GAS unsigned char* gb0 = outw ? Ag0 : Kg0;          const unsigned gs0 = outw ? 4096u : 8192u;
    const GAS unsigned char* gb1 = outw ? Qg0 : Kg0 + 1024;   const unsigned gs1 = 8192u;
    const GAS unsigned char* gb2 = outw ? Qg0 + 1024 : Dg0;   const unsigned gs2 = outw ? 8192u : 512u;
    const GAS unsigned char* gb3 = outw ? Ig0 : Dg0 + 64;     const unsigned gs3 = outw ? 131072u : 512u;
    u32x4 pf[HG_PD][4];
#define HG_LD(k_, j_, cc_) do { pf[k_][j_] = *(const GAS u32x4*)(((j_) == 0 ? gb0 : (j_) == 1 ? gb1 : (j_) == 2 ? gb2 : gb3) + (size_t)(cc_) * ((j_) == 0 ? gs0 : (j_) == 1 ? gs1 : (j_) == 2 ? gs2 : gs3)); } while (0)
#define HG_C3(cc_) (outw ? ((cc_) + 1 < 128 ? (cc_) + 1 : 127) : (cc_))
#pragma unroll
    for (int k = 0; k < HG_PD; ++k) { HG_LD(k, 0, k); HG_LD(k, 1, k); HG_LD(k, 2, k); HG_LD(k, 3, HG_C3(k)); __builtin_amdgcn_sched_barrier(0); }
    const GAS unsigned char* pfp; unsigned pfstride;
    { const int tt = (wave * 64 + lane) < 80 ? wave * 64 + lane : 79; const int idx = sl * 5 + (tt >> 4), off = (tt & 15) * 64;
      pfp = (idx < 4 ? ws + WS_ATT + (size_t)(p * 128) * 4096 + idx * 1024 : idx < 12 ? ws + WS_QTG + (size_t)(p * 128) * 8192 + (idx - 4) * 1024 : ws + WS_KENDT + (size_t)(p * 128) * 8192 + (idx - 12) * 1024) + off;
      pfstride = idx < 4 ? 4096u : 8192u; }
    unsigned pfv[HG_PD];
#pragma unroll
    for (int k = 0; k < HG_PD; ++k) pfv[k] = 0u;
#define HG_STAGE(dst_, iv_) do { LAS unsigned char* d0_ = (dst_) + (ipart * 8) * IP + is * 2; \
        *(LAS bf16_t*)(d0_ + 0 * IP) = (bf16_t)((iv_).x & 0xffffu); *(LAS bf16_t*)(d0_ + 1 * IP) = (bf16_t)((iv_).x >> 16); \
        *(LAS bf16_t*)(d0_ + 2 * IP) = (bf16_t)((iv_).y & 0xffffu); *(LAS bf16_t*)(d0_ + 3 * IP) = (bf16_t)((iv_).y >> 16); \
        *(LAS bf16_t*)(d0_ + 4 * IP) = (bf16_t)((iv_).z & 0xffffu); *(LAS bf16_t*)(d0_ + 5 * IP) = (bf16_t)((iv_).z >> 16); \
        *(LAS bf16_t*)(d0_ + 6 * IP) = (bf16_t)((iv_).w & 0xffffu); *(LAS bf16_t*)(d0_ + 7 * IP) = (bf16_t)((iv_).w >> 16); } while (0)
#define HG_F(reg_, half_) ((half_) ? fp8_frag((reg_).z, (reg_).w, 1.0f / HS) : fp8_frag((reg_).x, (reg_).y, 1.0f / HS))
    if (outw) { const u32x4 iv = *(const GAS u32x4*)Ig0; HG_STAGE(IT, iv); }
#pragma unroll 1
    for (int c0 = 0; c0 < 128; c0 += HG_PD) {
#pragma unroll
      for (int k = 0; k < HG_PD; ++k) {
        const int c = c0 + k;
        const int tl0 = bl * SEQ + c * 64;
        const int cn = (c + HG_PD < 128) ? c + HG_PD : 127;
        LAS unsigned char* it_ = IT + (k & 1) * ITB; LAS unsigned char* itn = IT + ((k + 1) & 1) * ITB; LAS unsigned char* st_ = ST + (k & 1) * STB; LAS unsigned char* stn = ST + ((k + 1) & 1) * STB;
        LDS_BAR();
        if (wave < 2) { asm volatile("" :: "v"(pfv[k])); const int c7 = (c + HG_PD + 3 < 128) ? c + HG_PD + 3 : 127; pfv[k] = *(const GAS unsigned*)(pfp + (size_t)c7 * pfstride); }
        bf16x8 itf[2][2];
#pragma unroll
        for (int vt = 0; vt < 2; ++vt)
#pragma unroll
            for (int ks = 0; ks < 2; ++ks) itf[vt][ks] = lfrag(it_, IP, vt * 16 + fr, ks * 32, fq);
        bf16x8 sf[2][4];
        f32x4 acc[2];
        acc[0] = (f32x4){0.f, 0.f, 0.f, 0.f}; acc[1] = acc[0];
        if (outw) {
#pragma unroll
            for (int vt = 0; vt < 2; ++vt)
#pragma unroll
                for (int ks = 0; ks < 4; ++ks) sf[vt][ks] = lfrag(st_, PS_PITCH, vt * 16 + fr, ks * 32, fq);
#pragma unroll
            for (int ks = 0; ks < 2; ++ks) { const bf16x8 bA = HG_F(pf[k][0], ks);
#pragma unroll
                for (int vt = 0; vt < 2; ++vt) acc[vt] = MFMA16(itf[vt][ks], bA, acc[vt]); }
        } else {
            const f32x4 dec = __builtin_bit_cast(f32x4, pf[k][2]);
#pragma unroll
            for (int vt = 0; vt < 2; ++vt) st[0][vt] = st[0][vt] * dec;
#pragma unroll
            for (int ks = 0; ks < 2; ++ks) { const bf16x8 aK = HG_F(pf[k][0], ks);
#pragma unroll
                for (int vt = 0; vt < 2; ++vt) st[0][vt] = MFMA16(aK, itf[vt][ks], st[0][vt]); }
        }
        __builtin_amdgcn_sched_barrier(0);
        HG_LD(k, 0, cn);
        __builtin_amdgcn_sched_barrier(0);
        if (outw) {
#pragma unroll
            for (int ks = 0; ks < 2; ++ks) { const bf16x8 bQ = HG_F(pf[k][1], ks);
#pragma unroll
                for (int vt = 0; vt < 2; ++vt) acc[vt] = MFMA16(sf[vt][ks], bQ, acc[vt]); }
        } else {
            const f32x4 dec = __builtin_bit_cast(f32x4, pf[k][3]);
#pragma unroll
            for (int vt = 0; vt < 2; ++vt) st[1][vt] = st[1][vt] * dec;
#pragma unroll
            for (int ks = 0; ks < 2; ++ks) { const bf16x8 aK = HG_F(pf[k][1], ks);
#pragma unroll
                for (int vt = 0; vt < 2; ++vt) st[1][vt] = MFMA16(aK, itf[vt][ks], st[1][vt]); }
        }
        __builtin_amdgcn_sched_barrier(0);
        HG_LD(k, 1, cn);
        __builtin_amdgcn_sched_barrier(0);
        if (outw) {
#pragma unroll
            for (int ks = 2; ks < 4; ++ks) { const bf16x8 bQ = HG_F(pf[k][2], ks & 1);
#pragma unroll
                for (int vt = 0; vt < 2; ++vt) acc[vt] = MFMA16(sf[vt][ks], bQ, acc[vt]); }
        } else {
#pragma unroll
            for (int dtile = 0; dtile < 2; ++dtile)
#pragma unroll
                for (int vt = 0; vt < 2; ++vt) { const f32x4 sp = st[dtile][vt]; u32x2 o; o.x = pk2(sp[0], sp[1]); o.y = pk2(sp[2], sp[3]);
                    *(LAS u32x2*)(stn + (vt * 16 + fr) * PS_PITCH + (w4 * 32 + dtile * 16 + 4 * fq) * 2) = o; }
        }
        __builtin_amdgcn_sched_barrier(0);
        HG_LD(k, 2, cn);
        __builtin_amdgcn_sched_barrier(0);
        if (outw) {
            HG_STAGE(itn, pf[k][3]);
            GAS bf16_t* og = (GAS bf16_t*)(ws + WS_GQ) + (size_t)(tl0 + w4 * 16 + fr) * 1024 + vcol + 4 * fq;
#pragma unroll
            for (int vt = 0; vt < 2; ++vt) { const f32x4 av = acc[vt]; u32x2 o; o.x = pk2(av[0], av[1]); o.y = pk2(av[2], av[3]); *(GAS u32x2*)(og + vt * 16) = o; }
        }
        __builtin_amdgcn_sched_barrier(0);
        HG_LD(k, 3, HG_C3(cn));
        __builtin_amdgcn_sched_barrier(0);
      }
    }
#pragma unroll
    for (int k = 0; k < HG_PD; ++k) asm volatile("" :: "v"(pfv[k]));
    __syncthreads();
#undef HG_LD
#undef HG_C3
#undef HG_F
#undef HG_STAGE
}

__device__ __forceinline__ void xn8_convert(const DArgs& a, int round, int vcu, int G) {
    const int tid = tid_(), lane = tid & 63, wave = tid >> 6;
    const int gw = vcu * NWAVES + wave, NGW = G * NWAVES;
    GAS unsigned char* ws = a.ws;
    for (int tl = gw; tl < RT; tl += NGW) {
        const size_t tg = (size_t)round * RT + tl;
        const GAS u32x2* xr = (const GAS u32x2*)((const GAS bf16_t*)(ws + WS_XN) + tg * D) + lane;
        f32x4 v[4]; float mx = 0.f;
#pragma unroll
        for (int j = 0; j < 4; ++j) { const u32x2 xv = xr[64 * j]; v[j][0] = bf_lo(xv.x); v[j][1] = bf_hi(xv.x); v[j][2] = bf_lo(xv.y); v[j][3] = bf_hi(xv.y);
            mx = fmaxf(mx, fmaxf(fmaxf(fabsf(v[j][0]), fabsf(v[j][1])), fmaxf(fabsf(v[j][2]), fabsf(v[j][3])))); }
        mx = wave_max(mx);
        const float qs = mx > 0.f ? 127.0f / mx : 0.f;
#pragma unroll
        for (int j = 0; j < 4; ++j) ((GAS unsigned*)(ws + WS_XN8 + (size_t)tl * 1024))[64 * j + lane] = pack_i8x4(v[j][0] * qs, v[j][1] * qs, v[j][2] * qs, v[j][3] * qs);
        if (lane == 0) ((GAS float*)(ws + WS_SA8))[tg] = mx * (1.0f / 127.0f);
    }
}

__device__ __forceinline__ void phase_ypass(const DArgs& a, int round, int vcu, int G) {
    const int tid = tid_(), lane = tid & 63, wave = tid >> 6;
    const int gw = vcu * NWAVES + wave, NGW = G * NWAVES;
    GAS unsigned char* ws = a.ws;
    f32x4 mg0[4], mg1[4], gg4[4];
#pragma unroll
    for (int j = 0; j < 4; ++j) { mg0[j] = *(const GAS f32x4*)(a.m_head_g + j * 512 + lane * 8); mg1[j] = *(const GAS f32x4*)(a.m_head_g + j * 512 + lane * 8 + 4); gg4[j] = *(const GAS f32x4*)(a.g_head_g + lane * 16 + 4 * j); }
    f32x4 pden, pmt; u32x4 pnv[4], pn0, pn1, ps0, ps1; u32x2 pov[4];
#define YP_LOAD(tl_) do { const int t_ = (tl_); const size_t tg_ = (size_t)round * RT + t_; \
        pden = *(const GAS f32x4*)((const GAS float*)(ws + WS_DEN) + tg_ * 4); pmt = *(const GAS f32x4*)((const GAS float*)(ws + WS_MT) + tg_ * 4); \
        _Pragma("unroll") for (int j = 0; j < 4; ++j) { pnv[j] = *(const GAS u32x4*)((const GAS bf16_t*)(ws + WS_QKPRE) + (size_t)t_ * 2048 + j * 512 + lane * 8); pov[j] = *(const GAS u32x2*)(ws + WS_SIGO + (size_t)t_ * 2048 + j * 512 + lane * 8); } \
        pn0 = *(const GAS u32x4*)((const GAS bf16_t*)(ws + WS_GQ) + (size_t)t_ * 1024 + lane * 16); pn1 = *(const GAS u32x4*)((const GAS bf16_t*)(ws + WS_GQ) + (size_t)t_ * 1024 + lane * 16 + 8); \
        ps0 = *(const GAS u32x4*)((const GAS bf16_t*)(ws + WS_SGG) + (size_t)t_ * 1024 + lane * 16); ps1 = *(const GAS u32x4*)((const GAS bf16_t*)(ws + WS_SGG) + (size_t)t_ * 1024 + lane * 16 + 8); } while (0)
    if (gw < RT) YP_LOAD(gw);
    for (int tl = gw; tl < RT; tl += NGW) {
        const f32x4 den4 = pden, mt4 = pmt;
        u32x4 cnv[4]; u32x2 cov[4];
#pragma unroll
        for (int j = 0; j < 4; ++j) { cnv[j] = pnv[j]; cov[j] = pov[j]; }
        const u32x4 n0 = pn0, n1 = pn1, s0 = ps0, s1 = ps1;
        __builtin_amdgcn_sched_barrier(0);
        { const int tn = tl + NGW; YP_LOAD(tn < RT ? tn : tl); }
        __builtin_amdgcn_sched_barrier(0);
        float ym[4][8];
#pragma unroll
        for (int j = 0; j < 4; ++j) {
            const u32x4 nv = cnv[j]; const u32x2 ov = cov[j];
            const float inv = 1.0f / fmaxf(fabsf(den4[j]), __expf(-mt4[j]));
            float hv[8] = {bf_lo(nv.x) * inv, bf_hi(nv.x) * inv, bf_lo(nv.y) * inv, bf_hi(nv.y) * inv, bf_lo(nv.z) * inv, bf_hi(nv.z) * inv, bf_lo(nv.w) * inv, bf_hi(nv.w) * inv};
            float ss = 0.f;
#pragma unroll
            for (int e = 0; e < 8; ++e) ss += hv[e] * hv[e];
            const float r = rsqrtf(wave_sum(ss, lane) * (1.f / 512.f) + EPS);
            const f32x4 g0 = mg0[j], g1 = mg1[j];
            const float og[8] = {u8f(ov.x, 0), u8f(ov.x, 1), u8f(ov.x, 2), u8f(ov.x, 3), u8f(ov.y, 0), u8f(ov.y, 1), u8f(ov.y, 2), u8f(ov.y, 3)};
#pragma unroll
            for (int e = 0; e < 8; ++e) ym[j][e] = og[e] * hv[e] * r * (e < 4 ? g0[e] : g1[e - 4]);
        }
        {
            float mx = 0.f;
#pragma unroll
            for (int j = 0; j < 4; ++j)
#pragma unroll
                for (int e = 0; e < 8; ++e) mx = fmaxf(mx, fabsf(ym[j][e]));
            mx = wave_max(mx);
            const float qs = mx > 0.f ? 127.0f / mx : 0.f;
#pragma unroll
            for (int j = 0; j < 4; ++j) { u32x2 o; o.x = pack_i8x4(ym[j][0] * qs, ym[j][1] * qs, ym[j][2] * qs, ym[j][3] * qs); o.y = pack_i8x4(ym[j][4] * qs, ym[j][5] * qs, ym[j][6] * qs, ym[j][7] * qs);
                *(GAS u32x2*)(ws + WS_V + (size_t)tl * 2048 + j * 512 + lane * 8) = o; }
            if (lane == 0) ((GAS float*)(ws + WS_SYM))[tl] = mx * (1.0f / 127.0f);
        }
        {
            const int col = lane * 16;
            float ov[16] = {bf_lo(n0.x), bf_hi(n0.x), bf_lo(n0.y), bf_hi(n0.y), bf_lo(n0.z), bf_hi(n0.z), bf_lo(n0.w), bf_hi(n0.w), bf_lo(n1.x), bf_hi(n1.x), bf_lo(n1.y), bf_hi(n1.y), bf_lo(n1.z), bf_hi(n1.z), bf_lo(n1.w), bf_hi(n1.w)};
            const float sg[16] = {bf_lo(s0.x), bf_hi(s0.x), bf_lo(s0.y), bf_hi(s0.y), bf_lo(s0.z), bf_hi(s0.z), bf_lo(s0.w), bf_hi(s0.w), bf_lo(s1.x), bf_hi(s1.x), bf_lo(s1.y), bf_hi(s1.y), bf_lo(s1.z), bf_hi(s1.z), bf_lo(s1.w), bf_hi(s1.w)};
            float ss = 0.f;
#pragma unroll
            for (int e = 0; e < 16; ++e) ss += ov[e] * ov[e];
            ss += DPP_(ss, 0xB1); ss += DPP_(ss, 0x4E); ss += DPP_(ss, 0x141);
            const float r = rsqrtf(ss * (1.f / 128.f) + EPS);
            float y[16];
#pragma unroll
            for (int e = 0; e < 16; ++e) y[e] = ov[e] * r * gg4[e >> 2][e & 3] * sg[e];
            float mx = 0.f;
#pragma unroll
            for (int e = 0; e < 16; ++e) mx = fmaxf(mx, fabsf(y[e]));
            mx = wave_max(mx);
            const float qs = mx > 0.f ? 127.0f / mx : 0.f;
            u32x4 o; o.x = pack_i8x4(y[0] * qs, y[1] * qs, y[2] * qs, y[3] * qs); o.y = pack_i8x4(y[4] * qs, y[5] * qs, y[6] * qs, y[7] * qs);
            o.z = pack_i8x4(y[8] * qs, y[9] * qs, y[10] * qs, y[11] * qs); o.w = pack_i8x4(y[12] * qs, y[13] * qs, y[14] * qs, y[15] * qs);
            *(GAS u32x4*)(ws + WS_GI + (size_t)tl * 1024 + col) = o;
            if (lane == 0) ((GAS float*)(ws + WS_SYG))[tl] = mx * (1.0f / 127.0f);
        }
    }
#undef YP_LOAD
}


#define XB_TMO      128
#define XB_XCNT(j)  (256  + 64 * (j))
#define XB_XSUB(j)  (1280 + 64 * (j))
#define XB_XGEN(j)  (2304 + 64 * (j))
#define XB_TOP      3328
#define XB_TOPGEN   3392
#define XB_SPIN_CAP (1u << 22)
constexpr int CW_BAR = 4096;
constexpr int LDS_BARST = LDS_BYTES - 64;
__device__ __forceinline__ unsigned xb_ld(unsigned* p)              { return __hip_atomic_load(p, __ATOMIC_RELAXED, __HIP_MEMORY_SCOPE_AGENT); }
__device__ __forceinline__ unsigned xb_add(unsigned* p, unsigned v) { return __hip_atomic_fetch_add(p, v, __ATOMIC_RELAXED, __HIP_MEMORY_SCOPE_AGENT); }
__device__ __forceinline__ unsigned xb_xcc_id() { return (unsigned)__builtin_amdgcn_s_getreg((3 << 11) | 20) & 0xFu; }
#define XB_SPIN(cond, bar) do { unsigned _sp = 0; while (cond) { __builtin_amdgcn_s_sleep(1); \
    if ((++_sp & 255u) == 0u) { if (xb_ld(&(bar)[XB_TMO])) break; if (_sp > XB_SPIN_CAP) { atomicAdd(&(bar)[XB_TMO], 1u); break; } } } } while (0)
__device__ __forceinline__ void xcd_barrier_post(unsigned* bar, volatile LAS unsigned* st) { if (tid_() == 0) st[2] = xb_add(&bar[XB_XCNT(xb_xcc_id())], 1u); }
__device__ __forceinline__ void xcd_barrier_complete(unsigned* bar, unsigned x, unsigned& nloc, unsigned& nx) {
    const unsigned G = gridDim.x;
    unsigned sum, cnt, mine, sp = 0u;
    for (;;) {
        sum = 0u; cnt = 0u; mine = 0u;
#pragma unroll
        for (unsigned j = 0; j < 16; ++j) { const unsigned c = xb_ld(&bar[XB_XCNT(j)]); sum += c; cnt += (c > 0u) ? 1u : 0u; mine = (j == x) ? c : mine; }
        if (sum == G) break;
        __builtin_amdgcn_s_sleep(1);
        if ((++sp & 255u) == 0u) { if (xb_ld(&bar[XB_TMO])) break; if (sp > XB_SPIN_CAP) { atomicAdd(&bar[XB_TMO], 1u); break; } }
    }
    nloc = mine > 0u ? mine : 1u; nx = cnt > 0u ? cnt : 1u;
}
__device__ __forceinline__ void xcd_barrier(unsigned* bar, volatile LAS unsigned* st) {
    asm volatile("s_waitcnt vmcnt(0)" ::: "memory");
    __syncthreads();
    if (tid_() == 0) {
        const unsigned x = xb_xcc_id();
        __builtin_amdgcn_s_waitcnt(0);
        unsigned nloc = st[0], nx = st[1];
        if (nloc == 0u) { xcd_barrier_complete(bar, x, nloc, nx); st[0] = nloc; st[1] = nx; }
        const unsigned old = xb_add(&bar[XB_XSUB(x)], 1u);
        const unsigned gen = old / nloc;
        if (old + 1u == (gen + 1u) * nloc) {
            __builtin_amdgcn_fence(__ATOMIC_RELEASE, "agent");
            asm volatile("s_waitcnt vmcnt(0)" ::: "memory");
            const unsigned og = xb_add(&bar[XB_TOP], 1u);
            const unsigned tg = og / nx;
            if (og + 1u == (tg + 1u) * nx) xb_add(&bar[XB_TOPGEN], 1u);
            else XB_SPIN(xb_ld(&bar[XB_TOPGEN]) == tg, bar);
            __builtin_amdgcn_fence(__ATOMIC_ACQUIRE, "agent");
            xb_add(&bar[XB_XGEN(x)], 1u);
            asm volatile("s_waitcnt vmcnt(0)" ::: "memory");
        } else {
            XB_SPIN(xb_ld(&bar[XB_XGEN(x)]) == gen, bar);
            __builtin_amdgcn_fence(__ATOMIC_ACQUIRE, "agent");
            asm volatile("s_waitcnt vmcnt(0)" ::: "memory");
        }
    }
    __syncthreads();
}

__device__ __forceinline__ void phase_p8(const DArgs& a, int vcu, int G) {
    const int tid = tid_(), lane = tid & 63, wave = tid >> 6;
    const int gw = vcu * NWAVES + wave, NGW = G * NWAVES;
    GAS unsigned char* ws = a.ws;
    f32x4 g2[4];
#pragma unroll
    for (int j = 0; j < 4; ++j) g2[j] = ((const f32x4*)a.norm2_g)[64 * j + lane];
    u32x2 pxr[4];
    if (gw < T) {
#pragma unroll
        for (int j = 0; j < 4; ++j) pxr[j] = ((const GAS u32x2*)((const GAS bf16_t*)a.out + (size_t)gw * D) + lane)[64 * j]; }
    for (int m = gw; m < T; m += NGW) {
        u32x2 cxr[4];
#pragma unroll
        for (int j = 0; j < 4; ++j) cxr[j] = pxr[j];
        __builtin_amdgcn_sched_barrier(0);
        { const int mn = (m + NGW < T) ? m + NGW : m; const GAS u32x2* xn = (const GAS u32x2*)((const GAS bf16_t*)a.out + (size_t)mn * D) + lane;
#pragma unroll
          for (int j = 0; j < 4; ++j) pxr[j] = xn[64 * j]; }
        __builtin_amdgcn_sched_barrier(0);
        f32x4 v[4]; float s = 0.f;
#pragma unroll
        for (int j = 0; j < 4; ++j) { const u32x2 xv = cxr[j]; v[j][0] = bf_lo(xv.x); v[j][1] = bf_hi(xv.x); v[j][2] = bf_lo(xv.y); v[j][3] = bf_hi(xv.y); s += (v[j][0] * v[j][0] + v[j][1] * v[j][1]) + (v[j][2] * v[j][2] + v[j][3] * v[j][3]); }
        const float rstd = rsqrtf(wave_sum(s, lane) * (1.f / D) + EPS);
#pragma unroll
        for (int j = 0; j < 4; ++j) v[j] = v[j] * rstd * g2[j];
        float mx = 0.f;
#pragma unroll
        for (int j = 0; j < 4; ++j) mx = fmaxf(mx, fmaxf(fmaxf(fabsf(v[j][0]), fabsf(v[j][1])), fmaxf(fabsf(v[j][2]), fabsf(v[j][3]))));
        mx = wave_max(mx);
        const float qs = mx > 0.f ? 127.0f / mx : 0.f;
#pragma unroll
        for (int j = 0; j < 4; ++j) ((GAS unsigned*)(ws + WS_XQ + (size_t)m * 1024))[64 * j + lane] = pack_i8x4(v[j][0] * qs, v[j][1] * qs, v[j][2] * qs, v[j][3] * qs);
        if (lane == 0) ((GAS float*)(ws + WS_XQS))[m] = mx * (1.0f / 127.0f);
    }
    f32x4 puv[4], pvv[4];
    if (gw < 16384) {
#pragma unroll
        for (int j = 0; j < 4; ++j) { puv[j] = ((const GAS f32x4*)(a.u_emb + (size_t)gw * 1024))[64 * j + lane]; pvv[j] = ((const GAS f32x4*)(a.v_emb + (size_t)gw * 1024))[64 * j + lane]; } }
    for (int e = gw; e < 16384; e += NGW) {
        f32x4 uv[4], vv[4]; float mu = 0.f, mv = 0.f;
#pragma unroll
        for (int j = 0; j < 4; ++j) { uv[j] = puv[j]; vv[j] = pvv[j]; }
        __builtin_amdgcn_sched_barrier(0);
        { const int en = (e + NGW < 16384) ? e + NGW : e;
#pragma unroll
          for (int j = 0; j < 4; ++j) { puv[j] = ((const GAS f32x4*)(a.u_emb + (size_t)en * 1024))[64 * j + lane]; pvv[j] = ((const GAS f32x4*)(a.v_emb + (size_t)en * 1024))[64 * j + lane]; } }
        __builtin_amdgcn_sched_barrier(0);
#pragma unroll
        for (int j = 0; j < 4; ++j) {
            mu = fmaxf(mu, fmaxf(fmaxf(fabsf(uv[j][0]), fabsf(uv[j][1])), fmaxf(fabsf(uv[j][2]), fabsf(uv[j][3]))));
            mv = fmaxf(mv, fmaxf(fmaxf(fabsf(vv[j][0]), fabsf(vv[j][1])), fmaxf(fabsf(vv[j][2]), fabsf(vv[j][3])))); }
        mu = wave_max(mu); mv = wave_max(mv);
        const float su = mu > 0.f ? 127.0f / mu : 0.f, sv = mv > 0.f ? 448.0f / mv : 0.f;
        if (lane == 0) { ((GAS float*)(ws + WS_USC))[e] = mu * (1.0f / 127.0f); ((GAS float*)(ws + WS_VSC))[e] = mv * (1.0f / 448.0f); }
#pragma unroll
        for (int j = 0; j < 4; ++j) {
            const size_t ob = (size_t)(2 * j + (lane >> 5)) * 2097152 + (size_t)e * 128 + ((4 * lane) & 127);
            *(GAS unsigned*)(ws + WS_UB + ob) = pack_i8x4(uv[j][0] * su, uv[j][1] * su, uv[j][2] * su, uv[j][3] * su);
            int p = __builtin_amdgcn_cvt_pk_fp8_f32(vv[j][0] * sv, vv[j][1] * sv, 0, false); p = __builtin_amdgcn_cvt_pk_fp8_f32(vv[j][2] * sv, vv[j][3] * sv, p, true);
            *(GAS unsigned*)(ws + WS_VB + ob) = (unsigned)p; }
    }
}

__device__ __forceinline__ unsigned f2ord(float f) { const unsigned u = __builtin_bit_cast(unsigned, f); return (u & 0x80000000u) ? ~u : (u | 0x80000000u); }
__device__ __forceinline__ float ord2f(unsigned k) { const unsigned u = (k & 0x80000000u) ? (k & 0x7fffffffu) : ~k; return __builtin_bit_cast(float, u); }
__device__ __forceinline__ unsigned umax_(unsigned a, unsigned b) { return a > b ? a : b; }
__device__ __forceinline__ unsigned shxu(unsigned v, int o, int lane) { return (unsigned)__builtin_amdgcn_ds_bpermute((lane ^ o) << 2, (int)v); }

__device__ __forceinline__ unsigned umin_(unsigned a, unsigned b) { return a < b ? a : b; }
#define TK_CE(a_, b_) do { const unsigned hi_ = umax_((a_), (b_)), lo_ = umin_((a_), (b_)); (a_) = hi_; (b_) = lo_; } while (0)
__device__ __forceinline__ void tk_sort16(unsigned (&x)[32], int o) {
#pragma unroll
    for (int k = 2; k <= 16; k <<= 1)
#pragma unroll
        for (int j = k >> 1; j > 0; j >>= 1)
#pragma unroll
            for (int i = 0; i < 16; ++i) { const int l = i ^ j; if (l > i) { if ((i & k) == 0) TK_CE(x[o + i], x[o + l]); else TK_CE(x[o + l], x[o + i]); } }
}
__device__ __forceinline__ void tk_merge16(unsigned (&t)[16]) {
#pragma unroll
    for (int j = 8; j > 0; j >>= 1)
#pragma unroll
        for (int i = 0; i < 16; ++i) { const int l = i ^ j; if (l > i) TK_CE(t[i], t[l]); }
}
__device__ __forceinline__ void phase_topk(const DArgs& a, LAS unsigned char* lds, int bx, int G) {
    const int tid = tid_(), lane = tid & 63, wave = __builtin_amdgcn_readfirstlane(tid >> 6), fr = lane & 15, fq = lane >> 4;
    GAS unsigned char* ws = a.ws;
    const int h = bx & 7;
    LAS unsigned char* KY = lds;
    LAS unsigned char* QL = lds + 2 * 128 * PS_PITCH;
    LAS unsigned* TOP = (LAS unsigned*)(lds + 2 * 128 * PS_PITCH + 64 * PQ_PITCH);
#pragma unroll
    for (int i = 0; i < 8; ++i) { const int idx = tid + 512 * i, row = idx >> 4, ch = idx & 15;
        *(LAS u32x4*)(KY + row * PS_PITCH + ch * 16) = *(const u32x4*)((const bf16_t*)(ws + WS_SK) + ((size_t)h * 256 + row) * 128 + ch * 8); }
    const int ntile = T / 64;
    u32x4 qpre[4];
    { const int tile0 = bx >> 3; if (tile0 < ntile) {
#pragma unroll
        for (int i = 0; i < 4; ++i) { const int idx = tid + 512 * i, row = idx >> 5, ch = idx & 31;
            qpre[i] = *(const GAS u32x4*)((const GAS bf16_t*)(ws + WS_QP) + ((size_t)tile0 * 64 + row) * 2048 + h * 256 + ch * 8); } } }
    __syncthreads();
    for (int tile = bx >> 3; tile < ntile; tile += (G >> 3)) {
        const size_t t0 = (size_t)tile * 64;
        LDS_BAR();
#pragma unroll
        for (int i = 0; i < 4; ++i) { const int idx = tid + 512 * i, row = idx >> 5, ch = idx & 31;
            *(LAS u32x4*)(QL + row * PQ_PITCH + ch * 16) = qpre[i]; }
        { const int tn = tile + (G >> 3); if (tn < ntile) {
#pragma unroll
            for (int i = 0; i < 4; ++i) { const int idx = tid + 512 * i, row = idx >> 5, ch = idx & 31;
                qpre[i] = *(const GAS u32x4*)((const GAS bf16_t*)(ws + WS_QP) + ((size_t)tn * 64 + row) * 2048 + h * 256 + ch * 8); } } }
        LDS_BAR();
        {
            const int mt = wave & 3, p = wave >> 2;
            unsigned key[32];
#pragma unroll
            for (int nt = 0; nt < 8; ++nt) { f32x4 acc = (f32x4){0.f, 0.f, 0.f, 0.f};
#pragma unroll
                for (int ks = 0; ks < 4; ++ks) acc = MFMA16(lfrag(KY + p * 128 * PS_PITCH, PS_PITCH, nt * 16 + fr, ks * 32, fq), lfrag(QL, PQ_PITCH, mt * 16 + fr, p * 128 + ks * 32, fq), acc);
#pragma unroll
                for (int j = 0; j < 4; ++j) { const int n = nt * 16 + 4 * fq + j; key[nt * 4 + j] = (f2ord(acc[j]) & ~127u) | (unsigned)(127 - n); } }
            tk_sort16(key, 0); tk_sort16(key, 16);
            unsigned t[16];
#pragma unroll
            for (int i = 0; i < 16; ++i) t[i] = umax_(key[i], key[31 - i]);
            tk_merge16(t);
            {   unsigned pv[16];
#pragma unroll
                for (int i = 0; i < 16; ++i) pv[i] = (unsigned)SWZI_(t[15 - i], 0x401F);
#pragma unroll
                for (int i = 0; i < 16; ++i) t[i] = umax_(t[i], pv[i]);
                tk_merge16(t);
#pragma unroll
                for (int i = 0; i < 16; ++i) pv[i] = xor32u_(t[15 - i], lane >= 32);
#pragma unroll
                for (int i = 0; i < 16; ++i) t[i] = umax_(t[i], pv[i]);
                tk_merge16(t); }
#pragma unroll
            for (int k = 0; k < 16; ++k) { if (fq == (k & 3)) TOP[(p * 64 + mt * 16 + fr) * 16 + k] = t[k]; }
        }
        LDS_BAR();
        {
            const int t = tid >> 3, sub = tid & 7;
            unsigned ck[7];
#pragma unroll
            for (int e = 0; e < 7; ++e) {
                const int ci = sub + 8 * e;
                int i = 0, base = 0; bool ok = ci < 50;
                if (ci >= 42) { i = 8 + (ci - 42); base = ci; } else if (ci >= 40) { i = 7; base = 40; } else if (ci >= 38) { i = 6; base = 38; } else if (ci >= 36) { i = 5; base = 36; }
                else if (ci >= 33) { i = 4; base = 33; } else if (ci >= 29) { i = 3; base = 29; } else if (ci >= 24) { i = 2; base = 24; } else if (ci >= 16) { i = 1; base = 16; }
                const int j = ci - base;
                unsigned kk = 0u;
                if (ok) { const float s0 = ord2f(TOP[(0 * 64 + t) * 16 + i] & ~127u), s1 = ord2f(TOP[(1 * 64 + t) * 16 + j] & ~127u);
                    kk = (f2ord(s0 + s1) & ~255u) | (unsigned)(255 - (i * 16 + j)); }
                ck[e] = kk;
            }
            unsigned x[16];
#pragma unroll
            for (int e = 0; e < 7; ++e) x[e] = ck[e];
            x[7] = 0u;
#pragma unroll
            for (int k = 2; k <= 8; k <<= 1)
#pragma unroll
                for (int j = k >> 1; j > 0; j >>= 1)
#pragma unroll
                    for (int i = 0; i < 8; ++i) { const int l = i ^ j; if (l > i) { if ((i & k) == 0) TK_CE(x[i], x[l]); else TK_CE(x[l], x[i]); } }
#pragma unroll
            for (int i = 0; i < 8; ++i) x[8 + i] = (unsigned)DPPI_(x[7 - i], 0xB1);
            tk_merge16(x);
            {   unsigned pv[16];
#pragma unroll
                for (int i = 0; i < 16; ++i) pv[i] = (unsigned)DPPI_(x[15 - i], 0x4E);
#pragma unroll
                for (int i = 0; i < 16; ++i) x[i] = umax_(x[i], pv[i]);
                tk_merge16(x);
#pragma unroll
                for (int i = 0; i < 16; ++i) pv[i] = (unsigned)DPPI_(x[15 - i], 0x141);
#pragma unroll
                for (int i = 0; i < 16; ++i) x[i] = umax_(x[i], pv[i]);
                tk_merge16(x); }
            unsigned w0 = x[0], w1 = x[8];
#pragma unroll
            for (int e = 1; e < 8; ++e) { w0 = (sub == e) ? x[e] : w0; w1 = (sub == e) ? x[8 + e] : w1; }
            const int f0 = 255 - (int)(w0 & 255u), f1 = 255 - (int)(w1 & 255u);
            const float sc0 = ord2f(w0 & ~255u), sc1 = ord2f(w1 & ~255u);
            float mx = fmaxf(sc0, sc1); mx = fmaxf(mx, DPP_(mx, 0xB1)); mx = fmaxf(mx, DPP_(mx, 0x4E)); mx = fmaxf(mx, DPP_(mx, 0x141));
            const float e0 = __expf(sc0 - mx), e1 = __expf(sc1 - mx);
            float sm = e0 + e1; sm += DPP_(sm, 0xB1); sm += DPP_(sm, 0x4E); sm += DPP_(sm, 0x141);
            const float inv = 1.0f / sm;
            const int i0 = 127 - (int)(TOP[(0 * 64 + t) * 16 + (f0 >> 4)] & 127u), j0 = 127 - (int)(TOP[(1 * 64 + t) * 16 + (f0 & 15)] & 127u);
            const int i1 = 127 - (int)(TOP[(0 * 64 + t) * 16 + (f1 >> 4)] & 127u), j1 = 127 - (int)(TOP[(1 * 64 + t) * 16 + (f1 & 15)] & 127u);
            unsigned short* ei = (unsigned short*)(ws + WS_EIDX) + ((t0 + t) * 8 + h) * 16; float* gp = (float*)(ws + WS_GATE) + ((t0 + t) * 8 + h) * 16;
            ei[sub] = (unsigned short)(i0 * 128 + j0); ei[sub + 8] = (unsigned short)(i1 * 128 + j1); gp[sub] = e0 * inv; gp[sub + 8] = e1 * inv;
        }
    }
    __syncthreads();
}

__device__ __forceinline__ void ins16(float (&v)[16], int (&id)[16], float x, int n) {
    if (x > v[15]) { v[15] = x; id[15] = n;
#pragma unroll
        for (int i = 15; i >= 1; --i) { if (v[i] > v[i - 1]) { const float tv = v[i]; v[i] = v[i - 1]; v[i - 1] = tv; const int ti = id[i]; id[i] = id[i - 1]; id[i - 1] = ti; } } }
}
__device__ __forceinline__ void phase_topk_ref(const DArgs& a, int vcu, int G) {
    const int tid = tid_();
    GAS unsigned char* ws = a.ws;
    const int gt = vcu * NTHR + tid, NGT = G * NTHR;
    for (int pair = gt; pair < T * 8; pair += NGT) {
        const int t = pair >> 3, h = pair & 7;
        float sv[2][16]; int si[2][16];
#pragma unroll
        for (int p = 0; p < 2; ++p) {
#pragma unroll
            for (int i = 0; i < 16; ++i) { sv[p][i] = -INFINITY; si[p][i] = 0; }
            const bf16_t* qp = (const bf16_t*)(ws + WS_QP) + (size_t)t * 2048 + h * 256 + p * 128;
            for (int n = 0; n < 128; ++n) {
                const bf16_t* kp = (const bf16_t*)(ws + WS_SK) + ((size_t)(h * 2 + p) * 128 + n) * 128;
                float s = 0.f;
                for (int c = 0; c < 128; c += 8) { const u32x4 qv = *(const u32x4*)(qp + c), kv = *(const u32x4*)(kp + c);
                    s += bf_lo(qv.x) * bf_lo(kv.x) + bf_hi(qv.x) * bf_hi(kv.x) + bf_lo(qv.y) * bf_lo(kv.y) + bf_hi(qv.y) * bf_hi(kv.y)
                       + bf_lo(qv.z) * bf_lo(kv.z) + bf_hi(qv.z) * bf_hi(kv.z) + bf_lo(qv.w) * bf_lo(kv.w) + bf_hi(qv.w) * bf_hi(kv.w); }
                ins16(sv[p], si[p], s, n);
            }
        }
        float tv[16]; int ti[16];
#pragma unroll
        for (int i = 0; i < 16; ++i) { tv[i] = -INFINITY; ti[i] = 0; }
#pragma unroll
        for (int i = 0; i < 16; ++i)
#pragma unroll
            for (int j = 0; j < 16; ++j) ins16(tv, ti, sv[0][i] + sv[1][j], i * 16 + j);
        float sm = 0.f, ex[16];
#pragma unroll
        for (int k = 0; k < 16; ++k) { ex[k] = __expf(tv[k] - tv[0]); sm += ex[k]; }
        int* ei = (int*)(ws + WS_EIDX) + (size_t)pair * 16; float* gp = (float*)(ws + WS_GATE) + (size_t)pair * 16;
#pragma unroll
        for (int k = 0; k < 16; ++k) {
            int e0 = 0, e1 = 0;
#pragma unroll
            for (int i = 0; i < 16; ++i) { e0 = ((ti[k] >> 4) == i) ? si[0][i] : e0; e1 = ((ti[k] & 15) == i) ? si[1][i] : e1; }
            ei[k] = e0 * 128 + e1; gp[k] = ex[k] / sm; }
    }
}

#define FP8LO(w) __builtin_amdgcn_cvt_pk_f32_fp8((int)(w), false)
#define FP8HI(w) __builtin_amdgcn_cvt_pk_f32_fp8((int)(w), true)
__device__ __forceinline__ float dot16_fp8(const u32x4 r, const float (&x)[16]) {
    float c = 0.f;
#pragma unroll
    for (int j = 0; j < 4; ++j) { const f32x2 lo = FP8LO(r[j]), hi = FP8HI(r[j]); c += lo[0] * x[4 * j] + lo[1] * x[4 * j + 1] + hi[0] * x[4 * j + 2] + hi[1] * x[4 * j + 3]; }
    return c;
}
__device__ __forceinline__ float dot16_fp8p(const u32x4 r, const f32x2 (&xp)[8]) {
    f32x2 c2 = (f32x2){0.f, 0.f};
#pragma unroll
    for (int j = 0; j < 4; ++j) { c2 += FP8LO(r[j]) * xp[2 * j]; c2 += FP8HI(r[j]) * xp[2 * j + 1]; }
    return c2[0] + c2[1];
}
__device__ __forceinline__ float gelu_erf(float d) {
    const float ad = fabsf(d), t = __builtin_amdgcn_rcpf(ad * 0.2316418882f + 1.0f);
    float q = t * 0.5307027145f + (-0.7265760135f); q = q * t + 0.7107068705f; q = q * t + (-0.142248368f); q = q * t + 0.127414796f; q = q * t;
    const float m = d * (q * __builtin_amdgcn_exp2f(d * d * (-0.72134752044f)));
    return d < 0.f ? m : d - m;
}
__device__ __forceinline__ float bperm(float v, int srclane) { return __builtin_bit_cast(float, __builtin_amdgcn_ds_bpermute(srclane << 2, __builtin_bit_cast(int, v))); }
#define SWZ_(v, pat) __builtin_bit_cast(float, __builtin_amdgcn_ds_swizzle(__builtin_bit_cast(int, (v)), (pat)))
__device__ __forceinline__ float rs32_(float a, float b) {
#if defined(__HIP_DEVICE_COMPILE__)
    asm volatile("s_nop 1\n\tv_permlane32_swap_b32 %0, %1" : "+v"(a), "+v"(b));
#endif
    return a + b;
}
__device__ __forceinline__ float rs16_(float a, float b) {
#if defined(__HIP_DEVICE_COMPILE__)
    asm volatile("s_nop 1\n\tv_permlane16_swap_b32 %0, %1" : "+v"(a), "+v"(b));
#endif
    return a + b;
}
__device__ __forceinline__ float rs8_(float a, float b, bool bit3) {
    const float send = bit3 ? a : b, keep = bit3 ? b : a;
    return keep + DPP_(send, 0x128);
}
__device__ __forceinline__ float xor32_(float v, bool hi) {
#if defined(__HIP_DEVICE_COMPILE__)
    const auto r = __builtin_amdgcn_permlane32_swap(__builtin_bit_cast(unsigned, v), __builtin_bit_cast(unsigned, v), false, false);
    return __builtin_bit_cast(float, hi ? r[0] : r[1]);
#else
    (void)hi; return v;
#endif
}
__device__ __forceinline__ float reduce8(const float (&p)[8], int lane) {
    float q4[4], q2[2];
    const bool b5 = lane & 32, b4 = lane & 16, b3 = lane & 8;
#pragma unroll
    for (int i = 0; i < 4; ++i) { const float send = b5 ? p[i] : p[i + 4], keep = b5 ? p[i + 4] : p[i]; q4[i] = keep + xor32_(send, b5); }
#pragma unroll
    for (int i = 0; i < 2; ++i) { const float send = b4 ? q4[i] : q4[i + 2], keep = b4 ? q4[i + 2] : q4[i]; q2[i] = keep + SWZ_(send, 0x401F); }
    const float send = b3 ? q2[0] : q2[1], keep = b3 ? q2[1] : q2[0];
    float q1 = keep + SWZ_(send, 0x201F);
    q1 += DPP_(q1, 0xB1); q1 += DPP_(q1, 0x4E); q1 += DPP_(q1, 0x141);
    return q1;
}
__device__ __forceinline__ void phase_udots(const DArgs& a, LAS unsigned char* lds) {
    const int tid = tid_(), lane = tid & 63, wave = __builtin_amdgcn_readfirstlane(tid >> 6);
    GAS unsigned char* ws = a.ws;
    volatile LAS unsigned* bst = (volatile LAS unsigned*)(lds + LDS_BARST);
    const int nloc = (int)bst[0], nx = (int)bst[1], rank = (int)bst[2];
    unsigned* bar = (unsigned*)(ws + WS_CTL) + CW_BAR;
    const unsigned myx = xb_xcc_id();
    int q = 0;
    for (unsigned j = 0; j < 16; ++j) { const unsigned c = xb_ld(&bar[XB_XCNT(j)]); if (c > 0u && j < myx) ++q; }
    LAS int* LE = (LAS int*)(lds + wave * 2048);
    LAS int* LP = LE + 128; LAS float* LG = (LAS float*)(LE + 256);
    const GAS unsigned char* UB = ws + WS_UB;
    const int g8 = lane >> 3;
    const float usc = ((const GAS float*)(ws + WS_USC))[0], vsc = ((const GAS float*)(ws + WS_USC))[1];
    for (int s = q; s < 8; s += nx) {
        int tok = rank * 8 + wave;
        u32x4 xq0 = (u32x4){0u, 0u, 0u, 0u}, xq1 = xq0; u32x2 e2 = (u32x2){0u, 0u}; f32x2 g2 = (f32x2){0.f, 0.f};
#define U_INFO(t_) do { xq0 = *(const u32x4*)((const GAS bf16_t*)(ws + WS_XN) + (size_t)(t_) * D + lane * 16); xq1 = *(const u32x4*)((const GAS bf16_t*)(ws + WS_XN) + (size_t)(t_) * D + lane * 16 + 8); \
        e2 = *(const u32x2*)((const GAS int*)(ws + WS_EIDX) + (size_t)(t_) * 128 + 2 * lane); g2 = *(const f32x2*)((const GAS float*)(ws + WS_GATE) + (size_t)(t_) * 128 + 2 * lane); } while (0)
        if (tok < T) U_INFO(tok);
        for (; tok < T; tok += nloc * 8) {
            const bool in0 = (int)(e2.x >> 11) == s, in1 = (int)(e2.y >> 11) == s;
            const unsigned long long m0 = __ballot(in0), m1 = __ballot(in1);
            const unsigned long long lt = (1ull << lane) - 1ull;
            const int n0 = __popcll(m0), n = n0 + __popcll(m1);
            if (in0) { const int pos = __popcll(m0 & lt); LE[pos] = (int)e2.x; LP[pos] = 2 * lane; LG[pos] = g2[0]; }
            if (in1) { const int pos = n0 + __popcll(m1 & lt); LE[pos] = (int)e2.y; LP[pos] = 2 * lane + 1; LG[pos] = g2[1]; }
            const float xf[16] = {bf_lo(xq0.x), bf_hi(xq0.x), bf_lo(xq0.y), bf_hi(xq0.y), bf_lo(xq0.z), bf_hi(xq0.z), bf_lo(xq0.w), bf_hi(xq0.w),
                                  bf_lo(xq1.x), bf_hi(xq1.x), bf_lo(xq1.y), bf_hi(xq1.y), bf_lo(xq1.z), bf_hi(xq1.z), bf_lo(xq1.w), bf_hi(xq1.w)};
            asm volatile("s_waitcnt lgkmcnt(0)" ::: "memory");
            u32x4 R0[8], R1[8], R2[8];
#define U_ISSUE(R_, g0_) do { _Pragma("unroll") for (int k = 0; k < 8; ++k) { const int slot_ = ((g0_) + k < n) ? (g0_) + k : n - 1; const int e_ = LE[slot_]; R_[k] = *(const u32x4*)(UB + (size_t)e_ * 1024 + lane * 16); } } while (0)
#define U_DOTS(R_, g0_) do { float pp_[8]; _Pragma("unroll") for (int k = 0; k < 8; ++k) pp_[k] = dot16_fp8(R_[k], xf); const float dsum_ = reduce8(pp_, lane); const int slot_ = (g0_) + g8; \
            if (slot_ < n && (lane & 7) == 0) { const float d_ = dsum_ * usc; \
                ((GAS float*)(ws + WS_PW))[(size_t)tok * 128 + LP[slot_]] = 0.5f * d_ * (1.0f + erff(d_ * 0.70710678118654752f)) * LG[slot_] * vsc; } } while (0)
            if (n > 0) U_ISSUE(R0, 0);
            if (n > 8) U_ISSUE(R1, 8);
            if (n > 16) U_ISSUE(R2, 16);
            const int tokN = tok + nloc * 8;
            if (tokN < T) U_INFO(tokN);
            if (n > 0) U_DOTS(R0, 0);
            if (n > 8) U_DOTS(R1, 8);
            if (n > 16) U_DOTS(R2, 16);
            for (int g0 = 24; g0 < n; g0 += 8) { U_ISSUE(R0, g0); U_DOTS(R0, g0); }
            asm volatile("s_waitcnt lgkmcnt(0)" ::: "memory");
        }
#undef U_INFO
#undef U_ISSUE
#undef U_DOTS
    }
}

#define EV_OFF(ev_, g_) (((g_) & 1) ? ((ev_[(g_) >> 3][((g_) >> 1) & 3] >> 9) & 0x7fff80u) : ((ev_[(g_) >> 3][((g_) >> 1) & 3] << 7) & 0x7fff80u))
struct XcdSlice { int nloc, nx, rank, q; };
__device__ __forceinline__ XcdSlice xcd_slice_setup(const DArgs& a, LAS unsigned char* lds) {
    volatile LAS unsigned* bst = (volatile LAS unsigned*)(lds + LDS_BARST);
    XcdSlice x; x.nloc = __builtin_amdgcn_readfirstlane((int)bst[0]); x.nx = __builtin_amdgcn_readfirstlane((int)bst[1]); x.rank = __builtin_amdgcn_readfirstlane((int)bst[2]);
    unsigned* bar = (unsigned*)(a.ws + WS_CTL) + CW_BAR; const unsigned myx = xb_xcc_id();
    x.q = 0; for (unsigned j = 0; j < 16; ++j) { const unsigned c = xb_ld(&bar[XB_XCNT(j)]); if (c > 0u && j < myx) ++x.q; }
    x.q = __builtin_amdgcn_readfirstlane(x.q);
    return x;
}
__device__ __forceinline__ void phase_ua(const DArgs& a, LAS unsigned char* lds) {
    const int tid = tid_(), lane = tid & 63, wave = __builtin_amdgcn_readfirstlane(tid >> 6), k = lane >> 3, c = lane & 7;
    GAS unsigned char* ws = a.ws;
    const XcdSlice X = xcd_slice_setup(a, lds);
    const int tstride = X.nloc * 8;
    for (int sl = X.q; sl < 8; sl += X.nx) {
        const GAS unsigned char* UBs = ws + WS_UB + (size_t)sl * 2097152;
        const unsigned coff = (unsigned)c * 16u;
        GAS unsigned char* PU = ws + WS_PARTU + (size_t)sl * T * 256;
        u32x4 evA[2], evB[2], RA[16], RB[16], xa, xb; float sa, sb;
#define A_TOK(t_) ((t_) < T ? (t_) : T - 1)
#define A_INFO(ev_, t_) do { const int tq_ = A_TOK(t_); _Pragma("unroll") for (int j_ = 0; j_ < 2; ++j_) ev_[j_] = *(const GAS u32x4*)(ws + WS_EIDX + (size_t)tq_ * 256 + (unsigned)(32 * k + 16 * j_)); } while (0)
#define A_ISSUE(R_, x_, s_, ev_, t_) do { const int tq_ = A_TOK(t_); _Pragma("unroll") for (int g_ = 0; g_ < 16; ++g_) R_[g_] = *(const GAS u32x4*)(UBs + (EV_OFF(ev_, g_) | coff)); \
        x_ = *(const GAS u32x4*)(ws + WS_XQ + (size_t)tq_ * 1024 + sl * 128 + coff); s_ = ((const GAS float*)(ws + WS_XQS))[tq_]; } while (0)
#define A_DOTS(R_, x_, s_, t_) do { \
        int ir0_ = 0, ir1_ = 0; \
        _Pragma("unroll") for (int gg_ = 0; gg_ < 4; ++gg_) {           \
            int d_[4]; _Pragma("unroll") for (int q_ = 0; q_ < 4; ++q_) d_[q_] = 0; \
            _Pragma("unroll") for (int j_ = 0; j_ < 4; ++j_) { _Pragma("unroll") for (int q_ = 0; q_ < 4; ++q_) d_[q_] = __builtin_amdgcn_sdot4((int)R_[4 * gg_ + q_][j_], (int)x_[j_], d_[q_], false); } \
            _Pragma("unroll") for (int q_ = 0; q_ < 4; ++q_) d_[q_] += DPPI_(d_[q_], 0xB1); \
            _Pragma("unroll") for (int q_ = 0; q_ < 4; ++q_) d_[q_] += DPPI_(d_[q_], 0x4E); \
            _Pragma("unroll") for (int q_ = 0; q_ < 4; ++q_) d_[q_] += DPPI_(d_[q_], 0x141);          \
            _Pragma("unroll") for (int q_ = 0; q_ < 4; ++q_) { if (c == ((4 * gg_ + q_) >> 1)) { if (q_ & 1) ir1_ = d_[q_]; else ir0_ = d_[q_]; } }          \
            __builtin_amdgcn_sched_barrier(0); } \
        if ((t_) < T) *(GAS unsigned*)(PU + (size_t)(t_) * 256 + (unsigned)(4 * lane)) = pk2((float)ir0_ * s_, (float)ir1_ * s_); } while (0)
        const int n0 = X.rank * 8 + wave;
        A_INFO(evA, n0); A_INFO(evB, n0 + tstride);
        __builtin_amdgcn_sched_barrier(0);
        A_ISSUE(RA, xa, sa, evA, n0);
        __builtin_amdgcn_sched_barrier(0);
#pragma unroll 1
        for (int n = n0; n < T; n += 2 * tstride) {
            A_INFO(evA, n + 2 * tstride);
            __builtin_amdgcn_sched_barrier(0);
            A_ISSUE(RB, xb, sb, evB, n + tstride);
            __builtin_amdgcn_sched_barrier(0);
            A_DOTS(RA, xa, sa, n);
            __builtin_amdgcn_sched_barrier(0);
            A_INFO(evB, n + 3 * tstride);
            __builtin_amdgcn_sched_barrier(0);
            A_ISSUE(RA, xa, sa, evA, n + 2 * tstride);
            __builtin_amdgcn_sched_barrier(0);
            A_DOTS(RB, xb, sb, n + tstride);
            __builtin_amdgcn_sched_barrier(0);
        }
#undef A_TOK
#undef A_INFO
#undef A_ISSUE
#undef A_DOTS
    }
}
__device__ __forceinline__ void phase_ua2(const DArgs& a, int vcu, int G) {
    const int tid = tid_();
    GAS unsigned char* ws = a.ws;
    const GAS float* USC = (const GAS float*)(ws + WS_USC); const GAS float* VSC = (const GAS float*)(ws + WS_VSC);
    const GAS unsigned char* PU = ws + WS_PARTU;
    const size_t N4 = (size_t)T * 128 / 4, stride = (size_t)G * NTHR;
    for (size_t i = (size_t)vcu * NTHR + tid; i < N4; i += 2 * stride) {
        const size_t i1 = (i + stride < N4) ? i + stride : i;
        u32x2 pv0[8], pv1[8];
#pragma unroll
        for (int sl = 0; sl < 8; ++sl) { pv0[sl] = ((const GAS u32x2*)(PU + (size_t)sl * T * 256))[i]; pv1[sl] = ((const GAS u32x2*)(PU + (size_t)sl * T * 256))[i1]; }
        const f32x4 gt0 = ((const GAS f32x4*)(ws + WS_GATE))[i], gt1 = ((const GAS f32x4*)(ws + WS_GATE))[i1];
        const u32x2 ep0 = ((const GAS u32x2*)(ws + WS_EIDX))[i], ep1 = ((const GAS u32x2*)(ws + WS_EIDX))[i1];
        const unsigned e0[4] = {ep0.x & 0xffffu, ep0.x >> 16, ep0.y & 0xffffu, ep0.y >> 16}, e1[4] = {ep1.x & 0xffffu, ep1.x >> 16, ep1.y & 0xffffu, ep1.y >> 16};
        float us0[4], vs0[4], us1[4], vs1[4];
#pragma unroll
        for (int e = 0; e < 4; ++e) { us0[e] = USC[e0[e]]; vs0[e] = VSC[e0[e]]; us1[e] = USC[e1[e]]; vs1[e] = VSC[e1[e]]; }
        f32x4 d0 = (f32x4){0.f, 0.f, 0.f, 0.f}, d1 = d0;
#pragma unroll
        for (int sl = 0; sl < 8; ++sl) { d0[0] += bf_lo(pv0[sl].x); d0[1] += bf_hi(pv0[sl].x); d0[2] += bf_lo(pv0[sl].y); d0[3] += bf_hi(pv0[sl].y);
                                         d1[0] += bf_lo(pv1[sl].x); d1[1] += bf_hi(pv1[sl].x); d1[2] += bf_lo(pv1[sl].y); d1[3] += bf_hi(pv1[sl].y); }
        f32x4 w0, w1;
#pragma unroll
        for (int e = 0; e < 4; ++e) { w0[e] = gelu_erf(d0[e] * us0[e]) * gt0[e] * vs0[e]; w1[e] = gelu_erf(d1[e] * us1[e]) * gt1[e] * vs1[e]; }
        u32x2 wo; wo.x = pk2(w0[0], w0[1]); wo.y = pk2(w0[2], w0[3]); ((GAS u32x2*)(ws + WS_PW))[i] = wo;
        if (i + stride < N4) { wo.x = pk2(w1[0], w1[1]); wo.y = pk2(w1[2], w1[3]); ((GAS u32x2*)(ws + WS_PW))[i1] = wo; }
    }
}
__device__ __forceinline__ void phase_vb(const DArgs& a, LAS unsigned char* lds) {
    const int tid = tid_(), lane = tid & 63, wave = __builtin_amdgcn_readfirstlane(tid >> 6), k = lane >> 3, c = lane & 7;
    GAS unsigned char* ws = a.ws;
    const XcdSlice X = xcd_slice_setup(a, lds);
    const int tstride = X.nloc * 8;
    const bool bit3 = (lane & 8) != 0;
    for (int sl = X.q; sl < 8; sl += X.nx) {
        const GAS unsigned char* VBs = ws + WS_VB + (size_t)sl * 2097152;
        const unsigned coff = (unsigned)c * 16u;
        const unsigned xoff = (unsigned)(sl * 128 + c * 16 + 2 * k) * 4u;
        u32x4 evA[2], evB[2], RA[16], RB[16], wa[2], wb[2]; unsigned xa, xb;
#define B_TOK(t_) ((t_) < T ? (t_) : T - 1)
#define B_INFO(ev_, t_) do { const int tq_ = B_TOK(t_); _Pragma("unroll") for (int j_ = 0; j_ < 2; ++j_) ev_[j_] = *(const GAS u32x4*)(ws + WS_EIDX + (size_t)tq_ * 256 + (unsigned)(32 * k + 16 * j_)); } while (0)
#define B_ISSUE(R_, w_, x_, ev_, t_) do { const int tq_ = B_TOK(t_); _Pragma("unroll") for (int g_ = 0; g_ < 16; ++g_) R_[g_] = *(const GAS u32x4*)(VBs + (EV_OFF(ev_, g_) | coff)); \
        _Pragma("unroll") for (int j_ = 0; j_ < 2; ++j_) w_[j_] = *(const GAS u32x4*)(ws + WS_PW + (size_t)tq_ * 256 + (unsigned)(32 * k + 16 * j_)); \
        x_ = *(const GAS unsigned*)((const GAS unsigned char*)a.out + (size_t)tq_ * (D * 2) + (xoff >> 1)); } while (0)
#define B_DOTS(R_, w_, x_, t_) do { \
        f32x2 acc2_[8]; _Pragma("unroll") for (int e_ = 0; e_ < 8; ++e_) acc2_[e_] = (f32x2){0.f, 0.f}; \
        _Pragma("unroll") for (int g_ = 0; g_ < 16; ++g_) { const unsigned ww_ = w_[g_ >> 3][(g_ >> 1) & 3]; const float wk_ = (g_ & 1) ? bf_hi(ww_) : bf_lo(ww_); const f32x2 wp_ = (f32x2){wk_, wk_}; \
            _Pragma("unroll") for (int jj_ = 0; jj_ < 4; ++jj_) { acc2_[2 * jj_] += wp_ * FP8LO(R_[g_][jj_]); acc2_[2 * jj_ + 1] += wp_ * FP8HI(R_[g_][jj_]); } \
            if (g_ & 1) __builtin_amdgcn_sched_barrier(0); } \
        f32x2 w2_[4], x2_[2], y_; \
        _Pragma("unroll") for (int i_ = 0; i_ < 4; ++i_) { w2_[i_][0] = rs32_(acc2_[i_][0], acc2_[i_ + 4][0]); w2_[i_][1] = rs32_(acc2_[i_][1], acc2_[i_ + 4][1]); } \
        _Pragma("unroll") for (int i_ = 0; i_ < 2; ++i_) { x2_[i_][0] = rs16_(w2_[i_][0], w2_[i_ + 2][0]); x2_[i_][1] = rs16_(w2_[i_][1], w2_[i_ + 2][1]); } \
        y_[0] = rs8_(x2_[0][0], x2_[1][0], bit3) + bf_lo(x_); y_[1] = rs8_(x2_[0][1], x2_[1][1], bit3) + bf_hi(x_); \
        const float ss_ = wave_sum(y_[0] * y_[0] + y_[1] * y_[1], lane); \
        if ((t_) < T) { *(GAS unsigned*)(ws + WS_PARTU + (size_t)(t_) * (D * 2) + (xoff >> 1)) = pk2(y_[0], y_[1]);       \
            if (lane == 0) ((GAS float*)(ws + WS_SS))[(size_t)(t_) * 8 + sl] = ss_; } } while (0)
        const int n0 = X.rank * 8 + wave;
        B_INFO(evA, n0); B_INFO(evB, n0 + tstride);
        __builtin_amdgcn_sched_barrier(0);
        B_ISSUE(RA, wa, xa, evA, n0);
        __builtin_amdgcn_sched_barrier(0);
#pragma unroll 1
        for (int n = n0; n < T; n += 2 * tstride) {
            B_INFO(evA, n + 2 * tstride);
            __builtin_amdgcn_sched_barrier(0);
            B_ISSUE(RB, wb, xb, evB, n + tstride);
            __builtin_amdgcn_sched_barrier(0);
            B_DOTS(RA, wa, xa, n);
            __builtin_amdgcn_sched_barrier(0);
            B_INFO(evB, n + 3 * tstride);
            __builtin_amdgcn_sched_barrier(0);
            B_ISSUE(RA, wa, xa, evA, n + 2 * tstride);
            __builtin_amdgcn_sched_barrier(0);
            B_DOTS(RB, wb, xb, n + tstride);
            __builtin_amdgcn_sched_barrier(0);
        }
#undef B_TOK
#undef B_INFO
#undef B_ISSUE
#undef B_DOTS
    }
}
__device__ __forceinline__ void phase_vc(const DArgs& a, int vcu, int G) {
    const int tid = tid_(), lane = tid & 63, wave = tid >> 6;
    const int gw = vcu * NWAVES + wave, NGW = G * NWAVES;
    GAS unsigned char* ws = a.ws;
    f32x4 gf[4];
#pragma unroll
    for (int j = 0; j < 4; ++j) gf[j] = ((const GAS f32x4*)a.final_g)[64 * j + lane];
    f32x4 ps0, ps1; u32x2 pxi[4];
#define VC_LOAD(m_) do { const int t_ = (m_); ps0 = *(const GAS f32x4*)((const GAS float*)(ws + WS_SS) + (size_t)t_ * 8); ps1 = *(const GAS f32x4*)((const GAS float*)(ws + WS_SS) + (size_t)t_ * 8 + 4); \
        _Pragma("unroll") for (int j = 0; j < 4; ++j) pxi[j] = ((const GAS u32x2*)(ws + WS_PARTU + (size_t)t_ * (D * 2)) + lane)[64 * j]; } while (0)
    if (gw < T) VC_LOAD(gw);
    for (int m = gw; m < T; m += NGW) {
        const f32x4 s0 = ps0, s1 = ps1; u32x2 cxi[4];
#pragma unroll
        for (int j = 0; j < 4; ++j) cxi[j] = pxi[j];
        __builtin_amdgcn_sched_barrier(0);
        VC_LOAD((m + NGW < T) ? m + NGW : m);
        __builtin_amdgcn_sched_barrier(0);
        const float rstd = rsqrtf(((s0[0] + s0[1]) + (s0[2] + s0[3]) + (s1[0] + s1[1]) + (s1[2] + s1[3])) * (1.f / D) + EPS);
        GAS f32x4* o = (GAS f32x4*)(a.out + (size_t)m * D) + lane;
#pragma unroll
        for (int j = 0; j < 4; ++j) { const u32x2 xv = cxi[j]; f32x4 v; v[0] = bf_lo(xv.x); v[1] = bf_hi(xv.x); v[2] = bf_lo(xv.y); v[3] = bf_hi(xv.y); o[64 * j] = v * rstd * gf[j]; }
    }
}

__device__ __forceinline__ void phase_final_plain(const DArgs& a, const float* src, int vcu, int G) {
    const int tid = tid_(), lane = tid & 63, wave = tid >> 6;
    const int gw = vcu * NWAVES + wave, NGW = G * NWAVES;
    f32x4 gf[4];
#pragma unroll
    for (int j = 0; j < 4; ++j) gf[j] = ((const f32x4*)a.final_g)[64 * j + lane];
    for (int m = gw; m < T; m += NGW) {
        const f32x4* xr = (const f32x4*)(src + (size_t)m * D) + lane;
        f32x4 v[4]; float s = 0.f;
#pragma unroll
        for (int j = 0; j < 4; ++j) { v[j] = xr[64 * j]; s += (v[j][0] * v[j][0] + v[j][1] * v[j][1]) + (v[j][2] * v[j][2] + v[j][3] * v[j][3]); }
        const float rstd = rsqrtf(wave_sum(s, lane) * (1.f / D) + EPS);
        f32x4* o = (f32x4*)(a.out + (size_t)m * D) + lane;
#pragma unroll
        for (int j = 0; j < 4; ++j) o[64 * j] = v[j] * rstd * gf[j];
    }
}


__device__ __forceinline__ DArgs load_args() {
    DArgs r;
#if defined(__HIP_DEVICE_COMPILE__)
    typedef const DArgs __attribute__((address_space(4))) KArgs;
    KArgs* p = (KArgs*)__builtin_amdgcn_kernarg_segment_ptr();
    asm volatile("" : "+s"(p));
    r.x = p->x; r.norm1_g = p->norm1_g; r.w_in = p->w_in; r.b_in = p->b_in; r.conv_w = p->conv_w; r.conv_b = p->conv_b; r.m_head_g = p->m_head_g; r.lb_table = p->lb_table;
    r.g_head_g = p->g_head_g; r.w_br_m = p->w_br_m; r.w_br_g = p->w_br_g; r.w_out = p->w_out; r.norm2_g = p->norm2_g; r.w_pq = p->w_pq; r.sub_keys = p->sub_keys;
    r.u_emb = p->u_emb; r.v_emb = p->v_emb; r.final_g = p->final_g; r.out = p->out; r.ws = p->ws;
#else
    r = DArgs{};
#endif
    return r;
}
__device__ __forceinline__ EpiPtrs make_ep(const DArgs& a, int round) {
    EpiPtrs ep; ep.biasp = (const GAS float*)(a.ws + WS_BIASP); ep.lb = (const GAS float*)(a.ws + WS_LB); ep.x = a.x; ep.out = a.out; ep.ws = a.ws; ep.round = round; ep.pn0 = 0; ep.sa = (const GAS float*)(a.ws + WS_SA8); ep.sb = (const GAS float*)(a.ws + WS_SB8); ep.sym = (const GAS float*)(a.ws + WS_SYM); ep.syg = (const GAS float*)(a.ws + WS_SYG); ep.sxq = (const GAS float*)(a.ws + WS_XQS); return ep;
}
#define GRID_SYNC() do { const DArgs a_ = load_args(); xcd_barrier((unsigned*)(a_.ws + WS_CTL) + CW_BAR, (volatile LAS unsigned*)(lds + LDS_BARST)); } while (0)

__device__ __forceinline__ int bx_() { int t = blockIdx.x; asm volatile("" : "+s"(t)); return t; }
__device__ __forceinline__ int gd_() { int t = gridDim.x; asm volatile("" : "+s"(t)); return t; }
#define PH_BEGIN const DArgs a = load_args(); const int bx = bx_(), G = gd_(); const int vcu = (G % 8 == 0) ? (bx % 8) * (G / 8) + bx / 8 : bx; (void)vcu; (void)bx;

__global__ void __launch_bounds__(NTHR, 2) fwd_megakernel(Args a_unused) {
    extern __shared__ __attribute__((aligned(16))) unsigned char lds_raw[];
    LAS unsigned char* lds = (LAS unsigned char*)lds_raw;
    cg::grid_group grid = cg::this_grid();

    { const int t_ = tid_(); if (t_ < 16) ((LAS unsigned*)(lds + LDS_BARST))[t_] = 0u; __syncthreads();
      const DArgs a_ = load_args(); xcd_barrier_post((unsigned*)(a_.ws + WS_CTL) + CW_BAR, (volatile LAS unsigned*)(lds + LDS_BARST)); }
    { PH_BEGIN phase_p0(a, lds, vcu, G); }
    grid.sync();
    { PH_BEGIN if (G >= 64) { if (bx < 16) mscan_pair(a, lds, bx >> 3, bx & 7); else phase_p0c(a, lds, bx - 16, G - 16); }
               else { phase_p0c(a, lds, vcu, G); if (bx < 8) { mscan_pair(a, lds, 0, bx); mscan_pair(a, lds, 1, bx); } } }
    GRID_SYNC();
#pragma unroll 1
    for (int round = 0; round < NROUND; ++round) {
        {
            PH_BEGIN
            pg8::Gemm g{(const bf16_t*)(a.ws + WS_XN8 + (size_t)round * RT * 1024), (const bf16_t*)(a.ws + WS_W8A), RT, N1, D / 2};
            pg8::StaticOrder S; S.init(RT, N1, G, bx);
            EpiX<7> E{make_ep(a, round)};
            pg8::gemm_phase<EpiX<7>, pg8::StaticOrder, true, true, true>(lds, g, S, E);
        }
        GRID_SYNC();
        { PH_BEGIN for (int it = bx; it < 512; it += G) mlstm_pre_item(a, lds, round, it); }
        { PH_BEGIN for (int it = bx * 8 + (int)__builtin_amdgcn_readfirstlane(tid_() >> 6); it < 2048; it += G * 8) hgrn_pre_wave(a, round, it); }
        GRID_SYNC();
        { PH_BEGIN
          pg8::ExtraOrder XS{0, 0, 1, 0};
          if (bx < 128) mlstm_scan<2, false>(a, lds, round, bx & 7, bx >> 3);
          else if (bx >= 192 && bx < 200) mlstm_scan<1, true>(a, lds, round, bx - 192, 0);
          else if (bx < 192) { const int id2 = bx - 128; hgrn_scan(a, lds, round, (id2 & 7) * 2 + ((id2 >> 3) & 1), id2 >> 4);
              if (G >= 232) XS = pg8::ExtraOrder{XSPLIT, 512, 64, id2}; }
          else if (G >= 232) XS = pg8::ExtraOrder{0, XSPLIT, G - 200, bx - 200};
          if (XS.hi > XS.lo) {
              pg8::Gemm g{(const bf16_t*)(a.ws + WS_XN8 + (size_t)round * RT * 1024), (const bf16_t*)(a.ws + WS_W8), RT, 5120, D / 2};
              EpiPtrs ep = make_ep(a, round); ep.pn0 = 0; EpiX<2> E{ep};
              pg8::gemm_phase<EpiX<2>, pg8::ExtraOrder, true, true, true>(lds, g, XS, E); } }
        GRID_SYNC();
#define G2_PART(pn0_, ncol_) { PH_BEGIN \
            pg8::Gemm g{(const bf16_t*)(a.ws + WS_XN8 + (size_t)round * RT * 1024), (const bf16_t*)(a.ws + WS_W8 + (size_t)(pn0_) * 256 * 1024), RT, (ncol_), D / 2};       \
            pg8::StaticOrder S; S.init(RT, (ncol_), G, bx); \
            EpiPtrs ep = make_ep(a, round); ep.pn0 = (pn0_); EpiX<2> E{ep}; \
            pg8::gemm_phase<EpiX<2>, pg8::StaticOrder, true, true, true>(lds, g, S, E); }
        G2_PART(0, 2048)
        { const int n2 = (gd_() >= 232) ? 1024 : 2048; G2_PART(12, n2) }
        if (gd_() < 232) G2_PART(8, 1024)
#undef G2_PART
        GRID_SYNC();
        { PH_BEGIN phase_ypass(a, round, vcu, G); }
        GRID_SYNC();
        {
            { PH_BEGIN pg8::StaticOrder S; S.init(RT, D, G, bx);
              pg8::Gemm g{(const bf16_t*)(a.ws + WS_V), (const bf16_t*)(a.ws + WS_WM), RT, D, 2048 / 2}; EpiX<3> E{make_ep(a, round)}; pg8::gemm_phase<EpiX<3>, pg8::StaticOrder, true, true, true>(lds, g, S, E); }
            { PH_BEGIN pg8::StaticOrder S; S.init(RT, D, G, bx);
              pg8::Gemm g{(const bf16_t*)(a.ws + WS_GI), (const bf16_t*)(a.ws + WS_WG), RT, D, D / 2}; EpiX<4> E{make_ep(a, round)}; pg8::gemm_phase<EpiX<4>, pg8::StaticOrder, true, true, true>(lds, g, S, E); }
        }
        GRID_SYNC();
        {
            PH_BEGIN pg8::StaticOrder S; S.init(RT, D, G, bx);
            pg8::Gemm g{(const bf16_t*)(a.ws + WS_GFLOG), (const bf16_t*)(a.ws + WS_WO), RT, D, D}; EpiX<5> E{make_ep(a, round)}; pg8::gemm_phase<EpiX<5>, pg8::StaticOrder, true, true>(lds, g, S, E);
        }
        GRID_SYNC();
    }
    { PH_BEGIN phase_p8(a, vcu, G); }
    GRID_SYNC();
    {
        PH_BEGIN pg8::StaticOrder S; S.init(T, 2048, G, bx);
        pg8::Gemm g{(const bf16_t*)(a.ws + WS_XQ), (const bf16_t*)(a.ws + WS_WPQ), T, 2048, D / 2}; EpiX<6> E{make_ep(a, 0)}; pg8::gemm_phase<EpiX<6>, pg8::StaticOrder, true, true, true>(lds, g, S, E);
    }
    GRID_SYNC();
#ifdef TOPK_REF
    { PH_BEGIN phase_topk_ref(a, vcu, G); }
#else
    { PH_BEGIN phase_topk(a, lds, bx, G); }
#endif
    GRID_SYNC();
    { PH_BEGIN phase_ua(a, lds); }
    GRID_SYNC();
    { PH_BEGIN phase_ua2(a, vcu, G); }
    GRID_SYNC();
    { PH_BEGIN phase_vb(a, lds); }
    GRID_SYNC();
    { PH_BEGIN phase_vc(a, vcu, G); }
}

extern "C" void kernel_launch(void* const* d_in, const int* in_sizes, int n_in, void* d_out, int out_size, void* d_ws, size_t ws_size, hipStream_t stream) {
    static int grid = 0;
    if (grid == 0) {
        if (n_in != 18 || in_sizes[0] != T * D || out_size != T * D || ws_size < WS_END) {
            fprintf(stderr, "kernel_launch: unexpected shapes/workspace (n_in %d, in0 %d, out %d, ws %zu, need %zu)\n", n_in, n_in > 0 ? in_sizes[0] : -1, out_size, ws_size, (size_t)WS_END);
            grid = -1; return; }
        int dev = 0, cus = 0, per_cu = 0;
        hipGetDevice(&dev);
        hipDeviceGetAttribute(&cus, hipDeviceAttributeMultiprocessorCount, dev);
        hipFuncSetAttribute((const void*)fwd_megakernel, hipFuncAttributeMaxDynamicSharedMemorySize, LDS_BYTES);
        hipOccupancyMaxActiveBlocksPerMultiprocessor(&per_cu, (const void*)fwd_megakernel, NTHR, LDS_BYTES);
        if (per_cu < 1) { fprintf(stderr, "kernel_launch: occupancy query says %d blocks/CU\n", per_cu); per_cu = 1; }
        grid = cus;
        (void)hipGetLastError();
    }
    if (grid < 0) return;
    hipMemsetAsync((char*)d_ws + WS_CTL, 0, 131072, stream);
    Args a{};
    a.x = (const float*)d_in[0]; a.norm1_g = (const float*)d_in[1]; a.w_in = (const float*)d_in[2]; a.b_in = (const float*)d_in[3];
    a.conv_w = (const float*)d_in[4]; a.conv_b = (const float*)d_in[5]; a.m_head_g = (const float*)d_in[6]; a.lb_table = (const float*)d_in[7];
    a.g_head_g = (const float*)d_in[8]; a.w_br_m = (const float*)d_in[9]; a.w_br_g = (const float*)d_in[10]; a.w_out = (const float*)d_in[11];
    a.norm2_g = (const float*)d_in[12]; a.w_pq = (const float*)d_in[13]; a.sub_keys = (const float*)d_in[14]; a.u_emb = (const float*)d_in[15];
    a.v_emb = (const float*)d_in[16]; a.final_g = (const float*)d_in[17];
    a.out = (float*)d_out; a.ws = (unsigned char*)d_ws;
    void* args[] = {&a};
    hipError_t e = hipLaunchCooperativeKernel((const void*)fwd_megakernel, dim3(grid), dim3(NTHR), args, LDS_BYTES, stream);
    if (e != hipSuccess) fprintf(stderr, "cooperative launch failed: %s (grid %d)\n", hipGetErrorString(e), grid);
}
```
